# Optimizing an MI355X kernel written in HIP

```python
import math
import jax
import jax.numpy as jnp
from jax import lax
import numpy as np

D_MODEL = 4096
BATCH = 1
SEQ = 8192
DEPTH = 4

CTX_LEN = 256
GRID_W = 64
F32 = jnp.float32

A_HEADS = 20
A_HEAD_DIM = 64
A_WIDTH = A_HEADS * A_HEAD_DIM
A_DECAY_RANK = 64
A_ICLR_RANK = 64
A_GATE_RANK = 192
A_IN = 3 * A_WIDTH + A_DECAY_RANK + A_ICLR_RANK + A_GATE_RANK
GN_EPS = 64e-5
B_WIDTH = 1280
B_IN = 3 * B_WIDTH
FILTER_EMB = 33
FILTER_BANDS = (FILTER_EMB - 1) // 2
FILTER_HIDDEN = 64
MIN_DECAY = math.log(1e-2) / 1.5
MAX_DECAY = math.log(1e-2) / 0.3
C_HEADS = 12
QK_NOPE = 128
QK_ROPE = 64
QK_DIM = QK_NOPE + QK_ROPE
V_HEAD = 128
C_WIDTH = C_HEADS * V_HEAD
Q_RANK = 1024
KV_RANK = 512
C_IN = Q_RANK + KV_RANK + QK_ROPE
ROPE_THETA = 10000.0
Q_BLOCK = 128
D_MIX = A_WIDTH + B_WIDTH + C_WIDTH
N_IN = A_IN + B_IN + C_IN
FFN_HIDDEN = 6144
ADA_RANK = 256
N_MOD = 9
NORM_EPS = 1e-6

kernel_name = 'hybrid_rwkv7_hyena_mla_dit_block'


def rms_norm(x, gain):
    xf = x.astype(F32)
    xf = xf * lax.rsqrt(jnp.mean(xf * xf, axis=-1, keepdims=True) + NORM_EPS)
    return (xf * gain.astype(F32)).astype(x.dtype)


def modulate(x, gain, shift, scale):
    return rms_norm(x, gain) * (1 + scale) + shift


def swiglu(h, w_gu, w_down):
    gate, up = jnp.split(h @ w_gu, 2, axis=-1)
    return (jax.nn.silu(gate) * up) @ w_down


def short_conv3(u, w, b=None):
    up = jnp.pad(u, ((0, 0), (1, 1), (0, 0)))
    y = up[:, :-2] * w[0] + up[:, 1:-1] * w[1] + up[:, 2:] * w[2]
    return y if b is None else y + b


def heads(t, n):
    return t.reshape(t.shape[0], t.shape[1], n, -1)


def rwkv_prep(u_proj, p):
    u = short_conv3(u_proj, p['a_conv'])
    r, k, v, xw, xa, xg = jnp.split(
        u, [A_WIDTH, 2 * A_WIDTH, 3 * A_WIDTH, 3 * A_WIDTH + A_DECAY_RANK,
            3 * A_WIDTH + A_DECAY_RANK + A_ICLR_RANK], axis=-1)
    kk = heads(k * p['a_k_k'], A_HEADS).astype(F32)
    kk = kk / jnp.maximum(jnp.sqrt(jnp.sum(kk * kk, axis=-1, keepdims=True)), 1e-12)
    kk = kk.reshape(k.shape)
    dirs = []
    for d in range(2):
        logw = -jax.nn.softplus(-(p['a_w0'][d] + jnp.tanh(xw) @ p['a_w_up'][d])) - 0.5
        decay = jnp.exp(-jnp.exp(logw.astype(F32)))
        a = jax.nn.sigmoid(p['a_a0'][d] + xa @ p['a_a_up'][d])
        k_d = k * (1 + (a - 1) * p['a_k_a'])
        dirs.append((decay, a, k_d))
    g = jax.nn.sigmoid(xg) @ p['a_g_up']
    return r, v, kk, g, dirs


def wkv7_scan(state0, r, decay, k, v, kk, a, reverse):
    B, L = r.shape[0], r.shape[1]

    def tm(t):
        return jnp.moveaxis(heads(t.astype(F32), A_HEADS), 1, 0)

    def step(S, inp):
        r_t, w_t, k_t, v_t, kk_t, a_t = inp
        sa = jnp.einsum('bhvk,bhk->bhv', S, -kk_t)
        S = (S * w_t[:, :, None, :] + sa[..., None] * (kk_t * a_t)[:, :, None, :]
             + v_t[..., None] * k_t[:, :, None, :])
        return S, jnp.einsum('bhvk,bhk->bhv', S, r_t)

    xs = (tm(r), tm(decay), tm(k), tm(v), tm(kk), tm(a))
    S, ys = lax.scan(step, state0, xs, reverse=reverse)
    return S, jnp.moveaxis(ys, 0, 1).reshape(B, L, A_WIDTH)


def rwkv_out(y, r, k_mean, v, g, p):
    B, L, _ = y.shape
    yh = heads(y, A_HEADS)
    mu = jnp.mean(yh, axis=-1, keepdims=True)
    var = jnp.mean(jnp.square(yh - mu), axis=-1, keepdims=True)
    yn = ((yh - mu) * lax.rsqrt(var + GN_EPS)).reshape(B, L, A_WIDTH)
    yn = yn * p['a_ln_w'] + p['a_ln_b']
    bonus = jnp.sum(heads((r * k_mean * p['a_r_k']).astype(F32), A_HEADS), axis=-1, keepdims=True)
    bonus = (bonus * heads(v.astype(F32), A_HEADS)).reshape(B, L, A_WIDTH)
    return ((yn + bonus) * g).astype(r.dtype)


def rwkv_mixer(ux, uc, p, need_ctx):
    r_c, v_c, kk_c, g_c, dirs_c = rwkv_prep(uc, p)
    r_x, v_x, kk_x, g_x, dirs_x = rwkv_prep(ux, p)
    zeros = jnp.zeros((ux.shape[0], A_HEADS, A_HEAD_DIM, A_HEAD_DIM), F32)
    y_x, y_c = 0.0, 0.0
    for d, reverse in enumerate((False, True)):
        dec, a, k = dirs_c[d]
        S_c, yc = wkv7_scan(zeros, r_c, dec, k, v_c, kk_c, a, reverse)
        dec, a, k = dirs_x[d]
        _, yx = wkv7_scan(S_c, r_x, dec, k, v_x, kk_x, a, reverse)
        y_x = y_x + yx
        y_c = y_c + yc
    o_x = rwkv_out(y_x, r_x, 0.5 * (dirs_x[0][2] + dirs_x[1][2]), v_x, g_x, p)
    if not need_ctx:
        return o_x, None
    o_c = rwkv_out(y_c, r_c, 0.5 * (dirs_c[0][2] + dirs_c[1][2]), v_c, g_c, p)
    return o_x, o_c


def hyena_filter(L, p):
    t = jnp.linspace(0.0, 1.0, L, dtype=F32)[:, None]
    w = (2.0 * math.pi / L) * jnp.arange(L, dtype=F32)[:, None]
    f = jnp.linspace(1e-4, FILTER_BANDS - 1, FILTER_BANDS, dtype=F32)[None, :]
    z = jnp.concatenate([t, jnp.cos(f * w), -jnp.sin(f * w)], axis=-1)
    freq = p['b_freq']
    h = jnp.sin(freq * (z @ p['b_fw1'] + p['b_fb1']))
    h = jnp.sin(freq * (h @ p['b_fw2'] + p['b_fb2']))
    h = jnp.sin(freq * (h @ p['b_fw3'] + p['b_fb3']))
    h = (h @ p['b_fw4']).astype(F32)
    deltas = jnp.abs(jnp.linspace(MIN_DECAY, MAX_DECAY, B_WIDTH, dtype=F32))
    h = h * jnp.exp(-t * jnp.tile(deltas, 2)[None, :])
    h_fwd, h_bwd = h[:, :B_WIDTH], h[:L - 1, B_WIDTH:]
    taps = jnp.concatenate([h_fwd, jnp.zeros((1, B_WIDTH), F32), h_bwd[::-1]], axis=0)
    return taps / jnp.sum(jnp.abs(taps), axis=0, keepdims=True)


def hyena(u_proj, p):
    u = short_conv3(u_proj, p['b_conv'], p['b_conv_b'])
    x0, x1, v = jnp.split(u, 3, axis=-1)
    L = u.shape[1]
    g = x1 * v
    taps = hyena_filter(L, p)
    y = jnp.fft.irfft(jnp.fft.rfft(g.astype(F32), n=2 * L, axis=1) * jnp.fft.rfft(taps, axis=0)[None],
                      n=2 * L, axis=1)[:, :L]
    return x0 * (y.astype(g.dtype) + g * p['b_bias'])


def axial_rope_tables(rows):
    row = jnp.broadcast_to(jnp.arange(rows, dtype=F32)[:, None], (rows, GRID_W)).reshape(-1)
    col = jnp.broadcast_to(jnp.arange(GRID_W, dtype=F32)[None, :], (rows, GRID_W)).reshape(-1)
    half = QK_ROPE // 2
    inv = ROPE_THETA ** (-jnp.arange(0, half, 2, dtype=F32) / half)
    ang_r = row[:, None] * inv[None]
    ang_c = col[:, None] * inv[None]
    ang = jnp.concatenate([ang_r, ang_r, ang_c, ang_c], axis=-1)
    return jnp.cos(ang), jnp.sin(ang)


def rotate(t, cos, sin):
    half = QK_ROPE // 2

    def rh(u):
        u1, u2 = jnp.split(u, 2, axis=-1)
        return jnp.concatenate([-u2, u1], axis=-1)

    rot = jnp.concatenate([rh(t[..., :half]), rh(t[..., half:])], axis=-1)
    return t * cos + rot * sin


def mla_qkv(u_proj, p, rope):
    cq, ckv, kpe = jnp.split(u_proj, [Q_RANK, Q_RANK + KV_RANK], axis=-1)
    q = heads(rms_norm(cq, p['c_q_norm']) @ p['c_q_up'], C_HEADS)
    kv = heads(rms_norm(ckv, p['c_kv_norm']) @ p['c_kv_up'], C_HEADS)
    q_nope = rms_norm(q[..., :QK_NOPE], p['c_qn_nope'])
    q_pe = rms_norm(q[..., QK_NOPE:], p['c_qn_pe'])
    k_nope = rms_norm(kv[..., :QK_NOPE], p['c_kn_nope'])
    v = kv[..., QK_NOPE:]
    k_pe = rms_norm(kpe, p['c_kn_pe'])
    if rope is not None:
        cos, sin = rope
        q_pe = rotate(q_pe, cos[None, :, None], sin[None, :, None])
        k_pe = rotate(k_pe, cos[None], sin[None])
    k_pe = jnp.broadcast_to(k_pe[:, :, None], k_nope.shape[:-1] + (QK_ROPE,))
    q = jnp.concatenate([q_nope, q_pe], axis=-1)
    k = jnp.concatenate([k_nope, k_pe], axis=-1)
    return q, k, v


def attend(q, k, v):
    s = jnp.einsum('bqhd,bkhd->bhqk', q, k).astype(F32) * (1.0 / math.sqrt(QK_DIM))
    pr = jax.nn.softmax(s, axis=-1).astype(v.dtype)
    return jnp.einsum('bhqk,bkhd->bqhd', pr, v)


def latent_attention(q_x, k_all, v_all):
    B, L, H, dk = q_x.shape
    nb = L // Q_BLOCK
    qb = jnp.moveaxis(q_x.reshape(B, nb, Q_BLOCK, H, dk), 1, 0)
    ob = lax.map(lambda qi: attend(qi, k_all, v_all), qb)
    return jnp.moveaxis(ob, 0, 1).reshape(B, L, C_WIDTH)


def mixer(px, pc, p, rope, need_ctx):
    ax, bx, cx = jnp.split(px, [A_IN, A_IN + B_IN], axis=-1)
    ac, bc, cc = jnp.split(pc, [A_IN, A_IN + B_IN], axis=-1)
    oa_x, oa_c = rwkv_mixer(ax, ac, p, need_ctx)
    ob_x = hyena(bx, p)
    q_c, k_c, v_c = mla_qkv(cc, p, None)
    q_x, k_x, v_x = mla_qkv(cx, p, rope)
    oc_x = latent_attention(q_x, jnp.concatenate([k_c, k_x], axis=1), jnp.concatenate([v_c, v_x], axis=1))
    o_x = jnp.concatenate([oa_x, ob_x.astype(oa_x.dtype), oc_x.astype(oa_x.dtype)], axis=-1)
    if not need_ctx:
        return o_x, None
    oc_c = attend(q_c, k_c, v_c).reshape(pc.shape[0], pc.shape[1], C_WIDTH)
    o_c = jnp.concatenate([oa_c, hyena(bc, p).astype(oa_c.dtype), oc_c.astype(oa_c.dtype)], axis=-1)
    return o_x, o_c


def layer(x, ctx, c, c_ctx, p, rope, need_ctx):
    mod_x = (jax.nn.silu(c) @ p['ada_down']) @ p['ada_up'] + p['ada_bias']
    mod_c = (jax.nn.silu(c_ctx) @ p['ada_down']) @ p['ada_up'] + p['ada_bias']
    mx = jnp.split(mod_x[:, None, :], N_MOD, axis=-1)
    mc = jnp.split(mod_c, N_MOD, axis=-1)
    x = x + 0.5 * mx[2] * swiglu(modulate(x, p['norm_ffn1'], mx[0], mx[1]), p['ffn1_gu'], p['ffn1_down'])
    ctx = ctx + 0.5 * mc[2] * swiglu(modulate(ctx, p['norm_ffn1'], mc[0], mc[1]), p['ffn1_gu'], p['ffn1_down'])
    px = modulate(x, p['norm_mix'], mx[3], mx[4]) @ p['w_in']
    pc = modulate(ctx, p['norm_mix'], mc[3], mc[4]) @ p['w_in']
    o_x, o_c = mixer(px, pc, p, rope, need_ctx)
    x = x + mx[5] * (o_x @ p['w_out'])
    x = x + 0.5 * mx[8] * swiglu(modulate(x, p['norm_ffn2'], mx[6], mx[7]), p['ffn2_gu'], p['ffn2_down'])
    if need_ctx:
        ctx = ctx + mc[5] * (o_c @ p['w_out'])
        ctx = ctx + 0.5 * mc[8] * swiglu(modulate(ctx, p['norm_ffn2'], mc[6], mc[7]), p['ffn2_gu'], p['ffn2_down'])
    return x, ctx


def setup_inputs(seed: int = 0) -> dict:
    key = jax.random.key(seed)
    keys = jax.random.split(key, 64)
    counter = [0]

    def nxt():
        k = keys[counter[0]]
        counter[0] += 1
        return k

    def nrm(shape, scale):
        return scale * jax.random.normal(nxt(), shape, F32)

    def gain(shape):
        return 1.0 + nrm(shape, 0.05)

    conv_base = jnp.array([0.2, 0.6, 0.2], F32)[None, :, None]
    Dp = DEPTH
    return {
        'x': nrm((BATCH, SEQ, D_MODEL), 1.0),
        'c': nrm((BATCH, D_MODEL), 1.0),
        'ctx': nrm((BATCH, CTX_LEN, D_MODEL), 1.0),
        'c_ctx': nrm((D_MODEL,), 1.0),
        'ada_down': nrm((Dp, D_MODEL, ADA_RANK), D_MODEL ** -0.5),
        'ada_up': nrm((Dp, ADA_RANK, N_MOD * D_MODEL), 0.5 * ADA_RANK ** -0.5),
        'ada_bias': nrm((Dp, N_MOD * D_MODEL), 0.02),
        'norm_ffn1': gain((Dp, D_MODEL)),
        'norm_mix': gain((Dp, D_MODEL)),
        'norm_ffn2': gain((Dp, D_MODEL)),
        'ffn1_gu': nrm((Dp, D_MODEL, 2 * FFN_HIDDEN), D_MODEL ** -0.5),
        'ffn1_down': nrm((Dp, FFN_HIDDEN, D_MODEL), FFN_HIDDEN ** -0.5),
        'ffn2_gu': nrm((Dp, D_MODEL, 2 * FFN_HIDDEN), D_MODEL ** -0.5),
        'ffn2_down': nrm((Dp, FFN_HIDDEN, D_MODEL), FFN_HIDDEN ** -0.5),
        'w_in': nrm((Dp, D_MODEL, N_IN), D_MODEL ** -0.5),
        'w_out': nrm((Dp, D_MIX, D_MODEL), D_MIX ** -0.5),
        'a_conv': conv_base + nrm((Dp, 3, A_IN), 0.1),
        'a_w0': jax.random.uniform(nxt(), (Dp, 2, A_WIDTH), F32, -6.0, -1.0),
        'a_w_up': nrm((Dp, 2, A_DECAY_RANK, A_WIDTH), 0.1),
        'a_a0': nrm((Dp, 2, A_WIDTH), 0.1),
        'a_a_up': nrm((Dp, 2, A_ICLR_RANK, A_WIDTH), 0.5 * A_ICLR_RANK ** -0.5),
        'a_g_up': nrm((Dp, A_GATE_RANK, A_WIDTH), A_GATE_RANK ** -0.5),
        'a_k_k': 0.85 + nrm((Dp, A_WIDTH), 0.05),
        'a_k_a': gain((Dp, A_WIDTH)),
        'a_r_k': nrm((Dp, A_WIDTH), 0.1),
        'a_ln_w': gain((Dp, A_WIDTH)),
        'a_ln_b': nrm((Dp, A_WIDTH), 0.02),
        'b_conv': conv_base + nrm((Dp, 3, B_IN), 0.1),
        'b_conv_b': nrm((Dp, B_IN), 0.02),
        'b_fw1': nrm((Dp, FILTER_EMB, FILTER_HIDDEN), FILTER_EMB ** -0.5),
        'b_fb1': nrm((Dp, FILTER_HIDDEN), 0.1),
        'b_fw2': nrm((Dp, FILTER_HIDDEN, FILTER_HIDDEN), FILTER_HIDDEN ** -0.5),
        'b_fb2': nrm((Dp, FILTER_HIDDEN), 0.1),
        'b_fw3': nrm((Dp, FILTER_HIDDEN, FILTER_HIDDEN), FILTER_HIDDEN ** -0.5),
        'b_fb3': nrm((Dp, FILTER_HIDDEN), 0.1),
        'b_fw4': nrm((Dp, FILTER_HIDDEN, 2 * B_WIDTH), FILTER_HIDDEN ** -0.5),
        'b_freq': 1.0 + nrm((Dp, FILTER_HIDDEN), 0.1),
        'b_bias': nrm((Dp, B_WIDTH), 1.0),
        'c_q_norm': gain((Dp, Q_RANK)),
        'c_q_up': nrm((Dp, Q_RANK, C_HEADS * QK_DIM), Q_RANK ** -0.5),
        'c_kv_norm': gain((Dp, KV_RANK)),
        'c_kv_up': nrm((Dp, KV_RANK, C_HEADS * (QK_NOPE + V_HEAD)), KV_RANK ** -0.5),
        'c_qn_nope': gain((Dp, QK_NOPE)),
        'c_qn_pe': gain((Dp, QK_ROPE)),
        'c_kn_nope': gain((Dp, QK_NOPE)),
        'c_kn_pe': gain((Dp, QK_ROPE)),
    }


def reference(x, c, ctx, c_ctx, ada_down, ada_up, ada_bias, norm_ffn1, norm_mix, norm_ffn2,
              ffn1_gu, ffn1_down, ffn2_gu, ffn2_down, w_in, w_out,
              a_conv, a_w0, a_w_up, a_a0, a_a_up, a_g_up, a_k_k, a_k_a, a_r_k, a_ln_w, a_ln_b,
              b_conv, b_conv_b, b_fw1, b_fb1, b_fw2, b_fb2, b_fw3, b_fb3, b_fw4, b_freq, b_bias,
              c_q_norm, c_q_up, c_kv_norm, c_kv_up, c_qn_nope, c_qn_pe, c_kn_nope, c_kn_pe):
    ROWS = x.shape[1] // GRID_W
    rope = axial_rope_tables(ROWS)
    for l in range(DEPTH):
        p = {
            'ada_down': ada_down[l], 'ada_up': ada_up[l], 'ada_bias': ada_bias[l],
            'norm_ffn1': norm_ffn1[l], 'norm_mix': norm_mix[l], 'norm_ffn2': norm_ffn2[l],
            'ffn1_gu': ffn1_gu[l], 'ffn1_down': ffn1_down[l],
            'ffn2_gu': ffn2_gu[l], 'ffn2_down': ffn2_down[l],
            'w_in': w_in[l], 'w_out': w_out[l],
            'a_conv': a_conv[l], 'a_w0': a_w0[l], 'a_w_up': a_w_up[l], 'a_a0': a_a0[l],
            'a_a_up': a_a_up[l], 'a_g_up': a_g_up[l], 'a_k_k': a_k_k[l], 'a_k_a': a_k_a[l],
            'a_r_k': a_r_k[l], 'a_ln_w': a_ln_w[l], 'a_ln_b': a_ln_b[l],
            'b_conv': b_conv[l], 'b_conv_b': b_conv_b[l], 'b_fw1': b_fw1[l], 'b_fb1': b_fb1[l],
            'b_fw2': b_fw2[l], 'b_fb2': b_fb2[l], 'b_fw3': b_fw3[l], 'b_fb3': b_fb3[l],
            'b_fw4': b_fw4[l], 'b_freq': b_freq[l], 'b_bias': b_bias[l],
            'c_q_norm': c_q_norm[l], 'c_q_up': c_q_up[l], 'c_kv_norm': c_kv_norm[l],
            'c_kv_up': c_kv_up[l], 'c_qn_nope': c_qn_nope[l], 'c_qn_pe': c_qn_pe[l],
            'c_kn_nope': c_kn_nope[l], 'c_kn_pe': c_kn_pe[l],
        }
        x, ctx = layer(x, ctx, c, c_ctx, p, rope, l < DEPTH - 1)
    return x
```

```cpp
#include <hip/hip_runtime.h>
#include <stdint.h>
#include <cstdio>

#define LAS __attribute__((address_space(3)))
#define CAS __attribute__((address_space(4)))
typedef unsigned short bf16_t;
typedef float f32x4 __attribute__((ext_vector_type(4)));
typedef float f32x2 __attribute__((ext_vector_type(2)));
typedef unsigned u32x4 __attribute__((ext_vector_type(4)));
typedef unsigned u32x2 __attribute__((ext_vector_type(2)));

constexpr int T = 8448, NCTX = 256, SEQ = 8192, DM = 4096, FF = 6144, NL = 4;
constexpr int A_W = 1280, A_IN = 4160, B_IN = 3840, C_IN = 1600, NHA = 20;
constexpr int PXW = 9984, PXA = 0, PXB = 4352, PXC = 8192;
constexpr int NQ = 2304, NKV = 3072, NHC = 12;
constexpr int NMOD = 9 * DM;
constexpr float NORM_EPS = 1e-6f, GN_EPS = 64e-5f;

constexpr size_t MiB = 1u << 20;
constexpr size_t al(size_t x) { return (x + MiB - 1) / MiB * MiB; }
constexpr size_t WS_CTL = 0, CTL_BYTES = MiB;
constexpr size_t WS_XS = WS_CTL + CTL_BYTES;
constexpr size_t WS_ABUF = WS_XS + al((size_t)T * DM * 4);
constexpr size_t WS_HBUF = WS_ABUF + al((size_t)T * DM * 2);
constexpr size_t WS_OBUF = WS_HBUF + al((size_t)T * FF * 2);
constexpr size_t WS_PX = WS_OBUF + al((size_t)T * DM * 2);
constexpr size_t WS_MOD = WS_PX + al((size_t)T * PXW * 4);
constexpr size_t WS_HP = WS_MOD + al((size_t)NL * 2 * NMOD * 4);
constexpr size_t WS_SS = WS_HP + MiB;
constexpr size_t WS_SD = WS_SS + al((size_t)NHA * T * 192 * 4);
constexpr size_t WS_G = WS_SD + al((size_t)NHA * 2 * T * 192 * 4);
constexpr size_t WS_Y = WS_G + al((size_t)T * A_W * 4);
constexpr size_t WS_QA = WS_Y + al((size_t)2 * T * A_W * 4);
constexpr size_t WS_KVA = WS_QA + al((size_t)T * 1024 * 2);
constexpr size_t WS_KPE = WS_KVA + al((size_t)T * 512 * 2);
constexpr size_t WS_QRAW = WS_KPE + al((size_t)T * 64 * 2);
constexpr size_t WS_KVRAW = WS_QRAW + al((size_t)T * NQ * 2);
constexpr size_t WS_QF = WS_KVRAW + al((size_t)T * NKV * 2);
constexpr size_t WS_KF = WS_QF + al((size_t)T * NQ * 2);
constexpr size_t WS_H3 = WS_KF + al((size_t)T * NQ * 2);
constexpr size_t WS_HSCR = WS_H3 + al((size_t)NL * T * 64 * 4);
constexpr size_t WS_WB = WS_HSCR + al((size_t)256 * 16384 * 8);
constexpr size_t W_G1 = 0, W_D1 = W_G1 + (size_t)2 * FF * DM, W_IN = W_D1 + (size_t)DM * FF, W_OUT = W_IN + (size_t)PXW * DM, W_G2 = W_OUT + (size_t)DM * DM,
                 W_D2 = W_G2 + (size_t)2 * FF * DM, W_Q = W_D2 + (size_t)DM * FF, W_KV = W_Q + (size_t)NQ * 1024, W_LAYER = W_KV + (size_t)NKV * 512;
constexpr size_t WS_END = WS_WB + al(W_LAYER * NL * 2);
constexpr int CW_BAR = 4096;
constexpr int CW_QUEUE = 8192;

constexpr int LDS_MISC = 131072, LDS_BYTES = 147456;

__device__ __forceinline__ float wave_sum(float v) {
#pragma unroll
    for (int o = 1; o < 64; o <<= 1) v += __shfl_xor(v, o);
    return v;
}
__device__ __forceinline__ unsigned cvt_pk_bf16(float lo, float hi) { unsigned r; asm volatile("v_cvt_pk_bf16_f32 %0, %1, %2" : "=v"(r) : "v"(lo), "v"(hi)); return r; }
__device__ __forceinline__ float bf2f(unsigned short b) { return __uint_as_float(((unsigned)b) << 16); }
__device__ __forceinline__ float sigmoidf_(float x) { return 1.0f / (1.0f + __expf(-x)); }
__device__ __forceinline__ float siluf_(float x) { return x / (1.0f + __expf(-x)); }
__device__ __forceinline__ bool has_left(int tau) { return tau != 0 && tau != NCTX; }
__device__ __forceinline__ bool has_right(int tau) { return tau != NCTX - 1 && tau != T - 1; }

struct Args { const float* in[46]; float* out; unsigned char* ws; int ph_lo, ph_hi; };
struct Frame { LAS unsigned char* lds; volatile LAS unsigned* MISC; int tid, lane, wave, bid, G; };
constexpr int LDS_PTAB = LDS_MISC + 2048;
__device__ __forceinline__ const float* inp(const Frame& F, int i) {
    const volatile LAS unsigned* p = (const volatile LAS unsigned*)(F.lds + LDS_PTAB) + 2 * i;
    const unsigned lo = __builtin_amdgcn_readfirstlane(p[0]), hi = __builtin_amdgcn_readfirstlane(p[1]);
    return (const float*)(((unsigned long long)hi << 32) | lo);
}
#define IN_(i) inp(F, (i))
__device__ __forceinline__ Frame opq(const Frame& F) { Frame G = F; asm volatile("" : "+v"(G.tid), "+v"(G.lane), "+s"(G.wave), "+s"(G.bid)); return G; }
__device__ __forceinline__ unsigned char* opq_ptr(unsigned char* p) { asm volatile("" : "+s"(p)); return p; }
#define XB_TMO      128
#define XB_XCNT(j)  (256  + 64 * (j))
#define XB_XSUB(j)  (1280 + 64 * (j))
#define XB_XGEN(j)  (2304 + 64 * (j))
#define XB_TOP      3328
#define XB_TOPGEN   3392
#define XCD_BAR_WORDS 3456
#define XB_SPIN_CAP (1u << 18)

__device__ __forceinline__ unsigned xb_ld(unsigned* p)              { return __hip_atomic_load(p, __ATOMIC_RELAXED, __HIP_MEMORY_SCOPE_AGENT); }
__device__ __forceinline__ unsigned xb_add(unsigned* p, unsigned v) { return __hip_atomic_fetch_add(p, v, __ATOMIC_RELAXED, __HIP_MEMORY_SCOPE_AGENT); }
__device__ __forceinline__ unsigned xb_xcc_id() { return (unsigned)__builtin_amdgcn_s_getreg((3 << 11) | 20) & 0xFu; }
#define XB_SPIN(cond, bar) do { unsigned _sp = 0; while (cond) { __builtin_amdgcn_s_sleep(1); \
    if ((++_sp & 255u) == 0u) { if (xb_ld(&(bar)[XB_TMO])) break; if (_sp > XB_SPIN_CAP) { atomicAdd(&(bar)[XB_TMO], 1u); break; } } } } while (0)

struct XcdBarrier {
    unsigned* bar; unsigned x;
    volatile LAS unsigned* st;
};

__device__ __forceinline__ XcdBarrier xcd_barrier_post(unsigned* bar, volatile LAS unsigned* st) {
    XcdBarrier b; b.bar = bar; b.x = xb_xcc_id(); b.st = st;
    if (threadIdx.x == 0) (void)xb_add(&bar[XB_XCNT(b.x)], 1u);
    return b;
}
__device__ __forceinline__ void xcd_barrier_complete(unsigned* bar, unsigned x, unsigned& nloc, unsigned& nx) {
    const unsigned G = gridDim.x * gridDim.y * gridDim.z;
    unsigned sum, cnt, mine, sp = 0u;
    for (;;) {
        sum = 0u; cnt = 0u; mine = 0u;
#pragma unroll
        for (unsigned j = 0; j < 16; ++j) { const unsigned c = xb_ld(&bar[XB_XCNT(j)]); sum += c; cnt += (c > 0u) ? 1u : 0u; mine = (j == x) ? c : mine; }
        if (sum == G) break;
        __builtin_amdgcn_s_sleep(1);
        if ((++sp & 255u) == 0u) { if (xb_ld(&bar[XB_TMO])) break; if (sp > XB_SPIN_CAP) { atomicAdd(&bar[XB_TMO], 1u); break; } }
    }
    nloc = mine > 0u ? mine : 1u; nx = cnt > 0u ? cnt : 1u;
}

__device__ __forceinline__ void xcd_barrier(const XcdBarrier& b) {
    asm volatile("s_waitcnt vmcnt(0)" ::: "memory");
    __syncthreads();
    if (threadIdx.x == 0) {
        unsigned* bar = b.bar;
        __builtin_amdgcn_s_waitcnt(0);
        unsigned nloc = b.st[0], nx = b.st[1];
        if (nloc == 0u) { xcd_barrier_complete(bar, b.x, nloc, nx); b.st[0] = nloc; b.st[1] = nx; }
        const unsigned old = xb_add(&bar[XB_XSUB(b.x)], 1u);
        const unsigned gen = old / nloc;
        if (old + 1u == (gen + 1u) * nloc) {
            __builtin_amdgcn_fence(__ATOMIC_RELEASE, "agent");
            asm volatile("s_waitcnt vmcnt(0)" ::: "memory");
            const unsigned og = xb_add(&bar[XB_TOP], 1u);
            const unsigned tg = og / nx;
            if (og + 1u == (tg + 1u) * nx) xb_add(&bar[XB_TOPGEN], 1u);
            else XB_SPIN(xb_ld(&bar[XB_TOPGEN]) == tg, bar);
            __builtin_amdgcn_fence(__ATOMIC_ACQUIRE, "agent");
            xb_add(&bar[XB_XGEN(b.x)], 1u);
            asm volatile("s_waitcnt vmcnt(0)" ::: "memory");
        } else {
            XB_SPIN(xb_ld(&bar[XB_XGEN(b.x)]) == gen, bar);
            __builtin_amdgcn_fence(__ATOMIC_ACQUIRE, "agent");
            asm volatile("s_waitcnt vmcnt(0)" ::: "memory");
        }
    }
    __syncthreads();
}
namespace pg8 {
#define PG8_LAS __attribute__((address_space(3)))
typedef unsigned short bf16_t;
typedef short bf16x8 __attribute__((ext_vector_type(8)));
typedef float f32x4 __attribute__((ext_vector_type(4)));
typedef unsigned u32x4 __attribute__((ext_vector_type(4)));
constexpr int BM = 256, BK = 64, HALF = 128, HTB = HALF * BK * 2  , STAGE_BYTES = 8 * HTB, NXCD = 8, WGM = 8;

__host__ __device__ __forceinline__ int lds_byte(int r, int c) { const int st = (r >> 4) * 2 + (c >> 5), rr = r & 15, cc = c & 31, ob = rr * 64 + cc * 2; return st * 1024 + (ob ^ (((ob >> 9) & 1) << 5)); }
__host__ __device__ __forceinline__ void stage_rc(int b, int& R, int& C) { const int st = b / 1024, sb = b % 1024, swz = sb ^ (((sb >> 9) & 1) << 5); R = (st >> 1) * 16 + swz / 64; C = (st & 1) * 32 + (swz % 64) / 2; }
__host__ __device__ __forceinline__ int perm32(int rho) { const int n = rho >> 4, i = rho & 15; return 8 * (i >> 2) + 4 * n + (i & 3); }

struct Unit { int pm, pn; };
struct Gemm { const bf16_t* A; const bf16_t* Bt; int M, N, K; };

struct StaticOrder {
    int nM, nN, nwg, G, c;
    __host__ __device__ void init(int M, int N, int G_, int c_) { nM = M / BM; nN = N / BM; nwg = nM * nN; G = G_; c = c_; }
    __host__ __device__ bool next(int i, Unit& u) const {
        const long L = (long)i * G + c; if (L >= nwg) return false;
        int wgid = (int)L; { const int q = nwg / NXCD, r = nwg % NXCD, xcd = wgid % NXCD, off = wgid / NXCD; wgid = (xcd < r ? xcd * (q + 1) : r * (q + 1) + (xcd - r) * q) + off; }
        const int nig = WGM * nN, gid = wgid / nig, fm = gid * WGM, gsz = (nM - fm) < WGM ? (nM - fm) : WGM;
        u.pm = fm + ((wgid % nig) % gsz); u.pn = (wgid % nig) / gsz; return true;
    }
    __device__ __forceinline__ void a_ready(const Unit&) const {}
    __device__ __forceinline__ void done(const Unit&) const {}
};
struct CountedOrder : StaticOrder {
    const unsigned* ready; unsigned need; unsigned* tmo;
    __device__ __forceinline__ void a_ready(const Unit& u) const {
        if (threadIdx.x < 64) {
            const unsigned long long t0 = __builtin_amdgcn_s_memrealtime(); unsigned polls = 0;
            while ((unsigned)__builtin_amdgcn_readfirstlane(__hip_atomic_load(ready + 64 * u.pm, __ATOMIC_RELAXED, __HIP_MEMORY_SCOPE_AGENT)) < need) {
                if ((++polls & 255u) == 0u && __builtin_amdgcn_readfirstlane(__hip_atomic_load(tmo, __ATOMIC_RELAXED, __HIP_MEMORY_SCOPE_AGENT)) != 0u) break;
                if (__builtin_amdgcn_s_memrealtime() - t0 > 2000000ull) {
                    if (threadIdx.x == 0) { unsigned expect = 0u; __hip_atomic_compare_exchange_strong(tmo + 1, &expect, 0x600u | (unsigned)(u.pm & 0xff), __ATOMIC_RELAXED, __ATOMIC_RELAXED, __HIP_MEMORY_SCOPE_AGENT); __hip_atomic_store(tmo, 1u, __ATOMIC_RELAXED, __HIP_MEMORY_SCOPE_AGENT); }
                    break; }
                __builtin_amdgcn_s_sleep(2); }
            __builtin_amdgcn_fence(__ATOMIC_ACQUIRE, "agent");
            asm volatile("s_waitcnt vmcnt(0)" ::: "memory");
        }
#if !defined(BROKEN_HOOK_NO_BARRIER)
        asm volatile("" ::: "memory"); __builtin_amdgcn_s_barrier(); asm volatile("" ::: "memory");
#endif
    }
};

__device__ __forceinline__ unsigned cvt_pk_bf16(float lo, float hi) { unsigned r; asm volatile("v_cvt_pk_bf16_f32 %0, %1, %2" : "=v"(r) : "v"(lo), "v"(hi)); return r; }
typedef float f32x2 __attribute__((ext_vector_type(2)));
__device__ __forceinline__ f32x2 gelu_pk(f32x2 v) {
    const f32x2 av = __builtin_elementwise_abs(v), d = av * 0.2316418882f + 1.0f;
    f32x2 t; t.x = __builtin_amdgcn_rcpf(d.x); t.y = __builtin_amdgcn_rcpf(d.y);
    f32x2 q = t * 0.5307027145f + (-0.7265760135f); q = q * t + 0.7107068705f; q = q * t + (-0.142248368f); q = q * t + 0.127414796f; q = q * t;
    const f32x2 s = (v * v) * (-0.72134752044f);
    f32x2 e; e.x = __builtin_amdgcn_exp2f(s.x); e.y = __builtin_amdgcn_exp2f(s.y);
    const f32x2 m = v * (q * e), r = v - m;
    f32x2 o; o.x = v.x < 0.f ? m.x : r.x; o.y = v.y < 0.f ? m.y : r.y; return o;
}

struct EpiF32 {
    static constexpr bool PERM = false, AFTER_DRAIN = false;
    float* C; int ldc; const float* bias;
    __device__ __forceinline__ void operator()(const f32x4 (&acc)[2][2][4][2], const Unit& u, int wr, int wc, int fr, int fq) const {
        const int row0 = u.pm * BM + wr * 64 + fr, col0 = u.pn * BM + wc * 32 + 4 * fq;
        f32x4 bv[2][2];
#pragma unroll
        for (int bj = 0; bj < 2; ++bj)
#pragma unroll
            for (int n = 0; n < 2; ++n) bv[bj][n] = bias ? *(const f32x4*)(bias + col0 + bj * HALF + n * 16) : (f32x4){0.f, 0.f, 0.f, 0.f};
#pragma unroll
        for (int ai = 0; ai < 2; ++ai)
#pragma unroll
            for (int m = 0; m < 4; ++m) { float* rowp = C + (size_t)(row0 + ai * HALF + m * 16) * ldc + col0;
#pragma unroll
                for (int bj = 0; bj < 2; ++bj)
#pragma unroll
                    for (int n = 0; n < 2; ++n) *(f32x4*)(rowp + bj * HALF + n * 16) = acc[ai][bj][m][n] + bv[bj][n]; }
    }
};
template <int ACT  > struct EpiBf16 {
    static constexpr bool PERM = true, AFTER_DRAIN = false;
    bf16_t* O; int ldc; const float* bias; int split_cols; size_t split_stride;
    __device__ __forceinline__ void operator()(const f32x4 (&acc)[2][2][4][2], const Unit& u, int wr, int wc, int fr, int fq) const {
        const int row0 = u.pm * BM + wr * 64 + fr; int colt = u.pn * BM; bf16_t* base = O;
        if (split_cols) { const int t = colt / split_cols; base += (size_t)t * split_stride; colt -= t * split_cols; }
        const int col0 = colt + wc * 32 + 8 * fq, bcol0 = u.pn * BM + wc * 32 + 8 * fq;
        f32x4 bv[2][2];
#pragma unroll
        for (int bj = 0; bj < 2; ++bj)
#pragma unroll
            for (int n = 0; n < 2; ++n) bv[bj][n] = bias ? *(const f32x4*)(bias + bcol0 + bj * HALF + 4 * n) : (f32x4){0.f, 0.f, 0.f, 0.f};
#pragma unroll
        for (int ai = 0; ai < 2; ++ai)
#pragma unroll
            for (int m = 0; m < 4; ++m) { bf16_t* rowp = base + (size_t)(row0 + ai * HALF + m * 16) * ldc + col0;
#pragma unroll
                for (int bj = 0; bj < 2; ++bj) { f32x4 v0 = acc[ai][bj][m][0] + bv[bj][0], v1 = acc[ai][bj][m][1] + bv[bj][1];
                    if (ACT == 1) { f32x2 a = gelu_pk((f32x2){v0[0], v0[1]}), b = gelu_pk((f32x2){v0[2], v0[3]}), c = gelu_pk((f32x2){v1[0], v1[1]}), d = gelu_pk((f32x2){v1[2], v1[3]});
                        v0 = (f32x4){a.x, a.y, b.x, b.y}; v1 = (f32x4){c.x, c.y, d.x, d.y}; }
                    if (ACT == 2) {
#pragma unroll
                        for (int j = 0; j < 4; ++j) { v0[j] = 0.5f * v0[j] * (1.0f + erff(v0[j] * 0.70710678f)); v1[j] = 0.5f * v1[j] * (1.0f + erff(v1[j] * 0.70710678f)); } }
                    u32x4 w; w.x = cvt_pk_bf16(v0[0], v0[1]); w.y = cvt_pk_bf16(v0[2], v0[3]); w.z = cvt_pk_bf16(v1[0], v1[1]); w.w = cvt_pk_bf16(v1[2], v1[3]);
                    *(u32x4*)(rowp + bj * HALF) = w; } }
    }
};
}
namespace pg8 {
struct EpiSwiGLU {
    static constexpr bool PERM = true, AFTER_DRAIN = false;
    bf16_t* O; int ldc;
    __device__ __forceinline__ void operator()(const f32x4 (&acc)[2][2][4][2], const Unit& u, int wr, int wc, int fr, int fq) const {
        const int row0 = u.pm * BM + wr * 64 + fr, col0 = u.pn * HALF + wc * 32 + 8 * fq;
#pragma unroll
        for (int ai = 0; ai < 2; ++ai)
#pragma unroll
            for (int m = 0; m < 4; ++m) { bf16_t* rowp = O + (size_t)(row0 + ai * HALF + m * 16) * ldc + col0;
                float h[8];
#pragma unroll
                for (int n = 0; n < 2; ++n)
#pragma unroll
                    for (int j = 0; j < 4; ++j) { const float g = acc[ai][0][m][n][j], up = acc[ai][1][m][n][j]; h[n * 4 + j] = g * __builtin_amdgcn_rcpf(1.0f + __builtin_amdgcn_exp2f(-1.4426950408889634f * g)) * up; }
                u32x4 w; w.x = cvt_pk_bf16(h[0], h[1]); w.y = cvt_pk_bf16(h[2], h[3]); w.z = cvt_pk_bf16(h[4], h[5]); w.w = cvt_pk_bf16(h[6], h[7]);
                *(u32x4*)rowp = w; }
    }
};
struct EpiResid {
    static constexpr bool PERM = false, AFTER_DRAIN = false;
    float* X; const float* gate_x; const float* gate_c; float fac; float* out_x;
    __device__ __forceinline__ void operator()(const f32x4 (&acc)[2][2][4][2], const Unit& u, int wr, int wc, int fr, int fq) const {
        const int row0 = u.pm * BM + wr * 64 + fr, col0 = u.pn * BM + wc * 32 + 4 * fq;
        const float* gv = (u.pm == 0) ? gate_c : gate_x;
        float* dst = (u.pm != 0 && out_x) ? out_x - (size_t)256 * 4096 : X;
        f32x4 gg[2][2];
#pragma unroll
        for (int bj = 0; bj < 2; ++bj)
#pragma unroll
            for (int n = 0; n < 2; ++n) gg[bj][n] = *(const f32x4*)(gv + col0 + bj * HALF + n * 16) * fac;
#pragma unroll
        for (int ai = 0; ai < 2; ++ai)
#pragma unroll
            for (int m = 0; m < 4; ++m) { const size_t off = (size_t)(row0 + ai * HALF + m * 16) * 4096 + col0;
#pragma unroll
                for (int bj = 0; bj < 2; ++bj)
#pragma unroll
                    for (int n = 0; n < 2; ++n) { const f32x4 b = *(const f32x4*)(X + off + bj * HALF + n * 16); *(f32x4*)(dst + off + bj * HALF + n * 16) = b + gg[bj][n] * acc[ai][bj][m][n]; } }
    }
};
}
namespace pg8 {
template <class Epi, class Sched, bool STAMP = false>
__device__ __forceinline__ void gemm_phase(PG8_LAS unsigned char* lds, const Gemm g, const Sched& S, const Epi& E, unsigned long long* stamps) {
    int tid_ = threadIdx.x; asm volatile("" : "+v"(tid_));
    const int tid = tid_, wid = __builtin_amdgcn_readfirstlane(tid >> 6), lane = tid & 63, wr = wid >> 2, wc = wid & 3, fr = lane & 15, fq = lane >> 4;
    const int K = g.K, nt = K / BK;
    int ts_lo = 0, ts_hi = 0, nts = 0; const unsigned long long rt_entry = STAMP ? (unsigned long long)wall_clock64() : 0ull;
#define PG8_STAMP() do { if (STAMP && wid == 0 && nts < 64) { const unsigned long long _c = (unsigned long long)clock64(); \
        ts_lo = (lane == nts) ? (int)(unsigned)_c : ts_lo; ts_hi = (lane == nts) ? (int)(unsigned)(_c >> 32) : ts_hi; ++nts; } } while (0)
    PG8_STAMP();
    unsigned voffA[2], voffB[2];
#pragma unroll
    for (int i = 0; i < 2; ++i) { int R, C; stage_rc(tid * 16 + i * 8192, R, C); const int Rb = Epi::PERM ? ((R & ~31) + perm32(R & 31)) : R;
        voffA[i] = (unsigned)(R * K + C) * 2u; voffB[i] = (unsigned)(Rb * K + C) * 2u; }
    const size_t kstep = (size_t)(BK * 2);
    const size_t hstep = (size_t)HALF * K * 2;
    const size_t tstep = 2 * hstep;
    const unsigned ldsw = (unsigned)wid * 1024u;
    const int aoff = lds_byte(wr * 64 + fr, fq * 8), boff = lds_byte(wc * 32 + fr, fq * 8);
#define PG8_SA(b, h) (((b) * 2 + (h)) * HTB)
#define PG8_SB(b, h) ((4 + (b) * 2 + (h)) * HTB)
#define PG8_STAGE(bufoff, gbase, voff) do { _Pragma("unroll") for (int _i = 0; _i < 2; ++_i) \
        __builtin_amdgcn_global_load_lds((const unsigned*)((const char*)(gbase) + (voff)[_i]), (PG8_LAS unsigned*)(lds + (bufoff) + ldsw + _i * 8192), 16, 0, 0); } while (0)
#define PG8_LDA(dst, b, h) do { _Pragma("unroll") for (int m = 0; m < 4; ++m) _Pragma("unroll") for (int k = 0; k < 2; ++k) dst[m][k] = *(const PG8_LAS bf16x8*)(lds + PG8_SA(b, h) + aoff + m * 2048 + k * 1024); } while (0)
#define PG8_LDB(dst, b, h) do { _Pragma("unroll") for (int n = 0; n < 2; ++n) _Pragma("unroll") for (int k = 0; k < 2; ++k) dst[n][k] = *(const PG8_LAS bf16x8*)(lds + PG8_SB(b, h) + boff + n * 2048 + k * 1024); } while (0)
#define PG8_MMA(ai, bj, At, Bt) do { __builtin_amdgcn_s_setprio(1); _Pragma("unroll") for (int m = 0; m < 4; ++m) _Pragma("unroll") for (int n = 0; n < 2; ++n) _Pragma("unroll") for (int k = 0; k < 2; ++k) \
        acc[ai][bj][m][n] = __builtin_amdgcn_mfma_f32_16x16x32_bf16(Bt[n][k], At[m][k], acc[ai][bj][m][n], 0, 0, 0); __builtin_amdgcn_s_setprio(0); } while (0)
#define PG8_WAIT_V(n) asm volatile("s_waitcnt vmcnt(" #n ")" ::: "memory")
#define PG8_WAIT_L(n) asm volatile("s_waitcnt lgkmcnt(" #n ")" ::: "memory")
#define PG8_BAR __builtin_amdgcn_s_barrier()
#define PG8_SCHED __builtin_amdgcn_sched_barrier(0)
    Unit cur, nxt; int ui = 0;
    if (!S.next(0, cur)) return;
    f32x4 acc[2][2][4][2];
#pragma unroll
    for (int a = 0; a < 2; ++a)
#pragma unroll
        for (int b = 0; b < 2; ++b)
#pragma unroll
            for (int m = 0; m < 4; ++m)
#pragma unroll
                for (int n = 0; n < 2; ++n) acc[a][b][m][n] = (f32x4){0.f, 0.f, 0.f, 0.f};
    bf16x8 At[4][2], B0[2][2], B1[2][2];
    const char* cA = (const char*)g.A + (size_t)cur.pm * tstep; const char* cB = (const char*)g.Bt + (size_t)cur.pn * tstep;
    S.a_ready(cur);
    PG8_STAGE(PG8_SB(0, 0), cB, voffB); PG8_STAGE(PG8_SA(0, 0), cA, voffA); PG8_STAGE(PG8_SB(0, 1), cB + hstep, voffB); PG8_STAGE(PG8_SA(0, 1), cA + hstep, voffA);
    if (wr == 1) PG8_BAR;
    PG8_WAIT_V(4); PG8_BAR;
    PG8_STAGE(PG8_SB(1, 0), cB + kstep, voffB); PG8_STAGE(PG8_SA(1, 0), cA + kstep, voffA); PG8_STAGE(PG8_SB(1, 1), cB + hstep + kstep, voffB);
    PG8_WAIT_V(6); PG8_BAR;
    PG8_STAMP();
    for (;;) {
        const bool has_next = S.next(ui + 1, nxt);
        const char* nA = has_next ? (const char*)g.A + (size_t)nxt.pm * tstep : cA; const char* nB = has_next ? (const char*)g.Bt + (size_t)nxt.pn * tstep : cB;
        for (int t = 0; t < nt; t += 2) {
            const bool last = (t == nt - 2);
            const char* a1 = cA + (size_t)(t + 1) * kstep;
            const char* a2 = last ? nA : cA + (size_t)(t + 2) * kstep; const char* b2 = last ? nB : cB + (size_t)(t + 2) * kstep;
            const char* a3 = a2 + kstep; const char* b3 = b2 + kstep;
            if (last && has_next) S.a_ready(nxt);
            PG8_LDB(B0, 0, 0); PG8_SCHED; PG8_LDA(At, 0, 0); PG8_STAGE(PG8_SA(1, 1), a1 + hstep, voffA);
            PG8_WAIT_L(8); PG8_BAR; PG8_WAIT_L(0); PG8_MMA(0, 0, At, B0); PG8_BAR; PG8_SCHED;
            PG8_LDB(B1, 0, 1); PG8_STAGE(PG8_SB(0, 0), b2, voffB);
            PG8_BAR; PG8_WAIT_L(0); PG8_MMA(0, 1, At, B1); PG8_BAR;
            PG8_LDA(At, 0, 1); PG8_STAGE(PG8_SA(0, 0), a2, voffA);
            PG8_BAR; PG8_WAIT_L(0); PG8_MMA(1, 0, At, B0); PG8_BAR; PG8_SCHED;
            PG8_STAGE(PG8_SB(0, 1), b2 + hstep, voffB);
            PG8_WAIT_V(6); PG8_BAR; PG8_MMA(1, 1, At, B1); PG8_BAR;
            PG8_LDB(B0, 1, 0); PG8_SCHED; PG8_LDA(At, 1, 0); PG8_STAGE(PG8_SA(0, 1), a2 + hstep, voffA);
            PG8_WAIT_L(8); PG8_BAR; PG8_WAIT_L(0); PG8_MMA(0, 0, At, B0); PG8_BAR; PG8_SCHED;
            PG8_LDB(B1, 1, 1); PG8_STAGE(PG8_SB(1, 0), b3, voffB);
            PG8_BAR; PG8_WAIT_L(0); PG8_MMA(0, 1, At, B1); PG8_BAR;
            PG8_LDA(At, 1, 1); PG8_STAGE(PG8_SA(1, 0), a3, voffA);
            PG8_BAR; PG8_WAIT_L(0); PG8_MMA(1, 0, At, B0); PG8_BAR; PG8_SCHED;
            PG8_STAGE(PG8_SB(1, 1), b3 + hstep, voffB);
            PG8_WAIT_V(6); PG8_BAR; PG8_MMA(1, 1, At, B1); PG8_BAR;
        }
        PG8_STAMP();
        if constexpr (!Epi::AFTER_DRAIN) { E(acc, cur, wr, wc, fr, fq); S.done(cur); }
        PG8_STAMP();
        if (!has_next) break;
#pragma unroll
        for (int a = 0; a < 2; ++a)
#pragma unroll
            for (int b = 0; b < 2; ++b)
#pragma unroll
                for (int m = 0; m < 4; ++m)
#pragma unroll
                    for (int n = 0; n < 2; ++n) acc[a][b][m][n] = (f32x4){0.f, 0.f, 0.f, 0.f};
        cur = nxt; cA = nA; cB = nB; ++ui;
    }
    PG8_WAIT_V(0);
    if (wr == 0) PG8_BAR;
    PG8_BAR;
    if constexpr (Epi::AFTER_DRAIN) { E.fused(acc, cur, wr, wc, fr, fq, lds, wid, lane); S.done(cur); }
    PG8_STAMP();
    if (STAMP && wid == 0) { stamps[lane] = lane < nts ? (((unsigned long long)(unsigned)ts_hi << 32) | (unsigned)ts_lo) : 0ull;
        if (lane == 62) stamps[62] = rt_entry; if (lane == 63) stamps[63] = (unsigned long long)wall_clock64(); }
#undef PG8_STAMP
#undef PG8_SA
#undef PG8_SB
#undef PG8_STAGE
#undef PG8_LDA
#undef PG8_LDB
#undef PG8_MMA
#undef PG8_WAIT_V
#undef PG8_WAIT_L
#undef PG8_BAR
#undef PG8_SCHED
}
}
#define LDS_WAIT() asm volatile("s_waitcnt lgkmcnt(0)" ::: "memory")

__device__ __forceinline__ int map_row(int n, int mode) {
    if (mode == 1) { const int j = n < FF ? n : n - FF; return (j >> 7) * 256 + (n < FF ? 0 : 128) + (j & 127); }
    if (mode == 2) { return n < A_IN ? n : (n < A_IN + B_IN ? n - A_IN + PXB : n - (A_IN + B_IN) + PXC); }
    return n;
}
__device__ __forceinline__ void transpose_item(const float* __restrict__ W, int K, int N, bf16_t* WT, int mode, LAS float* scr, int item, int lane) {
    const int nblk = N / 32, kb = item / nblk, nb = item % nblk, k0 = 64 * kb, n0 = 32 * nb;
#pragma unroll 8
    for (int i = 0; i < 32; ++i) { const int kk = 2 * i + (lane >> 5); scr[kk * 33 + (lane & 31)] = W[(size_t)(k0 + kk) * N + n0 + (lane & 31)]; }
    LDS_WAIT(); asm volatile("" ::: "memory");
    const int c = lane & 7;
#pragma unroll
    for (int j = 0; j < 4; ++j) { const int n = (lane >> 3) + 8 * j; const LAS float* s = scr + (8 * c) * 33 + n;
        u32x4 o; o.x = cvt_pk_bf16(s[0 * 33], s[1 * 33]); o.y = cvt_pk_bf16(s[2 * 33], s[3 * 33]); o.z = cvt_pk_bf16(s[4 * 33], s[5 * 33]); o.w = cvt_pk_bf16(s[6 * 33], s[7 * 33]);
        *(u32x4*)(WT + (size_t)map_row(n0 + n, mode) * K + k0 + 8 * c) = o; }
    LDS_WAIT(); asm volatile("" ::: "memory");
}
constexpr int I_G = (DM / 64) * (2 * FF / 32), I_D = (FF / 64) * (DM / 32), I_IN = (DM / 64) * (9600 / 32), I_OUT = (DM / 64) * (DM / 32), I_Q = (1024 / 64) * (NQ / 32), I_KV = (512 / 64) * (NKV / 32);
constexpr int I_LAYER = 2 * I_G + 2 * I_D + I_IN + I_OUT + I_Q + I_KV;

__device__ __forceinline__ void phase0(const Frame& F, unsigned char* ws) {
    const int gw = F.bid * 8 + F.wave, NGW = F.G * 8;
    const size_t gt = (size_t)F.bid * 512 + F.tid, NGT = (size_t)F.G * 512;
    LAS float* scr = (LAS float*)(F.lds + F.wave * 8704);
    bf16_t* WB = (bf16_t*)(ws + WS_WB);
    for (int it = gw; it < NL * I_LAYER; it += NGW) {
        const int l = it / I_LAYER; int r = it - l * I_LAYER; bf16_t* wl = WB + (size_t)l * W_LAYER;
        if (r < I_G) { transpose_item(IN_(10) + (size_t)l * DM * 2 * FF, DM, 2 * FF, wl + W_G1, 1, scr, r, F.lane); continue; } r -= I_G;
        if (r < I_D) { transpose_item(IN_(11) + (size_t)l * FF * DM, FF, DM, wl + W_D1, 0, scr, r, F.lane); continue; } r -= I_D;
        if (r < I_G) { transpose_item(IN_(12) + (size_t)l * DM * 2 * FF, DM, 2 * FF, wl + W_G2, 1, scr, r, F.lane); continue; } r -= I_G;
        if (r < I_D) { transpose_item(IN_(13) + (size_t)l * FF * DM, FF, DM, wl + W_D2, 0, scr, r, F.lane); continue; } r -= I_D;
        if (r < I_IN) { transpose_item(IN_(14) + (size_t)l * DM * 9600, DM, 9600, wl + W_IN, 2, scr, r, F.lane); continue; } r -= I_IN;
        if (r < I_OUT) { transpose_item(IN_(15) + (size_t)l * DM * DM, DM, DM, wl + W_OUT, 0, scr, r, F.lane); continue; } r -= I_OUT;
        if (r < I_Q) { transpose_item(IN_(39) + (size_t)l * 1024 * NQ, 1024, NQ, wl + W_Q, 0, scr, r, F.lane); continue; } r -= I_Q;
        transpose_item(IN_(41) + (size_t)l * 512 * NKV, 512, NKV, wl + W_KV, 0, scr, r, F.lane);
    }
    for (size_t i = gt; i < (size_t)NL * 384 * 512; i += NGT) {
        const int l = (int)(i / (384 * 512)), rr = (int)((i / 512) % 384), c = (int)(i % 512);
        const int row = rr < 192 ? A_IN + rr : PXC + C_IN + (rr - 192);
        *(u32x4*)(WB + (size_t)l * W_LAYER + W_IN + (size_t)row * DM + c * 8) = (u32x4){0u, 0u, 0u, 0u};
    }
    { f32x4* xs = (f32x4*)(ws + WS_XS); const f32x4* cx = (const f32x4*)IN_(2); const f32x4* xx = (const f32x4*)IN_(0);
      for (size_t i = gt; i < (size_t)T * DM / 4; i += NGT) xs[i] = i < (size_t)NCTX * DM / 4 ? cx[i] : xx[i - (size_t)NCTX * DM / 4]; }
    { float* HP = (float*)(ws + WS_HP);
      for (int it = F.bid; it < NL * 16; it += F.G) { const int l = it >> 4, ch = it & 15, w = F.tid >> 8, j = F.tid & 255;
          const float* cv = w ? IN_(3) : IN_(1); const float* ad = IN_(4) + ((size_t)l * DM + ch * 256) * 256 + j; float s = 0.f;
          for (int i = 0; i < 256; ++i) s += siluf_(cv[ch * 256 + i]) * ad[(size_t)i * 256];
          HP[((l * 16 + ch) * 2 + w) * 256 + j] = s; } }
    { float* H3 = (float*)(ws + WS_H3);
      LAS float* zb = (LAS float*)(F.lds + 73728); LAS float* ha = zb + 8 * 36; LAS float* hb = ha + 8 * 64;
      for (int it = F.bid; it < NL * (T / 8); it += F.G) { const int l = it / (T / 8), pb = it % (T / 8);
          if (F.tid < 8 * 33) { const int p = F.tid / 33, i = F.tid % 33, P = pb * 8 + p; const int L = P < NCTX ? NCTX : SEQ, t = P < NCTX ? P : P - NCTX;
              float z;
              if (i == 0) z = (float)t / (float)(L - 1);
              else { const int b = (i - 1) & 15; const float fb = 1e-4f + (float)b * ((15.0f - 1e-4f) / 15.0f); const float rev2 = 2.0f * fb * (float)t / (float)L;
                  z = i <= 16 ? cospif(rev2) : -sinpif(rev2); }
              zb[p * 36 + i] = z; }
          __syncthreads();
          const int p = F.tid >> 6, j = F.tid & 63; const float fq = IN_(36)[l * 64 + j];
          { const float* w1 = IN_(29) + (size_t)l * 33 * 64 + j; float s = IN_(30)[l * 64 + j];
            for (int i = 0; i < 33; ++i) s += zb[p * 36 + i] * w1[i * 64];
            ha[p * 64 + j] = sinf(fq * s); }
          __syncthreads();
          { const float* w2 = IN_(31) + (size_t)l * 64 * 64 + j; float s = IN_(32)[l * 64 + j];
            for (int i = 0; i < 64; ++i) s += ha[p * 64 + i] * w2[i * 64];
            hb[p * 64 + j] = sinf(fq * s); }
          __syncthreads();
          { const float* w3 = IN_(33) + (size_t)l * 64 * 64 + j; float s = IN_(34)[l * 64 + j];
            for (int i = 0; i < 64; ++i) s += hb[p * 64 + i] * w3[i * 64];
            H3[((size_t)l * T + pb * 8 + p) * 64 + j] = sinf(fq * s); }
          __syncthreads(); } }
}
__device__ __forceinline__ void phase_mod(const Frame& F, unsigned char* ws) {
    const float* HP = (const float*)(ws + WS_HP); float* MOD = (float*)(ws + WS_MOD);
    LAS float* hs = (LAS float*)F.lds;
    for (int it = F.bid; it < NL * (NMOD / 512); it += F.G) { const int l = it / (NMOD / 512), nb = it % (NMOD / 512);
        { const int w = F.tid >> 8, j = F.tid & 255; float s = 0.f;
          for (int ch = 0; ch < 16; ++ch) s += HP[((l * 16 + ch) * 2 + w) * 256 + j];
          hs[w * 256 + j] = s; }
        __syncthreads();
        const int n = nb * 512 + F.tid; const float* au = IN_(5) + (size_t)l * 256 * NMOD + n; float s0 = IN_(6)[(size_t)l * NMOD + n], s1 = s0;
        for (int j = 0; j < 256; ++j) { const float u = au[(size_t)j * NMOD]; s0 += hs[j] * u; s1 += hs[256 + j] * u; }
        MOD[((size_t)l * 2 + 0) * NMOD + n] = s0; MOD[((size_t)l * 2 + 1) * NMOD + n] = s1;
        __syncthreads(); }
}
__device__ __forceinline__ void norm_phase(const Frame& F, const float* XS, const float* __restrict__ gain, const float* modx, const float* modc, int ish, int isc, bf16_t* out) {
    const int gw = F.bid * 8 + F.wave, NGW = F.G * 8;
    for (int row = gw; row < T; row += NGW) {
        const float* mod = row < NCTX ? modc : modx;
        const f32x4* xr = (const f32x4*)(XS + (size_t)row * DM) + F.lane; const f32x4* g4 = (const f32x4*)gain + F.lane;
        const f32x4* sh4 = (const f32x4*)(mod + (size_t)ish * DM) + F.lane; const f32x4* sc4 = (const f32x4*)(mod + (size_t)isc * DM) + F.lane;
        f32x4 v[16]; float s = 0.f;
#pragma unroll
        for (int j = 0; j < 16; ++j) { v[j] = xr[64 * j]; s += (v[j].x * v[j].x + v[j].y * v[j].y) + (v[j].z * v[j].z + v[j].w * v[j].w); }
        const float rstd = rsqrtf(wave_sum(s) * (1.0f / DM) + NORM_EPS);
        u32x2* o = (u32x2*)(out + (size_t)row * DM) + F.lane;
#pragma unroll
        for (int j = 0; j < 16; ++j) { const f32x4 y = v[j] * rstd * g4[64 * j] * (sc4[64 * j] + 1.0f) + sh4[64 * j];
            u32x2 w; w.x = cvt_pk_bf16(y.x, y.y); w.y = cvt_pk_bf16(y.z, y.w); o[64 * j] = w; }
    }
}
__device__ __forceinline__ float conv3_at(const float* PX, int tau, int col, float w0, float w1, float w2) {
    const float* p = PX + (size_t)tau * PXW + col;
    float y = p[0] * w1;
    if (has_left(tau)) y += p[-PXW] * w0;
    if (has_right(tau)) y += p[PXW] * w2;
    return y;
}
__device__ __forceinline__ void rwkv_prep_phase(const Frame& F, unsigned char* ws, int l) {
    const float* PX = (const float*)(ws + WS_PX); float* SS = (float*)(ws + WS_SS); float* SD = (float*)(ws + WS_SD); float* GB = (float*)(ws + WS_G);
    const float* cw = IN_(16) + (size_t)l * 3 * A_IN;
    LAS float* LW = (LAS float*)F.lds; LAS float* LA = LW + 32 * 64; LAS float* LG = LA + 32 * 64;
    for (int it = F.bid; it < (T / 32) * 5; it += F.G) {
        const int tt = it / 5, cb = it % 5, tau0 = tt * 32;
        for (int e = F.tid; e < 32 * 320; e += 512) { const int t = e / 320, c = e % 320, col = 3840 + c;
            const float val = conv3_at(PX, tau0 + t, PXA + col, cw[col], cw[A_IN + col], cw[2 * A_IN + col]);
            if (c < 64) LW[t * 64 + c] = tanhf(val); else if (c < 128) LA[t * 64 + (c - 64)] = val; else LG[t * 192 + (c - 128)] = sigmoidf_(val); }
        __syncthreads();
        const int col = cb * 256 + (F.tid & 255), half = F.tid >> 8;
        float aw0[16], aw1[16], aa0[16], aa1[16], ag[16];
#pragma unroll
        for (int i = 0; i < 16; ++i) { aw0[i] = 0.f; aw1[i] = 0.f; aa0[i] = 0.f; aa1[i] = 0.f; ag[i] = 0.f; }
        const float* wu0 = IN_(18) + ((size_t)l * 2 + 0) * 64 * A_W + col; const float* wu1 = wu0 + 64 * A_W;
        const float* au0 = IN_(20) + ((size_t)l * 2 + 0) * 64 * A_W + col; const float* au1 = au0 + 64 * A_W;
        const float* gu = IN_(21) + (size_t)l * 192 * A_W + col;
        for (int j = 0; j < 64; j += 4) {
            float w0v[4], w1v[4], a0v[4], a1v[4];
#pragma unroll
            for (int q = 0; q < 4; ++q) { w0v[q] = wu0[(j + q) * A_W]; w1v[q] = wu1[(j + q) * A_W]; a0v[q] = au0[(j + q) * A_W]; a1v[q] = au1[(j + q) * A_W]; }
#pragma unroll
            for (int i = 0; i < 16; ++i) { const f32x4 xw = *(const LAS f32x4*)(LW + (half * 16 + i) * 64 + j), xa = *(const LAS f32x4*)(LA + (half * 16 + i) * 64 + j);
#pragma unroll
                for (int q = 0; q < 4; ++q) { aw0[i] += xw[q] * w0v[q]; aw1[i] += xw[q] * w1v[q]; aa0[i] += xa[q] * a0v[q]; aa1[i] += xa[q] * a1v[q]; } }
        }
        for (int j = 0; j < 192; j += 4) {
            float gv[4];
#pragma unroll
            for (int q = 0; q < 4; ++q) gv[q] = gu[(j + q) * A_W];
#pragma unroll
            for (int i = 0; i < 16; ++i) { const f32x4 xg = *(const LAS f32x4*)(LG + (half * 16 + i) * 192 + j);
#pragma unroll
                for (int q = 0; q < 4; ++q) ag[i] += xg[q] * gv[q]; }
        }
        const int h = col >> 6, ln = col & 63;
        const float cr0 = cw[col], cr1 = cw[A_IN + col], cr2 = cw[2 * A_IN + col];
        const float ck0 = cw[A_W + col], ck1 = cw[A_IN + A_W + col], ck2 = cw[2 * A_IN + A_W + col];
        const float cv0 = cw[2 * A_W + col], cv1 = cw[A_IN + 2 * A_W + col], cv2 = cw[2 * A_IN + 2 * A_W + col];
        const float kk_w = IN_(22)[l * A_W + col], ka_w = IN_(23)[l * A_W + col];
        const float w00 = IN_(17)[(l * 2 + 0) * A_W + col], w01 = IN_(17)[(l * 2 + 1) * A_W + col];
        const float a00 = IN_(19)[(l * 2 + 0) * A_W + col], a01 = IN_(19)[(l * 2 + 1) * A_W + col];
#pragma unroll
        for (int i = 0; i < 16; ++i) { const int tau = tau0 + half * 16 + i;
            const float r = conv3_at(PX, tau, PXA + col, cr0, cr1, cr2), k = conv3_at(PX, tau, PXA + A_W + col, ck0, ck1, ck2), v = conv3_at(PX, tau, PXA + 2 * A_W + col, cv0, cv1, cv2);
            const float kr = k * kk_w; const float nrm = sqrtf(wave_sum(kr * kr)); const float kk = kr / fmaxf(nrm, 1e-12f);
            float* ss = SS + ((size_t)h * T + tau) * 192 + ln; ss[0] = kk; ss[64] = r; ss[128] = v;
            GB[(size_t)tau * A_W + col] = ag[i];
#pragma unroll
            for (int d = 0; d < 2; ++d) { const float z = (d ? w01 : w00) + (d ? aw1[i] : aw0[i]);
                const float sp = fmaxf(-z, 0.f) + log1pf(__expf(-fabsf(z)));
                const float logw = -sp - 0.5f; const float decay = __expf(-__expf(logw));
                const float av = sigmoidf_((d ? a01 : a00) + (d ? aa1[i] : aa0[i]));
                const float kd = k * (1.0f + (av - 1.0f) * ka_w);
                float* sd = SD + (((size_t)h * 2 + d) * T + tau) * 192 + ln; sd[0] = decay; sd[64] = kk * av; sd[128] = kd; } }
        __syncthreads();
    }
}
__device__ __forceinline__ float rope_apply(float val, int tau, int j) {
    const int pos = tau - NCTX, prow = pos >> 6, pcol = pos & 63;
    const float inv = __powf(10000.0f, -(float)(j & 15) * (1.0f / 16.0f));
    const float ang = (float)(j < 32 ? prow : pcol) * inv;
    float sn, cs; sincosf(ang, &sn, &cs);
    const float partner = __shfl_xor(val, 16);
    const float rot = (j & 16) ? partner : -partner;
    return val * cs + rot * sn;
}
__device__ __forceinline__ void mla_prep_phase(const Frame& F, unsigned char* ws, int l) {
    const float* PX = (const float*)(ws + WS_PX); bf16_t* QA = (bf16_t*)(ws + WS_QA); bf16_t* KVA = (bf16_t*)(ws + WS_KVA); bf16_t* KPE = (bf16_t*)(ws + WS_KPE);
    const int gw = F.bid * 8 + F.wave, NGW = F.G * 8;
    const f32x4* gq = (const f32x4*)(IN_(38) + l * 1024) + F.lane; const f32x4* gkv = (const f32x4*)(IN_(40) + l * 512) + F.lane; const float gpe = IN_(45)[l * 64 + F.lane];
    for (int tau = gw; tau < T; tau += NGW) {
        const f32x4* p = (const f32x4*)(PX + (size_t)tau * PXW + PXC) + F.lane;
        f32x4 q[4], kv[2]; float sq = 0.f, skv = 0.f;
#pragma unroll
        for (int j = 0; j < 4; ++j) { q[j] = p[64 * j]; sq += (q[j].x * q[j].x + q[j].y * q[j].y) + (q[j].z * q[j].z + q[j].w * q[j].w); }
#pragma unroll
        for (int j = 0; j < 2; ++j) { kv[j] = p[256 + 64 * j]; skv += (kv[j].x * kv[j].x + kv[j].y * kv[j].y) + (kv[j].z * kv[j].z + kv[j].w * kv[j].w); }
        const float pe = PX[(size_t)tau * PXW + PXC + 1536 + F.lane];
        const float rq = rsqrtf(wave_sum(sq) * (1.0f / 1024.0f) + NORM_EPS), rkv = rsqrtf(wave_sum(skv) * (1.0f / 512.0f) + NORM_EPS), rpe = rsqrtf(wave_sum(pe * pe) * (1.0f / 64.0f) + NORM_EPS);
        u32x2* oq = (u32x2*)(QA + (size_t)tau * 1024) + F.lane; u32x2* okv = (u32x2*)(KVA + (size_t)tau * 512) + F.lane;
#pragma unroll
        for (int j = 0; j < 4; ++j) { const f32x4 y = q[j] * rq * gq[64 * j]; u32x2 w; w.x = cvt_pk_bf16(y.x, y.y); w.y = cvt_pk_bf16(y.z, y.w); oq[64 * j] = w; }
#pragma unroll
        for (int j = 0; j < 2; ++j) { const f32x4 y = kv[j] * rkv * gkv[64 * j]; u32x2 w; w.x = cvt_pk_bf16(y.x, y.y); w.y = cvt_pk_bf16(y.z, y.w); okv[64 * j] = w; }
        float kp = pe * rpe * gpe;
        if (tau >= NCTX) kp = rope_apply(kp, tau, F.lane);
        KPE[(size_t)tau * 64 + F.lane] = (bf16_t)(cvt_pk_bf16(kp, kp) & 0xffffu);
    }
}
__device__ __forceinline__ void qkv_final_phase(const Frame& F, unsigned char* ws, int l, bool need_ctx) {
    const bf16_t* QRAW = (const bf16_t*)(ws + WS_QRAW); const bf16_t* KVRAW = (const bf16_t*)(ws + WS_KVRAW); const bf16_t* KPE = (const bf16_t*)(ws + WS_KPE);
    bf16_t* QF = (bf16_t*)(ws + WS_QF); bf16_t* KF = (bf16_t*)(ws + WS_KF);
    const int gw = F.bid * 8 + F.wave, NGW = F.G * 8, ln = F.lane;
    const float gqn0 = IN_(42)[l * 128 + 2 * ln], gqn1 = IN_(42)[l * 128 + 2 * ln + 1], gqp = IN_(43)[l * 64 + ln];
    const float gkn0 = IN_(44)[l * 128 + 2 * ln], gkn1 = IN_(44)[l * 128 + 2 * ln + 1];
    (void)need_ctx;
    for (int it = gw; it < T * NHC; it += NGW) { const int tau = it / NHC, h = it % NHC;
        const unsigned qn = *(const unsigned*)(QRAW + (size_t)tau * NQ + h * 192 + 2 * ln); const float q0 = bf2f((unsigned short)(qn & 0xffffu)), q1 = bf2f((unsigned short)(qn >> 16));
        const float qp = bf2f(QRAW[(size_t)tau * NQ + h * 192 + 128 + ln]);
        const unsigned kn = *(const unsigned*)(KVRAW + (size_t)tau * NKV + h * 256 + 2 * ln); const float k0 = bf2f((unsigned short)(kn & 0xffffu)), k1 = bf2f((unsigned short)(kn >> 16));
        const float rqn = rsqrtf(wave_sum(q0 * q0 + q1 * q1) * (1.0f / 128.0f) + NORM_EPS), rqp = rsqrtf(wave_sum(qp * qp) * (1.0f / 64.0f) + NORM_EPS), rkn = rsqrtf(wave_sum(k0 * k0 + k1 * k1) * (1.0f / 128.0f) + NORM_EPS);
        float qpe = qp * rqp * gqp; if (tau >= NCTX) qpe = rope_apply(qpe, tau, ln);
        *(unsigned*)(QF + (size_t)tau * NQ + h * 192 + 2 * ln) = cvt_pk_bf16(q0 * rqn * gqn0, q1 * rqn * gqn1);
        QF[(size_t)tau * NQ + h * 192 + 128 + ln] = (bf16_t)(cvt_pk_bf16(qpe, qpe) & 0xffffu);
        *(unsigned*)(KF + (size_t)tau * NQ + h * 192 + 2 * ln) = cvt_pk_bf16(k0 * rkn * gkn0, k1 * rkn * gkn1);
        KF[(size_t)tau * NQ + h * 192 + 128 + ln] = KPE[(size_t)tau * 64 + ln];
    }
}
__device__ __forceinline__ void rwkv_out_phase(const Frame& F, unsigned char* ws, int l, bool need_ctx) {
    const float* SS = (const float*)(ws + WS_SS); const float* SD = (const float*)(ws + WS_SD); const float* GB = (const float*)(ws + WS_G); const float* Y = (const float*)(ws + WS_Y);
    bf16_t* OB = (bf16_t*)(ws + WS_OBUF);
    const int gw = F.bid * 8 + F.wave, NGW = F.G * 8, ln = F.lane;
    const int lo = need_ctx ? 0 : NCTX * NHA;
    for (int it = lo + gw; it < T * NHA; it += NGW) { const int tau = it / NHA, h = it % NHA, col = h * 64 + ln;
        const float y = Y[(size_t)tau * A_W + col] + Y[((size_t)T + tau) * A_W + col];
        const float mu = wave_sum(y) * (1.0f / 64.0f); const float dy = y - mu; const float var = wave_sum(dy * dy) * (1.0f / 64.0f);
        const float yn = dy * rsqrtf(var + GN_EPS) * IN_(25)[l * A_W + col] + IN_(26)[l * A_W + col];
        const float* ss = SS + ((size_t)h * T + tau) * 192 + ln; const float r = ss[64], v = ss[128];
        const float km = 0.5f * (SD[(((size_t)h * 2 + 0) * T + tau) * 192 + 128 + ln] + SD[(((size_t)h * 2 + 1) * T + tau) * 192 + 128 + ln]);
        const float bonus = wave_sum(r * km * IN_(24)[l * A_W + col]) * v;
        const float o = (yn + bonus) * GB[(size_t)tau * A_W + col];
        OB[(size_t)tau * DM + col] = (bf16_t)(cvt_pk_bf16(o, o) & 0xffffu);
    }
}
namespace att {
constexpr int DK = 192, DV = 128, NW = 8, QBLK = 32, KVBLK = 64;
constexpr float SCALE = 0.07216878364870322f;
constexpr float THR = 8.f;
#ifndef ATT_SDEPTH
#define ATT_SDEPTH 2
#endif
constexpr int SDEPTH = ATT_SDEPTH;
constexpr int LDQ = 2304, LDK = 2304, LDV = 3072, LDO = 4096;
constexpr int SHM_V = KVBLK * DV * 2, SHM_K = KVBLK * DK * 2, SHM_ATTN = 2 * SHM_V + 2 * SHM_K + NW * 64 * 4;
using bf16x8 = __attribute__((ext_vector_type(8))) short;
using s16x4  = __attribute__((ext_vector_type(4))) short;
using f32x16 = __attribute__((ext_vector_type(16))) float;
using u32x4  = __attribute__((ext_vector_type(4))) unsigned;
#define KSWZ(row, colB) ((row) * 384 + ((colB) ^ (((row) & 7) << 4)))
#define SBAR() __builtin_amdgcn_sched_barrier(0)
__device__ __forceinline__ int crow(int r, int hi) { return (r & 3) + 8 * (r >> 2) + 4 * hi; }
__device__ __forceinline__ unsigned cvtpk(float lo, float hi) { unsigned r; asm volatile("v_cvt_pk_bf16_f32 %0, %1, %2" : "=v"(r) : "v"(lo), "v"(hi)); return r; }
__device__ __forceinline__ void partialSM(f32x16& p0, f32x16& p1, float& m_reg, float& mn, float& alpha) {
  constexpr float C = SCALE * 1.4426950408889634f;
  float pmax = p0[0]; for (int r = 1; r < 16; ++r) pmax = fmaxf(pmax, p0[r]); for (int r = 0; r < 16; ++r) pmax = fmaxf(pmax, p1[r]);
  { auto rr = __builtin_amdgcn_permlane32_swap(__float_as_uint(pmax), __float_as_uint(pmax), false, false);
    pmax = fmaxf(__uint_as_float(rr[0]), __uint_as_float(rr[1])); }
  if (__builtin_expect(__all(pmax - m_reg <= THR / SCALE), 1)) { mn = m_reg; alpha = 1.f; }
  else { mn = fmaxf(m_reg, pmax); alpha = __builtin_amdgcn_exp2f((m_reg - mn) * C); m_reg = mn; }
  float mnC = -mn * C;
  for (int r = 0; r < 16; ++r) p0[r] = fmaf(p0[r], C, mnC); for (int r = 0; r < 16; ++r) p1[r] = fmaf(p1[r], C, mnC);
  for (int r = 0; r < 16; ++r) p0[r] = __builtin_amdgcn_exp2f(p0[r]);
}
__device__ __forceinline__ void finishSM(f32x16& p0, f32x16& p1, float alpha, float& l_reg, bf16x8& pa0, bf16x8& pa1, bf16x8& pa2, bf16x8& pa3) {
  for (int r = 0; r < 16; ++r) p1[r] = __builtin_amdgcn_exp2f(p1[r]);
  float ps = 0; for (int r = 0; r < 16; ++r) ps += p0[r]; for (int r = 0; r < 16; ++r) ps += p1[r];
  { auto rr = __builtin_amdgcn_permlane32_swap(__float_as_uint(ps), __float_as_uint(ps), false, false);
    ps = __uint_as_float(rr[0]) + __uint_as_float(rr[1]); }
  l_reg = l_reg * alpha + ps;
#define PK4(P, BASE, OUT) do { unsigned a0 = cvtpk(P[BASE + 0], P[BASE + 1]), a1 = cvtpk(P[BASE + 2], P[BASE + 3]);   \
    unsigned b0 = cvtpk(P[BASE + 4], P[BASE + 5]), b1 = cvtpk(P[BASE + 6], P[BASE + 7]);                              \
    auto r0 = __builtin_amdgcn_permlane32_swap(a0, b0, false, false); auto r1 = __builtin_amdgcn_permlane32_swap(a1, b1, false, false); \
    u32x4 w = {r0[0], r1[0], r0[1], r1[1]}; OUT = *reinterpret_cast<bf16x8*>(&w); } while (0)
  PK4(p0, 0, pa0); PK4(p0, 8, pa1); PK4(p1, 0, pa2); PK4(p1, 8, pa3);
#undef PK4
}
__device__ __forceinline__ void qkt(f32x16& p0, f32x16& p1, const char* Ks, const bf16x8* qr, int r32, int hi) {
  p0 = f32x16{}; p1 = f32x16{};
#pragma unroll
  for (int d0 = 0; d0 < 12; ++d0) { int cb = (d0 * 16 + hi * 8) * 2;
    bf16x8 b0 = *reinterpret_cast<const bf16x8*>(Ks + KSWZ(r32, cb));
    bf16x8 b1 = *reinterpret_cast<const bf16x8*>(Ks + KSWZ(32 + r32, cb));
    p0 = __builtin_amdgcn_mfma_f32_32x32x16_bf16(b0, qr[d0], p0, 0, 0, 0);
    p1 = __builtin_amdgcn_mfma_f32_32x32x16_bf16(b1, qr[d0], p1, 0, 0, 0); }
}
__device__ __forceinline__ int v_st(int k, int c) { const int kk = (k & ~0xC) | ((k & 4) << 1) | ((k & 8) >> 1); return ((kk >> 3) * 4 + (c >> 5)) * 512 + ((kk & 7) * 32 + (c & 31)) * 2; }
__device__ __forceinline__ int v_rd_base(int lane) { return ((lane & 3) << 3) | (((lane >> 2) & 3) << 6) | (((lane >> 4) & 1) << 5) | (((lane >> 5) & 1) << 8); }
constexpr int v_rd_off(int d0, int ks, int half) { return d0 * 512 + ks * 4096 + half * 2048; }
template <int OFF> __device__ __forceinline__ s16x4 tr_read(int vb) {
  s16x4 r; asm volatile("ds_read_b64_tr_b16 %0, %1 offset:%2" : "=&v"(r) : "v"(vb), "i"(OFF) : "memory"); return r;
}
template <int D0> __device__ __forceinline__ void pv_one(f32x16& od, int vb, bf16x8 pa0, bf16x8 pa1, bf16x8 pa2, bf16x8 pa3) {
  const s16x4 l0 = tr_read<v_rd_off(D0, 0, 0)>(vb), h0 = tr_read<v_rd_off(D0, 0, 1)>(vb), l1 = tr_read<v_rd_off(D0, 1, 0)>(vb), h1 = tr_read<v_rd_off(D0, 1, 1)>(vb);
  const s16x4 l2 = tr_read<v_rd_off(D0, 2, 0)>(vb), h2 = tr_read<v_rd_off(D0, 2, 1)>(vb), l3 = tr_read<v_rd_off(D0, 3, 0)>(vb), h3 = tr_read<v_rd_off(D0, 3, 1)>(vb);
  asm volatile("s_waitcnt lgkmcnt(0)" ::: "memory"); SBAR();
#define PK(L, H) (bf16x8){L[0], L[1], L[2], L[3], H[0], H[1], H[2], H[3]}
  od = __builtin_amdgcn_mfma_f32_32x32x16_bf16(pa0, PK(l0, h0), od, 0, 0, 0);
  od = __builtin_amdgcn_mfma_f32_32x32x16_bf16(pa1, PK(l1, h1), od, 0, 0, 0);
  od = __builtin_amdgcn_mfma_f32_32x32x16_bf16(pa2, PK(l2, h2), od, 0, 0, 0);
  od = __builtin_amdgcn_mfma_f32_32x32x16_bf16(pa3, PK(l3, h3), od, 0, 0, 0);
#undef PK
}
__device__ __forceinline__ void pv_d0(f32x16* o, int vb, bf16x8 pa0, bf16x8 pa1, bf16x8 pa2, bf16x8 pa3) {
  pv_one<0>(o[0], vb, pa0, pa1, pa2, pa3); pv_one<1>(o[1], vb, pa0, pa1, pa2, pa3); pv_one<2>(o[2], vb, pa0, pa1, pa2, pa3); pv_one<3>(o[3], vb, pa0, pa1, pa2, pa3);
}
__device__ __forceinline__ void attn_body(const bf16_t* __restrict__ Qb, const bf16_t* __restrict__ Kh, const bf16_t* __restrict__ Vh, bf16_t* __restrict__ Ob, int seq, char* lds) {
  int tid_ = threadIdx.x; asm volatile("" : "+v"(tid_));
  const int tid = tid_, wid = tid >> 6, lane = tid & 63, r32 = lane & 31, hi = lane >> 5;
  char* V_lds = lds; char* K_lds = lds + 2 * SHM_V;
  float* ws = (float*)(lds + 2 * SHM_V + 2 * SHM_K) + wid * 64; float* li_l = ws; float* al_l = ws + 32;
  float m_reg = -1e30f, l_reg = 0; f32x16 o[4] = {}; bf16x8 qr[12];
  const bf16_t* Qw = Qb + (long)(wid * QBLK + r32) * LDQ + hi * 8;
#pragma unroll
  for (int d0 = 0; d0 < 12; ++d0) qr[d0] = *reinterpret_cast<const bf16x8*>(Qw + d0 * 16);
  unsigned kgo[3], vgo[2];
#pragma unroll
  for (int i = 0; i < 3; ++i) { const int p = (i * 8 + wid) * 64 + lane, row = p / 24, slot = p % 24, ch = slot ^ (row & 7); kgo[i] = (unsigned)(row * LDK + ch * 8) * 2u; }
#pragma unroll
  for (int i = 0; i < 2; ++i) { const int p = (i * 8 + wid) * 64 + lane, sub = p >> 5, within = p & 31, kk = (sub >> 2) * 8 + (within >> 2), c = (sub & 3) * 32 + (within & 3) * 8;
    const int k = (kk & ~0xC) | ((kk & 4) << 1) | ((kk & 8) >> 1); vgo[i] = (unsigned)(k * LDV + c) * 2u; }
  const int vb0 = (int)(uintptr_t)V_lds + v_rd_base(lane);
  typedef __attribute__((address_space(3))) unsigned lds_u32;
#define DMA(b, k0) do { const char* kg = (const char*)Kh + (size_t)(k0) * (LDK * 2); const char* vg = (const char*)Vh + (size_t)(k0) * (LDV * 2); \
    _Pragma("unroll") for (int _i = 0; _i < 3; ++_i) __builtin_amdgcn_global_load_lds((const unsigned*)(kg + kgo[_i]), (lds_u32*)(K_lds + (b) * SHM_K + (_i * 8 + wid) * 1024), 16, 0, 0); \
    _Pragma("unroll") for (int _i = 0; _i < 2; ++_i) __builtin_amdgcn_global_load_lds((const unsigned*)(vg + vgo[_i]), (lds_u32*)(V_lds + (b) * SHM_V + (_i * 8 + wid) * 1024), 16, 0, 0); } while (0)
#define RESC(a) do { if (__any((a) < 1.f)) { if (hi == 0) al_l[r32] = (a); asm volatile("s_waitcnt lgkmcnt(0)" ::: "memory"); \
    for (int d = 0; d < 4; ++d) for (int r = 0; r < 16; ++r) o[d][r] *= al_l[crow(r, hi)]; } } while (0)
  f32x16 p0, p1; float mn, al; bf16x8 pa0, pa1, pa2, pa3; const int NT = seq / KVBLK;
  DMA(0, 0); asm volatile("s_waitcnt vmcnt(0)" ::: "memory"); __syncthreads();
#define TILE(b) do { SBAR(); qkt(p0, p1, K_lds + (b) * SHM_K, qr, r32, hi); partialSM(p0, p1, m_reg, mn, al); RESC(al); \
    finishSM(p0, p1, al, l_reg, pa0, pa1, pa2, pa3); SBAR(); pv_d0(o, vb0 + (b) * (int)SHM_V, pa0, pa1, pa2, pa3); } while (0)
  for (int j = 0; j < NT; j += 2) {
    DMA(1, (j + 1) * KVBLK);
    TILE(0); asm volatile("s_waitcnt vmcnt(0)" ::: "memory"); __syncthreads();
    if (j + 2 < NT) DMA(0, (j + 2) * KVBLK);
    TILE(1); asm volatile("s_waitcnt vmcnt(0)" ::: "memory"); __syncthreads();
  }
#undef TILE
#undef DMA
  if (hi == 0) li_l[r32] = l_reg; asm volatile("s_waitcnt lgkmcnt(0)" ::: "memory");
  float rli[16];
#pragma unroll
  for (int r = 0; r < 16; ++r) rli[r] = __builtin_amdgcn_rcpf(li_l[crow(r, hi)]);
  bf16_t* Ow = Ob + (long)(wid * QBLK) * LDO;
#pragma unroll
  for (int r = 0; r < 16; ++r) { int orow = crow(r, hi);
#pragma unroll
    for (int d0 = 0; d0 < 4; ++d0) { const float val = o[d0][r] * rli[r]; Ow[(long)orow * LDO + d0 * 32 + r32] = (bf16_t)(cvtpk(val, val) & 0xffff); } }
  __syncthreads();
#undef RESC
}
}
__device__ __forceinline__ void scan_chain(const Frame& F, unsigned char* ws, int chain) {
    const int h = chain >> 1, d = chain & 1, tid = F.tid, lane = F.lane;
    const float* SSh = (const float*)(ws + WS_SS) + (size_t)h * T * 192; const float* SDh = (const float*)(ws + WS_SD) + ((size_t)h * 2 + d) * T * 192;
    float* Yd = (float*)(ws + WS_Y) + (size_t)d * T * A_W + h * 64;
    LAS float* buf = (LAS float*)F.lds;
    constexpr int NCH = T / 32;
    f32x4 st[6];
#define SC_TAULO(c) (d == 0 ? 32 * (c) : ((c) < 8 ? 224 - 32 * (c) : (T - 32) - 32 * ((c) - 8)))
#define SC_LOAD(c) do { const int tl_ = SC_TAULO(c); _Pragma("unroll") for (int i_ = 0; i_ < 6; ++i_) { const int idx = tid + 512 * i_; \
        st[i_] = idx < 1536 ? *(const f32x4*)(SSh + (size_t)tl_ * 192 + idx * 4) : *(const f32x4*)(SDh + (size_t)tl_ * 192 + (idx - 1536) * 4); } } while (0)
#define SC_WRITE(b) do { _Pragma("unroll") for (int i_ = 0; i_ < 6; ++i_) { const int idx = tid + 512 * i_, id2 = idx < 1536 ? idx : idx - 1536; \
        *(LAS f32x4*)(buf + (b) * 12288 + (id2 / 48) * 384 + (idx < 1536 ? 0 : 192) + (id2 % 48) * 4) = st[i_]; } } while (0)
    f32x2 S[32];
#pragma unroll
    for (int j = 0; j < 32; ++j) S[j] = (f32x2){0.f, 0.f};
    SC_LOAD(0); SC_WRITE(0); __syncthreads();
    for (int c = 0; c < NCH; ++c) {
        if (c + 1 < NCH) SC_LOAD(c + 1);
        if (F.wave == 0) {
            const int tau_lo = SC_TAULO(c);
            for (int i = 0; i < 32; ++i) {
                const int slot = d ? 31 - i : i;
                const LAS float* p = buf + (c & 1) * 12288 + slot * 384;
                const float v = p[128 + lane];
                f32x2 ac0 = (f32x2){0.f, 0.f}, ac1 = ac0, ac2 = ac0, ac3 = ac0;
#pragma unroll
                for (int j = 0; j < 32; j += 4) { const f32x4 k0 = *(const LAS f32x4*)(p + 2 * j), k1 = *(const LAS f32x4*)(p + 2 * j + 4);
                    ac0 += S[j] * (f32x2){k0.x, k0.y}; ac1 += S[j + 1] * (f32x2){k0.z, k0.w}; ac2 += S[j + 2] * (f32x2){k1.x, k1.y}; ac3 += S[j + 3] * (f32x2){k1.z, k1.w}; }
                const f32x2 at = (ac0 + ac1) + (ac2 + ac3);
                const float sa = -(at.x + at.y);
                f32x2 y0 = (f32x2){0.f, 0.f}, y1 = y0;
#pragma unroll
                for (int j = 0; j < 32; j += 2) { const f32x4 w4 = *(const LAS f32x4*)(p + 192 + 2 * j), b4 = *(const LAS f32x4*)(p + 256 + 2 * j), k4 = *(const LAS f32x4*)(p + 320 + 2 * j), r4 = *(const LAS f32x4*)(p + 64 + 2 * j);
                    S[j] = S[j] * (f32x2){w4.x, w4.y} + ((f32x2){b4.x, b4.y} * sa + (f32x2){k4.x, k4.y} * v);
                    S[j + 1] = S[j + 1] * (f32x2){w4.z, w4.w} + ((f32x2){b4.z, b4.w} * sa + (f32x2){k4.z, k4.w} * v);
                    y0 += S[j] * (f32x2){r4.x, r4.y}; y1 += S[j + 1] * (f32x2){r4.z, r4.w}; }
                Yd[(size_t)(tau_lo + slot) * A_W + lane] = (y0.x + y0.y) + (y1.x + y1.y);
            }
        }
        if (c + 1 < NCH) SC_WRITE((c + 1) & 1);
        __syncthreads();
    }
#undef SC_TAULO
#undef SC_LOAD
#undef SC_WRITE
}
__device__ __forceinline__ f32x2 cmul(f32x2 a, f32x2 b) { return (f32x2){a.x * b.x - a.y * b.y, a.x * b.y + a.y * b.x}; }
__device__ __forceinline__ int rev4_14(int k) { const unsigned r = __brev((unsigned)k) >> 18; return (int)(((r & 0x1555u) << 1) | ((r >> 1) & 0x1555u)); }
__device__ __forceinline__ void fft16k_dif(LAS f32x2* Z, int tid) {
#pragma unroll 1
    for (int s = 0; s < 7; ++s) { int lq = 12 - 2 * s; asm volatile("" : "+s"(lq)); const int q = 1 << lq;
#pragma unroll 2
        for (int i = 0; i < 8; ++i) { const int b = tid + 512 * i, j = b & (q - 1), base = ((b >> lq) << (lq + 2)) + j;
            const f32x2 a0 = Z[base], a1 = Z[base + q], a2 = Z[base + 2 * q], a3 = Z[base + 3 * q];
            const f32x2 t0 = a0 + a2, t1 = a0 - a2, t2 = a1 + a3, t3 = a1 - a3;
            float sn, cs; sincospif((float)j / (float)(2 * q), &sn, &cs);
            const f32x2 w1 = (f32x2){cs, -sn}, w2 = cmul(w1, w1), w3 = cmul(w2, w1);
            Z[base] = t0 + t2; Z[base + q] = cmul((f32x2){t1.x + t3.y, t1.y - t3.x}, w1); Z[base + 2 * q] = cmul(t0 - t2, w2); Z[base + 3 * q] = cmul((f32x2){t1.x - t3.y, t1.y + t3.x}, w3); }
        __syncthreads(); }
}
__device__ __forceinline__ void fft16k_dit_inv(LAS f32x2* Z, int tid) {
#pragma unroll 1
    for (int s = 0; s < 7; ++s) { int lq = 2 * s; asm volatile("" : "+s"(lq)); const int q = 1 << lq;
#pragma unroll 2
        for (int i = 0; i < 8; ++i) { const int b = tid + 512 * i, j = b & (q - 1), base = ((b >> lq) << (lq + 2)) + j;
            float sn, cs; sincospif((float)j / (float)(2 * q), &sn, &cs);
            const f32x2 w1 = (f32x2){cs, sn}, w2 = cmul(w1, w1), w3 = cmul(w2, w1);
            const f32x2 b0 = Z[base], b1 = cmul(Z[base + q], w1), b2 = cmul(Z[base + 2 * q], w2), b3 = cmul(Z[base + 3 * q], w3);
            const f32x2 t0 = b0 + b2, t1 = b0 - b2, t2 = b1 + b3, t3 = b1 - b3;
            Z[base] = t0 + t2; Z[base + q] = (f32x2){t1.x - t3.y, t1.y + t3.x}; Z[base + 2 * q] = t0 - t2; Z[base + 3 * q] = (f32x2){t1.x + t3.y, t1.y - t3.x}; }
        __syncthreads(); }
}
constexpr float HY_MIN_DECAY = -3.0701134573253945f, HY_MAX_DECAY = -15.350567286626973f;
__device__ __forceinline__ float hy_delta(int c) { return fabsf(HY_MIN_DECAY + (HY_MAX_DECAY - HY_MIN_DECAY) * ((float)c / 1279.0f)); }
__device__ __forceinline__ float conv3b_at(const float* PX, int tau, int col, const float* cw, int l, int c) {
    const float* w = cw + (size_t)l * 3 * B_IN;
    return conv3_at(PX, tau, col, w[c], w[B_IN + c], w[2 * B_IN + c]);
}
__device__ __forceinline__ void hyena_unit(const Frame& F, unsigned char* ws, int l, int pair) {
    LAS f32x2* Z = (LAS f32x2*)F.lds; LAS float* red = (LAS float*)(F.lds + LDS_MISC + 128);
    const int tid = F.tid, c0 = 2 * pair;
    const float* PX = (const float*)(ws + WS_PX); const float* H3x = (const float*)(ws + WS_H3) + ((size_t)l * T + NCTX) * 64;
    f32x2* scr = (f32x2*)(ws + WS_HSCR) + (size_t)F.bid * 16384; bf16_t* OB = (bf16_t*)(ws + WS_OBUF);
    LAS f32x4* FW = (LAS f32x4*)(F.lds + LDS_MISC + 256);
    if (tid < 256) { const int j = tid >> 2, q = tid & 3; ((LAS float*)FW)[tid] = IN_(35)[(size_t)l * 64 * 2560 + (size_t)j * 2560 + (q >> 1) * 1280 + c0 + (q & 1)]; }
    __syncthreads();
    const float d0 = hy_delta(c0), d1 = hy_delta(c0 + 1);
#ifndef HYS
#define HYS 31
#endif
    float s0 = 0.f, s1 = 0.f;
    if (HYS & 1)
#pragma unroll 1
    for (int i = 0; i < 16; ++i) { const int t = tid + 512 * i; const f32x4* hr = (const f32x4*)(H3x + (size_t)t * 64);
        asm volatile("" ::: "memory");
        f32x4 acc = (f32x4){0.f, 0.f, 0.f, 0.f};
#pragma unroll 2
        for (int j4 = 0; j4 < 16; ++j4) { const f32x4 hv = hr[j4];
#pragma unroll
            for (int q = 0; q < 4; ++q) acc += FW[4 * j4 + q] * hv[q]; }
        const float tl = (float)t * (1.0f / 8191.0f), e0 = __expf(-tl * d0), e1 = __expf(-tl * d1);
        const float f0 = acc.x * e0, f1 = acc.y * e1, b0 = acc.z * e0, b1 = acc.w * e1;
        Z[t] = (f32x2){f0, f1}; s0 += fabsf(f0); s1 += fabsf(f1);
        if (t < 8191) { Z[16383 - t] = (f32x2){b0, b1}; s0 += fabsf(b0); s1 += fabsf(b1); } }
    if (tid == 0) Z[8192] = (f32x2){0.f, 0.f};
    s0 = wave_sum(s0); s1 = wave_sum(s1);
    if (F.lane == 0) { red[F.wave * 2] = s0; red[F.wave * 2 + 1] = s1; }
    __syncthreads();
    float n0 = 0.f, n1 = 0.f;
#pragma unroll
    for (int w = 0; w < 8; ++w) { n0 += red[2 * w]; n1 += red[2 * w + 1]; }
    const float sc0 = 1.0f / (16384.0f * n0), sc1 = 1.0f / (16384.0f * n1);
    if (HYS & 2) fft16k_dif(Z, tid);
#pragma unroll 4
    for (int i = 0; i < 32; ++i) scr[tid + 512 * i] = Z[tid + 512 * i];
    __syncthreads();
    const float* cwb = IN_(27); const float* cbb = IN_(28) + (size_t)l * B_IN;
    if (HYS & 4)
#pragma unroll 1
    for (int i = 0; i < 16; ++i) { const int t = tid + 512 * i, tau = NCTX + t;
        float u[4];
#pragma unroll
        for (int e = 0; e < 4; ++e) { const int c = ((e >> 1) + 1) * 1280 + c0 + (e & 1); u[e] = conv3b_at(PX, tau, PXB + c, cwb, l, c) + cbb[c]; }
        Z[t] = (f32x2){u[0] * u[2], u[1] * u[3]}; Z[8192 + t] = (f32x2){0.f, 0.f}; }
    __syncthreads();
    if (HYS & 2) fft16k_dif(Z, tid);
    if (HYS & 8)
#pragma unroll 2
    for (int i = 0; i < 17; ++i) { const int k = tid + 512 * i; if (i == 16 && tid != 0) break;
        const int pk = rev4_14(k & 16383), pn = rev4_14((16384 - k) & 16383);
        const f32x2 A = Z[pk], B = Z[pn], At = scr[pk], Bt = scr[pn];
        const f32x2 G0 = (f32x2){0.5f * (A.x + B.x), 0.5f * (A.y - B.y)}, G1 = (f32x2){0.5f * (A.y + B.y), -0.5f * (A.x - B.x)};
        const f32x2 H0 = (f32x2){0.5f * (At.x + Bt.x), 0.5f * (At.y - Bt.y)}, H1 = (f32x2){0.5f * (At.y + Bt.y), -0.5f * (At.x - Bt.x)};
        const f32x2 P0 = cmul(G0, H0), P1 = cmul(G1, H1);
        Z[pk] = (f32x2){P0.x - P1.y, P0.y + P1.x};
        if (pn != pk) Z[pn] = (f32x2){P0.x + P1.y, P1.x - P0.y}; }
    __syncthreads();
    if (HYS & 2) fft16k_dit_inv(Z, tid);
    const float bb0 = IN_(37)[l * 1280 + c0], bb1 = IN_(37)[l * 1280 + c0 + 1];
    if (HYS & 16)
#pragma unroll 1
    for (int i = 0; i < 16; ++i) { const int t = tid + 512 * i, tau = NCTX + t; const f32x2 z = Z[t];
        float u[6];
#pragma unroll
        for (int e = 0; e < 6; ++e) { const int c = (e >> 1) * 1280 + c0 + (e & 1); u[e] = conv3b_at(PX, tau, PXB + c, cwb, l, c) + cbb[c]; }
        const float o0 = u[0] * (z.x * sc0 + u[2] * u[4] * bb0), o1 = u[1] * (z.y * sc1 + u[3] * u[5] * bb1);
        *(unsigned*)(OB + (size_t)(NCTX + t) * DM + 1280 + c0) = cvt_pk_bf16(o0, o1); }
    __syncthreads();
}
__device__ __forceinline__ void hyena_ctx_unit(const Frame& F, unsigned char* ws, int l, int unit) {
    LAS float* TF = (LAS float*)F.lds; LAS float* TB = TF + 2048; LAS float* GG = TB + 2048; LAS float* X0 = GG + 2048;
    const int tid = F.tid, t = tid >> 1, cc = (tid & 1) * 4, cbase = unit * 8 + cc;
    const float* PX = (const float*)(ws + WS_PX); const float* H3c = (const float*)(ws + WS_H3) + (size_t)l * T * 64; bf16_t* OB = (bf16_t*)(ws + WS_OBUF);
    const float* cwb = IN_(27); const float* cbb = IN_(28) + (size_t)l * B_IN;
    { float f[4] = {0.f, 0.f, 0.f, 0.f}, b[4] = {0.f, 0.f, 0.f, 0.f}; const float* hr = H3c + (size_t)t * 64;
      for (int j = 0; j < 64; ++j) { const float hv = hr[j]; const float* wrow = IN_(35) + (size_t)l * 64 * 2560 + (size_t)j * 2560 + cbase;
#pragma unroll
          for (int q = 0; q < 4; ++q) { f[q] += hv * wrow[q]; b[q] += hv * wrow[1280 + q]; } }
      const float tl = (float)t * (1.0f / 255.0f);
#pragma unroll
      for (int q = 0; q < 4; ++q) { const float e = __expf(-tl * hy_delta(cbase + q)); TF[t * 8 + cc + q] = f[q] * e; TB[t * 8 + cc + q] = b[q] * e; }
      float u[12];
#pragma unroll
      for (int e = 0; e < 12; ++e) { const int c = (e >> 2) * 1280 + cbase + (e & 3); u[e] = conv3b_at(PX, t, PXB + c, cwb, l, c) + cbb[c]; }
#pragma unroll
      for (int q = 0; q < 4; ++q) { X0[t * 8 + cc + q] = u[q]; GG[t * 8 + cc + q] = u[4 + q] * u[8 + q]; } }
    __syncthreads();
    float nrm[4] = {0.f, 0.f, 0.f, 0.f}, y[4] = {0.f, 0.f, 0.f, 0.f};
    for (int s = 0; s < 256; ++s) {
#pragma unroll
        for (int q = 0; q < 4; ++q) { nrm[q] += fabsf(TF[s * 8 + cc + q]) + (s < 255 ? fabsf(TB[s * 8 + cc + q]) : 0.f);
            const int o = t - s; const float tap = o >= 0 ? TF[o * 8 + cc + q] : TB[(-o - 1) * 8 + cc + q];
            y[q] += tap * GG[s * 8 + cc + q]; } }
    float o4[4];
#pragma unroll
    for (int q = 0; q < 4; ++q) o4[q] = X0[t * 8 + cc + q] * (y[q] / nrm[q] + GG[t * 8 + cc + q] * IN_(37)[l * 1280 + cbase + q]);
    u32x2 w; w.x = cvt_pk_bf16(o4[0], o4[1]); w.y = cvt_pk_bf16(o4[2], o4[3]);
    *(u32x2*)(OB + (size_t)t * DM + 1280 + cbase) = w;
    __syncthreads();
}
__device__ __forceinline__ void mixer_phase(const Frame& F0, unsigned char* ws0, int l, bool need_ctx, char* lds_g) {
#ifndef MK_MIX
#define MK_MIX 15
#endif
    { const Frame F = opq(F0); unsigned char* ws = opq_ptr(ws0);
      if (MK_MIX & 1) for (int chain = F.bid; chain < 2 * NHA; chain += F.G) scan_chain(F, ws, chain); }
    const Frame& F = F0;
    const int n_att = 32 * NHC, n_hy = 640, n_ca = need_ctx ? NHC : 0, n_ch = need_ctx ? 160 : 0, total = n_att + n_hy + n_ca + n_ch;
    unsigned* qhead = (unsigned*)(ws0 + WS_CTL) + CW_QUEUE + 64 * l;
    for (;;) {
        if (F.tid == 0) F.MISC[16] = __hip_atomic_fetch_add(qhead, 1u, __ATOMIC_RELAXED, __HIP_MEMORY_SCOPE_AGENT);
        __syncthreads();
        const int item = (int)F.MISC[16];
        __syncthreads();
        if (item >= total) break;
        const Frame Fu = opq(F0); unsigned char* ws = opq_ptr(ws0);
        const bf16_t* QF = (const bf16_t*)(ws + WS_QF); const bf16_t* KF = (const bf16_t*)(ws + WS_KF); const bf16_t* KVRAW = (const bf16_t*)(ws + WS_KVRAW); bf16_t* OB = (bf16_t*)(ws + WS_OBUF);
        const bool is_xa = item < n_att, is_ca = item >= n_att + n_hy && item < n_att + n_hy + n_ca;
        if ((MK_MIX & 2) && (is_xa || is_ca)) { const int h = is_xa ? item % NHC : item - n_att - n_hy, row0 = is_xa ? NCTX + (item / NHC) * 256 : 0;
            att::attn_body(QF + (size_t)row0 * NQ + h * 192, KF + h * 192, KVRAW + h * 256 + 128, OB + (size_t)row0 * DM + 2560 + h * 128, is_xa ? T : NCTX, lds_g); }
        else if ((MK_MIX & 4) && item >= n_att && item < n_att + n_hy) hyena_unit(Fu, ws, l, item - n_att);
        else if ((MK_MIX & 8) && item >= n_att + n_hy + n_ca) hyena_ctx_unit(Fu, ws, l, item - n_att - n_hy - n_ca);
    }
}

constexpr int NPH = 2 + 14 * NL;
__global__ void __launch_bounds__(512, 2) mk_fwd(Args a) {
    extern __shared__ __attribute__((aligned(16))) unsigned char lds[];
    Frame F; F.lds = (LAS unsigned char*)lds; F.MISC = (volatile LAS unsigned*)(F.lds + LDS_MISC);
    F.tid = threadIdx.x; F.lane = F.tid & 63; F.wave = __builtin_amdgcn_readfirstlane(F.tid >> 6); F.bid = blockIdx.x; F.G = gridDim.x;
    if (F.tid < 64) F.MISC[F.tid] = 0u;
    if (F.tid < 46) *(LAS unsigned long long*)(F.lds + LDS_PTAB + 8 * F.tid) = (unsigned long long)(uintptr_t)a.in[F.tid];
    __syncthreads();
    unsigned char* ws = a.ws;
    XcdBarrier bar = xcd_barrier_post((unsigned*)(ws + WS_CTL) + CW_BAR, F.MISC + 8);
    const int lo = a.ph_lo, hi = a.ph_hi;
#ifndef MK_MASK
#define MK_MASK 0xffff
#endif
#define EN(x) (((MK_MASK) >> (x)) & 1)
#define IN(k) (lo <= (k) && (k) < hi)
#define SEAM(k) do { if (IN(k) && IN((k) + 1)) xcd_barrier(bar); } while (0)
    float* XS = (float*)(ws + WS_XS); bf16_t* ABUF = (bf16_t*)(ws + WS_ABUF); bf16_t* HBUF = (bf16_t*)(ws + WS_HBUF); bf16_t* OBUF = (bf16_t*)(ws + WS_OBUF); float* PX = (float*)(ws + WS_PX);
    const float* MOD = (const float*)(ws + WS_MOD); const bf16_t* WB = (const bf16_t*)(ws + WS_WB);
    if (EN(0) && IN(0)) phase0(opq(F), opq_ptr(ws));
    SEAM(0);
    if (EN(1) && IN(1)) phase_mod(opq(F), opq_ptr(ws));
    SEAM(1);
#pragma unroll 1
    for (int l = 0; l < NL; ++l) {
        const int pb = 2 + 14 * l; const bool need_ctx = l < NL - 1;
        const float* modx = MOD + ((size_t)l * 2 + 0) * NMOD; const float* modc = MOD + ((size_t)l * 2 + 1) * NMOD;
        const bf16_t* wl = WB + (size_t)l * W_LAYER;
        if (EN(2) && IN(pb + 0)) norm_phase(opq(F), XS, IN_(7) + l * DM, modx, modc, 0, 1, ABUF);
        SEAM(pb + 0);
        if (EN(3) && IN(pb + 1)) { pg8::Gemm g{ABUF, wl + W_G1, T, 2 * FF, DM}; pg8::StaticOrder S; S.init(T, 2 * FF, F.G, F.bid); pg8::EpiSwiGLU E{HBUF, FF};
            pg8::gemm_phase<pg8::EpiSwiGLU, pg8::StaticOrder>(F.lds, g, S, E, nullptr); }
        SEAM(pb + 1);
        if (EN(4) && IN(pb + 2)) { pg8::Gemm g{HBUF, wl + W_D1, T, DM, FF}; pg8::StaticOrder S; S.init(T, DM, F.G, F.bid); pg8::EpiResid E{XS, modx + 2 * DM, modc + 2 * DM, 0.5f, nullptr};
            pg8::gemm_phase<pg8::EpiResid, pg8::StaticOrder>(F.lds, g, S, E, nullptr); }
        SEAM(pb + 2);
        if (EN(5) && IN(pb + 3)) norm_phase(opq(F), XS, IN_(8) + l * DM, modx, modc, 3, 4, ABUF);
        SEAM(pb + 3);
        if (EN(6) && IN(pb + 4)) { pg8::Gemm g{ABUF, wl + W_IN, T, PXW, DM}; pg8::StaticOrder S; S.init(T, PXW, F.G, F.bid); pg8::EpiF32 E{PX, PXW, nullptr};
            pg8::gemm_phase<pg8::EpiF32, pg8::StaticOrder>(F.lds, g, S, E, nullptr); }
        SEAM(pb + 4);
        if (EN(7) && IN(pb + 5)) { rwkv_prep_phase(opq(F), opq_ptr(ws), l); mla_prep_phase(opq(F), opq_ptr(ws), l); }
        SEAM(pb + 5);
        if (EN(8) && IN(pb + 6)) {
            { pg8::Gemm g{(const bf16_t*)(ws + WS_QA), wl + W_Q, T, NQ, 1024}; pg8::StaticOrder S; S.init(T, NQ, F.G, F.bid); pg8::EpiBf16<0> E{(bf16_t*)(ws + WS_QRAW), NQ, nullptr, 0, 0};
              pg8::gemm_phase<pg8::EpiBf16<0>, pg8::StaticOrder>(F.lds, g, S, E, nullptr); }
            __syncthreads();
            { pg8::Gemm g{(const bf16_t*)(ws + WS_KVA), wl + W_KV, T, NKV, 512}; pg8::StaticOrder S; S.init(T, NKV, F.G, F.bid); pg8::EpiBf16<0> E{(bf16_t*)(ws + WS_KVRAW), NKV, nullptr, 0, 0};
              pg8::gemm_phase<pg8::EpiBf16<0>, pg8::StaticOrder>(F.lds, g, S, E, nullptr); }
        }
        SEAM(pb + 6);
        if (EN(9) && IN(pb + 7)) qkv_final_phase(opq(F), opq_ptr(ws), l, need_ctx);
        SEAM(pb + 7);
        if (EN(10) && IN(pb + 8)) mixer_phase(F, ws, l, need_ctx, (char*)lds);
        SEAM(pb + 8);
        if (EN(11) && IN(pb + 9)) rwkv_out_phase(opq(F), opq_ptr(ws), l, need_ctx);
        SEAM(pb + 9);
        if (EN(12) && IN(pb + 10)) { pg8::Gemm g{OBUF, wl + W_OUT, T, DM, DM}; pg8::StaticOrder S; S.init(T, DM, F.G, F.bid); pg8::EpiResid E{XS, modx + 5 * DM, modc + 5 * DM, 1.0f, nullptr};
            pg8::gemm_phase<pg8::EpiResid, pg8::StaticOrder>(F.lds, g, S, E, nullptr); }
        SEAM(pb + 10);
        if (EN(13) && IN(pb + 11)) norm_phase(opq(F), XS, IN_(9) + l * DM, modx, modc, 6, 7, ABUF);
        SEAM(pb + 11);
        if (EN(14) && IN(pb + 12)) { pg8::Gemm g{ABUF, wl + W_G2, T, 2 * FF, DM}; pg8::StaticOrder S; S.init(T, 2 * FF, F.G, F.bid); pg8::EpiSwiGLU E{HBUF, FF};
            pg8::gemm_phase<pg8::EpiSwiGLU, pg8::StaticOrder>(F.lds, g, S, E, nullptr); }
        SEAM(pb + 12);
        if (EN(15) && IN(pb + 13)) { pg8::Gemm g{HBUF, wl + W_D2, T, DM, FF}; pg8::StaticOrder S; S.init(T, DM, F.G, F.bid); pg8::EpiResid E{XS, modx + 8 * DM, modc + 8 * DM, 0.5f, l == NL - 1 ? a.out : nullptr};
            pg8::gemm_phase<pg8::EpiResid, pg8::StaticOrder>(F.lds, g, S, E, nullptr); }
        SEAM(pb + 13);
    }
#undef IN
#undef SEAM
}

#ifndef MK_LAUNCHES
#define MK_LAUNCHES 1
#endif
extern "C" void kernel_launch(void* const* d_in, const int* in_sizes, int n_in, void* d_out, int out_size, void* d_ws, size_t ws_size, hipStream_t stream) {
    static int grid = 0;
    if (grid == 0) {
        if (n_in != 46 || in_sizes[0] != SEQ * DM || out_size != SEQ * DM || ws_size < WS_END) {
            fprintf(stderr, "kernel_launch: shape mismatch: n_in %d in0 %d out %d ws %zu (need %zu); nothing launched\n", n_in, n_in > 0 ? in_sizes[0] : -1, out_size, ws_size, (size_t)WS_END); grid = -1; return; }
        int dev = 0, cus = 0, per_cu = 0;
        if (hipGetDevice(&dev) != hipSuccess || hipDeviceGetAttribute(&cus, hipDeviceAttributeMultiprocessorCount, dev) != hipSuccess) { fprintf(stderr, "kernel_launch: device query failed\n"); grid = -1; return; }
        if (hipFuncSetAttribute((const void*)mk_fwd, hipFuncAttributeMaxDynamicSharedMemorySize, LDS_BYTES) != hipSuccess) { fprintf(stderr, "kernel_launch: hipFuncSetAttribute failed\n"); grid = -1; return; }
        if (hipOccupancyMaxActiveBlocksPerMultiprocessor(&per_cu, (const void*)mk_fwd, 512, LDS_BYTES) != hipSuccess || per_cu < 1) fprintf(stderr, "kernel_launch: note: occupancy query reports %d blocks per CU\n", per_cu);
        (void)hipGetLastError();
        grid = cus;
    }
    if (grid < 0) return;
    if (hipMemsetAsync((char*)d_ws + WS_CTL, 0, CTL_BYTES, stream) != hipSuccess) { fprintf(stderr, "kernel_launch: memset failed\n"); return; }
    Args a{};
    for (int i = 0; i < 46; ++i) a.in[i] = (const float*)d_in[i];
    a.out = (float*)d_out; a.ws = (unsigned char*)d_ws;
#if MK_LAUNCHES == 1
    a.ph_lo = 0; a.ph_hi = NPH;
    hipLaunchKernelGGL(mk_fwd, dim3(grid), dim3(512), LDS_BYTES, stream, a);
#else
    for (int p = 0; p < NPH; ++p) { a.ph_lo = p; a.ph_hi = p + 1; hipLaunchKernelGGL(mk_fwd, dim3(grid), dim3(512), LDS_BYTES, stream, a); }
#endif
    const hipError_t le = hipPeekAtLastError();
    if (le != hipSuccess) fprintf(stderr, "kernel_launch: launch failed: %s\n", hipGetErrorName(le));
}
```

```cpp
#include <hip/hip_runtime.h>
#include <stdint.h>
#include <cstdio>

#define LAS __attribute__((address_space(3)))
#define CAS __attribute__((address_space(4)))
typedef unsigned short bf16_t;
typedef float f32x4 __attribute__((ext_vector_type(4)));
typedef float f32x2 __attribute__((ext_vector_type(2)));
typedef unsigned u32x4 __attribute__((ext_vector_type(4)));
typedef unsigned u32x2 __attribute__((ext_vector_type(2)));

constexpr int T = 8448, NCTX = 256, SEQ = 8192, DM = 4096, FF = 6144, NL = 4;
constexpr int A_W = 1280, A_IN = 4160, B_IN = 3840, C_IN = 1600, NHA = 20;
constexpr int PXW = 9984, PXA = 0, PXB = 4352, PXC = 8192;
constexpr int NQ = 2304, NKV = 3072, NHC = 12;
constexpr int NMOD = 9 * DM;
constexpr float NORM_EPS = 1e-6f, GN_EPS = 64e-5f;

constexpr size_t MiB = 1u << 20;
constexpr size_t al(size_t x) { return (x + MiB - 1) / MiB * MiB; }
constexpr size_t WS_CTL = 0, CTL_BYTES = MiB;
constexpr size_t WS_XS = WS_CTL + CTL_BYTES;
constexpr size_t WS_ABUF = WS_XS + al((size_t)T * DM * 4);
constexpr size_t WS_HBUF = WS_ABUF + al((size_t)T * DM * 2);
constexpr size_t WS_OBUF = WS_HBUF + al((size_t)T * FF * 2);
constexpr size_t WS_PX = WS_OBUF + al((size_t)T * DM * 2);
constexpr size_t WS_MOD = WS_PX + al((size_t)T * PXW * 4);
constexpr size_t WS_HP = WS_MOD + al((size_t)NL * 2 * NMOD * 4);
constexpr size_t WS_SS = WS_HP + MiB;
constexpr size_t WS_SD = WS_SS + al((size_t)NHA * T * 192 * 4);
constexpr size_t WS_G = WS_SD + al((size_t)NHA * 2 * T * 192 * 4);
constexpr size_t WS_Y = WS_G + al((size_t)T * A_W * 4);
constexpr size_t WS_QA = WS_Y + al((size_t)2 * T * A_W * 4);
constexpr size_t WS_KVA = WS_QA + al((size_t)T * 1024 * 2);
constexpr size_t WS_KPE = WS_KVA + al((size_t)T * 512 * 2);
constexpr size_t WS_QRAW = WS_KPE + al((size_t)T * 64 * 2);
constexpr size_t WS_KVRAW = WS_QRAW + al((size_t)T * NQ * 2);
constexpr size_t WS_QF = WS_KVRAW + al((size_t)T * NKV * 2);
constexpr size_t WS_KF = WS_QF + al((size_t)T * NQ * 2);
constexpr size_t WS_H3 = WS_KF + al((size_t)T * NQ * 2);
constexpr size_t WS_HSCR = WS_H3 + al((size_t)NL * T * 64 * 4);
constexpr size_t WS_FR = WS_HSCR + al((size_t)256 * 16384 * 8);
constexpr size_t WS_WB = WS_FR + al((size_t)40 * 528 * (13 * 1024 + 256));
constexpr size_t W_G1 = 0, W_D1 = W_G1 + (size_t)2 * FF * DM, W_IN = W_D1 + (size_t)DM * FF, W_OUT = W_IN + (size_t)PXW * DM, W_G2 = W_OUT + (size_t)DM * DM,
                 W_D2 = W_G2 + (size_t)2 * FF * DM, W_Q = W_D2 + (size_t)DM * FF, W_KV = W_Q + (size_t)NQ * 1024, W_LAYER = W_KV + (size_t)NKV * 512;
constexpr size_t WS_END = WS_WB + al(W_LAYER * NL * 2);
constexpr int CW_BAR = 4096;
constexpr int CW_QUEUE = 8192;

constexpr int LDS_MISC = 131072, LDS_BYTES = 147456;

__device__ __forceinline__ float wave_sum(float v) {
#pragma unroll
    for (int o = 1; o < 64; o <<= 1) v += __shfl_xor(v, o);
    return v;
}
typedef __bf16 bf16x2_t __attribute__((ext_vector_type(2)));
__device__ __forceinline__ unsigned cvt_pk_bf16(float lo, float hi) { const f32x2 v = {lo, hi}; return __builtin_bit_cast(unsigned, __builtin_convertvector(v, bf16x2_t)); }
__device__ __forceinline__ float bf2f(unsigned short b) { return __uint_as_float(((unsigned)b) << 16); }
__device__ __forceinline__ float sigmoidf_(float x) { return 1.0f / (1.0f + __expf(-x)); }
__device__ __forceinline__ float siluf_(float x) { return x / (1.0f + __expf(-x)); }
__device__ __forceinline__ bool has_left(int tau) { return tau != 0 && tau != NCTX; }
__device__ __forceinline__ bool has_right(int tau) { return tau != NCTX - 1 && tau != T - 1; }

struct Args { const float* in[46]; float* out; unsigned char* ws; int ph_lo, ph_hi; };
struct Frame { LAS unsigned char* lds; volatile LAS unsigned* MISC; int tid, lane, wave, bid, G; };
constexpr int LDS_PTAB = LDS_MISC + 2048;
__device__ __forceinline__ const float* inp(const Frame& F, int i) {
    const volatile LAS unsigned* p = (const volatile LAS unsigned*)(F.lds + LDS_PTAB) + 2 * i;
    const unsigned lo = __builtin_amdgcn_readfirstlane(p[0]), hi = __builtin_amdgcn_readfirstlane(p[1]);
    return (const float*)(((unsigned long long)hi << 32) | lo);
}
#define IN_(i) inp(F, (i))
__device__ __forceinline__ Frame opq(const Frame& F) { Frame G = F; asm volatile("" : "+v"(G.tid), "+v"(G.lane), "+s"(G.wave), "+s"(G.bid)); return G; }
__device__ __forceinline__ unsigned char* opq_ptr(unsigned char* p) { asm volatile("" : "+s"(p)); return p; }
#define XB_TMO      128
#define XB_XCNT(j)  (256  + 64 * (j))
#define XB_XSUB(j)  (1280 + 64 * (j))
#define XB_XGEN(j)  (2304 + 64 * (j))
#define XB_TOP      3328
#define XB_TOPGEN   3392
#define XCD_BAR_WORDS 3456
#define XB_SPIN_CAP (1u << 18)

__device__ __forceinline__ unsigned xb_ld(unsigned* p)              { return __hip_atomic_load(p, __ATOMIC_RELAXED, __HIP_MEMORY_SCOPE_AGENT); }
__device__ __forceinline__ unsigned xb_add(unsigned* p, unsigned v) { return __hip_atomic_fetch_add(p, v, __ATOMIC_RELAXED, __HIP_MEMORY_SCOPE_AGENT); }
__device__ __forceinline__ unsigned xb_xcc_id() { return (unsigned)__builtin_amdgcn_s_getreg((3 << 11) | 20) & 0xFu; }
#define XB_SPIN(cond, bar) do { unsigned _sp = 0; while (cond) { __builtin_amdgcn_s_sleep(1); \
    if ((++_sp & 255u) == 0u) { if (xb_ld(&(bar)[XB_TMO])) break; if (_sp > XB_SPIN_CAP) { atomicAdd(&(bar)[XB_TMO], 1u); break; } } } } while (0)

struct XcdBarrier {
    unsigned* bar; unsigned x;
    volatile LAS unsigned* st;
};

__device__ __forceinline__ XcdBarrier xcd_barrier_post(unsigned* bar, volatile LAS unsigned* st) {
    XcdBarrier b; b.bar = bar; b.x = xb_xcc_id(); b.st = st;
    if (threadIdx.x == 0) (void)xb_add(&bar[XB_XCNT(b.x)], 1u);
    return b;
}
__device__ __forceinline__ void xcd_barrier_complete(unsigned* bar, unsigned x, unsigned& nloc, unsigned& nx) {
    const unsigned G = gridDim.x * gridDim.y * gridDim.z;
    unsigned sum, cnt, mine, sp = 0u;
    for (;;) {
        sum = 0u; cnt = 0u; mine = 0u;
#pragma unroll
        for (unsigned j = 0; j < 16; ++j) { const unsigned c = xb_ld(&bar[XB_XCNT(j)]); sum += c; cnt += (c > 0u) ? 1u : 0u; mine = (j == x) ? c : mine; }
        if (sum == G) break;
        __builtin_amdgcn_s_sleep(1);
        if ((++sp & 255u) == 0u) { if (xb_ld(&bar[XB_TMO])) break; if (sp > XB_SPIN_CAP) { atomicAdd(&bar[XB_TMO], 1u); break; } }
    }
    nloc = mine > 0u ? mine : 1u; nx = cnt > 0u ? cnt : 1u;
}

__device__ __forceinline__ void xcd_barrier(const XcdBarrier& b) {
    asm volatile("s_waitcnt vmcnt(0)" ::: "memory");
    __syncthreads();
    if (threadIdx.x == 0) {
        unsigned* bar = b.bar;
        __builtin_amdgcn_s_waitcnt(0);
        unsigned nloc = b.st[0], nx = b.st[1];
        if (nloc == 0u) { xcd_barrier_complete(bar, b.x, nloc, nx); b.st[0] = nloc; b.st[1] = nx; }
        const unsigned old = xb_add(&bar[XB_XSUB(b.x)], 1u);
        const unsigned gen = old / nloc;
        if (old + 1u == (gen + 1u) * nloc) {
            __builtin_amdgcn_fence(__ATOMIC_RELEASE, "agent");
            asm volatile("s_waitcnt vmcnt(0)" ::: "memory");
            const unsigned og = xb_add(&bar[XB_TOP], 1u);
            const unsigned tg = og / nx;
            if (og + 1u == (tg + 1u) * nx) xb_add(&bar[XB_TOPGEN], 1u);
            else XB_SPIN(xb_ld(&bar[XB_TOPGEN]) == tg, bar);
            __builtin_amdgcn_fence(__ATOMIC_ACQUIRE, "agent");
            xb_add(&bar[XB_XGEN(b.x)], 1u);
            asm volatile("s_waitcnt vmcnt(0)" ::: "memory");
        } else {
            XB_SPIN(xb_ld(&bar[XB_XGEN(b.x)]) == gen, bar);
            __builtin_amdgcn_fence(__ATOMIC_ACQUIRE, "agent");
            asm volatile("s_waitcnt vmcnt(0)" ::: "memory");
        }
    }
    __syncthreads();
}
namespace pg8 {
#define PG8_LAS __attribute__((address_space(3)))
typedef unsigned short bf16_t;
typedef short bf16x8 __attribute__((ext_vector_type(8)));
typedef float f32x4 __attribute__((ext_vector_type(4)));
typedef unsigned u32x4 __attribute__((ext_vector_type(4)));
constexpr int BM = 256, BK = 64, HALF = 128, HTB = HALF * BK * 2  , STAGE_BYTES = 8 * HTB, NXCD = 8, WGM = 8;

__host__ __device__ __forceinline__ int lds_byte(int r, int c) { const int st = (r >> 4) * 2 + (c >> 5), rr = r & 15, cc = c & 31, ob = rr * 64 + cc * 2; return st * 1024 + (ob ^ (((ob >> 9) & 1) << 5)); }
__host__ __device__ __forceinline__ void stage_rc(int b, int& R, int& C) { const int st = b / 1024, sb = b % 1024, swz = sb ^ (((sb >> 9) & 1) << 5); R = (st >> 1) * 16 + swz / 64; C = (st & 1) * 32 + (swz % 64) / 2; }
__host__ __device__ __forceinline__ int perm32(int rho) { const int n = rho >> 4, i = rho & 15; return 8 * (i >> 2) + 4 * n + (i & 3); }

struct Unit { int pm, pn; };
struct Gemm { const bf16_t* A; const bf16_t* Bt; int M, N, K; };

struct StaticOrder {
    int nM, nN, nwg, G, c;
    __host__ __device__ void init(int M, int N, int G_, int c_) { nM = M / BM; nN = N / BM; nwg = nM * nN; G = G_; c = c_; }
    __host__ __device__ bool next(int i, Unit& u) const {
        const long L = (long)i * G + c; if (L >= nwg) return false;
        int wgid = (int)L; { const int q = nwg / NXCD, r = nwg % NXCD, xcd = wgid % NXCD, off = wgid / NXCD; wgid = (xcd < r ? xcd * (q + 1) : r * (q + 1) + (xcd - r) * q) + off; }
        const int nig = WGM * nN, gid = wgid / nig, fm = gid * WGM, gsz = (nM - fm) < WGM ? (nM - fm) : WGM;
        u.pm = fm + ((wgid % nig) % gsz); u.pn = (wgid % nig) / gsz; return true;
    }
    __device__ __forceinline__ void a_ready(const Unit&) const {}
    __device__ __forceinline__ void done(const Unit&) const {}
};
struct CountedOrder : StaticOrder {
    const unsigned* ready; unsigned need; unsigned* tmo;
    __device__ __forceinline__ void a_ready(const Unit& u) const {
        if (threadIdx.x < 64) {
            const unsigned long long t0 = __builtin_amdgcn_s_memrealtime(); unsigned polls = 0;
            while ((unsigned)__builtin_amdgcn_readfirstlane(__hip_atomic_load(ready + 64 * u.pm, __ATOMIC_RELAXED, __HIP_MEMORY_SCOPE_AGENT)) < need) {
                if ((++polls & 255u) == 0u && __builtin_amdgcn_readfirstlane(__hip_atomic_load(tmo, __ATOMIC_RELAXED, __HIP_MEMORY_SCOPE_AGENT)) != 0u) break;
                if (__builtin_amdgcn_s_memrealtime() - t0 > 2000000ull) {
                    if (threadIdx.x == 0) { unsigned expect = 0u; __hip_atomic_compare_exchange_strong(tmo + 1, &expect, 0x600u | (unsigned)(u.pm & 0xff), __ATOMIC_RELAXED, __ATOMIC_RELAXED, __HIP_MEMORY_SCOPE_AGENT); __hip_atomic_store(tmo, 1u, __ATOMIC_RELAXED, __HIP_MEMORY_SCOPE_AGENT); }
                    break; }
                __builtin_amdgcn_s_sleep(2); }
            __builtin_amdgcn_fence(__ATOMIC_ACQUIRE, "agent");
            asm volatile("s_waitcnt vmcnt(0)" ::: "memory");
        }
#if !defined(BROKEN_HOOK_NO_BARRIER)
        asm volatile("" ::: "memory"); __builtin_amdgcn_s_barrier(); asm volatile("" ::: "memory");
#endif
    }
};

__device__ __forceinline__ unsigned cvt_pk_bf16(float lo, float hi) { unsigned r; asm volatile("v_cvt_pk_bf16_f32 %0, %1, %2" : "=v"(r) : "v"(lo), "v"(hi)); return r; }
typedef float f32x2 __attribute__((ext_vector_type(2)));
__device__ __forceinline__ f32x2 gelu_pk(f32x2 v) {
    const f32x2 av = __builtin_elementwise_abs(v), d = av * 0.2316418882f + 1.0f;
    f32x2 t; t.x = __builtin_amdgcn_rcpf(d.x); t.y = __builtin_amdgcn_rcpf(d.y);
    f32x2 q = t * 0.5307027145f + (-0.7265760135f); q = q * t + 0.7107068705f; q = q * t + (-0.142248368f); q = q * t + 0.127414796f; q = q * t;
    const f32x2 s = (v * v) * (-0.72134752044f);
    f32x2 e; e.x = __builtin_amdgcn_exp2f(s.x); e.y = __builtin_amdgcn_exp2f(s.y);
    const f32x2 m = v * (q * e), r = v - m;
    f32x2 o; o.x = v.x < 0.f ? m.x : r.x; o.y = v.y < 0.f ? m.y : r.y; return o;
}

struct EpiF32 {
    static constexpr bool PERM = false, AFTER_DRAIN = false;
    float* C; int ldc; const float* bias;
    __device__ __forceinline__ void operator()(const f32x4 (&acc)[2][2][4][2], const Unit& u, int wr, int wc, int fr, int fq) const {
        const int row0 = u.pm * BM + wr * 64 + fr, col0 = u.pn * BM + wc * 32 + 4 * fq;
        f32x4 bv[2][2];
#pragma unroll
        for (int bj = 0; bj < 2; ++bj)
#pragma unroll
            for (int n = 0; n < 2; ++n) bv[bj][n] = bias ? *(const f32x4*)(bias + col0 + bj * HALF + n * 16) : (f32x4){0.f, 0.f, 0.f, 0.f};
#pragma unroll
        for (int ai = 0; ai < 2; ++ai)
#pragma unroll
            for (int m = 0; m < 4; ++m) { float* rowp = C + (size_t)(row0 + ai * HALF + m * 16) * ldc + col0;
#pragma unroll
                for (int bj = 0; bj < 2; ++bj)
#pragma unroll
                    for (int n = 0; n < 2; ++n) *(f32x4*)(rowp + bj * HALF + n * 16) = acc[ai][bj][m][n] + bv[bj][n]; }
    }
};
template <int ACT  > struct EpiBf16 {
    static constexpr bool PERM = true, AFTER_DRAIN = false;
    bf16_t* O; int ldc; const float* bias; int split_cols; size_t split_stride;
    __device__ __forceinline__ void operator()(const f32x4 (&acc)[2][2][4][2], const Unit& u, int wr, int wc, int fr, int fq) const {
        const int row0 = u.pm * BM + wr * 64 + fr; int colt = u.pn * BM; bf16_t* base = O;
        if (split_cols) { const int t = colt / split_cols; base += (size_t)t * split_stride; colt -= t * split_cols; }
        const int col0 = colt + wc * 32 + 8 * fq, bcol0 = u.pn * BM + wc * 32 + 8 * fq;
        f32x4 bv[2][2];
#pragma unroll
        for (int bj = 0; bj < 2; ++bj)
#pragma unroll
            for (int n = 0; n < 2; ++n) bv[bj][n] = bias ? *(const f32x4*)(bias + bcol0 + bj * HALF + 4 * n) : (f32x4){0.f, 0.f, 0.f, 0.f};
#pragma unroll
        for (int ai = 0; ai < 2; ++ai)
#pragma unroll
            for (int m = 0; m < 4; ++m) { bf16_t* rowp = base + (size_t)(row0 + ai * HALF + m * 16) * ldc + col0;
#pragma unroll
                for (int bj = 0; bj < 2; ++bj) { f32x4 v0 = acc[ai][bj][m][0] + bv[bj][0], v1 = acc[ai][bj][m][1] + bv[bj][1];
                    if (ACT == 1) { f32x2 a = gelu_pk((f32x2){v0[0], v0[1]}), b = gelu_pk((f32x2){v0[2], v0[3]}), c = gelu_pk((f32x2){v1[0], v1[1]}), d = gelu_pk((f32x2){v1[2], v1[3]});
                        v0 = (f32x4){a.x, a.y, b.x, b.y}; v1 = (f32x4){c.x, c.y, d.x, d.y}; }
                    if (ACT == 2) {
#pragma unroll
                        for (int j = 0; j < 4; ++j) { v0[j] = 0.5f * v0[j] * (1.0f + erff(v0[j] * 0.70710678f)); v1[j] = 0.5f * v1[j] * (1.0f + erff(v1[j] * 0.70710678f)); } }
                    u32x4 w; w.x = cvt_pk_bf16(v0[0], v0[1]); w.y = cvt_pk_bf16(v0[2], v0[3]); w.z = cvt_pk_bf16(v1[0], v1[1]); w.w = cvt_pk_bf16(v1[2], v1[3]);
                    *(u32x4*)(rowp + bj * HALF) = w; } }
    }
};
}
namespace pg8 {
struct EpiSwiGLU {
    static constexpr bool PERM = true, AFTER_DRAIN = false;
    bf16_t* O; int ldc;
    __device__ __forceinline__ void operator()(const f32x4 (&acc)[2][2][4][2], const Unit& u, int wr, int wc, int fr, int fq) const {
        const int row0 = u.pm * BM + wr * 64 + fr, col0 = u.pn * HALF + wc * 32 + 8 * fq;
#pragma unroll
        for (int ai = 0; ai < 2; ++ai)
#pragma unroll
            for (int m = 0; m < 4; ++m) { bf16_t* rowp = O + (size_t)(row0 + ai * HALF + m * 16) * ldc + col0;
                float h[8];
#pragma unroll
                for (int n = 0; n < 2; ++n)
#pragma unroll
                    for (int j = 0; j < 4; ++j) { const float g = acc[ai][0][m][n][j], up = acc[ai][1][m][n][j]; h[n * 4 + j] = g * __builtin_amdgcn_rcpf(1.0f + __builtin_amdgcn_exp2f(-1.4426950408889634f * g)) * up; }
                u32x4 w; w.x = cvt_pk_bf16(h[0], h[1]); w.y = cvt_pk_bf16(h[2], h[3]); w.z = cvt_pk_bf16(h[4], h[5]); w.w = cvt_pk_bf16(h[6], h[7]);
                *(u32x4*)rowp = w; }
    }
};
struct EpiResid {
    static constexpr bool PERM = false, AFTER_DRAIN = false;
    float* X; const float* gate_x; const float* gate_c; float fac; float* out_x;
    __device__ __forceinline__ void operator()(const f32x4 (&acc)[2][2][4][2], const Unit& u, int wr, int wc, int fr, int fq) const {
        const int row0 = u.pm * BM + wr * 64 + fr, col0 = u.pn * BM + wc * 32 + 4 * fq;
        const float* gv = (u.pm == 0) ? gate_c : gate_x;
        float* dst = (u.pm != 0 && out_x) ? out_x - (size_t)256 * 4096 : X;
        f32x4 gg[2][2];
#pragma unroll
        for (int bj = 0; bj < 2; ++bj)
#pragma unroll
            for (int n = 0; n < 2; ++n) gg[bj][n] = *(const f32x4*)(gv + col0 + bj * HALF + n * 16) * fac;
#pragma unroll
        for (int ai = 0; ai < 2; ++ai)
#pragma unroll
            for (int m = 0; m < 4; ++m) { const size_t off = (size_t)(row0 + ai * HALF + m * 16) * 4096 + col0;
#pragma unroll
                for (int bj = 0; bj < 2; ++bj)
#pragma unroll
                    for (int n = 0; n < 2; ++n) { const f32x4 b = *(const f32x4*)(X + off + bj * HALF + n * 16); *(f32x4*)(dst + off + bj * HALF + n * 16) = b + gg[bj][n] * acc[ai][bj][m][n]; } }
    }
};
}
namespace pg8 {
template <class Epi, class Sched, bool STAMP = false>
__device__ __forceinline__ void gemm_phase(PG8_LAS unsigned char* lds, const Gemm g, const Sched& S, const Epi& E, unsigned long long* stamps) {
    int tid_ = threadIdx.x; asm volatile("" : "+v"(tid_));
    const int tid = tid_, wid = __builtin_amdgcn_readfirstlane(tid >> 6), lane = tid & 63, wr = wid >> 2, wc = wid & 3, fr = lane & 15, fq = lane >> 4;
    const int K = g.K, nt = K / BK;
    int ts_lo = 0, ts_hi = 0, nts = 0; const unsigned long long rt_entry = STAMP ? (unsigned long long)wall_clock64() : 0ull;
#define PG8_STAMP() do { if (STAMP && wid == 0 && nts < 64) { const unsigned long long _c = (unsigned long long)clock64(); \
        ts_lo = (lane == nts) ? (int)(unsigned)_c : ts_lo; ts_hi = (lane == nts) ? (int)(unsigned)(_c >> 32) : ts_hi; ++nts; } } while (0)
    PG8_STAMP();
    unsigned voffA[2], voffB[2];
#pragma unroll
    for (int i = 0; i < 2; ++i) { int R, C; stage_rc(tid * 16 + i * 8192, R, C); const int Rb = Epi::PERM ? ((R & ~31) + perm32(R & 31)) : R;
        voffA[i] = (unsigned)(R * K + C) * 2u; voffB[i] = (unsigned)(Rb * K + C) * 2u; }
    const size_t kstep = (size_t)(BK * 2);
    const size_t hstep = (size_t)HALF * K * 2;
    const size_t tstep = 2 * hstep;
    const unsigned ldsw = (unsigned)wid * 1024u;
    const int aoff = lds_byte(wr * 64 + fr, fq * 8), boff = lds_byte(wc * 32 + fr, fq * 8);
#define PG8_SA(b, h) (((b) * 2 + (h)) * HTB)
#define PG8_SB(b, h) ((4 + (b) * 2 + (h)) * HTB)
#define PG8_STAGE(bufoff, gbase, voff) do { _Pragma("unroll") for (int _i = 0; _i < 2; ++_i) \
        __builtin_amdgcn_global_load_lds((const unsigned*)((const char*)(gbase) + (voff)[_i]), (PG8_LAS unsigned*)(lds + (bufoff) + ldsw + _i * 8192), 16, 0, 0); } while (0)
#define PG8_LDA(dst, b, h) do { _Pragma("unroll") for (int m = 0; m < 4; ++m) _Pragma("unroll") for (int k = 0; k < 2; ++k) dst[m][k] = *(const PG8_LAS bf16x8*)(lds + PG8_SA(b, h) + aoff + m * 2048 + k * 1024); } while (0)
#define PG8_LDB(dst, b, h) do { _Pragma("unroll") for (int n = 0; n < 2; ++n) _Pragma("unroll") for (int k = 0; k < 2; ++k) dst[n][k] = *(const PG8_LAS bf16x8*)(lds + PG8_SB(b, h) + boff + n * 2048 + k * 1024); } while (0)
#define PG8_MMA(ai, bj, At, Bt) do { __builtin_amdgcn_s_setprio(1); _Pragma("unroll") for (int m = 0; m < 4; ++m) _Pragma("unroll") for (int n = 0; n < 2; ++n) _Pragma("unroll") for (int k = 0; k < 2; ++k) \
        acc[ai][bj][m][n] = __builtin_amdgcn_mfma_f32_16x16x32_bf16(Bt[n][k], At[m][k], acc[ai][bj][m][n], 0, 0, 0); __builtin_amdgcn_s_setprio(0); } while (0)
#define PG8_WAIT_V(n) asm volatile("s_waitcnt vmcnt(" #n ")" ::: "memory")
#define PG8_WAIT_L(n) asm volatile("s_waitcnt lgkmcnt(" #n ")" ::: "memory")
#define PG8_BAR __builtin_amdgcn_s_barrier()
#define PG8_SCHED __builtin_amdgcn_sched_barrier(0)
    Unit cur, nxt; int ui = 0;
    if (!S.next(0, cur)) return;
    f32x4 acc[2][2][4][2];
#pragma unroll
    for (int a = 0; a < 2; ++a)
#pragma unroll
        for (int b = 0; b < 2; ++b)
#pragma unroll
            for (int m = 0; m < 4; ++m)
#pragma unroll
                for (int n = 0; n < 2; ++n) acc[a][b][m][n] = (f32x4){0.f, 0.f, 0.f, 0.f};
    bf16x8 At[4][2], B0[2][2], B1[2][2];
    const char* cA = (const char*)g.A + (size_t)cur.pm * tstep; const char* cB = (const char*)g.Bt + (size_t)cur.pn * tstep;
    S.a_ready(cur);
    PG8_STAGE(PG8_SB(0, 0), cB, voffB); PG8_STAGE(PG8_SA(0, 0), cA, voffA); PG8_STAGE(PG8_SB(0, 1), cB + hstep, voffB); PG8_STAGE(PG8_SA(0, 1), cA + hstep, voffA);
    if (wr == 1) PG8_BAR;
    PG8_WAIT_V(4); PG8_BAR;
    PG8_STAGE(PG8_SB(1, 0), cB + kstep, voffB); PG8_STAGE(PG8_SA(1, 0), cA + kstep, voffA); PG8_STAGE(PG8_SB(1, 1), cB + hstep + kstep, voffB);
    PG8_WAIT_V(6); PG8_BAR;
    PG8_STAMP();
    for (;;) {
        const bool has_next = S.next(ui + 1, nxt);
        const char* nA = has_next ? (const char*)g.A + (size_t)nxt.pm * tstep : cA; const char* nB = has_next ? (const char*)g.Bt + (size_t)nxt.pn * tstep : cB;
        for (int t = 0; t < nt; t += 2) {
            const bool last = (t == nt - 2);
            const char* a1 = cA + (size_t)(t + 1) * kstep;
            const char* a2 = last ? nA : cA + (size_t)(t + 2) * kstep; const char* b2 = last ? nB : cB + (size_t)(t + 2) * kstep;
            const char* a3 = a2 + kstep; const char* b3 = b2 + kstep;
            if (last && has_next) S.a_ready(nxt);
            PG8_LDB(B0, 0, 0); PG8_SCHED; PG8_LDA(At, 0, 0); PG8_STAGE(PG8_SA(1, 1), a1 + hstep, voffA);
            PG8_WAIT_L(8); PG8_BAR; PG8_WAIT_L(0); PG8_MMA(0, 0, At, B0); PG8_BAR; PG8_SCHED;
            PG8_LDB(B1, 0, 1); PG8_STAGE(PG8_SB(0, 0), b2, voffB);
            PG8_BAR; PG8_WAIT_L(0); PG8_MMA(0, 1, At, B1); PG8_BAR;
            PG8_LDA(At, 0, 1); PG8_STAGE(PG8_SA(0, 0), a2, voffA);
            PG8_BAR; PG8_WAIT_L(0); PG8_MMA(1, 0, At, B0); PG8_BAR; PG8_SCHED;
            PG8_STAGE(PG8_SB(0, 1), b2 + hstep, voffB);
            PG8_WAIT_V(6); PG8_BAR; PG8_MMA(1, 1, At, B1); PG8_BAR;
            PG8_LDB(B0, 1, 0); PG8_SCHED; PG8_LDA(At, 1, 0); PG8_STAGE(PG8_SA(0, 1), a2 + hstep, voffA);
            PG8_WAIT_L(8); PG8_BAR; PG8_WAIT_L(0); PG8_MMA(0, 0, At, B0); PG8_BAR; PG8_SCHED;
            PG8_LDB(B1, 1, 1); PG8_STAGE(PG8_SB(1, 0), b3, voffB);
            PG8_BAR; PG8_WAIT_L(0); PG8_MMA(0, 1, At, B1); PG8_BAR;
            PG8_LDA(At, 1, 1); PG8_STAGE(PG8_SA(1, 0), a3, voffA);
            PG8_BAR; PG8_WAIT_L(0); PG8_MMA(1, 0, At, B0); PG8_BAR; PG8_SCHED;
            PG8_STAGE(PG8_SB(1, 1), b3 + hstep, voffB);
            PG8_WAIT_V(6); PG8_BAR; PG8_MMA(1, 1, At, B1); PG8_BAR;
        }
        PG8_STAMP();
        if constexpr (!Epi::AFTER_DRAIN) { E(acc, cur, wr, wc, fr, fq); S.done(cur); }
        PG8_STAMP();
        if (!has_next) break;
#pragma unroll
        for (int a = 0; a < 2; ++a)
#pragma unroll
            for (int b = 0; b < 2; ++b)
#pragma unroll
                for (int m = 0; m < 4; ++m)
#pragma unroll
                    for (int n = 0; n < 2; ++n) acc[a][b][m][n] = (f32x4){0.f, 0.f, 0.f, 0.f};
        cur = nxt; cA = nA; cB = nB; ++ui;
    }
    PG8_WAIT_V(0);
    if (wr == 0) PG8_BAR;
    PG8_BAR;
    if constexpr (Epi::AFTER_DRAIN) { E.fused(acc, cur, wr, wc, fr, fq, lds, wid, lane); S.done(cur); }
    PG8_STAMP();
    if (STAMP && wid == 0) { stamps[lane] = lane < nts ? (((unsigned long long)(unsigned)ts_hi << 32) | (unsigned)ts_lo) : 0ull;
        if (lane == 62) stamps[62] = rt_entry; if (lane == 63) stamps[63] = (unsigned long long)wall_clock64(); }
#undef PG8_STAMP
#undef PG8_SA
#undef PG8_SB
#undef PG8_STAGE
#undef PG8_LDA
#undef PG8_LDB
#undef PG8_MMA
#undef PG8_WAIT_V
#undef PG8_WAIT_L
#undef PG8_BAR
#undef PG8_SCHED
}
}
#define LDS_WAIT() asm volatile("s_waitcnt lgkmcnt(0)" ::: "memory")

__device__ __forceinline__ int map_row(int n, int mode) {
    if (mode == 1) { const int j = n < FF ? n : n - FF; return (j >> 7) * 256 + (n < FF ? 0 : 128) + (j & 127); }
    if (mode == 2) { return n < A_IN ? n : (n < A_IN + B_IN ? n - A_IN + PXB : n - (A_IN + B_IN) + PXC); }
    return n;
}
__device__ __forceinline__ void transpose_item(const float* __restrict__ W, int K, int N, bf16_t* WT, int mode, LAS float* scr, int item, int lane) {
    const int nblk = N / 32, kb = item / nblk, nb = item % nblk, k0 = 64 * kb, n0 = 32 * nb;
#pragma unroll 8
    for (int i = 0; i < 32; ++i) { const int kk = 2 * i + (lane >> 5); scr[kk * 33 + (lane & 31)] = W[(size_t)(k0 + kk) * N + n0 + (lane & 31)]; }
    LDS_WAIT(); asm volatile("" ::: "memory");
    const int c = lane & 7;
#pragma unroll
    for (int j = 0; j < 4; ++j) { const int n = (lane >> 3) + 8 * j; const LAS float* s = scr + (8 * c) * 33 + n;
        u32x4 o; o.x = cvt_pk_bf16(s[0 * 33], s[1 * 33]); o.y = cvt_pk_bf16(s[2 * 33], s[3 * 33]); o.z = cvt_pk_bf16(s[4 * 33], s[5 * 33]); o.w = cvt_pk_bf16(s[6 * 33], s[7 * 33]);
        *(u32x4*)(WT + (size_t)map_row(n0 + n, mode) * K + k0 + 8 * c) = o; }
    LDS_WAIT(); asm volatile("" ::: "memory");
}
constexpr int I_G = (DM / 64) * (2 * FF / 32), I_D = (FF / 64) * (DM / 32), I_IN = (DM / 64) * (9600 / 32), I_OUT = (DM / 64) * (DM / 32), I_Q = (1024 / 64) * (NQ / 32), I_KV = (512 / 64) * (NKV / 32);
constexpr int I_LAYER = 2 * I_G + 2 * I_D + I_IN + I_OUT + I_Q + I_KV;

__device__ __forceinline__ void phase0(const Frame& F, unsigned char* ws) {
    const int gw = F.bid * 8 + F.wave, NGW = F.G * 8;
    const size_t gt = (size_t)F.bid * 512 + F.tid, NGT = (size_t)F.G * 512;
    LAS float* scr = (LAS float*)(F.lds + F.wave * 8704);
    bf16_t* WB = (bf16_t*)(ws + WS_WB);
    for (int it = gw; it < NL * I_LAYER; it += NGW) {
        const int l = it / I_LAYER; int r = it - l * I_LAYER; bf16_t* wl = WB + (size_t)l * W_LAYER;
        if (r < I_G) { transpose_item(IN_(10) + (size_t)l * DM * 2 * FF, DM, 2 * FF, wl + W_G1, 1, scr, r, F.lane); continue; } r -= I_G;
        if (r < I_D) { transpose_item(IN_(11) + (size_t)l * FF * DM, FF, DM, wl + W_D1, 0, scr, r, F.lane); continue; } r -= I_D;
        if (r < I_G) { transpose_item(IN_(12) + (size_t)l * DM * 2 * FF, DM, 2 * FF, wl + W_G2, 1, scr, r, F.lane); continue; } r -= I_G;
        if (r < I_D) { transpose_item(IN_(13) + (size_t)l * FF * DM, FF, DM, wl + W_D2, 0, scr, r, F.lane); continue; } r -= I_D;
        if (r < I_IN) { transpose_item(IN_(14) + (size_t)l * DM * 9600, DM, 9600, wl + W_IN, 2, scr, r, F.lane); continue; } r -= I_IN;
        if (r < I_OUT) { transpose_item(IN_(15) + (size_t)l * DM * DM, DM, DM, wl + W_OUT, 0, scr, r, F.lane); continue; } r -= I_OUT;
        if (r < I_Q) { transpose_item(IN_(39) + (size_t)l * 1024 * NQ, 1024, NQ, wl + W_Q, 0, scr, r, F.lane); continue; } r -= I_Q;
        transpose_item(IN_(41) + (size_t)l * 512 * NKV, 512, NKV, wl + W_KV, 0, scr, r, F.lane);
    }
    for (size_t i = gt; i < (size_t)NL * 384 * 512; i += NGT) {
        const int l = (int)(i / (384 * 512)), rr = (int)((i / 512) % 384), c = (int)(i % 512);
        const int row = rr < 192 ? A_IN + rr : PXC + C_IN + (rr - 192);
        *(u32x4*)(WB + (size_t)l * W_LAYER + W_IN + (size_t)row * DM + c * 8) = (u32x4){0u, 0u, 0u, 0u};
    }
    { f32x4* xs = (f32x4*)(ws + WS_XS); const f32x4* cx = (const f32x4*)IN_(2); const f32x4* xx = (const f32x4*)IN_(0);
      for (size_t i = gt; i < (size_t)T * DM / 4; i += NGT) xs[i] = i < (size_t)NCTX * DM / 4 ? cx[i] : xx[i - (size_t)NCTX * DM / 4]; }
    { float* HP = (float*)(ws + WS_HP);
      for (int it = F.bid; it < NL * 16; it += F.G) { const int l = it >> 4, ch = it & 15, w = F.tid >> 8, j = F.tid & 255;
          const float* cv = w ? IN_(3) : IN_(1); const float* ad = IN_(4) + ((size_t)l * DM + ch * 256) * 256 + j; float s = 0.f;
          for (int i = 0; i < 256; ++i) s += siluf_(cv[ch * 256 + i]) * ad[(size_t)i * 256];
          HP[((l * 16 + ch) * 2 + w) * 256 + j] = s; } }
    { float* H3 = (float*)(ws + WS_H3);
      LAS float* zb = (LAS float*)(F.lds + 73728); LAS float* ha = zb + 8 * 36; LAS float* hb = ha + 8 * 64;
      for (int it = F.bid; it < NL * (T / 8); it += F.G) { const int l = it / (T / 8), pb = it % (T / 8);
          if (F.tid < 8 * 33) { const int p = F.tid / 33, i = F.tid % 33, P = pb * 8 + p; const int L = P < NCTX ? NCTX : SEQ, t = P < NCTX ? P : P - NCTX;
              float z;
              if (i == 0) z = (float)t / (float)(L - 1);
              else { const int b = (i - 1) & 15; const float fb = 1e-4f + (float)b * ((15.0f - 1e-4f) / 15.0f); const float rev2 = 2.0f * fb * (float)t / (float)L;
                  z = i <= 16 ? cospif(rev2) : -sinpif(rev2); }
              zb[p * 36 + i] = z; }
          __syncthreads();
          const int p = F.tid >> 6, j = F.tid & 63; const float fq = IN_(36)[l * 64 + j];
          { const float* w1 = IN_(29) + (size_t)l * 33 * 64 + j; float s = IN_(30)[l * 64 + j];
            for (int i = 0; i < 33; ++i) s += zb[p * 36 + i] * w1[i * 64];
            ha[p * 64 + j] = sinf(fq * s); }
          __syncthreads();
          { const float* w2 = IN_(31) + (size_t)l * 64 * 64 + j; float s = IN_(32)[l * 64 + j];
            for (int i = 0; i < 64; ++i) s += ha[p * 64 + i] * w2[i * 64];
            hb[p * 64 + j] = sinf(fq * s); }
          __syncthreads();
          { const float* w3 = IN_(33) + (size_t)l * 64 * 64 + j; float s = IN_(34)[l * 64 + j];
            for (int i = 0; i < 64; ++i) s += hb[p * 64 + i] * w3[i * 64];
            H3[((size_t)l * T + pb * 8 + p) * 64 + j] = sinf(fq * s); }
          __syncthreads(); } }
}
__device__ __forceinline__ void phase_mod(const Frame& F, unsigned char* ws) {
    const float* HP = (const float*)(ws + WS_HP); float* MOD = (float*)(ws + WS_MOD);
    LAS float* hs = (LAS float*)F.lds;
    for (int it = F.bid; it < NL * (NMOD / 512); it += F.G) { const int l = it / (NMOD / 512), nb = it % (NMOD / 512);
        { const int w = F.tid >> 8, j = F.tid & 255; float s = 0.f;
          for (int ch = 0; ch < 16; ++ch) s += HP[((l * 16 + ch) * 2 + w) * 256 + j];
          hs[w * 256 + j] = s; }
        __syncthreads();
        const int n = nb * 512 + F.tid; const float* au = IN_(5) + (size_t)l * 256 * NMOD + n; float s0 = IN_(6)[(size_t)l * NMOD + n], s1 = s0;
        for (int j = 0; j < 256; ++j) { const float u = au[(size_t)j * NMOD]; s0 += hs[j] * u; s1 += hs[256 + j] * u; }
        MOD[((size_t)l * 2 + 0) * NMOD + n] = s0; MOD[((size_t)l * 2 + 1) * NMOD + n] = s1;
        __syncthreads(); }
}
__device__ __forceinline__ void norm_phase(const Frame& F, const float* XS, const float* __restrict__ gain, const float* modx, const float* modc, int ish, int isc, bf16_t* out) {
    const int gw = F.bid * 8 + F.wave, NGW = F.G * 8;
    for (int row = gw; row < T; row += NGW) {
        const float* mod = row < NCTX ? modc : modx;
        const f32x4* xr = (const f32x4*)(XS + (size_t)row * DM) + F.lane; const f32x4* g4 = (const f32x4*)gain + F.lane;
        const f32x4* sh4 = (const f32x4*)(mod + (size_t)ish * DM) + F.lane; const f32x4* sc4 = (const f32x4*)(mod + (size_t)isc * DM) + F.lane;
        f32x4 v[16]; float s = 0.f;
#pragma unroll
        for (int j = 0; j < 16; ++j) { v[j] = xr[64 * j]; s += (v[j].x * v[j].x + v[j].y * v[j].y) + (v[j].z * v[j].z + v[j].w * v[j].w); }
        const float rstd = rsqrtf(wave_sum(s) * (1.0f / DM) + NORM_EPS);
        u32x2* o = (u32x2*)(out + (size_t)row * DM) + F.lane;
#pragma unroll
        for (int j = 0; j < 16; ++j) { const f32x4 y = v[j] * rstd * g4[64 * j] * (sc4[64 * j] + 1.0f) + sh4[64 * j];
            u32x2 w; w.x = cvt_pk_bf16(y.x, y.y); w.y = cvt_pk_bf16(y.z, y.w); o[64 * j] = w; }
    }
}
__device__ __forceinline__ float conv3_at(const float* PX, int tau, int col, float w0, float w1, float w2) {
    const float* p = PX + (size_t)tau * PXW + col;
    float y = p[0] * w1;
    if (has_left(tau)) y += p[-PXW] * w0;
    if (has_right(tau)) y += p[PXW] * w2;
    return y;
}
__device__ __forceinline__ void rwkv_prep_phase(const Frame& F, unsigned char* ws, int l) {
    const float* PX = (const float*)(ws + WS_PX); float* SS = (float*)(ws + WS_SS); float* SD = (float*)(ws + WS_SD); float* GB = (float*)(ws + WS_G);
    const float* cw = IN_(16) + (size_t)l * 3 * A_IN;
    LAS float* LW = (LAS float*)F.lds; LAS float* LA = LW + 32 * 64; LAS float* LG = LA + 32 * 64;
    for (int it = F.bid; it < (T / 32) * 5; it += F.G) {
        const int tt = it / 5, cb = it % 5, tau0 = tt * 32;
        for (int e = F.tid; e < 32 * 320; e += 512) { const int t = e / 320, c = e % 320, col = 3840 + c;
            const float val = conv3_at(PX, tau0 + t, PXA + col, cw[col], cw[A_IN + col], cw[2 * A_IN + col]);
            if (c < 64) LW[t * 64 + c] = tanhf(val); else if (c < 128) LA[t * 64 + (c - 64)] = val; else LG[t * 192 + (c - 128)] = sigmoidf_(val); }
        __syncthreads();
        const int col = cb * 256 + (F.tid & 255), half = F.tid >> 8;
        float aw0[16], aw1[16], aa0[16], aa1[16], ag[16];
#pragma unroll
        for (int i = 0; i < 16; ++i) { aw0[i] = 0.f; aw1[i] = 0.f; aa0[i] = 0.f; aa1[i] = 0.f; ag[i] = 0.f; }
        const float* wu0 = IN_(18) + ((size_t)l * 2 + 0) * 64 * A_W + col; const float* wu1 = wu0 + 64 * A_W;
        const float* au0 = IN_(20) + ((size_t)l * 2 + 0) * 64 * A_W + col; const float* au1 = au0 + 64 * A_W;
        const float* gu = IN_(21) + (size_t)l * 192 * A_W + col;
        for (int j = 0; j < 64; j += 4) {
            float w0v[4], w1v[4], a0v[4], a1v[4];
#pragma unroll
            for (int q = 0; q < 4; ++q) { w0v[q] = wu0[(j + q) * A_W]; w1v[q] = wu1[(j + q) * A_W]; a0v[q] = au0[(j + q) * A_W]; a1v[q] = au1[(j + q) * A_W]; }
#pragma unroll
            for (int i = 0; i < 16; ++i) { const f32x4 xw = *(const LAS f32x4*)(LW + (half * 16 + i) * 64 + j), xa = *(const LAS f32x4*)(LA + (half * 16 + i) * 64 + j);
#pragma unroll
                for (int q = 0; q < 4; ++q) { aw0[i] += xw[q] * w0v[q]; aw1[i] += xw[q] * w1v[q]; aa0[i] += xa[q] * a0v[q]; aa1[i] += xa[q] * a1v[q]; } }
        }
        for (int j = 0; j < 192; j += 4) {
            float gv[4];
#pragma unroll
            for (int q = 0; q < 4; ++q) gv[q] = gu[(j + q) * A_W];
#pragma unroll
            for (int i = 0; i < 16; ++i) { const f32x4 xg = *(const LAS f32x4*)(LG + (half * 16 + i) * 192 + j);
#pragma unroll
                for (int q = 0; q < 4; ++q) ag[i] += xg[q] * gv[q]; }
        }
        const int h = col >> 6, ln = col & 63;
        const float cr0 = cw[col], cr1 = cw[A_IN + col], cr2 = cw[2 * A_IN + col];
        const float ck0 = cw[A_W + col], ck1 = cw[A_IN + A_W + col], ck2 = cw[2 * A_IN + A_W + col];
        const float cv0 = cw[2 * A_W + col], cv1 = cw[A_IN + 2 * A_W + col], cv2 = cw[2 * A_IN + 2 * A_W + col];
        const float kk_w = IN_(22)[l * A_W + col], ka_w = IN_(23)[l * A_W + col];
        const float w00 = IN_(17)[(l * 2 + 0) * A_W + col], w01 = IN_(17)[(l * 2 + 1) * A_W + col];
        const float a00 = IN_(19)[(l * 2 + 0) * A_W + col], a01 = IN_(19)[(l * 2 + 1) * A_W + col];
#pragma unroll
        for (int i = 0; i < 16; ++i) { const int tau = tau0 + half * 16 + i;
            const float r = conv3_at(PX, tau, PXA + col, cr0, cr1, cr2), k = conv3_at(PX, tau, PXA + A_W + col, ck0, ck1, ck2), v = conv3_at(PX, tau, PXA + 2 * A_W + col, cv0, cv1, cv2);
            const float kr = k * kk_w; const float nrm = sqrtf(wave_sum(kr * kr)); const float kk = kr / fmaxf(nrm, 1e-12f);
            float* ss = SS + ((size_t)h * T + tau) * 192 + ln; ss[0] = kk; ss[64] = r; ss[128] = v;
            GB[(size_t)tau * A_W + col] = ag[i];
#pragma unroll
            for (int d = 0; d < 2; ++d) { const float z = (d ? w01 : w00) + (d ? aw1[i] : aw0[i]);
                const float sp = fmaxf(-z, 0.f) + log1pf(__expf(-fabsf(z)));
                const float logw = -sp - 0.5f; const float decay = __expf(-__expf(logw));
                const float av = sigmoidf_((d ? a01 : a00) + (d ? aa1[i] : aa0[i]));
                const float kd = k * (1.0f + (av - 1.0f) * ka_w);
                float* sd = SD + (((size_t)h * 2 + d) * T + tau) * 192 + ln; sd[0] = decay; sd[64] = kk * av; sd[128] = kd; } }
        __syncthreads();
    }
}
__device__ __forceinline__ float rope_apply(float val, int tau, int j) {
    const int pos = tau - NCTX, prow = pos >> 6, pcol = pos & 63;
    const float inv = __powf(10000.0f, -(float)(j & 15) * (1.0f / 16.0f));
    const float ang = (float)(j < 32 ? prow : pcol) * inv;
    float sn, cs; sincosf(ang, &sn, &cs);
    const float partner = __shfl_xor(val, 16);
    const float rot = (j & 16) ? partner : -partner;
    return val * cs + rot * sn;
}
__device__ __forceinline__ void mla_prep_phase(const Frame& F, unsigned char* ws, int l) {
    const float* PX = (const float*)(ws + WS_PX); bf16_t* QA = (bf16_t*)(ws + WS_QA); bf16_t* KVA = (bf16_t*)(ws + WS_KVA); bf16_t* KPE = (bf16_t*)(ws + WS_KPE);
    const int gw = F.bid * 8 + F.wave, NGW = F.G * 8;
    const f32x4* gq = (const f32x4*)(IN_(38) + l * 1024) + F.lane; const f32x4* gkv = (const f32x4*)(IN_(40) + l * 512) + F.lane; const float gpe = IN_(45)[l * 64 + F.lane];
    for (int tau = gw; tau < T; tau += NGW) {
        const f32x4* p = (const f32x4*)(PX + (size_t)tau * PXW + PXC) + F.lane;
        f32x4 q[4], kv[2]; float sq = 0.f, skv = 0.f;
#pragma unroll
        for (int j = 0; j < 4; ++j) { q[j] = p[64 * j]; sq += (q[j].x * q[j].x + q[j].y * q[j].y) + (q[j].z * q[j].z + q[j].w * q[j].w); }
#pragma unroll
        for (int j = 0; j < 2; ++j) { kv[j] = p[256 + 64 * j]; skv += (kv[j].x * kv[j].x + kv[j].y * kv[j].y) + (kv[j].z * kv[j].z + kv[j].w * kv[j].w); }
        const float pe = PX[(size_t)tau * PXW + PXC + 1536 + F.lane];
        const float rq = rsqrtf(wave_sum(sq) * (1.0f / 1024.0f) + NORM_EPS), rkv = rsqrtf(wave_sum(skv) * (1.0f / 512.0f) + NORM_EPS), rpe = rsqrtf(wave_sum(pe * pe) * (1.0f / 64.0f) + NORM_EPS);
        u32x2* oq = (u32x2*)(QA + (size_t)tau * 1024) + F.lane; u32x2* okv = (u32x2*)(KVA + (size_t)tau * 512) + F.lane;
#pragma unroll
        for (int j = 0; j < 4; ++j) { const f32x4 y = q[j] * rq * gq[64 * j]; u32x2 w; w.x = cvt_pk_bf16(y.x, y.y); w.y = cvt_pk_bf16(y.z, y.w); oq[64 * j] = w; }
#pragma unroll
        for (int j = 0; j < 2; ++j) { const f32x4 y = kv[j] * rkv * gkv[64 * j]; u32x2 w; w.x = cvt_pk_bf16(y.x, y.y); w.y = cvt_pk_bf16(y.z, y.w); okv[64 * j] = w; }
        float kp = pe * rpe * gpe;
        if (tau >= NCTX) kp = rope_apply(kp, tau, F.lane);
        KPE[(size_t)tau * 64 + F.lane] = (bf16_t)(cvt_pk_bf16(kp, kp) & 0xffffu);
    }
}
__device__ __forceinline__ void qkv_final_phase(const Frame& F, unsigned char* ws, int l, bool need_ctx) {
    const bf16_t* QRAW = (const bf16_t*)(ws + WS_QRAW); const bf16_t* KVRAW = (const bf16_t*)(ws + WS_KVRAW); const bf16_t* KPE = (const bf16_t*)(ws + WS_KPE);
    bf16_t* QF = (bf16_t*)(ws + WS_QF); bf16_t* KF = (bf16_t*)(ws + WS_KF);
    const int gw = F.bid * 8 + F.wave, NGW = F.G * 8, ln = F.lane;
    const float gqn0 = IN_(42)[l * 128 + 2 * ln], gqn1 = IN_(42)[l * 128 + 2 * ln + 1], gqp = IN_(43)[l * 64 + ln];
    const float gkn0 = IN_(44)[l * 128 + 2 * ln], gkn1 = IN_(44)[l * 128 + 2 * ln + 1];
    (void)need_ctx;
    for (int it = gw; it < T * NHC; it += NGW) { const int tau = it / NHC, h = it % NHC;
        const unsigned qn = *(const unsigned*)(QRAW + (size_t)tau * NQ + h * 192 + 2 * ln); const float q0 = bf2f((unsigned short)(qn & 0xffffu)), q1 = bf2f((unsigned short)(qn >> 16));
        const float qp = bf2f(QRAW[(size_t)tau * NQ + h * 192 + 128 + ln]);
        const unsigned kn = *(const unsigned*)(KVRAW + (size_t)tau * NKV + h * 256 + 2 * ln); const float k0 = bf2f((unsigned short)(kn & 0xffffu)), k1 = bf2f((unsigned short)(kn >> 16));
        const float rqn = rsqrtf(wave_sum(q0 * q0 + q1 * q1) * (1.0f / 128.0f) + NORM_EPS), rqp = rsqrtf(wave_sum(qp * qp) * (1.0f / 64.0f) + NORM_EPS), rkn = rsqrtf(wave_sum(k0 * k0 + k1 * k1) * (1.0f / 128.0f) + NORM_EPS);
        float qpe = qp * rqp * gqp; if (tau >= NCTX) qpe = rope_apply(qpe, tau, ln);
        *(unsigned*)(QF + (size_t)tau * NQ + h * 192 + 2 * ln) = cvt_pk_bf16(q0 * rqn * gqn0, q1 * rqn * gqn1);
        QF[(size_t)tau * NQ + h * 192 + 128 + ln] = (bf16_t)(cvt_pk_bf16(qpe, qpe) & 0xffffu);
        *(unsigned*)(KF + (size_t)tau * NQ + h * 192 + 2 * ln) = cvt_pk_bf16(k0 * rkn * gkn0, k1 * rkn * gkn1);
        KF[(size_t)tau * NQ + h * 192 + 128 + ln] = KPE[(size_t)tau * 64 + ln];
    }
}
__device__ __forceinline__ void rwkv_out_phase(const Frame& F, unsigned char* ws, int l, bool need_ctx) {
    const float* SS = (const float*)(ws + WS_SS); const float* SD = (const float*)(ws + WS_SD); const float* GB = (const float*)(ws + WS_G); const float* Y = (const float*)(ws + WS_Y);
    bf16_t* OB = (bf16_t*)(ws + WS_OBUF);
    const int gw = F.bid * 8 + F.wave, NGW = F.G * 8, ln = F.lane;
    const int lo = need_ctx ? 0 : NCTX * NHA;
    for (int it = lo + gw; it < T * NHA; it += NGW) { const int tau = it / NHA, h = it % NHA, col = h * 64 + ln;
        const float y = Y[(size_t)tau * A_W + col] + Y[((size_t)T + tau) * A_W + col];
        const float mu = wave_sum(y) * (1.0f / 64.0f); const float dy = y - mu; const float var = wave_sum(dy * dy) * (1.0f / 64.0f);
        const float yn = dy * rsqrtf(var + GN_EPS) * IN_(25)[l * A_W + col] + IN_(26)[l * A_W + col];
        const float* ss = SS + ((size_t)h * T + tau) * 192 + ln; const float r = ss[64], v = ss[128];
        const float km = 0.5f * (SD[(((size_t)h * 2 + 0) * T + tau) * 192 + 128 + ln] + SD[(((size_t)h * 2 + 1) * T + tau) * 192 + 128 + ln]);
        const float bonus = wave_sum(r * km * IN_(24)[l * A_W + col]) * v;
        const float o = (yn + bonus) * GB[(size_t)tau * A_W + col];
        OB[(size_t)tau * DM + col] = (bf16_t)(cvt_pk_bf16(o, o) & 0xffffu);
    }
}
namespace att {
constexpr int DK = 192, DV = 128, NW = 8, QBLK = 32, KVBLK = 64;
constexpr float SCALE = 0.07216878364870322f;
constexpr float THR = 8.f;
#ifndef ATT_SDEPTH
#define ATT_SDEPTH 2
#endif
constexpr int SDEPTH = ATT_SDEPTH;
constexpr int LDQ = 2304, LDK = 2304, LDV = 3072, LDO = 4096;
constexpr int SHM_V = KVBLK * DV * 2, SHM_K = KVBLK * DK * 2, SHM_ATTN = 2 * SHM_V + 2 * SHM_K + NW * 64 * 4;
using bf16x8 = __attribute__((ext_vector_type(8))) short;
using s16x4  = __attribute__((ext_vector_type(4))) short;
using f32x16 = __attribute__((ext_vector_type(16))) float;
using u32x4  = __attribute__((ext_vector_type(4))) unsigned;
#define KSWZ(row, colB) ((row) * 384 + ((colB) ^ (((row) & 7) << 4)))
#define SBAR() __builtin_amdgcn_sched_barrier(0)
__device__ __forceinline__ int crow(int r, int hi) { return (r & 3) + 8 * (r >> 2) + 4 * hi; }
__device__ __forceinline__ unsigned cvtpk(float lo, float hi) { unsigned r; asm volatile("v_cvt_pk_bf16_f32 %0, %1, %2" : "=v"(r) : "v"(lo), "v"(hi)); return r; }
__device__ __forceinline__ void partialSM(f32x16& p0, f32x16& p1, float& m_reg, float& mn, float& alpha) {
  constexpr float C = SCALE * 1.4426950408889634f;
  float pmax = p0[0]; for (int r = 1; r < 16; ++r) pmax = fmaxf(pmax, p0[r]); for (int r = 0; r < 16; ++r) pmax = fmaxf(pmax, p1[r]);
  { auto rr = __builtin_amdgcn_permlane32_swap(__float_as_uint(pmax), __float_as_uint(pmax), false, false);
    pmax = fmaxf(__uint_as_float(rr[0]), __uint_as_float(rr[1])); }
  if (__builtin_expect(__all(pmax - m_reg <= THR / SCALE), 1)) { mn = m_reg; alpha = 1.f; }
  else { mn = fmaxf(m_reg, pmax); alpha = __builtin_amdgcn_exp2f((m_reg - mn) * C); m_reg = mn; }
  float mnC = -mn * C;
  for (int r = 0; r < 16; ++r) p0[r] = fmaf(p0[r], C, mnC); for (int r = 0; r < 16; ++r) p1[r] = fmaf(p1[r], C, mnC);
  for (int r = 0; r < 16; ++r) p0[r] = __builtin_amdgcn_exp2f(p0[r]);
}
__device__ __forceinline__ void finishSM(f32x16& p0, f32x16& p1, float alpha, float& l_reg, bf16x8& pa0, bf16x8& pa1, bf16x8& pa2, bf16x8& pa3) {
  for (int r = 0; r < 16; ++r) p1[r] = __builtin_amdgcn_exp2f(p1[r]);
  float ps = 0; for (int r = 0; r < 16; ++r) ps += p0[r]; for (int r = 0; r < 16; ++r) ps += p1[r];
  { auto rr = __builtin_amdgcn_permlane32_swap(__float_as_uint(ps), __float_as_uint(ps), false, false);
    ps = __uint_as_float(rr[0]) + __uint_as_float(rr[1]); }
  l_reg = l_reg * alpha + ps;
#define PK4(P, BASE, OUT) do { unsigned a0 = cvtpk(P[BASE + 0], P[BASE + 1]), a1 = cvtpk(P[BASE + 2], P[BASE + 3]);   \
    unsigned b0 = cvtpk(P[BASE + 4], P[BASE + 5]), b1 = cvtpk(P[BASE + 6], P[BASE + 7]);                              \
    auto r0 = __builtin_amdgcn_permlane32_swap(a0, b0, false, false); auto r1 = __builtin_amdgcn_permlane32_swap(a1, b1, false, false); \
    u32x4 w = {r0[0], r1[0], r0[1], r1[1]}; OUT = *reinterpret_cast<bf16x8*>(&w); } while (0)
  PK4(p0, 0, pa0); PK4(p0, 8, pa1); PK4(p1, 0, pa2); PK4(p1, 8, pa3);
#undef PK4
}
__device__ __forceinline__ void qkt(f32x16& p0, f32x16& p1, const char* Ks, const bf16x8* qr, int r32, int hi) {
  p0 = f32x16{}; p1 = f32x16{};
#pragma unroll
  for (int d0 = 0; d0 < 12; ++d0) { int cb = (d0 * 16 + hi * 8) * 2;
    bf16x8 b0 = *reinterpret_cast<const bf16x8*>(Ks + KSWZ(r32, cb));
    bf16x8 b1 = *reinterpret_cast<const bf16x8*>(Ks + KSWZ(32 + r32, cb));
    p0 = __builtin_amdgcn_mfma_f32_32x32x16_bf16(b0, qr[d0], p0, 0, 0, 0);
    p1 = __builtin_amdgcn_mfma_f32_32x32x16_bf16(b1, qr[d0], p1, 0, 0, 0); }
}
__device__ __forceinline__ int v_st(int k, int c) { const int kk = (k & ~0xC) | ((k & 4) << 1) | ((k & 8) >> 1); return ((kk >> 3) * 4 + (c >> 5)) * 512 + ((kk & 7) * 32 + (c & 31)) * 2; }
__device__ __forceinline__ int v_rd_base(int lane) { return ((lane & 3) << 3) | (((lane >> 2) & 3) << 6) | (((lane >> 4) & 1) << 5) | (((lane >> 5) & 1) << 8); }
constexpr int v_rd_off(int d0, int ks, int half) { return d0 * 512 + ks * 4096 + half * 2048; }
template <int OFF> __device__ __forceinline__ s16x4 tr_read(int vb) {
  s16x4 r; asm volatile("ds_read_b64_tr_b16 %0, %1 offset:%2" : "=&v"(r) : "v"(vb), "i"(OFF) : "memory"); return r;
}
template <int D0> __device__ __forceinline__ void pv_one(f32x16& od, int vb, bf16x8 pa0, bf16x8 pa1, bf16x8 pa2, bf16x8 pa3) {
  const s16x4 l0 = tr_read<v_rd_off(D0, 0, 0)>(vb), h0 = tr_read<v_rd_off(D0, 0, 1)>(vb), l1 = tr_read<v_rd_off(D0, 1, 0)>(vb), h1 = tr_read<v_rd_off(D0, 1, 1)>(vb);
  const s16x4 l2 = tr_read<v_rd_off(D0, 2, 0)>(vb), h2 = tr_read<v_rd_off(D0, 2, 1)>(vb), l3 = tr_read<v_rd_off(D0, 3, 0)>(vb), h3 = tr_read<v_rd_off(D0, 3, 1)>(vb);
  asm volatile("s_waitcnt lgkmcnt(0)" ::: "memory"); SBAR();
#define PK(L, H) (bf16x8){L[0], L[1], L[2], L[3], H[0], H[1], H[2], H[3]}
  od = __builtin_amdgcn_mfma_f32_32x32x16_bf16(pa0, PK(l0, h0), od, 0, 0, 0);
  od = __builtin_amdgcn_mfma_f32_32x32x16_bf16(pa1, PK(l1, h1), od, 0, 0, 0);
  od = __builtin_amdgcn_mfma_f32_32x32x16_bf16(pa2, PK(l2, h2), od, 0, 0, 0);
  od = __builtin_amdgcn_mfma_f32_32x32x16_bf16(pa3, PK(l3, h3), od, 0, 0, 0);
#undef PK
}
__device__ __forceinline__ void pv_d0(f32x16* o, int vb, bf16x8 pa0, bf16x8 pa1, bf16x8 pa2, bf16x8 pa3) {
  pv_one<0>(o[0], vb, pa0, pa1, pa2, pa3); pv_one<1>(o[1], vb, pa0, pa1, pa2, pa3); pv_one<2>(o[2], vb, pa0, pa1, pa2, pa3); pv_one<3>(o[3], vb, pa0, pa1, pa2, pa3);
}
__device__ __forceinline__ void attn_body(const bf16_t* __restrict__ Qb, const bf16_t* __restrict__ Kh, const bf16_t* __restrict__ Vh, bf16_t* __restrict__ Ob, int seq, char* lds) {
  int tid_ = threadIdx.x; asm volatile("" : "+v"(tid_));
  const int tid = tid_, wid = tid >> 6, lane = tid & 63, r32 = lane & 31, hi = lane >> 5;
  char* V_lds = lds; char* K_lds = lds + 2 * SHM_V;
  float* ws = (float*)(lds + 2 * SHM_V + 2 * SHM_K) + wid * 64; float* li_l = ws; float* al_l = ws + 32;
  float m_reg = -1e30f, l_reg = 0; f32x16 o[4] = {}; bf16x8 qr[12];
  const bf16_t* Qw = Qb + (long)(wid * QBLK + r32) * LDQ + hi * 8;
#pragma unroll
  for (int d0 = 0; d0 < 12; ++d0) qr[d0] = *reinterpret_cast<const bf16x8*>(Qw + d0 * 16);
  unsigned kgo[3], vgo[2];
#pragma unroll
  for (int i = 0; i < 3; ++i) { const int p = (i * 8 + wid) * 64 + lane, row = p / 24, slot = p % 24, ch = slot ^ (row & 7); kgo[i] = (unsigned)(row * LDK + ch * 8) * 2u; }
#pragma unroll
  for (int i = 0; i < 2; ++i) { const int p = (i * 8 + wid) * 64 + lane, sub = p >> 5, within = p & 31, kk = (sub >> 2) * 8 + (within >> 2), c = (sub & 3) * 32 + (within & 3) * 8;
    const int k = (kk & ~0xC) | ((kk & 4) << 1) | ((kk & 8) >> 1); vgo[i] = (unsigned)(k * LDV + c) * 2u; }
  const int vb0 = (int)(uintptr_t)V_lds + v_rd_base(lane);
  typedef __attribute__((address_space(3))) unsigned lds_u32;
#define DMA(b, k0) do { const char* kg = (const char*)Kh + (size_t)(k0) * (LDK * 2); const char* vg = (const char*)Vh + (size_t)(k0) * (LDV * 2); \
    _Pragma("unroll") for (int _i = 0; _i < 3; ++_i) __builtin_amdgcn_global_load_lds((const unsigned*)(kg + kgo[_i]), (lds_u32*)(K_lds + (b) * SHM_K + (_i * 8 + wid) * 1024), 16, 0, 0); \
    _Pragma("unroll") for (int _i = 0; _i < 2; ++_i) __builtin_amdgcn_global_load_lds((const unsigned*)(vg + vgo[_i]), (lds_u32*)(V_lds + (b) * SHM_V + (_i * 8 + wid) * 1024), 16, 0, 0); } while (0)
#define RESC(a) do { if (__any((a) < 1.f)) { if (hi == 0) al_l[r32] = (a); asm volatile("s_waitcnt lgkmcnt(0)" ::: "memory"); \
    for (int d = 0; d < 4; ++d) for (int r = 0; r < 16; ++r) o[d][r] *= al_l[crow(r, hi)]; } } while (0)
  f32x16 p0, p1; float mn, al; bf16x8 pa0, pa1, pa2, pa3; const int NT = seq / KVBLK;
  DMA(0, 0); asm volatile("s_waitcnt vmcnt(0)" ::: "memory"); __syncthreads();
#define TILE(b) do { SBAR(); qkt(p0, p1, K_lds + (b) * SHM_K, qr, r32, hi); partialSM(p0, p1, m_reg, mn, al); RESC(al); \
    finishSM(p0, p1, al, l_reg, pa0, pa1, pa2, pa3); SBAR(); pv_d0(o, vb0 + (b) * (int)SHM_V, pa0, pa1, pa2, pa3); } while (0)
  for (int j = 0; j < NT; j += 2) {
    DMA(1, (j + 1) * KVBLK);
    TILE(0); asm volatile("s_waitcnt vmcnt(0)" ::: "memory"); __syncthreads();
    if (j + 2 < NT) DMA(0, (j + 2) * KVBLK);
    TILE(1); asm volatile("s_waitcnt vmcnt(0)" ::: "memory"); __syncthreads();
  }
#undef TILE
#undef DMA
  if (hi == 0) li_l[r32] = l_reg; asm volatile("s_waitcnt lgkmcnt(0)" ::: "memory");
  float rli[16];
#pragma unroll
  for (int r = 0; r < 16; ++r) rli[r] = __builtin_amdgcn_rcpf(li_l[crow(r, hi)]);
  bf16_t* Ow = Ob + (long)(wid * QBLK) * LDO;
#pragma unroll
  for (int r = 0; r < 16; ++r) { int orow = crow(r, hi);
#pragma unroll
    for (int d0 = 0; d0 < 4; ++d0) { const float val = o[d0][r] * rli[r]; Ow[(long)orow * LDO + d0 * 32 + r32] = (bf16_t)(cvtpk(val, val) & 0xffff); } }
  __syncthreads();
#undef RESC
}
}
__device__ __forceinline__ void scan_chain(const Frame& F, unsigned char* ws, int chain) {
    const int h = chain >> 1, d = chain & 1, tid = F.tid, lane = F.lane;
    const float* SSh = (const float*)(ws + WS_SS) + (size_t)h * T * 192; const float* SDh = (const float*)(ws + WS_SD) + ((size_t)h * 2 + d) * T * 192;
    float* Yd = (float*)(ws + WS_Y) + (size_t)d * T * A_W + h * 64;
    LAS float* buf = (LAS float*)F.lds;
    constexpr int NCH = T / 32;
    f32x4 st[6];
#define SC_TAULO(c) (d == 0 ? 32 * (c) : ((c) < 8 ? 224 - 32 * (c) : (T - 32) - 32 * ((c) - 8)))
#define SC_LOAD(c) do { const int tl_ = SC_TAULO(c); _Pragma("unroll") for (int i_ = 0; i_ < 6; ++i_) { const int idx = tid + 512 * i_; \
        st[i_] = idx < 1536 ? *(const f32x4*)(SSh + (size_t)tl_ * 192 + idx * 4) : *(const f32x4*)(SDh + (size_t)tl_ * 192 + (idx - 1536) * 4); } } while (0)
#define SC_WRITE(b) do { _Pragma("unroll") for (int i_ = 0; i_ < 6; ++i_) { const int idx = tid + 512 * i_, id2 = idx < 1536 ? idx : idx - 1536; \
        *(LAS f32x4*)(buf + (b) * 12288 + (id2 / 48) * 384 + (idx < 1536 ? 0 : 192) + (id2 % 48) * 4) = st[i_]; } } while (0)
    f32x2 S[32];
#pragma unroll
    for (int j = 0; j < 32; ++j) S[j] = (f32x2){0.f, 0.f};
    SC_LOAD(0); SC_WRITE(0); __syncthreads();
    for (int c = 0; c < NCH; ++c) {
        if (c + 1 < NCH) SC_LOAD(c + 1);
        if (F.wave == 0) {
            const int tau_lo = SC_TAULO(c);
            for (int i = 0; i < 32; ++i) {
                const int slot = d ? 31 - i : i;
                const LAS float* p = buf + (c & 1) * 12288 + slot * 384;
                const float v = p[128 + lane];
                f32x2 ac0 = (f32x2){0.f, 0.f}, ac1 = ac0, ac2 = ac0, ac3 = ac0;
#pragma unroll
                for (int j = 0; j < 32; j += 4) { const f32x4 k0 = *(const LAS f32x4*)(p + 2 * j), k1 = *(const LAS f32x4*)(p + 2 * j + 4);
                    ac0 += S[j] * (f32x2){k0.x, k0.y}; ac1 += S[j + 1] * (f32x2){k0.z, k0.w}; ac2 += S[j + 2] * (f32x2){k1.x, k1.y}; ac3 += S[j + 3] * (f32x2){k1.z, k1.w}; }
                const f32x2 at = (ac0 + ac1) + (ac2 + ac3);
                const float sa = -(at.x + at.y);
                f32x2 y0 = (f32x2){0.f, 0.f}, y1 = y0;
#pragma unroll
                for (int j = 0; j < 32; j += 2) { const f32x4 w4 = *(const LAS f32x4*)(p + 192 + 2 * j), b4 = *(const LAS f32x4*)(p + 256 + 2 * j), k4 = *(const LAS f32x4*)(p + 320 + 2 * j), r4 = *(const LAS f32x4*)(p + 64 + 2 * j);
                    S[j] = S[j] * (f32x2){w4.x, w4.y} + ((f32x2){b4.x, b4.y} * sa + (f32x2){k4.x, k4.y} * v);
                    S[j + 1] = S[j + 1] * (f32x2){w4.z, w4.w} + ((f32x2){b4.z, b4.w} * sa + (f32x2){k4.z, k4.w} * v);
                    y0 += S[j] * (f32x2){r4.x, r4.y}; y1 += S[j + 1] * (f32x2){r4.z, r4.w}; }
                Yd[(size_t)(tau_lo + slot) * A_W + lane] = (y0.x + y0.y) + (y1.x + y1.y);
            }
        }
        if (c + 1 < NCH) SC_WRITE((c + 1) & 1);
        __syncthreads();
    }
#undef SC_TAULO
#undef SC_LOAD
#undef SC_WRITE
}
__device__ __forceinline__ f32x2 cmul(f32x2 a, f32x2 b) { return (f32x2){a.x * b.x - a.y * b.y, a.x * b.y + a.y * b.x}; }
__device__ __forceinline__ int rev4_14(int k) { const unsigned r = __brev((unsigned)k) >> 18; return (int)(((r & 0x1555u) << 1) | ((r >> 1) & 0x1555u)); }
__device__ __forceinline__ void fft16k_dif(LAS f32x2* Z, int tid) {
#pragma unroll 1
    for (int s = 0; s < 7; ++s) { int lq = 12 - 2 * s; asm volatile("" : "+s"(lq)); const int q = 1 << lq;
#pragma unroll 2
        for (int i = 0; i < 8; ++i) { const int b = tid + 512 * i, j = b & (q - 1), base = ((b >> lq) << (lq + 2)) + j;
            const f32x2 a0 = Z[base], a1 = Z[base + q], a2 = Z[base + 2 * q], a3 = Z[base + 3 * q];
            const f32x2 t0 = a0 + a2, t1 = a0 - a2, t2 = a1 + a3, t3 = a1 - a3;
            float sn, cs; sincospif((float)j / (float)(2 * q), &sn, &cs);
            const f32x2 w1 = (f32x2){cs, -sn}, w2 = cmul(w1, w1), w3 = cmul(w2, w1);
            Z[base] = t0 + t2; Z[base + q] = cmul((f32x2){t1.x + t3.y, t1.y - t3.x}, w1); Z[base + 2 * q] = cmul(t0 - t2, w2); Z[base + 3 * q] = cmul((f32x2){t1.x - t3.y, t1.y + t3.x}, w3); }
        __syncthreads(); }
}
__device__ __forceinline__ void fft16k_dit_inv(LAS f32x2* Z, int tid) {
#pragma unroll 1
    for (int s = 0; s < 7; ++s) { int lq = 2 * s; asm volatile("" : "+s"(lq)); const int q = 1 << lq;
#pragma unroll 2
        for (int i = 0; i < 8; ++i) { const int b = tid + 512 * i, j = b & (q - 1), base = ((b >> lq) << (lq + 2)) + j;
            float sn, cs; sincospif((float)j / (float)(2 * q), &sn, &cs);
            const f32x2 w1 = (f32x2){cs, sn}, w2 = cmul(w1, w1), w3 = cmul(w2, w1);
            const f32x2 b0 = Z[base], b1 = cmul(Z[base + q], w1), b2 = cmul(Z[base + 2 * q], w2), b3 = cmul(Z[base + 3 * q], w3);
            const f32x2 t0 = b0 + b2, t1 = b0 - b2, t2 = b1 + b3, t3 = b1 - b3;
            Z[base] = t0 + t2; Z[base + q] = (f32x2){t1.x - t3.y, t1.y + t3.x}; Z[base + 2 * q] = t0 - t2; Z[base + 3 * q] = (f32x2){t1.x + t3.y, t1.y - t3.x}; }
        __syncthreads(); }
}
constexpr float HY_MIN_DECAY = -3.0701134573253945f, HY_MAX_DECAY = -15.350567286626973f;
__device__ __forceinline__ float hy_delta(int c) { return fabsf(HY_MIN_DECAY + (HY_MAX_DECAY - HY_MIN_DECAY) * ((float)c / 1279.0f)); }
__device__ __forceinline__ float conv3b_at(const float* PX, int tau, int col, const float* cw, int l, int c) {
    const float* w = cw + (size_t)l * 3 * B_IN;
    return conv3_at(PX, tau, col, w[c], w[B_IN + c], w[2 * B_IN + c]);
}
__device__ __forceinline__ void hyena_unit(const Frame& F, unsigned char* ws, int l, int pair) {
    LAS f32x2* Z = (LAS f32x2*)F.lds; LAS float* red = (LAS float*)(F.lds + LDS_MISC + 128);
    const int tid = F.tid, c0 = 2 * pair;
    const float* PX = (const float*)(ws + WS_PX); const float* H3x = (const float*)(ws + WS_H3) + ((size_t)l * T + NCTX) * 64;
    f32x2* scr = (f32x2*)(ws + WS_HSCR) + (size_t)F.bid * 16384; bf16_t* OB = (bf16_t*)(ws + WS_OBUF);
    LAS f32x4* FW = (LAS f32x4*)(F.lds + LDS_MISC + 256);
    if (tid < 256) { const int j = tid >> 2, q = tid & 3; ((LAS float*)FW)[tid] = IN_(35)[(size_t)l * 64 * 2560 + (size_t)j * 2560 + (q >> 1) * 1280 + c0 + (q & 1)]; }
    __syncthreads();
    const float d0 = hy_delta(c0), d1 = hy_delta(c0 + 1);
#ifndef HYS
#define HYS 31
#endif
    float s0 = 0.f, s1 = 0.f;
    if (HYS & 1)
#pragma unroll 1
    for (int i = 0; i < 16; ++i) { const int t = tid + 512 * i; const f32x4* hr = (const f32x4*)(H3x + (size_t)t * 64);
        asm volatile("" ::: "memory");
        f32x4 acc = (f32x4){0.f, 0.f, 0.f, 0.f};
#pragma unroll 2
        for (int j4 = 0; j4 < 16; ++j4) { const f32x4 hv = hr[j4];
#pragma unroll
            for (int q = 0; q < 4; ++q) acc += FW[4 * j4 + q] * hv[q]; }
        const float tl = (float)t * (1.0f / 8191.0f), e0 = __expf(-tl * d0), e1 = __expf(-tl * d1);
        const float f0 = acc.x * e0, f1 = acc.y * e1, b0 = acc.z * e0, b1 = acc.w * e1;
        Z[t] = (f32x2){f0, f1}; s0 += fabsf(f0); s1 += fabsf(f1);
        if (t < 8191) { Z[16383 - t] = (f32x2){b0, b1}; s0 += fabsf(b0); s1 += fabsf(b1); } }
    if (tid == 0) Z[8192] = (f32x2){0.f, 0.f};
    s0 = wave_sum(s0); s1 = wave_sum(s1);
    if (F.lane == 0) { red[F.wave * 2] = s0; red[F.wave * 2 + 1] = s1; }
    __syncthreads();
    float n0 = 0.f, n1 = 0.f;
#pragma unroll
    for (int w = 0; w < 8; ++w) { n0 += red[2 * w]; n1 += red[2 * w + 1]; }
    const float sc0 = 1.0f / (16384.0f * n0), sc1 = 1.0f / (16384.0f * n1);
    if (HYS & 2) fft16k_dif(Z, tid);
#pragma unroll 4
    for (int i = 0; i < 32; ++i) scr[tid + 512 * i] = Z[tid + 512 * i];
    __syncthreads();
    const float* cwb = IN_(27); const float* cbb = IN_(28) + (size_t)l * B_IN;
    if (HYS & 4)
#pragma unroll 1
    for (int i = 0; i < 16; ++i) { const int t = tid + 512 * i, tau = NCTX + t;
        float u[4];
#pragma unroll
        for (int e = 0; e < 4; ++e) { const int c = ((e >> 1) + 1) * 1280 + c0 + (e & 1); u[e] = conv3b_at(PX, tau, PXB + c, cwb, l, c) + cbb[c]; }
        Z[t] = (f32x2){u[0] * u[2], u[1] * u[3]}; Z[8192 + t] = (f32x2){0.f, 0.f}; }
    __syncthreads();
    if (HYS & 2) fft16k_dif(Z, tid);
    if (HYS & 8)
#pragma unroll 2
    for (int i = 0; i < 17; ++i) { const int k = tid + 512 * i; if (i == 16 && tid != 0) break;
        const int pk = rev4_14(k & 16383), pn = rev4_14((16384 - k) & 16383);
        const f32x2 A = Z[pk], B = Z[pn], At = scr[pk], Bt = scr[pn];
        const f32x2 G0 = (f32x2){0.5f * (A.x + B.x), 0.5f * (A.y - B.y)}, G1 = (f32x2){0.5f * (A.y + B.y), -0.5f * (A.x - B.x)};
        const f32x2 H0 = (f32x2){0.5f * (At.x + Bt.x), 0.5f * (At.y - Bt.y)}, H1 = (f32x2){0.5f * (At.y + Bt.y), -0.5f * (At.x - Bt.x)};
        const f32x2 P0 = cmul(G0, H0), P1 = cmul(G1, H1);
        Z[pk] = (f32x2){P0.x - P1.y, P0.y + P1.x};
        if (pn != pk) Z[pn] = (f32x2){P0.x + P1.y, P1.x - P0.y}; }
    __syncthreads();
    if (HYS & 2) fft16k_dit_inv(Z, tid);
    const float bb0 = IN_(37)[l * 1280 + c0], bb1 = IN_(37)[l * 1280 + c0 + 1];
    if (HYS & 16)
#pragma unroll 1
    for (int i = 0; i < 16; ++i) { const int t = tid + 512 * i, tau = NCTX + t; const f32x2 z = Z[t];
        float u[6];
#pragma unroll
        for (int e = 0; e < 6; ++e) { const int c = (e >> 1) * 1280 + c0 + (e & 1); u[e] = conv3b_at(PX, tau, PXB + c, cwb, l, c) + cbb[c]; }
        const float o0 = u[0] * (z.x * sc0 + u[2] * u[4] * bb0), o1 = u[1] * (z.y * sc1 + u[3] * u[5] * bb1);
        *(unsigned*)(OB + (size_t)(NCTX + t) * DM + 1280 + c0) = cvt_pk_bf16(o0, o1); }
    __syncthreads();
}
__device__ __forceinline__ void hyena_ctx_unit(const Frame& F, unsigned char* ws, int l, int unit) {
    LAS float* TF = (LAS float*)F.lds; LAS float* TB = TF + 2048; LAS float* GG = TB + 2048; LAS float* X0 = GG + 2048;
    const int tid = F.tid, t = tid >> 1, cc = (tid & 1) * 4, cbase = unit * 8 + cc;
    const float* PX = (const float*)(ws + WS_PX); const float* H3c = (const float*)(ws + WS_H3) + (size_t)l * T * 64; bf16_t* OB = (bf16_t*)(ws + WS_OBUF);
    const float* cwb = IN_(27); const float* cbb = IN_(28) + (size_t)l * B_IN;
    { float f[4] = {0.f, 0.f, 0.f, 0.f}, b[4] = {0.f, 0.f, 0.f, 0.f}; const float* hr = H3c + (size_t)t * 64;
      for (int j = 0; j < 64; ++j) { const float hv = hr[j]; const float* wrow = IN_(35) + (size_t)l * 64 * 2560 + (size_t)j * 2560 + cbase;
#pragma unroll
          for (int q = 0; q < 4; ++q) { f[q] += hv * wrow[q]; b[q] += hv * wrow[1280 + q]; } }
      const float tl = (float)t * (1.0f / 255.0f);
#pragma unroll
      for (int q = 0; q < 4; ++q) { const float e = __expf(-tl * hy_delta(cbase + q)); TF[t * 8 + cc + q] = f[q] * e; TB[t * 8 + cc + q] = b[q] * e; }
      float u[12];
#pragma unroll
      for (int e = 0; e < 12; ++e) { const int c = (e >> 2) * 1280 + cbase + (e & 3); u[e] = conv3b_at(PX, t, PXB + c, cwb, l, c) + cbb[c]; }
#pragma unroll
      for (int q = 0; q < 4; ++q) { X0[t * 8 + cc + q] = u[q]; GG[t * 8 + cc + q] = u[4 + q] * u[8 + q]; } }
    __syncthreads();
    float nrm[4] = {0.f, 0.f, 0.f, 0.f}, y[4] = {0.f, 0.f, 0.f, 0.f};
    for (int s = 0; s < 256; ++s) {
#pragma unroll
        for (int q = 0; q < 4; ++q) { nrm[q] += fabsf(TF[s * 8 + cc + q]) + (s < 255 ? fabsf(TB[s * 8 + cc + q]) : 0.f);
            const int o = t - s; const float tap = o >= 0 ? TF[o * 8 + cc + q] : TB[(-o - 1) * 8 + cc + q];
            y[q] += tap * GG[s * 8 + cc + q]; } }
    float o4[4];
#pragma unroll
    for (int q = 0; q < 4; ++q) o4[q] = X0[t * 8 + cc + q] * (y[q] / nrm[q] + GG[t * 8 + cc + q] * IN_(37)[l * 1280 + cbase + q]);
    u32x2 w; w.x = cvt_pk_bf16(o4[0], o4[1]); w.y = cvt_pk_bf16(o4[2], o4[3]);
    *(u32x2*)(OB + (size_t)t * DM + 1280 + cbase) = w;
    __syncthreads();
}
constexpr int SC_C = 16, SC_NCHUNK = T / SC_C, SC_CHUNK_BYTES = 13 * 1024 + 256, SC_GRP = 4, SC_NGRP = SC_NCHUNK / SC_GRP;
__device__ __forceinline__ int sc_tau(int d, int c, int t) { return d == 0 ? SC_C * c + t : (c < NCTX / SC_C ? NCTX - 1 - SC_C * c - t : T - 1 - SC_C * (c - NCTX / SC_C) - t); }
__device__ __forceinline__ int sc_perm(int e, int hi) { return (e & 3) + 8 * (e >> 2) + 4 * hi; }
constexpr size_t WS_FR_BYTES = (size_t)2 * NHA * SC_NCHUNK * SC_CHUNK_BYTES;

__device__ __forceinline__ void scan_prep_phase(const Frame& F, unsigned char* ws) {
    const float* SS = (const float*)(ws + WS_SS); const float* SD = (const float*)(ws + WS_SD); unsigned char* FR = ws + WS_FR;
    LAS float* Wl = (LAS float*)F.lds; LAS float* At = Wl + 1024; LAS float* Rt = At + 16 * 68; LAS float* Bh = Rt + 16 * 68; LAS float* Kh = Bh + 16 * 68;
    LAS float* Bb = Kh + 16 * 68; LAS float* Kb = Bb + 1024; LAS float* Vv = Kb + 1024; LAS float* Mg = Vv + 1024; LAS float* Tm = Mg + 1024; LAS float* gC = Tm + 256;
    const int tid = F.tid;
    for (int it = F.bid; it < 2 * NHA * SC_NCHUNK; it += F.G) {
        const int chain = it / SC_NCHUNK, c = it % SC_NCHUNK, h = chain >> 1, d = chain & 1;
        { const int t = tid >> 5, j = (tid & 31) * 2, tau = sc_tau(d, c, t);
          const float* ss = SS + ((size_t)h * T + tau) * 192 + j; const float* sd = SD + (((size_t)h * 2 + d) * T + tau) * 192 + j;
          const f32x2 w = *(const f32x2*)sd, b = *(const f32x2*)(sd + 64), k = *(const f32x2*)(sd + 128), kk = *(const f32x2*)ss, r = *(const f32x2*)(ss + 64), v = *(const f32x2*)(ss + 128);
          *(LAS f32x2*)(Wl + t * 64 + j) = w;
          __syncthreads();
          f32x2 p = (f32x2){1.f, 1.f}, gm1 = p, g = p;
#pragma unroll
          for (int i = 0; i < 16; ++i) { if (i == t) gm1 = p; p *= *(const LAS f32x2*)(Wl + i * 64 + j); if (i == t) g = p; }
          const f32x2 ig = (f32x2){1.0f / g.x, 1.0f / g.y};
          *(LAS f32x2*)(At + t * 68 + j) = -kk * gm1; *(LAS f32x2*)(Rt + t * 68 + j) = r * g;
          const f32x2 bh = b * ig, kh = k * ig;
          *(LAS f32x2*)(Bh + t * 68 + j) = bh; *(LAS f32x2*)(Kh + t * 68 + j) = kh;
          *(LAS f32x2*)(Bb + t * 64 + j) = bh * p; *(LAS f32x2*)(Kb + t * 64 + j) = kh * p; *(LAS f32x2*)(Vv + t * 64 + j) = v;
          if (t == 0) *(LAS f32x2*)(gC + j) = p; }
        __syncthreads();
        { const int m4 = tid >> 7, e = tid & 127, s = e >> 3, t0 = (e & 7) * 2;
          const LAS float* X = (m4 & 1) ? Kh : Bh; const LAS float* Yv = (m4 & 2) ? Rt : At;
          float a0 = 0.f, a1 = 0.f;
#pragma unroll 4
          for (int j = 0; j < 64; j += 4) { const f32x4 x = *(const LAS f32x4*)(X + s * 68 + j), y0 = *(const LAS f32x4*)(Yv + t0 * 68 + j), y1 = *(const LAS f32x4*)(Yv + (t0 + 1) * 68 + j);
              a0 += (x.x * y0.x + x.y * y0.y) + (x.z * y0.z + x.w * y0.w); a1 += (x.x * y1.x + x.y * y1.y) + (x.z * y1.z + x.w * y1.w); }
          const bool incl = (m4 & 2) != 0;
          Mg[m4 * 256 + s * 16 + t0] = (s < t0 || (incl && s == t0)) ? a0 : 0.f;
          Mg[m4 * 256 + s * 16 + t0 + 1] = (s < t0 + 1 || (incl && s == t0 + 1)) ? a1 : 0.f; }
        __syncthreads();
        if (tid < 16) { float trow[16];
#pragma unroll
            for (int t = 0; t < 16; ++t) { float acc = (t == tid) ? 1.f : 0.f;
#pragma unroll
                for (int s = 0; s < 16; ++s) if (s < t) acc += trow[s] * Mg[s * 16 + t];
                trow[t] = acc; }
#pragma unroll
            for (int t = 0; t < 16; ++t) Tm[tid * 16 + t] = trow[t]; }
        __syncthreads();
        unsigned char* dst = FR + ((size_t)chain * SC_NCHUNK + c) * SC_CHUNK_BYTES;
        for (int q = tid; q < 13 * 64; q += 512) { const int f = q >> 6, l = q & 63, m = l & 31, hi = l >> 5;
            float x[8];
#pragma unroll
            for (int e = 0; e < 8; ++e) { const int pe = sc_perm(e, hi), ne = 8 * hi + e; float val;
                if (f < 4) { const int j = 16 * f + pe; val = m < 16 ? At[m * 68 + j] : Rt[(m - 16) * 68 + j]; }
                else if (f == 4) val = m < 16 ? Mg[256 + ne * 16 + m] : Mg[768 + ne * 16 + (m - 16)];
                else if (f == 5) val = m < 16 ? Tm[pe * 16 + m] : 0.f;
                else if (f == 6) val = m >= 16 ? Mg[512 + pe * 16 + (m - 16)] : 0.f;
                else if (f < 11) { const int jb = (f - 7) >> 1, kblk = (f - 7) & 1, j = 32 * jb + m; val = kblk ? Kb[ne * 64 + j] : Bb[pe * 64 + j]; }
                else val = Vv[ne * 64 + 32 * (f - 11) + m];
                x[e] = val; }
            u32x4 o; o.x = cvt_pk_bf16(x[0], x[1]); o.y = cvt_pk_bf16(x[2], x[3]); o.z = cvt_pk_bf16(x[4], x[5]); o.w = cvt_pk_bf16(x[6], x[7]);
            *(u32x4*)(dst + (size_t)f * 1024 + l * 16) = o; }
        if (tid < 64) { const int hi = tid >> 5, jb = (tid >> 4) & 1, r = tid & 15; ((float*)(dst + 13 * 1024))[tid] = gC[32 * jb + (r & 3) + 8 * (r >> 2) + 4 * hi]; }
        __syncthreads();
    }
}
typedef short sc_bf16x8 __attribute__((ext_vector_type(8)));
typedef float sc_f32x16 __attribute__((ext_vector_type(16)));
__device__ __forceinline__ sc_bf16x8 sc_pack8(const sc_f32x16& a, int base) {
    u32x4 w; w.x = cvt_pk_bf16(a[base + 0], a[base + 1]); w.y = cvt_pk_bf16(a[base + 2], a[base + 3]); w.z = cvt_pk_bf16(a[base + 4], a[base + 5]); w.w = cvt_pk_bf16(a[base + 6], a[base + 7]);
    return *reinterpret_cast<sc_bf16x8*>(&w);
}
__device__ __forceinline__ void scan_chain_mfma(const Frame& F, unsigned char* ws, int chain) {
    const int h = chain >> 1, d = chain & 1, tid = F.tid, lane = F.lane, n = lane & 31, hi = lane >> 5, ib = F.wave;
    const unsigned char* FRc = ws + WS_FR + (size_t)chain * SC_NCHUNK * SC_CHUNK_BYTES;
    float* Yd = (float*)(ws + WS_Y) + (size_t)d * T * A_W + h * 64;
    LAS unsigned char* buf = F.lds;
    constexpr int GRP_BYTES = SC_GRP * SC_CHUNK_BYTES, GRP_V4 = GRP_BYTES / 16;
    f32x4 st[7];
#define SCM_LOAD(g) do { const f32x4* src_ = (const f32x4*)(FRc + (size_t)(g) * GRP_BYTES); _Pragma("unroll") for (int i_ = 0; i_ < 7; ++i_) { const int idx = tid + 512 * i_; if (idx < GRP_V4) st[i_] = src_[idx]; } } while (0)
#define SCM_WRITE(b) do { _Pragma("unroll") for (int i_ = 0; i_ < 7; ++i_) { const int idx = tid + 512 * i_; if (idx < GRP_V4) *(LAS f32x4*)(buf + (b) * GRP_BYTES + idx * 16) = st[i_]; } } while (0)
    sc_f32x16 S0 = {}, S1 = {};
    SCM_LOAD(0); SCM_WRITE(0); __syncthreads();
    for (int g = 0; g < SC_NGRP; ++g) {
        if (g + 1 < SC_NGRP) SCM_LOAD(g + 1);
        if (ib < 2) {
#pragma unroll 1
            for (int cc = 0; cc < SC_GRP; ++cc) {
                const LAS unsigned char* fb = buf + (g & 1) * GRP_BYTES + cc * SC_CHUNK_BYTES;
#define SCM_FRAG(f) (*(const LAS sc_bf16x8*)(fb + (f) * 1024 + lane * 16))
                const sc_bf16x8 vf = SCM_FRAG(11 + ib);
                sc_f32x16 P = {};
                const sc_bf16x8 sb00 = sc_pack8(S0, 0), sb01 = sc_pack8(S0, 8), sb10 = sc_pack8(S1, 0), sb11 = sc_pack8(S1, 8);
                P = __builtin_amdgcn_mfma_f32_32x32x16_bf16(SCM_FRAG(0), sb00, P, 0, 0, 0);
                P = __builtin_amdgcn_mfma_f32_32x32x16_bf16(SCM_FRAG(1), sb01, P, 0, 0, 0);
                P = __builtin_amdgcn_mfma_f32_32x32x16_bf16(SCM_FRAG(2), sb10, P, 0, 0, 0);
                P = __builtin_amdgcn_mfma_f32_32x32x16_bf16(SCM_FRAG(3), sb11, P, 0, 0, 0);
                P = __builtin_amdgcn_mfma_f32_32x32x16_bf16(SCM_FRAG(4), vf, P, 0, 0, 0);
                const sc_bf16x8 xb = sc_pack8(P, 0);
                sc_f32x16 U = {};
                U = __builtin_amdgcn_mfma_f32_32x32x16_bf16(SCM_FRAG(5), xb, U, 0, 0, 0);
                const sc_bf16x8 ub = sc_pack8(U, 0);
                P = __builtin_amdgcn_mfma_f32_32x32x16_bf16(SCM_FRAG(6), ub, P, 0, 0, 0);
                const int c = g * SC_GRP + cc;
#pragma unroll
                for (int r = 8; r < 16; ++r) { const int t = (r & 3) + 8 * ((r >> 2) - 2) + 4 * hi; Yd[(size_t)sc_tau(d, c, t) * A_W + 32 * ib + n] = P[r]; }
                const LAS f32x4* gt = (const LAS f32x4*)(fb + 13 * 1024 + hi * 128);
#pragma unroll
                for (int q = 0; q < 4; ++q) { const f32x4 g0 = gt[q], g1 = gt[4 + q];
#pragma unroll
                    for (int e = 0; e < 4; ++e) { S0[4 * q + e] *= g0[e]; S1[4 * q + e] *= g1[e]; } }
                S0 = __builtin_amdgcn_mfma_f32_32x32x16_bf16(SCM_FRAG(7), ub, S0, 0, 0, 0);
                S0 = __builtin_amdgcn_mfma_f32_32x32x16_bf16(SCM_FRAG(8), vf, S0, 0, 0, 0);
                S1 = __builtin_amdgcn_mfma_f32_32x32x16_bf16(SCM_FRAG(9), ub, S1, 0, 0, 0);
                S1 = __builtin_amdgcn_mfma_f32_32x32x16_bf16(SCM_FRAG(10), vf, S1, 0, 0, 0);
#undef SCM_FRAG
            }
        }
        if (g + 1 < SC_NGRP) SCM_WRITE((g + 1) & 1);
        __syncthreads();
    }
#undef SCM_LOAD
#undef SCM_WRITE
}
__device__ __forceinline__ void mixer_phase(const Frame& F0, unsigned char* ws0, int l, bool need_ctx, char* lds_g) {
#ifndef MK_MIX
#define MK_MIX 15
#endif
    { const Frame F = opq(F0); unsigned char* ws = opq_ptr(ws0);
      if (MK_MIX & 1) for (int chain = F.bid; chain < 2 * NHA; chain += F.G) scan_chain_mfma(F, ws, chain); }
    const Frame& F = F0;
    const int n_att = 32 * NHC, n_hy = 640, n_ca = need_ctx ? NHC : 0, n_ch = need_ctx ? 160 : 0, total = n_att + n_hy + n_ca + n_ch;
    unsigned* qhead = (unsigned*)(ws0 + WS_CTL) + CW_QUEUE + 64 * l;
    for (;;) {
        if (F.tid == 0) F.MISC[16] = __hip_atomic_fetch_add(qhead, 1u, __ATOMIC_RELAXED, __HIP_MEMORY_SCOPE_AGENT);
        __syncthreads();
        const int item = (int)F.MISC[16];
        __syncthreads();
        if (item >= total) break;
        const Frame Fu = opq(F0); unsigned char* ws = opq_ptr(ws0);
        const bf16_t* QF = (const bf16_t*)(ws + WS_QF); const bf16_t* KF = (const bf16_t*)(ws + WS_KF); const bf16_t* KVRAW = (const bf16_t*)(ws + WS_KVRAW); bf16_t* OB = (bf16_t*)(ws + WS_OBUF);
        const bool is_xa = item < n_att, is_ca = item >= n_att + n_hy && item < n_att + n_hy + n_ca;
        if ((MK_MIX & 2) && (is_xa || is_ca)) { const int h = is_xa ? item % NHC : item - n_att - n_hy, row0 = is_xa ? NCTX + (item / NHC) * 256 : 0;
            att::attn_body(QF + (size_t)row0 * NQ + h * 192, KF + h * 192, KVRAW + h * 256 + 128, OB + (size_t)row0 * DM + 2560 + h * 128, is_xa ? T : NCTX, lds_g); }
        else if ((MK_MIX & 4) && item >= n_att && item < n_att + n_hy) hyena_unit(Fu, ws, l, item - n_att);
        else if ((MK_MIX & 8) && item >= n_att + n_hy + n_ca) hyena_ctx_unit(Fu, ws, l, item - n_att - n_hy - n_ca);
    }
}

constexpr int NPH = 2 + 14 * NL;
__global__ void __launch_bounds__(512, 2) mk_fwd(Args a) {
    extern __shared__ __attribute__((aligned(16))) unsigned char lds[];
    Frame F; F.lds = (LAS unsigned char*)lds; F.MISC = (volatile LAS unsigned*)(F.lds + LDS_MISC);
    F.tid = threadIdx.x; F.lane = F.tid & 63; F.wave = __builtin_amdgcn_readfirstlane(F.tid >> 6); F.bid = blockIdx.x; F.G = gridDim.x;
    if (F.tid < 64) F.MISC[F.tid] = 0u;
    if (F.tid < 46) *(LAS unsigned long long*)(F.lds + LDS_PTAB + 8 * F.tid) = (unsigned long long)(uintptr_t)a.in[F.tid];
    __syncthreads();
    unsigned char* ws = a.ws;
    XcdBarrier bar = xcd_barrier_post((unsigned*)(ws + WS_CTL) + CW_BAR, F.MISC + 8);
    const int lo = a.ph_lo, hi = a.ph_hi;
#ifndef MK_MASK
#define MK_MASK 0xffff
#endif
#define EN(x) (((MK_MASK) >> (x)) & 1)
#define IN(k) (lo <= (k) && (k) < hi)
#define SEAM(k) do { if (IN(k) && IN((k) + 1)) xcd_barrier(bar); } while (0)
    float* XS = (float*)(ws + WS_XS); bf16_t* ABUF = (bf16_t*)(ws + WS_ABUF); bf16_t* HBUF = (bf16_t*)(ws + WS_HBUF); bf16_t* OBUF = (bf16_t*)(ws + WS_OBUF); float* PX = (float*)(ws + WS_PX);
    const float* MOD = (const float*)(ws + WS_MOD); const bf16_t* WB = (const bf16_t*)(ws + WS_WB);
    if (EN(0) && IN(0)) phase0(opq(F), opq_ptr(ws));
    SEAM(0);
    if (EN(1) && IN(1)) phase_mod(opq(F), opq_ptr(ws));
    SEAM(1);
#pragma unroll 1
    for (int l = 0; l < NL; ++l) {
        const int pb = 2 + 14 * l; const bool need_ctx = l < NL - 1;
        const float* modx = MOD + ((size_t)l * 2 + 0) * NMOD; const float* modc = MOD + ((size_t)l * 2 + 1) * NMOD;
        const bf16_t* wl = WB + (size_t)l * W_LAYER;
        if (EN(2) && IN(pb + 0)) norm_phase(opq(F), XS, IN_(7) + l * DM, modx, modc, 0, 1, ABUF);
        SEAM(pb + 0);
        if (EN(3) && IN(pb + 1)) { pg8::Gemm g{ABUF, wl + W_G1, T, 2 * FF, DM}; pg8::StaticOrder S; S.init(T, 2 * FF, F.G, F.bid); pg8::EpiSwiGLU E{HBUF, FF};
            pg8::gemm_phase<pg8::EpiSwiGLU, pg8::StaticOrder>(F.lds, g, S, E, nullptr); }
        SEAM(pb + 1);
        if (EN(4) && IN(pb + 2)) { pg8::Gemm g{HBUF, wl + W_D1, T, DM, FF}; pg8::StaticOrder S; S.init(T, DM, F.G, F.bid); pg8::EpiResid E{XS, modx + 2 * DM, modc + 2 * DM, 0.5f, nullptr};
            pg8::gemm_phase<pg8::EpiResid, pg8::StaticOrder>(F.lds, g, S, E, nullptr); }
        SEAM(pb + 2);
        if (EN(5) && IN(pb + 3)) norm_phase(opq(F), XS, IN_(8) + l * DM, modx, modc, 3, 4, ABUF);
        SEAM(pb + 3);
        if (EN(6) && IN(pb + 4)) { pg8::Gemm g{ABUF, wl + W_IN, T, PXW, DM}; pg8::StaticOrder S; S.init(T, PXW, F.G, F.bid); pg8::EpiF32 E{PX, PXW, nullptr};
            pg8::gemm_phase<pg8::EpiF32, pg8::StaticOrder>(F.lds, g, S, E, nullptr); }
        SEAM(pb + 4);
        if (EN(7) && IN(pb + 5)) { rwkv_prep_phase(opq(F), opq_ptr(ws), l); mla_prep_phase(opq(F), opq_ptr(ws), l); }
        SEAM(pb + 5);
        if (EN(8) && IN(pb + 6)) {
            { pg8::Gemm g{(const bf16_t*)(ws + WS_QA), wl + W_Q, T, NQ, 1024}; pg8::StaticOrder S; S.init(T, NQ, F.G, F.bid); pg8::EpiBf16<0> E{(bf16_t*)(ws + WS_QRAW), NQ, nullptr, 0, 0};
              pg8::gemm_phase<pg8::EpiBf16<0>, pg8::StaticOrder>(F.lds, g, S, E, nullptr); }
            __syncthreads();
            { pg8::Gemm g{(const bf16_t*)(ws + WS_KVA), wl + W_KV, T, NKV, 512}; pg8::StaticOrder S; S.init(T, NKV, F.G, F.bid); pg8::EpiBf16<0> E{(bf16_t*)(ws + WS_KVRAW), NKV, nullptr, 0, 0};
              pg8::gemm_phase<pg8::EpiBf16<0>, pg8::StaticOrder>(F.lds, g, S, E, nullptr); }
        }
        SEAM(pb + 6);
        if (EN(9) && IN(pb + 7)) { qkv_final_phase(opq(F), opq_ptr(ws), l, need_ctx); scan_prep_phase(opq(F), opq_ptr(ws)); }
        SEAM(pb + 7);
        if (EN(10) && IN(pb + 8)) mixer_phase(F, ws, l, need_ctx, (char*)lds);
        SEAM(pb + 8);
        if (EN(11) && IN(pb + 9)) rwkv_out_phase(opq(F), opq_ptr(ws), l, need_ctx);
        SEAM(pb + 9);
        if (EN(12) && IN(pb + 10)) { pg8::Gemm g{OBUF, wl + W_OUT, T, DM, DM}; pg8::StaticOrder S; S.init(T, DM, F.G, F.bid); pg8::EpiResid E{XS, modx + 5 * DM, modc + 5 * DM, 1.0f, nullptr};
            pg8::gemm_phase<pg8::EpiResid, pg8::StaticOrder>(F.lds, g, S, E, nullptr); }
        SEAM(pb + 10);
        if (EN(13) && IN(pb + 11)) norm_phase(opq(F), XS, IN_(9) + l * DM, modx, modc, 6, 7, ABUF);
        SEAM(pb + 11);
        if (EN(14) && IN(pb + 12)) { pg8::Gemm g{ABUF, wl + W_G2, T, 2 * FF, DM}; pg8::StaticOrder S; S.init(T, 2 * FF, F.G, F.bid); pg8::EpiSwiGLU E{HBUF, FF};
            pg8::gemm_phase<pg8::EpiSwiGLU, pg8::StaticOrder>(F.lds, g, S, E, nullptr); }
        SEAM(pb + 12);
        if (EN(15) && IN(pb + 13)) { pg8::Gemm g{HBUF, wl + W_D2, T, DM, FF}; pg8::StaticOrder S; S.init(T, DM, F.G, F.bid); pg8::EpiResid E{XS, modx + 8 * DM, modc + 8 * DM, 0.5f, l == NL - 1 ? a.out : nullptr};
            pg8::gemm_phase<pg8::EpiResid, pg8::StaticOrder>(F.lds, g, S, E, nullptr); }
        SEAM(pb + 13);
    }
#undef IN
#undef SEAM
}

#ifndef MK_LAUNCHES
#define MK_LAUNCHES 1
#endif
extern "C" void kernel_launch(void* const* d_in, const int* in_sizes, int n_in, void* d_out, int out_size, void* d_ws, size_t ws_size, hipStream_t stream) {
    static int grid = 0;
    if (grid == 0) {
        if (n_in != 46 || in_sizes[0] != SEQ * DM || out_size != SEQ * DM || ws_size < WS_END) {
            fprintf(stderr, "kernel_launch: shape mismatch: n_in %d in0 %d out %d ws %zu (need %zu); nothing launched\n", n_in, n_in > 0 ? in_sizes[0] : -1, out_size, ws_size, (size_t)WS_END); grid = -1; return; }
        int dev = 0, cus = 0, per_cu = 0;
        if (hipGetDevice(&dev) != hipSuccess || hipDeviceGetAttribute(&cus, hipDeviceAttributeMultiprocessorCount, dev) != hipSuccess) { fprintf(stderr, "kernel_launch: device query failed\n"); grid = -1; return; }
        if (hipFuncSetAttribute((const void*)mk_fwd, hipFuncAttributeMaxDynamicSharedMemorySize, LDS_BYTES) != hipSuccess) { fprintf(stderr, "kernel_launch: hipFuncSetAttribute failed\n"); grid = -1; return; }
        if (hipOccupancyMaxActiveBlocksPerMultiprocessor(&per_cu, (const void*)mk_fwd, 512, LDS_BYTES) != hipSuccess || per_cu < 1) fprintf(stderr, "kernel_launch: note: occupancy query reports %d blocks per CU\n", per_cu);
        (void)hipGetLastError();
        grid = cus;
    }
    if (grid < 0) return;
    if (hipMemsetAsync((char*)d_ws + WS_CTL, 0, CTL_BYTES, stream) != hipSuccess) { fprintf(stderr, "kernel_launch: memset failed\n"); return; }
    Args a{};
    for (int i = 0; i < 46; ++i) a.in[i] = (const float*)d_in[i];
    a.out = (float*)d_out; a.ws = (unsigned char*)d_ws;
#if MK_LAUNCHES == 1
    a.ph_lo = 0; a.ph_hi = NPH;
    hipLaunchKernelGGL(mk_fwd, dim3(grid), dim3(512), LDS_BYTES, stream, a);
#else
    for (int p = 0; p < NPH; ++p) { a.ph_lo = p; a.ph_hi = p + 1; hipLaunchKernelGGL(mk_fwd, dim3(grid), dim3(512), LDS_BYTES, stream, a); }
#endif
    const hipError_t le = hipPeekAtLastError();
    if (le != hipSuccess) fprintf(stderr, "kernel_launch: launch failed: %s\n", hipGetErrorName(le));
}
```

```cpp
#include <hip/hip_runtime.h>
#include <stdint.h>
#include <cstdio>

#define LAS __attribute__((address_space(3)))
#define CAS __attribute__((address_space(4)))
typedef unsigned short bf16_t;
typedef float f32x4 __attribute__((ext_vector_type(4)));
typedef float f32x2 __attribute__((ext_vector_type(2)));
typedef unsigned u32x4 __attribute__((ext_vector_type(4)));
typedef unsigned u32x2 __attribute__((ext_vector_type(2)));

constexpr int T = 8448, NCTX = 256, SEQ = 8192, DM = 4096, FF = 6144, NL = 4;
constexpr int A_W = 1280, A_IN = 4160, B_IN = 3840, C_IN = 1600, NHA = 20;
constexpr int PXW = 9728, PXA = 0, PXB = 4160, PXC = 8000;
constexpr int NQ = 2304, NKV = 3072, NHC = 12;
constexpr int NMOD = 9 * DM;
constexpr float NORM_EPS = 1e-6f, GN_EPS = 64e-5f;

constexpr size_t MiB = 1u << 20;
constexpr size_t al(size_t x) { return (x + MiB - 1) / MiB * MiB; }
constexpr size_t WS_CTL = 0, CTL_BYTES = MiB;
constexpr size_t WS_XS = WS_CTL + CTL_BYTES;
constexpr size_t WS_ABUF = WS_XS + al((size_t)T * DM * 4);
constexpr size_t WS_HBUF = WS_ABUF + al((size_t)T * DM * 2);
constexpr size_t WS_OBUF = WS_HBUF + al((size_t)T * FF * 2);
constexpr size_t WS_PX = WS_OBUF + al((size_t)T * DM * 2);
constexpr size_t WS_MOD = WS_PX + al((size_t)T * PXW * 4);
constexpr size_t WS_HP = WS_MOD + al((size_t)NL * 2 * NMOD * 4);
constexpr size_t WS_SS = WS_HP + MiB;
constexpr size_t WS_SD = WS_SS + al((size_t)NHA * T * 192 * 4);
constexpr size_t WS_WLR = WS_SD + al((size_t)NHA * 2 * T * 192 * 4);
constexpr size_t WS_G = WS_WLR + al((size_t)NL * A_W * 448 * 2);
constexpr size_t WS_Y = WS_G + al((size_t)T * A_W * 4);
constexpr size_t WS_QA = WS_Y + al((size_t)2 * T * A_W * 4);
constexpr size_t WS_KVA = WS_QA + al((size_t)T * 1024 * 2);
constexpr size_t WS_KPE = WS_KVA + al((size_t)T * 512 * 2);
constexpr size_t WS_QRAW = WS_KPE + al((size_t)T * 64 * 2);
constexpr size_t WS_KVRAW = WS_QRAW + al((size_t)T * NQ * 2);
constexpr size_t WS_QF = WS_KVRAW + al((size_t)T * NKV * 2);
constexpr size_t WS_KF = WS_QF + al((size_t)T * NQ * 2);
constexpr size_t WS_H3 = WS_KF + al((size_t)T * NQ * 2);
constexpr size_t WS_HSCR = WS_H3 + al((size_t)NL * T * 64 * 4);
constexpr size_t WS_FR = WS_HSCR + al((size_t)256 * 16384 * 8);
constexpr size_t WS_GT = WS_FR + al((size_t)40 * 528 * (13 * 1024 + 256));
constexpr size_t WS_X0T = WS_GT + al((size_t)1280 * T * 4);
constexpr size_t WS_WB = WS_X0T + al((size_t)1280 * T * 4);
constexpr size_t W_G1 = 0, W_D1 = W_G1 + (size_t)2 * FF * DM, W_IN = W_D1 + (size_t)DM * FF, W_OUT = W_IN + (size_t)PXW * DM, W_G2 = W_OUT + (size_t)DM * DM,
                 W_D2 = W_G2 + (size_t)2 * FF * DM, W_Q = W_D2 + (size_t)DM * FF, W_KV = W_Q + (size_t)NQ * 1024, W_LAYER = W_KV + (size_t)NKV * 512;
constexpr size_t WS_END = WS_WB + al(W_LAYER * NL * 2);
constexpr int CW_BAR = 4096;
constexpr int CW_QUEUE = 8192;

constexpr int LDS_MISC = 143360, LDS_BYTES = 147456;

__device__ __forceinline__ float wave_sum(float v) {
#pragma unroll
    for (int o = 1; o < 64; o <<= 1) v += __shfl_xor(v, o);
    return v;
}
typedef __bf16 bf16x2_t __attribute__((ext_vector_type(2)));
__device__ __forceinline__ unsigned cvt_pk_bf16(float lo, float hi) { const f32x2 v = {lo, hi}; return __builtin_bit_cast(unsigned, __builtin_convertvector(v, bf16x2_t)); }
__device__ __forceinline__ float bf2f(unsigned short b) { return __uint_as_float(((unsigned)b) << 16); }
__device__ __forceinline__ float sigmoidf_(float x) { return 1.0f / (1.0f + __expf(-x)); }
__device__ __forceinline__ float siluf_(float x) { return x / (1.0f + __expf(-x)); }
__device__ __forceinline__ bool has_left(int tau) { return tau != 0 && tau != NCTX; }
__device__ __forceinline__ bool has_right(int tau) { return tau != NCTX - 1 && tau != T - 1; }

struct Args { const float* in[46]; float* out; unsigned char* ws; int ph_lo, ph_hi; };
struct Frame { LAS unsigned char* lds; volatile LAS unsigned* MISC; int tid, lane, wave, bid, G; };
constexpr int LDS_PTAB = LDS_MISC + 2048;
__device__ __forceinline__ const float* inp(const Frame& F, int i) {
    const volatile LAS unsigned* p = (const volatile LAS unsigned*)(F.lds + LDS_PTAB) + 2 * i;
    const unsigned lo = __builtin_amdgcn_readfirstlane(p[0]), hi = __builtin_amdgcn_readfirstlane(p[1]);
    return (const float*)(((unsigned long long)hi << 32) | lo);
}
#define IN_(i) inp(F, (i))
__device__ __forceinline__ Frame opq(const Frame& F) { Frame G = F; asm volatile("" : "+v"(G.tid), "+v"(G.lane), "+s"(G.wave), "+s"(G.bid)); return G; }
__device__ __forceinline__ unsigned char* opq_ptr(unsigned char* p) { asm volatile("" : "+s"(p)); return p; }
#ifndef MK_REP
#define MK_REP 0
#endif
#ifndef MK_ONLYRP
#define MK_ONLYRP 0
#endif
#define REP(x) (1 + (((MK_REP) >> (x)) & 1))
#define XB_TMO      128
#define XB_XCNT(j)  (256  + 64 * (j))
#define XB_XSUB(j)  (1280 + 64 * (j))
#define XB_XGEN(j)  (2304 + 64 * (j))
#define XB_TOP      3328
#define XB_TOPGEN   3392
#define XCD_BAR_WORDS 3456
#define XB_SPIN_CAP (1u << 18)

__device__ __forceinline__ unsigned xb_ld(unsigned* p)              { return __hip_atomic_load(p, __ATOMIC_RELAXED, __HIP_MEMORY_SCOPE_AGENT); }
__device__ __forceinline__ unsigned xb_add(unsigned* p, unsigned v) { return __hip_atomic_fetch_add(p, v, __ATOMIC_RELAXED, __HIP_MEMORY_SCOPE_AGENT); }
__device__ __forceinline__ unsigned xb_xcc_id() { return (unsigned)__builtin_amdgcn_s_getreg((3 << 11) | 20) & 0xFu; }
#define XB_SPIN(cond, bar) do { unsigned _sp = 0; while (cond) { __builtin_amdgcn_s_sleep(1); \
    if ((++_sp & 255u) == 0u) { if (xb_ld(&(bar)[XB_TMO])) break; if (_sp > XB_SPIN_CAP) { atomicAdd(&(bar)[XB_TMO], 1u); break; } } } } while (0)

struct XcdBarrier {
    unsigned* bar; unsigned x;
    volatile LAS unsigned* st;
};

__device__ __forceinline__ XcdBarrier xcd_barrier_post(unsigned* bar, volatile LAS unsigned* st) {
    XcdBarrier b; b.bar = bar; b.x = xb_xcc_id(); b.st = st;
    if (threadIdx.x == 0) (void)xb_add(&bar[XB_XCNT(b.x)], 1u);
    return b;
}
__device__ __forceinline__ void xcd_barrier_complete(unsigned* bar, unsigned x, unsigned& nloc, unsigned& nx) {
    const unsigned G = gridDim.x * gridDim.y * gridDim.z;
    unsigned sum, cnt, mine, sp = 0u;
    for (;;) {
        sum = 0u; cnt = 0u; mine = 0u;
#pragma unroll
        for (unsigned j = 0; j < 16; ++j) { const unsigned c = xb_ld(&bar[XB_XCNT(j)]); sum += c; cnt += (c > 0u) ? 1u : 0u; mine = (j == x) ? c : mine; }
        if (sum == G) break;
        __builtin_amdgcn_s_sleep(1);
        if ((++sp & 255u) == 0u) { if (xb_ld(&bar[XB_TMO])) break; if (sp > XB_SPIN_CAP) { atomicAdd(&bar[XB_TMO], 1u); break; } }
    }
    nloc = mine > 0u ? mine : 1u; nx = cnt > 0u ? cnt : 1u;
}

__device__ __forceinline__ void xcd_barrier(const XcdBarrier& b) {
    asm volatile("s_waitcnt vmcnt(0)" ::: "memory");
    __syncthreads();
    if (threadIdx.x == 0) {
        unsigned* bar = b.bar;
        __builtin_amdgcn_s_waitcnt(0);
        unsigned nloc = b.st[0], nx = b.st[1];
        if (nloc == 0u) { xcd_barrier_complete(bar, b.x, nloc, nx); b.st[0] = nloc; b.st[1] = nx; }
        const unsigned old = xb_add(&bar[XB_XSUB(b.x)], 1u);
        const unsigned gen = old / nloc;
        if (old + 1u == (gen + 1u) * nloc) {
            __builtin_amdgcn_fence(__ATOMIC_RELEASE, "agent");
            asm volatile("s_waitcnt vmcnt(0)" ::: "memory");
            const unsigned og = xb_add(&bar[XB_TOP], 1u);
            const unsigned tg = og / nx;
            if (og + 1u == (tg + 1u) * nx) xb_add(&bar[XB_TOPGEN], 1u);
            else XB_SPIN(xb_ld(&bar[XB_TOPGEN]) == tg, bar);
            __builtin_amdgcn_fence(__ATOMIC_ACQUIRE, "agent");
            xb_add(&bar[XB_XGEN(b.x)], 1u);
            asm volatile("s_waitcnt vmcnt(0)" ::: "memory");
        } else {
            XB_SPIN(xb_ld(&bar[XB_XGEN(b.x)]) == gen, bar);
            __builtin_amdgcn_fence(__ATOMIC_ACQUIRE, "agent");
            asm volatile("s_waitcnt vmcnt(0)" ::: "memory");
        }
    }
    __syncthreads();
}
namespace pg8 {
#define PG8_LAS __attribute__((address_space(3)))
typedef unsigned short bf16_t;
typedef short bf16x8 __attribute__((ext_vector_type(8)));
typedef float f32x4 __attribute__((ext_vector_type(4)));
typedef unsigned u32x4 __attribute__((ext_vector_type(4)));
constexpr int BM = 256, BK = 64, HALF = 128, HTB = HALF * BK * 2  , STAGE_BYTES = 8 * HTB, NXCD = 8, WGM = 8;

__host__ __device__ __forceinline__ int lds_byte(int r, int c) { const int st = (r >> 4) * 2 + (c >> 5), rr = r & 15, cc = c & 31, ob = rr * 64 + cc * 2; return st * 1024 + (ob ^ (((ob >> 9) & 1) << 5)); }
__host__ __device__ __forceinline__ void stage_rc(int b, int& R, int& C) { const int st = b / 1024, sb = b % 1024, swz = sb ^ (((sb >> 9) & 1) << 5); R = (st >> 1) * 16 + swz / 64; C = (st & 1) * 32 + (swz % 64) / 2; }
__host__ __device__ __forceinline__ int perm32(int rho) { const int n = rho >> 4, i = rho & 15; return 8 * (i >> 2) + 4 * n + (i & 3); }

struct Unit { int pm, pn; };
struct Gemm { const bf16_t* A; const bf16_t* Bt; int M, N, K; };

struct StaticOrder {
    int nM, nN, nwg, G, c;
    __host__ __device__ void init(int M, int N, int G_, int c_) { nM = M / BM; nN = N / BM; nwg = nM * nN; G = G_; c = c_; }
    __host__ __device__ bool next(int i, Unit& u) const {
        const long L = (long)i * G + c; if (L >= nwg) return false;
        int wgid = (int)L; { const int q = nwg / NXCD, r = nwg % NXCD, xcd = wgid % NXCD, off = wgid / NXCD; wgid = (xcd < r ? xcd * (q + 1) : r * (q + 1) + (xcd - r) * q) + off; }
        const int nig = WGM * nN, gid = wgid / nig, fm = gid * WGM, gsz = (nM - fm) < WGM ? (nM - fm) : WGM;
        u.pm = fm + ((wgid % nig) % gsz); u.pn = (wgid % nig) / gsz; return true;
    }
    __device__ __forceinline__ void a_ready(const Unit&) const {}
    __device__ __forceinline__ void done(const Unit&) const {}
};
struct CountedOrder : StaticOrder {
    const unsigned* ready; unsigned need; unsigned* tmo;
    __device__ __forceinline__ void a_ready(const Unit& u) const {
        if (threadIdx.x < 64) {
            const unsigned long long t0 = __builtin_amdgcn_s_memrealtime(); unsigned polls = 0;
            while ((unsigned)__builtin_amdgcn_readfirstlane(__hip_atomic_load(ready + 64 * u.pm, __ATOMIC_RELAXED, __HIP_MEMORY_SCOPE_AGENT)) < need) {
                if ((++polls & 255u) == 0u && __builtin_amdgcn_readfirstlane(__hip_atomic_load(tmo, __ATOMIC_RELAXED, __HIP_MEMORY_SCOPE_AGENT)) != 0u) break;
                if (__builtin_amdgcn_s_memrealtime() - t0 > 2000000ull) {
                    if (threadIdx.x == 0) { unsigned expect = 0u; __hip_atomic_compare_exchange_strong(tmo + 1, &expect, 0x600u | (unsigned)(u.pm & 0xff), __ATOMIC_RELAXED, __ATOMIC_RELAXED, __HIP_MEMORY_SCOPE_AGENT); __hip_atomic_store(tmo, 1u, __ATOMIC_RELAXED, __HIP_MEMORY_SCOPE_AGENT); }
                    break; }
                __builtin_amdgcn_s_sleep(2); }
            __builtin_amdgcn_fence(__ATOMIC_ACQUIRE, "agent");
            asm volatile("s_waitcnt vmcnt(0)" ::: "memory");
        }
#if !defined(BROKEN_HOOK_NO_BARRIER)
        asm volatile("" ::: "memory"); __builtin_amdgcn_s_barrier(); asm volatile("" ::: "memory");
#endif
    }
};

__device__ __forceinline__ unsigned cvt_pk_bf16(float lo, float hi) { unsigned r; asm volatile("v_cvt_pk_bf16_f32 %0, %1, %2" : "=v"(r) : "v"(lo), "v"(hi)); return r; }
typedef float f32x2 __attribute__((ext_vector_type(2)));
__device__ __forceinline__ f32x2 gelu_pk(f32x2 v) {
    const f32x2 av = __builtin_elementwise_abs(v), d = av * 0.2316418882f + 1.0f;
    f32x2 t; t.x = __builtin_amdgcn_rcpf(d.x); t.y = __builtin_amdgcn_rcpf(d.y);
    f32x2 q = t * 0.5307027145f + (-0.7265760135f); q = q * t + 0.7107068705f; q = q * t + (-0.142248368f); q = q * t + 0.127414796f; q = q * t;
    const f32x2 s = (v * v) * (-0.72134752044f);
    f32x2 e; e.x = __builtin_amdgcn_exp2f(s.x); e.y = __builtin_amdgcn_exp2f(s.y);
    const f32x2 m = v * (q * e), r = v - m;
    f32x2 o; o.x = v.x < 0.f ? m.x : r.x; o.y = v.y < 0.f ? m.y : r.y; return o;
}

struct EpiF32 {
    static constexpr bool PERM = false, AFTER_DRAIN = false;
    float* C; int ldc; const float* bias;
    __device__ __forceinline__ void operator()(const f32x4 (&acc)[2][2][4][2], const Unit& u, int wr, int wc, int fr, int fq) const {
        const int row0 = u.pm * BM + wr * 64 + fr, col0 = u.pn * BM + wc * 32 + 4 * fq;
        f32x4 bv[2][2];
#pragma unroll
        for (int bj = 0; bj < 2; ++bj)
#pragma unroll
            for (int n = 0; n < 2; ++n) bv[bj][n] = bias ? *(const f32x4*)(bias + col0 + bj * HALF + n * 16) : (f32x4){0.f, 0.f, 0.f, 0.f};
#pragma unroll
        for (int ai = 0; ai < 2; ++ai)
#pragma unroll
            for (int m = 0; m < 4; ++m) { float* rowp = C + (size_t)(row0 + ai * HALF + m * 16) * ldc + col0;
#pragma unroll
                for (int bj = 0; bj < 2; ++bj)
#pragma unroll
                    for (int n = 0; n < 2; ++n) *(f32x4*)(rowp + bj * HALF + n * 16) = acc[ai][bj][m][n] + bv[bj][n]; }
    }
};
template <int ACT  > struct EpiBf16 {
    static constexpr bool PERM = true, AFTER_DRAIN = false;
    bf16_t* O; int ldc; const float* bias; int split_cols; size_t split_stride;
    __device__ __forceinline__ void operator()(const f32x4 (&acc)[2][2][4][2], const Unit& u, int wr, int wc, int fr, int fq) const {
        const int row0 = u.pm * BM + wr * 64 + fr; int colt = u.pn * BM; bf16_t* base = O;
        if (split_cols) { const int t = colt / split_cols; base += (size_t)t * split_stride; colt -= t * split_cols; }
        const int col0 = colt + wc * 32 + 8 * fq, bcol0 = u.pn * BM + wc * 32 + 8 * fq;
        f32x4 bv[2][2];
#pragma unroll
        for (int bj = 0; bj < 2; ++bj)
#pragma unroll
            for (int n = 0; n < 2; ++n) bv[bj][n] = bias ? *(const f32x4*)(bias + bcol0 + bj * HALF + 4 * n) : (f32x4){0.f, 0.f, 0.f, 0.f};
#pragma unroll
        for (int ai = 0; ai < 2; ++ai)
#pragma unroll
            for (int m = 0; m < 4; ++m) { bf16_t* rowp = base + (size_t)(row0 + ai * HALF + m * 16) * ldc + col0;
#pragma unroll
                for (int bj = 0; bj < 2; ++bj) { f32x4 v0 = acc[ai][bj][m][0] + bv[bj][0], v1 = acc[ai][bj][m][1] + bv[bj][1];
                    if (ACT == 1) { f32x2 a = gelu_pk((f32x2){v0[0], v0[1]}), b = gelu_pk((f32x2){v0[2], v0[3]}), c = gelu_pk((f32x2){v1[0], v1[1]}), d = gelu_pk((f32x2){v1[2], v1[3]});
                        v0 = (f32x4){a.x, a.y, b.x, b.y}; v1 = (f32x4){c.x, c.y, d.x, d.y}; }
                    if (ACT == 2) {
#pragma unroll
                        for (int j = 0; j < 4; ++j) { v0[j] = 0.5f * v0[j] * (1.0f + erff(v0[j] * 0.70710678f)); v1[j] = 0.5f * v1[j] * (1.0f + erff(v1[j] * 0.70710678f)); } }
                    u32x4 w; w.x = cvt_pk_bf16(v0[0], v0[1]); w.y = cvt_pk_bf16(v0[2], v0[3]); w.z = cvt_pk_bf16(v1[0], v1[1]); w.w = cvt_pk_bf16(v1[2], v1[3]);
                    *(u32x4*)(rowp + bj * HALF) = w; } }
    }
};
}
namespace pg8 {
struct EpiSwiGLU {
    static constexpr bool PERM = true, AFTER_DRAIN = false;
    bf16_t* O; int ldc;
    __device__ __forceinline__ void operator()(const f32x4 (&acc)[2][2][4][2], const Unit& u, int wr, int wc, int fr, int fq) const {
        const int row0 = u.pm * BM + wr * 64 + fr, col0 = u.pn * HALF + wc * 32 + 8 * fq;
#pragma unroll
        for (int ai = 0; ai < 2; ++ai)
#pragma unroll
            for (int m = 0; m < 4; ++m) { bf16_t* rowp = O + (size_t)(row0 + ai * HALF + m * 16) * ldc + col0;
                float h[8];
#pragma unroll
                for (int n = 0; n < 2; ++n)
#pragma unroll
                    for (int j = 0; j < 4; ++j) { const float g = acc[ai][0][m][n][j], up = acc[ai][1][m][n][j]; h[n * 4 + j] = g * __builtin_amdgcn_rcpf(1.0f + __builtin_amdgcn_exp2f(-1.4426950408889634f * g)) * up; }
                u32x4 w; w.x = cvt_pk_bf16(h[0], h[1]); w.y = cvt_pk_bf16(h[2], h[3]); w.z = cvt_pk_bf16(h[4], h[5]); w.w = cvt_pk_bf16(h[6], h[7]);
                *(u32x4*)rowp = w; }
    }
};
struct EpiResid {
    static constexpr bool PERM = false, AFTER_DRAIN = false;
    float* X; const float* gate_x; const float* gate_c; float fac; float* out_x;
    __device__ __forceinline__ void operator()(const f32x4 (&acc)[2][2][4][2], const Unit& u, int wr, int wc, int fr, int fq) const {
        const int row0 = u.pm * BM + wr * 64 + fr, col0 = u.pn * BM + wc * 32 + 4 * fq;
        const float* gv = (u.pm == 0) ? gate_c : gate_x;
        float* dst = (u.pm != 0 && out_x) ? out_x - (size_t)256 * 4096 : X;
        f32x4 gg[2][2];
#pragma unroll
        for (int bj = 0; bj < 2; ++bj)
#pragma unroll
            for (int n = 0; n < 2; ++n) gg[bj][n] = *(const f32x4*)(gv + col0 + bj * HALF + n * 16) * fac;
#pragma unroll
        for (int ai = 0; ai < 2; ++ai)
#pragma unroll
            for (int m = 0; m < 4; ++m) { const size_t off = (size_t)(row0 + ai * HALF + m * 16) * 4096 + col0;
#pragma unroll
                for (int bj = 0; bj < 2; ++bj)
#pragma unroll
                    for (int n = 0; n < 2; ++n) { const f32x4 b = *(const f32x4*)(X + off + bj * HALF + n * 16); *(f32x4*)(dst + off + bj * HALF + n * 16) = b + gg[bj][n] * acc[ai][bj][m][n]; } }
    }
};
struct StaticOrderX { StaticOrder b;
    __host__ __device__ void init(int M, int N, int G_, int c_) { b.init(M - BM, N, G_, c_); }
    __host__ __device__ bool next(int i, Unit& u) const { const bool ok = b.next(i, u); u.pm += 1; return ok; }
    __device__ __forceinline__ void a_ready(const Unit&) const {}
    __device__ __forceinline__ void done(const Unit&) const {}
};
}
namespace pg8 {
template <class Epi, class Sched, bool STAMP = false>
__device__ __forceinline__ void gemm_phase(PG8_LAS unsigned char* lds, const Gemm g, const Sched& S, const Epi& E, unsigned long long* stamps) {
    int tid_ = threadIdx.x; asm volatile("" : "+v"(tid_));
    const int tid = tid_, wid = __builtin_amdgcn_readfirstlane(tid >> 6), lane = tid & 63, wr = wid >> 2, wc = wid & 3, fr = lane & 15, fq = lane >> 4;
    const int K = g.K, nt = K / BK;
    int ts_lo = 0, ts_hi = 0, nts = 0; const unsigned long long rt_entry = STAMP ? (unsigned long long)wall_clock64() : 0ull;
#define PG8_STAMP() do { if (STAMP && wid == 0 && nts < 64) { const unsigned long long _c = (unsigned long long)clock64(); \
        ts_lo = (lane == nts) ? (int)(unsigned)_c : ts_lo; ts_hi = (lane == nts) ? (int)(unsigned)(_c >> 32) : ts_hi; ++nts; } } while (0)
    PG8_STAMP();
    unsigned voffA[2], voffB[2];
#pragma unroll
    for (int i = 0; i < 2; ++i) { int R, C; stage_rc(tid * 16 + i * 8192, R, C); const int Rb = Epi::PERM ? ((R & ~31) + perm32(R & 31)) : R;
        voffA[i] = (unsigned)(R * K + C) * 2u; voffB[i] = (unsigned)(Rb * K + C) * 2u; }
    const size_t kstep = (size_t)(BK * 2);
    const size_t hstep = (size_t)HALF * K * 2;
    const size_t tstep = 2 * hstep;
    const unsigned ldsw = (unsigned)wid * 1024u;
    const int aoff = lds_byte(wr * 64 + fr, fq * 8), boff = lds_byte(wc * 32 + fr, fq * 8);
#define PG8_SA(b, h) (((b) * 2 + (h)) * HTB)
#define PG8_SB(b, h) ((4 + (b) * 2 + (h)) * HTB)
#define PG8_STAGE(bufoff, gbase, voff) do { _Pragma("unroll") for (int _i = 0; _i < 2; ++_i) \
        __builtin_amdgcn_global_load_lds((const unsigned*)((const char*)(gbase) + (voff)[_i]), (PG8_LAS unsigned*)(lds + (bufoff) + ldsw + _i * 8192), 16, 0, 0); } while (0)
#define PG8_LDA(dst, b, h) do { _Pragma("unroll") for (int m = 0; m < 4; ++m) _Pragma("unroll") for (int k = 0; k < 2; ++k) dst[m][k] = *(const PG8_LAS bf16x8*)(lds + PG8_SA(b, h) + aoff + m * 2048 + k * 1024); } while (0)
#define PG8_LDB(dst, b, h) do { _Pragma("unroll") for (int n = 0; n < 2; ++n) _Pragma("unroll") for (int k = 0; k < 2; ++k) dst[n][k] = *(const PG8_LAS bf16x8*)(lds + PG8_SB(b, h) + boff + n * 2048 + k * 1024); } while (0)
#define PG8_MMA(ai, bj, At, Bt) do { __builtin_amdgcn_s_setprio(1); _Pragma("unroll") for (int m = 0; m < 4; ++m) _Pragma("unroll") for (int n = 0; n < 2; ++n) _Pragma("unroll") for (int k = 0; k < 2; ++k) \
        acc[ai][bj][m][n] = __builtin_amdgcn_mfma_f32_16x16x32_bf16(Bt[n][k], At[m][k], acc[ai][bj][m][n], 0, 0, 0); __builtin_amdgcn_s_setprio(0); } while (0)
#define PG8_WAIT_V(n) asm volatile("s_waitcnt vmcnt(" #n ")" ::: "memory")
#define PG8_WAIT_L(n) asm volatile("s_waitcnt lgkmcnt(" #n ")" ::: "memory")
#define PG8_BAR __builtin_amdgcn_s_barrier()
#define PG8_SCHED __builtin_amdgcn_sched_barrier(0)
    Unit cur, nxt; int ui = 0;
    if (!S.next(0, cur)) return;
    f32x4 acc[2][2][4][2];
#pragma unroll
    for (int a = 0; a < 2; ++a)
#pragma unroll
        for (int b = 0; b < 2; ++b)
#pragma unroll
            for (int m = 0; m < 4; ++m)
#pragma unroll
                for (int n = 0; n < 2; ++n) acc[a][b][m][n] = (f32x4){0.f, 0.f, 0.f, 0.f};
    bf16x8 At[4][2], B0[2][2], B1[2][2];
    const char* cA = (const char*)g.A + (size_t)cur.pm * tstep; const char* cB = (const char*)g.Bt + (size_t)cur.pn * tstep;
    S.a_ready(cur);
    PG8_STAGE(PG8_SB(0, 0), cB, voffB); PG8_STAGE(PG8_SA(0, 0), cA, voffA); PG8_STAGE(PG8_SB(0, 1), cB + hstep, voffB); PG8_STAGE(PG8_SA(0, 1), cA + hstep, voffA);
    if (wr == 1) PG8_BAR;
    PG8_WAIT_V(4); PG8_BAR;
    PG8_STAGE(PG8_SB(1, 0), cB + kstep, voffB); PG8_STAGE(PG8_SA(1, 0), cA + kstep, voffA); PG8_STAGE(PG8_SB(1, 1), cB + hstep + kstep, voffB);
    PG8_WAIT_V(6); PG8_BAR;
    PG8_STAMP();
    for (;;) {
        const bool has_next = S.next(ui + 1, nxt);
        const char* nA = has_next ? (const char*)g.A + (size_t)nxt.pm * tstep : cA; const char* nB = has_next ? (const char*)g.Bt + (size_t)nxt.pn * tstep : cB;
        for (int t = 0; t < nt; t += 2) {
            const bool last = (t == nt - 2);
            const char* a1 = cA + (size_t)(t + 1) * kstep;
            const char* a2 = last ? nA : cA + (size_t)(t + 2) * kstep; const char* b2 = last ? nB : cB + (size_t)(t + 2) * kstep;
            const char* a3 = a2 + kstep; const char* b3 = b2 + kstep;
            if (last && has_next) S.a_ready(nxt);
            PG8_LDB(B0, 0, 0); PG8_SCHED; PG8_LDA(At, 0, 0); PG8_STAGE(PG8_SA(1, 1), a1 + hstep, voffA);
            PG8_WAIT_L(8); PG8_BAR; PG8_WAIT_L(0); PG8_MMA(0, 0, At, B0); PG8_BAR; PG8_SCHED;
            PG8_LDB(B1, 0, 1); PG8_STAGE(PG8_SB(0, 0), b2, voffB);
            PG8_BAR; PG8_WAIT_L(0); PG8_MMA(0, 1, At, B1); PG8_BAR;
            PG8_LDA(At, 0, 1); PG8_STAGE(PG8_SA(0, 0), a2, voffA);
            PG8_BAR; PG8_WAIT_L(0); PG8_MMA(1, 0, At, B0); PG8_BAR; PG8_SCHED;
            PG8_STAGE(PG8_SB(0, 1), b2 + hstep, voffB);
            PG8_WAIT_V(6); PG8_BAR; PG8_MMA(1, 1, At, B1); PG8_BAR;
            PG8_LDB(B0, 1, 0); PG8_SCHED; PG8_LDA(At, 1, 0); PG8_STAGE(PG8_SA(0, 1), a2 + hstep, voffA);
            PG8_WAIT_L(8); PG8_BAR; PG8_WAIT_L(0); PG8_MMA(0, 0, At, B0); PG8_BAR; PG8_SCHED;
            PG8_LDB(B1, 1, 1); PG8_STAGE(PG8_SB(1, 0), b3, voffB);
            PG8_BAR; PG8_WAIT_L(0); PG8_MMA(0, 1, At, B1); PG8_BAR;
            PG8_LDA(At, 1, 1); PG8_STAGE(PG8_SA(1, 0), a3, voffA);
            PG8_BAR; PG8_WAIT_L(0); PG8_MMA(1, 0, At, B0); PG8_BAR; PG8_SCHED;
            PG8_STAGE(PG8_SB(1, 1), b3 + hstep, voffB);
            PG8_WAIT_V(6); PG8_BAR; PG8_MMA(1, 1, At, B1); PG8_BAR;
        }
        PG8_STAMP();
        if constexpr (!Epi::AFTER_DRAIN) { E(acc, cur, wr, wc, fr, fq); S.done(cur); }
        PG8_STAMP();
        if (!has_next) break;
#pragma unroll
        for (int a = 0; a < 2; ++a)
#pragma unroll
            for (int b = 0; b < 2; ++b)
#pragma unroll
                for (int m = 0; m < 4; ++m)
#pragma unroll
                    for (int n = 0; n < 2; ++n) acc[a][b][m][n] = (f32x4){0.f, 0.f, 0.f, 0.f};
        cur = nxt; cA = nA; cB = nB; ++ui;
    }
    PG8_WAIT_V(0);
    if (wr == 0) PG8_BAR;
    PG8_BAR;
    if constexpr (Epi::AFTER_DRAIN) { E.fused(acc, cur, wr, wc, fr, fq, lds, wid, lane); S.done(cur); }
    PG8_STAMP();
    if (STAMP && wid == 0) { stamps[lane] = lane < nts ? (((unsigned long long)(unsigned)ts_hi << 32) | (unsigned)ts_lo) : 0ull;
        if (lane == 62) stamps[62] = rt_entry; if (lane == 63) stamps[63] = (unsigned long long)wall_clock64(); }
#undef PG8_STAMP
#undef PG8_SA
#undef PG8_SB
#undef PG8_STAGE
#undef PG8_LDA
#undef PG8_LDB
#undef PG8_MMA
#undef PG8_WAIT_V
#undef PG8_WAIT_L
#undef PG8_BAR
#undef PG8_SCHED
}
}
#define LDS_WAIT() asm volatile("s_waitcnt lgkmcnt(0)" ::: "memory")

__device__ __forceinline__ int map_row(int n, int mode) {
    if (mode == 1) { const int j = n < FF ? n : n - FF; return (j >> 7) * 256 + (n < FF ? 0 : 128) + (j & 127); }
    return n;
}
__device__ __forceinline__ void transpose_item(const float* __restrict__ W, int K, int N, bf16_t* WT, int mode, LAS float* scr, int item, int lane) {
    const int nblk = N / 32, kb = item / nblk, nb = item % nblk, k0 = 64 * kb, n0 = 32 * nb;
#pragma unroll 8
    for (int i = 0; i < 32; ++i) { const int kk = 2 * i + (lane >> 5); scr[kk * 33 + (lane & 31)] = W[(size_t)(k0 + kk) * N + n0 + (lane & 31)]; }
    LDS_WAIT(); asm volatile("" ::: "memory");
    const int c = lane & 7;
#pragma unroll
    for (int j = 0; j < 4; ++j) { const int n = (lane >> 3) + 8 * j; const LAS float* s = scr + (8 * c) * 33 + n;
        u32x4 o; o.x = cvt_pk_bf16(s[0 * 33], s[1 * 33]); o.y = cvt_pk_bf16(s[2 * 33], s[3 * 33]); o.z = cvt_pk_bf16(s[4 * 33], s[5 * 33]); o.w = cvt_pk_bf16(s[6 * 33], s[7 * 33]);
        *(u32x4*)(WT + (size_t)map_row(n0 + n, mode) * K + k0 + 8 * c) = o; }
    LDS_WAIT(); asm volatile("" ::: "memory");
}
constexpr int I_G = (DM / 64) * (2 * FF / 32), I_D = (FF / 64) * (DM / 32), I_IN = (DM / 64) * (9600 / 32), I_OUT = (DM / 64) * (DM / 32), I_Q = (1024 / 64) * (NQ / 32), I_KV = (512 / 64) * (NKV / 32);
constexpr int I_LAYER = 2 * I_G + 2 * I_D + I_IN + I_OUT + I_Q + I_KV;

__device__ __forceinline__ void phase0(const Frame& F, unsigned char* ws) {
    const int gw = F.bid * 8 + F.wave, NGW = F.G * 8;
    const size_t gt = (size_t)F.bid * 512 + F.tid, NGT = (size_t)F.G * 512;
    LAS float* scr = (LAS float*)(F.lds + F.wave * 8704);
    bf16_t* WB = (bf16_t*)(ws + WS_WB);
    for (int it = gw; it < NL * I_LAYER; it += NGW) {
        const int l = it / I_LAYER; int r = it - l * I_LAYER; bf16_t* wl = WB + (size_t)l * W_LAYER;
        if (r < I_G) { transpose_item(IN_(10) + (size_t)l * DM * 2 * FF, DM, 2 * FF, wl + W_G1, 1, scr, r, F.lane); continue; } r -= I_G;
        if (r < I_D) { transpose_item(IN_(11) + (size_t)l * FF * DM, FF, DM, wl + W_D1, 0, scr, r, F.lane); continue; } r -= I_D;
        if (r < I_G) { transpose_item(IN_(12) + (size_t)l * DM * 2 * FF, DM, 2 * FF, wl + W_G2, 1, scr, r, F.lane); continue; } r -= I_G;
        if (r < I_D) { transpose_item(IN_(13) + (size_t)l * FF * DM, FF, DM, wl + W_D2, 0, scr, r, F.lane); continue; } r -= I_D;
        if (r < I_IN) { transpose_item(IN_(14) + (size_t)l * DM * 9600, DM, 9600, wl + W_IN, 0, scr, r, F.lane); continue; } r -= I_IN;
        if (r < I_OUT) { transpose_item(IN_(15) + (size_t)l * DM * DM, DM, DM, wl + W_OUT, 0, scr, r, F.lane); continue; } r -= I_OUT;
        if (r < I_Q) { transpose_item(IN_(39) + (size_t)l * 1024 * NQ, 1024, NQ, wl + W_Q, 0, scr, r, F.lane); continue; } r -= I_Q;
        transpose_item(IN_(41) + (size_t)l * 512 * NKV, 512, NKV, wl + W_KV, 0, scr, r, F.lane);
    }
    for (size_t i = gt; i < (size_t)NL * 128 * 512; i += NGT) {
        const int l = (int)(i / (128 * 512)), rr = (int)((i / 512) % 128), c = (int)(i % 512);
        const int row = 9600 + rr;
        *(u32x4*)(WB + (size_t)l * W_LAYER + W_IN + (size_t)row * DM + c * 8) = (u32x4){0u, 0u, 0u, 0u};
    }
    { bf16_t* WLR = (bf16_t*)(ws + WS_WLR); const float* wu = IN_(18); const float* au = IN_(20); const float* gu = IN_(21);
      for (size_t i = gt; i < (size_t)NL * 448 * A_W; i += NGT) { const int l = (int)(i / (448 * A_W)), k = (int)((i / A_W) % 448), col = (int)(i % A_W);
          float v;
          if (k < 128) v = wu[(((size_t)l * 2 + (k >> 6)) * 64 + (k & 63)) * A_W + col];
          else if (k < 256) v = au[(((size_t)l * 2 + ((k - 128) >> 6)) * 64 + (k & 63)) * A_W + col];
          else v = gu[((size_t)l * 192 + (k - 256)) * A_W + col];
          WLR[((size_t)l * A_W + col) * 448 + k] = (bf16_t)(cvt_pk_bf16(v, v) & 0xffffu); } }
    { f32x4* xs = (f32x4*)(ws + WS_XS); const f32x4* cx = (const f32x4*)IN_(2); const f32x4* xx = (const f32x4*)IN_(0);
      for (size_t i = gt; i < (size_t)T * DM / 4; i += NGT) xs[i] = i < (size_t)NCTX * DM / 4 ? cx[i] : xx[i - (size_t)NCTX * DM / 4]; }
    { float* HP = (float*)(ws + WS_HP);
      for (int it = F.bid; it < NL * 16; it += F.G) { const int l = it >> 4, ch = it & 15, w = F.tid >> 8, j = F.tid & 255;
          const float* cv = w ? IN_(3) : IN_(1); const float* ad = IN_(4) + ((size_t)l * DM + ch * 256) * 256 + j; float s = 0.f;
          for (int i = 0; i < 256; ++i) s += siluf_(cv[ch * 256 + i]) * ad[(size_t)i * 256];
          HP[((l * 16 + ch) * 2 + w) * 256 + j] = s; } }
    { float* H3 = (float*)(ws + WS_H3);
      LAS float* zb = (LAS float*)(F.lds + 73728); LAS float* ha = zb + 8 * 36; LAS float* hb = ha + 8 * 64;
      for (int it = F.bid; it < NL * (T / 8); it += F.G) { const int l = it / (T / 8), pb = it % (T / 8);
          if (F.tid < 8 * 33) { const int p = F.tid / 33, i = F.tid % 33, P = pb * 8 + p; const int L = P < NCTX ? NCTX : SEQ, t = P < NCTX ? P : P - NCTX;
              float z;
              if (i == 0) z = (float)t / (float)(L - 1);
              else { const int b = (i - 1) & 15; const float fb = 1e-4f + (float)b * ((15.0f - 1e-4f) / 15.0f); const float rev2 = 2.0f * fb * (float)t / (float)L;
                  z = i <= 16 ? cospif(rev2) : -sinpif(rev2); }
              zb[p * 36 + i] = z; }
          __syncthreads();
          const int p = F.tid >> 6, j = F.tid & 63; const float fq = IN_(36)[l * 64 + j];
          { const float* w1 = IN_(29) + (size_t)l * 33 * 64 + j; float s = IN_(30)[l * 64 + j];
            for (int i = 0; i < 33; ++i) s += zb[p * 36 + i] * w1[i * 64];
            ha[p * 64 + j] = sinf(fq * s); }
          __syncthreads();
          { const float* w2 = IN_(31) + (size_t)l * 64 * 64 + j; float s = IN_(32)[l * 64 + j];
            for (int i = 0; i < 64; ++i) s += ha[p * 64 + i] * w2[i * 64];
            hb[p * 64 + j] = sinf(fq * s); }
          __syncthreads();
          { const float* w3 = IN_(33) + (size_t)l * 64 * 64 + j; float s = IN_(34)[l * 64 + j];
            for (int i = 0; i < 64; ++i) s += hb[p * 64 + i] * w3[i * 64];
            H3[((size_t)l * 64 + j) * T + pb * 8 + p] = sinf(fq * s); }
          __syncthreads(); } }
}
__device__ __forceinline__ void phase_mod(const Frame& F, unsigned char* ws) {
    const float* HP = (const float*)(ws + WS_HP); float* MOD = (float*)(ws + WS_MOD);
    LAS float* hs = (LAS float*)F.lds;
    for (int it = F.bid; it < NL * (NMOD / 512); it += F.G) { const int l = it / (NMOD / 512), nb = it % (NMOD / 512);
        { const int w = F.tid >> 8, j = F.tid & 255; float s = 0.f;
          for (int ch = 0; ch < 16; ++ch) s += HP[((l * 16 + ch) * 2 + w) * 256 + j];
          hs[w * 256 + j] = s; }
        __syncthreads();
        const int n = nb * 512 + F.tid; const float* au = IN_(5) + (size_t)l * 256 * NMOD + n; float s0 = IN_(6)[(size_t)l * NMOD + n], s1 = s0;
        for (int j = 0; j < 256; ++j) { const float u = au[(size_t)j * NMOD]; s0 += hs[j] * u; s1 += hs[256 + j] * u; }
        MOD[((size_t)l * 2 + 0) * NMOD + n] = s0; MOD[((size_t)l * 2 + 1) * NMOD + n] = s1;
        __syncthreads(); }
}
__device__ __forceinline__ void norm_phase(const Frame& F, const float* XS, const float* __restrict__ gain, const float* modx, const float* modc, int ish, int isc, bf16_t* out) {
    const int gw = F.bid * 8 + F.wave, NGW = F.G * 8;
    for (int row = gw; row < T; row += NGW) {
        const float* mod = row < NCTX ? modc : modx;
        const f32x4* xr = (const f32x4*)(XS + (size_t)row * DM) + F.lane; const f32x4* g4 = (const f32x4*)gain + F.lane;
        const f32x4* sh4 = (const f32x4*)(mod + (size_t)ish * DM) + F.lane; const f32x4* sc4 = (const f32x4*)(mod + (size_t)isc * DM) + F.lane;
        f32x4 v[16]; float s = 0.f;
#pragma unroll
        for (int j = 0; j < 16; ++j) { v[j] = xr[64 * j]; s += (v[j].x * v[j].x + v[j].y * v[j].y) + (v[j].z * v[j].z + v[j].w * v[j].w); }
        const float rstd = rsqrtf(wave_sum(s) * (1.0f / DM) + NORM_EPS);
        u32x2* o = (u32x2*)(out + (size_t)row * DM) + F.lane;
#pragma unroll
        for (int j = 0; j < 16; ++j) { const f32x4 y = v[j] * rstd * g4[64 * j] * (sc4[64 * j] + 1.0f) + sh4[64 * j];
            u32x2 w; w.x = cvt_pk_bf16(y.x, y.y); w.y = cvt_pk_bf16(y.z, y.w); o[64 * j] = w; }
    }
}
__device__ __forceinline__ float conv3_at(const float* PX, int tau, int col, float w0, float w1, float w2) {
    const float* p = PX + (size_t)tau * PXW + col;
    const bool hl = has_left(tau), hr = has_right(tau);
    return p[0] * w1 + p[hl ? -PXW : 0] * (hl ? w0 : 0.f) + p[hr ? PXW : 0] * (hr ? w2 : 0.f);
}
__device__ __forceinline__ float rope_apply(float val, int tau, int j) {
    const int pos = tau - NCTX, prow = pos >> 6, pcol = pos & 63;
    const float inv = __powf(10000.0f, -(float)(j & 15) * (1.0f / 16.0f));
    const float ang = (float)(j < 32 ? prow : pcol) * inv;
    float sn, cs; sincosf(ang, &sn, &cs);
    const float partner = __shfl_xor(val, 16);
    const float rot = (j & 16) ? partner : -partner;
    return val * cs + rot * sn;
}
__device__ __forceinline__ void mla_prep_phase(const Frame& F, unsigned char* ws, int l) {
    const float* PX = (const float*)(ws + WS_PX); bf16_t* QA = (bf16_t*)(ws + WS_QA); bf16_t* KVA = (bf16_t*)(ws + WS_KVA); bf16_t* KPE = (bf16_t*)(ws + WS_KPE);
    const int gw = F.bid * 8 + F.wave, NGW = F.G * 8;
    const f32x4* gq = (const f32x4*)(IN_(38) + l * 1024) + F.lane; const f32x4* gkv = (const f32x4*)(IN_(40) + l * 512) + F.lane; const float gpe = IN_(45)[l * 64 + F.lane];
    for (int tau = gw; tau < T; tau += NGW) {
        const f32x4* p = (const f32x4*)(PX + (size_t)tau * PXW + PXC) + F.lane;
        f32x4 q[4], kv[2]; float sq = 0.f, skv = 0.f;
#pragma unroll
        for (int j = 0; j < 4; ++j) { q[j] = p[64 * j]; sq += (q[j].x * q[j].x + q[j].y * q[j].y) + (q[j].z * q[j].z + q[j].w * q[j].w); }
#pragma unroll
        for (int j = 0; j < 2; ++j) { kv[j] = p[256 + 64 * j]; skv += (kv[j].x * kv[j].x + kv[j].y * kv[j].y) + (kv[j].z * kv[j].z + kv[j].w * kv[j].w); }
        const float pe = PX[(size_t)tau * PXW + PXC + 1536 + F.lane];
        const float rq = rsqrtf(wave_sum(sq) * (1.0f / 1024.0f) + NORM_EPS), rkv = rsqrtf(wave_sum(skv) * (1.0f / 512.0f) + NORM_EPS), rpe = rsqrtf(wave_sum(pe * pe) * (1.0f / 64.0f) + NORM_EPS);
        u32x2* oq = (u32x2*)(QA + (size_t)tau * 1024) + F.lane; u32x2* okv = (u32x2*)(KVA + (size_t)tau * 512) + F.lane;
#pragma unroll
        for (int j = 0; j < 4; ++j) { const f32x4 y = q[j] * rq * gq[64 * j]; u32x2 w; w.x = cvt_pk_bf16(y.x, y.y); w.y = cvt_pk_bf16(y.z, y.w); oq[64 * j] = w; }
#pragma unroll
        for (int j = 0; j < 2; ++j) { const f32x4 y = kv[j] * rkv * gkv[64 * j]; u32x2 w; w.x = cvt_pk_bf16(y.x, y.y); w.y = cvt_pk_bf16(y.z, y.w); okv[64 * j] = w; }
        float kp = pe * rpe * gpe;
        if (tau >= NCTX) kp = rope_apply(kp, tau, F.lane);
        KPE[(size_t)tau * 64 + F.lane] = (bf16_t)(cvt_pk_bf16(kp, kp) & 0xffffu);
    }
}
__device__ __forceinline__ void qkv_final_phase(const Frame& F, unsigned char* ws, int l, bool need_ctx) {
    const bf16_t* QRAW = (const bf16_t*)(ws + WS_QRAW); const bf16_t* KVRAW = (const bf16_t*)(ws + WS_KVRAW); const bf16_t* KPE = (const bf16_t*)(ws + WS_KPE);
    bf16_t* QF = (bf16_t*)(ws + WS_QF); bf16_t* KF = (bf16_t*)(ws + WS_KF);
    const int gw = F.bid * 8 + F.wave, NGW = F.G * 8, ln = F.lane;
    const float gqn0 = IN_(42)[l * 128 + 2 * ln], gqn1 = IN_(42)[l * 128 + 2 * ln + 1], gqp = IN_(43)[l * 64 + ln];
    const float gkn0 = IN_(44)[l * 128 + 2 * ln], gkn1 = IN_(44)[l * 128 + 2 * ln + 1];
    (void)need_ctx;
    for (int it = gw; it < T * NHC; it += NGW) { const int tau = it / NHC, h = it % NHC;
        const unsigned qn = *(const unsigned*)(QRAW + (size_t)tau * NQ + h * 192 + 2 * ln); const float q0 = bf2f((unsigned short)(qn & 0xffffu)), q1 = bf2f((unsigned short)(qn >> 16));
        const float qp = bf2f(QRAW[(size_t)tau * NQ + h * 192 + 128 + ln]);
        const unsigned kn = *(const unsigned*)(KVRAW + (size_t)tau * NKV + h * 256 + 2 * ln); const float k0 = bf2f((unsigned short)(kn & 0xffffu)), k1 = bf2f((unsigned short)(kn >> 16));
        const float rqn = rsqrtf(wave_sum(q0 * q0 + q1 * q1) * (1.0f / 128.0f) + NORM_EPS), rqp = rsqrtf(wave_sum(qp * qp) * (1.0f / 64.0f) + NORM_EPS), rkn = rsqrtf(wave_sum(k0 * k0 + k1 * k1) * (1.0f / 128.0f) + NORM_EPS);
        float qpe = qp * rqp * gqp; if (tau >= NCTX) qpe = rope_apply(qpe, tau, ln);
        *(unsigned*)(QF + (size_t)tau * NQ + h * 192 + 2 * ln) = cvt_pk_bf16(q0 * rqn * gqn0, q1 * rqn * gqn1);
        QF[(size_t)tau * NQ + h * 192 + 128 + ln] = (bf16_t)(cvt_pk_bf16(qpe, qpe) & 0xffffu);
        *(unsigned*)(KF + (size_t)tau * NQ + h * 192 + 2 * ln) = cvt_pk_bf16(k0 * rkn * gkn0, k1 * rkn * gkn1);
        KF[(size_t)tau * NQ + h * 192 + 128 + ln] = KPE[(size_t)tau * 64 + ln];
    }
}
__device__ __forceinline__ void rwkv_out_phase(const Frame& F, unsigned char* ws, int l, bool need_ctx) {
    const float* SS = (const float*)(ws + WS_SS); const float* SD = (const float*)(ws + WS_SD); const float* GB = (const float*)(ws + WS_G); const float* Y = (const float*)(ws + WS_Y);
    bf16_t* OB = (bf16_t*)(ws + WS_OBUF);
    const int gw = F.bid * 8 + F.wave, NGW = F.G * 8, ln = F.lane;
    const int lo = need_ctx ? 0 : NCTX * NHA;
    for (int it = lo + gw; it < T * NHA; it += NGW) { const int tau = it / NHA, h = it % NHA, col = h * 64 + ln;
        const float y = Y[(size_t)tau * A_W + col] + Y[((size_t)T + tau) * A_W + col];
        const float mu = wave_sum(y) * (1.0f / 64.0f); const float dy = y - mu; const float var = wave_sum(dy * dy) * (1.0f / 64.0f);
        const float yn = dy * rsqrtf(var + GN_EPS) * IN_(25)[l * A_W + col] + IN_(26)[l * A_W + col];
        const float* ss = SS + ((size_t)h * T + tau) * 192 + ln; const float r = ss[64], v = ss[128];
        const float km = 0.5f * (SD[(((size_t)h * 2 + 0) * T + tau) * 192 + 128 + ln] + SD[(((size_t)h * 2 + 1) * T + tau) * 192 + 128 + ln]);
        const float bonus = wave_sum(r * km * IN_(24)[l * A_W + col]) * v;
        const float o = (yn + bonus) * GB[(size_t)tau * A_W + col];
        OB[(size_t)tau * DM + col] = (bf16_t)(cvt_pk_bf16(o, o) & 0xffffu);
    }
}
__device__ __forceinline__ void hyena_prep_phase(const Frame& F, unsigned char* ws, int l) {
    const float* PX = (const float*)(ws + WS_PX); float* GT = (float*)(ws + WS_GT); float* X0T = (float*)(ws + WS_X0T);
    LAS float* LGt = (LAS float*)F.lds; LAS float* LX0 = LGt + 64 * 65;
    const float* cw = IN_(27) + (size_t)l * 3 * B_IN; const float* cb = IN_(28) + (size_t)l * B_IN;
    for (int it = F.bid; it < (T / 64) * 20; it += F.G) { const int tt = it / 20, ct = it % 20;
        { const int t = F.tid >> 3, c0 = ct * 64 + (F.tid & 7) * 8, tau = tt * 64 + t;
          f32x4 u[3][2];
#pragma unroll
          for (int grp = 0; grp < 3; ++grp)
#pragma unroll
              for (int q = 0; q < 2; ++q) { const int c = grp * 1280 + c0 + 4 * q; const float* p = PX + (size_t)tau * PXW + PXB + c;
                  const bool hl = has_left(tau), hr = has_right(tau);
                  const f32x4 y = *(const f32x4*)p * *(const f32x4*)(cw + B_IN + c) + *(const f32x4*)(cb + c) + *(const f32x4*)(p - (hl ? PXW : 0)) * (*(const f32x4*)(cw + c) * (hl ? 1.f : 0.f))
                                + *(const f32x4*)(p + (hr ? PXW : 0)) * (*(const f32x4*)(cw + 2 * B_IN + c) * (hr ? 1.f : 0.f));
                  u[grp][q] = y; }
#pragma unroll
          for (int q = 0; q < 2; ++q)
#pragma unroll
              for (int e = 0; e < 4; ++e) { const int ch = (F.tid & 7) * 8 + 4 * q + e; LGt[ch * 65 + t] = u[1][q][e] * u[2][q][e]; LX0[ch * 65 + t] = u[0][q][e]; } }
        __syncthreads();
        { const int ch = F.tid >> 3, t0 = (F.tid & 7) * 8; const size_t o = (size_t)(ct * 64 + ch) * T + tt * 64 + t0;
          f32x4 a0, a1, b0, b1;
#pragma unroll
          for (int e = 0; e < 4; ++e) { a0[e] = LGt[ch * 65 + t0 + e]; a1[e] = LGt[ch * 65 + t0 + 4 + e]; b0[e] = LX0[ch * 65 + t0 + e]; b1[e] = LX0[ch * 65 + t0 + 4 + e]; }
          *(f32x4*)(GT + o) = a0; *(f32x4*)(GT + o + 4) = a1; *(f32x4*)(X0T + o) = b0; *(f32x4*)(X0T + o + 4) = b1; }
        __syncthreads(); }
}
__device__ __forceinline__ void hyena_out_phase(const Frame& F, unsigned char* ws, bool need_ctx) {
    const float* YT = (const float*)(ws + WS_GT); bf16_t* OB = (bf16_t*)(ws + WS_OBUF);
    LAS float* L = (LAS float*)F.lds;
    const int it0 = need_ctx ? 0 : (NCTX / 64) * 20;
    for (int it = it0 + F.bid; it < (T / 64) * 20; it += F.G) { const int tt = it / 20, ct = it % 20;
        { const int ch = F.tid >> 3, t0 = (F.tid & 7) * 8; const size_t o = (size_t)(ct * 64 + ch) * T + tt * 64 + t0;
          const f32x4 a0 = *(const f32x4*)(YT + o), a1 = *(const f32x4*)(YT + o + 4);
#pragma unroll
          for (int e = 0; e < 4; ++e) { L[ch * 65 + t0 + e] = a0[e]; L[ch * 65 + t0 + 4 + e] = a1[e]; } }
        __syncthreads();
        { const int t = F.tid >> 3, c0 = (F.tid & 7) * 8; float x[8];
#pragma unroll
          for (int e = 0; e < 8; ++e) x[e] = L[(c0 + e) * 65 + t];
          u32x4 w; w.x = cvt_pk_bf16(x[0], x[1]); w.y = cvt_pk_bf16(x[2], x[3]); w.z = cvt_pk_bf16(x[4], x[5]); w.w = cvt_pk_bf16(x[6], x[7]);
          *(u32x4*)(OB + (size_t)(tt * 64 + t) * DM + 1280 + ct * 64 + c0) = w; }
        __syncthreads(); }
}
namespace att {
constexpr int DK = 192, DV = 128, NW = 8, QBLK = 32, KVBLK = 64;
constexpr float SCALE = 0.07216878364870322f;
constexpr float THR = 8.f;
#ifndef ATT_SDEPTH
#define ATT_SDEPTH 2
#endif
constexpr int SDEPTH = ATT_SDEPTH;
constexpr int LDQ = 2304, LDK = 2304, LDV = 3072, LDO = 4096;
constexpr int SHM_V = KVBLK * DV * 2, SHM_K = KVBLK * DK * 2, SHM_ATTN = 2 * SHM_V + 2 * SHM_K + NW * 64 * 4;
using bf16x8 = __attribute__((ext_vector_type(8))) short;
using s16x4  = __attribute__((ext_vector_type(4))) short;
using f32x16 = __attribute__((ext_vector_type(16))) float;
using u32x4  = __attribute__((ext_vector_type(4))) unsigned;
#define KSWZ(row, colB) ((row) * 384 + ((colB) ^ (((row) & 7) << 4)))
#define SBAR() __builtin_amdgcn_sched_barrier(0)
__device__ __forceinline__ int crow(int r, int hi) { return (r & 3) + 8 * (r >> 2) + 4 * hi; }
__device__ __forceinline__ unsigned cvtpk(float lo, float hi) { unsigned r; asm volatile("v_cvt_pk_bf16_f32 %0, %1, %2" : "=v"(r) : "v"(lo), "v"(hi)); return r; }
__device__ __forceinline__ void partialSM(f32x16& p0, f32x16& p1, float& m_reg, float& mn, float& alpha) {
  constexpr float C = SCALE * 1.4426950408889634f;
  float pmax = p0[0]; for (int r = 1; r < 16; ++r) pmax = fmaxf(pmax, p0[r]); for (int r = 0; r < 16; ++r) pmax = fmaxf(pmax, p1[r]);
  { auto rr = __builtin_amdgcn_permlane32_swap(__float_as_uint(pmax), __float_as_uint(pmax), false, false);
    pmax = fmaxf(__uint_as_float(rr[0]), __uint_as_float(rr[1])); }
  if (__builtin_expect(__all(pmax - m_reg <= THR / SCALE), 1)) { mn = m_reg; alpha = 1.f; }
  else { mn = fmaxf(m_reg, pmax); alpha = __builtin_amdgcn_exp2f((m_reg - mn) * C); m_reg = mn; }
  float mnC = -mn * C;
  for (int r = 0; r < 16; ++r) p0[r] = fmaf(p0[r], C, mnC); for (int r = 0; r < 16; ++r) p1[r] = fmaf(p1[r], C, mnC);
  for (int r = 0; r < 16; ++r) p0[r] = __builtin_amdgcn_exp2f(p0[r]);
}
__device__ __forceinline__ void finishSM(f32x16& p0, f32x16& p1, float alpha, float& l_reg, bf16x8& pa0, bf16x8& pa1, bf16x8& pa2, bf16x8& pa3) {
  for (int r = 0; r < 16; ++r) p1[r] = __builtin_amdgcn_exp2f(p1[r]);
  float ps = 0; for (int r = 0; r < 16; ++r) ps += p0[r]; for (int r = 0; r < 16; ++r) ps += p1[r];
  { auto rr = __builtin_amdgcn_permlane32_swap(__float_as_uint(ps), __float_as_uint(ps), false, false);
    ps = __uint_as_float(rr[0]) + __uint_as_float(rr[1]); }
  l_reg = l_reg * alpha + ps;
#define PK4(P, BASE, OUT) do { unsigned a0 = cvtpk(P[BASE + 0], P[BASE + 1]), a1 = cvtpk(P[BASE + 2], P[BASE + 3]);   \
    unsigned b0 = cvtpk(P[BASE + 4], P[BASE + 5]), b1 = cvtpk(P[BASE + 6], P[BASE + 7]);                              \
    auto r0 = __builtin_amdgcn_permlane32_swap(a0, b0, false, false); auto r1 = __builtin_amdgcn_permlane32_swap(a1, b1, false, false); \
    u32x4 w = {r0[0], r1[0], r0[1], r1[1]}; OUT = *reinterpret_cast<bf16x8*>(&w); } while (0)
  PK4(p0, 0, pa0); PK4(p0, 8, pa1); PK4(p1, 0, pa2); PK4(p1, 8, pa3);
#undef PK4
}
__device__ __forceinline__ void qkt(f32x16& p0, f32x16& p1, const char* Ks, const bf16x8* qr, int r32, int hi) {
  p0 = f32x16{}; p1 = f32x16{};
#pragma unroll
  for (int d0 = 0; d0 < 12; ++d0) { int cb = (d0 * 16 + hi * 8) * 2;
    bf16x8 b0 = *reinterpret_cast<const bf16x8*>(Ks + KSWZ(r32, cb));
    bf16x8 b1 = *reinterpret_cast<const bf16x8*>(Ks + KSWZ(32 + r32, cb));
    p0 = __builtin_amdgcn_mfma_f32_32x32x16_bf16(b0, qr[d0], p0, 0, 0, 0);
    p1 = __builtin_amdgcn_mfma_f32_32x32x16_bf16(b1, qr[d0], p1, 0, 0, 0); }
}
__device__ __forceinline__ int v_st(int k, int c) { const int kk = (k & ~0xC) | ((k & 4) << 1) | ((k & 8) >> 1); return ((kk >> 3) * 4 + (c >> 5)) * 512 + ((kk & 7) * 32 + (c & 31)) * 2; }
__device__ __forceinline__ int v_rd_base(int lane) { return ((lane & 3) << 3) | (((lane >> 2) & 3) << 6) | (((lane >> 4) & 1) << 5) | (((lane >> 5) & 1) << 8); }
constexpr int v_rd_off(int d0, int ks, int half) { return d0 * 512 + ks * 4096 + half * 2048; }
template <int OFF> __device__ __forceinline__ s16x4 tr_read(int vb) {
  s16x4 r; asm volatile("ds_read_b64_tr_b16 %0, %1 offset:%2" : "=&v"(r) : "v"(vb), "i"(OFF) : "memory"); return r;
}
template <int D0> __device__ __forceinline__ void pv_one(f32x16& od, int vb, bf16x8 pa0, bf16x8 pa1, bf16x8 pa2, bf16x8 pa3) {
  const s16x4 l0 = tr_read<v_rd_off(D0, 0, 0)>(vb), h0 = tr_read<v_rd_off(D0, 0, 1)>(vb), l1 = tr_read<v_rd_off(D0, 1, 0)>(vb), h1 = tr_read<v_rd_off(D0, 1, 1)>(vb);
  const s16x4 l2 = tr_read<v_rd_off(D0, 2, 0)>(vb), h2 = tr_read<v_rd_off(D0, 2, 1)>(vb), l3 = tr_read<v_rd_off(D0, 3, 0)>(vb), h3 = tr_read<v_rd_off(D0, 3, 1)>(vb);
  asm volatile("s_waitcnt lgkmcnt(0)" ::: "memory"); SBAR();
#define PK(L, H) (bf16x8){L[0], L[1], L[2], L[3], H[0], H[1], H[2], H[3]}
  od = __builtin_amdgcn_mfma_f32_32x32x16_bf16(pa0, PK(l0, h0), od, 0, 0, 0);
  od = __builtin_amdgcn_mfma_f32_32x32x16_bf16(pa1, PK(l1, h1), od, 0, 0, 0);
  od = __builtin_amdgcn_mfma_f32_32x32x16_bf16(pa2, PK(l2, h2), od, 0, 0, 0);
  od = __builtin_amdgcn_mfma_f32_32x32x16_bf16(pa3, PK(l3, h3), od, 0, 0, 0);
#undef PK
}
__device__ __forceinline__ void pv_d0(f32x16* o, int vb, bf16x8 pa0, bf16x8 pa1, bf16x8 pa2, bf16x8 pa3) {
  pv_one<0>(o[0], vb, pa0, pa1, pa2, pa3); pv_one<1>(o[1], vb, pa0, pa1, pa2, pa3); pv_one<2>(o[2], vb, pa0, pa1, pa2, pa3); pv_one<3>(o[3], vb, pa0, pa1, pa2, pa3);
}
__device__ __forceinline__ void attn_body(const bf16_t* __restrict__ Qb, const bf16_t* __restrict__ Kh, const bf16_t* __restrict__ Vh, bf16_t* __restrict__ Ob, int seq, char* lds) {
  int tid_ = threadIdx.x; asm volatile("" : "+v"(tid_));
  const int tid = tid_, wid = tid >> 6, lane = tid & 63, r32 = lane & 31, hi = lane >> 5;
  char* V_lds = lds; char* K_lds = lds + 2 * SHM_V;
  float* ws = (float*)(lds + 2 * SHM_V + 2 * SHM_K) + wid * 64; float* li_l = ws; float* al_l = ws + 32;
  float m_reg = -1e30f, l_reg = 0; f32x16 o[4] = {}; bf16x8 qr[12];
  const bf16_t* Qw = Qb + (long)(wid * QBLK + r32) * LDQ + hi * 8;
#pragma unroll
  for (int d0 = 0; d0 < 12; ++d0) qr[d0] = *reinterpret_cast<const bf16x8*>(Qw + d0 * 16);
  unsigned kgo[3], vgo[2];
#pragma unroll
  for (int i = 0; i < 3; ++i) { const int p = (i * 8 + wid) * 64 + lane, row = p / 24, slot = p % 24, ch = slot ^ (row & 7); kgo[i] = (unsigned)(row * LDK + ch * 8) * 2u; }
#pragma unroll
  for (int i = 0; i < 2; ++i) { const int p = (i * 8 + wid) * 64 + lane, sub = p >> 5, within = p & 31, kk = (sub >> 2) * 8 + (within >> 2), c = (sub & 3) * 32 + (within & 3) * 8;
    const int k = (kk & ~0xC) | ((kk & 4) << 1) | ((kk & 8) >> 1); vgo[i] = (unsigned)(k * LDV + c) * 2u; }
  const int vb0 = (int)(uintptr_t)V_lds + v_rd_base(lane);
  typedef __attribute__((address_space(3))) unsigned lds_u32;
#define DMA(b, k0) do { const char* kg = (const char*)Kh + (size_t)(k0) * (LDK * 2); const char* vg = (const char*)Vh + (size_t)(k0) * (LDV * 2); \
    _Pragma("unroll") for (int _i = 0; _i < 3; ++_i) __builtin_amdgcn_global_load_lds((const unsigned*)(kg + kgo[_i]), (lds_u32*)(K_lds + (b) * SHM_K + (_i * 8 + wid) * 1024), 16, 0, 0); \
    _Pragma("unroll") for (int _i = 0; _i < 2; ++_i) __builtin_amdgcn_global_load_lds((const unsigned*)(vg + vgo[_i]), (lds_u32*)(V_lds + (b) * SHM_V + (_i * 8 + wid) * 1024), 16, 0, 0); } while (0)
#define RESC(a) do { if (__any((a) < 1.f)) { if (hi == 0) al_l[r32] = (a); asm volatile("s_waitcnt lgkmcnt(0)" ::: "memory"); \
    for (int d = 0; d < 4; ++d) for (int r = 0; r < 16; ++r) o[d][r] *= al_l[crow(r, hi)]; } } while (0)
  f32x16 p0, p1; float mn, al; bf16x8 pa0, pa1, pa2, pa3; const int NT = seq / KVBLK;
  DMA(0, 0); asm volatile("s_waitcnt vmcnt(0)" ::: "memory"); __syncthreads();
#define TILE(b) do { SBAR(); qkt(p0, p1, K_lds + (b) * SHM_K, qr, r32, hi); partialSM(p0, p1, m_reg, mn, al); RESC(al); \
    finishSM(p0, p1, al, l_reg, pa0, pa1, pa2, pa3); SBAR(); pv_d0(o, vb0 + (b) * (int)SHM_V, pa0, pa1, pa2, pa3); } while (0)
  for (int j = 0; j < NT; j += 2) {
    DMA(1, (j + 1) * KVBLK);
    TILE(0); asm volatile("s_waitcnt vmcnt(0)" ::: "memory"); __syncthreads();
    if (j + 2 < NT) DMA(0, (j + 2) * KVBLK);
    TILE(1); asm volatile("s_waitcnt vmcnt(0)" ::: "memory"); __syncthreads();
  }
#undef TILE
#undef DMA
  if (hi == 0) li_l[r32] = l_reg; asm volatile("s_waitcnt lgkmcnt(0)" ::: "memory");
  float rli[16];
#pragma unroll
  for (int r = 0; r < 16; ++r) rli[r] = __builtin_amdgcn_rcpf(li_l[crow(r, hi)]);
  bf16_t* Ow = Ob + (long)(wid * QBLK) * LDO;
#pragma unroll
  for (int r = 0; r < 16; ++r) { int orow = crow(r, hi);
#pragma unroll
    for (int d0 = 0; d0 < 4; ++d0) { const float val = o[d0][r] * rli[r]; Ow[(long)orow * LDO + d0 * 32 + r32] = (bf16_t)(cvtpk(val, val) & 0xffff); } }
  __syncthreads();
#undef RESC
}
}
__device__ __forceinline__ f32x2 cmul(f32x2 a, f32x2 b) { return (f32x2){a.x * b.x - a.y * b.y, a.x * b.y + a.y * b.x}; }
__device__ __forceinline__ int rev4_14(int k) { const unsigned r = __brev((unsigned)k) >> 18; return (int)(((r & 0x1555u) << 1) | ((r >> 1) & 0x1555u)); }
#define ZI(i) ((i) + ((i) >> 5))
__device__ __forceinline__ void fft16k_dif(LAS f32x2* Z, int tid) {
#pragma unroll 1
    for (int s = 0; s < 7; ++s) { int lq = 12 - 2 * s; asm volatile("" : "+s"(lq)); const int q = 1 << lq;
#pragma unroll 2
        for (int i = 0; i < 8; ++i) { const int b = tid + 512 * i, j = b & (q - 1), base = ((b >> lq) << (lq + 2)) + j;
            const int i0 = ZI(base), i1 = ZI(base + q), i2 = ZI(base + 2 * q), i3 = ZI(base + 3 * q);
            const f32x2 a0 = Z[i0], a1 = Z[i1], a2 = Z[i2], a3 = Z[i3];
            const f32x2 t0 = a0 + a2, t1 = a0 - a2, t2 = a1 + a3, t3 = a1 - a3;
            float sn, cs; sincospif((float)j / (float)(2 * q), &sn, &cs);
            const f32x2 w1 = (f32x2){cs, -sn}, w2 = cmul(w1, w1), w3 = cmul(w2, w1);
            Z[i0] = t0 + t2; Z[i1] = cmul((f32x2){t1.x + t3.y, t1.y - t3.x}, w1); Z[i2] = cmul(t0 - t2, w2); Z[i3] = cmul((f32x2){t1.x - t3.y, t1.y + t3.x}, w3); }
        __syncthreads(); }
}
__device__ __forceinline__ void fft16k_dit_inv(LAS f32x2* Z, int tid) {
#pragma unroll 1
    for (int s = 0; s < 7; ++s) { int lq = 2 * s; asm volatile("" : "+s"(lq)); const int q = 1 << lq;
#pragma unroll 2
        for (int i = 0; i < 8; ++i) { const int b = tid + 512 * i, j = b & (q - 1), base = ((b >> lq) << (lq + 2)) + j;
            float sn, cs; sincospif((float)j / (float)(2 * q), &sn, &cs);
            const f32x2 w1 = (f32x2){cs, sn}, w2 = cmul(w1, w1), w3 = cmul(w2, w1);
            const int i0 = ZI(base), i1 = ZI(base + q), i2 = ZI(base + 2 * q), i3 = ZI(base + 3 * q);
            const f32x2 b0 = Z[i0], b1 = cmul(Z[i1], w1), b2 = cmul(Z[i2], w2), b3 = cmul(Z[i3], w3);
            const f32x2 t0 = b0 + b2, t1 = b0 - b2, t2 = b1 + b3, t3 = b1 - b3;
            Z[i0] = t0 + t2; Z[i1] = (f32x2){t1.x - t3.y, t1.y + t3.x}; Z[i2] = t0 - t2; Z[i3] = (f32x2){t1.x + t3.y, t1.y - t3.x}; }
        __syncthreads(); }
}
constexpr float HY_MIN_DECAY = -3.0701134573253945f, HY_MAX_DECAY = -15.350567286626973f;
__device__ __forceinline__ float hy_delta(int c) { return fabsf(HY_MIN_DECAY + (HY_MAX_DECAY - HY_MIN_DECAY) * ((float)c / 1279.0f)); }
__device__ __forceinline__ float conv3b_at(const float* PX, int tau, int col, const float* cw, int l, int c) {
    const float* w = cw + (size_t)l * 3 * B_IN;
    return conv3_at(PX, tau, col, w[c], w[B_IN + c], w[2 * B_IN + c]);
}
__device__ __forceinline__ void hyena_unit(const Frame& F, unsigned char* ws, int l, int pair) {
    LAS f32x2* Z = (LAS f32x2*)F.lds; LAS float* red = (LAS float*)(F.lds + LDS_MISC + 128);
    const int tid = F.tid, c0 = 2 * pair;
    const float* H3x = (const float*)(ws + WS_H3) + (size_t)l * 64 * T + NCTX;
    float* GT = (float*)(ws + WS_GT); const float* X0T = (const float*)(ws + WS_X0T);
    f32x2* scr = (f32x2*)(ws + WS_HSCR) + (size_t)F.bid * 16384;
    LAS f32x4* FW = (LAS f32x4*)(F.lds + LDS_MISC + 256);
    if (tid < 256) { const int j = tid >> 2, q = tid & 3; ((LAS float*)FW)[tid] = IN_(35)[(size_t)l * 64 * 2560 + (size_t)j * 2560 + (q >> 1) * 1280 + c0 + (q & 1)]; }
    __syncthreads();
    const float d0 = hy_delta(c0), d1 = hy_delta(c0 + 1);
#ifndef HYS
#define HYS 31
#endif
    float s0, s1, sc0 = 0.f, sc1 = 0.f;
    for (int rp14 = 0; rp14 < REP(14); ++rp14) {
    s0 = 0.f; s1 = 0.f;
    if (HYS & 1)
#pragma unroll 1
    for (int i = 0; i < 4; ++i) { const int tb = 2048 * i + 4 * tid; const float* hc = H3x + tb;
        asm volatile("" ::: "memory");
        f32x4 acc[4];
#pragma unroll
        for (int p = 0; p < 4; ++p) acc[p] = (f32x4){0.f, 0.f, 0.f, 0.f};
#pragma unroll 8
        for (int j = 0; j < 64; ++j) { const f32x4 w = FW[j]; const f32x4 hv = *(const f32x4*)(hc + (size_t)j * T);
#pragma unroll
            for (int p = 0; p < 4; ++p) acc[p] += w * hv[p]; }
#pragma unroll
        for (int p = 0; p < 4; ++p) { const int t = tb + p;
            const float tl = (float)t * (1.0f / 8191.0f), e0 = __expf(-tl * d0), e1 = __expf(-tl * d1);
            const float f0 = acc[p].x * e0, f1 = acc[p].y * e1, b0 = acc[p].z * e0, b1 = acc[p].w * e1;
            Z[ZI(t)] = (f32x2){f0, f1}; s0 += fabsf(f0); s1 += fabsf(f1);
            if (t < 8191) { Z[ZI(16383 - t)] = (f32x2){b0, b1}; s0 += fabsf(b0); s1 += fabsf(b1); } } }
    if (tid == 0) { float zz = 0.f; asm volatile("" : "+v"(zz)); Z[ZI(8192)] = (f32x2){zz, zz}; }
    s0 = wave_sum(s0); s1 = wave_sum(s1);
    if (F.lane == 0) { red[F.wave * 2] = s0; red[F.wave * 2 + 1] = s1; }
    __syncthreads();
    float n0 = 0.f, n1 = 0.f;
#pragma unroll
    for (int w = 0; w < 8; ++w) { n0 += red[2 * w]; n1 += red[2 * w + 1]; }
    sc0 = 1.0f / (16384.0f * n0); sc1 = 1.0f / (16384.0f * n1);
    if (HYS & 2) fft16k_dif(Z, tid);
#pragma unroll 4
    for (int i = 0; i < 32; ++i) scr[tid + 512 * i] = Z[ZI(tid + 512 * i)];
    __syncthreads();
    }
    for (int rp15 = 0; rp15 < REP(15); ++rp15) {
    const float* g0p = GT + (size_t)c0 * T + NCTX; const float* g1p = g0p + T;
    { float zz = 0.f; asm volatile("" : "+v"(zz));
#pragma unroll 4
      for (int i = 0; i < 16; ++i) { const int t = tid + 512 * i; Z[ZI(t)] = (f32x2){g0p[t], g1p[t]}; Z[ZI(8192 + t)] = (f32x2){zz, zz}; } }
    __syncthreads();
    if (HYS & 2) fft16k_dif(Z, tid);
    if (HYS & 8)
#pragma unroll 2
    for (int i = 0; i < 17; ++i) { const int k = tid + 512 * i; if (i == 16 && tid != 0) break;
        const int pk = rev4_14(k & 16383), pn = rev4_14((16384 - k) & 16383);
        const f32x2 A = Z[ZI(pk)], B = Z[ZI(pn)], At = scr[pk], Bt = scr[pn];
        const f32x2 G0 = (f32x2){0.5f * (A.x + B.x), 0.5f * (A.y - B.y)}, G1 = (f32x2){0.5f * (A.y + B.y), -0.5f * (A.x - B.x)};
        const f32x2 H0 = (f32x2){0.5f * (At.x + Bt.x), 0.5f * (At.y - Bt.y)}, H1 = (f32x2){0.5f * (At.y + Bt.y), -0.5f * (At.x - Bt.x)};
        const f32x2 P0 = cmul(G0, H0), P1 = cmul(G1, H1);
        Z[ZI(pk)] = (f32x2){P0.x - P1.y, P0.y + P1.x};
        if (pn != pk) Z[ZI(pn)] = (f32x2){P0.x + P1.y, P1.x - P0.y}; }
    __syncthreads();
    if (HYS & 2) fft16k_dit_inv(Z, tid);
    }
    const float bb0 = IN_(37)[l * 1280 + c0], bb1 = IN_(37)[l * 1280 + c0 + 1];
    { float* y0p = GT + (size_t)c0 * T + NCTX; float* y1p = y0p + T; const float* x0p = X0T + (size_t)c0 * T + NCTX; const float* x1p = x0p + T;
#pragma unroll 4
      for (int i = 0; i < 16; ++i) { const int t = tid + 512 * i; const f32x2 z = Z[ZI(t)]; const float ga = y0p[t], gb = y1p[t];
          y0p[t] = x0p[t] * (z.x * sc0 + ga * bb0); y1p[t] = x1p[t] * (z.y * sc1 + gb * bb1); } }
    __syncthreads();
}
__device__ __forceinline__ void hyena_ctx_unit(const Frame& F, unsigned char* ws, int l, int unit) {
    LAS float* TF = (LAS float*)F.lds; LAS float* TB = TF + 2048; LAS float* GG = TB + 2048;
    const int tid = F.tid, t = tid >> 1, cc = (tid & 1) * 4, cbase = unit * 8 + cc;
    const float* H3c = (const float*)(ws + WS_H3) + (size_t)l * 64 * T; float* GT = (float*)(ws + WS_GT); const float* X0T = (const float*)(ws + WS_X0T);
    { float f[4] = {0.f, 0.f, 0.f, 0.f}, b[4] = {0.f, 0.f, 0.f, 0.f};
      const float* wbase = IN_(35) + (size_t)l * 64 * 2560 + cbase;
      for (int j = 0; j < 64; ++j) { const float hv = H3c[(size_t)j * T + t]; const float* wrow = wbase + (size_t)j * 2560;
#pragma unroll
          for (int q = 0; q < 4; ++q) { f[q] += hv * wrow[q]; b[q] += hv * wrow[1280 + q]; } }
      const float tl = (float)t * (1.0f / 255.0f);
#pragma unroll
      for (int q = 0; q < 4; ++q) { const float e = __expf(-tl * hy_delta(cbase + q)); TF[t * 8 + cc + q] = f[q] * e; TB[t * 8 + cc + q] = b[q] * e; GG[t * 8 + cc + q] = GT[(size_t)(cbase + q) * T + t]; } }
    __syncthreads();
    float nrm[4] = {0.f, 0.f, 0.f, 0.f}, y[4] = {0.f, 0.f, 0.f, 0.f};
    for (int s = 0; s < 256; ++s) {
#pragma unroll
        for (int q = 0; q < 4; ++q) { nrm[q] += fabsf(TF[s * 8 + cc + q]) + (s < 255 ? fabsf(TB[s * 8 + cc + q]) : 0.f);
            const int o = t - s; const float tap = o >= 0 ? TF[o * 8 + cc + q] : TB[(-o - 1) * 8 + cc + q];
            y[q] += tap * GG[s * 8 + cc + q]; } }
    __syncthreads();
#pragma unroll
    for (int q = 0; q < 4; ++q) GT[(size_t)(cbase + q) * T + t] = X0T[(size_t)(cbase + q) * T + t] * (y[q] / nrm[q] + GG[t * 8 + cc + q] * IN_(37)[l * 1280 + cbase + q]);
    __syncthreads();
}
constexpr int SC_C = 16, SC_NCHUNK = T / SC_C, SC_CHUNK_BYTES = 13 * 1024 + 256, SC_GRP = 4, SC_NGRP = SC_NCHUNK / SC_GRP;
__device__ __forceinline__ int sc_tau(int d, int c, int t) { return d == 0 ? SC_C * c + t : (c < NCTX / SC_C ? NCTX - 1 - SC_C * c - t : T - 1 - SC_C * (c - NCTX / SC_C) - t); }
__device__ __forceinline__ int sc_perm(int e, int hi) { return (e & 3) + 8 * (e >> 2) + 4 * hi; }
constexpr size_t WS_FR_BYTES = (size_t)2 * NHA * SC_NCHUNK * SC_CHUNK_BYTES;

typedef short sc_bf16x8 __attribute__((ext_vector_type(8)));
typedef float sc_f32x16 __attribute__((ext_vector_type(16)));
__device__ __forceinline__ sc_bf16x8 sc_pack8(const sc_f32x16& a, int base) {
    u32x4 w; w.x = cvt_pk_bf16(a[base + 0], a[base + 1]); w.y = cvt_pk_bf16(a[base + 2], a[base + 3]); w.z = cvt_pk_bf16(a[base + 4], a[base + 5]); w.w = cvt_pk_bf16(a[base + 6], a[base + 7]);
    return *reinterpret_cast<sc_bf16x8*>(&w);
}
__device__ __forceinline__ void scan_chain_mfma(const Frame& F, unsigned char* ws, int chain) {
    const int h = chain >> 1, d = chain & 1, tid = F.tid, lane = F.lane, n = lane & 31, hi = lane >> 5, ib = F.wave;
    const unsigned char* FRc = ws + WS_FR + (size_t)chain * SC_NCHUNK * SC_CHUNK_BYTES;
    float* Yd = (float*)(ws + WS_Y) + (size_t)d * T * A_W + h * 64;
    LAS unsigned char* buf = F.lds;
    constexpr int GRP_BYTES = SC_GRP * SC_CHUNK_BYTES, GRP_V4 = GRP_BYTES / 16;
    f32x4 st[7];
#define SCM_LOAD(g) do { const f32x4* src_ = (const f32x4*)(FRc + (size_t)(g) * GRP_BYTES); _Pragma("unroll") for (int i_ = 0; i_ < 7; ++i_) { const int idx = tid + 512 * i_; if (idx < GRP_V4) st[i_] = src_[idx]; } } while (0)
#define SCM_WRITE(b) do { _Pragma("unroll") for (int i_ = 0; i_ < 7; ++i_) { const int idx = tid + 512 * i_; if (idx < GRP_V4) *(LAS f32x4*)(buf + (b) * GRP_BYTES + idx * 16) = st[i_]; } } while (0)
    sc_f32x16 S0 = {}, S1 = {};
    SCM_LOAD(0); SCM_WRITE(0); __syncthreads();
    for (int g = 0; g < SC_NGRP; ++g) {
        if (g + 1 < SC_NGRP) SCM_LOAD(g + 1);
        if (ib < 2) {
#pragma unroll 1
            for (int cc = 0; cc < SC_GRP; ++cc) {
                const LAS unsigned char* fb = buf + (g & 1) * GRP_BYTES + cc * SC_CHUNK_BYTES;
#define SCM_FRAG(f) (*(const LAS sc_bf16x8*)(fb + (f) * 1024 + lane * 16))
                const sc_bf16x8 vf = SCM_FRAG(11 + ib);
                sc_f32x16 P = {};
                const sc_bf16x8 sb00 = sc_pack8(S0, 0), sb01 = sc_pack8(S0, 8), sb10 = sc_pack8(S1, 0), sb11 = sc_pack8(S1, 8);
                P = __builtin_amdgcn_mfma_f32_32x32x16_bf16(SCM_FRAG(0), sb00, P, 0, 0, 0);
                P = __builtin_amdgcn_mfma_f32_32x32x16_bf16(SCM_FRAG(1), sb01, P, 0, 0, 0);
                P = __builtin_amdgcn_mfma_f32_32x32x16_bf16(SCM_FRAG(2), sb10, P, 0, 0, 0);
                P = __builtin_amdgcn_mfma_f32_32x32x16_bf16(SCM_FRAG(3), sb11, P, 0, 0, 0);
                P = __builtin_amdgcn_mfma_f32_32x32x16_bf16(SCM_FRAG(4), vf, P, 0, 0, 0);
                const sc_bf16x8 xb = sc_pack8(P, 0);
                sc_f32x16 U = {};
                U = __builtin_amdgcn_mfma_f32_32x32x16_bf16(SCM_FRAG(5), xb, U, 0, 0, 0);
                const sc_bf16x8 ub = sc_pack8(U, 0);
                P = __builtin_amdgcn_mfma_f32_32x32x16_bf16(SCM_FRAG(6), ub, P, 0, 0, 0);
                const int c = g * SC_GRP + cc;
#pragma unroll
                for (int r = 8; r < 16; ++r) { const int t = (r & 3) + 8 * ((r >> 2) - 2) + 4 * hi; Yd[(size_t)sc_tau(d, c, t) * A_W + 32 * ib + n] = P[r]; }
                const LAS f32x4* gt = (const LAS f32x4*)(fb + 13 * 1024 + hi * 128);
#pragma unroll
                for (int q = 0; q < 4; ++q) { const f32x4 g0 = gt[q], g1 = gt[4 + q];
#pragma unroll
                    for (int e = 0; e < 4; ++e) { S0[4 * q + e] *= g0[e]; S1[4 * q + e] *= g1[e]; } }
                S0 = __builtin_amdgcn_mfma_f32_32x32x16_bf16(SCM_FRAG(7), ub, S0, 0, 0, 0);
                S0 = __builtin_amdgcn_mfma_f32_32x32x16_bf16(SCM_FRAG(8), vf, S0, 0, 0, 0);
                S1 = __builtin_amdgcn_mfma_f32_32x32x16_bf16(SCM_FRAG(9), ub, S1, 0, 0, 0);
                S1 = __builtin_amdgcn_mfma_f32_32x32x16_bf16(SCM_FRAG(10), vf, S1, 0, 0, 0);
#undef SCM_FRAG
            }
        }
        if (g + 1 < SC_NGRP) SCM_WRITE((g + 1) & 1);
        __syncthreads();
    }
#undef SCM_LOAD
#undef SCM_WRITE
}
__device__ __forceinline__ float conv3_u(const float* PX, int tau, unsigned ucol, float w0, float w1, float w2) {
    const float* p = PX + (size_t)tau * PXW;
    float y = p[ucol] * w1;
    if (has_left(tau)) y += (p - PXW)[ucol] * w0;
    if (has_right(tau)) y += (p + PXW)[ucol] * w2;
    return y;
}
constexpr int WLR_K = 448;
constexpr int RP_WAVE_LDS = 16896;
typedef short rp_bf16x8 __attribute__((ext_vector_type(8)));
typedef float rp_f32x16 __attribute__((ext_vector_type(16)));
__device__ __forceinline__ unsigned short f2bf16(float x) { return (unsigned short)(cvt_pk_bf16(x, x) & 0xffffu); }
template <int NKB, class AF>
__device__ __forceinline__ void rp_lowrank(float (&dst)[16], const AF& afrag, const bf16_t* WLRh, int kw0, int n, int hi) {
    rp_f32x16 c0 = {}, c1 = {}; const bf16_t* wb0 = WLRh + (size_t)n * WLR_K + kw0 + 8 * hi; const bf16_t* wb1 = wb0 + (size_t)32 * WLR_K;
#pragma unroll
    for (int kb = 0; kb < NKB; ++kb) { const rp_bf16x8 b0 = *(const rp_bf16x8*)(wb0 + 16 * kb), b1 = *(const rp_bf16x8*)(wb1 + 16 * kb); const rp_bf16x8 a_ = afrag(kb);
        c0 = __builtin_amdgcn_mfma_f32_32x32x16_bf16(a_, b0, c0, 0, 0, 0); c1 = __builtin_amdgcn_mfma_f32_32x32x16_bf16(a_, b1, c1, 0, 0, 0); }
#pragma unroll
    for (int r = 0; r < 8; ++r) { auto sw = __builtin_amdgcn_permlane32_swap(__float_as_uint(c0[r]), __float_as_uint(c1[r]), false, false);
        dst[(r & 3) + 8 * (r >> 2)] = __uint_as_float(sw[0]); dst[(r & 3) + 8 * (r >> 2) + 4] = __uint_as_float(sw[1]); }
}
struct RpAfLds { const LAS bf16_t* base; __device__ __forceinline__ rp_bf16x8 operator()(int kb) const { return *(const LAS rp_bf16x8*)(base + 16 * kb); } };
__device__ __forceinline__ void rwkv_elem_phase(const Frame& F, unsigned char* ws, int l) {
    const float* PX = (const float*)(ws + WS_PX); float* SS = (float*)(ws + WS_SS); float* SD = (float*)(ws + WS_SD); float* GB = (float*)(ws + WS_G);
    const bf16_t* WLR = (const bf16_t*)(ws + WS_WLR) + (size_t)l * A_W * WLR_K;
    const float* cw = IN_(16) + (size_t)l * 3 * A_IN;
    LAS bf16_t* ACT = (LAS bf16_t*)(F.lds + F.wave * 10752);
    const int lane = F.lane, n = lane & 31, hi = lane >> 5;
    const int gw = F.bid * 8 + F.wave, NGW = F.G * 8;
    for (int it = gw; it < (T / 16) * 4; it += NGW) {
        const int tg = it >> 2, hq = it & 3, tau0 = tg * 16;
        asm volatile("s_waitcnt lgkmcnt(0)" ::: "memory");
        const float* prow0 = PX + (size_t)(tau0 > 0 ? tau0 - 1 : 0) * PXW; const int roff = tau0 > 0 ? 0 : -1;
#define RP_WIN(x, ucol_) do { _Pragma("unroll") for (int i_ = 0; i_ < 18; ++i_) { int ri_ = i_ + roff; ri_ = ri_ < 0 ? 0 : ri_; ri_ = (tau0 - 1 + i_ > T - 1) ? (T - 1 - (tau0 > 0 ? tau0 - 1 : 0)) : ri_; x[i_] = (prow0 + (size_t)ri_ * PXW)[ucol_]; } } while (0)
#define RP_CONV(x, t_, w0_, w1_, w2_) (x[(t_)] * (has_left(tau0 + (t_)) ? (w0_) : 0.f) + x[(t_) + 1] * (w1_) + x[(t_) + 2] * (has_right(tau0 + (t_)) ? (w2_) : 0.f))
#pragma unroll
        for (int i = 0; i < 5; ++i) { const int c = lane + 64 * i, col = 3840 + c; const float c0 = cw[col], c1 = cw[A_IN + col], c2 = cw[2 * A_IN + col];
            float x[18]; RP_WIN(x, (unsigned)(PXA + col));
#pragma unroll
            for (int t = 0; t < 16; ++t) { const float val = RP_CONV(x, t, c0, c1, c2);
                const float act = i == 0 ? 1.0f - 2.0f / (1.0f + __expf(2.0f * val)) : (i == 1 ? val : sigmoidf_(val));
                ACT[t * 328 + c] = f2bf16(act); } }
        asm volatile("s_waitcnt lgkmcnt(0)" ::: "memory");
        const RpAfLds afw{ACT + (n & 15) * 328 + 8 * hi}, afa{ACT + (n & 15) * 328 + 64 + 8 * hi}, afg{ACT + (n & 15) * 328 + 128 + 8 * hi};
#pragma unroll 1
        for (int hh = 0; hh < 5; ++hh) {
            const int h = hq * 5 + hh, col = h * 64 + lane; const bf16_t* WLRh = WLR + (size_t)h * 64 * WLR_K;
            { float lg[16]; rp_lowrank<12>(lg, afg, WLRh, 256, n, hi);
#pragma unroll
              for (int t = 0; t < 16; ++t) GB[(size_t)(tau0 + t) * A_W + col] = lg[t]; }
            const float cr0 = cw[col], cr1 = cw[A_IN + col], cr2 = cw[2 * A_IN + col];
            const float ck0 = cw[A_W + col], ck1 = cw[A_IN + A_W + col], ck2 = cw[2 * A_IN + A_W + col];
            const float cv0 = cw[2 * A_W + col], cv1 = cw[A_IN + 2 * A_W + col], cv2 = cw[2 * A_IN + 2 * A_W + col];
            const float kk_w = IN_(22)[l * A_W + col], ka_w = IN_(23)[l * A_W + col];
            float kkv[16], kv[16];
            { float xr[18], xk[18], xv[18]; const unsigned uc = (unsigned)(PXA + col); RP_WIN(xr, uc); RP_WIN(xk, uc + A_W); RP_WIN(xv, uc + 2 * A_W);
#pragma unroll
              for (int t = 0; t < 16; ++t) { const int tau = tau0 + t;
                  const float r = RP_CONV(xr, t, cr0, cr1, cr2), v = RP_CONV(xv, t, cv0, cv1, cv2); kv[t] = RP_CONV(xk, t, ck0, ck1, ck2);
                  const float kr = kv[t] * kk_w; const float nrm = sqrtf(wave_sum(kr * kr)); kkv[t] = kr / fmaxf(nrm, 1e-12f);
                  float* ss = SS + ((size_t)h * T + tau) * 192 + lane; ss[0] = kkv[t]; ss[64] = r; ss[128] = v; } }
#pragma unroll 1
            for (int d = 0; d < 2; ++d) { const float w0b = IN_(17)[(l * 2 + d) * A_W + col], a0b = IN_(19)[(l * 2 + d) * A_W + col]; float lw[16], la[16];
                rp_lowrank<4>(lw, afw, WLRh, 64 * d, n, hi); rp_lowrank<4>(la, afa, WLRh, 128 + 64 * d, n, hi);
#pragma unroll
                for (int t = 0; t < 16; ++t) { const float z = w0b + lw[t]; const float decay = __expf(-__expf(-(fmaxf(-z, 0.f) + __logf(1.0f + __expf(-fabsf(z)))) - 0.5f)); const float av = sigmoidf_(a0b + la[t]);
                    float* sd = SD + (((size_t)h * 2 + d) * T + tau0 + t) * 192 + lane; sd[0] = decay; sd[64] = kkv[t] * av; sd[128] = kv[t] * (1.0f + (av - 1.0f) * ka_w); } }
        }
    }
}
#undef RP_WIN
#undef RP_CONV
constexpr int SP_WAVE_LDS = 16640;
__device__ __forceinline__ void scan_prep_phase(const Frame& F, unsigned char* ws) {
    const float* SS = (const float*)(ws + WS_SS); const float* SD = (const float*)(ws + WS_SD); unsigned char* FR = ws + WS_FR;
    LAS bf16_t* R1 = (LAS bf16_t*)(F.lds + F.wave * SP_WAVE_LDS); LAS bf16_t* R2 = R1 + 32 * 72; LAS bf16_t* BbT = R2 + 32 * 72; LAS bf16_t* KbT = BbT + 64 * 16; LAS bf16_t* VT = KbT + 64 * 16; LAS float* Lm = (LAS float*)(VT + 64 * 16);
    const int lane = F.lane, n = lane & 31, hi = lane >> 5;
    const int gw = F.bid * 8 + F.wave, NGW = F.G * 8;
    for (int it = gw; it < 2 * NHA * SC_NCHUNK; it += NGW) {
        const int chain = it / SC_NCHUNK, c = it % SC_NCHUNK, h = chain >> 1, d = chain & 1;
        const int tau_first = sc_tau(d, c, 0), dstep = d ? -1 : 1;
        const float* ssb = SS + (size_t)h * T * 192 + lane; const float* sdb = SD + ((size_t)h * 2 + d) * T * 192 + lane;
        float xw[16], xb[16], xk[16], xkk[16], xr[16], xv[16];
#pragma unroll
        for (int s = 0; s < 16; ++s) { const size_t o = (size_t)(tau_first + dstep * s) * 192; xw[s] = sdb[o]; xb[s] = sdb[o + 64]; xk[s] = sdb[o + 128]; xkk[s] = ssb[o]; xr[s] = ssb[o + 64]; xv[s] = ssb[o + 128]; }
        float gC = 1.f;
#pragma unroll
        for (int s = 0; s < 16; ++s) gC *= xw[s];
        float g = 1.f;
#pragma unroll
        for (int s = 0; s < 16; ++s) {
            const float gm1 = g; g *= xw[s]; const float ig = 1.0f / g; const float bh = xb[s] * ig, kh = xk[s] * ig;
            R1[s * 72 + lane] = f2bf16(-xkk[s] * gm1); R1[(16 + s) * 72 + lane] = f2bf16(xr[s] * g);
            R2[s * 72 + lane] = f2bf16(bh); R2[(16 + s) * 72 + lane] = f2bf16(kh);
            BbT[lane * 16 + s] = f2bf16(bh * gC); KbT[lane * 16 + s] = f2bf16(kh * gC); VT[lane * 16 + s] = f2bf16(xv[s]); }
        asm volatile("s_waitcnt lgkmcnt(0)" ::: "memory");
        unsigned char* dst = FR + ((size_t)chain * SC_NCHUNK + c) * SC_CHUNK_BYTES;
        rp_f32x16 C = {};
#pragma unroll
        for (int kb = 0; kb < 4; ++kb) { const rp_bf16x8 a_ = *(const LAS rp_bf16x8*)(R2 + n * 72 + 16 * kb + 8 * hi), b_ = *(const LAS rp_bf16x8*)(R1 + n * 72 + 16 * kb + 8 * hi);
            C = __builtin_amdgcn_mfma_f32_32x32x16_bf16(a_, b_, C, 0, 0, 0); }
        const int tt_ = n & 15; const bool incl = n >= 16;
#pragma unroll
        for (int r = 0; r < 16; ++r) { const int s = ((r & 7) & 3) + 8 * ((r & 7) >> 2) + 4 * hi; if (!(s < tt_ || (incl && s == tt_))) C[r] = 0.f; }
        if (n < 16) {
#pragma unroll
            for (int r = 0; r < 8; ++r) Lm[((r & 3) + 8 * (r >> 2) + 4 * hi) * 20 + n] = C[r]; }
        { u32x4 f4; f4.x = cvt_pk_bf16(C[8], C[9]); f4.y = cvt_pk_bf16(C[10], C[11]); f4.z = cvt_pk_bf16(C[12], C[13]); f4.w = cvt_pk_bf16(C[14], C[15]);
          u32x4 f6; f6.x = cvt_pk_bf16(C[0], C[1]); f6.y = cvt_pk_bf16(C[2], C[3]); f6.z = cvt_pk_bf16(C[4], C[5]); f6.w = cvt_pk_bf16(C[6], C[7]);
          if (n < 16) f6 = (u32x4){0u, 0u, 0u, 0u};
          *(u32x4*)(dst + 4 * 1024 + lane * 16) = f4; *(u32x4*)(dst + 6 * 1024 + lane * 16) = f6; }
        asm volatile("s_waitcnt lgkmcnt(0)" ::: "memory");
        { float Tc[16];
#pragma unroll
          for (int s = 15; s >= 0; --s) { float acc = (s == n) ? 1.f : 0.f;
#pragma unroll
              for (int u = s + 1; u < 16; ++u) acc += Lm[s * 20 + u] * Tc[u];
              Tc[s] = acc; }
          u32x4 f5; f5.x = cvt_pk_bf16(hi ? Tc[4] : Tc[0], hi ? Tc[5] : Tc[1]); f5.y = cvt_pk_bf16(hi ? Tc[6] : Tc[2], hi ? Tc[7] : Tc[3]);
          f5.z = cvt_pk_bf16(hi ? Tc[12] : Tc[8], hi ? Tc[13] : Tc[9]); f5.w = cvt_pk_bf16(hi ? Tc[14] : Tc[10], hi ? Tc[15] : Tc[11]);
          if (n >= 16) f5 = (u32x4){0u, 0u, 0u, 0u};
          *(u32x4*)(dst + 5 * 1024 + lane * 16) = f5; }
#pragma unroll
        for (int f = 0; f < 4; ++f) { const u32x2 p0 = *(const LAS u32x2*)(R1 + n * 72 + 16 * f + 4 * hi), p1 = *(const LAS u32x2*)(R1 + n * 72 + 16 * f + 8 + 4 * hi);
            *(u32x4*)(dst + f * 1024 + lane * 16) = (u32x4){p0.x, p0.y, p1.x, p1.y}; }
#pragma unroll
        for (int jb = 0; jb < 2; ++jb) { const int row = 32 * jb + n;
            const u32x2 b0 = *(const LAS u32x2*)(BbT + row * 16 + 4 * hi), b1 = *(const LAS u32x2*)(BbT + row * 16 + 8 + 4 * hi), k0 = *(const LAS u32x2*)(KbT + row * 16 + 4 * hi), k1 = *(const LAS u32x2*)(KbT + row * 16 + 8 + 4 * hi);
            const u32x2 v0 = *(const LAS u32x2*)(VT + row * 16 + 4 * hi), v1 = *(const LAS u32x2*)(VT + row * 16 + 8 + 4 * hi);
            *(u32x4*)(dst + (7 + 2 * jb) * 1024 + lane * 16) = (u32x4){b0.x, b0.y, b1.x, b1.y}; *(u32x4*)(dst + (8 + 2 * jb) * 1024 + lane * 16) = (u32x4){k0.x, k0.y, k1.x, k1.y};
            *(u32x4*)(dst + (11 + jb) * 1024 + lane * 16) = (u32x4){v0.x, v0.y, v1.x, v1.y}; }
        { const int jj = lane & 31; ((float*)(dst + 13 * 1024))[((jj >> 2) & 1) * 32 + (lane >> 5) * 16 + (jj & 3) + 4 * (jj >> 3)] = gC; }
        asm volatile("s_waitcnt lgkmcnt(0)" ::: "memory");
    }
}
__device__ __forceinline__ void mixer_phase(const Frame& F0, unsigned char* ws0, int lq, bool need_ctx, char* lds_g) {
    const int l = lq & 3;
#ifndef MK_MIX
#define MK_MIX 15
#endif
    { const Frame F = opq(F0); unsigned char* ws = opq_ptr(ws0);
      if (MK_MIX & 1) for (int chain = F.bid; chain < 2 * NHA; chain += F.G) scan_chain_mfma(F, ws, chain); }
    const Frame& F = F0;
    const int n_att = 32 * NHC, n_hy = 640, n_ca = need_ctx ? NHC : 0, n_ch = need_ctx ? 160 : 0, total = n_att + n_hy + n_ca + n_ch;
    unsigned* qhead = (unsigned*)(ws0 + WS_CTL) + CW_QUEUE + 64 * lq;
    for (;;) {
        if (F.tid == 0) F.MISC[16] = __hip_atomic_fetch_add(qhead, 1u, __ATOMIC_RELAXED, __HIP_MEMORY_SCOPE_AGENT);
        __syncthreads();
        const int item = (int)F.MISC[16];
        __syncthreads();
        if (item >= total) break;
        const Frame Fu = opq(F0); unsigned char* ws = opq_ptr(ws0);
        const bf16_t* QF = (const bf16_t*)(ws + WS_QF); const bf16_t* KF = (const bf16_t*)(ws + WS_KF); const bf16_t* KVRAW = (const bf16_t*)(ws + WS_KVRAW); bf16_t* OB = (bf16_t*)(ws + WS_OBUF);
        const bool is_xa = item < n_att, is_ca = item >= n_att + n_hy && item < n_att + n_hy + n_ca;
        if ((MK_MIX & 2) && (is_xa || is_ca)) { const int h = is_xa ? item % NHC : item - n_att - n_hy, row0 = is_xa ? NCTX + (item / NHC) * 256 : 0;
            for (int rp = 0; rp < REP(13); ++rp) att::attn_body(QF + (size_t)row0 * NQ + h * 192, KF + h * 192, KVRAW + h * 256 + 128, OB + (size_t)row0 * DM + 2560 + h * 128, is_xa ? T : NCTX, lds_g); }
        else if ((MK_MIX & 4) && item >= n_att && item < n_att + n_hy) { for (int rp = 0; rp < REP(12); ++rp) hyena_unit(Fu, ws, l, item - n_att); }
        else if ((MK_MIX & 8) && item >= n_att + n_hy + n_ca) hyena_ctx_unit(Fu, ws, l, item - n_att - n_hy - n_ca);
    }
}

constexpr int NPH = 2 + 14 * NL;
__global__ void __launch_bounds__(512, 2) mk_fwd(Args a) {
    extern __shared__ __attribute__((aligned(16))) unsigned char lds[];
    Frame F; F.lds = (LAS unsigned char*)lds; F.MISC = (volatile LAS unsigned*)(F.lds + LDS_MISC);
    F.tid = threadIdx.x; F.lane = F.tid & 63; F.wave = __builtin_amdgcn_readfirstlane(F.tid >> 6); F.bid = blockIdx.x; F.G = gridDim.x;
    if (F.tid < 64) F.MISC[F.tid] = 0u;
    if (F.tid < 46) *(LAS unsigned long long*)(F.lds + LDS_PTAB + 8 * F.tid) = (unsigned long long)(uintptr_t)a.in[F.tid];
    __syncthreads();
    unsigned char* ws = a.ws;
    XcdBarrier bar = xcd_barrier_post((unsigned*)(ws + WS_CTL) + CW_BAR, F.MISC + 8);
    const int lo = a.ph_lo, hi = a.ph_hi;
#ifndef MK_MASK
#define MK_MASK 0xffff
#endif
#define EN(x) (((MK_MASK) >> (x)) & 1)
#define IN(k) (lo <= (k) && (k) < hi)
#define SEAM(k) do { if (IN(k) && IN((k) + 1)) xcd_barrier(bar); } while (0)
#define WSP opq_ptr(ws)
#define P_XS(w) ((float*)((w) + WS_XS))
#define P_ABUF(w) ((bf16_t*)((w) + WS_ABUF))
#define P_HBUF(w) ((bf16_t*)((w) + WS_HBUF))
#define P_OBUF(w) ((bf16_t*)((w) + WS_OBUF))
#define P_MODX(w, l) ((const float*)((w) + WS_MOD) + ((size_t)(l) * 2 + 0) * NMOD)
#define P_MODC(w, l) ((const float*)((w) + WS_MOD) + ((size_t)(l) * 2 + 1) * NMOD)
#define P_WL(w, l) ((const bf16_t*)((w) + WS_WB) + (size_t)(l) * W_LAYER)
    if (EN(0) && IN(0)) for (int rp = 0; rp < REP(0); ++rp) phase0(opq(F), opq_ptr(ws));
    SEAM(0);
    if (EN(1) && IN(1)) phase_mod(opq(F), opq_ptr(ws));
    SEAM(1);
#pragma unroll 1
    for (int l = 0; l < NL; ++l) {
        const int pb = 2 + 14 * l; const bool need_ctx = l < NL - 1;
        if (EN(2) && IN(pb + 0)) for (int rp = 0; rp < REP(2); ++rp) { unsigned char* w = WSP; norm_phase(opq(F), P_XS(w), IN_(7) + l * DM, P_MODX(w, l), P_MODC(w, l), 0, 1, P_ABUF(w)); }
        SEAM(pb + 0);
        if (EN(3) && IN(pb + 1)) { unsigned char* w = WSP; pg8::Gemm g{P_ABUF(w), P_WL(w, l) + W_G1, T, 2 * FF, DM}; pg8::StaticOrder S; S.init(T, 2 * FF, F.G, F.bid); pg8::EpiSwiGLU E{P_HBUF(w), FF};
            pg8::gemm_phase<pg8::EpiSwiGLU, pg8::StaticOrder>(F.lds, g, S, E, nullptr); }
        SEAM(pb + 1);
        if (EN(4) && IN(pb + 2)) { unsigned char* w = WSP; pg8::Gemm g{P_HBUF(w), P_WL(w, l) + W_D1, T, DM, FF}; pg8::StaticOrder S; S.init(T, DM, F.G, F.bid); pg8::EpiResid E{P_XS(w), P_MODX(w, l) + 2 * DM, P_MODC(w, l) + 2 * DM, 0.5f, nullptr};
            pg8::gemm_phase<pg8::EpiResid, pg8::StaticOrder>(F.lds, g, S, E, nullptr); }
        SEAM(pb + 2);
        if (EN(5) && IN(pb + 3)) for (int rp = 0; rp < REP(2); ++rp) { unsigned char* w = WSP; norm_phase(opq(F), P_XS(w), IN_(8) + l * DM, P_MODX(w, l), P_MODC(w, l), 3, 4, P_ABUF(w)); }
        SEAM(pb + 3);
        if (EN(6) && IN(pb + 4)) { unsigned char* w = WSP; pg8::Gemm g{P_ABUF(w), P_WL(w, l) + W_IN, T, PXW, DM}; pg8::StaticOrder S; S.init(T, PXW, F.G, F.bid); pg8::EpiF32 E{(float*)(w + WS_PX), PXW, nullptr};
            pg8::gemm_phase<pg8::EpiF32, pg8::StaticOrder>(F.lds, g, S, E, nullptr); }
        SEAM(pb + 4);
        if (EN(7) && IN(pb + 5)) { for (int rp = 0; rp < REP(7); ++rp) rwkv_elem_phase(opq(F), opq_ptr(ws), l); if (!(MK_ONLYRP)) { for (int rp = 0; rp < REP(8); ++rp) mla_prep_phase(opq(F), opq_ptr(ws), l); hyena_prep_phase(opq(F), opq_ptr(ws), l); } }
        SEAM(pb + 5);
        if (EN(8) && IN(pb + 6)) {
            { unsigned char* w = WSP; pg8::Gemm g{(const bf16_t*)(w + WS_QA), P_WL(w, l) + W_Q, T, NQ, 1024}; pg8::StaticOrder S; S.init(T, NQ, F.G, F.bid); pg8::EpiBf16<0> E{(bf16_t*)(w + WS_QRAW), NQ, nullptr, 0, 0};
              pg8::gemm_phase<pg8::EpiBf16<0>, pg8::StaticOrder>(F.lds, g, S, E, nullptr); }
            __syncthreads();
            { unsigned char* w = WSP; pg8::Gemm g{(const bf16_t*)(w + WS_KVA), P_WL(w, l) + W_KV, T, NKV, 512}; pg8::StaticOrder S; S.init(T, NKV, F.G, F.bid); pg8::EpiBf16<0> E{(bf16_t*)(w + WS_KVRAW), NKV, nullptr, 0, 0};
              pg8::gemm_phase<pg8::EpiBf16<0>, pg8::StaticOrder>(F.lds, g, S, E, nullptr); }
        }
        SEAM(pb + 6);
        if (EN(9) && IN(pb + 7)) { for (int rp = 0; rp < REP(8); ++rp) qkv_final_phase(opq(F), opq_ptr(ws), l, need_ctx); for (int rp = 0; rp < REP(9); ++rp) scan_prep_phase(opq(F), opq_ptr(ws)); }
        SEAM(pb + 7);
        if (EN(10) && IN(pb + 8)) for (int rp = 0; rp < REP(10); ++rp) mixer_phase(F, ws, l + 4 * rp, need_ctx, (char*)lds);
        SEAM(pb + 8);
        if (EN(11) && IN(pb + 9)) { for (int rp = 0; rp < REP(8); ++rp) rwkv_out_phase(opq(F), opq_ptr(ws), l, need_ctx); hyena_out_phase(opq(F), opq_ptr(ws), need_ctx); }
        SEAM(pb + 9);
        if (EN(12) && IN(pb + 10)) { if (need_ctx) { unsigned char* w = WSP; pg8::Gemm g{P_OBUF(w), P_WL(w, l) + W_OUT, T, DM, DM}; pg8::StaticOrder S; S.init(T, DM, F.G, F.bid); pg8::EpiResid E{P_XS(w), P_MODX(w, l) + 5 * DM, P_MODC(w, l) + 5 * DM, 1.0f, nullptr};
            pg8::gemm_phase<pg8::EpiResid, pg8::StaticOrder>(F.lds, g, S, E, nullptr); } else { unsigned char* w = WSP; pg8::Gemm g{P_OBUF(w), P_WL(w, l) + W_OUT, T, DM, DM}; pg8::StaticOrderX S; S.init(T, DM, F.G, F.bid); pg8::EpiResid E{P_XS(w), P_MODX(w, l) + 5 * DM, P_MODC(w, l) + 5 * DM, 1.0f, nullptr};
            pg8::gemm_phase<pg8::EpiResid, pg8::StaticOrderX>(F.lds, g, S, E, nullptr); } }
        SEAM(pb + 10);
        if (EN(13) && IN(pb + 11)) for (int rp = 0; rp < REP(2); ++rp) { unsigned char* w = WSP; norm_phase(opq(F), P_XS(w), IN_(9) + l * DM, P_MODX(w, l), P_MODC(w, l), 6, 7, P_ABUF(w)); }
        SEAM(pb + 11);
        if (EN(14) && IN(pb + 12)) { if (need_ctx) { unsigned char* w = WSP; pg8::Gemm g{P_ABUF(w), P_WL(w, l) + W_G2, T, 2 * FF, DM}; pg8::StaticOrder S; S.init(T, 2 * FF, F.G, F.bid); pg8::EpiSwiGLU E{P_HBUF(w), FF};
            pg8::gemm_phase<pg8::EpiSwiGLU, pg8::StaticOrder>(F.lds, g, S, E, nullptr); } else { unsigned char* w = WSP; pg8::Gemm g{P_ABUF(w), P_WL(w, l) + W_G2, T, 2 * FF, DM}; pg8::StaticOrderX S; S.init(T, 2 * FF, F.G, F.bid); pg8::EpiSwiGLU E{P_HBUF(w), FF};
            pg8::gemm_phase<pg8::EpiSwiGLU, pg8::StaticOrderX>(F.lds, g, S, E, nullptr); } }
        SEAM(pb + 12);
        if (EN(15) && IN(pb + 13)) { if (need_ctx) { unsigned char* w = WSP; pg8::Gemm g{P_HBUF(w), P_WL(w, l) + W_D2, T, DM, FF}; pg8::StaticOrder S; S.init(T, DM, F.G, F.bid); pg8::EpiResid E{P_XS(w), P_MODX(w, l) + 8 * DM, P_MODC(w, l) + 8 * DM, 0.5f, l == NL - 1 ? a.out : nullptr};
            pg8::gemm_phase<pg8::EpiResid, pg8::StaticOrder>(F.lds, g, S, E, nullptr); } else { unsigned char* w = WSP; pg8::Gemm g{P_HBUF(w), P_WL(w, l) + W_D2, T, DM, FF}; pg8::StaticOrderX S; S.init(T, DM, F.G, F.bid); pg8::EpiResid E{P_XS(w), P_MODX(w, l) + 8 * DM, P_MODC(w, l) + 8 * DM, 0.5f, l == NL - 1 ? a.out : nullptr};
            pg8::gemm_phase<pg8::EpiResid, pg8::StaticOrderX>(F.lds, g, S, E, nullptr); } }
        SEAM(pb + 13);
    }
#undef IN
#undef SEAM
}

#ifndef MK_LAUNCHES
#define MK_LAUNCHES 1
#endif
extern "C" void kernel_launch(void* const* d_in, const int* in_sizes, int n_in, void* d_out, int out_size, void* d_ws, size_t ws_size, hipStream_t stream) {
    static int grid = 0;
    if (grid == 0) {
        if (n_in != 46 || in_sizes[0] != SEQ * DM || out_size != SEQ * DM || ws_size < WS_END) {
            fprintf(stderr, "kernel_launch: shape mismatch: n_in %d in0 %d out %d ws %zu (need %zu); nothing launched\n", n_in, n_in > 0 ? in_sizes[0] : -1, out_size, ws_size, (size_t)WS_END); grid = -1; return; }
        int dev = 0, cus = 0, per_cu = 0;
        if (hipGetDevice(&dev) != hipSuccess || hipDeviceGetAttribute(&cus, hipDeviceAttributeMultiprocessorCount, dev) != hipSuccess) { fprintf(stderr, "kernel_launch: device query failed\n"); grid = -1; return; }
        if (hipFuncSetAttribute((const void*)mk_fwd, hipFuncAttributeMaxDynamicSharedMemorySize, LDS_BYTES) != hipSuccess) { fprintf(stderr, "kernel_launch: hipFuncSetAttribute failed\n"); grid = -1; return; }
        if (hipOccupancyMaxActiveBlocksPerMultiprocessor(&per_cu, (const void*)mk_fwd, 512, LDS_BYTES) != hipSuccess || per_cu < 1) fprintf(stderr, "kernel_launch: note: occupancy query reports %d blocks per CU\n", per_cu);
        (void)hipGetLastError();
        grid = cus;
    }
    if (grid < 0) return;
    if (hipMemsetAsync((char*)d_ws + WS_CTL, 0, CTL_BYTES, stream) != hipSuccess) { fprintf(stderr, "kernel_launch: memset failed\n"); return; }
    Args a{};
    for (int i = 0; i < 46; ++i) a.in[i] = (const float*)d_in[i];
    a.out = (float*)d_out; a.ws = (unsigned char*)d_ws;
#if MK_LAUNCHES == 1
    a.ph_lo = 0; a.ph_hi = NPH;
    hipLaunchKernelGGL(mk_fwd, dim3(grid), dim3(512), LDS_BYTES, stream, a);
#else
    for (int p = 0; p < NPH; ++p) { a.ph_lo = p; a.ph_hi = p + 1; hipLaunchKernelGGL(mk_fwd, dim3(grid), dim3(512), LDS_BYTES, stream, a); }
#endif
    const hipError_t le = hipPeekAtLastError();
    if (le != hipSuccess) fprintf(stderr, "kernel_launch: launch failed: %s\n", hipGetErrorName(le));
}
```

```cpp
#include <hip/hip_runtime.h>
#include <stdint.h>
#include <cstdio>

#define LAS __attribute__((address_space(3)))
#define CAS __attribute__((address_space(4)))
typedef unsigned short bf16_t;
typedef float f32x4 __attribute__((ext_vector_type(4)));
typedef float f32x2 __attribute__((ext_vector_type(2)));
typedef unsigned u32x4 __attribute__((ext_vector_type(4)));
typedef unsigned u32x2 __attribute__((ext_vector_type(2)));

constexpr int T = 8448, NCTX = 256, SEQ = 8192, DM = 4096, FF = 6144, NL = 4;
constexpr int A_W = 1280, A_IN = 4160, B_IN = 3840, C_IN = 1600, NHA = 20;
constexpr int PXW = 9728, PXA = 0, PXB = 4160, PXC = 8000;
constexpr int NQ = 2304, NKV = 3072, NHC = 12;
constexpr int NMOD = 9 * DM;
constexpr float NORM_EPS = 1e-6f, GN_EPS = 64e-5f;

constexpr size_t MiB = 1u << 20;
constexpr size_t al(size_t x) { return (x + MiB - 1) / MiB * MiB; }
constexpr size_t WS_CTL = 0, CTL_BYTES = MiB;
constexpr size_t WS_XS = WS_CTL + CTL_BYTES;
constexpr size_t WS_ABUF = WS_XS + al((size_t)T * DM * 4);
constexpr size_t WS_HBUF = WS_ABUF + al((size_t)T * DM * 2);
constexpr size_t WS_OBUF = WS_HBUF + al((size_t)T * FF * 2);
constexpr size_t WS_PX = WS_OBUF + al((size_t)T * DM * 2);
constexpr size_t WS_MOD = WS_PX + al((size_t)T * PXW * 4);
constexpr size_t WS_HP = WS_MOD + al((size_t)NL * 2 * NMOD * 4);
constexpr size_t WS_SS = WS_HP + MiB;
constexpr size_t WS_SD = WS_SS + al((size_t)NHA * T * 192 * 4);
constexpr size_t WS_WLR = WS_SD + al((size_t)NHA * 2 * T * 192 * 4);
constexpr size_t WS_G = WS_WLR + al((size_t)NL * A_W * 448 * 2);
constexpr size_t WS_Y = WS_G + al((size_t)T * A_W * 4);
constexpr size_t WS_QA = WS_Y + al((size_t)2 * T * A_W * 4);
constexpr size_t WS_KVA = WS_QA + al((size_t)T * 1024 * 2);
constexpr size_t WS_KPE = WS_KVA + al((size_t)T * 512 * 2);
constexpr size_t WS_QRAW = WS_KPE + al((size_t)T * 64 * 2);
constexpr size_t WS_KVRAW = WS_QRAW + al((size_t)T * NQ * 2);
constexpr size_t WS_QF = WS_KVRAW + al((size_t)T * NKV * 2);
constexpr size_t WS_KF = WS_QF + al((size_t)T * NQ * 2);
constexpr size_t WS_H3 = WS_KF + al((size_t)T * NQ * 2);
constexpr size_t WS_HSCR = WS_H3 + al((size_t)NL * T * 64 * 4);
constexpr size_t WS_FR = WS_HSCR + al((size_t)256 * 16384 * 8);
constexpr size_t WS_GT = WS_FR + al((size_t)40 * 528 * (13 * 1024 + 256));
constexpr size_t WS_X0T = WS_GT + al((size_t)1280 * T * 4);
constexpr size_t WS_SLAB = WS_X0T + al((size_t)1280 * T * 4);
constexpr size_t WS_WB = WS_SLAB + al((size_t)16 * 256 * 4096 * 4);
constexpr size_t W_G1 = 0, W_D1 = W_G1 + (size_t)2 * FF * DM, W_IN = W_D1 + (size_t)DM * FF, W_OUT = W_IN + (size_t)PXW * DM, W_G2 = W_OUT + (size_t)DM * DM,
                 W_D2 = W_G2 + (size_t)2 * FF * DM, W_Q = W_D2 + (size_t)DM * FF, W_KV = W_Q + (size_t)NQ * 1024, W_LAYER = W_KV + (size_t)NKV * 512;
constexpr size_t WS_END = WS_WB + al(W_LAYER * NL * 2);
constexpr int CW_BAR = 4096;
constexpr int CW_QUEUE = 8192;

constexpr int LDS_MISC = 143360, LDS_BYTES = 147456;

__device__ __forceinline__ float wave_sum(float v) {
#pragma unroll
    for (int o = 1; o < 64; o <<= 1) v += __shfl_xor(v, o);
    return v;
}
typedef __bf16 bf16x2_t __attribute__((ext_vector_type(2)));
__device__ __forceinline__ unsigned cvt_pk_bf16(float lo, float hi) { const f32x2 v = {lo, hi}; return __builtin_bit_cast(unsigned, __builtin_convertvector(v, bf16x2_t)); }
__device__ __forceinline__ float bf2f(unsigned short b) { return __uint_as_float(((unsigned)b) << 16); }
__device__ __forceinline__ float sigmoidf_(float x) { return 1.0f / (1.0f + __expf(-x)); }
__device__ __forceinline__ float siluf_(float x) { return x / (1.0f + __expf(-x)); }
__device__ __forceinline__ bool has_left(int tau) { return tau != 0 && tau != NCTX; }
__device__ __forceinline__ bool has_right(int tau) { return tau != NCTX - 1 && tau != T - 1; }

struct Args { const float* in[46]; float* out; unsigned char* ws; int ph_lo, ph_hi; };
struct Frame { LAS unsigned char* lds; volatile LAS unsigned* MISC; int tid, lane, wave, bid, G; };
constexpr int LDS_PTAB = LDS_MISC + 2048;
__device__ __forceinline__ const float* inp(const Frame& F, int i) {
    const volatile LAS unsigned* p = (const volatile LAS unsigned*)(F.lds + LDS_PTAB) + 2 * i;
    const unsigned lo = __builtin_amdgcn_readfirstlane(p[0]), hi = __builtin_amdgcn_readfirstlane(p[1]);
    return (const float*)(((unsigned long long)hi << 32) | lo);
}
#define IN_(i) inp(F, (i))
__device__ __forceinline__ Frame opq(const Frame& F) { Frame G = F; asm volatile("" : "+v"(G.tid), "+v"(G.lane), "+s"(G.wave), "+s"(G.bid)); return G; }
__device__ __forceinline__ unsigned char* opq_ptr(unsigned char* p) { asm volatile("" : "+s"(p)); return p; }
#ifndef MK_REP
#define MK_REP 0
#endif
#ifndef MK_ONLYRP
#define MK_ONLYRP 0
#endif
#define REP(x) (1 + (((MK_REP) >> (x)) & 1))
#define XB_TMO      128
#define XB_XCNT(j)  (256  + 64 * (j))
#define XB_XSUB(j)  (1280 + 64 * (j))
#define XB_XGEN(j)  (2304 + 64 * (j))
#define XB_TOP      3328
#define XB_TOPGEN   3392
#define XCD_BAR_WORDS 3456
#define XB_SPIN_CAP (1u << 18)

__device__ __forceinline__ unsigned xb_ld(unsigned* p)              { return __hip_atomic_load(p, __ATOMIC_RELAXED, __HIP_MEMORY_SCOPE_AGENT); }
__device__ __forceinline__ unsigned xb_add(unsigned* p, unsigned v) { return __hip_atomic_fetch_add(p, v, __ATOMIC_RELAXED, __HIP_MEMORY_SCOPE_AGENT); }
__device__ __forceinline__ unsigned xb_xcc_id() { return (unsigned)__builtin_amdgcn_s_getreg((3 << 11) | 20) & 0xFu; }
#define XB_SPIN(cond, bar) do { unsigned _sp = 0; while (cond) { __builtin_amdgcn_s_sleep(1); \
    if ((++_sp & 255u) == 0u) { if (xb_ld(&(bar)[XB_TMO])) break; if (_sp > XB_SPIN_CAP) { atomicAdd(&(bar)[XB_TMO], 1u); break; } } } } while (0)

struct XcdBarrier {
    unsigned* bar; unsigned x;
    volatile LAS unsigned* st;
};

__device__ __forceinline__ XcdBarrier xcd_barrier_post(unsigned* bar, volatile LAS unsigned* st) {
    XcdBarrier b; b.bar = bar; b.x = xb_xcc_id(); b.st = st;
    if (threadIdx.x == 0) (void)xb_add(&bar[XB_XCNT(b.x)], 1u);
    return b;
}
__device__ __forceinline__ void xcd_barrier_complete(unsigned* bar, unsigned x, unsigned& nloc, unsigned& nx) {
    const unsigned G = gridDim.x * gridDim.y * gridDim.z;
    unsigned sum, cnt, mine, sp = 0u;
    for (;;) {
        sum = 0u; cnt = 0u; mine = 0u;
#pragma unroll
        for (unsigned j = 0; j < 16; ++j) { const unsigned c = xb_ld(&bar[XB_XCNT(j)]); sum += c; cnt += (c > 0u) ? 1u : 0u; mine = (j == x) ? c : mine; }
        if (sum == G) break;
        __builtin_amdgcn_s_sleep(1);
        if ((++sp & 255u) == 0u) { if (xb_ld(&bar[XB_TMO])) break; if (sp > XB_SPIN_CAP) { atomicAdd(&bar[XB_TMO], 1u); break; } }
    }
    nloc = mine > 0u ? mine : 1u; nx = cnt > 0u ? cnt : 1u;
}

__device__ __forceinline__ void xcd_barrier(const XcdBarrier& b) {
    asm volatile("s_waitcnt vmcnt(0)" ::: "memory");
    __syncthreads();
    if (threadIdx.x == 0) {
        unsigned* bar = b.bar;
        __builtin_amdgcn_s_waitcnt(0);
        unsigned nloc = b.st[0], nx = b.st[1];
        if (nloc == 0u) { xcd_barrier_complete(bar, b.x, nloc, nx); b.st[0] = nloc; b.st[1] = nx; }
        const unsigned old = xb_add(&bar[XB_XSUB(b.x)], 1u);
        const unsigned gen = old / nloc;
        if (old + 1u == (gen + 1u) * nloc) {
            __builtin_amdgcn_fence(__ATOMIC_RELEASE, "agent");
            asm volatile("s_waitcnt vmcnt(0)" ::: "memory");
            const unsigned og = xb_add(&bar[XB_TOP], 1u);
            const unsigned tg = og / nx;
            if (og + 1u == (tg + 1u) * nx) xb_add(&bar[XB_TOPGEN], 1u);
            else XB_SPIN(xb_ld(&bar[XB_TOPGEN]) == tg, bar);
            __builtin_amdgcn_fence(__ATOMIC_ACQUIRE, "agent");
            xb_add(&bar[XB_XGEN(b.x)], 1u);
            asm volatile("s_waitcnt vmcnt(0)" ::: "memory");
        } else {
            XB_SPIN(xb_ld(&bar[XB_XGEN(b.x)]) == gen, bar);
            __builtin_amdgcn_fence(__ATOMIC_ACQUIRE, "agent");
            asm volatile("s_waitcnt vmcnt(0)" ::: "memory");
        }
    }
    __syncthreads();
}
namespace pg8 {
#define PG8_LAS __attribute__((address_space(3)))
typedef unsigned short bf16_t;
typedef short bf16x8 __attribute__((ext_vector_type(8)));
typedef float f32x4 __attribute__((ext_vector_type(4)));
typedef unsigned u32x4 __attribute__((ext_vector_type(4)));
constexpr int BM = 256, BK = 64, HALF = 128, HTB = HALF * BK * 2  , STAGE_BYTES = 8 * HTB, NXCD = 8, WGM = 8;

__host__ __device__ __forceinline__ int lds_byte(int r, int c) { const int st = (r >> 4) * 2 + (c >> 5), rr = r & 15, cc = c & 31, ob = rr * 64 + cc * 2; return st * 1024 + (ob ^ (((ob >> 9) & 1) << 5)); }
__host__ __device__ __forceinline__ void stage_rc(int b, int& R, int& C) { const int st = b / 1024, sb = b % 1024, swz = sb ^ (((sb >> 9) & 1) << 5); R = (st >> 1) * 16 + swz / 64; C = (st & 1) * 32 + (swz % 64) / 2; }
__host__ __device__ __forceinline__ int perm32(int rho) { const int n = rho >> 4, i = rho & 15; return 8 * (i >> 2) + 4 * n + (i & 3); }

struct Unit { int pm, pn; };
struct Gemm { const bf16_t* A; const bf16_t* Bt; int M, N, K, ld; };

struct StaticOrder {
    int nM, nN, nwg, G, c;
    __host__ __device__ void init(int M, int N, int G_, int c_) { nM = M / BM; nN = N / BM; nwg = nM * nN; G = G_; c = c_; }
    __host__ __device__ bool next(int i, Unit& u) const {
        const long L = (long)i * G + c; if (L >= nwg) return false;
        int wgid = (int)L; { const int q = nwg / NXCD, r = nwg % NXCD, xcd = wgid % NXCD, off = wgid / NXCD; wgid = (xcd < r ? xcd * (q + 1) : r * (q + 1) + (xcd - r) * q) + off; }
        const int nig = WGM * nN, gid = wgid / nig, fm = gid * WGM, gsz = (nM - fm) < WGM ? (nM - fm) : WGM;
        u.pm = fm + ((wgid % nig) % gsz); u.pn = (wgid % nig) / gsz; return true;
    }
    __device__ __forceinline__ void a_ready(const Unit&) const {}
    __device__ __forceinline__ void done(const Unit&) const {}
};
struct CountedOrder : StaticOrder {
    const unsigned* ready; unsigned need; unsigned* tmo;
    __device__ __forceinline__ void a_ready(const Unit& u) const {
        if (threadIdx.x < 64) {
            const unsigned long long t0 = __builtin_amdgcn_s_memrealtime(); unsigned polls = 0;
            while ((unsigned)__builtin_amdgcn_readfirstlane(__hip_atomic_load(ready + 64 * u.pm, __ATOMIC_RELAXED, __HIP_MEMORY_SCOPE_AGENT)) < need) {
                if ((++polls & 255u) == 0u && __builtin_amdgcn_readfirstlane(__hip_atomic_load(tmo, __ATOMIC_RELAXED, __HIP_MEMORY_SCOPE_AGENT)) != 0u) break;
                if (__builtin_amdgcn_s_memrealtime() - t0 > 2000000ull) {
                    if (threadIdx.x == 0) { unsigned expect = 0u; __hip_atomic_compare_exchange_strong(tmo + 1, &expect, 0x600u | (unsigned)(u.pm & 0xff), __ATOMIC_RELAXED, __ATOMIC_RELAXED, __HIP_MEMORY_SCOPE_AGENT); __hip_atomic_store(tmo, 1u, __ATOMIC_RELAXED, __HIP_MEMORY_SCOPE_AGENT); }
                    break; }
                __builtin_amdgcn_s_sleep(2); }
            __builtin_amdgcn_fence(__ATOMIC_ACQUIRE, "agent");
            asm volatile("s_waitcnt vmcnt(0)" ::: "memory");
        }
#if !defined(BROKEN_HOOK_NO_BARRIER)
        asm volatile("" ::: "memory"); __builtin_amdgcn_s_barrier(); asm volatile("" ::: "memory");
#endif
    }
};

__device__ __forceinline__ unsigned cvt_pk_bf16(float lo, float hi) { unsigned r; asm volatile("v_cvt_pk_bf16_f32 %0, %1, %2" : "=v"(r) : "v"(lo), "v"(hi)); return r; }
typedef float f32x2 __attribute__((ext_vector_type(2)));
__device__ __forceinline__ f32x2 gelu_pk(f32x2 v) {
    const f32x2 av = __builtin_elementwise_abs(v), d = av * 0.2316418882f + 1.0f;
    f32x2 t; t.x = __builtin_amdgcn_rcpf(d.x); t.y = __builtin_amdgcn_rcpf(d.y);
    f32x2 q = t * 0.5307027145f + (-0.7265760135f); q = q * t + 0.7107068705f; q = q * t + (-0.142248368f); q = q * t + 0.127414796f; q = q * t;
    const f32x2 s = (v * v) * (-0.72134752044f);
    f32x2 e; e.x = __builtin_amdgcn_exp2f(s.x); e.y = __builtin_amdgcn_exp2f(s.y);
    const f32x2 m = v * (q * e), r = v - m;
    f32x2 o; o.x = v.x < 0.f ? m.x : r.x; o.y = v.y < 0.f ? m.y : r.y; return o;
}

struct EpiF32 {
    static constexpr bool PERM = false, AFTER_DRAIN = false;
    float* C; int ldc; const float* bias;
    __device__ __forceinline__ void operator()(const f32x4 (&acc)[2][2][4][2], const Unit& u, int wr, int wc, int fr, int fq) const {
        const int row0 = u.pm * BM + wr * 64 + fr, col0 = u.pn * BM + wc * 32 + 4 * fq;
        f32x4 bv[2][2];
#pragma unroll
        for (int bj = 0; bj < 2; ++bj)
#pragma unroll
            for (int n = 0; n < 2; ++n) bv[bj][n] = bias ? *(const f32x4*)(bias + col0 + bj * HALF + n * 16) : (f32x4){0.f, 0.f, 0.f, 0.f};
#pragma unroll
        for (int ai = 0; ai < 2; ++ai)
#pragma unroll
            for (int m = 0; m < 4; ++m) { float* rowp = C + (size_t)(row0 + ai * HALF + m * 16) * ldc + col0;
#pragma unroll
                for (int bj = 0; bj < 2; ++bj)
#pragma unroll
                    for (int n = 0; n < 2; ++n) *(f32x4*)(rowp + bj * HALF + n * 16) = acc[ai][bj][m][n] + bv[bj][n]; }
    }
};
template <int ACT  > struct EpiBf16 {
    static constexpr bool PERM = true, AFTER_DRAIN = false;
    bf16_t* O; int ldc; const float* bias; int split_cols; size_t split_stride;
    __device__ __forceinline__ void operator()(const f32x4 (&acc)[2][2][4][2], const Unit& u, int wr, int wc, int fr, int fq) const {
        const int row0 = u.pm * BM + wr * 64 + fr; int colt = u.pn * BM; bf16_t* base = O;
        if (split_cols) { const int t = colt / split_cols; base += (size_t)t * split_stride; colt -= t * split_cols; }
        const int col0 = colt + wc * 32 + 8 * fq, bcol0 = u.pn * BM + wc * 32 + 8 * fq;
        f32x4 bv[2][2];
#pragma unroll
        for (int bj = 0; bj < 2; ++bj)
#pragma unroll
            for (int n = 0; n < 2; ++n) bv[bj][n] = bias ? *(const f32x4*)(bias + bcol0 + bj * HALF + 4 * n) : (f32x4){0.f, 0.f, 0.f, 0.f};
#pragma unroll
        for (int ai = 0; ai < 2; ++ai)
#pragma unroll
            for (int m = 0; m < 4; ++m) { bf16_t* rowp = base + (size_t)(row0 + ai * HALF + m * 16) * ldc + col0;
#pragma unroll
                for (int bj = 0; bj < 2; ++bj) { f32x4 v0 = acc[ai][bj][m][0] + bv[bj][0], v1 = acc[ai][bj][m][1] + bv[bj][1];
                    if (ACT == 1) { f32x2 a = gelu_pk((f32x2){v0[0], v0[1]}), b = gelu_pk((f32x2){v0[2], v0[3]}), c = gelu_pk((f32x2){v1[0], v1[1]}), d = gelu_pk((f32x2){v1[2], v1[3]});
                        v0 = (f32x4){a.x, a.y, b.x, b.y}; v1 = (f32x4){c.x, c.y, d.x, d.y}; }
                    if (ACT == 2) {
#pragma unroll
                        for (int j = 0; j < 4; ++j) { v0[j] = 0.5f * v0[j] * (1.0f + erff(v0[j] * 0.70710678f)); v1[j] = 0.5f * v1[j] * (1.0f + erff(v1[j] * 0.70710678f)); } }
                    u32x4 w; w.x = cvt_pk_bf16(v0[0], v0[1]); w.y = cvt_pk_bf16(v0[2], v0[3]); w.z = cvt_pk_bf16(v1[0], v1[1]); w.w = cvt_pk_bf16(v1[2], v1[3]);
                    *(u32x4*)(rowp + bj * HALF) = w; } }
    }
};
}
namespace pg8 {
struct EpiSwiGLU {
    static constexpr bool PERM = true, AFTER_DRAIN = false;
    bf16_t* O; int ldc;
    __device__ __forceinline__ void operator()(const f32x4 (&acc)[2][2][4][2], const Unit& u, int wr, int wc, int fr, int fq) const {
        const int row0 = u.pm * BM + wr * 64 + fr, col0 = u.pn * HALF + wc * 32 + 8 * fq;
#pragma unroll
        for (int ai = 0; ai < 2; ++ai)
#pragma unroll
            for (int m = 0; m < 4; ++m) { bf16_t* rowp = O + (size_t)(row0 + ai * HALF + m * 16) * ldc + col0;
                float h[8];
#pragma unroll
                for (int n = 0; n < 2; ++n)
#pragma unroll
                    for (int j = 0; j < 4; ++j) { const float g = acc[ai][0][m][n][j], up = acc[ai][1][m][n][j]; h[n * 4 + j] = g * __builtin_amdgcn_rcpf(1.0f + __builtin_amdgcn_exp2f(-1.4426950408889634f * g)) * up; }
                u32x4 w; w.x = cvt_pk_bf16(h[0], h[1]); w.y = cvt_pk_bf16(h[2], h[3]); w.z = cvt_pk_bf16(h[4], h[5]); w.w = cvt_pk_bf16(h[6], h[7]);
                *(u32x4*)rowp = w; }
    }
};
struct EpiResid {
    static constexpr bool PERM = false, AFTER_DRAIN = false;
    float* X; const float* gate_x; const float* gate_c; float fac; float* out_x;
    __device__ __forceinline__ void operator()(const f32x4 (&acc)[2][2][4][2], const Unit& u, int wr, int wc, int fr, int fq) const {
        const int row0 = u.pm * BM + wr * 64 + fr, col0 = u.pn * BM + wc * 32 + 4 * fq;
        const float* gv = (u.pm == 0) ? gate_c : gate_x;
        float* dst = (u.pm != 0 && out_x) ? out_x - (size_t)256 * 4096 : X;
        f32x4 gg[2][2];
#pragma unroll
        for (int bj = 0; bj < 2; ++bj)
#pragma unroll
            for (int n = 0; n < 2; ++n) gg[bj][n] = *(const f32x4*)(gv + col0 + bj * HALF + n * 16) * fac;
#pragma unroll
        for (int ai = 0; ai < 2; ++ai)
#pragma unroll
            for (int m = 0; m < 4; ++m) { const size_t off = (size_t)(row0 + ai * HALF + m * 16) * 4096 + col0;
#pragma unroll
                for (int bj = 0; bj < 2; ++bj)
#pragma unroll
                    for (int n = 0; n < 2; ++n) { const f32x4 b = *(const f32x4*)(X + off + bj * HALF + n * 16); *(f32x4*)(dst + off + bj * HALF + n * 16) = b + gg[bj][n] * acc[ai][bj][m][n]; } }
    }
};
struct OneUnit { int pn;
    __host__ __device__ bool next(int i, Unit& u) const { u.pm = 0; u.pn = pn; return i == 0; }
    __device__ __forceinline__ void a_ready(const Unit&) const {}
    __device__ __forceinline__ void done(const Unit&) const {}
};
struct StaticOrderX { StaticOrder b;
    __host__ __device__ void init(int M, int N, int G_, int c_) { b.init(M - BM, N, G_, c_); }
    __host__ __device__ bool next(int i, Unit& u) const { const bool ok = b.next(i, u); u.pm += 1; return ok; }
    __device__ __forceinline__ void a_ready(const Unit&) const {}
    __device__ __forceinline__ void done(const Unit&) const {}
};
}
namespace pg8 {
template <class Epi, class Sched, bool STAMP = false>
__device__ __forceinline__ void gemm_phase(PG8_LAS unsigned char* lds, const Gemm g, const Sched& S, const Epi& E, unsigned long long* stamps) {
    int tid_ = threadIdx.x; asm volatile("" : "+v"(tid_));
    const int tid = tid_, wid = __builtin_amdgcn_readfirstlane(tid >> 6), lane = tid & 63, wr = wid >> 2, wc = wid & 3, fr = lane & 15, fq = lane >> 4;
    const int K = g.ld, nt = g.K / BK;
    int ts_lo = 0, ts_hi = 0, nts = 0; const unsigned long long rt_entry = STAMP ? (unsigned long long)wall_clock64() : 0ull;
#define PG8_STAMP() do { if (STAMP && wid == 0 && nts < 64) { const unsigned long long _c = (unsigned long long)clock64(); \
        ts_lo = (lane == nts) ? (int)(unsigned)_c : ts_lo; ts_hi = (lane == nts) ? (int)(unsigned)(_c >> 32) : ts_hi; ++nts; } } while (0)
    PG8_STAMP();
    unsigned voffA[2], voffB[2];
#pragma unroll
    for (int i = 0; i < 2; ++i) { int R, C; stage_rc(tid * 16 + i * 8192, R, C); const int Rb = Epi::PERM ? ((R & ~31) + perm32(R & 31)) : R;
        voffA[i] = (unsigned)(R * K + C) * 2u; voffB[i] = (unsigned)(Rb * K + C) * 2u; }
    const size_t kstep = (size_t)(BK * 2);
    const size_t hstep = (size_t)HALF * K * 2;
    const size_t tstep = 2 * hstep;
    const unsigned ldsw = (unsigned)wid * 1024u;
    const int aoff = lds_byte(wr * 64 + fr, fq * 8), boff = lds_byte(wc * 32 + fr, fq * 8);
#define PG8_SA(b, h) (((b) * 2 + (h)) * HTB)
#define PG8_SB(b, h) ((4 + (b) * 2 + (h)) * HTB)
#define PG8_STAGE(bufoff, gbase, voff) do { _Pragma("unroll") for (int _i = 0; _i < 2; ++_i) \
        __builtin_amdgcn_global_load_lds((const unsigned*)((const char*)(gbase) + (voff)[_i]), (PG8_LAS unsigned*)(lds + (bufoff) + ldsw + _i * 8192), 16, 0, 0); } while (0)
#define PG8_LDA(dst, b, h) do { _Pragma("unroll") for (int m = 0; m < 4; ++m) _Pragma("unroll") for (int k = 0; k < 2; ++k) dst[m][k] = *(const PG8_LAS bf16x8*)(lds + PG8_SA(b, h) + aoff + m * 2048 + k * 1024); } while (0)
#define PG8_LDB(dst, b, h) do { _Pragma("unroll") for (int n = 0; n < 2; ++n) _Pragma("unroll") for (int k = 0; k < 2; ++k) dst[n][k] = *(const PG8_LAS bf16x8*)(lds + PG8_SB(b, h) + boff + n * 2048 + k * 1024); } while (0)
#define PG8_MMA(ai, bj, At, Bt) do { __builtin_amdgcn_s_setprio(1); _Pragma("unroll") for (int m = 0; m < 4; ++m) _Pragma("unroll") for (int n = 0; n < 2; ++n) _Pragma("unroll") for (int k = 0; k < 2; ++k) \
        acc[ai][bj][m][n] = __builtin_amdgcn_mfma_f32_16x16x32_bf16(Bt[n][k], At[m][k], acc[ai][bj][m][n], 0, 0, 0); __builtin_amdgcn_s_setprio(0); } while (0)
#define PG8_WAIT_V(n) asm volatile("s_waitcnt vmcnt(" #n ")" ::: "memory")
#define PG8_WAIT_L(n) asm volatile("s_waitcnt lgkmcnt(" #n ")" ::: "memory")
#define PG8_BAR __builtin_amdgcn_s_barrier()
#define PG8_SCHED __builtin_amdgcn_sched_barrier(0)
    Unit cur, nxt; int ui = 0;
    if (!S.next(0, cur)) return;
    f32x4 acc[2][2][4][2];
#pragma unroll
    for (int a = 0; a < 2; ++a)
#pragma unroll
        for (int b = 0; b < 2; ++b)
#pragma unroll
            for (int m = 0; m < 4; ++m)
#pragma unroll
                for (int n = 0; n < 2; ++n) acc[a][b][m][n] = (f32x4){0.f, 0.f, 0.f, 0.f};
    bf16x8 At[4][2], B0[2][2], B1[2][2];
    const char* cA = (const char*)g.A + (size_t)cur.pm * tstep; const char* cB = (const char*)g.Bt + (size_t)cur.pn * tstep;
    S.a_ready(cur);
    PG8_STAGE(PG8_SB(0, 0), cB, voffB); PG8_STAGE(PG8_SA(0, 0), cA, voffA); PG8_STAGE(PG8_SB(0, 1), cB + hstep, voffB); PG8_STAGE(PG8_SA(0, 1), cA + hstep, voffA);
    if (wr == 1) PG8_BAR;
    PG8_WAIT_V(4); PG8_BAR;
    PG8_STAGE(PG8_SB(1, 0), cB + kstep, voffB); PG8_STAGE(PG8_SA(1, 0), cA + kstep, voffA); PG8_STAGE(PG8_SB(1, 1), cB + hstep + kstep, voffB);
    PG8_WAIT_V(6); PG8_BAR;
    PG8_STAMP();
    for (;;) {
        const bool has_next = S.next(ui + 1, nxt);
        const char* nA = has_next ? (const char*)g.A + (size_t)nxt.pm * tstep : cA; const char* nB = has_next ? (const char*)g.Bt + (size_t)nxt.pn * tstep : cB;
        for (int t = 0; t < nt; t += 2) {
            const bool last = (t == nt - 2);
            const char* a1 = cA + (size_t)(t + 1) * kstep;
            const char* a2 = last ? nA : cA + (size_t)(t + 2) * kstep; const char* b2 = last ? nB : cB + (size_t)(t + 2) * kstep;
            const char* a3 = a2 + kstep; const char* b3 = b2 + kstep;
            if (last && has_next) S.a_ready(nxt);
            PG8_LDB(B0, 0, 0); PG8_SCHED; PG8_LDA(At, 0, 0); PG8_STAGE(PG8_SA(1, 1), a1 + hstep, voffA);
            PG8_WAIT_L(8); PG8_BAR; PG8_WAIT_L(0); PG8_MMA(0, 0, At, B0); PG8_BAR; PG8_SCHED;
            PG8_LDB(B1, 0, 1); PG8_STAGE(PG8_SB(0, 0), b2, voffB);
            PG8_BAR; PG8_WAIT_L(0); PG8_MMA(0, 1, At, B1); PG8_BAR;
            PG8_LDA(At, 0, 1); PG8_STAGE(PG8_SA(0, 0), a2, voffA);
            PG8_BAR; PG8_WAIT_L(0); PG8_MMA(1, 0, At, B0); PG8_BAR; PG8_SCHED;
            PG8_STAGE(PG8_SB(0, 1), b2 + hstep, voffB);
            PG8_WAIT_V(6); PG8_BAR; PG8_MMA(1, 1, At, B1); PG8_BAR;
            PG8_LDB(B0, 1, 0); PG8_SCHED; PG8_LDA(At, 1, 0); PG8_STAGE(PG8_SA(0, 1), a2 + hstep, voffA);
            PG8_WAIT_L(8); PG8_BAR; PG8_WAIT_L(0); PG8_MMA(0, 0, At, B0); PG8_BAR; PG8_SCHED;
            PG8_LDB(B1, 1, 1); PG8_STAGE(PG8_SB(1, 0), b3, voffB);
            PG8_BAR; PG8_WAIT_L(0); PG8_MMA(0, 1, At, B1); PG8_BAR;
            PG8_LDA(At, 1, 1); PG8_STAGE(PG8_SA(1, 0), a3, voffA);
            PG8_BAR; PG8_WAIT_L(0); PG8_MMA(1, 0, At, B0); PG8_BAR; PG8_SCHED;
            PG8_STAGE(PG8_SB(1, 1), b3 + hstep, voffB);
            PG8_WAIT_V(6); PG8_BAR; PG8_MMA(1, 1, At, B1); PG8_BAR;
        }
        PG8_STAMP();
        if constexpr (!Epi::AFTER_DRAIN) { E(acc, cur, wr, wc, fr, fq); S.done(cur); }
        PG8_STAMP();
        if (!has_next) break;
#pragma unroll
        for (int a = 0; a < 2; ++a)
#pragma unroll
            for (int b = 0; b < 2; ++b)
#pragma unroll
                for (int m = 0; m < 4; ++m)
#pragma unroll
                    for (int n = 0; n < 2; ++n) acc[a][b][m][n] = (f32x4){0.f, 0.f, 0.f, 0.f};
        cur = nxt; cA = nA; cB = nB; ++ui;
    }
    PG8_WAIT_V(0);
    if (wr == 0) PG8_BAR;
    PG8_BAR;
    if constexpr (Epi::AFTER_DRAIN) { E.fused(acc, cur, wr, wc, fr, fq, lds, wid, lane); S.done(cur); }
    PG8_STAMP();
    if (STAMP && wid == 0) { stamps[lane] = lane < nts ? (((unsigned long long)(unsigned)ts_hi << 32) | (unsigned)ts_lo) : 0ull;
        if (lane == 62) stamps[62] = rt_entry; if (lane == 63) stamps[63] = (unsigned long long)wall_clock64(); }
#undef PG8_STAMP
#undef PG8_SA
#undef PG8_SB
#undef PG8_STAGE
#undef PG8_LDA
#undef PG8_LDB
#undef PG8_MMA
#undef PG8_WAIT_V
#undef PG8_WAIT_L
#undef PG8_BAR
#undef PG8_SCHED
}
}
#define LDS_WAIT() asm volatile("s_waitcnt lgkmcnt(0)" ::: "memory")

__device__ __forceinline__ int map_row(int n, int mode) {
    if (mode == 1) { const int j = n < FF ? n : n - FF; return (j >> 7) * 256 + (n < FF ? 0 : 128) + (j & 127); }
    return n;
}
__device__ __forceinline__ void transpose_item(const float* __restrict__ W, int K, int N, bf16_t* WT, int mode, LAS float* scr, int item, int lane) {
    const int nblk = N / 32, kb = item / nblk, nb = item % nblk, k0 = 64 * kb, n0 = 32 * nb;
#pragma unroll 8
    for (int i = 0; i < 32; ++i) { const int kk = 2 * i + (lane >> 5); scr[kk * 33 + (lane & 31)] = W[(size_t)(k0 + kk) * N + n0 + (lane & 31)]; }
    LDS_WAIT(); asm volatile("" ::: "memory");
    const int c = lane & 7;
#pragma unroll
    for (int j = 0; j < 4; ++j) { const int n = (lane >> 3) + 8 * j; const LAS float* s = scr + (8 * c) * 33 + n;
        u32x4 o; o.x = cvt_pk_bf16(s[0 * 33], s[1 * 33]); o.y = cvt_pk_bf16(s[2 * 33], s[3 * 33]); o.z = cvt_pk_bf16(s[4 * 33], s[5 * 33]); o.w = cvt_pk_bf16(s[6 * 33], s[7 * 33]);
        *(u32x4*)(WT + (size_t)map_row(n0 + n, mode) * K + k0 + 8 * c) = o; }
    LDS_WAIT(); asm volatile("" ::: "memory");
}
constexpr int I_G = (DM / 64) * (2 * FF / 32), I_D = (FF / 64) * (DM / 32), I_IN = (DM / 64) * (9600 / 32), I_OUT = (DM / 64) * (DM / 32), I_Q = (1024 / 64) * (NQ / 32), I_KV = (512 / 64) * (NKV / 32);
constexpr int I_LAYER = 2 * I_G + 2 * I_D + I_IN + I_OUT + I_Q + I_KV;

__device__ __forceinline__ void phase0(const Frame& F, unsigned char* ws) {
    const int gw = F.bid * 8 + F.wave, NGW = F.G * 8;
    const size_t gt = (size_t)F.bid * 512 + F.tid, NGT = (size_t)F.G * 512;
    LAS float* scr = (LAS float*)(F.lds + F.wave * 8704);
    bf16_t* WB = (bf16_t*)(ws + WS_WB);
    for (int it = gw; it < NL * I_LAYER; it += NGW) {
        const int l = it / I_LAYER; int r = it - l * I_LAYER; bf16_t* wl = WB + (size_t)l * W_LAYER;
        if (r < I_G) { transpose_item(IN_(10) + (size_t)l * DM * 2 * FF, DM, 2 * FF, wl + W_G1, 1, scr, r, F.lane); continue; } r -= I_G;
        if (r < I_D) { transpose_item(IN_(11) + (size_t)l * FF * DM, FF, DM, wl + W_D1, 0, scr, r, F.lane); continue; } r -= I_D;
        if (r < I_G) { transpose_item(IN_(12) + (size_t)l * DM * 2 * FF, DM, 2 * FF, wl + W_G2, 1, scr, r, F.lane); continue; } r -= I_G;
        if (r < I_D) { transpose_item(IN_(13) + (size_t)l * FF * DM, FF, DM, wl + W_D2, 0, scr, r, F.lane); continue; } r -= I_D;
        if (r < I_IN) { transpose_item(IN_(14) + (size_t)l * DM * 9600, DM, 9600, wl + W_IN, 0, scr, r, F.lane); continue; } r -= I_IN;
        if (r < I_OUT) { transpose_item(IN_(15) + (size_t)l * DM * DM, DM, DM, wl + W_OUT, 0, scr, r, F.lane); continue; } r -= I_OUT;
        if (r < I_Q) { transpose_item(IN_(39) + (size_t)l * 1024 * NQ, 1024, NQ, wl + W_Q, 0, scr, r, F.lane); continue; } r -= I_Q;
        transpose_item(IN_(41) + (size_t)l * 512 * NKV, 512, NKV, wl + W_KV, 0, scr, r, F.lane);
    }
    for (size_t i = gt; i < (size_t)NL * 128 * 512; i += NGT) {
        const int l = (int)(i / (128 * 512)), rr = (int)((i / 512) % 128), c = (int)(i % 512);
        const int row = 9600 + rr;
        *(u32x4*)(WB + (size_t)l * W_LAYER + W_IN + (size_t)row * DM + c * 8) = (u32x4){0u, 0u, 0u, 0u};
    }
    { bf16_t* WLR = (bf16_t*)(ws + WS_WLR); const float* wu = IN_(18); const float* au = IN_(20); const float* gu = IN_(21);
      for (size_t i = gt; i < (size_t)NL * 448 * A_W; i += NGT) { const int l = (int)(i / (448 * A_W)), k = (int)((i / A_W) % 448), col = (int)(i % A_W);
          float v;
          if (k < 128) v = wu[(((size_t)l * 2 + (k >> 6)) * 64 + (k & 63)) * A_W + col];
          else if (k < 256) v = au[(((size_t)l * 2 + ((k - 128) >> 6)) * 64 + (k & 63)) * A_W + col];
          else v = gu[((size_t)l * 192 + (k - 256)) * A_W + col];
          WLR[((size_t)l * A_W + col) * 448 + k] = (bf16_t)(cvt_pk_bf16(v, v) & 0xffffu); } }
    { f32x4* xs = (f32x4*)(ws + WS_XS); const f32x4* cx = (const f32x4*)IN_(2); const f32x4* xx = (const f32x4*)IN_(0);
      for (size_t i = gt; i < (size_t)T * DM / 4; i += NGT) xs[i] = i < (size_t)NCTX * DM / 4 ? cx[i] : xx[i - (size_t)NCTX * DM / 4]; }
    { float* HP = (float*)(ws + WS_HP);
      for (int it = F.bid; it < NL * 16; it += F.G) { const int l = it >> 4, ch = it & 15, w = F.tid >> 8, j = F.tid & 255;
          const float* cv = w ? IN_(3) : IN_(1); const float* ad = IN_(4) + ((size_t)l * DM + ch * 256) * 256 + j; float s = 0.f;
          for (int i = 0; i < 256; ++i) s += siluf_(cv[ch * 256 + i]) * ad[(size_t)i * 256];
          HP[((l * 16 + ch) * 2 + w) * 256 + j] = s; } }
    { float* H3 = (float*)(ws + WS_H3);
      LAS float* zb = (LAS float*)(F.lds + 73728); LAS float* ha = zb + 8 * 36; LAS float* hb = ha + 8 * 64;
      for (int it = F.bid; it < NL * (T / 8); it += F.G) { const int l = it / (T / 8), pb = it % (T / 8);
          if (F.tid < 8 * 33) { const int p = F.tid / 33, i = F.tid % 33, P = pb * 8 + p; const int L = P < NCTX ? NCTX : SEQ, t = P < NCTX ? P : P - NCTX;
              float z;
              if (i == 0) z = (float)t / (float)(L - 1);
              else { const int b = (i - 1) & 15; const float fb = 1e-4f + (float)b * ((15.0f - 1e-4f) / 15.0f); const float rev2 = 2.0f * fb * (float)t / (float)L;
                  z = i <= 16 ? cospif(rev2) : -sinpif(rev2); }
              zb[p * 36 + i] = z; }
          __syncthreads();
          const int p = F.tid >> 6, j = F.tid & 63; const float fq = IN_(36)[l * 64 + j];
          { const float* w1 = IN_(29) + (size_t)l * 33 * 64 + j; float s = IN_(30)[l * 64 + j];
            for (int i = 0; i < 33; ++i) s += zb[p * 36 + i] * w1[i * 64];
            ha[p * 64 + j] = sinf(fq * s); }
          __syncthreads();
          { const float* w2 = IN_(31) + (size_t)l * 64 * 64 + j; float s = IN_(32)[l * 64 + j];
            for (int i = 0; i < 64; ++i) s += ha[p * 64 + i] * w2[i * 64];
            hb[p * 64 + j] = sinf(fq * s); }
          __syncthreads();
          { const float* w3 = IN_(33) + (size_t)l * 64 * 64 + j; float s = IN_(34)[l * 64 + j];
            for (int i = 0; i < 64; ++i) s += hb[p * 64 + i] * w3[i * 64];
            H3[((size_t)l * 64 + j) * T + pb * 8 + p] = sinf(fq * s); }
          __syncthreads(); } }
}
__device__ __forceinline__ void phase_mod(const Frame& F, unsigned char* ws) {
    const float* HP = (const float*)(ws + WS_HP); float* MOD = (float*)(ws + WS_MOD);
    LAS float* hs = (LAS float*)F.lds;
    for (int it = F.bid; it < NL * (NMOD / 512); it += F.G) { const int l = it / (NMOD / 512), nb = it % (NMOD / 512);
        { const int w = F.tid >> 8, j = F.tid & 255; float s = 0.f;
          for (int ch = 0; ch < 16; ++ch) s += HP[((l * 16 + ch) * 2 + w) * 256 + j];
          hs[w * 256 + j] = s; }
        __syncthreads();
        const int n = nb * 512 + F.tid; const float* au = IN_(5) + (size_t)l * 256 * NMOD + n; float s0 = IN_(6)[(size_t)l * NMOD + n], s1 = s0;
        for (int j = 0; j < 256; ++j) { const float u = au[(size_t)j * NMOD]; s0 += hs[j] * u; s1 += hs[256 + j] * u; }
        MOD[((size_t)l * 2 + 0) * NMOD + n] = s0; MOD[((size_t)l * 2 + 1) * NMOD + n] = s1;
        __syncthreads(); }
}
__device__ __forceinline__ void norm_phase(const Frame& F, float* XS, const float* __restrict__ gain, const float* modx, const float* modc, int ish, int isc, bf16_t* out, const float* slab, const float* sgate, float sfac) {
    const int gw = F.bid * 8 + F.wave, NGW = F.G * 8;
    int row_lo = 0;
    if (slab) { row_lo = NCTX;
        LAS float* red = (LAS float*)F.lds;
        for (int row = F.bid; row < NCTX; row += F.G) { const size_t o = (size_t)row * DM + F.wave * 512;
            f32x4 v[2]; float s = 0.f;
#pragma unroll
            for (int j = 0; j < 2; ++j) { f32x4 acc = (f32x4){0.f, 0.f, 0.f, 0.f};
#pragma unroll
                for (int ks = 0; ks < 16; ++ks) acc += ((const f32x4*)(slab + (size_t)ks * NCTX * DM + o) + F.lane)[64 * j];
                v[j] = ((const f32x4*)(XS + o) + F.lane)[64 * j] + acc * ((const f32x4*)(sgate + F.wave * 512) + F.lane)[64 * j] * sfac;
                ((f32x4*)(XS + o) + F.lane)[64 * j] = v[j]; s += (v[j].x * v[j].x + v[j].y * v[j].y) + (v[j].z * v[j].z + v[j].w * v[j].w); }
            s = wave_sum(s); if (F.lane == 0) red[F.wave] = s;
            __syncthreads();
            float tot = 0.f;
#pragma unroll
            for (int w = 0; w < 8; ++w) tot += red[w];
            const float rstd = rsqrtf(tot * (1.0f / DM) + NORM_EPS);
#pragma unroll
            for (int j = 0; j < 2; ++j) { const int c4 = F.wave * 128 + F.lane + 64 * j;
                const f32x4 y = v[j] * rstd * ((const f32x4*)gain)[c4] * (((const f32x4*)(modc + (size_t)isc * DM))[c4] + 1.0f) + ((const f32x4*)(modc + (size_t)ish * DM))[c4];
                u32x2 w2; w2.x = cvt_pk_bf16(y.x, y.y); w2.y = cvt_pk_bf16(y.z, y.w); ((u32x2*)(out + (size_t)row * DM))[c4] = w2; }
            __syncthreads(); } }
    for (int row = row_lo + gw; row < T; row += NGW) {
        const float* mod = row < NCTX ? modc : modx;
        const f32x4* xr = (const f32x4*)(XS + (size_t)row * DM) + F.lane; const f32x4* g4 = (const f32x4*)gain + F.lane;
        const f32x4* sh4 = (const f32x4*)(mod + (size_t)ish * DM) + F.lane; const f32x4* sc4 = (const f32x4*)(mod + (size_t)isc * DM) + F.lane;
        f32x4 v[16]; float s = 0.f;
#pragma unroll
        for (int j = 0; j < 16; ++j) { v[j] = xr[64 * j]; s += (v[j].x * v[j].x + v[j].y * v[j].y) + (v[j].z * v[j].z + v[j].w * v[j].w); }
        const float rstd = rsqrtf(wave_sum(s) * (1.0f / DM) + NORM_EPS);
        u32x2* o = (u32x2*)(out + (size_t)row * DM) + F.lane;
#pragma unroll
        for (int j = 0; j < 16; ++j) { const f32x4 y = v[j] * rstd * g4[64 * j] * (sc4[64 * j] + 1.0f) + sh4[64 * j];
            u32x2 w; w.x = cvt_pk_bf16(y.x, y.y); w.y = cvt_pk_bf16(y.z, y.w); o[64 * j] = w; }
    }
}
__device__ __forceinline__ float conv3_at(const float* PX, int tau, int col, float w0, float w1, float w2) {
    const float* p = PX + (size_t)tau * PXW + col;
    const bool hl = has_left(tau), hr = has_right(tau);
    return p[0] * w1 + p[hl ? -PXW : 0] * (hl ? w0 : 0.f) + p[hr ? PXW : 0] * (hr ? w2 : 0.f);
}
__device__ __forceinline__ float rope_apply(float val, int tau, int j) {
    const int pos = tau - NCTX, prow = pos >> 6, pcol = pos & 63;
    const float inv = __powf(10000.0f, -(float)(j & 15) * (1.0f / 16.0f));
    const float ang = (float)(j < 32 ? prow : pcol) * inv;
    float sn, cs; sincosf(ang, &sn, &cs);
    const float partner = __shfl_xor(val, 16);
    const float rot = (j & 16) ? partner : -partner;
    return val * cs + rot * sn;
}
__device__ __forceinline__ void mla_prep_phase(const Frame& F, unsigned char* ws, int l) {
    const float* PX = (const float*)(ws + WS_PX); bf16_t* QA = (bf16_t*)(ws + WS_QA); bf16_t* KVA = (bf16_t*)(ws + WS_KVA); bf16_t* KPE = (bf16_t*)(ws + WS_KPE);
    const int gw = F.bid * 8 + F.wave, NGW = F.G * 8;
    const f32x4* gq = (const f32x4*)(IN_(38) + l * 1024) + F.lane; const f32x4* gkv = (const f32x4*)(IN_(40) + l * 512) + F.lane; const float gpe = IN_(45)[l * 64 + F.lane];
    for (int tau = gw; tau < T; tau += NGW) {
        const f32x4* p = (const f32x4*)(PX + (size_t)tau * PXW + PXC) + F.lane;
        f32x4 q[4], kv[2]; float sq = 0.f, skv = 0.f;
#pragma unroll
        for (int j = 0; j < 4; ++j) { q[j] = p[64 * j]; sq += (q[j].x * q[j].x + q[j].y * q[j].y) + (q[j].z * q[j].z + q[j].w * q[j].w); }
#pragma unroll
        for (int j = 0; j < 2; ++j) { kv[j] = p[256 + 64 * j]; skv += (kv[j].x * kv[j].x + kv[j].y * kv[j].y) + (kv[j].z * kv[j].z + kv[j].w * kv[j].w); }
        const float pe = PX[(size_t)tau * PXW + PXC + 1536 + F.lane];
        const float rq = rsqrtf(wave_sum(sq) * (1.0f / 1024.0f) + NORM_EPS), rkv = rsqrtf(wave_sum(skv) * (1.0f / 512.0f) + NORM_EPS), rpe = rsqrtf(wave_sum(pe * pe) * (1.0f / 64.0f) + NORM_EPS);
        u32x2* oq = (u32x2*)(QA + (size_t)tau * 1024) + F.lane; u32x2* okv = (u32x2*)(KVA + (size_t)tau * 512) + F.lane;
#pragma unroll
        for (int j = 0; j < 4; ++j) { const f32x4 y = q[j] * rq * gq[64 * j]; u32x2 w; w.x = cvt_pk_bf16(y.x, y.y); w.y = cvt_pk_bf16(y.z, y.w); oq[64 * j] = w; }
#pragma unroll
        for (int j = 0; j < 2; ++j) { const f32x4 y = kv[j] * rkv * gkv[64 * j]; u32x2 w; w.x = cvt_pk_bf16(y.x, y.y); w.y = cvt_pk_bf16(y.z, y.w); okv[64 * j] = w; }
        float kp = pe * rpe * gpe;
        if (tau >= NCTX) kp = rope_apply(kp, tau, F.lane);
        KPE[(size_t)tau * 64 + F.lane] = (bf16_t)(cvt_pk_bf16(kp, kp) & 0xffffu);
    }
}
__device__ __forceinline__ void qkv_final_phase(const Frame& F, unsigned char* ws, int l, bool need_ctx) {
    const bf16_t* QRAW = (const bf16_t*)(ws + WS_QRAW); const bf16_t* KVRAW = (const bf16_t*)(ws + WS_KVRAW); const bf16_t* KPE = (const bf16_t*)(ws + WS_KPE);
    bf16_t* QF = (bf16_t*)(ws + WS_QF); bf16_t* KF = (bf16_t*)(ws + WS_KF);
    const int gw = F.bid * 8 + F.wave, NGW = F.G * 8, ln = F.lane;
    const float gqn0 = IN_(42)[l * 128 + 2 * ln], gqn1 = IN_(42)[l * 128 + 2 * ln + 1], gqp = IN_(43)[l * 64 + ln];
    const float gkn0 = IN_(44)[l * 128 + 2 * ln], gkn1 = IN_(44)[l * 128 + 2 * ln + 1];
    (void)need_ctx;
    for (int it = gw; it < T * NHC; it += NGW) { const int tau = it / NHC, h = it % NHC;
        const unsigned qn = *(const unsigned*)(QRAW + (size_t)tau * NQ + h * 192 + 2 * ln); const float q0 = bf2f((unsigned short)(qn & 0xffffu)), q1 = bf2f((unsigned short)(qn >> 16));
        const float qp = bf2f(QRAW[(size_t)tau * NQ + h * 192 + 128 + ln]);
        const unsigned kn = *(const unsigned*)(KVRAW + (size_t)tau * NKV + h * 256 + 2 * ln); const float k0 = bf2f((unsigned short)(kn & 0xffffu)), k1 = bf2f((unsigned short)(kn >> 16));
        const float rqn = rsqrtf(wave_sum(q0 * q0 + q1 * q1) * (1.0f / 128.0f) + NORM_EPS), rqp = rsqrtf(wave_sum(qp * qp) * (1.0f / 64.0f) + NORM_EPS), rkn = rsqrtf(wave_sum(k0 * k0 + k1 * k1) * (1.0f / 128.0f) + NORM_EPS);
        float qpe = qp * rqp * gqp; if (tau >= NCTX) qpe = rope_apply(qpe, tau, ln);
        *(unsigned*)(QF + (size_t)tau * NQ + h * 192 + 2 * ln) = cvt_pk_bf16(q0 * rqn * gqn0, q1 * rqn * gqn1);
        QF[(size_t)tau * NQ + h * 192 + 128 + ln] = (bf16_t)(cvt_pk_bf16(qpe, qpe) & 0xffffu);
        *(unsigned*)(KF + (size_t)tau * NQ + h * 192 + 2 * ln) = cvt_pk_bf16(k0 * rkn * gkn0, k1 * rkn * gkn1);
        KF[(size_t)tau * NQ + h * 192 + 128 + ln] = KPE[(size_t)tau * 64 + ln];
    }
}
__device__ __forceinline__ void rwkv_out_phase(const Frame& F, unsigned char* ws, int l, bool need_ctx) {
    const float* SS = (const float*)(ws + WS_SS); const float* SD = (const float*)(ws + WS_SD); const float* GB = (const float*)(ws + WS_G); const float* Y = (const float*)(ws + WS_Y);
    bf16_t* OB = (bf16_t*)(ws + WS_OBUF);
    const int gw = F.bid * 8 + F.wave, NGW = F.G * 8, ln = F.lane;
    const int lo = need_ctx ? 0 : NCTX * NHA;
    for (int it = lo + gw; it < T * NHA; it += NGW) { const int tau = it / NHA, h = it % NHA, col = h * 64 + ln;
        const float y = Y[(size_t)tau * A_W + col] + Y[((size_t)T + tau) * A_W + col];
        const float mu = wave_sum(y) * (1.0f / 64.0f); const float dy = y - mu; const float var = wave_sum(dy * dy) * (1.0f / 64.0f);
        const float yn = dy * rsqrtf(var + GN_EPS) * IN_(25)[l * A_W + col] + IN_(26)[l * A_W + col];
        const float* ss = SS + ((size_t)h * T + tau) * 192 + ln; const float r = ss[64], v = ss[128];
        const float km = 0.5f * (SD[(((size_t)h * 2 + 0) * T + tau) * 192 + 128 + ln] + SD[(((size_t)h * 2 + 1) * T + tau) * 192 + 128 + ln]);
        const float bonus = wave_sum(r * km * IN_(24)[l * A_W + col]) * v;
        const float o = (yn + bonus) * GB[(size_t)tau * A_W + col];
        OB[(size_t)tau * DM + col] = (bf16_t)(cvt_pk_bf16(o, o) & 0xffffu);
    }
}
__device__ __forceinline__ void hyena_prep_phase(const Frame& F, unsigned char* ws, int l) {
    const float* PX = (const float*)(ws + WS_PX); float* GT = (float*)(ws + WS_GT); float* X0T = (float*)(ws + WS_X0T);
    LAS float* LGt = (LAS float*)F.lds; LAS float* LX0 = LGt + 64 * 65;
    const float* cw = IN_(27) + (size_t)l * 3 * B_IN; const float* cb = IN_(28) + (size_t)l * B_IN;
    for (int it = F.bid; it < (T / 64) * 20; it += F.G) { const int tt = it / 20, ct = it % 20;
        { const int t = F.tid >> 3, c0 = ct * 64 + (F.tid & 7) * 8, tau = tt * 64 + t;
          f32x4 u[3][2];
#pragma unroll
          for (int grp = 0; grp < 3; ++grp)
#pragma unroll
              for (int q = 0; q < 2; ++q) { const int c = grp * 1280 + c0 + 4 * q; const float* p = PX + (size_t)tau * PXW + PXB + c;
                  const bool hl = has_left(tau), hr = has_right(tau);
                  const f32x4 y = *(const f32x4*)p * *(const f32x4*)(cw + B_IN + c) + *(const f32x4*)(cb + c) + *(const f32x4*)(p - (hl ? PXW : 0)) * (*(const f32x4*)(cw + c) * (hl ? 1.f : 0.f))
                                + *(const f32x4*)(p + (hr ? PXW : 0)) * (*(const f32x4*)(cw + 2 * B_IN + c) * (hr ? 1.f : 0.f));
                  u[grp][q] = y; }
#pragma unroll
          for (int q = 0; q < 2; ++q)
#pragma unroll
              for (int e = 0; e < 4; ++e) { const int ch = (F.tid & 7) * 8 + 4 * q + e; LGt[ch * 65 + t] = u[1][q][e] * u[2][q][e]; LX0[ch * 65 + t] = u[0][q][e]; } }
        __syncthreads();
        { const int ch = F.tid >> 3, t0 = (F.tid & 7) * 8; const size_t o = (size_t)(ct * 64 + ch) * T + tt * 64 + t0;
          f32x4 a0, a1, b0, b1;
#pragma unroll
          for (int e = 0; e < 4; ++e) { a0[e] = LGt[ch * 65 + t0 + e]; a1[e] = LGt[ch * 65 + t0 + 4 + e]; b0[e] = LX0[ch * 65 + t0 + e]; b1[e] = LX0[ch * 65 + t0 + 4 + e]; }
          *(f32x4*)(GT + o) = a0; *(f32x4*)(GT + o + 4) = a1; *(f32x4*)(X0T + o) = b0; *(f32x4*)(X0T + o + 4) = b1; }
        __syncthreads(); }
}
__device__ __forceinline__ void hyena_out_phase(const Frame& F, unsigned char* ws, bool need_ctx) {
    const float* YT = (const float*)(ws + WS_GT); bf16_t* OB = (bf16_t*)(ws + WS_OBUF);
    LAS float* L = (LAS float*)F.lds;
    const int it0 = need_ctx ? 0 : (NCTX / 64) * 20;
    for (int it = it0 + F.bid; it < (T / 64) * 20; it += F.G) { const int tt = it / 20, ct = it % 20;
        { const int ch = F.tid >> 3, t0 = (F.tid & 7) * 8; const size_t o = (size_t)(ct * 64 + ch) * T + tt * 64 + t0;
          const f32x4 a0 = *(const f32x4*)(YT + o), a1 = *(const f32x4*)(YT + o + 4);
#pragma unroll
          for (int e = 0; e < 4; ++e) { L[ch * 65 + t0 + e] = a0[e]; L[ch * 65 + t0 + 4 + e] = a1[e]; } }
        __syncthreads();
        { const int t = F.tid >> 3, c0 = (F.tid & 7) * 8; float x[8];
#pragma unroll
          for (int e = 0; e < 8; ++e) x[e] = L[(c0 + e) * 65 + t];
          u32x4 w; w.x = cvt_pk_bf16(x[0], x[1]); w.y = cvt_pk_bf16(x[2], x[3]); w.z = cvt_pk_bf16(x[4], x[5]); w.w = cvt_pk_bf16(x[6], x[7]);
          *(u32x4*)(OB + (size_t)(tt * 64 + t) * DM + 1280 + ct * 64 + c0) = w; }
        __syncthreads(); }
}
namespace att {
constexpr int DK = 192, DV = 128, NW = 8, QBLK = 32, KVBLK = 64;
constexpr float SCALE = 0.07216878364870322f;
constexpr float THR = 8.f;
#ifndef ATT_SDEPTH
#define ATT_SDEPTH 2
#endif
constexpr int SDEPTH = ATT_SDEPTH;
constexpr int LDQ = 2304, LDK = 2304, LDV = 3072, LDO = 4096;
constexpr int SHM_V = KVBLK * DV * 2, SHM_K = KVBLK * DK * 2, SHM_ATTN = 2 * SHM_V + 2 * SHM_K + NW * 64 * 4;
using bf16x8 = __attribute__((ext_vector_type(8))) short;
using s16x4  = __attribute__((ext_vector_type(4))) short;
using f32x16 = __attribute__((ext_vector_type(16))) float;
using u32x4  = __attribute__((ext_vector_type(4))) unsigned;
#define KSWZ(row, colB) ((row) * 384 + ((colB) ^ (((row) & 7) << 4)))
#define SBAR() __builtin_amdgcn_sched_barrier(0)
__device__ __forceinline__ int crow(int r, int hi) { return (r & 3) + 8 * (r >> 2) + 4 * hi; }
__device__ __forceinline__ unsigned cvtpk(float lo, float hi) { unsigned r; asm volatile("v_cvt_pk_bf16_f32 %0, %1, %2" : "=v"(r) : "v"(lo), "v"(hi)); return r; }
__device__ __forceinline__ void partialSM(f32x16& p0, f32x16& p1, float& m_reg, float& mn, float& alpha) {
  constexpr float C = SCALE * 1.4426950408889634f;
  float pmax = p0[0]; for (int r = 1; r < 16; ++r) pmax = fmaxf(pmax, p0[r]); for (int r = 0; r < 16; ++r) pmax = fmaxf(pmax, p1[r]);
  { auto rr = __builtin_amdgcn_permlane32_swap(__float_as_uint(pmax), __float_as_uint(pmax), false, false);
    pmax = fmaxf(__uint_as_float(rr[0]), __uint_as_float(rr[1])); }
  if (__builtin_expect(__all(pmax - m_reg <= THR / SCALE), 1)) { mn = m_reg; alpha = 1.f; }
  else { mn = fmaxf(m_reg, pmax); alpha = __builtin_amdgcn_exp2f((m_reg - mn) * C); m_reg = mn; }
  float mnC = -mn * C;
  for (int r = 0; r < 16; ++r) p0[r] = fmaf(p0[r], C, mnC); for (int r = 0; r < 16; ++r) p1[r] = fmaf(p1[r], C, mnC);
  for (int r = 0; r < 16; ++r) p0[r] = __builtin_amdgcn_exp2f(p0[r]);
}
__device__ __forceinline__ void finishSM(f32x16& p0, f32x16& p1, float alpha, float& l_reg, bf16x8& pa0, bf16x8& pa1, bf16x8& pa2, bf16x8& pa3) {
  for (int r = 0; r < 16; ++r) p1[r] = __builtin_amdgcn_exp2f(p1[r]);
  float ps = 0; for (int r = 0; r < 16; ++r) ps += p0[r]; for (int r = 0; r < 16; ++r) ps += p1[r];
  { auto rr = __builtin_amdgcn_permlane32_swap(__float_as_uint(ps), __float_as_uint(ps), false, false);
    ps = __uint_as_float(rr[0]) + __uint_as_float(rr[1]); }
  l_reg = l_reg * alpha + ps;
#define PK4(P, BASE, OUT) do { unsigned a0 = cvtpk(P[BASE + 0], P[BASE + 1]), a1 = cvtpk(P[BASE + 2], P[BASE + 3]);   \
    unsigned b0 = cvtpk(P[BASE + 4], P[BASE + 5]), b1 = cvtpk(P[BASE + 6], P[BASE + 7]);                              \
    auto r0 = __builtin_amdgcn_permlane32_swap(a0, b0, false, false); auto r1 = __builtin_amdgcn_permlane32_swap(a1, b1, false, false); \
    u32x4 w = {r0[0], r1[0], r0[1], r1[1]}; OUT = *reinterpret_cast<bf16x8*>(&w); } while (0)
  PK4(p0, 0, pa0); PK4(p0, 8, pa1); PK4(p1, 0, pa2); PK4(p1, 8, pa3);
#undef PK4
}
__device__ __forceinline__ void qkt(f32x16& p0, f32x16& p1, const char* Ks, const bf16x8* qr, int r32, int hi) {
  p0 = f32x16{}; p1 = f32x16{};
#pragma unroll
  for (int d0 = 0; d0 < 12; ++d0) { int cb = (d0 * 16 + hi * 8) * 2;
    bf16x8 b0 = *reinterpret_cast<const bf16x8*>(Ks + KSWZ(r32, cb));
    bf16x8 b1 = *reinterpret_cast<const bf16x8*>(Ks + KSWZ(32 + r32, cb));
    p0 = __builtin_amdgcn_mfma_f32_32x32x16_bf16(b0, qr[d0], p0, 0, 0, 0);
    p1 = __builtin_amdgcn_mfma_f32_32x32x16_bf16(b1, qr[d0], p1, 0, 0, 0); }
}
__device__ __forceinline__ int v_st(int k, int c) { const int kk = (k & ~0xC) | ((k & 4) << 1) | ((k & 8) >> 1); return ((kk >> 3) * 4 + (c >> 5)) * 512 + ((kk & 7) * 32 + (c & 31)) * 2; }
__device__ __forceinline__ int v_rd_base(int lane) { return ((lane & 3) << 3) | (((lane >> 2) & 3) << 6) | (((lane >> 4) & 1) << 5) | (((lane >> 5) & 1) << 8); }
constexpr int v_rd_off(int d0, int ks, int half) { return d0 * 512 + ks * 4096 + half * 2048; }
template <int OFF> __device__ __forceinline__ s16x4 tr_read(int vb) {
  s16x4 r; asm volatile("ds_read_b64_tr_b16 %0, %1 offset:%2" : "=&v"(r) : "v"(vb), "i"(OFF) : "memory"); return r;
}
template <int D0> __device__ __forceinline__ void pv_one(f32x16& od, int vb, bf16x8 pa0, bf16x8 pa1, bf16x8 pa2, bf16x8 pa3) {
  const s16x4 l0 = tr_read<v_rd_off(D0, 0, 0)>(vb), h0 = tr_read<v_rd_off(D0, 0, 1)>(vb), l1 = tr_read<v_rd_off(D0, 1, 0)>(vb), h1 = tr_read<v_rd_off(D0, 1, 1)>(vb);
  const s16x4 l2 = tr_read<v_rd_off(D0, 2, 0)>(vb), h2 = tr_read<v_rd_off(D0, 2, 1)>(vb), l3 = tr_read<v_rd_off(D0, 3, 0)>(vb), h3 = tr_read<v_rd_off(D0, 3, 1)>(vb);
  asm volatile("s_waitcnt lgkmcnt(0)" ::: "memory"); SBAR();
#define PK(L, H) (bf16x8){L[0], L[1], L[2], L[3], H[0], H[1], H[2], H[3]}
  od = __builtin_amdgcn_mfma_f32_32x32x16_bf16(pa0, PK(l0, h0), od, 0, 0, 0);
  od = __builtin_amdgcn_mfma_f32_32x32x16_bf16(pa1, PK(l1, h1), od, 0, 0, 0);
  od = __builtin_amdgcn_mfma_f32_32x32x16_bf16(pa2, PK(l2, h2), od, 0, 0, 0);
  od = __builtin_amdgcn_mfma_f32_32x32x16_bf16(pa3, PK(l3, h3), od, 0, 0, 0);
#undef PK
}
__device__ __forceinline__ void pv_d0(f32x16* o, int vb, bf16x8 pa0, bf16x8 pa1, bf16x8 pa2, bf16x8 pa3) {
  pv_one<0>(o[0], vb, pa0, pa1, pa2, pa3); pv_one<1>(o[1], vb, pa0, pa1, pa2, pa3); pv_one<2>(o[2], vb, pa0, pa1, pa2, pa3); pv_one<3>(o[3], vb, pa0, pa1, pa2, pa3);
}
__device__ __forceinline__ void attn_body(const bf16_t* __restrict__ Qb, const bf16_t* __restrict__ Kh, const bf16_t* __restrict__ Vh, bf16_t* __restrict__ Ob, int seq, char* lds) {
  int tid_ = threadIdx.x; asm volatile("" : "+v"(tid_));
  const int tid = tid_, wid = tid >> 6, lane = tid & 63, r32 = lane & 31, hi = lane >> 5;
  char* V_lds = lds; char* K_lds = lds + 2 * SHM_V;
  float* ws = (float*)(lds + 2 * SHM_V + 2 * SHM_K) + wid * 64; float* li_l = ws; float* al_l = ws + 32;
  float m_reg = -1e30f, l_reg = 0; f32x16 o[4] = {}; bf16x8 qr[12];
  const bf16_t* Qw = Qb + (long)(wid * QBLK + r32) * LDQ + hi * 8;
#pragma unroll
  for (int d0 = 0; d0 < 12; ++d0) qr[d0] = *reinterpret_cast<const bf16x8*>(Qw + d0 * 16);
  unsigned kgo[3], vgo[2];
#pragma unroll
  for (int i = 0; i < 3; ++i) { const int p = (i * 8 + wid) * 64 + lane, row = p / 24, slot = p % 24, ch = slot ^ (row & 7); kgo[i] = (unsigned)(row * LDK + ch * 8) * 2u; }
#pragma unroll
  for (int i = 0; i < 2; ++i) { const int p = (i * 8 + wid) * 64 + lane, sub = p >> 5, within = p & 31, kk = (sub >> 2) * 8 + (within >> 2), c = (sub & 3) * 32 + (within & 3) * 8;
    const int k = (kk & ~0xC) | ((kk & 4) << 1) | ((kk & 8) >> 1); vgo[i] = (unsigned)(k * LDV + c) * 2u; }
  const int vb0 = (int)(uintptr_t)V_lds + v_rd_base(lane);
  typedef __attribute__((address_space(3))) unsigned lds_u32;
#define DMA(b, k0) do { const char* kg = (const char*)Kh + (size_t)(k0) * (LDK * 2); const char* vg = (const char*)Vh + (size_t)(k0) * (LDV * 2); \
    _Pragma("unroll") for (int _i = 0; _i < 3; ++_i) __builtin_amdgcn_global_load_lds((const unsigned*)(kg + kgo[_i]), (lds_u32*)(K_lds + (b) * SHM_K + (_i * 8 + wid) * 1024), 16, 0, 0); \
    _Pragma("unroll") for (int _i = 0; _i < 2; ++_i) __builtin_amdgcn_global_load_lds((const unsigned*)(vg + vgo[_i]), (lds_u32*)(V_lds + (b) * SHM_V + (_i * 8 + wid) * 1024), 16, 0, 0); } while (0)
#define RESC(a) do { if (__any((a) < 1.f)) { if (hi == 0) al_l[r32] = (a); asm volatile("s_waitcnt lgkmcnt(0)" ::: "memory"); \
    for (int d = 0; d < 4; ++d) for (int r = 0; r < 16; ++r) o[d][r] *= al_l[crow(r, hi)]; } } while (0)
  f32x16 p0, p1; float mn, al; bf16x8 pa0, pa1, pa2, pa3; const int NT = seq / KVBLK;
  DMA(0, 0); asm volatile("s_waitcnt vmcnt(0)" ::: "memory"); __syncthreads();
#define TILE(b) do { SBAR(); qkt(p0, p1, K_lds + (b) * SHM_K, qr, r32, hi); partialSM(p0, p1, m_reg, mn, al); RESC(al); \
    finishSM(p0, p1, al, l_reg, pa0, pa1, pa2, pa3); SBAR(); pv_d0(o, vb0 + (b) * (int)SHM_V, pa0, pa1, pa2, pa3); } while (0)
  for (int j = 0; j < NT; j += 2) {
    DMA(1, (j + 1) * KVBLK);
    TILE(0); asm volatile("s_waitcnt vmcnt(0)" ::: "memory"); __syncthreads();
    if (j + 2 < NT) DMA(0, (j + 2) * KVBLK);
    TILE(1); asm volatile("s_waitcnt vmcnt(0)" ::: "memory"); __syncthreads();
  }
#undef TILE
#undef DMA
  if (hi == 0) li_l[r32] = l_reg; asm volatile("s_waitcnt lgkmcnt(0)" ::: "memory");
  float rli[16];
#pragma unroll
  for (int r = 0; r < 16; ++r) rli[r] = __builtin_amdgcn_rcpf(li_l[crow(r, hi)]);
  bf16_t* Ow = Ob + (long)(wid * QBLK) * LDO;
#pragma unroll
  for (int r = 0; r < 16; ++r) { int orow = crow(r, hi);
#pragma unroll
    for (int d0 = 0; d0 < 4; ++d0) { const float val = o[d0][r] * rli[r]; Ow[(long)orow * LDO + d0 * 32 + r32] = (bf16_t)(cvtpk(val, val) & 0xffff); } }
  __syncthreads();
#undef RESC
}
}
__device__ __forceinline__ f32x2 cmul(f32x2 a, f32x2 b) { return (f32x2){a.x * b.x - a.y * b.y, a.x * b.y + a.y * b.x}; }
__device__ __forceinline__ int rev4_14(int k) { const unsigned r = __brev((unsigned)k) >> 18; return (int)(((r & 0x1555u) << 1) | ((r >> 1) & 0x1555u)); }
#define ZI(i) ((i) + ((i) >> 5))
__device__ __forceinline__ void fft16k_dif(LAS f32x2* Z, int tid) {
#pragma unroll 1
    for (int s = 0; s < 7; ++s) { int lq = 12 - 2 * s; asm volatile("" : "+s"(lq)); const int q = 1 << lq;
#pragma unroll 2
        for (int i = 0; i < 8; ++i) { const int b = tid + 512 * i, j = b & (q - 1), base = ((b >> lq) << (lq + 2)) + j;
            const int i0 = ZI(base), i1 = ZI(base + q), i2 = ZI(base + 2 * q), i3 = ZI(base + 3 * q);
            const f32x2 a0 = Z[i0], a1 = Z[i1], a2 = Z[i2], a3 = Z[i3];
            const f32x2 t0 = a0 + a2, t1 = a0 - a2, t2 = a1 + a3, t3 = a1 - a3;
            const float rev = (float)j / (float)(4 * q); const float sn = __builtin_amdgcn_sinf(rev), cs = __builtin_amdgcn_cosf(rev);
            const f32x2 w1 = (f32x2){cs, -sn}, w2 = cmul(w1, w1), w3 = cmul(w2, w1);
            Z[i0] = t0 + t2; Z[i1] = cmul((f32x2){t1.x + t3.y, t1.y - t3.x}, w1); Z[i2] = cmul(t0 - t2, w2); Z[i3] = cmul((f32x2){t1.x - t3.y, t1.y + t3.x}, w3); }
        __syncthreads(); }
}
__device__ __forceinline__ void fft16k_dit_inv(LAS f32x2* Z, int tid) {
#pragma unroll 1
    for (int s = 0; s < 7; ++s) { int lq = 2 * s; asm volatile("" : "+s"(lq)); const int q = 1 << lq;
#pragma unroll 2
        for (int i = 0; i < 8; ++i) { const int b = tid + 512 * i, j = b & (q - 1), base = ((b >> lq) << (lq + 2)) + j;
            const float rev = (float)j / (float)(4 * q); const float sn = __builtin_amdgcn_sinf(rev), cs = __builtin_amdgcn_cosf(rev);
            const f32x2 w1 = (f32x2){cs, sn}, w2 = cmul(w1, w1), w3 = cmul(w2, w1);
            const int i0 = ZI(base), i1 = ZI(base + q), i2 = ZI(base + 2 * q), i3 = ZI(base + 3 * q);
            const f32x2 b0 = Z[i0], b1 = cmul(Z[i1], w1), b2 = cmul(Z[i2], w2), b3 = cmul(Z[i3], w3);
            const f32x2 t0 = b0 + b2, t1 = b0 - b2, t2 = b1 + b3, t3 = b1 - b3;
            Z[i0] = t0 + t2; Z[i1] = (f32x2){t1.x - t3.y, t1.y + t3.x}; Z[i2] = t0 - t2; Z[i3] = (f32x2){t1.x + t3.y, t1.y - t3.x}; }
        __syncthreads(); }
}
constexpr float HY_MIN_DECAY = -3.0701134573253945f, HY_MAX_DECAY = -15.350567286626973f;
__device__ __forceinline__ float hy_delta(int c) { return fabsf(HY_MIN_DECAY + (HY_MAX_DECAY - HY_MIN_DECAY) * ((float)c / 1279.0f)); }
__device__ __forceinline__ float conv3b_at(const float* PX, int tau, int col, const float* cw, int l, int c) {
    const float* w = cw + (size_t)l * 3 * B_IN;
    return conv3_at(PX, tau, col, w[c], w[B_IN + c], w[2 * B_IN + c]);
}
__device__ __forceinline__ void hyena_unit(const Frame& F, unsigned char* ws, int l, int pair) {
    LAS f32x2* Z = (LAS f32x2*)F.lds; LAS float* red = (LAS float*)(F.lds + LDS_MISC + 128);
    const int tid = F.tid, c0 = 2 * pair;
    const float* H3x = (const float*)(ws + WS_H3) + (size_t)l * 64 * T + NCTX;
    float* GT = (float*)(ws + WS_GT); const float* X0T = (const float*)(ws + WS_X0T);
    f32x2* scr = (f32x2*)(ws + WS_HSCR) + (size_t)F.bid * 16384;
    LAS f32x4* FW = (LAS f32x4*)(F.lds + LDS_MISC + 256);
    if (tid < 256) { const int j = tid >> 2, q = tid & 3; ((LAS float*)FW)[tid] = IN_(35)[(size_t)l * 64 * 2560 + (size_t)j * 2560 + (q >> 1) * 1280 + c0 + (q & 1)]; }
    __syncthreads();
    const float d0 = hy_delta(c0), d1 = hy_delta(c0 + 1);
#ifndef HYS
#define HYS 31
#endif
    float s0, s1, sc0 = 0.f, sc1 = 0.f;
    for (int rp14 = 0; rp14 < REP(14); ++rp14) {
    s0 = 0.f; s1 = 0.f;
    if (HYS & 1)
#pragma unroll 1
    for (int i = 0; i < 4; ++i) { const int tb = 2048 * i + 4 * tid; const float* hc = H3x + tb;
        asm volatile("" ::: "memory");
        f32x4 acc[4];
#pragma unroll
        for (int p = 0; p < 4; ++p) acc[p] = (f32x4){0.f, 0.f, 0.f, 0.f};
#pragma unroll 8
        for (int j = 0; j < 64; ++j) { const f32x4 w = FW[j]; const f32x4 hv = *(const f32x4*)(hc + (size_t)j * T);
#pragma unroll
            for (int p = 0; p < 4; ++p) acc[p] += w * hv[p]; }
#pragma unroll
        for (int p = 0; p < 4; ++p) { const int t = tb + p;
            const float tl = (float)t * (1.0f / 8191.0f), e0 = __expf(-tl * d0), e1 = __expf(-tl * d1);
            const float f0 = acc[p].x * e0, f1 = acc[p].y * e1, b0 = acc[p].z * e0, b1 = acc[p].w * e1;
            Z[ZI(t)] = (f32x2){f0, f1}; s0 += fabsf(f0); s1 += fabsf(f1);
            if (t < 8191) { Z[ZI(16383 - t)] = (f32x2){b0, b1}; s0 += fabsf(b0); s1 += fabsf(b1); } } }
    if (tid == 0) { float zz = 0.f; asm volatile("" : "+v"(zz)); Z[ZI(8192)] = (f32x2){zz, zz}; }
    s0 = wave_sum(s0); s1 = wave_sum(s1);
    if (F.lane == 0) { red[F.wave * 2] = s0; red[F.wave * 2 + 1] = s1; }
    __syncthreads();
    float n0 = 0.f, n1 = 0.f;
#pragma unroll
    for (int w = 0; w < 8; ++w) { n0 += red[2 * w]; n1 += red[2 * w + 1]; }
    sc0 = 1.0f / (16384.0f * n0); sc1 = 1.0f / (16384.0f * n1);
    if (HYS & 2) fft16k_dif(Z, tid);
#pragma unroll 4
    for (int i = 0; i < 32; ++i) scr[tid + 512 * i] = Z[ZI(tid + 512 * i)];
    __syncthreads();
    }
    for (int rp15 = 0; rp15 < REP(15); ++rp15) {
    const float* g0p = GT + (size_t)c0 * T + NCTX; const float* g1p = g0p + T;
    { float zz = 0.f; asm volatile("" : "+v"(zz));
#pragma unroll 4
      for (int i = 0; i < 16; ++i) { const int t = tid + 512 * i; Z[ZI(t)] = (f32x2){g0p[t], g1p[t]}; Z[ZI(8192 + t)] = (f32x2){zz, zz}; } }
    __syncthreads();
    if (HYS & 2) fft16k_dif(Z, tid);
    if (HYS & 8)
#pragma unroll 2
    for (int i = 0; i < 17; ++i) { const int k = tid + 512 * i; if (i == 16 && tid != 0) break;
        const int pk = rev4_14(k & 16383), pn = rev4_14((16384 - k) & 16383);
        const f32x2 A = Z[ZI(pk)], B = Z[ZI(pn)], At = scr[pk], Bt = scr[pn];
        const f32x2 G0 = (f32x2){0.5f * (A.x + B.x), 0.5f * (A.y - B.y)}, G1 = (f32x2){0.5f * (A.y + B.y), -0.5f * (A.x - B.x)};
        const f32x2 H0 = (f32x2){0.5f * (At.x + Bt.x), 0.5f * (At.y - Bt.y)}, H1 = (f32x2){0.5f * (At.y + Bt.y), -0.5f * (At.x - Bt.x)};
        const f32x2 P0 = cmul(G0, H0), P1 = cmul(G1, H1);
        Z[ZI(pk)] = (f32x2){P0.x - P1.y, P0.y + P1.x};
        if (pn != pk) Z[ZI(pn)] = (f32x2){P0.x + P1.y, P1.x - P0.y}; }
    __syncthreads();
    if (HYS & 2) fft16k_dit_inv(Z, tid);
    }
    const float bb0 = IN_(37)[l * 1280 + c0], bb1 = IN_(37)[l * 1280 + c0 + 1];
    { float* y0p = GT + (size_t)c0 * T + NCTX; float* y1p = y0p + T; const float* x0p = X0T + (size_t)c0 * T + NCTX; const float* x1p = x0p + T;
#pragma unroll 4
      for (int i = 0; i < 16; ++i) { const int t = tid + 512 * i; const f32x2 z = Z[ZI(t)]; const float ga = y0p[t], gb = y1p[t];
          y0p[t] = x0p[t] * (z.x * sc0 + ga * bb0); y1p[t] = x1p[t] * (z.y * sc1 + gb * bb1); } }
    __syncthreads();
}
__device__ __forceinline__ void hyena_ctx_unit(const Frame& F, unsigned char* ws, int l, int unit) {
    LAS float* TF = (LAS float*)F.lds; LAS float* TB = TF + 2048; LAS float* GG = TB + 2048;
    const int tid = F.tid, t = tid >> 1, cc = (tid & 1) * 4, cbase = unit * 8 + cc;
    const float* H3c = (const float*)(ws + WS_H3) + (size_t)l * 64 * T; float* GT = (float*)(ws + WS_GT); const float* X0T = (const float*)(ws + WS_X0T);
    { float f[4] = {0.f, 0.f, 0.f, 0.f}, b[4] = {0.f, 0.f, 0.f, 0.f};
      const float* wbase = IN_(35) + (size_t)l * 64 * 2560 + cbase;
      for (int j = 0; j < 64; ++j) { const float hv = H3c[(size_t)j * T + t]; const float* wrow = wbase + (size_t)j * 2560;
#pragma unroll
          for (int q = 0; q < 4; ++q) { f[q] += hv * wrow[q]; b[q] += hv * wrow[1280 + q]; } }
      const float tl = (float)t * (1.0f / 255.0f);
#pragma unroll
      for (int q = 0; q < 4; ++q) { const float e = __expf(-tl * hy_delta(cbase + q)); TF[t * 8 + cc + q] = f[q] * e; TB[t * 8 + cc + q] = b[q] * e; GG[t * 8 + cc + q] = GT[(size_t)(cbase + q) * T + t]; } }
    __syncthreads();
    float nrm[4] = {0.f, 0.f, 0.f, 0.f}, y[4] = {0.f, 0.f, 0.f, 0.f};
    for (int s = 0; s < 256; ++s) {
#pragma unroll
        for (int q = 0; q < 4; ++q) { nrm[q] += fabsf(TF[s * 8 + cc + q]) + (s < 255 ? fabsf(TB[s * 8 + cc + q]) : 0.f);
            const int o = t - s; const float tap = o >= 0 ? TF[o * 8 + cc + q] : TB[(-o - 1) * 8 + cc + q];
            y[q] += tap * GG[s * 8 + cc + q]; } }
    __syncthreads();
#pragma unroll
    for (int q = 0; q < 4; ++q) GT[(size_t)(cbase + q) * T + t] = X0T[(size_t)(cbase + q) * T + t] * (y[q] / nrm[q] + GG[t * 8 + cc + q] * IN_(37)[l * 1280 + cbase + q]);
    __syncthreads();
}
constexpr int SC_C = 16, SC_NCHUNK = T / SC_C, SC_CHUNK_BYTES = 13 * 1024 + 256, SC_GRP = 4, SC_NGRP = SC_NCHUNK / SC_GRP;
__device__ __forceinline__ int sc_tau(int d, int c, int t) { return d == 0 ? SC_C * c + t : (c < NCTX / SC_C ? NCTX - 1 - SC_C * c - t : T - 1 - SC_C * (c - NCTX / SC_C) - t); }
__device__ __forceinline__ int sc_perm(int e, int hi) { return (e & 3) + 8 * (e >> 2) + 4 * hi; }
constexpr size_t WS_FR_BYTES = (size_t)2 * NHA * SC_NCHUNK * SC_CHUNK_BYTES;

typedef short sc_bf16x8 __attribute__((ext_vector_type(8)));
typedef float sc_f32x16 __attribute__((ext_vector_type(16)));
__device__ __forceinline__ sc_bf16x8 sc_pack8(const sc_f32x16& a, int base) {
    u32x4 w; w.x = cvt_pk_bf16(a[base + 0], a[base + 1]); w.y = cvt_pk_bf16(a[base + 2], a[base + 3]); w.z = cvt_pk_bf16(a[base + 4], a[base + 5]); w.w = cvt_pk_bf16(a[base + 6], a[base + 7]);
    return *reinterpret_cast<sc_bf16x8*>(&w);
}
__device__ __forceinline__ void scan_chain_mfma(const Frame& F, unsigned char* ws, int chain) {
    const int h = chain >> 1, d = chain & 1, tid = F.tid, lane = F.lane, n = lane & 31, hi = lane >> 5, ib = F.wave;
    const unsigned char* FRc = ws + WS_FR + (size_t)chain * SC_NCHUNK * SC_CHUNK_BYTES;
    float* Yd = (float*)(ws + WS_Y) + (size_t)d * T * A_W + h * 64;
    LAS unsigned char* buf = F.lds;
    constexpr int GRP_BYTES = SC_GRP * SC_CHUNK_BYTES, GRP_V4 = GRP_BYTES / 16;
    f32x4 st[7];
#define SCM_LOAD(g) do { const f32x4* src_ = (const f32x4*)(FRc + (size_t)(g) * GRP_BYTES); _Pragma("unroll") for (int i_ = 0; i_ < 7; ++i_) { const int idx = tid + 512 * i_; if (idx < GRP_V4) st[i_] = src_[idx]; } } while (0)
#define SCM_WRITE(b) do { _Pragma("unroll") for (int i_ = 0; i_ < 7; ++i_) { const int idx = tid + 512 * i_; if (idx < GRP_V4) *(LAS f32x4*)(buf + (b) * GRP_BYTES + idx * 16) = st[i_]; } } while (0)
    sc_f32x16 S0 = {}, S1 = {};
    SCM_LOAD(0); SCM_WRITE(0); __syncthreads();
    for (int g = 0; g < SC_NGRP; ++g) {
        if (g + 1 < SC_NGRP) SCM_LOAD(g + 1);
        if (ib < 2) {
#pragma unroll 1
            for (int cc = 0; cc < SC_GRP; ++cc) {
                const LAS unsigned char* fb = buf + (g & 1) * GRP_BYTES + cc * SC_CHUNK_BYTES;
#define SCM_FRAG(f) (*(const LAS sc_bf16x8*)(fb + (f) * 1024 + lane * 16))
                const sc_bf16x8 vf = SCM_FRAG(11 + ib);
                sc_f32x16 P = {};
                const sc_bf16x8 sb00 = sc_pack8(S0, 0), sb01 = sc_pack8(S0, 8), sb10 = sc_pack8(S1, 0), sb11 = sc_pack8(S1, 8);
                P = __builtin_amdgcn_mfma_f32_32x32x16_bf16(SCM_FRAG(0), sb00, P, 0, 0, 0);
                P = __builtin_amdgcn_mfma_f32_32x32x16_bf16(SCM_FRAG(1), sb01, P, 0, 0, 0);
                P = __builtin_amdgcn_mfma_f32_32x32x16_bf16(SCM_FRAG(2), sb10, P, 0, 0, 0);
                P = __builtin_amdgcn_mfma_f32_32x32x16_bf16(SCM_FRAG(3), sb11, P, 0, 0, 0);
                P = __builtin_amdgcn_mfma_f32_32x32x16_bf16(SCM_FRAG(4), vf, P, 0, 0, 0);
                const sc_bf16x8 xb = sc_pack8(P, 0);
                sc_f32x16 U = {};
                U = __builtin_amdgcn_mfma_f32_32x32x16_bf16(SCM_FRAG(5), xb, U, 0, 0, 0);
                const sc_bf16x8 ub = sc_pack8(U, 0);
                P = __builtin_amdgcn_mfma_f32_32x32x16_bf16(SCM_FRAG(6), ub, P, 0, 0, 0);
                const int c = g * SC_GRP + cc;
#pragma unroll
                for (int r = 8; r < 16; ++r) { const int t = (r & 3) + 8 * ((r >> 2) - 2) + 4 * hi; Yd[(size_t)sc_tau(d, c, t) * A_W + 32 * ib + n] = P[r]; }
                const LAS f32x4* gt = (const LAS f32x4*)(fb + 13 * 1024 + hi * 128);
#pragma unroll
                for (int q = 0; q < 4; ++q) { const f32x4 g0 = gt[q], g1 = gt[4 + q];
#pragma unroll
                    for (int e = 0; e < 4; ++e) { S0[4 * q + e] *= g0[e]; S1[4 * q + e] *= g1[e]; } }
                S0 = __builtin_amdgcn_mfma_f32_32x32x16_bf16(SCM_FRAG(7), ub, S0, 0, 0, 0);
                S0 = __builtin_amdgcn_mfma_f32_32x32x16_bf16(SCM_FRAG(8), vf, S0, 0, 0, 0);
                S1 = __builtin_amdgcn_mfma_f32_32x32x16_bf16(SCM_FRAG(9), ub, S1, 0, 0, 0);
                S1 = __builtin_amdgcn_mfma_f32_32x32x16_bf16(SCM_FRAG(10), vf, S1, 0, 0, 0);
#undef SCM_FRAG
            }
        }
        if (g + 1 < SC_NGRP) SCM_WRITE((g + 1) & 1);
        __syncthreads();
    }
#undef SCM_LOAD
#undef SCM_WRITE
}
__device__ __forceinline__ float conv3_u(const float* PX, int tau, unsigned ucol, float w0, float w1, float w2) {
    const float* p = PX + (size_t)tau * PXW;
    float y = p[ucol] * w1;
    if (has_left(tau)) y += (p - PXW)[ucol] * w0;
    if (has_right(tau)) y += (p + PXW)[ucol] * w2;
    return y;
}
constexpr int WLR_K = 448;
constexpr int RP_WAVE_LDS = 16896;
typedef short rp_bf16x8 __attribute__((ext_vector_type(8)));
typedef float rp_f32x16 __attribute__((ext_vector_type(16)));
__device__ __forceinline__ unsigned short f2bf16(float x) { return (unsigned short)(cvt_pk_bf16(x, x) & 0xffffu); }
template <int NKB, class AF>
__device__ __forceinline__ void rp_lowrank(float (&dst)[16], const AF& afrag, const bf16_t* WLRh, int kw0, int n, int hi) {
    rp_f32x16 c0 = {}, c1 = {}; const bf16_t* wb0 = WLRh + (size_t)n * WLR_K + kw0 + 8 * hi; const bf16_t* wb1 = wb0 + (size_t)32 * WLR_K;
#pragma unroll
    for (int kb = 0; kb < NKB; ++kb) { const rp_bf16x8 b0 = *(const rp_bf16x8*)(wb0 + 16 * kb), b1 = *(const rp_bf16x8*)(wb1 + 16 * kb); const rp_bf16x8 a_ = afrag(kb);
        c0 = __builtin_amdgcn_mfma_f32_32x32x16_bf16(a_, b0, c0, 0, 0, 0); c1 = __builtin_amdgcn_mfma_f32_32x32x16_bf16(a_, b1, c1, 0, 0, 0); }
#pragma unroll
    for (int r = 0; r < 8; ++r) { auto sw = __builtin_amdgcn_permlane32_swap(__float_as_uint(c0[r]), __float_as_uint(c1[r]), false, false);
        dst[(r & 3) + 8 * (r >> 2)] = __uint_as_float(sw[0]); dst[(r & 3) + 8 * (r >> 2) + 4] = __uint_as_float(sw[1]); }
}
struct RpAfLds { const LAS bf16_t* base; __device__ __forceinline__ rp_bf16x8 operator()(int kb) const { return *(const LAS rp_bf16x8*)(base + 16 * kb); } };
__device__ __forceinline__ void rwkv_elem_phase(const Frame& F, unsigned char* ws, int l) {
    const float* PX = (const float*)(ws + WS_PX); float* SS = (float*)(ws + WS_SS); float* SD = (float*)(ws + WS_SD); float* GB = (float*)(ws + WS_G);
    const bf16_t* WLR = (const bf16_t*)(ws + WS_WLR) + (size_t)l * A_W * WLR_K;
    const float* cw = IN_(16) + (size_t)l * 3 * A_IN;
    LAS bf16_t* ACT = (LAS bf16_t*)(F.lds + F.wave * 10752);
    const int lane = F.lane, n = lane & 31, hi = lane >> 5;
    const int gw = F.bid * 8 + F.wave, NGW = F.G * 8;
    for (int it = gw; it < (T / 16) * 10; it += NGW) {
        const int tg = it / 10, hq = it % 10, tau0 = tg * 16;
        asm volatile("s_waitcnt lgkmcnt(0)" ::: "memory");
        const float* prow0 = PX + (size_t)(tau0 > 0 ? tau0 - 1 : 0) * PXW; const int roff = tau0 > 0 ? 0 : -1;
#define RP_WIN(x, ucol_) do { _Pragma("unroll") for (int i_ = 0; i_ < 18; ++i_) { int ri_ = i_ + roff; ri_ = ri_ < 0 ? 0 : ri_; ri_ = (tau0 - 1 + i_ > T - 1) ? (T - 1 - (tau0 > 0 ? tau0 - 1 : 0)) : ri_; x[i_] = (prow0 + (size_t)ri_ * PXW)[ucol_]; } } while (0)
#define RP_CONV(x, t_, w0_, w1_, w2_) (x[(t_)] * (has_left(tau0 + (t_)) ? (w0_) : 0.f) + x[(t_) + 1] * (w1_) + x[(t_) + 2] * (has_right(tau0 + (t_)) ? (w2_) : 0.f))
#pragma unroll
        for (int i = 0; i < 5; ++i) { const int c = lane + 64 * i, col = 3840 + c; const float c0 = cw[col], c1 = cw[A_IN + col], c2 = cw[2 * A_IN + col];
            float x[18]; RP_WIN(x, (unsigned)(PXA + col));
#pragma unroll
            for (int t = 0; t < 16; ++t) { const float val = RP_CONV(x, t, c0, c1, c2);
                const float act = i == 0 ? 1.0f - 2.0f / (1.0f + __expf(2.0f * val)) : (i == 1 ? val : sigmoidf_(val));
                ACT[t * 328 + c] = f2bf16(act); } }
        asm volatile("s_waitcnt lgkmcnt(0)" ::: "memory");
        const RpAfLds afw{ACT + (n & 15) * 328 + 8 * hi}, afa{ACT + (n & 15) * 328 + 64 + 8 * hi}, afg{ACT + (n & 15) * 328 + 128 + 8 * hi};
#pragma unroll 1
        for (int hh = 0; hh < 2; ++hh) {
            const int h = hq * 2 + hh, col = h * 64 + lane; const bf16_t* WLRh = WLR + (size_t)h * 64 * WLR_K;
            { float lg[16]; rp_lowrank<12>(lg, afg, WLRh, 256, n, hi);
#pragma unroll
              for (int t = 0; t < 16; ++t) GB[(size_t)(tau0 + t) * A_W + col] = lg[t]; }
            const float cr0 = cw[col], cr1 = cw[A_IN + col], cr2 = cw[2 * A_IN + col];
            const float ck0 = cw[A_W + col], ck1 = cw[A_IN + A_W + col], ck2 = cw[2 * A_IN + A_W + col];
            const float cv0 = cw[2 * A_W + col], cv1 = cw[A_IN + 2 * A_W + col], cv2 = cw[2 * A_IN + 2 * A_W + col];
            const float kk_w = IN_(22)[l * A_W + col], ka_w = IN_(23)[l * A_W + col];
            float kkv[16], kv[16];
            { float xr[18], xk[18], xv[18]; const unsigned uc = (unsigned)(PXA + col); RP_WIN(xr, uc); RP_WIN(xk, uc + A_W); RP_WIN(xv, uc + 2 * A_W);
#pragma unroll
              for (int t = 0; t < 16; ++t) { const int tau = tau0 + t;
                  const float r = RP_CONV(xr, t, cr0, cr1, cr2), v = RP_CONV(xv, t, cv0, cv1, cv2); kv[t] = RP_CONV(xk, t, ck0, ck1, ck2);
                  const float kr = kv[t] * kk_w; const float nrm = sqrtf(wave_sum(kr * kr)); kkv[t] = kr / fmaxf(nrm, 1e-12f);
                  float* ss = SS + ((size_t)h * T + tau) * 192 + lane; ss[0] = kkv[t]; ss[64] = r; ss[128] = v; } }
#pragma unroll 1
            for (int d = 0; d < 2; ++d) { const float w0b = IN_(17)[(l * 2 + d) * A_W + col], a0b = IN_(19)[(l * 2 + d) * A_W + col]; float lw[16], la[16];
                rp_lowrank<4>(lw, afw, WLRh, 64 * d, n, hi); rp_lowrank<4>(la, afa, WLRh, 128 + 64 * d, n, hi);
#pragma unroll
                for (int t = 0; t < 16; ++t) { const float z = w0b + lw[t]; const float decay = __expf(-__expf(-(fmaxf(-z, 0.f) + __logf(1.0f + __expf(-fabsf(z)))) - 0.5f)); const float av = sigmoidf_(a0b + la[t]);
                    float* sd = SD + (((size_t)h * 2 + d) * T + tau0 + t) * 192 + lane; sd[0] = decay; sd[64] = kkv[t] * av; sd[128] = kv[t] * (1.0f + (av - 1.0f) * ka_w); } }
        }
    }
}
#undef RP_WIN
#undef RP_CONV
constexpr int SP_WAVE_LDS = 16640;
__device__ __forceinline__ void scan_prep_phase(const Frame& F, unsigned char* ws) {
    const float* SS = (const float*)(ws + WS_SS); const float* SD = (const float*)(ws + WS_SD); unsigned char* FR = ws + WS_FR;
    LAS bf16_t* R1 = (LAS bf16_t*)(F.lds + F.wave * SP_WAVE_LDS); LAS bf16_t* R2 = R1 + 32 * 72; LAS bf16_t* BbT = R2 + 32 * 72; LAS bf16_t* KbT = BbT + 64 * 16; LAS bf16_t* VT = KbT + 64 * 16; LAS float* Lm = (LAS float*)(VT + 64 * 16);
    const int lane = F.lane, n = lane & 31, hi = lane >> 5;
    const int gw = F.bid * 8 + F.wave, NGW = F.G * 8;
    for (int it = gw; it < 2 * NHA * SC_NCHUNK; it += NGW) {
        const int chain = it / SC_NCHUNK, c = it % SC_NCHUNK, h = chain >> 1, d = chain & 1;
        const int tau_first = sc_tau(d, c, 0), dstep = d ? -1 : 1;
        const float* ssb = SS + (size_t)h * T * 192 + lane; const float* sdb = SD + ((size_t)h * 2 + d) * T * 192 + lane;
        float xw[16], xb[16], xk[16], xkk[16], xr[16], xv[16];
#pragma unroll
        for (int s = 0; s < 16; ++s) { const size_t o = (size_t)(tau_first + dstep * s) * 192; xw[s] = sdb[o]; xb[s] = sdb[o + 64]; xk[s] = sdb[o + 128]; xkk[s] = ssb[o]; xr[s] = ssb[o + 64]; xv[s] = ssb[o + 128]; }
        float gC = 1.f;
#pragma unroll
        for (int s = 0; s < 16; ++s) gC *= xw[s];
        float g = 1.f;
#pragma unroll
        for (int s = 0; s < 16; ++s) {
            const float gm1 = g; g *= xw[s]; const float ig = 1.0f / g; const float bh = xb[s] * ig, kh = xk[s] * ig;
            R1[s * 72 + lane] = f2bf16(-xkk[s] * gm1); R1[(16 + s) * 72 + lane] = f2bf16(xr[s] * g);
            R2[s * 72 + lane] = f2bf16(bh); R2[(16 + s) * 72 + lane] = f2bf16(kh);
            BbT[lane * 16 + s] = f2bf16(bh * gC); KbT[lane * 16 + s] = f2bf16(kh * gC); VT[lane * 16 + s] = f2bf16(xv[s]); }
        asm volatile("s_waitcnt lgkmcnt(0)" ::: "memory");
        unsigned char* dst = FR + ((size_t)chain * SC_NCHUNK + c) * SC_CHUNK_BYTES;
        rp_f32x16 C = {};
#pragma unroll
        for (int kb = 0; kb < 4; ++kb) { const rp_bf16x8 a_ = *(const LAS rp_bf16x8*)(R2 + n * 72 + 16 * kb + 8 * hi), b_ = *(const LAS rp_bf16x8*)(R1 + n * 72 + 16 * kb + 8 * hi);
            C = __builtin_amdgcn_mfma_f32_32x32x16_bf16(a_, b_, C, 0, 0, 0); }
        const int tt_ = n & 15; const bool incl = n >= 16;
#pragma unroll
        for (int r = 0; r < 16; ++r) { const int s = ((r & 7) & 3) + 8 * ((r & 7) >> 2) + 4 * hi; if (!(s < tt_ || (incl && s == tt_))) C[r] = 0.f; }
        if (n < 16) {
#pragma unroll
            for (int r = 0; r < 8; ++r) Lm[((r & 3) + 8 * (r >> 2) + 4 * hi) * 20 + n] = C[r]; }
        { u32x4 f4; f4.x = cvt_pk_bf16(C[8], C[9]); f4.y = cvt_pk_bf16(C[10], C[11]); f4.z = cvt_pk_bf16(C[12], C[13]); f4.w = cvt_pk_bf16(C[14], C[15]);
          u32x4 f6; f6.x = cvt_pk_bf16(C[0], C[1]); f6.y = cvt_pk_bf16(C[2], C[3]); f6.z = cvt_pk_bf16(C[4], C[5]); f6.w = cvt_pk_bf16(C[6], C[7]);
          if (n < 16) f6 = (u32x4){0u, 0u, 0u, 0u};
          *(u32x4*)(dst + 4 * 1024 + lane * 16) = f4; *(u32x4*)(dst + 6 * 1024 + lane * 16) = f6; }
        asm volatile("s_waitcnt lgkmcnt(0)" ::: "memory");
        { float Tc[16];
#pragma unroll
          for (int s = 15; s >= 0; --s) { float acc = (s == n) ? 1.f : 0.f;
#pragma unroll
              for (int u = s + 1; u < 16; ++u) acc += Lm[s * 20 + u] * Tc[u];
              Tc[s] = acc; }
          u32x4 f5; f5.x = cvt_pk_bf16(hi ? Tc[4] : Tc[0], hi ? Tc[5] : Tc[1]); f5.y = cvt_pk_bf16(hi ? Tc[6] : Tc[2], hi ? Tc[7] : Tc[3]);
          f5.z = cvt_pk_bf16(hi ? Tc[12] : Tc[8], hi ? Tc[13] : Tc[9]); f5.w = cvt_pk_bf16(hi ? Tc[14] : Tc[10], hi ? Tc[15] : Tc[11]);
          if (n >= 16) f5 = (u32x4){0u, 0u, 0u, 0u};
          *(u32x4*)(dst + 5 * 1024 + lane * 16) = f5; }
#pragma unroll
        for (int f = 0; f < 4; ++f) { const u32x2 p0 = *(const LAS u32x2*)(R1 + n * 72 + 16 * f + 4 * hi), p1 = *(const LAS u32x2*)(R1 + n * 72 + 16 * f + 8 + 4 * hi);
            *(u32x4*)(dst + f * 1024 + lane * 16) = (u32x4){p0.x, p0.y, p1.x, p1.y}; }
#pragma unroll
        for (int jb = 0; jb < 2; ++jb) { const int row = 32 * jb + n;
            const u32x2 b0 = *(const LAS u32x2*)(BbT + row * 16 + 4 * hi), b1 = *(const LAS u32x2*)(BbT + row * 16 + 8 + 4 * hi), k0 = *(const LAS u32x2*)(KbT + row * 16 + 4 * hi), k1 = *(const LAS u32x2*)(KbT + row * 16 + 8 + 4 * hi);
            const u32x2 v0 = *(const LAS u32x2*)(VT + row * 16 + 4 * hi), v1 = *(const LAS u32x2*)(VT + row * 16 + 8 + 4 * hi);
            *(u32x4*)(dst + (7 + 2 * jb) * 1024 + lane * 16) = (u32x4){b0.x, b0.y, b1.x, b1.y}; *(u32x4*)(dst + (8 + 2 * jb) * 1024 + lane * 16) = (u32x4){k0.x, k0.y, k1.x, k1.y};
            *(u32x4*)(dst + (11 + jb) * 1024 + lane * 16) = (u32x4){v0.x, v0.y, v1.x, v1.y}; }
        { const int jj = lane & 31; ((float*)(dst + 13 * 1024))[((jj >> 2) & 1) * 32 + (lane >> 5) * 16 + (jj & 3) + 4 * (jj >> 3)] = gC; }
        asm volatile("s_waitcnt lgkmcnt(0)" ::: "memory");
    }
}
__device__ __forceinline__ void mixer_phase(const Frame& F0, unsigned char* ws0, int lq, bool need_ctx, char* lds_g) {
    const int l = lq & 3;
#ifndef MK_MIX
#define MK_MIX 15
#endif
    { const Frame F = opq(F0); unsigned char* ws = opq_ptr(ws0);
      if (MK_MIX & 1) for (int chain = F.bid; chain < 2 * NHA; chain += F.G) scan_chain_mfma(F, ws, chain); }
    const Frame& F = F0;
    const int n_att = 32 * NHC, n_hy = 640, n_ca = need_ctx ? NHC : 0, n_ch = need_ctx ? 160 : 0, total = n_att + n_hy + n_ca + n_ch;
    unsigned* qhead = (unsigned*)(ws0 + WS_CTL) + CW_QUEUE + 64 * lq;
    for (;;) {
        if (F.tid == 0) F.MISC[16] = __hip_atomic_fetch_add(qhead, 1u, __ATOMIC_RELAXED, __HIP_MEMORY_SCOPE_AGENT);
        __syncthreads();
        const int item = (int)F.MISC[16];
        __syncthreads();
        if (item >= total) break;
        const Frame Fu = opq(F0); unsigned char* ws = opq_ptr(ws0);
        const bf16_t* QF = (const bf16_t*)(ws + WS_QF); const bf16_t* KF = (const bf16_t*)(ws + WS_KF); const bf16_t* KVRAW = (const bf16_t*)(ws + WS_KVRAW); bf16_t* OB = (bf16_t*)(ws + WS_OBUF);
        const bool is_xa = item < n_att, is_ca = item >= n_att + n_hy && item < n_att + n_hy + n_ca;
        if ((MK_MIX & 2) && (is_xa || is_ca)) { const int h = is_xa ? item % NHC : item - n_att - n_hy, row0 = is_xa ? NCTX + (item / NHC) * 256 : 0;
            for (int rp = 0; rp < REP(13); ++rp) att::attn_body(QF + (size_t)row0 * NQ + h * 192, KF + h * 192, KVRAW + h * 256 + 128, OB + (size_t)row0 * DM + 2560 + h * 128, is_xa ? T : NCTX, lds_g); }
        else if ((MK_MIX & 4) && item >= n_att && item < n_att + n_hy) { for (int rp = 0; rp < REP(12); ++rp) hyena_unit(Fu, ws, l, item - n_att); }
        else if ((MK_MIX & 8) && item >= n_att + n_hy + n_ca) hyena_ctx_unit(Fu, ws, l, item - n_att - n_hy - n_ca);
    }
}

constexpr int NPH = 2 + 14 * NL;
__global__ void __launch_bounds__(512, 2) mk_fwd(Args a) {
    extern __shared__ __attribute__((aligned(16))) unsigned char lds[];
    Frame F; F.lds = (LAS unsigned char*)lds; F.MISC = (volatile LAS unsigned*)(F.lds + LDS_MISC);
    F.tid = threadIdx.x; F.lane = F.tid & 63; F.wave = __builtin_amdgcn_readfirstlane(F.tid >> 6); F.bid = blockIdx.x; F.G = gridDim.x;
    if (F.tid < 64) F.MISC[F.tid] = 0u;
    if (F.tid < 46) *(LAS unsigned long long*)(F.lds + LDS_PTAB + 8 * F.tid) = (unsigned long long)(uintptr_t)a.in[F.tid];
    __syncthreads();
    unsigned char* ws = a.ws;
    XcdBarrier bar = xcd_barrier_post((unsigned*)(ws + WS_CTL) + CW_BAR, F.MISC + 8);
    const int lo = a.ph_lo, hi = a.ph_hi;
#ifndef MK_MASK
#define MK_MASK 0xffff
#endif
#define EN(x) (((MK_MASK) >> (x)) & 1)
#define IN(k) (lo <= (k) && (k) < hi)
#define SEAM(k) do { if (IN(k) && IN((k) + 1)) xcd_barrier(bar); } while (0)
#define WSP opq_ptr(ws)
#define P_XS(w) ((float*)((w) + WS_XS))
#define P_ABUF(w) ((bf16_t*)((w) + WS_ABUF))
#define P_HBUF(w) ((bf16_t*)((w) + WS_HBUF))
#define P_OBUF(w) ((bf16_t*)((w) + WS_OBUF))
#define P_MODX(w, l) ((const float*)((w) + WS_MOD) + ((size_t)(l) * 2 + 0) * NMOD)
#define P_MODC(w, l) ((const float*)((w) + WS_MOD) + ((size_t)(l) * 2 + 1) * NMOD)
#define P_WL(w, l) ((const bf16_t*)((w) + WS_WB) + (size_t)(l) * W_LAYER)
    if (EN(0) && IN(0)) for (int rp = 0; rp < REP(0); ++rp) phase0(opq(F), opq_ptr(ws));
    SEAM(0);
    if (EN(1) && IN(1)) phase_mod(opq(F), opq_ptr(ws));
    SEAM(1);
#pragma unroll 1
    for (int l = 0; l < NL; ++l) {
        const int pb = 2 + 14 * l; const bool need_ctx = l < NL - 1;
        if (EN(2) && IN(pb + 0)) for (int rp = 0; rp < REP(2); ++rp) { unsigned char* w = WSP; norm_phase(opq(F), P_XS(w), IN_(7) + l * DM, P_MODX(w, l), P_MODC(w, l), 0, 1, P_ABUF(w), l > 0 ? (const float*)(w + WS_SLAB) : nullptr, l > 0 ? P_MODC(w, l - 1) + 8 * DM : nullptr, 0.5f); }
        SEAM(pb + 0);
        if (EN(3) && IN(pb + 1)) { unsigned char* w = WSP; pg8::Gemm g{P_ABUF(w), P_WL(w, l) + W_G1, T, 2 * FF, DM, DM}; pg8::StaticOrder S; S.init(T, 2 * FF, F.G, F.bid); pg8::EpiSwiGLU E{P_HBUF(w), FF};
            pg8::gemm_phase<pg8::EpiSwiGLU, pg8::StaticOrder>(F.lds, g, S, E, nullptr); }
        SEAM(pb + 1);
        if (EN(4) && IN(pb + 2)) {
            { unsigned char* w = WSP; pg8::Gemm g{P_HBUF(w), P_WL(w, l) + W_D1, T, DM, FF, FF}; pg8::StaticOrderX S; S.init(T, DM, F.G, F.bid); pg8::EpiResid E{P_XS(w), P_MODX(w, l) + 2 * DM, P_MODC(w, l) + 2 * DM, 0.5f, nullptr};
              pg8::gemm_phase<pg8::EpiResid, pg8::StaticOrderX>(F.lds, g, S, E, nullptr); }
            if (true) { __syncthreads();
              if (F.bid < 256) { unsigned char* w = WSP; const int ks = F.bid >> 4, ksz = FF / 16; pg8::Gemm g{P_HBUF(w) + ks * ksz, P_WL(w, l) + W_D1 + ks * ksz, NCTX, DM, ksz, FF}; pg8::OneUnit S{F.bid & 15};
                  pg8::EpiF32 E{(float*)(w + WS_SLAB) + (size_t)ks * NCTX * DM, DM, nullptr};
                  pg8::gemm_phase<pg8::EpiF32, pg8::OneUnit>(F.lds, g, S, E, nullptr); } }
        }
        SEAM(pb + 2);
        if (EN(5) && IN(pb + 3)) for (int rp = 0; rp < REP(2); ++rp) { unsigned char* w = WSP; norm_phase(opq(F), P_XS(w), IN_(8) + l * DM, P_MODX(w, l), P_MODC(w, l), 3, 4, P_ABUF(w), (const float*)(w + WS_SLAB), P_MODC(w, l) + 2 * DM, 0.5f); }
        SEAM(pb + 3);
        if (EN(6) && IN(pb + 4)) { unsigned char* w = WSP; pg8::Gemm g{P_ABUF(w), P_WL(w, l) + W_IN, T, PXW, DM, DM}; pg8::StaticOrder S; S.init(T, PXW, F.G, F.bid); pg8::EpiF32 E{(float*)(w + WS_PX), PXW, nullptr};
            pg8::gemm_phase<pg8::EpiF32, pg8::StaticOrder>(F.lds, g, S, E, nullptr); }
        SEAM(pb + 4);
        if (EN(7) && IN(pb + 5)) { for (int rp = 0; rp < REP(7); ++rp) rwkv_elem_phase(opq(F), opq_ptr(ws), l); if (!(MK_ONLYRP)) { for (int rp = 0; rp < REP(8); ++rp) mla_prep_phase(opq(F), opq_ptr(ws), l); hyena_prep_phase(opq(F), opq_ptr(ws), l); } }
        SEAM(pb + 5);
        if (EN(8) && IN(pb + 6)) {
            { unsigned char* w = WSP; pg8::Gemm g{(const bf16_t*)(w + WS_QA), P_WL(w, l) + W_Q, T, NQ, 1024, 1024}; pg8::StaticOrder S; S.init(T, NQ, F.G, F.bid); pg8::EpiBf16<0> E{(bf16_t*)(w + WS_QRAW), NQ, nullptr, 0, 0};
              pg8::gemm_phase<pg8::EpiBf16<0>, pg8::StaticOrder>(F.lds, g, S, E, nullptr); }
            __syncthreads();
            { unsigned char* w = WSP; pg8::Gemm g{(const bf16_t*)(w + WS_KVA), P_WL(w, l) + W_KV, T, NKV, 512, 512}; pg8::StaticOrder S; S.init(T, NKV, F.G, F.bid); pg8::EpiBf16<0> E{(bf16_t*)(w + WS_KVRAW), NKV, nullptr, 0, 0};
              pg8::gemm_phase<pg8::EpiBf16<0>, pg8::StaticOrder>(F.lds, g, S, E, nullptr); }
        }
        SEAM(pb + 6);
        if (EN(9) && IN(pb + 7)) { for (int rp = 0; rp < REP(8); ++rp) qkv_final_phase(opq(F), opq_ptr(ws), l, need_ctx); for (int rp = 0; rp < REP(9); ++rp) scan_prep_phase(opq(F), opq_ptr(ws)); }
        SEAM(pb + 7);
        if (EN(10) && IN(pb + 8)) for (int rp = 0; rp < REP(10); ++rp) mixer_phase(F, ws, l + 4 * rp, need_ctx, (char*)lds);
        SEAM(pb + 8);
        if (EN(11) && IN(pb + 9)) { for (int rp = 0; rp < REP(8); ++rp) rwkv_out_phase(opq(F), opq_ptr(ws), l, need_ctx); hyena_out_phase(opq(F), opq_ptr(ws), need_ctx); }
        SEAM(pb + 9);
        if (EN(12) && IN(pb + 10)) {
            { unsigned char* w = WSP; pg8::Gemm g{P_OBUF(w), P_WL(w, l) + W_OUT, T, DM, DM, DM}; pg8::StaticOrderX S; S.init(T, DM, F.G, F.bid); pg8::EpiResid E{P_XS(w), P_MODX(w, l) + 5 * DM, P_MODC(w, l) + 5 * DM, 1.0f, nullptr};
              pg8::gemm_phase<pg8::EpiResid, pg8::StaticOrderX>(F.lds, g, S, E, nullptr); }
            if (need_ctx) { __syncthreads();
              if (F.bid < 256) { unsigned char* w = WSP; const int ks = F.bid >> 4, ksz = DM / 16; pg8::Gemm g{P_OBUF(w) + ks * ksz, P_WL(w, l) + W_OUT + ks * ksz, NCTX, DM, ksz, DM}; pg8::OneUnit S{F.bid & 15};
                  pg8::EpiF32 E{(float*)(w + WS_SLAB) + (size_t)ks * NCTX * DM, DM, nullptr};
                  pg8::gemm_phase<pg8::EpiF32, pg8::OneUnit>(F.lds, g, S, E, nullptr); } }
        }
        SEAM(pb + 10);
        if (EN(13) && IN(pb + 11)) for (int rp = 0; rp < REP(2); ++rp) { unsigned char* w = WSP; norm_phase(opq(F), P_XS(w), IN_(9) + l * DM, P_MODX(w, l), P_MODC(w, l), 6, 7, P_ABUF(w), need_ctx ? (const float*)(w + WS_SLAB) : nullptr, P_MODC(w, l) + 5 * DM, 1.0f); }
        SEAM(pb + 11);
        if (EN(14) && IN(pb + 12)) { if (need_ctx) { unsigned char* w = WSP; pg8::Gemm g{P_ABUF(w), P_WL(w, l) + W_G2, T, 2 * FF, DM, DM}; pg8::StaticOrder S; S.init(T, 2 * FF, F.G, F.bid); pg8::EpiSwiGLU E{P_HBUF(w), FF};
            pg8::gemm_phase<pg8::EpiSwiGLU, pg8::StaticOrder>(F.lds, g, S, E, nullptr); } else { unsigned char* w = WSP; pg8::Gemm g{P_ABUF(w), P_WL(w, l) + W_G2, T, 2 * FF, DM, DM}; pg8::StaticOrderX S; S.init(T, 2 * FF, F.G, F.bid); pg8::EpiSwiGLU E{P_HBUF(w), FF};
            pg8::gemm_phase<pg8::EpiSwiGLU, pg8::StaticOrderX>(F.lds, g, S, E, nullptr); } }
        SEAM(pb + 12);
        if (EN(15) && IN(pb + 13)) {
            { unsigned char* w = WSP; pg8::Gemm g{P_HBUF(w), P_WL(w, l) + W_D2, T, DM, FF, FF}; pg8::StaticOrderX S; S.init(T, DM, F.G, F.bid); pg8::EpiResid E{P_XS(w), P_MODX(w, l) + 8 * DM, P_MODC(w, l) + 8 * DM, 0.5f, l == NL - 1 ? a.out : nullptr};
              pg8::gemm_phase<pg8::EpiResid, pg8::StaticOrderX>(F.lds, g, S, E, nullptr); }
            if (need_ctx) { __syncthreads();
              if (F.bid < 256) { unsigned char* w = WSP; const int ks = F.bid >> 4, ksz = FF / 16; pg8::Gemm g{P_HBUF(w) + ks * ksz, P_WL(w, l) + W_D2 + ks * ksz, NCTX, DM, ksz, FF}; pg8::OneUnit S{F.bid & 15};
                  pg8::EpiF32 E{(float*)(w + WS_SLAB) + (size_t)ks * NCTX * DM, DM, nullptr};
                  pg8::gemm_phase<pg8::EpiF32, pg8::OneUnit>(F.lds, g, S, E, nullptr); } }
        }
        SEAM(pb + 13);
    }
#undef IN
#undef SEAM
}

#ifndef MK_LAUNCHES
#define MK_LAUNCHES 1
#endif
extern "C" void kernel_launch(void* const* d_in, const int* in_sizes, int n_in, void* d_out, int out_size, void* d_ws, size_t ws_size, hipStream_t stream) {
    static int grid = 0;
    if (grid == 0) {
        if (n_in != 46 || in_sizes[0] != SEQ * DM || out_size != SEQ * DM || ws_size < WS_END) {
            fprintf(stderr, "kernel_launch: shape mismatch: n_in %d in0 %d out %d ws %zu (need %zu); nothing launched\n", n_in, n_in > 0 ? in_sizes[0] : -1, out_size, ws_size, (size_t)WS_END); grid = -1; return; }
        int dev = 0, cus = 0, per_cu = 0;
        if (hipGetDevice(&dev) != hipSuccess || hipDeviceGetAttribute(&cus, hipDeviceAttributeMultiprocessorCount, dev) != hipSuccess) { fprintf(stderr, "kernel_launch: device query failed\n"); grid = -1; return; }
        if (hipFuncSetAttribute((const void*)mk_fwd, hipFuncAttributeMaxDynamicSharedMemorySize, LDS_BYTES) != hipSuccess) { fprintf(stderr, "kernel_launch: hipFuncSetAttribute failed\n"); grid = -1; return; }
        if (hipOccupancyMaxActiveBlocksPerMultiprocessor(&per_cu, (const void*)mk_fwd, 512, LDS_BYTES) != hipSuccess || per_cu < 1) fprintf(stderr, "kernel_launch: note: occupancy query reports %d blocks per CU\n", per_cu);
        (void)hipGetLastError();
        grid = cus;
    }
    if (grid < 0) return;
    if (hipMemsetAsync((char*)d_ws + WS_CTL, 0, CTL_BYTES, stream) != hipSuccess) { fprintf(stderr, "kernel_launch: memset failed\n"); return; }
    Args a{};
    for (int i = 0; i < 46; ++i) a.in[i] = (const float*)d_in[i];
    a.out = (float*)d_out; a.ws = (unsigned char*)d_ws;
#if MK_LAUNCHES == 1
    a.ph_lo = 0; a.ph_hi = NPH;
    hipLaunchKernelGGL(mk_fwd, dim3(grid), dim3(512), LDS_BYTES, stream, a);
#else
    for (int p = 0; p < NPH; ++p) { a.ph_lo = p; a.ph_hi = p + 1; hipLaunchKernelGGL(mk_fwd, dim3(grid), dim3(512), LDS_BYTES, stream, a); }
#endif
    const hipError_t le = hipPeekAtLastError();
    if (le != hipSuccess) fprintf(stderr, "kernel_launch: launch failed: %s\n", hipGetErrorName(le));
}
```

```cpp
#include <hip/hip_runtime.h>
#include <stdint.h>
#include <cstdio>

#define LAS __attribute__((address_space(3)))
#define CAS __attribute__((address_space(4)))
typedef unsigned short bf16_t;
typedef float f32x4 __attribute__((ext_vector_type(4)));
typedef float f32x2 __attribute__((ext_vector_type(2)));
typedef unsigned u32x4 __attribute__((ext_vector_type(4)));
typedef unsigned u32x2 __attribute__((ext_vector_type(2)));

constexpr int T = 8448, NCTX = 256, SEQ = 8192, DM = 4096, FF = 6144, NL = 4;
constexpr int A_W = 1280, A_IN = 4160, B_IN = 3840, C_IN = 1600, NHA = 20;
constexpr int PXW = 9728, PXA = 0, PXB = 4160, PXC = 8000;
constexpr int NQ = 2304, NKV = 3072, NHC = 12;
constexpr int NMOD = 9 * DM;
constexpr float NORM_EPS = 1e-6f, GN_EPS = 64e-5f;

constexpr size_t MiB = 1u << 20;
constexpr size_t al(size_t x) { return (x + MiB - 1) / MiB * MiB; }
constexpr size_t WS_CTL = 0, CTL_BYTES = MiB;
constexpr size_t WS_XS = WS_CTL + CTL_BYTES;
constexpr size_t WS_ABUF = WS_XS + al((size_t)T * DM * 4);
constexpr size_t WS_HBUF = WS_ABUF + al((size_t)T * DM * 2);
constexpr size_t WS_OBUF = WS_HBUF + al((size_t)T * FF * 2);
constexpr size_t WS_PX = WS_OBUF + al((size_t)T * DM * 2);
constexpr size_t WS_MOD = WS_PX + al((size_t)T * PXW * 4);
constexpr size_t WS_HP = WS_MOD + al((size_t)NL * 2 * NMOD * 4);
constexpr size_t WS_SS = WS_HP + MiB;
constexpr size_t WS_SD = WS_SS + al((size_t)NHA * T * 192 * 4);
constexpr size_t WS_WLR = WS_SD + al((size_t)NHA * 2 * T * 192 * 4);
constexpr size_t WS_G = WS_WLR + al((size_t)NL * A_W * 448 * 2);
constexpr size_t WS_Y = WS_G + al((size_t)T * A_W * 4);
constexpr size_t WS_QA = WS_Y + al((size_t)2 * T * A_W * 4);
constexpr size_t WS_KVA = WS_QA + al((size_t)T * 1024 * 2);
constexpr size_t WS_KPE = WS_KVA + al((size_t)T * 512 * 2);
constexpr size_t WS_QRAW = WS_KPE + al((size_t)T * 64 * 2);
constexpr size_t WS_KVRAW = WS_QRAW + al((size_t)T * NQ * 2);
constexpr size_t WS_QF = WS_KVRAW + al((size_t)T * NKV * 2);
constexpr size_t WS_KF = WS_QF + al((size_t)T * NQ * 2);
constexpr size_t WS_H3 = WS_KF + al((size_t)T * NQ * 2);
constexpr size_t WS_HSCR = WS_H3 + al((size_t)NL * T * 64 * 4);
constexpr size_t WS_FR = WS_HSCR + al((size_t)256 * 16384 * 8);
constexpr size_t WS_GT = WS_FR + al((size_t)40 * 528 * (14 * 1024));
constexpr size_t WS_X0T = WS_GT + al((size_t)1280 * T * 4);
constexpr size_t WS_SLAB = WS_X0T + al((size_t)1280 * T * 4);
constexpr size_t WS_WB = WS_SLAB + al((size_t)16 * 256 * 4096 * 4);
constexpr size_t W_G1 = 0, W_D1 = W_G1 + (size_t)2 * FF * DM, W_IN = W_D1 + (size_t)DM * FF, W_OUT = W_IN + (size_t)PXW * DM, W_G2 = W_OUT + (size_t)DM * DM,
                 W_D2 = W_G2 + (size_t)2 * FF * DM, W_Q = W_D2 + (size_t)DM * FF, W_KV = W_Q + (size_t)NQ * 1024, W_LAYER = W_KV + (size_t)NKV * 512;
constexpr size_t WS_END = WS_WB + al(W_LAYER * NL * 2);
constexpr int CW_BAR = 4096;
constexpr int CW_QUEUE = 8192;

constexpr int LDS_MISC = 143360, LDS_BYTES = 147456;

__device__ __forceinline__ float wave_sum(float v) {
#pragma unroll
    for (int o = 1; o < 64; o <<= 1) v += __shfl_xor(v, o);
    return v;
}
typedef __bf16 bf16x2_t __attribute__((ext_vector_type(2)));
__device__ __forceinline__ unsigned cvt_pk_bf16(float lo, float hi) { const f32x2 v = {lo, hi}; return __builtin_bit_cast(unsigned, __builtin_convertvector(v, bf16x2_t)); }
__device__ __forceinline__ float bf2f(unsigned short b) { return __uint_as_float(((unsigned)b) << 16); }
__device__ __forceinline__ float sigmoidf_(float x) { return 1.0f / (1.0f + __expf(-x)); }
__device__ __forceinline__ float siluf_(float x) { return x / (1.0f + __expf(-x)); }
__device__ __forceinline__ bool has_left(int tau) { return tau != 0 && tau != NCTX; }
__device__ __forceinline__ bool has_right(int tau) { return tau != NCTX - 1 && tau != T - 1; }

struct Args { const float* in[46]; float* out; unsigned char* ws; int ph_lo, ph_hi; };
struct Frame { LAS unsigned char* lds; volatile LAS unsigned* MISC; int tid, lane, wave, bid, G; };
constexpr int LDS_PTAB = LDS_MISC + 2048;
__device__ __forceinline__ const float* inp(const Frame& F, int i) {
    const volatile LAS unsigned* p = (const volatile LAS unsigned*)(F.lds + LDS_PTAB) + 2 * i;
    const unsigned lo = __builtin_amdgcn_readfirstlane(p[0]), hi = __builtin_amdgcn_readfirstlane(p[1]);
    return (const float*)(((unsigned long long)hi << 32) | lo);
}
#define IN_(i) inp(F, (i))
__device__ __forceinline__ Frame opq(const Frame& F) { Frame G = F; asm volatile("" : "+v"(G.tid), "+s"(G.wave), "+s"(G.bid)); G.lane = G.tid & 63; return G; }
__device__ __forceinline__ unsigned char* opq_ptr(unsigned char* p) { asm volatile("" : "+s"(p)); return p; }
#ifndef MK_REP
#define MK_REP 0
#endif
#ifndef MK_ONLYRP
#define MK_ONLYRP 0
#endif
#define REP(x) (1 + (((MK_REP) >> (x)) & 1))
#define XB_TMO      128
#define XB_XCNT(j)  (256  + 64 * (j))
#define XB_XSUB(j)  (1280 + 64 * (j))
#define XB_XGEN(j)  (2304 + 64 * (j))
#define XB_TOP      3328
#define XB_TOPGEN   3392
#define XCD_BAR_WORDS 3456
#define XB_SPIN_CAP (1u << 18)

__device__ __forceinline__ unsigned xb_ld(unsigned* p)              { return __hip_atomic_load(p, __ATOMIC_RELAXED, __HIP_MEMORY_SCOPE_AGENT); }
__device__ __forceinline__ unsigned xb_add(unsigned* p, unsigned v) { return __hip_atomic_fetch_add(p, v, __ATOMIC_RELAXED, __HIP_MEMORY_SCOPE_AGENT); }
__device__ __forceinline__ unsigned xb_xcc_id() { return (unsigned)__builtin_amdgcn_s_getreg((3 << 11) | 20) & 0xFu; }
#define XB_SPIN(cond, bar) do { unsigned _sp = 0; while (cond) { __builtin_amdgcn_s_sleep(1); \
    if ((++_sp & 255u) == 0u) { if (xb_ld(&(bar)[XB_TMO])) break; if (_sp > XB_SPIN_CAP) { atomicAdd(&(bar)[XB_TMO], 1u); break; } } } } while (0)

struct XcdBarrier {
    unsigned* bar; unsigned x;
    volatile LAS unsigned* st;
};

__device__ __forceinline__ XcdBarrier xcd_barrier_post(unsigned* bar, volatile LAS unsigned* st) {
    XcdBarrier b; b.bar = bar; b.x = xb_xcc_id(); b.st = st;
    if (threadIdx.x == 0) (void)xb_add(&bar[XB_XCNT(b.x)], 1u);
    return b;
}
__device__ __forceinline__ void xcd_barrier_complete(unsigned* bar, unsigned x, unsigned& nloc, unsigned& nx) {
    const unsigned G = gridDim.x * gridDim.y * gridDim.z;
    unsigned sum, cnt, mine, sp = 0u;
    for (;;) {
        sum = 0u; cnt = 0u; mine = 0u;
#pragma unroll
        for (unsigned j = 0; j < 16; ++j) { const unsigned c = xb_ld(&bar[XB_XCNT(j)]); sum += c; cnt += (c > 0u) ? 1u : 0u; mine = (j == x) ? c : mine; }
        if (sum == G) break;
        __builtin_amdgcn_s_sleep(1);
        if ((++sp & 255u) == 0u) { if (xb_ld(&bar[XB_TMO])) break; if (sp > XB_SPIN_CAP) { atomicAdd(&bar[XB_TMO], 1u); break; } }
    }
    nloc = mine > 0u ? mine : 1u; nx = cnt > 0u ? cnt : 1u;
}

__device__ __forceinline__ void xcd_barrier(const XcdBarrier& b) {
    asm volatile("s_waitcnt vmcnt(0)" ::: "memory");
    __syncthreads();
    if (threadIdx.x == 0) {
        unsigned* bar = b.bar;
        __builtin_amdgcn_s_waitcnt(0);
        unsigned nloc = b.st[0], nx = b.st[1];
        if (nloc == 0u) { xcd_barrier_complete(bar, b.x, nloc, nx); b.st[0] = nloc; b.st[1] = nx; }
        const unsigned old = xb_add(&bar[XB_XSUB(b.x)], 1u);
        const unsigned gen = old / nloc;
        if (old + 1u == (gen + 1u) * nloc) {
            __builtin_amdgcn_fence(__ATOMIC_RELEASE, "agent");
            asm volatile("s_waitcnt vmcnt(0)" ::: "memory");
            const unsigned og = xb_add(&bar[XB_TOP], 1u);
            const unsigned tg = og / nx;
            if (og + 1u == (tg + 1u) * nx) xb_add(&bar[XB_TOPGEN], 1u);
            else XB_SPIN(xb_ld(&bar[XB_TOPGEN]) == tg, bar);
            __builtin_amdgcn_fence(__ATOMIC_ACQUIRE, "agent");
            xb_add(&bar[XB_XGEN(b.x)], 1u);
            asm volatile("s_waitcnt vmcnt(0)" ::: "memory");
        } else {
            XB_SPIN(xb_ld(&bar[XB_XGEN(b.x)]) == gen, bar);
            __builtin_amdgcn_fence(__ATOMIC_ACQUIRE, "agent");
            asm volatile("s_waitcnt vmcnt(0)" ::: "memory");
        }
    }
    __syncthreads();
}
namespace pg8 {
#define PG8_LAS __attribute__((address_space(3)))
typedef unsigned short bf16_t;
typedef short bf16x8 __attribute__((ext_vector_type(8)));
typedef float f32x4 __attribute__((ext_vector_type(4)));
typedef unsigned u32x4 __attribute__((ext_vector_type(4)));
constexpr int BM = 256, BK = 64, HALF = 128, HTB = HALF * BK * 2  , STAGE_BYTES = 8 * HTB, NXCD = 8, WGM = 8;

__host__ __device__ __forceinline__ int lds_byte(int r, int c) { const int st = (r >> 4) * 2 + (c >> 5), rr = r & 15, cc = c & 31, ob = rr * 64 + cc * 2; return st * 1024 + (ob ^ (((ob >> 9) & 1) << 5)); }
__host__ __device__ __forceinline__ void stage_rc(int b, int& R, int& C) { const int st = b / 1024, sb = b % 1024, swz = sb ^ (((sb >> 9) & 1) << 5); R = (st >> 1) * 16 + swz / 64; C = (st & 1) * 32 + (swz % 64) / 2; }
__host__ __device__ __forceinline__ int perm32(int rho) { const int n = rho >> 4, i = rho & 15; return 8 * (i >> 2) + 4 * n + (i & 3); }

struct Unit { int pm, pn; };
struct Gemm { const bf16_t* A; const bf16_t* Bt; int M, N, K, ld; };

struct StaticOrder {
    int nM, nN, nwg, G, c;
    __host__ __device__ void init(int M, int N, int G_, int c_) { nM = M / BM; nN = N / BM; nwg = nM * nN; G = G_; c = c_; }
    __host__ __device__ bool next(int i, Unit& u) const {
        const long L = (long)i * G + c; if (L >= nwg) return false;
        int wgid = (int)L; { const int q = nwg / NXCD, r = nwg % NXCD, xcd = wgid % NXCD, off = wgid / NXCD; wgid = (xcd < r ? xcd * (q + 1) : r * (q + 1) + (xcd - r) * q) + off; }
        const int nig = WGM * nN, gid = wgid / nig, fm = gid * WGM, gsz = (nM - fm) < WGM ? (nM - fm) : WGM;
        u.pm = fm + ((wgid % nig) % gsz); u.pn = (wgid % nig) / gsz; return true;
    }
    __device__ __forceinline__ void a_ready(const Unit&) const {}
    __device__ __forceinline__ void done(const Unit&) const {}
};
struct CountedOrder : StaticOrder {
    const unsigned* ready; unsigned need; unsigned* tmo;
    __device__ __forceinline__ void a_ready(const Unit& u) const {
        if (threadIdx.x < 64) {
            const unsigned long long t0 = __builtin_amdgcn_s_memrealtime(); unsigned polls = 0;
            while ((unsigned)__builtin_amdgcn_readfirstlane(__hip_atomic_load(ready + 64 * u.pm, __ATOMIC_RELAXED, __HIP_MEMORY_SCOPE_AGENT)) < need) {
                if ((++polls & 255u) == 0u && __builtin_amdgcn_readfirstlane(__hip_atomic_load(tmo, __ATOMIC_RELAXED, __HIP_MEMORY_SCOPE_AGENT)) != 0u) break;
                if (__builtin_amdgcn_s_memrealtime() - t0 > 2000000ull) {
                    if (threadIdx.x == 0) { unsigned expect = 0u; __hip_atomic_compare_exchange_strong(tmo + 1, &expect, 0x600u | (unsigned)(u.pm & 0xff), __ATOMIC_RELAXED, __ATOMIC_RELAXED, __HIP_MEMORY_SCOPE_AGENT); __hip_atomic_store(tmo, 1u, __ATOMIC_RELAXED, __HIP_MEMORY_SCOPE_AGENT); }
                    break; }
                __builtin_amdgcn_s_sleep(2); }
            __builtin_amdgcn_fence(__ATOMIC_ACQUIRE, "agent");
            asm volatile("s_waitcnt vmcnt(0)" ::: "memory");
        }
#if !defined(BROKEN_HOOK_NO_BARRIER)
        asm volatile("" ::: "memory"); __builtin_amdgcn_s_barrier(); asm volatile("" ::: "memory");
#endif
    }
};

__device__ __forceinline__ unsigned cvt_pk_bf16(float lo, float hi) { unsigned r; asm volatile("v_cvt_pk_bf16_f32 %0, %1, %2" : "=v"(r) : "v"(lo), "v"(hi)); return r; }
typedef float f32x2 __attribute__((ext_vector_type(2)));
__device__ __forceinline__ f32x2 gelu_pk(f32x2 v) {
    const f32x2 av = __builtin_elementwise_abs(v), d = av * 0.2316418882f + 1.0f;
    f32x2 t; t.x = __builtin_amdgcn_rcpf(d.x); t.y = __builtin_amdgcn_rcpf(d.y);
    f32x2 q = t * 0.5307027145f + (-0.7265760135f); q = q * t + 0.7107068705f; q = q * t + (-0.142248368f); q = q * t + 0.127414796f; q = q * t;
    const f32x2 s = (v * v) * (-0.72134752044f);
    f32x2 e; e.x = __builtin_amdgcn_exp2f(s.x); e.y = __builtin_amdgcn_exp2f(s.y);
    const f32x2 m = v * (q * e), r = v - m;
    f32x2 o; o.x = v.x < 0.f ? m.x : r.x; o.y = v.y < 0.f ? m.y : r.y; return o;
}

struct EpiF32 {
    static constexpr bool PERM = false, AFTER_DRAIN = false;
    float* C; int ldc; const float* bias;
    __device__ __forceinline__ void operator()(const f32x4 (&acc)[2][2][4][2], const Unit& u, int wr, int wc, int fr, int fq) const {
        const int row0 = u.pm * BM + wr * 64 + fr, col0 = u.pn * BM + wc * 32 + 4 * fq;
        f32x4 bv[2][2];
#pragma unroll
        for (int bj = 0; bj < 2; ++bj)
#pragma unroll
            for (int n = 0; n < 2; ++n) bv[bj][n] = bias ? *(const f32x4*)(bias + col0 + bj * HALF + n * 16) : (f32x4){0.f, 0.f, 0.f, 0.f};
#pragma unroll
        for (int ai = 0; ai < 2; ++ai)
#pragma unroll
            for (int m = 0; m < 4; ++m) { float* rowp = C + (size_t)(row0 + ai * HALF + m * 16) * ldc + col0;
#pragma unroll
                for (int bj = 0; bj < 2; ++bj)
#pragma unroll
                    for (int n = 0; n < 2; ++n) *(f32x4*)(rowp + bj * HALF + n * 16) = acc[ai][bj][m][n] + bv[bj][n]; }
    }
};
template <int ACT  > struct EpiBf16 {
    static constexpr bool PERM = true, AFTER_DRAIN = false;
    bf16_t* O; int ldc; const float* bias; int split_cols; size_t split_stride;
    __device__ __forceinline__ void operator()(const f32x4 (&acc)[2][2][4][2], const Unit& u, int wr, int wc, int fr, int fq) const {
        const int row0 = u.pm * BM + wr * 64 + fr; int colt = u.pn * BM; bf16_t* base = O;
        if (split_cols) { const int t = colt / split_cols; base += (size_t)t * split_stride; colt -= t * split_cols; }
        const int col0 = colt + wc * 32 + 8 * fq, bcol0 = u.pn * BM + wc * 32 + 8 * fq;
        f32x4 bv[2][2];
#pragma unroll
        for (int bj = 0; bj < 2; ++bj)
#pragma unroll
            for (int n = 0; n < 2; ++n) bv[bj][n] = bias ? *(const f32x4*)(bias + bcol0 + bj * HALF + 4 * n) : (f32x4){0.f, 0.f, 0.f, 0.f};
#pragma unroll
        for (int ai = 0; ai < 2; ++ai)
#pragma unroll
            for (int m = 0; m < 4; ++m) { bf16_t* rowp = base + (size_t)(row0 + ai * HALF + m * 16) * ldc + col0;
#pragma unroll
                for (int bj = 0; bj < 2; ++bj) { f32x4 v0 = acc[ai][bj][m][0] + bv[bj][0], v1 = acc[ai][bj][m][1] + bv[bj][1];
                    if (ACT == 1) { f32x2 a = gelu_pk((f32x2){v0[0], v0[1]}), b = gelu_pk((f32x2){v0[2], v0[3]}), c = gelu_pk((f32x2){v1[0], v1[1]}), d = gelu_pk((f32x2){v1[2], v1[3]});
                        v0 = (f32x4){a.x, a.y, b.x, b.y}; v1 = (f32x4){c.x, c.y, d.x, d.y}; }
                    if (ACT == 2) {
#pragma unroll
                        for (int j = 0; j < 4; ++j) { v0[j] = 0.5f * v0[j] * (1.0f + erff(v0[j] * 0.70710678f)); v1[j] = 0.5f * v1[j] * (1.0f + erff(v1[j] * 0.70710678f)); } }
                    u32x4 w; w.x = cvt_pk_bf16(v0[0], v0[1]); w.y = cvt_pk_bf16(v0[2], v0[3]); w.z = cvt_pk_bf16(v1[0], v1[1]); w.w = cvt_pk_bf16(v1[2], v1[3]);
                    *(u32x4*)(rowp + bj * HALF) = w; } }
    }
};
}
namespace pg8 {
struct EpiSwiGLU {
    static constexpr bool PERM = true, AFTER_DRAIN = false;
    bf16_t* O; int ldc;
    __device__ __forceinline__ void operator()(const f32x4 (&acc)[2][2][4][2], const Unit& u, int wr, int wc, int fr, int fq) const {
        const int row0 = u.pm * BM + wr * 64 + fr, col0 = u.pn * HALF + wc * 32 + 8 * fq;
#pragma unroll
        for (int ai = 0; ai < 2; ++ai)
#pragma unroll
            for (int m = 0; m < 4; ++m) { bf16_t* rowp = O + (size_t)(row0 + ai * HALF + m * 16) * ldc + col0;
                float h[8];
#pragma unroll
                for (int n = 0; n < 2; ++n)
#pragma unroll
                    for (int j = 0; j < 4; ++j) { const float g = acc[ai][0][m][n][j], up = acc[ai][1][m][n][j]; h[n * 4 + j] = g * __builtin_amdgcn_rcpf(1.0f + __builtin_amdgcn_exp2f(-1.4426950408889634f * g)) * up; }
                u32x4 w; w.x = cvt_pk_bf16(h[0], h[1]); w.y = cvt_pk_bf16(h[2], h[3]); w.z = cvt_pk_bf16(h[4], h[5]); w.w = cvt_pk_bf16(h[6], h[7]);
                *(u32x4*)rowp = w; }
    }
};
struct EpiResid {
    static constexpr bool PERM = false, AFTER_DRAIN = false;
    float* X; const float* gate_x; const float* gate_c; float fac; float* out_x;
    __device__ __forceinline__ void operator()(const f32x4 (&acc)[2][2][4][2], const Unit& u, int wr, int wc, int fr, int fq) const {
        const int row0 = u.pm * BM + wr * 64 + fr, col0 = u.pn * BM + wc * 32 + 4 * fq;
        const float* gv = (u.pm == 0) ? gate_c : gate_x;
        float* dst = (u.pm != 0 && out_x) ? out_x - (size_t)256 * 4096 : X;
        f32x4 gg[2][2];
#pragma unroll
        for (int bj = 0; bj < 2; ++bj)
#pragma unroll
            for (int n = 0; n < 2; ++n) gg[bj][n] = *(const f32x4*)(gv + col0 + bj * HALF + n * 16) * fac;
#pragma unroll
        for (int ai = 0; ai < 2; ++ai)
#pragma unroll
            for (int m = 0; m < 4; ++m) { const size_t off = (size_t)(row0 + ai * HALF + m * 16) * 4096 + col0;
#pragma unroll
                for (int bj = 0; bj < 2; ++bj)
#pragma unroll
                    for (int n = 0; n < 2; ++n) { const f32x4 b = *(const f32x4*)(X + off + bj * HALF + n * 16); *(f32x4*)(dst + off + bj * HALF + n * 16) = b + gg[bj][n] * acc[ai][bj][m][n]; } }
    }
};
struct OneUnit { int pn;
    __host__ __device__ bool next(int i, Unit& u) const { u.pm = 0; u.pn = pn; return i == 0; }
    __device__ __forceinline__ void a_ready(const Unit&) const {}
    __device__ __forceinline__ void done(const Unit&) const {}
};
struct StaticOrderX { StaticOrder b;
    __host__ __device__ void init(int M, int N, int G_, int c_) { b.init(M - BM, N, G_, c_); }
    __host__ __device__ bool next(int i, Unit& u) const { const bool ok = b.next(i, u); u.pm += 1; return ok; }
    __device__ __forceinline__ void a_ready(const Unit&) const {}
    __device__ __forceinline__ void done(const Unit&) const {}
};
}
namespace pg8 {
template <class Epi, class Sched, bool STAMP = false>
__device__ __forceinline__ void gemm_phase(PG8_LAS unsigned char* lds, const Gemm g, const Sched& S, const Epi& E, unsigned long long* stamps) {
    int tid_ = threadIdx.x; asm volatile("" : "+v"(tid_));
    const int tid = tid_, wid = __builtin_amdgcn_readfirstlane(tid >> 6), lane = tid & 63, wr = wid >> 2, wc = wid & 3, fr = lane & 15, fq = lane >> 4;
    const int K = g.ld, nt = g.K / BK;
    int ts_lo = 0, ts_hi = 0, nts = 0; const unsigned long long rt_entry = STAMP ? (unsigned long long)wall_clock64() : 0ull;
#define PG8_STAMP() do { if (STAMP && wid == 0 && nts < 64) { const unsigned long long _c = (unsigned long long)clock64(); \
        ts_lo = (lane == nts) ? (int)(unsigned)_c : ts_lo; ts_hi = (lane == nts) ? (int)(unsigned)(_c >> 32) : ts_hi; ++nts; } } while (0)
    PG8_STAMP();
    unsigned voffA[2], voffB[2];
#pragma unroll
    for (int i = 0; i < 2; ++i) { int R, C; stage_rc(tid * 16 + i * 8192, R, C); const int Rb = Epi::PERM ? ((R & ~31) + perm32(R & 31)) : R;
        voffA[i] = (unsigned)(R * K + C) * 2u; voffB[i] = (unsigned)(Rb * K + C) * 2u; }
    const size_t kstep = (size_t)(BK * 2);
    const size_t hstep = (size_t)HALF * K * 2;
    const size_t tstep = 2 * hstep;
    const unsigned ldsw = (unsigned)wid * 1024u;
    const int aoff = lds_byte(wr * 64 + fr, fq * 8), boff = lds_byte(wc * 32 + fr, fq * 8);
#define PG8_SA(b, h) (((b) * 2 + (h)) * HTB)
#define PG8_SB(b, h) ((4 + (b) * 2 + (h)) * HTB)
#define PG8_STAGE(bufoff, gbase, voff) do { _Pragma("unroll") for (int _i = 0; _i < 2; ++_i) \
        __builtin_amdgcn_global_load_lds((const unsigned*)((const char*)(gbase) + (voff)[_i]), (PG8_LAS unsigned*)(lds + (bufoff) + ldsw + _i * 8192), 16, 0, 0); } while (0)
#define PG8_LDA(dst, b, h) do { _Pragma("unroll") for (int m = 0; m < 4; ++m) _Pragma("unroll") for (int k = 0; k < 2; ++k) dst[m][k] = *(const PG8_LAS bf16x8*)(lds + PG8_SA(b, h) + aoff + m * 2048 + k * 1024); } while (0)
#define PG8_LDB(dst, b, h) do { _Pragma("unroll") for (int n = 0; n < 2; ++n) _Pragma("unroll") for (int k = 0; k < 2; ++k) dst[n][k] = *(const PG8_LAS bf16x8*)(lds + PG8_SB(b, h) + boff + n * 2048 + k * 1024); } while (0)
#define PG8_MMA(ai, bj, At, Bt) do { __builtin_amdgcn_s_setprio(1); _Pragma("unroll") for (int m = 0; m < 4; ++m) _Pragma("unroll") for (int n = 0; n < 2; ++n) _Pragma("unroll") for (int k = 0; k < 2; ++k) \
        acc[ai][bj][m][n] = __builtin_amdgcn_mfma_f32_16x16x32_bf16(Bt[n][k], At[m][k], acc[ai][bj][m][n], 0, 0, 0); __builtin_amdgcn_s_setprio(0); } while (0)
#define PG8_WAIT_V(n) asm volatile("s_waitcnt vmcnt(" #n ")" ::: "memory")
#define PG8_WAIT_L(n) asm volatile("s_waitcnt lgkmcnt(" #n ")" ::: "memory")
#define PG8_BAR __builtin_amdgcn_s_barrier()
#define PG8_SCHED __builtin_amdgcn_sched_barrier(0)
    Unit cur, nxt; int ui = 0;
    if (!S.next(0, cur)) return;
    f32x4 acc[2][2][4][2];
#pragma unroll
    for (int a = 0; a < 2; ++a)
#pragma unroll
        for (int b = 0; b < 2; ++b)
#pragma unroll
            for (int m = 0; m < 4; ++m)
#pragma unroll
                for (int n = 0; n < 2; ++n) acc[a][b][m][n] = (f32x4){0.f, 0.f, 0.f, 0.f};
    bf16x8 At[4][2], B0[2][2], B1[2][2];
    const char* cA = (const char*)g.A + (size_t)cur.pm * tstep; const char* cB = (const char*)g.Bt + (size_t)cur.pn * tstep;
    S.a_ready(cur);
    PG8_STAGE(PG8_SB(0, 0), cB, voffB); PG8_STAGE(PG8_SA(0, 0), cA, voffA); PG8_STAGE(PG8_SB(0, 1), cB + hstep, voffB); PG8_STAGE(PG8_SA(0, 1), cA + hstep, voffA);
    if (wr == 1) PG8_BAR;
    PG8_WAIT_V(4); PG8_BAR;
    PG8_STAGE(PG8_SB(1, 0), cB + kstep, voffB); PG8_STAGE(PG8_SA(1, 0), cA + kstep, voffA); PG8_STAGE(PG8_SB(1, 1), cB + hstep + kstep, voffB);
    PG8_WAIT_V(6); PG8_BAR;
    PG8_STAMP();
    for (;;) {
        const bool has_next = S.next(ui + 1, nxt);
        const char* nA = has_next ? (const char*)g.A + (size_t)nxt.pm * tstep : cA; const char* nB = has_next ? (const char*)g.Bt + (size_t)nxt.pn * tstep : cB;
        for (int t = 0; t < nt; t += 2) {
            const bool last = (t == nt - 2);
            const char* a1 = cA + (size_t)(t + 1) * kstep;
            const char* a2 = last ? nA : cA + (size_t)(t + 2) * kstep; const char* b2 = last ? nB : cB + (size_t)(t + 2) * kstep;
            const char* a3 = a2 + kstep; const char* b3 = b2 + kstep;
            if (last && has_next) S.a_ready(nxt);
            PG8_LDB(B0, 0, 0); PG8_SCHED; PG8_LDA(At, 0, 0); PG8_STAGE(PG8_SA(1, 1), a1 + hstep, voffA);
            PG8_WAIT_L(8); PG8_BAR; PG8_WAIT_L(0); PG8_MMA(0, 0, At, B0); PG8_BAR; PG8_SCHED;
            PG8_LDB(B1, 0, 1); PG8_STAGE(PG8_SB(0, 0), b2, voffB);
            PG8_BAR; PG8_WAIT_L(0); PG8_MMA(0, 1, At, B1); PG8_BAR;
            PG8_LDA(At, 0, 1); PG8_STAGE(PG8_SA(0, 0), a2, voffA);
            PG8_BAR; PG8_WAIT_L(0); PG8_MMA(1, 0, At, B0); PG8_BAR; PG8_SCHED;
            PG8_STAGE(PG8_SB(0, 1), b2 + hstep, voffB);
            PG8_WAIT_V(6); PG8_BAR; PG8_MMA(1, 1, At, B1); PG8_BAR;
            PG8_LDB(B0, 1, 0); PG8_SCHED; PG8_LDA(At, 1, 0); PG8_STAGE(PG8_SA(0, 1), a2 + hstep, voffA);
            PG8_WAIT_L(8); PG8_BAR; PG8_WAIT_L(0); PG8_MMA(0, 0, At, B0); PG8_BAR; PG8_SCHED;
            PG8_LDB(B1, 1, 1); PG8_STAGE(PG8_SB(1, 0), b3, voffB);
            PG8_BAR; PG8_WAIT_L(0); PG8_MMA(0, 1, At, B1); PG8_BAR;
            PG8_LDA(At, 1, 1); PG8_STAGE(PG8_SA(1, 0), a3, voffA);
            PG8_BAR; PG8_WAIT_L(0); PG8_MMA(1, 0, At, B0); PG8_BAR; PG8_SCHED;
            PG8_STAGE(PG8_SB(1, 1), b3 + hstep, voffB);
            PG8_WAIT_V(6); PG8_BAR; PG8_MMA(1, 1, At, B1); PG8_BAR;
        }
        PG8_STAMP();
        if constexpr (!Epi::AFTER_DRAIN) { E(acc, cur, wr, wc, fr, fq); S.done(cur); }
        PG8_STAMP();
        if (!has_next) break;
#pragma unroll
        for (int a = 0; a < 2; ++a)
#pragma unroll
            for (int b = 0; b < 2; ++b)
#pragma unroll
                for (int m = 0; m < 4; ++m)
#pragma unroll
                    for (int n = 0; n < 2; ++n) acc[a][b][m][n] = (f32x4){0.f, 0.f, 0.f, 0.f};
        cur = nxt; cA = nA; cB = nB; ++ui;
    }
    PG8_WAIT_V(0);
    if (wr == 0) PG8_BAR;
    PG8_BAR;
    if constexpr (Epi::AFTER_DRAIN) { E.fused(acc, cur, wr, wc, fr, fq, lds, wid, lane); S.done(cur); }
    PG8_STAMP();
    if (STAMP && wid == 0) { stamps[lane] = lane < nts ? (((unsigned long long)(unsigned)ts_hi << 32) | (unsigned)ts_lo) : 0ull;
        if (lane == 62) stamps[62] = rt_entry; if (lane == 63) stamps[63] = (unsigned long long)wall_clock64(); }
#undef PG8_STAMP
#undef PG8_SA
#undef PG8_SB
#undef PG8_STAGE
#undef PG8_LDA
#undef PG8_LDB
#undef PG8_MMA
#undef PG8_WAIT_V
#undef PG8_WAIT_L
#undef PG8_BAR
#undef PG8_SCHED
}
}
#define LDS_WAIT() asm volatile("s_waitcnt lgkmcnt(0)" ::: "memory")

__device__ __forceinline__ int map_row(int n, int mode) {
    if (mode == 1) { const int j = n < FF ? n : n - FF; return (j >> 7) * 256 + (n < FF ? 0 : 128) + (j & 127); }
    return n;
}
__device__ __forceinline__ void transpose_item(const float* __restrict__ W, int K, int N, bf16_t* WT, int mode, LAS float* scr, int item, int lane) {
    const int nblk = N / 32, kb = item / nblk, nb = item % nblk, k0 = 64 * kb, n0 = 32 * nb;
#pragma unroll 8
    for (int i = 0; i < 32; ++i) { const int kk = 2 * i + (lane >> 5); scr[kk * 33 + (lane & 31)] = W[(size_t)(k0 + kk) * N + n0 + (lane & 31)]; }
    LDS_WAIT(); asm volatile("" ::: "memory");
    const int c = lane & 7;
#pragma unroll
    for (int j = 0; j < 4; ++j) { const int n = (lane >> 3) + 8 * j; const LAS float* s = scr + (8 * c) * 33 + n;
        u32x4 o; o.x = cvt_pk_bf16(s[0 * 33], s[1 * 33]); o.y = cvt_pk_bf16(s[2 * 33], s[3 * 33]); o.z = cvt_pk_bf16(s[4 * 33], s[5 * 33]); o.w = cvt_pk_bf16(s[6 * 33], s[7 * 33]);
        *(u32x4*)(WT + (size_t)map_row(n0 + n, mode) * K + k0 + 8 * c) = o; }
    LDS_WAIT(); asm volatile("" ::: "memory");
}
constexpr int I_G = (DM / 64) * (2 * FF / 32), I_D = (FF / 64) * (DM / 32), I_IN = (DM / 64) * (9600 / 32), I_OUT = (DM / 64) * (DM / 32), I_Q = (1024 / 64) * (NQ / 32), I_KV = (512 / 64) * (NKV / 32);
constexpr int I_LAYER = 2 * I_G + 2 * I_D + I_IN + I_OUT + I_Q + I_KV;

__device__ __forceinline__ void phase0(const Frame& F, unsigned char* ws) {
    const int gw = F.bid * 8 + F.wave, NGW = F.G * 8;
    const size_t gt = (size_t)F.bid * 512 + F.tid, NGT = (size_t)F.G * 512;
    LAS float* scr = (LAS float*)(F.lds + F.wave * 8704);
    bf16_t* WB = (bf16_t*)(ws + WS_WB);
    for (int it = gw; it < NL * I_LAYER; it += NGW) {
        const int l = it / I_LAYER; int r = it - l * I_LAYER; bf16_t* wl = WB + (size_t)l * W_LAYER;
        if (r < I_G) { transpose_item(IN_(10) + (size_t)l * DM * 2 * FF, DM, 2 * FF, wl + W_G1, 1, scr, r, F.lane); continue; } r -= I_G;
        if (r < I_D) { transpose_item(IN_(11) + (size_t)l * FF * DM, FF, DM, wl + W_D1, 0, scr, r, F.lane); continue; } r -= I_D;
        if (r < I_G) { transpose_item(IN_(12) + (size_t)l * DM * 2 * FF, DM, 2 * FF, wl + W_G2, 1, scr, r, F.lane); continue; } r -= I_G;
        if (r < I_D) { transpose_item(IN_(13) + (size_t)l * FF * DM, FF, DM, wl + W_D2, 0, scr, r, F.lane); continue; } r -= I_D;
        if (r < I_IN) { transpose_item(IN_(14) + (size_t)l * DM * 9600, DM, 9600, wl + W_IN, 0, scr, r, F.lane); continue; } r -= I_IN;
        if (r < I_OUT) { transpose_item(IN_(15) + (size_t)l * DM * DM, DM, DM, wl + W_OUT, 0, scr, r, F.lane); continue; } r -= I_OUT;
        if (r < I_Q) { transpose_item(IN_(39) + (size_t)l * 1024 * NQ, 1024, NQ, wl + W_Q, 0, scr, r, F.lane); continue; } r -= I_Q;
        transpose_item(IN_(41) + (size_t)l * 512 * NKV, 512, NKV, wl + W_KV, 0, scr, r, F.lane);
    }
    for (size_t i = gt; i < (size_t)NL * 128 * 512; i += NGT) {
        const int l = (int)(i / (128 * 512)), rr = (int)((i / 512) % 128), c = (int)(i % 512);
        const int row = 9600 + rr;
        *(u32x4*)(WB + (size_t)l * W_LAYER + W_IN + (size_t)row * DM + c * 8) = (u32x4){0u, 0u, 0u, 0u};
    }
    { bf16_t* WLR = (bf16_t*)(ws + WS_WLR); const float* wu = IN_(18); const float* au = IN_(20); const float* gu = IN_(21);
      for (size_t i = gt; i < (size_t)NL * 448 * A_W; i += NGT) { const int l = (int)(i / (448 * A_W)), k = (int)((i / A_W) % 448), col = (int)(i % A_W);
          float v;
          if (k < 128) v = wu[(((size_t)l * 2 + (k >> 6)) * 64 + (k & 63)) * A_W + col];
          else if (k < 256) v = au[(((size_t)l * 2 + ((k - 128) >> 6)) * 64 + (k & 63)) * A_W + col];
          else v = gu[((size_t)l * 192 + (k - 256)) * A_W + col];
          WLR[((size_t)l * A_W + col) * 448 + k] = (bf16_t)(cvt_pk_bf16(v, v) & 0xffffu); } }
    { f32x4* xs = (f32x4*)(ws + WS_XS); const f32x4* cx = (const f32x4*)IN_(2); const f32x4* xx = (const f32x4*)IN_(0);
      for (size_t i = gt; i < (size_t)T * DM / 4; i += NGT) xs[i] = i < (size_t)NCTX * DM / 4 ? cx[i] : xx[i - (size_t)NCTX * DM / 4]; }
    { float* HP = (float*)(ws + WS_HP);
      for (int it = F.bid; it < NL * 16; it += F.G) { const int l = it >> 4, ch = it & 15, w = F.tid >> 8, j = F.tid & 255;
          const float* cv = w ? IN_(3) : IN_(1); const float* ad = IN_(4) + ((size_t)l * DM + ch * 256) * 256 + j; float s = 0.f;
          for (int i = 0; i < 256; ++i) s += siluf_(cv[ch * 256 + i]) * ad[(size_t)i * 256];
          HP[((l * 16 + ch) * 2 + w) * 256 + j] = s; } }
    { float* H3 = (float*)(ws + WS_H3);
      LAS float* zb = (LAS float*)(F.lds + 73728); LAS float* ha = zb + 8 * 36; LAS float* hb = ha + 8 * 64;
      for (int it = F.bid; it < NL * (T / 8); it += F.G) { const int l = it / (T / 8), pb = it % (T / 8);
          if (F.tid < 8 * 33) { const int p = F.tid / 33, i = F.tid % 33, P = pb * 8 + p; const int L = P < NCTX ? NCTX : SEQ, t = P < NCTX ? P : P - NCTX;
              float z;
              if (i == 0) z = (float)t / (float)(L - 1);
              else { const int b = (i - 1) & 15; const float fb = 1e-4f + (float)b * ((15.0f - 1e-4f) / 15.0f); const float rev2 = 2.0f * fb * (float)t / (float)L;
                  z = i <= 16 ? cospif(rev2) : -sinpif(rev2); }
              zb[p * 36 + i] = z; }
          __syncthreads();
          const int p = F.tid >> 6, j = F.tid & 63; const float fq = IN_(36)[l * 64 + j];
          { const float* w1 = IN_(29) + (size_t)l * 33 * 64 + j; float s = IN_(30)[l * 64 + j];
            for (int i = 0; i < 33; ++i) s += zb[p * 36 + i] * w1[i * 64];
            ha[p * 64 + j] = sinf(fq * s); }
          __syncthreads();
          { const float* w2 = IN_(31) + (size_t)l * 64 * 64 + j; float s = IN_(32)[l * 64 + j];
            for (int i = 0; i < 64; ++i) s += ha[p * 64 + i] * w2[i * 64];
            hb[p * 64 + j] = sinf(fq * s); }
          __syncthreads();
          { const float* w3 = IN_(33) + (size_t)l * 64 * 64 + j; float s = IN_(34)[l * 64 + j];
            for (int i = 0; i < 64; ++i) s += hb[p * 64 + i] * w3[i * 64];
            ((bf16_t*)H3)[((size_t)l * 64 + j) * T + pb * 8 + p] = (bf16_t)(cvt_pk_bf16(sinf(fq * s), 0.f) & 0xffffu); }
          __syncthreads(); } }
}
__device__ __forceinline__ void phase_mod(const Frame& F, unsigned char* ws) {
    const float* HP = (const float*)(ws + WS_HP); float* MOD = (float*)(ws + WS_MOD);
    LAS float* hs = (LAS float*)F.lds;
    for (int it = F.bid; it < NL * (NMOD / 512); it += F.G) { const int l = it / (NMOD / 512), nb = it % (NMOD / 512);
        { const int w = F.tid >> 8, j = F.tid & 255; float s = 0.f;
          for (int ch = 0; ch < 16; ++ch) s += HP[((l * 16 + ch) * 2 + w) * 256 + j];
          hs[w * 256 + j] = s; }
        __syncthreads();
        const int n = nb * 512 + F.tid; const float* au = IN_(5) + (size_t)l * 256 * NMOD + n; float s0 = IN_(6)[(size_t)l * NMOD + n], s1 = s0;
        for (int j = 0; j < 256; ++j) { const float u = au[(size_t)j * NMOD]; s0 += hs[j] * u; s1 += hs[256 + j] * u; }
        MOD[((size_t)l * 2 + 0) * NMOD + n] = s0; MOD[((size_t)l * 2 + 1) * NMOD + n] = s1;
        __syncthreads(); }
}
__device__ __forceinline__ void norm_phase(const Frame& F, float* XS, const float* __restrict__ gain, const float* modx, const float* modc, int ish, int isc, bf16_t* out, const float* slab, const float* sgate, float sfac) {
    const int gw = F.bid * 8 + F.wave, NGW = F.G * 8;
    int row_lo = 0;
    if (slab) { row_lo = NCTX;
        LAS float* red = (LAS float*)F.lds;
        for (int row = F.bid; row < NCTX; row += F.G) { const size_t o = (size_t)row * DM + F.wave * 512;
            f32x4 v[2]; float s = 0.f;
#pragma unroll
            for (int j = 0; j < 2; ++j) { f32x4 acc = (f32x4){0.f, 0.f, 0.f, 0.f};
#pragma unroll
                for (int ks = 0; ks < 16; ++ks) acc += ((const f32x4*)(slab + (size_t)ks * NCTX * DM + o) + F.lane)[64 * j];
                v[j] = ((const f32x4*)(XS + o) + F.lane)[64 * j] + acc * ((const f32x4*)(sgate + F.wave * 512) + F.lane)[64 * j] * sfac;
                ((f32x4*)(XS + o) + F.lane)[64 * j] = v[j]; s += (v[j].x * v[j].x + v[j].y * v[j].y) + (v[j].z * v[j].z + v[j].w * v[j].w); }
            s = wave_sum(s); if (F.lane == 0) red[F.wave] = s;
            __syncthreads();
            float tot = 0.f;
#pragma unroll
            for (int w = 0; w < 8; ++w) tot += red[w];
            const float rstd = rsqrtf(tot * (1.0f / DM) + NORM_EPS);
#pragma unroll
            for (int j = 0; j < 2; ++j) { const int c4 = F.wave * 128 + F.lane + 64 * j;
                const f32x4 y = v[j] * rstd * ((const f32x4*)gain)[c4] * (((const f32x4*)(modc + (size_t)isc * DM))[c4] + 1.0f) + ((const f32x4*)(modc + (size_t)ish * DM))[c4];
                u32x2 w2; w2.x = cvt_pk_bf16(y.x, y.y); w2.y = cvt_pk_bf16(y.z, y.w); ((u32x2*)(out + (size_t)row * DM))[c4] = w2; }
            __syncthreads(); } }
    for (int row = row_lo + gw; row < T; row += NGW) {
        const float* mod = row < NCTX ? modc : modx;
        const f32x4* xr = (const f32x4*)(XS + (size_t)row * DM) + F.lane; const f32x4* g4 = (const f32x4*)gain + F.lane;
        const f32x4* sh4 = (const f32x4*)(mod + (size_t)ish * DM) + F.lane; const f32x4* sc4 = (const f32x4*)(mod + (size_t)isc * DM) + F.lane;
        f32x4 v[16]; float s = 0.f;
#pragma unroll
        for (int j = 0; j < 16; ++j) { v[j] = xr[64 * j]; s += (v[j].x * v[j].x + v[j].y * v[j].y) + (v[j].z * v[j].z + v[j].w * v[j].w); }
        const float rstd = rsqrtf(wave_sum(s) * (1.0f / DM) + NORM_EPS);
        u32x2* o = (u32x2*)(out + (size_t)row * DM) + F.lane;
#pragma unroll
        for (int j = 0; j < 16; ++j) { const f32x4 y = v[j] * rstd * g4[64 * j] * (sc4[64 * j] + 1.0f) + sh4[64 * j];
            u32x2 w; w.x = cvt_pk_bf16(y.x, y.y); w.y = cvt_pk_bf16(y.z, y.w); o[64 * j] = w; }
    }
}
__device__ __forceinline__ float conv3_at(const float* PX, int tau, int col, float w0, float w1, float w2) {
    const float* p = PX + (size_t)tau * PXW + col;
    const bool hl = has_left(tau), hr = has_right(tau);
    return p[0] * w1 + p[hl ? -PXW : 0] * (hl ? w0 : 0.f) + p[hr ? PXW : 0] * (hr ? w2 : 0.f);
}
__device__ __forceinline__ float rope_apply(float val, int tau, int j) {
    const int pos = tau - NCTX, prow = pos >> 6, pcol = pos & 63;
    const float inv = __powf(10000.0f, -(float)(j & 15) * (1.0f / 16.0f));
    const float ang = (float)(j < 32 ? prow : pcol) * inv;
    float sn, cs; sincosf(ang, &sn, &cs);
    const float partner = __shfl_xor(val, 16);
    const float rot = (j & 16) ? partner : -partner;
    return val * cs + rot * sn;
}
__device__ __forceinline__ void mla_prep_phase(const Frame& F, unsigned char* ws, int l) {
    const float* PX = (const float*)(ws + WS_PX); bf16_t* QA = (bf16_t*)(ws + WS_QA); bf16_t* KVA = (bf16_t*)(ws + WS_KVA); bf16_t* KPE = (bf16_t*)(ws + WS_KPE);
    const int gw = F.bid * 8 + F.wave, NGW = F.G * 8;
    const f32x4* gq = (const f32x4*)(IN_(38) + l * 1024) + F.lane; const f32x4* gkv = (const f32x4*)(IN_(40) + l * 512) + F.lane; const float gpe = IN_(45)[l * 64 + F.lane];
    for (int tau = gw; tau < T; tau += NGW) {
        const f32x4* p = (const f32x4*)(PX + (size_t)tau * PXW + PXC) + F.lane;
        f32x4 q[4], kv[2]; float sq = 0.f, skv = 0.f;
#pragma unroll
        for (int j = 0; j < 4; ++j) { q[j] = p[64 * j]; sq += (q[j].x * q[j].x + q[j].y * q[j].y) + (q[j].z * q[j].z + q[j].w * q[j].w); }
#pragma unroll
        for (int j = 0; j < 2; ++j) { kv[j] = p[256 + 64 * j]; skv += (kv[j].x * kv[j].x + kv[j].y * kv[j].y) + (kv[j].z * kv[j].z + kv[j].w * kv[j].w); }
        const float pe = PX[(size_t)tau * PXW + PXC + 1536 + F.lane];
        const float rq = rsqrtf(wave_sum(sq) * (1.0f / 1024.0f) + NORM_EPS), rkv = rsqrtf(wave_sum(skv) * (1.0f / 512.0f) + NORM_EPS), rpe = rsqrtf(wave_sum(pe * pe) * (1.0f / 64.0f) + NORM_EPS);
        u32x2* oq = (u32x2*)(QA + (size_t)tau * 1024) + F.lane; u32x2* okv = (u32x2*)(KVA + (size_t)tau * 512) + F.lane;
#pragma unroll
        for (int j = 0; j < 4; ++j) { const f32x4 y = q[j] * rq * gq[64 * j]; u32x2 w; w.x = cvt_pk_bf16(y.x, y.y); w.y = cvt_pk_bf16(y.z, y.w); oq[64 * j] = w; }
#pragma unroll
        for (int j = 0; j < 2; ++j) { const f32x4 y = kv[j] * rkv * gkv[64 * j]; u32x2 w; w.x = cvt_pk_bf16(y.x, y.y); w.y = cvt_pk_bf16(y.z, y.w); okv[64 * j] = w; }
        float kp = pe * rpe * gpe;
        if (tau >= NCTX) kp = rope_apply(kp, tau, F.lane);
        KPE[(size_t)tau * 64 + F.lane] = (bf16_t)(cvt_pk_bf16(kp, kp) & 0xffffu);
    }
}
__device__ __forceinline__ void qkv_final_phase(const Frame& F, unsigned char* ws, int l, bool need_ctx) {
    const bf16_t* QRAW = (const bf16_t*)(ws + WS_QRAW); const bf16_t* KVRAW = (const bf16_t*)(ws + WS_KVRAW); const bf16_t* KPE = (const bf16_t*)(ws + WS_KPE);
    bf16_t* QF = (bf16_t*)(ws + WS_QF); bf16_t* KF = (bf16_t*)(ws + WS_KF);
    const int gw = F.bid * 8 + F.wave, NGW = F.G * 8, ln = F.lane;
    const float gqn0 = IN_(42)[l * 128 + 2 * ln], gqn1 = IN_(42)[l * 128 + 2 * ln + 1], gqp = IN_(43)[l * 64 + ln];
    const float gkn0 = IN_(44)[l * 128 + 2 * ln], gkn1 = IN_(44)[l * 128 + 2 * ln + 1];
    (void)need_ctx;
    for (int it = gw; it < T * NHC; it += NGW) { const int tau = it / NHC, h = it % NHC;
        const unsigned qn = *(const unsigned*)(QRAW + (size_t)tau * NQ + h * 192 + 2 * ln); const float q0 = bf2f((unsigned short)(qn & 0xffffu)), q1 = bf2f((unsigned short)(qn >> 16));
        const float qp = bf2f(QRAW[(size_t)tau * NQ + h * 192 + 128 + ln]);
        const unsigned kn = *(const unsigned*)(KVRAW + (size_t)tau * NKV + h * 256 + 2 * ln); const float k0 = bf2f((unsigned short)(kn & 0xffffu)), k1 = bf2f((unsigned short)(kn >> 16));
        const float rqn = rsqrtf(wave_sum(q0 * q0 + q1 * q1) * (1.0f / 128.0f) + NORM_EPS), rqp = rsqrtf(wave_sum(qp * qp) * (1.0f / 64.0f) + NORM_EPS), rkn = rsqrtf(wave_sum(k0 * k0 + k1 * k1) * (1.0f / 128.0f) + NORM_EPS);
        float qpe = qp * rqp * gqp; if (tau >= NCTX) qpe = rope_apply(qpe, tau, ln);
        *(unsigned*)(QF + (size_t)tau * NQ + h * 192 + 2 * ln) = cvt_pk_bf16(q0 * rqn * gqn0, q1 * rqn * gqn1);
        QF[(size_t)tau * NQ + h * 192 + 128 + ln] = (bf16_t)(cvt_pk_bf16(qpe, qpe) & 0xffffu);
        *(unsigned*)(KF + (size_t)tau * NQ + h * 192 + 2 * ln) = cvt_pk_bf16(k0 * rkn * gkn0, k1 * rkn * gkn1);
        KF[(size_t)tau * NQ + h * 192 + 128 + ln] = KPE[(size_t)tau * 64 + ln];
    }
}
__device__ __forceinline__ void rwkv_out_phase(const Frame& F, unsigned char* ws, int l, bool need_ctx) {
    const float* SS = (const float*)(ws + WS_SS); const float* SD = (const float*)(ws + WS_SD); const float* GB = (const float*)(ws + WS_G); const float* Y = (const float*)(ws + WS_Y);
    bf16_t* OB = (bf16_t*)(ws + WS_OBUF);
    const int gw = F.bid * 8 + F.wave, NGW = F.G * 8, ln = F.lane;
    const int lo = need_ctx ? 0 : NCTX * NHA;
    for (int it = lo + gw; it < T * NHA; it += NGW) { const int tau = it / NHA, h = it % NHA, col = h * 64 + ln;
        const float y = Y[(size_t)tau * A_W + col] + Y[((size_t)T + tau) * A_W + col];
        const float mu = wave_sum(y) * (1.0f / 64.0f); const float dy = y - mu; const float var = wave_sum(dy * dy) * (1.0f / 64.0f);
        const float yn = dy * rsqrtf(var + GN_EPS) * IN_(25)[l * A_W + col] + IN_(26)[l * A_W + col];
        const float* ss = SS + ((size_t)h * T + tau) * 192 + ln; const float r = ss[64], v = ss[128];
        const float km = 0.5f * (SD[(((size_t)h * 2 + 0) * T + tau) * 192 + 128 + ln] + SD[(((size_t)h * 2 + 1) * T + tau) * 192 + 128 + ln]);
        const float bonus = wave_sum(r * km * IN_(24)[l * A_W + col]) * v;
        const float o = (yn + bonus) * GB[(size_t)tau * A_W + col];
        OB[(size_t)tau * DM + col] = (bf16_t)(cvt_pk_bf16(o, o) & 0xffffu);
    }
}
__device__ __forceinline__ void hyena_prep_phase(const Frame& F, unsigned char* ws, int l) {
    const float* PX = (const float*)(ws + WS_PX); float* GT = (float*)(ws + WS_GT); float* X0T = (float*)(ws + WS_X0T);
    LAS float* LGt = (LAS float*)F.lds; LAS float* LX0 = LGt + 64 * 65;
    const float* cw = IN_(27) + (size_t)l * 3 * B_IN; const float* cb = IN_(28) + (size_t)l * B_IN;
    for (int it = F.bid; it < (T / 64) * 20; it += F.G) { const int tt = it / 20, ct = it % 20;
        { const int t = F.tid >> 3, c0 = ct * 64 + (F.tid & 7) * 8, tau = tt * 64 + t;
          f32x4 u[3][2];
#pragma unroll
          for (int grp = 0; grp < 3; ++grp)
#pragma unroll
              for (int q = 0; q < 2; ++q) { const int c = grp * 1280 + c0 + 4 * q; const float* p = PX + (size_t)tau * PXW + PXB + c;
                  const bool hl = has_left(tau), hr = has_right(tau);
                  const f32x4 y = *(const f32x4*)p * *(const f32x4*)(cw + B_IN + c) + *(const f32x4*)(cb + c) + *(const f32x4*)(p - (hl ? PXW : 0)) * (*(const f32x4*)(cw + c) * (hl ? 1.f : 0.f))
                                + *(const f32x4*)(p + (hr ? PXW : 0)) * (*(const f32x4*)(cw + 2 * B_IN + c) * (hr ? 1.f : 0.f));
                  u[grp][q] = y; }
#pragma unroll
          for (int q = 0; q < 2; ++q)
#pragma unroll
              for (int e = 0; e < 4; ++e) { const int ch = (F.tid & 7) * 8 + 4 * q + e; LGt[ch * 65 + t] = u[1][q][e] * u[2][q][e]; LX0[ch * 65 + t] = u[0][q][e]; } }
        __syncthreads();
        { const int ch = F.tid >> 3, t0 = (F.tid & 7) * 8; const size_t o = (size_t)(ct * 64 + ch) * T + tt * 64 + t0;
          f32x4 a0, a1, b0, b1;
#pragma unroll
          for (int e = 0; e < 4; ++e) { a0[e] = LGt[ch * 65 + t0 + e]; a1[e] = LGt[ch * 65 + t0 + 4 + e]; b0[e] = LX0[ch * 65 + t0 + e]; b1[e] = LX0[ch * 65 + t0 + 4 + e]; }
          *(f32x4*)(GT + o) = a0; *(f32x4*)(GT + o + 4) = a1; *(f32x4*)(X0T + o) = b0; *(f32x4*)(X0T + o + 4) = b1; }
        __syncthreads(); }
}
__device__ __forceinline__ void hyena_out_phase(const Frame& F, unsigned char* ws, bool need_ctx) {
    const float* YT = (const float*)(ws + WS_GT); bf16_t* OB = (bf16_t*)(ws + WS_OBUF);
    LAS float* L = (LAS float*)F.lds;
    const int it0 = need_ctx ? 0 : (NCTX / 64) * 20;
    for (int it = it0 + F.bid; it < (T / 64) * 20; it += F.G) { const int tt = it / 20, ct = it % 20;
        { const int ch = F.tid >> 3, t0 = (F.tid & 7) * 8; const size_t o = (size_t)(ct * 64 + ch) * T + tt * 64 + t0;
          const f32x4 a0 = *(const f32x4*)(YT + o), a1 = *(const f32x4*)(YT + o + 4);
#pragma unroll
          for (int e = 0; e < 4; ++e) { L[ch * 65 + t0 + e] = a0[e]; L[ch * 65 + t0 + 4 + e] = a1[e]; } }
        __syncthreads();
        { const int t = F.tid >> 3, c0 = (F.tid & 7) * 8; float x[8];
#pragma unroll
          for (int e = 0; e < 8; ++e) x[e] = L[(c0 + e) * 65 + t];
          u32x4 w; w.x = cvt_pk_bf16(x[0], x[1]); w.y = cvt_pk_bf16(x[2], x[3]); w.z = cvt_pk_bf16(x[4], x[5]); w.w = cvt_pk_bf16(x[6], x[7]);
          *(u32x4*)(OB + (size_t)(tt * 64 + t) * DM + 1280 + ct * 64 + c0) = w; }
        __syncthreads(); }
}
namespace att {
constexpr int DK = 192, DV = 128, NW = 8, QBLK = 32, KVBLK = 64;
constexpr float SCALE = 0.07216878364870322f;
constexpr float THR = 8.f;
#ifndef ATT_SDEPTH
#define ATT_SDEPTH 2
#endif
constexpr int SDEPTH = ATT_SDEPTH;
constexpr int LDQ = 2304, LDK = 2304, LDV = 3072, LDO = 4096;
constexpr int SHM_V = KVBLK * DV * 2, SHM_K = KVBLK * DK * 2, SHM_ATTN = 2 * SHM_V + 2 * SHM_K + NW * 64 * 4 + NW * 4096;
using bf16x8 = __attribute__((ext_vector_type(8))) short;
using s16x4  = __attribute__((ext_vector_type(4))) short;
using f32x16 = __attribute__((ext_vector_type(16))) float;
using u32x4  = __attribute__((ext_vector_type(4))) unsigned;
#define KSWZ(row, colB) ((row) * 384 + ((colB) ^ (((row) & 7) << 4)))
#define SBAR() __builtin_amdgcn_sched_barrier(0)
__device__ __forceinline__ int crow(int r, int hi) { return (r & 3) + 8 * (r >> 2) + 4 * hi; }
__device__ __forceinline__ unsigned cvtpk(float lo, float hi) { unsigned r; asm volatile("v_cvt_pk_bf16_f32 %0, %1, %2" : "=v"(r) : "v"(lo), "v"(hi)); return r; }
__device__ __forceinline__ void partialSM(f32x16& p0, f32x16& p1, float& m_reg, float& mn, float& alpha) {
  constexpr float C = SCALE * 1.4426950408889634f;
  float pmax = p0[0]; for (int r = 1; r < 16; ++r) pmax = fmaxf(pmax, p0[r]); for (int r = 0; r < 16; ++r) pmax = fmaxf(pmax, p1[r]);
  { auto rr = __builtin_amdgcn_permlane32_swap(__float_as_uint(pmax), __float_as_uint(pmax), false, false);
    pmax = fmaxf(__uint_as_float(rr[0]), __uint_as_float(rr[1])); }
  if (__builtin_expect(__all(pmax - m_reg <= THR / SCALE), 1)) { mn = m_reg; alpha = 1.f; }
  else { mn = fmaxf(m_reg, pmax); alpha = __builtin_amdgcn_exp2f((m_reg - mn) * C); m_reg = mn; }
  float mnC = -mn * C;
  for (int r = 0; r < 16; ++r) p0[r] = fmaf(p0[r], C, mnC); for (int r = 0; r < 16; ++r) p1[r] = fmaf(p1[r], C, mnC);
  for (int r = 0; r < 16; ++r) p0[r] = __builtin_amdgcn_exp2f(p0[r]);
}
__device__ __forceinline__ void finishSM(f32x16& p0, f32x16& p1, float alpha, float& l_reg, bf16x8& pa0, bf16x8& pa1, bf16x8& pa2, bf16x8& pa3) {
  for (int r = 0; r < 16; ++r) p1[r] = __builtin_amdgcn_exp2f(p1[r]);
  float ps = 0; for (int r = 0; r < 16; ++r) ps += p0[r]; for (int r = 0; r < 16; ++r) ps += p1[r];
  { auto rr = __builtin_amdgcn_permlane32_swap(__float_as_uint(ps), __float_as_uint(ps), false, false);
    ps = __uint_as_float(rr[0]) + __uint_as_float(rr[1]); }
  l_reg = l_reg * alpha + ps;
#define PK4(P, BASE, OUT) do { unsigned a0 = cvtpk(P[BASE + 0], P[BASE + 1]), a1 = cvtpk(P[BASE + 2], P[BASE + 3]);   \
    unsigned b0 = cvtpk(P[BASE + 4], P[BASE + 5]), b1 = cvtpk(P[BASE + 6], P[BASE + 7]);                              \
    auto r0 = __builtin_amdgcn_permlane32_swap(a0, b0, false, false); auto r1 = __builtin_amdgcn_permlane32_swap(a1, b1, false, false); \
    u32x4 w = {r0[0], r1[0], r0[1], r1[1]}; OUT = *reinterpret_cast<bf16x8*>(&w); } while (0)
  PK4(p0, 0, pa0); PK4(p0, 8, pa1); PK4(p1, 0, pa2); PK4(p1, 8, pa3);
#undef PK4
}
__device__ __forceinline__ void qkt(f32x16& p0, f32x16& p1, const char* Ks, const bf16x8* qr, const char* qrl, int r32, int hi) {
  p0 = f32x16{}; p1 = f32x16{};
#pragma unroll
  for (int d0 = 0; d0 < 8; ++d0) { int cb = (d0 * 16 + hi * 8) * 2;
    bf16x8 b0 = *reinterpret_cast<const bf16x8*>(Ks + KSWZ(r32, cb));
    bf16x8 b1 = *reinterpret_cast<const bf16x8*>(Ks + KSWZ(32 + r32, cb));
    p0 = __builtin_amdgcn_mfma_f32_32x32x16_bf16(b0, qr[d0], p0, 0, 0, 0);
    p1 = __builtin_amdgcn_mfma_f32_32x32x16_bf16(b1, qr[d0], p1, 0, 0, 0); }
#pragma unroll
  for (int d0 = 8; d0 < 12; ++d0) { int cb = (d0 * 16 + hi * 8) * 2;
    bf16x8 b0 = *reinterpret_cast<const bf16x8*>(Ks + KSWZ(r32, cb));
    bf16x8 b1 = *reinterpret_cast<const bf16x8*>(Ks + KSWZ(32 + r32, cb));
    const bf16x8 q = *reinterpret_cast<const bf16x8*>(qrl + ((((d0 - 8) * 2 + hi) ^ (r32 & 7)) << 4));
    p0 = __builtin_amdgcn_mfma_f32_32x32x16_bf16(b0, q, p0, 0, 0, 0);
    p1 = __builtin_amdgcn_mfma_f32_32x32x16_bf16(b1, q, p1, 0, 0, 0); }
}
__device__ __forceinline__ int v_st(int k, int c) { const int kk = (k & ~0xC) | ((k & 4) << 1) | ((k & 8) >> 1); return ((kk >> 3) * 4 + (c >> 5)) * 512 + ((kk & 7) * 32 + (c & 31)) * 2; }
__device__ __forceinline__ int v_rd_base(int lane) { return ((lane & 3) << 3) | (((lane >> 2) & 3) << 6) | (((lane >> 4) & 1) << 5) | (((lane >> 5) & 1) << 8); }
constexpr int v_rd_off(int d0, int ks, int half) { return d0 * 512 + ks * 4096 + half * 2048; }
template <int OFF> __device__ __forceinline__ s16x4 tr_read(int vb) {
  s16x4 r; asm volatile("ds_read_b64_tr_b16 %0, %1 offset:%2" : "=&v"(r) : "v"(vb), "i"(OFF) : "memory"); return r;
}
template <int D0> __device__ __forceinline__ void pv_one(f32x16& od, int vb, bf16x8 pa0, bf16x8 pa1, bf16x8 pa2, bf16x8 pa3) {
  const s16x4 l0 = tr_read<v_rd_off(D0, 0, 0)>(vb), h0 = tr_read<v_rd_off(D0, 0, 1)>(vb), l1 = tr_read<v_rd_off(D0, 1, 0)>(vb), h1 = tr_read<v_rd_off(D0, 1, 1)>(vb);
  const s16x4 l2 = tr_read<v_rd_off(D0, 2, 0)>(vb), h2 = tr_read<v_rd_off(D0, 2, 1)>(vb), l3 = tr_read<v_rd_off(D0, 3, 0)>(vb), h3 = tr_read<v_rd_off(D0, 3, 1)>(vb);
  asm volatile("s_waitcnt lgkmcnt(0)" ::: "memory"); SBAR();
#define PK(L, H) (bf16x8){L[0], L[1], L[2], L[3], H[0], H[1], H[2], H[3]}
  od = __builtin_amdgcn_mfma_f32_32x32x16_bf16(pa0, PK(l0, h0), od, 0, 0, 0);
  od = __builtin_amdgcn_mfma_f32_32x32x16_bf16(pa1, PK(l1, h1), od, 0, 0, 0);
  od = __builtin_amdgcn_mfma_f32_32x32x16_bf16(pa2, PK(l2, h2), od, 0, 0, 0);
  od = __builtin_amdgcn_mfma_f32_32x32x16_bf16(pa3, PK(l3, h3), od, 0, 0, 0);
#undef PK
}
__device__ __forceinline__ void pv_d0(f32x16* o, int vb, bf16x8 pa0, bf16x8 pa1, bf16x8 pa2, bf16x8 pa3) {
  pv_one<0>(o[0], vb, pa0, pa1, pa2, pa3); pv_one<1>(o[1], vb, pa0, pa1, pa2, pa3); pv_one<2>(o[2], vb, pa0, pa1, pa2, pa3); pv_one<3>(o[3], vb, pa0, pa1, pa2, pa3);
}
__device__ __forceinline__ void attn_body(const bf16_t* __restrict__ Qb, const bf16_t* __restrict__ Kh, const bf16_t* __restrict__ Vh, bf16_t* __restrict__ Ob, int seq, char* lds) {
  int tid_ = threadIdx.x; asm volatile("" : "+v"(tid_));
  const int tid = tid_, wid = tid >> 6, lane = tid & 63, r32 = lane & 31, hi = lane >> 5;
  char* V_lds = lds; char* K_lds = lds + 2 * SHM_V;
  float* ws = (float*)(lds + 2 * SHM_V + 2 * SHM_K) + wid * 64; float* li_l = ws; float* al_l = ws + 32;
  float m_reg = -1e30f, l_reg = 0; f32x16 o[4] = {}; bf16x8 qr[8];
  const bf16_t* Qw = Qb + (long)(wid * QBLK + r32) * LDQ + hi * 8;
  char* qrl = lds + 2 * SHM_V + 2 * SHM_K + NW * 64 * 4 + wid * 4096 + r32 * 128;
#pragma unroll
  for (int d0 = 0; d0 < 8; ++d0) qr[d0] = *reinterpret_cast<const bf16x8*>(Qw + d0 * 16);
#pragma unroll
  for (int d0 = 8; d0 < 12; ++d0) *reinterpret_cast<bf16x8*>(qrl + ((((d0 - 8) * 2 + hi) ^ (r32 & 7)) << 4)) = *reinterpret_cast<const bf16x8*>(Qw + d0 * 16);
  asm volatile("s_waitcnt lgkmcnt(0)" ::: "memory");
  unsigned kgo[3], vgo[2];
#pragma unroll
  for (int i = 0; i < 3; ++i) { const int p = (i * 8 + wid) * 64 + lane, row = p / 24, slot = p % 24, ch = slot ^ (row & 7); kgo[i] = (unsigned)(row * LDK + ch * 8) * 2u; }
#pragma unroll
  for (int i = 0; i < 2; ++i) { const int p = (i * 8 + wid) * 64 + lane, sub = p >> 5, within = p & 31, kk = (sub >> 2) * 8 + (within >> 2), c = (sub & 3) * 32 + (within & 3) * 8;
    const int k = (kk & ~0xC) | ((kk & 4) << 1) | ((kk & 8) >> 1); vgo[i] = (unsigned)(k * LDV + c) * 2u; }
  const int vb0 = (int)(uintptr_t)V_lds + v_rd_base(lane);
  typedef __attribute__((address_space(3))) unsigned lds_u32;
#define DMA_K(b, k0) do { const char* kg = (const char*)Kh + (size_t)(k0) * (LDK * 2); \
    _Pragma("unroll") for (int _i = 0; _i < 3; ++_i) __builtin_amdgcn_global_load_lds((const unsigned*)(kg + kgo[_i]), (lds_u32*)(K_lds + (b) * SHM_K + (_i * 8 + wid) * 1024), 16, 0, 0); } while (0)
#define DMA_V(b, k0) do { const char* vg = (const char*)Vh + (size_t)(k0) * (LDV * 2); \
    _Pragma("unroll") for (int _i = 0; _i < 2; ++_i) __builtin_amdgcn_global_load_lds((const unsigned*)(vg + vgo[_i]), (lds_u32*)(V_lds + (b) * SHM_V + (_i * 8 + wid) * 1024), 16, 0, 0); } while (0)
#define RESC(a) do { if (__any((a) < 1.f)) { if (hi == 0) al_l[r32] = (a); asm volatile("s_waitcnt lgkmcnt(0)" ::: "memory"); \
    for (int d = 0; d < 4; ++d) for (int r = 0; r < 16; ++r) o[d][r] *= al_l[crow(r, hi)]; } } while (0)
#define ENDSTEP() do { asm volatile("s_waitcnt vmcnt(0)" ::: "memory"); __syncthreads(); } while (0)
  f32x16 pA0, pA1, pB0, pB1; float mnA, mnB, alA, alB; bf16x8 pa0, pa1, pa2, pa3; const int NT = seq / KVBLK;
  DMA_K(0, 0); ENDSTEP();
  DMA_K(1, KVBLK); DMA_V(0, 0);
  qkt(pA0, pA1, K_lds, qr, qrl, r32, hi); partialSM(pA0, pA1, m_reg, mnA, alA);
  ENDSTEP();
  for (int j = 1; j + 1 < NT; j += 2) {
    DMA_K(0, (j + 1) * KVBLK); DMA_V(1, j * KVBLK);
    SBAR(); qkt(pB0, pB1, K_lds + SHM_K, qr, qrl, r32, hi);
    finishSM(pA0, pA1, alA, l_reg, pa0, pa1, pa2, pa3); SBAR();
    pv_d0(o, vb0, pa0, pa1, pa2, pa3); partialSM(pB0, pB1, m_reg, mnB, alB);
    RESC(alB); ENDSTEP();
    if (j + 2 < NT) DMA_K(1, (j + 2) * KVBLK);
    DMA_V(0, (j + 1) * KVBLK);
    SBAR(); qkt(pA0, pA1, K_lds, qr, qrl, r32, hi);
    finishSM(pB0, pB1, alB, l_reg, pa0, pa1, pa2, pa3); SBAR();
    pv_d0(o, vb0 + (int)SHM_V, pa0, pa1, pa2, pa3); partialSM(pA0, pA1, m_reg, mnA, alA);
    RESC(alA); ENDSTEP();
  }
  DMA_V(1, (NT - 1) * KVBLK);
  SBAR(); qkt(pB0, pB1, K_lds + SHM_K, qr, qrl, r32, hi);
  finishSM(pA0, pA1, alA, l_reg, pa0, pa1, pa2, pa3); SBAR();
  pv_d0(o, vb0, pa0, pa1, pa2, pa3); partialSM(pB0, pB1, m_reg, mnB, alB);
  RESC(alB); ENDSTEP();
  finishSM(pB0, pB1, alB, l_reg, pa0, pa1, pa2, pa3); SBAR();
  pv_d0(o, vb0 + (int)SHM_V, pa0, pa1, pa2, pa3);
#undef DMA_K
#undef DMA_V
#undef ENDSTEP
  if (hi == 0) li_l[r32] = l_reg; asm volatile("s_waitcnt lgkmcnt(0)" ::: "memory");
  float rli[16];
#pragma unroll
  for (int r = 0; r < 16; ++r) rli[r] = __builtin_amdgcn_rcpf(li_l[crow(r, hi)]);
  bf16_t* Ow = Ob + (long)(wid * QBLK) * LDO;
#pragma unroll
  for (int r = 0; r < 16; ++r) { int orow = crow(r, hi);
#pragma unroll
    for (int d0 = 0; d0 < 4; ++d0) { const float val = o[d0][r] * rli[r]; Ow[(long)orow * LDO + d0 * 32 + r32] = (bf16_t)(cvtpk(val, val) & 0xffff); } }
  __syncthreads();
#undef RESC
}
}
__device__ __forceinline__ f32x2 cmul(f32x2 a, f32x2 b) { return (f32x2){a.x * b.x - a.y * b.y, a.x * b.y + a.y * b.x}; }
__device__ __forceinline__ int rev4_14(int k) { const unsigned r = __brev((unsigned)k) >> 18; return (int)(((r & 0x1555u) << 1) | ((r >> 1) & 0x1555u)); }
#define ZI(i) ((i) + ((i) >> 5))
__device__ __forceinline__ void fft16k_dif(LAS f32x2* Z, int tid) {
#pragma unroll 1
    for (int s = 0; s < 7; ++s) { int lq = 12 - 2 * s; asm volatile("" : "+s"(lq)); const int q = 1 << lq;
#pragma unroll 2
        for (int i = 0; i < 8; ++i) { const int b = tid + 512 * i, j = b & (q - 1), base = ((b >> lq) << (lq + 2)) + j;
            const int i0 = ZI(base), i1 = ZI(base + q), i2 = ZI(base + 2 * q), i3 = ZI(base + 3 * q);
            const f32x2 a0 = Z[i0], a1 = Z[i1], a2 = Z[i2], a3 = Z[i3];
            const f32x2 t0 = a0 + a2, t1 = a0 - a2, t2 = a1 + a3, t3 = a1 - a3;
            const float rev = (float)j / (float)(4 * q); const float sn = __builtin_amdgcn_sinf(rev), cs = __builtin_amdgcn_cosf(rev);
            const f32x2 w1 = (f32x2){cs, -sn}, w2 = cmul(w1, w1), w3 = cmul(w2, w1);
            Z[i0] = t0 + t2; Z[i1] = cmul((f32x2){t1.x + t3.y, t1.y - t3.x}, w1); Z[i2] = cmul(t0 - t2, w2); Z[i3] = cmul((f32x2){t1.x - t3.y, t1.y + t3.x}, w3); }
        __syncthreads(); }
}
__device__ __forceinline__ void fft16k_dit_inv(LAS f32x2* Z, int tid) {
#pragma unroll 1
    for (int s = 0; s < 7; ++s) { int lq = 2 * s; asm volatile("" : "+s"(lq)); const int q = 1 << lq;
#pragma unroll 2
        for (int i = 0; i < 8; ++i) { const int b = tid + 512 * i, j = b & (q - 1), base = ((b >> lq) << (lq + 2)) + j;
            const float rev = (float)j / (float)(4 * q); const float sn = __builtin_amdgcn_sinf(rev), cs = __builtin_amdgcn_cosf(rev);
            const f32x2 w1 = (f32x2){cs, sn}, w2 = cmul(w1, w1), w3 = cmul(w2, w1);
            const int i0 = ZI(base), i1 = ZI(base + q), i2 = ZI(base + 2 * q), i3 = ZI(base + 3 * q);
            const f32x2 b0 = Z[i0], b1 = cmul(Z[i1], w1), b2 = cmul(Z[i2], w2), b3 = cmul(Z[i3], w3);
            const f32x2 t0 = b0 + b2, t1 = b0 - b2, t2 = b1 + b3, t3 = b1 - b3;
            Z[i0] = t0 + t2; Z[i1] = (f32x2){t1.x - t3.y, t1.y + t3.x}; Z[i2] = t0 - t2; Z[i3] = (f32x2){t1.x + t3.y, t1.y - t3.x}; }
        __syncthreads(); }
}
constexpr float HY_MIN_DECAY = -3.0701134573253945f, HY_MAX_DECAY = -15.350567286626973f;
__device__ __forceinline__ float hy_delta(int c) { return fabsf(HY_MIN_DECAY + (HY_MAX_DECAY - HY_MIN_DECAY) * ((float)c / 1279.0f)); }
__device__ __forceinline__ float conv3b_at(const float* PX, int tau, int col, const float* cw, int l, int c) {
    const float* w = cw + (size_t)l * 3 * B_IN;
    return conv3_at(PX, tau, col, w[c], w[B_IN + c], w[2 * B_IN + c]);
}
__device__ __forceinline__ void hyena_unit(const Frame& F, unsigned char* ws, int l, int pair) {
    LAS f32x2* Z = (LAS f32x2*)F.lds; LAS float* red = (LAS float*)(F.lds + LDS_MISC + 128);
    const int tid = F.tid, c0 = 2 * pair;
    const bf16_t* H3x = (const bf16_t*)(ws + WS_H3) + (size_t)l * 64 * T + NCTX;
    float* GT = (float*)(ws + WS_GT); const float* X0T = (const float*)(ws + WS_X0T);
    f32x2* scr = (f32x2*)(ws + WS_HSCR) + (size_t)F.bid * 16384;
    LAS f32x4* FW = (LAS f32x4*)(F.lds + LDS_MISC + 256);
    if (tid < 256) { const int j = tid >> 2, q = tid & 3; ((LAS float*)FW)[tid] = IN_(35)[(size_t)l * 64 * 2560 + (size_t)j * 2560 + (q >> 1) * 1280 + c0 + (q & 1)]; }
    __syncthreads();
    const float d0 = hy_delta(c0), d1 = hy_delta(c0 + 1);
#ifndef HYS
#define HYS 31
#endif
    float s0, s1, sc0 = 0.f, sc1 = 0.f;
    for (int rp14 = 0; rp14 < REP(14); ++rp14) {
    s0 = 0.f; s1 = 0.f;
    if (HYS & 1)
#pragma unroll 1
    for (int i = 0; i < 2; ++i) { const int tb = 4096 * i + 8 * tid; const bf16_t* hc = H3x + tb;
        asm volatile("" ::: "memory");
        f32x4 acc[8];
#pragma unroll
        for (int p = 0; p < 8; ++p) acc[p] = (f32x4){0.f, 0.f, 0.f, 0.f};
#pragma unroll 8
        for (int j = 0; j < 64; ++j) { const f32x4 w = FW[j]; const u32x4 hv = *(const u32x4*)(hc + (size_t)j * T);
#pragma unroll
            for (int p = 0; p < 4; ++p) { acc[2 * p] += w * __uint_as_float(hv[p] << 16); acc[2 * p + 1] += w * __uint_as_float(hv[p] & 0xffff0000u); } }
#pragma unroll
        for (int p = 0; p < 8; ++p) { const int t = tb + p;
            const float tl = (float)t * (1.0f / 8191.0f), e0 = __expf(-tl * d0), e1 = __expf(-tl * d1);
            const float f0 = acc[p].x * e0, f1 = acc[p].y * e1, b0 = acc[p].z * e0, b1 = acc[p].w * e1;
            Z[ZI(t)] = (f32x2){f0, f1}; s0 += fabsf(f0); s1 += fabsf(f1);
            if (t < 8191) { Z[ZI(16383 - t)] = (f32x2){b0, b1}; s0 += fabsf(b0); s1 += fabsf(b1); } } }
    if (tid == 0) { float zz = 0.f; asm volatile("" : "+v"(zz)); Z[ZI(8192)] = (f32x2){zz, zz}; }
    s0 = wave_sum(s0); s1 = wave_sum(s1);
    if (F.lane == 0) { red[F.wave * 2] = s0; red[F.wave * 2 + 1] = s1; }
    __syncthreads();
    float n0 = 0.f, n1 = 0.f;
#pragma unroll
    for (int w = 0; w < 8; ++w) { n0 += red[2 * w]; n1 += red[2 * w + 1]; }
    sc0 = 1.0f / (16384.0f * n0); sc1 = 1.0f / (16384.0f * n1);
    if (HYS & 2) fft16k_dif(Z, tid);
#pragma unroll 4
    for (int i = 0; i < 32; ++i) scr[tid + 512 * i] = Z[ZI(tid + 512 * i)];
    __syncthreads();
    }
    for (int rp15 = 0; rp15 < REP(15); ++rp15) {
    const float* g0p = GT + (size_t)c0 * T + NCTX; const float* g1p = g0p + T;
    { float zz = 0.f; asm volatile("" : "+v"(zz));
#pragma unroll 4
      for (int i = 0; i < 16; ++i) { const int t = tid + 512 * i; Z[ZI(t)] = (f32x2){g0p[t], g1p[t]}; Z[ZI(8192 + t)] = (f32x2){zz, zz}; } }
    __syncthreads();
    if (HYS & 2) fft16k_dif(Z, tid);
    if (HYS & 8)
#pragma unroll 2
    for (int i = 0; i < 17; ++i) { const int k = tid + 512 * i; if (i == 16 && tid != 0) break;
        const int pk = rev4_14(k & 16383), pn = rev4_14((16384 - k) & 16383);
        const f32x2 A = Z[ZI(pk)], B = Z[ZI(pn)], At = scr[pk], Bt = scr[pn];
        const f32x2 G0 = (f32x2){0.5f * (A.x + B.x), 0.5f * (A.y - B.y)}, G1 = (f32x2){0.5f * (A.y + B.y), -0.5f * (A.x - B.x)};
        const f32x2 H0 = (f32x2){0.5f * (At.x + Bt.x), 0.5f * (At.y - Bt.y)}, H1 = (f32x2){0.5f * (At.y + Bt.y), -0.5f * (At.x - Bt.x)};
        const f32x2 P0 = cmul(G0, H0), P1 = cmul(G1, H1);
        Z[ZI(pk)] = (f32x2){P0.x - P1.y, P0.y + P1.x};
        if (pn != pk) Z[ZI(pn)] = (f32x2){P0.x + P1.y, P1.x - P0.y}; }
    __syncthreads();
    if (HYS & 2) fft16k_dit_inv(Z, tid);
    }
    const float bb0 = IN_(37)[l * 1280 + c0], bb1 = IN_(37)[l * 1280 + c0 + 1];
    { float* y0p = GT + (size_t)c0 * T + NCTX; float* y1p = y0p + T; const float* x0p = X0T + (size_t)c0 * T + NCTX; const float* x1p = x0p + T;
#pragma unroll 4
      for (int i = 0; i < 16; ++i) { const int t = tid + 512 * i; const f32x2 z = Z[ZI(t)]; const float ga = y0p[t], gb = y1p[t];
          y0p[t] = x0p[t] * (z.x * sc0 + ga * bb0); y1p[t] = x1p[t] * (z.y * sc1 + gb * bb1); } }
    __syncthreads();
}
__device__ __forceinline__ void hyena_ctx_unit(const Frame& F, unsigned char* ws, int l, int unit) {
    LAS float* TF = (LAS float*)F.lds; LAS float* TB = TF + 2048; LAS float* GG = TB + 2048;
    const int tid = F.tid, t = tid >> 1, cc = (tid & 1) * 4, cbase = unit * 8 + cc;
    const bf16_t* H3c = (const bf16_t*)(ws + WS_H3) + (size_t)l * 64 * T; float* GT = (float*)(ws + WS_GT); const float* X0T = (const float*)(ws + WS_X0T);
    { float f[4] = {0.f, 0.f, 0.f, 0.f}, b[4] = {0.f, 0.f, 0.f, 0.f};
      const float* wbase = IN_(35) + (size_t)l * 64 * 2560 + cbase;
      for (int j = 0; j < 64; ++j) { const float hv = bf2f(H3c[(size_t)j * T + t]); const float* wrow = wbase + (size_t)j * 2560;
#pragma unroll
          for (int q = 0; q < 4; ++q) { f[q] += hv * wrow[q]; b[q] += hv * wrow[1280 + q]; } }
      const float tl = (float)t * (1.0f / 255.0f);
#pragma unroll
      for (int q = 0; q < 4; ++q) { const float e = __expf(-tl * hy_delta(cbase + q)); TF[t * 8 + cc + q] = f[q] * e; TB[t * 8 + cc + q] = b[q] * e; GG[t * 8 + cc + q] = GT[(size_t)(cbase + q) * T + t]; } }
    __syncthreads();
    float nrm[4] = {0.f, 0.f, 0.f, 0.f}, y[4] = {0.f, 0.f, 0.f, 0.f};
    for (int s = 0; s < 256; ++s) {
#pragma unroll
        for (int q = 0; q < 4; ++q) { nrm[q] += fabsf(TF[s * 8 + cc + q]) + (s < 255 ? fabsf(TB[s * 8 + cc + q]) : 0.f);
            const int o = t - s; const float tap = o >= 0 ? TF[o * 8 + cc + q] : TB[(-o - 1) * 8 + cc + q];
            y[q] += tap * GG[s * 8 + cc + q]; } }
    __syncthreads();
#pragma unroll
    for (int q = 0; q < 4; ++q) GT[(size_t)(cbase + q) * T + t] = X0T[(size_t)(cbase + q) * T + t] * (y[q] / nrm[q] + GG[t * 8 + cc + q] * IN_(37)[l * 1280 + cbase + q]);
    __syncthreads();
}
constexpr int SC_C = 16, SC_NCHUNK = T / SC_C, SC_CHUNK_BYTES = 14 * 1024;
__device__ __forceinline__ int sc_tau(int d, int c, int t) { return d == 0 ? SC_C * c + t : (c < NCTX / SC_C ? NCTX - 1 - SC_C * c - t : T - 1 - SC_C * (c - NCTX / SC_C) - t); }
__device__ __forceinline__ int sc_perm(int e, int hi) { return (e & 3) + 8 * (e >> 2) + 4 * hi; }
constexpr size_t WS_FR_BYTES = (size_t)2 * NHA * SC_NCHUNK * SC_CHUNK_BYTES;

typedef short sc_bf16x8 __attribute__((ext_vector_type(8)));
typedef float sc_f32x16 __attribute__((ext_vector_type(16)));
__device__ __forceinline__ sc_bf16x8 sc_pack8(const sc_f32x16& a, int base) {
    u32x4 w; w.x = cvt_pk_bf16(a[base + 0], a[base + 1]); w.y = cvt_pk_bf16(a[base + 2], a[base + 3]); w.z = cvt_pk_bf16(a[base + 4], a[base + 5]); w.w = cvt_pk_bf16(a[base + 6], a[base + 7]);
    return *reinterpret_cast<sc_bf16x8*>(&w);
}
constexpr int SC_NSLOT = 9, SC_AHEAD = 7;
__device__ __forceinline__ void scan_chain_mfma(const Frame& F, unsigned char* ws, int chain) {
    const int h = chain >> 1, d = chain & 1, lane = F.lane, n = lane & 31, hi = lane >> 5, ib = F.wave;
    const unsigned char* FRc = ws + WS_FR + (size_t)chain * SC_NCHUNK * SC_CHUNK_BYTES;
    float* Yd = (float*)(ws + WS_Y) + (size_t)d * T * A_W + h * 64;
    LAS unsigned char* buf = F.lds;
    typedef __attribute__((address_space(3))) unsigned sc_lds_u32;
#define SCM_DMA(c_) do { if (ib < 7) { const unsigned char* src_ = FRc + (size_t)(c_) * SC_CHUNK_BYTES; LAS unsigned char* dst_ = buf + ((c_) % SC_NSLOT) * SC_CHUNK_BYTES; \
        _Pragma("unroll") for (int i_ = 0; i_ < 2; ++i_) __builtin_amdgcn_global_load_lds((const unsigned*)(src_ + (i_ * 7 + ib) * 1024 + lane * 16), (sc_lds_u32*)(dst_ + (i_ * 7 + ib) * 1024), 16, 0, 0); } } while (0)
    sc_f32x16 S0 = {}, S1 = {};
    int yoff[8];
#pragma unroll
    for (int r = 0; r < 8; ++r) { const int t = (r & 3) + 8 * (r >> 2) + 4 * hi; yoff[r] = (d ? -t : t) * A_W + 32 * ib + n; }
    __syncthreads();
#pragma unroll
    for (int c = 0; c < SC_AHEAD; ++c) SCM_DMA(c);
    asm volatile("s_waitcnt vmcnt(12)" ::: "memory"); __builtin_amdgcn_s_barrier(); asm volatile("" ::: "memory");
#pragma unroll 1
    for (int c = 0; c < SC_NCHUNK; ++c) {
        const bool steady = c + SC_AHEAD < SC_NCHUNK;
        if (steady) SCM_DMA(c + SC_AHEAD);
        if (ib < 2) {
                const LAS unsigned char* fb = buf + (c % SC_NSLOT) * SC_CHUNK_BYTES;
                sc_bf16x8 fr[11]; sc_bf16x8 vf; f32x4 gt[8];
                { const unsigned fa = (unsigned)(uintptr_t)fb + lane * 16, va = fa + (11 + ib) * 1024, ga = (unsigned)(uintptr_t)fb + 13 * 1024 + hi * 128;
#define SC_DSRD(dst, addr, off) asm volatile("ds_read_b128 %0, %1 offset:%2" : "=v"(dst) : "v"(addr), "i"(off))
                  SC_DSRD(fr[0], fa, 0); SC_DSRD(fr[1], fa, 1024); SC_DSRD(fr[2], fa, 2048); SC_DSRD(fr[3], fa, 3072); SC_DSRD(fr[4], fa, 4096); SC_DSRD(fr[5], fa, 5120);
                  SC_DSRD(fr[6], fa, 6144); SC_DSRD(fr[7], fa, 7168); SC_DSRD(fr[8], fa, 8192); SC_DSRD(fr[9], fa, 9216); SC_DSRD(fr[10], fa, 10240); SC_DSRD(vf, va, 0);
                  SC_DSRD(gt[0], ga, 0); SC_DSRD(gt[1], ga, 16); SC_DSRD(gt[2], ga, 32); SC_DSRD(gt[3], ga, 48); SC_DSRD(gt[4], ga, 64); SC_DSRD(gt[5], ga, 80); SC_DSRD(gt[6], ga, 96); SC_DSRD(gt[7], ga, 112);
#undef SC_DSRD
                  asm volatile("s_waitcnt lgkmcnt(0)" : "+v"(fr[0]), "+v"(fr[1]), "+v"(fr[2]), "+v"(fr[3]), "+v"(fr[4]), "+v"(fr[5]), "+v"(fr[6]), "+v"(fr[7]), "+v"(fr[8]), "+v"(fr[9]), "+v"(fr[10]), "+v"(vf) :: "memory");
                  asm volatile("" : "+v"(gt[0]), "+v"(gt[1]), "+v"(gt[2]), "+v"(gt[3]), "+v"(gt[4]), "+v"(gt[5]), "+v"(gt[6]), "+v"(gt[7])); }
                const sc_bf16x8 sb00 = sc_pack8(S0, 0), sb01 = sc_pack8(S0, 8), sb10 = sc_pack8(S1, 0), sb11 = sc_pack8(S1, 8);
                sc_f32x16 P = {}, P2 = {};
                P = __builtin_amdgcn_mfma_f32_32x32x16_bf16(fr[0], sb00, P, 0, 0, 0);
                P2 = __builtin_amdgcn_mfma_f32_32x32x16_bf16(fr[2], sb10, P2, 0, 0, 0);
                P = __builtin_amdgcn_mfma_f32_32x32x16_bf16(fr[1], sb01, P, 0, 0, 0);
                P2 = __builtin_amdgcn_mfma_f32_32x32x16_bf16(fr[3], sb11, P2, 0, 0, 0);
                P = __builtin_amdgcn_mfma_f32_32x32x16_bf16(fr[4], vf, P, 0, 0, 0);
#pragma unroll
                for (int q = 0; q < 4; ++q)
#pragma unroll
                    for (int e = 0; e < 4; ++e) { S0[4 * q + e] *= gt[q][e]; S1[4 * q + e] *= gt[4 + q][e]; }
                S0 = __builtin_amdgcn_mfma_f32_32x32x16_bf16(fr[8], vf, S0, 0, 0, 0);
                S1 = __builtin_amdgcn_mfma_f32_32x32x16_bf16(fr[10], vf, S1, 0, 0, 0);
#pragma unroll
                for (int r = 0; r < 16; ++r) P[r] += P2[r];
                const sc_bf16x8 xb = sc_pack8(P, 0);
                sc_f32x16 U = {};
                U = __builtin_amdgcn_mfma_f32_32x32x16_bf16(fr[5], xb, U, 0, 0, 0);
                const sc_bf16x8 ub = sc_pack8(U, 0);
                S0 = __builtin_amdgcn_mfma_f32_32x32x16_bf16(fr[7], ub, S0, 0, 0, 0);
                S1 = __builtin_amdgcn_mfma_f32_32x32x16_bf16(fr[9], ub, S1, 0, 0, 0);
                P = __builtin_amdgcn_mfma_f32_32x32x16_bf16(fr[6], ub, P, 0, 0, 0);
                float* yb = Yd + (size_t)sc_tau(d, c, 0) * A_W;
#pragma unroll
                for (int r = 0; r < 8; ++r) yb[yoff[r]] = P[8 + r];
        }
        if (steady) asm volatile("s_waitcnt vmcnt(12)" ::: "memory"); else asm volatile("s_waitcnt vmcnt(0)" ::: "memory");
        asm volatile("s_waitcnt lgkmcnt(0)" ::: "memory"); __builtin_amdgcn_s_barrier(); asm volatile("" ::: "memory");
    }
    asm volatile("s_waitcnt vmcnt(0)" ::: "memory"); __syncthreads();
#undef SCM_DMA
}
__device__ __forceinline__ float conv3_u(const float* PX, int tau, unsigned ucol, float w0, float w1, float w2) {
    const float* p = PX + (size_t)tau * PXW;
    float y = p[ucol] * w1;
    if (has_left(tau)) y += (p - PXW)[ucol] * w0;
    if (has_right(tau)) y += (p + PXW)[ucol] * w2;
    return y;
}
constexpr int WLR_K = 448;
constexpr int RP_WAVE_LDS = 16896;
typedef short rp_bf16x8 __attribute__((ext_vector_type(8)));
typedef float rp_f32x16 __attribute__((ext_vector_type(16)));
__device__ __forceinline__ unsigned short f2bf16(float x) { return (unsigned short)(cvt_pk_bf16(x, x) & 0xffffu); }
template <int NKB, class AF>
__device__ __forceinline__ void rp_lowrank(float (&dst)[16], const AF& afrag, const bf16_t* WLRh, int kw0, int n, int hi) {
    rp_f32x16 c0 = {}, c1 = {}; const bf16_t* wb0 = WLRh + (size_t)n * WLR_K + kw0 + 8 * hi; const bf16_t* wb1 = wb0 + (size_t)32 * WLR_K;
#pragma unroll
    for (int kb = 0; kb < NKB; ++kb) { const rp_bf16x8 b0 = *(const rp_bf16x8*)(wb0 + 16 * kb), b1 = *(const rp_bf16x8*)(wb1 + 16 * kb); const rp_bf16x8 a_ = afrag(kb);
        c0 = __builtin_amdgcn_mfma_f32_32x32x16_bf16(a_, b0, c0, 0, 0, 0); c1 = __builtin_amdgcn_mfma_f32_32x32x16_bf16(a_, b1, c1, 0, 0, 0); }
#pragma unroll
    for (int r = 0; r < 8; ++r) { auto sw = __builtin_amdgcn_permlane32_swap(__float_as_uint(c0[r]), __float_as_uint(c1[r]), false, false);
        dst[(r & 3) + 8 * (r >> 2)] = __uint_as_float(sw[0]); dst[(r & 3) + 8 * (r >> 2) + 4] = __uint_as_float(sw[1]); }
}
struct RpAfLds { const LAS bf16_t* base; __device__ __forceinline__ rp_bf16x8 operator()(int kb) const { return *(const LAS rp_bf16x8*)(base + 16 * kb); } };
__device__ __forceinline__ void rwkv_elem_phase(const Frame& F, unsigned char* ws, int l) {
    const float* PX = (const float*)(ws + WS_PX); float* SS = (float*)(ws + WS_SS); float* SD = (float*)(ws + WS_SD); float* GB = (float*)(ws + WS_G);
    const bf16_t* WLR = (const bf16_t*)(ws + WS_WLR) + (size_t)l * A_W * WLR_K;
    const float* cw = IN_(16) + (size_t)l * 3 * A_IN;
    LAS bf16_t* ACT = (LAS bf16_t*)(F.lds + F.wave * 10752);
    const int lane = F.lane, n = lane & 31, hi = lane >> 5;
    const int gw = F.bid * 8 + F.wave, NGW = F.G * 8;
    for (int it = gw; it < (T / 16) * 10; it += NGW) {
        const int tg = it / 10, hq = it % 10, tau0 = tg * 16;
        asm volatile("s_waitcnt lgkmcnt(0)" ::: "memory");
        const float* prow0 = PX + (size_t)(tau0 > 0 ? tau0 - 1 : 0) * PXW; const int roff = tau0 > 0 ? 0 : -1;
#define RP_WIN(x, ucol_) do { _Pragma("unroll") for (int i_ = 0; i_ < 18; ++i_) { int ri_ = i_ + roff; ri_ = ri_ < 0 ? 0 : ri_; ri_ = (tau0 - 1 + i_ > T - 1) ? (T - 1 - (tau0 > 0 ? tau0 - 1 : 0)) : ri_; x[i_] = (prow0 + (size_t)ri_ * PXW)[ucol_]; } } while (0)
#define RP_CONV(x, t_, w0_, w1_, w2_) (x[(t_)] * (has_left(tau0 + (t_)) ? (w0_) : 0.f) + x[(t_) + 1] * (w1_) + x[(t_) + 2] * (has_right(tau0 + (t_)) ? (w2_) : 0.f))
#pragma unroll
        for (int i = 0; i < 5; ++i) { const int c = lane + 64 * i, col = 3840 + c; const float c0 = cw[col], c1 = cw[A_IN + col], c2 = cw[2 * A_IN + col];
            float x[18]; RP_WIN(x, (unsigned)(PXA + col));
#pragma unroll
            for (int t = 0; t < 16; ++t) { const float val = RP_CONV(x, t, c0, c1, c2);
                const float act = i == 0 ? 1.0f - 2.0f / (1.0f + __expf(2.0f * val)) : (i == 1 ? val : sigmoidf_(val));
                ACT[t * 328 + c] = f2bf16(act); } }
        asm volatile("s_waitcnt lgkmcnt(0)" ::: "memory");
        const RpAfLds afw{ACT + (n & 15) * 328 + 8 * hi}, afa{ACT + (n & 15) * 328 + 64 + 8 * hi}, afg{ACT + (n & 15) * 328 + 128 + 8 * hi};
#pragma unroll 1
        for (int hh = 0; hh < 2; ++hh) {
            const int h = hq * 2 + hh, col = h * 64 + lane; const bf16_t* WLRh = WLR + (size_t)h * 64 * WLR_K;
            { float lg[16]; rp_lowrank<12>(lg, afg, WLRh, 256, n, hi);
#pragma unroll
              for (int t = 0; t < 16; ++t) GB[(size_t)(tau0 + t) * A_W + col] = lg[t]; }
            const float cr0 = cw[col], cr1 = cw[A_IN + col], cr2 = cw[2 * A_IN + col];
            const float ck0 = cw[A_W + col], ck1 = cw[A_IN + A_W + col], ck2 = cw[2 * A_IN + A_W + col];
            const float cv0 = cw[2 * A_W + col], cv1 = cw[A_IN + 2 * A_W + col], cv2 = cw[2 * A_IN + 2 * A_W + col];
            const float kk_w = IN_(22)[l * A_W + col], ka_w = IN_(23)[l * A_W + col];
            float kkv[16], kv[16];
            { float xr[18], xk[18], xv[18]; const unsigned uc = (unsigned)(PXA + col); RP_WIN(xr, uc); RP_WIN(xk, uc + A_W); RP_WIN(xv, uc + 2 * A_W);
#pragma unroll
              for (int t = 0; t < 16; ++t) { const int tau = tau0 + t;
                  const float r = RP_CONV(xr, t, cr0, cr1, cr2), v = RP_CONV(xv, t, cv0, cv1, cv2); kv[t] = RP_CONV(xk, t, ck0, ck1, ck2);
                  const float kr = kv[t] * kk_w; const float nrm = sqrtf(wave_sum(kr * kr)); kkv[t] = kr / fmaxf(nrm, 1e-12f);
                  float* ss = SS + ((size_t)h * T + tau) * 192 + lane; ss[0] = kkv[t]; ss[64] = r; ss[128] = v; } }
#pragma unroll 1
            for (int d = 0; d < 2; ++d) { const float w0b = IN_(17)[(l * 2 + d) * A_W + col], a0b = IN_(19)[(l * 2 + d) * A_W + col]; float lw[16], la[16];
                rp_lowrank<4>(lw, afw, WLRh, 64 * d, n, hi); rp_lowrank<4>(la, afa, WLRh, 128 + 64 * d, n, hi);
#pragma unroll
                for (int t = 0; t < 16; ++t) { const float z = w0b + lw[t]; const float decay = __expf(-__expf(-(fmaxf(-z, 0.f) + __logf(1.0f + __expf(-fabsf(z)))) - 0.5f)); const float av = sigmoidf_(a0b + la[t]);
                    float* sd = SD + (((size_t)h * 2 + d) * T + tau0 + t) * 192 + lane; sd[0] = decay; sd[64] = kkv[t] * av; sd[128] = kv[t] * (1.0f + (av - 1.0f) * ka_w); } }
        }
    }
}
#undef RP_WIN
#undef RP_CONV
constexpr int SP_WAVE_LDS = 16640;
__device__ __forceinline__ void scan_prep_phase(const Frame& F, unsigned char* ws) {
    const float* SS = (const float*)(ws + WS_SS); const float* SD = (const float*)(ws + WS_SD); unsigned char* FR = ws + WS_FR;
    LAS bf16_t* R1 = (LAS bf16_t*)(F.lds + F.wave * SP_WAVE_LDS); LAS bf16_t* R2 = R1 + 32 * 72; LAS bf16_t* BbT = R2 + 32 * 72; LAS bf16_t* KbT = BbT + 64 * 16; LAS bf16_t* VT = KbT + 64 * 16; LAS float* Lm = (LAS float*)(VT + 64 * 16);
    const int lane = F.lane, n = lane & 31, hi = lane >> 5;
    const int gw = F.bid * 8 + F.wave, NGW = F.G * 8;
    for (int it = gw; it < 2 * NHA * SC_NCHUNK; it += NGW) {
        const int chain = it / SC_NCHUNK, c = it % SC_NCHUNK, h = chain >> 1, d = chain & 1;
        const int tau_first = sc_tau(d, c, 0), dstep = d ? -1 : 1;
        const float* ssb = SS + (size_t)h * T * 192 + lane; const float* sdb = SD + ((size_t)h * 2 + d) * T * 192 + lane;
        float xw[16], xb[16], xk[16], xkk[16], xr[16], xv[16];
#pragma unroll
        for (int s = 0; s < 16; ++s) { const size_t o = (size_t)(tau_first + dstep * s) * 192; xw[s] = sdb[o]; xb[s] = sdb[o + 64]; xk[s] = sdb[o + 128]; xkk[s] = ssb[o]; xr[s] = ssb[o + 64]; xv[s] = ssb[o + 128]; }
        float gC = 1.f;
#pragma unroll
        for (int s = 0; s < 16; ++s) gC *= xw[s];
        float g = 1.f;
#pragma unroll
        for (int s = 0; s < 16; ++s) {
            const float gm1 = g; g *= xw[s]; const float ig = 1.0f / g; const float bh = xb[s] * ig, kh = xk[s] * ig;
            R1[s * 72 + lane] = f2bf16(-xkk[s] * gm1); R1[(16 + s) * 72 + lane] = f2bf16(xr[s] * g);
            R2[s * 72 + lane] = f2bf16(bh); R2[(16 + s) * 72 + lane] = f2bf16(kh);
            BbT[lane * 16 + s] = f2bf16(bh * gC); KbT[lane * 16 + s] = f2bf16(kh * gC); VT[lane * 16 + s] = f2bf16(xv[s]); }
        asm volatile("s_waitcnt lgkmcnt(0)" ::: "memory");
        unsigned char* dst = FR + ((size_t)chain * SC_NCHUNK + c) * SC_CHUNK_BYTES;
        rp_f32x16 C = {};
#pragma unroll
        for (int kb = 0; kb < 4; ++kb) { const rp_bf16x8 a_ = *(const LAS rp_bf16x8*)(R2 + n * 72 + 16 * kb + 8 * hi), b_ = *(const LAS rp_bf16x8*)(R1 + n * 72 + 16 * kb + 8 * hi);
            C = __builtin_amdgcn_mfma_f32_32x32x16_bf16(a_, b_, C, 0, 0, 0); }
        const int tt_ = n & 15; const bool incl = n >= 16;
#pragma unroll
        for (int r = 0; r < 16; ++r) { const int s = ((r & 7) & 3) + 8 * ((r & 7) >> 2) + 4 * hi; if (!(s < tt_ || (incl && s == tt_))) C[r] = 0.f; }
        if (n < 16) {
#pragma unroll
            for (int r = 0; r < 8; ++r) Lm[((r & 3) + 8 * (r >> 2) + 4 * hi) * 20 + n] = C[r]; }
        { u32x4 f4; f4.x = cvt_pk_bf16(C[8], C[9]); f4.y = cvt_pk_bf16(C[10], C[11]); f4.z = cvt_pk_bf16(C[12], C[13]); f4.w = cvt_pk_bf16(C[14], C[15]);
          u32x4 f6; f6.x = cvt_pk_bf16(C[0], C[1]); f6.y = cvt_pk_bf16(C[2], C[3]); f6.z = cvt_pk_bf16(C[4], C[5]); f6.w = cvt_pk_bf16(C[6], C[7]);
          if (n < 16) f6 = (u32x4){0u, 0u, 0u, 0u};
          *(u32x4*)(dst + 4 * 1024 + lane * 16) = f4; *(u32x4*)(dst + 6 * 1024 + lane * 16) = f6; }
        asm volatile("s_waitcnt lgkmcnt(0)" ::: "memory");
        { float Tc[16];
#pragma unroll
          for (int s = 15; s >= 0; --s) { float acc = (s == n) ? 1.f : 0.f;
#pragma unroll
              for (int u = s + 1; u < 16; ++u) acc += Lm[s * 20 + u] * Tc[u];
              Tc[s] = acc; }
          u32x4 f5; f5.x = cvt_pk_bf16(hi ? Tc[4] : Tc[0], hi ? Tc[5] : Tc[1]); f5.y = cvt_pk_bf16(hi ? Tc[6] : Tc[2], hi ? Tc[7] : Tc[3]);
          f5.z = cvt_pk_bf16(hi ? Tc[12] : Tc[8], hi ? Tc[13] : Tc[9]); f5.w = cvt_pk_bf16(hi ? Tc[14] : Tc[10], hi ? Tc[15] : Tc[11]);
          if (n >= 16) f5 = (u32x4){0u, 0u, 0u, 0u};
          *(u32x4*)(dst + 5 * 1024 + lane * 16) = f5; }
#pragma unroll
        for (int f = 0; f < 4; ++f) { const u32x2 p0 = *(const LAS u32x2*)(R1 + n * 72 + 16 * f + 4 * hi), p1 = *(const LAS u32x2*)(R1 + n * 72 + 16 * f + 8 + 4 * hi);
            *(u32x4*)(dst + f * 1024 + lane * 16) = (u32x4){p0.x, p0.y, p1.x, p1.y}; }
#pragma unroll
        for (int jb = 0; jb < 2; ++jb) { const int row = 32 * jb + n;
            const u32x2 b0 = *(const LAS u32x2*)(BbT + row * 16 + 4 * hi), b1 = *(const LAS u32x2*)(BbT + row * 16 + 8 + 4 * hi), k0 = *(const LAS u32x2*)(KbT + row * 16 + 4 * hi), k1 = *(const LAS u32x2*)(KbT + row * 16 + 8 + 4 * hi);
            const u32x2 v0 = *(const LAS u32x2*)(VT + row * 16 + 4 * hi), v1 = *(const LAS u32x2*)(VT + row * 16 + 8 + 4 * hi);
            *(u32x4*)(dst + (7 + 2 * jb) * 1024 + lane * 16) = (u32x4){b0.x, b0.y, b1.x, b1.y}; *(u32x4*)(dst + (8 + 2 * jb) * 1024 + lane * 16) = (u32x4){k0.x, k0.y, k1.x, k1.y};
            *(u32x4*)(dst + (11 + jb) * 1024 + lane * 16) = (u32x4){v0.x, v0.y, v1.x, v1.y}; }
        { const int jj = lane & 31; ((float*)(dst + 13 * 1024))[((jj >> 2) & 1) * 32 + (lane >> 5) * 16 + (jj & 3) + 4 * (jj >> 3)] = gC; }
        asm volatile("s_waitcnt lgkmcnt(0)" ::: "memory");
    }
}
__device__ __forceinline__ void mixer_phase(const Frame& F0, unsigned char* ws0, int lq, bool need_ctx, char* lds_g) {
    const int l = lq & 3;
#ifndef MK_MIX
#define MK_MIX 15
#endif
    { const Frame F = opq(F0); unsigned char* ws = opq_ptr(ws0);
      if (MK_MIX & 1) for (int chain = F.bid; chain < 2 * NHA; chain += F.G) scan_chain_mfma(F, ws, chain); }
    const Frame& F = F0;
    const int n_xa = 32 * NHC, n_ca = need_ctx ? NHC : 0, n_att = n_xa + n_ca, n_hy = 640, n_ch = need_ctx ? 160 : 0;
    unsigned* qatt = (unsigned*)(ws0 + WS_CTL) + CW_QUEUE + 64 * lq; unsigned* qhy = qatt + 32;
    int item;
#define MIX_POP(q) do { if (F.tid == 0) F.MISC[16] = __hip_atomic_fetch_add((q), 1u, __ATOMIC_RELAXED, __HIP_MEMORY_SCOPE_AGENT); __syncthreads(); item = (int)F.MISC[16]; __syncthreads(); } while (0)
    if (F.bid >= 2 * NHA) {
        MIX_POP(qatt);
        while (item < n_att) {
            if (MK_MIX & 2) { unsigned char* ws = opq_ptr(ws0);
                const bf16_t* QF = (const bf16_t*)(ws + WS_QF); const bf16_t* KF = (const bf16_t*)(ws + WS_KF); const bf16_t* KVRAW = (const bf16_t*)(ws + WS_KVRAW); bf16_t* OB = (bf16_t*)(ws + WS_OBUF);
                const bool is_xa = item < n_xa; const int h = is_xa ? item % NHC : item - n_xa, row0 = is_xa ? NCTX + (item / NHC) * 256 : 0;
                for (int rp = 0; rp < REP(13); ++rp) att::attn_body(QF + (size_t)row0 * NQ + h * 192, KF + h * 192, KVRAW + h * 256 + 128, OB + (size_t)row0 * DM + 2560 + h * 128, is_xa ? T : NCTX, lds_g); }
            MIX_POP(qatt);
        }
    }
    MIX_POP(qhy);
    while (item < n_hy + n_ch) {
        const Frame Fu = opq(F0); unsigned char* ws = opq_ptr(ws0);
        if ((MK_MIX & 4) && item < n_hy) hyena_unit(Fu, ws, l, item);
        else if ((MK_MIX & 8) && item >= n_hy) hyena_ctx_unit(Fu, ws, l, item - n_hy);
        MIX_POP(qhy);
    }
#undef MIX_POP
}

constexpr int NPH = 2 + 14 * NL;
__global__ void __launch_bounds__(512, 2) mk_fwd(Args a) {
    extern __shared__ __attribute__((aligned(16))) unsigned char lds[];
    Frame F; F.lds = (LAS unsigned char*)lds; F.MISC = (volatile LAS unsigned*)(F.lds + LDS_MISC);
    F.tid = threadIdx.x; F.lane = F.tid & 63; F.wave = __builtin_amdgcn_readfirstlane(F.tid >> 6); F.bid = blockIdx.x; F.G = gridDim.x;
    if (F.tid < 64) F.MISC[F.tid] = 0u;
    if (F.tid < 46) *(LAS unsigned long long*)(F.lds + LDS_PTAB + 8 * F.tid) = (unsigned long long)(uintptr_t)a.in[F.tid];
    __syncthreads();
    unsigned char* ws = a.ws;
    XcdBarrier bar = xcd_barrier_post((unsigned*)(ws + WS_CTL) + CW_BAR, F.MISC + 8);
    const int lo = a.ph_lo, hi = a.ph_hi;
#ifndef MK_MASK
#define MK_MASK 0xffff
#endif
#define EN(x) (((MK_MASK) >> (x)) & 1)
#define IN(k) (lo <= (k) && (k) < hi)
#define SEAM(k) do { if (IN(k) && IN((k) + 1)) xcd_barrier(bar); } while (0)
#define WSP opq_ptr(ws)
#define P_XS(w) ((float*)((w) + WS_XS))
#define P_ABUF(w) ((bf16_t*)((w) + WS_ABUF))
#define P_HBUF(w) ((bf16_t*)((w) + WS_HBUF))
#define P_OBUF(w) ((bf16_t*)((w) + WS_OBUF))
#define P_MODX(w, l) ((const float*)((w) + WS_MOD) + ((size_t)(l) * 2 + 0) * NMOD)
#define P_MODC(w, l) ((const float*)((w) + WS_MOD) + ((size_t)(l) * 2 + 1) * NMOD)
#define P_WL(w, l) ((const bf16_t*)((w) + WS_WB) + (size_t)(l) * W_LAYER)
    if (EN(0) && IN(0)) for (int rp = 0; rp < REP(0); ++rp) phase0(opq(F), opq_ptr(ws));
    SEAM(0);
    if (EN(1) && IN(1)) phase_mod(opq(F), opq_ptr(ws));
    SEAM(1);
#pragma clang loop unroll(full)
    for (int l = 0; l < NL; ++l) {
        const int pb = 2 + 14 * l; const bool need_ctx = l < NL - 1;
        if (EN(2) && IN(pb + 0)) for (int rp = 0; rp < REP(2); ++rp) { unsigned char* w = WSP; norm_phase(opq(F), P_XS(w), IN_(7) + l * DM, P_MODX(w, l), P_MODC(w, l), 0, 1, P_ABUF(w), l > 0 ? (const float*)(w + WS_SLAB) : nullptr, l > 0 ? P_MODC(w, l - 1) + 8 * DM : nullptr, 0.5f); }
        SEAM(pb + 0);
        if (EN(3) && IN(pb + 1)) { unsigned char* w = WSP; pg8::Gemm g{P_ABUF(w), P_WL(w, l) + W_G1, T, 2 * FF, DM, DM}; pg8::StaticOrder S; S.init(T, 2 * FF, F.G, F.bid); pg8::EpiSwiGLU E{P_HBUF(w), FF};
            pg8::gemm_phase<pg8::EpiSwiGLU, pg8::StaticOrder>(F.lds, g, S, E, nullptr); }
        SEAM(pb + 1);
        if (EN(4) && IN(pb + 2)) {
            { unsigned char* w = WSP; pg8::Gemm g{P_HBUF(w), P_WL(w, l) + W_D1, T, DM, FF, FF}; pg8::StaticOrderX S; S.init(T, DM, F.G, F.bid); pg8::EpiResid E{P_XS(w), P_MODX(w, l) + 2 * DM, P_MODC(w, l) + 2 * DM, 0.5f, nullptr};
              pg8::gemm_phase<pg8::EpiResid, pg8::StaticOrderX>(F.lds, g, S, E, nullptr); }
            if (true) { __syncthreads();
              if (F.bid < 256) { unsigned char* w = WSP; const int ks = F.bid >> 4, ksz = FF / 16; pg8::Gemm g{P_HBUF(w) + ks * ksz, P_WL(w, l) + W_D1 + ks * ksz, NCTX, DM, ksz, FF}; pg8::OneUnit S{F.bid & 15};
                  pg8::EpiF32 E{(float*)(w + WS_SLAB) + (size_t)ks * NCTX * DM, DM, nullptr};
                  pg8::gemm_phase<pg8::EpiF32, pg8::OneUnit>(F.lds, g, S, E, nullptr); } }
        }
        SEAM(pb + 2);
        if (EN(5) && IN(pb + 3)) for (int rp = 0; rp < REP(2); ++rp) { unsigned char* w = WSP; norm_phase(opq(F), P_XS(w), IN_(8) + l * DM, P_MODX(w, l), P_MODC(w, l), 3, 4, P_ABUF(w), (const float*)(w + WS_SLAB), P_MODC(w, l) + 2 * DM, 0.5f); }
        SEAM(pb + 3);
        if (EN(6) && IN(pb + 4)) { unsigned char* w = WSP; pg8::Gemm g{P_ABUF(w), P_WL(w, l) + W_IN, T, PXW, DM, DM}; pg8::StaticOrder S; S.init(T, PXW, F.G, F.bid); pg8::EpiF32 E{(float*)(w + WS_PX), PXW, nullptr};
            pg8::gemm_phase<pg8::EpiF32, pg8::StaticOrder>(F.lds, g, S, E, nullptr); }
        SEAM(pb + 4);
        if (EN(7) && IN(pb + 5)) { for (int rp = 0; rp < REP(7); ++rp) rwkv_elem_phase(opq(F), opq_ptr(ws), l); if (!(MK_ONLYRP)) { for (int rp = 0; rp < REP(8); ++rp) mla_prep_phase(opq(F), opq_ptr(ws), l); hyena_prep_phase(opq(F), opq_ptr(ws), l); } }
        SEAM(pb + 5);
        if (EN(8) && IN(pb + 6)) {
            { unsigned char* w = WSP; pg8::Gemm g{(const bf16_t*)(w + WS_QA), P_WL(w, l) + W_Q, T, NQ, 1024, 1024}; pg8::StaticOrder S; S.init(T, NQ, F.G, F.bid); pg8::EpiBf16<0> E{(bf16_t*)(w + WS_QRAW), NQ, nullptr, 0, 0};
              pg8::gemm_phase<pg8::EpiBf16<0>, pg8::StaticOrder>(F.lds, g, S, E, nullptr); }
            __syncthreads();
            { unsigned char* w = WSP; pg8::Gemm g{(const bf16_t*)(w + WS_KVA), P_WL(w, l) + W_KV, T, NKV, 512, 512}; pg8::StaticOrder S; S.init(T, NKV, F.G, F.bid); pg8::EpiBf16<0> E{(bf16_t*)(w + WS_KVRAW), NKV, nullptr, 0, 0};
              pg8::gemm_phase<pg8::EpiBf16<0>, pg8::StaticOrder>(F.lds, g, S, E, nullptr); }
        }
        SEAM(pb + 6);
        if (EN(9) && IN(pb + 7)) { for (int rp = 0; rp < REP(8); ++rp) qkv_final_phase(opq(F), opq_ptr(ws), l, need_ctx); for (int rp = 0; rp < REP(9); ++rp) scan_prep_phase(opq(F), opq_ptr(ws)); }
        SEAM(pb + 7);
        if (EN(10) && IN(pb + 8)) for (int rp = 0; rp < REP(10); ++rp) mixer_phase(F, ws, l + 4 * rp, need_ctx, (char*)lds);
        SEAM(pb + 8);
        if (EN(11) && IN(pb + 9)) { for (int rp = 0; rp < REP(8); ++rp) rwkv_out_phase(opq(F), opq_ptr(ws), l, need_ctx); hyena_out_phase(opq(F), opq_ptr(ws), need_ctx); }
        SEAM(pb + 9);
        if (EN(12) && IN(pb + 10)) {
            { unsigned char* w = WSP; pg8::Gemm g{P_OBUF(w), P_WL(w, l) + W_OUT, T, DM, DM, DM}; pg8::StaticOrderX S; S.init(T, DM, F.G, F.bid); pg8::EpiResid E{P_XS(w), P_MODX(w, l) + 5 * DM, P_MODC(w, l) + 5 * DM, 1.0f, nullptr};
              pg8::gemm_phase<pg8::EpiResid, pg8::StaticOrderX>(F.lds, g, S, E, nullptr); }
            if (need_ctx) { __syncthreads();
              if (F.bid < 256) { unsigned char* w = WSP; const int ks = F.bid >> 4, ksz = DM / 16; pg8::Gemm g{P_OBUF(w) + ks * ksz, P_WL(w, l) + W_OUT + ks * ksz, NCTX, DM, ksz, DM}; pg8::OneUnit S{F.bid & 15};
                  pg8::EpiF32 E{(float*)(w + WS_SLAB) + (size_t)ks * NCTX * DM, DM, nullptr};
                  pg8::gemm_phase<pg8::EpiF32, pg8::OneUnit>(F.lds, g, S, E, nullptr); } }
        }
        SEAM(pb + 10);
        if (EN(13) && IN(pb + 11)) for (int rp = 0; rp < REP(2); ++rp) { unsigned char* w = WSP; norm_phase(opq(F), P_XS(w), IN_(9) + l * DM, P_MODX(w, l), P_MODC(w, l), 6, 7, P_ABUF(w), need_ctx ? (const float*)(w + WS_SLAB) : nullptr, P_MODC(w, l) + 5 * DM, 1.0f); }
        SEAM(pb + 11);
        if (EN(14) && IN(pb + 12)) { if (need_ctx) { unsigned char* w = WSP; pg8::Gemm g{P_ABUF(w), P_WL(w, l) + W_G2, T, 2 * FF, DM, DM}; pg8::StaticOrder S; S.init(T, 2 * FF, F.G, F.bid); pg8::EpiSwiGLU E{P_HBUF(w), FF};
            pg8::gemm_phase<pg8::EpiSwiGLU, pg8::StaticOrder>(F.lds, g, S, E, nullptr); } else { unsigned char* w = WSP; pg8::Gemm g{P_ABUF(w), P_WL(w, l) + W_G2, T, 2 * FF, DM, DM}; pg8::StaticOrderX S; S.init(T, 2 * FF, F.G, F.bid); pg8::EpiSwiGLU E{P_HBUF(w), FF};
            pg8::gemm_phase<pg8::EpiSwiGLU, pg8::StaticOrderX>(F.lds, g, S, E, nullptr); } }
        SEAM(pb + 12);
        if (EN(15) && IN(pb + 13)) {
            { unsigned char* w = WSP; pg8::Gemm g{P_HBUF(w), P_WL(w, l) + W_D2, T, DM, FF, FF}; pg8::StaticOrderX S; S.init(T, DM, F.G, F.bid); pg8::EpiResid E{P_XS(w), P_MODX(w, l) + 8 * DM, P_MODC(w, l) + 8 * DM, 0.5f, l == NL - 1 ? a.out : nullptr};
              pg8::gemm_phase<pg8::EpiResid, pg8::StaticOrderX>(F.lds, g, S, E, nullptr); }
            if (need_ctx) { __syncthreads();
              if (F.bid < 256) { unsigned char* w = WSP; const int ks = F.bid >> 4, ksz = FF / 16; pg8::Gemm g{P_HBUF(w) + ks * ksz, P_WL(w, l) + W_D2 + ks * ksz, NCTX, DM, ksz, FF}; pg8::OneUnit S{F.bid & 15};
                  pg8::EpiF32 E{(float*)(w + WS_SLAB) + (size_t)ks * NCTX * DM, DM, nullptr};
                  pg8::gemm_phase<pg8::EpiF32, pg8::OneUnit>(F.lds, g, S, E, nullptr); } }
        }
        SEAM(pb + 13);
    }
#undef IN
#undef SEAM
}

#ifndef MK_LAUNCHES
#define MK_LAUNCHES 1
#endif
extern "C" void kernel_launch(void* const* d_in, const int* in_sizes, int n_in, void* d_out, int out_size, void* d_ws, size_t ws_size, hipStream_t stream) {
    static int grid = 0;
    if (grid == 0) {
        if (n_in != 46 || in_sizes[0] != SEQ * DM || out_size != SEQ * DM || ws_size < WS_END) {
            fprintf(stderr, "kernel_launch: shape mismatch: n_in %d in0 %d out %d ws %zu (need %zu); nothing launched\n", n_in, n_in > 0 ? in_sizes[0] : -1, out_size, ws_size, (size_t)WS_END); grid = -1; return; }
        int dev = 0, cus = 0, per_cu = 0;
        if (hipGetDevice(&dev) != hipSuccess || hipDeviceGetAttribute(&cus, hipDeviceAttributeMultiprocessorCount, dev) != hipSuccess) { fprintf(stderr, "kernel_launch: device query failed\n"); grid = -1; return; }
        if (hipFuncSetAttribute((const void*)mk_fwd, hipFuncAttributeMaxDynamicSharedMemorySize, LDS_BYTES) != hipSuccess) { fprintf(stderr, "kernel_launch: hipFuncSetAttribute failed\n"); grid = -1; return; }
        if (hipOccupancyMaxActiveBlocksPerMultiprocessor(&per_cu, (const void*)mk_fwd, 512, LDS_BYTES) != hipSuccess || per_cu < 1) fprintf(stderr, "kernel_launch: note: occupancy query reports %d blocks per CU\n", per_cu);
        (void)hipGetLastError();
        grid = cus;
        if (cus != 256) { fprintf(stderr, "kernel_launch: built for 256 CUs (split-K of the context panel, hyena scratch), found %d; nothing launched\n", cus); grid = -1; return; }
    }
    if (grid < 0) return;
    if (hipMemsetAsync((char*)d_ws + WS_CTL, 0, CTL_BYTES, stream) != hipSuccess) { fprintf(stderr, "kernel_launch: memset failed\n"); return; }
    Args a{};
    for (int i = 0; i < 46; ++i) a.in[i] = (const float*)d_in[i];
    a.out = (float*)d_out; a.ws = (unsigned char*)d_ws;
#if MK_LAUNCHES == 1
    a.ph_lo = 0; a.ph_hi = NPH;
    hipLaunchKernelGGL(mk_fwd, dim3(grid), dim3(512), LDS_BYTES, stream, a);
#else
    for (int p = 0; p < NPH; ++p) { a.ph_lo = p; a.ph_hi = p + 1; hipLaunchKernelGGL(mk_fwd, dim3(grid), dim3(512), LDS_BYTES, stream, a); }
#endif
    const hipError_t le = hipPeekAtLastError();
    if (le != hipSuccess) fprintf(stderr, "kernel_launch: launch failed: %s\n", hipGetErrorName(le));
}
```

```cpp
#include <hip/hip_runtime.h>
#include <stdint.h>
#include <cstdio>

#define LAS __attribute__((address_space(3)))
#define CAS __attribute__((address_space(4)))
typedef unsigned short bf16_t;
typedef float f32x4 __attribute__((ext_vector_type(4)));
typedef float f32x2 __attribute__((ext_vector_type(2)));
typedef unsigned u32x4 __attribute__((ext_vector_type(4)));
typedef unsigned u32x2 __attribute__((ext_vector_type(2)));

constexpr int T = 8448, NCTX = 256, SEQ = 8192, DM = 4096, FF = 6144, NL = 4;
constexpr int A_W = 1280, A_IN = 4160, B_IN = 3840, C_IN = 1600, NHA = 20;
constexpr int PXW = 9728, PXA = 0, PXB = 4160, PXC = 8000;
constexpr int NQ = 2304, NKV = 3072, NHC = 12;
constexpr int NMOD = 9 * DM;
constexpr float NORM_EPS = 1e-6f, GN_EPS = 64e-5f;

constexpr size_t MiB = 1u << 20;
constexpr size_t al(size_t x) { return (x + MiB - 1) / MiB * MiB; }
constexpr size_t WS_CTL = 0, CTL_BYTES = MiB;
constexpr size_t WS_XS = WS_CTL + CTL_BYTES;
constexpr size_t WS_ABUF = WS_XS + al((size_t)T * DM * 4);
constexpr size_t WS_HBUF = WS_ABUF + al((size_t)T * DM * 2);
constexpr size_t WS_OBUF = WS_HBUF + al((size_t)T * FF * 2);
constexpr size_t WS_PX = WS_OBUF + al((size_t)T * DM * 2);
constexpr size_t WS_MOD = WS_PX + al((size_t)T * PXW * 4);
constexpr size_t WS_HP = WS_MOD + al((size_t)NL * 2 * NMOD * 4);
constexpr size_t WS_SS = WS_HP + MiB;
constexpr size_t WS_SD = WS_SS + al((size_t)NHA * T * 192 * 4);
constexpr size_t WS_WLR = WS_SD + al((size_t)NHA * 2 * T * 192 * 4);
constexpr size_t WS_G = WS_WLR + al((size_t)NL * A_W * 448 * 2);
constexpr size_t WS_Y = WS_G + al((size_t)T * A_W * 4);
constexpr size_t WS_QA = WS_Y + al((size_t)2 * T * A_W * 4);
constexpr size_t WS_KVA = WS_QA + al((size_t)T * 1024 * 2);
constexpr size_t WS_KPE = WS_KVA + al((size_t)T * 512 * 2);
constexpr size_t WS_QRAW = WS_KPE + al((size_t)T * 64 * 2);
constexpr size_t WS_KVRAW = WS_QRAW + al((size_t)T * NQ * 2);
constexpr size_t WS_QF = WS_KVRAW + al((size_t)T * NKV * 2);
constexpr size_t WS_KF = WS_QF + al((size_t)T * NQ * 2);
constexpr size_t WS_H3 = WS_KF + al((size_t)T * NQ * 2);
constexpr size_t WS_HSCR = WS_H3 + al((size_t)NL * T * 64 * 4);
constexpr size_t WS_FR = WS_HSCR + al((size_t)256 * 16384 * 8);
constexpr size_t WS_GT = WS_FR + al((size_t)40 * 528 * (14 * 1024));
constexpr size_t WS_X0T = WS_GT + al((size_t)1280 * T * 4);
constexpr size_t WS_SLAB = WS_X0T + al((size_t)1280 * T * 4);
constexpr size_t WS_WB = WS_SLAB + al((size_t)16 * 256 * 4096 * 4);
constexpr size_t W_G1 = 0, W_D1 = W_G1 + (size_t)2 * FF * DM, W_IN = W_D1 + (size_t)DM * FF, W_OUT = W_IN + (size_t)PXW * DM, W_G2 = W_OUT + (size_t)DM * DM,
                 W_D2 = W_G2 + (size_t)2 * FF * DM, W_Q = W_D2 + (size_t)DM * FF, W_KV = W_Q + (size_t)NQ * 1024, W_LAYER = W_KV + (size_t)NKV * 512;
constexpr size_t WS_END = WS_WB + al(W_LAYER * NL * 2);
constexpr int CW_BAR = 4096;
constexpr int CW_QUEUE = 8192;

constexpr int LDS_MISC = 143360, LDS_BYTES = 147456;

__device__ __forceinline__ float wave_sum(float v) {
#pragma unroll
    for (int o = 1; o < 64; o <<= 1) v += __shfl_xor(v, o);
    return v;
}
typedef __bf16 bf16x2_t __attribute__((ext_vector_type(2)));
__device__ __forceinline__ unsigned cvt_pk_bf16(float lo, float hi) { const f32x2 v = {lo, hi}; return __builtin_bit_cast(unsigned, __builtin_convertvector(v, bf16x2_t)); }
__device__ __forceinline__ float bf2f(unsigned short b) { return __uint_as_float(((unsigned)b) << 16); }
__device__ __forceinline__ float sigmoidf_(float x) { return 1.0f / (1.0f + __expf(-x)); }
__device__ __forceinline__ float siluf_(float x) { return x / (1.0f + __expf(-x)); }
__device__ __forceinline__ bool has_left(int tau) { return tau != 0 && tau != NCTX; }
__device__ __forceinline__ bool has_right(int tau) { return tau != NCTX - 1 && tau != T - 1; }

struct Args { const float* in[46]; float* out; unsigned char* ws; int ph_lo, ph_hi; };
struct Frame { LAS unsigned char* lds; volatile LAS unsigned* MISC; int tid, lane, wave, bid, G; };
constexpr int LDS_PTAB = LDS_MISC + 2048;
__device__ __forceinline__ const float* inp(const Frame& F, int i) {
    const volatile LAS unsigned* p = (const volatile LAS unsigned*)(F.lds + LDS_PTAB) + 2 * i;
    const unsigned lo = __builtin_amdgcn_readfirstlane(p[0]), hi = __builtin_amdgcn_readfirstlane(p[1]);
    return (const float*)(((unsigned long long)hi << 32) | lo);
}
#define IN_(i) inp(F, (i))
__device__ __forceinline__ Frame opq(const Frame& F) { Frame G = F; asm volatile("" : "+v"(G.tid), "+s"(G.wave), "+s"(G.bid)); G.lane = G.tid & 63; return G; }
__device__ __forceinline__ unsigned char* opq_ptr(unsigned char* p) { asm volatile("" : "+s"(p)); return p; }
#ifndef MK_REP
#define MK_REP 0
#endif
#ifndef MK_ONLYRP
#define MK_ONLYRP 0
#endif
#define REP(x) (1 + (((MK_REP) >> (x)) & 1))
#define XB_TMO      128
#define XB_XCNT(j)  (256  + 64 * (j))
#define XB_XSUB(j)  (1280 + 64 * (j))
#define XB_XGEN(j)  (2304 + 64 * (j))
#define XB_TOP      3328
#define XB_TOPGEN   3392
#define XCD_BAR_WORDS 3456
#define XB_SPIN_CAP (1u << 18)

__device__ __forceinline__ unsigned xb_ld(unsigned* p)              { return __hip_atomic_load(p, __ATOMIC_RELAXED, __HIP_MEMORY_SCOPE_AGENT); }
__device__ __forceinline__ unsigned xb_add(unsigned* p, unsigned v) { return __hip_atomic_fetch_add(p, v, __ATOMIC_RELAXED, __HIP_MEMORY_SCOPE_AGENT); }
__device__ __forceinline__ unsigned xb_xcc_id() { return (unsigned)__builtin_amdgcn_s_getreg((3 << 11) | 20) & 0xFu; }
#define XB_SPIN(cond, bar) do { unsigned _sp = 0; while (cond) { __builtin_amdgcn_s_sleep(1); \
    if ((++_sp & 255u) == 0u) { if (xb_ld(&(bar)[XB_TMO])) break; if (_sp > XB_SPIN_CAP) { atomicAdd(&(bar)[XB_TMO], 1u); break; } } } } while (0)

struct XcdBarrier {
    unsigned* bar; unsigned x;
    volatile LAS unsigned* st;
};

__device__ __forceinline__ XcdBarrier xcd_barrier_post(unsigned* bar, volatile LAS unsigned* st) {
    XcdBarrier b; b.bar = bar; b.x = xb_xcc_id(); b.st = st;
    if (threadIdx.x == 0) (void)xb_add(&bar[XB_XCNT(b.x)], 1u);
    return b;
}
__device__ __forceinline__ void xcd_barrier_complete(unsigned* bar, unsigned x, unsigned& nloc, unsigned& nx) {
    const unsigned G = gridDim.x * gridDim.y * gridDim.z;
    unsigned sum, cnt, mine, sp = 0u;
    for (;;) {
        sum = 0u; cnt = 0u; mine = 0u;
#pragma unroll
        for (unsigned j = 0; j < 16; ++j) { const unsigned c = xb_ld(&bar[XB_XCNT(j)]); sum += c; cnt += (c > 0u) ? 1u : 0u; mine = (j == x) ? c : mine; }
        if (sum == G) break;
        __builtin_amdgcn_s_sleep(1);
        if ((++sp & 255u) == 0u) { if (xb_ld(&bar[XB_TMO])) break; if (sp > XB_SPIN_CAP) { atomicAdd(&bar[XB_TMO], 1u); break; } }
    }
    nloc = mine > 0u ? mine : 1u; nx = cnt > 0u ? cnt : 1u;
}

__device__ __forceinline__ void xcd_barrier(const XcdBarrier& b) {
    asm volatile("s_waitcnt vmcnt(0)" ::: "memory");
    __syncthreads();
    if (threadIdx.x == 0) {
        unsigned* bar = b.bar;
        __builtin_amdgcn_s_waitcnt(0);
        unsigned nloc = b.st[0], nx = b.st[1];
        if (nloc == 0u) { xcd_barrier_complete(bar, b.x, nloc, nx); b.st[0] = nloc; b.st[1] = nx; }
        const unsigned old = xb_add(&bar[XB_XSUB(b.x)], 1u);
        const unsigned gen = old / nloc;
        if (old + 1u == (gen + 1u) * nloc) {
            __builtin_amdgcn_fence(__ATOMIC_RELEASE, "agent");
            asm volatile("s_waitcnt vmcnt(0)" ::: "memory");
            const unsigned og = xb_add(&bar[XB_TOP], 1u);
            const unsigned tg = og / nx;
            if (og + 1u == (tg + 1u) * nx) xb_add(&bar[XB_TOPGEN], 1u);
            else XB_SPIN(xb_ld(&bar[XB_TOPGEN]) == tg, bar);
            __builtin_amdgcn_fence(__ATOMIC_ACQUIRE, "agent");
            xb_add(&bar[XB_XGEN(b.x)], 1u);
            asm volatile("s_waitcnt vmcnt(0)" ::: "memory");
        } else {
            XB_SPIN(xb_ld(&bar[XB_XGEN(b.x)]) == gen, bar);
            __builtin_amdgcn_fence(__ATOMIC_ACQUIRE, "agent");
            asm volatile("s_waitcnt vmcnt(0)" ::: "memory");
        }
    }
    __syncthreads();
}
namespace pg8 {
#define PG8_LAS __attribute__((address_space(3)))
typedef unsigned short bf16_t;
typedef short bf16x8 __attribute__((ext_vector_type(8)));
typedef float f32x4 __attribute__((ext_vector_type(4)));
typedef unsigned u32x4 __attribute__((ext_vector_type(4)));
constexpr int BM = 256, BK = 64, HALF = 128, HTB = HALF * BK * 2  , STAGE_BYTES = 8 * HTB, NXCD = 8, WGM = 8;

__host__ __device__ __forceinline__ int lds_byte(int r, int c) { const int st = (r >> 4) * 2 + (c >> 5), rr = r & 15, cc = c & 31, ob = rr * 64 + cc * 2; return st * 1024 + (ob ^ (((ob >> 9) & 1) << 5)); }
__host__ __device__ __forceinline__ void stage_rc(int b, int& R, int& C) { const int st = b / 1024, sb = b % 1024, swz = sb ^ (((sb >> 9) & 1) << 5); R = (st >> 1) * 16 + swz / 64; C = (st & 1) * 32 + (swz % 64) / 2; }
__host__ __device__ __forceinline__ int perm32(int rho) { const int n = rho >> 4, i = rho & 15; return 8 * (i >> 2) + 4 * n + (i & 3); }

struct Unit { int pm, pn; };
struct Gemm { const bf16_t* A; const bf16_t* Bt; int M, N, K, ld; };

struct StaticOrder {
    int nM, nN, nwg, G, c;
    __host__ __device__ void init(int M, int N, int G_, int c_) { nM = M / BM; nN = N / BM; nwg = nM * nN; G = G_; c = c_; }
    __host__ __device__ bool next(int i, Unit& u) const {
        const long L = (long)i * G + c; if (L >= nwg) return false;
        int wgid = (int)L; { const int q = nwg / NXCD, r = nwg % NXCD, xcd = wgid % NXCD, off = wgid / NXCD; wgid = (xcd < r ? xcd * (q + 1) : r * (q + 1) + (xcd - r) * q) + off; }
        const int nig = WGM * nN, gid = wgid / nig, fm = gid * WGM, gsz = (nM - fm) < WGM ? (nM - fm) : WGM;
        u.pm = fm + ((wgid % nig) % gsz); u.pn = (wgid % nig) / gsz; return true;
    }
    __device__ __forceinline__ void a_ready(const Unit&) const {}
    __device__ __forceinline__ void done(const Unit&) const {}
};
struct CountedOrder : StaticOrder {
    const unsigned* ready; unsigned need; unsigned* tmo;
    __device__ __forceinline__ void a_ready(const Unit& u) const {
        if (threadIdx.x < 64) {
            const unsigned long long t0 = __builtin_amdgcn_s_memrealtime(); unsigned polls = 0;
            while ((unsigned)__builtin_amdgcn_readfirstlane(__hip_atomic_load(ready + 64 * u.pm, __ATOMIC_RELAXED, __HIP_MEMORY_SCOPE_AGENT)) < need) {
                if ((++polls & 255u) == 0u && __builtin_amdgcn_readfirstlane(__hip_atomic_load(tmo, __ATOMIC_RELAXED, __HIP_MEMORY_SCOPE_AGENT)) != 0u) break;
                if (__builtin_amdgcn_s_memrealtime() - t0 > 2000000ull) {
                    if (threadIdx.x == 0) { unsigned expect = 0u; __hip_atomic_compare_exchange_strong(tmo + 1, &expect, 0x600u | (unsigned)(u.pm & 0xff), __ATOMIC_RELAXED, __ATOMIC_RELAXED, __HIP_MEMORY_SCOPE_AGENT); __hip_atomic_store(tmo, 1u, __ATOMIC_RELAXED, __HIP_MEMORY_SCOPE_AGENT); }
                    break; }
                __builtin_amdgcn_s_sleep(2); }
            __builtin_amdgcn_fence(__ATOMIC_ACQUIRE, "agent");
            asm volatile("s_waitcnt vmcnt(0)" ::: "memory");
        }
#if !defined(BROKEN_HOOK_NO_BARRIER)
        asm volatile("" ::: "memory"); __builtin_amdgcn_s_barrier(); asm volatile("" ::: "memory");
#endif
    }
};

__device__ __forceinline__ unsigned cvt_pk_bf16(float lo, float hi) { unsigned r; asm volatile("v_cvt_pk_bf16_f32 %0, %1, %2" : "=v"(r) : "v"(lo), "v"(hi)); return r; }
typedef float f32x2 __attribute__((ext_vector_type(2)));
__device__ __forceinline__ f32x2 gelu_pk(f32x2 v) {
    const f32x2 av = __builtin_elementwise_abs(v), d = av * 0.2316418882f + 1.0f;
    f32x2 t; t.x = __builtin_amdgcn_rcpf(d.x); t.y = __builtin_amdgcn_rcpf(d.y);
    f32x2 q = t * 0.5307027145f + (-0.7265760135f); q = q * t + 0.7107068705f; q = q * t + (-0.142248368f); q = q * t + 0.127414796f; q = q * t;
    const f32x2 s = (v * v) * (-0.72134752044f);
    f32x2 e; e.x = __builtin_amdgcn_exp2f(s.x); e.y = __builtin_amdgcn_exp2f(s.y);
    const f32x2 m = v * (q * e), r = v - m;
    f32x2 o; o.x = v.x < 0.f ? m.x : r.x; o.y = v.y < 0.f ? m.y : r.y; return o;
}

struct EpiF32 {
    static constexpr bool PERM = false, AFTER_DRAIN = false;
    float* C; int ldc; const float* bias;
    __device__ __forceinline__ void operator()(const f32x4 (&acc)[2][2][4][2], const Unit& u, int wr, int wc, int fr, int fq) const {
        const int row0 = u.pm * BM + wr * 64 + fr, col0 = u.pn * BM + wc * 32 + 4 * fq;
        f32x4 bv[2][2];
#pragma unroll
        for (int bj = 0; bj < 2; ++bj)
#pragma unroll
            for (int n = 0; n < 2; ++n) bv[bj][n] = bias ? *(const f32x4*)(bias + col0 + bj * HALF + n * 16) : (f32x4){0.f, 0.f, 0.f, 0.f};
#pragma unroll
        for (int ai = 0; ai < 2; ++ai)
#pragma unroll
            for (int m = 0; m < 4; ++m) { float* rowp = C + (size_t)(row0 + ai * HALF + m * 16) * ldc + col0;
#pragma unroll
                for (int bj = 0; bj < 2; ++bj)
#pragma unroll
                    for (int n = 0; n < 2; ++n) *(f32x4*)(rowp + bj * HALF + n * 16) = acc[ai][bj][m][n] + bv[bj][n]; }
    }
};
template <int ACT  > struct EpiBf16 {
    static constexpr bool PERM = true, AFTER_DRAIN = false;
    bf16_t* O; int ldc; const float* bias; int split_cols; size_t split_stride;
    __device__ __forceinline__ void operator()(const f32x4 (&acc)[2][2][4][2], const Unit& u, int wr, int wc, int fr, int fq) const {
        const int row0 = u.pm * BM + wr * 64 + fr; int colt = u.pn * BM; bf16_t* base = O;
        if (split_cols) { const int t = colt / split_cols; base += (size_t)t * split_stride; colt -= t * split_cols; }
        const int col0 = colt + wc * 32 + 8 * fq, bcol0 = u.pn * BM + wc * 32 + 8 * fq;
        f32x4 bv[2][2];
#pragma unroll
        for (int bj = 0; bj < 2; ++bj)
#pragma unroll
            for (int n = 0; n < 2; ++n) bv[bj][n] = bias ? *(const f32x4*)(bias + bcol0 + bj * HALF + 4 * n) : (f32x4){0.f, 0.f, 0.f, 0.f};
#pragma unroll
        for (int ai = 0; ai < 2; ++ai)
#pragma unroll
            for (int m = 0; m < 4; ++m) { bf16_t* rowp = base + (size_t)(row0 + ai * HALF + m * 16) * ldc + col0;
#pragma unroll
                for (int bj = 0; bj < 2; ++bj) { f32x4 v0 = acc[ai][bj][m][0] + bv[bj][0], v1 = acc[ai][bj][m][1] + bv[bj][1];
                    if (ACT == 1) { f32x2 a = gelu_pk((f32x2){v0[0], v0[1]}), b = gelu_pk((f32x2){v0[2], v0[3]}), c = gelu_pk((f32x2){v1[0], v1[1]}), d = gelu_pk((f32x2){v1[2], v1[3]});
                        v0 = (f32x4){a.x, a.y, b.x, b.y}; v1 = (f32x4){c.x, c.y, d.x, d.y}; }
                    if (ACT == 2) {
#pragma unroll
                        for (int j = 0; j < 4; ++j) { v0[j] = 0.5f * v0[j] * (1.0f + erff(v0[j] * 0.70710678f)); v1[j] = 0.5f * v1[j] * (1.0f + erff(v1[j] * 0.70710678f)); } }
                    u32x4 w; w.x = cvt_pk_bf16(v0[0], v0[1]); w.y = cvt_pk_bf16(v0[2], v0[3]); w.z = cvt_pk_bf16(v1[0], v1[1]); w.w = cvt_pk_bf16(v1[2], v1[3]);
                    *(u32x4*)(rowp + bj * HALF) = w; } }
    }
};
}
namespace pg8 {
struct EpiSwiGLU {
    static constexpr bool PERM = true, AFTER_DRAIN = false;
    bf16_t* O; int ldc;
    __device__ __forceinline__ void operator()(const f32x4 (&acc)[2][2][4][2], const Unit& u, int wr, int wc, int fr, int fq) const {
        const int row0 = u.pm * BM + wr * 64 + fr, col0 = u.pn * HALF + wc * 32 + 8 * fq;
#pragma unroll
        for (int ai = 0; ai < 2; ++ai)
#pragma unroll
            for (int m = 0; m < 4; ++m) { bf16_t* rowp = O + (size_t)(row0 + ai * HALF + m * 16) * ldc + col0;
                float h[8];
#pragma unroll
                for (int n = 0; n < 2; ++n)
#pragma unroll
                    for (int j = 0; j < 4; ++j) { const float g = acc[ai][0][m][n][j], up = acc[ai][1][m][n][j]; h[n * 4 + j] = g * __builtin_amdgcn_rcpf(1.0f + __builtin_amdgcn_exp2f(-1.4426950408889634f * g)) * up; }
                u32x4 w; w.x = cvt_pk_bf16(h[0], h[1]); w.y = cvt_pk_bf16(h[2], h[3]); w.z = cvt_pk_bf16(h[4], h[5]); w.w = cvt_pk_bf16(h[6], h[7]);
                *(u32x4*)rowp = w; }
    }
};
struct EpiResid {
    static constexpr bool PERM = false, AFTER_DRAIN = false;
    float* X; const float* gate_x; const float* gate_c; float fac; float* out_x;
    __device__ __forceinline__ void operator()(const f32x4 (&acc)[2][2][4][2], const Unit& u, int wr, int wc, int fr, int fq) const {
        const int row0 = u.pm * BM + wr * 64 + fr, col0 = u.pn * BM + wc * 32 + 4 * fq;
        const float* gv = (u.pm == 0) ? gate_c : gate_x;
        float* dst = (u.pm != 0 && out_x) ? out_x - (size_t)256 * 4096 : X;
        f32x4 gg[2][2];
#pragma unroll
        for (int bj = 0; bj < 2; ++bj)
#pragma unroll
            for (int n = 0; n < 2; ++n) gg[bj][n] = *(const f32x4*)(gv + col0 + bj * HALF + n * 16) * fac;
#pragma unroll
        for (int ai = 0; ai < 2; ++ai)
#pragma unroll
            for (int m = 0; m < 4; ++m) { const size_t off = (size_t)(row0 + ai * HALF + m * 16) * 4096 + col0;
#pragma unroll
                for (int bj = 0; bj < 2; ++bj)
#pragma unroll
                    for (int n = 0; n < 2; ++n) { const f32x4 b = *(const f32x4*)(X + off + bj * HALF + n * 16); *(f32x4*)(dst + off + bj * HALF + n * 16) = b + gg[bj][n] * acc[ai][bj][m][n]; } }
    }
};
struct OneUnit { int pn;
    __host__ __device__ bool next(int i, Unit& u) const { u.pm = 0; u.pn = pn; return i == 0; }
    __device__ __forceinline__ void a_ready(const Unit&) const {}
    __device__ __forceinline__ void done(const Unit&) const {}
};
struct StaticOrderX { StaticOrder b;
    __host__ __device__ void init(int M, int N, int G_, int c_) { b.init(M - BM, N, G_, c_); }
    __host__ __device__ bool next(int i, Unit& u) const { const bool ok = b.next(i, u); u.pm += 1; return ok; }
    __device__ __forceinline__ void a_ready(const Unit&) const {}
    __device__ __forceinline__ void done(const Unit&) const {}
};
}
namespace pg8 {
template <class Epi, class Sched, bool STAMP = false>
__device__ __forceinline__ void gemm_phase(PG8_LAS unsigned char* lds, const Gemm g, const Sched& S, const Epi& E, unsigned long long* stamps) {
    int tid_ = threadIdx.x; asm volatile("" : "+v"(tid_));
    const int tid = tid_, wid = __builtin_amdgcn_readfirstlane(tid >> 6), lane = tid & 63, wr = wid >> 2, wc = wid & 3, fr = lane & 15, fq = lane >> 4;
    const int K = g.ld, nt = g.K / BK;
    int ts_lo = 0, ts_hi = 0, nts = 0; const unsigned long long rt_entry = STAMP ? (unsigned long long)wall_clock64() : 0ull;
#define PG8_STAMP() do { if (STAMP && wid == 0 && nts < 64) { const unsigned long long _c = (unsigned long long)clock64(); \
        ts_lo = (lane == nts) ? (int)(unsigned)_c : ts_lo; ts_hi = (lane == nts) ? (int)(unsigned)(_c >> 32) : ts_hi; ++nts; } } while (0)
    PG8_STAMP();
    unsigned voffA[2], voffB[2];
#pragma unroll
    for (int i = 0; i < 2; ++i) { int R, C; stage_rc(tid * 16 + i * 8192, R, C); const int Rb = Epi::PERM ? ((R & ~31) + perm32(R & 31)) : R;
        voffA[i] = (unsigned)(R * K + C) * 2u; voffB[i] = (unsigned)(Rb * K + C) * 2u; }
    const size_t kstep = (size_t)(BK * 2);
    const size_t hstep = (size_t)HALF * K * 2;
    const size_t tstep = 2 * hstep;
    const unsigned ldsw = (unsigned)wid * 1024u;
    const int aoff = lds_byte(wr * 64 + fr, fq * 8), boff = lds_byte(wc * 32 + fr, fq * 8);
#define PG8_SA(b, h) (((b) * 2 + (h)) * HTB)
#define PG8_SB(b, h) ((4 + (b) * 2 + (h)) * HTB)
#define PG8_STAGE(bufoff, gbase, voff) do { _Pragma("unroll") for (int _i = 0; _i < 2; ++_i) \
        __builtin_amdgcn_global_load_lds((const unsigned*)((const char*)(gbase) + (voff)[_i]), (PG8_LAS unsigned*)(lds + (bufoff) + ldsw + _i * 8192), 16, 0, 0); } while (0)
#define PG8_LDA(dst, b, h) do { _Pragma("unroll") for (int m = 0; m < 4; ++m) _Pragma("unroll") for (int k = 0; k < 2; ++k) dst[m][k] = *(const PG8_LAS bf16x8*)(lds + PG8_SA(b, h) + aoff + m * 2048 + k * 1024); } while (0)
#define PG8_LDB(dst, b, h) do { _Pragma("unroll") for (int n = 0; n < 2; ++n) _Pragma("unroll") for (int k = 0; k < 2; ++k) dst[n][k] = *(const PG8_LAS bf16x8*)(lds + PG8_SB(b, h) + boff + n * 2048 + k * 1024); } while (0)
#define PG8_MMA(ai, bj, At, Bt) do { __builtin_amdgcn_s_setprio(1); _Pragma("unroll") for (int m = 0; m < 4; ++m) _Pragma("unroll") for (int n = 0; n < 2; ++n) _Pragma("unroll") for (int k = 0; k < 2; ++k) \
        acc[ai][bj][m][n] = __builtin_amdgcn_mfma_f32_16x16x32_bf16(Bt[n][k], At[m][k], acc[ai][bj][m][n], 0, 0, 0); __builtin_amdgcn_s_setprio(0); } while (0)
#define PG8_WAIT_V(n) asm volatile("s_waitcnt vmcnt(" #n ")" ::: "memory")
#define PG8_WAIT_L(n) asm volatile("s_waitcnt lgkmcnt(" #n ")" ::: "memory")
#define PG8_BAR __builtin_amdgcn_s_barrier()
#define PG8_SCHED __builtin_amdgcn_sched_barrier(0)
    Unit cur, nxt; int ui = 0;
    if (!S.next(0, cur)) return;
    f32x4 acc[2][2][4][2];
#pragma unroll
    for (int a = 0; a < 2; ++a)
#pragma unroll
        for (int b = 0; b < 2; ++b)
#pragma unroll
            for (int m = 0; m < 4; ++m)
#pragma unroll
                for (int n = 0; n < 2; ++n) acc[a][b][m][n] = (f32x4){0.f, 0.f, 0.f, 0.f};
    bf16x8 At[4][2], B0[2][2], B1[2][2];
    const char* cA = (const char*)g.A + (size_t)cur.pm * tstep; const char* cB = (const char*)g.Bt + (size_t)cur.pn * tstep;
    S.a_ready(cur);
    PG8_STAGE(PG8_SB(0, 0), cB, voffB); PG8_STAGE(PG8_SA(0, 0), cA, voffA); PG8_STAGE(PG8_SB(0, 1), cB + hstep, voffB); PG8_STAGE(PG8_SA(0, 1), cA + hstep, voffA);
    if (wr == 1) PG8_BAR;
    PG8_WAIT_V(4); PG8_BAR;
    PG8_STAGE(PG8_SB(1, 0), cB + kstep, voffB); PG8_STAGE(PG8_SA(1, 0), cA + kstep, voffA); PG8_STAGE(PG8_SB(1, 1), cB + hstep + kstep, voffB);
    PG8_WAIT_V(6); PG8_BAR;
    PG8_STAMP();
    for (;;) {
        const bool has_next = S.next(ui + 1, nxt);
        const char* nA = has_next ? (const char*)g.A + (size_t)nxt.pm * tstep : cA; const char* nB = has_next ? (const char*)g.Bt + (size_t)nxt.pn * tstep : cB;
        for (int t = 0; t < nt; t += 2) {
            const bool last = (t == nt - 2);
            const char* a1 = cA + (size_t)(t + 1) * kstep;
            const char* a2 = last ? nA : cA + (size_t)(t + 2) * kstep; const char* b2 = last ? nB : cB + (size_t)(t + 2) * kstep;
            const char* a3 = a2 + kstep; const char* b3 = b2 + kstep;
            if (last && has_next) S.a_ready(nxt);
            PG8_LDB(B0, 0, 0); PG8_SCHED; PG8_LDA(At, 0, 0); PG8_STAGE(PG8_SA(1, 1), a1 + hstep, voffA);
            PG8_WAIT_L(8); PG8_BAR; PG8_WAIT_L(0); PG8_MMA(0, 0, At, B0); PG8_BAR; PG8_SCHED;
            PG8_LDB(B1, 0, 1); PG8_STAGE(PG8_SB(0, 0), b2, voffB);
            PG8_BAR; PG8_WAIT_L(0); PG8_MMA(0, 1, At, B1); PG8_BAR;
            PG8_LDA(At, 0, 1); PG8_STAGE(PG8_SA(0, 0), a2, voffA);
            PG8_BAR; PG8_WAIT_L(0); PG8_MMA(1, 0, At, B0); PG8_BAR; PG8_SCHED;
            PG8_STAGE(PG8_SB(0, 1), b2 + hstep, voffB);
            PG8_WAIT_V(6); PG8_BAR; PG8_MMA(1, 1, At, B1); PG8_BAR;
            PG8_LDB(B0, 1, 0); PG8_SCHED; PG8_LDA(At, 1, 0); PG8_STAGE(PG8_SA(0, 1), a2 + hstep, voffA);
            PG8_WAIT_L(8); PG8_BAR; PG8_WAIT_L(0); PG8_MMA(0, 0, At, B0); PG8_BAR; PG8_SCHED;
            PG8_LDB(B1, 1, 1); PG8_STAGE(PG8_SB(1, 0), b3, voffB);
            PG8_BAR; PG8_WAIT_L(0); PG8_MMA(0, 1, At, B1); PG8_BAR;
            PG8_LDA(At, 1, 1); PG8_STAGE(PG8_SA(1, 0), a3, voffA);
            PG8_BAR; PG8_WAIT_L(0); PG8_MMA(1, 0, At, B0); PG8_BAR; PG8_SCHED;
            PG8_STAGE(PG8_SB(1, 1), b3 + hstep, voffB);
            PG8_WAIT_V(6); PG8_BAR; PG8_MMA(1, 1, At, B1); PG8_BAR;
        }
        PG8_STAMP();
        if constexpr (!Epi::AFTER_DRAIN) { E(acc, cur, wr, wc, fr, fq); S.done(cur); }
        PG8_STAMP();
        if (!has_next) break;
#pragma unroll
        for (int a = 0; a < 2; ++a)
#pragma unroll
            for (int b = 0; b < 2; ++b)
#pragma unroll
                for (int m = 0; m < 4; ++m)
#pragma unroll
                    for (int n = 0; n < 2; ++n) acc[a][b][m][n] = (f32x4){0.f, 0.f, 0.f, 0.f};
        cur = nxt; cA = nA; cB = nB; ++ui;
    }
    PG8_WAIT_V(0);
    if (wr == 0) PG8_BAR;
    PG8_BAR;
    if constexpr (Epi::AFTER_DRAIN) { E.fused(acc, cur, wr, wc, fr, fq, lds, wid, lane); S.done(cur); }
    PG8_STAMP();
    if (STAMP && wid == 0) { stamps[lane] = lane < nts ? (((unsigned long long)(unsigned)ts_hi << 32) | (unsigned)ts_lo) : 0ull;
        if (lane == 62) stamps[62] = rt_entry; if (lane == 63) stamps[63] = (unsigned long long)wall_clock64(); }
#undef PG8_STAMP
#undef PG8_SA
#undef PG8_SB
#undef PG8_STAGE
#undef PG8_LDA
#undef PG8_LDB
#undef PG8_MMA
#undef PG8_WAIT_V
#undef PG8_WAIT_L
#undef PG8_BAR
#undef PG8_SCHED
}
}
#define LDS_WAIT() asm volatile("s_waitcnt lgkmcnt(0)" ::: "memory")

__device__ __forceinline__ int map_row(int n, int mode) {
    if (mode == 1) { const int j = n < FF ? n : n - FF; return (j >> 7) * 256 + (n < FF ? 0 : 128) + (j & 127); }
    return n;
}
__device__ __forceinline__ void transpose_item(const float* __restrict__ W, int K, int N, bf16_t* WT, int mode, LAS float* scr, int item, int lane) {
    const int nblk = N / 32, kb = item / nblk, nb = item % nblk, k0 = 64 * kb, n0 = 32 * nb;
#pragma unroll 8
    for (int i = 0; i < 32; ++i) { const int kk = 2 * i + (lane >> 5); scr[kk * 33 + (lane & 31)] = W[(size_t)(k0 + kk) * N + n0 + (lane & 31)]; }
    LDS_WAIT(); asm volatile("" ::: "memory");
    const int c = lane & 7;
#pragma unroll
    for (int j = 0; j < 4; ++j) { const int n = (lane >> 3) + 8 * j; const LAS float* s = scr + (8 * c) * 33 + n;
        u32x4 o; o.x = cvt_pk_bf16(s[0 * 33], s[1 * 33]); o.y = cvt_pk_bf16(s[2 * 33], s[3 * 33]); o.z = cvt_pk_bf16(s[4 * 33], s[5 * 33]); o.w = cvt_pk_bf16(s[6 * 33], s[7 * 33]);
        *(u32x4*)(WT + (size_t)map_row(n0 + n, mode) * K + k0 + 8 * c) = o; }
    LDS_WAIT(); asm volatile("" ::: "memory");
}
constexpr int I_G = (DM / 64) * (2 * FF / 32), I_D = (FF / 64) * (DM / 32), I_IN = (DM / 64) * (9600 / 32), I_OUT = (DM / 64) * (DM / 32), I_Q = (1024 / 64) * (NQ / 32), I_KV = (512 / 64) * (NKV / 32);
constexpr int I_LAYER = 2 * I_G + 2 * I_D + I_IN + I_OUT + I_Q + I_KV;

__device__ __forceinline__ void phase0(const Frame& F, unsigned char* ws) {
    const int gw = F.bid * 8 + F.wave, NGW = F.G * 8;
    const size_t gt = (size_t)F.bid * 512 + F.tid, NGT = (size_t)F.G * 512;
    LAS float* scr = (LAS float*)(F.lds + F.wave * 8704);
    bf16_t* WB = (bf16_t*)(ws + WS_WB);
    for (int it = gw; it < NL * I_LAYER; it += NGW) {
        const int l = it / I_LAYER; int r = it - l * I_LAYER; bf16_t* wl = WB + (size_t)l * W_LAYER;
        if (r < I_G) { transpose_item(IN_(10) + (size_t)l * DM * 2 * FF, DM, 2 * FF, wl + W_G1, 1, scr, r, F.lane); continue; } r -= I_G;
        if (r < I_D) { transpose_item(IN_(11) + (size_t)l * FF * DM, FF, DM, wl + W_D1, 0, scr, r, F.lane); continue; } r -= I_D;
        if (r < I_G) { transpose_item(IN_(12) + (size_t)l * DM * 2 * FF, DM, 2 * FF, wl + W_G2, 1, scr, r, F.lane); continue; } r -= I_G;
        if (r < I_D) { transpose_item(IN_(13) + (size_t)l * FF * DM, FF, DM, wl + W_D2, 0, scr, r, F.lane); continue; } r -= I_D;
        if (r < I_IN) { transpose_item(IN_(14) + (size_t)l * DM * 9600, DM, 9600, wl + W_IN, 0, scr, r, F.lane); continue; } r -= I_IN;
        if (r < I_OUT) { transpose_item(IN_(15) + (size_t)l * DM * DM, DM, DM, wl + W_OUT, 0, scr, r, F.lane); continue; } r -= I_OUT;
        if (r < I_Q) { transpose_item(IN_(39) + (size_t)l * 1024 * NQ, 1024, NQ, wl + W_Q, 0, scr, r, F.lane); continue; } r -= I_Q;
        transpose_item(IN_(41) + (size_t)l * 512 * NKV, 512, NKV, wl + W_KV, 0, scr, r, F.lane);
    }
    for (size_t i = gt; i < (size_t)NL * 128 * 512; i += NGT) {
        const int l = (int)(i / (128 * 512)), rr = (int)((i / 512) % 128), c = (int)(i % 512);
        const int row = 9600 + rr;
        *(u32x4*)(WB + (size_t)l * W_LAYER + W_IN + (size_t)row * DM + c * 8) = (u32x4){0u, 0u, 0u, 0u};
    }
    { bf16_t* WLR = (bf16_t*)(ws + WS_WLR); const float* wu = IN_(18); const float* au = IN_(20); const float* gu = IN_(21);
      for (size_t i = gt; i < (size_t)NL * 448 * A_W; i += NGT) { const int l = (int)(i / (448 * A_W)), k = (int)((i / A_W) % 448), col = (int)(i % A_W);
          float v;
          if (k < 128) v = wu[(((size_t)l * 2 + (k >> 6)) * 64 + (k & 63)) * A_W + col];
          else if (k < 256) v = au[(((size_t)l * 2 + ((k - 128) >> 6)) * 64 + (k & 63)) * A_W + col];
          else v = gu[((size_t)l * 192 + (k - 256)) * A_W + col];
          WLR[((size_t)l * A_W + col) * 448 + k] = (bf16_t)(cvt_pk_bf16(v, v) & 0xffffu); } }
    { f32x4* xs = (f32x4*)(ws + WS_XS); const f32x4* cx = (const f32x4*)IN_(2); const f32x4* xx = (const f32x4*)IN_(0);
      for (size_t i = gt; i < (size_t)T * DM / 4; i += NGT) xs[i] = i < (size_t)NCTX * DM / 4 ? cx[i] : xx[i - (size_t)NCTX * DM / 4]; }
    { float* HP = (float*)(ws + WS_HP);
      for (int it = F.bid; it < NL * 16; it += F.G) { const int l = it >> 4, ch = it & 15, w = F.tid >> 8, j = F.tid & 255;
          const float* cv = w ? IN_(3) : IN_(1); const float* ad = IN_(4) + ((size_t)l * DM + ch * 256) * 256 + j; float s = 0.f;
          for (int i = 0; i < 256; ++i) s += siluf_(cv[ch * 256 + i]) * ad[(size_t)i * 256];
          HP[((l * 16 + ch) * 2 + w) * 256 + j] = s; } }
    { float* H3 = (float*)(ws + WS_H3);
      LAS float* zb = (LAS float*)(F.lds + 73728); LAS float* ha = zb + 8 * 36; LAS float* hb = ha + 8 * 64;
      for (int it = F.bid; it < NL * (T / 8); it += F.G) { const int l = it / (T / 8), pb = it % (T / 8);
          if (F.tid < 8 * 33) { const int p = F.tid / 33, i = F.tid % 33, P = pb * 8 + p; const int L = P < NCTX ? NCTX : SEQ, t = P < NCTX ? P : P - NCTX;
              float z;
              if (i == 0) z = (float)t / (float)(L - 1);
              else { const int b = (i - 1) & 15; const float fb = 1e-4f + (float)b * ((15.0f - 1e-4f) / 15.0f); const float rev2 = 2.0f * fb * (float)t / (float)L;
                  z = i <= 16 ? cospif(rev2) : -sinpif(rev2); }
              zb[p * 36 + i] = z; }
          __syncthreads();
          const int p = F.tid >> 6, j = F.tid & 63; const float fq = IN_(36)[l * 64 + j];
          { const float* w1 = IN_(29) + (size_t)l * 33 * 64 + j; float s = IN_(30)[l * 64 + j];
            for (int i = 0; i < 33; ++i) s += zb[p * 36 + i] * w1[i * 64];
            ha[p * 64 + j] = sinf(fq * s); }
          __syncthreads();
          { const float* w2 = IN_(31) + (size_t)l * 64 * 64 + j; float s = IN_(32)[l * 64 + j];
            for (int i = 0; i < 64; ++i) s += ha[p * 64 + i] * w2[i * 64];
            hb[p * 64 + j] = sinf(fq * s); }
          __syncthreads();
          { const float* w3 = IN_(33) + (size_t)l * 64 * 64 + j; float s = IN_(34)[l * 64 + j];
            for (int i = 0; i < 64; ++i) s += hb[p * 64 + i] * w3[i * 64];
            ((bf16_t*)H3)[((size_t)l * 64 + j) * T + pb * 8 + p] = (bf16_t)(cvt_pk_bf16(sinf(fq * s), 0.f) & 0xffffu); }
          __syncthreads(); } }
}
__device__ __forceinline__ void phase_mod(const Frame& F, unsigned char* ws) {
    const float* HP = (const float*)(ws + WS_HP); float* MOD = (float*)(ws + WS_MOD);
    LAS float* hs = (LAS float*)F.lds;
    for (int it = F.bid; it < NL * (NMOD / 512); it += F.G) { const int l = it / (NMOD / 512), nb = it % (NMOD / 512);
        { const int w = F.tid >> 8, j = F.tid & 255; float s = 0.f;
          for (int ch = 0; ch < 16; ++ch) s += HP[((l * 16 + ch) * 2 + w) * 256 + j];
          hs[w * 256 + j] = s; }
        __syncthreads();
        const int n = nb * 512 + F.tid; const float* au = IN_(5) + (size_t)l * 256 * NMOD + n; float s0 = IN_(6)[(size_t)l * NMOD + n], s1 = s0;
        for (int j = 0; j < 256; ++j) { const float u = au[(size_t)j * NMOD]; s0 += hs[j] * u; s1 += hs[256 + j] * u; }
        MOD[((size_t)l * 2 + 0) * NMOD + n] = s0; MOD[((size_t)l * 2 + 1) * NMOD + n] = s1;
        __syncthreads(); }
}
__device__ __forceinline__ void norm_phase(const Frame& F, float* XS, const float* __restrict__ gain, const float* modx, const float* modc, int ish, int isc, bf16_t* out, const float* slab, const float* sgate, float sfac) {
    const int gw = F.bid * 8 + F.wave, NGW = F.G * 8;
    int row_lo = 0;
    if (slab) { row_lo = NCTX;
        LAS float* red = (LAS float*)F.lds;
        for (int row = F.bid; row < NCTX; row += F.G) { const size_t o = (size_t)row * DM + F.wave * 512;
            f32x4 v[2]; float s = 0.f;
#pragma unroll
            for (int j = 0; j < 2; ++j) { f32x4 acc = (f32x4){0.f, 0.f, 0.f, 0.f};
#pragma unroll
                for (int ks = 0; ks < 16; ++ks) acc += ((const f32x4*)(slab + (size_t)ks * NCTX * DM + o) + F.lane)[64 * j];
                v[j] = ((const f32x4*)(XS + o) + F.lane)[64 * j] + acc * ((const f32x4*)(sgate + F.wave * 512) + F.lane)[64 * j] * sfac;
                ((f32x4*)(XS + o) + F.lane)[64 * j] = v[j]; s += (v[j].x * v[j].x + v[j].y * v[j].y) + (v[j].z * v[j].z + v[j].w * v[j].w); }
            s = wave_sum(s); if (F.lane == 0) red[F.wave] = s;
            __syncthreads();
            float tot = 0.f;
#pragma unroll
            for (int w = 0; w < 8; ++w) tot += red[w];
            const float rstd = rsqrtf(tot * (1.0f / DM) + NORM_EPS);
#pragma unroll
            for (int j = 0; j < 2; ++j) { const int c4 = F.wave * 128 + F.lane + 64 * j;
                const f32x4 y = v[j] * rstd * ((const f32x4*)gain)[c4] * (((const f32x4*)(modc + (size_t)isc * DM))[c4] + 1.0f) + ((const f32x4*)(modc + (size_t)ish * DM))[c4];
                u32x2 w2; w2.x = cvt_pk_bf16(y.x, y.y); w2.y = cvt_pk_bf16(y.z, y.w); ((u32x2*)(out + (size_t)row * DM))[c4] = w2; }
            __syncthreads(); } }
    for (int row = row_lo + gw; row < T; row += NGW) {
        const float* mod = row < NCTX ? modc : modx;
        const f32x4* xr = (const f32x4*)(XS + (size_t)row * DM) + F.lane; const f32x4* g4 = (const f32x4*)gain + F.lane;
        const f32x4* sh4 = (const f32x4*)(mod + (size_t)ish * DM) + F.lane; const f32x4* sc4 = (const f32x4*)(mod + (size_t)isc * DM) + F.lane;
        f32x4 v[16]; float s = 0.f;
#pragma unroll
        for (int j = 0; j < 16; ++j) { v[j] = xr[64 * j]; s += (v[j].x * v[j].x + v[j].y * v[j].y) + (v[j].z * v[j].z + v[j].w * v[j].w); }
        const float rstd = rsqrtf(wave_sum(s) * (1.0f / DM) + NORM_EPS);
        u32x2* o = (u32x2*)(out + (size_t)row * DM) + F.lane;
#pragma unroll
        for (int j = 0; j < 16; ++j) { const f32x4 y = v[j] * rstd * g4[64 * j] * (sc4[64 * j] + 1.0f) + sh4[64 * j];
            u32x2 w; w.x = cvt_pk_bf16(y.x, y.y); w.y = cvt_pk_bf16(y.z, y.w); o[64 * j] = w; }
    }
}
__device__ __forceinline__ float conv3_at(const float* PX, int tau, int col, float w0, float w1, float w2) {
    const float* p = PX + (size_t)tau * PXW + col;
    const bool hl = has_left(tau), hr = has_right(tau);
    return p[0] * w1 + p[hl ? -PXW : 0] * (hl ? w0 : 0.f) + p[hr ? PXW : 0] * (hr ? w2 : 0.f);
}
__device__ __forceinline__ float rope_apply(float val, int tau, int j) {
    const int pos = tau - NCTX, prow = pos >> 6, pcol = pos & 63;
    const float inv = __powf(10000.0f, -(float)(j & 15) * (1.0f / 16.0f));
    const float ang = (float)(j < 32 ? prow : pcol) * inv;
    float sn, cs; sincosf(ang, &sn, &cs);
    const float partner = __shfl_xor(val, 16);
    const float rot = (j & 16) ? partner : -partner;
    return val * cs + rot * sn;
}
__device__ __forceinline__ void mla_prep_phase(const Frame& F, unsigned char* ws, int l) {
    const float* PX = (const float*)(ws + WS_PX); bf16_t* QA = (bf16_t*)(ws + WS_QA); bf16_t* KVA = (bf16_t*)(ws + WS_KVA); bf16_t* KPE = (bf16_t*)(ws + WS_KPE);
    const int gw = F.bid * 8 + F.wave, NGW = F.G * 8;
    const f32x4* gq = (const f32x4*)(IN_(38) + l * 1024) + F.lane; const f32x4* gkv = (const f32x4*)(IN_(40) + l * 512) + F.lane; const float gpe = IN_(45)[l * 64 + F.lane];
    for (int tau = gw; tau < T; tau += NGW) {
        const f32x4* p = (const f32x4*)(PX + (size_t)tau * PXW + PXC) + F.lane;
        f32x4 q[4], kv[2]; float sq = 0.f, skv = 0.f;
#pragma unroll
        for (int j = 0; j < 4; ++j) { q[j] = p[64 * j]; sq += (q[j].x * q[j].x + q[j].y * q[j].y) + (q[j].z * q[j].z + q[j].w * q[j].w); }
#pragma unroll
        for (int j = 0; j < 2; ++j) { kv[j] = p[256 + 64 * j]; skv += (kv[j].x * kv[j].x + kv[j].y * kv[j].y) + (kv[j].z * kv[j].z + kv[j].w * kv[j].w); }
        const float pe = PX[(size_t)tau * PXW + PXC + 1536 + F.lane];
        const float rq = rsqrtf(wave_sum(sq) * (1.0f / 1024.0f) + NORM_EPS), rkv = rsqrtf(wave_sum(skv) * (1.0f / 512.0f) + NORM_EPS), rpe = rsqrtf(wave_sum(pe * pe) * (1.0f / 64.0f) + NORM_EPS);
        u32x2* oq = (u32x2*)(QA + (size_t)tau * 1024) + F.lane; u32x2* okv = (u32x2*)(KVA + (size_t)tau * 512) + F.lane;
#pragma unroll
        for (int j = 0; j < 4; ++j) { const f32x4 y = q[j] * rq * gq[64 * j]; u32x2 w; w.x = cvt_pk_bf16(y.x, y.y); w.y = cvt_pk_bf16(y.z, y.w); oq[64 * j] = w; }
#pragma unroll
        for (int j = 0; j < 2; ++j) { const f32x4 y = kv[j] * rkv * gkv[64 * j]; u32x2 w; w.x = cvt_pk_bf16(y.x, y.y); w.y = cvt_pk_bf16(y.z, y.w); okv[64 * j] = w; }
        float kp = pe * rpe * gpe;
        if (tau >= NCTX) kp = rope_apply(kp, tau, F.lane);
        KPE[(size_t)tau * 64 + F.lane] = (bf16_t)(cvt_pk_bf16(kp, kp) & 0xffffu);
    }
}
__device__ __forceinline__ void qkv_final_phase(const Frame& F, unsigned char* ws, int l, bool need_ctx) {
    const bf16_t* QRAW = (const bf16_t*)(ws + WS_QRAW); const bf16_t* KVRAW = (const bf16_t*)(ws + WS_KVRAW); const bf16_t* KPE = (const bf16_t*)(ws + WS_KPE);
    bf16_t* QF = (bf16_t*)(ws + WS_QF); bf16_t* KF = (bf16_t*)(ws + WS_KF);
    const int gw = F.bid * 8 + F.wave, NGW = F.G * 8, ln = F.lane;
    const float gqn0 = IN_(42)[l * 128 + 2 * ln], gqn1 = IN_(42)[l * 128 + 2 * ln + 1], gqp = IN_(43)[l * 64 + ln];
    const float gkn0 = IN_(44)[l * 128 + 2 * ln], gkn1 = IN_(44)[l * 128 + 2 * ln + 1];
    (void)need_ctx;
    for (int it = gw; it < T * NHC; it += NGW) { const int tau = it / NHC, h = it % NHC;
        const unsigned qn = *(const unsigned*)(QRAW + (size_t)tau * NQ + h * 192 + 2 * ln); const float q0 = bf2f((unsigned short)(qn & 0xffffu)), q1 = bf2f((unsigned short)(qn >> 16));
        const float qp = bf2f(QRAW[(size_t)tau * NQ + h * 192 + 128 + ln]);
        const unsigned kn = *(const unsigned*)(KVRAW + (size_t)tau * NKV + h * 256 + 2 * ln); const float k0 = bf2f((unsigned short)(kn & 0xffffu)), k1 = bf2f((unsigned short)(kn >> 16));
        const float rqn = rsqrtf(wave_sum(q0 * q0 + q1 * q1) * (1.0f / 128.0f) + NORM_EPS), rqp = rsqrtf(wave_sum(qp * qp) * (1.0f / 64.0f) + NORM_EPS), rkn = rsqrtf(wave_sum(k0 * k0 + k1 * k1) * (1.0f / 128.0f) + NORM_EPS);
        float qpe = qp * rqp * gqp; if (tau >= NCTX) qpe = rope_apply(qpe, tau, ln);
        *(unsigned*)(QF + (size_t)tau * NQ + h * 192 + 2 * ln) = cvt_pk_bf16(q0 * rqn * gqn0, q1 * rqn * gqn1);
        QF[(size_t)tau * NQ + h * 192 + 128 + ln] = (bf16_t)(cvt_pk_bf16(qpe, qpe) & 0xffffu);
        *(unsigned*)(KF + (size_t)tau * NQ + h * 192 + 2 * ln) = cvt_pk_bf16(k0 * rkn * gkn0, k1 * rkn * gkn1);
        KF[(size_t)tau * NQ + h * 192 + 128 + ln] = KPE[(size_t)tau * 64 + ln];
    }
}
__device__ __forceinline__ void rwkv_out_phase(const Frame& F, unsigned char* ws, int l, bool need_ctx) {
    const float* SS = (const float*)(ws + WS_SS); const float* SD = (const float*)(ws + WS_SD); const float* GB = (const float*)(ws + WS_G); const float* Y = (const float*)(ws + WS_Y);
    bf16_t* OB = (bf16_t*)(ws + WS_OBUF);
    const int gw = F.bid * 8 + F.wave, NGW = F.G * 8, ln = F.lane;
    const int lo = need_ctx ? 0 : NCTX * NHA;
    for (int it = lo + gw; it < T * NHA; it += NGW) { const int tau = it / NHA, h = it % NHA, col = h * 64 + ln;
        const float y = Y[(size_t)tau * A_W + col] + Y[((size_t)T + tau) * A_W + col];
        const float mu = wave_sum(y) * (1.0f / 64.0f); const float dy = y - mu; const float var = wave_sum(dy * dy) * (1.0f / 64.0f);
        const float yn = dy * rsqrtf(var + GN_EPS) * IN_(25)[l * A_W + col] + IN_(26)[l * A_W + col];
        const float* ss = SS + ((size_t)h * T + tau) * 192 + ln; const float r = ss[64], v = ss[128];
        const float km = 0.5f * (SD[(((size_t)h * 2 + 0) * T + tau) * 192 + 128 + ln] + SD[(((size_t)h * 2 + 1) * T + tau) * 192 + 128 + ln]);
        const float bonus = wave_sum(r * km * IN_(24)[l * A_W + col]) * v;
        const float o = (yn + bonus) * GB[(size_t)tau * A_W + col];
        OB[(size_t)tau * DM + col] = (bf16_t)(cvt_pk_bf16(o, o) & 0xffffu);
    }
}
__device__ __forceinline__ void hyena_prep_phase(const Frame& F, unsigned char* ws, int l) {
    const float* PX = (const float*)(ws + WS_PX); float* GT = (float*)(ws + WS_GT); float* X0T = (float*)(ws + WS_X0T);
    LAS float* LGt = (LAS float*)F.lds; LAS float* LX0 = LGt + 64 * 65;
    const float* cw = IN_(27) + (size_t)l * 3 * B_IN; const float* cb = IN_(28) + (size_t)l * B_IN;
    for (int it = F.bid; it < (T / 64) * 20; it += F.G) { const int tt = it / 20, ct = it % 20;
        { const int t = F.tid >> 3, c0 = ct * 64 + (F.tid & 7) * 8, tau = tt * 64 + t;
          f32x4 u[3][2];
#pragma unroll
          for (int grp = 0; grp < 3; ++grp)
#pragma unroll
              for (int q = 0; q < 2; ++q) { const int c = grp * 1280 + c0 + 4 * q; const float* p = PX + (size_t)tau * PXW + PXB + c;
                  const bool hl = has_left(tau), hr = has_right(tau);
                  const f32x4 y = *(const f32x4*)p * *(const f32x4*)(cw + B_IN + c) + *(const f32x4*)(cb + c) + *(const f32x4*)(p - (hl ? PXW : 0)) * (*(const f32x4*)(cw + c) * (hl ? 1.f : 0.f))
                                + *(const f32x4*)(p + (hr ? PXW : 0)) * (*(const f32x4*)(cw + 2 * B_IN + c) * (hr ? 1.f : 0.f));
                  u[grp][q] = y; }
#pragma unroll
          for (int q = 0; q < 2; ++q)
#pragma unroll
              for (int e = 0; e < 4; ++e) { const int ch = (F.tid & 7) * 8 + 4 * q + e; LGt[ch * 65 + t] = u[1][q][e] * u[2][q][e]; LX0[ch * 65 + t] = u[0][q][e]; } }
        __syncthreads();
        { const int ch = F.tid >> 3, t0 = (F.tid & 7) * 8; const size_t o = (size_t)(ct * 64 + ch) * T + tt * 64 + t0;
          f32x4 a0, a1, b0, b1;
#pragma unroll
          for (int e = 0; e < 4; ++e) { a0[e] = LGt[ch * 65 + t0 + e]; a1[e] = LGt[ch * 65 + t0 + 4 + e]; b0[e] = LX0[ch * 65 + t0 + e]; b1[e] = LX0[ch * 65 + t0 + 4 + e]; }
          *(f32x4*)(GT + o) = a0; *(f32x4*)(GT + o + 4) = a1; *(f32x4*)(X0T + o) = b0; *(f32x4*)(X0T + o + 4) = b1; }
        __syncthreads(); }
}
__device__ __forceinline__ void hyena_out_phase(const Frame& F, unsigned char* ws, bool need_ctx) {
    const float* YT = (const float*)(ws + WS_GT); bf16_t* OB = (bf16_t*)(ws + WS_OBUF);
    LAS float* L = (LAS float*)F.lds;
    const int it0 = need_ctx ? 0 : (NCTX / 64) * 20;
    for (int it = it0 + F.bid; it < (T / 64) * 20; it += F.G) { const int tt = it / 20, ct = it % 20;
        { const int ch = F.tid >> 3, t0 = (F.tid & 7) * 8; const size_t o = (size_t)(ct * 64 + ch) * T + tt * 64 + t0;
          const f32x4 a0 = *(const f32x4*)(YT + o), a1 = *(const f32x4*)(YT + o + 4);
#pragma unroll
          for (int e = 0; e < 4; ++e) { L[ch * 65 + t0 + e] = a0[e]; L[ch * 65 + t0 + 4 + e] = a1[e]; } }
        __syncthreads();
        { const int t = F.tid >> 3, c0 = (F.tid & 7) * 8; float x[8];
#pragma unroll
          for (int e = 0; e < 8; ++e) x[e] = L[(c0 + e) * 65 + t];
          u32x4 w; w.x = cvt_pk_bf16(x[0], x[1]); w.y = cvt_pk_bf16(x[2], x[3]); w.z = cvt_pk_bf16(x[4], x[5]); w.w = cvt_pk_bf16(x[6], x[7]);
          *(u32x4*)(OB + (size_t)(tt * 64 + t) * DM + 1280 + ct * 64 + c0) = w; }
        __syncthreads(); }
}
namespace att {
constexpr int DK = 192, DV = 128, NW = 8, QBLK = 32, KVBLK = 64;
constexpr float SCALE = 0.07216878364870322f;
constexpr float THR = 8.f;
#ifndef ATT_SDEPTH
#define ATT_SDEPTH 2
#endif
constexpr int SDEPTH = ATT_SDEPTH;
constexpr int LDQ = 2304, LDK = 2304, LDV = 3072, LDO = 4096;
constexpr int SHM_V = KVBLK * DV * 2, SHM_K = KVBLK * DK * 2, SHM_ATTN = 2 * SHM_V + 2 * SHM_K + NW * 64 * 4 + NW * 4096;
using bf16x8 = __attribute__((ext_vector_type(8))) short;
using s16x4  = __attribute__((ext_vector_type(4))) short;
using f32x16 = __attribute__((ext_vector_type(16))) float;
using u32x4  = __attribute__((ext_vector_type(4))) unsigned;
#define KSWZ(row, colB) ((row) * 384 + ((colB) ^ (((row) & 7) << 4)))
#define SBAR() __builtin_amdgcn_sched_barrier(0)
__device__ __forceinline__ int crow(int r, int hi) { return (r & 3) + 8 * (r >> 2) + 4 * hi; }
__device__ __forceinline__ unsigned cvtpk(float lo, float hi) { unsigned r; asm volatile("v_cvt_pk_bf16_f32 %0, %1, %2" : "=v"(r) : "v"(lo), "v"(hi)); return r; }
__device__ __forceinline__ void partialSM(f32x16& p0, f32x16& p1, float& m_reg, float& mn, float& alpha) {
  constexpr float C = SCALE * 1.4426950408889634f;
  float pmax = p0[0]; for (int r = 1; r < 16; ++r) pmax = fmaxf(pmax, p0[r]); for (int r = 0; r < 16; ++r) pmax = fmaxf(pmax, p1[r]);
  { auto rr = __builtin_amdgcn_permlane32_swap(__float_as_uint(pmax), __float_as_uint(pmax), false, false);
    pmax = fmaxf(__uint_as_float(rr[0]), __uint_as_float(rr[1])); }
  if (__builtin_expect(__all(pmax - m_reg <= THR / SCALE), 1)) { mn = m_reg; alpha = 1.f; }
  else { mn = fmaxf(m_reg, pmax); alpha = __builtin_amdgcn_exp2f((m_reg - mn) * C); m_reg = mn; }
  float mnC = -mn * C;
  for (int r = 0; r < 16; ++r) p0[r] = fmaf(p0[r], C, mnC); for (int r = 0; r < 16; ++r) p1[r] = fmaf(p1[r], C, mnC);
  for (int r = 0; r < 16; ++r) p0[r] = __builtin_amdgcn_exp2f(p0[r]);
}
__device__ __forceinline__ void finishSM(f32x16& p0, f32x16& p1, float alpha, float& l_reg, bf16x8& pa0, bf16x8& pa1, bf16x8& pa2, bf16x8& pa3) {
  for (int r = 0; r < 16; ++r) p1[r] = __builtin_amdgcn_exp2f(p1[r]);
  float ps = 0; for (int r = 0; r < 16; ++r) ps += p0[r]; for (int r = 0; r < 16; ++r) ps += p1[r];
  { auto rr = __builtin_amdgcn_permlane32_swap(__float_as_uint(ps), __float_as_uint(ps), false, false);
    ps = __uint_as_float(rr[0]) + __uint_as_float(rr[1]); }
  l_reg = l_reg * alpha + ps;
#define PK4(P, BASE, OUT) do { unsigned a0 = cvtpk(P[BASE + 0], P[BASE + 1]), a1 = cvtpk(P[BASE + 2], P[BASE + 3]);   \
    unsigned b0 = cvtpk(P[BASE + 4], P[BASE + 5]), b1 = cvtpk(P[BASE + 6], P[BASE + 7]);                              \
    auto r0 = __builtin_amdgcn_permlane32_swap(a0, b0, false, false); auto r1 = __builtin_amdgcn_permlane32_swap(a1, b1, false, false); \
    u32x4 w = {r0[0], r1[0], r0[1], r1[1]}; OUT = *reinterpret_cast<bf16x8*>(&w); } while (0)
  PK4(p0, 0, pa0); PK4(p0, 8, pa1); PK4(p1, 0, pa2); PK4(p1, 8, pa3);
#undef PK4
}
__device__ __forceinline__ void qkt(f32x16& p0, f32x16& p1, const char* Ks, const bf16x8* qr, const char* qrl, int r32, int hi) {
  p0 = f32x16{}; p1 = f32x16{};
#pragma unroll
  for (int d0 = 0; d0 < 8; ++d0) { int cb = (d0 * 16 + hi * 8) * 2;
    bf16x8 b0 = *reinterpret_cast<const bf16x8*>(Ks + KSWZ(r32, cb));
    bf16x8 b1 = *reinterpret_cast<const bf16x8*>(Ks + KSWZ(32 + r32, cb));
    p0 = __builtin_amdgcn_mfma_f32_32x32x16_bf16(b0, qr[d0], p0, 0, 0, 0);
    p1 = __builtin_amdgcn_mfma_f32_32x32x16_bf16(b1, qr[d0], p1, 0, 0, 0); }
#pragma unroll
  for (int d0 = 8; d0 < 12; ++d0) { int cb = (d0 * 16 + hi * 8) * 2;
    bf16x8 b0 = *reinterpret_cast<const bf16x8*>(Ks + KSWZ(r32, cb));
    bf16x8 b1 = *reinterpret_cast<const bf16x8*>(Ks + KSWZ(32 + r32, cb));
    const bf16x8 q = *reinterpret_cast<const bf16x8*>(qrl + ((((d0 - 8) * 2 + hi) ^ (r32 & 7)) << 4));
    p0 = __builtin_amdgcn_mfma_f32_32x32x16_bf16(b0, q, p0, 0, 0, 0);
    p1 = __builtin_amdgcn_mfma_f32_32x32x16_bf16(b1, q, p1, 0, 0, 0); }
}
__device__ __forceinline__ int v_st(int k, int c) { const int kk = (k & ~0xC) | ((k & 4) << 1) | ((k & 8) >> 1); return ((kk >> 3) * 4 + (c >> 5)) * 512 + ((kk & 7) * 32 + (c & 31)) * 2; }
__device__ __forceinline__ int v_rd_base(int lane) { return ((lane & 3) << 3) | (((lane >> 2) & 3) << 6) | (((lane >> 4) & 1) << 5) | (((lane >> 5) & 1) << 8); }
constexpr int v_rd_off(int d0, int ks, int half) { return d0 * 512 + ks * 4096 + half * 2048; }
template <int OFF> __device__ __forceinline__ s16x4 tr_read(int vb) {
  s16x4 r; asm volatile("ds_read_b64_tr_b16 %0, %1 offset:%2" : "=&v"(r) : "v"(vb), "i"(OFF) : "memory"); return r;
}
template <int D0> __device__ __forceinline__ void pv_one(f32x16& od, int vb, bf16x8 pa0, bf16x8 pa1, bf16x8 pa2, bf16x8 pa3) {
  const s16x4 l0 = tr_read<v_rd_off(D0, 0, 0)>(vb), h0 = tr_read<v_rd_off(D0, 0, 1)>(vb), l1 = tr_read<v_rd_off(D0, 1, 0)>(vb), h1 = tr_read<v_rd_off(D0, 1, 1)>(vb);
  const s16x4 l2 = tr_read<v_rd_off(D0, 2, 0)>(vb), h2 = tr_read<v_rd_off(D0, 2, 1)>(vb), l3 = tr_read<v_rd_off(D0, 3, 0)>(vb), h3 = tr_read<v_rd_off(D0, 3, 1)>(vb);
  asm volatile("s_waitcnt lgkmcnt(0)" ::: "memory"); SBAR();
#define PK(L, H) (bf16x8){L[0], L[1], L[2], L[3], H[0], H[1], H[2], H[3]}
  od = __builtin_amdgcn_mfma_f32_32x32x16_bf16(pa0, PK(l0, h0), od, 0, 0, 0);
  od = __builtin_amdgcn_mfma_f32_32x32x16_bf16(pa1, PK(l1, h1), od, 0, 0, 0);
  od = __builtin_amdgcn_mfma_f32_32x32x16_bf16(pa2, PK(l2, h2), od, 0, 0, 0);
  od = __builtin_amdgcn_mfma_f32_32x32x16_bf16(pa3, PK(l3, h3), od, 0, 0, 0);
#undef PK
}
__device__ __forceinline__ void pv_d0(f32x16* o, int vb, bf16x8 pa0, bf16x8 pa1, bf16x8 pa2, bf16x8 pa3) {
  pv_one<0>(o[0], vb, pa0, pa1, pa2, pa3); pv_one<1>(o[1], vb, pa0, pa1, pa2, pa3); pv_one<2>(o[2], vb, pa0, pa1, pa2, pa3); pv_one<3>(o[3], vb, pa0, pa1, pa2, pa3);
}
__device__ __forceinline__ void attn_body(const bf16_t* __restrict__ Qb, const bf16_t* __restrict__ Kh, const bf16_t* __restrict__ Vh, bf16_t* __restrict__ Ob, int seq, char* lds) {
  int tid_ = threadIdx.x; asm volatile("" : "+v"(tid_));
  const int tid = tid_, wid = tid >> 6, lane = tid & 63, r32 = lane & 31, hi = lane >> 5;
  char* V_lds = lds; char* K_lds = lds + 2 * SHM_V;
  float* ws = (float*)(lds + 2 * SHM_V + 2 * SHM_K) + wid * 64; float* li_l = ws; float* al_l = ws + 32;
  float m_reg = -1e30f, l_reg = 0; f32x16 o[4] = {}; bf16x8 qr[8];
  const bf16_t* Qw = Qb + (long)(wid * QBLK + r32) * LDQ + hi * 8;
  char* qrl = lds + 2 * SHM_V + 2 * SHM_K + NW * 64 * 4 + wid * 4096 + r32 * 128;
#pragma unroll
  for (int d0 = 0; d0 < 8; ++d0) qr[d0] = *reinterpret_cast<const bf16x8*>(Qw + d0 * 16);
#pragma unroll
  for (int d0 = 8; d0 < 12; ++d0) *reinterpret_cast<bf16x8*>(qrl + ((((d0 - 8) * 2 + hi) ^ (r32 & 7)) << 4)) = *reinterpret_cast<const bf16x8*>(Qw + d0 * 16);
  asm volatile("s_waitcnt lgkmcnt(0)" ::: "memory");
  unsigned kgo[3], vgo[2];
#pragma unroll
  for (int i = 0; i < 3; ++i) { const int p = (i * 8 + wid) * 64 + lane, row = p / 24, slot = p % 24, ch = slot ^ (row & 7); kgo[i] = (unsigned)(row * LDK + ch * 8) * 2u; }
#pragma unroll
  for (int i = 0; i < 2; ++i) { const int p = (i * 8 + wid) * 64 + lane, sub = p >> 5, within = p & 31, kk = (sub >> 2) * 8 + (within >> 2), c = (sub & 3) * 32 + (within & 3) * 8;
    const int k = (kk & ~0xC) | ((kk & 4) << 1) | ((kk & 8) >> 1); vgo[i] = (unsigned)(k * LDV + c) * 2u; }
  const int vb0 = (int)(uintptr_t)V_lds + v_rd_base(lane);
  typedef __attribute__((address_space(3))) unsigned lds_u32;
#define DMA_K(b, k0) do { const char* kg = (const char*)Kh + (size_t)(k0) * (LDK * 2); \
    _Pragma("unroll") for (int _i = 0; _i < 3; ++_i) __builtin_amdgcn_global_load_lds((const unsigned*)(kg + kgo[_i]), (lds_u32*)(K_lds + (b) * SHM_K + (_i * 8 + wid) * 1024), 16, 0, 0); } while (0)
#define DMA_V(b, k0) do { const char* vg = (const char*)Vh + (size_t)(k0) * (LDV * 2); \
    _Pragma("unroll") for (int _i = 0; _i < 2; ++_i) __builtin_amdgcn_global_load_lds((const unsigned*)(vg + vgo[_i]), (lds_u32*)(V_lds + (b) * SHM_V + (_i * 8 + wid) * 1024), 16, 0, 0); } while (0)
#define RESC(a) do { if (__any((a) < 1.f)) { if (hi == 0) al_l[r32] = (a); asm volatile("s_waitcnt lgkmcnt(0)" ::: "memory"); \
    for (int d = 0; d < 4; ++d) for (int r = 0; r < 16; ++r) o[d][r] *= al_l[crow(r, hi)]; } } while (0)
#define ENDSTEP() do { asm volatile("s_waitcnt vmcnt(0)" ::: "memory"); __syncthreads(); } while (0)
  f32x16 pA0, pA1, pB0, pB1; float mnA, mnB, alA, alB; bf16x8 pa0, pa1, pa2, pa3; const int NT = seq / KVBLK;
  DMA_K(0, 0); ENDSTEP();
  DMA_K(1, KVBLK); DMA_V(0, 0);
  qkt(pA0, pA1, K_lds, qr, qrl, r32, hi); partialSM(pA0, pA1, m_reg, mnA, alA);
  ENDSTEP();
  for (int j = 1; j + 1 < NT; j += 2) {
    DMA_K(0, (j + 1) * KVBLK); DMA_V(1, j * KVBLK);
    SBAR(); qkt(pB0, pB1, K_lds + SHM_K, qr, qrl, r32, hi);
    finishSM(pA0, pA1, alA, l_reg, pa0, pa1, pa2, pa3); SBAR();
    pv_d0(o, vb0, pa0, pa1, pa2, pa3); partialSM(pB0, pB1, m_reg, mnB, alB);
    RESC(alB); ENDSTEP();
    if (j + 2 < NT) DMA_K(1, (j + 2) * KVBLK);
    DMA_V(0, (j + 1) * KVBLK);
    SBAR(); qkt(pA0, pA1, K_lds, qr, qrl, r32, hi);
    finishSM(pB0, pB1, alB, l_reg, pa0, pa1, pa2, pa3); SBAR();
    pv_d0(o, vb0 + (int)SHM_V, pa0, pa1, pa2, pa3); partialSM(pA0, pA1, m_reg, mnA, alA);
    RESC(alA); ENDSTEP();
  }
  DMA_V(1, (NT - 1) * KVBLK);
  SBAR(); qkt(pB0, pB1, K_lds + SHM_K, qr, qrl, r32, hi);
  finishSM(pA0, pA1, alA, l_reg, pa0, pa1, pa2, pa3); SBAR();
  pv_d0(o, vb0, pa0, pa1, pa2, pa3); partialSM(pB0, pB1, m_reg, mnB, alB);
  RESC(alB); ENDSTEP();
  finishSM(pB0, pB1, alB, l_reg, pa0, pa1, pa2, pa3); SBAR();
  pv_d0(o, vb0 + (int)SHM_V, pa0, pa1, pa2, pa3);
#undef DMA_K
#undef DMA_V
#undef ENDSTEP
  if (hi == 0) li_l[r32] = l_reg; asm volatile("s_waitcnt lgkmcnt(0)" ::: "memory");
  float rli[16];
#pragma unroll
  for (int r = 0; r < 16; ++r) rli[r] = __builtin_amdgcn_rcpf(li_l[crow(r, hi)]);
  bf16_t* Ow = Ob + (long)(wid * QBLK) * LDO;
#pragma unroll
  for (int r = 0; r < 16; ++r) { int orow = crow(r, hi);
#pragma unroll
    for (int d0 = 0; d0 < 4; ++d0) { const float val = o[d0][r] * rli[r]; Ow[(long)orow * LDO + d0 * 32 + r32] = (bf16_t)(cvtpk(val, val) & 0xffff); } }
  __syncthreads();
#undef RESC
}
}
__device__ __forceinline__ f32x2 cmul(f32x2 a, f32x2 b) { return (f32x2){a.x * b.x - a.y * b.y, a.x * b.y + a.y * b.x}; }
__device__ __forceinline__ int rev4_14(int k) { const unsigned r = __brev((unsigned)k) >> 18; return (int)(((r & 0x1555u) << 1) | ((r >> 1) & 0x1555u)); }
#define ZI(i) ((i) + ((i) >> 5))
__device__ __forceinline__ void fft_tw(int j, int q, float sign, f32x2& w1, f32x2& w2, f32x2& w3) {
    const float rev = (float)j / (float)(4 * q); const float sn = __builtin_amdgcn_sinf(rev), cs = __builtin_amdgcn_cosf(rev);
    w1 = (f32x2){cs, sign * sn}; w2 = cmul(w1, w1); w3 = cmul(w2, w1);
}
__device__ __forceinline__ void fft16k_dif(LAS f32x2* Z, int tid) {
#pragma unroll 1
    for (int s = 0; s < 7; ++s) { int lq = 12 - 2 * s; asm volatile("" : "+s"(lq)); const int q = 1 << lq;
        const bool shared = q <= 512; f32x2 w1, w2, w3; fft_tw(tid & (q - 1), q, -1.f, w1, w2, w3);
#pragma unroll 2
        for (int i = 0; i < 8; ++i) { const int b = tid + 512 * i, j = b & (q - 1), base = ((b >> lq) << (lq + 2)) + j;
            const int i0 = ZI(base), i1 = ZI(base + q), i2 = ZI(base + 2 * q), i3 = ZI(base + 3 * q);
            const f32x2 a0 = Z[i0], a1 = Z[i1], a2 = Z[i2], a3 = Z[i3];
            const f32x2 t0 = a0 + a2, t1 = a0 - a2, t2 = a1 + a3, t3 = a1 - a3;
            if (!shared) fft_tw(j, q, -1.f, w1, w2, w3);
            Z[i0] = t0 + t2; Z[i1] = cmul((f32x2){t1.x + t3.y, t1.y - t3.x}, w1); Z[i2] = cmul(t0 - t2, w2); Z[i3] = cmul((f32x2){t1.x - t3.y, t1.y + t3.x}, w3); }
        __syncthreads(); }
}
__device__ __forceinline__ void fft16k_dit_inv(LAS f32x2* Z, int tid) {
#pragma unroll 1
    for (int s = 0; s < 7; ++s) { int lq = 2 * s; asm volatile("" : "+s"(lq)); const int q = 1 << lq;
        const bool shared = q <= 512; f32x2 w1, w2, w3; fft_tw(tid & (q - 1), q, 1.f, w1, w2, w3);
#pragma unroll 2
        for (int i = 0; i < 8; ++i) { const int b = tid + 512 * i, j = b & (q - 1), base = ((b >> lq) << (lq + 2)) + j;
            if (!shared) fft_tw(j, q, 1.f, w1, w2, w3);
            const int i0 = ZI(base), i1 = ZI(base + q), i2 = ZI(base + 2 * q), i3 = ZI(base + 3 * q);
            const f32x2 b0 = Z[i0], b1 = cmul(Z[i1], w1), b2 = cmul(Z[i2], w2), b3 = cmul(Z[i3], w3);
            const f32x2 t0 = b0 + b2, t1 = b0 - b2, t2 = b1 + b3, t3 = b1 - b3;
            Z[i0] = t0 + t2; Z[i1] = (f32x2){t1.x - t3.y, t1.y + t3.x}; Z[i2] = t0 - t2; Z[i3] = (f32x2){t1.x + t3.y, t1.y - t3.x}; }
        __syncthreads(); }
}
constexpr float HY_MIN_DECAY = -3.0701134573253945f, HY_MAX_DECAY = -15.350567286626973f;
__device__ __forceinline__ float hy_delta(int c) { return fabsf(HY_MIN_DECAY + (HY_MAX_DECAY - HY_MIN_DECAY) * ((float)c / 1279.0f)); }
__device__ __forceinline__ float conv3b_at(const float* PX, int tau, int col, const float* cw, int l, int c) {
    const float* w = cw + (size_t)l * 3 * B_IN;
    return conv3_at(PX, tau, col, w[c], w[B_IN + c], w[2 * B_IN + c]);
}
__device__ __forceinline__ void hyena_unit(const Frame& F, unsigned char* ws, int l, int pair) {
    LAS f32x2* Z = (LAS f32x2*)F.lds; LAS float* red = (LAS float*)(F.lds + LDS_MISC + 128);
    const int tid = F.tid, c0 = 2 * pair;
    const bf16_t* H3x = (const bf16_t*)(ws + WS_H3) + (size_t)l * 64 * T + NCTX;
    float* GT = (float*)(ws + WS_GT); const float* X0T = (const float*)(ws + WS_X0T);
    f32x2* scr = (f32x2*)(ws + WS_HSCR) + (size_t)F.bid * 16384;
    LAS f32x4* FW = (LAS f32x4*)(F.lds + LDS_MISC + 256);
    if (tid < 256) { const int j = tid >> 2, q = tid & 3; ((LAS float*)FW)[tid] = IN_(35)[(size_t)l * 64 * 2560 + (size_t)j * 2560 + (q >> 1) * 1280 + c0 + (q & 1)]; }
    __syncthreads();
    const float d0 = hy_delta(c0), d1 = hy_delta(c0 + 1);
#ifndef HYS
#define HYS 31
#endif
    float s0, s1, sc0 = 0.f, sc1 = 0.f;
    for (int rp14 = 0; rp14 < REP(14); ++rp14) {
    s0 = 0.f; s1 = 0.f;
    if (HYS & 1)
#pragma unroll 1
    for (int i = 0; i < 2; ++i) { const int tb = 4096 * i + 8 * tid; const bf16_t* hc = H3x + tb;
        asm volatile("" ::: "memory");
        f32x4 acc[8];
#pragma unroll
        for (int p = 0; p < 8; ++p) acc[p] = (f32x4){0.f, 0.f, 0.f, 0.f};
#pragma unroll 8
        for (int j = 0; j < 64; ++j) { const f32x4 w = FW[j]; const u32x4 hv = *(const u32x4*)(hc + (size_t)j * T);
#pragma unroll
            for (int p = 0; p < 4; ++p) { acc[2 * p] += w * __uint_as_float(hv[p] << 16); acc[2 * p + 1] += w * __uint_as_float(hv[p] & 0xffff0000u); } }
#pragma unroll
        for (int p = 0; p < 8; ++p) { const int t = tb + p;
            const float tl = (float)t * (1.0f / 8191.0f), e0 = __expf(-tl * d0), e1 = __expf(-tl * d1);
            const float f0 = acc[p].x * e0, f1 = acc[p].y * e1, b0 = acc[p].z * e0, b1 = acc[p].w * e1;
            Z[ZI(t)] = (f32x2){f0, f1}; s0 += fabsf(f0); s1 += fabsf(f1);
            if (t < 8191) { Z[ZI(16383 - t)] = (f32x2){b0, b1}; s0 += fabsf(b0); s1 += fabsf(b1); } } }
    if (tid == 0) { float zz = 0.f; asm volatile("" : "+v"(zz)); Z[ZI(8192)] = (f32x2){zz, zz}; }
    s0 = wave_sum(s0); s1 = wave_sum(s1);
    if (F.lane == 0) { red[F.wave * 2] = s0; red[F.wave * 2 + 1] = s1; }
    __syncthreads();
    float n0 = 0.f, n1 = 0.f;
#pragma unroll
    for (int w = 0; w < 8; ++w) { n0 += red[2 * w]; n1 += red[2 * w + 1]; }
    sc0 = 1.0f / (16384.0f * n0); sc1 = 1.0f / (16384.0f * n1);
    if (HYS & 2) fft16k_dif(Z, tid);
#pragma unroll 4
    for (int i = 0; i < 32; ++i) scr[tid + 512 * i] = Z[ZI(tid + 512 * i)];
    __syncthreads();
    }
    for (int rp15 = 0; rp15 < REP(15); ++rp15) {
    const float* g0p = GT + (size_t)c0 * T + NCTX; const float* g1p = g0p + T;
    { float zz = 0.f; asm volatile("" : "+v"(zz));
#pragma unroll 4
      for (int i = 0; i < 16; ++i) { const int t = tid + 512 * i; Z[ZI(t)] = (f32x2){g0p[t], g1p[t]}; Z[ZI(8192 + t)] = (f32x2){zz, zz}; } }
    __syncthreads();
    if (HYS & 2) fft16k_dif(Z, tid);
    if (HYS & 8)
#pragma unroll 2
    for (int i = 0; i < 17; ++i) { const int k = tid + 512 * i; if (i == 16 && tid != 0) break;
        const int pk = rev4_14(k & 16383), pn = rev4_14((16384 - k) & 16383);
        const f32x2 A = Z[ZI(pk)], B = Z[ZI(pn)], At = scr[pk], Bt = scr[pn];
        const f32x2 G0 = (f32x2){0.5f * (A.x + B.x), 0.5f * (A.y - B.y)}, G1 = (f32x2){0.5f * (A.y + B.y), -0.5f * (A.x - B.x)};
        const f32x2 H0 = (f32x2){0.5f * (At.x + Bt.x), 0.5f * (At.y - Bt.y)}, H1 = (f32x2){0.5f * (At.y + Bt.y), -0.5f * (At.x - Bt.x)};
        const f32x2 P0 = cmul(G0, H0), P1 = cmul(G1, H1);
        Z[ZI(pk)] = (f32x2){P0.x - P1.y, P0.y + P1.x};
        if (pn != pk) Z[ZI(pn)] = (f32x2){P0.x + P1.y, P1.x - P0.y}; }
    __syncthreads();
    if (HYS & 2) fft16k_dit_inv(Z, tid);
    }
    const float bb0 = IN_(37)[l * 1280 + c0], bb1 = IN_(37)[l * 1280 + c0 + 1];
    { float* y0p = GT + (size_t)c0 * T + NCTX; float* y1p = y0p + T; const float* x0p = X0T + (size_t)c0 * T + NCTX; const float* x1p = x0p + T;
#pragma unroll 4
      for (int i = 0; i < 16; ++i) { const int t = tid + 512 * i; const f32x2 z = Z[ZI(t)]; const float ga = y0p[t], gb = y1p[t];
          y0p[t] = x0p[t] * (z.x * sc0 + ga * bb0); y1p[t] = x1p[t] * (z.y * sc1 + gb * bb1); } }
    __syncthreads();
}
__device__ __forceinline__ void hyena_ctx_unit(const Frame& F, unsigned char* ws, int l, int unit) {
    LAS float* TF = (LAS float*)F.lds; LAS float* TB = TF + 2048; LAS float* GG = TB + 2048;
    const int tid = F.tid, t = tid >> 1, cc = (tid & 1) * 4, cbase = unit * 8 + cc;
    const bf16_t* H3c = (const bf16_t*)(ws + WS_H3) + (size_t)l * 64 * T; float* GT = (float*)(ws + WS_GT); const float* X0T = (const float*)(ws + WS_X0T);
    { float f[4] = {0.f, 0.f, 0.f, 0.f}, b[4] = {0.f, 0.f, 0.f, 0.f};
      const float* wbase = IN_(35) + (size_t)l * 64 * 2560 + cbase;
      for (int j = 0; j < 64; ++j) { const float hv = bf2f(H3c[(size_t)j * T + t]); const float* wrow = wbase + (size_t)j * 2560;
#pragma unroll
          for (int q = 0; q < 4; ++q) { f[q] += hv * wrow[q]; b[q] += hv * wrow[1280 + q]; } }
      const float tl = (float)t * (1.0f / 255.0f);
#pragma unroll
      for (int q = 0; q < 4; ++q) { const float e = __expf(-tl * hy_delta(cbase + q)); TF[t * 8 + cc + q] = f[q] * e; TB[t * 8 + cc + q] = b[q] * e; GG[t * 8 + cc + q] = GT[(size_t)(cbase + q) * T + t]; } }
    __syncthreads();
    float nrm[4] = {0.f, 0.f, 0.f, 0.f}, y[4] = {0.f, 0.f, 0.f, 0.f};
    for (int s = 0; s < 256; ++s) {
#pragma unroll
        for (int q = 0; q < 4; ++q) { nrm[q] += fabsf(TF[s * 8 + cc + q]) + (s < 255 ? fabsf(TB[s * 8 + cc + q]) : 0.f);
            const int o = t - s; const float tap = o >= 0 ? TF[o * 8 + cc + q] : TB[(-o - 1) * 8 + cc + q];
            y[q] += tap * GG[s * 8 + cc + q]; } }
    __syncthreads();
#pragma unroll
    for (int q = 0; q < 4; ++q) GT[(size_t)(cbase + q) * T + t] = X0T[(size_t)(cbase + q) * T + t] * (y[q] / nrm[q] + GG[t * 8 + cc + q] * IN_(37)[l * 1280 + cbase + q]);
    __syncthreads();
}
constexpr int SC_C = 16, SC_NCHUNK = T / SC_C, SC_CHUNK_BYTES = 14 * 1024;
__device__ __forceinline__ int sc_tau(int d, int c, int t) { return d == 0 ? SC_C * c + t : (c < NCTX / SC_C ? NCTX - 1 - SC_C * c - t : T - 1 - SC_C * (c - NCTX / SC_C) - t); }
__device__ __forceinline__ int sc_perm(int e, int hi) { return (e & 3) + 8 * (e >> 2) + 4 * hi; }
constexpr size_t WS_FR_BYTES = (size_t)2 * NHA * SC_NCHUNK * SC_CHUNK_BYTES;

typedef short sc_bf16x8 __attribute__((ext_vector_type(8)));
typedef float sc_f32x16 __attribute__((ext_vector_type(16)));
__device__ __forceinline__ sc_bf16x8 sc_pack8(const sc_f32x16& a, int base) {
    u32x4 w; w.x = cvt_pk_bf16(a[base + 0], a[base + 1]); w.y = cvt_pk_bf16(a[base + 2], a[base + 3]); w.z = cvt_pk_bf16(a[base + 4], a[base + 5]); w.w = cvt_pk_bf16(a[base + 6], a[base + 7]);
    return *reinterpret_cast<sc_bf16x8*>(&w);
}
constexpr int SC_NSLOT = 9, SC_AHEAD = 7;
__device__ __forceinline__ void scan_chain_mfma(const Frame& F, unsigned char* ws, int chain) {
    const int h = chain >> 1, d = chain & 1, lane = F.lane, n = lane & 31, hi = lane >> 5, ib = F.wave;
    const unsigned char* FRc = ws + WS_FR + (size_t)chain * SC_NCHUNK * SC_CHUNK_BYTES;
    float* Yd = (float*)(ws + WS_Y) + (size_t)d * T * A_W + h * 64;
    LAS unsigned char* buf = F.lds;
    typedef __attribute__((address_space(3))) unsigned sc_lds_u32;
#define SCM_DMA(c_) do { if (ib < 7) { const unsigned char* src_ = FRc + (size_t)(c_) * SC_CHUNK_BYTES; LAS unsigned char* dst_ = buf + ((c_) % SC_NSLOT) * SC_CHUNK_BYTES; \
        _Pragma("unroll") for (int i_ = 0; i_ < 2; ++i_) __builtin_amdgcn_global_load_lds((const unsigned*)(src_ + (i_ * 7 + ib) * 1024 + lane * 16), (sc_lds_u32*)(dst_ + (i_ * 7 + ib) * 1024), 16, 0, 0); } } while (0)
    sc_f32x16 S0 = {}, S1 = {};
    int yoff[8];
#pragma unroll
    for (int r = 0; r < 8; ++r) { const int t = (r & 3) + 8 * (r >> 2) + 4 * hi; yoff[r] = (d ? -t : t) * A_W + 32 * ib + n; }
    __syncthreads();
#pragma unroll
    for (int c = 0; c < SC_AHEAD; ++c) SCM_DMA(c);
    asm volatile("s_waitcnt vmcnt(12)" ::: "memory"); __builtin_amdgcn_s_barrier(); asm volatile("" ::: "memory");
#pragma unroll 1
    for (int c = 0; c < SC_NCHUNK; ++c) {
        const bool steady = c + SC_AHEAD < SC_NCHUNK;
        if (steady) SCM_DMA(c + SC_AHEAD);
        if (ib < 2) {
                const LAS unsigned char* fb = buf + (c % SC_NSLOT) * SC_CHUNK_BYTES;
                sc_bf16x8 fr[11]; sc_bf16x8 vf; f32x4 gt[8];
                { const unsigned fa = (unsigned)(uintptr_t)fb + lane * 16, va = fa + (11 + ib) * 1024, ga = (unsigned)(uintptr_t)fb + 13 * 1024 + hi * 128;
#define SC_DSRD(dst, addr, off) asm volatile("ds_read_b128 %0, %1 offset:%2" : "=v"(dst) : "v"(addr), "i"(off))
                  SC_DSRD(fr[0], fa, 0); SC_DSRD(fr[1], fa, 1024); SC_DSRD(fr[2], fa, 2048); SC_DSRD(fr[3], fa, 3072); SC_DSRD(fr[4], fa, 4096); SC_DSRD(fr[5], fa, 5120);
                  SC_DSRD(fr[6], fa, 6144); SC_DSRD(fr[7], fa, 7168); SC_DSRD(fr[8], fa, 8192); SC_DSRD(fr[9], fa, 9216); SC_DSRD(fr[10], fa, 10240); SC_DSRD(vf, va, 0);
                  SC_DSRD(gt[0], ga, 0); SC_DSRD(gt[1], ga, 16); SC_DSRD(gt[2], ga, 32); SC_DSRD(gt[3], ga, 48); SC_DSRD(gt[4], ga, 64); SC_DSRD(gt[5], ga, 80); SC_DSRD(gt[6], ga, 96); SC_DSRD(gt[7], ga, 112);
#undef SC_DSRD
                  asm volatile("s_waitcnt lgkmcnt(0)" : "+v"(fr[0]), "+v"(fr[1]), "+v"(fr[2]), "+v"(fr[3]), "+v"(fr[4]), "+v"(fr[5]), "+v"(fr[6]), "+v"(fr[7]), "+v"(fr[8]), "+v"(fr[9]), "+v"(fr[10]), "+v"(vf) :: "memory");
                  asm volatile("" : "+v"(gt[0]), "+v"(gt[1]), "+v"(gt[2]), "+v"(gt[3]), "+v"(gt[4]), "+v"(gt[5]), "+v"(gt[6]), "+v"(gt[7])); }
                const sc_bf16x8 sb00 = sc_pack8(S0, 0), sb01 = sc_pack8(S0, 8), sb10 = sc_pack8(S1, 0), sb11 = sc_pack8(S1, 8);
                sc_f32x16 P = {}, P2 = {};
                P = __builtin_amdgcn_mfma_f32_32x32x16_bf16(fr[0], sb00, P, 0, 0, 0);
                P2 = __builtin_amdgcn_mfma_f32_32x32x16_bf16(fr[2], sb10, P2, 0, 0, 0);
                P = __builtin_amdgcn_mfma_f32_32x32x16_bf16(fr[1], sb01, P, 0, 0, 0);
                P2 = __builtin_amdgcn_mfma_f32_32x32x16_bf16(fr[3], sb11, P2, 0, 0, 0);
                P = __builtin_amdgcn_mfma_f32_32x32x16_bf16(fr[4], vf, P, 0, 0, 0);
#pragma unroll
                for (int q = 0; q < 4; ++q)
#pragma unroll
                    for (int e = 0; e < 4; ++e) { S0[4 * q + e] *= gt[q][e]; S1[4 * q + e] *= gt[4 + q][e]; }
                S0 = __builtin_amdgcn_mfma_f32_32x32x16_bf16(fr[8], vf, S0, 0, 0, 0);
                S1 = __builtin_amdgcn_mfma_f32_32x32x16_bf16(fr[10], vf, S1, 0, 0, 0);
#pragma unroll
                for (int r = 0; r < 16; ++r) P[r] += P2[r];
                const sc_bf16x8 xb = sc_pack8(P, 0);
                sc_f32x16 U = {};
                U = __builtin_amdgcn_mfma_f32_32x32x16_bf16(fr[5], xb, U, 0, 0, 0);
                const sc_bf16x8 ub = sc_pack8(U, 0);
                S0 = __builtin_amdgcn_mfma_f32_32x32x16_bf16(fr[7], ub, S0, 0, 0, 0);
                S1 = __builtin_amdgcn_mfma_f32_32x32x16_bf16(fr[9], ub, S1, 0, 0, 0);
                P = __builtin_amdgcn_mfma_f32_32x32x16_bf16(fr[6], ub, P, 0, 0, 0);
                float* yb = Yd + (size_t)sc_tau(d, c, 0) * A_W;
#pragma unroll
                for (int r = 0; r < 8; ++r) yb[yoff[r]] = P[8 + r];
        }
        if (steady) asm volatile("s_waitcnt vmcnt(12)" ::: "memory"); else asm volatile("s_waitcnt vmcnt(0)" ::: "memory");
        asm volatile("s_waitcnt lgkmcnt(0)" ::: "memory"); __builtin_amdgcn_s_barrier(); asm volatile("" ::: "memory");
    }
    asm volatile("s_waitcnt vmcnt(0)" ::: "memory"); __syncthreads();
#undef SCM_DMA
}
__device__ __forceinline__ float conv3_u(const float* PX, int tau, unsigned ucol, float w0, float w1, float w2) {
    const float* p = PX + (size_t)tau * PXW;
    float y = p[ucol] * w1;
    if (has_left(tau)) y += (p - PXW)[ucol] * w0;
    if (has_right(tau)) y += (p + PXW)[ucol] * w2;
    return y;
}
constexpr int WLR_K = 448;
constexpr int RP_WAVE_LDS = 16896;
typedef short rp_bf16x8 __attribute__((ext_vector_type(8)));
typedef float rp_f32x16 __attribute__((ext_vector_type(16)));
__device__ __forceinline__ unsigned short f2bf16(float x) { return (unsigned short)(cvt_pk_bf16(x, x) & 0xffffu); }
template <int NKB, class AF>
__device__ __forceinline__ void rp_lowrank(float (&dst)[16], const AF& afrag, const bf16_t* WLRh, int kw0, int n, int hi) {
    rp_f32x16 c0 = {}, c1 = {}; const bf16_t* wb0 = WLRh + (size_t)n * WLR_K + kw0 + 8 * hi; const bf16_t* wb1 = wb0 + (size_t)32 * WLR_K;
#pragma unroll
    for (int kb = 0; kb < NKB; ++kb) { const rp_bf16x8 b0 = *(const rp_bf16x8*)(wb0 + 16 * kb), b1 = *(const rp_bf16x8*)(wb1 + 16 * kb); const rp_bf16x8 a_ = afrag(kb);
        c0 = __builtin_amdgcn_mfma_f32_32x32x16_bf16(a_, b0, c0, 0, 0, 0); c1 = __builtin_amdgcn_mfma_f32_32x32x16_bf16(a_, b1, c1, 0, 0, 0); }
#pragma unroll
    for (int r = 0; r < 8; ++r) { auto sw = __builtin_amdgcn_permlane32_swap(__float_as_uint(c0[r]), __float_as_uint(c1[r]), false, false);
        dst[(r & 3) + 8 * (r >> 2)] = __uint_as_float(sw[0]); dst[(r & 3) + 8 * (r >> 2) + 4] = __uint_as_float(sw[1]); }
}
struct RpAfLds { const LAS bf16_t* base; __device__ __forceinline__ rp_bf16x8 operator()(int kb) const { return *(const LAS rp_bf16x8*)(base + 16 * kb); } };
__device__ __forceinline__ void rwkv_elem_phase(const Frame& F, unsigned char* ws, int l) {
    const float* PX = (const float*)(ws + WS_PX); float* SS = (float*)(ws + WS_SS); float* SD = (float*)(ws + WS_SD); float* GB = (float*)(ws + WS_G);
    const bf16_t* WLR = (const bf16_t*)(ws + WS_WLR) + (size_t)l * A_W * WLR_K;
    const float* cw = IN_(16) + (size_t)l * 3 * A_IN;
    LAS bf16_t* ACT = (LAS bf16_t*)(F.lds + F.wave * 10752);
    const int lane = F.lane, n = lane & 31, hi = lane >> 5;
    const int gw = F.bid * 8 + F.wave, NGW = F.G * 8;
    for (int it = gw; it < (T / 16) * 10; it += NGW) {
        const int tg = it / 10, hq = it % 10, tau0 = tg * 16;
        asm volatile("s_waitcnt lgkmcnt(0)" ::: "memory");
        const float* prow0 = PX + (size_t)(tau0 > 0 ? tau0 - 1 : 0) * PXW; const int roff = tau0 > 0 ? 0 : -1;
#define RP_WIN(x, ucol_) do { _Pragma("unroll") for (int i_ = 0; i_ < 18; ++i_) { int ri_ = i_ + roff; ri_ = ri_ < 0 ? 0 : ri_; ri_ = (tau0 - 1 + i_ > T - 1) ? (T - 1 - (tau0 > 0 ? tau0 - 1 : 0)) : ri_; x[i_] = (prow0 + (size_t)ri_ * PXW)[ucol_]; } } while (0)
#define RP_CONV(x, t_, w0_, w1_, w2_) (x[(t_)] * (has_left(tau0 + (t_)) ? (w0_) : 0.f) + x[(t_) + 1] * (w1_) + x[(t_) + 2] * (has_right(tau0 + (t_)) ? (w2_) : 0.f))
#pragma unroll
        for (int i = 0; i < 5; ++i) { const int c = lane + 64 * i, col = 3840 + c; const float c0 = cw[col], c1 = cw[A_IN + col], c2 = cw[2 * A_IN + col];
            float x[18]; RP_WIN(x, (unsigned)(PXA + col));
#pragma unroll
            for (int t = 0; t < 16; ++t) { const float val = RP_CONV(x, t, c0, c1, c2);
                const float act = i == 0 ? 1.0f - 2.0f / (1.0f + __expf(2.0f * val)) : (i == 1 ? val : sigmoidf_(val));
                ACT[t * 328 + c] = f2bf16(act); } }
        asm volatile("s_waitcnt lgkmcnt(0)" ::: "memory");
        const RpAfLds afw{ACT + (n & 15) * 328 + 8 * hi}, afa{ACT + (n & 15) * 328 + 64 + 8 * hi}, afg{ACT + (n & 15) * 328 + 128 + 8 * hi};
#pragma unroll 1
        for (int hh = 0; hh < 2; ++hh) {
            const int h = hq * 2 + hh, col = h * 64 + lane; const bf16_t* WLRh = WLR + (size_t)h * 64 * WLR_K;
            { float lg[16]; rp_lowrank<12>(lg, afg, WLRh, 256, n, hi);
#pragma unroll
              for (int t = 0; t < 16; ++t) GB[(size_t)(tau0 + t) * A_W + col] = lg[t]; }
            const float cr0 = cw[col], cr1 = cw[A_IN + col], cr2 = cw[2 * A_IN + col];
            const float ck0 = cw[A_W + col], ck1 = cw[A_IN + A_W + col], ck2 = cw[2 * A_IN + A_W + col];
            const float cv0 = cw[2 * A_W + col], cv1 = cw[A_IN + 2 * A_W + col], cv2 = cw[2 * A_IN + 2 * A_W + col];
            const float kk_w = IN_(22)[l * A_W + col], ka_w = IN_(23)[l * A_W + col];
            float kkv[16], kv[16];
            { float xr[18], xk[18], xv[18]; const unsigned uc = (unsigned)(PXA + col); RP_WIN(xr, uc); RP_WIN(xk, uc + A_W); RP_WIN(xv, uc + 2 * A_W);
#pragma unroll
              for (int t = 0; t < 16; ++t) { const int tau = tau0 + t;
                  const float r = RP_CONV(xr, t, cr0, cr1, cr2), v = RP_CONV(xv, t, cv0, cv1, cv2); kv[t] = RP_CONV(xk, t, ck0, ck1, ck2);
                  const float kr = kv[t] * kk_w; const float nrm = sqrtf(wave_sum(kr * kr)); kkv[t] = kr / fmaxf(nrm, 1e-12f);
                  float* ss = SS + ((size_t)h * T + tau) * 192 + lane; ss[0] = kkv[t]; ss[64] = r; ss[128] = v; } }
#pragma unroll 1
            for (int d = 0; d < 2; ++d) { const float w0b = IN_(17)[(l * 2 + d) * A_W + col], a0b = IN_(19)[(l * 2 + d) * A_W + col]; float lw[16], la[16];
                rp_lowrank<4>(lw, afw, WLRh, 64 * d, n, hi); rp_lowrank<4>(la, afa, WLRh, 128 + 64 * d, n, hi);
#pragma unroll
                for (int t = 0; t < 16; ++t) { const float z = w0b + lw[t]; const float decay = __expf(-__expf(-(fmaxf(-z, 0.f) + __logf(1.0f + __expf(-fabsf(z)))) - 0.5f)); const float av = sigmoidf_(a0b + la[t]);
                    float* sd = SD + (((size_t)h * 2 + d) * T + tau0 + t) * 192 + lane; sd[0] = decay; sd[64] = kkv[t] * av; sd[128] = kv[t] * (1.0f + (av - 1.0f) * ka_w); } }
        }
    }
}
#undef RP_WIN
#undef RP_CONV
constexpr int SP_WAVE_LDS = 16640;
__device__ __forceinline__ void scan_prep_phase(const Frame& F, unsigned char* ws) {
    const float* SS = (const float*)(ws + WS_SS); const float* SD = (const float*)(ws + WS_SD); unsigned char* FR = ws + WS_FR;
    LAS bf16_t* R1 = (LAS bf16_t*)(F.lds + F.wave * SP_WAVE_LDS); LAS bf16_t* R2 = R1 + 32 * 72; LAS bf16_t* BbT = R2 + 32 * 72; LAS bf16_t* KbT = BbT + 64 * 16; LAS bf16_t* VT = KbT + 64 * 16; LAS float* Lm = (LAS float*)(VT + 64 * 16);
    const int lane = F.lane, n = lane & 31, hi = lane >> 5;
    const int gw = F.bid * 8 + F.wave, NGW = F.G * 8;
    for (int it = gw; it < 2 * NHA * SC_NCHUNK; it += NGW) {
        const int chain = it / SC_NCHUNK, c = it % SC_NCHUNK, h = chain >> 1, d = chain & 1;
        const int tau_first = sc_tau(d, c, 0), dstep = d ? -1 : 1;
        const float* ssb = SS + (size_t)h * T * 192 + lane; const float* sdb = SD + ((size_t)h * 2 + d) * T * 192 + lane;
        float xw[16], xb[16], xk[16], xkk[16], xr[16], xv[16];
#pragma unroll
        for (int s = 0; s < 16; ++s) { const size_t o = (size_t)(tau_first + dstep * s) * 192; xw[s] = sdb[o]; xb[s] = sdb[o + 64]; xk[s] = sdb[o + 128]; xkk[s] = ssb[o]; xr[s] = ssb[o + 64]; xv[s] = ssb[o + 128]; }
        float gC = 1.f;
#pragma unroll
        for (int s = 0; s < 16; ++s) gC *= xw[s];
        float g = 1.f;
#pragma unroll
        for (int s = 0; s < 16; ++s) {
            const float gm1 = g; g *= xw[s]; const float ig = 1.0f / g; const float bh = xb[s] * ig, kh = xk[s] * ig;
            R1[s * 72 + lane] = f2bf16(-xkk[s] * gm1); R1[(16 + s) * 72 + lane] = f2bf16(xr[s] * g);
            R2[s * 72 + lane] = f2bf16(bh); R2[(16 + s) * 72 + lane] = f2bf16(kh);
            BbT[lane * 16 + s] = f2bf16(bh * gC); KbT[lane * 16 + s] = f2bf16(kh * gC); VT[lane * 16 + s] = f2bf16(xv[s]); }
        asm volatile("s_waitcnt lgkmcnt(0)" ::: "memory");
        unsigned char* dst = FR + ((size_t)chain * SC_NCHUNK + c) * SC_CHUNK_BYTES;
        rp_f32x16 C = {};
#pragma unroll
        for (int kb = 0; kb < 4; ++kb) { const rp_bf16x8 a_ = *(const LAS rp_bf16x8*)(R2 + n * 72 + 16 * kb + 8 * hi), b_ = *(const LAS rp_bf16x8*)(R1 + n * 72 + 16 * kb + 8 * hi);
            C = __builtin_amdgcn_mfma_f32_32x32x16_bf16(a_, b_, C, 0, 0, 0); }
        const int tt_ = n & 15; const bool incl = n >= 16;
#pragma unroll
        for (int r = 0; r < 16; ++r) { const int s = ((r & 7) & 3) + 8 * ((r & 7) >> 2) + 4 * hi; if (!(s < tt_ || (incl && s == tt_))) C[r] = 0.f; }
        if (n < 16) {
#pragma unroll
            for (int r = 0; r < 8; ++r) Lm[((r & 3) + 8 * (r >> 2) + 4 * hi) * 20 + n] = C[r]; }
        { u32x4 f4; f4.x = cvt_pk_bf16(C[8], C[9]); f4.y = cvt_pk_bf16(C[10], C[11]); f4.z = cvt_pk_bf16(C[12], C[13]); f4.w = cvt_pk_bf16(C[14], C[15]);
          u32x4 f6; f6.x = cvt_pk_bf16(C[0], C[1]); f6.y = cvt_pk_bf16(C[2], C[3]); f6.z = cvt_pk_bf16(C[4], C[5]); f6.w = cvt_pk_bf16(C[6], C[7]);
          if (n < 16) f6 = (u32x4){0u, 0u, 0u, 0u};
          *(u32x4*)(dst + 4 * 1024 + lane * 16) = f4; *(u32x4*)(dst + 6 * 1024 + lane * 16) = f6; }
        asm volatile("s_waitcnt lgkmcnt(0)" ::: "memory");
        { float Tc[16];
#pragma unroll
          for (int s = 15; s >= 0; --s) { float acc = (s == n) ? 1.f : 0.f;
#pragma unroll
              for (int u = s + 1; u < 16; ++u) acc += Lm[s * 20 + u] * Tc[u];
              Tc[s] = acc; }
          u32x4 f5; f5.x = cvt_pk_bf16(hi ? Tc[4] : Tc[0], hi ? Tc[5] : Tc[1]); f5.y = cvt_pk_bf16(hi ? Tc[6] : Tc[2], hi ? Tc[7] : Tc[3]);
          f5.z = cvt_pk_bf16(hi ? Tc[12] : Tc[8], hi ? Tc[13] : Tc[9]); f5.w = cvt_pk_bf16(hi ? Tc[14] : Tc[10], hi ? Tc[15] : Tc[11]);
          if (n >= 16) f5 = (u32x4){0u, 0u, 0u, 0u};
          *(u32x4*)(dst + 5 * 1024 + lane * 16) = f5; }
#pragma unroll
        for (int f = 0; f < 4; ++f) { const u32x2 p0 = *(const LAS u32x2*)(R1 + n * 72 + 16 * f + 4 * hi), p1 = *(const LAS u32x2*)(R1 + n * 72 + 16 * f + 8 + 4 * hi);
            *(u32x4*)(dst + f * 1024 + lane * 16) = (u32x4){p0.x, p0.y, p1.x, p1.y}; }
#pragma unroll
        for (int jb = 0; jb < 2; ++jb) { const int row = 32 * jb + n;
            const u32x2 b0 = *(const LAS u32x2*)(BbT + row * 16 + 4 * hi), b1 = *(const LAS u32x2*)(BbT + row * 16 + 8 + 4 * hi), k0 = *(const LAS u32x2*)(KbT + row * 16 + 4 * hi), k1 = *(const LAS u32x2*)(KbT + row * 16 + 8 + 4 * hi);
            const u32x2 v0 = *(const LAS u32x2*)(VT + row * 16 + 4 * hi), v1 = *(const LAS u32x2*)(VT + row * 16 + 8 + 4 * hi);
            *(u32x4*)(dst + (7 + 2 * jb) * 1024 + lane * 16) = (u32x4){b0.x, b0.y, b1.x, b1.y}; *(u32x4*)(dst + (8 + 2 * jb) * 1024 + lane * 16) = (u32x4){k0.x, k0.y, k1.x, k1.y};
            *(u32x4*)(dst + (11 + jb) * 1024 + lane * 16) = (u32x4){v0.x, v0.y, v1.x, v1.y}; }
        { const int jj = lane & 31; ((float*)(dst + 13 * 1024))[((jj >> 2) & 1) * 32 + (lane >> 5) * 16 + (jj & 3) + 4 * (jj >> 3)] = gC; }
        asm volatile("s_waitcnt lgkmcnt(0)" ::: "memory");
    }
}
__device__ __forceinline__ void mixer_phase(const Frame& F0, unsigned char* ws0, int lq, bool need_ctx, char* lds_g) {
    const int l = lq & 3;
#ifndef MK_MIX
#define MK_MIX 15
#endif
    { const Frame F = opq(F0); unsigned char* ws = opq_ptr(ws0);
      if (MK_MIX & 1) for (int chain = F.bid; chain < 2 * NHA; chain += F.G) scan_chain_mfma(F, ws, chain); }
    const Frame& F = F0;
    const int n_xa = 32 * NHC, n_ca = need_ctx ? NHC : 0, n_att = n_xa + n_ca, n_hy = 640, n_ch = need_ctx ? 160 : 0;
    unsigned* qatt = (unsigned*)(ws0 + WS_CTL) + CW_QUEUE + 64 * lq; unsigned* qhy = qatt + 32;
    int item;
#define MIX_POP(q) do { if (F.tid == 0) F.MISC[16] = __hip_atomic_fetch_add((q), 1u, __ATOMIC_RELAXED, __HIP_MEMORY_SCOPE_AGENT); __syncthreads(); item = (int)F.MISC[16]; __syncthreads(); } while (0)
    if (F.bid >= 2 * NHA) {
        MIX_POP(qatt);
        while (item < n_att) {
            if (MK_MIX & 2) { unsigned char* ws = opq_ptr(ws0);
                const bf16_t* QF = (const bf16_t*)(ws + WS_QF); const bf16_t* KF = (const bf16_t*)(ws + WS_KF); const bf16_t* KVRAW = (const bf16_t*)(ws + WS_KVRAW); bf16_t* OB = (bf16_t*)(ws + WS_OBUF);
                const bool is_xa = item < n_xa; const int h = is_xa ? item % NHC : item - n_xa, row0 = is_xa ? NCTX + (item / NHC) * 256 : 0;
                for (int rp = 0; rp < REP(13); ++rp) att::attn_body(QF + (size_t)row0 * NQ + h * 192, KF + h * 192, KVRAW + h * 256 + 128, OB + (size_t)row0 * DM + 2560 + h * 128, is_xa ? T : NCTX, lds_g); }
            MIX_POP(qatt);
        }
    }
    MIX_POP(qhy);
    while (item < n_hy + n_ch) {
        const Frame Fu = opq(F0); unsigned char* ws = opq_ptr(ws0);
        if ((MK_MIX & 4) && item < n_hy) hyena_unit(Fu, ws, l, item);
        else if ((MK_MIX & 8) && item >= n_hy) hyena_ctx_unit(Fu, ws, l, item - n_hy);
        MIX_POP(qhy);
    }
#undef MIX_POP
}

constexpr int NPH = 2 + 14 * NL;
__global__ void __launch_bounds__(512, 2) mk_fwd(Args a) {
    extern __shared__ __attribute__((aligned(16))) unsigned char lds[];
    Frame F; F.lds = (LAS unsigned char*)lds; F.MISC = (volatile LAS unsigned*)(F.lds + LDS_MISC);
    F.tid = threadIdx.x; F.lane = F.tid & 63; F.wave = __builtin_amdgcn_readfirstlane(F.tid >> 6); F.bid = blockIdx.x; F.G = gridDim.x;
    if (F.tid < 64) F.MISC[F.tid] = 0u;
    if (F.tid < 46) *(LAS unsigned long long*)(F.lds + LDS_PTAB + 8 * F.tid) = (unsigned long long)(uintptr_t)a.in[F.tid];
    __syncthreads();
    unsigned char* ws = a.ws;
    XcdBarrier bar = xcd_barrier_post((unsigned*)(ws + WS_CTL) + CW_BAR, F.MISC + 8);
    const int lo = a.ph_lo, hi = a.ph_hi;
#ifndef MK_MASK
#define MK_MASK 0xffff
#endif
#define EN(x) (((MK_MASK) >> (x)) & 1)
#define IN(k) (lo <= (k) && (k) < hi)
#define SEAM(k) do { if (IN(k) && IN((k) + 1)) xcd_barrier(bar); } while (0)
#define WSP opq_ptr(ws)
#define P_XS(w) ((float*)((w) + WS_XS))
#define P_ABUF(w) ((bf16_t*)((w) + WS_ABUF))
#define P_HBUF(w) ((bf16_t*)((w) + WS_HBUF))
#define P_OBUF(w) ((bf16_t*)((w) + WS_OBUF))
#define P_MODX(w, l) ((const float*)((w) + WS_MOD) + ((size_t)(l) * 2 + 0) * NMOD)
#define P_MODC(w, l) ((const float*)((w) + WS_MOD) + ((size_t)(l) * 2 + 1) * NMOD)
#define P_WL(w, l) ((const bf16_t*)((w) + WS_WB) + (size_t)(l) * W_LAYER)
    if (EN(0) && IN(0)) for (int rp = 0; rp < REP(0); ++rp) phase0(opq(F), opq_ptr(ws));
    SEAM(0);
    if (EN(1) && IN(1)) phase_mod(opq(F), opq_ptr(ws));
    SEAM(1);
#pragma clang loop unroll(full)
    for (int l = 0; l < NL; ++l) {
        const int pb = 2 + 14 * l; const bool need_ctx = l < NL - 1;
        if (EN(2) && IN(pb + 0)) for (int rp = 0; rp < REP(2); ++rp) { unsigned char* w = WSP; norm_phase(opq(F), P_XS(w), IN_(7) + l * DM, P_MODX(w, l), P_MODC(w, l), 0, 1, P_ABUF(w), l > 0 ? (const float*)(w + WS_SLAB) : nullptr, l > 0 ? P_MODC(w, l - 1) + 8 * DM : nullptr, 0.5f); }
        SEAM(pb + 0);
        if (EN(3) && IN(pb + 1)) { unsigned char* w = WSP; pg8::Gemm g{P_ABUF(w), P_WL(w, l) + W_G1, T, 2 * FF, DM, DM}; pg8::StaticOrder S; S.init(T, 2 * FF, F.G, F.bid); pg8::EpiSwiGLU E{P_HBUF(w), FF};
            pg8::gemm_phase<pg8::EpiSwiGLU, pg8::StaticOrder>(F.lds, g, S, E, nullptr); }
        SEAM(pb + 1);
        if (EN(4) && IN(pb + 2)) {
            { unsigned char* w = WSP; pg8::Gemm g{P_HBUF(w), P_WL(w, l) + W_D1, T, DM, FF, FF}; pg8::StaticOrderX S; S.init(T, DM, F.G, F.bid); pg8::EpiResid E{P_XS(w), P_MODX(w, l) + 2 * DM, P_MODC(w, l) + 2 * DM, 0.5f, nullptr};
              pg8::gemm_phase<pg8::EpiResid, pg8::StaticOrderX>(F.lds, g, S, E, nullptr); }
            if (true) { __syncthreads();
              if (F.bid < 256) { unsigned char* w = WSP; const int ks = F.bid >> 4, ksz = FF / 16; pg8::Gemm g{P_HBUF(w) + ks * ksz, P_WL(w, l) + W_D1 + ks * ksz, NCTX, DM, ksz, FF}; pg8::OneUnit S{F.bid & 15};
                  pg8::EpiF32 E{(float*)(w + WS_SLAB) + (size_t)ks * NCTX * DM, DM, nullptr};
                  pg8::gemm_phase<pg8::EpiF32, pg8::OneUnit>(F.lds, g, S, E, nullptr); } }
        }
        SEAM(pb + 2);
        if (EN(5) && IN(pb + 3)) for (int rp = 0; rp < REP(2); ++rp) { unsigned char* w = WSP; norm_phase(opq(F), P_XS(w), IN_(8) + l * DM, P_MODX(w, l), P_MODC(w, l), 3, 4, P_ABUF(w), (const float*)(w + WS_SLAB), P_MODC(w, l) + 2 * DM, 0.5f); }
        SEAM(pb + 3);
        if (EN(6) && IN(pb + 4)) { unsigned char* w = WSP; pg8::Gemm g{P_ABUF(w), P_WL(w, l) + W_IN, T, PXW, DM, DM}; pg8::StaticOrder S; S.init(T, PXW, F.G, F.bid); pg8::EpiF32 E{(float*)(w + WS_PX), PXW, nullptr};
            pg8::gemm_phase<pg8::EpiF32, pg8::StaticOrder>(F.lds, g, S, E, nullptr); }
        SEAM(pb + 4);
        if (EN(7) && IN(pb + 5)) { for (int rp = 0; rp < REP(7); ++rp) rwkv_elem_phase(opq(F), opq_ptr(ws), l); if (!(MK_ONLYRP)) { for (int rp = 0; rp < REP(8); ++rp) mla_prep_phase(opq(F), opq_ptr(ws), l); hyena_prep_phase(opq(F), opq_ptr(ws), l); } }
        SEAM(pb + 5);
        if (EN(8) && IN(pb + 6)) {
            { unsigned char* w = WSP; pg8::Gemm g{(const bf16_t*)(w + WS_QA), P_WL(w, l) + W_Q, T, NQ, 1024, 1024}; pg8::StaticOrder S; S.init(T, NQ, F.G, F.bid); pg8::EpiBf16<0> E{(bf16_t*)(w + WS_QRAW), NQ, nullptr, 0, 0};
              pg8::gemm_phase<pg8::EpiBf16<0>, pg8::StaticOrder>(F.lds, g, S, E, nullptr); }
            __syncthreads();
            { unsigned char* w = WSP; pg8::Gemm g{(const bf16_t*)(w + WS_KVA), P_WL(w, l) + W_KV, T, NKV, 512, 512}; pg8::StaticOrder S; S.init(T, NKV, F.G, F.bid); pg8::EpiBf16<0> E{(bf16_t*)(w + WS_KVRAW), NKV, nullptr, 0, 0};
              pg8::gemm_phase<pg8::EpiBf16<0>, pg8::StaticOrder>(F.lds, g, S, E, nullptr); }
        }
        SEAM(pb + 6);
        if (EN(9) && IN(pb + 7)) { for (int rp = 0; rp < REP(8); ++rp) qkv_final_phase(opq(F), opq_ptr(ws), l, need_ctx); for (int rp = 0; rp < REP(9); ++rp) scan_prep_phase(opq(F), opq_ptr(ws)); }
        SEAM(pb + 7);
        if (EN(10) && IN(pb + 8)) for (int rp = 0; rp < REP(10); ++rp) mixer_phase(F, ws, l + 4 * rp, need_ctx, (char*)lds);
        SEAM(pb + 8);
        if (EN(11) && IN(pb + 9)) { for (int rp = 0; rp < REP(8); ++rp) rwkv_out_phase(opq(F), opq_ptr(ws), l, need_ctx); hyena_out_phase(opq(F), opq_ptr(ws), need_ctx); }
        SEAM(pb + 9);
        if (EN(12) && IN(pb + 10)) {
            { unsigned char* w = WSP; pg8::Gemm g{P_OBUF(w), P_WL(w, l) + W_OUT, T, DM, DM, DM}; pg8::StaticOrderX S; S.init(T, DM, F.G, F.bid); pg8::EpiResid E{P_XS(w), P_MODX(w, l) + 5 * DM, P_MODC(w, l) + 5 * DM, 1.0f, nullptr};
              pg8::gemm_phase<pg8::EpiResid, pg8::StaticOrderX>(F.lds, g, S, E, nullptr); }
            if (need_ctx) { __syncthreads();
              if (F.bid < 256) { unsigned char* w = WSP; const int ks = F.bid >> 4, ksz = DM / 16; pg8::Gemm g{P_OBUF(w) + ks * ksz, P_WL(w, l) + W_OUT + ks * ksz, NCTX, DM, ksz, DM}; pg8::OneUnit S{F.bid & 15};
                  pg8::EpiF32 E{(float*)(w + WS_SLAB) + (size_t)ks * NCTX * DM, DM, nullptr};
                  pg8::gemm_phase<pg8::EpiF32, pg8::OneUnit>(F.lds, g, S, E, nullptr); } }
        }
        SEAM(pb + 10);
        if (EN(13) && IN(pb + 11)) for (int rp = 0; rp < REP(2); ++rp) { unsigned char* w = WSP; norm_phase(opq(F), P_XS(w), IN_(9) + l * DM, P_MODX(w, l), P_MODC(w, l), 6, 7, P_ABUF(w), need_ctx ? (const float*)(w + WS_SLAB) : nullptr, P_MODC(w, l) + 5 * DM, 1.0f); }
        SEAM(pb + 11);
        if (EN(14) && IN(pb + 12)) { if (need_ctx) { unsigned char* w = WSP; pg8::Gemm g{P_ABUF(w), P_WL(w, l) + W_G2, T, 2 * FF, DM, DM}; pg8::StaticOrder S; S.init(T, 2 * FF, F.G, F.bid); pg8::EpiSwiGLU E{P_HBUF(w), FF};
            pg8::gemm_phase<pg8::EpiSwiGLU, pg8::StaticOrder>(F.lds, g, S, E, nullptr); } else { unsigned char* w = WSP; pg8::Gemm g{P_ABUF(w), P_WL(w, l) + W_G2, T, 2 * FF, DM, DM}; pg8::StaticOrderX S; S.init(T, 2 * FF, F.G, F.bid); pg8::EpiSwiGLU E{P_HBUF(w), FF};
            pg8::gemm_phase<pg8::EpiSwiGLU, pg8::StaticOrderX>(F.lds, g, S, E, nullptr); } }
        SEAM(pb + 12);
        if (EN(15) && IN(pb + 13)) {
            { unsigned char* w = WSP; pg8::Gemm g{P_HBUF(w), P_WL(w, l) + W_D2, T, DM, FF, FF}; pg8::StaticOrderX S; S.init(T, DM, F.G, F.bid); pg8::EpiResid E{P_XS(w), P_MODX(w, l) + 8 * DM, P_MODC(w, l) + 8 * DM, 0.5f, l == NL - 1 ? a.out : nullptr};
              pg8::gemm_phase<pg8::EpiResid, pg8::StaticOrderX>(F.lds, g, S, E, nullptr); }
            if (need_ctx) { __syncthreads();
              if (F.bid < 256) { unsigned char* w = WSP; const int ks = F.bid >> 4, ksz = FF / 16; pg8::Gemm g{P_HBUF(w) + ks * ksz, P_WL(w, l) + W_D2 + ks * ksz, NCTX, DM, ksz, FF}; pg8::OneUnit S{F.bid & 15};
                  pg8::EpiF32 E{(float*)(w + WS_SLAB) + (size_t)ks * NCTX * DM, DM, nullptr};
                  pg8::gemm_phase<pg8::EpiF32, pg8::OneUnit>(F.lds, g, S, E, nullptr); } }
        }
        SEAM(pb + 13);
    }
#undef IN
#undef SEAM
}

#ifndef MK_LAUNCHES
#define MK_LAUNCHES 1
#endif
extern "C" void kernel_launch(void* const* d_in, const int* in_sizes, int n_in, void* d_out, int out_size, void* d_ws, size_t ws_size, hipStream_t stream) {
    static int grid = 0;
    if (grid == 0) {
        if (n_in != 46 || in_sizes[0] != SEQ * DM || out_size != SEQ * DM || ws_size < WS_END) {
            fprintf(stderr, "kernel_launch: shape mismatch: n_in %d in0 %d out %d ws %zu (need %zu); nothing launched\n", n_in, n_in > 0 ? in_sizes[0] : -1, out_size, ws_size, (size_t)WS_END); grid = -1; return; }
        int dev = 0, cus = 0, per_cu = 0;
        if (hipGetDevice(&dev) != hipSuccess || hipDeviceGetAttribute(&cus, hipDeviceAttributeMultiprocessorCount, dev) != hipSuccess) { fprintf(stderr, "kernel_launch: device query failed\n"); grid = -1; return; }
        if (hipFuncSetAttribute((const void*)mk_fwd, hipFuncAttributeMaxDynamicSharedMemorySize, LDS_BYTES) != hipSuccess) { fprintf(stderr, "kernel_launch: hipFuncSetAttribute failed\n"); grid = -1; return; }
        if (hipOccupancyMaxActiveBlocksPerMultiprocessor(&per_cu, (const void*)mk_fwd, 512, LDS_BYTES) != hipSuccess || per_cu < 1) fprintf(stderr, "kernel_launch: note: occupancy query reports %d blocks per CU\n", per_cu);
        (void)hipGetLastError();
        grid = cus;
        if (cus != 256) { fprintf(stderr, "kernel_launch: built for 256 CUs (split-K of the context panel, hyena scratch), found %d; nothing launched\n", cus); grid = -1; return; }
    }
    if (grid < 0) return;
    if (hipMemsetAsync((char*)d_ws + WS_CTL, 0, CTL_BYTES, stream) != hipSuccess) { fprintf(stderr, "kernel_launch: memset failed\n"); return; }
    Args a{};
    for (int i = 0; i < 46; ++i) a.in[i] = (const float*)d_in[i];
    a.out = (float*)d_out; a.ws = (unsigned char*)d_ws;
#if MK_LAUNCHES == 1
    a.ph_lo = 0; a.ph_hi = NPH;
    hipLaunchKernelGGL(mk_fwd, dim3(grid), dim3(512), LDS_BYTES, stream, a);
#else
    for (int p = 0; p < NPH; ++p) { a.ph_lo = p; a.ph_hi = p + 1; hipLaunchKernelGGL(mk_fwd, dim3(grid), dim3(512), LDS_BYTES, stream, a); }
#endif
    const hipError_t le = hipPeekAtLastError();
    if (le != hipSuccess) fprintf(stderr, "kernel_launch: launch failed: %s\n", hipGetErrorName(le));
}
```

```cpp
#include <hip/hip_runtime.h>
#include <stdint.h>
#include <cstdio>

#define LAS __attribute__((address_space(3)))
#define CAS __attribute__((address_space(4)))
typedef unsigned short bf16_t;
typedef float f32x4 __attribute__((ext_vector_type(4)));
typedef float f32x2 __attribute__((ext_vector_type(2)));
typedef unsigned u32x4 __attribute__((ext_vector_type(4)));
typedef unsigned u32x2 __attribute__((ext_vector_type(2)));

constexpr int T = 8448, NCTX = 256, SEQ = 8192, DM = 4096, FF = 6144, NL = 4;
constexpr int A_W = 1280, A_IN = 4160, B_IN = 3840, C_IN = 1600, NHA = 20;
constexpr int PXW = 9728, PXA = 0, PXB = 4160, PXC = 8000;
constexpr int NQ = 2304, NKV = 3072, NHC = 12;
constexpr int NMOD = 9 * DM;
constexpr float NORM_EPS = 1e-6f, GN_EPS = 64e-5f;

constexpr size_t MiB = 1u << 20;
constexpr size_t al(size_t x) { return (x + MiB - 1) / MiB * MiB; }
constexpr size_t WS_CTL = 0, CTL_BYTES = MiB;
constexpr size_t WS_XS = WS_CTL + CTL_BYTES;
constexpr size_t WS_ABUF = WS_XS + al((size_t)T * DM * 4);
constexpr size_t WS_HBUF = WS_ABUF + al((size_t)T * DM * 2);
constexpr size_t WS_OBUF = WS_HBUF + al((size_t)T * FF * 2);
constexpr size_t WS_PX = WS_OBUF + al((size_t)T * DM * 2);
constexpr size_t WS_MOD = WS_PX + al((size_t)T * PXW * 4);
constexpr size_t WS_HP = WS_MOD + al((size_t)NL * 2 * NMOD * 4);
constexpr size_t WS_SS = WS_HP + MiB;
constexpr size_t WS_SD = WS_SS + al((size_t)NHA * T * 192 * 4);
constexpr size_t WS_WLR = WS_SD + al((size_t)NHA * 2 * T * 192 * 4);
constexpr size_t WS_G = WS_WLR + al((size_t)NL * A_W * 448 * 2);
constexpr size_t WS_Y = WS_G + al((size_t)T * A_W * 4);
constexpr size_t WS_QA = WS_Y + al((size_t)2 * T * A_W * 4);
constexpr size_t WS_KVA = WS_QA + al((size_t)T * 1024 * 2);
constexpr size_t WS_KPE = WS_KVA + al((size_t)T * 512 * 2);
constexpr size_t WS_QRAW = WS_KPE + al((size_t)T * 64 * 2);
constexpr size_t WS_KVRAW = WS_QRAW + al((size_t)T * NQ * 2);
constexpr size_t WS_QF = WS_KVRAW + al((size_t)T * NKV * 2);
constexpr size_t WS_KF = WS_QF + al((size_t)T * NQ * 2);
constexpr size_t WS_H3 = WS_KF + al((size_t)T * NQ * 2);
constexpr size_t WS_HSCR = WS_H3 + al((size_t)NL * T * 64 * 4);
constexpr size_t WS_FR = WS_HSCR + al((size_t)640 * 16384 * 8 + 640 * 8);
constexpr size_t WS_GT = WS_FR + al((size_t)40 * 528 * (14 * 1024));
constexpr size_t WS_X0T = WS_GT + al((size_t)1280 * T * 4);
constexpr size_t WS_SLAB = WS_FR;
constexpr size_t WS_WB = WS_X0T + al((size_t)1280 * T * 4);
constexpr size_t W_G1 = 0, W_D1 = W_G1 + (size_t)2 * FF * DM, W_IN = W_D1 + (size_t)DM * FF, W_OUT = W_IN + (size_t)PXW * DM, W_G2 = W_OUT + (size_t)DM * DM,
                 W_D2 = W_G2 + (size_t)2 * FF * DM, W_Q = W_D2 + (size_t)DM * FF, W_KV = W_Q + (size_t)NQ * 1024, W_LAYER = W_KV + (size_t)NKV * 512;
constexpr size_t WS_END = WS_WB + al(W_LAYER * NL * 2);
constexpr int CW_BAR = 4096;
constexpr int CW_QUEUE = 8192;

constexpr int LDS_MISC = 143360, LDS_BYTES = 147456;

__device__ __forceinline__ float wave_sum(float v) {
#pragma unroll
    for (int o = 1; o < 64; o <<= 1) v += __shfl_xor(v, o);
    return v;
}
typedef __bf16 bf16x2_t __attribute__((ext_vector_type(2)));
__device__ __forceinline__ unsigned cvt_pk_bf16(float lo, float hi) { const f32x2 v = {lo, hi}; return __builtin_bit_cast(unsigned, __builtin_convertvector(v, bf16x2_t)); }
__device__ __forceinline__ float bf2f(unsigned short b) { return __uint_as_float(((unsigned)b) << 16); }
__device__ __forceinline__ float sigmoidf_(float x) { return 1.0f / (1.0f + __expf(-x)); }
__device__ __forceinline__ float siluf_(float x) { return x / (1.0f + __expf(-x)); }
__device__ __forceinline__ bool has_left(int tau) { return tau != 0 && tau != NCTX; }
__device__ __forceinline__ bool has_right(int tau) { return tau != NCTX - 1 && tau != T - 1; }

struct Args { const float* in[46]; float* out; unsigned char* ws; int ph_lo, ph_hi; };
struct Frame { LAS unsigned char* lds; volatile LAS unsigned* MISC; int tid, lane, wave, bid, G; };
constexpr int LDS_PTAB = LDS_MISC + 2048;
__device__ __forceinline__ const float* inp(const Frame& F, int i) {
    const volatile LAS unsigned* p = (const volatile LAS unsigned*)(F.lds + LDS_PTAB) + 2 * i;
    const unsigned lo = __builtin_amdgcn_readfirstlane(p[0]), hi = __builtin_amdgcn_readfirstlane(p[1]);
    return (const float*)(((unsigned long long)hi << 32) | lo);
}
#define IN_(i) inp(F, (i))
__device__ __forceinline__ Frame opq(const Frame& F) { Frame G = F; asm volatile("" : "+v"(G.tid), "+s"(G.wave), "+s"(G.bid)); G.lane = G.tid & 63; return G; }
__device__ __forceinline__ unsigned char* opq_ptr(unsigned char* p) { asm volatile("" : "+s"(p)); return p; }
#ifndef MK_REP
#define MK_REP 0
#endif
#ifndef MK_ONLYRP
#define MK_ONLYRP 0
#endif
#define REP(x) (1 + (((MK_REP) >> (x)) & 1))
#define XB_TMO      128
#define XB_XCNT(j)  (256  + 64 * (j))
#define XB_XSUB(j)  (1280 + 64 * (j))
#define XB_XGEN(j)  (2304 + 64 * (j))
#define XB_TOP      3328
#define XB_TOPGEN   3392
#define XCD_BAR_WORDS 3456
#define XB_SPIN_CAP (1u << 18)

__device__ __forceinline__ unsigned xb_ld(unsigned* p)              { return __hip_atomic_load(p, __ATOMIC_RELAXED, __HIP_MEMORY_SCOPE_AGENT); }
__device__ __forceinline__ unsigned xb_add(unsigned* p, unsigned v) { return __hip_atomic_fetch_add(p, v, __ATOMIC_RELAXED, __HIP_MEMORY_SCOPE_AGENT); }
__device__ __forceinline__ unsigned xb_xcc_id() { return (unsigned)__builtin_amdgcn_s_getreg((3 << 11) | 20) & 0xFu; }
#define XB_SPIN(cond, bar) do { unsigned _sp = 0; while (cond) { __builtin_amdgcn_s_sleep(1); \
    if ((++_sp & 255u) == 0u) { if (xb_ld(&(bar)[XB_TMO])) break; if (_sp > XB_SPIN_CAP) { atomicAdd(&(bar)[XB_TMO], 1u); break; } } } } while (0)

struct XcdBarrier {
    unsigned* bar; unsigned x;
    volatile LAS unsigned* st;
};

__device__ __forceinline__ XcdBarrier xcd_barrier_post(unsigned* bar, volatile LAS unsigned* st) {
    XcdBarrier b; b.bar = bar; b.x = xb_xcc_id(); b.st = st;
    if (threadIdx.x == 0) (void)xb_add(&bar[XB_XCNT(b.x)], 1u);
    return b;
}
__device__ __forceinline__ void xcd_barrier_complete(unsigned* bar, unsigned x, unsigned& nloc, unsigned& nx) {
    const unsigned G = gridDim.x * gridDim.y * gridDim.z;
    unsigned sum, cnt, mine, sp = 0u;
    for (;;) {
        sum = 0u; cnt = 0u; mine = 0u;
#pragma unroll
        for (unsigned j = 0; j < 16; ++j) { const unsigned c = xb_ld(&bar[XB_XCNT(j)]); sum += c; cnt += (c > 0u) ? 1u : 0u; mine = (j == x) ? c : mine; }
        if (sum == G) break;
        __builtin_amdgcn_s_sleep(1);
        if ((++sp & 255u) == 0u) { if (xb_ld(&bar[XB_TMO])) break; if (sp > XB_SPIN_CAP) { atomicAdd(&bar[XB_TMO], 1u); break; } }
    }
    nloc = mine > 0u ? mine : 1u; nx = cnt > 0u ? cnt : 1u;
}

__device__ __forceinline__ void xcd_barrier(const XcdBarrier& b) {
    asm volatile("s_waitcnt vmcnt(0)" ::: "memory");
    __syncthreads();
    if (threadIdx.x == 0) {
        unsigned* bar = b.bar;
        __builtin_amdgcn_s_waitcnt(0);
        unsigned nloc = b.st[0], nx = b.st[1];
        if (nloc == 0u) { xcd_barrier_complete(bar, b.x, nloc, nx); b.st[0] = nloc; b.st[1] = nx; }
        const unsigned old = xb_add(&bar[XB_XSUB(b.x)], 1u);
        const unsigned gen = old / nloc;
        if (old + 1u == (gen + 1u) * nloc) {
            __builtin_amdgcn_fence(__ATOMIC_RELEASE, "agent");
            asm volatile("s_waitcnt vmcnt(0)" ::: "memory");
            const unsigned og = xb_add(&bar[XB_TOP], 1u);
            const unsigned tg = og / nx;
            if (og + 1u == (tg + 1u) * nx) xb_add(&bar[XB_TOPGEN], 1u);
            else XB_SPIN(xb_ld(&bar[XB_TOPGEN]) == tg, bar);
            __builtin_amdgcn_fence(__ATOMIC_ACQUIRE, "agent");
            xb_add(&bar[XB_XGEN(b.x)], 1u);
            asm volatile("s_waitcnt vmcnt(0)" ::: "memory");
        } else {
            XB_SPIN(xb_ld(&bar[XB_XGEN(b.x)]) == gen, bar);
            __builtin_amdgcn_fence(__ATOMIC_ACQUIRE, "agent");
            asm volatile("s_waitcnt vmcnt(0)" ::: "memory");
        }
    }
    __syncthreads();
}
namespace pg8 {
#define PG8_LAS __attribute__((address_space(3)))
typedef unsigned short bf16_t;
typedef short bf16x8 __attribute__((ext_vector_type(8)));
typedef float f32x4 __attribute__((ext_vector_type(4)));
typedef unsigned u32x4 __attribute__((ext_vector_type(4)));
constexpr int BM = 256, BK = 64, HALF = 128, HTB = HALF * BK * 2  , STAGE_BYTES = 8 * HTB, NXCD = 8, WGM = 8;

__host__ __device__ __forceinline__ int lds_byte(int r, int c) { const int st = (r >> 4) * 2 + (c >> 5), rr = r & 15, cc = c & 31, ob = rr * 64 + cc * 2; return st * 1024 + (ob ^ (((ob >> 9) & 1) << 5)); }
__host__ __device__ __forceinline__ void stage_rc(int b, int& R, int& C) { const int st = b / 1024, sb = b % 1024, swz = sb ^ (((sb >> 9) & 1) << 5); R = (st >> 1) * 16 + swz / 64; C = (st & 1) * 32 + (swz % 64) / 2; }
__host__ __device__ __forceinline__ int perm32(int rho) { const int n = rho >> 4, i = rho & 15; return 8 * (i >> 2) + 4 * n + (i & 3); }

struct Unit { int pm, pn; };
struct Gemm { const bf16_t* A; const bf16_t* Bt; int M, N, K, ld; };

struct StaticOrder {
    int nM, nN, nwg, G, c;
    __host__ __device__ void init(int M, int N, int G_, int c_) { nM = M / BM; nN = N / BM; nwg = nM * nN; G = G_; c = c_; }
    __host__ __device__ bool next(int i, Unit& u) const {
        const long L = (long)i * G + c; if (L >= nwg) return false;
        int wgid = (int)L; { const int q = nwg / NXCD, r = nwg % NXCD, xcd = wgid % NXCD, off = wgid / NXCD; wgid = (xcd < r ? xcd * (q + 1) : r * (q + 1) + (xcd - r) * q) + off; }
        const int nig = WGM * nN, gid = wgid / nig, fm = gid * WGM, gsz = (nM - fm) < WGM ? (nM - fm) : WGM;
        u.pm = fm + ((wgid % nig) % gsz); u.pn = (wgid % nig) / gsz; return true;
    }
    __device__ __forceinline__ void a_ready(const Unit&) const {}
    __device__ __forceinline__ void done(const Unit&) const {}
};
struct CountedOrder : StaticOrder {
    const unsigned* ready; unsigned need; unsigned* tmo;
    __device__ __forceinline__ void a_ready(const Unit& u) const {
        if (threadIdx.x < 64) {
            const unsigned long long t0 = __builtin_amdgcn_s_memrealtime(); unsigned polls = 0;
            while ((unsigned)__builtin_amdgcn_readfirstlane(__hip_atomic_load(ready + 64 * u.pm, __ATOMIC_RELAXED, __HIP_MEMORY_SCOPE_AGENT)) < need) {
                if ((++polls & 255u) == 0u && __builtin_amdgcn_readfirstlane(__hip_atomic_load(tmo, __ATOMIC_RELAXED, __HIP_MEMORY_SCOPE_AGENT)) != 0u) break;
                if (__builtin_amdgcn_s_memrealtime() - t0 > 2000000ull) {
                    if (threadIdx.x == 0) { unsigned expect = 0u; __hip_atomic_compare_exchange_strong(tmo + 1, &expect, 0x600u | (unsigned)(u.pm & 0xff), __ATOMIC_RELAXED, __ATOMIC_RELAXED, __HIP_MEMORY_SCOPE_AGENT); __hip_atomic_store(tmo, 1u, __ATOMIC_RELAXED, __HIP_MEMORY_SCOPE_AGENT); }
                    break; }
                __builtin_amdgcn_s_sleep(2); }
            __builtin_amdgcn_fence(__ATOMIC_ACQUIRE, "agent");
            asm volatile("s_waitcnt vmcnt(0)" ::: "memory");
        }
#if !defined(BROKEN_HOOK_NO_BARRIER)
        asm volatile("" ::: "memory"); __builtin_amdgcn_s_barrier(); asm volatile("" ::: "memory");
#endif
    }
};

__device__ __forceinline__ unsigned cvt_pk_bf16(float lo, float hi) { unsigned r; asm volatile("v_cvt_pk_bf16_f32 %0, %1, %2" : "=v"(r) : "v"(lo), "v"(hi)); return r; }
typedef float f32x2 __attribute__((ext_vector_type(2)));
__device__ __forceinline__ f32x2 gelu_pk(f32x2 v) {
    const f32x2 av = __builtin_elementwise_abs(v), d = av * 0.2316418882f + 1.0f;
    f32x2 t; t.x = __builtin_amdgcn_rcpf(d.x); t.y = __builtin_amdgcn_rcpf(d.y);
    f32x2 q = t * 0.5307027145f + (-0.7265760135f); q = q * t + 0.7107068705f; q = q * t + (-0.142248368f); q = q * t + 0.127414796f; q = q * t;
    const f32x2 s = (v * v) * (-0.72134752044f);
    f32x2 e; e.x = __builtin_amdgcn_exp2f(s.x); e.y = __builtin_amdgcn_exp2f(s.y);
    const f32x2 m = v * (q * e), r = v - m;
    f32x2 o; o.x = v.x < 0.f ? m.x : r.x; o.y = v.y < 0.f ? m.y : r.y; return o;
}

struct EpiF32 {
    static constexpr bool PERM = false, AFTER_DRAIN = false;
    float* C; int ldc; const float* bias;
    __device__ __forceinline__ void operator()(const f32x4 (&acc)[2][2][4][2], const Unit& u, int wr, int wc, int fr, int fq) const {
        const int row0 = u.pm * BM + wr * 64 + fr, col0 = u.pn * BM + wc * 32 + 4 * fq;
        f32x4 bv[2][2];
#pragma unroll
        for (int bj = 0; bj < 2; ++bj)
#pragma unroll
            for (int n = 0; n < 2; ++n) bv[bj][n] = bias ? *(const f32x4*)(bias + col0 + bj * HALF + n * 16) : (f32x4){0.f, 0.f, 0.f, 0.f};
#pragma unroll
        for (int ai = 0; ai < 2; ++ai)
#pragma unroll
            for (int m = 0; m < 4; ++m) { float* rowp = C + (size_t)(row0 + ai * HALF + m * 16) * ldc + col0;
#pragma unroll
                for (int bj = 0; bj < 2; ++bj)
#pragma unroll
                    for (int n = 0; n < 2; ++n) *(f32x4*)(rowp + bj * HALF + n * 16) = acc[ai][bj][m][n] + bv[bj][n]; }
    }
};
template <int ACT  > struct EpiBf16 {
    static constexpr bool PERM = true, AFTER_DRAIN = false;
    bf16_t* O; int ldc; const float* bias; int split_cols; size_t split_stride;
    __device__ __forceinline__ void operator()(const f32x4 (&acc)[2][2][4][2], const Unit& u, int wr, int wc, int fr, int fq) const {
        const int row0 = u.pm * BM + wr * 64 + fr; int colt = u.pn * BM; bf16_t* base = O;
        if (split_cols) { const int t = colt / split_cols; base += (size_t)t * split_stride; colt -= t * split_cols; }
        const int col0 = colt + wc * 32 + 8 * fq, bcol0 = u.pn * BM + wc * 32 + 8 * fq;
        f32x4 bv[2][2];
#pragma unroll
        for (int bj = 0; bj < 2; ++bj)
#pragma unroll
            for (int n = 0; n < 2; ++n) bv[bj][n] = bias ? *(const f32x4*)(bias + bcol0 + bj * HALF + 4 * n) : (f32x4){0.f, 0.f, 0.f, 0.f};
#pragma unroll
        for (int ai = 0; ai < 2; ++ai)
#pragma unroll
            for (int m = 0; m < 4; ++m) { bf16_t* rowp = base + (size_t)(row0 + ai * HALF + m * 16) * ldc + col0;
#pragma unroll
                for (int bj = 0; bj < 2; ++bj) { f32x4 v0 = acc[ai][bj][m][0] + bv[bj][0], v1 = acc[ai][bj][m][1] + bv[bj][1];
                    if (ACT == 1) { f32x2 a = gelu_pk((f32x2){v0[0], v0[1]}), b = gelu_pk((f32x2){v0[2], v0[3]}), c = gelu_pk((f32x2){v1[0], v1[1]}), d = gelu_pk((f32x2){v1[2], v1[3]});
                        v0 = (f32x4){a.x, a.y, b.x, b.y}; v1 = (f32x4){c.x, c.y, d.x, d.y}; }
                    if (ACT == 2) {
#pragma unroll
                        for (int j = 0; j < 4; ++j) { v0[j] = 0.5f * v0[j] * (1.0f + erff(v0[j] * 0.70710678f)); v1[j] = 0.5f * v1[j] * (1.0f + erff(v1[j] * 0.70710678f)); } }
                    u32x4 w; w.x = cvt_pk_bf16(v0[0], v0[1]); w.y = cvt_pk_bf16(v0[2], v0[3]); w.z = cvt_pk_bf16(v1[0], v1[1]); w.w = cvt_pk_bf16(v1[2], v1[3]);
                    *(u32x4*)(rowp + bj * HALF) = w; } }
    }
};
}
namespace pg8 {
struct EpiSwiGLU {
    static constexpr bool PERM = true, AFTER_DRAIN = false;
    bf16_t* O; int ldc;
    __device__ __forceinline__ void operator()(const f32x4 (&acc)[2][2][4][2], const Unit& u, int wr, int wc, int fr, int fq) const {
        const int row0 = u.pm * BM + wr * 64 + fr, col0 = u.pn * HALF + wc * 32 + 8 * fq;
#pragma unroll
        for (int ai = 0; ai < 2; ++ai)
#pragma unroll
            for (int m = 0; m < 4; ++m) { bf16_t* rowp = O + (size_t)(row0 + ai * HALF + m * 16) * ldc + col0;
                float h[8];
#pragma unroll
                for (int n = 0; n < 2; ++n)
#pragma unroll
                    for (int j = 0; j < 4; ++j) { const float g = acc[ai][0][m][n][j], up = acc[ai][1][m][n][j]; h[n * 4 + j] = g * __builtin_amdgcn_rcpf(1.0f + __builtin_amdgcn_exp2f(-1.4426950408889634f * g)) * up; }
                u32x4 w; w.x = cvt_pk_bf16(h[0], h[1]); w.y = cvt_pk_bf16(h[2], h[3]); w.z = cvt_pk_bf16(h[4], h[5]); w.w = cvt_pk_bf16(h[6], h[7]);
                *(u32x4*)rowp = w; }
    }
};
struct EpiResid {
    static constexpr bool PERM = false, AFTER_DRAIN = false;
    float* X; const float* gate_x; const float* gate_c; float fac; float* out_x;
    __device__ __forceinline__ void operator()(const f32x4 (&acc)[2][2][4][2], const Unit& u, int wr, int wc, int fr, int fq) const {
        const int row0 = u.pm * BM + wr * 64 + fr, col0 = u.pn * BM + wc * 32 + 4 * fq;
        const float* gv = (u.pm == 0) ? gate_c : gate_x;
        float* dst = (u.pm != 0 && out_x) ? out_x - (size_t)256 * 4096 : X;
        f32x4 gg[2][2];
#pragma unroll
        for (int bj = 0; bj < 2; ++bj)
#pragma unroll
            for (int n = 0; n < 2; ++n) gg[bj][n] = *(const f32x4*)(gv + col0 + bj * HALF + n * 16) * fac;
#pragma unroll
        for (int ai = 0; ai < 2; ++ai)
#pragma unroll
            for (int m = 0; m < 4; ++m) { const size_t off = (size_t)(row0 + ai * HALF + m * 16) * 4096 + col0;
#pragma unroll
                for (int bj = 0; bj < 2; ++bj)
#pragma unroll
                    for (int n = 0; n < 2; ++n) { const f32x4 b = *(const f32x4*)(X + off + bj * HALF + n * 16); *(f32x4*)(dst + off + bj * HALF + n * 16) = b + gg[bj][n] * acc[ai][bj][m][n]; } }
    }
};
struct OneUnit { int pn;
    __host__ __device__ bool next(int i, Unit& u) const { u.pm = 0; u.pn = pn; return i == 0; }
    __device__ __forceinline__ void a_ready(const Unit&) const {}
    __device__ __forceinline__ void done(const Unit&) const {}
};
struct StaticOrderX { StaticOrder b;
    __host__ __device__ void init(int M, int N, int G_, int c_) { b.init(M - BM, N, G_, c_); }
    __host__ __device__ bool next(int i, Unit& u) const { const bool ok = b.next(i, u); u.pm += 1; return ok; }
    __device__ __forceinline__ void a_ready(const Unit&) const {}
    __device__ __forceinline__ void done(const Unit&) const {}
};
}
namespace pg8 {
template <class Epi, class Sched, bool STAMP = false>
__device__ __forceinline__ void gemm_phase(PG8_LAS unsigned char* lds, const Gemm g, const Sched& S, const Epi& E, unsigned long long* stamps) {
    int tid_ = threadIdx.x; asm volatile("" : "+v"(tid_));
    const int tid = tid_, wid = __builtin_amdgcn_readfirstlane(tid >> 6), lane = tid & 63, wr = wid >> 2, wc = wid & 3, fr = lane & 15, fq = lane >> 4;
    const int K = g.ld, nt = g.K / BK;
    int ts_lo = 0, ts_hi = 0, nts = 0; const unsigned long long rt_entry = STAMP ? (unsigned long long)wall_clock64() : 0ull;
#define PG8_STAMP() do { if (STAMP && wid == 0 && nts < 64) { const unsigned long long _c = (unsigned long long)clock64(); \
        ts_lo = (lane == nts) ? (int)(unsigned)_c : ts_lo; ts_hi = (lane == nts) ? (int)(unsigned)(_c >> 32) : ts_hi; ++nts; } } while (0)
    PG8_STAMP();
    unsigned voffA[2], voffB[2];
#pragma unroll
    for (int i = 0; i < 2; ++i) { int R, C; stage_rc(tid * 16 + i * 8192, R, C); const int Rb = Epi::PERM ? ((R & ~31) + perm32(R & 31)) : R;
        voffA[i] = (unsigned)(R * K + C) * 2u; voffB[i] = (unsigned)(Rb * K + C) * 2u; }
    const size_t kstep = (size_t)(BK * 2);
    const size_t hstep = (size_t)HALF * K * 2;
    const size_t tstep = 2 * hstep;
    const unsigned ldsw = (unsigned)wid * 1024u;
    const int aoff = lds_byte(wr * 64 + fr, fq * 8), boff = lds_byte(wc * 32 + fr, fq * 8);
#define PG8_SA(b, h) (((b) * 2 + (h)) * HTB)
#define PG8_SB(b, h) ((4 + (b) * 2 + (h)) * HTB)
#define PG8_STAGE(bufoff, gbase, voff) do { _Pragma("unroll") for (int _i = 0; _i < 2; ++_i) \
        __builtin_amdgcn_global_load_lds((const unsigned*)((const char*)(gbase) + (voff)[_i]), (PG8_LAS unsigned*)(lds + (bufoff) + ldsw + _i * 8192), 16, 0, 0); } while (0)
#define PG8_LDA(dst, b, h) do { _Pragma("unroll") for (int m = 0; m < 4; ++m) _Pragma("unroll") for (int k = 0; k < 2; ++k) dst[m][k] = *(const PG8_LAS bf16x8*)(lds + PG8_SA(b, h) + aoff + m * 2048 + k * 1024); } while (0)
#define PG8_LDB(dst, b, h) do { _Pragma("unroll") for (int n = 0; n < 2; ++n) _Pragma("unroll") for (int k = 0; k < 2; ++k) dst[n][k] = *(const PG8_LAS bf16x8*)(lds + PG8_SB(b, h) + boff + n * 2048 + k * 1024); } while (0)
#define PG8_MMA(ai, bj, At, Bt) do { __builtin_amdgcn_s_setprio(1); _Pragma("unroll") for (int m = 0; m < 4; ++m) _Pragma("unroll") for (int n = 0; n < 2; ++n) _Pragma("unroll") for (int k = 0; k < 2; ++k) \
        acc[ai][bj][m][n] = __builtin_amdgcn_mfma_f32_16x16x32_bf16(Bt[n][k], At[m][k], acc[ai][bj][m][n], 0, 0, 0); __builtin_amdgcn_s_setprio(0); } while (0)
#define PG8_WAIT_V(n) asm volatile("s_waitcnt vmcnt(" #n ")" ::: "memory")
#define PG8_WAIT_L(n) asm volatile("s_waitcnt lgkmcnt(" #n ")" ::: "memory")
#define PG8_BAR __builtin_amdgcn_s_barrier()
#define PG8_SCHED __builtin_amdgcn_sched_barrier(0)
    Unit cur, nxt; int ui = 0;
    if (!S.next(0, cur)) return;
    f32x4 acc[2][2][4][2];
#pragma unroll
    for (int a = 0; a < 2; ++a)
#pragma unroll
        for (int b = 0; b < 2; ++b)
#pragma unroll
            for (int m = 0; m < 4; ++m)
#pragma unroll
                for (int n = 0; n < 2; ++n) acc[a][b][m][n] = (f32x4){0.f, 0.f, 0.f, 0.f};
    bf16x8 At[4][2], B0[2][2], B1[2][2];
    const char* cA = (const char*)g.A + (size_t)cur.pm * tstep; const char* cB = (const char*)g.Bt + (size_t)cur.pn * tstep;
    S.a_ready(cur);
    PG8_STAGE(PG8_SB(0, 0), cB, voffB); PG8_STAGE(PG8_SA(0, 0), cA, voffA); PG8_STAGE(PG8_SB(0, 1), cB + hstep, voffB); PG8_STAGE(PG8_SA(0, 1), cA + hstep, voffA);
    if (wr == 1) PG8_BAR;
    PG8_WAIT_V(4); PG8_BAR;
    PG8_STAGE(PG8_SB(1, 0), cB + kstep, voffB); PG8_STAGE(PG8_SA(1, 0), cA + kstep, voffA); PG8_STAGE(PG8_SB(1, 1), cB + hstep + kstep, voffB);
    PG8_WAIT_V(6); PG8_BAR;
    PG8_STAMP();
    for (;;) {
        const bool has_next = S.next(ui + 1, nxt);
        const char* nA = has_next ? (const char*)g.A + (size_t)nxt.pm * tstep : cA; const char* nB = has_next ? (const char*)g.Bt + (size_t)nxt.pn * tstep : cB;
        for (int t = 0; t < nt; t += 2) {
            const bool last = (t == nt - 2);
            const char* a1 = cA + (size_t)(t + 1) * kstep;
            const char* a2 = last ? nA : cA + (size_t)(t + 2) * kstep; const char* b2 = last ? nB : cB + (size_t)(t + 2) * kstep;
            const char* a3 = a2 + kstep; const char* b3 = b2 + kstep;
            if (last && has_next) S.a_ready(nxt);
            PG8_LDB(B0, 0, 0); PG8_SCHED; PG8_LDA(At, 0, 0); PG8_STAGE(PG8_SA(1, 1), a1 + hstep, voffA);
            PG8_WAIT_L(8); PG8_BAR; PG8_WAIT_L(0); PG8_MMA(0, 0, At, B0); PG8_BAR; PG8_SCHED;
            PG8_LDB(B1, 0, 1); PG8_STAGE(PG8_SB(0, 0), b2, voffB);
            PG8_BAR; PG8_WAIT_L(0); PG8_MMA(0, 1, At, B1); PG8_BAR;
            PG8_LDA(At, 0, 1); PG8_STAGE(PG8_SA(0, 0), a2, voffA);
            PG8_BAR; PG8_WAIT_L(0); PG8_MMA(1, 0, At, B0); PG8_BAR; PG8_SCHED;
            PG8_STAGE(PG8_SB(0, 1), b2 + hstep, voffB);
            PG8_WAIT_V(6); PG8_BAR; PG8_MMA(1, 1, At, B1); PG8_BAR;
            PG8_LDB(B0, 1, 0); PG8_SCHED; PG8_LDA(At, 1, 0); PG8_STAGE(PG8_SA(0, 1), a2 + hstep, voffA);
            PG8_WAIT_L(8); PG8_BAR; PG8_WAIT_L(0); PG8_MMA(0, 0, At, B0); PG8_BAR; PG8_SCHED;
            PG8_LDB(B1, 1, 1); PG8_STAGE(PG8_SB(1, 0), b3, voffB);
            PG8_BAR; PG8_WAIT_L(0); PG8_MMA(0, 1, At, B1); PG8_BAR;
            PG8_LDA(At, 1, 1); PG8_STAGE(PG8_SA(1, 0), a3, voffA);
            PG8_BAR; PG8_WAIT_L(0); PG8_MMA(1, 0, At, B0); PG8_BAR; PG8_SCHED;
            PG8_STAGE(PG8_SB(1, 1), b3 + hstep, voffB);
            PG8_WAIT_V(6); PG8_BAR; PG8_MMA(1, 1, At, B1); PG8_BAR;
        }
        PG8_STAMP();
        if constexpr (!Epi::AFTER_DRAIN) { E(acc, cur, wr, wc, fr, fq); S.done(cur); }
        PG8_STAMP();
        if (!has_next) break;
#pragma unroll
        for (int a = 0; a < 2; ++a)
#pragma unroll
            for (int b = 0; b < 2; ++b)
#pragma unroll
                for (int m = 0; m < 4; ++m)
#pragma unroll
                    for (int n = 0; n < 2; ++n) acc[a][b][m][n] = (f32x4){0.f, 0.f, 0.f, 0.f};
        cur = nxt; cA = nA; cB = nB; ++ui;
    }
    PG8_WAIT_V(0);
    if (wr == 0) PG8_BAR;
    PG8_BAR;
    if constexpr (Epi::AFTER_DRAIN) { E.fused(acc, cur, wr, wc, fr, fq, lds, wid, lane); S.done(cur); }
    PG8_STAMP();
    if (STAMP && wid == 0) { stamps[lane] = lane < nts ? (((unsigned long long)(unsigned)ts_hi << 32) | (unsigned)ts_lo) : 0ull;
        if (lane == 62) stamps[62] = rt_entry; if (lane == 63) stamps[63] = (unsigned long long)wall_clock64(); }
#undef PG8_STAMP
#undef PG8_SA
#undef PG8_SB
#undef PG8_STAGE
#undef PG8_LDA
#undef PG8_LDB
#undef PG8_MMA
#undef PG8_WAIT_V
#undef PG8_WAIT_L
#undef PG8_BAR
#undef PG8_SCHED
}
}
#define LDS_WAIT() asm volatile("s_waitcnt lgkmcnt(0)" ::: "memory")

__device__ __forceinline__ int map_row(int n, int mode) {
    if (mode == 1) { const int j = n < FF ? n : n - FF; return (j >> 7) * 256 + (n < FF ? 0 : 128) + (j & 127); }
    return n;
}
__device__ __forceinline__ void transpose_item(const float* __restrict__ W, int K, int N, bf16_t* WT, int mode, LAS float* scr, int item, int lane) {
    const int nblk = N / 32, kb = item / nblk, nb = item % nblk, k0 = 64 * kb, n0 = 32 * nb;
#pragma unroll 8
    for (int i = 0; i < 32; ++i) { const int kk = 2 * i + (lane >> 5); scr[kk * 33 + (lane & 31)] = W[(size_t)(k0 + kk) * N + n0 + (lane & 31)]; }
    LDS_WAIT(); asm volatile("" ::: "memory");
    const int c = lane & 7;
#pragma unroll
    for (int j = 0; j < 4; ++j) { const int n = (lane >> 3) + 8 * j; const LAS float* s = scr + (8 * c) * 33 + n;
        u32x4 o; o.x = cvt_pk_bf16(s[0 * 33], s[1 * 33]); o.y = cvt_pk_bf16(s[2 * 33], s[3 * 33]); o.z = cvt_pk_bf16(s[4 * 33], s[5 * 33]); o.w = cvt_pk_bf16(s[6 * 33], s[7 * 33]);
        *(u32x4*)(WT + (size_t)map_row(n0 + n, mode) * K + k0 + 8 * c) = o; }
    LDS_WAIT(); asm volatile("" ::: "memory");
}
constexpr int I_G = (DM / 64) * (2 * FF / 32), I_D = (FF / 64) * (DM / 32), I_IN = (DM / 64) * (9600 / 32), I_OUT = (DM / 64) * (DM / 32), I_Q = (1024 / 64) * (NQ / 32), I_KV = (512 / 64) * (NKV / 32);
constexpr int I_LAYER = 2 * I_G + 2 * I_D + I_IN + I_OUT + I_Q + I_KV;

__device__ __forceinline__ void phase0(const Frame& F, unsigned char* ws) {
    const int gw = F.bid * 8 + F.wave, NGW = F.G * 8;
    const size_t gt = (size_t)F.bid * 512 + F.tid, NGT = (size_t)F.G * 512;
    LAS float* scr = (LAS float*)(F.lds + F.wave * 8704);
    bf16_t* WB = (bf16_t*)(ws + WS_WB);
    for (int it = gw; it < NL * I_LAYER; it += NGW) {
        const int l = it / I_LAYER; int r = it - l * I_LAYER; bf16_t* wl = WB + (size_t)l * W_LAYER;
        if (r < I_G) { transpose_item(IN_(10) + (size_t)l * DM * 2 * FF, DM, 2 * FF, wl + W_G1, 1, scr, r, F.lane); continue; } r -= I_G;
        if (r < I_D) { transpose_item(IN_(11) + (size_t)l * FF * DM, FF, DM, wl + W_D1, 0, scr, r, F.lane); continue; } r -= I_D;
        if (r < I_G) { transpose_item(IN_(12) + (size_t)l * DM * 2 * FF, DM, 2 * FF, wl + W_G2, 1, scr, r, F.lane); continue; } r -= I_G;
        if (r < I_D) { transpose_item(IN_(13) + (size_t)l * FF * DM, FF, DM, wl + W_D2, 0, scr, r, F.lane); continue; } r -= I_D;
        if (r < I_IN) { transpose_item(IN_(14) + (size_t)l * DM * 9600, DM, 9600, wl + W_IN, 0, scr, r, F.lane); continue; } r -= I_IN;
        if (r < I_OUT) { transpose_item(IN_(15) + (size_t)l * DM * DM, DM, DM, wl + W_OUT, 0, scr, r, F.lane); continue; } r -= I_OUT;
        if (r < I_Q) { transpose_item(IN_(39) + (size_t)l * 1024 * NQ, 1024, NQ, wl + W_Q, 0, scr, r, F.lane); continue; } r -= I_Q;
        transpose_item(IN_(41) + (size_t)l * 512 * NKV, 512, NKV, wl + W_KV, 0, scr, r, F.lane);
    }
    for (size_t i = gt; i < (size_t)NL * 128 * 512; i += NGT) {
        const int l = (int)(i / (128 * 512)), rr = (int)((i / 512) % 128), c = (int)(i % 512);
        const int row = 9600 + rr;
        *(u32x4*)(WB + (size_t)l * W_LAYER + W_IN + (size_t)row * DM + c * 8) = (u32x4){0u, 0u, 0u, 0u};
    }
    { bf16_t* WLR = (bf16_t*)(ws + WS_WLR); const float* wu = IN_(18); const float* au = IN_(20); const float* gu = IN_(21);
      for (size_t i = gt; i < (size_t)NL * 448 * A_W; i += NGT) { const int l = (int)(i / (448 * A_W)), k = (int)((i / A_W) % 448), col = (int)(i % A_W);
          float v;
          if (k < 128) v = wu[(((size_t)l * 2 + (k >> 6)) * 64 + (k & 63)) * A_W + col];
          else if (k < 256) v = au[(((size_t)l * 2 + ((k - 128) >> 6)) * 64 + (k & 63)) * A_W + col];
          else v = gu[((size_t)l * 192 + (k - 256)) * A_W + col];
          WLR[((size_t)l * A_W + col) * 448 + k] = (bf16_t)(cvt_pk_bf16(v, v) & 0xffffu); } }
    { f32x4* xs = (f32x4*)(ws + WS_XS); const f32x4* cx = (const f32x4*)IN_(2); const f32x4* xx = (const f32x4*)IN_(0);
      for (size_t i = gt; i < (size_t)T * DM / 4; i += NGT) xs[i] = i < (size_t)NCTX * DM / 4 ? cx[i] : xx[i - (size_t)NCTX * DM / 4]; }
    { float* HP = (float*)(ws + WS_HP);
      for (int it = F.bid; it < NL * 16; it += F.G) { const int l = it >> 4, ch = it & 15, w = F.tid >> 8, j = F.tid & 255;
          const float* cv = w ? IN_(3) : IN_(1); const float* ad = IN_(4) + ((size_t)l * DM + ch * 256) * 256 + j; float s = 0.f;
          for (int i = 0; i < 256; ++i) s += siluf_(cv[ch * 256 + i]) * ad[(size_t)i * 256];
          HP[((l * 16 + ch) * 2 + w) * 256 + j] = s; } }
    { float* H3 = (float*)(ws + WS_H3);
      LAS float* zb = (LAS float*)(F.lds + 73728); LAS float* ha = zb + 8 * 36; LAS float* hb = ha + 8 * 64;
      for (int it = F.bid; it < NL * (T / 8); it += F.G) { const int l = it / (T / 8), pb = it % (T / 8);
          if (F.tid < 8 * 33) { const int p = F.tid / 33, i = F.tid % 33, P = pb * 8 + p; const int L = P < NCTX ? NCTX : SEQ, t = P < NCTX ? P : P - NCTX;
              float z;
              if (i == 0) z = (float)t / (float)(L - 1);
              else { const int b = (i - 1) & 15; const float fb = 1e-4f + (float)b * ((15.0f - 1e-4f) / 15.0f); const float rev2 = 2.0f * fb * (float)t / (float)L;
                  z = i <= 16 ? cospif(rev2) : -sinpif(rev2); }
              zb[p * 36 + i] = z; }
          __syncthreads();
          const int p = F.tid >> 6, j = F.tid & 63; const float fq = IN_(36)[l * 64 + j];
          { const float* w1 = IN_(29) + (size_t)l * 33 * 64 + j; float s = IN_(30)[l * 64 + j];
            for (int i = 0; i < 33; ++i) s += zb[p * 36 + i] * w1[i * 64];
            ha[p * 64 + j] = sinf(fq * s); }
          __syncthreads();
          { const float* w2 = IN_(31) + (size_t)l * 64 * 64 + j; float s = IN_(32)[l * 64 + j];
            for (int i = 0; i < 64; ++i) s += ha[p * 64 + i] * w2[i * 64];
            hb[p * 64 + j] = sinf(fq * s); }
          __syncthreads();
          { const float* w3 = IN_(33) + (size_t)l * 64 * 64 + j; float s = IN_(34)[l * 64 + j];
            for (int i = 0; i < 64; ++i) s += hb[p * 64 + i] * w3[i * 64];
            ((bf16_t*)H3)[((size_t)l * 64 + j) * T + pb * 8 + p] = (bf16_t)(cvt_pk_bf16(sinf(fq * s), 0.f) & 0xffffu); }
          __syncthreads(); } }
}
__device__ __forceinline__ void phase_mod(const Frame& F, unsigned char* ws) {
    const float* HP = (const float*)(ws + WS_HP); float* MOD = (float*)(ws + WS_MOD);
    LAS float* hs = (LAS float*)F.lds;
    for (int it = F.bid; it < NL * (NMOD / 512); it += F.G) { const int l = it / (NMOD / 512), nb = it % (NMOD / 512);
        { const int w = F.tid >> 8, j = F.tid & 255; float s = 0.f;
          for (int ch = 0; ch < 16; ++ch) s += HP[((l * 16 + ch) * 2 + w) * 256 + j];
          hs[w * 256 + j] = s; }
        __syncthreads();
        const int n = nb * 512 + F.tid; const float* au = IN_(5) + (size_t)l * 256 * NMOD + n; float s0 = IN_(6)[(size_t)l * NMOD + n], s1 = s0;
        for (int j = 0; j < 256; ++j) { const float u = au[(size_t)j * NMOD]; s0 += hs[j] * u; s1 += hs[256 + j] * u; }
        MOD[((size_t)l * 2 + 0) * NMOD + n] = s0; MOD[((size_t)l * 2 + 1) * NMOD + n] = s1;
        __syncthreads(); }
}
__device__ __forceinline__ void norm_phase(const Frame& F, float* XS, const float* __restrict__ gain, const float* modx, const float* modc, int ish, int isc, bf16_t* out, const float* slab, const float* sgate, float sfac) {
    const int gw = F.bid * 8 + F.wave, NGW = F.G * 8;
    int row_lo = 0;
    if (slab) { row_lo = NCTX;
        LAS float* red = (LAS float*)F.lds;
        for (int row = F.bid; row < NCTX; row += F.G) { const size_t o = (size_t)row * DM + F.wave * 512;
            f32x4 v[2]; float s = 0.f;
#pragma unroll
            for (int j = 0; j < 2; ++j) { f32x4 acc = (f32x4){0.f, 0.f, 0.f, 0.f};
#pragma unroll
                for (int ks = 0; ks < 16; ++ks) acc += ((const f32x4*)(slab + (size_t)ks * NCTX * DM + o) + F.lane)[64 * j];
                v[j] = ((const f32x4*)(XS + o) + F.lane)[64 * j] + acc * ((const f32x4*)(sgate + F.wave * 512) + F.lane)[64 * j] * sfac;
                ((f32x4*)(XS + o) + F.lane)[64 * j] = v[j]; s += (v[j].x * v[j].x + v[j].y * v[j].y) + (v[j].z * v[j].z + v[j].w * v[j].w); }
            s = wave_sum(s); if (F.lane == 0) red[F.wave] = s;
            __syncthreads();
            float tot = 0.f;
#pragma unroll
            for (int w = 0; w < 8; ++w) tot += red[w];
            const float rstd = rsqrtf(tot * (1.0f / DM) + NORM_EPS);
#pragma unroll
            for (int j = 0; j < 2; ++j) { const int c4 = F.wave * 128 + F.lane + 64 * j;
                const f32x4 y = v[j] * rstd * ((const f32x4*)gain)[c4] * (((const f32x4*)(modc + (size_t)isc * DM))[c4] + 1.0f) + ((const f32x4*)(modc + (size_t)ish * DM))[c4];
                u32x2 w2; w2.x = cvt_pk_bf16(y.x, y.y); w2.y = cvt_pk_bf16(y.z, y.w); ((u32x2*)(out + (size_t)row * DM))[c4] = w2; }
            __syncthreads(); } }
    for (int row = row_lo + gw; row < T; row += NGW) {
        const float* mod = row < NCTX ? modc : modx;
        const f32x4* xr = (const f32x4*)(XS + (size_t)row * DM) + F.lane; const f32x4* g4 = (const f32x4*)gain + F.lane;
        const f32x4* sh4 = (const f32x4*)(mod + (size_t)ish * DM) + F.lane; const f32x4* sc4 = (const f32x4*)(mod + (size_t)isc * DM) + F.lane;
        f32x4 v[16]; float s = 0.f;
#pragma unroll
        for (int j = 0; j < 16; ++j) { v[j] = xr[64 * j]; s += (v[j].x * v[j].x + v[j].y * v[j].y) + (v[j].z * v[j].z + v[j].w * v[j].w); }
        const float rstd = rsqrtf(wave_sum(s) * (1.0f / DM) + NORM_EPS);
        u32x2* o = (u32x2*)(out + (size_t)row * DM) + F.lane;
#pragma unroll
        for (int j = 0; j < 16; ++j) { const f32x4 y = v[j] * rstd * g4[64 * j] * (sc4[64 * j] + 1.0f) + sh4[64 * j];
            u32x2 w; w.x = cvt_pk_bf16(y.x, y.y); w.y = cvt_pk_bf16(y.z, y.w); o[64 * j] = w; }
    }
}
__device__ __forceinline__ float conv3_at(const float* PX, int tau, int col, float w0, float w1, float w2) {
    const float* p = PX + (size_t)tau * PXW + col;
    const bool hl = has_left(tau), hr = has_right(tau);
    return p[0] * w1 + p[hl ? -PXW : 0] * (hl ? w0 : 0.f) + p[hr ? PXW : 0] * (hr ? w2 : 0.f);
}
__device__ __forceinline__ float rope_apply(float val, int tau, int j) {
    const int pos = tau - NCTX, prow = pos >> 6, pcol = pos & 63;
    const float inv = __powf(10000.0f, -(float)(j & 15) * (1.0f / 16.0f));
    const float ang = (float)(j < 32 ? prow : pcol) * inv;
    float sn, cs; sincosf(ang, &sn, &cs);
    const float partner = __shfl_xor(val, 16);
    const float rot = (j & 16) ? partner : -partner;
    return val * cs + rot * sn;
}
__device__ __forceinline__ void mla_prep_phase(const Frame& F, unsigned char* ws, int l) {
    const float* PX = (const float*)(ws + WS_PX); bf16_t* QA = (bf16_t*)(ws + WS_QA); bf16_t* KVA = (bf16_t*)(ws + WS_KVA); bf16_t* KPE = (bf16_t*)(ws + WS_KPE);
    const int gw = F.bid * 8 + F.wave, NGW = F.G * 8;
    const f32x4* gq = (const f32x4*)(IN_(38) + l * 1024) + F.lane; const f32x4* gkv = (const f32x4*)(IN_(40) + l * 512) + F.lane; const float gpe = IN_(45)[l * 64 + F.lane];
    for (int tau = gw; tau < T; tau += NGW) {
        const f32x4* p = (const f32x4*)(PX + (size_t)tau * PXW + PXC) + F.lane;
        f32x4 q[4], kv[2]; float sq = 0.f, skv = 0.f;
#pragma unroll
        for (int j = 0; j < 4; ++j) { q[j] = p[64 * j]; sq += (q[j].x * q[j].x + q[j].y * q[j].y) + (q[j].z * q[j].z + q[j].w * q[j].w); }
#pragma unroll
        for (int j = 0; j < 2; ++j) { kv[j] = p[256 + 64 * j]; skv += (kv[j].x * kv[j].x + kv[j].y * kv[j].y) + (kv[j].z * kv[j].z + kv[j].w * kv[j].w); }
        const float pe = PX[(size_t)tau * PXW + PXC + 1536 + F.lane];
        const float rq = rsqrtf(wave_sum(sq) * (1.0f / 1024.0f) + NORM_EPS), rkv = rsqrtf(wave_sum(skv) * (1.0f / 512.0f) + NORM_EPS), rpe = rsqrtf(wave_sum(pe * pe) * (1.0f / 64.0f) + NORM_EPS);
        u32x2* oq = (u32x2*)(QA + (size_t)tau * 1024) + F.lane; u32x2* okv = (u32x2*)(KVA + (size_t)tau * 512) + F.lane;
#pragma unroll
        for (int j = 0; j < 4; ++j) { const f32x4 y = q[j] * rq * gq[64 * j]; u32x2 w; w.x = cvt_pk_bf16(y.x, y.y); w.y = cvt_pk_bf16(y.z, y.w); oq[64 * j] = w; }
#pragma unroll
        for (int j = 0; j < 2; ++j) { const f32x4 y = kv[j] * rkv * gkv[64 * j]; u32x2 w; w.x = cvt_pk_bf16(y.x, y.y); w.y = cvt_pk_bf16(y.z, y.w); okv[64 * j] = w; }
        float kp = pe * rpe * gpe;
        if (tau >= NCTX) kp = rope_apply(kp, tau, F.lane);
        KPE[(size_t)tau * 64 + F.lane] = (bf16_t)(cvt_pk_bf16(kp, kp) & 0xffffu);
    }
}
__device__ __forceinline__ void qkv_final_phase(const Frame& F, unsigned char* ws, int l, bool need_ctx) {
    const bf16_t* QRAW = (const bf16_t*)(ws + WS_QRAW); const bf16_t* KVRAW = (const bf16_t*)(ws + WS_KVRAW); const bf16_t* KPE = (const bf16_t*)(ws + WS_KPE);
    bf16_t* QF = (bf16_t*)(ws + WS_QF); bf16_t* KF = (bf16_t*)(ws + WS_KF);
    const int gw = F.bid * 8 + F.wave, NGW = F.G * 8, ln = F.lane;
    const float gqn0 = IN_(42)[l * 128 + 2 * ln], gqn1 = IN_(42)[l * 128 + 2 * ln + 1], gqp = IN_(43)[l * 64 + ln];
    const float gkn0 = IN_(44)[l * 128 + 2 * ln], gkn1 = IN_(44)[l * 128 + 2 * ln + 1];
    (void)need_ctx;
    for (int tau = gw; tau < T; tau += NGW) {
        float cs = 1.f, sn = 0.f;
        if (tau >= NCTX) { const int pos = tau - NCTX, prow = pos >> 6, pcol = pos & 63; const float inv = __powf(10000.0f, -(float)(ln & 15) * (1.0f / 16.0f)); sincosf((float)(ln < 32 ? prow : pcol) * inv, &sn, &cs); }
        const bf16_t kpe = KPE[(size_t)tau * 64 + ln];
        const bf16_t* qrow = QRAW + (size_t)tau * NQ; const bf16_t* krow = KVRAW + (size_t)tau * NKV;
        unsigned qn[NHC], kn[NHC]; bf16_t qpv[NHC];
#pragma unroll
        for (int h = 0; h < NHC; ++h) { qn[h] = *(const unsigned*)(qrow + h * 192 + 2 * ln); qpv[h] = qrow[h * 192 + 128 + ln]; kn[h] = *(const unsigned*)(krow + h * 256 + 2 * ln); }
#pragma unroll
        for (int h = 0; h < NHC; ++h) {
            const float q0 = bf2f((unsigned short)(qn[h] & 0xffffu)), q1 = bf2f((unsigned short)(qn[h] >> 16)), qp = bf2f(qpv[h]), k0 = bf2f((unsigned short)(kn[h] & 0xffffu)), k1 = bf2f((unsigned short)(kn[h] >> 16));
            const float rqn = rsqrtf(wave_sum(q0 * q0 + q1 * q1) * (1.0f / 128.0f) + NORM_EPS), rqp = rsqrtf(wave_sum(qp * qp) * (1.0f / 64.0f) + NORM_EPS), rkn = rsqrtf(wave_sum(k0 * k0 + k1 * k1) * (1.0f / 128.0f) + NORM_EPS);
            float qpe = qp * rqp * gqp;
            { const float partner = __shfl_xor(qpe, 16); const float rot = (ln & 16) ? partner : -partner; qpe = qpe * cs + rot * sn; }
            *(unsigned*)(QF + (size_t)tau * NQ + h * 192 + 2 * ln) = cvt_pk_bf16(q0 * rqn * gqn0, q1 * rqn * gqn1);
            QF[(size_t)tau * NQ + h * 192 + 128 + ln] = (bf16_t)(cvt_pk_bf16(qpe, qpe) & 0xffffu);
            *(unsigned*)(KF + (size_t)tau * NQ + h * 192 + 2 * ln) = cvt_pk_bf16(k0 * rkn * gkn0, k1 * rkn * gkn1);
            KF[(size_t)tau * NQ + h * 192 + 128 + ln] = kpe; }
    }
}
__device__ __forceinline__ void rwkv_out_phase(const Frame& F, unsigned char* ws, int l, bool need_ctx) {
    const float* SS = (const float*)(ws + WS_SS); const float* SD = (const float*)(ws + WS_SD); const float* GB = (const float*)(ws + WS_G); const float* Y = (const float*)(ws + WS_Y);
    bf16_t* OB = (bf16_t*)(ws + WS_OBUF);
    const int gw = F.bid * 8 + F.wave, NGW = F.G * 8, ln = F.lane;
    for (int it = (need_ctx ? 0 : NCTX * 5) + gw; it < T * 5; it += NGW) { const int tau = it / 5, h0 = (it % 5) * 4;
        float y0[4], y1[4], r[4], v[4], ka[4], kb[4], g[4];
#pragma unroll
        for (int q = 0; q < 4; ++q) { const int h = h0 + q, col = h * 64 + ln; const size_t o = (size_t)tau * A_W + col;
            y0[q] = Y[o]; y1[q] = Y[(size_t)T * A_W + o]; const float* ss = SS + ((size_t)h * T + tau) * 192 + ln; r[q] = ss[64]; v[q] = ss[128];
            ka[q] = SD[(((size_t)h * 2 + 0) * T + tau) * 192 + 128 + ln]; kb[q] = SD[(((size_t)h * 2 + 1) * T + tau) * 192 + 128 + ln]; g[q] = GB[o]; }
#pragma unroll
        for (int q = 0; q < 4; ++q) { const int col = (h0 + q) * 64 + ln;
            const float y = y0[q] + y1[q];
            const float mu = wave_sum(y) * (1.0f / 64.0f); const float dy = y - mu; const float var = wave_sum(dy * dy) * (1.0f / 64.0f);
            const float yn = dy * rsqrtf(var + GN_EPS) * IN_(25)[l * A_W + col] + IN_(26)[l * A_W + col];
            const float bonus = wave_sum(r[q] * (0.5f * (ka[q] + kb[q])) * IN_(24)[l * A_W + col]) * v[q];
            const float ov = (yn + bonus) * g[q];
            OB[(size_t)tau * DM + col] = (bf16_t)(cvt_pk_bf16(ov, ov) & 0xffffu); }
    }
}
__device__ __forceinline__ void hyena_prep_phase(const Frame& F, unsigned char* ws, int l) {
    const float* PX = (const float*)(ws + WS_PX); float* GT = (float*)(ws + WS_GT); float* X0T = (float*)(ws + WS_X0T);
    LAS float* LGt = (LAS float*)F.lds; LAS float* LX0 = LGt + 64 * 65;
    const float* cw = IN_(27) + (size_t)l * 3 * B_IN; const float* cb = IN_(28) + (size_t)l * B_IN;
    for (int it = F.bid; it < (T / 64) * 20; it += F.G) { const int tt = it / 20, ct = it % 20;
        { const int t = F.tid >> 3, c0 = ct * 64 + (F.tid & 7) * 8, tau = tt * 64 + t;
          f32x4 u[3][2];
#pragma unroll
          for (int grp = 0; grp < 3; ++grp)
#pragma unroll
              for (int q = 0; q < 2; ++q) { const int c = grp * 1280 + c0 + 4 * q; const float* p = PX + (size_t)tau * PXW + PXB + c;
                  const bool hl = has_left(tau), hr = has_right(tau);
                  const f32x4 y = *(const f32x4*)p * *(const f32x4*)(cw + B_IN + c) + *(const f32x4*)(cb + c) + *(const f32x4*)(p - (hl ? PXW : 0)) * (*(const f32x4*)(cw + c) * (hl ? 1.f : 0.f))
                                + *(const f32x4*)(p + (hr ? PXW : 0)) * (*(const f32x4*)(cw + 2 * B_IN + c) * (hr ? 1.f : 0.f));
                  u[grp][q] = y; }
#pragma unroll
          for (int q = 0; q < 2; ++q)
#pragma unroll
              for (int e = 0; e < 4; ++e) { const int ch = (F.tid & 7) * 8 + 4 * q + e; LGt[ch * 65 + t] = u[1][q][e] * u[2][q][e]; LX0[ch * 65 + t] = u[0][q][e]; } }
        __syncthreads();
        { const int ch = F.tid >> 3, t0 = (F.tid & 7) * 8; const size_t o = (size_t)(ct * 64 + ch) * T + tt * 64 + t0;
          f32x4 a0, a1, b0, b1;
#pragma unroll
          for (int e = 0; e < 4; ++e) { a0[e] = LGt[ch * 65 + t0 + e]; a1[e] = LGt[ch * 65 + t0 + 4 + e]; b0[e] = LX0[ch * 65 + t0 + e]; b1[e] = LX0[ch * 65 + t0 + 4 + e]; }
          *(f32x4*)(GT + o) = a0; *(f32x4*)(GT + o + 4) = a1; *(f32x4*)(X0T + o) = b0; *(f32x4*)(X0T + o + 4) = b1; }
        __syncthreads(); }
}
__device__ __forceinline__ void hyena_out_phase(const Frame& F, unsigned char* ws, bool need_ctx) {
    const float* YT = (const float*)(ws + WS_GT); bf16_t* OB = (bf16_t*)(ws + WS_OBUF);
    LAS float* L = (LAS float*)F.lds;
    const int it0 = need_ctx ? 0 : (NCTX / 64) * 20;
    for (int it = it0 + F.bid; it < (T / 64) * 20; it += F.G) { const int tt = it / 20, ct = it % 20;
        { const int ch = F.tid >> 3, t0 = (F.tid & 7) * 8; const size_t o = (size_t)(ct * 64 + ch) * T + tt * 64 + t0;
          const f32x4 a0 = *(const f32x4*)(YT + o), a1 = *(const f32x4*)(YT + o + 4);
#pragma unroll
          for (int e = 0; e < 4; ++e) { L[ch * 65 + t0 + e] = a0[e]; L[ch * 65 + t0 + 4 + e] = a1[e]; } }
        __syncthreads();
        { const int t = F.tid >> 3, c0 = (F.tid & 7) * 8; float x[8];
#pragma unroll
          for (int e = 0; e < 8; ++e) x[e] = L[(c0 + e) * 65 + t];
          u32x4 w; w.x = cvt_pk_bf16(x[0], x[1]); w.y = cvt_pk_bf16(x[2], x[3]); w.z = cvt_pk_bf16(x[4], x[5]); w.w = cvt_pk_bf16(x[6], x[7]);
          *(u32x4*)(OB + (size_t)(tt * 64 + t) * DM + 1280 + ct * 64 + c0) = w; }
        __syncthreads(); }
}
namespace att {
constexpr int DK = 192, DV = 128, NW = 8, QBLK = 32, KVBLK = 64;
constexpr float SCALE = 0.07216878364870322f;
constexpr float THR = 8.f;
#ifndef ATT_SDEPTH
#define ATT_SDEPTH 2
#endif
constexpr int SDEPTH = ATT_SDEPTH;
constexpr int LDQ = 2304, LDK = 2304, LDV = 3072, LDO = 4096;
constexpr int SHM_V = KVBLK * DV * 2, SHM_K = KVBLK * DK * 2, SHM_ATTN = 2 * SHM_V + 2 * SHM_K + NW * 64 * 4 + NW * 4096;
using bf16x8 = __attribute__((ext_vector_type(8))) short;
using s16x4  = __attribute__((ext_vector_type(4))) short;
using f32x16 = __attribute__((ext_vector_type(16))) float;
using u32x4  = __attribute__((ext_vector_type(4))) unsigned;
#define KSWZ(row, colB) ((row) * 384 + ((colB) ^ (((row) & 7) << 4)))
#define SBAR() __builtin_amdgcn_sched_barrier(0)
__device__ __forceinline__ int crow(int r, int hi) { return (r & 3) + 8 * (r >> 2) + 4 * hi; }
__device__ __forceinline__ unsigned cvtpk(float lo, float hi) { unsigned r; asm volatile("v_cvt_pk_bf16_f32 %0, %1, %2" : "=v"(r) : "v"(lo), "v"(hi)); return r; }
__device__ __forceinline__ void partialSM(f32x16& p0, f32x16& p1, float& m_reg, float& mn, float& alpha) {
  constexpr float C = SCALE * 1.4426950408889634f;
  float pmax = p0[0]; for (int r = 1; r < 16; ++r) pmax = fmaxf(pmax, p0[r]); for (int r = 0; r < 16; ++r) pmax = fmaxf(pmax, p1[r]);
  { auto rr = __builtin_amdgcn_permlane32_swap(__float_as_uint(pmax), __float_as_uint(pmax), false, false);
    pmax = fmaxf(__uint_as_float(rr[0]), __uint_as_float(rr[1])); }
  if (__builtin_expect(__all(pmax - m_reg <= THR / SCALE), 1)) { mn = m_reg; alpha = 1.f; }
  else { mn = fmaxf(m_reg, pmax); alpha = __builtin_amdgcn_exp2f((m_reg - mn) * C); m_reg = mn; }
  float mnC = -mn * C;
  for (int r = 0; r < 16; ++r) p0[r] = fmaf(p0[r], C, mnC); for (int r = 0; r < 16; ++r) p1[r] = fmaf(p1[r], C, mnC);
  for (int r = 0; r < 16; ++r) p0[r] = __builtin_amdgcn_exp2f(p0[r]);
}
__device__ __forceinline__ void finishSM(f32x16& p0, f32x16& p1, float alpha, float& l_reg, bf16x8& pa0, bf16x8& pa1, bf16x8& pa2, bf16x8& pa3) {
  for (int r = 0; r < 16; ++r) p1[r] = __builtin_amdgcn_exp2f(p1[r]);
  float ps = 0; for (int r = 0; r < 16; ++r) ps += p0[r]; for (int r = 0; r < 16; ++r) ps += p1[r];
  { auto rr = __builtin_amdgcn_permlane32_swap(__float_as_uint(ps), __float_as_uint(ps), false, false);
    ps = __uint_as_float(rr[0]) + __uint_as_float(rr[1]); }
  l_reg = l_reg * alpha + ps;
#define PK4(P, BASE, OUT) do { unsigned a0 = cvtpk(P[BASE + 0], P[BASE + 1]), a1 = cvtpk(P[BASE + 2], P[BASE + 3]);   \
    unsigned b0 = cvtpk(P[BASE + 4], P[BASE + 5]), b1 = cvtpk(P[BASE + 6], P[BASE + 7]);                              \
    auto r0 = __builtin_amdgcn_permlane32_swap(a0, b0, false, false); auto r1 = __builtin_amdgcn_permlane32_swap(a1, b1, false, false); \
    u32x4 w = {r0[0], r1[0], r0[1], r1[1]}; OUT = *reinterpret_cast<bf16x8*>(&w); } while (0)
  PK4(p0, 0, pa0); PK4(p0, 8, pa1); PK4(p1, 0, pa2); PK4(p1, 8, pa3);
#undef PK4
}
__device__ __forceinline__ void qkt(f32x16& p0, f32x16& p1, const char* Ks, const bf16x8* qr, const char* qrl, int r32, int hi) {
  p0 = f32x16{}; p1 = f32x16{};
#pragma unroll
  for (int d0 = 0; d0 < 8; ++d0) { int cb = (d0 * 16 + hi * 8) * 2;
    bf16x8 b0 = *reinterpret_cast<const bf16x8*>(Ks + KSWZ(r32, cb));
    bf16x8 b1 = *reinterpret_cast<const bf16x8*>(Ks + KSWZ(32 + r32, cb));
    p0 = __builtin_amdgcn_mfma_f32_32x32x16_bf16(b0, qr[d0], p0, 0, 0, 0);
    p1 = __builtin_amdgcn_mfma_f32_32x32x16_bf16(b1, qr[d0], p1, 0, 0, 0); }
#pragma unroll
  for (int d0 = 8; d0 < 12; ++d0) { int cb = (d0 * 16 + hi * 8) * 2;
    bf16x8 b0 = *reinterpret_cast<const bf16x8*>(Ks + KSWZ(r32, cb));
    bf16x8 b1 = *reinterpret_cast<const bf16x8*>(Ks + KSWZ(32 + r32, cb));
    const bf16x8 q = *reinterpret_cast<const bf16x8*>(qrl + ((((d0 - 8) * 2 + hi) ^ (r32 & 7)) << 4));
    p0 = __builtin_amdgcn_mfma_f32_32x32x16_bf16(b0, q, p0, 0, 0, 0);
    p1 = __builtin_amdgcn_mfma_f32_32x32x16_bf16(b1, q, p1, 0, 0, 0); }
}
__device__ __forceinline__ int v_st(int k, int c) { const int kk = (k & ~0xC) | ((k & 4) << 1) | ((k & 8) >> 1); return ((kk >> 3) * 4 + (c >> 5)) * 512 + ((kk & 7) * 32 + (c & 31)) * 2; }
__device__ __forceinline__ int v_rd_base(int lane) { return ((lane & 3) << 3) | (((lane >> 2) & 3) << 6) | (((lane >> 4) & 1) << 5) | (((lane >> 5) & 1) << 8); }
constexpr int v_rd_off(int d0, int ks, int half) { return d0 * 512 + ks * 4096 + half * 2048; }
template <int OFF> __device__ __forceinline__ s16x4 tr_read(int vb) {
  s16x4 r; asm volatile("ds_read_b64_tr_b16 %0, %1 offset:%2" : "=&v"(r) : "v"(vb), "i"(OFF) : "memory"); return r;
}
template <int D0> __device__ __forceinline__ void pv_one(f32x16& od, int vb, bf16x8 pa0, bf16x8 pa1, bf16x8 pa2, bf16x8 pa3) {
  const s16x4 l0 = tr_read<v_rd_off(D0, 0, 0)>(vb), h0 = tr_read<v_rd_off(D0, 0, 1)>(vb), l1 = tr_read<v_rd_off(D0, 1, 0)>(vb), h1 = tr_read<v_rd_off(D0, 1, 1)>(vb);
  const s16x4 l2 = tr_read<v_rd_off(D0, 2, 0)>(vb), h2 = tr_read<v_rd_off(D0, 2, 1)>(vb), l3 = tr_read<v_rd_off(D0, 3, 0)>(vb), h3 = tr_read<v_rd_off(D0, 3, 1)>(vb);
  asm volatile("s_waitcnt lgkmcnt(0)" ::: "memory"); SBAR();
#define PK(L, H) (bf16x8){L[0], L[1], L[2], L[3], H[0], H[1], H[2], H[3]}
  od = __builtin_amdgcn_mfma_f32_32x32x16_bf16(pa0, PK(l0, h0), od, 0, 0, 0);
  od = __builtin_amdgcn_mfma_f32_32x32x16_bf16(pa1, PK(l1, h1), od, 0, 0, 0);
  od = __builtin_amdgcn_mfma_f32_32x32x16_bf16(pa2, PK(l2, h2), od, 0, 0, 0);
  od = __builtin_amdgcn_mfma_f32_32x32x16_bf16(pa3, PK(l3, h3), od, 0, 0, 0);
#undef PK
}
__device__ __forceinline__ void pv_d0(f32x16* o, int vb, bf16x8 pa0, bf16x8 pa1, bf16x8 pa2, bf16x8 pa3) {
  pv_one<0>(o[0], vb, pa0, pa1, pa2, pa3); pv_one<1>(o[1], vb, pa0, pa1, pa2, pa3); pv_one<2>(o[2], vb, pa0, pa1, pa2, pa3); pv_one<3>(o[3], vb, pa0, pa1, pa2, pa3);
}
__device__ __forceinline__ void attn_body(const bf16_t* __restrict__ Qb, const bf16_t* __restrict__ Kh, const bf16_t* __restrict__ Vh, bf16_t* __restrict__ Ob, int seq, char* lds) {
  int tid_ = threadIdx.x; asm volatile("" : "+v"(tid_));
  const int tid = tid_, wid = tid >> 6, lane = tid & 63, r32 = lane & 31, hi = lane >> 5;
  char* V_lds = lds; char* K_lds = lds + 2 * SHM_V;
  float* ws = (float*)(lds + 2 * SHM_V + 2 * SHM_K) + wid * 64; float* li_l = ws; float* al_l = ws + 32;
  float m_reg = -1e30f, l_reg = 0; f32x16 o[4] = {}; bf16x8 qr[8];
  const bf16_t* Qw = Qb + (long)(wid * QBLK + r32) * LDQ + hi * 8;
  char* qrl = lds + 2 * SHM_V + 2 * SHM_K + NW * 64 * 4 + wid * 4096 + r32 * 128;
#pragma unroll
  for (int d0 = 0; d0 < 8; ++d0) qr[d0] = *reinterpret_cast<const bf16x8*>(Qw + d0 * 16);
#pragma unroll
  for (int d0 = 8; d0 < 12; ++d0) *reinterpret_cast<bf16x8*>(qrl + ((((d0 - 8) * 2 + hi) ^ (r32 & 7)) << 4)) = *reinterpret_cast<const bf16x8*>(Qw + d0 * 16);
  asm volatile("s_waitcnt lgkmcnt(0)" ::: "memory");
  unsigned kgo[3], vgo[2];
#pragma unroll
  for (int i = 0; i < 3; ++i) { const int p = (i * 8 + wid) * 64 + lane, row = p / 24, slot = p % 24, ch = slot ^ (row & 7); kgo[i] = (unsigned)(row * LDK + ch * 8) * 2u; }
#pragma unroll
  for (int i = 0; i < 2; ++i) { const int p = (i * 8 + wid) * 64 + lane, sub = p >> 5, within = p & 31, kk = (sub >> 2) * 8 + (within >> 2), c = (sub & 3) * 32 + (within & 3) * 8;
    const int k = (kk & ~0xC) | ((kk & 4) << 1) | ((kk & 8) >> 1); vgo[i] = (unsigned)(k * LDV + c) * 2u; }
  const int vb0 = (int)(uintptr_t)V_lds + v_rd_base(lane);
  typedef __attribute__((address_space(3))) unsigned lds_u32;
#define DMA_K(b, k0) do { const char* kg = (const char*)Kh + (size_t)(k0) * (LDK * 2); \
    _Pragma("unroll") for (int _i = 0; _i < 3; ++_i) __builtin_amdgcn_global_load_lds((const unsigned*)(kg + kgo[_i]), (lds_u32*)(K_lds + (b) * SHM_K + (_i * 8 + wid) * 1024), 16, 0, 0); } while (0)
#define DMA_V(b, k0) do { const char* vg = (const char*)Vh + (size_t)(k0) * (LDV * 2); \
    _Pragma("unroll") for (int _i = 0; _i < 2; ++_i) __builtin_amdgcn_global_load_lds((const unsigned*)(vg + vgo[_i]), (lds_u32*)(V_lds + (b) * SHM_V + (_i * 8 + wid) * 1024), 16, 0, 0); } while (0)
#define RESC(a) do { if (__any((a) < 1.f)) { if (hi == 0) al_l[r32] = (a); asm volatile("s_waitcnt lgkmcnt(0)" ::: "memory"); \
    for (int d = 0; d < 4; ++d) for (int r = 0; r < 16; ++r) o[d][r] *= al_l[crow(r, hi)]; } } while (0)
#define ENDSTEP() do { asm volatile("s_waitcnt vmcnt(0)" ::: "memory"); __syncthreads(); } while (0)
  f32x16 pA0, pA1, pB0, pB1; float mnA, mnB, alA, alB; bf16x8 pa0, pa1, pa2, pa3; const int NT = seq / KVBLK;
  DMA_K(0, 0); ENDSTEP();
  DMA_K(1, KVBLK); DMA_V(0, 0);
  qkt(pA0, pA1, K_lds, qr, qrl, r32, hi); partialSM(pA0, pA1, m_reg, mnA, alA);
  ENDSTEP();
  for (int j = 1; j + 1 < NT; j += 2) {
    DMA_K(0, (j + 1) * KVBLK); DMA_V(1, j * KVBLK);
    SBAR(); qkt(pB0, pB1, K_lds + SHM_K, qr, qrl, r32, hi);
    finishSM(pA0, pA1, alA, l_reg, pa0, pa1, pa2, pa3); SBAR();
    pv_d0(o, vb0, pa0, pa1, pa2, pa3); partialSM(pB0, pB1, m_reg, mnB, alB);
    RESC(alB); ENDSTEP();
    if (j + 2 < NT) DMA_K(1, (j + 2) * KVBLK);
    DMA_V(0, (j + 1) * KVBLK);
    SBAR(); qkt(pA0, pA1, K_lds, qr, qrl, r32, hi);
    finishSM(pB0, pB1, alB, l_reg, pa0, pa1, pa2, pa3); SBAR();
    pv_d0(o, vb0 + (int)SHM_V, pa0, pa1, pa2, pa3); partialSM(pA0, pA1, m_reg, mnA, alA);
    RESC(alA); ENDSTEP();
  }
  DMA_V(1, (NT - 1) * KVBLK);
  SBAR(); qkt(pB0, pB1, K_lds + SHM_K, qr, qrl, r32, hi);
  finishSM(pA0, pA1, alA, l_reg, pa0, pa1, pa2, pa3); SBAR();
  pv_d0(o, vb0, pa0, pa1, pa2, pa3); partialSM(pB0, pB1, m_reg, mnB, alB);
  RESC(alB); ENDSTEP();
  finishSM(pB0, pB1, alB, l_reg, pa0, pa1, pa2, pa3); SBAR();
  pv_d0(o, vb0 + (int)SHM_V, pa0, pa1, pa2, pa3);
#undef DMA_K
#undef DMA_V
#undef ENDSTEP
  if (hi == 0) li_l[r32] = l_reg; asm volatile("s_waitcnt lgkmcnt(0)" ::: "memory");
  float rli[16];
#pragma unroll
  for (int r = 0; r < 16; ++r) rli[r] = __builtin_amdgcn_rcpf(li_l[crow(r, hi)]);
  bf16_t* Ow = Ob + (long)(wid * QBLK) * LDO;
#pragma unroll
  for (int r = 0; r < 16; ++r) { int orow = crow(r, hi);
#pragma unroll
    for (int d0 = 0; d0 < 4; ++d0) { const float val = o[d0][r] * rli[r]; Ow[(long)orow * LDO + d0 * 32 + r32] = (bf16_t)(cvtpk(val, val) & 0xffff); } }
  __syncthreads();
#undef RESC
}
}
__device__ __forceinline__ f32x2 cmul(f32x2 a, f32x2 b) { return (f32x2){a.x * b.x - a.y * b.y, a.x * b.y + a.y * b.x}; }
__device__ __forceinline__ int rev4_14(int k) { const unsigned r = __brev((unsigned)k) >> 18; return (int)(((r & 0x1555u) << 1) | ((r >> 1) & 0x1555u)); }
#define ZI(i) ((i) + ((i) >> 5))
__device__ __forceinline__ void fft_tw(int j, int q, float sign, f32x2& w1, f32x2& w2, f32x2& w3) {
    const float rev = (float)j / (float)(4 * q); const float sn = __builtin_amdgcn_sinf(rev), cs = __builtin_amdgcn_cosf(rev);
    w1 = (f32x2){cs, sign * sn}; w2 = cmul(w1, w1); w3 = cmul(w2, w1);
}
__device__ __forceinline__ void fft16k_dif(LAS f32x2* Z, int tid) {
#pragma unroll 1
    for (int s = 0; s < 7; ++s) { int lq = 12 - 2 * s; asm volatile("" : "+s"(lq)); const int q = 1 << lq;
        const bool shared = q <= 512; f32x2 w1, w2, w3; fft_tw(tid & (q - 1), q, -1.f, w1, w2, w3);
#pragma unroll 2
        for (int i = 0; i < 8; ++i) { const int b = tid + 512 * i, j = b & (q - 1), base = ((b >> lq) << (lq + 2)) + j;
            const int i0 = ZI(base), i1 = ZI(base + q), i2 = ZI(base + 2 * q), i3 = ZI(base + 3 * q);
            const f32x2 a0 = Z[i0], a1 = Z[i1], a2 = Z[i2], a3 = Z[i3];
            const f32x2 t0 = a0 + a2, t1 = a0 - a2, t2 = a1 + a3, t3 = a1 - a3;
            if (!shared) fft_tw(j, q, -1.f, w1, w2, w3);
            Z[i0] = t0 + t2; Z[i1] = cmul((f32x2){t1.x + t3.y, t1.y - t3.x}, w1); Z[i2] = cmul(t0 - t2, w2); Z[i3] = cmul((f32x2){t1.x - t3.y, t1.y + t3.x}, w3); }
        __syncthreads(); }
}
__device__ __forceinline__ void fft16k_dit_inv(LAS f32x2* Z, int tid) {
#pragma unroll 1
    for (int s = 0; s < 7; ++s) { int lq = 2 * s; asm volatile("" : "+s"(lq)); const int q = 1 << lq;
        const bool shared = q <= 512; f32x2 w1, w2, w3; fft_tw(tid & (q - 1), q, 1.f, w1, w2, w3);
#pragma unroll 2
        for (int i = 0; i < 8; ++i) { const int b = tid + 512 * i, j = b & (q - 1), base = ((b >> lq) << (lq + 2)) + j;
            if (!shared) fft_tw(j, q, 1.f, w1, w2, w3);
            const int i0 = ZI(base), i1 = ZI(base + q), i2 = ZI(base + 2 * q), i3 = ZI(base + 3 * q);
            const f32x2 b0 = Z[i0], b1 = cmul(Z[i1], w1), b2 = cmul(Z[i2], w2), b3 = cmul(Z[i3], w3);
            const f32x2 t0 = b0 + b2, t1 = b0 - b2, t2 = b1 + b3, t3 = b1 - b3;
            Z[i0] = t0 + t2; Z[i1] = (f32x2){t1.x - t3.y, t1.y + t3.x}; Z[i2] = t0 - t2; Z[i3] = (f32x2){t1.x + t3.y, t1.y - t3.x}; }
        __syncthreads(); }
}
constexpr float HY_MIN_DECAY = -3.0701134573253945f, HY_MAX_DECAY = -15.350567286626973f;
__device__ __forceinline__ float hy_delta(int c) { return fabsf(HY_MIN_DECAY + (HY_MAX_DECAY - HY_MIN_DECAY) * ((float)c / 1279.0f)); }
__device__ __forceinline__ float conv3b_at(const float* PX, int tau, int col, const float* cw, int l, int c) {
    const float* w = cw + (size_t)l * 3 * B_IN;
    return conv3_at(PX, tau, col, w[c], w[B_IN + c], w[2 * B_IN + c]);
}
__device__ __forceinline__ void hyena_taps_unit(const Frame& F, unsigned char* ws, int l, int pair) {
    LAS f32x2* Z = (LAS f32x2*)F.lds; LAS float* red = (LAS float*)(F.lds + LDS_MISC + 128);
    const int tid = F.tid, c0 = 2 * pair;
    const bf16_t* H3x = (const bf16_t*)(ws + WS_H3) + (size_t)l * 64 * T + NCTX;
    f32x2* scr = (f32x2*)(ws + WS_HSCR) + (size_t)pair * 16384; float* htn = (float*)(ws + WS_HSCR + (size_t)640 * 16384 * 8) + 2 * pair;
    LAS f32x4* FW = (LAS f32x4*)(F.lds + LDS_MISC + 256);
    if (tid < 256) { const int j = tid >> 2, q = tid & 3; ((LAS float*)FW)[tid] = IN_(35)[(size_t)l * 64 * 2560 + (size_t)j * 2560 + (q >> 1) * 1280 + c0 + (q & 1)]; }
    __syncthreads();
    const float d0 = hy_delta(c0), d1 = hy_delta(c0 + 1);
#ifndef HYS
#define HYS 31
#endif
    float s0, s1, sc0 = 0.f, sc1 = 0.f;
    {
    s0 = 0.f; s1 = 0.f;
    if (HYS & 1)
#pragma unroll 1
    for (int i = 0; i < 2; ++i) { const int tb = 4096 * i + 8 * tid; const bf16_t* hc = H3x + tb;
        asm volatile("" ::: "memory");
        f32x4 acc[8];
#pragma unroll
        for (int p = 0; p < 8; ++p) acc[p] = (f32x4){0.f, 0.f, 0.f, 0.f};
#pragma unroll 8
        for (int j = 0; j < 64; ++j) { const f32x4 w = FW[j]; const u32x4 hv = *(const u32x4*)(hc + (size_t)j * T);
#pragma unroll
            for (int p = 0; p < 4; ++p) { acc[2 * p] += w * __uint_as_float(hv[p] << 16); acc[2 * p + 1] += w * __uint_as_float(hv[p] & 0xffff0000u); } }
#pragma unroll
        for (int p = 0; p < 8; ++p) { const int t = tb + p;
            const float tl = (float)t * (1.0f / 8191.0f), e0 = __expf(-tl * d0), e1 = __expf(-tl * d1);
            const float f0 = acc[p].x * e0, f1 = acc[p].y * e1, b0 = acc[p].z * e0, b1 = acc[p].w * e1;
            Z[ZI(t)] = (f32x2){f0, f1}; s0 += fabsf(f0); s1 += fabsf(f1);
            if (t < 8191) { Z[ZI(16383 - t)] = (f32x2){b0, b1}; s0 += fabsf(b0); s1 += fabsf(b1); } } }
    if (tid == 0) { float zz = 0.f; asm volatile("" : "+v"(zz)); Z[ZI(8192)] = (f32x2){zz, zz}; }
    s0 = wave_sum(s0); s1 = wave_sum(s1);
    if (F.lane == 0) { red[F.wave * 2] = s0; red[F.wave * 2 + 1] = s1; }
    __syncthreads();
    float n0 = 0.f, n1 = 0.f;
#pragma unroll
    for (int w = 0; w < 8; ++w) { n0 += red[2 * w]; n1 += red[2 * w + 1]; }
    sc0 = 1.0f / (16384.0f * n0); sc1 = 1.0f / (16384.0f * n1);
    if (HYS & 2) fft16k_dif(Z, tid);
#pragma unroll 4
    for (int i = 0; i < 32; ++i) scr[tid + 512 * i] = Z[ZI(tid + 512 * i)];
    __syncthreads();
    }
    if (tid == 0) { htn[0] = sc0; htn[1] = sc1; }
    __syncthreads();
}
__device__ __forceinline__ void hyena_unit(const Frame& F, unsigned char* ws, int l, int pair) {
    LAS f32x2* Z = (LAS f32x2*)F.lds;
    const int tid = F.tid, c0 = 2 * pair;
    float* GT = (float*)(ws + WS_GT); const float* X0T = (const float*)(ws + WS_X0T);
    const f32x2* scr = (const f32x2*)(ws + WS_HSCR) + (size_t)pair * 16384; const float* htn = (const float*)(ws + WS_HSCR + (size_t)640 * 16384 * 8) + 2 * pair;
    const float sc0 = htn[0], sc1 = htn[1];
#ifndef HYS
#define HYS 31
#endif
    for (int rp15 = 0; rp15 < REP(15); ++rp15) {
    const float* g0p = GT + (size_t)c0 * T + NCTX; const float* g1p = g0p + T;
    { float zz = 0.f; asm volatile("" : "+v"(zz));
#pragma unroll 4
      for (int i = 0; i < 16; ++i) { const int t = tid + 512 * i; Z[ZI(t)] = (f32x2){g0p[t], g1p[t]}; Z[ZI(8192 + t)] = (f32x2){zz, zz}; } }
    __syncthreads();
    if (HYS & 2) fft16k_dif(Z, tid);
    if (HYS & 8)
#pragma unroll 2
    for (int i = 0; i < 17; ++i) { const int k = tid + 512 * i; if (i == 16 && tid != 0) break;
        const int pk = rev4_14(k & 16383), pn = rev4_14((16384 - k) & 16383);
        const f32x2 A = Z[ZI(pk)], B = Z[ZI(pn)], At = scr[pk], Bt = scr[pn];
        const f32x2 G0 = (f32x2){0.5f * (A.x + B.x), 0.5f * (A.y - B.y)}, G1 = (f32x2){0.5f * (A.y + B.y), -0.5f * (A.x - B.x)};
        const f32x2 H0 = (f32x2){0.5f * (At.x + Bt.x), 0.5f * (At.y - Bt.y)}, H1 = (f32x2){0.5f * (At.y + Bt.y), -0.5f * (At.x - Bt.x)};
        const f32x2 P0 = cmul(G0, H0), P1 = cmul(G1, H1);
        Z[ZI(pk)] = (f32x2){P0.x - P1.y, P0.y + P1.x};
        if (pn != pk) Z[ZI(pn)] = (f32x2){P0.x + P1.y, P1.x - P0.y}; }
    __syncthreads();
    if (HYS & 2) fft16k_dit_inv(Z, tid);
    }
    const float bb0 = IN_(37)[l * 1280 + c0], bb1 = IN_(37)[l * 1280 + c0 + 1];
    { float* y0p = GT + (size_t)c0 * T + NCTX; float* y1p = y0p + T; const float* x0p = X0T + (size_t)c0 * T + NCTX; const float* x1p = x0p + T;
#pragma unroll 4
      for (int i = 0; i < 16; ++i) { const int t = tid + 512 * i; const f32x2 z = Z[ZI(t)]; const float ga = y0p[t], gb = y1p[t];
          y0p[t] = x0p[t] * (z.x * sc0 + ga * bb0); y1p[t] = x1p[t] * (z.y * sc1 + gb * bb1); } }
    __syncthreads();
}
__device__ __forceinline__ void hyena_ctx_unit(const Frame& F, unsigned char* ws, int l, int unit) {
    LAS float* TF = (LAS float*)F.lds; LAS float* TB = TF + 2048; LAS float* GG = TB + 2048;
    const int tid = F.tid, t = tid >> 1, cc = (tid & 1) * 4, cbase = unit * 8 + cc;
    const bf16_t* H3c = (const bf16_t*)(ws + WS_H3) + (size_t)l * 64 * T; float* GT = (float*)(ws + WS_GT); const float* X0T = (const float*)(ws + WS_X0T);
    { float f[4] = {0.f, 0.f, 0.f, 0.f}, b[4] = {0.f, 0.f, 0.f, 0.f};
      const float* wbase = IN_(35) + (size_t)l * 64 * 2560 + cbase;
      for (int j = 0; j < 64; ++j) { const float hv = bf2f(H3c[(size_t)j * T + t]); const float* wrow = wbase + (size_t)j * 2560;
#pragma unroll
          for (int q = 0; q < 4; ++q) { f[q] += hv * wrow[q]; b[q] += hv * wrow[1280 + q]; } }
      const float tl = (float)t * (1.0f / 255.0f);
#pragma unroll
      for (int q = 0; q < 4; ++q) { const float e = __expf(-tl * hy_delta(cbase + q)); TF[t * 8 + cc + q] = f[q] * e; TB[t * 8 + cc + q] = b[q] * e; GG[t * 8 + cc + q] = GT[(size_t)(cbase + q) * T + t]; } }
    __syncthreads();
    float nrm[4] = {0.f, 0.f, 0.f, 0.f}, y[4] = {0.f, 0.f, 0.f, 0.f};
    for (int s = 0; s < 256; ++s) {
#pragma unroll
        for (int q = 0; q < 4; ++q) { nrm[q] += fabsf(TF[s * 8 + cc + q]) + (s < 255 ? fabsf(TB[s * 8 + cc + q]) : 0.f);
            const int o = t - s; const float tap = o >= 0 ? TF[o * 8 + cc + q] : TB[(-o - 1) * 8 + cc + q];
            y[q] += tap * GG[s * 8 + cc + q]; } }
    __syncthreads();
#pragma unroll
    for (int q = 0; q < 4; ++q) GT[(size_t)(cbase + q) * T + t] = X0T[(size_t)(cbase + q) * T + t] * (y[q] / nrm[q] + GG[t * 8 + cc + q] * IN_(37)[l * 1280 + cbase + q]);
    __syncthreads();
}
constexpr int SC_C = 16, SC_NCHUNK = T / SC_C, SC_CHUNK_BYTES = 14 * 1024;
__device__ __forceinline__ int sc_tau(int d, int c, int t) { return d == 0 ? SC_C * c + t : (c < NCTX / SC_C ? NCTX - 1 - SC_C * c - t : T - 1 - SC_C * (c - NCTX / SC_C) - t); }
__device__ __forceinline__ int sc_perm(int e, int hi) { return (e & 3) + 8 * (e >> 2) + 4 * hi; }
constexpr size_t WS_FR_BYTES = (size_t)2 * NHA * SC_NCHUNK * SC_CHUNK_BYTES;

typedef short sc_bf16x8 __attribute__((ext_vector_type(8)));
typedef float sc_f32x16 __attribute__((ext_vector_type(16)));
__device__ __forceinline__ sc_bf16x8 sc_pack8(const sc_f32x16& a, int base) {
    u32x4 w; w.x = cvt_pk_bf16(a[base + 0], a[base + 1]); w.y = cvt_pk_bf16(a[base + 2], a[base + 3]); w.z = cvt_pk_bf16(a[base + 4], a[base + 5]); w.w = cvt_pk_bf16(a[base + 6], a[base + 7]);
    return *reinterpret_cast<sc_bf16x8*>(&w);
}
constexpr int SC_NSLOT = 9, SC_AHEAD = 7;
__device__ __forceinline__ void scan_chain_mfma(const Frame& F, unsigned char* ws, int chain) {
    const int h = chain >> 1, d = chain & 1, lane = F.lane, n = lane & 31, hi = lane >> 5, ib = F.wave;
    const unsigned char* FRc = ws + WS_FR + (size_t)chain * SC_NCHUNK * SC_CHUNK_BYTES;
    float* Yd = (float*)(ws + WS_Y) + (size_t)d * T * A_W + h * 64;
    LAS unsigned char* buf = F.lds;
    typedef __attribute__((address_space(3))) unsigned sc_lds_u32;
#define SCM_DMA(c_) do { if (ib < 7) { const unsigned char* src_ = FRc + (size_t)(c_) * SC_CHUNK_BYTES; LAS unsigned char* dst_ = buf + ((c_) % SC_NSLOT) * SC_CHUNK_BYTES; \
        _Pragma("unroll") for (int i_ = 0; i_ < 2; ++i_) __builtin_amdgcn_global_load_lds((const unsigned*)(src_ + (i_ * 7 + ib) * 1024 + lane * 16), (sc_lds_u32*)(dst_ + (i_ * 7 + ib) * 1024), 16, 0, 0); } } while (0)
    sc_f32x16 S0 = {}, S1 = {};
    int yoff[8];
#pragma unroll
    for (int r = 0; r < 8; ++r) { const int t = (r & 3) + 8 * (r >> 2) + 4 * hi; yoff[r] = (d ? -t : t) * A_W + 32 * ib + n; }
    __syncthreads();
#pragma unroll
    for (int c = 0; c < SC_AHEAD; ++c) SCM_DMA(c);
    asm volatile("s_waitcnt vmcnt(12)" ::: "memory"); __builtin_amdgcn_s_barrier(); asm volatile("" ::: "memory");
#pragma unroll 1
    for (int c = 0; c < SC_NCHUNK; ++c) {
        const bool steady = c + SC_AHEAD < SC_NCHUNK;
        if (steady) SCM_DMA(c + SC_AHEAD);
        if (ib < 2) {
                const LAS unsigned char* fb = buf + (c % SC_NSLOT) * SC_CHUNK_BYTES;
                sc_bf16x8 fr[11]; sc_bf16x8 vf; f32x4 gt[8];
                { const unsigned fa = (unsigned)(uintptr_t)fb + lane * 16, va = fa + (11 + ib) * 1024, ga = (unsigned)(uintptr_t)fb + 13 * 1024 + hi * 128;
#define SC_DSRD(dst, addr, off) asm volatile("ds_read_b128 %0, %1 offset:%2" : "=v"(dst) : "v"(addr), "i"(off))
                  SC_DSRD(fr[0], fa, 0); SC_DSRD(fr[1], fa, 1024); SC_DSRD(fr[2], fa, 2048); SC_DSRD(fr[3], fa, 3072); SC_DSRD(fr[4], fa, 4096); SC_DSRD(fr[5], fa, 5120);
                  SC_DSRD(fr[6], fa, 6144); SC_DSRD(fr[7], fa, 7168); SC_DSRD(fr[8], fa, 8192); SC_DSRD(fr[9], fa, 9216); SC_DSRD(fr[10], fa, 10240); SC_DSRD(vf, va, 0);
                  SC_DSRD(gt[0], ga, 0); SC_DSRD(gt[1], ga, 16); SC_DSRD(gt[2], ga, 32); SC_DSRD(gt[3], ga, 48); SC_DSRD(gt[4], ga, 64); SC_DSRD(gt[5], ga, 80); SC_DSRD(gt[6], ga, 96); SC_DSRD(gt[7], ga, 112);
#undef SC_DSRD
                  asm volatile("s_waitcnt lgkmcnt(0)" : "+v"(fr[0]), "+v"(fr[1]), "+v"(fr[2]), "+v"(fr[3]), "+v"(fr[4]), "+v"(fr[5]), "+v"(fr[6]), "+v"(fr[7]), "+v"(fr[8]), "+v"(fr[9]), "+v"(fr[10]), "+v"(vf) :: "memory");
                  asm volatile("" : "+v"(gt[0]), "+v"(gt[1]), "+v"(gt[2]), "+v"(gt[3]), "+v"(gt[4]), "+v"(gt[5]), "+v"(gt[6]), "+v"(gt[7])); }
                const sc_bf16x8 sb00 = sc_pack8(S0, 0), sb01 = sc_pack8(S0, 8), sb10 = sc_pack8(S1, 0), sb11 = sc_pack8(S1, 8);
                sc_f32x16 P = {}, P2 = {};
                P = __builtin_amdgcn_mfma_f32_32x32x16_bf16(fr[0], sb00, P, 0, 0, 0);
                P2 = __builtin_amdgcn_mfma_f32_32x32x16_bf16(fr[2], sb10, P2, 0, 0, 0);
                P = __builtin_amdgcn_mfma_f32_32x32x16_bf16(fr[1], sb01, P, 0, 0, 0);
                P2 = __builtin_amdgcn_mfma_f32_32x32x16_bf16(fr[3], sb11, P2, 0, 0, 0);
                P = __builtin_amdgcn_mfma_f32_32x32x16_bf16(fr[4], vf, P, 0, 0, 0);
#pragma unroll
                for (int q = 0; q < 4; ++q)
#pragma unroll
                    for (int e = 0; e < 4; ++e) { S0[4 * q + e] *= gt[q][e]; S1[4 * q + e] *= gt[4 + q][e]; }
                S0 = __builtin_amdgcn_mfma_f32_32x32x16_bf16(fr[8], vf, S0, 0, 0, 0);
                S1 = __builtin_amdgcn_mfma_f32_32x32x16_bf16(fr[10], vf, S1, 0, 0, 0);
#pragma unroll
                for (int r = 0; r < 16; ++r) P[r] += P2[r];
                const sc_bf16x8 xb = sc_pack8(P, 0);
                sc_f32x16 U = {};
                U = __builtin_amdgcn_mfma_f32_32x32x16_bf16(fr[5], xb, U, 0, 0, 0);
                const sc_bf16x8 ub = sc_pack8(U, 0);
                S0 = __builtin_amdgcn_mfma_f32_32x32x16_bf16(fr[7], ub, S0, 0, 0, 0);
                S1 = __builtin_amdgcn_mfma_f32_32x32x16_bf16(fr[9], ub, S1, 0, 0, 0);
                P = __builtin_amdgcn_mfma_f32_32x32x16_bf16(fr[6], ub, P, 0, 0, 0);
                float* yb = Yd + (size_t)sc_tau(d, c, 0) * A_W;
#pragma unroll
                for (int r = 0; r < 8; ++r) yb[yoff[r]] = P[8 + r];
        }
        if (steady) asm volatile("s_waitcnt vmcnt(12)" ::: "memory"); else asm volatile("s_waitcnt vmcnt(0)" ::: "memory");
        asm volatile("s_waitcnt lgkmcnt(0)" ::: "memory"); __builtin_amdgcn_s_barrier(); asm volatile("" ::: "memory");
    }
    asm volatile("s_waitcnt vmcnt(0)" ::: "memory"); __syncthreads();
#undef SCM_DMA
}
__device__ __forceinline__ float conv3_u(const float* PX, int tau, unsigned ucol, float w0, float w1, float w2) {
    const float* p = PX + (size_t)tau * PXW;
    float y = p[ucol] * w1;
    if (has_left(tau)) y += (p - PXW)[ucol] * w0;
    if (has_right(tau)) y += (p + PXW)[ucol] * w2;
    return y;
}
constexpr int WLR_K = 448;
constexpr int RP_WAVE_LDS = 16896;
typedef short rp_bf16x8 __attribute__((ext_vector_type(8)));
typedef float rp_f32x16 __attribute__((ext_vector_type(16)));
__device__ __forceinline__ unsigned short f2bf16(float x) { return (unsigned short)(cvt_pk_bf16(x, x) & 0xffffu); }
template <int NKB, class AF>
__device__ __forceinline__ void rp_lowrank(float (&dst)[16], const AF& afrag, const bf16_t* WLRh, int kw0, int n, int hi) {
    rp_f32x16 c0 = {}, c1 = {}; const bf16_t* wb0 = WLRh + (size_t)n * WLR_K + kw0 + 8 * hi; const bf16_t* wb1 = wb0 + (size_t)32 * WLR_K;
#pragma unroll
    for (int kb = 0; kb < NKB; ++kb) { const rp_bf16x8 b0 = *(const rp_bf16x8*)(wb0 + 16 * kb), b1 = *(const rp_bf16x8*)(wb1 + 16 * kb); const rp_bf16x8 a_ = afrag(kb);
        c0 = __builtin_amdgcn_mfma_f32_32x32x16_bf16(a_, b0, c0, 0, 0, 0); c1 = __builtin_amdgcn_mfma_f32_32x32x16_bf16(a_, b1, c1, 0, 0, 0); }
#pragma unroll
    for (int r = 0; r < 8; ++r) { auto sw = __builtin_amdgcn_permlane32_swap(__float_as_uint(c0[r]), __float_as_uint(c1[r]), false, false);
        dst[(r & 3) + 8 * (r >> 2)] = __uint_as_float(sw[0]); dst[(r & 3) + 8 * (r >> 2) + 4] = __uint_as_float(sw[1]); }
}
struct RpAfLds { const LAS bf16_t* base; __device__ __forceinline__ rp_bf16x8 operator()(int kb) const { return *(const LAS rp_bf16x8*)(base + 16 * kb); } };
__device__ __forceinline__ void rwkv_elem_phase(const Frame& F, unsigned char* ws, int l) {
    const float* PX = (const float*)(ws + WS_PX); float* SS = (float*)(ws + WS_SS); float* SD = (float*)(ws + WS_SD); float* GB = (float*)(ws + WS_G);
    const bf16_t* WLR = (const bf16_t*)(ws + WS_WLR) + (size_t)l * A_W * WLR_K;
    const float* cw = IN_(16) + (size_t)l * 3 * A_IN;
    LAS bf16_t* ACT = (LAS bf16_t*)(F.lds + F.wave * 10752);
    const int lane = F.lane, n = lane & 31, hi = lane >> 5;
    const int gw = F.bid * 8 + F.wave, NGW = F.G * 8;
    for (int it = gw; it < (T / 16) * 10; it += NGW) {
        const int tg = it / 10, hq = it % 10, tau0 = tg * 16;
        asm volatile("s_waitcnt lgkmcnt(0)" ::: "memory");
        const float* prow0 = PX + (size_t)(tau0 > 0 ? tau0 - 1 : 0) * PXW; const int roff = tau0 > 0 ? 0 : -1;
#define RP_WIN(x, ucol_) do { _Pragma("unroll") for (int i_ = 0; i_ < 18; ++i_) { int ri_ = i_ + roff; ri_ = ri_ < 0 ? 0 : ri_; ri_ = (tau0 - 1 + i_ > T - 1) ? (T - 1 - (tau0 > 0 ? tau0 - 1 : 0)) : ri_; x[i_] = (prow0 + (size_t)ri_ * PXW)[ucol_]; } } while (0)
#define RP_CONV(x, t_, w0_, w1_, w2_) (x[(t_)] * (has_left(tau0 + (t_)) ? (w0_) : 0.f) + x[(t_) + 1] * (w1_) + x[(t_) + 2] * (has_right(tau0 + (t_)) ? (w2_) : 0.f))
#pragma unroll
        for (int i = 0; i < 5; ++i) { const int c = lane + 64 * i, col = 3840 + c; const float c0 = cw[col], c1 = cw[A_IN + col], c2 = cw[2 * A_IN + col];
            float x[18]; RP_WIN(x, (unsigned)(PXA + col));
#pragma unroll
            for (int t = 0; t < 16; ++t) { const float val = RP_CONV(x, t, c0, c1, c2);
                const float act = i == 0 ? 1.0f - 2.0f / (1.0f + __expf(2.0f * val)) : (i == 1 ? val : sigmoidf_(val));
                ACT[t * 328 + c] = f2bf16(act); } }
        asm volatile("s_waitcnt lgkmcnt(0)" ::: "memory");
        const RpAfLds afw{ACT + (n & 15) * 328 + 8 * hi}, afa{ACT + (n & 15) * 328 + 64 + 8 * hi}, afg{ACT + (n & 15) * 328 + 128 + 8 * hi};
#pragma unroll 1
        for (int hh = 0; hh < 2; ++hh) {
            const int h = hq * 2 + hh, col = h * 64 + lane; const bf16_t* WLRh = WLR + (size_t)h * 64 * WLR_K;
            { float lg[16]; rp_lowrank<12>(lg, afg, WLRh, 256, n, hi);
#pragma unroll
              for (int t = 0; t < 16; ++t) GB[(size_t)(tau0 + t) * A_W + col] = lg[t]; }
            const float cr0 = cw[col], cr1 = cw[A_IN + col], cr2 = cw[2 * A_IN + col];
            const float ck0 = cw[A_W + col], ck1 = cw[A_IN + A_W + col], ck2 = cw[2 * A_IN + A_W + col];
            const float cv0 = cw[2 * A_W + col], cv1 = cw[A_IN + 2 * A_W + col], cv2 = cw[2 * A_IN + 2 * A_W + col];
            const float kk_w = IN_(22)[l * A_W + col], ka_w = IN_(23)[l * A_W + col];
            float kkv[16], kv[16];
            { float xr[18], xk[18], xv[18]; const unsigned uc = (unsigned)(PXA + col); RP_WIN(xr, uc); RP_WIN(xk, uc + A_W); RP_WIN(xv, uc + 2 * A_W);
#pragma unroll
              for (int t = 0; t < 16; ++t) { const int tau = tau0 + t;
                  const float r = RP_CONV(xr, t, cr0, cr1, cr2), v = RP_CONV(xv, t, cv0, cv1, cv2); kv[t] = RP_CONV(xk, t, ck0, ck1, ck2);
                  const float kr = kv[t] * kk_w; const float nrm = sqrtf(wave_sum(kr * kr)); kkv[t] = kr / fmaxf(nrm, 1e-12f);
                  float* ss = SS + ((size_t)h * T + tau) * 192 + lane; ss[0] = kkv[t]; ss[64] = r; ss[128] = v; } }
#pragma unroll 1
            for (int d = 0; d < 2; ++d) { const float w0b = IN_(17)[(l * 2 + d) * A_W + col], a0b = IN_(19)[(l * 2 + d) * A_W + col]; float lw[16], la[16];
                rp_lowrank<4>(lw, afw, WLRh, 64 * d, n, hi); rp_lowrank<4>(la, afa, WLRh, 128 + 64 * d, n, hi);
#pragma unroll
                for (int t = 0; t < 16; ++t) { const float z = w0b + lw[t]; const float decay = __expf(-__expf(-(fmaxf(-z, 0.f) + __logf(1.0f + __expf(-fabsf(z)))) - 0.5f)); const float av = sigmoidf_(a0b + la[t]);
                    float* sd = SD + (((size_t)h * 2 + d) * T + tau0 + t) * 192 + lane; sd[0] = decay; sd[64] = kkv[t] * av; sd[128] = kv[t] * (1.0f + (av - 1.0f) * ka_w); } }
        }
    }
}
#undef RP_WIN
#undef RP_CONV
constexpr int SP_WAVE_LDS = 16640;
__device__ __forceinline__ void scan_prep_phase(const Frame& F, unsigned char* ws) {
    const float* SS = (const float*)(ws + WS_SS); const float* SD = (const float*)(ws + WS_SD); unsigned char* FR = ws + WS_FR;
    LAS bf16_t* R1 = (LAS bf16_t*)(F.lds + F.wave * SP_WAVE_LDS); LAS bf16_t* R2 = R1 + 32 * 72; LAS bf16_t* BbT = R2 + 32 * 72; LAS bf16_t* KbT = BbT + 64 * 16; LAS bf16_t* VT = KbT + 64 * 16; LAS float* Lm = (LAS float*)(VT + 64 * 16);
    const int lane = F.lane, n = lane & 31, hi = lane >> 5;
    const int gw = F.bid * 8 + F.wave, NGW = F.G * 8;
    for (int it = gw; it < 2 * NHA * SC_NCHUNK; it += NGW) {
        const int chain = it / SC_NCHUNK, c = it % SC_NCHUNK, h = chain >> 1, d = chain & 1;
        const int tau_first = sc_tau(d, c, 0), dstep = d ? -1 : 1;
        const float* ssb = SS + (size_t)h * T * 192 + lane; const float* sdb = SD + ((size_t)h * 2 + d) * T * 192 + lane;
        float xw[16], xb[16], xk[16], xkk[16], xr[16], xv[16];
#pragma unroll
        for (int s = 0; s < 16; ++s) { const size_t o = (size_t)(tau_first + dstep * s) * 192; xw[s] = sdb[o]; xb[s] = sdb[o + 64]; xk[s] = sdb[o + 128]; xkk[s] = ssb[o]; xr[s] = ssb[o + 64]; xv[s] = ssb[o + 128]; }
        float gC = 1.f;
#pragma unroll
        for (int s = 0; s < 16; ++s) gC *= xw[s];
        float g = 1.f;
#pragma unroll
        for (int s = 0; s < 16; ++s) {
            const float gm1 = g; g *= xw[s]; const float ig = 1.0f / g; const float bh = xb[s] * ig, kh = xk[s] * ig;
            R1[s * 72 + lane] = f2bf16(-xkk[s] * gm1); R1[(16 + s) * 72 + lane] = f2bf16(xr[s] * g);
            R2[s * 72 + lane] = f2bf16(bh); R2[(16 + s) * 72 + lane] = f2bf16(kh);
            BbT[lane * 16 + s] = f2bf16(bh * gC); KbT[lane * 16 + s] = f2bf16(kh * gC); VT[lane * 16 + s] = f2bf16(xv[s]); }
        asm volatile("s_waitcnt lgkmcnt(0)" ::: "memory");
        unsigned char* dst = FR + ((size_t)chain * SC_NCHUNK + c) * SC_CHUNK_BYTES;
        rp_f32x16 C = {};
#pragma unroll
        for (int kb = 0; kb < 4; ++kb) { const rp_bf16x8 a_ = *(const LAS rp_bf16x8*)(R2 + n * 72 + 16 * kb + 8 * hi), b_ = *(const LAS rp_bf16x8*)(R1 + n * 72 + 16 * kb + 8 * hi);
            C = __builtin_amdgcn_mfma_f32_32x32x16_bf16(a_, b_, C, 0, 0, 0); }
        const int tt_ = n & 15; const bool incl = n >= 16;
#pragma unroll
        for (int r = 0; r < 16; ++r) { const int s = ((r & 7) & 3) + 8 * ((r & 7) >> 2) + 4 * hi; if (!(s < tt_ || (incl && s == tt_))) C[r] = 0.f; }
        if (n < 16) {
#pragma unroll
            for (int r = 0; r < 8; ++r) Lm[((r & 3) + 8 * (r >> 2) + 4 * hi) * 20 + n] = C[r]; }
        { u32x4 f4; f4.x = cvt_pk_bf16(C[8], C[9]); f4.y = cvt_pk_bf16(C[10], C[11]); f4.z = cvt_pk_bf16(C[12], C[13]); f4.w = cvt_pk_bf16(C[14], C[15]);
          u32x4 f6; f6.x = cvt_pk_bf16(C[0], C[1]); f6.y = cvt_pk_bf16(C[2], C[3]); f6.z = cvt_pk_bf16(C[4], C[5]); f6.w = cvt_pk_bf16(C[6], C[7]);
          if (n < 16) f6 = (u32x4){0u, 0u, 0u, 0u};
          *(u32x4*)(dst + 4 * 1024 + lane * 16) = f4; *(u32x4*)(dst + 6 * 1024 + lane * 16) = f6; }
        asm volatile("s_waitcnt lgkmcnt(0)" ::: "memory");
        { float Tc[16];
#pragma unroll
          for (int s = 15; s >= 0; --s) { float acc = (s == n) ? 1.f : 0.f;
#pragma unroll
              for (int u = s + 1; u < 16; ++u) acc += Lm[s * 20 + u] * Tc[u];
              Tc[s] = acc; }
          u32x4 f5; f5.x = cvt_pk_bf16(hi ? Tc[4] : Tc[0], hi ? Tc[5] : Tc[1]); f5.y = cvt_pk_bf16(hi ? Tc[6] : Tc[2], hi ? Tc[7] : Tc[3]);
          f5.z = cvt_pk_bf16(hi ? Tc[12] : Tc[8], hi ? Tc[13] : Tc[9]); f5.w = cvt_pk_bf16(hi ? Tc[14] : Tc[10], hi ? Tc[15] : Tc[11]);
          if (n >= 16) f5 = (u32x4){0u, 0u, 0u, 0u};
          *(u32x4*)(dst + 5 * 1024 + lane * 16) = f5; }
#pragma unroll
        for (int f = 0; f < 4; ++f) { const u32x2 p0 = *(const LAS u32x2*)(R1 + n * 72 + 16 * f + 4 * hi), p1 = *(const LAS u32x2*)(R1 + n * 72 + 16 * f + 8 + 4 * hi);
            *(u32x4*)(dst + f * 1024 + lane * 16) = (u32x4){p0.x, p0.y, p1.x, p1.y}; }
#pragma unroll
        for (int jb = 0; jb < 2; ++jb) { const int row = 32 * jb + n;
            const u32x2 b0 = *(const LAS u32x2*)(BbT + row * 16 + 4 * hi), b1 = *(const LAS u32x2*)(BbT + row * 16 + 8 + 4 * hi), k0 = *(const LAS u32x2*)(KbT + row * 16 + 4 * hi), k1 = *(const LAS u32x2*)(KbT + row * 16 + 8 + 4 * hi);
            const u32x2 v0 = *(const LAS u32x2*)(VT + row * 16 + 4 * hi), v1 = *(const LAS u32x2*)(VT + row * 16 + 8 + 4 * hi);
            *(u32x4*)(dst + (7 + 2 * jb) * 1024 + lane * 16) = (u32x4){b0.x, b0.y, b1.x, b1.y}; *(u32x4*)(dst + (8 + 2 * jb) * 1024 + lane * 16) = (u32x4){k0.x, k0.y, k1.x, k1.y};
            *(u32x4*)(dst + (11 + jb) * 1024 + lane * 16) = (u32x4){v0.x, v0.y, v1.x, v1.y}; }
        { const int jj = lane & 31; ((float*)(dst + 13 * 1024))[((jj >> 2) & 1) * 32 + (lane >> 5) * 16 + (jj & 3) + 4 * (jj >> 3)] = gC; }
        asm volatile("s_waitcnt lgkmcnt(0)" ::: "memory");
    }
}
__device__ __forceinline__ void mixer_phase(const Frame& F0, unsigned char* ws0, int lq, bool need_ctx, char* lds_g) {
    const int l = lq & 3;
#ifndef MK_MIX
#define MK_MIX 15
#endif
    { const Frame F = opq(F0); unsigned char* ws = opq_ptr(ws0);
      if (MK_MIX & 1) for (int chain = F.bid; chain < 2 * NHA; chain += F.G) scan_chain_mfma(F, ws, chain); }
    const Frame& F = F0;
    const int n_xa = 32 * NHC, n_ca = need_ctx ? NHC : 0, n_att = n_xa + n_ca, n_hy = 640, n_ch = need_ctx ? 160 : 0;
    unsigned* qatt = (unsigned*)(ws0 + WS_CTL) + CW_QUEUE + 64 * lq; unsigned* qhy = qatt + 32;
    int item;
#define MIX_POP(q) do { if (F.tid == 0) F.MISC[16] = __hip_atomic_fetch_add((q), 1u, __ATOMIC_RELAXED, __HIP_MEMORY_SCOPE_AGENT); __syncthreads(); item = (int)F.MISC[16]; __syncthreads(); } while (0)
    if (F.bid >= 2 * NHA) {
        MIX_POP(qatt);
        while (item < n_att) {
            if (MK_MIX & 2) { unsigned char* ws = opq_ptr(ws0);
                const bf16_t* QF = (const bf16_t*)(ws + WS_QF); const bf16_t* KF = (const bf16_t*)(ws + WS_KF); const bf16_t* KVRAW = (const bf16_t*)(ws + WS_KVRAW); bf16_t* OB = (bf16_t*)(ws + WS_OBUF);
                const bool is_xa = item < n_xa; const int h = is_xa ? item % NHC : item - n_xa, row0 = is_xa ? NCTX + (item / NHC) * 256 : 0;
                for (int rp = 0; rp < REP(13); ++rp) att::attn_body(QF + (size_t)row0 * NQ + h * 192, KF + h * 192, KVRAW + h * 256 + 128, OB + (size_t)row0 * DM + 2560 + h * 128, is_xa ? T : NCTX, lds_g); }
            MIX_POP(qatt);
        }
    }
    MIX_POP(qhy);
    while (item < n_hy + n_ch) {
        const Frame Fu = opq(F0); unsigned char* ws = opq_ptr(ws0);
        if ((MK_MIX & 4) && item < n_hy) hyena_unit(Fu, ws, l, item);
        else if ((MK_MIX & 8) && item >= n_hy) hyena_ctx_unit(Fu, ws, l, item - n_hy);
        MIX_POP(qhy);
    }
#undef MIX_POP
}

__device__ __forceinline__ void hyena_taps_tail(const Frame& F0, unsigned char* ws0, int lt, int first, int end) {
    if (F0.bid < 48) return;
#pragma unroll 1
    for (int p = first + F0.bid - 48; p < end; p += 208) hyena_taps_unit(opq(F0), opq_ptr(ws0), lt, p);
}
constexpr int NPH = 2 + 14 * NL;
__global__ void __launch_bounds__(512, 2) mk_fwd(Args a) {
    extern __shared__ __attribute__((aligned(16))) unsigned char lds[];
    Frame F; F.lds = (LAS unsigned char*)lds; F.MISC = (volatile LAS unsigned*)(F.lds + LDS_MISC);
    F.tid = threadIdx.x; F.lane = F.tid & 63; F.wave = __builtin_amdgcn_readfirstlane(F.tid >> 6); F.bid = blockIdx.x; F.G = gridDim.x;
    if (F.tid < 64) F.MISC[F.tid] = 0u;
    if (F.tid < 46) *(LAS unsigned long long*)(F.lds + LDS_PTAB + 8 * F.tid) = (unsigned long long)(uintptr_t)a.in[F.tid];
    __syncthreads();
    unsigned char* ws = a.ws;
    const int lo = a.ph_lo, hi = a.ph_hi;
    XcdBarrier bar = xcd_barrier_post((unsigned*)(ws + WS_CTL) + CW_BAR, F.MISC + 8);
#ifndef MK_MASK
#define MK_MASK 0xffff
#endif
#define EN(x) (((MK_MASK) >> (x)) & 1)
#define IN(k) (lo <= (k) && (k) < hi)
#define SEAM(k) do { if (IN(k) && IN((k) + 1)) xcd_barrier(bar); } while (0)
#define WSP opq_ptr(ws)
#define P_XS(w) ((float*)((w) + WS_XS))
#define P_ABUF(w) ((bf16_t*)((w) + WS_ABUF))
#define P_HBUF(w) ((bf16_t*)((w) + WS_HBUF))
#define P_OBUF(w) ((bf16_t*)((w) + WS_OBUF))
#define P_MODX(w, l) ((const float*)((w) + WS_MOD) + ((size_t)(l) * 2 + 0) * NMOD)
#define P_MODC(w, l) ((const float*)((w) + WS_MOD) + ((size_t)(l) * 2 + 1) * NMOD)
#define P_WL(w, l) ((const bf16_t*)((w) + WS_WB) + (size_t)(l) * W_LAYER)
    if (EN(0) && IN(0)) for (int rp = 0; rp < REP(0); ++rp) phase0(opq(F), opq_ptr(ws));
    SEAM(0);
    if (EN(1) && IN(1)) phase_mod(opq(F), opq_ptr(ws));
    SEAM(1);
#pragma clang loop unroll(full)
    for (int l = 0; l < NL; ++l) {
        const int pb = 2 + 14 * l; const bool need_ctx = l < NL - 1;
        if (EN(2) && IN(pb + 0)) for (int rp = 0; rp < REP(2); ++rp) { unsigned char* w = WSP; norm_phase(opq(F), P_XS(w), IN_(7) + l * DM, P_MODX(w, l), P_MODC(w, l), 0, 1, P_ABUF(w), l > 0 ? (const float*)(w + WS_SLAB) : nullptr, l > 0 ? P_MODC(w, l - 1) + 8 * DM : nullptr, 0.5f); }
        SEAM(pb + 0);
        if (EN(3) && IN(pb + 1)) { unsigned char* w = WSP; pg8::Gemm g{P_ABUF(w), P_WL(w, l) + W_G1, T, 2 * FF, DM, DM}; pg8::StaticOrder S; S.init(T, 2 * FF, F.G, F.bid); pg8::EpiSwiGLU E{P_HBUF(w), FF};
            pg8::gemm_phase<pg8::EpiSwiGLU, pg8::StaticOrder>(F.lds, g, S, E, nullptr);
            hyena_taps_tail(F, ws, l, 0, l == 0 ? 640 : 416); }
        SEAM(pb + 1);
        if (EN(4) && IN(pb + 2)) {
            { unsigned char* w = WSP; pg8::Gemm g{P_HBUF(w), P_WL(w, l) + W_D1, T, DM, FF, FF}; pg8::StaticOrderX S; S.init(T, DM, F.G, F.bid); pg8::EpiResid E{P_XS(w), P_MODX(w, l) + 2 * DM, P_MODC(w, l) + 2 * DM, 0.5f, nullptr};
              pg8::gemm_phase<pg8::EpiResid, pg8::StaticOrderX>(F.lds, g, S, E, nullptr); }
            if (true) { __syncthreads();
              if (F.bid < 256) { unsigned char* w = WSP; const int ks = F.bid >> 4, ksz = FF / 16; pg8::Gemm g{P_HBUF(w) + ks * ksz, P_WL(w, l) + W_D1 + ks * ksz, NCTX, DM, ksz, FF}; pg8::OneUnit S{F.bid & 15};
                  pg8::EpiF32 E{(float*)(w + WS_SLAB) + (size_t)ks * NCTX * DM, DM, nullptr};
                  pg8::gemm_phase<pg8::EpiF32, pg8::OneUnit>(F.lds, g, S, E, nullptr); } }
        }
        SEAM(pb + 2);
        if (EN(5) && IN(pb + 3)) for (int rp = 0; rp < REP(2); ++rp) { unsigned char* w = WSP; norm_phase(opq(F), P_XS(w), IN_(8) + l * DM, P_MODX(w, l), P_MODC(w, l), 3, 4, P_ABUF(w), (const float*)(w + WS_SLAB), P_MODC(w, l) + 2 * DM, 0.5f); }
        SEAM(pb + 3);
        if (EN(6) && IN(pb + 4)) { unsigned char* w = WSP; pg8::Gemm g{P_ABUF(w), P_WL(w, l) + W_IN, T, PXW, DM, DM}; pg8::StaticOrder S; S.init(T, PXW, F.G, F.bid); pg8::EpiF32 E{(float*)(w + WS_PX), PXW, nullptr};
            pg8::gemm_phase<pg8::EpiF32, pg8::StaticOrder>(F.lds, g, S, E, nullptr); }
        SEAM(pb + 4);
        if (EN(7) && IN(pb + 5)) { for (int rp = 0; rp < REP(7); ++rp) rwkv_elem_phase(opq(F), opq_ptr(ws), l); if (!(MK_ONLYRP)) { for (int rp = 0; rp < REP(8); ++rp) mla_prep_phase(opq(F), opq_ptr(ws), l); hyena_prep_phase(opq(F), opq_ptr(ws), l); } }
        SEAM(pb + 5);
        if (EN(8) && IN(pb + 6)) {
            { unsigned char* w = WSP; pg8::Gemm g{(const bf16_t*)(w + WS_QA), P_WL(w, l) + W_Q, T, NQ, 1024, 1024}; pg8::StaticOrder S; S.init(T, NQ, F.G, F.bid); pg8::EpiBf16<0> E{(bf16_t*)(w + WS_QRAW), NQ, nullptr, 0, 0};
              pg8::gemm_phase<pg8::EpiBf16<0>, pg8::StaticOrder>(F.lds, g, S, E, nullptr); }
            __syncthreads();
            { unsigned char* w = WSP; pg8::Gemm g{(const bf16_t*)(w + WS_KVA), P_WL(w, l) + W_KV, T, NKV, 512, 512}; pg8::StaticOrder S; S.init(T, NKV, F.G, F.bid); pg8::EpiBf16<0> E{(bf16_t*)(w + WS_KVRAW), NKV, nullptr, 0, 0};
              pg8::gemm_phase<pg8::EpiBf16<0>, pg8::StaticOrder>(F.lds, g, S, E, nullptr); }
        }
        SEAM(pb + 6);
        if (EN(9) && IN(pb + 7)) { for (int rp = 0; rp < REP(8); ++rp) qkv_final_phase(opq(F), opq_ptr(ws), l, need_ctx); for (int rp = 0; rp < REP(9); ++rp) scan_prep_phase(opq(F), opq_ptr(ws)); }
        SEAM(pb + 7);
        if (EN(10) && IN(pb + 8)) for (int rp = 0; rp < REP(10); ++rp) mixer_phase(F, ws, l + 4 * rp, need_ctx, (char*)lds);
        SEAM(pb + 8);
        if (EN(11) && IN(pb + 9)) { for (int rp = 0; rp < REP(8); ++rp) rwkv_out_phase(opq(F), opq_ptr(ws), l, need_ctx); hyena_out_phase(opq(F), opq_ptr(ws), need_ctx); }
        SEAM(pb + 9);
        if (EN(12) && IN(pb + 10)) {
            { unsigned char* w = WSP; pg8::Gemm g{P_OBUF(w), P_WL(w, l) + W_OUT, T, DM, DM, DM}; pg8::StaticOrderX S; S.init(T, DM, F.G, F.bid); pg8::EpiResid E{P_XS(w), P_MODX(w, l) + 5 * DM, P_MODC(w, l) + 5 * DM, 1.0f, nullptr};
              pg8::gemm_phase<pg8::EpiResid, pg8::StaticOrderX>(F.lds, g, S, E, nullptr); }
            if (need_ctx) { __syncthreads();
              if (F.bid < 256) { unsigned char* w = WSP; const int ks = F.bid >> 4, ksz = DM / 16; pg8::Gemm g{P_OBUF(w) + ks * ksz, P_WL(w, l) + W_OUT + ks * ksz, NCTX, DM, ksz, DM}; pg8::OneUnit S{F.bid & 15};
                  pg8::EpiF32 E{(float*)(w + WS_SLAB) + (size_t)ks * NCTX * DM, DM, nullptr};
                  pg8::gemm_phase<pg8::EpiF32, pg8::OneUnit>(F.lds, g, S, E, nullptr); } }
        }
        SEAM(pb + 10);
        if (EN(13) && IN(pb + 11)) for (int rp = 0; rp < REP(2); ++rp) { unsigned char* w = WSP; norm_phase(opq(F), P_XS(w), IN_(9) + l * DM, P_MODX(w, l), P_MODC(w, l), 6, 7, P_ABUF(w), need_ctx ? (const float*)(w + WS_SLAB) : nullptr, P_MODC(w, l) + 5 * DM, 1.0f); }
        SEAM(pb + 11);
        if (EN(14) && IN(pb + 12)) { if (need_ctx) { unsigned char* w = WSP; pg8::Gemm g{P_ABUF(w), P_WL(w, l) + W_G2, T, 2 * FF, DM, DM}; pg8::StaticOrder S; S.init(T, 2 * FF, F.G, F.bid); pg8::EpiSwiGLU E{P_HBUF(w), FF};
            pg8::gemm_phase<pg8::EpiSwiGLU, pg8::StaticOrder>(F.lds, g, S, E, nullptr);
            hyena_taps_tail(F, ws, l + 1, 416, 640); }       else { unsigned char* w = WSP; pg8::Gemm g{P_ABUF(w), P_WL(w, l) + W_G2, T, 2 * FF, DM, DM}; pg8::StaticOrderX S; S.init(T, 2 * FF, F.G, F.bid); pg8::EpiSwiGLU E{P_HBUF(w), FF};
            pg8::gemm_phase<pg8::EpiSwiGLU, pg8::StaticOrderX>(F.lds, g, S, E, nullptr); } }
        SEAM(pb + 12);
        if (EN(15) && IN(pb + 13)) {
            { unsigned char* w = WSP; pg8::Gemm g{P_HBUF(w), P_WL(w, l) + W_D2, T, DM, FF, FF}; pg8::StaticOrderX S; S.init(T, DM, F.G, F.bid); pg8::EpiResid E{P_XS(w), P_MODX(w, l) + 8 * DM, P_MODC(w, l) + 8 * DM, 0.5f, l == NL - 1 ? a.out : nullptr};
              pg8::gemm_phase<pg8::EpiResid, pg8::StaticOrderX>(F.lds, g, S, E, nullptr); }
            if (need_ctx) { __syncthreads();
              if (F.bid < 256) { unsigned char* w = WSP; const int ks = F.bid >> 4, ksz = FF / 16; pg8::Gemm g{P_HBUF(w) + ks * ksz, P_WL(w, l) + W_D2 + ks * ksz, NCTX, DM, ksz, FF}; pg8::OneUnit S{F.bid & 15};
                  pg8::EpiF32 E{(float*)(w + WS_SLAB) + (size_t)ks * NCTX * DM, DM, nullptr};
                  pg8::gemm_phase<pg8::EpiF32, pg8::OneUnit>(F.lds, g, S, E, nullptr); } }
        }
        SEAM(pb + 13);
    }
#undef IN
#undef SEAM
}

#ifndef MK_LAUNCHES
#define MK_LAUNCHES 1
#endif
extern "C" void kernel_launch(void* const* d_in, const int* in_sizes, int n_in, void* d_out, int out_size, void* d_ws, size_t ws_size, hipStream_t stream) {
    static int grid = 0;
    if (grid == 0) {
        if (n_in != 46 || in_sizes[0] != SEQ * DM || out_size != SEQ * DM || ws_size < WS_END) {
            fprintf(stderr, "kernel_launch: shape mismatch: n_in %d in0 %d out %d ws %zu (need %zu); nothing launched\n", n_in, n_in > 0 ? in_sizes[0] : -1, out_size, ws_size, (size_t)WS_END); grid = -1; return; }
        int dev = 0, cus = 0, per_cu = 0;
        if (hipGetDevice(&dev) != hipSuccess || hipDeviceGetAttribute(&cus, hipDeviceAttributeMultiprocessorCount, dev) != hipSuccess) { fprintf(stderr, "kernel_launch: device query failed\n"); grid = -1; return; }
        if (hipFuncSetAttribute((const void*)mk_fwd, hipFuncAttributeMaxDynamicSharedMemorySize, LDS_BYTES) != hipSuccess) { fprintf(stderr, "kernel_launch: hipFuncSetAttribute failed\n"); grid = -1; return; }
        if (hipOccupancyMaxActiveBlocksPerMultiprocessor(&per_cu, (const void*)mk_fwd, 512, LDS_BYTES) != hipSuccess || per_cu < 1) fprintf(stderr, "kernel_launch: note: occupancy query reports %d blocks per CU\n", per_cu);
        (void)hipGetLastError();
        grid = cus;
        if (cus != 256) { fprintf(stderr, "kernel_launch: built for 256 CUs (split-K of the context panel, hyena scratch), found %d; nothing launched\n", cus); grid = -1; return; }
    }
    if (grid < 0) return;
    if (hipMemsetAsync((char*)d_ws + WS_CTL, 0, CTL_BYTES, stream) != hipSuccess) { fprintf(stderr, "kernel_launch: memset failed\n"); return; }
    Args a{};
    for (int i = 0; i < 46; ++i) a.in[i] = (const float*)d_in[i];
    a.out = (float*)d_out; a.ws = (unsigned char*)d_ws;
    a.ph_lo = 0; a.ph_hi = NPH;
    hipLaunchKernelGGL(mk_fwd, dim3(grid), dim3(512), LDS_BYTES, stream, a);
    const hipError_t le = hipPeekAtLastError();
    if (le != hipSuccess) fprintf(stderr, "kernel_launch: launch failed: %s\n", hipGetErrorName(le));
}
```

```cpp
#include <hip/hip_runtime.h>
#include <stdint.h>
#include <cstdio>

#define LAS __attribute__((address_space(3)))
#define CAS __attribute__((address_space(4)))
typedef unsigned short bf16_t;
typedef float f32x4 __attribute__((ext_vector_type(4)));
typedef float f32x2 __attribute__((ext_vector_type(2)));
typedef unsigned u32x4 __attribute__((ext_vector_type(4)));
typedef unsigned u32x2 __attribute__((ext_vector_type(2)));

constexpr int T = 8448, NCTX = 256, SEQ = 8192, DM = 4096, FF = 6144, NL = 4;
constexpr int A_W = 1280, A_IN = 4160, B_IN = 3840, C_IN = 1600, NHA = 20;
constexpr int PXW = 9728, PXA = 0, PXB = 4160, PXC = 8000;
constexpr int NQ = 2304, NKV = 3072, NHC = 12;
constexpr int NMOD = 9 * DM;
constexpr float NORM_EPS = 1e-6f, GN_EPS = 64e-5f;

constexpr size_t MiB = 1u << 20;
constexpr size_t al(size_t x) { return (x + MiB - 1) / MiB * MiB; }
constexpr size_t WS_CTL = 0, CTL_BYTES = MiB;
constexpr size_t WS_XS = WS_CTL + CTL_BYTES;
constexpr size_t WS_ABUF = WS_XS + al((size_t)T * DM * 4);
constexpr size_t WS_HBUF = WS_ABUF + al((size_t)T * DM * 2);
constexpr size_t WS_OBUF = WS_HBUF + al((size_t)T * FF * 2);
constexpr size_t WS_PX = WS_OBUF + al((size_t)T * DM * 2);
constexpr size_t WS_MOD = WS_PX + al((size_t)T * PXW * 4);
constexpr size_t WS_HP = WS_MOD + al((size_t)NL * 2 * NMOD * 4);
constexpr size_t WS_SS = WS_HP + MiB;
constexpr size_t WS_SD = WS_SS + al((size_t)NHA * T * 192 * 4);
constexpr size_t WS_WLR = WS_SD + al((size_t)NHA * 2 * T * 192 * 4);
constexpr size_t WS_G = WS_WLR + al((size_t)NL * A_W * 448 * 2);
constexpr size_t WS_Y = WS_G + al((size_t)T * A_W * 4);
constexpr size_t WS_QA = WS_Y + al((size_t)2 * T * A_W * 4);
constexpr size_t WS_KVA = WS_QA + al((size_t)T * 1024 * 2);
constexpr size_t WS_KPE = WS_KVA + al((size_t)T * 512 * 2);
constexpr size_t WS_QRAW = WS_KPE + al((size_t)T * 64 * 2);
constexpr size_t WS_KVRAW = WS_QRAW + al((size_t)T * NQ * 2);
constexpr size_t WS_QF = WS_KVRAW + al((size_t)T * NKV * 2);
constexpr size_t WS_KF = WS_QF + al((size_t)T * NQ * 2);
constexpr size_t WS_H3 = WS_KF + al((size_t)T * NQ * 2);
constexpr size_t WS_HSCR = WS_H3 + al((size_t)NL * T * 64 * 4);
constexpr size_t WS_FR = WS_HSCR + al((size_t)640 * 16384 * 8 + 640 * 8);
constexpr size_t WS_GT = WS_FR + al((size_t)40 * 528 * (14 * 1024));
constexpr size_t WS_X0T = WS_GT + al((size_t)1280 * T * 4);
constexpr size_t WS_SLAB = WS_FR;
constexpr size_t WS_WB = WS_X0T + al((size_t)1280 * T * 4);
constexpr size_t W_G1 = 0, W_D1 = W_G1 + (size_t)2 * FF * DM, W_IN = W_D1 + (size_t)DM * FF, W_OUT = W_IN + (size_t)PXW * DM, W_G2 = W_OUT + (size_t)DM * DM,
                 W_D2 = W_G2 + (size_t)2 * FF * DM, W_Q = W_D2 + (size_t)DM * FF, W_KV = W_Q + (size_t)NQ * 1024, W_LAYER = W_KV + (size_t)NKV * 512;
constexpr size_t WS_END = WS_WB + al(W_LAYER * NL * 2);
constexpr int CW_BAR = 4096;
constexpr int CW_QUEUE = 8192;

constexpr int LDS_MISC = 143360, LDS_BYTES = 147456;

__device__ __forceinline__ float wave_sum(float v) {
#pragma unroll
    for (int o = 1; o < 64; o <<= 1) v += __shfl_xor(v, o);
    return v;
}
typedef __bf16 bf16x2_t __attribute__((ext_vector_type(2)));
__device__ __forceinline__ unsigned cvt_pk_bf16(float lo, float hi) { const f32x2 v = {lo, hi}; return __builtin_bit_cast(unsigned, __builtin_convertvector(v, bf16x2_t)); }
__device__ __forceinline__ float bf2f(unsigned short b) { return __uint_as_float(((unsigned)b) << 16); }
__device__ __forceinline__ float sigmoidf_(float x) { return 1.0f / (1.0f + __expf(-x)); }
__device__ __forceinline__ float siluf_(float x) { return x / (1.0f + __expf(-x)); }
__device__ __forceinline__ bool has_left(int tau) { return tau != 0 && tau != NCTX; }
__device__ __forceinline__ bool has_right(int tau) { return tau != NCTX - 1 && tau != T - 1; }

struct Args { const float* in[46]; float* out; unsigned char* ws; int ph_lo, ph_hi; };
struct Frame { LAS unsigned char* lds; volatile LAS unsigned* MISC; int tid, lane, wave, bid, G; };
constexpr int LDS_PTAB = LDS_MISC + 2048;
__device__ __forceinline__ const float* inp(const Frame& F, int i) {
    const volatile LAS unsigned* p = (const volatile LAS unsigned*)(F.lds + LDS_PTAB) + 2 * i;
    const unsigned lo = __builtin_amdgcn_readfirstlane(p[0]), hi = __builtin_amdgcn_readfirstlane(p[1]);
    return (const float*)(((unsigned long long)hi << 32) | lo);
}
#define IN_(i) inp(F, (i))
__device__ __forceinline__ Frame opq(const Frame& F) { Frame G = F; asm volatile("" : "+v"(G.tid), "+s"(G.wave), "+s"(G.bid)); G.lane = G.tid & 63; return G; }
__device__ __forceinline__ unsigned char* opq_ptr(unsigned char* p) { asm volatile("" : "+s"(p)); return p; }
#ifndef MK_REP
#define MK_REP 0
#endif
#ifndef MK_ONLYRP
#define MK_ONLYRP 0
#endif
#define REP(x) (1 + (((MK_REP) >> (x)) & 1))
#define XB_TMO      128
#define XB_XCNT(j)  (256  + 64 * (j))
#define XB_XSUB(j)  (1280 + 64 * (j))
#define XB_XGEN(j)  (2304 + 64 * (j))
#define XB_TOP      3328
#define XB_TOPGEN   3392
#define XCD_BAR_WORDS 3456
#define XB_SPIN_CAP (1u << 18)

__device__ __forceinline__ unsigned xb_ld(unsigned* p)              { return __hip_atomic_load(p, __ATOMIC_RELAXED, __HIP_MEMORY_SCOPE_AGENT); }
__device__ __forceinline__ unsigned xb_add(unsigned* p, unsigned v) { return __hip_atomic_fetch_add(p, v, __ATOMIC_RELAXED, __HIP_MEMORY_SCOPE_AGENT); }
__device__ __forceinline__ unsigned xb_xcc_id() { return (unsigned)__builtin_amdgcn_s_getreg((3 << 11) | 20) & 0xFu; }
#define XB_SPIN(cond, bar) do { unsigned _sp = 0; while (cond) { __builtin_amdgcn_s_sleep(1); \
    if ((++_sp & 255u) == 0u) { if (xb_ld(&(bar)[XB_TMO])) break; if (_sp > XB_SPIN_CAP) { atomicAdd(&(bar)[XB_TMO], 1u); break; } } } } while (0)

struct XcdBarrier {
    unsigned* bar; unsigned x;
    volatile LAS unsigned* st;
};

__device__ __forceinline__ XcdBarrier xcd_barrier_post(unsigned* bar, volatile LAS unsigned* st) {
    XcdBarrier b; b.bar = bar; b.x = xb_xcc_id(); b.st = st;
    if (threadIdx.x == 0) (void)xb_add(&bar[XB_XCNT(b.x)], 1u);
    return b;
}
__device__ __forceinline__ void xcd_barrier_complete(unsigned* bar, unsigned x, unsigned& nloc, unsigned& nx) {
    const unsigned G = gridDim.x * gridDim.y * gridDim.z;
    unsigned sum, cnt, mine, sp = 0u;
    for (;;) {
        sum = 0u; cnt = 0u; mine = 0u;
#pragma unroll
        for (unsigned j = 0; j < 16; ++j) { const unsigned c = xb_ld(&bar[XB_XCNT(j)]); sum += c; cnt += (c > 0u) ? 1u : 0u; mine = (j == x) ? c : mine; }
        if (sum == G) break;
        __builtin_amdgcn_s_sleep(1);
        if ((++sp & 255u) == 0u) { if (xb_ld(&bar[XB_TMO])) break; if (sp > XB_SPIN_CAP) { atomicAdd(&bar[XB_TMO], 1u); break; } }
    }
    nloc = mine > 0u ? mine : 1u; nx = cnt > 0u ? cnt : 1u;
}

__device__ __forceinline__ void xcd_barrier(const XcdBarrier& b) {
    asm volatile("s_waitcnt vmcnt(0)" ::: "memory");
    __syncthreads();
    if (threadIdx.x == 0) {
        unsigned* bar = b.bar;
        __builtin_amdgcn_s_waitcnt(0);
        unsigned nloc = b.st[0], nx = b.st[1];
        if (nloc == 0u) { xcd_barrier_complete(bar, b.x, nloc, nx); b.st[0] = nloc; b.st[1] = nx; }
        const unsigned old = xb_add(&bar[XB_XSUB(b.x)], 1u);
        const unsigned gen = old / nloc;
        if (old + 1u == (gen + 1u) * nloc) {
            __builtin_amdgcn_fence(__ATOMIC_RELEASE, "agent");
            asm volatile("s_waitcnt vmcnt(0)" ::: "memory");
            const unsigned og = xb_add(&bar[XB_TOP], 1u);
            const unsigned tg = og / nx;
            if (og + 1u == (tg + 1u) * nx) xb_add(&bar[XB_TOPGEN], 1u);
            else XB_SPIN(xb_ld(&bar[XB_TOPGEN]) == tg, bar);
            __builtin_amdgcn_fence(__ATOMIC_ACQUIRE, "agent");
            xb_add(&bar[XB_XGEN(b.x)], 1u);
            asm volatile("s_waitcnt vmcnt(0)" ::: "memory");
        } else {
            XB_SPIN(xb_ld(&bar[XB_XGEN(b.x)]) == gen, bar);
            __builtin_amdgcn_fence(__ATOMIC_ACQUIRE, "agent");
            asm volatile("s_waitcnt vmcnt(0)" ::: "memory");
        }
    }
    __syncthreads();
}
namespace pg8 {
#define PG8_LAS __attribute__((address_space(3)))
typedef unsigned short bf16_t;
typedef short bf16x8 __attribute__((ext_vector_type(8)));
typedef float f32x4 __attribute__((ext_vector_type(4)));
typedef unsigned u32x4 __attribute__((ext_vector_type(4)));
constexpr int BM = 256, BK = 64, HALF = 128, HTB = HALF * BK * 2  , STAGE_BYTES = 8 * HTB, NXCD = 8, WGM = 4;

__host__ __device__ __forceinline__ int lds_byte(int r, int c) { const int st = (r >> 4) * 2 + (c >> 5), rr = r & 15, cc = c & 31, ob = rr * 64 + cc * 2; return st * 1024 + (ob ^ (((ob >> 9) & 1) << 5)); }
__host__ __device__ __forceinline__ void stage_rc(int b, int& R, int& C) { const int st = b / 1024, sb = b % 1024, swz = sb ^ (((sb >> 9) & 1) << 5); R = (st >> 1) * 16 + swz / 64; C = (st & 1) * 32 + (swz % 64) / 2; }
__host__ __device__ __forceinline__ int perm32(int rho) { const int n = rho >> 4, i = rho & 15; return 8 * (i >> 2) + 4 * n + (i & 3); }

struct Unit { int pm, pn; };
struct Gemm { const bf16_t* A; const bf16_t* Bt; int M, N, K, ld; };

struct StaticOrder {
    int nM, nN, nwg, G, c;
    __host__ __device__ void init(int M, int N, int G_, int c_) { nM = M / BM; nN = N / BM; nwg = nM * nN; G = G_; c = c_; }
    __host__ __device__ bool next(int i, Unit& u) const {
        const long L = (long)i * G + c; if (L >= nwg) return false;
        int wgid = (int)L; { const int q = nwg / NXCD, r = nwg % NXCD, xcd = wgid % NXCD, off = wgid / NXCD; wgid = (xcd < r ? xcd * (q + 1) : r * (q + 1) + (xcd - r) * q) + off; }
        const int nig = WGM * nN, gid = wgid / nig, fm = gid * WGM, gsz = (nM - fm) < WGM ? (nM - fm) : WGM;
        u.pm = fm + ((wgid % nig) % gsz); u.pn = (wgid % nig) / gsz; return true;
    }
    __device__ __forceinline__ void a_ready(const Unit&) const {}
    __device__ __forceinline__ void done(const Unit&) const {}
};
struct CountedOrder : StaticOrder {
    const unsigned* ready; unsigned need; unsigned* tmo;
    __device__ __forceinline__ void a_ready(const Unit& u) const {
        if (threadIdx.x < 64) {
            const unsigned long long t0 = __builtin_amdgcn_s_memrealtime(); unsigned polls = 0;
            while ((unsigned)__builtin_amdgcn_readfirstlane(__hip_atomic_load(ready + 64 * u.pm, __ATOMIC_RELAXED, __HIP_MEMORY_SCOPE_AGENT)) < need) {
                if ((++polls & 255u) == 0u && __builtin_amdgcn_readfirstlane(__hip_atomic_load(tmo, __ATOMIC_RELAXED, __HIP_MEMORY_SCOPE_AGENT)) != 0u) break;
                if (__builtin_amdgcn_s_memrealtime() - t0 > 2000000ull) {
                    if (threadIdx.x == 0) { unsigned expect = 0u; __hip_atomic_compare_exchange_strong(tmo + 1, &expect, 0x600u | (unsigned)(u.pm & 0xff), __ATOMIC_RELAXED, __ATOMIC_RELAXED, __HIP_MEMORY_SCOPE_AGENT); __hip_atomic_store(tmo, 1u, __ATOMIC_RELAXED, __HIP_MEMORY_SCOPE_AGENT); }
                    break; }
                __builtin_amdgcn_s_sleep(2); }
            __builtin_amdgcn_fence(__ATOMIC_ACQUIRE, "agent");
            asm volatile("s_waitcnt vmcnt(0)" ::: "memory");
        }
#if !defined(BROKEN_HOOK_NO_BARRIER)
        asm volatile("" ::: "memory"); __builtin_amdgcn_s_barrier(); asm volatile("" ::: "memory");
#endif
    }
};

__device__ __forceinline__ unsigned cvt_pk_bf16(float lo, float hi) { unsigned r; asm volatile("v_cvt_pk_bf16_f32 %0, %1, %2" : "=v"(r) : "v"(lo), "v"(hi)); return r; }
typedef float f32x2 __attribute__((ext_vector_type(2)));
__device__ __forceinline__ f32x2 gelu_pk(f32x2 v) {
    const f32x2 av = __builtin_elementwise_abs(v), d = av * 0.2316418882f + 1.0f;
    f32x2 t; t.x = __builtin_amdgcn_rcpf(d.x); t.y = __builtin_amdgcn_rcpf(d.y);
    f32x2 q = t * 0.5307027145f + (-0.7265760135f); q = q * t + 0.7107068705f; q = q * t + (-0.142248368f); q = q * t + 0.127414796f; q = q * t;
    const f32x2 s = (v * v) * (-0.72134752044f);
    f32x2 e; e.x = __builtin_amdgcn_exp2f(s.x); e.y = __builtin_amdgcn_exp2f(s.y);
    const f32x2 m = v * (q * e), r = v - m;
    f32x2 o; o.x = v.x < 0.f ? m.x : r.x; o.y = v.y < 0.f ? m.y : r.y; return o;
}

struct EpiF32 {
    static constexpr bool PERM = false, AFTER_DRAIN = false;
    float* C; int ldc; const float* bias;
    __device__ __forceinline__ void operator()(const f32x4 (&acc)[2][2][4][2], const Unit& u, int wr, int wc, int fr, int fq) const {
        const int row0 = u.pm * BM + wr * 64 + fr, col0 = u.pn * BM + wc * 32 + 4 * fq;
        f32x4 bv[2][2];
#pragma unroll
        for (int bj = 0; bj < 2; ++bj)
#pragma unroll
            for (int n = 0; n < 2; ++n) bv[bj][n] = bias ? *(const f32x4*)(bias + col0 + bj * HALF + n * 16) : (f32x4){0.f, 0.f, 0.f, 0.f};
#pragma unroll
        for (int ai = 0; ai < 2; ++ai)
#pragma unroll
            for (int m = 0; m < 4; ++m) { float* rowp = C + (size_t)(row0 + ai * HALF + m * 16) * ldc + col0;
#pragma unroll
                for (int bj = 0; bj < 2; ++bj)
#pragma unroll
                    for (int n = 0; n < 2; ++n) *(f32x4*)(rowp + bj * HALF + n * 16) = acc[ai][bj][m][n] + bv[bj][n]; }
    }
};
template <int ACT  > struct EpiBf16 {
    static constexpr bool PERM = true, AFTER_DRAIN = false;
    bf16_t* O; int ldc; const float* bias; int split_cols; size_t split_stride;
    __device__ __forceinline__ void operator()(const f32x4 (&acc)[2][2][4][2], const Unit& u, int wr, int wc, int fr, int fq) const {
        const int row0 = u.pm * BM + wr * 64 + fr; int colt = u.pn * BM; bf16_t* base = O;
        if (split_cols) { const int t = colt / split_cols; base += (size_t)t * split_stride; colt -= t * split_cols; }
        const int col0 = colt + wc * 32 + 8 * fq, bcol0 = u.pn * BM + wc * 32 + 8 * fq;
        f32x4 bv[2][2];
#pragma unroll
        for (int bj = 0; bj < 2; ++bj)
#pragma unroll
            for (int n = 0; n < 2; ++n) bv[bj][n] = bias ? *(const f32x4*)(bias + bcol0 + bj * HALF + 4 * n) : (f32x4){0.f, 0.f, 0.f, 0.f};
#pragma unroll
        for (int ai = 0; ai < 2; ++ai)
#pragma unroll
            for (int m = 0; m < 4; ++m) { bf16_t* rowp = base + (size_t)(row0 + ai * HALF + m * 16) * ldc + col0;
#pragma unroll
                for (int bj = 0; bj < 2; ++bj) { f32x4 v0 = acc[ai][bj][m][0] + bv[bj][0], v1 = acc[ai][bj][m][1] + bv[bj][1];
                    if (ACT == 1) { f32x2 a = gelu_pk((f32x2){v0[0], v0[1]}), b = gelu_pk((f32x2){v0[2], v0[3]}), c = gelu_pk((f32x2){v1[0], v1[1]}), d = gelu_pk((f32x2){v1[2], v1[3]});
                        v0 = (f32x4){a.x, a.y, b.x, b.y}; v1 = (f32x4){c.x, c.y, d.x, d.y}; }
                    if (ACT == 2) {
#pragma unroll
                        for (int j = 0; j < 4; ++j) { v0[j] = 0.5f * v0[j] * (1.0f + erff(v0[j] * 0.70710678f)); v1[j] = 0.5f * v1[j] * (1.0f + erff(v1[j] * 0.70710678f)); } }
                    u32x4 w; w.x = cvt_pk_bf16(v0[0], v0[1]); w.y = cvt_pk_bf16(v0[2], v0[3]); w.z = cvt_pk_bf16(v1[0], v1[1]); w.w = cvt_pk_bf16(v1[2], v1[3]);
                    *(u32x4*)(rowp + bj * HALF) = w; } }
    }
};
}
namespace pg8 {
struct EpiSwiGLU {
    static constexpr bool PERM = true, AFTER_DRAIN = false;
    bf16_t* O; int ldc;
    __device__ __forceinline__ void operator()(const f32x4 (&acc)[2][2][4][2], const Unit& u, int wr, int wc, int fr, int fq) const {
        const int row0 = u.pm * BM + wr * 64 + fr, col0 = u.pn * HALF + wc * 32 + 8 * fq;
#pragma unroll
        for (int ai = 0; ai < 2; ++ai)
#pragma unroll
            for (int m = 0; m < 4; ++m) { bf16_t* rowp = O + (size_t)(row0 + ai * HALF + m * 16) * ldc + col0;
                float h[8];
#pragma unroll
                for (int n = 0; n < 2; ++n)
#pragma unroll
                    for (int j = 0; j < 4; ++j) { const float g = acc[ai][0][m][n][j], up = acc[ai][1][m][n][j]; h[n * 4 + j] = g * __builtin_amdgcn_rcpf(1.0f + __builtin_amdgcn_exp2f(-1.4426950408889634f * g)) * up; }
                u32x4 w; w.x = cvt_pk_bf16(h[0], h[1]); w.y = cvt_pk_bf16(h[2], h[3]); w.z = cvt_pk_bf16(h[4], h[5]); w.w = cvt_pk_bf16(h[6], h[7]);
                *(u32x4*)rowp = w; }
    }
};
struct EpiResid {
    static constexpr bool PERM = false, AFTER_DRAIN = false;
    float* X; const float* gate_x; const float* gate_c; float fac; float* out_x;
    __device__ __forceinline__ void operator()(const f32x4 (&acc)[2][2][4][2], const Unit& u, int wr, int wc, int fr, int fq) const {
        const int row0 = u.pm * BM + wr * 64 + fr, col0 = u.pn * BM + wc * 32 + 4 * fq;
        const float* gv = (u.pm == 0) ? gate_c : gate_x;
        float* dst = (u.pm != 0 && out_x) ? out_x - (size_t)256 * 4096 : X;
        f32x4 gg[2][2];
#pragma unroll
        for (int bj = 0; bj < 2; ++bj)
#pragma unroll
            for (int n = 0; n < 2; ++n) gg[bj][n] = *(const f32x4*)(gv + col0 + bj * HALF + n * 16) * fac;
#pragma unroll
        for (int ai = 0; ai < 2; ++ai)
#pragma unroll
            for (int m = 0; m < 4; ++m) { const size_t off = (size_t)(row0 + ai * HALF + m * 16) * 4096 + col0;
#pragma unroll
                for (int bj = 0; bj < 2; ++bj)
#pragma unroll
                    for (int n = 0; n < 2; ++n) { const f32x4 b = *(const f32x4*)(X + off + bj * HALF + n * 16); *(f32x4*)(dst + off + bj * HALF + n * 16) = b + gg[bj][n] * acc[ai][bj][m][n]; } }
    }
};
struct OneUnit { int pn;
    __host__ __device__ bool next(int i, Unit& u) const { u.pm = 0; u.pn = pn; return i == 0; }
    __device__ __forceinline__ void a_ready(const Unit&) const {}
    __device__ __forceinline__ void done(const Unit&) const {}
};
struct StaticOrderX { StaticOrder b;
    __host__ __device__ void init(int M, int N, int G_, int c_) { b.init(M - BM, N, G_, c_); }
    __host__ __device__ bool next(int i, Unit& u) const { const bool ok = b.next(i, u); u.pm += 1; return ok; }
    __device__ __forceinline__ void a_ready(const Unit&) const {}
    __device__ __forceinline__ void done(const Unit&) const {}
};
}
namespace pg8 {
template <class Epi, class Sched, bool STAMP = false>
__device__ __forceinline__ void gemm_phase(PG8_LAS unsigned char* lds, const Gemm g, const Sched& S, const Epi& E, unsigned long long* stamps) {
    int tid_ = threadIdx.x; asm volatile("" : "+v"(tid_));
    const int tid = tid_, wid = __builtin_amdgcn_readfirstlane(tid >> 6), lane = tid & 63, wr = wid >> 2, wc = wid & 3, fr = lane & 15, fq = lane >> 4;
    const int K = g.ld, nt = g.K / BK;
    int ts_lo = 0, ts_hi = 0, nts = 0; const unsigned long long rt_entry = STAMP ? (unsigned long long)wall_clock64() : 0ull;
#define PG8_STAMP() do { if (STAMP && wid == 0 && nts < 64) { const unsigned long long _c = (unsigned long long)clock64(); \
        ts_lo = (lane == nts) ? (int)(unsigned)_c : ts_lo; ts_hi = (lane == nts) ? (int)(unsigned)(_c >> 32) : ts_hi; ++nts; } } while (0)
    PG8_STAMP();
    unsigned voffA[2], voffB[2];
#pragma unroll
    for (int i = 0; i < 2; ++i) { int R, C; stage_rc(tid * 16 + i * 8192, R, C); const int Rb = Epi::PERM ? ((R & ~31) + perm32(R & 31)) : R;
        voffA[i] = (unsigned)(R * K + C) * 2u; voffB[i] = (unsigned)(Rb * K + C) * 2u; }
    const size_t kstep = (size_t)(BK * 2);
    const size_t hstep = (size_t)HALF * K * 2;
    const size_t tstep = 2 * hstep;
    const unsigned ldsw = (unsigned)wid * 1024u;
    const int aoff = lds_byte(wr * 64 + fr, fq * 8), boff = lds_byte(wc * 32 + fr, fq * 8);
#define PG8_SA(b, h) (((b) * 2 + (h)) * HTB)
#define PG8_SB(b, h) ((4 + (b) * 2 + (h)) * HTB)
#define PG8_STAGE(bufoff, gbase, voff) do { _Pragma("unroll") for (int _i = 0; _i < 2; ++_i) \
        __builtin_amdgcn_global_load_lds((const unsigned*)((const char*)(gbase) + (voff)[_i]), (PG8_LAS unsigned*)(lds + (bufoff) + ldsw + _i * 8192), 16, 0, 0); } while (0)
#define PG8_LDA(dst, b, h) do { _Pragma("unroll") for (int m = 0; m < 4; ++m) _Pragma("unroll") for (int k = 0; k < 2; ++k) dst[m][k] = *(const PG8_LAS bf16x8*)(lds + PG8_SA(b, h) + aoff + m * 2048 + k * 1024); } while (0)
#define PG8_LDB(dst, b, h) do { _Pragma("unroll") for (int n = 0; n < 2; ++n) _Pragma("unroll") for (int k = 0; k < 2; ++k) dst[n][k] = *(const PG8_LAS bf16x8*)(lds + PG8_SB(b, h) + boff + n * 2048 + k * 1024); } while (0)
#define PG8_MMA(ai, bj, At, Bt) do { __builtin_amdgcn_s_setprio(1); _Pragma("unroll") for (int m = 0; m < 4; ++m) _Pragma("unroll") for (int n = 0; n < 2; ++n) _Pragma("unroll") for (int k = 0; k < 2; ++k) \
        acc[ai][bj][m][n] = __builtin_amdgcn_mfma_f32_16x16x32_bf16(Bt[n][k], At[m][k], acc[ai][bj][m][n], 0, 0, 0); __builtin_amdgcn_s_setprio(0); } while (0)
#define PG8_WAIT_V(n) asm volatile("s_waitcnt vmcnt(" #n ")" ::: "memory")
#define PG8_WAIT_L(n) asm volatile("s_waitcnt lgkmcnt(" #n ")" ::: "memory")
#define PG8_BAR __builtin_amdgcn_s_barrier()
#define PG8_SCHED __builtin_amdgcn_sched_barrier(0)
    Unit cur, nxt; int ui = 0;
    if (!S.next(0, cur)) return;
    f32x4 acc[2][2][4][2];
#pragma unroll
    for (int a = 0; a < 2; ++a)
#pragma unroll
        for (int b = 0; b < 2; ++b)
#pragma unroll
            for (int m = 0; m < 4; ++m)
#pragma unroll
                for (int n = 0; n < 2; ++n) acc[a][b][m][n] = (f32x4){0.f, 0.f, 0.f, 0.f};
    bf16x8 At[4][2], B0[2][2], B1[2][2];
    const char* cA = (const char*)g.A + (size_t)cur.pm * tstep; const char* cB = (const char*)g.Bt + (size_t)cur.pn * tstep;
    S.a_ready(cur);
    PG8_STAGE(PG8_SB(0, 0), cB, voffB); PG8_STAGE(PG8_SA(0, 0), cA, voffA); PG8_STAGE(PG8_SB(0, 1), cB + hstep, voffB); PG8_STAGE(PG8_SA(0, 1), cA + hstep, voffA);
    if (wr == 1) PG8_BAR;
    PG8_WAIT_V(4); PG8_BAR;
    PG8_STAGE(PG8_SB(1, 0), cB + kstep, voffB); PG8_STAGE(PG8_SA(1, 0), cA + kstep, voffA); PG8_STAGE(PG8_SB(1, 1), cB + hstep + kstep, voffB);
    PG8_WAIT_V(6); PG8_BAR;
    PG8_STAMP();
    for (;;) {
        const bool has_next = S.next(ui + 1, nxt);
        const char* nA = has_next ? (const char*)g.A + (size_t)nxt.pm * tstep : cA; const char* nB = has_next ? (const char*)g.Bt + (size_t)nxt.pn * tstep : cB;
        for (int t = 0; t < nt; t += 2) {
            const bool last = (t == nt - 2);
            const char* a1 = cA + (size_t)(t + 1) * kstep;
            const char* a2 = last ? nA : cA + (size_t)(t + 2) * kstep; const char* b2 = last ? nB : cB + (size_t)(t + 2) * kstep;
            const char* a3 = a2 + kstep; const char* b3 = b2 + kstep;
            if (last && has_next) S.a_ready(nxt);
            PG8_LDB(B0, 0, 0); PG8_SCHED; PG8_LDA(At, 0, 0); PG8_STAGE(PG8_SA(1, 1), a1 + hstep, voffA);
            PG8_WAIT_L(8); PG8_BAR; PG8_WAIT_L(0); PG8_MMA(0, 0, At, B0); PG8_BAR; PG8_SCHED;
            PG8_LDB(B1, 0, 1); PG8_STAGE(PG8_SB(0, 0), b2, voffB);
            PG8_BAR; PG8_WAIT_L(0); PG8_MMA(0, 1, At, B1); PG8_BAR;
            PG8_LDA(At, 0, 1); PG8_STAGE(PG8_SA(0, 0), a2, voffA);
            PG8_BAR; PG8_WAIT_L(0); PG8_MMA(1, 0, At, B0); PG8_BAR; PG8_SCHED;
            PG8_STAGE(PG8_SB(0, 1), b2 + hstep, voffB);
            PG8_WAIT_V(6); PG8_BAR; PG8_MMA(1, 1, At, B1); PG8_BAR;
            PG8_LDB(B0, 1, 0); PG8_SCHED; PG8_LDA(At, 1, 0); PG8_STAGE(PG8_SA(0, 1), a2 + hstep, voffA);
            PG8_WAIT_L(8); PG8_BAR; PG8_WAIT_L(0); PG8_MMA(0, 0, At, B0); PG8_BAR; PG8_SCHED;
            PG8_LDB(B1, 1, 1); PG8_STAGE(PG8_SB(1, 0), b3, voffB);
            PG8_BAR; PG8_WAIT_L(0); PG8_MMA(0, 1, At, B1); PG8_BAR;
            PG8_LDA(At, 1, 1); PG8_STAGE(PG8_SA(1, 0), a3, voffA);
            PG8_BAR; PG8_WAIT_L(0); PG8_MMA(1, 0, At, B0); PG8_BAR; PG8_SCHED;
            PG8_STAGE(PG8_SB(1, 1), b3 + hstep, voffB);
            PG8_WAIT_V(6); PG8_BAR; PG8_MMA(1, 1, At, B1); PG8_BAR;
        }
        PG8_STAMP();
        if constexpr (!Epi::AFTER_DRAIN) { E(acc, cur, wr, wc, fr, fq); S.done(cur); }
        PG8_STAMP();
        if (!has_next) break;
#pragma unroll
        for (int a = 0; a < 2; ++a)
#pragma unroll
            for (int b = 0; b < 2; ++b)
#pragma unroll
                for (int m = 0; m < 4; ++m)
#pragma unroll
                    for (int n = 0; n < 2; ++n) acc[a][b][m][n] = (f32x4){0.f, 0.f, 0.f, 0.f};
        cur = nxt; cA = nA; cB = nB; ++ui;
    }
    PG8_WAIT_V(0);
    if (wr == 0) PG8_BAR;
    PG8_BAR;
    if constexpr (Epi::AFTER_DRAIN) { E.fused(acc, cur, wr, wc, fr, fq, lds, wid, lane); S.done(cur); }
    PG8_STAMP();
    if (STAMP && wid == 0) { stamps[lane] = lane < nts ? (((unsigned long long)(unsigned)ts_hi << 32) | (unsigned)ts_lo) : 0ull;
        if (lane == 62) stamps[62] = rt_entry; if (lane == 63) stamps[63] = (unsigned long long)wall_clock64(); }
#undef PG8_STAMP
#undef PG8_SA
#undef PG8_SB
#undef PG8_STAGE
#undef PG8_LDA
#undef PG8_LDB
#undef PG8_MMA
#undef PG8_WAIT_V
#undef PG8_WAIT_L
#undef PG8_BAR
#undef PG8_SCHED
}
}
#define LDS_WAIT() asm volatile("s_waitcnt lgkmcnt(0)" ::: "memory")

__device__ __forceinline__ int map_row(int n, int mode) {
    if (mode == 1) { const int j = n < FF ? n : n - FF; return (j >> 7) * 256 + (n < FF ? 0 : 128) + (j & 127); }
    return n;
}
__device__ __forceinline__ void transpose_item(const float* __restrict__ W, int K, int N, bf16_t* WT, int mode, LAS float* scr, int item, int lane) {
    const int nblk = N / 32, kb = item / nblk, nb = item % nblk, k0 = 64 * kb, n0 = 32 * nb;
#pragma unroll 8
    for (int i = 0; i < 32; ++i) { const int kk = 2 * i + (lane >> 5); scr[kk * 33 + (lane & 31)] = W[(size_t)(k0 + kk) * N + n0 + (lane & 31)]; }
    LDS_WAIT(); asm volatile("" ::: "memory");
    const int c = lane & 7;
#pragma unroll
    for (int j = 0; j < 4; ++j) { const int n = (lane >> 3) + 8 * j; const LAS float* s = scr + (8 * c) * 33 + n;
        u32x4 o; o.x = cvt_pk_bf16(s[0 * 33], s[1 * 33]); o.y = cvt_pk_bf16(s[2 * 33], s[3 * 33]); o.z = cvt_pk_bf16(s[4 * 33], s[5 * 33]); o.w = cvt_pk_bf16(s[6 * 33], s[7 * 33]);
        *(u32x4*)(WT + (size_t)map_row(n0 + n, mode) * K + k0 + 8 * c) = o; }
    LDS_WAIT(); asm volatile("" ::: "memory");
}
constexpr int I_G = (DM / 64) * (2 * FF / 32), I_D = (FF / 64) * (DM / 32), I_IN = (DM / 64) * (9600 / 32), I_OUT = (DM / 64) * (DM / 32), I_Q = (1024 / 64) * (NQ / 32), I_KV = (512 / 64) * (NKV / 32);
constexpr int I_LAYER = 2 * I_G + 2 * I_D + I_IN + I_OUT + I_Q + I_KV;

__device__ __forceinline__ void phase0(const Frame& F, unsigned char* ws) {
    const int gw = F.bid * 8 + F.wave, NGW = F.G * 8;
    const size_t gt = (size_t)F.bid * 512 + F.tid, NGT = (size_t)F.G * 512;
    LAS float* scr = (LAS float*)(F.lds + F.wave * 8704);
    bf16_t* WB = (bf16_t*)(ws + WS_WB);
    for (int it = gw; it < NL * I_LAYER; it += NGW) {
        const int l = it / I_LAYER; int r = it - l * I_LAYER; bf16_t* wl = WB + (size_t)l * W_LAYER;
        if (r < I_G) { transpose_item(IN_(10) + (size_t)l * DM * 2 * FF, DM, 2 * FF, wl + W_G1, 1, scr, r, F.lane); continue; } r -= I_G;
        if (r < I_D) { transpose_item(IN_(11) + (size_t)l * FF * DM, FF, DM, wl + W_D1, 0, scr, r, F.lane); continue; } r -= I_D;
        if (r < I_G) { transpose_item(IN_(12) + (size_t)l * DM * 2 * FF, DM, 2 * FF, wl + W_G2, 1, scr, r, F.lane); continue; } r -= I_G;
        if (r < I_D) { transpose_item(IN_(13) + (size_t)l * FF * DM, FF, DM, wl + W_D2, 0, scr, r, F.lane); continue; } r -= I_D;
        if (r < I_IN) { transpose_item(IN_(14) + (size_t)l * DM * 9600, DM, 9600, wl + W_IN, 0, scr, r, F.lane); continue; } r -= I_IN;
        if (r < I_OUT) { transpose_item(IN_(15) + (size_t)l * DM * DM, DM, DM, wl + W_OUT, 0, scr, r, F.lane); continue; } r -= I_OUT;
        if (r < I_Q) { transpose_item(IN_(39) + (size_t)l * 1024 * NQ, 1024, NQ, wl + W_Q, 0, scr, r, F.lane); continue; } r -= I_Q;
        transpose_item(IN_(41) + (size_t)l * 512 * NKV, 512, NKV, wl + W_KV, 0, scr, r, F.lane);
    }
    for (size_t i = gt; i < (size_t)NL * 128 * 512; i += NGT) {
        const int l = (int)(i / (128 * 512)), rr = (int)((i / 512) % 128), c = (int)(i % 512);
        const int row = 9600 + rr;
        *(u32x4*)(WB + (size_t)l * W_LAYER + W_IN + (size_t)row * DM + c * 8) = (u32x4){0u, 0u, 0u, 0u};
    }
    { bf16_t* WLR = (bf16_t*)(ws + WS_WLR); const float* wu = IN_(18); const float* au = IN_(20); const float* gu = IN_(21);
      for (size_t i = gt; i < (size_t)NL * 448 * A_W; i += NGT) { const int l = (int)(i / (448 * A_W)), k = (int)((i / A_W) % 448), col = (int)(i % A_W);
          float v;
          if (k < 128) v = wu[(((size_t)l * 2 + (k >> 6)) * 64 + (k & 63)) * A_W + col];
          else if (k < 256) v = au[(((size_t)l * 2 + ((k - 128) >> 6)) * 64 + (k & 63)) * A_W + col];
          else v = gu[((size_t)l * 192 + (k - 256)) * A_W + col];
          WLR[((size_t)l * A_W + col) * 448 + k] = (bf16_t)(cvt_pk_bf16(v, v) & 0xffffu); } }
    { f32x4* xs = (f32x4*)(ws + WS_XS); const f32x4* cx = (const f32x4*)IN_(2); const f32x4* xx = (const f32x4*)IN_(0);
      for (size_t i = gt; i < (size_t)T * DM / 4; i += NGT) xs[i] = i < (size_t)NCTX * DM / 4 ? cx[i] : xx[i - (size_t)NCTX * DM / 4]; }
    { float* HP = (float*)(ws + WS_HP);
      for (int it = F.bid; it < NL * 16; it += F.G) { const int l = it >> 4, ch = it & 15, w = F.tid >> 8, j = F.tid & 255;
          const float* cv = w ? IN_(3) : IN_(1); const float* ad = IN_(4) + ((size_t)l * DM + ch * 256) * 256 + j; float s = 0.f;
          for (int i = 0; i < 256; ++i) s += siluf_(cv[ch * 256 + i]) * ad[(size_t)i * 256];
          HP[((l * 16 + ch) * 2 + w) * 256 + j] = s; } }
    { float* H3 = (float*)(ws + WS_H3);
      LAS float* zb = (LAS float*)(F.lds + 73728); LAS float* ha = zb + 8 * 36; LAS float* hb = ha + 8 * 64;
      for (int it = F.bid; it < NL * (T / 8); it += F.G) { const int l = it / (T / 8), pb = it % (T / 8);
          if (F.tid < 8 * 33) { const int p = F.tid / 33, i = F.tid % 33, P = pb * 8 + p; const int L = P < NCTX ? NCTX : SEQ, t = P < NCTX ? P : P - NCTX;
              float z;
              if (i == 0) z = (float)t / (float)(L - 1);
              else { const int b = (i - 1) & 15; const float fb = 1e-4f + (float)b * ((15.0f - 1e-4f) / 15.0f); const float rev2 = 2.0f * fb * (float)t / (float)L;
                  z = i <= 16 ? cospif(rev2) : -sinpif(rev2); }
              zb[p * 36 + i] = z; }
          __syncthreads();
          const int p = F.tid >> 6, j = F.tid & 63; const float fq = IN_(36)[l * 64 + j];
          { const float* w1 = IN_(29) + (size_t)l * 33 * 64 + j; float s = IN_(30)[l * 64 + j];
            for (int i = 0; i < 33; ++i) s += zb[p * 36 + i] * w1[i * 64];
            ha[p * 64 + j] = sinf(fq * s); }
          __syncthreads();
          { const float* w2 = IN_(31) + (size_t)l * 64 * 64 + j; float s = IN_(32)[l * 64 + j];
            for (int i = 0; i < 64; ++i) s += ha[p * 64 + i] * w2[i * 64];
            hb[p * 64 + j] = sinf(fq * s); }
          __syncthreads();
          { const float* w3 = IN_(33) + (size_t)l * 64 * 64 + j; float s = IN_(34)[l * 64 + j];
            for (int i = 0; i < 64; ++i) s += hb[p * 64 + i] * w3[i * 64];
            ((bf16_t*)H3)[((size_t)l * 64 + j) * T + pb * 8 + p] = (bf16_t)(cvt_pk_bf16(sinf(fq * s), 0.f) & 0xffffu); }
          __syncthreads(); } }
}
__device__ __forceinline__ void phase_mod(const Frame& F, unsigned char* ws) {
    const float* HP = (const float*)(ws + WS_HP); float* MOD = (float*)(ws + WS_MOD);
    LAS float* hs = (LAS float*)F.lds;
    for (int it = F.bid; it < NL * (NMOD / 512); it += F.G) { const int l = it / (NMOD / 512), nb = it % (NMOD / 512);
        { const int w = F.tid >> 8, j = F.tid & 255; float s = 0.f;
          for (int ch = 0; ch < 16; ++ch) s += HP[((l * 16 + ch) * 2 + w) * 256 + j];
          hs[w * 256 + j] = s; }
        __syncthreads();
        const int n = nb * 512 + F.tid; const float* au = IN_(5) + (size_t)l * 256 * NMOD + n; float s0 = IN_(6)[(size_t)l * NMOD + n], s1 = s0;
        for (int j = 0; j < 256; ++j) { const float u = au[(size_t)j * NMOD]; s0 += hs[j] * u; s1 += hs[256 + j] * u; }
        MOD[((size_t)l * 2 + 0) * NMOD + n] = s0; MOD[((size_t)l * 2 + 1) * NMOD + n] = s1;
        __syncthreads(); }
}
__device__ __forceinline__ void norm_phase(const Frame& F, float* XS, const float* __restrict__ gain, const float* modx, const float* modc, int ish, int isc, bf16_t* out, const float* slab, const float* sgate, float sfac) {
    const int gw = F.bid * 8 + F.wave, NGW = F.G * 8;
    int row_lo = 0;
    if (slab) { row_lo = NCTX;
        LAS float* red = (LAS float*)F.lds;
        for (int row = F.bid; row < NCTX; row += F.G) { const size_t o = (size_t)row * DM + F.wave * 512;
            f32x4 v[2]; float s = 0.f;
#pragma unroll
            for (int j = 0; j < 2; ++j) { f32x4 acc = (f32x4){0.f, 0.f, 0.f, 0.f};
#pragma unroll
                for (int ks = 0; ks < 16; ++ks) acc += ((const f32x4*)(slab + (size_t)ks * NCTX * DM + o) + F.lane)[64 * j];
                v[j] = ((const f32x4*)(XS + o) + F.lane)[64 * j] + acc * ((const f32x4*)(sgate + F.wave * 512) + F.lane)[64 * j] * sfac;
                ((f32x4*)(XS + o) + F.lane)[64 * j] = v[j]; s += (v[j].x * v[j].x + v[j].y * v[j].y) + (v[j].z * v[j].z + v[j].w * v[j].w); }
            s = wave_sum(s); if (F.lane == 0) red[F.wave] = s;
            __syncthreads();
            float tot = 0.f;
#pragma unroll
            for (int w = 0; w < 8; ++w) tot += red[w];
            const float rstd = rsqrtf(tot * (1.0f / DM) + NORM_EPS);
#pragma unroll
            for (int j = 0; j < 2; ++j) { const int c4 = F.wave * 128 + F.lane + 64 * j;
                const f32x4 y = v[j] * rstd * ((const f32x4*)gain)[c4] * (((const f32x4*)(modc + (size_t)isc * DM))[c4] + 1.0f) + ((const f32x4*)(modc + (size_t)ish * DM))[c4];
                u32x2 w2; w2.x = cvt_pk_bf16(y.x, y.y); w2.y = cvt_pk_bf16(y.z, y.w); ((u32x2*)(out + (size_t)row * DM))[c4] = w2; }
            __syncthreads(); } }
    for (int row = row_lo + gw; row < T; row += NGW) {
        const float* mod = row < NCTX ? modc : modx;
        const f32x4* xr = (const f32x4*)(XS + (size_t)row * DM) + F.lane; const f32x4* g4 = (const f32x4*)gain + F.lane;
        const f32x4* sh4 = (const f32x4*)(mod + (size_t)ish * DM) + F.lane; const f32x4* sc4 = (const f32x4*)(mod + (size_t)isc * DM) + F.lane;
        f32x4 v[16]; float s = 0.f;
#pragma unroll
        for (int j = 0; j < 16; ++j) { v[j] = xr[64 * j]; s += (v[j].x * v[j].x + v[j].y * v[j].y) + (v[j].z * v[j].z + v[j].w * v[j].w); }
        const float rstd = rsqrtf(wave_sum(s) * (1.0f / DM) + NORM_EPS);
        u32x2* o = (u32x2*)(out + (size_t)row * DM) + F.lane;
#pragma unroll
        for (int j = 0; j < 16; ++j) { const f32x4 y = v[j] * rstd * g4[64 * j] * (sc4[64 * j] + 1.0f) + sh4[64 * j];
            u32x2 w; w.x = cvt_pk_bf16(y.x, y.y); w.y = cvt_pk_bf16(y.z, y.w); o[64 * j] = w; }
    }
}
__device__ __forceinline__ float conv3_at(const float* PX, int tau, int col, float w0, float w1, float w2) {
    const float* p = PX + (size_t)tau * PXW + col;
    const bool hl = has_left(tau), hr = has_right(tau);
    return p[0] * w1 + p[hl ? -PXW : 0] * (hl ? w0 : 0.f) + p[hr ? PXW : 0] * (hr ? w2 : 0.f);
}
__device__ __forceinline__ float rope_apply(float val, int tau, int j) {
    const int pos = tau - NCTX, prow = pos >> 6, pcol = pos & 63;
    const float inv = __powf(10000.0f, -(float)(j & 15) * (1.0f / 16.0f));
    const float ang = (float)(j < 32 ? prow : pcol) * inv;
    float sn, cs; sincosf(ang, &sn, &cs);
    const float partner = __shfl_xor(val, 16);
    const float rot = (j & 16) ? partner : -partner;
    return val * cs + rot * sn;
}
__device__ __forceinline__ void mla_prep_phase(const Frame& F, unsigned char* ws, int l) {
    const float* PX = (const float*)(ws + WS_PX); bf16_t* QA = (bf16_t*)(ws + WS_QA); bf16_t* KVA = (bf16_t*)(ws + WS_KVA); bf16_t* KPE = (bf16_t*)(ws + WS_KPE);
    const int gw = F.bid * 8 + F.wave, NGW = F.G * 8;
    const f32x4* gq = (const f32x4*)(IN_(38) + l * 1024) + F.lane; const f32x4* gkv = (const f32x4*)(IN_(40) + l * 512) + F.lane; const float gpe = IN_(45)[l * 64 + F.lane];
    for (int tau = gw; tau < T; tau += NGW) {
        const f32x4* p = (const f32x4*)(PX + (size_t)tau * PXW + PXC) + F.lane;
        f32x4 q[4], kv[2]; float sq = 0.f, skv = 0.f;
#pragma unroll
        for (int j = 0; j < 4; ++j) { q[j] = p[64 * j]; sq += (q[j].x * q[j].x + q[j].y * q[j].y) + (q[j].z * q[j].z + q[j].w * q[j].w); }
#pragma unroll
        for (int j = 0; j < 2; ++j) { kv[j] = p[256 + 64 * j]; skv += (kv[j].x * kv[j].x + kv[j].y * kv[j].y) + (kv[j].z * kv[j].z + kv[j].w * kv[j].w); }
        const float pe = PX[(size_t)tau * PXW + PXC + 1536 + F.lane];
        const float rq = rsqrtf(wave_sum(sq) * (1.0f / 1024.0f) + NORM_EPS), rkv = rsqrtf(wave_sum(skv) * (1.0f / 512.0f) + NORM_EPS), rpe = rsqrtf(wave_sum(pe * pe) * (1.0f / 64.0f) + NORM_EPS);
        u32x2* oq = (u32x2*)(QA + (size_t)tau * 1024) + F.lane; u32x2* okv = (u32x2*)(KVA + (size_t)tau * 512) + F.lane;
#pragma unroll
        for (int j = 0; j < 4; ++j) { const f32x4 y = q[j] * rq * gq[64 * j]; u32x2 w; w.x = cvt_pk_bf16(y.x, y.y); w.y = cvt_pk_bf16(y.z, y.w); oq[64 * j] = w; }
#pragma unroll
        for (int j = 0; j < 2; ++j) { const f32x4 y = kv[j] * rkv * gkv[64 * j]; u32x2 w; w.x = cvt_pk_bf16(y.x, y.y); w.y = cvt_pk_bf16(y.z, y.w); okv[64 * j] = w; }
        float kp = pe * rpe * gpe;
        if (tau >= NCTX) kp = rope_apply(kp, tau, F.lane);
        KPE[(size_t)tau * 64 + F.lane] = (bf16_t)(cvt_pk_bf16(kp, kp) & 0xffffu);
    }
}
__device__ __forceinline__ void qkv_final_phase(const Frame& F, unsigned char* ws, int l, bool need_ctx) {
    const bf16_t* QRAW = (const bf16_t*)(ws + WS_QRAW); const bf16_t* KVRAW = (const bf16_t*)(ws + WS_KVRAW); const bf16_t* KPE = (const bf16_t*)(ws + WS_KPE);
    bf16_t* QF = (bf16_t*)(ws + WS_QF); bf16_t* KF = (bf16_t*)(ws + WS_KF);
    const int gw = F.bid * 8 + F.wave, NGW = F.G * 8, ln = F.lane;
    const float gqn0 = IN_(42)[l * 128 + 2 * ln], gqn1 = IN_(42)[l * 128 + 2 * ln + 1], gqp = IN_(43)[l * 64 + ln];
    const float gkn0 = IN_(44)[l * 128 + 2 * ln], gkn1 = IN_(44)[l * 128 + 2 * ln + 1];
    (void)need_ctx;
    for (int tau = gw; tau < T; tau += NGW) {
        float cs = 1.f, sn = 0.f;
        if (tau >= NCTX) { const int pos = tau - NCTX, prow = pos >> 6, pcol = pos & 63; const float inv = __powf(10000.0f, -(float)(ln & 15) * (1.0f / 16.0f)); sincosf((float)(ln < 32 ? prow : pcol) * inv, &sn, &cs); }
        const bf16_t kpe = KPE[(size_t)tau * 64 + ln];
        const bf16_t* qrow = QRAW + (size_t)tau * NQ; const bf16_t* krow = KVRAW + (size_t)tau * NKV;
        unsigned qn[NHC], kn[NHC]; bf16_t qpv[NHC];
#pragma unroll
        for (int h = 0; h < NHC; ++h) { qn[h] = *(const unsigned*)(qrow + h * 192 + 2 * ln); qpv[h] = qrow[h * 192 + 128 + ln]; kn[h] = *(const unsigned*)(krow + h * 256 + 2 * ln); }
#pragma unroll
        for (int h = 0; h < NHC; ++h) {
            const float q0 = bf2f((unsigned short)(qn[h] & 0xffffu)), q1 = bf2f((unsigned short)(qn[h] >> 16)), qp = bf2f(qpv[h]), k0 = bf2f((unsigned short)(kn[h] & 0xffffu)), k1 = bf2f((unsigned short)(kn[h] >> 16));
            const float rqn = rsqrtf(wave_sum(q0 * q0 + q1 * q1) * (1.0f / 128.0f) + NORM_EPS), rqp = rsqrtf(wave_sum(qp * qp) * (1.0f / 64.0f) + NORM_EPS), rkn = rsqrtf(wave_sum(k0 * k0 + k1 * k1) * (1.0f / 128.0f) + NORM_EPS);
            float qpe = qp * rqp * gqp;
            { const float partner = __shfl_xor(qpe, 16); const float rot = (ln & 16) ? partner : -partner; qpe = qpe * cs + rot * sn; }
            *(unsigned*)(QF + (size_t)tau * NQ + h * 192 + 2 * ln) = cvt_pk_bf16(q0 * rqn * gqn0, q1 * rqn * gqn1);
            QF[(size_t)tau * NQ + h * 192 + 128 + ln] = (bf16_t)(cvt_pk_bf16(qpe, qpe) & 0xffffu);
            *(unsigned*)(KF + (size_t)tau * NQ + h * 192 + 2 * ln) = cvt_pk_bf16(k0 * rkn * gkn0, k1 * rkn * gkn1);
            KF[(size_t)tau * NQ + h * 192 + 128 + ln] = kpe; }
    }
}
__device__ __forceinline__ void rwkv_out_phase(const Frame& F, unsigned char* ws, int l, bool need_ctx) {
    const float* SS = (const float*)(ws + WS_SS); const float* SD = (const float*)(ws + WS_SD); const float* GB = (const float*)(ws + WS_G); const float* Y = (const float*)(ws + WS_Y);
    bf16_t* OB = (bf16_t*)(ws + WS_OBUF);
    const int gw = F.bid * 8 + F.wave, NGW = F.G * 8, ln = F.lane;
    for (int it = (need_ctx ? 0 : NCTX * 5) + gw; it < T * 5; it += NGW) { const int tau = it / 5, h0 = (it % 5) * 4;
        float y0[4], y1[4], r[4], v[4], ka[4], kb[4], g[4];
#pragma unroll
        for (int q = 0; q < 4; ++q) { const int h = h0 + q, col = h * 64 + ln; const size_t o = (size_t)tau * A_W + col;
            y0[q] = Y[o]; y1[q] = Y[(size_t)T * A_W + o]; const float* ss = SS + ((size_t)h * T + tau) * 192 + ln; r[q] = ss[64]; v[q] = ss[128];
            ka[q] = SD[(((size_t)h * 2 + 0) * T + tau) * 192 + 128 + ln]; kb[q] = SD[(((size_t)h * 2 + 1) * T + tau) * 192 + 128 + ln]; g[q] = GB[o]; }
#pragma unroll
        for (int q = 0; q < 4; ++q) { const int col = (h0 + q) * 64 + ln;
            const float y = y0[q] + y1[q];
            const float mu = wave_sum(y) * (1.0f / 64.0f); const float dy = y - mu; const float var = wave_sum(dy * dy) * (1.0f / 64.0f);
            const float yn = dy * rsqrtf(var + GN_EPS) * IN_(25)[l * A_W + col] + IN_(26)[l * A_W + col];
            const float bonus = wave_sum(r[q] * (0.5f * (ka[q] + kb[q])) * IN_(24)[l * A_W + col]) * v[q];
            const float ov = (yn + bonus) * g[q];
            OB[(size_t)tau * DM + col] = (bf16_t)(cvt_pk_bf16(ov, ov) & 0xffffu); }
    }
}
__device__ __forceinline__ void hyena_prep_phase(const Frame& F, unsigned char* ws, int l) {
    const float* PX = (const float*)(ws + WS_PX); float* GT = (float*)(ws + WS_GT); float* X0T = (float*)(ws + WS_X0T);
    LAS float* LGt = (LAS float*)F.lds; LAS float* LX0 = LGt + 64 * 65;
    const float* cw = IN_(27) + (size_t)l * 3 * B_IN; const float* cb = IN_(28) + (size_t)l * B_IN;
    for (int it = F.bid; it < (T / 64) * 20; it += F.G) { const int tt = it / 20, ct = it % 20;
        { const int t = F.tid >> 3, c0 = ct * 64 + (F.tid & 7) * 8, tau = tt * 64 + t;
          f32x4 u[3][2];
#pragma unroll
          for (int grp = 0; grp < 3; ++grp)
#pragma unroll
              for (int q = 0; q < 2; ++q) { const int c = grp * 1280 + c0 + 4 * q; const float* p = PX + (size_t)tau * PXW + PXB + c;
                  const bool hl = has_left(tau), hr = has_right(tau);
                  const f32x4 y = *(const f32x4*)p * *(const f32x4*)(cw + B_IN + c) + *(const f32x4*)(cb + c) + *(const f32x4*)(p - (hl ? PXW : 0)) * (*(const f32x4*)(cw + c) * (hl ? 1.f : 0.f))
                                + *(const f32x4*)(p + (hr ? PXW : 0)) * (*(const f32x4*)(cw + 2 * B_IN + c) * (hr ? 1.f : 0.f));
                  u[grp][q] = y; }
#pragma unroll
          for (int q = 0; q < 2; ++q)
#pragma unroll
              for (int e = 0; e < 4; ++e) { const int ch = (F.tid & 7) * 8 + 4 * q + e; LGt[ch * 65 + t] = u[1][q][e] * u[2][q][e]; LX0[ch * 65 + t] = u[0][q][e]; } }
        __syncthreads();
        { const int ch = F.tid >> 3, t0 = (F.tid & 7) * 8; const size_t o = (size_t)(ct * 64 + ch) * T + tt * 64 + t0;
          f32x4 a0, a1, b0, b1;
#pragma unroll
          for (int e = 0; e < 4; ++e) { a0[e] = LGt[ch * 65 + t0 + e]; a1[e] = LGt[ch * 65 + t0 + 4 + e]; b0[e] = LX0[ch * 65 + t0 + e]; b1[e] = LX0[ch * 65 + t0 + 4 + e]; }
          *(f32x4*)(GT + o) = a0; *(f32x4*)(GT + o + 4) = a1; *(f32x4*)(X0T + o) = b0; *(f32x4*)(X0T + o + 4) = b1; }
        __syncthreads(); }
}
__device__ __forceinline__ void hyena_out_phase(const Frame& F, unsigned char* ws, bool need_ctx) {
    const float* YT = (const float*)(ws + WS_GT); bf16_t* OB = (bf16_t*)(ws + WS_OBUF);
    LAS float* L = (LAS float*)F.lds;
    const int it0 = need_ctx ? 0 : (NCTX / 64) * 20;
    for (int it = it0 + F.bid; it < (T / 64) * 20; it += F.G) { const int tt = it / 20, ct = it % 20;
        { const int ch = F.tid >> 3, t0 = (F.tid & 7) * 8; const size_t o = (size_t)(ct * 64 + ch) * T + tt * 64 + t0;
          const f32x4 a0 = *(const f32x4*)(YT + o), a1 = *(const f32x4*)(YT + o + 4);
#pragma unroll
          for (int e = 0; e < 4; ++e) { L[ch * 65 + t0 + e] = a0[e]; L[ch * 65 + t0 + 4 + e] = a1[e]; } }
        __syncthreads();
        { const int t = F.tid >> 3, c0 = (F.tid & 7) * 8; float x[8];
#pragma unroll
          for (int e = 0; e < 8; ++e) x[e] = L[(c0 + e) * 65 + t];
          u32x4 w; w.x = cvt_pk_bf16(x[0], x[1]); w.y = cvt_pk_bf16(x[2], x[3]); w.z = cvt_pk_bf16(x[4], x[5]); w.w = cvt_pk_bf16(x[6], x[7]);
          *(u32x4*)(OB + (size_t)(tt * 64 + t) * DM + 1280 + ct * 64 + c0) = w; }
        __syncthreads(); }
}
namespace att {
constexpr int DK = 192, DV = 128, NW = 8, QBLK = 32, KVBLK = 64;
constexpr float SCALE = 0.07216878364870322f;
constexpr float THR = 8.f;
#ifndef ATT_SDEPTH
#define ATT_SDEPTH 2
#endif
constexpr int SDEPTH = ATT_SDEPTH;
constexpr int LDQ = 2304, LDK = 2304, LDV = 3072, LDO = 4096;
constexpr int SHM_V = KVBLK * DV * 2, SHM_K = KVBLK * DK * 2, SHM_ATTN = 2 * SHM_V + 2 * SHM_K + NW * 64 * 4 + NW * 4096;
using bf16x8 = __attribute__((ext_vector_type(8))) short;
using s16x4  = __attribute__((ext_vector_type(4))) short;
using f32x16 = __attribute__((ext_vector_type(16))) float;
using u32x4  = __attribute__((ext_vector_type(4))) unsigned;
#define KSWZ(row, colB) ((row) * 384 + ((colB) ^ (((row) & 7) << 4)))
#define SBAR() __builtin_amdgcn_sched_barrier(0)
__device__ __forceinline__ int crow(int r, int hi) { return (r & 3) + 8 * (r >> 2) + 4 * hi; }
__device__ __forceinline__ unsigned cvtpk(float lo, float hi) { unsigned r; asm volatile("v_cvt_pk_bf16_f32 %0, %1, %2" : "=v"(r) : "v"(lo), "v"(hi)); return r; }
__device__ __forceinline__ void partialSM(f32x16& p0, f32x16& p1, float& m_reg, float& mn, float& alpha) {
  constexpr float C = SCALE * 1.4426950408889634f;
  float pmax = p0[0]; for (int r = 1; r < 16; ++r) pmax = fmaxf(pmax, p0[r]); for (int r = 0; r < 16; ++r) pmax = fmaxf(pmax, p1[r]);
  { auto rr = __builtin_amdgcn_permlane32_swap(__float_as_uint(pmax), __float_as_uint(pmax), false, false);
    pmax = fmaxf(__uint_as_float(rr[0]), __uint_as_float(rr[1])); }
  if (__builtin_expect(__all(pmax - m_reg <= THR / SCALE), 1)) { mn = m_reg; alpha = 1.f; }
  else { mn = fmaxf(m_reg, pmax); alpha = __builtin_amdgcn_exp2f((m_reg - mn) * C); m_reg = mn; }
  float mnC = -mn * C;
  for (int r = 0; r < 16; ++r) p0[r] = fmaf(p0[r], C, mnC); for (int r = 0; r < 16; ++r) p1[r] = fmaf(p1[r], C, mnC);
  for (int r = 0; r < 16; ++r) p0[r] = __builtin_amdgcn_exp2f(p0[r]);
}
__device__ __forceinline__ void finishSM(f32x16& p0, f32x16& p1, float alpha, float& l_reg, bf16x8& pa0, bf16x8& pa1, bf16x8& pa2, bf16x8& pa3) {
  for (int r = 0; r < 16; ++r) p1[r] = __builtin_amdgcn_exp2f(p1[r]);
  float ps = 0; for (int r = 0; r < 16; ++r) ps += p0[r]; for (int r = 0; r < 16; ++r) ps += p1[r];
  { auto rr = __builtin_amdgcn_permlane32_swap(__float_as_uint(ps), __float_as_uint(ps), false, false);
    ps = __uint_as_float(rr[0]) + __uint_as_float(rr[1]); }
  l_reg = l_reg * alpha + ps;
#define PK4(P, BASE, OUT) do { unsigned a0 = cvtpk(P[BASE + 0], P[BASE + 1]), a1 = cvtpk(P[BASE + 2], P[BASE + 3]);   \
    unsigned b0 = cvtpk(P[BASE + 4], P[BASE + 5]), b1 = cvtpk(P[BASE + 6], P[BASE + 7]);                              \
    auto r0 = __builtin_amdgcn_permlane32_swap(a0, b0, false, false); auto r1 = __builtin_amdgcn_permlane32_swap(a1, b1, false, false); \
    u32x4 w = {r0[0], r1[0], r0[1], r1[1]}; OUT = *reinterpret_cast<bf16x8*>(&w); } while (0)
  PK4(p0, 0, pa0); PK4(p0, 8, pa1); PK4(p1, 0, pa2); PK4(p1, 8, pa3);
#undef PK4
}
__device__ __forceinline__ void qkt(f32x16& p0, f32x16& p1, const char* Ks, const bf16x8* qr, const char* qrl, int r32, int hi) {
  p0 = f32x16{}; p1 = f32x16{};
#pragma unroll
  for (int d0 = 0; d0 < 8; ++d0) { int cb = (d0 * 16 + hi * 8) * 2;
    bf16x8 b0 = *reinterpret_cast<const bf16x8*>(Ks + KSWZ(r32, cb));
    bf16x8 b1 = *reinterpret_cast<const bf16x8*>(Ks + KSWZ(32 + r32, cb));
    p0 = __builtin_amdgcn_mfma_f32_32x32x16_bf16(b0, qr[d0], p0, 0, 0, 0);
    p1 = __builtin_amdgcn_mfma_f32_32x32x16_bf16(b1, qr[d0], p1, 0, 0, 0); }
#pragma unroll
  for (int d0 = 8; d0 < 12; ++d0) { int cb = (d0 * 16 + hi * 8) * 2;
    bf16x8 b0 = *reinterpret_cast<const bf16x8*>(Ks + KSWZ(r32, cb));
    bf16x8 b1 = *reinterpret_cast<const bf16x8*>(Ks + KSWZ(32 + r32, cb));
    const bf16x8 q = *reinterpret_cast<const bf16x8*>(qrl + ((((d0 - 8) * 2 + hi) ^ (r32 & 7)) << 4));
    p0 = __builtin_amdgcn_mfma_f32_32x32x16_bf16(b0, q, p0, 0, 0, 0);
    p1 = __builtin_amdgcn_mfma_f32_32x32x16_bf16(b1, q, p1, 0, 0, 0); }
}
__device__ __forceinline__ int v_st(int k, int c) { const int kk = (k & ~0xC) | ((k & 4) << 1) | ((k & 8) >> 1); return ((kk >> 3) * 4 + (c >> 5)) * 512 + ((kk & 7) * 32 + (c & 31)) * 2; }
__device__ __forceinline__ int v_rd_base(int lane) { return ((lane & 3) << 3) | (((lane >> 2) & 3) << 6) | (((lane >> 4) & 1) << 5) | (((lane >> 5) & 1) << 8); }
constexpr int v_rd_off(int d0, int ks, int half) { return d0 * 512 + ks * 4096 + half * 2048; }
template <int OFF> __device__ __forceinline__ s16x4 tr_read(int vb) {
  s16x4 r; asm volatile("ds_read_b64_tr_b16 %0, %1 offset:%2" : "=&v"(r) : "v"(vb), "i"(OFF) : "memory"); return r;
}
template <int D0> __device__ __forceinline__ void pv_one(f32x16& od, int vb, bf16x8 pa0, bf16x8 pa1, bf16x8 pa2, bf16x8 pa3) {
  const s16x4 l0 = tr_read<v_rd_off(D0, 0, 0)>(vb), h0 = tr_read<v_rd_off(D0, 0, 1)>(vb), l1 = tr_read<v_rd_off(D0, 1, 0)>(vb), h1 = tr_read<v_rd_off(D0, 1, 1)>(vb);
  const s16x4 l2 = tr_read<v_rd_off(D0, 2, 0)>(vb), h2 = tr_read<v_rd_off(D0, 2, 1)>(vb), l3 = tr_read<v_rd_off(D0, 3, 0)>(vb), h3 = tr_read<v_rd_off(D0, 3, 1)>(vb);
  asm volatile("s_waitcnt lgkmcnt(0)" ::: "memory"); SBAR();
#define PK(L, H) (bf16x8){L[0], L[1], L[2], L[3], H[0], H[1], H[2], H[3]}
  od = __builtin_amdgcn_mfma_f32_32x32x16_bf16(pa0, PK(l0, h0), od, 0, 0, 0);
  od = __builtin_amdgcn_mfma_f32_32x32x16_bf16(pa1, PK(l1, h1), od, 0, 0, 0);
  od = __builtin_amdgcn_mfma_f32_32x32x16_bf16(pa2, PK(l2, h2), od, 0, 0, 0);
  od = __builtin_amdgcn_mfma_f32_32x32x16_bf16(pa3, PK(l3, h3), od, 0, 0, 0);
#undef PK
}
__device__ __forceinline__ void pv_d0(f32x16* o, int vb, bf16x8 pa0, bf16x8 pa1, bf16x8 pa2, bf16x8 pa3) {
  pv_one<0>(o[0], vb, pa0, pa1, pa2, pa3); pv_one<1>(o[1], vb, pa0, pa1, pa2, pa3); pv_one<2>(o[2], vb, pa0, pa1, pa2, pa3); pv_one<3>(o[3], vb, pa0, pa1, pa2, pa3);
}
__device__ __forceinline__ void attn_body(const bf16_t* __restrict__ Qb, const bf16_t* __restrict__ Kh, const bf16_t* __restrict__ Vh, bf16_t* __restrict__ Ob, int seq, char* lds) {
  int tid_ = threadIdx.x; asm volatile("" : "+v"(tid_));
  const int tid = tid_, wid = tid >> 6, lane = tid & 63, r32 = lane & 31, hi = lane >> 5;
  char* V_lds = lds; char* K_lds = lds + 2 * SHM_V;
  float* ws = (float*)(lds + 2 * SHM_V + 2 * SHM_K) + wid * 64; float* li_l = ws; float* al_l = ws + 32;
  float m_reg = -1e30f, l_reg = 0; f32x16 o[4] = {}; bf16x8 qr[8];
  const bf16_t* Qw = Qb + (long)(wid * QBLK + r32) * LDQ + hi * 8;
  char* qrl = lds + 2 * SHM_V + 2 * SHM_K + NW * 64 * 4 + wid * 4096 + r32 * 128;
#pragma unroll
  for (int d0 = 0; d0 < 8; ++d0) qr[d0] = *reinterpret_cast<const bf16x8*>(Qw + d0 * 16);
#pragma unroll
  for (int d0 = 8; d0 < 12; ++d0) *reinterpret_cast<bf16x8*>(qrl + ((((d0 - 8) * 2 + hi) ^ (r32 & 7)) << 4)) = *reinterpret_cast<const bf16x8*>(Qw + d0 * 16);
  asm volatile("s_waitcnt lgkmcnt(0)" ::: "memory");
  unsigned kgo[3], vgo[2];
#pragma unroll
  for (int i = 0; i < 3; ++i) { const int p = (i * 8 + wid) * 64 + lane, row = p / 24, slot = p % 24, ch = slot ^ (row & 7); kgo[i] = (unsigned)(row * LDK + ch * 8) * 2u; }
#pragma unroll
  for (int i = 0; i < 2; ++i) { const int p = (i * 8 + wid) * 64 + lane, sub = p >> 5, within = p & 31, kk = (sub >> 2) * 8 + (within >> 2), c = (sub & 3) * 32 + (within & 3) * 8;
    const int k = (kk & ~0xC) | ((kk & 4) << 1) | ((kk & 8) >> 1); vgo[i] = (unsigned)(k * LDV + c) * 2u; }
  const int vb0 = (int)(uintptr_t)V_lds + v_rd_base(lane);
  typedef __attribute__((address_space(3))) unsigned lds_u32;
#define DMA_K(b, k0) do { const char* kg = (const char*)Kh + (size_t)(k0) * (LDK * 2); \
    _Pragma("unroll") for (int _i = 0; _i < 3; ++_i) __builtin_amdgcn_global_load_lds((const unsigned*)(kg + kgo[_i]), (lds_u32*)(K_lds + (b) * SHM_K + (_i * 8 + wid) * 1024), 16, 0, 0); } while (0)
#define DMA_V(b, k0) do { const char* vg = (const char*)Vh + (size_t)(k0) * (LDV * 2); \
    _Pragma("unroll") for (int _i = 0; _i < 2; ++_i) __builtin_amdgcn_global_load_lds((const unsigned*)(vg + vgo[_i]), (lds_u32*)(V_lds + (b) * SHM_V + (_i * 8 + wid) * 1024), 16, 0, 0); } while (0)
#define RESC(a) do { if (__any((a) < 1.f)) { if (hi == 0) al_l[r32] = (a); asm volatile("s_waitcnt lgkmcnt(0)" ::: "memory"); \
    for (int d = 0; d < 4; ++d) for (int r = 0; r < 16; ++r) o[d][r] *= al_l[crow(r, hi)]; } } while (0)
#define ENDSTEP() do { asm volatile("s_waitcnt vmcnt(0)" ::: "memory"); __syncthreads(); } while (0)
  f32x16 pA0, pA1, pB0, pB1; float mnA, mnB, alA, alB; bf16x8 pa0, pa1, pa2, pa3; const int NT = seq / KVBLK;
  DMA_K(0, 0); ENDSTEP();
  DMA_K(1, KVBLK); DMA_V(0, 0);
  qkt(pA0, pA1, K_lds, qr, qrl, r32, hi); partialSM(pA0, pA1, m_reg, mnA, alA);
  ENDSTEP();
  for (int j = 1; j + 1 < NT; j += 2) {
    DMA_K(0, (j + 1) * KVBLK); DMA_V(1, j * KVBLK);
    SBAR(); qkt(pB0, pB1, K_lds + SHM_K, qr, qrl, r32, hi);
    finishSM(pA0, pA1, alA, l_reg, pa0, pa1, pa2, pa3); SBAR();
    pv_d0(o, vb0, pa0, pa1, pa2, pa3); partialSM(pB0, pB1, m_reg, mnB, alB);
    RESC(alB); ENDSTEP();
    if (j + 2 < NT) DMA_K(1, (j + 2) * KVBLK);
    DMA_V(0, (j + 1) * KVBLK);
    SBAR(); qkt(pA0, pA1, K_lds, qr, qrl, r32, hi);
    finishSM(pB0, pB1, alB, l_reg, pa0, pa1, pa2, pa3); SBAR();
    pv_d0(o, vb0 + (int)SHM_V, pa0, pa1, pa2, pa3); partialSM(pA0, pA1, m_reg, mnA, alA);
    RESC(alA); ENDSTEP();
  }
  DMA_V(1, (NT - 1) * KVBLK);
  SBAR(); qkt(pB0, pB1, K_lds + SHM_K, qr, qrl, r32, hi);
  finishSM(pA0, pA1, alA, l_reg, pa0, pa1, pa2, pa3); SBAR();
  pv_d0(o, vb0, pa0, pa1, pa2, pa3); partialSM(pB0, pB1, m_reg, mnB, alB);
  RESC(alB); ENDSTEP();
  finishSM(pB0, pB1, alB, l_reg, pa0, pa1, pa2, pa3); SBAR();
  pv_d0(o, vb0 + (int)SHM_V, pa0, pa1, pa2, pa3);
#undef DMA_K
#undef DMA_V
#undef ENDSTEP
  if (hi == 0) li_l[r32] = l_reg; asm volatile("s_waitcnt lgkmcnt(0)" ::: "memory");
  float rli[16];
#pragma unroll
  for (int r = 0; r < 16; ++r) rli[r] = __builtin_amdgcn_rcpf(li_l[crow(r, hi)]);
  bf16_t* Ow = Ob + (long)(wid * QBLK) * LDO;
#pragma unroll
  for (int r = 0; r < 16; ++r) { int orow = crow(r, hi);
#pragma unroll
    for (int d0 = 0; d0 < 4; ++d0) { const float val = o[d0][r] * rli[r]; Ow[(long)orow * LDO + d0 * 32 + r32] = (bf16_t)(cvtpk(val, val) & 0xffff); } }
  __syncthreads();
#undef RESC
}
}
__device__ __forceinline__ f32x2 cmul(f32x2 a, f32x2 b) { return (f32x2){a.x * b.x - a.y * b.y, a.x * b.y + a.y * b.x}; }
__device__ __forceinline__ int rev4_14(int k) { const unsigned r = __brev((unsigned)k) >> 18; return (int)(((r & 0x1555u) << 1) | ((r >> 1) & 0x1555u)); }
#define ZI(i) ((i) + ((i) >> 5))
__device__ __forceinline__ void fft_tw(int j, int q, float sign, f32x2& w1, f32x2& w2, f32x2& w3) {
    const float rev = (float)j / (float)(4 * q); const float sn = __builtin_amdgcn_sinf(rev), cs = __builtin_amdgcn_cosf(rev);
    w1 = (f32x2){cs, sign * sn}; w2 = cmul(w1, w1); w3 = cmul(w2, w1);
}
__device__ __forceinline__ void fft16k_dif(LAS f32x2* Z, int tid) {
#pragma unroll 1
    for (int s = 0; s < 7; ++s) { int lq = 12 - 2 * s; asm volatile("" : "+s"(lq)); const int q = 1 << lq;
        const bool shared = q <= 512; f32x2 w1, w2, w3; fft_tw(tid & (q - 1), q, -1.f, w1, w2, w3);
#pragma unroll 2
        for (int i = 0; i < 8; ++i) { const int b = tid + 512 * i, j = b & (q - 1), base = ((b >> lq) << (lq + 2)) + j;
            const int i0 = ZI(base), i1 = ZI(base + q), i2 = ZI(base + 2 * q), i3 = ZI(base + 3 * q);
            const f32x2 a0 = Z[i0], a1 = Z[i1], a2 = Z[i2], a3 = Z[i3];
            const f32x2 t0 = a0 + a2, t1 = a0 - a2, t2 = a1 + a3, t3 = a1 - a3;
            if (!shared) fft_tw(j, q, -1.f, w1, w2, w3);
            Z[i0] = t0 + t2; Z[i1] = cmul((f32x2){t1.x + t3.y, t1.y - t3.x}, w1); Z[i2] = cmul(t0 - t2, w2); Z[i3] = cmul((f32x2){t1.x - t3.y, t1.y + t3.x}, w3); }
        __syncthreads(); }
}
__device__ __forceinline__ void fft16k_dit_inv(LAS f32x2* Z, int tid) {
#pragma unroll 1
    for (int s = 0; s < 7; ++s) { int lq = 2 * s; asm volatile("" : "+s"(lq)); const int q = 1 << lq;
        const bool shared = q <= 512; f32x2 w1, w2, w3; fft_tw(tid & (q - 1), q, 1.f, w1, w2, w3);
#pragma unroll 2
        for (int i = 0; i < 8; ++i) { const int b = tid + 512 * i, j = b & (q - 1), base = ((b >> lq) << (lq + 2)) + j;
            if (!shared) fft_tw(j, q, 1.f, w1, w2, w3);
            const int i0 = ZI(base), i1 = ZI(base + q), i2 = ZI(base + 2 * q), i3 = ZI(base + 3 * q);
            const f32x2 b0 = Z[i0], b1 = cmul(Z[i1], w1), b2 = cmul(Z[i2], w2), b3 = cmul(Z[i3], w3);
            const f32x2 t0 = b0 + b2, t1 = b0 - b2, t2 = b1 + b3, t3 = b1 - b3;
            Z[i0] = t0 + t2; Z[i1] = (f32x2){t1.x - t3.y, t1.y + t3.x}; Z[i2] = t0 - t2; Z[i3] = (f32x2){t1.x + t3.y, t1.y - t3.x}; }
        __syncthreads(); }
}
constexpr float HY_MIN_DECAY = -3.0701134573253945f, HY_MAX_DECAY = -15.350567286626973f;
__device__ __forceinline__ float hy_delta(int c) { return fabsf(HY_MIN_DECAY + (HY_MAX_DECAY - HY_MIN_DECAY) * ((float)c / 1279.0f)); }
__device__ __forceinline__ float conv3b_at(const float* PX, int tau, int col, const float* cw, int l, int c) {
    const float* w = cw + (size_t)l * 3 * B_IN;
    return conv3_at(PX, tau, col, w[c], w[B_IN + c], w[2 * B_IN + c]);
}
__device__ __forceinline__ void hyena_taps_unit(const Frame& F, unsigned char* ws, int l, int pair) {
    LAS f32x2* Z = (LAS f32x2*)F.lds; LAS float* red = (LAS float*)(F.lds + LDS_MISC + 128);
    const int tid = F.tid, c0 = 2 * pair;
    const bf16_t* H3x = (const bf16_t*)(ws + WS_H3) + (size_t)l * 64 * T + NCTX;
    f32x2* scr = (f32x2*)(ws + WS_HSCR) + (size_t)pair * 16384; float* htn = (float*)(ws + WS_HSCR + (size_t)640 * 16384 * 8) + 2 * pair;
    LAS f32x4* FW = (LAS f32x4*)(F.lds + LDS_MISC + 256);
    if (tid < 256) { const int j = tid >> 2, q = tid & 3; ((LAS float*)FW)[tid] = IN_(35)[(size_t)l * 64 * 2560 + (size_t)j * 2560 + (q >> 1) * 1280 + c0 + (q & 1)]; }
    __syncthreads();
    const float d0 = hy_delta(c0), d1 = hy_delta(c0 + 1);
#ifndef HYS
#define HYS 31
#endif
    float s0, s1, sc0 = 0.f, sc1 = 0.f;
    {
    s0 = 0.f; s1 = 0.f;
    if (HYS & 1)
#pragma unroll 1
    for (int i = 0; i < 2; ++i) { const int tb = 4096 * i + 8 * tid; const bf16_t* hc = H3x + tb;
        asm volatile("" ::: "memory");
        f32x4 acc[8];
#pragma unroll
        for (int p = 0; p < 8; ++p) acc[p] = (f32x4){0.f, 0.f, 0.f, 0.f};
#pragma unroll 8
        for (int j = 0; j < 64; ++j) { const f32x4 w = FW[j]; const u32x4 hv = *(const u32x4*)(hc + (size_t)j * T);
#pragma unroll
            for (int p = 0; p < 4; ++p) { acc[2 * p] += w * __uint_as_float(hv[p] << 16); acc[2 * p + 1] += w * __uint_as_float(hv[p] & 0xffff0000u); } }
#pragma unroll
        for (int p = 0; p < 8; ++p) { const int t = tb + p;
            const float tl = (float)t * (1.0f / 8191.0f), e0 = __expf(-tl * d0), e1 = __expf(-tl * d1);
            const float f0 = acc[p].x * e0, f1 = acc[p].y * e1, b0 = acc[p].z * e0, b1 = acc[p].w * e1;
            Z[ZI(t)] = (f32x2){f0, f1}; s0 += fabsf(f0); s1 += fabsf(f1);
            if (t < 8191) { Z[ZI(16383 - t)] = (f32x2){b0, b1}; s0 += fabsf(b0); s1 += fabsf(b1); } } }
    if (tid == 0) { float zz = 0.f; asm volatile("" : "+v"(zz)); Z[ZI(8192)] = (f32x2){zz, zz}; }
    s0 = wave_sum(s0); s1 = wave_sum(s1);
    if (F.lane == 0) { red[F.wave * 2] = s0; red[F.wave * 2 + 1] = s1; }
    __syncthreads();
    float n0 = 0.f, n1 = 0.f;
#pragma unroll
    for (int w = 0; w < 8; ++w) { n0 += red[2 * w]; n1 += red[2 * w + 1]; }
    sc0 = 1.0f / (16384.0f * n0); sc1 = 1.0f / (16384.0f * n1);
    if (HYS & 2) fft16k_dif(Z, tid);
#pragma unroll 4
    for (int i = 0; i < 32; ++i) scr[tid + 512 * i] = Z[ZI(tid + 512 * i)];
    __syncthreads();
    }
    if (tid == 0) { htn[0] = sc0; htn[1] = sc1; }
    __syncthreads();
}
__device__ __forceinline__ void hyena_unit(const Frame& F, unsigned char* ws, int l, int pair) {
    LAS f32x2* Z = (LAS f32x2*)F.lds;
    const int tid = F.tid, c0 = 2 * pair;
    float* GT = (float*)(ws + WS_GT); const float* X0T = (const float*)(ws + WS_X0T);
    const f32x2* scr = (const f32x2*)(ws + WS_HSCR) + (size_t)pair * 16384; const float* htn = (const float*)(ws + WS_HSCR + (size_t)640 * 16384 * 8) + 2 * pair;
    const float sc0 = htn[0], sc1 = htn[1];
#ifndef HYS
#define HYS 31
#endif
    for (int rp15 = 0; rp15 < REP(15); ++rp15) {
    const float* g0p = GT + (size_t)c0 * T + NCTX; const float* g1p = g0p + T;
    { float zz = 0.f; asm volatile("" : "+v"(zz));
#pragma unroll 4
      for (int i = 0; i < 16; ++i) { const int t = tid + 512 * i; Z[ZI(t)] = (f32x2){g0p[t], g1p[t]}; Z[ZI(8192 + t)] = (f32x2){zz, zz}; } }
    __syncthreads();
    if (HYS & 2) fft16k_dif(Z, tid);
    if (HYS & 8)
#pragma unroll 2
    for (int i = 0; i < 17; ++i) { const int k = tid + 512 * i; if (i == 16 && tid != 0) break;
        const int pk = rev4_14(k & 16383), pn = rev4_14((16384 - k) & 16383);
        const f32x2 A = Z[ZI(pk)], B = Z[ZI(pn)], At = scr[pk], Bt = scr[pn];
        const f32x2 G0 = (f32x2){0.5f * (A.x + B.x), 0.5f * (A.y - B.y)}, G1 = (f32x2){0.5f * (A.y + B.y), -0.5f * (A.x - B.x)};
        const f32x2 H0 = (f32x2){0.5f * (At.x + Bt.x), 0.5f * (At.y - Bt.y)}, H1 = (f32x2){0.5f * (At.y + Bt.y), -0.5f * (At.x - Bt.x)};
        const f32x2 P0 = cmul(G0, H0), P1 = cmul(G1, H1);
        Z[ZI(pk)] = (f32x2){P0.x - P1.y, P0.y + P1.x};
        if (pn != pk) Z[ZI(pn)] = (f32x2){P0.x + P1.y, P1.x - P0.y}; }
    __syncthreads();
    if (HYS & 2) fft16k_dit_inv(Z, tid);
    }
    const float bb0 = IN_(37)[l * 1280 + c0], bb1 = IN_(37)[l * 1280 + c0 + 1];
    { float* y0p = GT + (size_t)c0 * T + NCTX; float* y1p = y0p + T; const float* x0p = X0T + (size_t)c0 * T + NCTX; const float* x1p = x0p + T;
#pragma unroll 4
      for (int i = 0; i < 16; ++i) { const int t = tid + 512 * i; const f32x2 z = Z[ZI(t)]; const float ga = y0p[t], gb = y1p[t];
          y0p[t] = x0p[t] * (z.x * sc0 + ga * bb0); y1p[t] = x1p[t] * (z.y * sc1 + gb * bb1); } }
    __syncthreads();
}
__device__ __forceinline__ void hyena_ctx_unit(const Frame& F, unsigned char* ws, int l, int unit) {
    LAS float* TF = (LAS float*)F.lds; LAS float* TB = TF + 2048; LAS float* GG = TB + 2048;
    const int tid = F.tid, t = tid >> 1, cc = (tid & 1) * 4, cbase = unit * 8 + cc;
    const bf16_t* H3c = (const bf16_t*)(ws + WS_H3) + (size_t)l * 64 * T; float* GT = (float*)(ws + WS_GT); const float* X0T = (const float*)(ws + WS_X0T);
    { float f[4] = {0.f, 0.f, 0.f, 0.f}, b[4] = {0.f, 0.f, 0.f, 0.f};
      const float* wbase = IN_(35) + (size_t)l * 64 * 2560 + cbase;
      for (int j = 0; j < 64; ++j) { const float hv = bf2f(H3c[(size_t)j * T + t]); const float* wrow = wbase + (size_t)j * 2560;
#pragma unroll
          for (int q = 0; q < 4; ++q) { f[q] += hv * wrow[q]; b[q] += hv * wrow[1280 + q]; } }
      const float tl = (float)t * (1.0f / 255.0f);
#pragma unroll
      for (int q = 0; q < 4; ++q) { const float e = __expf(-tl * hy_delta(cbase + q)); TF[t * 8 + cc + q] = f[q] * e; TB[t * 8 + cc + q] = b[q] * e; GG[t * 8 + cc + q] = GT[(size_t)(cbase + q) * T + t]; } }
    __syncthreads();
    float nrm[4] = {0.f, 0.f, 0.f, 0.f}, y[4] = {0.f, 0.f, 0.f, 0.f};
    for (int s = 0; s < 256; ++s) {
#pragma unroll
        for (int q = 0; q < 4; ++q) { nrm[q] += fabsf(TF[s * 8 + cc + q]) + (s < 255 ? fabsf(TB[s * 8 + cc + q]) : 0.f);
            const int o = t - s; const float tap = o >= 0 ? TF[o * 8 + cc + q] : TB[(-o - 1) * 8 + cc + q];
            y[q] += tap * GG[s * 8 + cc + q]; } }
    __syncthreads();
#pragma unroll
    for (int q = 0; q < 4; ++q) GT[(size_t)(cbase + q) * T + t] = X0T[(size_t)(cbase + q) * T + t] * (y[q] / nrm[q] + GG[t * 8 + cc + q] * IN_(37)[l * 1280 + cbase + q]);
    __syncthreads();
}
constexpr int SC_C = 16, SC_NCHUNK = T / SC_C, SC_CHUNK_BYTES = 14 * 1024;
__device__ __forceinline__ int sc_tau(int d, int c, int t) { return d == 0 ? SC_C * c + t : (c < NCTX / SC_C ? NCTX - 1 - SC_C * c - t : T - 1 - SC_C * (c - NCTX / SC_C) - t); }
__device__ __forceinline__ int sc_perm(int e, int hi) { return (e & 3) + 8 * (e >> 2) + 4 * hi; }
constexpr size_t WS_FR_BYTES = (size_t)2 * NHA * SC_NCHUNK * SC_CHUNK_BYTES;

typedef short sc_bf16x8 __attribute__((ext_vector_type(8)));
typedef float sc_f32x16 __attribute__((ext_vector_type(16)));
__device__ __forceinline__ sc_bf16x8 sc_pack8(const sc_f32x16& a, int base) {
    u32x4 w; w.x = cvt_pk_bf16(a[base + 0], a[base + 1]); w.y = cvt_pk_bf16(a[base + 2], a[base + 3]); w.z = cvt_pk_bf16(a[base + 4], a[base + 5]); w.w = cvt_pk_bf16(a[base + 6], a[base + 7]);
    return *reinterpret_cast<sc_bf16x8*>(&w);
}
constexpr int SC_NSLOT = 9, SC_AHEAD = 7;
__device__ __forceinline__ void scan_chain_mfma(const Frame& F, unsigned char* ws, int chain) {
    const int h = chain >> 1, d = chain & 1, lane = F.lane, n = lane & 31, hi = lane >> 5, ib = F.wave;
    const unsigned char* FRc = ws + WS_FR + (size_t)chain * SC_NCHUNK * SC_CHUNK_BYTES;
    float* Yd = (float*)(ws + WS_Y) + (size_t)d * T * A_W + h * 64;
    LAS unsigned char* buf = F.lds;
    typedef __attribute__((address_space(3))) unsigned sc_lds_u32;
#define SCM_DMA(c_) do { if (ib < 7) { const unsigned char* src_ = FRc + (size_t)(c_) * SC_CHUNK_BYTES; LAS unsigned char* dst_ = buf + ((c_) % SC_NSLOT) * SC_CHUNK_BYTES; \
        _Pragma("unroll") for (int i_ = 0; i_ < 2; ++i_) __builtin_amdgcn_global_load_lds((const unsigned*)(src_ + (i_ * 7 + ib) * 1024 + lane * 16), (sc_lds_u32*)(dst_ + (i_ * 7 + ib) * 1024), 16, 0, 0); } } while (0)
    sc_f32x16 S0 = {}, S1 = {};
    int yoff[8];
#pragma unroll
    for (int r = 0; r < 8; ++r) { const int t = (r & 3) + 8 * (r >> 2) + 4 * hi; yoff[r] = (d ? -t : t) * A_W + 32 * ib + n; }
    __syncthreads();
#pragma unroll
    for (int c = 0; c < SC_AHEAD; ++c) SCM_DMA(c);
    asm volatile("s_waitcnt vmcnt(12)" ::: "memory"); __builtin_amdgcn_s_barrier(); asm volatile("" ::: "memory");
#pragma unroll 1
    for (int c = 0; c < SC_NCHUNK; ++c) {
        const bool steady = c + SC_AHEAD < SC_NCHUNK;
        if (steady) SCM_DMA(c + SC_AHEAD);
        if (ib < 2) {
                const LAS unsigned char* fb = buf + (c % SC_NSLOT) * SC_CHUNK_BYTES;
                sc_bf16x8 fr[11]; sc_bf16x8 vf; f32x4 gt[8];
                { const unsigned fa = (unsigned)(uintptr_t)fb + lane * 16, va = fa + (11 + ib) * 1024, ga = (unsigned)(uintptr_t)fb + 13 * 1024 + hi * 128;
#define SC_DSRD(dst, addr, off) asm volatile("ds_read_b128 %0, %1 offset:%2" : "=v"(dst) : "v"(addr), "i"(off))
                  SC_DSRD(fr[0], fa, 0); SC_DSRD(fr[1], fa, 1024); SC_DSRD(fr[2], fa, 2048); SC_DSRD(fr[3], fa, 3072); SC_DSRD(fr[4], fa, 4096); SC_DSRD(fr[5], fa, 5120);
                  SC_DSRD(fr[6], fa, 6144); SC_DSRD(fr[7], fa, 7168); SC_DSRD(fr[8], fa, 8192); SC_DSRD(fr[9], fa, 9216); SC_DSRD(fr[10], fa, 10240); SC_DSRD(vf, va, 0);
                  SC_DSRD(gt[0], ga, 0); SC_DSRD(gt[1], ga, 16); SC_DSRD(gt[2], ga, 32); SC_DSRD(gt[3], ga, 48); SC_DSRD(gt[4], ga, 64); SC_DSRD(gt[5], ga, 80); SC_DSRD(gt[6], ga, 96); SC_DSRD(gt[7], ga, 112);
#undef SC_DSRD
                  asm volatile("s_waitcnt lgkmcnt(0)" : "+v"(fr[0]), "+v"(fr[1]), "+v"(fr[2]), "+v"(fr[3]), "+v"(fr[4]), "+v"(fr[5]), "+v"(fr[6]), "+v"(fr[7]), "+v"(fr[8]), "+v"(fr[9]), "+v"(fr[10]), "+v"(vf) :: "memory");
                  asm volatile("" : "+v"(gt[0]), "+v"(gt[1]), "+v"(gt[2]), "+v"(gt[3]), "+v"(gt[4]), "+v"(gt[5]), "+v"(gt[6]), "+v"(gt[7])); }
                const sc_bf16x8 sb00 = sc_pack8(S0, 0), sb01 = sc_pack8(S0, 8), sb10 = sc_pack8(S1, 0), sb11 = sc_pack8(S1, 8);
                sc_f32x16 P = {}, P2 = {};
                P = __builtin_amdgcn_mfma_f32_32x32x16_bf16(fr[0], sb00, P, 0, 0, 0);
                P2 = __builtin_amdgcn_mfma_f32_32x32x16_bf16(fr[2], sb10, P2, 0, 0, 0);
                P = __builtin_amdgcn_mfma_f32_32x32x16_bf16(fr[1], sb01, P, 0, 0, 0);
                P2 = __builtin_amdgcn_mfma_f32_32x32x16_bf16(fr[3], sb11, P2, 0, 0, 0);
                P = __builtin_amdgcn_mfma_f32_32x32x16_bf16(fr[4], vf, P, 0, 0, 0);
#pragma unroll
                for (int q = 0; q < 4; ++q)
#pragma unroll
                    for (int e = 0; e < 4; ++e) { S0[4 * q + e] *= gt[q][e]; S1[4 * q + e] *= gt[4 + q][e]; }
                S0 = __builtin_amdgcn_mfma_f32_32x32x16_bf16(fr[8], vf, S0, 0, 0, 0);
                S1 = __builtin_amdgcn_mfma_f32_32x32x16_bf16(fr[10], vf, S1, 0, 0, 0);
#pragma unroll
                for (int r = 0; r < 16; ++r) P[r] += P2[r];
                const sc_bf16x8 xb = sc_pack8(P, 0);
                sc_f32x16 U = {};
                U = __builtin_amdgcn_mfma_f32_32x32x16_bf16(fr[5], xb, U, 0, 0, 0);
                const sc_bf16x8 ub = sc_pack8(U, 0);
                S0 = __builtin_amdgcn_mfma_f32_32x32x16_bf16(fr[7], ub, S0, 0, 0, 0);
                S1 = __builtin_amdgcn_mfma_f32_32x32x16_bf16(fr[9], ub, S1, 0, 0, 0);
                P = __builtin_amdgcn_mfma_f32_32x32x16_bf16(fr[6], ub, P, 0, 0, 0);
                float* yb = Yd + (size_t)sc_tau(d, c, 0) * A_W;
#pragma unroll
                for (int r = 0; r < 8; ++r) yb[yoff[r]] = P[8 + r];
        }
        if (steady) asm volatile("s_waitcnt vmcnt(12)" ::: "memory"); else asm volatile("s_waitcnt vmcnt(0)" ::: "memory");
        asm volatile("s_waitcnt lgkmcnt(0)" ::: "memory"); __builtin_amdgcn_s_barrier(); asm volatile("" ::: "memory");
    }
    asm volatile("s_waitcnt vmcnt(0)" ::: "memory"); __syncthreads();
#undef SCM_DMA
}
__device__ __forceinline__ float conv3_u(const float* PX, int tau, unsigned ucol, float w0, float w1, float w2) {
    const float* p = PX + (size_t)tau * PXW;
    float y = p[ucol] * w1;
    if (has_left(tau)) y += (p - PXW)[ucol] * w0;
    if (has_right(tau)) y += (p + PXW)[ucol] * w2;
    return y;
}
constexpr int WLR_K = 448;
constexpr int RP_WAVE_LDS = 16896;
typedef short rp_bf16x8 __attribute__((ext_vector_type(8)));
typedef float rp_f32x16 __attribute__((ext_vector_type(16)));
__device__ __forceinline__ unsigned short f2bf16(float x) { return (unsigned short)(cvt_pk_bf16(x, x) & 0xffffu); }
template <int NKB, class AF>
__device__ __forceinline__ void rp_lowrank(float (&dst)[16], const AF& afrag, const bf16_t* WLRh, int kw0, int n, int hi) {
    rp_f32x16 c0 = {}, c1 = {}; const bf16_t* wb0 = WLRh + (size_t)n * WLR_K + kw0 + 8 * hi; const bf16_t* wb1 = wb0 + (size_t)32 * WLR_K;
#pragma unroll
    for (int kb = 0; kb < NKB; ++kb) { const rp_bf16x8 b0 = *(const rp_bf16x8*)(wb0 + 16 * kb), b1 = *(const rp_bf16x8*)(wb1 + 16 * kb); const rp_bf16x8 a_ = afrag(kb);
        c0 = __builtin_amdgcn_mfma_f32_32x32x16_bf16(a_, b0, c0, 0, 0, 0); c1 = __builtin_amdgcn_mfma_f32_32x32x16_bf16(a_, b1, c1, 0, 0, 0); }
#pragma unroll
    for (int r = 0; r < 8; ++r) { auto sw = __builtin_amdgcn_permlane32_swap(__float_as_uint(c0[r]), __float_as_uint(c1[r]), false, false);
        dst[(r & 3) + 8 * (r >> 2)] = __uint_as_float(sw[0]); dst[(r & 3) + 8 * (r >> 2) + 4] = __uint_as_float(sw[1]); }
}
struct RpAfLds { const LAS bf16_t* base; __device__ __forceinline__ rp_bf16x8 operator()(int kb) const { return *(const LAS rp_bf16x8*)(base + 16 * kb); } };
__device__ __forceinline__ void rwkv_elem_phase(const Frame& F, unsigned char* ws, int l) {
    const float* PX = (const float*)(ws + WS_PX); float* SS = (float*)(ws + WS_SS); float* SD = (float*)(ws + WS_SD); float* GB = (float*)(ws + WS_G);
    const bf16_t* WLR = (const bf16_t*)(ws + WS_WLR) + (size_t)l * A_W * WLR_K;
    const float* cw = IN_(16) + (size_t)l * 3 * A_IN;
    LAS bf16_t* ACT = (LAS bf16_t*)(F.lds + F.wave * 10752);
    const int lane = F.lane, n = lane & 31, hi = lane >> 5;
    const int gw = F.bid * 8 + F.wave, NGW = F.G * 8;
    for (int it = gw; it < (T / 16) * 10; it += NGW) {
        const int tg = it / 10, hq = it % 10, tau0 = tg * 16;
        asm volatile("s_waitcnt lgkmcnt(0)" ::: "memory");
        const float* prow0 = PX + (size_t)(tau0 > 0 ? tau0 - 1 : 0) * PXW; const int roff = tau0 > 0 ? 0 : -1;
#define RP_WIN(x, ucol_) do { _Pragma("unroll") for (int i_ = 0; i_ < 18; ++i_) { int ri_ = i_ + roff; ri_ = ri_ < 0 ? 0 : ri_; ri_ = (tau0 - 1 + i_ > T - 1) ? (T - 1 - (tau0 > 0 ? tau0 - 1 : 0)) : ri_; x[i_] = (prow0 + (size_t)ri_ * PXW)[ucol_]; } } while (0)
#define RP_CONV(x, t_, w0_, w1_, w2_) (x[(t_)] * (has_left(tau0 + (t_)) ? (w0_) : 0.f) + x[(t_) + 1] * (w1_) + x[(t_) + 2] * (has_right(tau0 + (t_)) ? (w2_) : 0.f))
#pragma unroll
        for (int i = 0; i < 5; ++i) { const int c = lane + 64 * i, col = 3840 + c; const float c0 = cw[col], c1 = cw[A_IN + col], c2 = cw[2 * A_IN + col];
            float x[18]; RP_WIN(x, (unsigned)(PXA + col));
#pragma unroll
            for (int t = 0; t < 16; ++t) { const float val = RP_CONV(x, t, c0, c1, c2);
                const float act = i == 0 ? 1.0f - 2.0f / (1.0f + __expf(2.0f * val)) : (i == 1 ? val : sigmoidf_(val));
                ACT[t * 328 + c] = f2bf16(act); } }
        asm volatile("s_waitcnt lgkmcnt(0)" ::: "memory");
        const RpAfLds afw{ACT + (n & 15) * 328 + 8 * hi}, afa{ACT + (n & 15) * 328 + 64 + 8 * hi}, afg{ACT + (n & 15) * 328 + 128 + 8 * hi};
#pragma unroll 1
        for (int hh = 0; hh < 2; ++hh) {
            const int h = hq * 2 + hh, col = h * 64 + lane; const bf16_t* WLRh = WLR + (size_t)h * 64 * WLR_K;
            { float lg[16]; rp_lowrank<12>(lg, afg, WLRh, 256, n, hi);
#pragma unroll
              for (int t = 0; t < 16; ++t) GB[(size_t)(tau0 + t) * A_W + col] = lg[t]; }
            const float cr0 = cw[col], cr1 = cw[A_IN + col], cr2 = cw[2 * A_IN + col];
            const float ck0 = cw[A_W + col], ck1 = cw[A_IN + A_W + col], ck2 = cw[2 * A_IN + A_W + col];
            const float cv0 = cw[2 * A_W + col], cv1 = cw[A_IN + 2 * A_W + col], cv2 = cw[2 * A_IN + 2 * A_W + col];
            const float kk_w = IN_(22)[l * A_W + col], ka_w = IN_(23)[l * A_W + col];
            float kkv[16], kv[16];
            { float xr[18], xk[18], xv[18]; const unsigned uc = (unsigned)(PXA + col); RP_WIN(xr, uc); RP_WIN(xk, uc + A_W); RP_WIN(xv, uc + 2 * A_W);
#pragma unroll
              for (int t = 0; t < 16; ++t) { const int tau = tau0 + t;
                  const float r = RP_CONV(xr, t, cr0, cr1, cr2), v = RP_CONV(xv, t, cv0, cv1, cv2); kv[t] = RP_CONV(xk, t, ck0, ck1, ck2);
                  const float kr = kv[t] * kk_w; const float nrm = sqrtf(wave_sum(kr * kr)); kkv[t] = kr / fmaxf(nrm, 1e-12f);
                  float* ss = SS + ((size_t)h * T + tau) * 192 + lane; ss[0] = kkv[t]; ss[64] = r; ss[128] = v; } }
#pragma unroll 1
            for (int d = 0; d < 2; ++d) { const float w0b = IN_(17)[(l * 2 + d) * A_W + col], a0b = IN_(19)[(l * 2 + d) * A_W + col]; float lw[16], la[16];
                rp_lowrank<4>(lw, afw, WLRh, 64 * d, n, hi); rp_lowrank<4>(la, afa, WLRh, 128 + 64 * d, n, hi);
#pragma unroll
                for (int t = 0; t < 16; ++t) { const float z = w0b + lw[t]; const float decay = __expf(-__expf(-(fmaxf(-z, 0.f) + __logf(1.0f + __expf(-fabsf(z)))) - 0.5f)); const float av = sigmoidf_(a0b + la[t]);
                    float* sd = SD + (((size_t)h * 2 + d) * T + tau0 + t) * 192 + lane; sd[0] = decay; sd[64] = kkv[t] * av; sd[128] = kv[t] * (1.0f + (av - 1.0f) * ka_w); } }
        }
    }
}
#undef RP_WIN
#undef RP_CONV
constexpr int SP_WAVE_LDS = 16640;
__device__ __forceinline__ void scan_prep_phase(const Frame& F, unsigned char* ws) {
    const float* SS = (const float*)(ws + WS_SS); const float* SD = (const float*)(ws + WS_SD); unsigned char* FR = ws + WS_FR;
    LAS bf16_t* R1 = (LAS bf16_t*)(F.lds + F.wave * SP_WAVE_LDS); LAS bf16_t* R2 = R1 + 32 * 72; LAS bf16_t* BbT = R2 + 32 * 72; LAS bf16_t* KbT = BbT + 64 * 16; LAS bf16_t* VT = KbT + 64 * 16; LAS float* Lm = (LAS float*)(VT + 64 * 16);
    const int lane = F.lane, n = lane & 31, hi = lane >> 5;
    const int gw = F.bid * 8 + F.wave, NGW = F.G * 8;
    for (int it = gw; it < 2 * NHA * SC_NCHUNK; it += NGW) {
        const int chain = it / SC_NCHUNK, c = it % SC_NCHUNK, h = chain >> 1, d = chain & 1;
        const int tau_first = sc_tau(d, c, 0), dstep = d ? -1 : 1;
        const float* ssb = SS + (size_t)h * T * 192 + lane; const float* sdb = SD + ((size_t)h * 2 + d) * T * 192 + lane;
        float xw[16], xb[16], xk[16], xkk[16], xr[16], xv[16];
#pragma unroll
        for (int s = 0; s < 16; ++s) { const size_t o = (size_t)(tau_first + dstep * s) * 192; xw[s] = sdb[o]; xb[s] = sdb[o + 64]; xk[s] = sdb[o + 128]; xkk[s] = ssb[o]; xr[s] = ssb[o + 64]; xv[s] = ssb[o + 128]; }
        float gC = 1.f;
#pragma unroll
        for (int s = 0; s < 16; ++s) gC *= xw[s];
        float g = 1.f;
#pragma unroll
        for (int s = 0; s < 16; ++s) {
            const float gm1 = g; g *= xw[s]; const float ig = 1.0f / g; const float bh = xb[s] * ig, kh = xk[s] * ig;
            R1[s * 72 + lane] = f2bf16(-xkk[s] * gm1); R1[(16 + s) * 72 + lane] = f2bf16(xr[s] * g);
            R2[s * 72 + lane] = f2bf16(bh); R2[(16 + s) * 72 + lane] = f2bf16(kh);
            BbT[lane * 16 + s] = f2bf16(bh * gC); KbT[lane * 16 + s] = f2bf16(kh * gC); VT[lane * 16 + s] = f2bf16(xv[s]); }
        asm volatile("s_waitcnt lgkmcnt(0)" ::: "memory");
        unsigned char* dst = FR + ((size_t)chain * SC_NCHUNK + c) * SC_CHUNK_BYTES;
        rp_f32x16 C = {};
#pragma unroll
        for (int kb = 0; kb < 4; ++kb) { const rp_bf16x8 a_ = *(const LAS rp_bf16x8*)(R2 + n * 72 + 16 * kb + 8 * hi), b_ = *(const LAS rp_bf16x8*)(R1 + n * 72 + 16 * kb + 8 * hi);
            C = __builtin_amdgcn_mfma_f32_32x32x16_bf16(a_, b_, C, 0, 0, 0); }
        const int tt_ = n & 15; const bool incl = n >= 16;
#pragma unroll
        for (int r = 0; r < 16; ++r) { const int s = ((r & 7) & 3) + 8 * ((r & 7) >> 2) + 4 * hi; if (!(s < tt_ || (incl && s == tt_))) C[r] = 0.f; }
        if (n < 16) {
#pragma unroll
            for (int r = 0; r < 8; ++r) Lm[((r & 3) + 8 * (r >> 2) + 4 * hi) * 20 + n] = C[r]; }
        { u32x4 f4; f4.x = cvt_pk_bf16(C[8], C[9]); f4.y = cvt_pk_bf16(C[10], C[11]); f4.z = cvt_pk_bf16(C[12], C[13]); f4.w = cvt_pk_bf16(C[14], C[15]);
          u32x4 f6; f6.x = cvt_pk_bf16(C[0], C[1]); f6.y = cvt_pk_bf16(C[2], C[3]); f6.z = cvt_pk_bf16(C[4], C[5]); f6.w = cvt_pk_bf16(C[6], C[7]);
          if (n < 16) f6 = (u32x4){0u, 0u, 0u, 0u};
          *(u32x4*)(dst + 4 * 1024 + lane * 16) = f4; *(u32x4*)(dst + 6 * 1024 + lane * 16) = f6; }
        asm volatile("s_waitcnt lgkmcnt(0)" ::: "memory");
        { float Tc[16];
#pragma unroll
          for (int s = 15; s >= 0; --s) { float acc = (s == n) ? 1.f : 0.f;
#pragma unroll
              for (int u = s + 1; u < 16; ++u) acc += Lm[s * 20 + u] * Tc[u];
              Tc[s] = acc; }
          u32x4 f5; f5.x = cvt_pk_bf16(hi ? Tc[4] : Tc[0], hi ? Tc[5] : Tc[1]); f5.y = cvt_pk_bf16(hi ? Tc[6] : Tc[2], hi ? Tc[7] : Tc[3]);
          f5.z = cvt_pk_bf16(hi ? Tc[12] : Tc[8], hi ? Tc[13] : Tc[9]); f5.w = cvt_pk_bf16(hi ? Tc[14] : Tc[10], hi ? Tc[15] : Tc[11]);
          if (n >= 16) f5 = (u32x4){0u, 0u, 0u, 0u};
          *(u32x4*)(dst + 5 * 1024 + lane * 16) = f5; }
#pragma unroll
        for (int f = 0; f < 4; ++f) { const u32x2 p0 = *(const LAS u32x2*)(R1 + n * 72 + 16 * f + 4 * hi), p1 = *(const LAS u32x2*)(R1 + n * 72 + 16 * f + 8 + 4 * hi);
            *(u32x4*)(dst + f * 1024 + lane * 16) = (u32x4){p0.x, p0.y, p1.x, p1.y}; }
#pragma unroll
        for (int jb = 0; jb < 2; ++jb) { const int row = 32 * jb + n;
            const u32x2 b0 = *(const LAS u32x2*)(BbT + row * 16 + 4 * hi), b1 = *(const LAS u32x2*)(BbT + row * 16 + 8 + 4 * hi), k0 = *(const LAS u32x2*)(KbT + row * 16 + 4 * hi), k1 = *(const LAS u32x2*)(KbT + row * 16 + 8 + 4 * hi);
            const u32x2 v0 = *(const LAS u32x2*)(VT + row * 16 + 4 * hi), v1 = *(const LAS u32x2*)(VT + row * 16 + 8 + 4 * hi);
            *(u32x4*)(dst + (7 + 2 * jb) * 1024 + lane * 16) = (u32x4){b0.x, b0.y, b1.x, b1.y}; *(u32x4*)(dst + (8 + 2 * jb) * 1024 + lane * 16) = (u32x4){k0.x, k0.y, k1.x, k1.y};
            *(u32x4*)(dst + (11 + jb) * 1024 + lane * 16) = (u32x4){v0.x, v0.y, v1.x, v1.y}; }
        { const int jj = lane & 31; ((float*)(dst + 13 * 1024))[((jj >> 2) & 1) * 32 + (lane >> 5) * 16 + (jj & 3) + 4 * (jj >> 3)] = gC; }
        asm volatile("s_waitcnt lgkmcnt(0)" ::: "memory");
    }
}
__device__ __forceinline__ void mixer_phase(const Frame& F0, unsigned char* ws0, int lq, bool need_ctx, char* lds_g) {
    const int l = lq & 3;
#ifndef MK_MIX
#define MK_MIX 15
#endif
    { const Frame F = opq(F0); unsigned char* ws = opq_ptr(ws0);
      if (MK_MIX & 1) for (int chain = F.bid; chain < 2 * NHA; chain += F.G) scan_chain_mfma(F, ws, chain); }
    const Frame& F = F0;
    const int n_xa = 32 * NHC, n_ca = need_ctx ? NHC : 0, n_att = n_xa + n_ca, n_hy = 640, n_ch = need_ctx ? 160 : 0;
    unsigned* qatt = (unsigned*)(ws0 + WS_CTL) + CW_QUEUE + 64 * lq; unsigned* qhy = qatt + 32;
    int item;
#define MIX_POP(q) do { if (F.tid == 0) F.MISC[16] = __hip_atomic_fetch_add((q), 1u, __ATOMIC_RELAXED, __HIP_MEMORY_SCOPE_AGENT); __syncthreads(); item = (int)F.MISC[16]; __syncthreads(); } while (0)
    if (F.bid >= 2 * NHA) {
        MIX_POP(qatt);
        while (item < n_att) {
            if (MK_MIX & 2) { unsigned char* ws = opq_ptr(ws0);
                const bf16_t* QF = (const bf16_t*)(ws + WS_QF); const bf16_t* KF = (const bf16_t*)(ws + WS_KF); const bf16_t* KVRAW = (const bf16_t*)(ws + WS_KVRAW); bf16_t* OB = (bf16_t*)(ws + WS_OBUF);
                const bool is_xa = item < n_xa; const int h = is_xa ? item % NHC : item - n_xa, row0 = is_xa ? NCTX + (item / NHC) * 256 : 0;
                for (int rp = 0; rp < REP(13); ++rp) att::attn_body(QF + (size_t)row0 * NQ + h * 192, KF + h * 192, KVRAW + h * 256 + 128, OB + (size_t)row0 * DM + 2560 + h * 128, is_xa ? T : NCTX, lds_g); }
            MIX_POP(qatt);
        }
    }
    MIX_POP(qhy);
    while (item < n_hy + n_ch) {
        const Frame Fu = opq(F0); unsigned char* ws = opq_ptr(ws0);
        if ((MK_MIX & 4) && item < n_hy) hyena_unit(Fu, ws, l, item);
        else if ((MK_MIX & 8) && item >= n_hy) hyena_ctx_unit(Fu, ws, l, item - n_hy);
        MIX_POP(qhy);
    }
#undef MIX_POP
}

__device__ __forceinline__ void hyena_taps_tail(const Frame& F0, unsigned char* ws0, int lt, int first, int end) {
    if (F0.bid < 48) return;
#pragma unroll 1
    for (int p = first + F0.bid - 48; p < end; p += 208) hyena_taps_unit(opq(F0), opq_ptr(ws0), lt, p);
}
constexpr int NPH = 2 + 14 * NL;
__global__ void __launch_bounds__(512, 2) mk_fwd(Args a) {
    extern __shared__ __attribute__((aligned(16))) unsigned char lds[];
    Frame F; F.lds = (LAS unsigned char*)lds; F.MISC = (volatile LAS unsigned*)(F.lds + LDS_MISC);
    F.tid = threadIdx.x; F.lane = F.tid & 63; F.wave = __builtin_amdgcn_readfirstlane(F.tid >> 6); F.bid = blockIdx.x; F.G = gridDim.x;
    if (F.tid < 64) F.MISC[F.tid] = 0u;
    if (F.tid < 46) *(LAS unsigned long long*)(F.lds + LDS_PTAB + 8 * F.tid) = (unsigned long long)(uintptr_t)a.in[F.tid];
    __syncthreads();
    unsigned char* ws = a.ws;
    const int lo = a.ph_lo, hi = a.ph_hi;
    XcdBarrier bar = xcd_barrier_post((unsigned*)(ws + WS_CTL) + CW_BAR, F.MISC + 8);
#ifndef MK_MASK
#define MK_MASK 0xffff
#endif
#define EN(x) (((MK_MASK) >> (x)) & 1)
#define IN(k) (lo <= (k) && (k) < hi)
#define SEAM(k) do { if (IN(k) && IN((k) + 1)) xcd_barrier(bar); } while (0)
#define WSP opq_ptr(ws)
#define P_XS(w) ((float*)((w) + WS_XS))
#define P_ABUF(w) ((bf16_t*)((w) + WS_ABUF))
#define P_HBUF(w) ((bf16_t*)((w) + WS_HBUF))
#define P_OBUF(w) ((bf16_t*)((w) + WS_OBUF))
#define P_MODX(w, l) ((const float*)((w) + WS_MOD) + ((size_t)(l) * 2 + 0) * NMOD)
#define P_MODC(w, l) ((const float*)((w) + WS_MOD) + ((size_t)(l) * 2 + 1) * NMOD)
#define P_WL(w, l) ((const bf16_t*)((w) + WS_WB) + (size_t)(l) * W_LAYER)
    if (EN(0) && IN(0)) for (int rp = 0; rp < REP(0); ++rp) phase0(opq(F), opq_ptr(ws));
    SEAM(0);
    if (EN(1) && IN(1)) phase_mod(opq(F), opq_ptr(ws));
    SEAM(1);
#pragma clang loop unroll(full)
    for (int l = 0; l < NL; ++l) {
        const int pb = 2 + 14 * l; const bool need_ctx = l < NL - 1;
        if (EN(2) && IN(pb + 0)) for (int rp = 0; rp < REP(2); ++rp) { unsigned char* w = WSP; norm_phase(opq(F), P_XS(w), IN_(7) + l * DM, P_MODX(w, l), P_MODC(w, l), 0, 1, P_ABUF(w), l > 0 ? (const float*)(w + WS_SLAB) : nullptr, l > 0 ? P_MODC(w, l - 1) + 8 * DM : nullptr, 0.5f); }
        SEAM(pb + 0);
        if (EN(3) && IN(pb + 1)) { unsigned char* w = WSP; pg8::Gemm g{P_ABUF(w), P_WL(w, l) + W_G1, T, 2 * FF, DM, DM}; pg8::StaticOrder S; S.init(T, 2 * FF, F.G, F.bid); pg8::EpiSwiGLU E{P_HBUF(w), FF};
            pg8::gemm_phase<pg8::EpiSwiGLU, pg8::StaticOrder>(F.lds, g, S, E, nullptr);
            hyena_taps_tail(F, ws, l, 0, l == 0 ? 640 : 416); }
        SEAM(pb + 1);
        if (EN(4) && IN(pb + 2)) {
            { unsigned char* w = WSP; pg8::Gemm g{P_HBUF(w), P_WL(w, l) + W_D1, T, DM, FF, FF}; pg8::StaticOrderX S; S.init(T, DM, F.G, F.bid); pg8::EpiResid E{P_XS(w), P_MODX(w, l) + 2 * DM, P_MODC(w, l) + 2 * DM, 0.5f, nullptr};
              pg8::gemm_phase<pg8::EpiResid, pg8::StaticOrderX>(F.lds, g, S, E, nullptr); }
            if (true) { __syncthreads();
              if (F.bid < 256) { unsigned char* w = WSP; const int ks = F.bid >> 4, ksz = FF / 16; pg8::Gemm g{P_HBUF(w) + ks * ksz, P_WL(w, l) + W_D1 + ks * ksz, NCTX, DM, ksz, FF}; pg8::OneUnit S{F.bid & 15};
                  pg8::EpiF32 E{(float*)(w + WS_SLAB) + (size_t)ks * NCTX * DM, DM, nullptr};
                  pg8::gemm_phase<pg8::EpiF32, pg8::OneUnit>(F.lds, g, S, E, nullptr); } }
        }
        SEAM(pb + 2);
        if (EN(5) && IN(pb + 3)) for (int rp = 0; rp < REP(2); ++rp) { unsigned char* w = WSP; norm_phase(opq(F), P_XS(w), IN_(8) + l * DM, P_MODX(w, l), P_MODC(w, l), 3, 4, P_ABUF(w), (const float*)(w + WS_SLAB), P_MODC(w, l) + 2 * DM, 0.5f); }
        SEAM(pb + 3);
        if (EN(6) && IN(pb + 4)) { unsigned char* w = WSP; pg8::Gemm g{P_ABUF(w), P_WL(w, l) + W_IN, T, PXW, DM, DM}; pg8::StaticOrder S; S.init(T, PXW, F.G, F.bid); pg8::EpiF32 E{(float*)(w + WS_PX), PXW, nullptr};
            pg8::gemm_phase<pg8::EpiF32, pg8::StaticOrder>(F.lds, g, S, E, nullptr); }
        SEAM(pb + 4);
        if (EN(7) && IN(pb + 5)) { for (int rp = 0; rp < REP(7); ++rp) rwkv_elem_phase(opq(F), opq_ptr(ws), l); if (!(MK_ONLYRP)) { for (int rp = 0; rp < REP(8); ++rp) mla_prep_phase(opq(F), opq_ptr(ws), l); hyena_prep_phase(opq(F), opq_ptr(ws), l); } }
        SEAM(pb + 5);
        if (EN(8) && IN(pb + 6)) {
            { unsigned char* w = WSP; pg8::Gemm g{(const bf16_t*)(w + WS_QA), P_WL(w, l) + W_Q, T, NQ, 1024, 1024}; pg8::StaticOrder S; S.init(T, NQ, F.G, F.bid); pg8::EpiBf16<0> E{(bf16_t*)(w + WS_QRAW), NQ, nullptr, 0, 0};
              pg8::gemm_phase<pg8::EpiBf16<0>, pg8::StaticOrder>(F.lds, g, S, E, nullptr); }
            __syncthreads();
            { unsigned char* w = WSP; pg8::Gemm g{(const bf16_t*)(w + WS_KVA), P_WL(w, l) + W_KV, T, NKV, 512, 512}; pg8::StaticOrder S; S.init(T, NKV, F.G, F.bid); pg8::EpiBf16<0> E{(bf16_t*)(w + WS_KVRAW), NKV, nullptr, 0, 0};
              pg8::gemm_phase<pg8::EpiBf16<0>, pg8::StaticOrder>(F.lds, g, S, E, nullptr); }
        }
        SEAM(pb + 6);
        if (EN(9) && IN(pb + 7)) { for (int rp = 0; rp < REP(8); ++rp) qkv_final_phase(opq(F), opq_ptr(ws), l, need_ctx); for (int rp = 0; rp < REP(9); ++rp) scan_prep_phase(opq(F), opq_ptr(ws)); }
        SEAM(pb + 7);
        if (EN(10) && IN(pb + 8)) for (int rp = 0; rp < REP(10); ++rp) mixer_phase(F, ws, l + 4 * rp, need_ctx, (char*)lds);
        SEAM(pb + 8);
        if (EN(11) && IN(pb + 9)) { for (int rp = 0; rp < REP(8); ++rp) rwkv_out_phase(opq(F), opq_ptr(ws), l, need_ctx); hyena_out_phase(opq(F), opq_ptr(ws), need_ctx); }
        SEAM(pb + 9);
        if (EN(12) && IN(pb + 10)) {
            { unsigned char* w = WSP; pg8::Gemm g{P_OBUF(w), P_WL(w, l) + W_OUT, T, DM, DM, DM}; pg8::StaticOrderX S; S.init(T, DM, F.G, F.bid); pg8::EpiResid E{P_XS(w), P_MODX(w, l) + 5 * DM, P_MODC(w, l) + 5 * DM, 1.0f, nullptr};
              pg8::gemm_phase<pg8::EpiResid, pg8::StaticOrderX>(F.lds, g, S, E, nullptr); }
            if (need_ctx) { __syncthreads();
              if (F.bid < 256) { unsigned char* w = WSP; const int ks = F.bid >> 4, ksz = DM / 16; pg8::Gemm g{P_OBUF(w) + ks * ksz, P_WL(w, l) + W_OUT + ks * ksz, NCTX, DM, ksz, DM}; pg8::OneUnit S{F.bid & 15};
                  pg8::EpiF32 E{(float*)(w + WS_SLAB) + (size_t)ks * NCTX * DM, DM, nullptr};
                  pg8::gemm_phase<pg8::EpiF32, pg8::OneUnit>(F.lds, g, S, E, nullptr); } }
        }
        SEAM(pb + 10);
        if (EN(13) && IN(pb + 11)) for (int rp = 0; rp < REP(2); ++rp) { unsigned char* w = WSP; norm_phase(opq(F), P_XS(w), IN_(9) + l * DM, P_MODX(w, l), P_MODC(w, l), 6, 7, P_ABUF(w), need_ctx ? (const float*)(w + WS_SLAB) : nullptr, P_MODC(w, l) + 5 * DM, 1.0f); }
        SEAM(pb + 11);
        if (EN(14) && IN(pb + 12)) { if (need_ctx) { unsigned char* w = WSP; pg8::Gemm g{P_ABUF(w), P_WL(w, l) + W_G2, T, 2 * FF, DM, DM}; pg8::StaticOrder S; S.init(T, 2 * FF, F.G, F.bid); pg8::EpiSwiGLU E{P_HBUF(w), FF};
            pg8::gemm_phase<pg8::EpiSwiGLU, pg8::StaticOrder>(F.lds, g, S, E, nullptr);
            hyena_taps_tail(F, ws, l + 1, 416, 640); }       else { unsigned char* w = WSP; pg8::Gemm g{P_ABUF(w), P_WL(w, l) + W_G2, T, 2 * FF, DM, DM}; pg8::StaticOrderX S; S.init(T, 2 * FF, F.G, F.bid); pg8::EpiSwiGLU E{P_HBUF(w), FF};
            pg8::gemm_phase<pg8::EpiSwiGLU, pg8::StaticOrderX>(F.lds, g, S, E, nullptr); } }
        SEAM(pb + 12);
        if (EN(15) && IN(pb + 13)) {
            { unsigned char* w = WSP; pg8::Gemm g{P_HBUF(w), P_WL(w, l) + W_D2, T, DM, FF, FF}; pg8::StaticOrderX S; S.init(T, DM, F.G, F.bid); pg8::EpiResid E{P_XS(w), P_MODX(w, l) + 8 * DM, P_MODC(w, l) + 8 * DM, 0.5f, l == NL - 1 ? a.out : nullptr};
              pg8::gemm_phase<pg8::EpiResid, pg8::StaticOrderX>(F.lds, g, S, E, nullptr); }
            if (need_ctx) { __syncthreads();
              if (F.bid < 256) { unsigned char* w = WSP; const int ks = F.bid >> 4, ksz = FF / 16; pg8::Gemm g{P_HBUF(w) + ks * ksz, P_WL(w, l) + W_D2 + ks * ksz, NCTX, DM, ksz, FF}; pg8::OneUnit S{F.bid & 15};
                  pg8::EpiF32 E{(float*)(w + WS_SLAB) + (size_t)ks * NCTX * DM, DM, nullptr};
                  pg8::gemm_phase<pg8::EpiF32, pg8::OneUnit>(F.lds, g, S, E, nullptr); } }
        }
        SEAM(pb + 13);
    }
#undef IN
#undef SEAM
}

#ifndef MK_LAUNCHES
#define MK_LAUNCHES 1
#endif
extern "C" void kernel_launch(void* const* d_in, const int* in_sizes, int n_in, void* d_out, int out_size, void* d_ws, size_t ws_size, hipStream_t stream) {
    static int grid = 0;
    if (grid == 0) {
        if (n_in != 46 || in_sizes[0] != SEQ * DM || out_size != SEQ * DM || ws_size < WS_END) {
            fprintf(stderr, "kernel_launch: shape mismatch: n_in %d in0 %d out %d ws %zu (need %zu); nothing launched\n", n_in, n_in > 0 ? in_sizes[0] : -1, out_size, ws_size, (size_t)WS_END); grid = -1; return; }
        int dev = 0, cus = 0, per_cu = 0;
        if (hipGetDevice(&dev) != hipSuccess || hipDeviceGetAttribute(&cus, hipDeviceAttributeMultiprocessorCount, dev) != hipSuccess) { fprintf(stderr, "kernel_launch: device query failed\n"); grid = -1; return; }
        if (hipFuncSetAttribute((const void*)mk_fwd, hipFuncAttributeMaxDynamicSharedMemorySize, LDS_BYTES) != hipSuccess) { fprintf(stderr, "kernel_launch: hipFuncSetAttribute failed\n"); grid = -1; return; }
        if (hipOccupancyMaxActiveBlocksPerMultiprocessor(&per_cu, (const void*)mk_fwd, 512, LDS_BYTES) != hipSuccess || per_cu < 1) fprintf(stderr, "kernel_launch: note: occupancy query reports %d blocks per CU\n", per_cu);
        (void)hipGetLastError();
        grid = cus;
        if (cus != 256) { fprintf(stderr, "kernel_launch: built for 256 CUs (split-K of the context panel, hyena scratch), found %d; nothing launched\n", cus); grid = -1; return; }
    }
    if (grid < 0) return;
    if (hipMemsetAsync((char*)d_ws + WS_CTL, 0, CTL_BYTES, stream) != hipSuccess) { fprintf(stderr, "kernel_launch: memset failed\n"); return; }
    Args a{};
    for (int i = 0; i < 46; ++i) a.in[i] = (const float*)d_in[i];
    a.out = (float*)d_out; a.ws = (unsigned char*)d_ws;
    a.ph_lo = 0; a.ph_hi = NPH;
    hipLaunchKernelGGL(mk_fwd, dim3(grid), dim3(512), LDS_BYTES, stream, a);
    const hipError_t le = hipPeekAtLastError();
    if (le != hipSuccess) fprintf(stderr, "kernel_launch: launch failed: %s\n", hipGetErrorName(le));
}
```

```cpp
#include <hip/hip_runtime.h>
#include <stdint.h>
#include <cstdio>

#define LAS __attribute__((address_space(3)))
#define CAS __attribute__((address_space(4)))
typedef unsigned short bf16_t;
typedef float f32x4 __attribute__((ext_vector_type(4)));
typedef float f32x2 __attribute__((ext_vector_type(2)));
typedef unsigned u32x4 __attribute__((ext_vector_type(4)));
typedef unsigned u32x2 __attribute__((ext_vector_type(2)));

constexpr int T = 8448, NCTX = 256, SEQ = 8192, DM = 4096, FF = 6144, NL = 4;
constexpr int A_W = 1280, A_IN = 4160, B_IN = 3840, C_IN = 1600, NHA = 20;
constexpr int PXW = 9728, PXA = 0, PXB = 4160, PXC = 8000;
constexpr int NQ = 2304, NKV = 3072, NHC = 12;
constexpr int NMOD = 9 * DM;
constexpr float NORM_EPS = 1e-6f, GN_EPS = 64e-5f;

constexpr size_t MiB = 1u << 20;
constexpr size_t al(size_t x) { return (x + MiB - 1) / MiB * MiB; }
constexpr size_t WS_CTL = 0, CTL_BYTES = MiB;
constexpr size_t WS_XS = WS_CTL + CTL_BYTES;
constexpr size_t WS_ABUF = WS_XS + al((size_t)T * DM * 4);
constexpr size_t WS_HBUF = WS_ABUF + al((size_t)T * DM * 2);
constexpr size_t WS_OBUF = WS_HBUF + al((size_t)T * FF * 2);
constexpr size_t WS_PX = WS_OBUF + al((size_t)T * DM * 2);
constexpr size_t WS_MOD = WS_PX + al((size_t)T * PXW * 4);
constexpr size_t WS_HP = WS_MOD + al((size_t)NL * 2 * NMOD * 4);
constexpr size_t WS_SS = WS_HP + MiB;
constexpr size_t WS_SD = WS_SS + al((size_t)NHA * T * 192 * 4);
constexpr size_t WS_WLR = WS_SD + al((size_t)NHA * 2 * T * 192 * 4);
constexpr size_t WS_G = WS_WLR + al((size_t)NL * A_W * 448 * 2);
constexpr size_t WS_Y = WS_G + al((size_t)T * A_W * 4);
constexpr size_t WS_QA = WS_Y + al((size_t)2 * T * A_W * 4);
constexpr size_t WS_KVA = WS_QA + al((size_t)T * 1024 * 2);
constexpr size_t WS_KPE = WS_KVA + al((size_t)T * 512 * 2);
constexpr size_t WS_QRAW = WS_KPE + al((size_t)T * 64 * 2);
constexpr size_t WS_KVRAW = WS_QRAW + al((size_t)T * NQ * 2);
constexpr size_t WS_QF = WS_KVRAW + al((size_t)T * NKV * 2);
constexpr size_t WS_KF = WS_QF + al((size_t)T * NQ * 2);
constexpr size_t WS_H3 = WS_KF + al((size_t)T * NQ * 2);
constexpr size_t WS_HSCR = WS_H3 + al((size_t)NL * T * 64 * 4);
constexpr size_t WS_FR = WS_HSCR + al((size_t)640 * 16384 * 8 + 640 * 8);
constexpr size_t WS_GT = WS_FR + al((size_t)40 * 528 * (14 * 1024));
constexpr size_t WS_X0T = WS_GT + al((size_t)1280 * T * 4);
constexpr size_t WS_SLAB = WS_FR;
constexpr size_t WS_WB = WS_X0T + al((size_t)1280 * T * 4);
constexpr size_t W_G1 = 0, W_D1 = W_G1 + (size_t)2 * FF * DM, W_IN = W_D1 + (size_t)DM * FF, W_OUT = W_IN + (size_t)PXW * DM, W_G2 = W_OUT + (size_t)DM * DM,
                 W_D2 = W_G2 + (size_t)2 * FF * DM, W_Q = W_D2 + (size_t)DM * FF, W_KV = W_Q + (size_t)NQ * 1024, W_LAYER = W_KV + (size_t)NKV * 512;
constexpr size_t WS_END = WS_WB + al(W_LAYER * NL * 2);
constexpr int CW_BAR = 4096;
constexpr int CW_QUEUE = 8192;

constexpr int LDS_MISC = 143360, LDS_BYTES = 147456;

__device__ __forceinline__ float wave_sum(float v) {
#pragma unroll
    for (int o = 1; o < 64; o <<= 1) v += __shfl_xor(v, o);
    return v;
}
typedef __bf16 bf16x2_t __attribute__((ext_vector_type(2)));
__device__ __forceinline__ unsigned cvt_pk_bf16(float lo, float hi) { const f32x2 v = {lo, hi}; return __builtin_bit_cast(unsigned, __builtin_convertvector(v, bf16x2_t)); }
__device__ __forceinline__ float bf2f(unsigned short b) { return __uint_as_float(((unsigned)b) << 16); }
__device__ __forceinline__ float sigmoidf_(float x) { return 1.0f / (1.0f + __expf(-x)); }
__device__ __forceinline__ float siluf_(float x) { return x / (1.0f + __expf(-x)); }
__device__ __forceinline__ bool has_left(int tau) { return tau != 0 && tau != NCTX; }
__device__ __forceinline__ bool has_right(int tau) { return tau != NCTX - 1 && tau != T - 1; }

struct Args { const float* in[46]; float* out; unsigned char* ws; int ph_lo, ph_hi; };
struct Frame { LAS unsigned char* lds; volatile LAS unsigned* MISC; int tid, lane, wave, bid, G; };
constexpr int LDS_PTAB = LDS_MISC + 2048;
__device__ __forceinline__ const float* inp(const Frame& F, int i) {
    const volatile LAS unsigned* p = (const volatile LAS unsigned*)(F.lds + LDS_PTAB) + 2 * i;
    const unsigned lo = __builtin_amdgcn_readfirstlane(p[0]), hi = __builtin_amdgcn_readfirstlane(p[1]);
    return (const float*)(((unsigned long long)hi << 32) | lo);
}
#define IN_(i) inp(F, (i))
__device__ __forceinline__ Frame opq(const Frame& F) { Frame G = F; asm volatile("" : "+v"(G.tid), "+s"(G.wave), "+s"(G.bid)); G.lane = G.tid & 63; return G; }
__device__ __forceinline__ unsigned char* opq_ptr(unsigned char* p) { asm volatile("" : "+s"(p)); return p; }
#ifndef MK_REP
#define MK_REP 0
#endif
#ifndef MK_ONLYRP
#define MK_ONLYRP 0
#endif
#define REP(x) (1 + (((MK_REP) >> (x)) & 1))
#define XB_TMO      128
#define XB_XCNT(j)  (256  + 64 * (j))
#define XB_XSUB(j)  (1280 + 64 * (j))
#define XB_XGEN(j)  (2304 + 64 * (j))
#define XB_TOP      3328
#define XB_TOPGEN   3392
#define XCD_BAR_WORDS 3456
#define XB_SPIN_CAP (1u << 18)

__device__ __forceinline__ unsigned xb_ld(unsigned* p)              { return __hip_atomic_load(p, __ATOMIC_RELAXED, __HIP_MEMORY_SCOPE_AGENT); }
__device__ __forceinline__ unsigned xb_add(unsigned* p, unsigned v) { return __hip_atomic_fetch_add(p, v, __ATOMIC_RELAXED, __HIP_MEMORY_SCOPE_AGENT); }
__device__ __forceinline__ unsigned xb_xcc_id() { return (unsigned)__builtin_amdgcn_s_getreg((3 << 11) | 20) & 0xFu; }
#define XB_SPIN(cond, bar) do { unsigned _sp = 0; while (cond) { __builtin_amdgcn_s_sleep(1); \
    if ((++_sp & 255u) == 0u) { if (xb_ld(&(bar)[XB_TMO])) break; if (_sp > XB_SPIN_CAP) { atomicAdd(&(bar)[XB_TMO], 1u); break; } } } } while (0)

struct XcdBarrier {
    unsigned* bar; unsigned x;
    volatile LAS unsigned* st;
};

__device__ __forceinline__ XcdBarrier xcd_barrier_post(unsigned* bar, volatile LAS unsigned* st) {
    XcdBarrier b; b.bar = bar; b.x = xb_xcc_id(); b.st = st;
    if (threadIdx.x == 0) (void)xb_add(&bar[XB_XCNT(b.x)], 1u);
    return b;
}
__device__ __forceinline__ void xcd_barrier_complete(unsigned* bar, unsigned x, unsigned& nloc, unsigned& nx) {
    const unsigned G = gridDim.x * gridDim.y * gridDim.z;
    unsigned sum, cnt, mine, sp = 0u;
    for (;;) {
        sum = 0u; cnt = 0u; mine = 0u;
#pragma unroll
        for (unsigned j = 0; j < 16; ++j) { const unsigned c = xb_ld(&bar[XB_XCNT(j)]); sum += c; cnt += (c > 0u) ? 1u : 0u; mine = (j == x) ? c : mine; }
        if (sum == G) break;
        __builtin_amdgcn_s_sleep(1);
        if ((++sp & 255u) == 0u) { if (xb_ld(&bar[XB_TMO])) break; if (sp > XB_SPIN_CAP) { atomicAdd(&bar[XB_TMO], 1u); break; } }
    }
    nloc = mine > 0u ? mine : 1u; nx = cnt > 0u ? cnt : 1u;
}

__device__ __forceinline__ void xcd_barrier(const XcdBarrier& b) {
    asm volatile("s_waitcnt vmcnt(0)" ::: "memory");
    __syncthreads();
    if (threadIdx.x == 0) {
        unsigned* bar = b.bar;
        __builtin_amdgcn_s_waitcnt(0);
        unsigned nloc = b.st[0], nx = b.st[1];
        if (nloc == 0u) { xcd_barrier_complete(bar, b.x, nloc, nx); b.st[0] = nloc; b.st[1] = nx; }
        const unsigned old = xb_add(&bar[XB_XSUB(b.x)], 1u);
        const unsigned gen = old / nloc;
        if (old + 1u == (gen + 1u) * nloc) {
            __builtin_amdgcn_fence(__ATOMIC_RELEASE, "agent");
            asm volatile("s_waitcnt vmcnt(0)" ::: "memory");
            const unsigned og = xb_add(&bar[XB_TOP], 1u);
            const unsigned tg = og / nx;
            if (og + 1u == (tg + 1u) * nx) xb_add(&bar[XB_TOPGEN], 1u);
            else XB_SPIN(xb_ld(&bar[XB_TOPGEN]) == tg, bar);
            __builtin_amdgcn_fence(__ATOMIC_ACQUIRE, "agent");
            xb_add(&bar[XB_XGEN(b.x)], 1u);
            asm volatile("s_waitcnt vmcnt(0)" ::: "memory");
        } else {
            XB_SPIN(xb_ld(&bar[XB_XGEN(b.x)]) == gen, bar);
            __builtin_amdgcn_fence(__ATOMIC_ACQUIRE, "agent");
            asm volatile("s_waitcnt vmcnt(0)" ::: "memory");
        }
    }
    __syncthreads();
}
namespace pg8 {
#define PG8_LAS __attribute__((address_space(3)))
typedef unsigned short bf16_t;
typedef short bf16x8 __attribute__((ext_vector_type(8)));
typedef float f32x4 __attribute__((ext_vector_type(4)));
typedef unsigned u32x4 __attribute__((ext_vector_type(4)));
constexpr int BM = 256, BK = 64, HALF = 128, HTB = HALF * BK * 2  , STAGE_BYTES = 8 * HTB, NXCD = 8, WGM = 4;

__host__ __device__ __forceinline__ int lds_byte(int r, int c) { const int st = (r >> 4) * 2 + (c >> 5), rr = r & 15, cc = c & 31, ob = rr * 64 + cc * 2; return st * 1024 + (ob ^ (((ob >> 9) & 1) << 5)); }
__host__ __device__ __forceinline__ void stage_rc(int b, int& R, int& C) { const int st = b / 1024, sb = b % 1024, swz = sb ^ (((sb >> 9) & 1) << 5); R = (st >> 1) * 16 + swz / 64; C = (st & 1) * 32 + (swz % 64) / 2; }
__host__ __device__ __forceinline__ int perm32(int rho) { const int n = rho >> 4, i = rho & 15; return 8 * (i >> 2) + 4 * n + (i & 3); }

struct Unit { int pm, pn; };
struct Gemm { const bf16_t* A; const bf16_t* Bt; int M, N, K, ld; };

struct StaticOrder {
    int nM, nN, nwg, G, c;
    __host__ __device__ void init(int M, int N, int G_, int c_) { nM = M / BM; nN = N / BM; nwg = nM * nN; G = G_; c = c_; }
    __host__ __device__ bool next(int i, Unit& u) const {
        const long L = (long)i * G + c; if (L >= nwg) return false;
        int wgid = (int)L; { const int q = nwg / NXCD, r = nwg % NXCD, xcd = wgid % NXCD, off = wgid / NXCD; wgid = (xcd < r ? xcd * (q + 1) : r * (q + 1) + (xcd - r) * q) + off; }
        const int nig = WGM * nN, gid = wgid / nig, fm = gid * WGM, gsz = (nM - fm) < WGM ? (nM - fm) : WGM;
        u.pm = fm + ((wgid % nig) % gsz); u.pn = (wgid % nig) / gsz; return true;
    }
    __device__ __forceinline__ void a_ready(const Unit&) const {}
    __device__ __forceinline__ void done(const Unit&) const {}
};
struct CountedOrder : StaticOrder {
    const unsigned* ready; unsigned need; unsigned* tmo;
    __device__ __forceinline__ void a_ready(const Unit& u) const {
        if (threadIdx.x < 64) {
            const unsigned long long t0 = __builtin_amdgcn_s_memrealtime(); unsigned polls = 0;
            while ((unsigned)__builtin_amdgcn_readfirstlane(__hip_atomic_load(ready + 64 * u.pm, __ATOMIC_RELAXED, __HIP_MEMORY_SCOPE_AGENT)) < need) {
                if ((++polls & 255u) == 0u && __builtin_amdgcn_readfirstlane(__hip_atomic_load(tmo, __ATOMIC_RELAXED, __HIP_MEMORY_SCOPE_AGENT)) != 0u) break;
                if (__builtin_amdgcn_s_memrealtime() - t0 > 2000000ull) {
                    if (threadIdx.x == 0) { unsigned expect = 0u; __hip_atomic_compare_exchange_strong(tmo + 1, &expect, 0x600u | (unsigned)(u.pm & 0xff), __ATOMIC_RELAXED, __ATOMIC_RELAXED, __HIP_MEMORY_SCOPE_AGENT); __hip_atomic_store(tmo, 1u, __ATOMIC_RELAXED, __HIP_MEMORY_SCOPE_AGENT); }
                    break; }
                __builtin_amdgcn_s_sleep(2); }
            __builtin_amdgcn_fence(__ATOMIC_ACQUIRE, "agent");
            asm volatile("s_waitcnt vmcnt(0)" ::: "memory");
        }
#if !defined(BROKEN_HOOK_NO_BARRIER)
        asm volatile("" ::: "memory"); __builtin_amdgcn_s_barrier(); asm volatile("" ::: "memory");
#endif
    }
};

__device__ __forceinline__ unsigned cvt_pk_bf16(float lo, float hi) { unsigned r; asm volatile("v_cvt_pk_bf16_f32 %0, %1, %2" : "=v"(r) : "v"(lo), "v"(hi)); return r; }
typedef float f32x2 __attribute__((ext_vector_type(2)));
__device__ __forceinline__ f32x2 gelu_pk(f32x2 v) {
    const f32x2 av = __builtin_elementwise_abs(v), d = av * 0.2316418882f + 1.0f;
    f32x2 t; t.x = __builtin_amdgcn_rcpf(d.x); t.y = __builtin_amdgcn_rcpf(d.y);
    f32x2 q = t * 0.5307027145f + (-0.7265760135f); q = q * t + 0.7107068705f; q = q * t + (-0.142248368f); q = q * t + 0.127414796f; q = q * t;
    const f32x2 s = (v * v) * (-0.72134752044f);
    f32x2 e; e.x = __builtin_amdgcn_exp2f(s.x); e.y = __builtin_amdgcn_exp2f(s.y);
    const f32x2 m = v * (q * e), r = v - m;
    f32x2 o; o.x = v.x < 0.f ? m.x : r.x; o.y = v.y < 0.f ? m.y : r.y; return o;
}

struct EpiF32 {
    static constexpr bool PERM = false, AFTER_DRAIN = false;
    float* C; int ldc; const float* bias;
    __device__ __forceinline__ void operator()(const f32x4 (&acc)[2][2][4][2], const Unit& u, int wr, int wc, int fr, int fq) const {
        const int row0 = u.pm * BM + wr * 64 + fr, col0 = u.pn * BM + wc * 32 + 4 * fq;
        f32x4 bv[2][2];
#pragma unroll
        for (int bj = 0; bj < 2; ++bj)
#pragma unroll
            for (int n = 0; n < 2; ++n) bv[bj][n] = bias ? *(const f32x4*)(bias + col0 + bj * HALF + n * 16) : (f32x4){0.f, 0.f, 0.f, 0.f};
#pragma unroll
        for (int ai = 0; ai < 2; ++ai)
#pragma unroll
            for (int m = 0; m < 4; ++m) { float* rowp = C + (size_t)(row0 + ai * HALF + m * 16) * ldc + col0;
#pragma unroll
                for (int bj = 0; bj < 2; ++bj)
#pragma unroll
                    for (int n = 0; n < 2; ++n) *(f32x4*)(rowp + bj * HALF + n * 16) = acc[ai][bj][m][n] + bv[bj][n]; }
    }
};
template <int ACT  > struct EpiBf16 {
    static constexpr bool PERM = true, AFTER_DRAIN = false;
    bf16_t* O; int ldc; const float* bias; int split_cols; size_t split_stride;
    __device__ __forceinline__ void operator()(const f32x4 (&acc)[2][2][4][2], const Unit& u, int wr, int wc, int fr, int fq) const {
        const int row0 = u.pm * BM + wr * 64 + fr; int colt = u.pn * BM; bf16_t* base = O;
        if (split_cols) { const int t = colt / split_cols; base += (size_t)t * split_stride; colt -= t * split_cols; }
        const int col0 = colt + wc * 32 + 8 * fq, bcol0 = u.pn * BM + wc * 32 + 8 * fq;
        f32x4 bv[2][2];
#pragma unroll
        for (int bj = 0; bj < 2; ++bj)
#pragma unroll
            for (int n = 0; n < 2; ++n) bv[bj][n] = bias ? *(const f32x4*)(bias + bcol0 + bj * HALF + 4 * n) : (f32x4){0.f, 0.f, 0.f, 0.f};
#pragma unroll
        for (int ai = 0; ai < 2; ++ai)
#pragma unroll
            for (int m = 0; m < 4; ++m) { bf16_t* rowp = base + (size_t)(row0 + ai * HALF + m * 16) * ldc + col0;
#pragma unroll
                for (int bj = 0; bj < 2; ++bj) { f32x4 v0 = acc[ai][bj][m][0] + bv[bj][0], v1 = acc[ai][bj][m][1] + bv[bj][1];
                    if (ACT == 1) { f32x2 a = gelu_pk((f32x2){v0[0], v0[1]}), b = gelu_pk((f32x2){v0[2], v0[3]}), c = gelu_pk((f32x2){v1[0], v1[1]}), d = gelu_pk((f32x2){v1[2], v1[3]});
                        v0 = (f32x4){a.x, a.y, b.x, b.y}; v1 = (f32x4){c.x, c.y, d.x, d.y}; }
                    if (ACT == 2) {
#pragma unroll
                        for (int j = 0; j < 4; ++j) { v0[j] = 0.5f * v0[j] * (1.0f + erff(v0[j] * 0.70710678f)); v1[j] = 0.5f * v1[j] * (1.0f + erff(v1[j] * 0.70710678f)); } }
                    u32x4 w; w.x = cvt_pk_bf16(v0[0], v0[1]); w.y = cvt_pk_bf16(v0[2], v0[3]); w.z = cvt_pk_bf16(v1[0], v1[1]); w.w = cvt_pk_bf16(v1[2], v1[3]);
                    *(u32x4*)(rowp + bj * HALF) = w; } }
    }
};
}
namespace pg8 {
struct EpiSwiGLU {
    static constexpr bool PERM = true, AFTER_DRAIN = false;
    bf16_t* O; int ldc;
    __device__ __forceinline__ void operator()(const f32x4 (&acc)[2][2][4][2], const Unit& u, int wr, int wc, int fr, int fq) const {
        const int row0 = u.pm * BM + wr * 64 + fr, col0 = u.pn * HALF + wc * 32 + 8 * fq;
#pragma unroll
        for (int ai = 0; ai < 2; ++ai)
#pragma unroll
            for (int m = 0; m < 4; ++m) { bf16_t* rowp = O + (size_t)(row0 + ai * HALF + m * 16) * ldc + col0;
                float h[8];
#pragma unroll
                for (int n = 0; n < 2; ++n)
#pragma unroll
                    for (int j = 0; j < 4; ++j) { const float g = acc[ai][0][m][n][j], up = acc[ai][1][m][n][j]; h[n * 4 + j] = g * __builtin_amdgcn_rcpf(1.0f + __builtin_amdgcn_exp2f(-1.4426950408889634f * g)) * up; }
                u32x4 w; w.x = cvt_pk_bf16(h[0], h[1]); w.y = cvt_pk_bf16(h[2], h[3]); w.z = cvt_pk_bf16(h[4], h[5]); w.w = cvt_pk_bf16(h[6], h[7]);
                *(u32x4*)rowp = w; }
    }
};
struct EpiResid {
    static constexpr bool PERM = false, AFTER_DRAIN = false;
    float* X; const float* gate_x; const float* gate_c; float fac; float* out_x;
    __device__ __forceinline__ void operator()(const f32x4 (&acc)[2][2][4][2], const Unit& u, int wr, int wc, int fr, int fq) const {
        const int row0 = u.pm * BM + wr * 64 + fr, col0 = u.pn * BM + wc * 32 + 4 * fq;
        const float* gv = (u.pm == 0) ? gate_c : gate_x;
        float* dst = (u.pm != 0 && out_x) ? out_x - (size_t)256 * 4096 : X;
        f32x4 gg[2][2];
#pragma unroll
        for (int bj = 0; bj < 2; ++bj)
#pragma unroll
            for (int n = 0; n < 2; ++n) gg[bj][n] = *(const f32x4*)(gv + col0 + bj * HALF + n * 16) * fac;
#pragma unroll
        for (int ai = 0; ai < 2; ++ai)
#pragma unroll
            for (int m = 0; m < 4; ++m) { const size_t off = (size_t)(row0 + ai * HALF + m * 16) * 4096 + col0;
#pragma unroll
                for (int bj = 0; bj < 2; ++bj)
#pragma unroll
                    for (int n = 0; n < 2; ++n) { const f32x4 b = *(const f32x4*)(X + off + bj * HALF + n * 16); *(f32x4*)(dst + off + bj * HALF + n * 16) = b + gg[bj][n] * acc[ai][bj][m][n]; } }
    }
};
struct OneUnit { int pn;
    __host__ __device__ bool next(int i, Unit& u) const { u.pm = 0; u.pn = pn; return i == 0; }
    __device__ __forceinline__ void a_ready(const Unit&) const {}
    __device__ __forceinline__ void done(const Unit&) const {}
};
struct StaticOrderX { StaticOrder b;
    __host__ __device__ void init(int M, int N, int G_, int c_) { b.init(M - BM, N, G_, c_); }
    __host__ __device__ bool next(int i, Unit& u) const { const bool ok = b.next(i, u); u.pm += 1; return ok; }
    __device__ __forceinline__ void a_ready(const Unit&) const {}
    __device__ __forceinline__ void done(const Unit&) const {}
};
}
namespace pg8 {
template <class Epi, class Sched, bool STAMP = false>
__device__ __forceinline__ void gemm_phase(PG8_LAS unsigned char* lds, const Gemm g, const Sched& S, const Epi& E, unsigned long long* stamps) {
    int tid_ = threadIdx.x; asm volatile("" : "+v"(tid_));
    const int tid = tid_, wid = __builtin_amdgcn_readfirstlane(tid >> 6), lane = tid & 63, wr = wid >> 2, wc = wid & 3, fr = lane & 15, fq = lane >> 4;
    const int K = g.ld, nt = g.K / BK;
    int ts_lo = 0, ts_hi = 0, nts = 0; const unsigned long long rt_entry = STAMP ? (unsigned long long)wall_clock64() : 0ull;
#define PG8_STAMP() do { if (STAMP && wid == 0 && nts < 64) { const unsigned long long _c = (unsigned long long)clock64(); \
        ts_lo = (lane == nts) ? (int)(unsigned)_c : ts_lo; ts_hi = (lane == nts) ? (int)(unsigned)(_c >> 32) : ts_hi; ++nts; } } while (0)
    PG8_STAMP();
    unsigned voffA[2], voffB[2];
#pragma unroll
    for (int i = 0; i < 2; ++i) { int R, C; stage_rc(tid * 16 + i * 8192, R, C); const int Rb = Epi::PERM ? ((R & ~31) + perm32(R & 31)) : R;
        voffA[i] = (unsigned)(R * K + C) * 2u; voffB[i] = (unsigned)(Rb * K + C) * 2u; }
    const size_t kstep = (size_t)(BK * 2);
    const size_t hstep = (size_t)HALF * K * 2;
    const size_t tstep = 2 * hstep;
    const unsigned ldsw = (unsigned)wid * 1024u;
    const int aoff = lds_byte(wr * 64 + fr, fq * 8), boff = lds_byte(wc * 32 + fr, fq * 8);
#define PG8_SA(b, h) (((b) * 2 + (h)) * HTB)
#define PG8_SB(b, h) ((4 + (b) * 2 + (h)) * HTB)
#define PG8_STAGE(bufoff, gbase, voff) do { _Pragma("unroll") for (int _i = 0; _i < 2; ++_i) \
        __builtin_amdgcn_global_load_lds((const unsigned*)((const char*)(gbase) + (voff)[_i]), (PG8_LAS unsigned*)(lds + (bufoff) + ldsw + _i * 8192), 16, 0, 0); } while (0)
#define PG8_LDA(dst, b, h) do { _Pragma("unroll") for (int m = 0; m < 4; ++m) _Pragma("unroll") for (int k = 0; k < 2; ++k) dst[m][k] = *(const PG8_LAS bf16x8*)(lds + PG8_SA(b, h) + aoff + m * 2048 + k * 1024); } while (0)
#define PG8_LDB(dst, b, h) do { _Pragma("unroll") for (int n = 0; n < 2; ++n) _Pragma("unroll") for (int k = 0; k < 2; ++k) dst[n][k] = *(const PG8_LAS bf16x8*)(lds + PG8_SB(b, h) + boff + n * 2048 + k * 1024); } while (0)
#define PG8_MMA(ai, bj, At, Bt) do { __builtin_amdgcn_s_setprio(1); _Pragma("unroll") for (int m = 0; m < 4; ++m) _Pragma("unroll") for (int n = 0; n < 2; ++n) _Pragma("unroll") for (int k = 0; k < 2; ++k) \
        acc[ai][bj][m][n] = __builtin_amdgcn_mfma_f32_16x16x32_bf16(Bt[n][k], At[m][k], acc[ai][bj][m][n], 0, 0, 0); __builtin_amdgcn_s_setprio(0); } while (0)
#define PG8_WAIT_V(n) asm volatile("s_waitcnt vmcnt(" #n ")" ::: "memory")
#define PG8_WAIT_L(n) asm volatile("s_waitcnt lgkmcnt(" #n ")" ::: "memory")
#define PG8_BAR __builtin_amdgcn_s_barrier()
#define PG8_SCHED __builtin_amdgcn_sched_barrier(0)
    Unit cur, nxt; int ui = 0;
    if (!S.next(0, cur)) return;
    f32x4 acc[2][2][4][2];
#pragma unroll
    for (int a = 0; a < 2; ++a)
#pragma unroll
        for (int b = 0; b < 2; ++b)
#pragma unroll
            for (int m = 0; m < 4; ++m)
#pragma unroll
                for (int n = 0; n < 2; ++n) acc[a][b][m][n] = (f32x4){0.f, 0.f, 0.f, 0.f};
    bf16x8 At[4][2], B0[2][2], B1[2][2];
    const char* cA = (const char*)g.A + (size_t)cur.pm * tstep; const char* cB = (const char*)g.Bt + (size_t)cur.pn * tstep;
    S.a_ready(cur);
    PG8_STAGE(PG8_SB(0, 0), cB, voffB); PG8_STAGE(PG8_SA(0, 0), cA, voffA); PG8_STAGE(PG8_SB(0, 1), cB + hstep, voffB); PG8_STAGE(PG8_SA(0, 1), cA + hstep, voffA);
    if (wr == 1) PG8_BAR;
    PG8_WAIT_V(4); PG8_BAR;
    PG8_STAGE(PG8_SB(1, 0), cB + kstep, voffB); PG8_STAGE(PG8_SA(1, 0), cA + kstep, voffA); PG8_STAGE(PG8_SB(1, 1), cB + hstep + kstep, voffB);
    PG8_WAIT_V(6); PG8_BAR;
    PG8_STAMP();
    for (;;) {
        const bool has_next = S.next(ui + 1, nxt);
        const char* nA = has_next ? (const char*)g.A + (size_t)nxt.pm * tstep : cA; const char* nB = has_next ? (const char*)g.Bt + (size_t)nxt.pn * tstep : cB;
        for (int t = 0; t < nt; t += 2) {
            const bool last = (t == nt - 2);
            const char* a1 = cA + (size_t)(t + 1) * kstep;
            const char* a2 = last ? nA : cA + (size_t)(t + 2) * kstep; const char* b2 = last ? nB : cB + (size_t)(t + 2) * kstep;
            const char* a3 = a2 + kstep; const char* b3 = b2 + kstep;
            if (last && has_next) S.a_ready(nxt);
            PG8_LDB(B0, 0, 0); PG8_SCHED; PG8_LDA(At, 0, 0); PG8_STAGE(PG8_SA(1, 1), a1 + hstep, voffA);
            PG8_WAIT_L(8); PG8_BAR; PG8_WAIT_L(0); PG8_MMA(0, 0, At, B0); PG8_BAR; PG8_SCHED;
            PG8_LDB(B1, 0, 1); PG8_STAGE(PG8_SB(0, 0), b2, voffB);
            PG8_BAR; PG8_WAIT_L(0); PG8_MMA(0, 1, At, B1); PG8_BAR;
            PG8_LDA(At, 0, 1); PG8_STAGE(PG8_SA(0, 0), a2, voffA);
            PG8_BAR; PG8_WAIT_L(0); PG8_MMA(1, 0, At, B0); PG8_BAR; PG8_SCHED;
            PG8_STAGE(PG8_SB(0, 1), b2 + hstep, voffB);
            PG8_WAIT_V(6); PG8_BAR; PG8_MMA(1, 1, At, B1); PG8_BAR;
            PG8_LDB(B0, 1, 0); PG8_SCHED; PG8_LDA(At, 1, 0); PG8_STAGE(PG8_SA(0, 1), a2 + hstep, voffA);
            PG8_WAIT_L(8); PG8_BAR; PG8_WAIT_L(0); PG8_MMA(0, 0, At, B0); PG8_BAR; PG8_SCHED;
            PG8_LDB(B1, 1, 1); PG8_STAGE(PG8_SB(1, 0), b3, voffB);
            PG8_BAR; PG8_WAIT_L(0); PG8_MMA(0, 1, At, B1); PG8_BAR;
            PG8_LDA(At, 1, 1); PG8_STAGE(PG8_SA(1, 0), a3, voffA);
            PG8_BAR; PG8_WAIT_L(0); PG8_MMA(1, 0, At, B0); PG8_BAR; PG8_SCHED;
            PG8_STAGE(PG8_SB(1, 1), b3 + hstep, voffB);
            PG8_WAIT_V(6); PG8_BAR; PG8_MMA(1, 1, At, B1); PG8_BAR;
        }
        PG8_STAMP();
        if constexpr (!Epi::AFTER_DRAIN) { E(acc, cur, wr, wc, fr, fq); S.done(cur); }
        PG8_STAMP();
        if (!has_next) break;
#pragma unroll
        for (int a = 0; a < 2; ++a)
#pragma unroll
            for (int b = 0; b < 2; ++b)
#pragma unroll
                for (int m = 0; m < 4; ++m)
#pragma unroll
                    for (int n = 0; n < 2; ++n) acc[a][b][m][n] = (f32x4){0.f, 0.f, 0.f, 0.f};
        cur = nxt; cA = nA; cB = nB; ++ui;
    }
    PG8_WAIT_V(0);
    if (wr == 0) PG8_BAR;
    PG8_BAR;
    if constexpr (Epi::AFTER_DRAIN) { E.fused(acc, cur, wr, wc, fr, fq, lds, wid, lane); S.done(cur); }
    PG8_STAMP();
    if (STAMP && wid == 0) { stamps[lane] = lane < nts ? (((unsigned long long)(unsigned)ts_hi << 32) | (unsigned)ts_lo) : 0ull;
        if (lane == 62) stamps[62] = rt_entry; if (lane == 63) stamps[63] = (unsigned long long)wall_clock64(); }
#undef PG8_STAMP
#undef PG8_SA
#undef PG8_SB
#undef PG8_STAGE
#undef PG8_LDA
#undef PG8_LDB
#undef PG8_MMA
#undef PG8_WAIT_V
#undef PG8_WAIT_L
#undef PG8_BAR
#undef PG8_SCHED
}
}
#define LDS_WAIT() asm volatile("s_waitcnt lgkmcnt(0)" ::: "memory")

__device__ __forceinline__ int map_row(int n, int mode) {
    if (mode == 1) { const int j = n < FF ? n : n - FF; return (j >> 7) * 256 + (n < FF ? 0 : 128) + (j & 127); }
    return n;
}
__device__ __forceinline__ void transpose_item(const float* __restrict__ W, int K, int N, bf16_t* WT, int mode, LAS float* scr, int item, int lane) {
    const int nblk = N / 32, kb = item / nblk, nb = item % nblk, k0 = 64 * kb, n0 = 32 * nb;
#pragma unroll 8
    for (int i = 0; i < 32; ++i) { const int kk = 2 * i + (lane >> 5); scr[kk * 33 + (lane & 31)] = W[(size_t)(k0 + kk) * N + n0 + (lane & 31)]; }
    LDS_WAIT(); asm volatile("" ::: "memory");
    const int c = lane & 7;
#pragma unroll
    for (int j = 0; j < 4; ++j) { const int n = (lane >> 3) + 8 * j; const LAS float* s = scr + (8 * c) * 33 + n;
        u32x4 o; o.x = cvt_pk_bf16(s[0 * 33], s[1 * 33]); o.y = cvt_pk_bf16(s[2 * 33], s[3 * 33]); o.z = cvt_pk_bf16(s[4 * 33], s[5 * 33]); o.w = cvt_pk_bf16(s[6 * 33], s[7 * 33]);
        *(u32x4*)(WT + (size_t)map_row(n0 + n, mode) * K + k0 + 8 * c) = o; }
    LDS_WAIT(); asm volatile("" ::: "memory");
}
constexpr int I_G = (DM / 64) * (2 * FF / 32), I_D = (FF / 64) * (DM / 32), I_IN = (DM / 64) * (9600 / 32), I_OUT = (DM / 64) * (DM / 32), I_Q = (1024 / 64) * (NQ / 32), I_KV = (512 / 64) * (NKV / 32);
constexpr int I_LAYER = 2 * I_G + 2 * I_D + I_IN + I_OUT + I_Q + I_KV;

__device__ __forceinline__ void phase0(const Frame& F, unsigned char* ws) {
    const int gw = F.bid * 8 + F.wave, NGW = F.G * 8;
    const size_t gt = (size_t)F.bid * 512 + F.tid, NGT = (size_t)F.G * 512;
    LAS float* scr = (LAS float*)(F.lds + F.wave * 8704);
    bf16_t* WB = (bf16_t*)(ws + WS_WB);
    for (int it = gw; it < NL * I_LAYER; it += NGW) {
        const int l = it / I_LAYER; int r = it - l * I_LAYER; bf16_t* wl = WB + (size_t)l * W_LAYER;
        if (r < I_G) { transpose_item(IN_(10) + (size_t)l * DM * 2 * FF, DM, 2 * FF, wl + W_G1, 1, scr, r, F.lane); continue; } r -= I_G;
        if (r < I_D) { transpose_item(IN_(11) + (size_t)l * FF * DM, FF, DM, wl + W_D1, 0, scr, r, F.lane); continue; } r -= I_D;
        if (r < I_G) { transpose_item(IN_(12) + (size_t)l * DM * 2 * FF, DM, 2 * FF, wl + W_G2, 1, scr, r, F.lane); continue; } r -= I_G;
        if (r < I_D) { transpose_item(IN_(13) + (size_t)l * FF * DM, FF, DM, wl + W_D2, 0, scr, r, F.lane); continue; } r -= I_D;
        if (r < I_IN) { transpose_item(IN_(14) + (size_t)l * DM * 9600, DM, 9600, wl + W_IN, 0, scr, r, F.lane); continue; } r -= I_IN;
        if (r < I_OUT) { transpose_item(IN_(15) + (size_t)l * DM * DM, DM, DM, wl + W_OUT, 0, scr, r, F.lane); continue; } r -= I_OUT;
        if (r < I_Q) { transpose_item(IN_(39) + (size_t)l * 1024 * NQ, 1024, NQ, wl + W_Q, 0, scr, r, F.lane); continue; } r -= I_Q;
        transpose_item(IN_(41) + (size_t)l * 512 * NKV, 512, NKV, wl + W_KV, 0, scr, r, F.lane);
    }
    for (size_t i = gt; i < (size_t)NL * 128 * 512; i += NGT) {
        const int l = (int)(i / (128 * 512)), rr = (int)((i / 512) % 128), c = (int)(i % 512);
        const int row = 9600 + rr;
        *(u32x4*)(WB + (size_t)l * W_LAYER + W_IN + (size_t)row * DM + c * 8) = (u32x4){0u, 0u, 0u, 0u};
    }
    { bf16_t* WLR = (bf16_t*)(ws + WS_WLR); const float* wu = IN_(18); const float* au = IN_(20); const float* gu = IN_(21);
      for (size_t i = gt; i < (size_t)NL * 448 * A_W; i += NGT) { const int l = (int)(i / (448 * A_W)), k = (int)((i / A_W) % 448), col = (int)(i % A_W);
          float v;
          if (k < 128) v = wu[(((size_t)l * 2 + (k >> 6)) * 64 + (k & 63)) * A_W + col];
          else if (k < 256) v = au[(((size_t)l * 2 + ((k - 128) >> 6)) * 64 + (k & 63)) * A_W + col];
          else v = gu[((size_t)l * 192 + (k - 256)) * A_W + col];
          WLR[((size_t)l * A_W + col) * 448 + k] = (bf16_t)(cvt_pk_bf16(v, v) & 0xffffu); } }
    { f32x4* xs = (f32x4*)(ws + WS_XS); const f32x4* cx = (const f32x4*)IN_(2); const f32x4* xx = (const f32x4*)IN_(0);
      for (size_t i = gt; i < (size_t)T * DM / 4; i += NGT) xs[i] = i < (size_t)NCTX * DM / 4 ? cx[i] : xx[i - (size_t)NCTX * DM / 4]; }
    { float* HP = (float*)(ws + WS_HP);
      for (int it = F.bid; it < NL * 16; it += F.G) { const int l = it >> 4, ch = it & 15, w = F.tid >> 8, j = F.tid & 255;
          const float* cv = w ? IN_(3) : IN_(1); const float* ad = IN_(4) + ((size_t)l * DM + ch * 256) * 256 + j; float s = 0.f;
          for (int i = 0; i < 256; ++i) s += siluf_(cv[ch * 256 + i]) * ad[(size_t)i * 256];
          HP[((l * 16 + ch) * 2 + w) * 256 + j] = s; } }
    { float* H3 = (float*)(ws + WS_H3);
      LAS float* zb = (LAS float*)(F.lds + 73728); LAS float* ha = zb + 8 * 36; LAS float* hb = ha + 8 * 64;
      for (int it = F.bid; it < NL * (T / 8); it += F.G) { const int l = it / (T / 8), pb = it % (T / 8);
          if (F.tid < 8 * 33) { const int p = F.tid / 33, i = F.tid % 33, P = pb * 8 + p; const int L = P < NCTX ? NCTX : SEQ, t = P < NCTX ? P : P - NCTX;
              float z;
              if (i == 0) z = (float)t / (float)(L - 1);
              else { const int b = (i - 1) & 15; const float fb = 1e-4f + (float)b * ((15.0f - 1e-4f) / 15.0f); const float rev2 = 2.0f * fb * (float)t / (float)L;
                  z = i <= 16 ? cospif(rev2) : -sinpif(rev2); }
              zb[p * 36 + i] = z; }
          __syncthreads();
          const int p = F.tid >> 6, j = F.tid & 63; const float fq = IN_(36)[l * 64 + j];
          { const float* w1 = IN_(29) + (size_t)l * 33 * 64 + j; float s = IN_(30)[l * 64 + j];
            for (int i = 0; i < 33; ++i) s += zb[p * 36 + i] * w1[i * 64];
            ha[p * 64 + j] = sinf(fq * s); }
          __syncthreads();
          { const float* w2 = IN_(31) + (size_t)l * 64 * 64 + j; float s = IN_(32)[l * 64 + j];
            for (int i = 0; i < 64; ++i) s += ha[p * 64 + i] * w2[i * 64];
            hb[p * 64 + j] = sinf(fq * s); }
          __syncthreads();
          { const float* w3 = IN_(33) + (size_t)l * 64 * 64 + j; float s = IN_(34)[l * 64 + j];
            for (int i = 0; i < 64; ++i) s += hb[p * 64 + i] * w3[i * 64];
            ((bf16_t*)H3)[((size_t)l * 64 + j) * T + pb * 8 + p] = (bf16_t)(cvt_pk_bf16(sinf(fq * s), 0.f) & 0xffffu); }
          __syncthreads(); } }
}
__device__ __forceinline__ void phase_mod(const Frame& F, unsigned char* ws) {
    const float* HP = (const float*)(ws + WS_HP); float* MOD = (float*)(ws + WS_MOD);
    LAS float* hs = (LAS float*)F.lds;
    for (int it = F.bid; it < NL * (NMOD / 512); it += F.G) { const int l = it / (NMOD / 512), nb = it % (NMOD / 512);
        { const int w = F.tid >> 8, j = F.tid & 255; float s = 0.f;
          for (int ch = 0; ch < 16; ++ch) s += HP[((l * 16 + ch) * 2 + w) * 256 + j];
          hs[w * 256 + j] = s; }
        __syncthreads();
        const int n = nb * 512 + F.tid; const float* au = IN_(5) + (size_t)l * 256 * NMOD + n; float s0 = IN_(6)[(size_t)l * NMOD + n], s1 = s0;
        for (int j = 0; j < 256; ++j) { const float u = au[(size_t)j * NMOD]; s0 += hs[j] * u; s1 += hs[256 + j] * u; }
        MOD[((size_t)l * 2 + 0) * NMOD + n] = s0; MOD[((size_t)l * 2 + 1) * NMOD + n] = s1;
        __syncthreads(); }
}
__device__ __forceinline__ void norm_phase(const Frame& F, float* XS, const float* __restrict__ gain, const float* modx, const float* modc, int ish, int isc, bf16_t* out, const float* slab, const float* sgate, float sfac) {
    const int gw = F.bid * 8 + F.wave, NGW = F.G * 8;
    int row_lo = 0;
    if (slab) { row_lo = NCTX;
        LAS float* red = (LAS float*)F.lds;
        for (int row = F.bid; row < NCTX; row += F.G) { const size_t o = (size_t)row * DM + F.wave * 512;
            f32x4 v[2]; float s = 0.f;
#pragma unroll
            for (int j = 0; j < 2; ++j) { f32x4 acc = (f32x4){0.f, 0.f, 0.f, 0.f};
#pragma unroll
                for (int ks = 0; ks < 16; ++ks) acc += ((const f32x4*)(slab + (size_t)ks * NCTX * DM + o) + F.lane)[64 * j];
                v[j] = ((const f32x4*)(XS + o) + F.lane)[64 * j] + acc * ((const f32x4*)(sgate + F.wave * 512) + F.lane)[64 * j] * sfac;
                ((f32x4*)(XS + o) + F.lane)[64 * j] = v[j]; s += (v[j].x * v[j].x + v[j].y * v[j].y) + (v[j].z * v[j].z + v[j].w * v[j].w); }
            s = wave_sum(s); if (F.lane == 0) red[F.wave] = s;
            __syncthreads();
            float tot = 0.f;
#pragma unroll
            for (int w = 0; w < 8; ++w) tot += red[w];
            const float rstd = rsqrtf(tot * (1.0f / DM) + NORM_EPS);
#pragma unroll
            for (int j = 0; j < 2; ++j) { const int c4 = F.wave * 128 + F.lane + 64 * j;
                const f32x4 y = v[j] * rstd * ((const f32x4*)gain)[c4] * (((const f32x4*)(modc + (size_t)isc * DM))[c4] + 1.0f) + ((const f32x4*)(modc + (size_t)ish * DM))[c4];
                u32x2 w2; w2.x = cvt_pk_bf16(y.x, y.y); w2.y = cvt_pk_bf16(y.z, y.w); ((u32x2*)(out + (size_t)row * DM))[c4] = w2; }
            __syncthreads(); } }
    for (int row = row_lo + gw; row < T; row += NGW) {
        const float* mod = row < NCTX ? modc : modx;
        const f32x4* xr = (const f32x4*)(XS + (size_t)row * DM) + F.lane; const f32x4* g4 = (const f32x4*)gain + F.lane;
        const f32x4* sh4 = (const f32x4*)(mod + (size_t)ish * DM) + F.lane; const f32x4* sc4 = (const f32x4*)(mod + (size_t)isc * DM) + F.lane;
        f32x4 v[16]; float s = 0.f;
#pragma unroll
        for (int j = 0; j < 16; ++j) { v[j] = xr[64 * j]; s += (v[j].x * v[j].x + v[j].y * v[j].y) + (v[j].z * v[j].z + v[j].w * v[j].w); }
        const float rstd = rsqrtf(wave_sum(s) * (1.0f / DM) + NORM_EPS);
        u32x2* o = (u32x2*)(out + (size_t)row * DM) + F.lane;
#pragma unroll
        for (int j = 0; j < 16; ++j) { const f32x4 y = v[j] * rstd * g4[64 * j] * (sc4[64 * j] + 1.0f) + sh4[64 * j];
            u32x2 w; w.x = cvt_pk_bf16(y.x, y.y); w.y = cvt_pk_bf16(y.z, y.w); o[64 * j] = w; }
    }
}
__device__ __forceinline__ float conv3_at(const float* PX, int tau, int col, float w0, float w1, float w2) {
    const float* p = PX + (size_t)tau * PXW + col;
    const bool hl = has_left(tau), hr = has_right(tau);
    return p[0] * w1 + p[hl ? -PXW : 0] * (hl ? w0 : 0.f) + p[hr ? PXW : 0] * (hr ? w2 : 0.f);
}
__device__ __forceinline__ float rope_apply(float val, int tau, int j) {
    const int pos = tau - NCTX, prow = pos >> 6, pcol = pos & 63;
    const float inv = __powf(10000.0f, -(float)(j & 15) * (1.0f / 16.0f));
    const float ang = (float)(j < 32 ? prow : pcol) * inv;
    float sn, cs; sincosf(ang, &sn, &cs);
    const float partner = __shfl_xor(val, 16);
    const float rot = (j & 16) ? partner : -partner;
    return val * cs + rot * sn;
}
__device__ __forceinline__ void mla_prep_phase(const Frame& F, unsigned char* ws, int l) {
    const float* PX = (const float*)(ws + WS_PX); bf16_t* QA = (bf16_t*)(ws + WS_QA); bf16_t* KVA = (bf16_t*)(ws + WS_KVA); bf16_t* KPE = (bf16_t*)(ws + WS_KPE);
    const int gw = F.bid * 8 + F.wave, NGW = F.G * 8;
    const f32x4* gq = (const f32x4*)(IN_(38) + l * 1024) + F.lane; const f32x4* gkv = (const f32x4*)(IN_(40) + l * 512) + F.lane; const float gpe = IN_(45)[l * 64 + F.lane];
    for (int tau = gw; tau < T; tau += NGW) {
        const f32x4* p = (const f32x4*)(PX + (size_t)tau * PXW + PXC) + F.lane;
        f32x4 q[4], kv[2]; float sq = 0.f, skv = 0.f;
#pragma unroll
        for (int j = 0; j < 4; ++j) { q[j] = p[64 * j]; sq += (q[j].x * q[j].x + q[j].y * q[j].y) + (q[j].z * q[j].z + q[j].w * q[j].w); }
#pragma unroll
        for (int j = 0; j < 2; ++j) { kv[j] = p[256 + 64 * j]; skv += (kv[j].x * kv[j].x + kv[j].y * kv[j].y) + (kv[j].z * kv[j].z + kv[j].w * kv[j].w); }
        const float pe = PX[(size_t)tau * PXW + PXC + 1536 + F.lane];
        const float rq = rsqrtf(wave_sum(sq) * (1.0f / 1024.0f) + NORM_EPS), rkv = rsqrtf(wave_sum(skv) * (1.0f / 512.0f) + NORM_EPS), rpe = rsqrtf(wave_sum(pe * pe) * (1.0f / 64.0f) + NORM_EPS);
        u32x2* oq = (u32x2*)(QA + (size_t)tau * 1024) + F.lane; u32x2* okv = (u32x2*)(KVA + (size_t)tau * 512) + F.lane;
#pragma unroll
        for (int j = 0; j < 4; ++j) { const f32x4 y = q[j] * rq * gq[64 * j]; u32x2 w; w.x = cvt_pk_bf16(y.x, y.y); w.y = cvt_pk_bf16(y.z, y.w); oq[64 * j] = w; }
#pragma unroll
        for (int j = 0; j < 2; ++j) { const f32x4 y = kv[j] * rkv * gkv[64 * j]; u32x2 w; w.x = cvt_pk_bf16(y.x, y.y); w.y = cvt_pk_bf16(y.z, y.w); okv[64 * j] = w; }
        float kp = pe * rpe * gpe;
        if (tau >= NCTX) kp = rope_apply(kp, tau, F.lane);
        KPE[(size_t)tau * 64 + F.lane] = (bf16_t)(cvt_pk_bf16(kp, kp) & 0xffffu);
    }
}
__device__ __forceinline__ void qkv_final_phase(const Frame& F, unsigned char* ws, int l, bool need_ctx) {
    const bf16_t* QRAW = (const bf16_t*)(ws + WS_QRAW); const bf16_t* KVRAW = (const bf16_t*)(ws + WS_KVRAW); const bf16_t* KPE = (const bf16_t*)(ws + WS_KPE);
    bf16_t* QF = (bf16_t*)(ws + WS_QF); bf16_t* KF = (bf16_t*)(ws + WS_KF);
    const int gw = F.bid * 8 + F.wave, NGW = F.G * 8, ln = F.lane;
    const float gqn0 = IN_(42)[l * 128 + 2 * ln], gqn1 = IN_(42)[l * 128 + 2 * ln + 1], gqp = IN_(43)[l * 64 + ln];
    const float gkn0 = IN_(44)[l * 128 + 2 * ln], gkn1 = IN_(44)[l * 128 + 2 * ln + 1];
    (void)need_ctx;
    for (int tau = gw; tau < T; tau += NGW) {
        float cs = 1.f, sn = 0.f;
        if (tau >= NCTX) { const int pos = tau - NCTX, prow = pos >> 6, pcol = pos & 63; const float inv = __powf(10000.0f, -(float)(ln & 15) * (1.0f / 16.0f)); sincosf((float)(ln < 32 ? prow : pcol) * inv, &sn, &cs); }
        const bf16_t kpe = KPE[(size_t)tau * 64 + ln];
        const bf16_t* qrow = QRAW + (size_t)tau * NQ; const bf16_t* krow = KVRAW + (size_t)tau * NKV;
        unsigned qn[NHC], kn[NHC]; bf16_t qpv[NHC];
#pragma unroll
        for (int h = 0; h < NHC; ++h) { qn[h] = *(const unsigned*)(qrow + h * 192 + 2 * ln); qpv[h] = qrow[h * 192 + 128 + ln]; kn[h] = *(const unsigned*)(krow + h * 256 + 2 * ln); }
#pragma unroll
        for (int h = 0; h < NHC; ++h) {
            const float q0 = bf2f((unsigned short)(qn[h] & 0xffffu)), q1 = bf2f((unsigned short)(qn[h] >> 16)), qp = bf2f(qpv[h]), k0 = bf2f((unsigned short)(kn[h] & 0xffffu)), k1 = bf2f((unsigned short)(kn[h] >> 16));
            const float rqn = rsqrtf(wave_sum(q0 * q0 + q1 * q1) * (1.0f / 128.0f) + NORM_EPS), rqp = rsqrtf(wave_sum(qp * qp) * (1.0f / 64.0f) + NORM_EPS), rkn = rsqrtf(wave_sum(k0 * k0 + k1 * k1) * (1.0f / 128.0f) + NORM_EPS);
            float qpe = qp * rqp * gqp;
            { const float partner = __shfl_xor(qpe, 16); const float rot = (ln & 16) ? partner : -partner; qpe = qpe * cs + rot * sn; }
            *(unsigned*)(QF + (size_t)tau * NQ + h * 192 + 2 * ln) = cvt_pk_bf16(q0 * rqn * gqn0, q1 * rqn * gqn1);
            QF[(size_t)tau * NQ + h * 192 + 128 + ln] = (bf16_t)(cvt_pk_bf16(qpe, qpe) & 0xffffu);
            *(unsigned*)(KF + (size_t)tau * NQ + h * 192 + 2 * ln) = cvt_pk_bf16(k0 * rkn * gkn0, k1 * rkn * gkn1);
            KF[(size_t)tau * NQ + h * 192 + 128 + ln] = kpe; }
    }
}
__device__ __forceinline__ void rwkv_out_phase(const Frame& F, unsigned char* ws, int l, bool need_ctx) {
    const float* SS = (const float*)(ws + WS_SS); const float* SD = (const float*)(ws + WS_SD); const float* GB = (const float*)(ws + WS_G); const float* Y = (const float*)(ws + WS_Y);
    bf16_t* OB = (bf16_t*)(ws + WS_OBUF);
    const int gw = F.bid * 8 + F.wave, NGW = F.G * 8, ln = F.lane;
    for (int it = (need_ctx ? 0 : NCTX * 5) + gw; it < T * 5; it += NGW) { const int tau = it / 5, h0 = (it % 5) * 4;
        float y0[4], y1[4], r[4], v[4], ka[4], kb[4], g[4];
#pragma unroll
        for (int q = 0; q < 4; ++q) { const int h = h0 + q, col = h * 64 + ln; const size_t o = (size_t)tau * A_W + col;
            y0[q] = Y[o]; y1[q] = Y[(size_t)T * A_W + o]; r[q] = SS[o]; v[q] = SS[(size_t)T * A_W + o];
            ka[q] = SD[o]; kb[q] = SD[(size_t)T * A_W + o]; g[q] = GB[o]; }
#pragma unroll
        for (int q = 0; q < 4; ++q) { const int col = (h0 + q) * 64 + ln;
            const float y = y0[q] + y1[q];
            const float mu = wave_sum(y) * (1.0f / 64.0f); const float dy = y - mu; const float var = wave_sum(dy * dy) * (1.0f / 64.0f);
            const float yn = dy * rsqrtf(var + GN_EPS) * IN_(25)[l * A_W + col] + IN_(26)[l * A_W + col];
            const float bonus = wave_sum(r[q] * (0.5f * (ka[q] + kb[q])) * IN_(24)[l * A_W + col]) * v[q];
            const float ov = (yn + bonus) * g[q];
            OB[(size_t)tau * DM + col] = (bf16_t)(cvt_pk_bf16(ov, ov) & 0xffffu); }
    }
}
__device__ __forceinline__ void hyena_prep_phase(const Frame& F, unsigned char* ws, int l) {
    const float* PX = (const float*)(ws + WS_PX); float* GT = (float*)(ws + WS_GT); float* X0T = (float*)(ws + WS_X0T);
    LAS float* LGt = (LAS float*)F.lds; LAS float* LX0 = LGt + 64 * 65;
    const float* cw = IN_(27) + (size_t)l * 3 * B_IN; const float* cb = IN_(28) + (size_t)l * B_IN;
    for (int it = F.bid; it < (T / 64) * 20; it += F.G) { const int tt = it / 20, ct = it % 20;
        { const int t = F.tid >> 3, c0 = ct * 64 + (F.tid & 7) * 8, tau = tt * 64 + t;
          f32x4 u[3][2];
#pragma unroll
          for (int grp = 0; grp < 3; ++grp)
#pragma unroll
              for (int q = 0; q < 2; ++q) { const int c = grp * 1280 + c0 + 4 * q; const float* p = PX + (size_t)tau * PXW + PXB + c;
                  const bool hl = has_left(tau), hr = has_right(tau);
                  const f32x4 y = *(const f32x4*)p * *(const f32x4*)(cw + B_IN + c) + *(const f32x4*)(cb + c) + *(const f32x4*)(p - (hl ? PXW : 0)) * (*(const f32x4*)(cw + c) * (hl ? 1.f : 0.f))
                                + *(const f32x4*)(p + (hr ? PXW : 0)) * (*(const f32x4*)(cw + 2 * B_IN + c) * (hr ? 1.f : 0.f));
                  u[grp][q] = y; }
#pragma unroll
          for (int q = 0; q < 2; ++q)
#pragma unroll
              for (int e = 0; e < 4; ++e) { const int ch = (F.tid & 7) * 8 + 4 * q + e; LGt[ch * 65 + t] = u[1][q][e] * u[2][q][e]; LX0[ch * 65 + t] = u[0][q][e]; } }
        __syncthreads();
        { const int ch = F.tid >> 3, t0 = (F.tid & 7) * 8; const size_t o = (size_t)(ct * 64 + ch) * T + tt * 64 + t0;
          f32x4 a0, a1, b0, b1;
#pragma unroll
          for (int e = 0; e < 4; ++e) { a0[e] = LGt[ch * 65 + t0 + e]; a1[e] = LGt[ch * 65 + t0 + 4 + e]; b0[e] = LX0[ch * 65 + t0 + e]; b1[e] = LX0[ch * 65 + t0 + 4 + e]; }
          *(f32x4*)(GT + o) = a0; *(f32x4*)(GT + o + 4) = a1; *(f32x4*)(X0T + o) = b0; *(f32x4*)(X0T + o + 4) = b1; }
        __syncthreads(); }
}
__device__ __forceinline__ void hyena_out_phase(const Frame& F, unsigned char* ws, bool need_ctx) {
    const float* YT = (const float*)(ws + WS_GT); bf16_t* OB = (bf16_t*)(ws + WS_OBUF);
    LAS float* L = (LAS float*)F.lds;
    const int it0 = need_ctx ? 0 : (NCTX / 64) * 20;
    for (int it = it0 + F.bid; it < (T / 64) * 20; it += F.G) { const int tt = it / 20, ct = it % 20;
        { const int ch = F.tid >> 3, t0 = (F.tid & 7) * 8; const size_t o = (size_t)(ct * 64 + ch) * T + tt * 64 + t0;
          const f32x4 a0 = *(const f32x4*)(YT + o), a1 = *(const f32x4*)(YT + o + 4);
#pragma unroll
          for (int e = 0; e < 4; ++e) { L[ch * 65 + t0 + e] = a0[e]; L[ch * 65 + t0 + 4 + e] = a1[e]; } }
        __syncthreads();
        { const int t = F.tid >> 3, c0 = (F.tid & 7) * 8; float x[8];
#pragma unroll
          for (int e = 0; e < 8; ++e) x[e] = L[(c0 + e) * 65 + t];
          u32x4 w; w.x = cvt_pk_bf16(x[0], x[1]); w.y = cvt_pk_bf16(x[2], x[3]); w.z = cvt_pk_bf16(x[4], x[5]); w.w = cvt_pk_bf16(x[6], x[7]);
          *(u32x4*)(OB + (size_t)(tt * 64 + t) * DM + 1280 + ct * 64 + c0) = w; }
        __syncthreads(); }
}
namespace att {
constexpr int DK = 192, DV = 128, NW = 8, QBLK = 32, KVBLK = 64;
constexpr float SCALE = 0.07216878364870322f;
constexpr float THR = 8.f;
#ifndef ATT_SDEPTH
#define ATT_SDEPTH 2
#endif
constexpr int SDEPTH = ATT_SDEPTH;
constexpr int LDQ = 2304, LDK = 2304, LDV = 3072, LDO = 4096;
constexpr int SHM_V = KVBLK * DV * 2, SHM_K = KVBLK * DK * 2, SHM_ATTN = 2 * SHM_V + 2 * SHM_K + NW * 64 * 4 + NW * 4096;
using bf16x8 = __attribute__((ext_vector_type(8))) short;
using s16x4  = __attribute__((ext_vector_type(4))) short;
using f32x16 = __attribute__((ext_vector_type(16))) float;
using u32x4  = __attribute__((ext_vector_type(4))) unsigned;
#define KSWZ(row, colB) ((row) * 384 + ((colB) ^ (((row) & 7) << 4)))
#define SBAR() __builtin_amdgcn_sched_barrier(0)
__device__ __forceinline__ int crow(int r, int hi) { return (r & 3) + 8 * (r >> 2) + 4 * hi; }
__device__ __forceinline__ unsigned cvtpk(float lo, float hi) { unsigned r; asm volatile("v_cvt_pk_bf16_f32 %0, %1, %2" : "=v"(r) : "v"(lo), "v"(hi)); return r; }
__device__ __forceinline__ void partialSM(f32x16& p0, f32x16& p1, float& m_reg, float& mn, float& alpha) {
  constexpr float C = SCALE * 1.4426950408889634f;
  float pmax = p0[0]; for (int r = 1; r < 16; ++r) pmax = fmaxf(pmax, p0[r]); for (int r = 0; r < 16; ++r) pmax = fmaxf(pmax, p1[r]);
  { auto rr = __builtin_amdgcn_permlane32_swap(__float_as_uint(pmax), __float_as_uint(pmax), false, false);
    pmax = fmaxf(__uint_as_float(rr[0]), __uint_as_float(rr[1])); }
  if (__builtin_expect(__all(pmax - m_reg <= THR / SCALE), 1)) { mn = m_reg; alpha = 1.f; }
  else { mn = fmaxf(m_reg, pmax); alpha = __builtin_amdgcn_exp2f((m_reg - mn) * C); m_reg = mn; }
  float mnC = -mn * C;
  for (int r = 0; r < 16; ++r) p0[r] = fmaf(p0[r], C, mnC); for (int r = 0; r < 16; ++r) p1[r] = fmaf(p1[r], C, mnC);
  for (int r = 0; r < 16; ++r) p0[r] = __builtin_amdgcn_exp2f(p0[r]);
}
__device__ __forceinline__ void finishSM(f32x16& p0, f32x16& p1, float alpha, float& l_reg, bf16x8& pa0, bf16x8& pa1, bf16x8& pa2, bf16x8& pa3) {
  for (int r = 0; r < 16; ++r) p1[r] = __builtin_amdgcn_exp2f(p1[r]);
  float ps = 0; for (int r = 0; r < 16; ++r) ps += p0[r]; for (int r = 0; r < 16; ++r) ps += p1[r];
  { auto rr = __builtin_amdgcn_permlane32_swap(__float_as_uint(ps), __float_as_uint(ps), false, false);
    ps = __uint_as_float(rr[0]) + __uint_as_float(rr[1]); }
  l_reg = l_reg * alpha + ps;
#define PK4(P, BASE, OUT) do { unsigned a0 = cvtpk(P[BASE + 0], P[BASE + 1]), a1 = cvtpk(P[BASE + 2], P[BASE + 3]);   \
    unsigned b0 = cvtpk(P[BASE + 4], P[BASE + 5]), b1 = cvtpk(P[BASE + 6], P[BASE + 7]);                              \
    auto r0 = __builtin_amdgcn_permlane32_swap(a0, b0, false, false); auto r1 = __builtin_amdgcn_permlane32_swap(a1, b1, false, false); \
    u32x4 w = {r0[0], r1[0], r0[1], r1[1]}; OUT = *reinterpret_cast<bf16x8*>(&w); } while (0)
  PK4(p0, 0, pa0); PK4(p0, 8, pa1); PK4(p1, 0, pa2); PK4(p1, 8, pa3);
#undef PK4
}
__device__ __forceinline__ void qkt(f32x16& p0, f32x16& p1, const char* Ks, const bf16x8* qr, const char* qrl, int r32, int hi) {
  p0 = f32x16{}; p1 = f32x16{};
#pragma unroll
  for (int d0 = 0; d0 < 8; ++d0) { int cb = (d0 * 16 + hi * 8) * 2;
    bf16x8 b0 = *reinterpret_cast<const bf16x8*>(Ks + KSWZ(r32, cb));
    bf16x8 b1 = *reinterpret_cast<const bf16x8*>(Ks + KSWZ(32 + r32, cb));
    p0 = __builtin_amdgcn_mfma_f32_32x32x16_bf16(b0, qr[d0], p0, 0, 0, 0);
    p1 = __builtin_amdgcn_mfma_f32_32x32x16_bf16(b1, qr[d0], p1, 0, 0, 0); }
#pragma unroll
  for (int d0 = 8; d0 < 12; ++d0) { int cb = (d0 * 16 + hi * 8) * 2;
    bf16x8 b0 = *reinterpret_cast<const bf16x8*>(Ks + KSWZ(r32, cb));
    bf16x8 b1 = *reinterpret_cast<const bf16x8*>(Ks + KSWZ(32 + r32, cb));
    const bf16x8 q = *reinterpret_cast<const bf16x8*>(qrl + ((((d0 - 8) * 2 + hi) ^ (r32 & 7)) << 4));
    p0 = __builtin_amdgcn_mfma_f32_32x32x16_bf16(b0, q, p0, 0, 0, 0);
    p1 = __builtin_amdgcn_mfma_f32_32x32x16_bf16(b1, q, p1, 0, 0, 0); }
}
__device__ __forceinline__ int v_st(int k, int c) { const int kk = (k & ~0xC) | ((k & 4) << 1) | ((k & 8) >> 1); return ((kk >> 3) * 4 + (c >> 5)) * 512 + ((kk & 7) * 32 + (c & 31)) * 2; }
__device__ __forceinline__ int v_rd_base(int lane) { return ((lane & 3) << 3) | (((lane >> 2) & 3) << 6) | (((lane >> 4) & 1) << 5) | (((lane >> 5) & 1) << 8); }
constexpr int v_rd_off(int d0, int ks, int half) { return d0 * 512 + ks * 4096 + half * 2048; }
template <int OFF> __device__ __forceinline__ s16x4 tr_read(int vb) {
  s16x4 r; asm volatile("ds_read_b64_tr_b16 %0, %1 offset:%2" : "=&v"(r) : "v"(vb), "i"(OFF) : "memory"); return r;
}
template <int D0> __device__ __forceinline__ void pv_one(f32x16& od, int vb, bf16x8 pa0, bf16x8 pa1, bf16x8 pa2, bf16x8 pa3) {
  const s16x4 l0 = tr_read<v_rd_off(D0, 0, 0)>(vb), h0 = tr_read<v_rd_off(D0, 0, 1)>(vb), l1 = tr_read<v_rd_off(D0, 1, 0)>(vb), h1 = tr_read<v_rd_off(D0, 1, 1)>(vb);
  const s16x4 l2 = tr_read<v_rd_off(D0, 2, 0)>(vb), h2 = tr_read<v_rd_off(D0, 2, 1)>(vb), l3 = tr_read<v_rd_off(D0, 3, 0)>(vb), h3 = tr_read<v_rd_off(D0, 3, 1)>(vb);
  asm volatile("s_waitcnt lgkmcnt(0)" ::: "memory"); SBAR();
#define PK(L, H) (bf16x8){L[0], L[1], L[2], L[3], H[0], H[1], H[2], H[3]}
  od = __builtin_amdgcn_mfma_f32_32x32x16_bf16(pa0, PK(l0, h0), od, 0, 0, 0);
  od = __builtin_amdgcn_mfma_f32_32x32x16_bf16(pa1, PK(l1, h1), od, 0, 0, 0);
  od = __builtin_amdgcn_mfma_f32_32x32x16_bf16(pa2, PK(l2, h2), od, 0, 0, 0);
  od = __builtin_amdgcn_mfma_f32_32x32x16_bf16(pa3, PK(l3, h3), od, 0, 0, 0);
#undef PK
}
__device__ __forceinline__ void pv_d0(f32x16* o, int vb, bf16x8 pa0, bf16x8 pa1, bf16x8 pa2, bf16x8 pa3) {
  pv_one<0>(o[0], vb, pa0, pa1, pa2, pa3); pv_one<1>(o[1], vb, pa0, pa1, pa2, pa3); pv_one<2>(o[2], vb, pa0, pa1, pa2, pa3); pv_one<3>(o[3], vb, pa0, pa1, pa2, pa3);
}
__device__ __forceinline__ void attn_body(const bf16_t* __restrict__ Qb, const bf16_t* __restrict__ Kh, const bf16_t* __restrict__ Vh, bf16_t* __restrict__ Ob, int seq, char* lds) {
  int tid_ = threadIdx.x; asm volatile("" : "+v"(tid_));
  const int tid = tid_, wid = tid >> 6, lane = tid & 63, r32 = lane & 31, hi = lane >> 5;
  char* V_lds = lds; char* K_lds = lds + 2 * SHM_V;
  float* ws = (float*)(lds + 2 * SHM_V + 2 * SHM_K) + wid * 64; float* li_l = ws; float* al_l = ws + 32;
  float m_reg = -1e30f, l_reg = 0; f32x16 o[4] = {}; bf16x8 qr[8];
  const bf16_t* Qw = Qb + (long)(wid * QBLK + r32) * LDQ + hi * 8;
  char* qrl = lds + 2 * SHM_V + 2 * SHM_K + NW * 64 * 4 + wid * 4096 + r32 * 128;
#pragma unroll
  for (int d0 = 0; d0 < 8; ++d0) qr[d0] = *reinterpret_cast<const bf16x8*>(Qw + d0 * 16);
#pragma unroll
  for (int d0 = 8; d0 < 12; ++d0) *reinterpret_cast<bf16x8*>(qrl + ((((d0 - 8) * 2 + hi) ^ (r32 & 7)) << 4)) = *reinterpret_cast<const bf16x8*>(Qw + d0 * 16);
  asm volatile("s_waitcnt lgkmcnt(0)" ::: "memory");
  unsigned kgo[3], vgo[2];
#pragma unroll
  for (int i = 0; i < 3; ++i) { const int p = (i * 8 + wid) * 64 + lane, row = p / 24, slot = p % 24, ch = slot ^ (row & 7); kgo[i] = (unsigned)(row * LDK + ch * 8) * 2u; }
#pragma unroll
  for (int i = 0; i < 2; ++i) { const int p = (i * 8 + wid) * 64 + lane, sub = p >> 5, within = p & 31, kk = (sub >> 2) * 8 + (within >> 2), c = (sub & 3) * 32 + (within & 3) * 8;
    const int k = (kk & ~0xC) | ((kk & 4) << 1) | ((kk & 8) >> 1); vgo[i] = (unsigned)(k * LDV + c) * 2u; }
  const int vb0 = (int)(uintptr_t)V_lds + v_rd_base(lane);
  typedef __attribute__((address_space(3))) unsigned lds_u32;
#define DMA_K(b, k0) do { const char* kg = (const char*)Kh + (size_t)(k0) * (LDK * 2); \
    _Pragma("unroll") for (int _i = 0; _i < 3; ++_i) __builtin_amdgcn_global_load_lds((const unsigned*)(kg + kgo[_i]), (lds_u32*)(K_lds + (b) * SHM_K + (_i * 8 + wid) * 1024), 16, 0, 0); } while (0)
#define DMA_V(b, k0) do { const char* vg = (const char*)Vh + (size_t)(k0) * (LDV * 2); \
    _Pragma("unroll") for (int _i = 0; _i < 2; ++_i) __builtin_amdgcn_global_load_lds((const unsigned*)(vg + vgo[_i]), (lds_u32*)(V_lds + (b) * SHM_V + (_i * 8 + wid) * 1024), 16, 0, 0); } while (0)
#define RESC(a) do { if (__any((a) < 1.f)) { if (hi == 0) al_l[r32] = (a); asm volatile("s_waitcnt lgkmcnt(0)" ::: "memory"); \
    for (int d = 0; d < 4; ++d) for (int r = 0; r < 16; ++r) o[d][r] *= al_l[crow(r, hi)]; } } while (0)
#define ENDSTEP() do { asm volatile("s_waitcnt vmcnt(0)" ::: "memory"); __syncthreads(); } while (0)
  f32x16 pA0, pA1, pB0, pB1; float mnA, mnB, alA, alB; bf16x8 pa0, pa1, pa2, pa3; const int NT = seq / KVBLK;
  DMA_K(0, 0); ENDSTEP();
  DMA_K(1, KVBLK); DMA_V(0, 0);
  qkt(pA0, pA1, K_lds, qr, qrl, r32, hi); partialSM(pA0, pA1, m_reg, mnA, alA);
  ENDSTEP();
  for (int j = 1; j + 1 < NT; j += 2) {
    DMA_K(0, (j + 1) * KVBLK); DMA_V(1, j * KVBLK);
    SBAR(); qkt(pB0, pB1, K_lds + SHM_K, qr, qrl, r32, hi);
    finishSM(pA0, pA1, alA, l_reg, pa0, pa1, pa2, pa3); SBAR();
    pv_d0(o, vb0, pa0, pa1, pa2, pa3); partialSM(pB0, pB1, m_reg, mnB, alB);
    RESC(alB); ENDSTEP();
    if (j + 2 < NT) DMA_K(1, (j + 2) * KVBLK);
    DMA_V(0, (j + 1) * KVBLK);
    SBAR(); qkt(pA0, pA1, K_lds, qr, qrl, r32, hi);
    finishSM(pB0, pB1, alB, l_reg, pa0, pa1, pa2, pa3); SBAR();
    pv_d0(o, vb0 + (int)SHM_V, pa0, pa1, pa2, pa3); partialSM(pA0, pA1, m_reg, mnA, alA);
    RESC(alA); ENDSTEP();
  }
  DMA_V(1, (NT - 1) * KVBLK);
  SBAR(); qkt(pB0, pB1, K_lds + SHM_K, qr, qrl, r32, hi);
  finishSM(pA0, pA1, alA, l_reg, pa0, pa1, pa2, pa3); SBAR();
  pv_d0(o, vb0, pa0, pa1, pa2, pa3); partialSM(pB0, pB1, m_reg, mnB, alB);
  RESC(alB); ENDSTEP();
  finishSM(pB0, pB1, alB, l_reg, pa0, pa1, pa2, pa3); SBAR();
  pv_d0(o, vb0 + (int)SHM_V, pa0, pa1, pa2, pa3);
#undef DMA_K
#undef DMA_V
#undef ENDSTEP
  if (hi == 0) li_l[r32] = l_reg; asm volatile("s_waitcnt lgkmcnt(0)" ::: "memory");
  float rli[16];
#pragma unroll
  for (int r = 0; r < 16; ++r) rli[r] = __builtin_amdgcn_rcpf(li_l[crow(r, hi)]);
  bf16_t* Ow = Ob + (long)(wid * QBLK) * LDO;
#pragma unroll
  for (int r = 0; r < 16; ++r) { int orow = crow(r, hi);
#pragma unroll
    for (int d0 = 0; d0 < 4; ++d0) { const float val = o[d0][r] * rli[r]; Ow[(long)orow * LDO + d0 * 32 + r32] = (bf16_t)(cvtpk(val, val) & 0xffff); } }
  __syncthreads();
#undef RESC
}
}
__device__ __forceinline__ f32x2 cmul(f32x2 a, f32x2 b) { return (f32x2){a.x * b.x - a.y * b.y, a.x * b.y + a.y * b.x}; }
__device__ __forceinline__ int rev4_14(int k) { const unsigned r = __brev((unsigned)k) >> 18; return (int)(((r & 0x1555u) << 1) | ((r >> 1) & 0x1555u)); }
#define ZI(i) ((i) + ((i) >> 5))
__device__ __forceinline__ void fft_tw(int j, int q, float sign, f32x2& w1, f32x2& w2, f32x2& w3) {
    const float rev = (float)j / (float)(4 * q); const float sn = __builtin_amdgcn_sinf(rev), cs = __builtin_amdgcn_cosf(rev);
    w1 = (f32x2){cs, sign * sn}; w2 = cmul(w1, w1); w3 = cmul(w2, w1);
}
__device__ __forceinline__ void fft16k_dif(LAS f32x2* Z, int tid) {
#pragma unroll 1
    for (int s = 0; s < 7; ++s) { int lq = 12 - 2 * s; asm volatile("" : "+s"(lq)); const int q = 1 << lq;
        const bool shared = q <= 512; f32x2 w1, w2, w3; fft_tw(tid & (q - 1), q, -1.f, w1, w2, w3);
#pragma unroll 2
        for (int i = 0; i < 8; ++i) { const int b = tid + 512 * i, j = b & (q - 1), base = ((b >> lq) << (lq + 2)) + j;
            const int i0 = ZI(base), i1 = ZI(base + q), i2 = ZI(base + 2 * q), i3 = ZI(base + 3 * q);
            const f32x2 a0 = Z[i0], a1 = Z[i1], a2 = Z[i2], a3 = Z[i3];
            const f32x2 t0 = a0 + a2, t1 = a0 - a2, t2 = a1 + a3, t3 = a1 - a3;
            if (!shared) fft_tw(j, q, -1.f, w1, w2, w3);
            Z[i0] = t0 + t2; Z[i1] = cmul((f32x2){t1.x + t3.y, t1.y - t3.x}, w1); Z[i2] = cmul(t0 - t2, w2); Z[i3] = cmul((f32x2){t1.x - t3.y, t1.y + t3.x}, w3); }
        __syncthreads(); }
}
__device__ __forceinline__ void fft16k_dit_inv(LAS f32x2* Z, int tid) {
#pragma unroll 1
    for (int s = 0; s < 7; ++s) { int lq = 2 * s; asm volatile("" : "+s"(lq)); const int q = 1 << lq;
        const bool shared = q <= 512; f32x2 w1, w2, w3; fft_tw(tid & (q - 1), q, 1.f, w1, w2, w3);
#pragma unroll 2
        for (int i = 0; i < 8; ++i) { const int b = tid + 512 * i, j = b & (q - 1), base = ((b >> lq) << (lq + 2)) + j;
            if (!shared) fft_tw(j, q, 1.f, w1, w2, w3);
            const int i0 = ZI(base), i1 = ZI(base + q), i2 = ZI(base + 2 * q), i3 = ZI(base + 3 * q);
            const f32x2 b0 = Z[i0], b1 = cmul(Z[i1], w1), b2 = cmul(Z[i2], w2), b3 = cmul(Z[i3], w3);
            const f32x2 t0 = b0 + b2, t1 = b0 - b2, t2 = b1 + b3, t3 = b1 - b3;
            Z[i0] = t0 + t2; Z[i1] = (f32x2){t1.x - t3.y, t1.y + t3.x}; Z[i2] = t0 - t2; Z[i3] = (f32x2){t1.x + t3.y, t1.y - t3.x}; }
        __syncthreads(); }
}
constexpr float HY_MIN_DECAY = -3.0701134573253945f, HY_MAX_DECAY = -15.350567286626973f;
__device__ __forceinline__ float hy_delta(int c) { return fabsf(HY_MIN_DECAY + (HY_MAX_DECAY - HY_MIN_DECAY) * ((float)c / 1279.0f)); }
__device__ __forceinline__ float conv3b_at(const float* PX, int tau, int col, const float* cw, int l, int c) {
    const float* w = cw + (size_t)l * 3 * B_IN;
    return conv3_at(PX, tau, col, w[c], w[B_IN + c], w[2 * B_IN + c]);
}
__device__ __forceinline__ void hyena_taps_unit(const Frame& F, unsigned char* ws, int l, int pair) {
    LAS f32x2* Z = (LAS f32x2*)F.lds; LAS float* red = (LAS float*)(F.lds + LDS_MISC + 128);
    const int tid = F.tid, c0 = 2 * pair;
    const bf16_t* H3x = (const bf16_t*)(ws + WS_H3) + (size_t)l * 64 * T + NCTX;
    f32x2* scr = (f32x2*)(ws + WS_HSCR) + (size_t)pair * 16384; float* htn = (float*)(ws + WS_HSCR + (size_t)640 * 16384 * 8) + 2 * pair;
    LAS f32x4* FW = (LAS f32x4*)(F.lds + LDS_MISC + 256);
    if (tid < 256) { const int j = tid >> 2, q = tid & 3; ((LAS float*)FW)[tid] = IN_(35)[(size_t)l * 64 * 2560 + (size_t)j * 2560 + (q >> 1) * 1280 + c0 + (q & 1)]; }
    __syncthreads();
    const float d0 = hy_delta(c0), d1 = hy_delta(c0 + 1);
#ifndef HYS
#define HYS 31
#endif
    float s0, s1, sc0 = 0.f, sc1 = 0.f;
    {
    s0 = 0.f; s1 = 0.f;
    if (HYS & 1)
#pragma unroll 1
    for (int i = 0; i < 2; ++i) { const int tb = 4096 * i + 8 * tid; const bf16_t* hc = H3x + tb;
        asm volatile("" ::: "memory");
        f32x4 acc[8];
#pragma unroll
        for (int p = 0; p < 8; ++p) acc[p] = (f32x4){0.f, 0.f, 0.f, 0.f};
#pragma unroll 8
        for (int j = 0; j < 64; ++j) { const f32x4 w = FW[j]; const u32x4 hv = *(const u32x4*)(hc + (size_t)j * T);
#pragma unroll
            for (int p = 0; p < 4; ++p) { acc[2 * p] += w * __uint_as_float(hv[p] << 16); acc[2 * p + 1] += w * __uint_as_float(hv[p] & 0xffff0000u); } }
#pragma unroll
        for (int p = 0; p < 8; ++p) { const int t = tb + p;
            const float tl = (float)t * (1.0f / 8191.0f), e0 = __expf(-tl * d0), e1 = __expf(-tl * d1);
            const float f0 = acc[p].x * e0, f1 = acc[p].y * e1, b0 = acc[p].z * e0, b1 = acc[p].w * e1;
            Z[ZI(t)] = (f32x2){f0, f1}; s0 += fabsf(f0); s1 += fabsf(f1);
            if (t < 8191) { Z[ZI(16383 - t)] = (f32x2){b0, b1}; s0 += fabsf(b0); s1 += fabsf(b1); } } }
    if (tid == 0) { float zz = 0.f; asm volatile("" : "+v"(zz)); Z[ZI(8192)] = (f32x2){zz, zz}; }
    s0 = wave_sum(s0); s1 = wave_sum(s1);
    if (F.lane == 0) { red[F.wave * 2] = s0; red[F.wave * 2 + 1] = s1; }
    __syncthreads();
    float n0 = 0.f, n1 = 0.f;
#pragma unroll
    for (int w = 0; w < 8; ++w) { n0 += red[2 * w]; n1 += red[2 * w + 1]; }
    sc0 = 1.0f / (16384.0f * n0); sc1 = 1.0f / (16384.0f * n1);
    if (HYS & 2) fft16k_dif(Z, tid);
#pragma unroll 4
    for (int i = 0; i < 32; ++i) scr[tid + 512 * i] = Z[ZI(tid + 512 * i)];
    __syncthreads();
    }
    if (tid == 0) { htn[0] = sc0; htn[1] = sc1; }
    __syncthreads();
}
__device__ __forceinline__ void hyena_unit(const Frame& F, unsigned char* ws, int l, int pair) {
    LAS f32x2* Z = (LAS f32x2*)F.lds;
    const int tid = F.tid, c0 = 2 * pair;
    float* GT = (float*)(ws + WS_GT); const float* X0T = (const float*)(ws + WS_X0T);
    const f32x2* scr = (const f32x2*)(ws + WS_HSCR) + (size_t)pair * 16384; const float* htn = (const float*)(ws + WS_HSCR + (size_t)640 * 16384 * 8) + 2 * pair;
    const float sc0 = htn[0], sc1 = htn[1];
#ifndef HYS
#define HYS 31
#endif
    for (int rp15 = 0; rp15 < REP(15); ++rp15) {
    const float* g0p = GT + (size_t)c0 * T + NCTX; const float* g1p = g0p + T;
    { float zz = 0.f; asm volatile("" : "+v"(zz));
#pragma unroll 4
      for (int i = 0; i < 16; ++i) { const int t = tid + 512 * i; Z[ZI(t)] = (f32x2){g0p[t], g1p[t]}; Z[ZI(8192 + t)] = (f32x2){zz, zz}; } }
    __syncthreads();
    if (HYS & 2) fft16k_dif(Z, tid);
    if (HYS & 8)
#pragma unroll 2
    for (int i = 0; i < 17; ++i) { const int k = tid + 512 * i; if (i == 16 && tid != 0) break;
        const int pk = rev4_14(k & 16383), pn = rev4_14((16384 - k) & 16383);
        const f32x2 A = Z[ZI(pk)], B = Z[ZI(pn)], At = scr[pk], Bt = scr[pn];
        const f32x2 G0 = (f32x2){0.5f * (A.x + B.x), 0.5f * (A.y - B.y)}, G1 = (f32x2){0.5f * (A.y + B.y), -0.5f * (A.x - B.x)};
        const f32x2 H0 = (f32x2){0.5f * (At.x + Bt.x), 0.5f * (At.y - Bt.y)}, H1 = (f32x2){0.5f * (At.y + Bt.y), -0.5f * (At.x - Bt.x)};
        const f32x2 P0 = cmul(G0, H0), P1 = cmul(G1, H1);
        Z[ZI(pk)] = (f32x2){P0.x - P1.y, P0.y + P1.x};
        if (pn != pk) Z[ZI(pn)] = (f32x2){P0.x + P1.y, P1.x - P0.y}; }
    __syncthreads();
    if (HYS & 2) fft16k_dit_inv(Z, tid);
    }
    const float bb0 = IN_(37)[l * 1280 + c0], bb1 = IN_(37)[l * 1280 + c0 + 1];
    { float* y0p = GT + (size_t)c0 * T + NCTX; float* y1p = y0p + T; const float* x0p = X0T + (size_t)c0 * T + NCTX; const float* x1p = x0p + T;
#pragma unroll 4
      for (int i = 0; i < 16; ++i) { const int t = tid + 512 * i; const f32x2 z = Z[ZI(t)]; const float ga = y0p[t], gb = y1p[t];
          y0p[t] = x0p[t] * (z.x * sc0 + ga * bb0); y1p[t] = x1p[t] * (z.y * sc1 + gb * bb1); } }
    __syncthreads();
}
__device__ __forceinline__ void hyena_ctx_unit(const Frame& F, unsigned char* ws, int l, int unit) {
    LAS float* TF = (LAS float*)F.lds; LAS float* TB = TF + 2048; LAS float* GG = TB + 2048;
    const int tid = F.tid, t = tid >> 1, cc = (tid & 1) * 4, cbase = unit * 8 + cc;
    const bf16_t* H3c = (const bf16_t*)(ws + WS_H3) + (size_t)l * 64 * T; float* GT = (float*)(ws + WS_GT); const float* X0T = (const float*)(ws + WS_X0T);
    { float f[4] = {0.f, 0.f, 0.f, 0.f}, b[4] = {0.f, 0.f, 0.f, 0.f};
      const float* wbase = IN_(35) + (size_t)l * 64 * 2560 + cbase;
      for (int j = 0; j < 64; ++j) { const float hv = bf2f(H3c[(size_t)j * T + t]); const float* wrow = wbase + (size_t)j * 2560;
#pragma unroll
          for (int q = 0; q < 4; ++q) { f[q] += hv * wrow[q]; b[q] += hv * wrow[1280 + q]; } }
      const float tl = (float)t * (1.0f / 255.0f);
#pragma unroll
      for (int q = 0; q < 4; ++q) { const float e = __expf(-tl * hy_delta(cbase + q)); TF[t * 8 + cc + q] = f[q] * e; TB[t * 8 + cc + q] = b[q] * e; GG[t * 8 + cc + q] = GT[(size_t)(cbase + q) * T + t]; } }
    __syncthreads();
    float nrm[4] = {0.f, 0.f, 0.f, 0.f}, y[4] = {0.f, 0.f, 0.f, 0.f};
    for (int s = 0; s < 256; ++s) {
#pragma unroll
        for (int q = 0; q < 4; ++q) { nrm[q] += fabsf(TF[s * 8 + cc + q]) + (s < 255 ? fabsf(TB[s * 8 + cc + q]) : 0.f);
            const int o = t - s; const float tap = o >= 0 ? TF[o * 8 + cc + q] : TB[(-o - 1) * 8 + cc + q];
            y[q] += tap * GG[s * 8 + cc + q]; } }
    __syncthreads();
#pragma unroll
    for (int q = 0; q < 4; ++q) GT[(size_t)(cbase + q) * T + t] = X0T[(size_t)(cbase + q) * T + t] * (y[q] / nrm[q] + GG[t * 8 + cc + q] * IN_(37)[l * 1280 + cbase + q]);
    __syncthreads();
}
constexpr int SC_C = 16, SC_NCHUNK = T / SC_C, SC_CHUNK_BYTES = 14 * 1024;
__device__ __forceinline__ int sc_tau(int d, int c, int t) { return d == 0 ? SC_C * c + t : (c < NCTX / SC_C ? NCTX - 1 - SC_C * c - t : T - 1 - SC_C * (c - NCTX / SC_C) - t); }
__device__ __forceinline__ int sc_perm(int e, int hi) { return (e & 3) + 8 * (e >> 2) + 4 * hi; }
constexpr size_t WS_FR_BYTES = (size_t)2 * NHA * SC_NCHUNK * SC_CHUNK_BYTES;

typedef short sc_bf16x8 __attribute__((ext_vector_type(8)));
typedef float sc_f32x16 __attribute__((ext_vector_type(16)));
__device__ __forceinline__ sc_bf16x8 sc_pack8(const sc_f32x16& a, int base) {
    u32x4 w; w.x = cvt_pk_bf16(a[base + 0], a[base + 1]); w.y = cvt_pk_bf16(a[base + 2], a[base + 3]); w.z = cvt_pk_bf16(a[base + 4], a[base + 5]); w.w = cvt_pk_bf16(a[base + 6], a[base + 7]);
    return *reinterpret_cast<sc_bf16x8*>(&w);
}
constexpr int SC_NSLOT = 9, SC_AHEAD = 7;
__device__ __forceinline__ void scan_chain_mfma(const Frame& F, unsigned char* ws, int chain) {
    const int h = chain >> 1, d = chain & 1, lane = F.lane, n = lane & 31, hi = lane >> 5, ib = F.wave;
    const unsigned char* FRc = ws + WS_FR + (size_t)chain * SC_NCHUNK * SC_CHUNK_BYTES;
    float* Yd = (float*)(ws + WS_Y) + (size_t)d * T * A_W + h * 64;
    LAS unsigned char* buf = F.lds;
    typedef __attribute__((address_space(3))) unsigned sc_lds_u32;
#define SCM_DMA(c_) do { if (ib < 7) { const unsigned char* src_ = FRc + (size_t)(c_) * SC_CHUNK_BYTES; LAS unsigned char* dst_ = buf + ((c_) % SC_NSLOT) * SC_CHUNK_BYTES; \
        _Pragma("unroll") for (int i_ = 0; i_ < 2; ++i_) __builtin_amdgcn_global_load_lds((const unsigned*)(src_ + (i_ * 7 + ib) * 1024 + lane * 16), (sc_lds_u32*)(dst_ + (i_ * 7 + ib) * 1024), 16, 0, 0); } } while (0)
    sc_f32x16 S0 = {}, S1 = {};
    int yoff[8];
#pragma unroll
    for (int r = 0; r < 8; ++r) { const int t = (r & 3) + 8 * (r >> 2) + 4 * hi; yoff[r] = (d ? -t : t) * A_W + 32 * ib + n; }
    __syncthreads();
#pragma unroll
    for (int c = 0; c < SC_AHEAD; ++c) SCM_DMA(c);
    asm volatile("s_waitcnt vmcnt(12)" ::: "memory"); __builtin_amdgcn_s_barrier(); asm volatile("" ::: "memory");
#pragma unroll 1
    for (int c = 0; c < SC_NCHUNK; ++c) {
        const bool steady = c + SC_AHEAD < SC_NCHUNK;
        if (steady) SCM_DMA(c + SC_AHEAD);
        if (ib < 2) {
                const LAS unsigned char* fb = buf + (c % SC_NSLOT) * SC_CHUNK_BYTES;
                sc_bf16x8 fr[11]; sc_bf16x8 vf; f32x4 gt[8];
                { const unsigned fa = (unsigned)(uintptr_t)fb + lane * 16, va = fa + (11 + ib) * 1024, ga = (unsigned)(uintptr_t)fb + 13 * 1024 + hi * 128;
#define SC_DSRD(dst, addr, off) asm volatile("ds_read_b128 %0, %1 offset:%2" : "=v"(dst) : "v"(addr), "i"(off))
                  SC_DSRD(fr[0], fa, 0); SC_DSRD(fr[1], fa, 1024); SC_DSRD(fr[2], fa, 2048); SC_DSRD(fr[3], fa, 3072); SC_DSRD(fr[4], fa, 4096); SC_DSRD(fr[5], fa, 5120);
                  SC_DSRD(fr[6], fa, 6144); SC_DSRD(fr[7], fa, 7168); SC_DSRD(fr[8], fa, 8192); SC_DSRD(fr[9], fa, 9216); SC_DSRD(fr[10], fa, 10240); SC_DSRD(vf, va, 0);
                  SC_DSRD(gt[0], ga, 0); SC_DSRD(gt[1], ga, 16); SC_DSRD(gt[2], ga, 32); SC_DSRD(gt[3], ga, 48); SC_DSRD(gt[4], ga, 64); SC_DSRD(gt[5], ga, 80); SC_DSRD(gt[6], ga, 96); SC_DSRD(gt[7], ga, 112);
#undef SC_DSRD
                  asm volatile("s_waitcnt lgkmcnt(0)" : "+v"(fr[0]), "+v"(fr[1]), "+v"(fr[2]), "+v"(fr[3]), "+v"(fr[4]), "+v"(fr[5]), "+v"(fr[6]), "+v"(fr[7]), "+v"(fr[8]), "+v"(fr[9]), "+v"(fr[10]), "+v"(vf) :: "memory");
                  asm volatile("" : "+v"(gt[0]), "+v"(gt[1]), "+v"(gt[2]), "+v"(gt[3]), "+v"(gt[4]), "+v"(gt[5]), "+v"(gt[6]), "+v"(gt[7])); }
                const sc_bf16x8 sb00 = sc_pack8(S0, 0), sb01 = sc_pack8(S0, 8), sb10 = sc_pack8(S1, 0), sb11 = sc_pack8(S1, 8);
                sc_f32x16 P = {}, P2 = {};
                P = __builtin_amdgcn_mfma_f32_32x32x16_bf16(fr[0], sb00, P, 0, 0, 0);
                P2 = __builtin_amdgcn_mfma_f32_32x32x16_bf16(fr[2], sb10, P2, 0, 0, 0);
                P = __builtin_amdgcn_mfma_f32_32x32x16_bf16(fr[1], sb01, P, 0, 0, 0);
                P2 = __builtin_amdgcn_mfma_f32_32x32x16_bf16(fr[3], sb11, P2, 0, 0, 0);
                P = __builtin_amdgcn_mfma_f32_32x32x16_bf16(fr[4], vf, P, 0, 0, 0);
#pragma unroll
                for (int q = 0; q < 4; ++q)
#pragma unroll
                    for (int e = 0; e < 4; ++e) { S0[4 * q + e] *= gt[q][e]; S1[4 * q + e] *= gt[4 + q][e]; }
                S0 = __builtin_amdgcn_mfma_f32_32x32x16_bf16(fr[8], vf, S0, 0, 0, 0);
                S1 = __builtin_amdgcn_mfma_f32_32x32x16_bf16(fr[10], vf, S1, 0, 0, 0);
#pragma unroll
                for (int r = 0; r < 16; ++r) P[r] += P2[r];
                const sc_bf16x8 xb = sc_pack8(P, 0);
                sc_f32x16 U = {};
                U = __builtin_amdgcn_mfma_f32_32x32x16_bf16(fr[5], xb, U, 0, 0, 0);
                const sc_bf16x8 ub = sc_pack8(U, 0);
                S0 = __builtin_amdgcn_mfma_f32_32x32x16_bf16(fr[7], ub, S0, 0, 0, 0);
                S1 = __builtin_amdgcn_mfma_f32_32x32x16_bf16(fr[9], ub, S1, 0, 0, 0);
                P = __builtin_amdgcn_mfma_f32_32x32x16_bf16(fr[6], ub, P, 0, 0, 0);
                float* yb = Yd + (size_t)sc_tau(d, c, 0) * A_W;
#pragma unroll
                for (int r = 0; r < 8; ++r) yb[yoff[r]] = P[8 + r];
        }
        if (steady) asm volatile("s_waitcnt vmcnt(12)" ::: "memory"); else asm volatile("s_waitcnt vmcnt(0)" ::: "memory");
        asm volatile("s_waitcnt lgkmcnt(0)" ::: "memory"); __builtin_amdgcn_s_barrier(); asm volatile("" ::: "memory");
    }
    asm volatile("s_waitcnt vmcnt(0)" ::: "memory"); __syncthreads();
#undef SCM_DMA
}
__device__ __forceinline__ float conv3_u(const float* PX, int tau, unsigned ucol, float w0, float w1, float w2) {
    const float* p = PX + (size_t)tau * PXW;
    float y = p[ucol] * w1;
    if (has_left(tau)) y += (p - PXW)[ucol] * w0;
    if (has_right(tau)) y += (p + PXW)[ucol] * w2;
    return y;
}
constexpr int WLR_K = 448;
constexpr int RP_WAVE_LDS = 16896;
typedef short rp_bf16x8 __attribute__((ext_vector_type(8)));
typedef float rp_f32x16 __attribute__((ext_vector_type(16)));
__device__ __forceinline__ unsigned short f2bf16(float x) { return (unsigned short)(cvt_pk_bf16(x, x) & 0xffffu); }
template <int NKB, class AF>
__device__ __forceinline__ void rp_lowrank(float (&dst)[16], const AF& afrag, const bf16_t* WLRh, int kw0, int n, int hi) {
    rp_f32x16 c0 = {}, c1 = {}; const bf16_t* wb0 = WLRh + (size_t)n * WLR_K + kw0 + 8 * hi; const bf16_t* wb1 = wb0 + (size_t)32 * WLR_K;
#pragma unroll
    for (int kb = 0; kb < NKB; ++kb) { const rp_bf16x8 b0 = *(const rp_bf16x8*)(wb0 + 16 * kb), b1 = *(const rp_bf16x8*)(wb1 + 16 * kb); const rp_bf16x8 a_ = afrag(kb);
        c0 = __builtin_amdgcn_mfma_f32_32x32x16_bf16(a_, b0, c0, 0, 0, 0); c1 = __builtin_amdgcn_mfma_f32_32x32x16_bf16(a_, b1, c1, 0, 0, 0); }
#pragma unroll
    for (int r = 0; r < 8; ++r) { auto sw = __builtin_amdgcn_permlane32_swap(__float_as_uint(c0[r]), __float_as_uint(c1[r]), false, false);
        dst[(r & 3) + 8 * (r >> 2)] = __uint_as_float(sw[0]); dst[(r & 3) + 8 * (r >> 2) + 4] = __uint_as_float(sw[1]); }
}
struct RpAfLds { const LAS bf16_t* base; __device__ __forceinline__ rp_bf16x8 operator()(int kb) const { return *(const LAS rp_bf16x8*)(base + 16 * kb); } };
__device__ __forceinline__ void rwkv_elem_phase(const Frame& F, unsigned char* ws, int l) {
    const float* PX = (const float*)(ws + WS_PX); float* SS = (float*)(ws + WS_SS); float* SD = (float*)(ws + WS_SD); float* GB = (float*)(ws + WS_G);
    const bf16_t* WLR = (const bf16_t*)(ws + WS_WLR) + (size_t)l * A_W * WLR_K;
    const float* cw = IN_(16) + (size_t)l * 3 * A_IN;
    LAS bf16_t* ACT = (LAS bf16_t*)(F.lds + F.wave * 10752);
    const int lane = F.lane, n = lane & 31, hi = lane >> 5;
    const int gw = F.bid * 8 + F.wave, NGW = F.G * 8;
    for (int it = gw; it < (T / 16) * 10; it += NGW) {
        const int tg = it / 10, hq = it % 10, tau0 = tg * 16;
        asm volatile("s_waitcnt lgkmcnt(0)" ::: "memory");
        const float* prow0 = PX + (size_t)(tau0 > 0 ? tau0 - 1 : 0) * PXW; const int roff = tau0 > 0 ? 0 : -1;
#define RP_WIN(x, ucol_) do { _Pragma("unroll") for (int i_ = 0; i_ < 18; ++i_) { int ri_ = i_ + roff; ri_ = ri_ < 0 ? 0 : ri_; ri_ = (tau0 - 1 + i_ > T - 1) ? (T - 1 - (tau0 > 0 ? tau0 - 1 : 0)) : ri_; x[i_] = (prow0 + (size_t)ri_ * PXW)[ucol_]; } } while (0)
#define RP_CONV(x, t_, w0_, w1_, w2_) (x[(t_)] * (has_left(tau0 + (t_)) ? (w0_) : 0.f) + x[(t_) + 1] * (w1_) + x[(t_) + 2] * (has_right(tau0 + (t_)) ? (w2_) : 0.f))
#pragma unroll
        for (int i = 0; i < 5; ++i) { const int c = lane + 64 * i, col = 3840 + c; const float c0 = cw[col], c1 = cw[A_IN + col], c2 = cw[2 * A_IN + col];
            float x[18]; RP_WIN(x, (unsigned)(PXA + col));
#pragma unroll
            for (int t = 0; t < 16; ++t) { const float val = RP_CONV(x, t, c0, c1, c2);
                const float act = i == 0 ? 1.0f - 2.0f / (1.0f + __expf(2.0f * val)) : (i == 1 ? val : sigmoidf_(val));
                ACT[t * 328 + c] = f2bf16(act); } }
        asm volatile("s_waitcnt lgkmcnt(0)" ::: "memory");
        const RpAfLds afw{ACT + (n & 15) * 328 + 8 * hi}, afa{ACT + (n & 15) * 328 + 64 + 8 * hi}, afg{ACT + (n & 15) * 328 + 128 + 8 * hi};
#pragma unroll 1
        for (int hh = 0; hh < 2; ++hh) {
            const int h = hq * 2 + hh, col = h * 64 + lane; const bf16_t* WLRh = WLR + (size_t)h * 64 * WLR_K;
            { float lg[16]; rp_lowrank<12>(lg, afg, WLRh, 256, n, hi);
#pragma unroll
              for (int t = 0; t < 16; ++t) GB[(size_t)(tau0 + t) * A_W + col] = lg[t]; }
            const float cr0 = cw[col], cr1 = cw[A_IN + col], cr2 = cw[2 * A_IN + col];
            const float ck0 = cw[A_W + col], ck1 = cw[A_IN + A_W + col], ck2 = cw[2 * A_IN + A_W + col];
            const float cv0 = cw[2 * A_W + col], cv1 = cw[A_IN + 2 * A_W + col], cv2 = cw[2 * A_IN + 2 * A_W + col];
            const float kk_w = IN_(22)[l * A_W + col], ka_w = IN_(23)[l * A_W + col];
            float kkv[16], kv[16];
            { float xr[18], xk[18], xv[18]; const unsigned uc = (unsigned)(PXA + col); RP_WIN(xr, uc); RP_WIN(xk, uc + A_W); RP_WIN(xv, uc + 2 * A_W);
#pragma unroll
              for (int t = 0; t < 16; ++t) { const int tau = tau0 + t;
                  const float r = RP_CONV(xr, t, cr0, cr1, cr2), v = RP_CONV(xv, t, cv0, cv1, cv2); kv[t] = RP_CONV(xk, t, ck0, ck1, ck2);
                  const float kr = kv[t] * kk_w; const float nrm = sqrtf(wave_sum(kr * kr)); kkv[t] = kr / fmaxf(nrm, 1e-12f);
                  float* ss = SS + ((size_t)h * T + tau) * 192 + lane; ss[0] = kkv[t]; ss[64] = r; ss[128] = v; } }
#pragma unroll 1
            for (int d = 0; d < 2; ++d) { const float w0b = IN_(17)[(l * 2 + d) * A_W + col], a0b = IN_(19)[(l * 2 + d) * A_W + col]; float lw[16], la[16];
                rp_lowrank<4>(lw, afw, WLRh, 64 * d, n, hi); rp_lowrank<4>(la, afa, WLRh, 128 + 64 * d, n, hi);
#pragma unroll
                for (int t = 0; t < 16; ++t) { const float z = w0b + lw[t]; const float decay = __expf(-__expf(-(fmaxf(-z, 0.f) + __logf(1.0f + __expf(-fabsf(z)))) - 0.5f)); const float av = sigmoidf_(a0b + la[t]);
                    float* sd = SD + (((size_t)h * 2 + d) * T + tau0 + t) * 192 + lane; sd[0] = decay; sd[64] = kkv[t] * av; sd[128] = kv[t] * (1.0f + (av - 1.0f) * ka_w); } }
        }
    }
}
#undef RP_WIN
#undef RP_CONV
constexpr int SP_WAVE_LDS = 16640;
__device__ __forceinline__ void scan_prep_phase(const Frame& F, unsigned char* ws) {
    const float* SS = (const float*)(ws + WS_SS); const float* SD = (const float*)(ws + WS_SD); unsigned char* FR = ws + WS_FR;
    LAS bf16_t* R1 = (LAS bf16_t*)(F.lds + F.wave * SP_WAVE_LDS); LAS bf16_t* R2 = R1 + 32 * 72; LAS bf16_t* BbT = R2 + 32 * 72; LAS bf16_t* KbT = BbT + 64 * 16; LAS bf16_t* VT = KbT + 64 * 16; LAS float* Lm = (LAS float*)(VT + 64 * 16);
    const int lane = F.lane, n = lane & 31, hi = lane >> 5;
    const int gw = F.bid * 8 + F.wave, NGW = F.G * 8;
    for (int it = gw; it < 2 * NHA * SC_NCHUNK; it += NGW) {
        const int chain = it / SC_NCHUNK, c = it % SC_NCHUNK, h = chain >> 1, d = chain & 1;
        const int tau_first = sc_tau(d, c, 0), dstep = d ? -1 : 1;
        const float* ssb = SS + (size_t)h * T * 192 + lane; const float* sdb = SD + ((size_t)h * 2 + d) * T * 192 + lane;
        float xw[16], xb[16], xk[16], xkk[16], xr[16], xv[16];
#pragma unroll
        for (int s = 0; s < 16; ++s) { const size_t o = (size_t)(tau_first + dstep * s) * 192; xw[s] = sdb[o]; xb[s] = sdb[o + 64]; xk[s] = sdb[o + 128]; xkk[s] = ssb[o]; xr[s] = ssb[o + 64]; xv[s] = ssb[o + 128]; }
        float gC = 1.f;
#pragma unroll
        for (int s = 0; s < 16; ++s) gC *= xw[s];
        float g = 1.f;
#pragma unroll
        for (int s = 0; s < 16; ++s) {
            const float gm1 = g; g *= xw[s]; const float ig = 1.0f / g; const float bh = xb[s] * ig, kh = xk[s] * ig;
            R1[s * 72 + lane] = f2bf16(-xkk[s] * gm1); R1[(16 + s) * 72 + lane] = f2bf16(xr[s] * g);
            R2[s * 72 + lane] = f2bf16(bh); R2[(16 + s) * 72 + lane] = f2bf16(kh);
            BbT[lane * 16 + s] = f2bf16(bh * gC); KbT[lane * 16 + s] = f2bf16(kh * gC); VT[lane * 16 + s] = f2bf16(xv[s]); }
        asm volatile("s_waitcnt lgkmcnt(0)" ::: "memory");
        unsigned char* dst = FR + ((size_t)chain * SC_NCHUNK + c) * SC_CHUNK_BYTES;
        rp_f32x16 C = {};
#pragma unroll
        for (int kb = 0; kb < 4; ++kb) { const rp_bf16x8 a_ = *(const LAS rp_bf16x8*)(R2 + n * 72 + 16 * kb + 8 * hi), b_ = *(const LAS rp_bf16x8*)(R1 + n * 72 + 16 * kb + 8 * hi);
            C = __builtin_amdgcn_mfma_f32_32x32x16_bf16(a_, b_, C, 0, 0, 0); }
        const int tt_ = n & 15; const bool incl = n >= 16;
#pragma unroll
        for (int r = 0; r < 16; ++r) { const int s = ((r & 7) & 3) + 8 * ((r & 7) >> 2) + 4 * hi; if (!(s < tt_ || (incl && s == tt_))) C[r] = 0.f; }
        if (n < 16) {
#pragma unroll
            for (int r = 0; r < 8; ++r) Lm[((r & 3) + 8 * (r >> 2) + 4 * hi) * 20 + n] = C[r]; }
        { u32x4 f4; f4.x = cvt_pk_bf16(C[8], C[9]); f4.y = cvt_pk_bf16(C[10], C[11]); f4.z = cvt_pk_bf16(C[12], C[13]); f4.w = cvt_pk_bf16(C[14], C[15]);
          u32x4 f6; f6.x = cvt_pk_bf16(C[0], C[1]); f6.y = cvt_pk_bf16(C[2], C[3]); f6.z = cvt_pk_bf16(C[4], C[5]); f6.w = cvt_pk_bf16(C[6], C[7]);
          if (n < 16) f6 = (u32x4){0u, 0u, 0u, 0u};
          *(u32x4*)(dst + 4 * 1024 + lane * 16) = f4; *(u32x4*)(dst + 6 * 1024 + lane * 16) = f6; }
        asm volatile("s_waitcnt lgkmcnt(0)" ::: "memory");
        { float Tc[16];
#pragma unroll
          for (int s = 15; s >= 0; --s) { float acc = (s == n) ? 1.f : 0.f;
#pragma unroll
              for (int u = s + 1; u < 16; ++u) acc += Lm[s * 20 + u] * Tc[u];
              Tc[s] = acc; }
          u32x4 f5; f5.x = cvt_pk_bf16(hi ? Tc[4] : Tc[0], hi ? Tc[5] : Tc[1]); f5.y = cvt_pk_bf16(hi ? Tc[6] : Tc[2], hi ? Tc[7] : Tc[3]);
          f5.z = cvt_pk_bf16(hi ? Tc[12] : Tc[8], hi ? Tc[13] : Tc[9]); f5.w = cvt_pk_bf16(hi ? Tc[14] : Tc[10], hi ? Tc[15] : Tc[11]);
          if (n >= 16) f5 = (u32x4){0u, 0u, 0u, 0u};
          *(u32x4*)(dst + 5 * 1024 + lane * 16) = f5; }
#pragma unroll
        for (int f = 0; f < 4; ++f) { const u32x2 p0 = *(const LAS u32x2*)(R1 + n * 72 + 16 * f + 4 * hi), p1 = *(const LAS u32x2*)(R1 + n * 72 + 16 * f + 8 + 4 * hi);
            *(u32x4*)(dst + f * 1024 + lane * 16) = (u32x4){p0.x, p0.y, p1.x, p1.y}; }
#pragma unroll
        for (int jb = 0; jb < 2; ++jb) { const int row = 32 * jb + n;
            const u32x2 b0 = *(const LAS u32x2*)(BbT + row * 16 + 4 * hi), b1 = *(const LAS u32x2*)(BbT + row * 16 + 8 + 4 * hi), k0 = *(const LAS u32x2*)(KbT + row * 16 + 4 * hi), k1 = *(const LAS u32x2*)(KbT + row * 16 + 8 + 4 * hi);
            const u32x2 v0 = *(const LAS u32x2*)(VT + row * 16 + 4 * hi), v1 = *(const LAS u32x2*)(VT + row * 16 + 8 + 4 * hi);
            *(u32x4*)(dst + (7 + 2 * jb) * 1024 + lane * 16) = (u32x4){b0.x, b0.y, b1.x, b1.y}; *(u32x4*)(dst + (8 + 2 * jb) * 1024 + lane * 16) = (u32x4){k0.x, k0.y, k1.x, k1.y};
            *(u32x4*)(dst + (11 + jb) * 1024 + lane * 16) = (u32x4){v0.x, v0.y, v1.x, v1.y}; }
        { const int jj = lane & 31; ((float*)(dst + 13 * 1024))[((jj >> 2) & 1) * 32 + (lane >> 5) * 16 + (jj & 3) + 4 * (jj >> 3)] = gC; }
        asm volatile("s_waitcnt lgkmcnt(0)" ::: "memory");
    }
}
constexpr int RF_ACT_BYTES = 16 * 320 * 2;
__device__ __forceinline__ void rwkv_fused_phase(const Frame& F, unsigned char* ws, int l) {
    const float* PX = (const float*)(ws + WS_PX); unsigned char* FR = ws + WS_FR;
    float* GB = (float*)(ws + WS_G); float* RB = (float*)(ws + WS_SS); float* VB = RB + (size_t)T * A_W; float* KD = (float*)(ws + WS_SD);
    const bf16_t* WLR = (const bf16_t*)(ws + WS_WLR) + (size_t)l * A_W * WLR_K;
    const float* cw = IN_(16) + (size_t)l * 3 * A_IN;
    LAS bf16_t* ACT = (LAS bf16_t*)F.lds;
    LAS bf16_t* R1 = (LAS bf16_t*)(F.lds + RF_ACT_BYTES + F.wave * SP_WAVE_LDS); LAS bf16_t* R2 = R1 + 32 * 72; LAS bf16_t* BbT = R2 + 32 * 72; LAS bf16_t* KbT = BbT + 64 * 16; LAS bf16_t* VT = KbT + 64 * 16; LAS float* Lm = (LAS float*)(VT + 64 * 16);
    const int lane = F.lane, n = lane & 31, hi = lane >> 5, hh = F.wave >> 1, d = F.wave & 1;
    for (int it = F.bid; it < (T / 16) * 5; it += F.G) {
        const int tg = it / 5, hg = it % 5, tau0 = tg * 16, h = hg * 4 + hh, col = h * 64 + lane;
        __syncthreads();
        for (int e = F.tid; e < 16 * 320; e += 512) { const int t = e / 320, c = e % 320, cc = 3840 + c;
            const float val = conv3_at(PX, tau0 + t, PXA + cc, cw[cc], cw[A_IN + cc], cw[2 * A_IN + cc]);
            const float act = c < 64 ? 1.0f - 2.0f / (1.0f + __expf(2.0f * val)) : (c < 128 ? val : sigmoidf_(val));
            ACT[t * 320 + c] = f2bf16(act); }
        __syncthreads();
        const float* prow0 = PX + (size_t)(tau0 > 0 ? tau0 - 1 : 0) * PXW; const int roff = tau0 > 0 ? 0 : -1;
#define RP_WIN(x, ucol_) do { _Pragma("unroll") for (int i_ = 0; i_ < 18; ++i_) { int ri_ = i_ + roff; ri_ = ri_ < 0 ? 0 : ri_; ri_ = (tau0 - 1 + i_ > T - 1) ? (T - 1 - (tau0 > 0 ? tau0 - 1 : 0)) : ri_; x[i_] = (prow0 + (size_t)ri_ * PXW)[ucol_]; } } while (0)
#define RP_CONV(x, t_, w0_, w1_, w2_) (x[(t_)] * (has_left(tau0 + (t_)) ? (w0_) : 0.f) + x[(t_) + 1] * (w1_) + x[(t_) + 2] * (has_right(tau0 + (t_)) ? (w2_) : 0.f))
        const bf16_t* WLRh = WLR + (size_t)h * 64 * WLR_K;
        const RpAfLds afw{ACT + (n & 15) * 320 + 8 * hi}, afa{ACT + (n & 15) * 320 + 64 + 8 * hi}, afg{ACT + (n & 15) * 320 + 128 + 8 * hi};
        float xw[16], xb[16], xk[16], xkk[16], xr[16], xv[16];
        { float wr_[18], wk_[18], wv_[18]; const unsigned uc = (unsigned)(PXA + col); RP_WIN(wr_, uc); RP_WIN(wk_, uc + A_W); RP_WIN(wv_, uc + 2 * A_W);
          if (d == 0) { float lg[16]; rp_lowrank<12>(lg, afg, WLRh, 256, n, hi);
#pragma unroll
              for (int t = 0; t < 16; ++t) GB[(size_t)(tau0 + t) * A_W + col] = lg[t]; }
          const float cr0 = cw[col], cr1 = cw[A_IN + col], cr2 = cw[2 * A_IN + col], ck0 = cw[A_W + col], ck1 = cw[A_IN + A_W + col], ck2 = cw[2 * A_IN + A_W + col];
          const float cv0 = cw[2 * A_W + col], cv1 = cw[A_IN + 2 * A_W + col], cv2 = cw[2 * A_IN + 2 * A_W + col], kk_w = IN_(22)[l * A_W + col];
#pragma unroll
          for (int t = 0; t < 16; ++t) { xr[t] = RP_CONV(wr_, t, cr0, cr1, cr2); xv[t] = RP_CONV(wv_, t, cv0, cv1, cv2); xk[t] = RP_CONV(wk_, t, ck0, ck1, ck2);
              const float kr = xk[t] * kk_w; const float nrm = sqrtf(wave_sum(kr * kr)); xkk[t] = kr / fmaxf(nrm, 1e-12f); } }
        if (d == 0) {
#pragma unroll
            for (int t = 0; t < 16; ++t) { RB[(size_t)(tau0 + t) * A_W + col] = xr[t]; VB[(size_t)(tau0 + t) * A_W + col] = xv[t]; } }
        { const float ka_w = IN_(23)[l * A_W + col], w0b = IN_(17)[(l * 2 + d) * A_W + col], a0b = IN_(19)[(l * 2 + d) * A_W + col]; float la[16];
          rp_lowrank<4>(xw, afw, WLRh, 64 * d, n, hi); rp_lowrank<4>(la, afa, WLRh, 128 + 64 * d, n, hi);
#pragma unroll
          for (int t = 0; t < 16; ++t) { const float z = w0b + xw[t]; xw[t] = __expf(-__expf(-(fmaxf(-z, 0.f) + __logf(1.0f + __expf(-fabsf(z)))) - 0.5f)); const float av = sigmoidf_(a0b + la[t]);
              xb[t] = xkk[t] * av; xk[t] = xk[t] * (1.0f + (av - 1.0f) * ka_w); KD[((size_t)d * T + tau0 + t) * A_W + col] = xk[t]; } }
        if (d) {
#pragma unroll
            for (int s = 0; s < 8; ++s) { float t_;
                t_ = xw[s]; xw[s] = xw[15 - s]; xw[15 - s] = t_; t_ = xb[s]; xb[s] = xb[15 - s]; xb[15 - s] = t_; t_ = xk[s]; xk[s] = xk[15 - s]; xk[15 - s] = t_;
                t_ = xkk[s]; xkk[s] = xkk[15 - s]; xkk[15 - s] = t_; t_ = xr[s]; xr[s] = xr[15 - s]; xr[15 - s] = t_; t_ = xv[s]; xv[s] = xv[15 - s]; xv[15 - s] = t_; } }
        const int c = d == 0 ? tg : (tg < NCTX / 16 ? NCTX / 16 - 1 - tg : NCTX / 16 + (T / 16 - 1) - tg);
        float gC = 1.f;
#pragma unroll
        for (int s = 0; s < 16; ++s) gC *= xw[s];
        float g = 1.f;
#pragma unroll
        for (int s = 0; s < 16; ++s) {
            const float gm1 = g; g *= xw[s]; const float ig = 1.0f / g; const float bh = xb[s] * ig, kh = xk[s] * ig;
            R1[s * 72 + lane] = f2bf16(-xkk[s] * gm1); R1[(16 + s) * 72 + lane] = f2bf16(xr[s] * g);
            R2[s * 72 + lane] = f2bf16(bh); R2[(16 + s) * 72 + lane] = f2bf16(kh);
            BbT[lane * 16 + s] = f2bf16(bh * gC); KbT[lane * 16 + s] = f2bf16(kh * gC); VT[lane * 16 + s] = f2bf16(xv[s]); }
        asm volatile("s_waitcnt lgkmcnt(0)" ::: "memory");
        unsigned char* dst = FR + ((size_t)(h * 2 + d) * SC_NCHUNK + c) * SC_CHUNK_BYTES;
        rp_f32x16 C = {};
#pragma unroll
        for (int kb = 0; kb < 4; ++kb) { const rp_bf16x8 a_ = *(const LAS rp_bf16x8*)(R2 + n * 72 + 16 * kb + 8 * hi), b_ = *(const LAS rp_bf16x8*)(R1 + n * 72 + 16 * kb + 8 * hi);
            C = __builtin_amdgcn_mfma_f32_32x32x16_bf16(a_, b_, C, 0, 0, 0); }
        const int tt_ = n & 15; const bool incl = n >= 16;
#pragma unroll
        for (int r = 0; r < 16; ++r) { const int s = ((r & 7) & 3) + 8 * ((r & 7) >> 2) + 4 * hi; if (!(s < tt_ || (incl && s == tt_))) C[r] = 0.f; }
        if (n < 16) {
#pragma unroll
            for (int r = 0; r < 8; ++r) Lm[((r & 3) + 8 * (r >> 2) + 4 * hi) * 20 + n] = C[r]; }
        { u32x4 f4; f4.x = cvt_pk_bf16(C[8], C[9]); f4.y = cvt_pk_bf16(C[10], C[11]); f4.z = cvt_pk_bf16(C[12], C[13]); f4.w = cvt_pk_bf16(C[14], C[15]);
          u32x4 f6; f6.x = cvt_pk_bf16(C[0], C[1]); f6.y = cvt_pk_bf16(C[2], C[3]); f6.z = cvt_pk_bf16(C[4], C[5]); f6.w = cvt_pk_bf16(C[6], C[7]);
          if (n < 16) f6 = (u32x4){0u, 0u, 0u, 0u};
          *(u32x4*)(dst + 4 * 1024 + lane * 16) = f4; *(u32x4*)(dst + 6 * 1024 + lane * 16) = f6; }
        asm volatile("s_waitcnt lgkmcnt(0)" ::: "memory");
        { float Tc[16];
#pragma unroll
          for (int s = 15; s >= 0; --s) { float acc = (s == n) ? 1.f : 0.f;
#pragma unroll
              for (int u = s + 1; u < 16; ++u) acc += Lm[s * 20 + u] * Tc[u];
              Tc[s] = acc; }
          u32x4 f5; f5.x = cvt_pk_bf16(hi ? Tc[4] : Tc[0], hi ? Tc[5] : Tc[1]); f5.y = cvt_pk_bf16(hi ? Tc[6] : Tc[2], hi ? Tc[7] : Tc[3]);
          f5.z = cvt_pk_bf16(hi ? Tc[12] : Tc[8], hi ? Tc[13] : Tc[9]); f5.w = cvt_pk_bf16(hi ? Tc[14] : Tc[10], hi ? Tc[15] : Tc[11]);
          if (n >= 16) f5 = (u32x4){0u, 0u, 0u, 0u};
          *(u32x4*)(dst + 5 * 1024 + lane * 16) = f5; }
#pragma unroll
        for (int f = 0; f < 4; ++f) { const u32x2 p0 = *(const LAS u32x2*)(R1 + n * 72 + 16 * f + 4 * hi), p1 = *(const LAS u32x2*)(R1 + n * 72 + 16 * f + 8 + 4 * hi);
            *(u32x4*)(dst + f * 1024 + lane * 16) = (u32x4){p0.x, p0.y, p1.x, p1.y}; }
#pragma unroll
        for (int jb = 0; jb < 2; ++jb) { const int row = 32 * jb + n;
            const u32x2 b0 = *(const LAS u32x2*)(BbT + row * 16 + 4 * hi), b1 = *(const LAS u32x2*)(BbT + row * 16 + 8 + 4 * hi), k0 = *(const LAS u32x2*)(KbT + row * 16 + 4 * hi), k1 = *(const LAS u32x2*)(KbT + row * 16 + 8 + 4 * hi);
            const u32x2 v0 = *(const LAS u32x2*)(VT + row * 16 + 4 * hi), v1 = *(const LAS u32x2*)(VT + row * 16 + 8 + 4 * hi);
            *(u32x4*)(dst + (7 + 2 * jb) * 1024 + lane * 16) = (u32x4){b0.x, b0.y, b1.x, b1.y}; *(u32x4*)(dst + (8 + 2 * jb) * 1024 + lane * 16) = (u32x4){k0.x, k0.y, k1.x, k1.y};
            *(u32x4*)(dst + (11 + jb) * 1024 + lane * 16) = (u32x4){v0.x, v0.y, v1.x, v1.y}; }
        { const int jj = lane & 31; ((float*)(dst + 13 * 1024))[((jj >> 2) & 1) * 32 + (lane >> 5) * 16 + (jj & 3) + 4 * (jj >> 3)] = gC; }
        asm volatile("s_waitcnt lgkmcnt(0)" ::: "memory");
    }
#undef RP_WIN
#undef RP_CONV
}
__device__ __forceinline__ void mixer_phase(const Frame& F0, unsigned char* ws0, int lq, bool need_ctx, char* lds_g) {
    const int l = lq & 3;
#ifndef MK_MIX
#define MK_MIX 15
#endif
    { const Frame F = opq(F0); unsigned char* ws = opq_ptr(ws0);
      if (MK_MIX & 1) for (int chain = F.bid; chain < 2 * NHA; chain += F.G) scan_chain_mfma(F, ws, chain); }
    const Frame& F = F0;
    const int n_xa = 32 * NHC, n_ca = need_ctx ? NHC : 0, n_att = n_xa + n_ca, n_hy = 640, n_ch = need_ctx ? 160 : 0;
    unsigned* qatt = (unsigned*)(ws0 + WS_CTL) + CW_QUEUE + 64 * lq; unsigned* qhy = qatt + 32;
    int item;
#define MIX_POP(q) do { if (F.tid == 0) F.MISC[16] = __hip_atomic_fetch_add((q), 1u, __ATOMIC_RELAXED, __HIP_MEMORY_SCOPE_AGENT); __syncthreads(); item = (int)F.MISC[16]; __syncthreads(); } while (0)
    if (F.bid >= 2 * NHA) {
        MIX_POP(qatt);
        while (item < n_att) {
            if (MK_MIX & 2) { unsigned char* ws = opq_ptr(ws0);
                const bf16_t* QF = (const bf16_t*)(ws + WS_QF); const bf16_t* KF = (const bf16_t*)(ws + WS_KF); const bf16_t* KVRAW = (const bf16_t*)(ws + WS_KVRAW); bf16_t* OB = (bf16_t*)(ws + WS_OBUF);
                const bool is_xa = item < n_xa; const int h = is_xa ? item % NHC : item - n_xa, row0 = is_xa ? NCTX + (item / NHC) * 256 : 0;
                for (int rp = 0; rp < REP(13); ++rp) att::attn_body(QF + (size_t)row0 * NQ + h * 192, KF + h * 192, KVRAW + h * 256 + 128, OB + (size_t)row0 * DM + 2560 + h * 128, is_xa ? T : NCTX, lds_g); }
            MIX_POP(qatt);
        }
    }
    MIX_POP(qhy);
    while (item < n_hy + n_ch) {
        const Frame Fu = opq(F0); unsigned char* ws = opq_ptr(ws0);
        if ((MK_MIX & 4) && item < n_hy) hyena_unit(Fu, ws, l, item);
        else if ((MK_MIX & 8) && item >= n_hy) hyena_ctx_unit(Fu, ws, l, item - n_hy);
        MIX_POP(qhy);
    }
#undef MIX_POP
}

__device__ __forceinline__ void hyena_taps_tail(const Frame& F0, unsigned char* ws0, int lt, int first, int end) {
    if (F0.bid < 48) return;
#pragma unroll 1
    for (int p = first + F0.bid - 48; p < end; p += 208) hyena_taps_unit(opq(F0), opq_ptr(ws0), lt, p);
}
constexpr int NPH = 2 + 14 * NL;
__global__ void __launch_bounds__(512, 2) mk_fwd(Args a) {
    extern __shared__ __attribute__((aligned(16))) unsigned char lds[];
    Frame F; F.lds = (LAS unsigned char*)lds; F.MISC = (volatile LAS unsigned*)(F.lds + LDS_MISC);
    F.tid = threadIdx.x; F.lane = F.tid & 63; F.wave = __builtin_amdgcn_readfirstlane(F.tid >> 6); F.bid = blockIdx.x; F.G = gridDim.x;
    if (F.tid < 64) F.MISC[F.tid] = 0u;
    if (F.tid < 46) *(LAS unsigned long long*)(F.lds + LDS_PTAB + 8 * F.tid) = (unsigned long long)(uintptr_t)a.in[F.tid];
    __syncthreads();
    unsigned char* ws = a.ws;
    const int lo = a.ph_lo, hi = a.ph_hi;
    XcdBarrier bar = xcd_barrier_post((unsigned*)(ws + WS_CTL) + CW_BAR, F.MISC + 8);
#ifndef MK_MASK
#define MK_MASK 0xffff
#endif
#define EN(x) (((MK_MASK) >> (x)) & 1)
#define IN(k) (lo <= (k) && (k) < hi)
#define SEAM(k) do { if (IN(k) && IN((k) + 1)) xcd_barrier(bar); } while (0)
#define WSP opq_ptr(ws)
#define P_XS(w) ((float*)((w) + WS_XS))
#define P_ABUF(w) ((bf16_t*)((w) + WS_ABUF))
#define P_HBUF(w) ((bf16_t*)((w) + WS_HBUF))
#define P_OBUF(w) ((bf16_t*)((w) + WS_OBUF))
#define P_MODX(w, l) ((const float*)((w) + WS_MOD) + ((size_t)(l) * 2 + 0) * NMOD)
#define P_MODC(w, l) ((const float*)((w) + WS_MOD) + ((size_t)(l) * 2 + 1) * NMOD)
#define P_WL(w, l) ((const bf16_t*)((w) + WS_WB) + (size_t)(l) * W_LAYER)
    if (EN(0) && IN(0)) for (int rp = 0; rp < REP(0); ++rp) phase0(opq(F), opq_ptr(ws));
    SEAM(0);
    if (EN(1) && IN(1)) phase_mod(opq(F), opq_ptr(ws));
    SEAM(1);
#pragma clang loop unroll(full)
    for (int l = 0; l < NL; ++l) {
        const int pb = 2 + 14 * l; const bool need_ctx = l < NL - 1;
        if (EN(2) && IN(pb + 0)) for (int rp = 0; rp < REP(2); ++rp) { unsigned char* w = WSP; norm_phase(opq(F), P_XS(w), IN_(7) + l * DM, P_MODX(w, l), P_MODC(w, l), 0, 1, P_ABUF(w), l > 0 ? (const float*)(w + WS_SLAB) : nullptr, l > 0 ? P_MODC(w, l - 1) + 8 * DM : nullptr, 0.5f); }
        SEAM(pb + 0);
        if (EN(3) && IN(pb + 1)) { unsigned char* w = WSP; pg8::Gemm g{P_ABUF(w), P_WL(w, l) + W_G1, T, 2 * FF, DM, DM}; pg8::StaticOrder S; S.init(T, 2 * FF, F.G, F.bid); pg8::EpiSwiGLU E{P_HBUF(w), FF};
            pg8::gemm_phase<pg8::EpiSwiGLU, pg8::StaticOrder>(F.lds, g, S, E, nullptr);
            hyena_taps_tail(F, ws, l, 0, l == 0 ? 640 : 416); }
        SEAM(pb + 1);
        if (EN(4) && IN(pb + 2)) {
            { unsigned char* w = WSP; pg8::Gemm g{P_HBUF(w), P_WL(w, l) + W_D1, T, DM, FF, FF}; pg8::StaticOrderX S; S.init(T, DM, F.G, F.bid); pg8::EpiResid E{P_XS(w), P_MODX(w, l) + 2 * DM, P_MODC(w, l) + 2 * DM, 0.5f, nullptr};
              pg8::gemm_phase<pg8::EpiResid, pg8::StaticOrderX>(F.lds, g, S, E, nullptr); }
            if (true) { __syncthreads();
              if (F.bid < 256) { unsigned char* w = WSP; const int ks = F.bid >> 4, ksz = FF / 16; pg8::Gemm g{P_HBUF(w) + ks * ksz, P_WL(w, l) + W_D1 + ks * ksz, NCTX, DM, ksz, FF}; pg8::OneUnit S{F.bid & 15};
                  pg8::EpiF32 E{(float*)(w + WS_SLAB) + (size_t)ks * NCTX * DM, DM, nullptr};
                  pg8::gemm_phase<pg8::EpiF32, pg8::OneUnit>(F.lds, g, S, E, nullptr); } }
        }
        SEAM(pb + 2);
        if (EN(5) && IN(pb + 3)) for (int rp = 0; rp < REP(2); ++rp) { unsigned char* w = WSP; norm_phase(opq(F), P_XS(w), IN_(8) + l * DM, P_MODX(w, l), P_MODC(w, l), 3, 4, P_ABUF(w), (const float*)(w + WS_SLAB), P_MODC(w, l) + 2 * DM, 0.5f); }
        SEAM(pb + 3);
        if (EN(6) && IN(pb + 4)) { unsigned char* w = WSP; pg8::Gemm g{P_ABUF(w), P_WL(w, l) + W_IN, T, PXW, DM, DM}; pg8::StaticOrder S; S.init(T, PXW, F.G, F.bid); pg8::EpiF32 E{(float*)(w + WS_PX), PXW, nullptr};
            pg8::gemm_phase<pg8::EpiF32, pg8::StaticOrder>(F.lds, g, S, E, nullptr); }
        SEAM(pb + 4);
        if (EN(7) && IN(pb + 5)) { for (int rp = 0; rp < REP(7); ++rp) rwkv_fused_phase(opq(F), opq_ptr(ws), l); if (!(MK_ONLYRP)) { for (int rp = 0; rp < REP(8); ++rp) mla_prep_phase(opq(F), opq_ptr(ws), l); hyena_prep_phase(opq(F), opq_ptr(ws), l); } }
        SEAM(pb + 5);
        if (EN(8) && IN(pb + 6)) {
            { unsigned char* w = WSP; pg8::Gemm g{(const bf16_t*)(w + WS_QA), P_WL(w, l) + W_Q, T, NQ, 1024, 1024}; pg8::StaticOrder S; S.init(T, NQ, F.G, F.bid); pg8::EpiBf16<0> E{(bf16_t*)(w + WS_QRAW), NQ, nullptr, 0, 0};
              pg8::gemm_phase<pg8::EpiBf16<0>, pg8::StaticOrder>(F.lds, g, S, E, nullptr); }
            __syncthreads();
            { unsigned char* w = WSP; pg8::Gemm g{(const bf16_t*)(w + WS_KVA), P_WL(w, l) + W_KV, T, NKV, 512, 512}; pg8::StaticOrder S; S.init(T, NKV, F.G, F.bid); pg8::EpiBf16<0> E{(bf16_t*)(w + WS_KVRAW), NKV, nullptr, 0, 0};
              pg8::gemm_phase<pg8::EpiBf16<0>, pg8::StaticOrder>(F.lds, g, S, E, nullptr); }
        }
        SEAM(pb + 6);
        if (EN(9) && IN(pb + 7)) { for (int rp = 0; rp < REP(8); ++rp) qkv_final_phase(opq(F), opq_ptr(ws), l, need_ctx); }
        SEAM(pb + 7);
        if (EN(10) && IN(pb + 8)) for (int rp = 0; rp < REP(10); ++rp) mixer_phase(F, ws, l + 4 * rp, need_ctx, (char*)lds);
        SEAM(pb + 8);
        if (EN(11) && IN(pb + 9)) { for (int rp = 0; rp < REP(8); ++rp) rwkv_out_phase(opq(F), opq_ptr(ws), l, need_ctx); hyena_out_phase(opq(F), opq_ptr(ws), need_ctx); }
        SEAM(pb + 9);
        if (EN(12) && IN(pb + 10)) {
            { unsigned char* w = WSP; pg8::Gemm g{P_OBUF(w), P_WL(w, l) + W_OUT, T, DM, DM, DM}; pg8::StaticOrderX S; S.init(T, DM, F.G, F.bid); pg8::EpiResid E{P_XS(w), P_MODX(w, l) + 5 * DM, P_MODC(w, l) + 5 * DM, 1.0f, nullptr};
              pg8::gemm_phase<pg8::EpiResid, pg8::StaticOrderX>(F.lds, g, S, E, nullptr); }
            if (need_ctx) { __syncthreads();
              if (F.bid < 256) { unsigned char* w = WSP; const int ks = F.bid >> 4, ksz = DM / 16; pg8::Gemm g{P_OBUF(w) + ks * ksz, P_WL(w, l) + W_OUT + ks * ksz, NCTX, DM, ksz, DM}; pg8::OneUnit S{F.bid & 15};
                  pg8::EpiF32 E{(float*)(w + WS_SLAB) + (size_t)ks * NCTX * DM, DM, nullptr};
                  pg8::gemm_phase<pg8::EpiF32, pg8::OneUnit>(F.lds, g, S, E, nullptr); } }
        }
        SEAM(pb + 10);
        if (EN(13) && IN(pb + 11)) for (int rp = 0; rp < REP(2); ++rp) { unsigned char* w = WSP; norm_phase(opq(F), P_XS(w), IN_(9) + l * DM, P_MODX(w, l), P_MODC(w, l), 6, 7, P_ABUF(w), need_ctx ? (const float*)(w + WS_SLAB) : nullptr, P_MODC(w, l) + 5 * DM, 1.0f); }
        SEAM(pb + 11);
        if (EN(14) && IN(pb + 12)) { if (need_ctx) { unsigned char* w = WSP; pg8::Gemm g{P_ABUF(w), P_WL(w, l) + W_G2, T, 2 * FF, DM, DM}; pg8::StaticOrder S; S.init(T, 2 * FF, F.G, F.bid); pg8::EpiSwiGLU E{P_HBUF(w), FF};
            pg8::gemm_phase<pg8::EpiSwiGLU, pg8::StaticOrder>(F.lds, g, S, E, nullptr);
            hyena_taps_tail(F, ws, l + 1, 416, 640); }       else { unsigned char* w = WSP; pg8::Gemm g{P_ABUF(w), P_WL(w, l) + W_G2, T, 2 * FF, DM, DM}; pg8::StaticOrderX S; S.init(T, 2 * FF, F.G, F.bid); pg8::EpiSwiGLU E{P_HBUF(w), FF};
            pg8::gemm_phase<pg8::EpiSwiGLU, pg8::StaticOrderX>(F.lds, g, S, E, nullptr); } }
        SEAM(pb + 12);
        if (EN(15) && IN(pb + 13)) {
            { unsigned char* w = WSP; pg8::Gemm g{P_HBUF(w), P_WL(w, l) + W_D2, T, DM, FF, FF}; pg8::StaticOrderX S; S.init(T, DM, F.G, F.bid); pg8::EpiResid E{P_XS(w), P_MODX(w, l) + 8 * DM, P_MODC(w, l) + 8 * DM, 0.5f, l == NL - 1 ? a.out : nullptr};
              pg8::gemm_phase<pg8::EpiResid, pg8::StaticOrderX>(F.lds, g, S, E, nullptr); }
            if (need_ctx) { __syncthreads();
              if (F.bid < 256) { unsigned char* w = WSP; const int ks = F.bid >> 4, ksz = FF / 16; pg8::Gemm g{P_HBUF(w) + ks * ksz, P_WL(w, l) + W_D2 + ks * ksz, NCTX, DM, ksz, FF}; pg8::OneUnit S{F.bid & 15};
                  pg8::EpiF32 E{(float*)(w + WS_SLAB) + (size_t)ks * NCTX * DM, DM, nullptr};
                  pg8::gemm_phase<pg8::EpiF32, pg8::OneUnit>(F.lds, g, S, E, nullptr); } }
        }
        SEAM(pb + 13);
    }
#undef IN
#undef SEAM
}

#ifndef MK_LAUNCHES
#define MK_LAUNCHES 1
#endif
extern "C" void kernel_launch(void* const* d_in, const int* in_sizes, int n_in, void* d_out, int out_size, void* d_ws, size_t ws_size, hipStream_t stream) {
    static int grid = 0;
    if (grid == 0) {
        if (n_in != 46 || in_sizes[0] != SEQ * DM || out_size != SEQ * DM || ws_size < WS_END) {
            fprintf(stderr, "kernel_launch: shape mismatch: n_in %d in0 %d out %d ws %zu (need %zu); nothing launched\n", n_in, n_in > 0 ? in_sizes[0] : -1, out_size, ws_size, (size_t)WS_END); grid = -1; return; }
        int dev = 0, cus = 0, per_cu = 0;
        if (hipGetDevice(&dev) != hipSuccess || hipDeviceGetAttribute(&cus, hipDeviceAttributeMultiprocessorCount, dev) != hipSuccess) { fprintf(stderr, "kernel_launch: device query failed\n"); grid = -1; return; }
        if (hipFuncSetAttribute((const void*)mk_fwd, hipFuncAttributeMaxDynamicSharedMemorySize, LDS_BYTES) != hipSuccess) { fprintf(stderr, "kernel_launch: hipFuncSetAttribute failed\n"); grid = -1; return; }
        if (hipOccupancyMaxActiveBlocksPerMultiprocessor(&per_cu, (const void*)mk_fwd, 512, LDS_BYTES) != hipSuccess || per_cu < 1) fprintf(stderr, "kernel_launch: note: occupancy query reports %d blocks per CU\n", per_cu);
        (void)hipGetLastError();
        grid = cus;
        if (cus != 256) { fprintf(stderr, "kernel_launch: built for 256 CUs (split-K of the context panel, hyena scratch), found %d; nothing launched\n", cus); grid = -1; return; }
    }
    if (grid < 0) return;
    if (hipMemsetAsync((char*)d_ws + WS_CTL, 0, CTL_BYTES, stream) != hipSuccess) { fprintf(stderr, "kernel_launch: memset failed\n"); return; }
    Args a{};
    for (int i = 0; i < 46; ++i) a.in[i] = (const float*)d_in[i];
    a.out = (float*)d_out; a.ws = (unsigned char*)d_ws;
    a.ph_lo = 0; a.ph_hi = NPH;
    hipLaunchKernelGGL(mk_fwd, dim3(grid), dim3(512), LDS_BYTES, stream, a);
    const hipError_t le = hipPeekAtLastError();
    if (le != hipSuccess) fprintf(stderr, "kernel_launch: launch failed: %s\n", hipGetErrorName(le));
}
```

```cpp
#include <hip/hip_runtime.h>
#include <stdint.h>
#include <cstdio>

#define LAS __attribute__((address_space(3)))
#define CAS __attribute__((address_space(4)))
typedef unsigned short bf16_t;
typedef float f32x4 __attribute__((ext_vector_type(4)));
typedef float f32x2 __attribute__((ext_vector_type(2)));
typedef unsigned u32x4 __attribute__((ext_vector_type(4)));
typedef unsigned u32x2 __attribute__((ext_vector_type(2)));

constexpr int T = 8448, NCTX = 256, SEQ = 8192, DM = 4096, FF = 6144, NL = 4;
constexpr int A_W = 1280, A_IN = 4160, B_IN = 3840, C_IN = 1600, NHA = 20;
constexpr int PXW = 9728, PXA = 0, PXB = 4160, PXC = 8000;
constexpr int NQ = 2304, NKV = 3072, NHC = 12;
constexpr int NMOD = 9 * DM;
constexpr float NORM_EPS = 1e-6f, GN_EPS = 64e-5f;

constexpr size_t MiB = 1u << 20;
constexpr size_t al(size_t x) { return (x + MiB - 1) / MiB * MiB; }
constexpr size_t WS_CTL = 0, CTL_BYTES = MiB;
constexpr size_t WS_XS = WS_CTL + CTL_BYTES;
constexpr size_t WS_ABUF = WS_XS + al((size_t)T * DM * 4);
constexpr size_t WS_HBUF = WS_ABUF + al((size_t)T * DM * 2);
constexpr size_t WS_OBUF = WS_HBUF + al((size_t)T * FF * 2);
constexpr size_t WS_PX = WS_OBUF + al((size_t)T * DM * 2);
constexpr size_t WS_MOD = WS_PX + al((size_t)T * PXW * 4);
constexpr size_t WS_HP = WS_MOD + al((size_t)NL * 2 * NMOD * 4);
constexpr size_t WS_SS = WS_HP + MiB;
constexpr size_t WS_SD = WS_SS + al((size_t)NHA * T * 192 * 4);
constexpr size_t WS_WLR = WS_SD + al((size_t)NHA * 2 * T * 192 * 4);
constexpr size_t WS_G = WS_WLR + al((size_t)NL * A_W * 448 * 2);
constexpr size_t WS_Y = WS_G + al((size_t)T * A_W * 4);
constexpr size_t WS_QA = WS_Y + al((size_t)2 * T * A_W * 4);
constexpr size_t WS_KVA = WS_QA + al((size_t)T * 1024 * 2);
constexpr size_t WS_KPE = WS_KVA + al((size_t)T * 512 * 2);
constexpr size_t WS_QRAW = WS_KPE + al((size_t)T * 64 * 2);
constexpr size_t WS_KVRAW = WS_QRAW + al((size_t)T * NQ * 2);
constexpr size_t WS_QF = WS_KVRAW + al((size_t)T * NKV * 2);
constexpr size_t WS_KF = WS_QF + al((size_t)T * NQ * 2);
constexpr size_t WS_H3 = WS_KF + al((size_t)T * NQ * 2);
constexpr size_t WS_HSCR = WS_H3 + al((size_t)NL * T * 64 * 4);
constexpr size_t WS_FR = WS_HSCR + al((size_t)640 * 16384 * 8 + 640 * 8);
constexpr size_t WS_GT = WS_FR + al((size_t)40 * 528 * (14 * 1024));
constexpr size_t WS_X0T = WS_GT + al((size_t)1280 * T * 4);
constexpr size_t WS_SLAB = WS_FR;
constexpr size_t WS_WB = WS_X0T + al((size_t)1280 * T * 4);
constexpr size_t W_G1 = 0, W_D1 = W_G1 + (size_t)2 * FF * DM, W_IN = W_D1 + (size_t)DM * FF, W_OUT = W_IN + (size_t)PXW * DM, W_G2 = W_OUT + (size_t)DM * DM,
                 W_D2 = W_G2 + (size_t)2 * FF * DM, W_Q = W_D2 + (size_t)DM * FF, W_KV = W_Q + (size_t)NQ * 1024, W_LAYER = W_KV + (size_t)NKV * 512;
constexpr size_t WS_END = WS_WB + al(W_LAYER * NL * 2);
constexpr int CW_BAR = 4096;
constexpr int CW_QUEUE = 8192;

constexpr int LDS_MISC = 143360, LDS_BYTES = 147456;

__device__ __forceinline__ float wave_sum(float v) {
#pragma unroll
    for (int o = 1; o < 64; o <<= 1) v += __shfl_xor(v, o);
    return v;
}
typedef __bf16 bf16x2_t __attribute__((ext_vector_type(2)));
__device__ __forceinline__ unsigned cvt_pk_bf16(float lo, float hi) { const f32x2 v = {lo, hi}; return __builtin_bit_cast(unsigned, __builtin_convertvector(v, bf16x2_t)); }
__device__ __forceinline__ float bf2f(unsigned short b) { return __uint_as_float(((unsigned)b) << 16); }
__device__ __forceinline__ f32x4 bf4f(u32x2 w) { return (f32x4){__uint_as_float(w.x << 16), __uint_as_float(w.x & 0xffff0000u), __uint_as_float(w.y << 16), __uint_as_float(w.y & 0xffff0000u)}; }
__device__ __forceinline__ float sigmoidf_(float x) { return 1.0f / (1.0f + __expf(-x)); }
__device__ __forceinline__ float siluf_(float x) { return x / (1.0f + __expf(-x)); }
__device__ __forceinline__ bool has_left(int tau) { return tau != 0 && tau != NCTX; }
__device__ __forceinline__ bool has_right(int tau) { return tau != NCTX - 1 && tau != T - 1; }

struct Args { const float* in[46]; float* out; unsigned char* ws; int ph_lo, ph_hi; };
struct Frame { LAS unsigned char* lds; volatile LAS unsigned* MISC; int tid, lane, wave, bid, G; };
constexpr int LDS_PTAB = LDS_MISC + 2048;
__device__ __forceinline__ const float* inp(const Frame& F, int i) {
    const volatile LAS unsigned* p = (const volatile LAS unsigned*)(F.lds + LDS_PTAB) + 2 * i;
    const unsigned lo = __builtin_amdgcn_readfirstlane(p[0]), hi = __builtin_amdgcn_readfirstlane(p[1]);
    return (const float*)(((unsigned long long)hi << 32) | lo);
}
#define IN_(i) inp(F, (i))
__device__ __forceinline__ Frame opq(const Frame& F) { Frame G = F; asm volatile("" : "+v"(G.tid), "+s"(G.wave), "+s"(G.bid)); G.lane = G.tid & 63; return G; }
__device__ __forceinline__ unsigned char* opq_ptr(unsigned char* p) { asm volatile("" : "+s"(p)); return p; }
#ifndef MK_REP
#define MK_REP 0
#endif
#ifndef MK_ONLYRP
#define MK_ONLYRP 0
#endif
#define REP(x) (1 + (((MK_REP) >> (x)) & 1))
#define XB_TMO      128
#define XB_XCNT(j)  (256  + 64 * (j))
#define XB_XSUB(j)  (1280 + 64 * (j))
#define XB_XGEN(j)  (2304 + 64 * (j))
#define XB_TOP      3328
#define XB_TOPGEN   3392
#define XCD_BAR_WORDS 3456
#define XB_SPIN_CAP (1u << 18)

__device__ __forceinline__ unsigned xb_ld(unsigned* p)              { return __hip_atomic_load(p, __ATOMIC_RELAXED, __HIP_MEMORY_SCOPE_AGENT); }
__device__ __forceinline__ unsigned xb_add(unsigned* p, unsigned v) { return __hip_atomic_fetch_add(p, v, __ATOMIC_RELAXED, __HIP_MEMORY_SCOPE_AGENT); }
__device__ __forceinline__ unsigned xb_xcc_id() { return (unsigned)__builtin_amdgcn_s_getreg((3 << 11) | 20) & 0xFu; }
#define XB_SPIN(cond, bar) do { unsigned _sp = 0; while (cond) { __builtin_amdgcn_s_sleep(1); \
    if ((++_sp & 255u) == 0u) { if (xb_ld(&(bar)[XB_TMO])) break; if (_sp > XB_SPIN_CAP) { atomicAdd(&(bar)[XB_TMO], 1u); break; } } } } while (0)

struct XcdBarrier {
    unsigned* bar; unsigned x;
    volatile LAS unsigned* st;
};

__device__ __forceinline__ XcdBarrier xcd_barrier_post(unsigned* bar, volatile LAS unsigned* st) {
    XcdBarrier b; b.bar = bar; b.x = xb_xcc_id(); b.st = st;
    if (threadIdx.x == 0) (void)xb_add(&bar[XB_XCNT(b.x)], 1u);
    return b;
}
__device__ __forceinline__ void xcd_barrier_complete(unsigned* bar, unsigned x, unsigned& nloc, unsigned& nx) {
    const unsigned G = gridDim.x * gridDim.y * gridDim.z;
    unsigned sum, cnt, mine, sp = 0u;
    for (;;) {
        sum = 0u; cnt = 0u; mine = 0u;
#pragma unroll
        for (unsigned j = 0; j < 16; ++j) { const unsigned c = xb_ld(&bar[XB_XCNT(j)]); sum += c; cnt += (c > 0u) ? 1u : 0u; mine = (j == x) ? c : mine; }
        if (sum == G) break;
        __builtin_amdgcn_s_sleep(1);
        if ((++sp & 255u) == 0u) { if (xb_ld(&bar[XB_TMO])) break; if (sp > XB_SPIN_CAP) { atomicAdd(&bar[XB_TMO], 1u); break; } }
    }
    nloc = mine > 0u ? mine : 1u; nx = cnt > 0u ? cnt : 1u;
}

__device__ __forceinline__ void xcd_barrier(const XcdBarrier& b) {
    asm volatile("s_waitcnt vmcnt(0)" ::: "memory");
    __syncthreads();
    if (threadIdx.x == 0) {
        unsigned* bar = b.bar;
        __builtin_amdgcn_s_waitcnt(0);
        unsigned nloc = b.st[0], nx = b.st[1];
        if (nloc == 0u) { xcd_barrier_complete(bar, b.x, nloc, nx); b.st[0] = nloc; b.st[1] = nx; }
        const unsigned old = xb_add(&bar[XB_XSUB(b.x)], 1u);
        const unsigned gen = old / nloc;
        if (old + 1u == (gen + 1u) * nloc) {
            __builtin_amdgcn_fence(__ATOMIC_RELEASE, "agent");
            asm volatile("s_waitcnt vmcnt(0)" ::: "memory");
            const unsigned og = xb_add(&bar[XB_TOP], 1u);
            const unsigned tg = og / nx;
            if (og + 1u == (tg + 1u) * nx) xb_add(&bar[XB_TOPGEN], 1u);
            else XB_SPIN(xb_ld(&bar[XB_TOPGEN]) == tg, bar);
            __builtin_amdgcn_fence(__ATOMIC_ACQUIRE, "agent");
            xb_add(&bar[XB_XGEN(b.x)], 1u);
            asm volatile("s_waitcnt vmcnt(0)" ::: "memory");
        } else {
            XB_SPIN(xb_ld(&bar[XB_XGEN(b.x)]) == gen, bar);
            __builtin_amdgcn_fence(__ATOMIC_ACQUIRE, "agent");
            asm volatile("s_waitcnt vmcnt(0)" ::: "memory");
        }
    }
    __syncthreads();
}
namespace pg8 {
#define PG8_LAS __attribute__((address_space(3)))
typedef unsigned short bf16_t;
typedef short bf16x8 __attribute__((ext_vector_type(8)));
typedef float f32x4 __attribute__((ext_vector_type(4)));
typedef unsigned u32x4 __attribute__((ext_vector_type(4)));
constexpr int BM = 256, BK = 64, HALF = 128, HTB = HALF * BK * 2  , STAGE_BYTES = 8 * HTB, NXCD = 8, WGM = 4;

__host__ __device__ __forceinline__ int lds_byte(int r, int c) { const int st = (r >> 4) * 2 + (c >> 5), rr = r & 15, cc = c & 31, ob = rr * 64 + cc * 2; return st * 1024 + (ob ^ (((ob >> 9) & 1) << 5)); }
__host__ __device__ __forceinline__ void stage_rc(int b, int& R, int& C) { const int st = b / 1024, sb = b % 1024, swz = sb ^ (((sb >> 9) & 1) << 5); R = (st >> 1) * 16 + swz / 64; C = (st & 1) * 32 + (swz % 64) / 2; }
__host__ __device__ __forceinline__ int perm32(int rho) { const int n = rho >> 4, i = rho & 15; return 8 * (i >> 2) + 4 * n + (i & 3); }

struct Unit { int pm, pn; };
struct Gemm { const bf16_t* A; const bf16_t* Bt; int M, N, K, ld; };

struct StaticOrder {
    int nM, nN, nwg, G, c;
    __host__ __device__ void init(int M, int N, int G_, int c_) { nM = M / BM; nN = N / BM; nwg = nM * nN; G = G_; c = c_; }
    __host__ __device__ bool next(int i, Unit& u) const {
        const long L = (long)i * G + c; if (L >= nwg) return false;
        int wgid = (int)L; { const int q = nwg / NXCD, r = nwg % NXCD, xcd = wgid % NXCD, off = wgid / NXCD; wgid = (xcd < r ? xcd * (q + 1) : r * (q + 1) + (xcd - r) * q) + off; }
        const int nig = WGM * nN, gid = wgid / nig, fm = gid * WGM, gsz = (nM - fm) < WGM ? (nM - fm) : WGM;
        u.pm = fm + ((wgid % nig) % gsz); u.pn = (wgid % nig) / gsz; return true;
    }
    __device__ __forceinline__ void a_ready(const Unit&) const {}
    __device__ __forceinline__ void done(const Unit&) const {}
};
struct CountedOrder : StaticOrder {
    const unsigned* ready; unsigned need; unsigned* tmo;
    __device__ __forceinline__ void a_ready(const Unit& u) const {
        if (threadIdx.x < 64) {
            const unsigned long long t0 = __builtin_amdgcn_s_memrealtime(); unsigned polls = 0;
            while ((unsigned)__builtin_amdgcn_readfirstlane(__hip_atomic_load(ready + 64 * u.pm, __ATOMIC_RELAXED, __HIP_MEMORY_SCOPE_AGENT)) < need) {
                if ((++polls & 255u) == 0u && __builtin_amdgcn_readfirstlane(__hip_atomic_load(tmo, __ATOMIC_RELAXED, __HIP_MEMORY_SCOPE_AGENT)) != 0u) break;
                if (__builtin_amdgcn_s_memrealtime() - t0 > 2000000ull) {
                    if (threadIdx.x == 0) { unsigned expect = 0u; __hip_atomic_compare_exchange_strong(tmo + 1, &expect, 0x600u | (unsigned)(u.pm & 0xff), __ATOMIC_RELAXED, __ATOMIC_RELAXED, __HIP_MEMORY_SCOPE_AGENT); __hip_atomic_store(tmo, 1u, __ATOMIC_RELAXED, __HIP_MEMORY_SCOPE_AGENT); }
                    break; }
                __builtin_amdgcn_s_sleep(2); }
            __builtin_amdgcn_fence(__ATOMIC_ACQUIRE, "agent");
            asm volatile("s_waitcnt vmcnt(0)" ::: "memory");
        }
#if !defined(BROKEN_HOOK_NO_BARRIER)
        asm volatile("" ::: "memory"); __builtin_amdgcn_s_barrier(); asm volatile("" ::: "memory");
#endif
    }
};

__device__ __forceinline__ unsigned cvt_pk_bf16(float lo, float hi) { unsigned r; asm volatile("v_cvt_pk_bf16_f32 %0, %1, %2" : "=v"(r) : "v"(lo), "v"(hi)); return r; }
typedef float f32x2 __attribute__((ext_vector_type(2)));
__device__ __forceinline__ f32x2 gelu_pk(f32x2 v) {
    const f32x2 av = __builtin_elementwise_abs(v), d = av * 0.2316418882f + 1.0f;
    f32x2 t; t.x = __builtin_amdgcn_rcpf(d.x); t.y = __builtin_amdgcn_rcpf(d.y);
    f32x2 q = t * 0.5307027145f + (-0.7265760135f); q = q * t + 0.7107068705f; q = q * t + (-0.142248368f); q = q * t + 0.127414796f; q = q * t;
    const f32x2 s = (v * v) * (-0.72134752044f);
    f32x2 e; e.x = __builtin_amdgcn_exp2f(s.x); e.y = __builtin_amdgcn_exp2f(s.y);
    const f32x2 m = v * (q * e), r = v - m;
    f32x2 o; o.x = v.x < 0.f ? m.x : r.x; o.y = v.y < 0.f ? m.y : r.y; return o;
}

struct EpiF32 {
    static constexpr bool PERM = false, AFTER_DRAIN = false;
    float* C; int ldc; const float* bias;
    __device__ __forceinline__ void operator()(const f32x4 (&acc)[2][2][4][2], const Unit& u, int wr, int wc, int fr, int fq) const {
        const int row0 = u.pm * BM + wr * 64 + fr, col0 = u.pn * BM + wc * 32 + 4 * fq;
        f32x4 bv[2][2];
#pragma unroll
        for (int bj = 0; bj < 2; ++bj)
#pragma unroll
            for (int n = 0; n < 2; ++n) bv[bj][n] = bias ? *(const f32x4*)(bias + col0 + bj * HALF + n * 16) : (f32x4){0.f, 0.f, 0.f, 0.f};
#pragma unroll
        for (int ai = 0; ai < 2; ++ai)
#pragma unroll
            for (int m = 0; m < 4; ++m) { float* rowp = C + (size_t)(row0 + ai * HALF + m * 16) * ldc + col0;
#pragma unroll
                for (int bj = 0; bj < 2; ++bj)
#pragma unroll
                    for (int n = 0; n < 2; ++n) *(f32x4*)(rowp + bj * HALF + n * 16) = acc[ai][bj][m][n] + bv[bj][n]; }
    }
};
template <int ACT  > struct EpiBf16 {
    static constexpr bool PERM = true, AFTER_DRAIN = false;
    bf16_t* O; int ldc; const float* bias; int split_cols; size_t split_stride;
    __device__ __forceinline__ void operator()(const f32x4 (&acc)[2][2][4][2], const Unit& u, int wr, int wc, int fr, int fq) const {
        const int row0 = u.pm * BM + wr * 64 + fr; int colt = u.pn * BM; bf16_t* base = O;
        if (split_cols) { const int t = colt / split_cols; base += (size_t)t * split_stride; colt -= t * split_cols; }
        const int col0 = colt + wc * 32 + 8 * fq, bcol0 = u.pn * BM + wc * 32 + 8 * fq;
        f32x4 bv[2][2];
#pragma unroll
        for (int bj = 0; bj < 2; ++bj)
#pragma unroll
            for (int n = 0; n < 2; ++n) bv[bj][n] = bias ? *(const f32x4*)(bias + bcol0 + bj * HALF + 4 * n) : (f32x4){0.f, 0.f, 0.f, 0.f};
#pragma unroll
        for (int ai = 0; ai < 2; ++ai)
#pragma unroll
            for (int m = 0; m < 4; ++m) { bf16_t* rowp = base + (size_t)(row0 + ai * HALF + m * 16) * ldc + col0;
#pragma unroll
                for (int bj = 0; bj < 2; ++bj) { f32x4 v0 = acc[ai][bj][m][0] + bv[bj][0], v1 = acc[ai][bj][m][1] + bv[bj][1];
                    if (ACT == 1) { f32x2 a = gelu_pk((f32x2){v0[0], v0[1]}), b = gelu_pk((f32x2){v0[2], v0[3]}), c = gelu_pk((f32x2){v1[0], v1[1]}), d = gelu_pk((f32x2){v1[2], v1[3]});
                        v0 = (f32x4){a.x, a.y, b.x, b.y}; v1 = (f32x4){c.x, c.y, d.x, d.y}; }
                    if (ACT == 2) {
#pragma unroll
                        for (int j = 0; j < 4; ++j) { v0[j] = 0.5f * v0[j] * (1.0f + erff(v0[j] * 0.70710678f)); v1[j] = 0.5f * v1[j] * (1.0f + erff(v1[j] * 0.70710678f)); } }
                    u32x4 w; w.x = cvt_pk_bf16(v0[0], v0[1]); w.y = cvt_pk_bf16(v0[2], v0[3]); w.z = cvt_pk_bf16(v1[0], v1[1]); w.w = cvt_pk_bf16(v1[2], v1[3]);
                    *(u32x4*)(rowp + bj * HALF) = w; } }
    }
};
}
namespace pg8 {
struct EpiSwiGLU {
    static constexpr bool PERM = true, AFTER_DRAIN = false;
    bf16_t* O; int ldc;
    __device__ __forceinline__ void operator()(const f32x4 (&acc)[2][2][4][2], const Unit& u, int wr, int wc, int fr, int fq) const {
        const int row0 = u.pm * BM + wr * 64 + fr, col0 = u.pn * HALF + wc * 32 + 8 * fq;
#pragma unroll
        for (int ai = 0; ai < 2; ++ai)
#pragma unroll
            for (int m = 0; m < 4; ++m) { bf16_t* rowp = O + (size_t)(row0 + ai * HALF + m * 16) * ldc + col0;
                float h[8];
#pragma unroll
                for (int n = 0; n < 2; ++n)
#pragma unroll
                    for (int j = 0; j < 4; ++j) { const float g = acc[ai][0][m][n][j], up = acc[ai][1][m][n][j]; h[n * 4 + j] = g * __builtin_amdgcn_rcpf(1.0f + __builtin_amdgcn_exp2f(-1.4426950408889634f * g)) * up; }
                u32x4 w; w.x = cvt_pk_bf16(h[0], h[1]); w.y = cvt_pk_bf16(h[2], h[3]); w.z = cvt_pk_bf16(h[4], h[5]); w.w = cvt_pk_bf16(h[6], h[7]);
                *(u32x4*)rowp = w; }
    }
};
struct EpiResid {
    static constexpr bool PERM = false, AFTER_DRAIN = false;
    float* X; const float* gate_x; const float* gate_c; float fac; float* out_x;
    __device__ __forceinline__ void operator()(const f32x4 (&acc)[2][2][4][2], const Unit& u, int wr, int wc, int fr, int fq) const {
        const int row0 = u.pm * BM + wr * 64 + fr, col0 = u.pn * BM + wc * 32 + 4 * fq;
        const float* gv = (u.pm == 0) ? gate_c : gate_x;
        float* dst = (u.pm != 0 && out_x) ? out_x - (size_t)256 * 4096 : X;
        f32x4 gg[2][2];
#pragma unroll
        for (int bj = 0; bj < 2; ++bj)
#pragma unroll
            for (int n = 0; n < 2; ++n) gg[bj][n] = *(const f32x4*)(gv + col0 + bj * HALF + n * 16) * fac;
#pragma unroll
        for (int ai = 0; ai < 2; ++ai)
#pragma unroll
            for (int m = 0; m < 4; ++m) { const size_t off = (size_t)(row0 + ai * HALF + m * 16) * 4096 + col0;
#pragma unroll
                for (int bj = 0; bj < 2; ++bj)
#pragma unroll
                    for (int n = 0; n < 2; ++n) { const f32x4 b = *(const f32x4*)(X + off + bj * HALF + n * 16); *(f32x4*)(dst + off + bj * HALF + n * 16) = b + gg[bj][n] * acc[ai][bj][m][n]; } }
    }
};
struct OneUnit { int pn;
    __host__ __device__ bool next(int i, Unit& u) const { u.pm = 0; u.pn = pn; return i == 0; }
    __device__ __forceinline__ void a_ready(const Unit&) const {}
    __device__ __forceinline__ void done(const Unit&) const {}
};
struct StaticOrderX { StaticOrder b;
    __host__ __device__ void init(int M, int N, int G_, int c_) { b.init(M - BM, N, G_, c_); }
    __host__ __device__ bool next(int i, Unit& u) const { const bool ok = b.next(i, u); u.pm += 1; return ok; }
    __device__ __forceinline__ void a_ready(const Unit&) const {}
    __device__ __forceinline__ void done(const Unit&) const {}
};
}
namespace pg8 {
template <class Epi, class Sched, bool STAMP = false>
__device__ __forceinline__ void gemm_phase(PG8_LAS unsigned char* lds, const Gemm g, const Sched& S, const Epi& E, unsigned long long* stamps) {
    int tid_ = threadIdx.x; asm volatile("" : "+v"(tid_));
    const int tid = tid_, wid = __builtin_amdgcn_readfirstlane(tid >> 6), lane = tid & 63, wr = wid >> 2, wc = wid & 3, fr = lane & 15, fq = lane >> 4;
    const int K = g.ld, nt = g.K / BK;
    int ts_lo = 0, ts_hi = 0, nts = 0; const unsigned long long rt_entry = STAMP ? (unsigned long long)wall_clock64() : 0ull;
#define PG8_STAMP() do { if (STAMP && wid == 0 && nts < 64) { const unsigned long long _c = (unsigned long long)clock64(); \
        ts_lo = (lane == nts) ? (int)(unsigned)_c : ts_lo; ts_hi = (lane == nts) ? (int)(unsigned)(_c >> 32) : ts_hi; ++nts; } } while (0)
    PG8_STAMP();
    unsigned voffA[2], voffB[2];
#pragma unroll
    for (int i = 0; i < 2; ++i) { int R, C; stage_rc(tid * 16 + i * 8192, R, C); const int Rb = Epi::PERM ? ((R & ~31) + perm32(R & 31)) : R;
        voffA[i] = (unsigned)(R * K + C) * 2u; voffB[i] = (unsigned)(Rb * K + C) * 2u; }
    const size_t kstep = (size_t)(BK * 2);
    const size_t hstep = (size_t)HALF * K * 2;
    const size_t tstep = 2 * hstep;
    const unsigned ldsw = (unsigned)wid * 1024u;
    const int aoff = lds_byte(wr * 64 + fr, fq * 8), boff = lds_byte(wc * 32 + fr, fq * 8);
#define PG8_SA(b, h) (((b) * 2 + (h)) * HTB)
#define PG8_SB(b, h) ((4 + (b) * 2 + (h)) * HTB)
#define PG8_STAGE(bufoff, gbase, voff) do { _Pragma("unroll") for (int _i = 0; _i < 2; ++_i) \
        __builtin_amdgcn_global_load_lds((const unsigned*)((const char*)(gbase) + (voff)[_i]), (PG8_LAS unsigned*)(lds + (bufoff) + ldsw + _i * 8192), 16, 0, 0); } while (0)
#define PG8_LDA(dst, b, h) do { _Pragma("unroll") for (int m = 0; m < 4; ++m) _Pragma("unroll") for (int k = 0; k < 2; ++k) dst[m][k] = *(const PG8_LAS bf16x8*)(lds + PG8_SA(b, h) + aoff + m * 2048 + k * 1024); } while (0)
#define PG8_LDB(dst, b, h) do { _Pragma("unroll") for (int n = 0; n < 2; ++n) _Pragma("unroll") for (int k = 0; k < 2; ++k) dst[n][k] = *(const PG8_LAS bf16x8*)(lds + PG8_SB(b, h) + boff + n * 2048 + k * 1024); } while (0)
#define PG8_MMA(ai, bj, At, Bt) do { __builtin_amdgcn_s_setprio(1); _Pragma("unroll") for (int m = 0; m < 4; ++m) _Pragma("unroll") for (int n = 0; n < 2; ++n) _Pragma("unroll") for (int k = 0; k < 2; ++k) \
        acc[ai][bj][m][n] = __builtin_amdgcn_mfma_f32_16x16x32_bf16(Bt[n][k], At[m][k], acc[ai][bj][m][n], 0, 0, 0); __builtin_amdgcn_s_setprio(0); } while (0)
#define PG8_WAIT_V(n) asm volatile("s_waitcnt vmcnt(" #n ")" ::: "memory")
#define PG8_WAIT_L(n) asm volatile("s_waitcnt lgkmcnt(" #n ")" ::: "memory")
#define PG8_BAR __builtin_amdgcn_s_barrier()
#define PG8_SCHED __builtin_amdgcn_sched_barrier(0)
    Unit cur, nxt; int ui = 0;
    if (!S.next(0, cur)) return;
    f32x4 acc[2][2][4][2];
#pragma unroll
    for (int a = 0; a < 2; ++a)
#pragma unroll
        for (int b = 0; b < 2; ++b)
#pragma unroll
            for (int m = 0; m < 4; ++m)
#pragma unroll
                for (int n = 0; n < 2; ++n) acc[a][b][m][n] = (f32x4){0.f, 0.f, 0.f, 0.f};
    bf16x8 At[4][2], B0[2][2], B1[2][2];
    const char* cA = (const char*)g.A + (size_t)cur.pm * tstep; const char* cB = (const char*)g.Bt + (size_t)cur.pn * tstep;
    S.a_ready(cur);
    PG8_STAGE(PG8_SB(0, 0), cB, voffB); PG8_STAGE(PG8_SA(0, 0), cA, voffA); PG8_STAGE(PG8_SB(0, 1), cB + hstep, voffB); PG8_STAGE(PG8_SA(0, 1), cA + hstep, voffA);
    if (wr == 1) PG8_BAR;
    PG8_WAIT_V(4); PG8_BAR;
    PG8_STAGE(PG8_SB(1, 0), cB + kstep, voffB); PG8_STAGE(PG8_SA(1, 0), cA + kstep, voffA); PG8_STAGE(PG8_SB(1, 1), cB + hstep + kstep, voffB);
    PG8_WAIT_V(6); PG8_BAR;
    PG8_STAMP();
    for (;;) {
        const bool has_next = S.next(ui + 1, nxt);
        const char* nA = has_next ? (const char*)g.A + (size_t)nxt.pm * tstep : cA; const char* nB = has_next ? (const char*)g.Bt + (size_t)nxt.pn * tstep : cB;
        for (int t = 0; t < nt; t += 2) {
            const bool last = (t == nt - 2);
            const char* a1 = cA + (size_t)(t + 1) * kstep;
            const char* a2 = last ? nA : cA + (size_t)(t + 2) * kstep; const char* b2 = last ? nB : cB + (size_t)(t + 2) * kstep;
            const char* a3 = a2 + kstep; const char* b3 = b2 + kstep;
            if (last && has_next) S.a_ready(nxt);
            PG8_LDB(B0, 0, 0); PG8_SCHED; PG8_LDA(At, 0, 0); PG8_STAGE(PG8_SA(1, 1), a1 + hstep, voffA);
            PG8_WAIT_L(8); PG8_BAR; PG8_WAIT_L(0); PG8_MMA(0, 0, At, B0); PG8_BAR; PG8_SCHED;
            PG8_LDB(B1, 0, 1); PG8_STAGE(PG8_SB(0, 0), b2, voffB);
            PG8_BAR; PG8_WAIT_L(0); PG8_MMA(0, 1, At, B1); PG8_BAR;
            PG8_LDA(At, 0, 1); PG8_STAGE(PG8_SA(0, 0), a2, voffA);
            PG8_BAR; PG8_WAIT_L(0); PG8_MMA(1, 0, At, B0); PG8_BAR; PG8_SCHED;
            PG8_STAGE(PG8_SB(0, 1), b2 + hstep, voffB);
            PG8_WAIT_V(6); PG8_BAR; PG8_MMA(1, 1, At, B1); PG8_BAR;
            PG8_LDB(B0, 1, 0); PG8_SCHED; PG8_LDA(At, 1, 0); PG8_STAGE(PG8_SA(0, 1), a2 + hstep, voffA);
            PG8_WAIT_L(8); PG8_BAR; PG8_WAIT_L(0); PG8_MMA(0, 0, At, B0); PG8_BAR; PG8_SCHED;
            PG8_LDB(B1, 1, 1); PG8_STAGE(PG8_SB(1, 0), b3, voffB);
            PG8_BAR; PG8_WAIT_L(0); PG8_MMA(0, 1, At, B1); PG8_BAR;
            PG8_LDA(At, 1, 1); PG8_STAGE(PG8_SA(1, 0), a3, voffA);
            PG8_BAR; PG8_WAIT_L(0); PG8_MMA(1, 0, At, B0); PG8_BAR; PG8_SCHED;
            PG8_STAGE(PG8_SB(1, 1), b3 + hstep, voffB);
            PG8_WAIT_V(6); PG8_BAR; PG8_MMA(1, 1, At, B1); PG8_BAR;
        }
        PG8_STAMP();
        if constexpr (!Epi::AFTER_DRAIN) { E(acc, cur, wr, wc, fr, fq); S.done(cur); }
        PG8_STAMP();
        if (!has_next) break;
#pragma unroll
        for (int a = 0; a < 2; ++a)
#pragma unroll
            for (int b = 0; b < 2; ++b)
#pragma unroll
                for (int m = 0; m < 4; ++m)
#pragma unroll
                    for (int n = 0; n < 2; ++n) acc[a][b][m][n] = (f32x4){0.f, 0.f, 0.f, 0.f};
        cur = nxt; cA = nA; cB = nB; ++ui;
    }
    PG8_WAIT_V(0);
    if (wr == 0) PG8_BAR;
    PG8_BAR;
    if constexpr (Epi::AFTER_DRAIN) { E.fused(acc, cur, wr, wc, fr, fq, lds, wid, lane); S.done(cur); }
    PG8_STAMP();
    if (STAMP && wid == 0) { stamps[lane] = lane < nts ? (((unsigned long long)(unsigned)ts_hi << 32) | (unsigned)ts_lo) : 0ull;
        if (lane == 62) stamps[62] = rt_entry; if (lane == 63) stamps[63] = (unsigned long long)wall_clock64(); }
#undef PG8_STAMP
#undef PG8_SA
#undef PG8_SB
#undef PG8_STAGE
#undef PG8_LDA
#undef PG8_LDB
#undef PG8_MMA
#undef PG8_WAIT_V
#undef PG8_WAIT_L
#undef PG8_BAR
#undef PG8_SCHED
}
}
#define LDS_WAIT() asm volatile("s_waitcnt lgkmcnt(0)" ::: "memory")

__device__ __forceinline__ int map_row(int n, int mode) {
    if (mode == 1) { const int j = n < FF ? n : n - FF; return (j >> 7) * 256 + (n < FF ? 0 : 128) + (j & 127); }
    return n;
}
__device__ __forceinline__ void transpose_item(const float* __restrict__ W, int K, int N, bf16_t* WT, int mode, LAS float* scr, int item, int lane) {
    const int nblk = N / 32, kb = item / nblk, nb = item % nblk, k0 = 64 * kb, n0 = 32 * nb;
#pragma unroll 8
    for (int i = 0; i < 32; ++i) { const int kk = 2 * i + (lane >> 5); scr[kk * 33 + (lane & 31)] = W[(size_t)(k0 + kk) * N + n0 + (lane & 31)]; }
    LDS_WAIT(); asm volatile("" ::: "memory");
    const int c = lane & 7;
#pragma unroll
    for (int j = 0; j < 4; ++j) { const int n = (lane >> 3) + 8 * j; const LAS float* s = scr + (8 * c) * 33 + n;
        u32x4 o; o.x = cvt_pk_bf16(s[0 * 33], s[1 * 33]); o.y = cvt_pk_bf16(s[2 * 33], s[3 * 33]); o.z = cvt_pk_bf16(s[4 * 33], s[5 * 33]); o.w = cvt_pk_bf16(s[6 * 33], s[7 * 33]);
        *(u32x4*)(WT + (size_t)map_row(n0 + n, mode) * K + k0 + 8 * c) = o; }
    LDS_WAIT(); asm volatile("" ::: "memory");
}
constexpr int I_G = (DM / 64) * (2 * FF / 32), I_D = (FF / 64) * (DM / 32), I_IN = (DM / 64) * (9600 / 32), I_OUT = (DM / 64) * (DM / 32), I_Q = (1024 / 64) * (NQ / 32), I_KV = (512 / 64) * (NKV / 32);
constexpr int I_LAYER = 2 * I_G + 2 * I_D + I_IN + I_OUT + I_Q + I_KV;

__device__ __forceinline__ void phase0(const Frame& F, unsigned char* ws) {
    const int gw = F.bid * 8 + F.wave, NGW = F.G * 8;
    const size_t gt = (size_t)F.bid * 512 + F.tid, NGT = (size_t)F.G * 512;
    LAS float* scr = (LAS float*)(F.lds + F.wave * 8704);
    bf16_t* WB = (bf16_t*)(ws + WS_WB);
    for (int it = gw; it < NL * I_LAYER; it += NGW) {
        const int l = it / I_LAYER; int r = it - l * I_LAYER; bf16_t* wl = WB + (size_t)l * W_LAYER;
        if (r < I_G) { transpose_item(IN_(10) + (size_t)l * DM * 2 * FF, DM, 2 * FF, wl + W_G1, 1, scr, r, F.lane); continue; } r -= I_G;
        if (r < I_D) { transpose_item(IN_(11) + (size_t)l * FF * DM, FF, DM, wl + W_D1, 0, scr, r, F.lane); continue; } r -= I_D;
        if (r < I_G) { transpose_item(IN_(12) + (size_t)l * DM * 2 * FF, DM, 2 * FF, wl + W_G2, 1, scr, r, F.lane); continue; } r -= I_G;
        if (r < I_D) { transpose_item(IN_(13) + (size_t)l * FF * DM, FF, DM, wl + W_D2, 0, scr, r, F.lane); continue; } r -= I_D;
        if (r < I_IN) { transpose_item(IN_(14) + (size_t)l * DM * 9600, DM, 9600, wl + W_IN, 0, scr, r, F.lane); continue; } r -= I_IN;
        if (r < I_OUT) { transpose_item(IN_(15) + (size_t)l * DM * DM, DM, DM, wl + W_OUT, 0, scr, r, F.lane); continue; } r -= I_OUT;
        if (r < I_Q) { transpose_item(IN_(39) + (size_t)l * 1024 * NQ, 1024, NQ, wl + W_Q, 0, scr, r, F.lane); continue; } r -= I_Q;
        transpose_item(IN_(41) + (size_t)l * 512 * NKV, 512, NKV, wl + W_KV, 0, scr, r, F.lane);
    }
    for (size_t i = gt; i < (size_t)NL * 128 * 512; i += NGT) {
        const int l = (int)(i / (128 * 512)), rr = (int)((i / 512) % 128), c = (int)(i % 512);
        const int row = 9600 + rr;
        *(u32x4*)(WB + (size_t)l * W_LAYER + W_IN + (size_t)row * DM + c * 8) = (u32x4){0u, 0u, 0u, 0u};
    }
    { bf16_t* WLR = (bf16_t*)(ws + WS_WLR); const float* wu = IN_(18); const float* au = IN_(20); const float* gu = IN_(21);
      for (size_t i = gt; i < (size_t)NL * 448 * A_W; i += NGT) { const int l = (int)(i / (448 * A_W)), k = (int)((i / A_W) % 448), col = (int)(i % A_W);
          float v;
          if (k < 128) v = wu[(((size_t)l * 2 + (k >> 6)) * 64 + (k & 63)) * A_W + col];
          else if (k < 256) v = au[(((size_t)l * 2 + ((k - 128) >> 6)) * 64 + (k & 63)) * A_W + col];
          else v = gu[((size_t)l * 192 + (k - 256)) * A_W + col];
          WLR[((size_t)l * A_W + col) * 448 + k] = (bf16_t)(cvt_pk_bf16(v, v) & 0xffffu); } }
    { f32x4* xs = (f32x4*)(ws + WS_XS); const f32x4* cx = (const f32x4*)IN_(2); const f32x4* xx = (const f32x4*)IN_(0);
      for (size_t i = gt; i < (size_t)T * DM / 4; i += NGT) xs[i] = i < (size_t)NCTX * DM / 4 ? cx[i] : xx[i - (size_t)NCTX * DM / 4]; }
    { float* HP = (float*)(ws + WS_HP);
      for (int it = F.bid; it < NL * 16; it += F.G) { const int l = it >> 4, ch = it & 15, w = F.tid >> 8, j = F.tid & 255;
          const float* cv = w ? IN_(3) : IN_(1); const float* ad = IN_(4) + ((size_t)l * DM + ch * 256) * 256 + j; float s = 0.f;
          for (int i = 0; i < 256; ++i) s += siluf_(cv[ch * 256 + i]) * ad[(size_t)i * 256];
          HP[((l * 16 + ch) * 2 + w) * 256 + j] = s; } }
    { float* H3 = (float*)(ws + WS_H3);
      LAS float* zb = (LAS float*)(F.lds + 73728); LAS float* ha = zb + 8 * 36; LAS float* hb = ha + 8 * 64;
      for (int it = F.bid; it < NL * (T / 8); it += F.G) { const int l = it / (T / 8), pb = it % (T / 8);
          if (F.tid < 8 * 33) { const int p = F.tid / 33, i = F.tid % 33, P = pb * 8 + p; const int L = P < NCTX ? NCTX : SEQ, t = P < NCTX ? P : P - NCTX;
              float z;
              if (i == 0) z = (float)t / (float)(L - 1);
              else { const int b = (i - 1) & 15; const float fb = 1e-4f + (float)b * ((15.0f - 1e-4f) / 15.0f); const float rev2 = 2.0f * fb * (float)t / (float)L;
                  z = i <= 16 ? cospif(rev2) : -sinpif(rev2); }
              zb[p * 36 + i] = z; }
          __syncthreads();
          const int p = F.tid >> 6, j = F.tid & 63; const float fq = IN_(36)[l * 64 + j];
          { const float* w1 = IN_(29) + (size_t)l * 33 * 64 + j; float s = IN_(30)[l * 64 + j];
            for (int i = 0; i < 33; ++i) s += zb[p * 36 + i] * w1[i * 64];
            ha[p * 64 + j] = sinf(fq * s); }
          __syncthreads();
          { const float* w2 = IN_(31) + (size_t)l * 64 * 64 + j; float s = IN_(32)[l * 64 + j];
            for (int i = 0; i < 64; ++i) s += ha[p * 64 + i] * w2[i * 64];
            hb[p * 64 + j] = sinf(fq * s); }
          __syncthreads();
          { const float* w3 = IN_(33) + (size_t)l * 64 * 64 + j; float s = IN_(34)[l * 64 + j];
            for (int i = 0; i < 64; ++i) s += hb[p * 64 + i] * w3[i * 64];
            ((bf16_t*)H3)[((size_t)l * 64 + j) * T + pb * 8 + p] = (bf16_t)(cvt_pk_bf16(sinf(fq * s), 0.f) & 0xffffu); }
          __syncthreads(); } }
}
__device__ __forceinline__ void phase_mod(const Frame& F, unsigned char* ws) {
    const float* HP = (const float*)(ws + WS_HP); float* MOD = (float*)(ws + WS_MOD);
    LAS float* hs = (LAS float*)F.lds;
    for (int it = F.bid; it < NL * (NMOD / 512); it += F.G) { const int l = it / (NMOD / 512), nb = it % (NMOD / 512);
        { const int w = F.tid >> 8, j = F.tid & 255; float s = 0.f;
          for (int ch = 0; ch < 16; ++ch) s += HP[((l * 16 + ch) * 2 + w) * 256 + j];
          hs[w * 256 + j] = s; }
        __syncthreads();
        const int n = nb * 512 + F.tid; const float* au = IN_(5) + (size_t)l * 256 * NMOD + n; float s0 = IN_(6)[(size_t)l * NMOD + n], s1 = s0;
        for (int j = 0; j < 256; ++j) { const float u = au[(size_t)j * NMOD]; s0 += hs[j] * u; s1 += hs[256 + j] * u; }
        MOD[((size_t)l * 2 + 0) * NMOD + n] = s0; MOD[((size_t)l * 2 + 1) * NMOD + n] = s1;
        __syncthreads(); }
}
__device__ __forceinline__ void norm_phase(const Frame& F, float* XS, const float* __restrict__ gain, const float* modx, const float* modc, int ish, int isc, bf16_t* out, const float* slab, const float* sgate, float sfac) {
    const int gw = F.bid * 8 + F.wave, NGW = F.G * 8;
    int row_lo = 0;
    if (slab) { row_lo = NCTX;
        LAS float* red = (LAS float*)F.lds;
        for (int row = F.bid; row < NCTX; row += F.G) { const size_t o = (size_t)row * DM + F.wave * 512;
            f32x4 v[2]; float s = 0.f;
#pragma unroll
            for (int j = 0; j < 2; ++j) { f32x4 acc = (f32x4){0.f, 0.f, 0.f, 0.f};
#pragma unroll
                for (int ks = 0; ks < 16; ++ks) acc += ((const f32x4*)(slab + (size_t)ks * NCTX * DM + o) + F.lane)[64 * j];
                v[j] = ((const f32x4*)(XS + o) + F.lane)[64 * j] + acc * ((const f32x4*)(sgate + F.wave * 512) + F.lane)[64 * j] * sfac;
                ((f32x4*)(XS + o) + F.lane)[64 * j] = v[j]; s += (v[j].x * v[j].x + v[j].y * v[j].y) + (v[j].z * v[j].z + v[j].w * v[j].w); }
            s = wave_sum(s); if (F.lane == 0) red[F.wave] = s;
            __syncthreads();
            float tot = 0.f;
#pragma unroll
            for (int w = 0; w < 8; ++w) tot += red[w];
            const float rstd = rsqrtf(tot * (1.0f / DM) + NORM_EPS);
#pragma unroll
            for (int j = 0; j < 2; ++j) { const int c4 = F.wave * 128 + F.lane + 64 * j;
                const f32x4 y = v[j] * rstd * ((const f32x4*)gain)[c4] * (((const f32x4*)(modc + (size_t)isc * DM))[c4] + 1.0f) + ((const f32x4*)(modc + (size_t)ish * DM))[c4];
                u32x2 w2; w2.x = cvt_pk_bf16(y.x, y.y); w2.y = cvt_pk_bf16(y.z, y.w); ((u32x2*)(out + (size_t)row * DM))[c4] = w2; }
            __syncthreads(); } }
    for (int row = row_lo + gw; row < T; row += NGW) {
        const float* mod = row < NCTX ? modc : modx;
        const f32x4* xr = (const f32x4*)(XS + (size_t)row * DM) + F.lane; const f32x4* g4 = (const f32x4*)gain + F.lane;
        const f32x4* sh4 = (const f32x4*)(mod + (size_t)ish * DM) + F.lane; const f32x4* sc4 = (const f32x4*)(mod + (size_t)isc * DM) + F.lane;
        f32x4 v[16]; float s = 0.f;
#pragma unroll
        for (int j = 0; j < 16; ++j) { v[j] = xr[64 * j]; s += (v[j].x * v[j].x + v[j].y * v[j].y) + (v[j].z * v[j].z + v[j].w * v[j].w); }
        const float rstd = rsqrtf(wave_sum(s) * (1.0f / DM) + NORM_EPS);
        u32x2* o = (u32x2*)(out + (size_t)row * DM) + F.lane;
#pragma unroll
        for (int j = 0; j < 16; ++j) { const f32x4 y = v[j] * rstd * g4[64 * j] * (sc4[64 * j] + 1.0f) + sh4[64 * j];
            u32x2 w; w.x = cvt_pk_bf16(y.x, y.y); w.y = cvt_pk_bf16(y.z, y.w); o[64 * j] = w; }
    }
}
__device__ __forceinline__ float conv3_at(const bf16_t* PX, int tau, int col, float w0, float w1, float w2) {
    const bf16_t* p = PX + (size_t)tau * PXW + col;
    const bool hl = has_left(tau), hr = has_right(tau);
    return bf2f(p[0]) * w1 + bf2f(p[hl ? -PXW : 0]) * (hl ? w0 : 0.f) + bf2f(p[hr ? PXW : 0]) * (hr ? w2 : 0.f);
}
__device__ __forceinline__ float rope_apply(float val, int tau, int j) {
    const int pos = tau - NCTX, prow = pos >> 6, pcol = pos & 63;
    const float inv = __powf(10000.0f, -(float)(j & 15) * (1.0f / 16.0f));
    const float ang = (float)(j < 32 ? prow : pcol) * inv;
    float sn, cs; sincosf(ang, &sn, &cs);
    const float partner = __shfl_xor(val, 16);
    const float rot = (j & 16) ? partner : -partner;
    return val * cs + rot * sn;
}
__device__ __forceinline__ void mla_prep_phase(const Frame& F, unsigned char* ws, int l) {
    const bf16_t* PX = (const bf16_t*)(ws + WS_PX); bf16_t* QA = (bf16_t*)(ws + WS_QA); bf16_t* KVA = (bf16_t*)(ws + WS_KVA); bf16_t* KPE = (bf16_t*)(ws + WS_KPE);
    const int gw = F.bid * 8 + F.wave, NGW = F.G * 8;
    const f32x4* gq = (const f32x4*)(IN_(38) + l * 1024) + F.lane; const f32x4* gkv = (const f32x4*)(IN_(40) + l * 512) + F.lane; const float gpe = IN_(45)[l * 64 + F.lane];
    for (int tau = gw; tau < T; tau += NGW) {
        const u32x2* p = (const u32x2*)(PX + (size_t)tau * PXW + PXC) + F.lane;
        f32x4 q[4], kv[2]; float sq = 0.f, skv = 0.f;
#pragma unroll
        for (int j = 0; j < 4; ++j) { q[j] = bf4f(p[64 * j]); sq += (q[j].x * q[j].x + q[j].y * q[j].y) + (q[j].z * q[j].z + q[j].w * q[j].w); }
#pragma unroll
        for (int j = 0; j < 2; ++j) { kv[j] = bf4f(p[256 + 64 * j]); skv += (kv[j].x * kv[j].x + kv[j].y * kv[j].y) + (kv[j].z * kv[j].z + kv[j].w * kv[j].w); }
        const float pe = bf2f(PX[(size_t)tau * PXW + PXC + 1536 + F.lane]);
        const float rq = rsqrtf(wave_sum(sq) * (1.0f / 1024.0f) + NORM_EPS), rkv = rsqrtf(wave_sum(skv) * (1.0f / 512.0f) + NORM_EPS), rpe = rsqrtf(wave_sum(pe * pe) * (1.0f / 64.0f) + NORM_EPS);
        u32x2* oq = (u32x2*)(QA + (size_t)tau * 1024) + F.lane; u32x2* okv = (u32x2*)(KVA + (size_t)tau * 512) + F.lane;
#pragma unroll
        for (int j = 0; j < 4; ++j) { const f32x4 y = q[j] * rq * gq[64 * j]; u32x2 w; w.x = cvt_pk_bf16(y.x, y.y); w.y = cvt_pk_bf16(y.z, y.w); oq[64 * j] = w; }
#pragma unroll
        for (int j = 0; j < 2; ++j) { const f32x4 y = kv[j] * rkv * gkv[64 * j]; u32x2 w; w.x = cvt_pk_bf16(y.x, y.y); w.y = cvt_pk_bf16(y.z, y.w); okv[64 * j] = w; }
        float kp = pe * rpe * gpe;
        if (tau >= NCTX) kp = rope_apply(kp, tau, F.lane);
        KPE[(size_t)tau * 64 + F.lane] = (bf16_t)(cvt_pk_bf16(kp, kp) & 0xffffu);
    }
}
__device__ __forceinline__ void qkv_final_phase(const Frame& F, unsigned char* ws, int l, bool need_ctx) {
    const bf16_t* QRAW = (const bf16_t*)(ws + WS_QRAW); const bf16_t* KVRAW = (const bf16_t*)(ws + WS_KVRAW); const bf16_t* KPE = (const bf16_t*)(ws + WS_KPE);
    bf16_t* QF = (bf16_t*)(ws + WS_QF); bf16_t* KF = (bf16_t*)(ws + WS_KF);
    const int gw = F.bid * 8 + F.wave, NGW = F.G * 8, ln = F.lane;
    const float gqn0 = IN_(42)[l * 128 + 2 * ln], gqn1 = IN_(42)[l * 128 + 2 * ln + 1], gqp = IN_(43)[l * 64 + ln];
    const float gkn0 = IN_(44)[l * 128 + 2 * ln], gkn1 = IN_(44)[l * 128 + 2 * ln + 1];
    (void)need_ctx;
    for (int tau = gw; tau < T; tau += NGW) {
        float cs = 1.f, sn = 0.f;
        if (tau >= NCTX) { const int pos = tau - NCTX, prow = pos >> 6, pcol = pos & 63; const float inv = __powf(10000.0f, -(float)(ln & 15) * (1.0f / 16.0f)); sincosf((float)(ln < 32 ? prow : pcol) * inv, &sn, &cs); }
        const bf16_t kpe = KPE[(size_t)tau * 64 + ln];
        const bf16_t* qrow = QRAW + (size_t)tau * NQ; const bf16_t* krow = KVRAW + (size_t)tau * NKV;
        unsigned qn[NHC], kn[NHC]; bf16_t qpv[NHC];
#pragma unroll
        for (int h = 0; h < NHC; ++h) { qn[h] = *(const unsigned*)(qrow + h * 192 + 2 * ln); qpv[h] = qrow[h * 192 + 128 + ln]; kn[h] = *(const unsigned*)(krow + h * 256 + 2 * ln); }
#pragma unroll
        for (int h = 0; h < NHC; ++h) {
            const float q0 = bf2f((unsigned short)(qn[h] & 0xffffu)), q1 = bf2f((unsigned short)(qn[h] >> 16)), qp = bf2f(qpv[h]), k0 = bf2f((unsigned short)(kn[h] & 0xffffu)), k1 = bf2f((unsigned short)(kn[h] >> 16));
            const float rqn = rsqrtf(wave_sum(q0 * q0 + q1 * q1) * (1.0f / 128.0f) + NORM_EPS), rqp = rsqrtf(wave_sum(qp * qp) * (1.0f / 64.0f) + NORM_EPS), rkn = rsqrtf(wave_sum(k0 * k0 + k1 * k1) * (1.0f / 128.0f) + NORM_EPS);
            float qpe = qp * rqp * gqp;
            { const float partner = __shfl_xor(qpe, 16); const float rot = (ln & 16) ? partner : -partner; qpe = qpe * cs + rot * sn; }
            *(unsigned*)(QF + (size_t)tau * NQ + h * 192 + 2 * ln) = cvt_pk_bf16(q0 * rqn * gqn0, q1 * rqn * gqn1);
            QF[(size_t)tau * NQ + h * 192 + 128 + ln] = (bf16_t)(cvt_pk_bf16(qpe, qpe) & 0xffffu);
            *(unsigned*)(KF + (size_t)tau * NQ + h * 192 + 2 * ln) = cvt_pk_bf16(k0 * rkn * gkn0, k1 * rkn * gkn1);
            KF[(size_t)tau * NQ + h * 192 + 128 + ln] = kpe; }
    }
}
__device__ __forceinline__ void rwkv_out_phase(const Frame& F, unsigned char* ws, int l, bool need_ctx) {
    const float* SS = (const float*)(ws + WS_SS); const float* SD = (const float*)(ws + WS_SD); const float* GB = (const float*)(ws + WS_G); const float* Y = (const float*)(ws + WS_Y);
    bf16_t* OB = (bf16_t*)(ws + WS_OBUF);
    const int gw = F.bid * 8 + F.wave, NGW = F.G * 8, ln = F.lane;
    for (int it = (need_ctx ? 0 : NCTX * 5) + gw; it < T * 5; it += NGW) { const int tau = it / 5, h0 = (it % 5) * 4;
        float y0[4], y1[4], r[4], v[4], ka[4], kb[4], g[4];
#pragma unroll
        for (int q = 0; q < 4; ++q) { const int h = h0 + q, col = h * 64 + ln; const size_t o = (size_t)tau * A_W + col;
            y0[q] = Y[o]; y1[q] = Y[(size_t)T * A_W + o]; r[q] = SS[o]; v[q] = SS[(size_t)T * A_W + o];
            ka[q] = SD[o]; kb[q] = SD[(size_t)T * A_W + o]; g[q] = GB[o]; }
#pragma unroll
        for (int q = 0; q < 4; ++q) { const int col = (h0 + q) * 64 + ln;
            const float y = y0[q] + y1[q];
            const float mu = wave_sum(y) * (1.0f / 64.0f); const float dy = y - mu; const float var = wave_sum(dy * dy) * (1.0f / 64.0f);
            const float yn = dy * rsqrtf(var + GN_EPS) * IN_(25)[l * A_W + col] + IN_(26)[l * A_W + col];
            const float bonus = wave_sum(r[q] * (0.5f * (ka[q] + kb[q])) * IN_(24)[l * A_W + col]) * v[q];
            const float ov = (yn + bonus) * g[q];
            OB[(size_t)tau * DM + col] = (bf16_t)(cvt_pk_bf16(ov, ov) & 0xffffu); }
    }
}
__device__ __forceinline__ void hyena_prep_phase(const Frame& F, unsigned char* ws, int l) {
    const bf16_t* PX = (const bf16_t*)(ws + WS_PX); float* GT = (float*)(ws + WS_GT); float* X0T = (float*)(ws + WS_X0T);
    LAS float* LGt = (LAS float*)F.lds; LAS float* LX0 = LGt + 64 * 65;
    const float* cw = IN_(27) + (size_t)l * 3 * B_IN; const float* cb = IN_(28) + (size_t)l * B_IN;
    for (int it = F.bid; it < (T / 64) * 20; it += F.G) { const int tt = it / 20, ct = it % 20;
        { const int t = F.tid >> 3, c0 = ct * 64 + (F.tid & 7) * 8, tau = tt * 64 + t;
          f32x4 u[3][2];
#pragma unroll
          for (int grp = 0; grp < 3; ++grp)
#pragma unroll
              for (int q = 0; q < 2; ++q) { const int c = grp * 1280 + c0 + 4 * q; const bf16_t* p = PX + (size_t)tau * PXW + PXB + c;
                  const bool hl = has_left(tau), hr = has_right(tau);
                  const f32x4 y = bf4f(*(const u32x2*)p) * *(const f32x4*)(cw + B_IN + c) + *(const f32x4*)(cb + c) + bf4f(*(const u32x2*)(p - (hl ? PXW : 0))) * (*(const f32x4*)(cw + c) * (hl ? 1.f : 0.f))
                                + bf4f(*(const u32x2*)(p + (hr ? PXW : 0))) * (*(const f32x4*)(cw + 2 * B_IN + c) * (hr ? 1.f : 0.f));
                  u[grp][q] = y; }
#pragma unroll
          for (int q = 0; q < 2; ++q)
#pragma unroll
              for (int e = 0; e < 4; ++e) { const int ch = (F.tid & 7) * 8 + 4 * q + e; LGt[ch * 65 + t] = u[1][q][e] * u[2][q][e]; LX0[ch * 65 + t] = u[0][q][e]; } }
        __syncthreads();
        { const int ch = F.tid >> 3, t0 = (F.tid & 7) * 8; const size_t o = (size_t)(ct * 64 + ch) * T + tt * 64 + t0;
          f32x4 a0, a1, b0, b1;
#pragma unroll
          for (int e = 0; e < 4; ++e) { a0[e] = LGt[ch * 65 + t0 + e]; a1[e] = LGt[ch * 65 + t0 + 4 + e]; b0[e] = LX0[ch * 65 + t0 + e]; b1[e] = LX0[ch * 65 + t0 + 4 + e]; }
          *(f32x4*)(GT + o) = a0; *(f32x4*)(GT + o + 4) = a1; *(f32x4*)(X0T + o) = b0; *(f32x4*)(X0T + o + 4) = b1; }
        __syncthreads(); }
}
__device__ __forceinline__ void hyena_out_phase(const Frame& F, unsigned char* ws, bool need_ctx) {
    const float* YT = (const float*)(ws + WS_GT); bf16_t* OB = (bf16_t*)(ws + WS_OBUF);
    LAS float* L = (LAS float*)F.lds;
    const int it0 = need_ctx ? 0 : (NCTX / 64) * 20;
    for (int it = it0 + F.bid; it < (T / 64) * 20; it += F.G) { const int tt = it / 20, ct = it % 20;
        { const int ch = F.tid >> 3, t0 = (F.tid & 7) * 8; const size_t o = (size_t)(ct * 64 + ch) * T + tt * 64 + t0;
          const f32x4 a0 = *(const f32x4*)(YT + o), a1 = *(const f32x4*)(YT + o + 4);
#pragma unroll
          for (int e = 0; e < 4; ++e) { L[ch * 65 + t0 + e] = a0[e]; L[ch * 65 + t0 + 4 + e] = a1[e]; } }
        __syncthreads();
        { const int t = F.tid >> 3, c0 = (F.tid & 7) * 8; float x[8];
#pragma unroll
          for (int e = 0; e < 8; ++e) x[e] = L[(c0 + e) * 65 + t];
          u32x4 w; w.x = cvt_pk_bf16(x[0], x[1]); w.y = cvt_pk_bf16(x[2], x[3]); w.z = cvt_pk_bf16(x[4], x[5]); w.w = cvt_pk_bf16(x[6], x[7]);
          *(u32x4*)(OB + (size_t)(tt * 64 + t) * DM + 1280 + ct * 64 + c0) = w; }
        __syncthreads(); }
}
namespace att {
constexpr int DK = 192, DV = 128, NW = 8, QBLK = 32, KVBLK = 64;
constexpr float SCALE = 0.07216878364870322f;
constexpr float THR = 8.f;
#ifndef ATT_SDEPTH
#define ATT_SDEPTH 2
#endif
constexpr int SDEPTH = ATT_SDEPTH;
constexpr int LDQ = 2304, LDK = 2304, LDV = 3072, LDO = 4096;
constexpr int SHM_V = KVBLK * DV * 2, SHM_K = KVBLK * DK * 2, SHM_ATTN = 2 * SHM_V + 2 * SHM_K + NW * 64 * 4 + NW * 4096;
using bf16x8 = __attribute__((ext_vector_type(8))) short;
using s16x4  = __attribute__((ext_vector_type(4))) short;
using f32x16 = __attribute__((ext_vector_type(16))) float;
using u32x4  = __attribute__((ext_vector_type(4))) unsigned;
#define KSWZ(row, colB) ((row) * 384 + ((colB) ^ (((row) & 7) << 4)))
#define SBAR() __builtin_amdgcn_sched_barrier(0)
__device__ __forceinline__ int crow(int r, int hi) { return (r & 3) + 8 * (r >> 2) + 4 * hi; }
__device__ __forceinline__ unsigned cvtpk(float lo, float hi) { unsigned r; asm volatile("v_cvt_pk_bf16_f32 %0, %1, %2" : "=v"(r) : "v"(lo), "v"(hi)); return r; }
__device__ __forceinline__ void partialSM(f32x16& p0, f32x16& p1, float& m_reg, float& mn, float& alpha) {
  constexpr float C = SCALE * 1.4426950408889634f;
  float pmax = p0[0]; for (int r = 1; r < 16; ++r) pmax = fmaxf(pmax, p0[r]); for (int r = 0; r < 16; ++r) pmax = fmaxf(pmax, p1[r]);
  { auto rr = __builtin_amdgcn_permlane32_swap(__float_as_uint(pmax), __float_as_uint(pmax), false, false);
    pmax = fmaxf(__uint_as_float(rr[0]), __uint_as_float(rr[1])); }
  if (__builtin_expect(__all(pmax - m_reg <= THR / SCALE), 1)) { mn = m_reg; alpha = 1.f; }
  else { mn = fmaxf(m_reg, pmax); alpha = __builtin_amdgcn_exp2f((m_reg - mn) * C); m_reg = mn; }
  float mnC = -mn * C;
  for (int r = 0; r < 16; ++r) p0[r] = fmaf(p0[r], C, mnC); for (int r = 0; r < 16; ++r) p1[r] = fmaf(p1[r], C, mnC);
  for (int r = 0; r < 16; ++r) p0[r] = __builtin_amdgcn_exp2f(p0[r]);
}
__device__ __forceinline__ void finishSM(f32x16& p0, f32x16& p1, float alpha, float& l_reg, bf16x8& pa0, bf16x8& pa1, bf16x8& pa2, bf16x8& pa3) {
  for (int r = 0; r < 16; ++r) p1[r] = __builtin_amdgcn_exp2f(p1[r]);
  float ps = 0; for (int r = 0; r < 16; ++r) ps += p0[r]; for (int r = 0; r < 16; ++r) ps += p1[r];
  { auto rr = __builtin_amdgcn_permlane32_swap(__float_as_uint(ps), __float_as_uint(ps), false, false);
    ps = __uint_as_float(rr[0]) + __uint_as_float(rr[1]); }
  l_reg = l_reg * alpha + ps;
#define PK4(P, BASE, OUT) do { unsigned a0 = cvtpk(P[BASE + 0], P[BASE + 1]), a1 = cvtpk(P[BASE + 2], P[BASE + 3]);   \
    unsigned b0 = cvtpk(P[BASE + 4], P[BASE + 5]), b1 = cvtpk(P[BASE + 6], P[BASE + 7]);                              \
    auto r0 = __builtin_amdgcn_permlane32_swap(a0, b0, false, false); auto r1 = __builtin_amdgcn_permlane32_swap(a1, b1, false, false); \
    u32x4 w = {r0[0], r1[0], r0[1], r1[1]}; OUT = *reinterpret_cast<bf16x8*>(&w); } while (0)
  PK4(p0, 0, pa0); PK4(p0, 8, pa1); PK4(p1, 0, pa2); PK4(p1, 8, pa3);
#undef PK4
}
__device__ __forceinline__ void qkt(f32x16& p0, f32x16& p1, const char* Ks, const bf16x8* qr, const char* qrl, int r32, int hi) {
  p0 = f32x16{}; p1 = f32x16{};
#pragma unroll
  for (int d0 = 0; d0 < 8; ++d0) { int cb = (d0 * 16 + hi * 8) * 2;
    bf16x8 b0 = *reinterpret_cast<const bf16x8*>(Ks + KSWZ(r32, cb));
    bf16x8 b1 = *reinterpret_cast<const bf16x8*>(Ks + KSWZ(32 + r32, cb));
    p0 = __builtin_amdgcn_mfma_f32_32x32x16_bf16(b0, qr[d0], p0, 0, 0, 0);
    p1 = __builtin_amdgcn_mfma_f32_32x32x16_bf16(b1, qr[d0], p1, 0, 0, 0); }
#pragma unroll
  for (int d0 = 8; d0 < 12; ++d0) { int cb = (d0 * 16 + hi * 8) * 2;
    bf16x8 b0 = *reinterpret_cast<const bf16x8*>(Ks + KSWZ(r32, cb));
    bf16x8 b1 = *reinterpret_cast<const bf16x8*>(Ks + KSWZ(32 + r32, cb));
    const bf16x8 q = *reinterpret_cast<const bf16x8*>(qrl + ((((d0 - 8) * 2 + hi) ^ (r32 & 7)) << 4));
    p0 = __builtin_amdgcn_mfma_f32_32x32x16_bf16(b0, q, p0, 0, 0, 0);
    p1 = __builtin_amdgcn_mfma_f32_32x32x16_bf16(b1, q, p1, 0, 0, 0); }
}
__device__ __forceinline__ int v_st(int k, int c) { const int kk = (k & ~0xC) | ((k & 4) << 1) | ((k & 8) >> 1); return ((kk >> 3) * 4 + (c >> 5)) * 512 + ((kk & 7) * 32 + (c & 31)) * 2; }
__device__ __forceinline__ int v_rd_base(int lane) { return ((lane & 3) << 3) | (((lane >> 2) & 3) << 6) | (((lane >> 4) & 1) << 5) | (((lane >> 5) & 1) << 8); }
constexpr int v_rd_off(int d0, int ks, int half) { return d0 * 512 + ks * 4096 + half * 2048; }
template <int OFF> __device__ __forceinline__ s16x4 tr_read(int vb) {
  s16x4 r; asm volatile("ds_read_b64_tr_b16 %0, %1 offset:%2" : "=&v"(r) : "v"(vb), "i"(OFF) : "memory"); return r;
}
template <int D0> __device__ __forceinline__ void pv_one(f32x16& od, int vb, bf16x8 pa0, bf16x8 pa1, bf16x8 pa2, bf16x8 pa3) {
  const s16x4 l0 = tr_read<v_rd_off(D0, 0, 0)>(vb), h0 = tr_read<v_rd_off(D0, 0, 1)>(vb), l1 = tr_read<v_rd_off(D0, 1, 0)>(vb), h1 = tr_read<v_rd_off(D0, 1, 1)>(vb);
  const s16x4 l2 = tr_read<v_rd_off(D0, 2, 0)>(vb), h2 = tr_read<v_rd_off(D0, 2, 1)>(vb), l3 = tr_read<v_rd_off(D0, 3, 0)>(vb), h3 = tr_read<v_rd_off(D0, 3, 1)>(vb);
  asm volatile("s_waitcnt lgkmcnt(0)" ::: "memory"); SBAR();
#define PK(L, H) (bf16x8){L[0], L[1], L[2], L[3], H[0], H[1], H[2], H[3]}
  od = __builtin_amdgcn_mfma_f32_32x32x16_bf16(pa0, PK(l0, h0), od, 0, 0, 0);
  od = __builtin_amdgcn_mfma_f32_32x32x16_bf16(pa1, PK(l1, h1), od, 0, 0, 0);
  od = __builtin_amdgcn_mfma_f32_32x32x16_bf16(pa2, PK(l2, h2), od, 0, 0, 0);
  od = __builtin_amdgcn_mfma_f32_32x32x16_bf16(pa3, PK(l3, h3), od, 0, 0, 0);
#undef PK
}
__device__ __forceinline__ void pv_d0(f32x16* o, int vb, bf16x8 pa0, bf16x8 pa1, bf16x8 pa2, bf16x8 pa3) {
  pv_one<0>(o[0], vb, pa0, pa1, pa2, pa3); pv_one<1>(o[1], vb, pa0, pa1, pa2, pa3); pv_one<2>(o[2], vb, pa0, pa1, pa2, pa3); pv_one<3>(o[3], vb, pa0, pa1, pa2, pa3);
}
__device__ __forceinline__ void attn_body(const bf16_t* __restrict__ Qb, const bf16_t* __restrict__ Kh, const bf16_t* __restrict__ Vh, bf16_t* __restrict__ Ob, int seq, char* lds) {
  int tid_ = threadIdx.x; asm volatile("" : "+v"(tid_));
  const int tid = tid_, wid = tid >> 6, lane = tid & 63, r32 = lane & 31, hi = lane >> 5;
  char* V_lds = lds; char* K_lds = lds + 2 * SHM_V;
  float* ws = (float*)(lds + 2 * SHM_V + 2 * SHM_K) + wid * 64; float* li_l = ws; float* al_l = ws + 32;
  float m_reg = -1e30f, l_reg = 0; f32x16 o[4] = {}; bf16x8 qr[8];
  const bf16_t* Qw = Qb + (long)(wid * QBLK + r32) * LDQ + hi * 8;
  char* qrl = lds + 2 * SHM_V + 2 * SHM_K + NW * 64 * 4 + wid * 4096 + r32 * 128;
#pragma unroll
  for (int d0 = 0; d0 < 8; ++d0) qr[d0] = *reinterpret_cast<const bf16x8*>(Qw + d0 * 16);
#pragma unroll
  for (int d0 = 8; d0 < 12; ++d0) *reinterpret_cast<bf16x8*>(qrl + ((((d0 - 8) * 2 + hi) ^ (r32 & 7)) << 4)) = *reinterpret_cast<const bf16x8*>(Qw + d0 * 16);
  asm volatile("s_waitcnt lgkmcnt(0)" ::: "memory");
  unsigned kgo[3], vgo[2];
#pragma unroll
  for (int i = 0; i < 3; ++i) { const int p = (i * 8 + wid) * 64 + lane, row = p / 24, slot = p % 24, ch = slot ^ (row & 7); kgo[i] = (unsigned)(row * LDK + ch * 8) * 2u; }
#pragma unroll
  for (int i = 0; i < 2; ++i) { const int p = (i * 8 + wid) * 64 + lane, sub = p >> 5, within = p & 31, kk = (sub >> 2) * 8 + (within >> 2), c = (sub & 3) * 32 + (within & 3) * 8;
    const int k = (kk & ~0xC) | ((kk & 4) << 1) | ((kk & 8) >> 1); vgo[i] = (unsigned)(k * LDV + c) * 2u; }
  const int vb0 = (int)(uintptr_t)V_lds + v_rd_base(lane);
  typedef __attribute__((address_space(3))) unsigned lds_u32;
#define DMA_K(b, k0) do { const char* kg = (const char*)Kh + (size_t)(k0) * (LDK * 2); \
    _Pragma("unroll") for (int _i = 0; _i < 3; ++_i) __builtin_amdgcn_global_load_lds((const unsigned*)(kg + kgo[_i]), (lds_u32*)(K_lds + (b) * SHM_K + (_i * 8 + wid) * 1024), 16, 0, 0); } while (0)
#define DMA_V(b, k0) do { const char* vg = (const char*)Vh + (size_t)(k0) * (LDV * 2); \
    _Pragma("unroll") for (int _i = 0; _i < 2; ++_i) __builtin_amdgcn_global_load_lds((const unsigned*)(vg + vgo[_i]), (lds_u32*)(V_lds + (b) * SHM_V + (_i * 8 + wid) * 1024), 16, 0, 0); } while (0)
#define RESC(a) do { if (__any((a) < 1.f)) { if (hi == 0) al_l[r32] = (a); asm volatile("s_waitcnt lgkmcnt(0)" ::: "memory"); \
    for (int d = 0; d < 4; ++d) for (int r = 0; r < 16; ++r) o[d][r] *= al_l[crow(r, hi)]; } } while (0)
#define ENDSTEP() do { asm volatile("s_waitcnt vmcnt(0)" ::: "memory"); __syncthreads(); } while (0)
  f32x16 pA0, pA1, pB0, pB1; float mnA, mnB, alA, alB; bf16x8 pa0, pa1, pa2, pa3; const int NT = seq / KVBLK;
  DMA_K(0, 0); ENDSTEP();
  DMA_K(1, KVBLK); DMA_V(0, 0);
  qkt(pA0, pA1, K_lds, qr, qrl, r32, hi); partialSM(pA0, pA1, m_reg, mnA, alA);
  ENDSTEP();
  for (int j = 1; j + 1 < NT; j += 2) {
    DMA_K(0, (j + 1) * KVBLK); DMA_V(1, j * KVBLK);
    SBAR(); qkt(pB0, pB1, K_lds + SHM_K, qr, qrl, r32, hi);
    finishSM(pA0, pA1, alA, l_reg, pa0, pa1, pa2, pa3); SBAR();
    pv_d0(o, vb0, pa0, pa1, pa2, pa3); partialSM(pB0, pB1, m_reg, mnB, alB);
    RESC(alB); ENDSTEP();
    if (j + 2 < NT) DMA_K(1, (j + 2) * KVBLK);
    DMA_V(0, (j + 1) * KVBLK);
    SBAR(); qkt(pA0, pA1, K_lds, qr, qrl, r32, hi);
    finishSM(pB0, pB1, alB, l_reg, pa0, pa1, pa2, pa3); SBAR();
    pv_d0(o, vb0 + (int)SHM_V, pa0, pa1, pa2, pa3); partialSM(pA0, pA1, m_reg, mnA, alA);
    RESC(alA); ENDSTEP();
  }
  DMA_V(1, (NT - 1) * KVBLK);
  SBAR(); qkt(pB0, pB1, K_lds + SHM_K, qr, qrl, r32, hi);
  finishSM(pA0, pA1, alA, l_reg, pa0, pa1, pa2, pa3); SBAR();
  pv_d0(o, vb0, pa0, pa1, pa2, pa3); partialSM(pB0, pB1, m_reg, mnB, alB);
  RESC(alB); ENDSTEP();
  finishSM(pB0, pB1, alB, l_reg, pa0, pa1, pa2, pa3); SBAR();
  pv_d0(o, vb0 + (int)SHM_V, pa0, pa1, pa2, pa3);
#undef DMA_K
#undef DMA_V
#undef ENDSTEP
  if (hi == 0) li_l[r32] = l_reg; asm volatile("s_waitcnt lgkmcnt(0)" ::: "memory");
  float rli[16];
#pragma unroll
  for (int r = 0; r < 16; ++r) rli[r] = __builtin_amdgcn_rcpf(li_l[crow(r, hi)]);
  bf16_t* Ow = Ob + (long)(wid * QBLK) * LDO;
#pragma unroll
  for (int r = 0; r < 16; ++r) { int orow = crow(r, hi);
#pragma unroll
    for (int d0 = 0; d0 < 4; ++d0) { const float val = o[d0][r] * rli[r]; Ow[(long)orow * LDO + d0 * 32 + r32] = (bf16_t)(cvtpk(val, val) & 0xffff); } }
  __syncthreads();
#undef RESC
}
}
__device__ __forceinline__ f32x2 cmul(f32x2 a, f32x2 b) { return (f32x2){a.x * b.x - a.y * b.y, a.x * b.y + a.y * b.x}; }
__device__ __forceinline__ int rev4_14(int k) { const unsigned r = __brev((unsigned)k) >> 18; return (int)(((r & 0x1555u) << 1) | ((r >> 1) & 0x1555u)); }
#define ZI(i) ((i) + ((i) >> 5))
__device__ __forceinline__ void fft_tw(int j, int q, float sign, f32x2& w1, f32x2& w2, f32x2& w3) {
    const float rev = (float)j / (float)(4 * q); const float sn = __builtin_amdgcn_sinf(rev), cs = __builtin_amdgcn_cosf(rev);
    w1 = (f32x2){cs, sign * sn}; w2 = cmul(w1, w1); w3 = cmul(w2, w1);
}
__device__ __forceinline__ void fft16k_dif(LAS f32x2* Z, int tid) {
#pragma unroll 1
    for (int s = 0; s < 7; ++s) { int lq = 12 - 2 * s; asm volatile("" : "+s"(lq)); const int q = 1 << lq;
        const bool shared = q <= 512; f32x2 w1, w2, w3; fft_tw(tid & (q - 1), q, -1.f, w1, w2, w3);
#pragma unroll 2
        for (int i = 0; i < 8; ++i) { const int b = tid + 512 * i, j = b & (q - 1), base = ((b >> lq) << (lq + 2)) + j;
            const int i0 = ZI(base), i1 = ZI(base + q), i2 = ZI(base + 2 * q), i3 = ZI(base + 3 * q);
            const f32x2 a0 = Z[i0], a1 = Z[i1], a2 = Z[i2], a3 = Z[i3];
            const f32x2 t0 = a0 + a2, t1 = a0 - a2, t2 = a1 + a3, t3 = a1 - a3;
            if (!shared) fft_tw(j, q, -1.f, w1, w2, w3);
            Z[i0] = t0 + t2; Z[i1] = cmul((f32x2){t1.x + t3.y, t1.y - t3.x}, w1); Z[i2] = cmul(t0 - t2, w2); Z[i3] = cmul((f32x2){t1.x - t3.y, t1.y + t3.x}, w3); }
        __syncthreads(); }
}
__device__ __forceinline__ void fft16k_dit_inv(LAS f32x2* Z, int tid) {
#pragma unroll 1
    for (int s = 0; s < 7; ++s) { int lq = 2 * s; asm volatile("" : "+s"(lq)); const int q = 1 << lq;
        const bool shared = q <= 512; f32x2 w1, w2, w3; fft_tw(tid & (q - 1), q, 1.f, w1, w2, w3);
#pragma unroll 2
        for (int i = 0; i < 8; ++i) { const int b = tid + 512 * i, j = b & (q - 1), base = ((b >> lq) << (lq + 2)) + j;
            if (!shared) fft_tw(j, q, 1.f, w1, w2, w3);
            const int i0 = ZI(base), i1 = ZI(base + q), i2 = ZI(base + 2 * q), i3 = ZI(base + 3 * q);
            const f32x2 b0 = Z[i0], b1 = cmul(Z[i1], w1), b2 = cmul(Z[i2], w2), b3 = cmul(Z[i3], w3);
            const f32x2 t0 = b0 + b2, t1 = b0 - b2, t2 = b1 + b3, t3 = b1 - b3;
            Z[i0] = t0 + t2; Z[i1] = (f32x2){t1.x - t3.y, t1.y + t3.x}; Z[i2] = t0 - t2; Z[i3] = (f32x2){t1.x + t3.y, t1.y - t3.x}; }
        __syncthreads(); }
}
constexpr float HY_MIN_DECAY = -3.0701134573253945f, HY_MAX_DECAY = -15.350567286626973f;
__device__ __forceinline__ float hy_delta(int c) { return fabsf(HY_MIN_DECAY + (HY_MAX_DECAY - HY_MIN_DECAY) * ((float)c / 1279.0f)); }
__device__ __forceinline__ float conv3b_at(const bf16_t* PX, int tau, int col, const float* cw, int l, int c) {
    const float* w = cw + (size_t)l * 3 * B_IN;
    return conv3_at(PX, tau, col, w[c], w[B_IN + c], w[2 * B_IN + c]);
}
__device__ __forceinline__ void hyena_taps_unit(const Frame& F, unsigned char* ws, int l, int pair) {
    LAS f32x2* Z = (LAS f32x2*)F.lds; LAS float* red = (LAS float*)(F.lds + LDS_MISC + 128);
    const int tid = F.tid, c0 = 2 * pair;
    const bf16_t* H3x = (const bf16_t*)(ws + WS_H3) + (size_t)l * 64 * T + NCTX;
    f32x2* scr = (f32x2*)(ws + WS_HSCR) + (size_t)pair * 16384; float* htn = (float*)(ws + WS_HSCR + (size_t)640 * 16384 * 8) + 2 * pair;
    LAS f32x4* FW = (LAS f32x4*)(F.lds + LDS_MISC + 256);
    if (tid < 256) { const int j = tid >> 2, q = tid & 3; ((LAS float*)FW)[tid] = IN_(35)[(size_t)l * 64 * 2560 + (size_t)j * 2560 + (q >> 1) * 1280 + c0 + (q & 1)]; }
    __syncthreads();
    const float d0 = hy_delta(c0), d1 = hy_delta(c0 + 1);
#ifndef HYS
#define HYS 31
#endif
    float s0, s1, sc0 = 0.f, sc1 = 0.f;
    {
    s0 = 0.f; s1 = 0.f;
    if (HYS & 1)
#pragma unroll 1
    for (int i = 0; i < 2; ++i) { const int tb = 4096 * i + 8 * tid; const bf16_t* hc = H3x + tb;
        asm volatile("" ::: "memory");
        f32x4 acc[8];
#pragma unroll
        for (int p = 0; p < 8; ++p) acc[p] = (f32x4){0.f, 0.f, 0.f, 0.f};
#pragma unroll 8
        for (int j = 0; j < 64; ++j) { const f32x4 w = FW[j]; const u32x4 hv = *(const u32x4*)(hc + (size_t)j * T);
#pragma unroll
            for (int p = 0; p < 4; ++p) { acc[2 * p] += w * __uint_as_float(hv[p] << 16); acc[2 * p + 1] += w * __uint_as_float(hv[p] & 0xffff0000u); } }
#pragma unroll
        for (int p = 0; p < 8; ++p) { const int t = tb + p;
            const float tl = (float)t * (1.0f / 8191.0f), e0 = __expf(-tl * d0), e1 = __expf(-tl * d1);
            const float f0 = acc[p].x * e0, f1 = acc[p].y * e1, b0 = acc[p].z * e0, b1 = acc[p].w * e1;
            Z[ZI(t)] = (f32x2){f0, f1}; s0 += fabsf(f0); s1 += fabsf(f1);
            if (t < 8191) { Z[ZI(16383 - t)] = (f32x2){b0, b1}; s0 += fabsf(b0); s1 += fabsf(b1); } } }
    if (tid == 0) { float zz = 0.f; asm volatile("" : "+v"(zz)); Z[ZI(8192)] = (f32x2){zz, zz}; }
    s0 = wave_sum(s0); s1 = wave_sum(s1);
    if (F.lane == 0) { red[F.wave * 2] = s0; red[F.wave * 2 + 1] = s1; }
    __syncthreads();
    float n0 = 0.f, n1 = 0.f;
#pragma unroll
    for (int w = 0; w < 8; ++w) { n0 += red[2 * w]; n1 += red[2 * w + 1]; }
    sc0 = 1.0f / (16384.0f * n0); sc1 = 1.0f / (16384.0f * n1);
    if (HYS & 2) fft16k_dif(Z, tid);
#pragma unroll 4
    for (int i = 0; i < 32; ++i) scr[tid + 512 * i] = Z[ZI(tid + 512 * i)];
    __syncthreads();
    }
    if (tid == 0) { htn[0] = sc0; htn[1] = sc1; }
    __syncthreads();
}
__device__ __forceinline__ void hyena_unit(const Frame& F, unsigned char* ws, int l, int pair) {
    LAS f32x2* Z = (LAS f32x2*)F.lds;
    const int tid = F.tid, c0 = 2 * pair;
    float* GT = (float*)(ws + WS_GT); const float* X0T = (const float*)(ws + WS_X0T);
    const f32x2* scr = (const f32x2*)(ws + WS_HSCR) + (size_t)pair * 16384; const float* htn = (const float*)(ws + WS_HSCR + (size_t)640 * 16384 * 8) + 2 * pair;
    const float sc0 = htn[0], sc1 = htn[1];
#ifndef HYS
#define HYS 31
#endif
    for (int rp15 = 0; rp15 < REP(15); ++rp15) {
    const float* g0p = GT + (size_t)c0 * T + NCTX; const float* g1p = g0p + T;
    { float zz = 0.f; asm volatile("" : "+v"(zz));
#pragma unroll 4
      for (int i = 0; i < 16; ++i) { const int t = tid + 512 * i; Z[ZI(t)] = (f32x2){g0p[t], g1p[t]}; Z[ZI(8192 + t)] = (f32x2){zz, zz}; } }
    __syncthreads();
    if (HYS & 2) fft16k_dif(Z, tid);
    if (HYS & 8)
#pragma unroll 2
    for (int i = 0; i < 17; ++i) { const int k = tid + 512 * i; if (i == 16 && tid != 0) break;
        const int pk = rev4_14(k & 16383), pn = rev4_14((16384 - k) & 16383);
        const f32x2 A = Z[ZI(pk)], B = Z[ZI(pn)], At = scr[pk], Bt = scr[pn];
        const f32x2 G0 = (f32x2){0.5f * (A.x + B.x), 0.5f * (A.y - B.y)}, G1 = (f32x2){0.5f * (A.y + B.y), -0.5f * (A.x - B.x)};
        const f32x2 H0 = (f32x2){0.5f * (At.x + Bt.x), 0.5f * (At.y - Bt.y)}, H1 = (f32x2){0.5f * (At.y + Bt.y), -0.5f * (At.x - Bt.x)};
        const f32x2 P0 = cmul(G0, H0), P1 = cmul(G1, H1);
        Z[ZI(pk)] = (f32x2){P0.x - P1.y, P0.y + P1.x};
        if (pn != pk) Z[ZI(pn)] = (f32x2){P0.x + P1.y, P1.x - P0.y}; }
    __syncthreads();
    if (HYS & 2) fft16k_dit_inv(Z, tid);
    }
    const float bb0 = IN_(37)[l * 1280 + c0], bb1 = IN_(37)[l * 1280 + c0 + 1];
    { float* y0p = GT + (size_t)c0 * T + NCTX; float* y1p = y0p + T; const float* x0p = X0T + (size_t)c0 * T + NCTX; const float* x1p = x0p + T;
#pragma unroll 4
      for (int i = 0; i < 16; ++i) { const int t = tid + 512 * i; const f32x2 z = Z[ZI(t)]; const float ga = y0p[t], gb = y1p[t];
          y0p[t] = x0p[t] * (z.x * sc0 + ga * bb0); y1p[t] = x1p[t] * (z.y * sc1 + gb * bb1); } }
    __syncthreads();
}
__device__ __forceinline__ void hyena_ctx_unit(const Frame& F, unsigned char* ws, int l, int unit) {
    LAS float* TF = (LAS float*)F.lds; LAS float* TB = TF + 2048; LAS float* GG = TB + 2048;
    const int tid = F.tid, t = tid >> 1, cc = (tid & 1) * 4, cbase = unit * 8 + cc;
    const bf16_t* H3c = (const bf16_t*)(ws + WS_H3) + (size_t)l * 64 * T; float* GT = (float*)(ws + WS_GT); const float* X0T = (const float*)(ws + WS_X0T);
    { float f[4] = {0.f, 0.f, 0.f, 0.f}, b[4] = {0.f, 0.f, 0.f, 0.f};
      const float* wbase = IN_(35) + (size_t)l * 64 * 2560 + cbase;
      for (int j = 0; j < 64; ++j) { const float hv = bf2f(H3c[(size_t)j * T + t]); const float* wrow = wbase + (size_t)j * 2560;
#pragma unroll
          for (int q = 0; q < 4; ++q) { f[q] += hv * wrow[q]; b[q] += hv * wrow[1280 + q]; } }
      const float tl = (float)t * (1.0f / 255.0f);
#pragma unroll
      for (int q = 0; q < 4; ++q) { const float e = __expf(-tl * hy_delta(cbase + q)); TF[t * 8 + cc + q] = f[q] * e; TB[t * 8 + cc + q] = b[q] * e; GG[t * 8 + cc + q] = GT[(size_t)(cbase + q) * T + t]; } }
    __syncthreads();
    float nrm[4] = {0.f, 0.f, 0.f, 0.f}, y[4] = {0.f, 0.f, 0.f, 0.f};
    for (int s = 0; s < 256; ++s) {
#pragma unroll
        for (int q = 0; q < 4; ++q) { nrm[q] += fabsf(TF[s * 8 + cc + q]) + (s < 255 ? fabsf(TB[s * 8 + cc + q]) : 0.f);
            const int o = t - s; const float tap = o >= 0 ? TF[o * 8 + cc + q] : TB[(-o - 1) * 8 + cc + q];
            y[q] += tap * GG[s * 8 + cc + q]; } }
    __syncthreads();
#pragma unroll
    for (int q = 0; q < 4; ++q) GT[(size_t)(cbase + q) * T + t] = X0T[(size_t)(cbase + q) * T + t] * (y[q] / nrm[q] + GG[t * 8 + cc + q] * IN_(37)[l * 1280 + cbase + q]);
    __syncthreads();
}
constexpr int SC_C = 16, SC_NCHUNK = T / SC_C, SC_CHUNK_BYTES = 14 * 1024;
__device__ __forceinline__ int sc_tau(int d, int c, int t) { return d == 0 ? SC_C * c + t : (c < NCTX / SC_C ? NCTX - 1 - SC_C * c - t : T - 1 - SC_C * (c - NCTX / SC_C) - t); }
__device__ __forceinline__ int sc_perm(int e, int hi) { return (e & 3) + 8 * (e >> 2) + 4 * hi; }
constexpr size_t WS_FR_BYTES = (size_t)2 * NHA * SC_NCHUNK * SC_CHUNK_BYTES;

typedef short sc_bf16x8 __attribute__((ext_vector_type(8)));
typedef float sc_f32x16 __attribute__((ext_vector_type(16)));
__device__ __forceinline__ sc_bf16x8 sc_pack8(const sc_f32x16& a, int base) {
    u32x4 w; w.x = cvt_pk_bf16(a[base + 0], a[base + 1]); w.y = cvt_pk_bf16(a[base + 2], a[base + 3]); w.z = cvt_pk_bf16(a[base + 4], a[base + 5]); w.w = cvt_pk_bf16(a[base + 6], a[base + 7]);
    return *reinterpret_cast<sc_bf16x8*>(&w);
}
constexpr int SC_NSLOT = 9, SC_AHEAD = 7;
__device__ __forceinline__ void scan_chain_mfma(const Frame& F, unsigned char* ws, int chain) {
    const int h = chain >> 1, d = chain & 1, lane = F.lane, n = lane & 31, hi = lane >> 5, ib = F.wave;
    const unsigned char* FRc = ws + WS_FR + (size_t)chain * SC_NCHUNK * SC_CHUNK_BYTES;
    float* Yd = (float*)(ws + WS_Y) + (size_t)d * T * A_W + h * 64;
    LAS unsigned char* buf = F.lds;
    typedef __attribute__((address_space(3))) unsigned sc_lds_u32;
#define SCM_DMA(c_) do { if (ib < 7) { const unsigned char* src_ = FRc + (size_t)(c_) * SC_CHUNK_BYTES; LAS unsigned char* dst_ = buf + ((c_) % SC_NSLOT) * SC_CHUNK_BYTES; \
        _Pragma("unroll") for (int i_ = 0; i_ < 2; ++i_) __builtin_amdgcn_global_load_lds((const unsigned*)(src_ + (i_ * 7 + ib) * 1024 + lane * 16), (sc_lds_u32*)(dst_ + (i_ * 7 + ib) * 1024), 16, 0, 0); } } while (0)
    sc_f32x16 S0 = {}, S1 = {};
    int yoff[8];
#pragma unroll
    for (int r = 0; r < 8; ++r) { const int t = (r & 3) + 8 * (r >> 2) + 4 * hi; yoff[r] = (d ? -t : t) * A_W + 32 * ib + n; }
    __syncthreads();
#pragma unroll
    for (int c = 0; c < SC_AHEAD; ++c) SCM_DMA(c);
    asm volatile("s_waitcnt vmcnt(12)" ::: "memory"); __builtin_amdgcn_s_barrier(); asm volatile("" ::: "memory");
#pragma unroll 1
    for (int c = 0; c < SC_NCHUNK; ++c) {
        const bool steady = c + SC_AHEAD < SC_NCHUNK;
        if (steady) SCM_DMA(c + SC_AHEAD);
        if (ib < 2) {
                const LAS unsigned char* fb = buf + (c % SC_NSLOT) * SC_CHUNK_BYTES;
                sc_bf16x8 fr[11]; sc_bf16x8 vf; f32x4 gt[8];
                { const unsigned fa = (unsigned)(uintptr_t)fb + lane * 16, va = fa + (11 + ib) * 1024, ga = (unsigned)(uintptr_t)fb + 13 * 1024 + hi * 128;
#define SC_DSRD(dst, addr, off) asm volatile("ds_read_b128 %0, %1 offset:%2" : "=v"(dst) : "v"(addr), "i"(off))
                  SC_DSRD(fr[0], fa, 0); SC_DSRD(fr[1], fa, 1024); SC_DSRD(fr[2], fa, 2048); SC_DSRD(fr[3], fa, 3072); SC_DSRD(fr[4], fa, 4096); SC_DSRD(fr[5], fa, 5120);
                  SC_DSRD(fr[6], fa, 6144); SC_DSRD(fr[7], fa, 7168); SC_DSRD(fr[8], fa, 8192); SC_DSRD(fr[9], fa, 9216); SC_DSRD(fr[10], fa, 10240); SC_DSRD(vf, va, 0);
                  SC_DSRD(gt[0], ga, 0); SC_DSRD(gt[1], ga, 16); SC_DSRD(gt[2], ga, 32); SC_DSRD(gt[3], ga, 48); SC_DSRD(gt[4], ga, 64); SC_DSRD(gt[5], ga, 80); SC_DSRD(gt[6], ga, 96); SC_DSRD(gt[7], ga, 112);
#undef SC_DSRD
                  asm volatile("s_waitcnt lgkmcnt(0)" : "+v"(fr[0]), "+v"(fr[1]), "+v"(fr[2]), "+v"(fr[3]), "+v"(fr[4]), "+v"(fr[5]), "+v"(fr[6]), "+v"(fr[7]), "+v"(fr[8]), "+v"(fr[9]), "+v"(fr[10]), "+v"(vf) :: "memory");
                  asm volatile("" : "+v"(gt[0]), "+v"(gt[1]), "+v"(gt[2]), "+v"(gt[3]), "+v"(gt[4]), "+v"(gt[5]), "+v"(gt[6]), "+v"(gt[7])); }
                const sc_bf16x8 sb00 = sc_pack8(S0, 0), sb01 = sc_pack8(S0, 8), sb10 = sc_pack8(S1, 0), sb11 = sc_pack8(S1, 8);
                sc_f32x16 P = {}, P2 = {};
                P = __builtin_amdgcn_mfma_f32_32x32x16_bf16(fr[0], sb00, P, 0, 0, 0);
                P2 = __builtin_amdgcn_mfma_f32_32x32x16_bf16(fr[2], sb10, P2, 0, 0, 0);
                P = __builtin_amdgcn_mfma_f32_32x32x16_bf16(fr[1], sb01, P, 0, 0, 0);
                P2 = __builtin_amdgcn_mfma_f32_32x32x16_bf16(fr[3], sb11, P2, 0, 0, 0);
                P = __builtin_amdgcn_mfma_f32_32x32x16_bf16(fr[4], vf, P, 0, 0, 0);
#pragma unroll
                for (int q = 0; q < 4; ++q)
#pragma unroll
                    for (int e = 0; e < 4; ++e) { S0[4 * q + e] *= gt[q][e]; S1[4 * q + e] *= gt[4 + q][e]; }
                S0 = __builtin_amdgcn_mfma_f32_32x32x16_bf16(fr[8], vf, S0, 0, 0, 0);
                S1 = __builtin_amdgcn_mfma_f32_32x32x16_bf16(fr[10], vf, S1, 0, 0, 0);
#pragma unroll
                for (int r = 0; r < 16; ++r) P[r] += P2[r];
                const sc_bf16x8 xb = sc_pack8(P, 0);
                sc_f32x16 U = {};
                U = __builtin_amdgcn_mfma_f32_32x32x16_bf16(fr[5], xb, U, 0, 0, 0);
                const sc_bf16x8 ub = sc_pack8(U, 0);
                S0 = __builtin_amdgcn_mfma_f32_32x32x16_bf16(fr[7], ub, S0, 0, 0, 0);
                S1 = __builtin_amdgcn_mfma_f32_32x32x16_bf16(fr[9], ub, S1, 0, 0, 0);
                P = __builtin_amdgcn_mfma_f32_32x32x16_bf16(fr[6], ub, P, 0, 0, 0);
                float* yb = Yd + (size_t)sc_tau(d, c, 0) * A_W;
#pragma unroll
                for (int r = 0; r < 8; ++r) yb[yoff[r]] = P[8 + r];
        }
        if (steady) asm volatile("s_waitcnt vmcnt(12)" ::: "memory"); else asm volatile("s_waitcnt vmcnt(0)" ::: "memory");
        asm volatile("s_waitcnt lgkmcnt(0)" ::: "memory"); __builtin_amdgcn_s_barrier(); asm volatile("" ::: "memory");
    }
    asm volatile("s_waitcnt vmcnt(0)" ::: "memory"); __syncthreads();
#undef SCM_DMA
}
__device__ __forceinline__ float conv3_u(const float* PX, int tau, unsigned ucol, float w0, float w1, float w2) {
    const float* p = PX + (size_t)tau * PXW;
    float y = p[ucol] * w1;
    if (has_left(tau)) y += (p - PXW)[ucol] * w0;
    if (has_right(tau)) y += (p + PXW)[ucol] * w2;
    return y;
}
constexpr int WLR_K = 448;
constexpr int RP_WAVE_LDS = 16896;
typedef short rp_bf16x8 __attribute__((ext_vector_type(8)));
typedef float rp_f32x16 __attribute__((ext_vector_type(16)));
__device__ __forceinline__ unsigned short f2bf16(float x) { return (unsigned short)(cvt_pk_bf16(x, x) & 0xffffu); }
template <int NKB, class AF>
__device__ __forceinline__ void rp_lowrank(float (&dst)[16], const AF& afrag, const bf16_t* WLRh, int kw0, int n, int hi) {
    rp_f32x16 c0 = {}, c1 = {}; const bf16_t* wb0 = WLRh + (size_t)n * WLR_K + kw0 + 8 * hi; const bf16_t* wb1 = wb0 + (size_t)32 * WLR_K;
#pragma unroll
    for (int kb = 0; kb < NKB; ++kb) { const rp_bf16x8 b0 = *(const rp_bf16x8*)(wb0 + 16 * kb), b1 = *(const rp_bf16x8*)(wb1 + 16 * kb); const rp_bf16x8 a_ = afrag(kb);
        c0 = __builtin_amdgcn_mfma_f32_32x32x16_bf16(a_, b0, c0, 0, 0, 0); c1 = __builtin_amdgcn_mfma_f32_32x32x16_bf16(a_, b1, c1, 0, 0, 0); }
#pragma unroll
    for (int r = 0; r < 8; ++r) { auto sw = __builtin_amdgcn_permlane32_swap(__float_as_uint(c0[r]), __float_as_uint(c1[r]), false, false);
        dst[(r & 3) + 8 * (r >> 2)] = __uint_as_float(sw[0]); dst[(r & 3) + 8 * (r >> 2) + 4] = __uint_as_float(sw[1]); }
}
struct RpAfLds { const LAS bf16_t* base; __device__ __forceinline__ rp_bf16x8 operator()(int kb) const { return *(const LAS rp_bf16x8*)(base + 16 * kb); } };
__device__ __forceinline__ void rwkv_elem_phase(const Frame& F, unsigned char* ws, int l) {
    const float* PX = (const float*)(ws + WS_PX); float* SS = (float*)(ws + WS_SS); float* SD = (float*)(ws + WS_SD); float* GB = (float*)(ws + WS_G);
    const bf16_t* WLR = (const bf16_t*)(ws + WS_WLR) + (size_t)l * A_W * WLR_K;
    const float* cw = IN_(16) + (size_t)l * 3 * A_IN;
    LAS bf16_t* ACT = (LAS bf16_t*)(F.lds + F.wave * 10752);
    const int lane = F.lane, n = lane & 31, hi = lane >> 5;
    const int gw = F.bid * 8 + F.wave, NGW = F.G * 8;
    for (int it = gw; it < (T / 16) * 10; it += NGW) {
        const int tg = it / 10, hq = it % 10, tau0 = tg * 16;
        asm volatile("s_waitcnt lgkmcnt(0)" ::: "memory");
        const float* prow0 = PX + (size_t)(tau0 > 0 ? tau0 - 1 : 0) * PXW; const int roff = tau0 > 0 ? 0 : -1;
#define RP_WIN(x, ucol_) do { _Pragma("unroll") for (int i_ = 0; i_ < 18; ++i_) { int ri_ = i_ + roff; ri_ = ri_ < 0 ? 0 : ri_; ri_ = (tau0 - 1 + i_ > T - 1) ? (T - 1 - (tau0 > 0 ? tau0 - 1 : 0)) : ri_; x[i_] = (prow0 + (size_t)ri_ * PXW)[ucol_]; } } while (0)
#define RP_CONV(x, t_, w0_, w1_, w2_) (x[(t_)] * (has_left(tau0 + (t_)) ? (w0_) : 0.f) + x[(t_) + 1] * (w1_) + x[(t_) + 2] * (has_right(tau0 + (t_)) ? (w2_) : 0.f))
#pragma unroll
        for (int i = 0; i < 5; ++i) { const int c = lane + 64 * i, col = 3840 + c; const float c0 = cw[col], c1 = cw[A_IN + col], c2 = cw[2 * A_IN + col];
            float x[18]; RP_WIN(x, (unsigned)(PXA + col));
#pragma unroll
            for (int t = 0; t < 16; ++t) { const float val = RP_CONV(x, t, c0, c1, c2);
                const float act = i == 0 ? 1.0f - 2.0f / (1.0f + __expf(2.0f * val)) : (i == 1 ? val : sigmoidf_(val));
                ACT[t * 328 + c] = f2bf16(act); } }
        asm volatile("s_waitcnt lgkmcnt(0)" ::: "memory");
        const RpAfLds afw{ACT + (n & 15) * 328 + 8 * hi}, afa{ACT + (n & 15) * 328 + 64 + 8 * hi}, afg{ACT + (n & 15) * 328 + 128 + 8 * hi};
#pragma unroll 1
        for (int hh = 0; hh < 2; ++hh) {
            const int h = hq * 2 + hh, col = h * 64 + lane; const bf16_t* WLRh = WLR + (size_t)h * 64 * WLR_K;
            { float lg[16]; rp_lowrank<12>(lg, afg, WLRh, 256, n, hi);
#pragma unroll
              for (int t = 0; t < 16; ++t) GB[(size_t)(tau0 + t) * A_W + col] = lg[t]; }
            const float cr0 = cw[col], cr1 = cw[A_IN + col], cr2 = cw[2 * A_IN + col];
            const float ck0 = cw[A_W + col], ck1 = cw[A_IN + A_W + col], ck2 = cw[2 * A_IN + A_W + col];
            const float cv0 = cw[2 * A_W + col], cv1 = cw[A_IN + 2 * A_W + col], cv2 = cw[2 * A_IN + 2 * A_W + col];
            const float kk_w = IN_(22)[l * A_W + col], ka_w = IN_(23)[l * A_W + col];
            float kkv[16], kv[16];
            { float xr[18], xk[18], xv[18]; const unsigned uc = (unsigned)(PXA + col); RP_WIN(xr, uc); RP_WIN(xk, uc + A_W); RP_WIN(xv, uc + 2 * A_W);
#pragma unroll
              for (int t = 0; t < 16; ++t) { const int tau = tau0 + t;
                  const float r = RP_CONV(xr, t, cr0, cr1, cr2), v = RP_CONV(xv, t, cv0, cv1, cv2); kv[t] = RP_CONV(xk, t, ck0, ck1, ck2);
                  const float kr = kv[t] * kk_w; const float nrm = sqrtf(wave_sum(kr * kr)); kkv[t] = kr / fmaxf(nrm, 1e-12f);
                  float* ss = SS + ((size_t)h * T + tau) * 192 + lane; ss[0] = kkv[t]; ss[64] = r; ss[128] = v; } }
#pragma unroll 1
            for (int d = 0; d < 2; ++d) { const float w0b = IN_(17)[(l * 2 + d) * A_W + col], a0b = IN_(19)[(l * 2 + d) * A_W + col]; float lw[16], la[16];
                rp_lowrank<4>(lw, afw, WLRh, 64 * d, n, hi); rp_lowrank<4>(la, afa, WLRh, 128 + 64 * d, n, hi);
#pragma unroll
                for (int t = 0; t < 16; ++t) { const float z = w0b + lw[t]; const float decay = __expf(-__expf(-(fmaxf(-z, 0.f) + __logf(1.0f + __expf(-fabsf(z)))) - 0.5f)); const float av = sigmoidf_(a0b + la[t]);
                    float* sd = SD + (((size_t)h * 2 + d) * T + tau0 + t) * 192 + lane; sd[0] = decay; sd[64] = kkv[t] * av; sd[128] = kv[t] * (1.0f + (av - 1.0f) * ka_w); } }
        }
    }
}
#undef RP_WIN
#undef RP_CONV
constexpr int SP_WAVE_LDS = 16640;
__device__ __forceinline__ void scan_prep_phase(const Frame& F, unsigned char* ws) {
    const float* SS = (const float*)(ws + WS_SS); const float* SD = (const float*)(ws + WS_SD); unsigned char* FR = ws + WS_FR;
    LAS bf16_t* R1 = (LAS bf16_t*)(F.lds + F.wave * SP_WAVE_LDS); LAS bf16_t* R2 = R1 + 32 * 72; LAS bf16_t* BbT = R2 + 32 * 72; LAS bf16_t* KbT = BbT + 64 * 16; LAS bf16_t* VT = KbT + 64 * 16; LAS float* Lm = (LAS float*)(VT + 64 * 16);
    const int lane = F.lane, n = lane & 31, hi = lane >> 5;
    const int gw = F.bid * 8 + F.wave, NGW = F.G * 8;
    for (int it = gw; it < 2 * NHA * SC_NCHUNK; it += NGW) {
        const int chain = it / SC_NCHUNK, c = it % SC_NCHUNK, h = chain >> 1, d = chain & 1;
        const int tau_first = sc_tau(d, c, 0), dstep = d ? -1 : 1;
        const float* ssb = SS + (size_t)h * T * 192 + lane; const float* sdb = SD + ((size_t)h * 2 + d) * T * 192 + lane;
        float xw[16], xb[16], xk[16], xkk[16], xr[16], xv[16];
#pragma unroll
        for (int s = 0; s < 16; ++s) { const size_t o = (size_t)(tau_first + dstep * s) * 192; xw[s] = sdb[o]; xb[s] = sdb[o + 64]; xk[s] = sdb[o + 128]; xkk[s] = ssb[o]; xr[s] = ssb[o + 64]; xv[s] = ssb[o + 128]; }
        float gC = 1.f;
#pragma unroll
        for (int s = 0; s < 16; ++s) gC *= xw[s];
        float g = 1.f;
#pragma unroll
        for (int s = 0; s < 16; ++s) {
            const float gm1 = g; g *= xw[s]; const float ig = 1.0f / g; const float bh = xb[s] * ig, kh = xk[s] * ig;
            R1[s * 72 + lane] = f2bf16(-xkk[s] * gm1); R1[(16 + s) * 72 + lane] = f2bf16(xr[s] * g);
            R2[s * 72 + lane] = f2bf16(bh); R2[(16 + s) * 72 + lane] = f2bf16(kh);
            BbT[lane * 16 + s] = f2bf16(bh * gC); KbT[lane * 16 + s] = f2bf16(kh * gC); VT[lane * 16 + s] = f2bf16(xv[s]); }
        asm volatile("s_waitcnt lgkmcnt(0)" ::: "memory");
        unsigned char* dst = FR + ((size_t)chain * SC_NCHUNK + c) * SC_CHUNK_BYTES;
        rp_f32x16 C = {};
#pragma unroll
        for (int kb = 0; kb < 4; ++kb) { const rp_bf16x8 a_ = *(const LAS rp_bf16x8*)(R2 + n * 72 + 16 * kb + 8 * hi), b_ = *(const LAS rp_bf16x8*)(R1 + n * 72 + 16 * kb + 8 * hi);
            C = __builtin_amdgcn_mfma_f32_32x32x16_bf16(a_, b_, C, 0, 0, 0); }
        const int tt_ = n & 15; const bool incl = n >= 16;
#pragma unroll
        for (int r = 0; r < 16; ++r) { const int s = ((r & 7) & 3) + 8 * ((r & 7) >> 2) + 4 * hi; if (!(s < tt_ || (incl && s == tt_))) C[r] = 0.f; }
        if (n < 16) {
#pragma unroll
            for (int r = 0; r < 8; ++r) Lm[((r & 3) + 8 * (r >> 2) + 4 * hi) * 20 + n] = C[r]; }
        { u32x4 f4; f4.x = cvt_pk_bf16(C[8], C[9]); f4.y = cvt_pk_bf16(C[10], C[11]); f4.z = cvt_pk_bf16(C[12], C[13]); f4.w = cvt_pk_bf16(C[14], C[15]);
          u32x4 f6; f6.x = cvt_pk_bf16(C[0], C[1]); f6.y = cvt_pk_bf16(C[2], C[3]); f6.z = cvt_pk_bf16(C[4], C[5]); f6.w = cvt_pk_bf16(C[6], C[7]);
          if (n < 16) f6 = (u32x4){0u, 0u, 0u, 0u};
          *(u32x4*)(dst + 4 * 1024 + lane * 16) = f4; *(u32x4*)(dst + 6 * 1024 + lane * 16) = f6; }
        asm volatile("s_waitcnt lgkmcnt(0)" ::: "memory");
        { float Tc[16];
#pragma unroll
          for (int s = 15; s >= 0; --s) { float acc = (s == n) ? 1.f : 0.f;
#pragma unroll
              for (int u = s + 1; u < 16; ++u) acc += Lm[s * 20 + u] * Tc[u];
              Tc[s] = acc; }
          u32x4 f5; f5.x = cvt_pk_bf16(hi ? Tc[4] : Tc[0], hi ? Tc[5] : Tc[1]); f5.y = cvt_pk_bf16(hi ? Tc[6] : Tc[2], hi ? Tc[7] : Tc[3]);
          f5.z = cvt_pk_bf16(hi ? Tc[12] : Tc[8], hi ? Tc[13] : Tc[9]); f5.w = cvt_pk_bf16(hi ? Tc[14] : Tc[10], hi ? Tc[15] : Tc[11]);
          if (n >= 16) f5 = (u32x4){0u, 0u, 0u, 0u};
          *(u32x4*)(dst + 5 * 1024 + lane * 16) = f5; }
#pragma unroll
        for (int f = 0; f < 4; ++f) { const u32x2 p0 = *(const LAS u32x2*)(R1 + n * 72 + 16 * f + 4 * hi), p1 = *(const LAS u32x2*)(R1 + n * 72 + 16 * f + 8 + 4 * hi);
            *(u32x4*)(dst + f * 1024 + lane * 16) = (u32x4){p0.x, p0.y, p1.x, p1.y}; }
#pragma unroll
        for (int jb = 0; jb < 2; ++jb) { const int row = 32 * jb + n;
            const u32x2 b0 = *(const LAS u32x2*)(BbT + row * 16 + 4 * hi), b1 = *(const LAS u32x2*)(BbT + row * 16 + 8 + 4 * hi), k0 = *(const LAS u32x2*)(KbT + row * 16 + 4 * hi), k1 = *(const LAS u32x2*)(KbT + row * 16 + 8 + 4 * hi);
            const u32x2 v0 = *(const LAS u32x2*)(VT + row * 16 + 4 * hi), v1 = *(const LAS u32x2*)(VT + row * 16 + 8 + 4 * hi);
            *(u32x4*)(dst + (7 + 2 * jb) * 1024 + lane * 16) = (u32x4){b0.x, b0.y, b1.x, b1.y}; *(u32x4*)(dst + (8 + 2 * jb) * 1024 + lane * 16) = (u32x4){k0.x, k0.y, k1.x, k1.y};
            *(u32x4*)(dst + (11 + jb) * 1024 + lane * 16) = (u32x4){v0.x, v0.y, v1.x, v1.y}; }
        { const int jj = lane & 31; ((float*)(dst + 13 * 1024))[((jj >> 2) & 1) * 32 + (lane >> 5) * 16 + (jj & 3) + 4 * (jj >> 3)] = gC; }
        asm volatile("s_waitcnt lgkmcnt(0)" ::: "memory");
    }
}
constexpr int RF_ACT_BYTES = 16 * 320 * 2;
__device__ __forceinline__ void rwkv_fused_phase(const Frame& F, unsigned char* ws, int l) {
    const bf16_t* PX = (const bf16_t*)(ws + WS_PX); unsigned char* FR = ws + WS_FR;
    float* GB = (float*)(ws + WS_G); float* RB = (float*)(ws + WS_SS); float* VB = RB + (size_t)T * A_W; float* KD = (float*)(ws + WS_SD);
    const bf16_t* WLR = (const bf16_t*)(ws + WS_WLR) + (size_t)l * A_W * WLR_K;
    const float* cw = IN_(16) + (size_t)l * 3 * A_IN;
    LAS bf16_t* ACT = (LAS bf16_t*)F.lds;
    LAS bf16_t* R1 = (LAS bf16_t*)(F.lds + RF_ACT_BYTES + F.wave * SP_WAVE_LDS); LAS bf16_t* R2 = R1 + 32 * 72; LAS bf16_t* BbT = R2 + 32 * 72; LAS bf16_t* KbT = BbT + 64 * 16; LAS bf16_t* VT = KbT + 64 * 16; LAS float* Lm = (LAS float*)(VT + 64 * 16);
    const int lane = F.lane, n = lane & 31, hi = lane >> 5, hh = F.wave >> 1, d = F.wave & 1;
    for (int it = F.bid; it < (T / 16) * 5; it += F.G) {
        const int tg = it / 5, hg = it % 5, tau0 = tg * 16, h = hg * 4 + hh, col = h * 64 + lane;
        __syncthreads();
        for (int e = F.tid; e < 16 * 320; e += 512) { const int t = e / 320, c = e % 320, cc = 3840 + c;
            const float val = conv3_at(PX, tau0 + t, PXA + cc, cw[cc], cw[A_IN + cc], cw[2 * A_IN + cc]);
            const float act = c < 64 ? 1.0f - 2.0f / (1.0f + __expf(2.0f * val)) : (c < 128 ? val : sigmoidf_(val));
            ACT[t * 320 + c] = f2bf16(act); }
        __syncthreads();
        const bf16_t* prow0 = PX + (size_t)(tau0 > 0 ? tau0 - 1 : 0) * PXW; const int roff = tau0 > 0 ? 0 : -1;
#define RP_WIN(x, ucol_) do { _Pragma("unroll") for (int i_ = 0; i_ < 18; ++i_) { int ri_ = i_ + roff; ri_ = ri_ < 0 ? 0 : ri_; ri_ = (tau0 - 1 + i_ > T - 1) ? (T - 1 - (tau0 > 0 ? tau0 - 1 : 0)) : ri_; x[i_] = bf2f((prow0 + (size_t)ri_ * PXW)[ucol_]); } } while (0)
#define RP_CONV(x, t_, w0_, w1_, w2_) (x[(t_)] * (has_left(tau0 + (t_)) ? (w0_) : 0.f) + x[(t_) + 1] * (w1_) + x[(t_) + 2] * (has_right(tau0 + (t_)) ? (w2_) : 0.f))
        const bf16_t* WLRh = WLR + (size_t)h * 64 * WLR_K;
        const RpAfLds afw{ACT + (n & 15) * 320 + 8 * hi}, afa{ACT + (n & 15) * 320 + 64 + 8 * hi}, afg{ACT + (n & 15) * 320 + 128 + 8 * hi};
        float xw[16], xb[16], xk[16], xkk[16], xr[16], xv[16];
        { float wr_[18], wk_[18], wv_[18]; const unsigned uc = (unsigned)(PXA + col); RP_WIN(wr_, uc); RP_WIN(wk_, uc + A_W); RP_WIN(wv_, uc + 2 * A_W);
          if (d == 0) { float lg[16]; rp_lowrank<12>(lg, afg, WLRh, 256, n, hi);
#pragma unroll
              for (int t = 0; t < 16; ++t) GB[(size_t)(tau0 + t) * A_W + col] = lg[t]; }
          const float cr0 = cw[col], cr1 = cw[A_IN + col], cr2 = cw[2 * A_IN + col], ck0 = cw[A_W + col], ck1 = cw[A_IN + A_W + col], ck2 = cw[2 * A_IN + A_W + col];
          const float cv0 = cw[2 * A_W + col], cv1 = cw[A_IN + 2 * A_W + col], cv2 = cw[2 * A_IN + 2 * A_W + col], kk_w = IN_(22)[l * A_W + col];
#pragma unroll
          for (int t = 0; t < 16; ++t) { xr[t] = RP_CONV(wr_, t, cr0, cr1, cr2); xv[t] = RP_CONV(wv_, t, cv0, cv1, cv2); xk[t] = RP_CONV(wk_, t, ck0, ck1, ck2);
              const float kr = xk[t] * kk_w; const float nrm = sqrtf(wave_sum(kr * kr)); xkk[t] = kr / fmaxf(nrm, 1e-12f); } }
        if (d == 0) {
#pragma unroll
            for (int t = 0; t < 16; ++t) { RB[(size_t)(tau0 + t) * A_W + col] = xr[t]; VB[(size_t)(tau0 + t) * A_W + col] = xv[t]; } }
        { const float ka_w = IN_(23)[l * A_W + col], w0b = IN_(17)[(l * 2 + d) * A_W + col], a0b = IN_(19)[(l * 2 + d) * A_W + col]; float la[16];
          rp_lowrank<4>(xw, afw, WLRh, 64 * d, n, hi); rp_lowrank<4>(la, afa, WLRh, 128 + 64 * d, n, hi);
#pragma unroll
          for (int t = 0; t < 16; ++t) { const float z = w0b + xw[t]; xw[t] = __expf(-__expf(-(fmaxf(-z, 0.f) + __logf(1.0f + __expf(-fabsf(z)))) - 0.5f)); const float av = sigmoidf_(a0b + la[t]);
              xb[t] = xkk[t] * av; xk[t] = xk[t] * (1.0f + (av - 1.0f) * ka_w); KD[((size_t)d * T + tau0 + t) * A_W + col] = xk[t]; } }
        if (d) {
#pragma unroll
            for (int s = 0; s < 8; ++s) { float t_;
                t_ = xw[s]; xw[s] = xw[15 - s]; xw[15 - s] = t_; t_ = xb[s]; xb[s] = xb[15 - s]; xb[15 - s] = t_; t_ = xk[s]; xk[s] = xk[15 - s]; xk[15 - s] = t_;
                t_ = xkk[s]; xkk[s] = xkk[15 - s]; xkk[15 - s] = t_; t_ = xr[s]; xr[s] = xr[15 - s]; xr[15 - s] = t_; t_ = xv[s]; xv[s] = xv[15 - s]; xv[15 - s] = t_; } }
        const int c = d == 0 ? tg : (tg < NCTX / 16 ? NCTX / 16 - 1 - tg : NCTX / 16 + (T / 16 - 1) - tg);
        float gC = 1.f;
#pragma unroll
        for (int s = 0; s < 16; ++s) gC *= xw[s];
        float g = 1.f;
#pragma unroll
        for (int s = 0; s < 16; ++s) {
            const float gm1 = g; g *= xw[s]; const float ig = 1.0f / g; const float bh = xb[s] * ig, kh = xk[s] * ig;
            R1[s * 72 + lane] = f2bf16(-xkk[s] * gm1); R1[(16 + s) * 72 + lane] = f2bf16(xr[s] * g);
            R2[s * 72 + lane] = f2bf16(bh); R2[(16 + s) * 72 + lane] = f2bf16(kh);
            BbT[lane * 16 + s] = f2bf16(bh * gC); KbT[lane * 16 + s] = f2bf16(kh * gC); VT[lane * 16 + s] = f2bf16(xv[s]); }
        asm volatile("s_waitcnt lgkmcnt(0)" ::: "memory");
        unsigned char* dst = FR + ((size_t)(h * 2 + d) * SC_NCHUNK + c) * SC_CHUNK_BYTES;
        rp_f32x16 C = {};
#pragma unroll
        for (int kb = 0; kb < 4; ++kb) { const rp_bf16x8 a_ = *(const LAS rp_bf16x8*)(R2 + n * 72 + 16 * kb + 8 * hi), b_ = *(const LAS rp_bf16x8*)(R1 + n * 72 + 16 * kb + 8 * hi);
            C = __builtin_amdgcn_mfma_f32_32x32x16_bf16(a_, b_, C, 0, 0, 0); }
        const int tt_ = n & 15; const bool incl = n >= 16;
#pragma unroll
        for (int r = 0; r < 16; ++r) { const int s = ((r & 7) & 3) + 8 * ((r & 7) >> 2) + 4 * hi; if (!(s < tt_ || (incl && s == tt_))) C[r] = 0.f; }
        if (n < 16) {
#pragma unroll
            for (int r = 0; r < 8; ++r) Lm[((r & 3) + 8 * (r >> 2) + 4 * hi) * 20 + n] = C[r]; }
        { u32x4 f4; f4.x = cvt_pk_bf16(C[8], C[9]); f4.y = cvt_pk_bf16(C[10], C[11]); f4.z = cvt_pk_bf16(C[12], C[13]); f4.w = cvt_pk_bf16(C[14], C[15]);
          u32x4 f6; f6.x = cvt_pk_bf16(C[0], C[1]); f6.y = cvt_pk_bf16(C[2], C[3]); f6.z = cvt_pk_bf16(C[4], C[5]); f6.w = cvt_pk_bf16(C[6], C[7]);
          if (n < 16) f6 = (u32x4){0u, 0u, 0u, 0u};
          *(u32x4*)(dst + 4 * 1024 + lane * 16) = f4; *(u32x4*)(dst + 6 * 1024 + lane * 16) = f6; }
        asm volatile("s_waitcnt lgkmcnt(0)" ::: "memory");
        { float Tc[16];
#pragma unroll
          for (int s = 15; s >= 0; --s) { float acc = (s == n) ? 1.f : 0.f;
#pragma unroll
              for (int u = s + 1; u < 16; ++u) acc += Lm[s * 20 + u] * Tc[u];
              Tc[s] = acc; }
          u32x4 f5; f5.x = cvt_pk_bf16(hi ? Tc[4] : Tc[0], hi ? Tc[5] : Tc[1]); f5.y = cvt_pk_bf16(hi ? Tc[6] : Tc[2], hi ? Tc[7] : Tc[3]);
          f5.z = cvt_pk_bf16(hi ? Tc[12] : Tc[8], hi ? Tc[13] : Tc[9]); f5.w = cvt_pk_bf16(hi ? Tc[14] : Tc[10], hi ? Tc[15] : Tc[11]);
          if (n >= 16) f5 = (u32x4){0u, 0u, 0u, 0u};
          *(u32x4*)(dst + 5 * 1024 + lane * 16) = f5; }
#pragma unroll
        for (int f = 0; f < 4; ++f) { const u32x2 p0 = *(const LAS u32x2*)(R1 + n * 72 + 16 * f + 4 * hi), p1 = *(const LAS u32x2*)(R1 + n * 72 + 16 * f + 8 + 4 * hi);
            *(u32x4*)(dst + f * 1024 + lane * 16) = (u32x4){p0.x, p0.y, p1.x, p1.y}; }
#pragma unroll
        for (int jb = 0; jb < 2; ++jb) { const int row = 32 * jb + n;
            const u32x2 b0 = *(const LAS u32x2*)(BbT + row * 16 + 4 * hi), b1 = *(const LAS u32x2*)(BbT + row * 16 + 8 + 4 * hi), k0 = *(const LAS u32x2*)(KbT + row * 16 + 4 * hi), k1 = *(const LAS u32x2*)(KbT + row * 16 + 8 + 4 * hi);
            const u32x2 v0 = *(const LAS u32x2*)(VT + row * 16 + 4 * hi), v1 = *(const LAS u32x2*)(VT + row * 16 + 8 + 4 * hi);
            *(u32x4*)(dst + (7 + 2 * jb) * 1024 + lane * 16) = (u32x4){b0.x, b0.y, b1.x, b1.y}; *(u32x4*)(dst + (8 + 2 * jb) * 1024 + lane * 16) = (u32x4){k0.x, k0.y, k1.x, k1.y};
            *(u32x4*)(dst + (11 + jb) * 1024 + lane * 16) = (u32x4){v0.x, v0.y, v1.x, v1.y}; }
        { const int jj = lane & 31; ((float*)(dst + 13 * 1024))[((jj >> 2) & 1) * 32 + (lane >> 5) * 16 + (jj & 3) + 4 * (jj >> 3)] = gC; }
        asm volatile("s_waitcnt lgkmcnt(0)" ::: "memory");
    }
#undef RP_WIN
#undef RP_CONV
}
__device__ __forceinline__ void mixer_phase(const Frame& F0, unsigned char* ws0, int lq, bool need_ctx, char* lds_g) {
    const int l = lq & 3;
#ifndef MK_MIX
#define MK_MIX 15
#endif
    { const Frame F = opq(F0); unsigned char* ws = opq_ptr(ws0);
      if (MK_MIX & 1) for (int chain = F.bid; chain < 2 * NHA; chain += F.G) scan_chain_mfma(F, ws, chain); }
    const Frame& F = F0;
    const int n_xa = 32 * NHC, n_ca = need_ctx ? NHC : 0, n_att = n_xa + n_ca, n_hy = 640, n_ch = need_ctx ? 160 : 0;
    unsigned* qatt = (unsigned*)(ws0 + WS_CTL) + CW_QUEUE + 64 * lq; unsigned* qhy = qatt + 32;
    int item;
#define MIX_POP(q) do { if (F.tid == 0) F.MISC[16] = __hip_atomic_fetch_add((q), 1u, __ATOMIC_RELAXED, __HIP_MEMORY_SCOPE_AGENT); __syncthreads(); item = (int)F.MISC[16]; __syncthreads(); } while (0)
    if (F.bid >= 2 * NHA) {
        MIX_POP(qatt);
        while (item < n_att) {
            if (MK_MIX & 2) { unsigned char* ws = opq_ptr(ws0);
                const bf16_t* QF = (const bf16_t*)(ws + WS_QF); const bf16_t* KF = (const bf16_t*)(ws + WS_KF); const bf16_t* KVRAW = (const bf16_t*)(ws + WS_KVRAW); bf16_t* OB = (bf16_t*)(ws + WS_OBUF);
                const bool is_xa = item < n_xa; const int h = is_xa ? item % NHC : item - n_xa, row0 = is_xa ? NCTX + (item / NHC) * 256 : 0;
                for (int rp = 0; rp < REP(13); ++rp) att::attn_body(QF + (size_t)row0 * NQ + h * 192, KF + h * 192, KVRAW + h * 256 + 128, OB + (size_t)row0 * DM + 2560 + h * 128, is_xa ? T : NCTX, lds_g); }
            MIX_POP(qatt);
        }
    }
    MIX_POP(qhy);
    while (item < n_hy + n_ch) {
        const Frame Fu = opq(F0); unsigned char* ws = opq_ptr(ws0);
        if ((MK_MIX & 4) && item < n_hy) hyena_unit(Fu, ws, l, item);
        else if ((MK_MIX & 8) && item >= n_hy) hyena_ctx_unit(Fu, ws, l, item - n_hy);
        MIX_POP(qhy);
    }
#undef MIX_POP
}

__device__ __forceinline__ void hyena_taps_tail(const Frame& F0, unsigned char* ws0, int lt, int first, int end) {
    if (F0.bid < 48) return;
#pragma unroll 1
    for (int p = first + F0.bid - 48; p < end; p += 208) hyena_taps_unit(opq(F0), opq_ptr(ws0), lt, p);
}
constexpr int NPH = 2 + 14 * NL;
__global__ void __launch_bounds__(512, 2) mk_fwd(Args a) {
    extern __shared__ __attribute__((aligned(16))) unsigned char lds[];
    Frame F; F.lds = (LAS unsigned char*)lds; F.MISC = (volatile LAS unsigned*)(F.lds + LDS_MISC);
    F.tid = threadIdx.x; F.lane = F.tid & 63; F.wave = __builtin_amdgcn_readfirstlane(F.tid >> 6); F.bid = blockIdx.x; F.G = gridDim.x;
    if (F.tid < 64) F.MISC[F.tid] = 0u;
    if (F.tid < 46) *(LAS unsigned long long*)(F.lds + LDS_PTAB + 8 * F.tid) = (unsigned long long)(uintptr_t)a.in[F.tid];
    __syncthreads();
    unsigned char* ws = a.ws;
    const int lo = a.ph_lo, hi = a.ph_hi;
    XcdBarrier bar = xcd_barrier_post((unsigned*)(ws + WS_CTL) + CW_BAR, F.MISC + 8);
#ifndef MK_MASK
#define MK_MASK 0xffff
#endif
#define EN(x) (((MK_MASK) >> (x)) & 1)
#define IN(k) (lo <= (k) && (k) < hi)
#define SEAM(k) do { if (IN(k) && IN((k) + 1)) xcd_barrier(bar); } while (0)
#define WSP opq_ptr(ws)
#define P_XS(w) ((float*)((w) + WS_XS))
#define P_ABUF(w) ((bf16_t*)((w) + WS_ABUF))
#define P_HBUF(w) ((bf16_t*)((w) + WS_HBUF))
#define P_OBUF(w) ((bf16_t*)((w) + WS_OBUF))
#define P_MODX(w, l) ((const float*)((w) + WS_MOD) + ((size_t)(l) * 2 + 0) * NMOD)
#define P_MODC(w, l) ((const float*)((w) + WS_MOD) + ((size_t)(l) * 2 + 1) * NMOD)
#define P_WL(w, l) ((const bf16_t*)((w) + WS_WB) + (size_t)(l) * W_LAYER)
    if (EN(0) && IN(0)) for (int rp = 0; rp < REP(0); ++rp) phase0(opq(F), opq_ptr(ws));
    SEAM(0);
    if (EN(1) && IN(1)) phase_mod(opq(F), opq_ptr(ws));
    SEAM(1);
#pragma clang loop unroll(full)
    for (int l = 0; l < NL; ++l) {
        const int pb = 2 + 14 * l; const bool need_ctx = l < NL - 1;
        if (EN(2) && IN(pb + 0)) for (int rp = 0; rp < REP(2); ++rp) { unsigned char* w = WSP; norm_phase(opq(F), P_XS(w), IN_(7) + l * DM, P_MODX(w, l), P_MODC(w, l), 0, 1, P_ABUF(w), l > 0 ? (const float*)(w + WS_SLAB) : nullptr, l > 0 ? P_MODC(w, l - 1) + 8 * DM : nullptr, 0.5f); }
        SEAM(pb + 0);
        if (EN(3) && IN(pb + 1)) { unsigned char* w = WSP; pg8::Gemm g{P_ABUF(w), P_WL(w, l) + W_G1, T, 2 * FF, DM, DM}; pg8::StaticOrder S; S.init(T, 2 * FF, F.G, F.bid); pg8::EpiSwiGLU E{P_HBUF(w), FF};
            pg8::gemm_phase<pg8::EpiSwiGLU, pg8::StaticOrder>(F.lds, g, S, E, nullptr);
            hyena_taps_tail(F, ws, l, 0, l == 0 ? 640 : 416); }
        SEAM(pb + 1);
        if (EN(4) && IN(pb + 2)) {
            { unsigned char* w = WSP; pg8::Gemm g{P_HBUF(w), P_WL(w, l) + W_D1, T, DM, FF, FF}; pg8::StaticOrderX S; S.init(T, DM, F.G, F.bid); pg8::EpiResid E{P_XS(w), P_MODX(w, l) + 2 * DM, P_MODC(w, l) + 2 * DM, 0.5f, nullptr};
              pg8::gemm_phase<pg8::EpiResid, pg8::StaticOrderX>(F.lds, g, S, E, nullptr); }
            if (true) { __syncthreads();
              if (F.bid < 256) { unsigned char* w = WSP; const int ks = F.bid >> 4, ksz = FF / 16; pg8::Gemm g{P_HBUF(w) + ks * ksz, P_WL(w, l) + W_D1 + ks * ksz, NCTX, DM, ksz, FF}; pg8::OneUnit S{F.bid & 15};
                  pg8::EpiF32 E{(float*)(w + WS_SLAB) + (size_t)ks * NCTX * DM, DM, nullptr};
                  pg8::gemm_phase<pg8::EpiF32, pg8::OneUnit>(F.lds, g, S, E, nullptr); } }
        }
        SEAM(pb + 2);
        if (EN(5) && IN(pb + 3)) for (int rp = 0; rp < REP(2); ++rp) { unsigned char* w = WSP; norm_phase(opq(F), P_XS(w), IN_(8) + l * DM, P_MODX(w, l), P_MODC(w, l), 3, 4, P_ABUF(w), (const float*)(w + WS_SLAB), P_MODC(w, l) + 2 * DM, 0.5f); }
        SEAM(pb + 3);
        if (EN(6) && IN(pb + 4)) { unsigned char* w = WSP; pg8::Gemm g{P_ABUF(w), P_WL(w, l) + W_IN, T, PXW, DM, DM}; pg8::StaticOrder S; S.init(T, PXW, F.G, F.bid); pg8::EpiBf16<0> E{(bf16_t*)(w + WS_PX), PXW, nullptr, 0, 0};
            pg8::gemm_phase<pg8::EpiBf16<0>, pg8::StaticOrder>(F.lds, g, S, E, nullptr); }
        SEAM(pb + 4);
        if (EN(7) && IN(pb + 5)) { for (int rp = 0; rp < REP(7); ++rp) rwkv_fused_phase(opq(F), opq_ptr(ws), l); if (!(MK_ONLYRP)) { for (int rp = 0; rp < REP(8); ++rp) mla_prep_phase(opq(F), opq_ptr(ws), l); hyena_prep_phase(opq(F), opq_ptr(ws), l); } }
        SEAM(pb + 5);
        if (EN(8) && IN(pb + 6)) {
            { unsigned char* w = WSP; pg8::Gemm g{(const bf16_t*)(w + WS_QA), P_WL(w, l) + W_Q, T, NQ, 1024, 1024}; pg8::StaticOrder S; S.init(T, NQ, F.G, F.bid); pg8::EpiBf16<0> E{(bf16_t*)(w + WS_QRAW), NQ, nullptr, 0, 0};
              pg8::gemm_phase<pg8::EpiBf16<0>, pg8::StaticOrder>(F.lds, g, S, E, nullptr); }
            __syncthreads();
            { unsigned char* w = WSP; pg8::Gemm g{(const bf16_t*)(w + WS_KVA), P_WL(w, l) + W_KV, T, NKV, 512, 512}; pg8::StaticOrder S; S.init(T, NKV, F.G, F.bid); pg8::EpiBf16<0> E{(bf16_t*)(w + WS_KVRAW), NKV, nullptr, 0, 0};
              pg8::gemm_phase<pg8::EpiBf16<0>, pg8::StaticOrder>(F.lds, g, S, E, nullptr); }
        }
        SEAM(pb + 6);
        if (EN(9) && IN(pb + 7)) { for (int rp = 0; rp < REP(8); ++rp) qkv_final_phase(opq(F), opq_ptr(ws), l, need_ctx); }
        SEAM(pb + 7);
        if (EN(10) && IN(pb + 8)) for (int rp = 0; rp < REP(10); ++rp) mixer_phase(F, ws, l + 4 * rp, need_ctx, (char*)lds);
        SEAM(pb + 8);
        if (EN(11) && IN(pb + 9)) { for (int rp = 0; rp < REP(8); ++rp) rwkv_out_phase(opq(F), opq_ptr(ws), l, need_ctx); hyena_out_phase(opq(F), opq_ptr(ws), need_ctx); }
        SEAM(pb + 9);
        if (EN(12) && IN(pb + 10)) {
            { unsigned char* w = WSP; pg8::Gemm g{P_OBUF(w), P_WL(w, l) + W_OUT, T, DM, DM, DM}; pg8::StaticOrderX S; S.init(T, DM, F.G, F.bid); pg8::EpiResid E{P_XS(w), P_MODX(w, l) + 5 * DM, P_MODC(w, l) + 5 * DM, 1.0f, nullptr};
              pg8::gemm_phase<pg8::EpiResid, pg8::StaticOrderX>(F.lds, g, S, E, nullptr); }
            if (need_ctx) { __syncthreads();
              if (F.bid < 256) { unsigned char* w = WSP; const int ks = F.bid >> 4, ksz = DM / 16; pg8::Gemm g{P_OBUF(w) + ks * ksz, P_WL(w, l) + W_OUT + ks * ksz, NCTX, DM, ksz, DM}; pg8::OneUnit S{F.bid & 15};
                  pg8::EpiF32 E{(float*)(w + WS_SLAB) + (size_t)ks * NCTX * DM, DM, nullptr};
                  pg8::gemm_phase<pg8::EpiF32, pg8::OneUnit>(F.lds, g, S, E, nullptr); } }
        }
        SEAM(pb + 10);
        if (EN(13) && IN(pb + 11)) for (int rp = 0; rp < REP(2); ++rp) { unsigned char* w = WSP; norm_phase(opq(F), P_XS(w), IN_(9) + l * DM, P_MODX(w, l), P_MODC(w, l), 6, 7, P_ABUF(w), need_ctx ? (const float*)(w + WS_SLAB) : nullptr, P_MODC(w, l) + 5 * DM, 1.0f); }
        SEAM(pb + 11);
        if (EN(14) && IN(pb + 12)) { if (need_ctx) { unsigned char* w = WSP; pg8::Gemm g{P_ABUF(w), P_WL(w, l) + W_G2, T, 2 * FF, DM, DM}; pg8::StaticOrder S; S.init(T, 2 * FF, F.G, F.bid); pg8::EpiSwiGLU E{P_HBUF(w), FF};
            pg8::gemm_phase<pg8::EpiSwiGLU, pg8::StaticOrder>(F.lds, g, S, E, nullptr);
            hyena_taps_tail(F, ws, l + 1, 416, 640); }       else { unsigned char* w = WSP; pg8::Gemm g{P_ABUF(w), P_WL(w, l) + W_G2, T, 2 * FF, DM, DM}; pg8::StaticOrderX S; S.init(T, 2 * FF, F.G, F.bid); pg8::EpiSwiGLU E{P_HBUF(w), FF};
            pg8::gemm_phase<pg8::EpiSwiGLU, pg8::StaticOrderX>(F.lds, g, S, E, nullptr); } }
        SEAM(pb + 12);
        if (EN(15) && IN(pb + 13)) {
            { unsigned char* w = WSP; pg8::Gemm g{P_HBUF(w), P_WL(w, l) + W_D2, T, DM, FF, FF}; pg8::StaticOrderX S; S.init(T, DM, F.G, F.bid); pg8::EpiResid E{P_XS(w), P_MODX(w, l) + 8 * DM, P_MODC(w, l) + 8 * DM, 0.5f, l == NL - 1 ? a.out : nullptr};
              pg8::gemm_phase<pg8::EpiResid, pg8::StaticOrderX>(F.lds, g, S, E, nullptr); }
            if (need_ctx) { __syncthreads();
              if (F.bid < 256) { unsigned char* w = WSP; const int ks = F.bid >> 4, ksz = FF / 16; pg8::Gemm g{P_HBUF(w) + ks * ksz, P_WL(w, l) + W_D2 + ks * ksz, NCTX, DM, ksz, FF}; pg8::OneUnit S{F.bid & 15};
                  pg8::EpiF32 E{(float*)(w + WS_SLAB) + (size_t)ks * NCTX * DM, DM, nullptr};
                  pg8::gemm_phase<pg8::EpiF32, pg8::OneUnit>(F.lds, g, S, E, nullptr); } }
        }
        SEAM(pb + 13);
    }
#undef IN
#undef SEAM
}

#ifndef MK_LAUNCHES
#define MK_LAUNCHES 1
#endif
extern "C" void kernel_launch(void* const* d_in, const int* in_sizes, int n_in, void* d_out, int out_size, void* d_ws, size_t ws_size, hipStream_t stream) {
    static int grid = 0;
    if (grid == 0) {
        if (n_in != 46 || in_sizes[0] != SEQ * DM || out_size != SEQ * DM || ws_size < WS_END) {
            fprintf(stderr, "kernel_launch: shape mismatch: n_in %d in0 %d out %d ws %zu (need %zu); nothing launched\n", n_in, n_in > 0 ? in_sizes[0] : -1, out_size, ws_size, (size_t)WS_END); grid = -1; return; }
        int dev = 0, cus = 0, per_cu = 0;
        if (hipGetDevice(&dev) != hipSuccess || hipDeviceGetAttribute(&cus, hipDeviceAttributeMultiprocessorCount, dev) != hipSuccess) { fprintf(stderr, "kernel_launch: device query failed\n"); grid = -1; return; }
        if (hipFuncSetAttribute((const void*)mk_fwd, hipFuncAttributeMaxDynamicSharedMemorySize, LDS_BYTES) != hipSuccess) { fprintf(stderr, "kernel_launch: hipFuncSetAttribute failed\n"); grid = -1; return; }
        if (hipOccupancyMaxActiveBlocksPerMultiprocessor(&per_cu, (const void*)mk_fwd, 512, LDS_BYTES) != hipSuccess || per_cu < 1) fprintf(stderr, "kernel_launch: note: occupancy query reports %d blocks per CU\n", per_cu);
        (void)hipGetLastError();
        grid = cus;
        if (cus != 256) { fprintf(stderr, "kernel_launch: built for 256 CUs (split-K of the context panel, hyena scratch), found %d; nothing launched\n", cus); grid = -1; return; }
    }
    if (grid < 0) return;
    if (hipMemsetAsync((char*)d_ws + WS_CTL, 0, CTL_BYTES, stream) != hipSuccess) { fprintf(stderr, "kernel_launch: memset failed\n"); return; }
    Args a{};
    for (int i = 0; i < 46; ++i) a.in[i] = (const float*)d_in[i];
    a.out = (float*)d_out; a.ws = (unsigned char*)d_ws;
    a.ph_lo = 0; a.ph_hi = NPH;
    hipLaunchKernelGGL(mk_fwd, dim3(grid), dim3(512), LDS_BYTES, stream, a);
    const hipError_t le = hipPeekAtLastError();
    if (le != hipSuccess) fprintf(stderr, "kernel_launch: launch failed: %s\n", hipGetErrorName(le));
}
```

```cpp
#include <hip/hip_runtime.h>
#include <stdint.h>
#include <cstdio>

#define LAS __attribute__((address_space(3)))
#define CAS __attribute__((address_space(4)))
typedef unsigned short bf16_t;
typedef float f32x4 __attribute__((ext_vector_type(4)));
typedef float f32x2 __attribute__((ext_vector_type(2)));
typedef unsigned u32x4 __attribute__((ext_vector_type(4)));
typedef unsigned u32x2 __attribute__((ext_vector_type(2)));

constexpr int T = 8448, NCTX = 256, SEQ = 8192, DM = 4096, FF = 6144, NL = 4;
constexpr int A_W = 1280, A_IN = 4160, B_IN = 3840, C_IN = 1600, NHA = 20;
constexpr int PXW = 9728, PXA = 0, PXB = 4160, PXC = 8000;
constexpr int NQ = 2304, NKV = 3072, NHC = 12;
constexpr int NMOD = 9 * DM;
constexpr float NORM_EPS = 1e-6f, GN_EPS = 64e-5f;

constexpr size_t MiB = 1u << 20;
constexpr size_t al(size_t x) { return (x + MiB - 1) / MiB * MiB; }
constexpr size_t WS_CTL = 0, CTL_BYTES = MiB;
constexpr size_t WS_XS = WS_CTL + CTL_BYTES;
constexpr size_t WS_ABUF = WS_XS + al((size_t)T * DM * 4);
constexpr size_t WS_HBUF = WS_ABUF + al((size_t)T * DM * 2);
constexpr size_t WS_OBUF = WS_HBUF + al((size_t)T * FF * 2);
constexpr size_t WS_PX = WS_OBUF + al((size_t)T * DM * 2);
constexpr size_t WS_MOD = WS_PX + al((size_t)T * PXW * 4);
constexpr size_t WS_HP = WS_MOD + al((size_t)NL * 2 * NMOD * 4);
constexpr size_t WS_SS = WS_HP + MiB;
constexpr size_t WS_SD = WS_SS + al((size_t)NHA * T * 192 * 4);
constexpr size_t WS_WLR = WS_SD + al((size_t)NHA * 2 * T * 192 * 4);
constexpr size_t WS_G = WS_WLR + al((size_t)NL * A_W * 448 * 2);
constexpr size_t WS_Y = WS_G + al((size_t)T * A_W * 4);
constexpr size_t WS_QA = WS_Y + al((size_t)2 * T * A_W * 4);
constexpr size_t WS_KVA = WS_QA + al((size_t)T * 1024 * 2);
constexpr size_t WS_KPE = WS_KVA + al((size_t)T * 512 * 2);
constexpr size_t WS_QRAW = WS_KPE + al((size_t)T * 64 * 2);
constexpr size_t WS_KVRAW = WS_QRAW + al((size_t)T * NQ * 2);
constexpr size_t WS_QF = WS_KVRAW + al((size_t)T * NKV * 2);
constexpr size_t WS_KF = WS_QF + al((size_t)T * NQ * 2);
constexpr size_t WS_H3 = WS_KF + al((size_t)T * NQ * 2);
constexpr size_t WS_HSCR = WS_H3 + al((size_t)NL * T * 64 * 4);
constexpr size_t WS_FR = WS_HSCR + al((size_t)640 * 16384 * 8 + 640 * 8);
constexpr size_t WS_GT = WS_FR + al((size_t)40 * 528 * (14 * 1024));
constexpr size_t WS_X0T = WS_GT + al((size_t)1280 * T * 4);
constexpr size_t WS_SLAB = WS_FR;
constexpr size_t WS_WB = WS_X0T + al((size_t)1280 * T * 4);
constexpr size_t W_G1 = 0, W_D1 = W_G1 + (size_t)2 * FF * DM, W_IN = W_D1 + (size_t)DM * FF, W_OUT = W_IN + (size_t)PXW * DM, W_G2 = W_OUT + (size_t)DM * DM,
                 W_D2 = W_G2 + (size_t)2 * FF * DM, W_Q = W_D2 + (size_t)DM * FF, W_KV = W_Q + (size_t)NQ * 1024, W_LAYER = W_KV + (size_t)NKV * 512;
constexpr size_t WS_END = WS_WB + al(W_LAYER * NL * 2);
constexpr int CW_BAR = 4096;
constexpr int CW_QUEUE = 8192;

constexpr int LDS_MISC = 143360, LDS_BYTES = 147456;

__device__ __forceinline__ float wave_sum(float v) {
#pragma unroll
    for (int o = 1; o < 64; o <<= 1) v += __shfl_xor(v, o);
    return v;
}
typedef __bf16 bf16x2_t __attribute__((ext_vector_type(2)));
__device__ __forceinline__ unsigned cvt_pk_bf16(float lo, float hi) { const f32x2 v = {lo, hi}; return __builtin_bit_cast(unsigned, __builtin_convertvector(v, bf16x2_t)); }
__device__ __forceinline__ float bf2f(unsigned short b) { return __uint_as_float(((unsigned)b) << 16); }
__device__ __forceinline__ f32x4 bf4f(u32x2 w) { return (f32x4){__uint_as_float(w.x << 16), __uint_as_float(w.x & 0xffff0000u), __uint_as_float(w.y << 16), __uint_as_float(w.y & 0xffff0000u)}; }
__device__ __forceinline__ float sigmoidf_(float x) { return 1.0f / (1.0f + __expf(-x)); }
__device__ __forceinline__ float siluf_(float x) { return x / (1.0f + __expf(-x)); }
__device__ __forceinline__ bool has_left(int tau) { return tau != 0 && tau != NCTX; }
__device__ __forceinline__ bool has_right(int tau) { return tau != NCTX - 1 && tau != T - 1; }

struct Args { const float* in[46]; float* out; unsigned char* ws; int ph_lo, ph_hi; };
struct Frame { LAS unsigned char* lds; volatile LAS unsigned* MISC; int tid, lane, wave, bid, G; };
constexpr int LDS_PTAB = LDS_MISC + 2048;
__device__ __forceinline__ const float* inp(const Frame& F, int i) {
    const volatile LAS unsigned* p = (const volatile LAS unsigned*)(F.lds + LDS_PTAB) + 2 * i;
    const unsigned lo = __builtin_amdgcn_readfirstlane(p[0]), hi = __builtin_amdgcn_readfirstlane(p[1]);
    return (const float*)(((unsigned long long)hi << 32) | lo);
}
#define IN_(i) inp(F, (i))
__device__ __forceinline__ Frame opq(const Frame& F) { Frame G = F; asm volatile("" : "+v"(G.tid), "+s"(G.wave), "+s"(G.bid)); G.lane = G.tid & 63; return G; }
__device__ __forceinline__ unsigned char* opq_ptr(unsigned char* p) { asm volatile("" : "+s"(p)); return p; }
#ifndef MK_REP
#define MK_REP 0
#endif
#ifndef MK_ONLYRP
#define MK_ONLYRP 0
#endif
#define REP(x) (1 + (((MK_REP) >> (x)) & 1))
#define XB_TMO      128
#define XB_XCNT(j)  (256  + 64 * (j))
#define XB_XSUB(j)  (1280 + 64 * (j))
#define XB_XGEN(j)  (2304 + 64 * (j))
#define XB_TOP      3328
#define XB_TOPGEN   3392
#define XCD_BAR_WORDS 3456
#define XB_SPIN_CAP (1u << 18)

__device__ __forceinline__ unsigned xb_ld(unsigned* p)              { return __hip_atomic_load(p, __ATOMIC_RELAXED, __HIP_MEMORY_SCOPE_AGENT); }
__device__ __forceinline__ unsigned xb_add(unsigned* p, unsigned v) { return __hip_atomic_fetch_add(p, v, __ATOMIC_RELAXED, __HIP_MEMORY_SCOPE_AGENT); }
__device__ __forceinline__ unsigned xb_xcc_id() { return (unsigned)__builtin_amdgcn_s_getreg((3 << 11) | 20) & 0xFu; }
#define XB_SPIN(cond, bar) do { unsigned _sp = 0; while (cond) { __builtin_amdgcn_s_sleep(1); \
    if ((++_sp & 255u) == 0u) { if (xb_ld(&(bar)[XB_TMO])) break; if (_sp > XB_SPIN_CAP) { atomicAdd(&(bar)[XB_TMO], 1u); break; } } } } while (0)

struct XcdBarrier {
    unsigned* bar; unsigned x;
    volatile LAS unsigned* st;
};

__device__ __forceinline__ XcdBarrier xcd_barrier_post(unsigned* bar, volatile LAS unsigned* st) {
    XcdBarrier b; b.bar = bar; b.x = xb_xcc_id(); b.st = st;
    if (threadIdx.x == 0) (void)xb_add(&bar[XB_XCNT(b.x)], 1u);
    return b;
}
__device__ __forceinline__ void xcd_barrier_complete(unsigned* bar, unsigned x, unsigned& nloc, unsigned& nx) {
    const unsigned G = gridDim.x * gridDim.y * gridDim.z;
    unsigned sum, cnt, mine, sp = 0u;
    for (;;) {
        sum = 0u; cnt = 0u; mine = 0u;
#pragma unroll
        for (unsigned j = 0; j < 16; ++j) { const unsigned c = xb_ld(&bar[XB_XCNT(j)]); sum += c; cnt += (c > 0u) ? 1u : 0u; mine = (j == x) ? c : mine; }
        if (sum == G) break;
        __builtin_amdgcn_s_sleep(1);
        if ((++sp & 255u) == 0u) { if (xb_ld(&bar[XB_TMO])) break; if (sp > XB_SPIN_CAP) { atomicAdd(&bar[XB_TMO], 1u); break; } }
    }
    nloc = mine > 0u ? mine : 1u; nx = cnt > 0u ? cnt : 1u;
}

__device__ __forceinline__ void xcd_barrier(const XcdBarrier& b) {
    asm volatile("s_waitcnt vmcnt(0)" ::: "memory");
    __syncthreads();
    if (threadIdx.x == 0) {
        unsigned* bar = b.bar;
        __builtin_amdgcn_s_waitcnt(0);
        unsigned nloc = b.st[0], nx = b.st[1];
        if (nloc == 0u) { xcd_barrier_complete(bar, b.x, nloc, nx); b.st[0] = nloc; b.st[1] = nx; }
        const unsigned old = xb_add(&bar[XB_XSUB(b.x)], 1u);
        const unsigned gen = old / nloc;
        if (old + 1u == (gen + 1u) * nloc) {
            __builtin_amdgcn_fence(__ATOMIC_RELEASE, "agent");
            asm volatile("s_waitcnt vmcnt(0)" ::: "memory");
            const unsigned og = xb_add(&bar[XB_TOP], 1u);
            const unsigned tg = og / nx;
            if (og + 1u == (tg + 1u) * nx) xb_add(&bar[XB_TOPGEN], 1u);
            else XB_SPIN(xb_ld(&bar[XB_TOPGEN]) == tg, bar);
            __builtin_amdgcn_fence(__ATOMIC_ACQUIRE, "agent");
            xb_add(&bar[XB_XGEN(b.x)], 1u);
            asm volatile("s_waitcnt vmcnt(0)" ::: "memory");
        } else {
            XB_SPIN(xb_ld(&bar[XB_XGEN(b.x)]) == gen, bar);
            __builtin_amdgcn_fence(__ATOMIC_ACQUIRE, "agent");
            asm volatile("s_waitcnt vmcnt(0)" ::: "memory");
        }
    }
    __syncthreads();
}
namespace pg8 {
#define PG8_LAS __attribute__((address_space(3)))
typedef unsigned short bf16_t;
typedef short bf16x8 __attribute__((ext_vector_type(8)));
typedef float f32x4 __attribute__((ext_vector_type(4)));
typedef unsigned u32x4 __attribute__((ext_vector_type(4)));
constexpr int BM = 256, BK = 64, HALF = 128, HTB = HALF * BK * 2  , STAGE_BYTES = 8 * HTB, NXCD = 8, WGM = 4;

__host__ __device__ __forceinline__ int lds_byte(int r, int c) { const int st = (r >> 4) * 2 + (c >> 5), rr = r & 15, cc = c & 31, ob = rr * 64 + cc * 2; return st * 1024 + (ob ^ (((ob >> 9) & 1) << 5)); }
__host__ __device__ __forceinline__ void stage_rc(int b, int& R, int& C) { const int st = b / 1024, sb = b % 1024, swz = sb ^ (((sb >> 9) & 1) << 5); R = (st >> 1) * 16 + swz / 64; C = (st & 1) * 32 + (swz % 64) / 2; }
__host__ __device__ __forceinline__ int perm32(int rho) { const int n = rho >> 4, i = rho & 15; return 8 * (i >> 2) + 4 * n + (i & 3); }

struct Unit { int pm, pn; };
struct Gemm { const bf16_t* A; const bf16_t* Bt; int M, N, K, ld; };

struct StaticOrder {
    int nM, nN, nwg, G, c;
    __host__ __device__ void init(int M, int N, int G_, int c_) { nM = M / BM; nN = N / BM; nwg = nM * nN; G = G_; c = c_; }
    __host__ __device__ bool next(int i, Unit& u) const {
        const long L = (long)i * G + c; if (L >= nwg) return false;
        int wgid = (int)L; { const int q = nwg / NXCD, r = nwg % NXCD, xcd = wgid % NXCD, off = wgid / NXCD; wgid = (xcd < r ? xcd * (q + 1) : r * (q + 1) + (xcd - r) * q) + off; }
        const int nig = WGM * nN, gid = wgid / nig, fm = gid * WGM, gsz = (nM - fm) < WGM ? (nM - fm) : WGM;
        u.pm = fm + ((wgid % nig) % gsz); u.pn = (wgid % nig) / gsz; return true;
    }
    __device__ __forceinline__ void a_ready(const Unit&) const {}
    __device__ __forceinline__ void done(const Unit&) const {}
};
struct CountedOrder : StaticOrder {
    const unsigned* ready; unsigned need; unsigned* tmo;
    __device__ __forceinline__ void a_ready(const Unit& u) const {
        if (threadIdx.x < 64) {
            const unsigned long long t0 = __builtin_amdgcn_s_memrealtime(); unsigned polls = 0;
            while ((unsigned)__builtin_amdgcn_readfirstlane(__hip_atomic_load(ready + 64 * u.pm, __ATOMIC_RELAXED, __HIP_MEMORY_SCOPE_AGENT)) < need) {
                if ((++polls & 255u) == 0u && __builtin_amdgcn_readfirstlane(__hip_atomic_load(tmo, __ATOMIC_RELAXED, __HIP_MEMORY_SCOPE_AGENT)) != 0u) break;
                if (__builtin_amdgcn_s_memrealtime() - t0 > 2000000ull) {
                    if (threadIdx.x == 0) { unsigned expect = 0u; __hip_atomic_compare_exchange_strong(tmo + 1, &expect, 0x600u | (unsigned)(u.pm & 0xff), __ATOMIC_RELAXED, __ATOMIC_RELAXED, __HIP_MEMORY_SCOPE_AGENT); __hip_atomic_store(tmo, 1u, __ATOMIC_RELAXED, __HIP_MEMORY_SCOPE_AGENT); }
                    break; }
                __builtin_amdgcn_s_sleep(2); }
            __builtin_amdgcn_fence(__ATOMIC_ACQUIRE, "agent");
            asm volatile("s_waitcnt vmcnt(0)" ::: "memory");
        }
#if !defined(BROKEN_HOOK_NO_BARRIER)
        asm volatile("" ::: "memory"); __builtin_amdgcn_s_barrier(); asm volatile("" ::: "memory");
#endif
    }
};

__device__ __forceinline__ unsigned cvt_pk_bf16(float lo, float hi) { unsigned r; asm volatile("v_cvt_pk_bf16_f32 %0, %1, %2" : "=v"(r) : "v"(lo), "v"(hi)); return r; }
typedef float f32x2 __attribute__((ext_vector_type(2)));
__device__ __forceinline__ f32x2 gelu_pk(f32x2 v) {
    const f32x2 av = __builtin_elementwise_abs(v), d = av * 0.2316418882f + 1.0f;
    f32x2 t; t.x = __builtin_amdgcn_rcpf(d.x); t.y = __builtin_amdgcn_rcpf(d.y);
    f32x2 q = t * 0.5307027145f + (-0.7265760135f); q = q * t + 0.7107068705f; q = q * t + (-0.142248368f); q = q * t + 0.127414796f; q = q * t;
    const f32x2 s = (v * v) * (-0.72134752044f);
    f32x2 e; e.x = __builtin_amdgcn_exp2f(s.x); e.y = __builtin_amdgcn_exp2f(s.y);
    const f32x2 m = v * (q * e), r = v - m;
    f32x2 o; o.x = v.x < 0.f ? m.x : r.x; o.y = v.y < 0.f ? m.y : r.y; return o;
}

struct EpiF32 {
    static constexpr bool PERM = false, AFTER_DRAIN = false;
    float* C; int ldc; const float* bias;
    __device__ __forceinline__ void operator()(const f32x4 (&acc)[2][2][4][2], const Unit& u, int wr, int wc, int fr, int fq) const {
        const int row0 = u.pm * BM + wr * 64 + fr, col0 = u.pn * BM + wc * 32 + 4 * fq;
        f32x4 bv[2][2];
#pragma unroll
        for (int bj = 0; bj < 2; ++bj)
#pragma unroll
            for (int n = 0; n < 2; ++n) bv[bj][n] = bias ? *(const f32x4*)(bias + col0 + bj * HALF + n * 16) : (f32x4){0.f, 0.f, 0.f, 0.f};
#pragma unroll
        for (int ai = 0; ai < 2; ++ai)
#pragma unroll
            for (int m = 0; m < 4; ++m) { float* rowp = C + (size_t)(row0 + ai * HALF + m * 16) * ldc + col0;
#pragma unroll
                for (int bj = 0; bj < 2; ++bj)
#pragma unroll
                    for (int n = 0; n < 2; ++n) *(f32x4*)(rowp + bj * HALF + n * 16) = acc[ai][bj][m][n] + bv[bj][n]; }
    }
};
template <int ACT  > struct EpiBf16 {
    static constexpr bool PERM = true, AFTER_DRAIN = false;
    bf16_t* O; int ldc; const float* bias; int split_cols; size_t split_stride;
    __device__ __forceinline__ void operator()(const f32x4 (&acc)[2][2][4][2], const Unit& u, int wr, int wc, int fr, int fq) const {
        const int row0 = u.pm * BM + wr * 64 + fr; int colt = u.pn * BM; bf16_t* base = O;
        if (split_cols) { const int t = colt / split_cols; base += (size_t)t * split_stride; colt -= t * split_cols; }
        const int col0 = colt + wc * 32 + 8 * fq, bcol0 = u.pn * BM + wc * 32 + 8 * fq;
        f32x4 bv[2][2];
#pragma unroll
        for (int bj = 0; bj < 2; ++bj)
#pragma unroll
            for (int n = 0; n < 2; ++n) bv[bj][n] = bias ? *(const f32x4*)(bias + bcol0 + bj * HALF + 4 * n) : (f32x4){0.f, 0.f, 0.f, 0.f};
#pragma unroll
        for (int ai = 0; ai < 2; ++ai)
#pragma unroll
            for (int m = 0; m < 4; ++m) { bf16_t* rowp = base + (size_t)(row0 + ai * HALF + m * 16) * ldc + col0;
#pragma unroll
                for (int bj = 0; bj < 2; ++bj) { f32x4 v0 = acc[ai][bj][m][0] + bv[bj][0], v1 = acc[ai][bj][m][1] + bv[bj][1];
                    if (ACT == 1) { f32x2 a = gelu_pk((f32x2){v0[0], v0[1]}), b = gelu_pk((f32x2){v0[2], v0[3]}), c = gelu_pk((f32x2){v1[0], v1[1]}), d = gelu_pk((f32x2){v1[2], v1[3]});
                        v0 = (f32x4){a.x, a.y, b.x, b.y}; v1 = (f32x4){c.x, c.y, d.x, d.y}; }
                    if (ACT == 2) {
#pragma unroll
                        for (int j = 0; j < 4; ++j) { v0[j] = 0.5f * v0[j] * (1.0f + erff(v0[j] * 0.70710678f)); v1[j] = 0.5f * v1[j] * (1.0f + erff(v1[j] * 0.70710678f)); } }
                    u32x4 w; w.x = cvt_pk_bf16(v0[0], v0[1]); w.y = cvt_pk_bf16(v0[2], v0[3]); w.z = cvt_pk_bf16(v1[0], v1[1]); w.w = cvt_pk_bf16(v1[2], v1[3]);
                    *(u32x4*)(rowp + bj * HALF) = w; } }
    }
};
}
namespace pg8 {
struct EpiSwiGLU {
    static constexpr bool PERM = true, AFTER_DRAIN = false;
    bf16_t* O; int ldc;
    __device__ __forceinline__ void operator()(const f32x4 (&acc)[2][2][4][2], const Unit& u, int wr, int wc, int fr, int fq) const {
        const int row0 = u.pm * BM + wr * 64 + fr, col0 = u.pn * HALF + wc * 32 + 8 * fq;
#pragma unroll
        for (int ai = 0; ai < 2; ++ai)
#pragma unroll
            for (int m = 0; m < 4; ++m) { bf16_t* rowp = O + (size_t)(row0 + ai * HALF + m * 16) * ldc + col0;
                float h[8];
#pragma unroll
                for (int n = 0; n < 2; ++n)
#pragma unroll
                    for (int j = 0; j < 4; ++j) { const float g = acc[ai][0][m][n][j], up = acc[ai][1][m][n][j]; h[n * 4 + j] = g * __builtin_amdgcn_rcpf(1.0f + __builtin_amdgcn_exp2f(-1.4426950408889634f * g)) * up; }
                u32x4 w; w.x = cvt_pk_bf16(h[0], h[1]); w.y = cvt_pk_bf16(h[2], h[3]); w.z = cvt_pk_bf16(h[4], h[5]); w.w = cvt_pk_bf16(h[6], h[7]);
                *(u32x4*)rowp = w; }
    }
};
struct EpiResid {
    static constexpr bool PERM = false, AFTER_DRAIN = false;
    float* X; const float* gate_x; const float* gate_c; float fac; float* out_x;
    __device__ __forceinline__ void operator()(const f32x4 (&acc)[2][2][4][2], const Unit& u, int wr, int wc, int fr, int fq) const {
        const int row0 = u.pm * BM + wr * 64 + fr, col0 = u.pn * BM + wc * 32 + 4 * fq;
        const float* gv = (u.pm == 0) ? gate_c : gate_x;
        float* dst = (u.pm != 0 && out_x) ? out_x - (size_t)256 * 4096 : X;
        f32x4 gg[2][2];
#pragma unroll
        for (int bj = 0; bj < 2; ++bj)
#pragma unroll
            for (int n = 0; n < 2; ++n) gg[bj][n] = *(const f32x4*)(gv + col0 + bj * HALF + n * 16) * fac;
#pragma unroll
        for (int ai = 0; ai < 2; ++ai)
#pragma unroll
            for (int m = 0; m < 4; ++m) { const size_t off = (size_t)(row0 + ai * HALF + m * 16) * 4096 + col0;
#pragma unroll
                for (int bj = 0; bj < 2; ++bj)
#pragma unroll
                    for (int n = 0; n < 2; ++n) { const f32x4 b = *(const f32x4*)(X + off + bj * HALF + n * 16); *(f32x4*)(dst + off + bj * HALF + n * 16) = b + gg[bj][n] * acc[ai][bj][m][n]; } }
    }
};
struct OneUnit { int pn;
    __host__ __device__ bool next(int i, Unit& u) const { u.pm = 0; u.pn = pn; return i == 0; }
    __device__ __forceinline__ void a_ready(const Unit&) const {}
    __device__ __forceinline__ void done(const Unit&) const {}
};
struct StaticOrderX { StaticOrder b;
    __host__ __device__ void init(int M, int N, int G_, int c_) { b.init(M - BM, N, G_, c_); }
    __host__ __device__ bool next(int i, Unit& u) const { const bool ok = b.next(i, u); u.pm += 1; return ok; }
    __device__ __forceinline__ void a_ready(const Unit&) const {}
    __device__ __forceinline__ void done(const Unit&) const {}
};
}
namespace pg8 {
template <class Epi, class Sched, bool STAMP = false>
__device__ __forceinline__ void gemm_phase(PG8_LAS unsigned char* lds, const Gemm g, const Sched& S, const Epi& E, unsigned long long* stamps) {
    int tid_ = threadIdx.x; asm volatile("" : "+v"(tid_));
    const int tid = tid_, wid = __builtin_amdgcn_readfirstlane(tid >> 6), lane = tid & 63, wr = wid >> 2, wc = wid & 3, fr = lane & 15, fq = lane >> 4;
    const int K = g.ld, nt = g.K / BK;
    int ts_lo = 0, ts_hi = 0, nts = 0; const unsigned long long rt_entry = STAMP ? (unsigned long long)wall_clock64() : 0ull;
#define PG8_STAMP() do { if (STAMP && wid == 0 && nts < 64) { const unsigned long long _c = (unsigned long long)clock64(); \
        ts_lo = (lane == nts) ? (int)(unsigned)_c : ts_lo; ts_hi = (lane == nts) ? (int)(unsigned)(_c >> 32) : ts_hi; ++nts; } } while (0)
    PG8_STAMP();
    unsigned voffA[2], voffB[2];
#pragma unroll
    for (int i = 0; i < 2; ++i) { int R, C; stage_rc(tid * 16 + i * 8192, R, C); const int Rb = Epi::PERM ? ((R & ~31) + perm32(R & 31)) : R;
        voffA[i] = (unsigned)(R * K + C) * 2u; voffB[i] = (unsigned)(Rb * K + C) * 2u; }
    const size_t kstep = (size_t)(BK * 2);
    const size_t hstep = (size_t)HALF * K * 2;
    const size_t tstep = 2 * hstep;
    const unsigned ldsw = (unsigned)wid * 1024u;
    const int aoff = lds_byte(wr * 64 + fr, fq * 8), boff = lds_byte(wc * 32 + fr, fq * 8);
#define PG8_SA(b, h) (((b) * 2 + (h)) * HTB)
#define PG8_SB(b, h) ((4 + (b) * 2 + (h)) * HTB)
#define PG8_STAGE(bufoff, gbase, voff) do { _Pragma("unroll") for (int _i = 0; _i < 2; ++_i) \
        __builtin_amdgcn_global_load_lds((const unsigned*)((const char*)(gbase) + (voff)[_i]), (PG8_LAS unsigned*)(lds + (bufoff) + ldsw + _i * 8192), 16, 0, 0); } while (0)
#define PG8_LDA(dst, b, h) do { _Pragma("unroll") for (int m = 0; m < 4; ++m) _Pragma("unroll") for (int k = 0; k < 2; ++k) dst[m][k] = *(const PG8_LAS bf16x8*)(lds + PG8_SA(b, h) + aoff + m * 2048 + k * 1024); } while (0)
#define PG8_LDB(dst, b, h) do { _Pragma("unroll") for (int n = 0; n < 2; ++n) _Pragma("unroll") for (int k = 0; k < 2; ++k) dst[n][k] = *(const PG8_LAS bf16x8*)(lds + PG8_SB(b, h) + boff + n * 2048 + k * 1024); } while (0)
#define PG8_MMA(ai, bj, At, Bt) do { __builtin_amdgcn_s_setprio(1); _Pragma("unroll") for (int m = 0; m < 4; ++m) _Pragma("unroll") for (int n = 0; n < 2; ++n) _Pragma("unroll") for (int k = 0; k < 2; ++k) \
        acc[ai][bj][m][n] = __builtin_amdgcn_mfma_f32_16x16x32_bf16(Bt[n][k], At[m][k], acc[ai][bj][m][n], 0, 0, 0); __builtin_amdgcn_s_setprio(0); } while (0)
#define PG8_WAIT_V(n) asm volatile("s_waitcnt vmcnt(" #n ")" ::: "memory")
#define PG8_WAIT_L(n) asm volatile("s_waitcnt lgkmcnt(" #n ")" ::: "memory")
#define PG8_BAR __builtin_amdgcn_s_barrier()
#define PG8_SCHED __builtin_amdgcn_sched_barrier(0)
    Unit cur, nxt; int ui = 0;
    if (!S.next(0, cur)) return;
    f32x4 acc[2][2][4][2];
#pragma unroll
    for (int a = 0; a < 2; ++a)
#pragma unroll
        for (int b = 0; b < 2; ++b)
#pragma unroll
            for (int m = 0; m < 4; ++m)
#pragma unroll
                for (int n = 0; n < 2; ++n) acc[a][b][m][n] = (f32x4){0.f, 0.f, 0.f, 0.f};
    bf16x8 At[4][2], B0[2][2], B1[2][2];
    const char* cA = (const char*)g.A + (size_t)cur.pm * tstep; const char* cB = (const char*)g.Bt + (size_t)cur.pn * tstep;
    S.a_ready(cur);
    PG8_STAGE(PG8_SB(0, 0), cB, voffB); PG8_STAGE(PG8_SA(0, 0), cA, voffA); PG8_STAGE(PG8_SB(0, 1), cB + hstep, voffB); PG8_STAGE(PG8_SA(0, 1), cA + hstep, voffA);
    if (wr == 1) PG8_BAR;
    PG8_WAIT_V(4); PG8_BAR;
    PG8_STAGE(PG8_SB(1, 0), cB + kstep, voffB); PG8_STAGE(PG8_SA(1, 0), cA + kstep, voffA); PG8_STAGE(PG8_SB(1, 1), cB + hstep + kstep, voffB);
    PG8_WAIT_V(6); PG8_BAR;
    PG8_STAMP();
    for (;;) {
        const bool has_next = S.next(ui + 1, nxt);
        const char* nA = has_next ? (const char*)g.A + (size_t)nxt.pm * tstep : cA; const char* nB = has_next ? (const char*)g.Bt + (size_t)nxt.pn * tstep : cB;
        for (int t = 0; t < nt; t += 2) {
            const bool last = (t == nt - 2);
            const char* a1 = cA + (size_t)(t + 1) * kstep;
            const char* a2 = last ? nA : cA + (size_t)(t + 2) * kstep; const char* b2 = last ? nB : cB + (size_t)(t + 2) * kstep;
            const char* a3 = a2 + kstep; const char* b3 = b2 + kstep;
            if (last && has_next) S.a_ready(nxt);
            PG8_LDB(B0, 0, 0); PG8_SCHED; PG8_LDA(At, 0, 0); PG8_STAGE(PG8_SA(1, 1), a1 + hstep, voffA);
            PG8_WAIT_L(8); PG8_BAR; PG8_WAIT_L(0); PG8_MMA(0, 0, At, B0); PG8_BAR; PG8_SCHED;
            PG8_LDB(B1, 0, 1); PG8_STAGE(PG8_SB(0, 0), b2, voffB);
            PG8_BAR; PG8_WAIT_L(0); PG8_MMA(0, 1, At, B1); PG8_BAR;
            PG8_LDA(At, 0, 1); PG8_STAGE(PG8_SA(0, 0), a2, voffA);
            PG8_BAR; PG8_WAIT_L(0); PG8_MMA(1, 0, At, B0); PG8_BAR; PG8_SCHED;
            PG8_STAGE(PG8_SB(0, 1), b2 + hstep, voffB);
            PG8_WAIT_V(6); PG8_BAR; PG8_MMA(1, 1, At, B1); PG8_BAR;
            PG8_LDB(B0, 1, 0); PG8_SCHED; PG8_LDA(At, 1, 0); PG8_STAGE(PG8_SA(0, 1), a2 + hstep, voffA);
            PG8_WAIT_L(8); PG8_BAR; PG8_WAIT_L(0); PG8_MMA(0, 0, At, B0); PG8_BAR; PG8_SCHED;
            PG8_LDB(B1, 1, 1); PG8_STAGE(PG8_SB(1, 0), b3, voffB);
            PG8_BAR; PG8_WAIT_L(0); PG8_MMA(0, 1, At, B1); PG8_BAR;
            PG8_LDA(At, 1, 1); PG8_STAGE(PG8_SA(1, 0), a3, voffA);
            PG8_BAR; PG8_WAIT_L(0); PG8_MMA(1, 0, At, B0); PG8_BAR; PG8_SCHED;
            PG8_STAGE(PG8_SB(1, 1), b3 + hstep, voffB);
            PG8_WAIT_V(6); PG8_BAR; PG8_MMA(1, 1, At, B1); PG8_BAR;
        }
        PG8_STAMP();
        if constexpr (!Epi::AFTER_DRAIN) { E(acc, cur, wr, wc, fr, fq); S.done(cur); }
        PG8_STAMP();
        if (!has_next) break;
#pragma unroll
        for (int a = 0; a < 2; ++a)
#pragma unroll
            for (int b = 0; b < 2; ++b)
#pragma unroll
                for (int m = 0; m < 4; ++m)
#pragma unroll
                    for (int n = 0; n < 2; ++n) acc[a][b][m][n] = (f32x4){0.f, 0.f, 0.f, 0.f};
        cur = nxt; cA = nA; cB = nB; ++ui;
    }
    PG8_WAIT_V(0);
    if (wr == 0) PG8_BAR;
    PG8_BAR;
    if constexpr (Epi::AFTER_DRAIN) { E.fused(acc, cur, wr, wc, fr, fq, lds, wid, lane); S.done(cur); }
    PG8_STAMP();
    if (STAMP && wid == 0) { stamps[lane] = lane < nts ? (((unsigned long long)(unsigned)ts_hi << 32) | (unsigned)ts_lo) : 0ull;
        if (lane == 62) stamps[62] = rt_entry; if (lane == 63) stamps[63] = (unsigned long long)wall_clock64(); }
#undef PG8_STAMP
#undef PG8_SA
#undef PG8_SB
#undef PG8_STAGE
#undef PG8_LDA
#undef PG8_LDB
#undef PG8_MMA
#undef PG8_WAIT_V
#undef PG8_WAIT_L
#undef PG8_BAR
#undef PG8_SCHED
}
}
#define LDS_WAIT() asm volatile("s_waitcnt lgkmcnt(0)" ::: "memory")

__device__ __forceinline__ int map_row(int n, int mode) {
    if (mode == 1) { const int j = n < FF ? n : n - FF; return (j >> 7) * 256 + (n < FF ? 0 : 128) + (j & 127); }
    return n;
}
__device__ __forceinline__ void transpose_item(const float* __restrict__ W, int K, int N, bf16_t* WT, int mode, LAS float* scr, int item, int lane) {
    const int nblk = N / 32, kb = item / nblk, nb = item % nblk, k0 = 64 * kb, n0 = 32 * nb;
#pragma unroll 8
    for (int i = 0; i < 32; ++i) { const int kk = 2 * i + (lane >> 5); scr[kk * 33 + (lane & 31)] = W[(size_t)(k0 + kk) * N + n0 + (lane & 31)]; }
    LDS_WAIT(); asm volatile("" ::: "memory");
    const int c = lane & 7;
#pragma unroll
    for (int j = 0; j < 4; ++j) { const int n = (lane >> 3) + 8 * j; const LAS float* s = scr + (8 * c) * 33 + n;
        u32x4 o; o.x = cvt_pk_bf16(s[0 * 33], s[1 * 33]); o.y = cvt_pk_bf16(s[2 * 33], s[3 * 33]); o.z = cvt_pk_bf16(s[4 * 33], s[5 * 33]); o.w = cvt_pk_bf16(s[6 * 33], s[7 * 33]);
        *(u32x4*)(WT + (size_t)map_row(n0 + n, mode) * K + k0 + 8 * c) = o; }
    LDS_WAIT(); asm volatile("" ::: "memory");
}
constexpr int I_G = (DM / 64) * (2 * FF / 32), I_D = (FF / 64) * (DM / 32), I_IN = (DM / 64) * (9600 / 32), I_OUT = (DM / 64) * (DM / 32), I_Q = (1024 / 64) * (NQ / 32), I_KV = (512 / 64) * (NKV / 32);
constexpr int I_LAYER = 2 * I_G + 2 * I_D + I_IN + I_OUT + I_Q + I_KV;

__device__ __forceinline__ void phase0(const Frame& F, unsigned char* ws) {
    const int gw = F.bid * 8 + F.wave, NGW = F.G * 8;
    const size_t gt = (size_t)F.bid * 512 + F.tid, NGT = (size_t)F.G * 512;
    LAS float* scr = (LAS float*)(F.lds + F.wave * 8704);
    bf16_t* WB = (bf16_t*)(ws + WS_WB);
    for (int it = gw; it < NL * I_LAYER; it += NGW) {
        const int l = it / I_LAYER; int r = it - l * I_LAYER; bf16_t* wl = WB + (size_t)l * W_LAYER;
        if (r < I_G) { transpose_item(IN_(10) + (size_t)l * DM * 2 * FF, DM, 2 * FF, wl + W_G1, 1, scr, r, F.lane); continue; } r -= I_G;
        if (r < I_D) { transpose_item(IN_(11) + (size_t)l * FF * DM, FF, DM, wl + W_D1, 0, scr, r, F.lane); continue; } r -= I_D;
        if (r < I_G) { transpose_item(IN_(12) + (size_t)l * DM * 2 * FF, DM, 2 * FF, wl + W_G2, 1, scr, r, F.lane); continue; } r -= I_G;
        if (r < I_D) { transpose_item(IN_(13) + (size_t)l * FF * DM, FF, DM, wl + W_D2, 0, scr, r, F.lane); continue; } r -= I_D;
        if (r < I_IN) { transpose_item(IN_(14) + (size_t)l * DM * 9600, DM, 9600, wl + W_IN, 0, scr, r, F.lane); continue; } r -= I_IN;
        if (r < I_OUT) { transpose_item(IN_(15) + (size_t)l * DM * DM, DM, DM, wl + W_OUT, 0, scr, r, F.lane); continue; } r -= I_OUT;
        if (r < I_Q) { transpose_item(IN_(39) + (size_t)l * 1024 * NQ, 1024, NQ, wl + W_Q, 0, scr, r, F.lane); continue; } r -= I_Q;
        transpose_item(IN_(41) + (size_t)l * 512 * NKV, 512, NKV, wl + W_KV, 0, scr, r, F.lane);
    }
    for (size_t i = gt; i < (size_t)NL * 128 * 512; i += NGT) {
        const int l = (int)(i / (128 * 512)), rr = (int)((i / 512) % 128), c = (int)(i % 512);
        const int row = 9600 + rr;
        *(u32x4*)(WB + (size_t)l * W_LAYER + W_IN + (size_t)row * DM + c * 8) = (u32x4){0u, 0u, 0u, 0u};
    }
    { bf16_t* WLR = (bf16_t*)(ws + WS_WLR); const float* wu = IN_(18); const float* au = IN_(20); const float* gu = IN_(21);
      for (size_t i = gt; i < (size_t)NL * 448 * A_W; i += NGT) { const int l = (int)(i / (448 * A_W)), k = (int)((i / A_W) % 448), col = (int)(i % A_W);
          float v;
          if (k < 128) v = wu[(((size_t)l * 2 + (k >> 6)) * 64 + (k & 63)) * A_W + col];
          else if (k < 256) v = au[(((size_t)l * 2 + ((k - 128) >> 6)) * 64 + (k & 63)) * A_W + col];
          else v = gu[((size_t)l * 192 + (k - 256)) * A_W + col];
          WLR[((size_t)l * A_W + col) * 448 + k] = (bf16_t)(cvt_pk_bf16(v, v) & 0xffffu); } }
    { f32x4* xs = (f32x4*)(ws + WS_XS); const f32x4* cx = (const f32x4*)IN_(2); const f32x4* xx = (const f32x4*)IN_(0);
      for (size_t i = gt; i < (size_t)T * DM / 4; i += NGT) xs[i] = i < (size_t)NCTX * DM / 4 ? cx[i] : xx[i - (size_t)NCTX * DM / 4]; }
    { float* HP = (float*)(ws + WS_HP);
      for (int it = F.bid; it < NL * 16; it += F.G) { const int l = it >> 4, ch = it & 15, w = F.tid >> 8, j = F.tid & 255;
          const float* cv = w ? IN_(3) : IN_(1); const float* ad = IN_(4) + ((size_t)l * DM + ch * 256) * 256 + j; float s = 0.f;
          for (int i = 0; i < 256; ++i) s += siluf_(cv[ch * 256 + i]) * ad[(size_t)i * 256];
          HP[((l * 16 + ch) * 2 + w) * 256 + j] = s; } }
    { float* H3 = (float*)(ws + WS_H3);
      LAS float* zb = (LAS float*)(F.lds + 73728); LAS float* ha = zb + 8 * 36; LAS float* hb = ha + 8 * 64;
      for (int it = F.bid; it < NL * (T / 8); it += F.G) { const int l = it / (T / 8), pb = it % (T / 8);
          if (F.tid < 8 * 33) { const int p = F.tid / 33, i = F.tid % 33, P = pb * 8 + p; const int L = P < NCTX ? NCTX : SEQ, t = P < NCTX ? P : P - NCTX;
              float z;
              if (i == 0) z = (float)t / (float)(L - 1);
              else { const int b = (i - 1) & 15; const float fb = 1e-4f + (float)b * ((15.0f - 1e-4f) / 15.0f); const float rev2 = 2.0f * fb * (float)t / (float)L;
                  z = i <= 16 ? cospif(rev2) : -sinpif(rev2); }
              zb[p * 36 + i] = z; }
          __syncthreads();
          const int p = F.tid >> 6, j = F.tid & 63; const float fq = IN_(36)[l * 64 + j];
          { const float* w1 = IN_(29) + (size_t)l * 33 * 64 + j; float s = IN_(30)[l * 64 + j];
            for (int i = 0; i < 33; ++i) s += zb[p * 36 + i] * w1[i * 64];
            ha[p * 64 + j] = sinf(fq * s); }
          __syncthreads();
          { const float* w2 = IN_(31) + (size_t)l * 64 * 64 + j; float s = IN_(32)[l * 64 + j];
            for (int i = 0; i < 64; ++i) s += ha[p * 64 + i] * w2[i * 64];
            hb[p * 64 + j] = sinf(fq * s); }
          __syncthreads();
          { const float* w3 = IN_(33) + (size_t)l * 64 * 64 + j; float s = IN_(34)[l * 64 + j];
            for (int i = 0; i < 64; ++i) s += hb[p * 64 + i] * w3[i * 64];
            ((bf16_t*)H3)[((size_t)l * 64 + j) * T + pb * 8 + p] = (bf16_t)(cvt_pk_bf16(sinf(fq * s), 0.f) & 0xffffu); }
          __syncthreads(); } }
}
__device__ __forceinline__ void phase_mod(const Frame& F, unsigned char* ws) {
    const float* HP = (const float*)(ws + WS_HP); float* MOD = (float*)(ws + WS_MOD);
    LAS float* hs = (LAS float*)F.lds;
    for (int it = F.bid; it < NL * (NMOD / 512); it += F.G) { const int l = it / (NMOD / 512), nb = it % (NMOD / 512);
        { const int w = F.tid >> 8, j = F.tid & 255; float s = 0.f;
          for (int ch = 0; ch < 16; ++ch) s += HP[((l * 16 + ch) * 2 + w) * 256 + j];
          hs[w * 256 + j] = s; }
        __syncthreads();
        const int n = nb * 512 + F.tid; const float* au = IN_(5) + (size_t)l * 256 * NMOD + n; float s0 = IN_(6)[(size_t)l * NMOD + n], s1 = s0;
        for (int j = 0; j < 256; ++j) { const float u = au[(size_t)j * NMOD]; s0 += hs[j] * u; s1 += hs[256 + j] * u; }
        MOD[((size_t)l * 2 + 0) * NMOD + n] = s0; MOD[((size_t)l * 2 + 1) * NMOD + n] = s1;
        __syncthreads(); }
}
__device__ __forceinline__ void norm_phase(const Frame& F, float* XS, const float* __restrict__ gain, const float* modx, const float* modc, int ish, int isc, bf16_t* out, const bf16_t* slab, const float* sgate, float sfac) {
    const int gw = F.bid * 8 + F.wave, NGW = F.G * 8;
    int row_lo = 0;
    if (slab) { row_lo = NCTX;
        LAS float* red = (LAS float*)F.lds;
        for (int row = F.bid; row < NCTX; row += F.G) { const size_t o = (size_t)row * DM + F.wave * 512;
            f32x4 v[2]; float s = 0.f;
#pragma unroll
            for (int j = 0; j < 2; ++j) { f32x4 acc = (f32x4){0.f, 0.f, 0.f, 0.f};
#pragma unroll
                for (int ks = 0; ks < 16; ++ks) acc += bf4f(((const u32x2*)(slab + (size_t)ks * NCTX * DM + o) + F.lane)[64 * j]);
                v[j] = ((const f32x4*)(XS + o) + F.lane)[64 * j] + acc * ((const f32x4*)(sgate + F.wave * 512) + F.lane)[64 * j] * sfac;
                ((f32x4*)(XS + o) + F.lane)[64 * j] = v[j]; s += (v[j].x * v[j].x + v[j].y * v[j].y) + (v[j].z * v[j].z + v[j].w * v[j].w); }
            s = wave_sum(s); if (F.lane == 0) red[F.wave] = s;
            __syncthreads();
            float tot = 0.f;
#pragma unroll
            for (int w = 0; w < 8; ++w) tot += red[w];
            const float rstd = rsqrtf(tot * (1.0f / DM) + NORM_EPS);
#pragma unroll
            for (int j = 0; j < 2; ++j) { const int c4 = F.wave * 128 + F.lane + 64 * j;
                const f32x4 y = v[j] * rstd * ((const f32x4*)gain)[c4] * (((const f32x4*)(modc + (size_t)isc * DM))[c4] + 1.0f) + ((const f32x4*)(modc + (size_t)ish * DM))[c4];
                u32x2 w2; w2.x = cvt_pk_bf16(y.x, y.y); w2.y = cvt_pk_bf16(y.z, y.w); ((u32x2*)(out + (size_t)row * DM))[c4] = w2; }
            __syncthreads(); } }
    for (int row = row_lo + gw; row < T; row += NGW) {
        const float* mod = row < NCTX ? modc : modx;
        const f32x4* xr = (const f32x4*)(XS + (size_t)row * DM) + F.lane; const f32x4* g4 = (const f32x4*)gain + F.lane;
        const f32x4* sh4 = (const f32x4*)(mod + (size_t)ish * DM) + F.lane; const f32x4* sc4 = (const f32x4*)(mod + (size_t)isc * DM) + F.lane;
        f32x4 v[16]; float s = 0.f;
#pragma unroll
        for (int j = 0; j < 16; ++j) { v[j] = xr[64 * j]; s += (v[j].x * v[j].x + v[j].y * v[j].y) + (v[j].z * v[j].z + v[j].w * v[j].w); }
        const float rstd = rsqrtf(wave_sum(s) * (1.0f / DM) + NORM_EPS);
        u32x2* o = (u32x2*)(out + (size_t)row * DM) + F.lane;
#pragma unroll
        for (int j = 0; j < 16; ++j) { const f32x4 y = v[j] * rstd * g4[64 * j] * (sc4[64 * j] + 1.0f) + sh4[64 * j];
            u32x2 w; w.x = cvt_pk_bf16(y.x, y.y); w.y = cvt_pk_bf16(y.z, y.w); o[64 * j] = w; }
    }
}
__device__ __forceinline__ float conv3_at(const bf16_t* PX, int tau, int col, float w0, float w1, float w2) {
    const bf16_t* p = PX + (size_t)tau * PXW + col;
    const bool hl = has_left(tau), hr = has_right(tau);
    return bf2f(p[0]) * w1 + bf2f(p[hl ? -PXW : 0]) * (hl ? w0 : 0.f) + bf2f(p[hr ? PXW : 0]) * (hr ? w2 : 0.f);
}
__device__ __forceinline__ float rope_apply(float val, int tau, int j) {
    const int pos = tau - NCTX, prow = pos >> 6, pcol = pos & 63;
    const float inv = __powf(10000.0f, -(float)(j & 15) * (1.0f / 16.0f));
    const float ang = (float)(j < 32 ? prow : pcol) * inv;
    float sn, cs; sincosf(ang, &sn, &cs);
    const float partner = __shfl_xor(val, 16);
    const float rot = (j & 16) ? partner : -partner;
    return val * cs + rot * sn;
}
__device__ __forceinline__ void mla_prep_phase(const Frame& F, unsigned char* ws, int l) {
    const bf16_t* PX = (const bf16_t*)(ws + WS_PX); bf16_t* QA = (bf16_t*)(ws + WS_QA); bf16_t* KVA = (bf16_t*)(ws + WS_KVA); bf16_t* KPE = (bf16_t*)(ws + WS_KPE);
    const int gw = F.bid * 8 + F.wave, NGW = F.G * 8;
    const f32x4* gq = (const f32x4*)(IN_(38) + l * 1024) + F.lane; const f32x4* gkv = (const f32x4*)(IN_(40) + l * 512) + F.lane; const float gpe = IN_(45)[l * 64 + F.lane];
    for (int tau = gw; tau < T; tau += NGW) {
        const u32x2* p = (const u32x2*)(PX + (size_t)tau * PXW + PXC) + F.lane;
        f32x4 q[4], kv[2]; float sq = 0.f, skv = 0.f;
#pragma unroll
        for (int j = 0; j < 4; ++j) { q[j] = bf4f(p[64 * j]); sq += (q[j].x * q[j].x + q[j].y * q[j].y) + (q[j].z * q[j].z + q[j].w * q[j].w); }
#pragma unroll
        for (int j = 0; j < 2; ++j) { kv[j] = bf4f(p[256 + 64 * j]); skv += (kv[j].x * kv[j].x + kv[j].y * kv[j].y) + (kv[j].z * kv[j].z + kv[j].w * kv[j].w); }
        const float pe = bf2f(PX[(size_t)tau * PXW + PXC + 1536 + F.lane]);
        const float rq = rsqrtf(wave_sum(sq) * (1.0f / 1024.0f) + NORM_EPS), rkv = rsqrtf(wave_sum(skv) * (1.0f / 512.0f) + NORM_EPS), rpe = rsqrtf(wave_sum(pe * pe) * (1.0f / 64.0f) + NORM_EPS);
        u32x2* oq = (u32x2*)(QA + (size_t)tau * 1024) + F.lane; u32x2* okv = (u32x2*)(KVA + (size_t)tau * 512) + F.lane;
#pragma unroll
        for (int j = 0; j < 4; ++j) { const f32x4 y = q[j] * rq * gq[64 * j]; u32x2 w; w.x = cvt_pk_bf16(y.x, y.y); w.y = cvt_pk_bf16(y.z, y.w); oq[64 * j] = w; }
#pragma unroll
        for (int j = 0; j < 2; ++j) { const f32x4 y = kv[j] * rkv * gkv[64 * j]; u32x2 w; w.x = cvt_pk_bf16(y.x, y.y); w.y = cvt_pk_bf16(y.z, y.w); okv[64 * j] = w; }
        float kp = pe * rpe * gpe;
        if (tau >= NCTX) kp = rope_apply(kp, tau, F.lane);
        KPE[(size_t)tau * 64 + F.lane] = (bf16_t)(cvt_pk_bf16(kp, kp) & 0xffffu);
    }
}
__device__ __forceinline__ void qkv_final_phase(const Frame& F, unsigned char* ws, int l, bool need_ctx) {
    const bf16_t* QRAW = (const bf16_t*)(ws + WS_QRAW); const bf16_t* KVRAW = (const bf16_t*)(ws + WS_KVRAW); const bf16_t* KPE = (const bf16_t*)(ws + WS_KPE);
    bf16_t* QF = (bf16_t*)(ws + WS_QF); bf16_t* KF = (bf16_t*)(ws + WS_KF);
    const int gw = F.bid * 8 + F.wave, NGW = F.G * 8, ln = F.lane;
    const float gqn0 = IN_(42)[l * 128 + 2 * ln], gqn1 = IN_(42)[l * 128 + 2 * ln + 1], gqp = IN_(43)[l * 64 + ln];
    const float gkn0 = IN_(44)[l * 128 + 2 * ln], gkn1 = IN_(44)[l * 128 + 2 * ln + 1];
    (void)need_ctx;
    for (int tau = gw; tau < T; tau += NGW) {
        float cs = 1.f, sn = 0.f;
        if (tau >= NCTX) { const int pos = tau - NCTX, prow = pos >> 6, pcol = pos & 63; const float inv = __powf(10000.0f, -(float)(ln & 15) * (1.0f / 16.0f)); sincosf((float)(ln < 32 ? prow : pcol) * inv, &sn, &cs); }
        const bf16_t kpe = KPE[(size_t)tau * 64 + ln];
        const bf16_t* qrow = QRAW + (size_t)tau * NQ; const bf16_t* krow = KVRAW + (size_t)tau * NKV;
        unsigned qn[NHC], kn[NHC]; bf16_t qpv[NHC];
#pragma unroll
        for (int h = 0; h < NHC; ++h) { qn[h] = *(const unsigned*)(qrow + h * 192 + 2 * ln); qpv[h] = qrow[h * 192 + 128 + ln]; kn[h] = *(const unsigned*)(krow + h * 256 + 2 * ln); }
#pragma unroll
        for (int h = 0; h < NHC; ++h) {
            const float q0 = bf2f((unsigned short)(qn[h] & 0xffffu)), q1 = bf2f((unsigned short)(qn[h] >> 16)), qp = bf2f(qpv[h]), k0 = bf2f((unsigned short)(kn[h] & 0xffffu)), k1 = bf2f((unsigned short)(kn[h] >> 16));
            const float rqn = rsqrtf(wave_sum(q0 * q0 + q1 * q1) * (1.0f / 128.0f) + NORM_EPS), rqp = rsqrtf(wave_sum(qp * qp) * (1.0f / 64.0f) + NORM_EPS), rkn = rsqrtf(wave_sum(k0 * k0 + k1 * k1) * (1.0f / 128.0f) + NORM_EPS);
            float qpe = qp * rqp * gqp;
            { const float partner = __shfl_xor(qpe, 16); const float rot = (ln & 16) ? partner : -partner; qpe = qpe * cs + rot * sn; }
            *(unsigned*)(QF + (size_t)tau * NQ + h * 192 + 2 * ln) = cvt_pk_bf16(q0 * rqn * gqn0, q1 * rqn * gqn1);
            QF[(size_t)tau * NQ + h * 192 + 128 + ln] = (bf16_t)(cvt_pk_bf16(qpe, qpe) & 0xffffu);
            *(unsigned*)(KF + (size_t)tau * NQ + h * 192 + 2 * ln) = cvt_pk_bf16(k0 * rkn * gkn0, k1 * rkn * gkn1);
            KF[(size_t)tau * NQ + h * 192 + 128 + ln] = kpe; }
    }
}
__device__ __forceinline__ void rwkv_out_phase(const Frame& F, unsigned char* ws, int l, bool need_ctx) {
    const float* SS = (const float*)(ws + WS_SS); const float* SD = (const float*)(ws + WS_SD); const float* GB = (const float*)(ws + WS_G); const float* Y = (const float*)(ws + WS_Y);
    bf16_t* OB = (bf16_t*)(ws + WS_OBUF);
    const int gw = F.bid * 8 + F.wave, NGW = F.G * 8, ln = F.lane;
    for (int it = (need_ctx ? 0 : NCTX * 5) + gw; it < T * 5; it += NGW) { const int tau = it / 5, h0 = (it % 5) * 4;
        float y0[4], y1[4], r[4], v[4], ka[4], kb[4], g[4];
#pragma unroll
        for (int q = 0; q < 4; ++q) { const int h = h0 + q, col = h * 64 + ln; const size_t o = (size_t)tau * A_W + col;
            y0[q] = Y[o]; y1[q] = Y[(size_t)T * A_W + o]; r[q] = SS[o]; v[q] = SS[(size_t)T * A_W + o];
            ka[q] = SD[o]; kb[q] = SD[(size_t)T * A_W + o]; g[q] = GB[o]; }
#pragma unroll
        for (int q = 0; q < 4; ++q) { const int col = (h0 + q) * 64 + ln;
            const float y = y0[q] + y1[q];
            const float mu = wave_sum(y) * (1.0f / 64.0f); const float dy = y - mu; const float var = wave_sum(dy * dy) * (1.0f / 64.0f);
            const float yn = dy * rsqrtf(var + GN_EPS) * IN_(25)[l * A_W + col] + IN_(26)[l * A_W + col];
            const float bonus = wave_sum(r[q] * (0.5f * (ka[q] + kb[q])) * IN_(24)[l * A_W + col]) * v[q];
            const float ov = (yn + bonus) * g[q];
            OB[(size_t)tau * DM + col] = (bf16_t)(cvt_pk_bf16(ov, ov) & 0xffffu); }
    }
}
__device__ __forceinline__ void hyena_prep_phase(const Frame& F, unsigned char* ws, int l) {
    const bf16_t* PX = (const bf16_t*)(ws + WS_PX); float* GT = (float*)(ws + WS_GT); float* X0T = (float*)(ws + WS_X0T);
    LAS float* LGt = (LAS float*)F.lds; LAS float* LX0 = LGt + 64 * 65;
    const float* cw = IN_(27) + (size_t)l * 3 * B_IN; const float* cb = IN_(28) + (size_t)l * B_IN;
    for (int it = F.bid; it < (T / 64) * 20; it += F.G) { const int tt = it / 20, ct = it % 20;
        { const int t = F.tid >> 3, c0 = ct * 64 + (F.tid & 7) * 8, tau = tt * 64 + t;
          f32x4 u[3][2];
#pragma unroll
          for (int grp = 0; grp < 3; ++grp)
#pragma unroll
              for (int q = 0; q < 2; ++q) { const int c = grp * 1280 + c0 + 4 * q; const bf16_t* p = PX + (size_t)tau * PXW + PXB + c;
                  const bool hl = has_left(tau), hr = has_right(tau);
                  const f32x4 y = bf4f(*(const u32x2*)p) * *(const f32x4*)(cw + B_IN + c) + *(const f32x4*)(cb + c) + bf4f(*(const u32x2*)(p - (hl ? PXW : 0))) * (*(const f32x4*)(cw + c) * (hl ? 1.f : 0.f))
                                + bf4f(*(const u32x2*)(p + (hr ? PXW : 0))) * (*(const f32x4*)(cw + 2 * B_IN + c) * (hr ? 1.f : 0.f));
                  u[grp][q] = y; }
#pragma unroll
          for (int q = 0; q < 2; ++q)
#pragma unroll
              for (int e = 0; e < 4; ++e) { const int ch = (F.tid & 7) * 8 + 4 * q + e; LGt[ch * 65 + t] = u[1][q][e] * u[2][q][e]; LX0[ch * 65 + t] = u[0][q][e]; } }
        __syncthreads();
        { const int ch = F.tid >> 3, t0 = (F.tid & 7) * 8; const size_t o = (size_t)(ct * 64 + ch) * T + tt * 64 + t0;
          f32x4 a0, a1, b0, b1;
#pragma unroll
          for (int e = 0; e < 4; ++e) { a0[e] = LGt[ch * 65 + t0 + e]; a1[e] = LGt[ch * 65 + t0 + 4 + e]; b0[e] = LX0[ch * 65 + t0 + e]; b1[e] = LX0[ch * 65 + t0 + 4 + e]; }
          *(f32x4*)(GT + o) = a0; *(f32x4*)(GT + o + 4) = a1; *(f32x4*)(X0T + o) = b0; *(f32x4*)(X0T + o + 4) = b1; }
        __syncthreads(); }
}
__device__ __forceinline__ void hyena_out_phase(const Frame& F, unsigned char* ws, bool need_ctx) {
    const float* YT = (const float*)(ws + WS_GT); bf16_t* OB = (bf16_t*)(ws + WS_OBUF);
    LAS float* L = (LAS float*)F.lds;
    const int it0 = need_ctx ? 0 : (NCTX / 64) * 20;
    for (int it = it0 + F.bid; it < (T / 64) * 20; it += F.G) { const int tt = it / 20, ct = it % 20;
        { const int ch = F.tid >> 3, t0 = (F.tid & 7) * 8; const size_t o = (size_t)(ct * 64 + ch) * T + tt * 64 + t0;
          const f32x4 a0 = *(const f32x4*)(YT + o), a1 = *(const f32x4*)(YT + o + 4);
#pragma unroll
          for (int e = 0; e < 4; ++e) { L[ch * 65 + t0 + e] = a0[e]; L[ch * 65 + t0 + 4 + e] = a1[e]; } }
        __syncthreads();
        { const int t = F.tid >> 3, c0 = (F.tid & 7) * 8; float x[8];
#pragma unroll
          for (int e = 0; e < 8; ++e) x[e] = L[(c0 + e) * 65 + t];
          u32x4 w; w.x = cvt_pk_bf16(x[0], x[1]); w.y = cvt_pk_bf16(x[2], x[3]); w.z = cvt_pk_bf16(x[4], x[5]); w.w = cvt_pk_bf16(x[6], x[7]);
          *(u32x4*)(OB + (size_t)(tt * 64 + t) * DM + 1280 + ct * 64 + c0) = w; }
        __syncthreads(); }
}
namespace att {
constexpr int DK = 192, DV = 128, NW = 8, QBLK = 32, KVBLK = 64;
constexpr float SCALE = 0.07216878364870322f;
constexpr float THR = 8.f;
#ifndef ATT_SDEPTH
#define ATT_SDEPTH 2
#endif
constexpr int SDEPTH = ATT_SDEPTH;
constexpr int LDQ = 2304, LDK = 2304, LDV = 3072, LDO = 4096;
constexpr int SHM_V = KVBLK * DV * 2, SHM_K = KVBLK * DK * 2, SHM_ATTN = 2 * SHM_V + 2 * SHM_K + NW * 64 * 4 + NW * 4096;
using bf16x8 = __attribute__((ext_vector_type(8))) short;
using s16x4  = __attribute__((ext_vector_type(4))) short;
using f32x16 = __attribute__((ext_vector_type(16))) float;
using u32x4  = __attribute__((ext_vector_type(4))) unsigned;
#define KSWZ(row, colB) ((row) * 384 + ((colB) ^ (((row) & 7) << 4)))
#define SBAR() __builtin_amdgcn_sched_barrier(0)
__device__ __forceinline__ int crow(int r, int hi) { return (r & 3) + 8 * (r >> 2) + 4 * hi; }
__device__ __forceinline__ unsigned cvtpk(float lo, float hi) { unsigned r; asm volatile("v_cvt_pk_bf16_f32 %0, %1, %2" : "=v"(r) : "v"(lo), "v"(hi)); return r; }
__device__ __forceinline__ void partialSM(f32x16& p0, f32x16& p1, float& m_reg, float& mn, float& alpha) {
  constexpr float C = SCALE * 1.4426950408889634f;
  float pmax = p0[0]; for (int r = 1; r < 16; ++r) pmax = fmaxf(pmax, p0[r]); for (int r = 0; r < 16; ++r) pmax = fmaxf(pmax, p1[r]);
  { auto rr = __builtin_amdgcn_permlane32_swap(__float_as_uint(pmax), __float_as_uint(pmax), false, false);
    pmax = fmaxf(__uint_as_float(rr[0]), __uint_as_float(rr[1])); }
  if (__builtin_expect(__all(pmax - m_reg <= THR / SCALE), 1)) { mn = m_reg; alpha = 1.f; }
  else { mn = fmaxf(m_reg, pmax); alpha = __builtin_amdgcn_exp2f((m_reg - mn) * C); m_reg = mn; }
  float mnC = -mn * C;
  for (int r = 0; r < 16; ++r) p0[r] = fmaf(p0[r], C, mnC); for (int r = 0; r < 16; ++r) p1[r] = fmaf(p1[r], C, mnC);
  for (int r = 0; r < 16; ++r) p0[r] = __builtin_amdgcn_exp2f(p0[r]);
}
__device__ __forceinline__ void finishSM(f32x16& p0, f32x16& p1, float alpha, float& l_reg, bf16x8& pa0, bf16x8& pa1, bf16x8& pa2, bf16x8& pa3) {
  for (int r = 0; r < 16; ++r) p1[r] = __builtin_amdgcn_exp2f(p1[r]);
  float ps = 0; for (int r = 0; r < 16; ++r) ps += p0[r]; for (int r = 0; r < 16; ++r) ps += p1[r];
  { auto rr = __builtin_amdgcn_permlane32_swap(__float_as_uint(ps), __float_as_uint(ps), false, false);
    ps = __uint_as_float(rr[0]) + __uint_as_float(rr[1]); }
  l_reg = l_reg * alpha + ps;
#define PK4(P, BASE, OUT) do { unsigned a0 = cvtpk(P[BASE + 0], P[BASE + 1]), a1 = cvtpk(P[BASE + 2], P[BASE + 3]);   \
    unsigned b0 = cvtpk(P[BASE + 4], P[BASE + 5]), b1 = cvtpk(P[BASE + 6], P[BASE + 7]);                              \
    auto r0 = __builtin_amdgcn_permlane32_swap(a0, b0, false, false); auto r1 = __builtin_amdgcn_permlane32_swap(a1, b1, false, false); \
    u32x4 w = {r0[0], r1[0], r0[1], r1[1]}; OUT = *reinterpret_cast<bf16x8*>(&w); } while (0)
  PK4(p0, 0, pa0); PK4(p0, 8, pa1); PK4(p1, 0, pa2); PK4(p1, 8, pa3);
#undef PK4
}
__device__ __forceinline__ void qkt(f32x16& p0, f32x16& p1, const char* Ks, const bf16x8* qr, const char* qrl, int r32, int hi) {
  p0 = f32x16{}; p1 = f32x16{};
#pragma unroll
  for (int d0 = 0; d0 < 8; ++d0) { int cb = (d0 * 16 + hi * 8) * 2;
    bf16x8 b0 = *reinterpret_cast<const bf16x8*>(Ks + KSWZ(r32, cb));
    bf16x8 b1 = *reinterpret_cast<const bf16x8*>(Ks + KSWZ(32 + r32, cb));
    p0 = __builtin_amdgcn_mfma_f32_32x32x16_bf16(b0, qr[d0], p0, 0, 0, 0);
    p1 = __builtin_amdgcn_mfma_f32_32x32x16_bf16(b1, qr[d0], p1, 0, 0, 0); }
#pragma unroll
  for (int d0 = 8; d0 < 12; ++d0) { int cb = (d0 * 16 + hi * 8) * 2;
    bf16x8 b0 = *reinterpret_cast<const bf16x8*>(Ks + KSWZ(r32, cb));
    bf16x8 b1 = *reinterpret_cast<const bf16x8*>(Ks + KSWZ(32 + r32, cb));
    const bf16x8 q = *reinterpret_cast<const bf16x8*>(qrl + ((((d0 - 8) * 2 + hi) ^ (r32 & 7)) << 4));
    p0 = __builtin_amdgcn_mfma_f32_32x32x16_bf16(b0, q, p0, 0, 0, 0);
    p1 = __builtin_amdgcn_mfma_f32_32x32x16_bf16(b1, q, p1, 0, 0, 0); }
}
__device__ __forceinline__ int v_st(int k, int c) { const int kk = (k & ~0xC) | ((k & 4) << 1) | ((k & 8) >> 1); return ((kk >> 3) * 4 + (c >> 5)) * 512 + ((kk & 7) * 32 + (c & 31)) * 2; }
__device__ __forceinline__ int v_rd_base(int lane) { return ((lane & 3) << 3) | (((lane >> 2) & 3) << 6) | (((lane >> 4) & 1) << 5) | (((lane >> 5) & 1) << 8); }
constexpr int v_rd_off(int d0, int ks, int half) { return d0 * 512 + ks * 4096 + half * 2048; }
template <int OFF> __device__ __forceinline__ s16x4 tr_read(int vb) {
  s16x4 r; asm volatile("ds_read_b64_tr_b16 %0, %1 offset:%2" : "=&v"(r) : "v"(vb), "i"(OFF) : "memory"); return r;
}
template <int D0> __device__ __forceinline__ void pv_one(f32x16& od, int vb, bf16x8 pa0, bf16x8 pa1, bf16x8 pa2, bf16x8 pa3) {
  const s16x4 l0 = tr_read<v_rd_off(D0, 0, 0)>(vb), h0 = tr_read<v_rd_off(D0, 0, 1)>(vb), l1 = tr_read<v_rd_off(D0, 1, 0)>(vb), h1 = tr_read<v_rd_off(D0, 1, 1)>(vb);
  const s16x4 l2 = tr_read<v_rd_off(D0, 2, 0)>(vb), h2 = tr_read<v_rd_off(D0, 2, 1)>(vb), l3 = tr_read<v_rd_off(D0, 3, 0)>(vb), h3 = tr_read<v_rd_off(D0, 3, 1)>(vb);
  asm volatile("s_waitcnt lgkmcnt(0)" ::: "memory"); SBAR();
#define PK(L, H) (bf16x8){L[0], L[1], L[2], L[3], H[0], H[1], H[2], H[3]}
  od = __builtin_amdgcn_mfma_f32_32x32x16_bf16(pa0, PK(l0, h0), od, 0, 0, 0);
  od = __builtin_amdgcn_mfma_f32_32x32x16_bf16(pa1, PK(l1, h1), od, 0, 0, 0);
  od = __builtin_amdgcn_mfma_f32_32x32x16_bf16(pa2, PK(l2, h2), od, 0, 0, 0);
  od = __builtin_amdgcn_mfma_f32_32x32x16_bf16(pa3, PK(l3, h3), od, 0, 0, 0);
#undef PK
}
__device__ __forceinline__ void pv_d0(f32x16* o, int vb, bf16x8 pa0, bf16x8 pa1, bf16x8 pa2, bf16x8 pa3) {
  pv_one<0>(o[0], vb, pa0, pa1, pa2, pa3); pv_one<1>(o[1], vb, pa0, pa1, pa2, pa3); pv_one<2>(o[2], vb, pa0, pa1, pa2, pa3); pv_one<3>(o[3], vb, pa0, pa1, pa2, pa3);
}
__device__ __forceinline__ void attn_body(const bf16_t* __restrict__ Qb, const bf16_t* __restrict__ Kh, const bf16_t* __restrict__ Vh, bf16_t* __restrict__ Ob, int seq, char* lds) {
  int tid_ = threadIdx.x; asm volatile("" : "+v"(tid_));
  const int tid = tid_, wid = tid >> 6, lane = tid & 63, r32 = lane & 31, hi = lane >> 5;
  char* V_lds = lds; char* K_lds = lds + 2 * SHM_V;
  float* ws = (float*)(lds + 2 * SHM_V + 2 * SHM_K) + wid * 64; float* li_l = ws; float* al_l = ws + 32;
  float m_reg = -1e30f, l_reg = 0; f32x16 o[4] = {}; bf16x8 qr[8];
  const bf16_t* Qw = Qb + (long)(wid * QBLK + r32) * LDQ + hi * 8;
  char* qrl = lds + 2 * SHM_V + 2 * SHM_K + NW * 64 * 4 + wid * 4096 + r32 * 128;
#pragma unroll
  for (int d0 = 0; d0 < 8; ++d0) qr[d0] = *reinterpret_cast<const bf16x8*>(Qw + d0 * 16);
#pragma unroll
  for (int d0 = 8; d0 < 12; ++d0) *reinterpret_cast<bf16x8*>(qrl + ((((d0 - 8) * 2 + hi) ^ (r32 & 7)) << 4)) = *reinterpret_cast<const bf16x8*>(Qw + d0 * 16);
  asm volatile("s_waitcnt lgkmcnt(0)" ::: "memory");
  unsigned kgo[3], vgo[2];
#pragma unroll
  for (int i = 0; i < 3; ++i) { const int p = (i * 8 + wid) * 64 + lane, row = p / 24, slot = p % 24, ch = slot ^ (row & 7); kgo[i] = (unsigned)(row * LDK + ch * 8) * 2u; }
#pragma unroll
  for (int i = 0; i < 2; ++i) { const int p = (i * 8 + wid) * 64 + lane, sub = p >> 5, within = p & 31, kk = (sub >> 2) * 8 + (within >> 2), c = (sub & 3) * 32 + (within & 3) * 8;
    const int k = (kk & ~0xC) | ((kk & 4) << 1) | ((kk & 8) >> 1); vgo[i] = (unsigned)(k * LDV + c) * 2u; }
  const int vb0 = (int)(uintptr_t)V_lds + v_rd_base(lane);
  typedef __attribute__((address_space(3))) unsigned lds_u32;
#define DMA_K(b, k0) do { const char* kg = (const char*)Kh + (size_t)(k0) * (LDK * 2); \
    _Pragma("unroll") for (int _i = 0; _i < 3; ++_i) __builtin_amdgcn_global_load_lds((const unsigned*)(kg + kgo[_i]), (lds_u32*)(K_lds + (b) * SHM_K + (_i * 8 + wid) * 1024), 16, 0, 0); } while (0)
#define DMA_V(b, k0) do { const char* vg = (const char*)Vh + (size_t)(k0) * (LDV * 2); \
    _Pragma("unroll") for (int _i = 0; _i < 2; ++_i) __builtin_amdgcn_global_load_lds((const unsigned*)(vg + vgo[_i]), (lds_u32*)(V_lds + (b) * SHM_V + (_i * 8 + wid) * 1024), 16, 0, 0); } while (0)
#define RESC(a) do { if (__any((a) < 1.f)) { if (hi == 0) al_l[r32] = (a); asm volatile("s_waitcnt lgkmcnt(0)" ::: "memory"); \
    for (int d = 0; d < 4; ++d) for (int r = 0; r < 16; ++r) o[d][r] *= al_l[crow(r, hi)]; } } while (0)
#define ENDSTEP() do { asm volatile("s_waitcnt vmcnt(0)" ::: "memory"); __syncthreads(); } while (0)
  f32x16 pA0, pA1, pB0, pB1; float mnA, mnB, alA, alB; bf16x8 pa0, pa1, pa2, pa3; const int NT = seq / KVBLK;
  DMA_K(0, 0); ENDSTEP();
  DMA_K(1, KVBLK); DMA_V(0, 0);
  qkt(pA0, pA1, K_lds, qr, qrl, r32, hi); partialSM(pA0, pA1, m_reg, mnA, alA);
  ENDSTEP();
  for (int j = 1; j + 1 < NT; j += 2) {
    DMA_K(0, (j + 1) * KVBLK); DMA_V(1, j * KVBLK);
    SBAR(); qkt(pB0, pB1, K_lds + SHM_K, qr, qrl, r32, hi);
    finishSM(pA0, pA1, alA, l_reg, pa0, pa1, pa2, pa3); SBAR();
    pv_d0(o, vb0, pa0, pa1, pa2, pa3); partialSM(pB0, pB1, m_reg, mnB, alB);
    RESC(alB); ENDSTEP();
    if (j + 2 < NT) DMA_K(1, (j + 2) * KVBLK);
    DMA_V(0, (j + 1) * KVBLK);
    SBAR(); qkt(pA0, pA1, K_lds, qr, qrl, r32, hi);
    finishSM(pB0, pB1, alB, l_reg, pa0, pa1, pa2, pa3); SBAR();
    pv_d0(o, vb0 + (int)SHM_V, pa0, pa1, pa2, pa3); partialSM(pA0, pA1, m_reg, mnA, alA);
    RESC(alA); ENDSTEP();
  }
  DMA_V(1, (NT - 1) * KVBLK);
  SBAR(); qkt(pB0, pB1, K_lds + SHM_K, qr, qrl, r32, hi);
  finishSM(pA0, pA1, alA, l_reg, pa0, pa1, pa2, pa3); SBAR();
  pv_d0(o, vb0, pa0, pa1, pa2, pa3); partialSM(pB0, pB1, m_reg, mnB, alB);
  RESC(alB); ENDSTEP();
  finishSM(pB0, pB1, alB, l_reg, pa0, pa1, pa2, pa3); SBAR();
  pv_d0(o, vb0 + (int)SHM_V, pa0, pa1, pa2, pa3);
#undef DMA_K
#undef DMA_V
#undef ENDSTEP
  if (hi == 0) li_l[r32] = l_reg; asm volatile("s_waitcnt lgkmcnt(0)" ::: "memory");
  float rli[16];
#pragma unroll
  for (int r = 0; r < 16; ++r) rli[r] = __builtin_amdgcn_rcpf(li_l[crow(r, hi)]);
  bf16_t* Ow = Ob + (long)(wid * QBLK) * LDO;
#pragma unroll
  for (int r = 0; r < 16; ++r) { int orow = crow(r, hi);
#pragma unroll
    for (int d0 = 0; d0 < 4; ++d0) { const float val = o[d0][r] * rli[r]; Ow[(long)orow * LDO + d0 * 32 + r32] = (bf16_t)(cvtpk(val, val) & 0xffff); } }
  __syncthreads();
#undef RESC
}
}
__device__ __forceinline__ f32x2 cmul(f32x2 a, f32x2 b) { return (f32x2){a.x * b.x - a.y * b.y, a.x * b.y + a.y * b.x}; }
__device__ __forceinline__ int rev4_14(int k) { const unsigned r = __brev((unsigned)k) >> 18; return (int)(((r & 0x1555u) << 1) | ((r >> 1) & 0x1555u)); }
#define ZI(i) ((i) + ((i) >> 5))
__device__ __forceinline__ void fft_tw(int j, int q, float sign, f32x2& w1, f32x2& w2, f32x2& w3) {
    const float rev = (float)j / (float)(4 * q); const float sn = __builtin_amdgcn_sinf(rev), cs = __builtin_amdgcn_cosf(rev);
    w1 = (f32x2){cs, sign * sn}; w2 = cmul(w1, w1); w3 = cmul(w2, w1);
}
__device__ __forceinline__ void fft16k_dif(LAS f32x2* Z, int tid) {
#pragma unroll 1
    for (int s = 0; s < 7; ++s) { int lq = 12 - 2 * s; asm volatile("" : "+s"(lq)); const int q = 1 << lq;
        const bool shared = q <= 512; f32x2 w1, w2, w3; fft_tw(tid & (q - 1), q, -1.f, w1, w2, w3);
#pragma unroll 2
        for (int i = 0; i < 8; ++i) { const int b = tid + 512 * i, j = b & (q - 1), base = ((b >> lq) << (lq + 2)) + j;
            const int i0 = ZI(base), i1 = ZI(base + q), i2 = ZI(base + 2 * q), i3 = ZI(base + 3 * q);
            const f32x2 a0 = Z[i0], a1 = Z[i1], a2 = Z[i2], a3 = Z[i3];
            const f32x2 t0 = a0 + a2, t1 = a0 - a2, t2 = a1 + a3, t3 = a1 - a3;
            if (!shared) fft_tw(j, q, -1.f, w1, w2, w3);
            Z[i0] = t0 + t2; Z[i1] = cmul((f32x2){t1.x + t3.y, t1.y - t3.x}, w1); Z[i2] = cmul(t0 - t2, w2); Z[i3] = cmul((f32x2){t1.x - t3.y, t1.y + t3.x}, w3); }
        __syncthreads(); }
}
__device__ __forceinline__ void fft16k_dit_inv(LAS f32x2* Z, int tid) {
#pragma unroll 1
    for (int s = 0; s < 7; ++s) { int lq = 2 * s; asm volatile("" : "+s"(lq)); const int q = 1 << lq;
        const bool shared = q <= 512; f32x2 w1, w2, w3; fft_tw(tid & (q - 1), q, 1.f, w1, w2, w3);
#pragma unroll 2
        for (int i = 0; i < 8; ++i) { const int b = tid + 512 * i, j = b & (q - 1), base = ((b >> lq) << (lq + 2)) + j;
            if (!shared) fft_tw(j, q, 1.f, w1, w2, w3);
            const int i0 = ZI(base), i1 = ZI(base + q), i2 = ZI(base + 2 * q), i3 = ZI(base + 3 * q);
            const f32x2 b0 = Z[i0], b1 = cmul(Z[i1], w1), b2 = cmul(Z[i2], w2), b3 = cmul(Z[i3], w3);
            const f32x2 t0 = b0 + b2, t1 = b0 - b2, t2 = b1 + b3, t3 = b1 - b3;
            Z[i0] = t0 + t2; Z[i1] = (f32x2){t1.x - t3.y, t1.y + t3.x}; Z[i2] = t0 - t2; Z[i3] = (f32x2){t1.x + t3.y, t1.y - t3.x}; }
        __syncthreads(); }
}
constexpr float HY_MIN_DECAY = -3.0701134573253945f, HY_MAX_DECAY = -15.350567286626973f;
__device__ __forceinline__ float hy_delta(int c) { return fabsf(HY_MIN_DECAY + (HY_MAX_DECAY - HY_MIN_DECAY) * ((float)c / 1279.0f)); }
__device__ __forceinline__ float conv3b_at(const bf16_t* PX, int tau, int col, const float* cw, int l, int c) {
    const float* w = cw + (size_t)l * 3 * B_IN;
    return conv3_at(PX, tau, col, w[c], w[B_IN + c], w[2 * B_IN + c]);
}
__device__ __forceinline__ void hyena_taps_unit(const Frame& F, unsigned char* ws, int l, int pair) {
    LAS f32x2* Z = (LAS f32x2*)F.lds; LAS float* red = (LAS float*)(F.lds + LDS_MISC + 128);
    const int tid = F.tid, c0 = 2 * pair;
    const bf16_t* H3x = (const bf16_t*)(ws + WS_H3) + (size_t)l * 64 * T + NCTX;
    f32x2* scr = (f32x2*)(ws + WS_HSCR) + (size_t)pair * 16384; float* htn = (float*)(ws + WS_HSCR + (size_t)640 * 16384 * 8) + 2 * pair;
    LAS f32x4* FW = (LAS f32x4*)(F.lds + LDS_MISC + 256);
    if (tid < 256) { const int j = tid >> 2, q = tid & 3; ((LAS float*)FW)[tid] = IN_(35)[(size_t)l * 64 * 2560 + (size_t)j * 2560 + (q >> 1) * 1280 + c0 + (q & 1)]; }
    __syncthreads();
    const float d0 = hy_delta(c0), d1 = hy_delta(c0 + 1);
#ifndef HYS
#define HYS 31
#endif
    float s0, s1, sc0 = 0.f, sc1 = 0.f;
    {
    s0 = 0.f; s1 = 0.f;
    if (HYS & 1)
#pragma unroll 1
    for (int i = 0; i < 2; ++i) { const int tb = 4096 * i + 8 * tid; const bf16_t* hc = H3x + tb;
        asm volatile("" ::: "memory");
        f32x4 acc[8];
#pragma unroll
        for (int p = 0; p < 8; ++p) acc[p] = (f32x4){0.f, 0.f, 0.f, 0.f};
#pragma unroll 8
        for (int j = 0; j < 64; ++j) { const f32x4 w = FW[j]; const u32x4 hv = *(const u32x4*)(hc + (size_t)j * T);
#pragma unroll
            for (int p = 0; p < 4; ++p) { acc[2 * p] += w * __uint_as_float(hv[p] << 16); acc[2 * p + 1] += w * __uint_as_float(hv[p] & 0xffff0000u); } }
#pragma unroll
        for (int p = 0; p < 8; ++p) { const int t = tb + p;
            const float tl = (float)t * (1.0f / 8191.0f), e0 = __expf(-tl * d0), e1 = __expf(-tl * d1);
            const float f0 = acc[p].x * e0, f1 = acc[p].y * e1, b0 = acc[p].z * e0, b1 = acc[p].w * e1;
            Z[ZI(t)] = (f32x2){f0, f1}; s0 += fabsf(f0); s1 += fabsf(f1);
            if (t < 8191) { Z[ZI(16383 - t)] = (f32x2){b0, b1}; s0 += fabsf(b0); s1 += fabsf(b1); } } }
    if (tid == 0) { float zz = 0.f; asm volatile("" : "+v"(zz)); Z[ZI(8192)] = (f32x2){zz, zz}; }
    s0 = wave_sum(s0); s1 = wave_sum(s1);
    if (F.lane == 0) { red[F.wave * 2] = s0; red[F.wave * 2 + 1] = s1; }
    __syncthreads();
    float n0 = 0.f, n1 = 0.f;
#pragma unroll
    for (int w = 0; w < 8; ++w) { n0 += red[2 * w]; n1 += red[2 * w + 1]; }
    sc0 = 1.0f / (16384.0f * n0); sc1 = 1.0f / (16384.0f * n1);
    if (HYS & 2) fft16k_dif(Z, tid);
#pragma unroll 4
    for (int i = 0; i < 32; ++i) scr[tid + 512 * i] = Z[ZI(tid + 512 * i)];
    __syncthreads();
    }
    if (tid == 0) { htn[0] = sc0; htn[1] = sc1; }
    __syncthreads();
}
__device__ __forceinline__ void hyena_unit(const Frame& F, unsigned char* ws, int l, int pair) {
    LAS f32x2* Z = (LAS f32x2*)F.lds;
    const int tid = F.tid, c0 = 2 * pair;
    float* GT = (float*)(ws + WS_GT); const float* X0T = (const float*)(ws + WS_X0T);
    const f32x2* scr = (const f32x2*)(ws + WS_HSCR) + (size_t)pair * 16384; const float* htn = (const float*)(ws + WS_HSCR + (size_t)640 * 16384 * 8) + 2 * pair;
    const float sc0 = htn[0], sc1 = htn[1];
#ifndef HYS
#define HYS 31
#endif
    for (int rp15 = 0; rp15 < REP(15); ++rp15) {
    const float* g0p = GT + (size_t)c0 * T + NCTX; const float* g1p = g0p + T;
    { float zz = 0.f; asm volatile("" : "+v"(zz));
#pragma unroll 4
      for (int i = 0; i < 16; ++i) { const int t = tid + 512 * i; Z[ZI(t)] = (f32x2){g0p[t], g1p[t]}; Z[ZI(8192 + t)] = (f32x2){zz, zz}; } }
    __syncthreads();
    if (HYS & 2) fft16k_dif(Z, tid);
    if (HYS & 8)
#pragma unroll 2
    for (int i = 0; i < 17; ++i) { const int k = tid + 512 * i; if (i == 16 && tid != 0) break;
        const int pk = rev4_14(k & 16383), pn = rev4_14((16384 - k) & 16383);
        const f32x2 A = Z[ZI(pk)], B = Z[ZI(pn)], At = scr[pk], Bt = scr[pn];
        const f32x2 G0 = (f32x2){0.5f * (A.x + B.x), 0.5f * (A.y - B.y)}, G1 = (f32x2){0.5f * (A.y + B.y), -0.5f * (A.x - B.x)};
        const f32x2 H0 = (f32x2){0.5f * (At.x + Bt.x), 0.5f * (At.y - Bt.y)}, H1 = (f32x2){0.5f * (At.y + Bt.y), -0.5f * (At.x - Bt.x)};
        const f32x2 P0 = cmul(G0, H0), P1 = cmul(G1, H1);
        Z[ZI(pk)] = (f32x2){P0.x - P1.y, P0.y + P1.x};
        if (pn != pk) Z[ZI(pn)] = (f32x2){P0.x + P1.y, P1.x - P0.y}; }
    __syncthreads();
    if (HYS & 2) fft16k_dit_inv(Z, tid);
    }
    const float bb0 = IN_(37)[l * 1280 + c0], bb1 = IN_(37)[l * 1280 + c0 + 1];
    { float* y0p = GT + (size_t)c0 * T + NCTX; float* y1p = y0p + T; const float* x0p = X0T + (size_t)c0 * T + NCTX; const float* x1p = x0p + T;
#pragma unroll 4
      for (int i = 0; i < 16; ++i) { const int t = tid + 512 * i; const f32x2 z = Z[ZI(t)]; const float ga = y0p[t], gb = y1p[t];
          y0p[t] = x0p[t] * (z.x * sc0 + ga * bb0); y1p[t] = x1p[t] * (z.y * sc1 + gb * bb1); } }
    __syncthreads();
}
__device__ __forceinline__ void hyena_ctx_unit(const Frame& F, unsigned char* ws, int l, int unit) {
    LAS float* TF = (LAS float*)F.lds; LAS float* TB = TF + 2048; LAS float* GG = TB + 2048;
    const int tid = F.tid, t = tid >> 1, cc = (tid & 1) * 4, cbase = unit * 8 + cc;
    const bf16_t* H3c = (const bf16_t*)(ws + WS_H3) + (size_t)l * 64 * T; float* GT = (float*)(ws + WS_GT); const float* X0T = (const float*)(ws + WS_X0T);
    { float f[4] = {0.f, 0.f, 0.f, 0.f}, b[4] = {0.f, 0.f, 0.f, 0.f};
      const float* wbase = IN_(35) + (size_t)l * 64 * 2560 + cbase;
      for (int j = 0; j < 64; ++j) { const float hv = bf2f(H3c[(size_t)j * T + t]); const float* wrow = wbase + (size_t)j * 2560;
#pragma unroll
          for (int q = 0; q < 4; ++q) { f[q] += hv * wrow[q]; b[q] += hv * wrow[1280 + q]; } }
      const float tl = (float)t * (1.0f / 255.0f);
#pragma unroll
      for (int q = 0; q < 4; ++q) { const float e = __expf(-tl * hy_delta(cbase + q)); TF[t * 8 + cc + q] = f[q] * e; TB[t * 8 + cc + q] = b[q] * e; GG[t * 8 + cc + q] = GT[(size_t)(cbase + q) * T + t]; } }
    __syncthreads();
    float nrm[4] = {0.f, 0.f, 0.f, 0.f}, y[4] = {0.f, 0.f, 0.f, 0.f};
    for (int s = 0; s < 256; ++s) {
#pragma unroll
        for (int q = 0; q < 4; ++q) { nrm[q] += fabsf(TF[s * 8 + cc + q]) + (s < 255 ? fabsf(TB[s * 8 + cc + q]) : 0.f);
            const int o = t - s; const float tap = o >= 0 ? TF[o * 8 + cc + q] : TB[(-o - 1) * 8 + cc + q];
            y[q] += tap * GG[s * 8 + cc + q]; } }
    __syncthreads();
#pragma unroll
    for (int q = 0; q < 4; ++q) GT[(size_t)(cbase + q) * T + t] = X0T[(size_t)(cbase + q) * T + t] * (y[q] / nrm[q] + GG[t * 8 + cc + q] * IN_(37)[l * 1280 + cbase + q]);
    __syncthreads();
}
constexpr int SC_C = 16, SC_NCHUNK = T / SC_C, SC_CHUNK_BYTES = 14 * 1024;
__device__ __forceinline__ int sc_tau(int d, int c, int t) { return d == 0 ? SC_C * c + t : (c < NCTX / SC_C ? NCTX - 1 - SC_C * c - t : T - 1 - SC_C * (c - NCTX / SC_C) - t); }
__device__ __forceinline__ int sc_perm(int e, int hi) { return (e & 3) + 8 * (e >> 2) + 4 * hi; }
constexpr size_t WS_FR_BYTES = (size_t)2 * NHA * SC_NCHUNK * SC_CHUNK_BYTES;

typedef short sc_bf16x8 __attribute__((ext_vector_type(8)));
typedef float sc_f32x16 __attribute__((ext_vector_type(16)));
__device__ __forceinline__ sc_bf16x8 sc_pack8(const sc_f32x16& a, int base) {
    u32x4 w; w.x = cvt_pk_bf16(a[base + 0], a[base + 1]); w.y = cvt_pk_bf16(a[base + 2], a[base + 3]); w.z = cvt_pk_bf16(a[base + 4], a[base + 5]); w.w = cvt_pk_bf16(a[base + 6], a[base + 7]);
    return *reinterpret_cast<sc_bf16x8*>(&w);
}
constexpr int SC_NSLOT = 9, SC_AHEAD = 7;
__device__ __forceinline__ void scan_chain_mfma(const Frame& F, unsigned char* ws, int chain) {
    const int h = chain >> 1, d = chain & 1, lane = F.lane, n = lane & 31, hi = lane >> 5, ib = F.wave;
    const unsigned char* FRc = ws + WS_FR + (size_t)chain * SC_NCHUNK * SC_CHUNK_BYTES;
    float* Yd = (float*)(ws + WS_Y) + (size_t)d * T * A_W + h * 64;
    LAS unsigned char* buf = F.lds;
    typedef __attribute__((address_space(3))) unsigned sc_lds_u32;
#define SCM_DMA(c_) do { if (ib < 7) { const unsigned char* src_ = FRc + (size_t)(c_) * SC_CHUNK_BYTES; LAS unsigned char* dst_ = buf + ((c_) % SC_NSLOT) * SC_CHUNK_BYTES; \
        _Pragma("unroll") for (int i_ = 0; i_ < 2; ++i_) __builtin_amdgcn_global_load_lds((const unsigned*)(src_ + (i_ * 7 + ib) * 1024 + lane * 16), (sc_lds_u32*)(dst_ + (i_ * 7 + ib) * 1024), 16, 0, 0); } } while (0)
    sc_f32x16 S0 = {}, S1 = {};
    int yoff[8];
#pragma unroll
    for (int r = 0; r < 8; ++r) { const int t = (r & 3) + 8 * (r >> 2) + 4 * hi; yoff[r] = (d ? -t : t) * A_W + 32 * ib + n; }
    __syncthreads();
#pragma unroll
    for (int c = 0; c < SC_AHEAD; ++c) SCM_DMA(c);
    asm volatile("s_waitcnt vmcnt(12)" ::: "memory"); __builtin_amdgcn_s_barrier(); asm volatile("" ::: "memory");
#pragma unroll 1
    for (int c = 0; c < SC_NCHUNK; ++c) {
        const bool steady = c + SC_AHEAD < SC_NCHUNK;
        if (steady) SCM_DMA(c + SC_AHEAD);
        if (ib < 2) {
                const LAS unsigned char* fb = buf + (c % SC_NSLOT) * SC_CHUNK_BYTES;
                sc_bf16x8 fr[11]; sc_bf16x8 vf; f32x4 gt[8];
                { const unsigned fa = (unsigned)(uintptr_t)fb + lane * 16, va = fa + (11 + ib) * 1024, ga = (unsigned)(uintptr_t)fb + 13 * 1024 + hi * 128;
#define SC_DSRD(dst, addr, off) asm volatile("ds_read_b128 %0, %1 offset:%2" : "=v"(dst) : "v"(addr), "i"(off))
                  SC_DSRD(fr[0], fa, 0); SC_DSRD(fr[1], fa, 1024); SC_DSRD(fr[2], fa, 2048); SC_DSRD(fr[3], fa, 3072); SC_DSRD(fr[4], fa, 4096); SC_DSRD(fr[5], fa, 5120);
                  SC_DSRD(fr[6], fa, 6144); SC_DSRD(fr[7], fa, 7168); SC_DSRD(fr[8], fa, 8192); SC_DSRD(fr[9], fa, 9216); SC_DSRD(fr[10], fa, 10240); SC_DSRD(vf, va, 0);
                  SC_DSRD(gt[0], ga, 0); SC_DSRD(gt[1], ga, 16); SC_DSRD(gt[2], ga, 32); SC_DSRD(gt[3], ga, 48); SC_DSRD(gt[4], ga, 64); SC_DSRD(gt[5], ga, 80); SC_DSRD(gt[6], ga, 96); SC_DSRD(gt[7], ga, 112);
#undef SC_DSRD
                  asm volatile("s_waitcnt lgkmcnt(0)" : "+v"(fr[0]), "+v"(fr[1]), "+v"(fr[2]), "+v"(fr[3]), "+v"(fr[4]), "+v"(fr[5]), "+v"(fr[6]), "+v"(fr[7]), "+v"(fr[8]), "+v"(fr[9]), "+v"(fr[10]), "+v"(vf) :: "memory");
                  asm volatile("" : "+v"(gt[0]), "+v"(gt[1]), "+v"(gt[2]), "+v"(gt[3]), "+v"(gt[4]), "+v"(gt[5]), "+v"(gt[6]), "+v"(gt[7])); }
                const sc_bf16x8 sb00 = sc_pack8(S0, 0), sb01 = sc_pack8(S0, 8), sb10 = sc_pack8(S1, 0), sb11 = sc_pack8(S1, 8);
                sc_f32x16 P = {}, P2 = {};
                P = __builtin_amdgcn_mfma_f32_32x32x16_bf16(fr[0], sb00, P, 0, 0, 0);
                P2 = __builtin_amdgcn_mfma_f32_32x32x16_bf16(fr[2], sb10, P2, 0, 0, 0);
                P = __builtin_amdgcn_mfma_f32_32x32x16_bf16(fr[1], sb01, P, 0, 0, 0);
                P2 = __builtin_amdgcn_mfma_f32_32x32x16_bf16(fr[3], sb11, P2, 0, 0, 0);
                P = __builtin_amdgcn_mfma_f32_32x32x16_bf16(fr[4], vf, P, 0, 0, 0);
#pragma unroll
                for (int q = 0; q < 4; ++q)
#pragma unroll
                    for (int e = 0; e < 4; ++e) { S0[4 * q + e] *= gt[q][e]; S1[4 * q + e] *= gt[4 + q][e]; }
                S0 = __builtin_amdgcn_mfma_f32_32x32x16_bf16(fr[8], vf, S0, 0, 0, 0);
                S1 = __builtin_amdgcn_mfma_f32_32x32x16_bf16(fr[10], vf, S1, 0, 0, 0);
#pragma unroll
                for (int r = 0; r < 16; ++r) P[r] += P2[r];
                const sc_bf16x8 xb = sc_pack8(P, 0);
                sc_f32x16 U = {};
                U = __builtin_amdgcn_mfma_f32_32x32x16_bf16(fr[5], xb, U, 0, 0, 0);
                const sc_bf16x8 ub = sc_pack8(U, 0);
                S0 = __builtin_amdgcn_mfma_f32_32x32x16_bf16(fr[7], ub, S0, 0, 0, 0);
                S1 = __builtin_amdgcn_mfma_f32_32x32x16_bf16(fr[9], ub, S1, 0, 0, 0);
                P = __builtin_amdgcn_mfma_f32_32x32x16_bf16(fr[6], ub, P, 0, 0, 0);
                float* yb = Yd + (size_t)sc_tau(d, c, 0) * A_W;
#pragma unroll
                for (int r = 0; r < 8; ++r) yb[yoff[r]] = P[8 + r];
        }
        if (steady) asm volatile("s_waitcnt vmcnt(12)" ::: "memory"); else asm volatile("s_waitcnt vmcnt(0)" ::: "memory");
        asm volatile("s_waitcnt lgkmcnt(0)" ::: "memory"); __builtin_amdgcn_s_barrier(); asm volatile("" ::: "memory");
    }
    asm volatile("s_waitcnt vmcnt(0)" ::: "memory"); __syncthreads();
#undef SCM_DMA
}
__device__ __forceinline__ float conv3_u(const float* PX, int tau, unsigned ucol, float w0, float w1, float w2) {
    const float* p = PX + (size_t)tau * PXW;
    float y = p[ucol] * w1;
    if (has_left(tau)) y += (p - PXW)[ucol] * w0;
    if (has_right(tau)) y += (p + PXW)[ucol] * w2;
    return y;
}
constexpr int WLR_K = 448;
constexpr int RP_WAVE_LDS = 16896;
typedef short rp_bf16x8 __attribute__((ext_vector_type(8)));
typedef float rp_f32x16 __attribute__((ext_vector_type(16)));
__device__ __forceinline__ unsigned short f2bf16(float x) { return (unsigned short)(cvt_pk_bf16(x, x) & 0xffffu); }
template <int NKB, class AF>
__device__ __forceinline__ void rp_lowrank(float (&dst)[16], const AF& afrag, const bf16_t* WLRh, int kw0, int n, int hi) {
    rp_f32x16 c0 = {}, c1 = {}; const bf16_t* wb0 = WLRh + (size_t)n * WLR_K + kw0 + 8 * hi; const bf16_t* wb1 = wb0 + (size_t)32 * WLR_K;
#pragma unroll
    for (int kb = 0; kb < NKB; ++kb) { const rp_bf16x8 b0 = *(const rp_bf16x8*)(wb0 + 16 * kb), b1 = *(const rp_bf16x8*)(wb1 + 16 * kb); const rp_bf16x8 a_ = afrag(kb);
        c0 = __builtin_amdgcn_mfma_f32_32x32x16_bf16(a_, b0, c0, 0, 0, 0); c1 = __builtin_amdgcn_mfma_f32_32x32x16_bf16(a_, b1, c1, 0, 0, 0); }
#pragma unroll
    for (int r = 0; r < 8; ++r) { auto sw = __builtin_amdgcn_permlane32_swap(__float_as_uint(c0[r]), __float_as_uint(c1[r]), false, false);
        dst[(r & 3) + 8 * (r >> 2)] = __uint_as_float(sw[0]); dst[(r & 3) + 8 * (r >> 2) + 4] = __uint_as_float(sw[1]); }
}
struct RpAfLds { const LAS bf16_t* base; __device__ __forceinline__ rp_bf16x8 operator()(int kb) const { return *(const LAS rp_bf16x8*)(base + 16 * kb); } };
__device__ __forceinline__ void rwkv_elem_phase(const Frame& F, unsigned char* ws, int l) {
    const float* PX = (const float*)(ws + WS_PX); float* SS = (float*)(ws + WS_SS); float* SD = (float*)(ws + WS_SD); float* GB = (float*)(ws + WS_G);
    const bf16_t* WLR = (const bf16_t*)(ws + WS_WLR) + (size_t)l * A_W * WLR_K;
    const float* cw = IN_(16) + (size_t)l * 3 * A_IN;
    LAS bf16_t* ACT = (LAS bf16_t*)(F.lds + F.wave * 10752);
    const int lane = F.lane, n = lane & 31, hi = lane >> 5;
    const int gw = F.bid * 8 + F.wave, NGW = F.G * 8;
    for (int it = gw; it < (T / 16) * 10; it += NGW) {
        const int tg = it / 10, hq = it % 10, tau0 = tg * 16;
        asm volatile("s_waitcnt lgkmcnt(0)" ::: "memory");
        const float* prow0 = PX + (size_t)(tau0 > 0 ? tau0 - 1 : 0) * PXW; const int roff = tau0 > 0 ? 0 : -1;
#define RP_WIN(x, ucol_) do { _Pragma("unroll") for (int i_ = 0; i_ < 18; ++i_) { int ri_ = i_ + roff; ri_ = ri_ < 0 ? 0 : ri_; ri_ = (tau0 - 1 + i_ > T - 1) ? (T - 1 - (tau0 > 0 ? tau0 - 1 : 0)) : ri_; x[i_] = (prow0 + (size_t)ri_ * PXW)[ucol_]; } } while (0)
#define RP_CONV(x, t_, w0_, w1_, w2_) (x[(t_)] * (has_left(tau0 + (t_)) ? (w0_) : 0.f) + x[(t_) + 1] * (w1_) + x[(t_) + 2] * (has_right(tau0 + (t_)) ? (w2_) : 0.f))
#pragma unroll
        for (int i = 0; i < 5; ++i) { const int c = lane + 64 * i, col = 3840 + c; const float c0 = cw[col], c1 = cw[A_IN + col], c2 = cw[2 * A_IN + col];
            float x[18]; RP_WIN(x, (unsigned)(PXA + col));
#pragma unroll
            for (int t = 0; t < 16; ++t) { const float val = RP_CONV(x, t, c0, c1, c2);
                const float act = i == 0 ? 1.0f - 2.0f / (1.0f + __expf(2.0f * val)) : (i == 1 ? val : sigmoidf_(val));
                ACT[t * 328 + c] = f2bf16(act); } }
        asm volatile("s_waitcnt lgkmcnt(0)" ::: "memory");
        const RpAfLds afw{ACT + (n & 15) * 328 + 8 * hi}, afa{ACT + (n & 15) * 328 + 64 + 8 * hi}, afg{ACT + (n & 15) * 328 + 128 + 8 * hi};
#pragma unroll 1
        for (int hh = 0; hh < 2; ++hh) {
            const int h = hq * 2 + hh, col = h * 64 + lane; const bf16_t* WLRh = WLR + (size_t)h * 64 * WLR_K;
            { float lg[16]; rp_lowrank<12>(lg, afg, WLRh, 256, n, hi);
#pragma unroll
              for (int t = 0; t < 16; ++t) GB[(size_t)(tau0 + t) * A_W + col] = lg[t]; }
            const float cr0 = cw[col], cr1 = cw[A_IN + col], cr2 = cw[2 * A_IN + col];
            const float ck0 = cw[A_W + col], ck1 = cw[A_IN + A_W + col], ck2 = cw[2 * A_IN + A_W + col];
            const float cv0 = cw[2 * A_W + col], cv1 = cw[A_IN + 2 * A_W + col], cv2 = cw[2 * A_IN + 2 * A_W + col];
            const float kk_w = IN_(22)[l * A_W + col], ka_w = IN_(23)[l * A_W + col];
            float kkv[16], kv[16];
            { float xr[18], xk[18], xv[18]; const unsigned uc = (unsigned)(PXA + col); RP_WIN(xr, uc); RP_WIN(xk, uc + A_W); RP_WIN(xv, uc + 2 * A_W);
#pragma unroll
              for (int t = 0; t < 16; ++t) { const int tau = tau0 + t;
                  const float r = RP_CONV(xr, t, cr0, cr1, cr2), v = RP_CONV(xv, t, cv0, cv1, cv2); kv[t] = RP_CONV(xk, t, ck0, ck1, ck2);
                  const float kr = kv[t] * kk_w; const float nrm = sqrtf(wave_sum(kr * kr)); kkv[t] = kr / fmaxf(nrm, 1e-12f);
                  float* ss = SS + ((size_t)h * T + tau) * 192 + lane; ss[0] = kkv[t]; ss[64] = r; ss[128] = v; } }
#pragma unroll 1
            for (int d = 0; d < 2; ++d) { const float w0b = IN_(17)[(l * 2 + d) * A_W + col], a0b = IN_(19)[(l * 2 + d) * A_W + col]; float lw[16], la[16];
                rp_lowrank<4>(lw, afw, WLRh, 64 * d, n, hi); rp_lowrank<4>(la, afa, WLRh, 128 + 64 * d, n, hi);
#pragma unroll
                for (int t = 0; t < 16; ++t) { const float z = w0b + lw[t]; const float decay = __expf(-__expf(-(fmaxf(-z, 0.f) + __logf(1.0f + __expf(-fabsf(z)))) - 0.5f)); const float av = sigmoidf_(a0b + la[t]);
                    float* sd = SD + (((size_t)h * 2 + d) * T + tau0 + t) * 192 + lane; sd[0] = decay; sd[64] = kkv[t] * av; sd[128] = kv[t] * (1.0f + (av - 1.0f) * ka_w); } }
        }
    }
}
#undef RP_WIN
#undef RP_CONV
constexpr int SP_WAVE_LDS = 16640;
__device__ __forceinline__ void scan_prep_phase(const Frame& F, unsigned char* ws) {
    const float* SS = (const float*)(ws + WS_SS); const float* SD = (const float*)(ws + WS_SD); unsigned char* FR = ws + WS_FR;
    LAS bf16_t* R1 = (LAS bf16_t*)(F.lds + F.wave * SP_WAVE_LDS); LAS bf16_t* R2 = R1 + 32 * 72; LAS bf16_t* BbT = R2 + 32 * 72; LAS bf16_t* KbT = BbT + 64 * 16; LAS bf16_t* VT = KbT + 64 * 16; LAS float* Lm = (LAS float*)(VT + 64 * 16);
    const int lane = F.lane, n = lane & 31, hi = lane >> 5;
    const int gw = F.bid * 8 + F.wave, NGW = F.G * 8;
    for (int it = gw; it < 2 * NHA * SC_NCHUNK; it += NGW) {
        const int chain = it / SC_NCHUNK, c = it % SC_NCHUNK, h = chain >> 1, d = chain & 1;
        const int tau_first = sc_tau(d, c, 0), dstep = d ? -1 : 1;
        const float* ssb = SS + (size_t)h * T * 192 + lane; const float* sdb = SD + ((size_t)h * 2 + d) * T * 192 + lane;
        float xw[16], xb[16], xk[16], xkk[16], xr[16], xv[16];
#pragma unroll
        for (int s = 0; s < 16; ++s) { const size_t o = (size_t)(tau_first + dstep * s) * 192; xw[s] = sdb[o]; xb[s] = sdb[o + 64]; xk[s] = sdb[o + 128]; xkk[s] = ssb[o]; xr[s] = ssb[o + 64]; xv[s] = ssb[o + 128]; }
        float gC = 1.f;
#pragma unroll
        for (int s = 0; s < 16; ++s) gC *= xw[s];
        float g = 1.f;
#pragma unroll
        for (int s = 0; s < 16; ++s) {
            const float gm1 = g; g *= xw[s]; const float ig = 1.0f / g; const float bh = xb[s] * ig, kh = xk[s] * ig;
            R1[s * 72 + lane] = f2bf16(-xkk[s] * gm1); R1[(16 + s) * 72 + lane] = f2bf16(xr[s] * g);
            R2[s * 72 + lane] = f2bf16(bh); R2[(16 + s) * 72 + lane] = f2bf16(kh);
            BbT[lane * 16 + s] = f2bf16(bh * gC); KbT[lane * 16 + s] = f2bf16(kh * gC); VT[lane * 16 + s] = f2bf16(xv[s]); }
        asm volatile("s_waitcnt lgkmcnt(0)" ::: "memory");
        unsigned char* dst = FR + ((size_t)chain * SC_NCHUNK + c) * SC_CHUNK_BYTES;
        rp_f32x16 C = {};
#pragma unroll
        for (int kb = 0; kb < 4; ++kb) { const rp_bf16x8 a_ = *(const LAS rp_bf16x8*)(R2 + n * 72 + 16 * kb + 8 * hi), b_ = *(const LAS rp_bf16x8*)(R1 + n * 72 + 16 * kb + 8 * hi);
            C = __builtin_amdgcn_mfma_f32_32x32x16_bf16(a_, b_, C, 0, 0, 0); }
        const int tt_ = n & 15; const bool incl = n >= 16;
#pragma unroll
        for (int r = 0; r < 16; ++r) { const int s = ((r & 7) & 3) + 8 * ((r & 7) >> 2) + 4 * hi; if (!(s < tt_ || (incl && s == tt_))) C[r] = 0.f; }
        if (n < 16) {
#pragma unroll
            for (int r = 0; r < 8; ++r) Lm[((r & 3) + 8 * (r >> 2) + 4 * hi) * 20 + n] = C[r]; }
        { u32x4 f4; f4.x = cvt_pk_bf16(C[8], C[9]); f4.y = cvt_pk_bf16(C[10], C[11]); f4.z = cvt_pk_bf16(C[12], C[13]); f4.w = cvt_pk_bf16(C[14], C[15]);
          u32x4 f6; f6.x = cvt_pk_bf16(C[0], C[1]); f6.y = cvt_pk_bf16(C[2], C[3]); f6.z = cvt_pk_bf16(C[4], C[5]); f6.w = cvt_pk_bf16(C[6], C[7]);
          if (n < 16) f6 = (u32x4){0u, 0u, 0u, 0u};
          *(u32x4*)(dst + 4 * 1024 + lane * 16) = f4; *(u32x4*)(dst + 6 * 1024 + lane * 16) = f6; }
        asm volatile("s_waitcnt lgkmcnt(0)" ::: "memory");
        { float Tc[16];
#pragma unroll
          for (int s = 15; s >= 0; --s) { float acc = (s == n) ? 1.f : 0.f;
#pragma unroll
              for (int u = s + 1; u < 16; ++u) acc += Lm[s * 20 + u] * Tc[u];
              Tc[s] = acc; }
          u32x4 f5; f5.x = cvt_pk_bf16(hi ? Tc[4] : Tc[0], hi ? Tc[5] : Tc[1]); f5.y = cvt_pk_bf16(hi ? Tc[6] : Tc[2], hi ? Tc[7] : Tc[3]);
          f5.z = cvt_pk_bf16(hi ? Tc[12] : Tc[8], hi ? Tc[13] : Tc[9]); f5.w = cvt_pk_bf16(hi ? Tc[14] : Tc[10], hi ? Tc[15] : Tc[11]);
          if (n >= 16) f5 = (u32x4){0u, 0u, 0u, 0u};
          *(u32x4*)(dst + 5 * 1024 + lane * 16) = f5; }
#pragma unroll
        for (int f = 0; f < 4; ++f) { const u32x2 p0 = *(const LAS u32x2*)(R1 + n * 72 + 16 * f + 4 * hi), p1 = *(const LAS u32x2*)(R1 + n * 72 + 16 * f + 8 + 4 * hi);
            *(u32x4*)(dst + f * 1024 + lane * 16) = (u32x4){p0.x, p0.y, p1.x, p1.y}; }
#pragma unroll
        for (int jb = 0; jb < 2; ++jb) { const int row = 32 * jb + n;
            const u32x2 b0 = *(const LAS u32x2*)(BbT + row * 16 + 4 * hi), b1 = *(const LAS u32x2*)(BbT + row * 16 + 8 + 4 * hi), k0 = *(const LAS u32x2*)(KbT + row * 16 + 4 * hi), k1 = *(const LAS u32x2*)(KbT + row * 16 + 8 + 4 * hi);
            const u32x2 v0 = *(const LAS u32x2*)(VT + row * 16 + 4 * hi), v1 = *(const LAS u32x2*)(VT + row * 16 + 8 + 4 * hi);
            *(u32x4*)(dst + (7 + 2 * jb) * 1024 + lane * 16) = (u32x4){b0.x, b0.y, b1.x, b1.y}; *(u32x4*)(dst + (8 + 2 * jb) * 1024 + lane * 16) = (u32x4){k0.x, k0.y, k1.x, k1.y};
            *(u32x4*)(dst + (11 + jb) * 1024 + lane * 16) = (u32x4){v0.x, v0.y, v1.x, v1.y}; }
        { const int jj = lane & 31; ((float*)(dst + 13 * 1024))[((jj >> 2) & 1) * 32 + (lane >> 5) * 16 + (jj & 3) + 4 * (jj >> 3)] = gC; }
        asm volatile("s_waitcnt lgkmcnt(0)" ::: "memory");
    }
}
constexpr int RF_ACT_BYTES = 16 * 320 * 2;
__device__ __forceinline__ void rwkv_fused_phase(const Frame& F, unsigned char* ws, int l) {
    const bf16_t* PX = (const bf16_t*)(ws + WS_PX); unsigned char* FR = ws + WS_FR;
    float* GB = (float*)(ws + WS_G); float* RB = (float*)(ws + WS_SS); float* VB = RB + (size_t)T * A_W; float* KD = (float*)(ws + WS_SD);
    const bf16_t* WLR = (const bf16_t*)(ws + WS_WLR) + (size_t)l * A_W * WLR_K;
    const float* cw = IN_(16) + (size_t)l * 3 * A_IN;
    LAS bf16_t* ACT = (LAS bf16_t*)F.lds;
    LAS bf16_t* R1 = (LAS bf16_t*)(F.lds + RF_ACT_BYTES + F.wave * SP_WAVE_LDS); LAS bf16_t* R2 = R1 + 32 * 72; LAS bf16_t* BbT = R2 + 32 * 72; LAS bf16_t* KbT = BbT + 64 * 16; LAS bf16_t* VT = KbT + 64 * 16; LAS float* Lm = (LAS float*)(VT + 64 * 16);
    const int lane = F.lane, n = lane & 31, hi = lane >> 5, hh = F.wave >> 1, d = F.wave & 1;
    for (int it = F.bid; it < (T / 16) * 5; it += F.G) {
        const int tg = it / 5, hg = it % 5, tau0 = tg * 16, h = hg * 4 + hh, col = h * 64 + lane;
        __syncthreads();
        for (int e = F.tid; e < 16 * 320; e += 512) { const int t = e / 320, c = e % 320, cc = 3840 + c;
            const float val = conv3_at(PX, tau0 + t, PXA + cc, cw[cc], cw[A_IN + cc], cw[2 * A_IN + cc]);
            const float act = c < 64 ? 1.0f - 2.0f / (1.0f + __expf(2.0f * val)) : (c < 128 ? val : sigmoidf_(val));
            ACT[t * 320 + c] = f2bf16(act); }
        __syncthreads();
        const bf16_t* prow0 = PX + (size_t)(tau0 > 0 ? tau0 - 1 : 0) * PXW; const int roff = tau0 > 0 ? 0 : -1;
#define RP_WIN(x, ucol_) do { _Pragma("unroll") for (int i_ = 0; i_ < 18; ++i_) { int ri_ = i_ + roff; ri_ = ri_ < 0 ? 0 : ri_; ri_ = (tau0 - 1 + i_ > T - 1) ? (T - 1 - (tau0 > 0 ? tau0 - 1 : 0)) : ri_; x[i_] = bf2f((prow0 + (size_t)ri_ * PXW)[ucol_]); } } while (0)
#define RP_CONV(x, t_, w0_, w1_, w2_) (x[(t_)] * (has_left(tau0 + (t_)) ? (w0_) : 0.f) + x[(t_) + 1] * (w1_) + x[(t_) + 2] * (has_right(tau0 + (t_)) ? (w2_) : 0.f))
        const bf16_t* WLRh = WLR + (size_t)h * 64 * WLR_K;
        const RpAfLds afw{ACT + (n & 15) * 320 + 8 * hi}, afa{ACT + (n & 15) * 320 + 64 + 8 * hi}, afg{ACT + (n & 15) * 320 + 128 + 8 * hi};
        float xw[16], xb[16], xk[16], xkk[16], xr[16], xv[16];
        { float wr_[18], wk_[18], wv_[18]; const unsigned uc = (unsigned)(PXA + col); RP_WIN(wr_, uc); RP_WIN(wk_, uc + A_W); RP_WIN(wv_, uc + 2 * A_W);
          if (d == 0) { float lg[16]; rp_lowrank<12>(lg, afg, WLRh, 256, n, hi);
#pragma unroll
              for (int t = 0; t < 16; ++t) GB[(size_t)(tau0 + t) * A_W + col] = lg[t]; }
          const float cr0 = cw[col], cr1 = cw[A_IN + col], cr2 = cw[2 * A_IN + col], ck0 = cw[A_W + col], ck1 = cw[A_IN + A_W + col], ck2 = cw[2 * A_IN + A_W + col];
          const float cv0 = cw[2 * A_W + col], cv1 = cw[A_IN + 2 * A_W + col], cv2 = cw[2 * A_IN + 2 * A_W + col], kk_w = IN_(22)[l * A_W + col];
#pragma unroll
          for (int t = 0; t < 16; ++t) { xr[t] = RP_CONV(wr_, t, cr0, cr1, cr2); xv[t] = RP_CONV(wv_, t, cv0, cv1, cv2); xk[t] = RP_CONV(wk_, t, ck0, ck1, ck2);
              const float kr = xk[t] * kk_w; const float nrm = sqrtf(wave_sum(kr * kr)); xkk[t] = kr / fmaxf(nrm, 1e-12f); } }
        if (d == 0) {
#pragma unroll
            for (int t = 0; t < 16; ++t) { RB[(size_t)(tau0 + t) * A_W + col] = xr[t]; VB[(size_t)(tau0 + t) * A_W + col] = xv[t]; } }
        { const float ka_w = IN_(23)[l * A_W + col], w0b = IN_(17)[(l * 2 + d) * A_W + col], a0b = IN_(19)[(l * 2 + d) * A_W + col]; float la[16];
          rp_lowrank<4>(xw, afw, WLRh, 64 * d, n, hi); rp_lowrank<4>(la, afa, WLRh, 128 + 64 * d, n, hi);
#pragma unroll
          for (int t = 0; t < 16; ++t) { const float z = w0b + xw[t]; xw[t] = __expf(-__expf(-(fmaxf(-z, 0.f) + __logf(1.0f + __expf(-fabsf(z)))) - 0.5f)); const float av = sigmoidf_(a0b + la[t]);
              xb[t] = xkk[t] * av; xk[t] = xk[t] * (1.0f + (av - 1.0f) * ka_w); KD[((size_t)d * T + tau0 + t) * A_W + col] = xk[t]; } }
        if (d) {
#pragma unroll
            for (int s = 0; s < 8; ++s) { float t_;
                t_ = xw[s]; xw[s] = xw[15 - s]; xw[15 - s] = t_; t_ = xb[s]; xb[s] = xb[15 - s]; xb[15 - s] = t_; t_ = xk[s]; xk[s] = xk[15 - s]; xk[15 - s] = t_;
                t_ = xkk[s]; xkk[s] = xkk[15 - s]; xkk[15 - s] = t_; t_ = xr[s]; xr[s] = xr[15 - s]; xr[15 - s] = t_; t_ = xv[s]; xv[s] = xv[15 - s]; xv[15 - s] = t_; } }
        const int c = d == 0 ? tg : (tg < NCTX / 16 ? NCTX / 16 - 1 - tg : NCTX / 16 + (T / 16 - 1) - tg);
        float gC = 1.f;
#pragma unroll
        for (int s = 0; s < 16; ++s) gC *= xw[s];
        float g = 1.f;
#pragma unroll
        for (int s = 0; s < 16; ++s) {
            const float gm1 = g; g *= xw[s]; const float ig = 1.0f / g; const float bh = xb[s] * ig, kh = xk[s] * ig;
            R1[s * 72 + lane] = f2bf16(-xkk[s] * gm1); R1[(16 + s) * 72 + lane] = f2bf16(xr[s] * g);
            R2[s * 72 + lane] = f2bf16(bh); R2[(16 + s) * 72 + lane] = f2bf16(kh);
            BbT[lane * 16 + s] = f2bf16(bh * gC); KbT[lane * 16 + s] = f2bf16(kh * gC); VT[lane * 16 + s] = f2bf16(xv[s]); }
        asm volatile("s_waitcnt lgkmcnt(0)" ::: "memory");
        unsigned char* dst = FR + ((size_t)(h * 2 + d) * SC_NCHUNK + c) * SC_CHUNK_BYTES;
        rp_f32x16 C = {};
#pragma unroll
        for (int kb = 0; kb < 4; ++kb) { const rp_bf16x8 a_ = *(const LAS rp_bf16x8*)(R2 + n * 72 + 16 * kb + 8 * hi), b_ = *(const LAS rp_bf16x8*)(R1 + n * 72 + 16 * kb + 8 * hi);
            C = __builtin_amdgcn_mfma_f32_32x32x16_bf16(a_, b_, C, 0, 0, 0); }
        const int tt_ = n & 15; const bool incl = n >= 16;
#pragma unroll
        for (int r = 0; r < 16; ++r) { const int s = ((r & 7) & 3) + 8 * ((r & 7) >> 2) + 4 * hi; if (!(s < tt_ || (incl && s == tt_))) C[r] = 0.f; }
        if (n < 16) {
#pragma unroll
            for (int r = 0; r < 8; ++r) Lm[((r & 3) + 8 * (r >> 2) + 4 * hi) * 20 + n] = C[r]; }
        { u32x4 f4; f4.x = cvt_pk_bf16(C[8], C[9]); f4.y = cvt_pk_bf16(C[10], C[11]); f4.z = cvt_pk_bf16(C[12], C[13]); f4.w = cvt_pk_bf16(C[14], C[15]);
          u32x4 f6; f6.x = cvt_pk_bf16(C[0], C[1]); f6.y = cvt_pk_bf16(C[2], C[3]); f6.z = cvt_pk_bf16(C[4], C[5]); f6.w = cvt_pk_bf16(C[6], C[7]);
          if (n < 16) f6 = (u32x4){0u, 0u, 0u, 0u};
          *(u32x4*)(dst + 4 * 1024 + lane * 16) = f4; *(u32x4*)(dst + 6 * 1024 + lane * 16) = f6; }
        asm volatile("s_waitcnt lgkmcnt(0)" ::: "memory");
        { float Tc[16];
#pragma unroll
          for (int s = 15; s >= 0; --s) { float acc = (s == n) ? 1.f : 0.f;
#pragma unroll
              for (int u = s + 1; u < 16; ++u) acc += Lm[s * 20 + u] * Tc[u];
              Tc[s] = acc; }
          u32x4 f5; f5.x = cvt_pk_bf16(hi ? Tc[4] : Tc[0], hi ? Tc[5] : Tc[1]); f5.y = cvt_pk_bf16(hi ? Tc[6] : Tc[2], hi ? Tc[7] : Tc[3]);
          f5.z = cvt_pk_bf16(hi ? Tc[12] : Tc[8], hi ? Tc[13] : Tc[9]); f5.w = cvt_pk_bf16(hi ? Tc[14] : Tc[10], hi ? Tc[15] : Tc[11]);
          if (n >= 16) f5 = (u32x4){0u, 0u, 0u, 0u};
          *(u32x4*)(dst + 5 * 1024 + lane * 16) = f5; }
#pragma unroll
        for (int f = 0; f < 4; ++f) { const u32x2 p0 = *(const LAS u32x2*)(R1 + n * 72 + 16 * f + 4 * hi), p1 = *(const LAS u32x2*)(R1 + n * 72 + 16 * f + 8 + 4 * hi);
            *(u32x4*)(dst + f * 1024 + lane * 16) = (u32x4){p0.x, p0.y, p1.x, p1.y}; }
#pragma unroll
        for (int jb = 0; jb < 2; ++jb) { const int row = 32 * jb + n;
            const u32x2 b0 = *(const LAS u32x2*)(BbT + row * 16 + 4 * hi), b1 = *(const LAS u32x2*)(BbT + row * 16 + 8 + 4 * hi), k0 = *(const LAS u32x2*)(KbT + row * 16 + 4 * hi), k1 = *(const LAS u32x2*)(KbT + row * 16 + 8 + 4 * hi);
            const u32x2 v0 = *(const LAS u32x2*)(VT + row * 16 + 4 * hi), v1 = *(const LAS u32x2*)(VT + row * 16 + 8 + 4 * hi);
            *(u32x4*)(dst + (7 + 2 * jb) * 1024 + lane * 16) = (u32x4){b0.x, b0.y, b1.x, b1.y}; *(u32x4*)(dst + (8 + 2 * jb) * 1024 + lane * 16) = (u32x4){k0.x, k0.y, k1.x, k1.y};
            *(u32x4*)(dst + (11 + jb) * 1024 + lane * 16) = (u32x4){v0.x, v0.y, v1.x, v1.y}; }
        { const int jj = lane & 31; ((float*)(dst + 13 * 1024))[((jj >> 2) & 1) * 32 + (lane >> 5) * 16 + (jj & 3) + 4 * (jj >> 3)] = gC; }
        asm volatile("s_waitcnt lgkmcnt(0)" ::: "memory");
    }
#undef RP_WIN
#undef RP_CONV
}
__device__ __forceinline__ void mixer_phase(const Frame& F0, unsigned char* ws0, int lq, bool need_ctx, char* lds_g) {
    const int l = lq & 3;
#ifndef MK_MIX
#define MK_MIX 15
#endif
    { const Frame F = opq(F0); unsigned char* ws = opq_ptr(ws0);
      if (MK_MIX & 1) for (int chain = F.bid; chain < 2 * NHA; chain += F.G) scan_chain_mfma(F, ws, chain); }
    const Frame& F = F0;
    const int n_xa = 32 * NHC, n_ca = need_ctx ? NHC : 0, n_att = n_xa + n_ca, n_hy = 640, n_ch = need_ctx ? 160 : 0;
    unsigned* qatt = (unsigned*)(ws0 + WS_CTL) + CW_QUEUE + 64 * lq; unsigned* qhy = qatt + 32;
    int item;
#define MIX_POP(q) do { if (F.tid == 0) F.MISC[16] = __hip_atomic_fetch_add((q), 1u, __ATOMIC_RELAXED, __HIP_MEMORY_SCOPE_AGENT); __syncthreads(); item = (int)F.MISC[16]; __syncthreads(); } while (0)
    if (F.bid >= 2 * NHA) {
        MIX_POP(qatt);
        while (item < n_att) {
            if (MK_MIX & 2) { unsigned char* ws = opq_ptr(ws0);
                const bf16_t* QF = (const bf16_t*)(ws + WS_QF); const bf16_t* KF = (const bf16_t*)(ws + WS_KF); const bf16_t* KVRAW = (const bf16_t*)(ws + WS_KVRAW); bf16_t* OB = (bf16_t*)(ws + WS_OBUF);
                const bool is_xa = item < n_xa; const int h = is_xa ? item % NHC : item - n_xa, row0 = is_xa ? NCTX + (item / NHC) * 256 : 0;
                for (int rp = 0; rp < REP(13); ++rp) att::attn_body(QF + (size_t)row0 * NQ + h * 192, KF + h * 192, KVRAW + h * 256 + 128, OB + (size_t)row0 * DM + 2560 + h * 128, is_xa ? T : NCTX, lds_g); }
            MIX_POP(qatt);
        }
    }
    MIX_POP(qhy);
    while (item < n_hy + n_ch) {
        const Frame Fu = opq(F0); unsigned char* ws = opq_ptr(ws0);
        if ((MK_MIX & 4) && item < n_hy) hyena_unit(Fu, ws, l, item);
        else if ((MK_MIX & 8) && item >= n_hy) hyena_ctx_unit(Fu, ws, l, item - n_hy);
        MIX_POP(qhy);
    }
#undef MIX_POP
}

__device__ __forceinline__ void hyena_taps_tail(const Frame& F0, unsigned char* ws0, int lt, int first, int end) {
    if (F0.bid < 48) return;
#pragma unroll 1
    for (int p = first + F0.bid - 48; p < end; p += 208) hyena_taps_unit(opq(F0), opq_ptr(ws0), lt, p);
}
constexpr int NPH = 2 + 14 * NL;
__global__ void __launch_bounds__(512, 2) mk_fwd(Args a) {
    extern __shared__ __attribute__((aligned(16))) unsigned char lds[];
    Frame F; F.lds = (LAS unsigned char*)lds; F.MISC = (volatile LAS unsigned*)(F.lds + LDS_MISC);
    F.tid = threadIdx.x; F.lane = F.tid & 63; F.wave = __builtin_amdgcn_readfirstlane(F.tid >> 6); F.bid = blockIdx.x; F.G = gridDim.x;
    if (F.tid < 64) F.MISC[F.tid] = 0u;
    if (F.tid < 46) *(LAS unsigned long long*)(F.lds + LDS_PTAB + 8 * F.tid) = (unsigned long long)(uintptr_t)a.in[F.tid];
    __syncthreads();
    unsigned char* ws = a.ws;
    const int lo = a.ph_lo, hi = a.ph_hi;
    XcdBarrier bar = xcd_barrier_post((unsigned*)(ws + WS_CTL) + CW_BAR, F.MISC + 8);
#ifndef MK_MASK
#define MK_MASK 0xffff
#endif
#define EN(x) (((MK_MASK) >> (x)) & 1)
#define IN(k) (lo <= (k) && (k) < hi)
#define SEAM(k) do { if (IN(k) && IN((k) + 1)) xcd_barrier(bar); } while (0)
#define WSP opq_ptr(ws)
#define P_XS(w) ((float*)((w) + WS_XS))
#define P_ABUF(w) ((bf16_t*)((w) + WS_ABUF))
#define P_HBUF(w) ((bf16_t*)((w) + WS_HBUF))
#define P_OBUF(w) ((bf16_t*)((w) + WS_OBUF))
#define P_MODX(w, l) ((const float*)((w) + WS_MOD) + ((size_t)(l) * 2 + 0) * NMOD)
#define P_MODC(w, l) ((const float*)((w) + WS_MOD) + ((size_t)(l) * 2 + 1) * NMOD)
#define P_WL(w, l) ((const bf16_t*)((w) + WS_WB) + (size_t)(l) * W_LAYER)
    if (EN(0) && IN(0)) for (int rp = 0; rp < REP(0); ++rp) phase0(opq(F), opq_ptr(ws));
    SEAM(0);
    if (EN(1) && IN(1)) phase_mod(opq(F), opq_ptr(ws));
    SEAM(1);
#pragma clang loop unroll(full)
    for (int l = 0; l < NL; ++l) {
        const int pb = 2 + 14 * l; const bool need_ctx = l < NL - 1;
        if (EN(2) && IN(pb + 0)) for (int rp = 0; rp < REP(2); ++rp) { unsigned char* w = WSP; norm_phase(opq(F), P_XS(w), IN_(7) + l * DM, P_MODX(w, l), P_MODC(w, l), 0, 1, P_ABUF(w), l > 0 ? (const bf16_t*)(w + WS_SLAB) : nullptr, l > 0 ? P_MODC(w, l - 1) + 8 * DM : nullptr, 0.5f); }
        SEAM(pb + 0);
        if (EN(3) && IN(pb + 1)) { unsigned char* w = WSP; pg8::Gemm g{P_ABUF(w), P_WL(w, l) + W_G1, T, 2 * FF, DM, DM}; pg8::StaticOrder S; S.init(T, 2 * FF, F.G, F.bid); pg8::EpiSwiGLU E{P_HBUF(w), FF};
            pg8::gemm_phase<pg8::EpiSwiGLU, pg8::StaticOrder>(F.lds, g, S, E, nullptr);
            hyena_taps_tail(F, ws, l, 0, l == 0 ? 640 : 416); }
        SEAM(pb + 1);
        if (EN(4) && IN(pb + 2)) {
            { unsigned char* w = WSP; pg8::Gemm g{P_HBUF(w), P_WL(w, l) + W_D1, T, DM, FF, FF}; pg8::StaticOrderX S; S.init(T, DM, F.G, F.bid); pg8::EpiResid E{P_XS(w), P_MODX(w, l) + 2 * DM, P_MODC(w, l) + 2 * DM, 0.5f, nullptr};
              pg8::gemm_phase<pg8::EpiResid, pg8::StaticOrderX>(F.lds, g, S, E, nullptr); }
            if (true) { __syncthreads();
              if (F.bid < 256) { unsigned char* w = WSP; const int ks = F.bid >> 4, ksz = FF / 16; pg8::Gemm g{P_HBUF(w) + ks * ksz, P_WL(w, l) + W_D1 + ks * ksz, NCTX, DM, ksz, FF}; pg8::OneUnit S{F.bid & 15};
                  pg8::EpiBf16<0> E{(bf16_t*)(w + WS_SLAB) + (size_t)ks * NCTX * DM, DM, nullptr, 0, 0};
                  pg8::gemm_phase<pg8::EpiBf16<0>, pg8::OneUnit>(F.lds, g, S, E, nullptr); } }
        }
        SEAM(pb + 2);
        if (EN(5) && IN(pb + 3)) for (int rp = 0; rp < REP(2); ++rp) { unsigned char* w = WSP; norm_phase(opq(F), P_XS(w), IN_(8) + l * DM, P_MODX(w, l), P_MODC(w, l), 3, 4, P_ABUF(w), (const bf16_t*)(w + WS_SLAB), P_MODC(w, l) + 2 * DM, 0.5f); }
        SEAM(pb + 3);
        if (EN(6) && IN(pb + 4)) { unsigned char* w = WSP; pg8::Gemm g{P_ABUF(w), P_WL(w, l) + W_IN, T, PXW, DM, DM}; pg8::StaticOrder S; S.init(T, PXW, F.G, F.bid); pg8::EpiBf16<0> E{(bf16_t*)(w + WS_PX), PXW, nullptr, 0, 0};
            pg8::gemm_phase<pg8::EpiBf16<0>, pg8::StaticOrder>(F.lds, g, S, E, nullptr); }
        SEAM(pb + 4);
        if (EN(7) && IN(pb + 5)) { for (int rp = 0; rp < REP(7); ++rp) rwkv_fused_phase(opq(F), opq_ptr(ws), l); if (!(MK_ONLYRP)) { for (int rp = 0; rp < REP(8); ++rp) mla_prep_phase(opq(F), opq_ptr(ws), l); hyena_prep_phase(opq(F), opq_ptr(ws), l); } }
        SEAM(pb + 5);
        if (EN(8) && IN(pb + 6)) {
            { unsigned char* w = WSP; pg8::Gemm g{(const bf16_t*)(w + WS_QA), P_WL(w, l) + W_Q, T, NQ, 1024, 1024}; pg8::StaticOrder S; S.init(T, NQ, F.G, F.bid); pg8::EpiBf16<0> E{(bf16_t*)(w + WS_QRAW), NQ, nullptr, 0, 0};
              pg8::gemm_phase<pg8::EpiBf16<0>, pg8::StaticOrder>(F.lds, g, S, E, nullptr); }
            __syncthreads();
            { unsigned char* w = WSP; pg8::Gemm g{(const bf16_t*)(w + WS_KVA), P_WL(w, l) + W_KV, T, NKV, 512, 512}; pg8::StaticOrder S; S.init(T, NKV, F.G, F.bid); pg8::EpiBf16<0> E{(bf16_t*)(w + WS_KVRAW), NKV, nullptr, 0, 0};
              pg8::gemm_phase<pg8::EpiBf16<0>, pg8::StaticOrder>(F.lds, g, S, E, nullptr); }
        }
        SEAM(pb + 6);
        if (EN(9) && IN(pb + 7)) { for (int rp = 0; rp < REP(8); ++rp) qkv_final_phase(opq(F), opq_ptr(ws), l, need_ctx); }
        SEAM(pb + 7);
        if (EN(10) && IN(pb + 8)) for (int rp = 0; rp < REP(10); ++rp) mixer_phase(F, ws, l + 4 * rp, need_ctx, (char*)lds);
        SEAM(pb + 8);
        if (EN(11) && IN(pb + 9)) { for (int rp = 0; rp < REP(8); ++rp) rwkv_out_phase(opq(F), opq_ptr(ws), l, need_ctx); hyena_out_phase(opq(F), opq_ptr(ws), need_ctx); }
        SEAM(pb + 9);
        if (EN(12) && IN(pb + 10)) {
            { unsigned char* w = WSP; pg8::Gemm g{P_OBUF(w), P_WL(w, l) + W_OUT, T, DM, DM, DM}; pg8::StaticOrderX S; S.init(T, DM, F.G, F.bid); pg8::EpiResid E{P_XS(w), P_MODX(w, l) + 5 * DM, P_MODC(w, l) + 5 * DM, 1.0f, nullptr};
              pg8::gemm_phase<pg8::EpiResid, pg8::StaticOrderX>(F.lds, g, S, E, nullptr); }
            if (need_ctx) { __syncthreads();
              if (F.bid < 256) { unsigned char* w = WSP; const int ks = F.bid >> 4, ksz = DM / 16; pg8::Gemm g{P_OBUF(w) + ks * ksz, P_WL(w, l) + W_OUT + ks * ksz, NCTX, DM, ksz, DM}; pg8::OneUnit S{F.bid & 15};
                  pg8::EpiBf16<0> E{(bf16_t*)(w + WS_SLAB) + (size_t)ks * NCTX * DM, DM, nullptr, 0, 0};
                  pg8::gemm_phase<pg8::EpiBf16<0>, pg8::OneUnit>(F.lds, g, S, E, nullptr); } }
        }
        SEAM(pb + 10);
        if (EN(13) && IN(pb + 11)) for (int rp = 0; rp < REP(2); ++rp) { unsigned char* w = WSP; norm_phase(opq(F), P_XS(w), IN_(9) + l * DM, P_MODX(w, l), P_MODC(w, l), 6, 7, P_ABUF(w), need_ctx ? (const bf16_t*)(w + WS_SLAB) : nullptr, P_MODC(w, l) + 5 * DM, 1.0f); }
        SEAM(pb + 11);
        if (EN(14) && IN(pb + 12)) { if (need_ctx) { unsigned char* w = WSP; pg8::Gemm g{P_ABUF(w), P_WL(w, l) + W_G2, T, 2 * FF, DM, DM}; pg8::StaticOrder S; S.init(T, 2 * FF, F.G, F.bid); pg8::EpiSwiGLU E{P_HBUF(w), FF};
            pg8::gemm_phase<pg8::EpiSwiGLU, pg8::StaticOrder>(F.lds, g, S, E, nullptr);
            hyena_taps_tail(F, ws, l + 1, 416, 640); }       else { unsigned char* w = WSP; pg8::Gemm g{P_ABUF(w), P_WL(w, l) + W_G2, T, 2 * FF, DM, DM}; pg8::StaticOrderX S; S.init(T, 2 * FF, F.G, F.bid); pg8::EpiSwiGLU E{P_HBUF(w), FF};
            pg8::gemm_phase<pg8::EpiSwiGLU, pg8::StaticOrderX>(F.lds, g, S, E, nullptr); } }
        SEAM(pb + 12);
        if (EN(15) && IN(pb + 13)) {
            { unsigned char* w = WSP; pg8::Gemm g{P_HBUF(w), P_WL(w, l) + W_D2, T, DM, FF, FF}; pg8::StaticOrderX S; S.init(T, DM, F.G, F.bid); pg8::EpiResid E{P_XS(w), P_MODX(w, l) + 8 * DM, P_MODC(w, l) + 8 * DM, 0.5f, l == NL - 1 ? a.out : nullptr};
              pg8::gemm_phase<pg8::EpiResid, pg8::StaticOrderX>(F.lds, g, S, E, nullptr); }
            if (need_ctx) { __syncthreads();
              if (F.bid < 256) { unsigned char* w = WSP; const int ks = F.bid >> 4, ksz = FF / 16; pg8::Gemm g{P_HBUF(w) + ks * ksz, P_WL(w, l) + W_D2 + ks * ksz, NCTX, DM, ksz, FF}; pg8::OneUnit S{F.bid & 15};
                  pg8::EpiBf16<0> E{(bf16_t*)(w + WS_SLAB) + (size_t)ks * NCTX * DM, DM, nullptr, 0, 0};
                  pg8::gemm_phase<pg8::EpiBf16<0>, pg8::OneUnit>(F.lds, g, S, E, nullptr); } }
        }
        SEAM(pb + 13);
    }
#undef IN
#undef SEAM
}

#ifndef MK_LAUNCHES
#define MK_LAUNCHES 1
#endif
extern "C" void kernel_launch(void* const* d_in, const int* in_sizes, int n_in, void* d_out, int out_size, void* d_ws, size_t ws_size, hipStream_t stream) {
    static int grid = 0;
    if (grid == 0) {
        if (n_in != 46 || in_sizes[0] != SEQ * DM || out_size != SEQ * DM || ws_size < WS_END) {
            fprintf(stderr, "kernel_launch: shape mismatch: n_in %d in0 %d out %d ws %zu (need %zu); nothing launched\n", n_in, n_in > 0 ? in_sizes[0] : -1, out_size, ws_size, (size_t)WS_END); grid = -1; return; }
        int dev = 0, cus = 0, per_cu = 0;
        if (hipGetDevice(&dev) != hipSuccess || hipDeviceGetAttribute(&cus, hipDeviceAttributeMultiprocessorCount, dev) != hipSuccess) { fprintf(stderr, "kernel_launch: device query failed\n"); grid = -1; return; }
        if (hipFuncSetAttribute((const void*)mk_fwd, hipFuncAttributeMaxDynamicSharedMemorySize, LDS_BYTES) != hipSuccess) { fprintf(stderr, "kernel_launch: hipFuncSetAttribute failed\n"); grid = -1; return; }
        if (hipOccupancyMaxActiveBlocksPerMultiprocessor(&per_cu, (const void*)mk_fwd, 512, LDS_BYTES) != hipSuccess || per_cu < 1) fprintf(stderr, "kernel_launch: note: occupancy query reports %d blocks per CU\n", per_cu);
        (void)hipGetLastError();
        grid = cus;
        if (cus != 256) { fprintf(stderr, "kernel_launch: built for 256 CUs (split-K of the context panel, hyena scratch), found %d; nothing launched\n", cus); grid = -1; return; }
    }
    if (grid < 0) return;
    if (hipMemsetAsync((char*)d_ws + WS_CTL, 0, CTL_BYTES, stream) != hipSuccess) { fprintf(stderr, "kernel_launch: memset failed\n"); return; }
    Args a{};
    for (int i = 0; i < 46; ++i) a.in[i] = (const float*)d_in[i];
    a.out = (float*)d_out; a.ws = (unsigned char*)d_ws;
    a.ph_lo = 0; a.ph_hi = NPH;
    hipLaunchKernelGGL(mk_fwd, dim3(grid), dim3(512), LDS_BYTES, stream, a);
    const hipError_t le = hipPeekAtLastError();
    if (le != hipSuccess) fprintf(stderr, "kernel_launch: launch failed: %s\n", hipGetErrorName(le));
}
```

```cpp
#include <hip/hip_runtime.h>
#include <stdint.h>
#include <cstdio>

#define LAS __attribute__((address_space(3)))
#define CAS __attribute__((address_space(4)))
typedef unsigned short bf16_t;
typedef float f32x4 __attribute__((ext_vector_type(4)));
typedef float f32x2 __attribute__((ext_vector_type(2)));
typedef unsigned u32x4 __attribute__((ext_vector_type(4)));
typedef unsigned u32x2 __attribute__((ext_vector_type(2)));

constexpr int T = 8448, NCTX = 256, SEQ = 8192, DM = 4096, FF = 6144, NL = 4;
constexpr int A_W = 1280, A_IN = 4160, B_IN = 3840, C_IN = 1600, NHA = 20;
constexpr int PXW = 9728, PXA = 0, PXB = 4160, PXC = 8000;
constexpr int NQ = 2304, NKV = 3072, NHC = 12;
constexpr int NMOD = 9 * DM;
constexpr float NORM_EPS = 1e-6f, GN_EPS = 64e-5f;

constexpr size_t MiB = 1u << 20;
constexpr size_t al(size_t x) { return (x + MiB - 1) / MiB * MiB; }
constexpr size_t WS_CTL = 0, CTL_BYTES = MiB;
constexpr size_t WS_XS = WS_CTL + CTL_BYTES;
constexpr size_t WS_ABUF = WS_XS + al((size_t)T * DM * 4);
constexpr size_t WS_HBUF = WS_ABUF + al((size_t)T * DM * 2);
constexpr size_t WS_OBUF = WS_HBUF + al((size_t)T * FF * 2);
constexpr size_t WS_PX = WS_OBUF + al((size_t)T * DM * 2);
constexpr size_t WS_MOD = WS_PX + al((size_t)T * PXW * 4);
constexpr size_t WS_HP = WS_MOD + al((size_t)NL * 2 * NMOD * 4);
constexpr size_t WS_SS = WS_HP + MiB;
constexpr size_t WS_SD = WS_SS + al((size_t)NHA * T * 192 * 4);
constexpr size_t WS_WLR = WS_SD + al((size_t)NHA * 2 * T * 192 * 4);
constexpr size_t WS_G = WS_WLR + al((size_t)NL * A_W * 448 * 2);
constexpr size_t WS_Y = WS_G + al((size_t)T * A_W * 4);
constexpr size_t WS_QA = WS_Y + al((size_t)2 * T * A_W * 4);
constexpr size_t WS_KVA = WS_QA + al((size_t)T * 1024 * 2);
constexpr size_t WS_KPE = WS_KVA + al((size_t)T * 512 * 2);
constexpr size_t WS_QRAW = WS_KPE + al((size_t)T * 64 * 2);
constexpr size_t WS_KVRAW = WS_QRAW + al((size_t)T * NQ * 2);
constexpr size_t WS_QF = WS_KVRAW + al((size_t)T * NKV * 2);
constexpr size_t WS_KF = WS_QF + al((size_t)T * NQ * 2);
constexpr size_t WS_H3 = WS_KF + al((size_t)T * NQ * 2);
constexpr size_t WS_HSCR = WS_H3 + al((size_t)NL * T * 64 * 4);
constexpr size_t WS_FR = WS_HSCR + al((size_t)640 * 16384 * 8 + 640 * 8);
constexpr size_t WS_GT = WS_FR + al((size_t)40 * 528 * (14 * 1024));
constexpr size_t WS_X0T = WS_GT + al((size_t)1280 * T * 4);
constexpr size_t WS_SLAB = WS_FR;
constexpr size_t WS_WB = WS_X0T + al((size_t)1280 * T * 4);
constexpr size_t W_G1 = 0, W_D1 = W_G1 + (size_t)2 * FF * DM, W_IN = W_D1 + (size_t)DM * FF, W_OUT = W_IN + (size_t)PXW * DM, W_G2 = W_OUT + (size_t)DM * DM,
                 W_D2 = W_G2 + (size_t)2 * FF * DM, W_Q = W_D2 + (size_t)DM * FF, W_KV = W_Q + (size_t)NQ * 1024, W_LAYER = W_KV + (size_t)NKV * 512;
constexpr size_t WS_END = WS_WB + al(W_LAYER * NL * 2);
constexpr int CW_BAR = 4096;
constexpr int CW_QUEUE = 8192;

constexpr int LDS_MISC = 143360, LDS_BYTES = 147456;

__device__ __forceinline__ float wave_sum(float v) {
#pragma unroll
    for (int o = 1; o < 64; o <<= 1) v += __shfl_xor(v, o);
    return v;
}
__device__ __forceinline__ float wave_sum16(const float (&x)[16], int lane) {
    const bool b5 = (lane & 32) != 0, b4 = (lane & 16) != 0, b3 = (lane & 8) != 0, b2 = (lane & 4) != 0;
    float k8[8], k4[4], k2[2];
#pragma unroll
    for (int i = 0; i < 8; ++i) k8[i] = (b5 ? x[8 + i] : x[i]) + __shfl_xor(b5 ? x[i] : x[8 + i], 32);
#pragma unroll
    for (int i = 0; i < 4; ++i) k4[i] = (b4 ? k8[4 + i] : k8[i]) + __shfl_xor(b4 ? k8[i] : k8[4 + i], 16);
#pragma unroll
    for (int i = 0; i < 2; ++i) k2[i] = (b3 ? k4[2 + i] : k4[i]) + __shfl_xor(b3 ? k4[i] : k4[2 + i], 8);
    float k1 = (b2 ? k2[1] : k2[0]) + __shfl_xor(b2 ? k2[0] : k2[1], 4);
    k1 += __shfl_xor(k1, 1); k1 += __shfl_xor(k1, 2);
    return k1;
}
typedef __bf16 bf16x2_t __attribute__((ext_vector_type(2)));
__device__ __forceinline__ unsigned cvt_pk_bf16(float lo, float hi) { const f32x2 v = {lo, hi}; return __builtin_bit_cast(unsigned, __builtin_convertvector(v, bf16x2_t)); }
__device__ __forceinline__ float bf2f(unsigned short b) { return __uint_as_float(((unsigned)b) << 16); }
__device__ __forceinline__ f32x4 bf4f(u32x2 w) { return (f32x4){__uint_as_float(w.x << 16), __uint_as_float(w.x & 0xffff0000u), __uint_as_float(w.y << 16), __uint_as_float(w.y & 0xffff0000u)}; }
__device__ __forceinline__ float sigmoidf_(float x) { return 1.0f / (1.0f + __expf(-x)); }
__device__ __forceinline__ float siluf_(float x) { return x / (1.0f + __expf(-x)); }
__device__ __forceinline__ bool has_left(int tau) { return tau != 0 && tau != NCTX; }
__device__ __forceinline__ bool has_right(int tau) { return tau != NCTX - 1 && tau != T - 1; }

struct Args { const float* in[46]; float* out; unsigned char* ws; int ph_lo, ph_hi; };
struct Frame { LAS unsigned char* lds; volatile LAS unsigned* MISC; int tid, lane, wave, bid, G; };
constexpr int LDS_PTAB = LDS_MISC + 2048;
__device__ __forceinline__ const float* inp(const Frame& F, int i) {
    const volatile LAS unsigned* p = (const volatile LAS unsigned*)(F.lds + LDS_PTAB) + 2 * i;
    const unsigned lo = __builtin_amdgcn_readfirstlane(p[0]), hi = __builtin_amdgcn_readfirstlane(p[1]);
    return (const float*)(((unsigned long long)hi << 32) | lo);
}
#define IN_(i) inp(F, (i))
__device__ __forceinline__ Frame opq(const Frame& F) { Frame G = F; asm volatile("" : "+v"(G.tid), "+s"(G.wave), "+s"(G.bid)); G.lane = G.tid & 63; return G; }
__device__ __forceinline__ unsigned char* opq_ptr(unsigned char* p) { asm volatile("" : "+s"(p)); return p; }
#ifndef MK_REP
#define MK_REP 0
#endif
#ifndef MK_ONLYRP
#define MK_ONLYRP 0
#endif
#define REP(x) (1 + (((MK_REP) >> (x)) & 1))
#define XB_TMO      128
#define XB_XCNT(j)  (256  + 64 * (j))
#define XB_XSUB(j)  (1280 + 64 * (j))
#define XB_XGEN(j)  (2304 + 64 * (j))
#define XB_TOP      3328
#define XB_TOPGEN   3392
#define XCD_BAR_WORDS 3456
#define XB_SPIN_CAP (1u << 18)

__device__ __forceinline__ unsigned xb_ld(unsigned* p)              { return __hip_atomic_load(p, __ATOMIC_RELAXED, __HIP_MEMORY_SCOPE_AGENT); }
__device__ __forceinline__ unsigned xb_add(unsigned* p, unsigned v) { return __hip_atomic_fetch_add(p, v, __ATOMIC_RELAXED, __HIP_MEMORY_SCOPE_AGENT); }
__device__ __forceinline__ unsigned xb_xcc_id() { return (unsigned)__builtin_amdgcn_s_getreg((3 << 11) | 20) & 0xFu; }
#define XB_SPIN(cond, bar) do { unsigned _sp = 0; while (cond) { __builtin_amdgcn_s_sleep(1); \
    if ((++_sp & 255u) == 0u) { if (xb_ld(&(bar)[XB_TMO])) break; if (_sp > XB_SPIN_CAP) { atomicAdd(&(bar)[XB_TMO], 1u); break; } } } } while (0)

struct XcdBarrier {
    unsigned* bar; unsigned x;
    volatile LAS unsigned* st;
};

__device__ __forceinline__ XcdBarrier xcd_barrier_post(unsigned* bar, volatile LAS unsigned* st) {
    XcdBarrier b; b.bar = bar; b.x = xb_xcc_id(); b.st = st;
    if (threadIdx.x == 0) (void)xb_add(&bar[XB_XCNT(b.x)], 1u);
    return b;
}
__device__ __forceinline__ void xcd_barrier_complete(unsigned* bar, unsigned x, unsigned& nloc, unsigned& nx) {
    const unsigned G = gridDim.x * gridDim.y * gridDim.z;
    unsigned sum, cnt, mine, sp = 0u;
    for (;;) {
        sum = 0u; cnt = 0u; mine = 0u;
#pragma unroll
        for (unsigned j = 0; j < 16; ++j) { const unsigned c = xb_ld(&bar[XB_XCNT(j)]); sum += c; cnt += (c > 0u) ? 1u : 0u; mine = (j == x) ? c : mine; }
        if (sum == G) break;
        __builtin_amdgcn_s_sleep(1);
        if ((++sp & 255u) == 0u) { if (xb_ld(&bar[XB_TMO])) break; if (sp > XB_SPIN_CAP) { atomicAdd(&bar[XB_TMO], 1u); break; } }
    }
    nloc = mine > 0u ? mine : 1u; nx = cnt > 0u ? cnt : 1u;
}

__device__ __forceinline__ void xcd_barrier(const XcdBarrier& b) {
    asm volatile("s_waitcnt vmcnt(0)" ::: "memory");
    __syncthreads();
    if (threadIdx.x == 0) {
        unsigned* bar = b.bar;
        __builtin_amdgcn_s_waitcnt(0);
        unsigned nloc = b.st[0], nx = b.st[1];
        if (nloc == 0u) { xcd_barrier_complete(bar, b.x, nloc, nx); b.st[0] = nloc; b.st[1] = nx; }
        const unsigned old = xb_add(&bar[XB_XSUB(b.x)], 1u);
        const unsigned gen = old / nloc;
        if (old + 1u == (gen + 1u) * nloc) {
            __builtin_amdgcn_fence(__ATOMIC_RELEASE, "agent");
            asm volatile("s_waitcnt vmcnt(0)" ::: "memory");
            const unsigned og = xb_add(&bar[XB_TOP], 1u);
            const unsigned tg = og / nx;
            if (og + 1u == (tg + 1u) * nx) xb_add(&bar[XB_TOPGEN], 1u);
            else XB_SPIN(xb_ld(&bar[XB_TOPGEN]) == tg, bar);
            __builtin_amdgcn_fence(__ATOMIC_ACQUIRE, "agent");
            xb_add(&bar[XB_XGEN(b.x)], 1u);
            asm volatile("s_waitcnt vmcnt(0)" ::: "memory");
        } else {
            XB_SPIN(xb_ld(&bar[XB_XGEN(b.x)]) == gen, bar);
            __builtin_amdgcn_fence(__ATOMIC_ACQUIRE, "agent");
            asm volatile("s_waitcnt vmcnt(0)" ::: "memory");
        }
    }
    __syncthreads();
}
namespace pg8 {
#define PG8_LAS __attribute__((address_space(3)))
typedef unsigned short bf16_t;
typedef short bf16x8 __attribute__((ext_vector_type(8)));
typedef float f32x4 __attribute__((ext_vector_type(4)));
typedef unsigned u32x4 __attribute__((ext_vector_type(4)));
constexpr int BM = 256, BK = 64, HALF = 128, HTB = HALF * BK * 2  , STAGE_BYTES = 8 * HTB, NXCD = 8, WGM = 4;

__host__ __device__ __forceinline__ int lds_byte(int r, int c) { const int st = (r >> 4) * 2 + (c >> 5), rr = r & 15, cc = c & 31, ob = rr * 64 + cc * 2; return st * 1024 + (ob ^ (((ob >> 9) & 1) << 5)); }
__host__ __device__ __forceinline__ void stage_rc(int b, int& R, int& C) { const int st = b / 1024, sb = b % 1024, swz = sb ^ (((sb >> 9) & 1) << 5); R = (st >> 1) * 16 + swz / 64; C = (st & 1) * 32 + (swz % 64) / 2; }
__host__ __device__ __forceinline__ int perm32(int rho) { const int n = rho >> 4, i = rho & 15; return 8 * (i >> 2) + 4 * n + (i & 3); }

struct Unit { int pm, pn; };
struct Gemm { const bf16_t* A; const bf16_t* Bt; int M, N, K, ld; };

struct StaticOrder {
    int nM, nN, nwg, G, c;
    __host__ __device__ void init(int M, int N, int G_, int c_) { nM = M / BM; nN = N / BM; nwg = nM * nN; G = G_; c = c_; }
    __host__ __device__ bool next(int i, Unit& u) const {
        const long L = (long)i * G + c; if (L >= nwg) return false;
        int wgid = (int)L; { const int q = nwg / NXCD, r = nwg % NXCD, xcd = wgid % NXCD, off = wgid / NXCD; wgid = (xcd < r ? xcd * (q + 1) : r * (q + 1) + (xcd - r) * q) + off; }
        const int nig = WGM * nN, gid = wgid / nig, fm = gid * WGM, gsz = (nM - fm) < WGM ? (nM - fm) : WGM;
        u.pm = fm + ((wgid % nig) % gsz); u.pn = (wgid % nig) / gsz; return true;
    }
    __device__ __forceinline__ void a_ready(const Unit&) const {}
    __device__ __forceinline__ void done(const Unit&) const {}
};
struct CountedOrder : StaticOrder {
    const unsigned* ready; unsigned need; unsigned* tmo;
    __device__ __forceinline__ void a_ready(const Unit& u) const {
        if (threadIdx.x < 64) {
            const unsigned long long t0 = __builtin_amdgcn_s_memrealtime(); unsigned polls = 0;
            while ((unsigned)__builtin_amdgcn_readfirstlane(__hip_atomic_load(ready + 64 * u.pm, __ATOMIC_RELAXED, __HIP_MEMORY_SCOPE_AGENT)) < need) {
                if ((++polls & 255u) == 0u && __builtin_amdgcn_readfirstlane(__hip_atomic_load(tmo, __ATOMIC_RELAXED, __HIP_MEMORY_SCOPE_AGENT)) != 0u) break;
                if (__builtin_amdgcn_s_memrealtime() - t0 > 2000000ull) {
                    if (threadIdx.x == 0) { unsigned expect = 0u; __hip_atomic_compare_exchange_strong(tmo + 1, &expect, 0x600u | (unsigned)(u.pm & 0xff), __ATOMIC_RELAXED, __ATOMIC_RELAXED, __HIP_MEMORY_SCOPE_AGENT); __hip_atomic_store(tmo, 1u, __ATOMIC_RELAXED, __HIP_MEMORY_SCOPE_AGENT); }
                    break; }
                __builtin_amdgcn_s_sleep(2); }
            __builtin_amdgcn_fence(__ATOMIC_ACQUIRE, "agent");
            asm volatile("s_waitcnt vmcnt(0)" ::: "memory");
        }
#if !defined(BROKEN_HOOK_NO_BARRIER)
        asm volatile("" ::: "memory"); __builtin_amdgcn_s_barrier(); asm volatile("" ::: "memory");
#endif
    }
};

__device__ __forceinline__ unsigned cvt_pk_bf16(float lo, float hi) { unsigned r; asm volatile("v_cvt_pk_bf16_f32 %0, %1, %2" : "=v"(r) : "v"(lo), "v"(hi)); return r; }
typedef float f32x2 __attribute__((ext_vector_type(2)));
__device__ __forceinline__ f32x2 gelu_pk(f32x2 v) {
    const f32x2 av = __builtin_elementwise_abs(v), d = av * 0.2316418882f + 1.0f;
    f32x2 t; t.x = __builtin_amdgcn_rcpf(d.x); t.y = __builtin_amdgcn_rcpf(d.y);
    f32x2 q = t * 0.5307027145f + (-0.7265760135f); q = q * t + 0.7107068705f; q = q * t + (-0.142248368f); q = q * t + 0.127414796f; q = q * t;
    const f32x2 s = (v * v) * (-0.72134752044f);
    f32x2 e; e.x = __builtin_amdgcn_exp2f(s.x); e.y = __builtin_amdgcn_exp2f(s.y);
    const f32x2 m = v * (q * e), r = v - m;
    f32x2 o; o.x = v.x < 0.f ? m.x : r.x; o.y = v.y < 0.f ? m.y : r.y; return o;
}

struct EpiF32 {
    static constexpr bool PERM = false, AFTER_DRAIN = false;
    float* C; int ldc; const float* bias;
    __device__ __forceinline__ void operator()(const f32x4 (&acc)[2][2][4][2], const Unit& u, int wr, int wc, int fr, int fq) const {
        const int row0 = u.pm * BM + wr * 64 + fr, col0 = u.pn * BM + wc * 32 + 4 * fq;
        f32x4 bv[2][2];
#pragma unroll
        for (int bj = 0; bj < 2; ++bj)
#pragma unroll
            for (int n = 0; n < 2; ++n) bv[bj][n] = bias ? *(const f32x4*)(bias + col0 + bj * HALF + n * 16) : (f32x4){0.f, 0.f, 0.f, 0.f};
#pragma unroll
        for (int ai = 0; ai < 2; ++ai)
#pragma unroll
            for (int m = 0; m < 4; ++m) { float* rowp = C + (size_t)(row0 + ai * HALF + m * 16) * ldc + col0;
#pragma unroll
                for (int bj = 0; bj < 2; ++bj)
#pragma unroll
                    for (int n = 0; n < 2; ++n) *(f32x4*)(rowp + bj * HALF + n * 16) = acc[ai][bj][m][n] + bv[bj][n]; }
    }
};
template <int ACT  > struct EpiBf16 {
    static constexpr bool PERM = true, AFTER_DRAIN = false;
    bf16_t* O; int ldc; const float* bias; int split_cols; size_t split_stride;
    __device__ __forceinline__ void operator()(const f32x4 (&acc)[2][2][4][2], const Unit& u, int wr, int wc, int fr, int fq) const {
        const int row0 = u.pm * BM + wr * 64 + fr; int colt = u.pn * BM; bf16_t* base = O;
        if (split_cols) { const int t = colt / split_cols; base += (size_t)t * split_stride; colt -= t * split_cols; }
        const int col0 = colt + wc * 32 + 8 * fq, bcol0 = u.pn * BM + wc * 32 + 8 * fq;
        f32x4 bv[2][2];
#pragma unroll
        for (int bj = 0; bj < 2; ++bj)
#pragma unroll
            for (int n = 0; n < 2; ++n) bv[bj][n] = bias ? *(const f32x4*)(bias + bcol0 + bj * HALF + 4 * n) : (f32x4){0.f, 0.f, 0.f, 0.f};
#pragma unroll
        for (int ai = 0; ai < 2; ++ai)
#pragma unroll
            for (int m = 0; m < 4; ++m) { bf16_t* rowp = base + (size_t)(row0 + ai * HALF + m * 16) * ldc + col0;
#pragma unroll
                for (int bj = 0; bj < 2; ++bj) { f32x4 v0 = acc[ai][bj][m][0] + bv[bj][0], v1 = acc[ai][bj][m][1] + bv[bj][1];
                    if (ACT == 1) { f32x2 a = gelu_pk((f32x2){v0[0], v0[1]}), b = gelu_pk((f32x2){v0[2], v0[3]}), c = gelu_pk((f32x2){v1[0], v1[1]}), d = gelu_pk((f32x2){v1[2], v1[3]});
                        v0 = (f32x4){a.x, a.y, b.x, b.y}; v1 = (f32x4){c.x, c.y, d.x, d.y}; }
                    if (ACT == 2) {
#pragma unroll
                        for (int j = 0; j < 4; ++j) { v0[j] = 0.5f * v0[j] * (1.0f + erff(v0[j] * 0.70710678f)); v1[j] = 0.5f * v1[j] * (1.0f + erff(v1[j] * 0.70710678f)); } }
                    u32x4 w; w.x = cvt_pk_bf16(v0[0], v0[1]); w.y = cvt_pk_bf16(v0[2], v0[3]); w.z = cvt_pk_bf16(v1[0], v1[1]); w.w = cvt_pk_bf16(v1[2], v1[3]);
                    *(u32x4*)(rowp + bj * HALF) = w; } }
    }
};
}
namespace pg8 {
struct EpiSwiGLU {
    static constexpr bool PERM = true, AFTER_DRAIN = false;
    bf16_t* O; int ldc;
    __device__ __forceinline__ void operator()(const f32x4 (&acc)[2][2][4][2], const Unit& u, int wr, int wc, int fr, int fq) const {
        const int row0 = u.pm * BM + wr * 64 + fr, col0 = u.pn * HALF + wc * 32 + 8 * fq;
#pragma unroll
        for (int ai = 0; ai < 2; ++ai)
#pragma unroll
            for (int m = 0; m < 4; ++m) { bf16_t* rowp = O + (size_t)(row0 + ai * HALF + m * 16) * ldc + col0;
                float h[8];
#pragma unroll
                for (int n = 0; n < 2; ++n)
#pragma unroll
                    for (int j = 0; j < 4; ++j) { const float g = acc[ai][0][m][n][j], up = acc[ai][1][m][n][j]; h[n * 4 + j] = g * __builtin_amdgcn_rcpf(1.0f + __builtin_amdgcn_exp2f(-1.4426950408889634f * g)) * up; }
                u32x4 w; w.x = cvt_pk_bf16(h[0], h[1]); w.y = cvt_pk_bf16(h[2], h[3]); w.z = cvt_pk_bf16(h[4], h[5]); w.w = cvt_pk_bf16(h[6], h[7]);
                *(u32x4*)rowp = w; }
    }
};
struct EpiResid {
    static constexpr bool PERM = false, AFTER_DRAIN = false;
    float* X; const float* gate_x; const float* gate_c; float fac; float* out_x;
    __device__ __forceinline__ void operator()(const f32x4 (&acc)[2][2][4][2], const Unit& u, int wr, int wc, int fr, int fq) const {
        const int row0 = u.pm * BM + wr * 64 + fr, col0 = u.pn * BM + wc * 32 + 4 * fq;
        const float* gv = (u.pm == 0) ? gate_c : gate_x;
        float* dst = (u.pm != 0 && out_x) ? out_x - (size_t)256 * 4096 : X;
        f32x4 gg[2][2];
#pragma unroll
        for (int bj = 0; bj < 2; ++bj)
#pragma unroll
            for (int n = 0; n < 2; ++n) gg[bj][n] = *(const f32x4*)(gv + col0 + bj * HALF + n * 16) * fac;
#pragma unroll
        for (int ai = 0; ai < 2; ++ai)
#pragma unroll
            for (int m = 0; m < 4; ++m) { const size_t off = (size_t)(row0 + ai * HALF + m * 16) * 4096 + col0;
#pragma unroll
                for (int bj = 0; bj < 2; ++bj)
#pragma unroll
                    for (int n = 0; n < 2; ++n) { const f32x4 b = *(const f32x4*)(X + off + bj * HALF + n * 16); *(f32x4*)(dst + off + bj * HALF + n * 16) = b + gg[bj][n] * acc[ai][bj][m][n]; } }
    }
};
struct OneUnit { int pn;
    __host__ __device__ bool next(int i, Unit& u) const { u.pm = 0; u.pn = pn; return i == 0; }
    __device__ __forceinline__ void a_ready(const Unit&) const {}
    __device__ __forceinline__ void done(const Unit&) const {}
};
struct StaticOrderX { StaticOrder b;
    __host__ __device__ void init(int M, int N, int G_, int c_) { b.init(M - BM, N, G_, c_); }
    __host__ __device__ bool next(int i, Unit& u) const { const bool ok = b.next(i, u); u.pm += 1; return ok; }
    __device__ __forceinline__ void a_ready(const Unit&) const {}
    __device__ __forceinline__ void done(const Unit&) const {}
};
}
namespace pg8 {
template <class Epi, class Sched, bool STAMP = false>
__device__ __forceinline__ void gemm_phase(PG8_LAS unsigned char* lds, const Gemm g, const Sched& S, const Epi& E, unsigned long long* stamps) {
    int tid_ = threadIdx.x; asm volatile("" : "+v"(tid_));
    const int tid = tid_, wid = __builtin_amdgcn_readfirstlane(tid >> 6), lane = tid & 63, wr = wid >> 2, wc = wid & 3, fr = lane & 15, fq = lane >> 4;
    const int K = g.ld, nt = g.K / BK;
    int ts_lo = 0, ts_hi = 0, nts = 0; const unsigned long long rt_entry = STAMP ? (unsigned long long)wall_clock64() : 0ull;
#define PG8_STAMP() do { if (STAMP && wid == 0 && nts < 64) { const unsigned long long _c = (unsigned long long)clock64(); \
        ts_lo = (lane == nts) ? (int)(unsigned)_c : ts_lo; ts_hi = (lane == nts) ? (int)(unsigned)(_c >> 32) : ts_hi; ++nts; } } while (0)
    PG8_STAMP();
    unsigned voffA[2], voffB[2];
#pragma unroll
    for (int i = 0; i < 2; ++i) { int R, C; stage_rc(tid * 16 + i * 8192, R, C); const int Rb = Epi::PERM ? ((R & ~31) + perm32(R & 31)) : R;
        voffA[i] = (unsigned)(R * K + C) * 2u; voffB[i] = (unsigned)(Rb * K + C) * 2u; }
    const size_t kstep = (size_t)(BK * 2);
    const size_t hstep = (size_t)HALF * K * 2;
    const size_t tstep = 2 * hstep;
    const unsigned ldsw = (unsigned)wid * 1024u;
    const int aoff = lds_byte(wr * 64 + fr, fq * 8), boff = lds_byte(wc * 32 + fr, fq * 8);
#define PG8_SA(b, h) (((b) * 2 + (h)) * HTB)
#define PG8_SB(b, h) ((4 + (b) * 2 + (h)) * HTB)
#define PG8_STAGE(bufoff, gbase, voff) do { _Pragma("unroll") for (int _i = 0; _i < 2; ++_i) \
        __builtin_amdgcn_global_load_lds((const unsigned*)((const char*)(gbase) + (voff)[_i]), (PG8_LAS unsigned*)(lds + (bufoff) + ldsw + _i * 8192), 16, 0, 0); } while (0)
#define PG8_LDA(dst, b, h) do { _Pragma("unroll") for (int m = 0; m < 4; ++m) _Pragma("unroll") for (int k = 0; k < 2; ++k) dst[m][k] = *(const PG8_LAS bf16x8*)(lds + PG8_SA(b, h) + aoff + m * 2048 + k * 1024); } while (0)
#define PG8_LDB(dst, b, h) do { _Pragma("unroll") for (int n = 0; n < 2; ++n) _Pragma("unroll") for (int k = 0; k < 2; ++k) dst[n][k] = *(const PG8_LAS bf16x8*)(lds + PG8_SB(b, h) + boff + n * 2048 + k * 1024); } while (0)
#define PG8_MMA(ai, bj, At, Bt) do { __builtin_amdgcn_s_setprio(1); _Pragma("unroll") for (int m = 0; m < 4; ++m) _Pragma("unroll") for (int n = 0; n < 2; ++n) _Pragma("unroll") for (int k = 0; k < 2; ++k) \
        acc[ai][bj][m][n] = __builtin_amdgcn_mfma_f32_16x16x32_bf16(Bt[n][k], At[m][k], acc[ai][bj][m][n], 0, 0, 0); __builtin_amdgcn_s_setprio(0); } while (0)
#define PG8_WAIT_V(n) asm volatile("s_waitcnt vmcnt(" #n ")" ::: "memory")
#define PG8_WAIT_L(n) asm volatile("s_waitcnt lgkmcnt(" #n ")" ::: "memory")
#define PG8_BAR __builtin_amdgcn_s_barrier()
#define PG8_SCHED __builtin_amdgcn_sched_barrier(0)
    Unit cur, nxt; int ui = 0;
    if (!S.next(0, cur)) return;
    f32x4 acc[2][2][4][2];
#pragma unroll
    for (int a = 0; a < 2; ++a)
#pragma unroll
        for (int b = 0; b < 2; ++b)
#pragma unroll
            for (int m = 0; m < 4; ++m)
#pragma unroll
                for (int n = 0; n < 2; ++n) acc[a][b][m][n] = (f32x4){0.f, 0.f, 0.f, 0.f};
    bf16x8 At[4][2], B0[2][2], B1[2][2];
    const char* cA = (const char*)g.A + (size_t)cur.pm * tstep; const char* cB = (const char*)g.Bt + (size_t)cur.pn * tstep;
    S.a_ready(cur);
    PG8_STAGE(PG8_SB(0, 0), cB, voffB); PG8_STAGE(PG8_SA(0, 0), cA, voffA); PG8_STAGE(PG8_SB(0, 1), cB + hstep, voffB); PG8_STAGE(PG8_SA(0, 1), cA + hstep, voffA);
    if (wr == 1) PG8_BAR;
    PG8_WAIT_V(4); PG8_BAR;
    PG8_STAGE(PG8_SB(1, 0), cB + kstep, voffB); PG8_STAGE(PG8_SA(1, 0), cA + kstep, voffA); PG8_STAGE(PG8_SB(1, 1), cB + hstep + kstep, voffB);
    PG8_WAIT_V(6); PG8_BAR;
    PG8_STAMP();
    for (;;) {
        const bool has_next = S.next(ui + 1, nxt);
        const char* nA = has_next ? (const char*)g.A + (size_t)nxt.pm * tstep : cA; const char* nB = has_next ? (const char*)g.Bt + (size_t)nxt.pn * tstep : cB;
        for (int t = 0; t < nt; t += 2) {
            const bool last = (t == nt - 2);
            const char* a1 = cA + (size_t)(t + 1) * kstep;
            const char* a2 = last ? nA : cA + (size_t)(t + 2) * kstep; const char* b2 = last ? nB : cB + (size_t)(t + 2) * kstep;
            const char* a3 = a2 + kstep; const char* b3 = b2 + kstep;
            if (last && has_next) S.a_ready(nxt);
            PG8_LDB(B0, 0, 0); PG8_SCHED; PG8_LDA(At, 0, 0); PG8_STAGE(PG8_SA(1, 1), a1 + hstep, voffA);
            PG8_WAIT_L(8); PG8_BAR; PG8_WAIT_L(0); PG8_MMA(0, 0, At, B0); PG8_BAR; PG8_SCHED;
            PG8_LDB(B1, 0, 1); PG8_STAGE(PG8_SB(0, 0), b2, voffB);
            PG8_BAR; PG8_WAIT_L(0); PG8_MMA(0, 1, At, B1); PG8_BAR;
            PG8_LDA(At, 0, 1); PG8_STAGE(PG8_SA(0, 0), a2, voffA);
            PG8_BAR; PG8_WAIT_L(0); PG8_MMA(1, 0, At, B0); PG8_BAR; PG8_SCHED;
            PG8_STAGE(PG8_SB(0, 1), b2 + hstep, voffB);
            PG8_WAIT_V(6); PG8_BAR; PG8_MMA(1, 1, At, B1); PG8_BAR;
            PG8_LDB(B0, 1, 0); PG8_SCHED; PG8_LDA(At, 1, 0); PG8_STAGE(PG8_SA(0, 1), a2 + hstep, voffA);
            PG8_WAIT_L(8); PG8_BAR; PG8_WAIT_L(0); PG8_MMA(0, 0, At, B0); PG8_BAR; PG8_SCHED;
            PG8_LDB(B1, 1, 1); PG8_STAGE(PG8_SB(1, 0), b3, voffB);
            PG8_BAR; PG8_WAIT_L(0); PG8_MMA(0, 1, At, B1); PG8_BAR;
            PG8_LDA(At, 1, 1); PG8_STAGE(PG8_SA(1, 0), a3, voffA);
            PG8_BAR; PG8_WAIT_L(0); PG8_MMA(1, 0, At, B0); PG8_BAR; PG8_SCHED;
            PG8_STAGE(PG8_SB(1, 1), b3 + hstep, voffB);
            PG8_WAIT_V(6); PG8_BAR; PG8_MMA(1, 1, At, B1); PG8_BAR;
        }
        PG8_STAMP();
        if constexpr (!Epi::AFTER_DRAIN) { E(acc, cur, wr, wc, fr, fq); S.done(cur); }
        PG8_STAMP();
        if (!has_next) break;
#pragma unroll
        for (int a = 0; a < 2; ++a)
#pragma unroll
            for (int b = 0; b < 2; ++b)
#pragma unroll
                for (int m = 0; m < 4; ++m)
#pragma unroll
                    for (int n = 0; n < 2; ++n) acc[a][b][m][n] = (f32x4){0.f, 0.f, 0.f, 0.f};
        cur = nxt; cA = nA; cB = nB; ++ui;
    }
    PG8_WAIT_V(0);
    if (wr == 0) PG8_BAR;
    PG8_BAR;
    if constexpr (Epi::AFTER_DRAIN) { E.fused(acc, cur, wr, wc, fr, fq, lds, wid, lane); S.done(cur); }
    PG8_STAMP();
    if (STAMP && wid == 0) { stamps[lane] = lane < nts ? (((unsigned long long)(unsigned)ts_hi << 32) | (unsigned)ts_lo) : 0ull;
        if (lane == 62) stamps[62] = rt_entry; if (lane == 63) stamps[63] = (unsigned long long)wall_clock64(); }
#undef PG8_STAMP
#undef PG8_SA
#undef PG8_SB
#undef PG8_STAGE
#undef PG8_LDA
#undef PG8_LDB
#undef PG8_MMA
#undef PG8_WAIT_V
#undef PG8_WAIT_L
#undef PG8_BAR
#undef PG8_SCHED
}
}
#define LDS_WAIT() asm volatile("s_waitcnt lgkmcnt(0)" ::: "memory")

__device__ __forceinline__ int map_row(int n, int mode) {
    if (mode == 1) { const int j = n < FF ? n : n - FF; return (j >> 7) * 256 + (n < FF ? 0 : 128) + (j & 127); }
    return n;
}
__device__ __forceinline__ void transpose_item(const float* __restrict__ W, int K, int N, bf16_t* WT, int mode, LAS float* scr, int item, int lane) {
    const int nblk = N / 32, kb = item / nblk, nb = item % nblk, k0 = 64 * kb, n0 = 32 * nb;
#pragma unroll 8
    for (int i = 0; i < 32; ++i) { const int kk = 2 * i + (lane >> 5); scr[kk * 33 + (lane & 31)] = W[(size_t)(k0 + kk) * N + n0 + (lane & 31)]; }
    LDS_WAIT(); asm volatile("" ::: "memory");
    const int c = lane & 7;
#pragma unroll
    for (int j = 0; j < 4; ++j) { const int n = (lane >> 3) + 8 * j; const LAS float* s = scr + (8 * c) * 33 + n;
        u32x4 o; o.x = cvt_pk_bf16(s[0 * 33], s[1 * 33]); o.y = cvt_pk_bf16(s[2 * 33], s[3 * 33]); o.z = cvt_pk_bf16(s[4 * 33], s[5 * 33]); o.w = cvt_pk_bf16(s[6 * 33], s[7 * 33]);
        *(u32x4*)(WT + (size_t)map_row(n0 + n, mode) * K + k0 + 8 * c) = o; }
    LDS_WAIT(); asm volatile("" ::: "memory");
}
constexpr int I_G = (DM / 64) * (2 * FF / 32), I_D = (FF / 64) * (DM / 32), I_IN = (DM / 64) * (9600 / 32), I_OUT = (DM / 64) * (DM / 32), I_Q = (1024 / 64) * (NQ / 32), I_KV = (512 / 64) * (NKV / 32);
constexpr int I_LAYER = 2 * I_G + 2 * I_D + I_IN + I_OUT + I_Q + I_KV;

__device__ __forceinline__ void phase0(const Frame& F, unsigned char* ws) {
    const int gw = F.bid * 8 + F.wave, NGW = F.G * 8;
    const size_t gt = (size_t)F.bid * 512 + F.tid, NGT = (size_t)F.G * 512;
    LAS float* scr = (LAS float*)(F.lds + F.wave * 8704);
    bf16_t* WB = (bf16_t*)(ws + WS_WB);
    for (int it = gw; it < NL * I_LAYER; it += NGW) {
        const int l = it / I_LAYER; int r = it - l * I_LAYER; bf16_t* wl = WB + (size_t)l * W_LAYER;
        if (r < I_G) { transpose_item(IN_(10) + (size_t)l * DM * 2 * FF, DM, 2 * FF, wl + W_G1, 1, scr, r, F.lane); continue; } r -= I_G;
        if (r < I_D) { transpose_item(IN_(11) + (size_t)l * FF * DM, FF, DM, wl + W_D1, 0, scr, r, F.lane); continue; } r -= I_D;
        if (r < I_G) { transpose_item(IN_(12) + (size_t)l * DM * 2 * FF, DM, 2 * FF, wl + W_G2, 1, scr, r, F.lane); continue; } r -= I_G;
        if (r < I_D) { transpose_item(IN_(13) + (size_t)l * FF * DM, FF, DM, wl + W_D2, 0, scr, r, F.lane); continue; } r -= I_D;
        if (r < I_IN) { transpose_item(IN_(14) + (size_t)l * DM * 9600, DM, 9600, wl + W_IN, 0, scr, r, F.lane); continue; } r -= I_IN;
        if (r < I_OUT) { transpose_item(IN_(15) + (size_t)l * DM * DM, DM, DM, wl + W_OUT, 0, scr, r, F.lane); continue; } r -= I_OUT;
        if (r < I_Q) { transpose_item(IN_(39) + (size_t)l * 1024 * NQ, 1024, NQ, wl + W_Q, 0, scr, r, F.lane); continue; } r -= I_Q;
        transpose_item(IN_(41) + (size_t)l * 512 * NKV, 512, NKV, wl + W_KV, 0, scr, r, F.lane);
    }
    for (size_t i = gt; i < (size_t)NL * 128 * 512; i += NGT) {
        const int l = (int)(i / (128 * 512)), rr = (int)((i / 512) % 128), c = (int)(i % 512);
        const int row = 9600 + rr;
        *(u32x4*)(WB + (size_t)l * W_LAYER + W_IN + (size_t)row * DM + c * 8) = (u32x4){0u, 0u, 0u, 0u};
    }
    { bf16_t* WLR = (bf16_t*)(ws + WS_WLR); const float* wu = IN_(18); const float* au = IN_(20); const float* gu = IN_(21);
      for (size_t i = gt; i < (size_t)NL * 448 * A_W; i += NGT) { const int l = (int)(i / (448 * A_W)), k = (int)((i / A_W) % 448), col = (int)(i % A_W);
          float v;
          if (k < 128) v = wu[(((size_t)l * 2 + (k >> 6)) * 64 + (k & 63)) * A_W + col];
          else if (k < 256) v = au[(((size_t)l * 2 + ((k - 128) >> 6)) * 64 + (k & 63)) * A_W + col];
          else v = gu[((size_t)l * 192 + (k - 256)) * A_W + col];
          WLR[((size_t)l * A_W + col) * 448 + k] = (bf16_t)(cvt_pk_bf16(v, v) & 0xffffu); } }
    { f32x4* xs = (f32x4*)(ws + WS_XS); const f32x4* cx = (const f32x4*)IN_(2); const f32x4* xx = (const f32x4*)IN_(0);
      for (size_t i = gt; i < (size_t)T * DM / 4; i += NGT) xs[i] = i < (size_t)NCTX * DM / 4 ? cx[i] : xx[i - (size_t)NCTX * DM / 4]; }
    { float* HP = (float*)(ws + WS_HP);
      for (int it = F.bid; it < NL * 16; it += F.G) { const int l = it >> 4, ch = it & 15, w = F.tid >> 8, j = F.tid & 255;
          const float* cv = w ? IN_(3) : IN_(1); const float* ad = IN_(4) + ((size_t)l * DM + ch * 256) * 256 + j; float s = 0.f;
          for (int i = 0; i < 256; ++i) s += siluf_(cv[ch * 256 + i]) * ad[(size_t)i * 256];
          HP[((l * 16 + ch) * 2 + w) * 256 + j] = s; } }
    { float* H3 = (float*)(ws + WS_H3);
      LAS float* zb = (LAS float*)(F.lds + 73728); LAS float* ha = zb + 8 * 36; LAS float* hb = ha + 8 * 64;
      for (int it = F.bid; it < NL * (T / 8); it += F.G) { const int l = it / (T / 8), pb = it % (T / 8);
          if (F.tid < 8 * 33) { const int p = F.tid / 33, i = F.tid % 33, P = pb * 8 + p; const int L = P < NCTX ? NCTX : SEQ, t = P < NCTX ? P : P - NCTX;
              float z;
              if (i == 0) z = (float)t / (float)(L - 1);
              else { const int b = (i - 1) & 15; const float fb = 1e-4f + (float)b * ((15.0f - 1e-4f) / 15.0f); const float rev2 = 2.0f * fb * (float)t / (float)L;
                  z = i <= 16 ? cospif(rev2) : -sinpif(rev2); }
              zb[p * 36 + i] = z; }
          __syncthreads();
          const int p = F.tid >> 6, j = F.tid & 63; const float fq = IN_(36)[l * 64 + j];
          { const float* w1 = IN_(29) + (size_t)l * 33 * 64 + j; float s = IN_(30)[l * 64 + j];
            for (int i = 0; i < 33; ++i) s += zb[p * 36 + i] * w1[i * 64];
            ha[p * 64 + j] = sinf(fq * s); }
          __syncthreads();
          { const float* w2 = IN_(31) + (size_t)l * 64 * 64 + j; float s = IN_(32)[l * 64 + j];
            for (int i = 0; i < 64; ++i) s += ha[p * 64 + i] * w2[i * 64];
            hb[p * 64 + j] = sinf(fq * s); }
          __syncthreads();
          { const float* w3 = IN_(33) + (size_t)l * 64 * 64 + j; float s = IN_(34)[l * 64 + j];
            for (int i = 0; i < 64; ++i) s += hb[p * 64 + i] * w3[i * 64];
            ((bf16_t*)H3)[((size_t)l * 64 + j) * T + pb * 8 + p] = (bf16_t)(cvt_pk_bf16(sinf(fq * s), 0.f) & 0xffffu); }
          __syncthreads(); } }
}
__device__ __forceinline__ void phase_mod(const Frame& F, unsigned char* ws) {
    const float* HP = (const float*)(ws + WS_HP); float* MOD = (float*)(ws + WS_MOD);
    LAS float* hs = (LAS float*)F.lds;
    for (int it = F.bid; it < NL * (NMOD / 512); it += F.G) { const int l = it / (NMOD / 512), nb = it % (NMOD / 512);
        { const int w = F.tid >> 8, j = F.tid & 255; float s = 0.f;
          for (int ch = 0; ch < 16; ++ch) s += HP[((l * 16 + ch) * 2 + w) * 256 + j];
          hs[w * 256 + j] = s; }
        __syncthreads();
        const int n = nb * 512 + F.tid; const float* au = IN_(5) + (size_t)l * 256 * NMOD + n; float s0 = IN_(6)[(size_t)l * NMOD + n], s1 = s0;
        for (int j = 0; j < 256; ++j) { const float u = au[(size_t)j * NMOD]; s0 += hs[j] * u; s1 += hs[256 + j] * u; }
        MOD[((size_t)l * 2 + 0) * NMOD + n] = s0; MOD[((size_t)l * 2 + 1) * NMOD + n] = s1;
        __syncthreads(); }
}
__device__ __forceinline__ void norm_phase(const Frame& F, float* XS, const float* __restrict__ gain, const float* modx, const float* modc, int ish, int isc, bf16_t* out, const bf16_t* slab, const float* sgate, float sfac) {
    const int gw = F.bid * 8 + F.wave, NGW = F.G * 8;
    int row_lo = 0;
    if (slab) { row_lo = NCTX;
        LAS float* red = (LAS float*)F.lds;
        for (int row = F.bid; row < NCTX; row += F.G) { const size_t o = (size_t)row * DM + F.wave * 512;
            f32x4 v[2]; float s = 0.f;
#pragma unroll
            for (int j = 0; j < 2; ++j) { f32x4 acc = (f32x4){0.f, 0.f, 0.f, 0.f};
#pragma unroll
                for (int ks = 0; ks < 16; ++ks) acc += bf4f(((const u32x2*)(slab + (size_t)ks * NCTX * DM + o) + F.lane)[64 * j]);
                v[j] = ((const f32x4*)(XS + o) + F.lane)[64 * j] + acc * ((const f32x4*)(sgate + F.wave * 512) + F.lane)[64 * j] * sfac;
                ((f32x4*)(XS + o) + F.lane)[64 * j] = v[j]; s += (v[j].x * v[j].x + v[j].y * v[j].y) + (v[j].z * v[j].z + v[j].w * v[j].w); }
            s = wave_sum(s); if (F.lane == 0) red[F.wave] = s;
            __syncthreads();
            float tot = 0.f;
#pragma unroll
            for (int w = 0; w < 8; ++w) tot += red[w];
            const float rstd = rsqrtf(tot * (1.0f / DM) + NORM_EPS);
#pragma unroll
            for (int j = 0; j < 2; ++j) { const int c4 = F.wave * 128 + F.lane + 64 * j;
                const f32x4 y = v[j] * rstd * ((const f32x4*)gain)[c4] * (((const f32x4*)(modc + (size_t)isc * DM))[c4] + 1.0f) + ((const f32x4*)(modc + (size_t)ish * DM))[c4];
                u32x2 w2; w2.x = cvt_pk_bf16(y.x, y.y); w2.y = cvt_pk_bf16(y.z, y.w); ((u32x2*)(out + (size_t)row * DM))[c4] = w2; }
            __syncthreads(); } }
    for (int row = row_lo + gw; row < T; row += NGW) {
        const float* mod = row < NCTX ? modc : modx;
        const f32x4* xr = (const f32x4*)(XS + (size_t)row * DM) + F.lane; const f32x4* g4 = (const f32x4*)gain + F.lane;
        const f32x4* sh4 = (const f32x4*)(mod + (size_t)ish * DM) + F.lane; const f32x4* sc4 = (const f32x4*)(mod + (size_t)isc * DM) + F.lane;
        f32x4 v[16]; float s = 0.f;
#pragma unroll
        for (int j = 0; j < 16; ++j) { v[j] = xr[64 * j]; s += (v[j].x * v[j].x + v[j].y * v[j].y) + (v[j].z * v[j].z + v[j].w * v[j].w); }
        const float rstd = rsqrtf(wave_sum(s) * (1.0f / DM) + NORM_EPS);
        u32x2* o = (u32x2*)(out + (size_t)row * DM) + F.lane;
#pragma unroll
        for (int j = 0; j < 16; ++j) { const f32x4 y = v[j] * rstd * g4[64 * j] * (sc4[64 * j] + 1.0f) + sh4[64 * j];
            u32x2 w; w.x = cvt_pk_bf16(y.x, y.y); w.y = cvt_pk_bf16(y.z, y.w); o[64 * j] = w; }
    }
}
__device__ __forceinline__ float conv3_at(const bf16_t* PX, int tau, int col, float w0, float w1, float w2) {
    const bf16_t* p = PX + (size_t)tau * PXW + col;
    const bool hl = has_left(tau), hr = has_right(tau);
    return bf2f(p[0]) * w1 + bf2f(p[hl ? -PXW : 0]) * (hl ? w0 : 0.f) + bf2f(p[hr ? PXW : 0]) * (hr ? w2 : 0.f);
}
__device__ __forceinline__ float rope_apply(float val, int tau, int j) {
    const int pos = tau - NCTX, prow = pos >> 6, pcol = pos & 63;
    const float inv = __powf(10000.0f, -(float)(j & 15) * (1.0f / 16.0f));
    const float ang = (float)(j < 32 ? prow : pcol) * inv;
    float sn, cs; sincosf(ang, &sn, &cs);
    const float partner = __shfl_xor(val, 16);
    const float rot = (j & 16) ? partner : -partner;
    return val * cs + rot * sn;
}
__device__ __forceinline__ void mla_prep_phase(const Frame& F, unsigned char* ws, int l) {
    const bf16_t* PX = (const bf16_t*)(ws + WS_PX); bf16_t* QA = (bf16_t*)(ws + WS_QA); bf16_t* KVA = (bf16_t*)(ws + WS_KVA); bf16_t* KPE = (bf16_t*)(ws + WS_KPE);
    const int gw = F.bid * 8 + F.wave, NGW = F.G * 8;
    const f32x4* gq = (const f32x4*)(IN_(38) + l * 1024) + F.lane; const f32x4* gkv = (const f32x4*)(IN_(40) + l * 512) + F.lane; const float gpe = IN_(45)[l * 64 + F.lane];
    for (int tau = gw; tau < T; tau += NGW) {
        const u32x2* p = (const u32x2*)(PX + (size_t)tau * PXW + PXC) + F.lane;
        f32x4 q[4], kv[2]; float sq = 0.f, skv = 0.f;
#pragma unroll
        for (int j = 0; j < 4; ++j) { q[j] = bf4f(p[64 * j]); sq += (q[j].x * q[j].x + q[j].y * q[j].y) + (q[j].z * q[j].z + q[j].w * q[j].w); }
#pragma unroll
        for (int j = 0; j < 2; ++j) { kv[j] = bf4f(p[256 + 64 * j]); skv += (kv[j].x * kv[j].x + kv[j].y * kv[j].y) + (kv[j].z * kv[j].z + kv[j].w * kv[j].w); }
        const float pe = bf2f(PX[(size_t)tau * PXW + PXC + 1536 + F.lane]);
        const float rq = rsqrtf(wave_sum(sq) * (1.0f / 1024.0f) + NORM_EPS), rkv = rsqrtf(wave_sum(skv) * (1.0f / 512.0f) + NORM_EPS), rpe = rsqrtf(wave_sum(pe * pe) * (1.0f / 64.0f) + NORM_EPS);
        u32x2* oq = (u32x2*)(QA + (size_t)tau * 1024) + F.lane; u32x2* okv = (u32x2*)(KVA + (size_t)tau * 512) + F.lane;
#pragma unroll
        for (int j = 0; j < 4; ++j) { const f32x4 y = q[j] * rq * gq[64 * j]; u32x2 w; w.x = cvt_pk_bf16(y.x, y.y); w.y = cvt_pk_bf16(y.z, y.w); oq[64 * j] = w; }
#pragma unroll
        for (int j = 0; j < 2; ++j) { const f32x4 y = kv[j] * rkv * gkv[64 * j]; u32x2 w; w.x = cvt_pk_bf16(y.x, y.y); w.y = cvt_pk_bf16(y.z, y.w); okv[64 * j] = w; }
        float kp = pe * rpe * gpe;
        if (tau >= NCTX) kp = rope_apply(kp, tau, F.lane);
        KPE[(size_t)tau * 64 + F.lane] = (bf16_t)(cvt_pk_bf16(kp, kp) & 0xffffu);
    }
}
__device__ __forceinline__ void qkv_final_phase(const Frame& F, unsigned char* ws, int l, bool need_ctx) {
    const bf16_t* QRAW = (const bf16_t*)(ws + WS_QRAW); const bf16_t* KVRAW = (const bf16_t*)(ws + WS_KVRAW); const bf16_t* KPE = (const bf16_t*)(ws + WS_KPE);
    bf16_t* QF = (bf16_t*)(ws + WS_QF); bf16_t* KF = (bf16_t*)(ws + WS_KF);
    const int gw = F.bid * 8 + F.wave, NGW = F.G * 8, ln = F.lane;
    const float gqn0 = IN_(42)[l * 128 + 2 * ln], gqn1 = IN_(42)[l * 128 + 2 * ln + 1], gqp = IN_(43)[l * 64 + ln];
    const float gkn0 = IN_(44)[l * 128 + 2 * ln], gkn1 = IN_(44)[l * 128 + 2 * ln + 1];
    (void)need_ctx;
    for (int tau = gw; tau < T; tau += NGW) {
        float cs = 1.f, sn = 0.f;
        if (tau >= NCTX) { const int pos = tau - NCTX, prow = pos >> 6, pcol = pos & 63; const float inv = __powf(10000.0f, -(float)(ln & 15) * (1.0f / 16.0f)); sincosf((float)(ln < 32 ? prow : pcol) * inv, &sn, &cs); }
        const bf16_t kpe = KPE[(size_t)tau * 64 + ln];
        const bf16_t* qrow = QRAW + (size_t)tau * NQ; const bf16_t* krow = KVRAW + (size_t)tau * NKV;
        unsigned qn[NHC], kn[NHC]; bf16_t qpv[NHC];
#pragma unroll
        for (int h = 0; h < NHC; ++h) { qn[h] = *(const unsigned*)(qrow + h * 192 + 2 * ln); qpv[h] = qrow[h * 192 + 128 + ln]; kn[h] = *(const unsigned*)(krow + h * 256 + 2 * ln); }
#pragma unroll
        for (int h = 0; h < NHC; ++h) {
            const float q0 = bf2f((unsigned short)(qn[h] & 0xffffu)), q1 = bf2f((unsigned short)(qn[h] >> 16)), qp = bf2f(qpv[h]), k0 = bf2f((unsigned short)(kn[h] & 0xffffu)), k1 = bf2f((unsigned short)(kn[h] >> 16));
            const float rqn = rsqrtf(wave_sum(q0 * q0 + q1 * q1) * (1.0f / 128.0f) + NORM_EPS), rqp = rsqrtf(wave_sum(qp * qp) * (1.0f / 64.0f) + NORM_EPS), rkn = rsqrtf(wave_sum(k0 * k0 + k1 * k1) * (1.0f / 128.0f) + NORM_EPS);
            float qpe = qp * rqp * gqp;
            { const float partner = __shfl_xor(qpe, 16); const float rot = (ln & 16) ? partner : -partner; qpe = qpe * cs + rot * sn; }
            *(unsigned*)(QF + (size_t)tau * NQ + h * 192 + 2 * ln) = cvt_pk_bf16(q0 * rqn * gqn0, q1 * rqn * gqn1);
            QF[(size_t)tau * NQ + h * 192 + 128 + ln] = (bf16_t)(cvt_pk_bf16(qpe, qpe) & 0xffffu);
            *(unsigned*)(KF + (size_t)tau * NQ + h * 192 + 2 * ln) = cvt_pk_bf16(k0 * rkn * gkn0, k1 * rkn * gkn1);
            KF[(size_t)tau * NQ + h * 192 + 128 + ln] = kpe; }
    }
}
__device__ __forceinline__ void rwkv_out_phase(const Frame& F, unsigned char* ws, int l, bool need_ctx) {
    const float* SS = (const float*)(ws + WS_SS); const float* SD = (const float*)(ws + WS_SD); const float* GB = (const float*)(ws + WS_G); const float* Y = (const float*)(ws + WS_Y);
    bf16_t* OB = (bf16_t*)(ws + WS_OBUF);
    const int gw = F.bid * 8 + F.wave, NGW = F.G * 8, ln = F.lane;
    for (int it = (need_ctx ? 0 : NCTX * 5) + gw; it < T * 5; it += NGW) { const int tau = it / 5, h0 = (it % 5) * 4;
        float y0[4], y1[4], v[4], sa[4], sb[4], g[4];
#pragma unroll
        for (int q = 0; q < 4; ++q) { const int h = h0 + q, col = h * 64 + ln; const size_t o = (size_t)tau * A_W + col;
            y0[q] = Y[o]; y1[q] = Y[(size_t)T * A_W + o]; v[q] = SS[(size_t)T * A_W + o];
            sa[q] = SD[(size_t)tau * NHA + h]; sb[q] = SD[((size_t)T + tau) * NHA + h]; g[q] = GB[o]; }
#pragma unroll
        for (int q = 0; q < 4; ++q) { const int col = (h0 + q) * 64 + ln;
            const float y = y0[q] + y1[q];
            const float mu = wave_sum(y) * (1.0f / 64.0f); const float dy = y - mu; const float var = wave_sum(dy * dy) * (1.0f / 64.0f);
            const float yn = dy * rsqrtf(var + GN_EPS) * IN_(25)[l * A_W + col] + IN_(26)[l * A_W + col];
            const float bonus = 0.5f * (sa[q] + sb[q]) * v[q];
            const float ov = (yn + bonus) * g[q];
            OB[(size_t)tau * DM + col] = (bf16_t)(cvt_pk_bf16(ov, ov) & 0xffffu); }
    }
}
__device__ __forceinline__ void hyena_prep_phase(const Frame& F, unsigned char* ws, int l) {
    const bf16_t* PX = (const bf16_t*)(ws + WS_PX); float* GT = (float*)(ws + WS_GT); float* X0T = (float*)(ws + WS_X0T);
    LAS float* LGt = (LAS float*)F.lds; LAS float* LX0 = LGt + 64 * 65;
    const float* cw = IN_(27) + (size_t)l * 3 * B_IN; const float* cb = IN_(28) + (size_t)l * B_IN;
    for (int it = F.bid; it < (T / 64) * 20; it += F.G) { const int tt = it / 20, ct = it % 20;
        { const int t = F.tid >> 3, c0 = ct * 64 + (F.tid & 7) * 8, tau = tt * 64 + t;
          f32x4 u[3][2];
#pragma unroll
          for (int grp = 0; grp < 3; ++grp)
#pragma unroll
              for (int q = 0; q < 2; ++q) { const int c = grp * 1280 + c0 + 4 * q; const bf16_t* p = PX + (size_t)tau * PXW + PXB + c;
                  const bool hl = has_left(tau), hr = has_right(tau);
                  const f32x4 y = bf4f(*(const u32x2*)p) * *(const f32x4*)(cw + B_IN + c) + *(const f32x4*)(cb + c) + bf4f(*(const u32x2*)(p - (hl ? PXW : 0))) * (*(const f32x4*)(cw + c) * (hl ? 1.f : 0.f))
                                + bf4f(*(const u32x2*)(p + (hr ? PXW : 0))) * (*(const f32x4*)(cw + 2 * B_IN + c) * (hr ? 1.f : 0.f));
                  u[grp][q] = y; }
#pragma unroll
          for (int q = 0; q < 2; ++q)
#pragma unroll
              for (int e = 0; e < 4; ++e) { const int ch = (F.tid & 7) * 8 + 4 * q + e; LGt[ch * 65 + t] = u[1][q][e] * u[2][q][e]; LX0[ch * 65 + t] = u[0][q][e]; } }
        __syncthreads();
        { const int ch = F.tid >> 3, t0 = (F.tid & 7) * 8; const size_t o = (size_t)(ct * 64 + ch) * T + tt * 64 + t0;
          f32x4 a0, a1, b0, b1;
#pragma unroll
          for (int e = 0; e < 4; ++e) { a0[e] = LGt[ch * 65 + t0 + e]; a1[e] = LGt[ch * 65 + t0 + 4 + e]; b0[e] = LX0[ch * 65 + t0 + e]; b1[e] = LX0[ch * 65 + t0 + 4 + e]; }
          *(f32x4*)(GT + o) = a0; *(f32x4*)(GT + o + 4) = a1; *(f32x4*)(X0T + o) = b0; *(f32x4*)(X0T + o + 4) = b1; }
        __syncthreads(); }
}
__device__ __forceinline__ void hyena_out_phase(const Frame& F, unsigned char* ws, bool need_ctx) {
    const float* YT = (const float*)(ws + WS_GT); bf16_t* OB = (bf16_t*)(ws + WS_OBUF);
    LAS float* L = (LAS float*)F.lds;
    const int it0 = need_ctx ? 0 : (NCTX / 64) * 20;
    for (int it = it0 + F.bid; it < (T / 64) * 20; it += F.G) { const int tt = it / 20, ct = it % 20;
        { const int ch = F.tid >> 3, t0 = (F.tid & 7) * 8; const size_t o = (size_t)(ct * 64 + ch) * T + tt * 64 + t0;
          const f32x4 a0 = *(const f32x4*)(YT + o), a1 = *(const f32x4*)(YT + o + 4);
#pragma unroll
          for (int e = 0; e < 4; ++e) { L[ch * 65 + t0 + e] = a0[e]; L[ch * 65 + t0 + 4 + e] = a1[e]; } }
        __syncthreads();
        { const int t = F.tid >> 3, c0 = (F.tid & 7) * 8; float x[8];
#pragma unroll
          for (int e = 0; e < 8; ++e) x[e] = L[(c0 + e) * 65 + t];
          u32x4 w; w.x = cvt_pk_bf16(x[0], x[1]); w.y = cvt_pk_bf16(x[2], x[3]); w.z = cvt_pk_bf16(x[4], x[5]); w.w = cvt_pk_bf16(x[6], x[7]);
          *(u32x4*)(OB + (size_t)(tt * 64 + t) * DM + 1280 + ct * 64 + c0) = w; }
        __syncthreads(); }
}
namespace att {
constexpr int DK = 192, DV = 128, NW = 8, QBLK = 32, KVBLK = 64;
constexpr float SCALE = 0.07216878364870322f;
constexpr float THR = 8.f;
#ifndef ATT_SDEPTH
#define ATT_SDEPTH 2
#endif
constexpr int SDEPTH = ATT_SDEPTH;
constexpr int LDQ = 2304, LDK = 2304, LDV = 3072, LDO = 4096;
constexpr int SHM_V = KVBLK * DV * 2, SHM_K = KVBLK * DK * 2, SHM_ATTN = 2 * SHM_V + 2 * SHM_K + NW * 64 * 4 + NW * 4096;
using bf16x8 = __attribute__((ext_vector_type(8))) short;
using s16x4  = __attribute__((ext_vector_type(4))) short;
using f32x16 = __attribute__((ext_vector_type(16))) float;
using u32x4  = __attribute__((ext_vector_type(4))) unsigned;
#define KSWZ(row, colB) ((row) * 384 + ((colB) ^ (((row) & 7) << 4)))
#define SBAR() __builtin_amdgcn_sched_barrier(0)
__device__ __forceinline__ int crow(int r, int hi) { return (r & 3) + 8 * (r >> 2) + 4 * hi; }
__device__ __forceinline__ unsigned cvtpk(float lo, float hi) { unsigned r; asm volatile("v_cvt_pk_bf16_f32 %0, %1, %2" : "=v"(r) : "v"(lo), "v"(hi)); return r; }
__device__ __forceinline__ void partialSM(f32x16& p0, f32x16& p1, float& m_reg, float& mn, float& alpha) {
  constexpr float C = SCALE * 1.4426950408889634f;
  float pmax = p0[0]; for (int r = 1; r < 16; ++r) pmax = fmaxf(pmax, p0[r]); for (int r = 0; r < 16; ++r) pmax = fmaxf(pmax, p1[r]);
  { auto rr = __builtin_amdgcn_permlane32_swap(__float_as_uint(pmax), __float_as_uint(pmax), false, false);
    pmax = fmaxf(__uint_as_float(rr[0]), __uint_as_float(rr[1])); }
  if (__builtin_expect(__all(pmax - m_reg <= THR / SCALE), 1)) { mn = m_reg; alpha = 1.f; }
  else { mn = fmaxf(m_reg, pmax); alpha = __builtin_amdgcn_exp2f((m_reg - mn) * C); m_reg = mn; }
  float mnC = -mn * C;
  for (int r = 0; r < 16; ++r) p0[r] = fmaf(p0[r], C, mnC); for (int r = 0; r < 16; ++r) p1[r] = fmaf(p1[r], C, mnC);
  for (int r = 0; r < 16; ++r) p0[r] = __builtin_amdgcn_exp2f(p0[r]);
}
__device__ __forceinline__ void finishSM(f32x16& p0, f32x16& p1, float alpha, float& l_reg, bf16x8& pa0, bf16x8& pa1, bf16x8& pa2, bf16x8& pa3) {
  for (int r = 0; r < 16; ++r) p1[r] = __builtin_amdgcn_exp2f(p1[r]);
  float ps = 0; for (int r = 0; r < 16; ++r) ps += p0[r]; for (int r = 0; r < 16; ++r) ps += p1[r];
  { auto rr = __builtin_amdgcn_permlane32_swap(__float_as_uint(ps), __float_as_uint(ps), false, false);
    ps = __uint_as_float(rr[0]) + __uint_as_float(rr[1]); }
  l_reg = l_reg * alpha + ps;
#define PK4(P, BASE, OUT) do { unsigned a0 = cvtpk(P[BASE + 0], P[BASE + 1]), a1 = cvtpk(P[BASE + 2], P[BASE + 3]);   \
    unsigned b0 = cvtpk(P[BASE + 4], P[BASE + 5]), b1 = cvtpk(P[BASE + 6], P[BASE + 7]);                              \
    auto r0 = __builtin_amdgcn_permlane32_swap(a0, b0, false, false); auto r1 = __builtin_amdgcn_permlane32_swap(a1, b1, false, false); \
    u32x4 w = {r0[0], r1[0], r0[1], r1[1]}; OUT = *reinterpret_cast<bf16x8*>(&w); } while (0)
  PK4(p0, 0, pa0); PK4(p0, 8, pa1); PK4(p1, 0, pa2); PK4(p1, 8, pa3);
#undef PK4
}
__device__ __forceinline__ void qkt(f32x16& p0, f32x16& p1, const char* Ks, const bf16x8* qr, const char* qrl, int r32, int hi) {
  p0 = f32x16{}; p1 = f32x16{};
#pragma unroll
  for (int d0 = 0; d0 < 8; ++d0) { int cb = (d0 * 16 + hi * 8) * 2;
    bf16x8 b0 = *reinterpret_cast<const bf16x8*>(Ks + KSWZ(r32, cb));
    bf16x8 b1 = *reinterpret_cast<const bf16x8*>(Ks + KSWZ(32 + r32, cb));
    p0 = __builtin_amdgcn_mfma_f32_32x32x16_bf16(b0, qr[d0], p0, 0, 0, 0);
    p1 = __builtin_amdgcn_mfma_f32_32x32x16_bf16(b1, qr[d0], p1, 0, 0, 0); }
#pragma unroll
  for (int d0 = 8; d0 < 12; ++d0) { int cb = (d0 * 16 + hi * 8) * 2;
    bf16x8 b0 = *reinterpret_cast<const bf16x8*>(Ks + KSWZ(r32, cb));
    bf16x8 b1 = *reinterpret_cast<const bf16x8*>(Ks + KSWZ(32 + r32, cb));
    const bf16x8 q = *reinterpret_cast<const bf16x8*>(qrl + ((((d0 - 8) * 2 + hi) ^ (r32 & 7)) << 4));
    p0 = __builtin_amdgcn_mfma_f32_32x32x16_bf16(b0, q, p0, 0, 0, 0);
    p1 = __builtin_amdgcn_mfma_f32_32x32x16_bf16(b1, q, p1, 0, 0, 0); }
}
__device__ __forceinline__ int v_st(int k, int c) { const int kk = (k & ~0xC) | ((k & 4) << 1) | ((k & 8) >> 1); return ((kk >> 3) * 4 + (c >> 5)) * 512 + ((kk & 7) * 32 + (c & 31)) * 2; }
__device__ __forceinline__ int v_rd_base(int lane) { return ((lane & 3) << 3) | (((lane >> 2) & 3) << 6) | (((lane >> 4) & 1) << 5) | (((lane >> 5) & 1) << 8); }
constexpr int v_rd_off(int d0, int ks, int half) { return d0 * 512 + ks * 4096 + half * 2048; }
template <int OFF> __device__ __forceinline__ s16x4 tr_read(int vb) {
  s16x4 r; asm volatile("ds_read_b64_tr_b16 %0, %1 offset:%2" : "=&v"(r) : "v"(vb), "i"(OFF) : "memory"); return r;
}
template <int D0> __device__ __forceinline__ void pv_one(f32x16& od, int vb, bf16x8 pa0, bf16x8 pa1, bf16x8 pa2, bf16x8 pa3) {
  const s16x4 l0 = tr_read<v_rd_off(D0, 0, 0)>(vb), h0 = tr_read<v_rd_off(D0, 0, 1)>(vb), l1 = tr_read<v_rd_off(D0, 1, 0)>(vb), h1 = tr_read<v_rd_off(D0, 1, 1)>(vb);
  const s16x4 l2 = tr_read<v_rd_off(D0, 2, 0)>(vb), h2 = tr_read<v_rd_off(D0, 2, 1)>(vb), l3 = tr_read<v_rd_off(D0, 3, 0)>(vb), h3 = tr_read<v_rd_off(D0, 3, 1)>(vb);
  asm volatile("s_waitcnt lgkmcnt(0)" ::: "memory"); SBAR();
#define PK(L, H) (bf16x8){L[0], L[1], L[2], L[3], H[0], H[1], H[2], H[3]}
  od = __builtin_amdgcn_mfma_f32_32x32x16_bf16(pa0, PK(l0, h0), od, 0, 0, 0);
  od = __builtin_amdgcn_mfma_f32_32x32x16_bf16(pa1, PK(l1, h1), od, 0, 0, 0);
  od = __builtin_amdgcn_mfma_f32_32x32x16_bf16(pa2, PK(l2, h2), od, 0, 0, 0);
  od = __builtin_amdgcn_mfma_f32_32x32x16_bf16(pa3, PK(l3, h3), od, 0, 0, 0);
#undef PK
}
__device__ __forceinline__ void pv_d0(f32x16* o, int vb, bf16x8 pa0, bf16x8 pa1, bf16x8 pa2, bf16x8 pa3) {
  pv_one<0>(o[0], vb, pa0, pa1, pa2, pa3); pv_one<1>(o[1], vb, pa0, pa1, pa2, pa3); pv_one<2>(o[2], vb, pa0, pa1, pa2, pa3); pv_one<3>(o[3], vb, pa0, pa1, pa2, pa3);
}
__device__ __forceinline__ void attn_body(const bf16_t* __restrict__ Qb, const bf16_t* __restrict__ Kh, const bf16_t* __restrict__ Vh, bf16_t* __restrict__ Ob, int seq, char* lds) {
  int tid_ = threadIdx.x; asm volatile("" : "+v"(tid_));
  const int tid = tid_, wid = tid >> 6, lane = tid & 63, r32 = lane & 31, hi = lane >> 5;
  char* V_lds = lds; char* K_lds = lds + 2 * SHM_V;
  float* ws = (float*)(lds + 2 * SHM_V + 2 * SHM_K) + wid * 64; float* li_l = ws; float* al_l = ws + 32;
  float m_reg = -1e30f, l_reg = 0; f32x16 o[4] = {}; bf16x8 qr[8];
  const bf16_t* Qw = Qb + (long)(wid * QBLK + r32) * LDQ + hi * 8;
  char* qrl = lds + 2 * SHM_V + 2 * SHM_K + NW * 64 * 4 + wid * 4096 + r32 * 128;
#pragma unroll
  for (int d0 = 0; d0 < 8; ++d0) qr[d0] = *reinterpret_cast<const bf16x8*>(Qw + d0 * 16);
#pragma unroll
  for (int d0 = 8; d0 < 12; ++d0) *reinterpret_cast<bf16x8*>(qrl + ((((d0 - 8) * 2 + hi) ^ (r32 & 7)) << 4)) = *reinterpret_cast<const bf16x8*>(Qw + d0 * 16);
  asm volatile("s_waitcnt lgkmcnt(0)" ::: "memory");
  unsigned kgo[3], vgo[2];
#pragma unroll
  for (int i = 0; i < 3; ++i) { const int p = (i * 8 + wid) * 64 + lane, row = p / 24, slot = p % 24, ch = slot ^ (row & 7); kgo[i] = (unsigned)(row * LDK + ch * 8) * 2u; }
#pragma unroll
  for (int i = 0; i < 2; ++i) { const int p = (i * 8 + wid) * 64 + lane, sub = p >> 5, within = p & 31, kk = (sub >> 2) * 8 + (within >> 2), c = (sub & 3) * 32 + (within & 3) * 8;
    const int k = (kk & ~0xC) | ((kk & 4) << 1) | ((kk & 8) >> 1); vgo[i] = (unsigned)(k * LDV + c) * 2u; }
  const int vb0 = (int)(uintptr_t)V_lds + v_rd_base(lane);
  typedef __attribute__((address_space(3))) unsigned lds_u32;
#define DMA_K(b, k0) do { const char* kg = (const char*)Kh + (size_t)(k0) * (LDK * 2); \
    _Pragma("unroll") for (int _i = 0; _i < 3; ++_i) __builtin_amdgcn_global_load_lds((const unsigned*)(kg + kgo[_i]), (lds_u32*)(K_lds + (b) * SHM_K + (_i * 8 + wid) * 1024), 16, 0, 0); } while (0)
#define DMA_V(b, k0) do { const char* vg = (const char*)Vh + (size_t)(k0) * (LDV * 2); \
    _Pragma("unroll") for (int _i = 0; _i < 2; ++_i) __builtin_amdgcn_global_load_lds((const unsigned*)(vg + vgo[_i]), (lds_u32*)(V_lds + (b) * SHM_V + (_i * 8 + wid) * 1024), 16, 0, 0); } while (0)
#define RESC(a) do { if (__any((a) < 1.f)) { if (hi == 0) al_l[r32] = (a); asm volatile("s_waitcnt lgkmcnt(0)" ::: "memory"); \
    for (int d = 0; d < 4; ++d) for (int r = 0; r < 16; ++r) o[d][r] *= al_l[crow(r, hi)]; } } while (0)
#define ENDSTEP() do { asm volatile("s_waitcnt vmcnt(0)" ::: "memory"); __syncthreads(); } while (0)
  f32x16 pA0, pA1, pB0, pB1; float mnA, mnB, alA, alB; bf16x8 pa0, pa1, pa2, pa3; const int NT = seq / KVBLK;
  DMA_K(0, 0); ENDSTEP();
  DMA_K(1, KVBLK); DMA_V(0, 0);
  qkt(pA0, pA1, K_lds, qr, qrl, r32, hi); partialSM(pA0, pA1, m_reg, mnA, alA);
  ENDSTEP();
  for (int j = 1; j + 1 < NT; j += 2) {
    DMA_K(0, (j + 1) * KVBLK); DMA_V(1, j * KVBLK);
    SBAR(); qkt(pB0, pB1, K_lds + SHM_K, qr, qrl, r32, hi);
    finishSM(pA0, pA1, alA, l_reg, pa0, pa1, pa2, pa3); SBAR();
    pv_d0(o, vb0, pa0, pa1, pa2, pa3); partialSM(pB0, pB1, m_reg, mnB, alB);
    RESC(alB); ENDSTEP();
    if (j + 2 < NT) DMA_K(1, (j + 2) * KVBLK);
    DMA_V(0, (j + 1) * KVBLK);
    SBAR(); qkt(pA0, pA1, K_lds, qr, qrl, r32, hi);
    finishSM(pB0, pB1, alB, l_reg, pa0, pa1, pa2, pa3); SBAR();
    pv_d0(o, vb0 + (int)SHM_V, pa0, pa1, pa2, pa3); partialSM(pA0, pA1, m_reg, mnA, alA);
    RESC(alA); ENDSTEP();
  }
  DMA_V(1, (NT - 1) * KVBLK);
  SBAR(); qkt(pB0, pB1, K_lds + SHM_K, qr, qrl, r32, hi);
  finishSM(pA0, pA1, alA, l_reg, pa0, pa1, pa2, pa3); SBAR();
  pv_d0(o, vb0, pa0, pa1, pa2, pa3); partialSM(pB0, pB1, m_reg, mnB, alB);
  RESC(alB); ENDSTEP();
  finishSM(pB0, pB1, alB, l_reg, pa0, pa1, pa2, pa3); SBAR();
  pv_d0(o, vb0 + (int)SHM_V, pa0, pa1, pa2, pa3);
#undef DMA_K
#undef DMA_V
#undef ENDSTEP
  if (hi == 0) li_l[r32] = l_reg; asm volatile("s_waitcnt lgkmcnt(0)" ::: "memory");
  float rli[16];
#pragma unroll
  for (int r = 0; r < 16; ++r) rli[r] = __builtin_amdgcn_rcpf(li_l[crow(r, hi)]);
  bf16_t* Ow = Ob + (long)(wid * QBLK) * LDO;
#pragma unroll
  for (int r = 0; r < 16; ++r) { int orow = crow(r, hi);
#pragma unroll
    for (int d0 = 0; d0 < 4; ++d0) { const float val = o[d0][r] * rli[r]; Ow[(long)orow * LDO + d0 * 32 + r32] = (bf16_t)(cvtpk(val, val) & 0xffff); } }
  __syncthreads();
#undef RESC
}
}
__device__ __forceinline__ f32x2 cmul(f32x2 a, f32x2 b) { return (f32x2){a.x * b.x - a.y * b.y, a.x * b.y + a.y * b.x}; }
__device__ __forceinline__ int rev4_14(int k) { const unsigned r = __brev((unsigned)k) >> 18; return (int)(((r & 0x1555u) << 1) | ((r >> 1) & 0x1555u)); }
#define ZI(i) ((i) + ((i) >> 5))
__device__ __forceinline__ void fft_tw(int j, int q, float sign, f32x2& w1, f32x2& w2, f32x2& w3) {
    const float rev = (float)j / (float)(4 * q); const float sn = __builtin_amdgcn_sinf(rev), cs = __builtin_amdgcn_cosf(rev);
    w1 = (f32x2){cs, sign * sn}; w2 = cmul(w1, w1); w3 = cmul(w2, w1);
}
__device__ __forceinline__ void fft16k_dif(LAS f32x2* Z, int tid) {
#pragma unroll 1
    for (int s = 0; s < 7; ++s) { int lq = 12 - 2 * s; asm volatile("" : "+s"(lq)); const int q = 1 << lq;
        const bool shared = q <= 512; f32x2 w1, w2, w3; fft_tw(tid & (q - 1), q, -1.f, w1, w2, w3);
#pragma unroll 2
        for (int i = 0; i < 8; ++i) { const int b = tid + 512 * i, j = b & (q - 1), base = ((b >> lq) << (lq + 2)) + j;
            const int i0 = ZI(base), i1 = ZI(base + q), i2 = ZI(base + 2 * q), i3 = ZI(base + 3 * q);
            const f32x2 a0 = Z[i0], a1 = Z[i1], a2 = Z[i2], a3 = Z[i3];
            const f32x2 t0 = a0 + a2, t1 = a0 - a2, t2 = a1 + a3, t3 = a1 - a3;
            if (!shared) fft_tw(j, q, -1.f, w1, w2, w3);
            Z[i0] = t0 + t2; Z[i1] = cmul((f32x2){t1.x + t3.y, t1.y - t3.x}, w1); Z[i2] = cmul(t0 - t2, w2); Z[i3] = cmul((f32x2){t1.x - t3.y, t1.y + t3.x}, w3); }
        __syncthreads(); }
}
__device__ __forceinline__ void fft16k_dit_inv(LAS f32x2* Z, int tid) {
#pragma unroll 1
    for (int s = 0; s < 7; ++s) { int lq = 2 * s; asm volatile("" : "+s"(lq)); const int q = 1 << lq;
        const bool shared = q <= 512; f32x2 w1, w2, w3; fft_tw(tid & (q - 1), q, 1.f, w1, w2, w3);
#pragma unroll 2
        for (int i = 0; i < 8; ++i) { const int b = tid + 512 * i, j = b & (q - 1), base = ((b >> lq) << (lq + 2)) + j;
            if (!shared) fft_tw(j, q, 1.f, w1, w2, w3);
            const int i0 = ZI(base), i1 = ZI(base + q), i2 = ZI(base + 2 * q), i3 = ZI(base + 3 * q);
            const f32x2 b0 = Z[i0], b1 = cmul(Z[i1], w1), b2 = cmul(Z[i2], w2), b3 = cmul(Z[i3], w3);
            const f32x2 t0 = b0 + b2, t1 = b0 - b2, t2 = b1 + b3, t3 = b1 - b3;
            Z[i0] = t0 + t2; Z[i1] = (f32x2){t1.x - t3.y, t1.y + t3.x}; Z[i2] = t0 - t2; Z[i3] = (f32x2){t1.x + t3.y, t1.y - t3.x}; }
        __syncthreads(); }
}
constexpr float HY_MIN_DECAY = -3.0701134573253945f, HY_MAX_DECAY = -15.350567286626973f;
__device__ __forceinline__ float hy_delta(int c) { return fabsf(HY_MIN_DECAY + (HY_MAX_DECAY - HY_MIN_DECAY) * ((float)c / 1279.0f)); }
__device__ __forceinline__ float conv3b_at(const bf16_t* PX, int tau, int col, const float* cw, int l, int c) {
    const float* w = cw + (size_t)l * 3 * B_IN;
    return conv3_at(PX, tau, col, w[c], w[B_IN + c], w[2 * B_IN + c]);
}
__device__ __forceinline__ void hyena_taps_unit(const Frame& F, unsigned char* ws, int l, int pair) {
    LAS f32x2* Z = (LAS f32x2*)F.lds; LAS float* red = (LAS float*)(F.lds + LDS_MISC + 128);
    const int tid = F.tid, c0 = 2 * pair;
    const bf16_t* H3x = (const bf16_t*)(ws + WS_H3) + (size_t)l * 64 * T + NCTX;
    f32x2* scr = (f32x2*)(ws + WS_HSCR) + (size_t)pair * 16384; float* htn = (float*)(ws + WS_HSCR + (size_t)640 * 16384 * 8) + 2 * pair;
    LAS f32x4* FW = (LAS f32x4*)(F.lds + LDS_MISC + 256);
    if (tid < 256) { const int j = tid >> 2, q = tid & 3; ((LAS float*)FW)[tid] = IN_(35)[(size_t)l * 64 * 2560 + (size_t)j * 2560 + (q >> 1) * 1280 + c0 + (q & 1)]; }
    __syncthreads();
    const float d0 = hy_delta(c0), d1 = hy_delta(c0 + 1);
#ifndef HYS
#define HYS 31
#endif
    float s0, s1, sc0 = 0.f, sc1 = 0.f;
    {
    s0 = 0.f; s1 = 0.f;
    if (HYS & 1)
#pragma unroll 1
    for (int i = 0; i < 2; ++i) { const int tb = 4096 * i + 8 * tid; const bf16_t* hc = H3x + tb;
        asm volatile("" ::: "memory");
        f32x4 acc[8];
#pragma unroll
        for (int p = 0; p < 8; ++p) acc[p] = (f32x4){0.f, 0.f, 0.f, 0.f};
#pragma unroll 8
        for (int j = 0; j < 64; ++j) { const f32x4 w = FW[j]; const u32x4 hv = *(const u32x4*)(hc + (size_t)j * T);
#pragma unroll
            for (int p = 0; p < 4; ++p) { acc[2 * p] += w * __uint_as_float(hv[p] << 16); acc[2 * p + 1] += w * __uint_as_float(hv[p] & 0xffff0000u); } }
#pragma unroll
        for (int p = 0; p < 8; ++p) { const int t = tb + p;
            const float tl = (float)t * (1.0f / 8191.0f), e0 = __expf(-tl * d0), e1 = __expf(-tl * d1);
            const float f0 = acc[p].x * e0, f1 = acc[p].y * e1, b0 = acc[p].z * e0, b1 = acc[p].w * e1;
            Z[ZI(t)] = (f32x2){f0, f1}; s0 += fabsf(f0); s1 += fabsf(f1);
            if (t < 8191) { Z[ZI(16383 - t)] = (f32x2){b0, b1}; s0 += fabsf(b0); s1 += fabsf(b1); } } }
    if (tid == 0) { float zz = 0.f; asm volatile("" : "+v"(zz)); Z[ZI(8192)] = (f32x2){zz, zz}; }
    s0 = wave_sum(s0); s1 = wave_sum(s1);
    if (F.lane == 0) { red[F.wave * 2] = s0; red[F.wave * 2 + 1] = s1; }
    __syncthreads();
    float n0 = 0.f, n1 = 0.f;
#pragma unroll
    for (int w = 0; w < 8; ++w) { n0 += red[2 * w]; n1 += red[2 * w + 1]; }
    sc0 = 1.0f / (16384.0f * n0); sc1 = 1.0f / (16384.0f * n1);
    if (HYS & 2) fft16k_dif(Z, tid);
#pragma unroll 4
    for (int i = 0; i < 32; ++i) scr[tid + 512 * i] = Z[ZI(tid + 512 * i)];
    __syncthreads();
    }
    if (tid == 0) { htn[0] = sc0; htn[1] = sc1; }
    __syncthreads();
}
__device__ __forceinline__ void hyena_unit(const Frame& F, unsigned char* ws, int l, int pair) {
    LAS f32x2* Z = (LAS f32x2*)F.lds;
    const int tid = F.tid, c0 = 2 * pair;
    float* GT = (float*)(ws + WS_GT); const float* X0T = (const float*)(ws + WS_X0T);
    const f32x2* scr = (const f32x2*)(ws + WS_HSCR) + (size_t)pair * 16384; const float* htn = (const float*)(ws + WS_HSCR + (size_t)640 * 16384 * 8) + 2 * pair;
    const float sc0 = htn[0], sc1 = htn[1];
#ifndef HYS
#define HYS 31
#endif
    for (int rp15 = 0; rp15 < REP(15); ++rp15) {
    const float* g0p = GT + (size_t)c0 * T + NCTX; const float* g1p = g0p + T;
    { float zz = 0.f; asm volatile("" : "+v"(zz));
#pragma unroll 4
      for (int i = 0; i < 16; ++i) { const int t = tid + 512 * i; Z[ZI(t)] = (f32x2){g0p[t], g1p[t]}; Z[ZI(8192 + t)] = (f32x2){zz, zz}; } }
    __syncthreads();
    if (HYS & 2) fft16k_dif(Z, tid);
    if (HYS & 8)
#pragma unroll 2
    for (int i = 0; i < 17; ++i) { const int k = tid + 512 * i; if (i == 16 && tid != 0) break;
        const int pk = rev4_14(k & 16383), pn = rev4_14((16384 - k) & 16383);
        const f32x2 A = Z[ZI(pk)], B = Z[ZI(pn)], At = scr[pk], Bt = scr[pn];
        const f32x2 G0 = (f32x2){0.5f * (A.x + B.x), 0.5f * (A.y - B.y)}, G1 = (f32x2){0.5f * (A.y + B.y), -0.5f * (A.x - B.x)};
        const f32x2 H0 = (f32x2){0.5f * (At.x + Bt.x), 0.5f * (At.y - Bt.y)}, H1 = (f32x2){0.5f * (At.y + Bt.y), -0.5f * (At.x - Bt.x)};
        const f32x2 P0 = cmul(G0, H0), P1 = cmul(G1, H1);
        Z[ZI(pk)] = (f32x2){P0.x - P1.y, P0.y + P1.x};
        if (pn != pk) Z[ZI(pn)] = (f32x2){P0.x + P1.y, P1.x - P0.y}; }
    __syncthreads();
    if (HYS & 2) fft16k_dit_inv(Z, tid);
    }
    const float bb0 = IN_(37)[l * 1280 + c0], bb1 = IN_(37)[l * 1280 + c0 + 1];
    { float* y0p = GT + (size_t)c0 * T + NCTX; float* y1p = y0p + T; const float* x0p = X0T + (size_t)c0 * T + NCTX; const float* x1p = x0p + T;
#pragma unroll 4
      for (int i = 0; i < 16; ++i) { const int t = tid + 512 * i; const f32x2 z = Z[ZI(t)]; const float ga = y0p[t], gb = y1p[t];
          y0p[t] = x0p[t] * (z.x * sc0 + ga * bb0); y1p[t] = x1p[t] * (z.y * sc1 + gb * bb1); } }
    __syncthreads();
}
__device__ __forceinline__ void hyena_ctx_unit(const Frame& F, unsigned char* ws, int l, int unit) {
    LAS float* TF = (LAS float*)F.lds; LAS float* TB = TF + 2048; LAS float* GG = TB + 2048;
    const int tid = F.tid, t = tid >> 1, cc = (tid & 1) * 4, cbase = unit * 8 + cc;
    const bf16_t* H3c = (const bf16_t*)(ws + WS_H3) + (size_t)l * 64 * T; float* GT = (float*)(ws + WS_GT); const float* X0T = (const float*)(ws + WS_X0T);
    { float f[4] = {0.f, 0.f, 0.f, 0.f}, b[4] = {0.f, 0.f, 0.f, 0.f};
      const float* wbase = IN_(35) + (size_t)l * 64 * 2560 + cbase;
      for (int j = 0; j < 64; ++j) { const float hv = bf2f(H3c[(size_t)j * T + t]); const float* wrow = wbase + (size_t)j * 2560;
#pragma unroll
          for (int q = 0; q < 4; ++q) { f[q] += hv * wrow[q]; b[q] += hv * wrow[1280 + q]; } }
      const float tl = (float)t * (1.0f / 255.0f);
#pragma unroll
      for (int q = 0; q < 4; ++q) { const float e = __expf(-tl * hy_delta(cbase + q)); TF[t * 8 + cc + q] = f[q] * e; TB[t * 8 + cc + q] = b[q] * e; GG[t * 8 + cc + q] = GT[(size_t)(cbase + q) * T + t]; } }
    __syncthreads();
    float nrm[4] = {0.f, 0.f, 0.f, 0.f}, y[4] = {0.f, 0.f, 0.f, 0.f};
    for (int s = 0; s < 256; ++s) {
#pragma unroll
        for (int q = 0; q < 4; ++q) { nrm[q] += fabsf(TF[s * 8 + cc + q]) + (s < 255 ? fabsf(TB[s * 8 + cc + q]) : 0.f);
            const int o = t - s; const float tap = o >= 0 ? TF[o * 8 + cc + q] : TB[(-o - 1) * 8 + cc + q];
            y[q] += tap * GG[s * 8 + cc + q]; } }
    __syncthreads();
#pragma unroll
    for (int q = 0; q < 4; ++q) GT[(size_t)(cbase + q) * T + t] = X0T[(size_t)(cbase + q) * T + t] * (y[q] / nrm[q] + GG[t * 8 + cc + q] * IN_(37)[l * 1280 + cbase + q]);
    __syncthreads();
}
constexpr int SC_C = 16, SC_NCHUNK = T / SC_C, SC_CHUNK_BYTES = 14 * 1024;
__device__ __forceinline__ int sc_tau(int d, int c, int t) { return d == 0 ? SC_C * c + t : (c < NCTX / SC_C ? NCTX - 1 - SC_C * c - t : T - 1 - SC_C * (c - NCTX / SC_C) - t); }
__device__ __forceinline__ int sc_perm(int e, int hi) { return (e & 3) + 8 * (e >> 2) + 4 * hi; }
constexpr size_t WS_FR_BYTES = (size_t)2 * NHA * SC_NCHUNK * SC_CHUNK_BYTES;

typedef short sc_bf16x8 __attribute__((ext_vector_type(8)));
typedef float sc_f32x16 __attribute__((ext_vector_type(16)));
__device__ __forceinline__ sc_bf16x8 sc_pack8(const sc_f32x16& a, int base) {
    u32x4 w; w.x = cvt_pk_bf16(a[base + 0], a[base + 1]); w.y = cvt_pk_bf16(a[base + 2], a[base + 3]); w.z = cvt_pk_bf16(a[base + 4], a[base + 5]); w.w = cvt_pk_bf16(a[base + 6], a[base + 7]);
    return *reinterpret_cast<sc_bf16x8*>(&w);
}
constexpr int SC_NSLOT = 9, SC_AHEAD = 7;
__device__ __forceinline__ void scan_chain_mfma(const Frame& F, unsigned char* ws, int chain) {
    const int h = chain >> 1, d = chain & 1, lane = F.lane, n = lane & 31, hi = lane >> 5, ib = F.wave;
    const unsigned char* FRc = ws + WS_FR + (size_t)chain * SC_NCHUNK * SC_CHUNK_BYTES;
    float* Yd = (float*)(ws + WS_Y) + (size_t)d * T * A_W + h * 64;
    LAS unsigned char* buf = F.lds;
    typedef __attribute__((address_space(3))) unsigned sc_lds_u32;
#define SCM_DMA(c_) do { if (ib < 7) { const unsigned char* src_ = FRc + (size_t)(c_) * SC_CHUNK_BYTES; LAS unsigned char* dst_ = buf + ((c_) % SC_NSLOT) * SC_CHUNK_BYTES; \
        _Pragma("unroll") for (int i_ = 0; i_ < 2; ++i_) __builtin_amdgcn_global_load_lds((const unsigned*)(src_ + (i_ * 7 + ib) * 1024 + lane * 16), (sc_lds_u32*)(dst_ + (i_ * 7 + ib) * 1024), 16, 0, 0); } } while (0)
    sc_f32x16 S0 = {}, S1 = {};
    int yoff[8];
#pragma unroll
    for (int r = 0; r < 8; ++r) { const int t = (r & 3) + 8 * (r >> 2) + 4 * hi; yoff[r] = (d ? -t : t) * A_W + 32 * ib + n; }
    __syncthreads();
#pragma unroll
    for (int c = 0; c < SC_AHEAD; ++c) SCM_DMA(c);
    asm volatile("s_waitcnt vmcnt(12)" ::: "memory"); __builtin_amdgcn_s_barrier(); asm volatile("" ::: "memory");
#pragma unroll 1
    for (int c = 0; c < SC_NCHUNK; ++c) {
        const bool steady = c + SC_AHEAD < SC_NCHUNK;
        if (steady) SCM_DMA(c + SC_AHEAD);
        if (ib < 2) {
                const LAS unsigned char* fb = buf + (c % SC_NSLOT) * SC_CHUNK_BYTES;
                sc_bf16x8 fr[11]; sc_bf16x8 vf; f32x4 gt[8];
                { const unsigned fa = (unsigned)(uintptr_t)fb + lane * 16, va = fa + (11 + ib) * 1024, ga = (unsigned)(uintptr_t)fb + 13 * 1024 + hi * 128;
#define SC_DSRD(dst, addr, off) asm volatile("ds_read_b128 %0, %1 offset:%2" : "=v"(dst) : "v"(addr), "i"(off))
                  SC_DSRD(fr[0], fa, 0); SC_DSRD(fr[1], fa, 1024); SC_DSRD(fr[2], fa, 2048); SC_DSRD(fr[3], fa, 3072); SC_DSRD(fr[4], fa, 4096); SC_DSRD(fr[5], fa, 5120);
                  SC_DSRD(fr[6], fa, 6144); SC_DSRD(fr[7], fa, 7168); SC_DSRD(fr[8], fa, 8192); SC_DSRD(fr[9], fa, 9216); SC_DSRD(fr[10], fa, 10240); SC_DSRD(vf, va, 0);
                  SC_DSRD(gt[0], ga, 0); SC_DSRD(gt[1], ga, 16); SC_DSRD(gt[2], ga, 32); SC_DSRD(gt[3], ga, 48); SC_DSRD(gt[4], ga, 64); SC_DSRD(gt[5], ga, 80); SC_DSRD(gt[6], ga, 96); SC_DSRD(gt[7], ga, 112);
#undef SC_DSRD
                  asm volatile("s_waitcnt lgkmcnt(0)" : "+v"(fr[0]), "+v"(fr[1]), "+v"(fr[2]), "+v"(fr[3]), "+v"(fr[4]), "+v"(fr[5]), "+v"(fr[6]), "+v"(fr[7]), "+v"(fr[8]), "+v"(fr[9]), "+v"(fr[10]), "+v"(vf) :: "memory");
                  asm volatile("" : "+v"(gt[0]), "+v"(gt[1]), "+v"(gt[2]), "+v"(gt[3]), "+v"(gt[4]), "+v"(gt[5]), "+v"(gt[6]), "+v"(gt[7])); }
                const sc_bf16x8 sb00 = sc_pack8(S0, 0), sb01 = sc_pack8(S0, 8), sb10 = sc_pack8(S1, 0), sb11 = sc_pack8(S1, 8);
                sc_f32x16 P = {}, P2 = {};
                P = __builtin_amdgcn_mfma_f32_32x32x16_bf16(fr[0], sb00, P, 0, 0, 0);
                P2 = __builtin_amdgcn_mfma_f32_32x32x16_bf16(fr[2], sb10, P2, 0, 0, 0);
                P = __builtin_amdgcn_mfma_f32_32x32x16_bf16(fr[1], sb01, P, 0, 0, 0);
                P2 = __builtin_amdgcn_mfma_f32_32x32x16_bf16(fr[3], sb11, P2, 0, 0, 0);
                P = __builtin_amdgcn_mfma_f32_32x32x16_bf16(fr[4], vf, P, 0, 0, 0);
#pragma unroll
                for (int q = 0; q < 4; ++q)
#pragma unroll
                    for (int e = 0; e < 4; ++e) { S0[4 * q + e] *= gt[q][e]; S1[4 * q + e] *= gt[4 + q][e]; }
                S0 = __builtin_amdgcn_mfma_f32_32x32x16_bf16(fr[8], vf, S0, 0, 0, 0);
                S1 = __builtin_amdgcn_mfma_f32_32x32x16_bf16(fr[10], vf, S1, 0, 0, 0);
#pragma unroll
                for (int r = 0; r < 16; ++r) P[r] += P2[r];
                const sc_bf16x8 xb = sc_pack8(P, 0);
                sc_f32x16 U = {};
                U = __builtin_amdgcn_mfma_f32_32x32x16_bf16(fr[5], xb, U, 0, 0, 0);
                const sc_bf16x8 ub = sc_pack8(U, 0);
                S0 = __builtin_amdgcn_mfma_f32_32x32x16_bf16(fr[7], ub, S0, 0, 0, 0);
                S1 = __builtin_amdgcn_mfma_f32_32x32x16_bf16(fr[9], ub, S1, 0, 0, 0);
                P = __builtin_amdgcn_mfma_f32_32x32x16_bf16(fr[6], ub, P, 0, 0, 0);
                float* yb = Yd + (size_t)sc_tau(d, c, 0) * A_W;
#pragma unroll
                for (int r = 0; r < 8; ++r) yb[yoff[r]] = P[8 + r];
        }
        if (steady) asm volatile("s_waitcnt vmcnt(12)" ::: "memory"); else asm volatile("s_waitcnt vmcnt(0)" ::: "memory");
        asm volatile("s_waitcnt lgkmcnt(0)" ::: "memory"); __builtin_amdgcn_s_barrier(); asm volatile("" ::: "memory");
    }
    asm volatile("s_waitcnt vmcnt(0)" ::: "memory"); __syncthreads();
#undef SCM_DMA
}
__device__ __forceinline__ float conv3_u(const float* PX, int tau, unsigned ucol, float w0, float w1, float w2) {
    const float* p = PX + (size_t)tau * PXW;
    float y = p[ucol] * w1;
    if (has_left(tau)) y += (p - PXW)[ucol] * w0;
    if (has_right(tau)) y += (p + PXW)[ucol] * w2;
    return y;
}
constexpr int WLR_K = 448;
constexpr int RP_WAVE_LDS = 16896;
typedef short rp_bf16x8 __attribute__((ext_vector_type(8)));
typedef float rp_f32x16 __attribute__((ext_vector_type(16)));
__device__ __forceinline__ unsigned short f2bf16(float x) { return (unsigned short)(cvt_pk_bf16(x, x) & 0xffffu); }
template <int NKB, class AF>
__device__ __forceinline__ void rp_lowrank(float (&dst)[16], const AF& afrag, const bf16_t* WLRh, int kw0, int n, int hi) {
    rp_f32x16 c0 = {}, c1 = {}; const bf16_t* wb0 = WLRh + (size_t)n * WLR_K + kw0 + 8 * hi; const bf16_t* wb1 = wb0 + (size_t)32 * WLR_K;
#pragma unroll
    for (int kb = 0; kb < NKB; ++kb) { const rp_bf16x8 b0 = *(const rp_bf16x8*)(wb0 + 16 * kb), b1 = *(const rp_bf16x8*)(wb1 + 16 * kb); const rp_bf16x8 a_ = afrag(kb);
        c0 = __builtin_amdgcn_mfma_f32_32x32x16_bf16(a_, b0, c0, 0, 0, 0); c1 = __builtin_amdgcn_mfma_f32_32x32x16_bf16(a_, b1, c1, 0, 0, 0); }
#pragma unroll
    for (int r = 0; r < 8; ++r) { auto sw = __builtin_amdgcn_permlane32_swap(__float_as_uint(c0[r]), __float_as_uint(c1[r]), false, false);
        dst[(r & 3) + 8 * (r >> 2)] = __uint_as_float(sw[0]); dst[(r & 3) + 8 * (r >> 2) + 4] = __uint_as_float(sw[1]); }
}
struct RpAfLds { const LAS bf16_t* base; __device__ __forceinline__ rp_bf16x8 operator()(int kb) const { return *(const LAS rp_bf16x8*)(base + 16 * kb); } };
__device__ __forceinline__ void rwkv_elem_phase(const Frame& F, unsigned char* ws, int l) {
    const float* PX = (const float*)(ws + WS_PX); float* SS = (float*)(ws + WS_SS); float* SD = (float*)(ws + WS_SD); float* GB = (float*)(ws + WS_G);
    const bf16_t* WLR = (const bf16_t*)(ws + WS_WLR) + (size_t)l * A_W * WLR_K;
    const float* cw = IN_(16) + (size_t)l * 3 * A_IN;
    LAS bf16_t* ACT = (LAS bf16_t*)(F.lds + F.wave * 10752);
    const int lane = F.lane, n = lane & 31, hi = lane >> 5;
    const int gw = F.bid * 8 + F.wave, NGW = F.G * 8;
    for (int it = gw; it < (T / 16) * 10; it += NGW) {
        const int tg = it / 10, hq = it % 10, tau0 = tg * 16;
        asm volatile("s_waitcnt lgkmcnt(0)" ::: "memory");
        const float* prow0 = PX + (size_t)(tau0 > 0 ? tau0 - 1 : 0) * PXW; const int roff = tau0 > 0 ? 0 : -1;
#define RP_WIN(x, ucol_) do { _Pragma("unroll") for (int i_ = 0; i_ < 18; ++i_) { int ri_ = i_ + roff; ri_ = ri_ < 0 ? 0 : ri_; ri_ = (tau0 - 1 + i_ > T - 1) ? (T - 1 - (tau0 > 0 ? tau0 - 1 : 0)) : ri_; x[i_] = (prow0 + (size_t)ri_ * PXW)[ucol_]; } } while (0)
#define RP_CONV(x, t_, w0_, w1_, w2_) (x[(t_)] * (has_left(tau0 + (t_)) ? (w0_) : 0.f) + x[(t_) + 1] * (w1_) + x[(t_) + 2] * (has_right(tau0 + (t_)) ? (w2_) : 0.f))
#pragma unroll
        for (int i = 0; i < 5; ++i) { const int c = lane + 64 * i, col = 3840 + c; const float c0 = cw[col], c1 = cw[A_IN + col], c2 = cw[2 * A_IN + col];
            float x[18]; RP_WIN(x, (unsigned)(PXA + col));
#pragma unroll
            for (int t = 0; t < 16; ++t) { const float val = RP_CONV(x, t, c0, c1, c2);
                const float act = i == 0 ? 1.0f - 2.0f / (1.0f + __expf(2.0f * val)) : (i == 1 ? val : sigmoidf_(val));
                ACT[t * 328 + c] = f2bf16(act); } }
        asm volatile("s_waitcnt lgkmcnt(0)" ::: "memory");
        const RpAfLds afw{ACT + (n & 15) * 328 + 8 * hi}, afa{ACT + (n & 15) * 328 + 64 + 8 * hi}, afg{ACT + (n & 15) * 328 + 128 + 8 * hi};
#pragma unroll 1
        for (int hh = 0; hh < 2; ++hh) {
            const int h = hq * 2 + hh, col = h * 64 + lane; const bf16_t* WLRh = WLR + (size_t)h * 64 * WLR_K;
            { float lg[16]; rp_lowrank<12>(lg, afg, WLRh, 256, n, hi);
#pragma unroll
              for (int t = 0; t < 16; ++t) GB[(size_t)(tau0 + t) * A_W + col] = lg[t]; }
            const float cr0 = cw[col], cr1 = cw[A_IN + col], cr2 = cw[2 * A_IN + col];
            const float ck0 = cw[A_W + col], ck1 = cw[A_IN + A_W + col], ck2 = cw[2 * A_IN + A_W + col];
            const float cv0 = cw[2 * A_W + col], cv1 = cw[A_IN + 2 * A_W + col], cv2 = cw[2 * A_IN + 2 * A_W + col];
            const float kk_w = IN_(22)[l * A_W + col], ka_w = IN_(23)[l * A_W + col];
            float kkv[16], kv[16];
            { float xr[18], xk[18], xv[18]; const unsigned uc = (unsigned)(PXA + col); RP_WIN(xr, uc); RP_WIN(xk, uc + A_W); RP_WIN(xv, uc + 2 * A_W);
#pragma unroll
              for (int t = 0; t < 16; ++t) { const int tau = tau0 + t;
                  const float r = RP_CONV(xr, t, cr0, cr1, cr2), v = RP_CONV(xv, t, cv0, cv1, cv2); kv[t] = RP_CONV(xk, t, ck0, ck1, ck2);
                  const float kr = kv[t] * kk_w; const float nrm = sqrtf(wave_sum(kr * kr)); kkv[t] = kr / fmaxf(nrm, 1e-12f);
                  float* ss = SS + ((size_t)h * T + tau) * 192 + lane; ss[0] = kkv[t]; ss[64] = r; ss[128] = v; } }
#pragma unroll 1
            for (int d = 0; d < 2; ++d) { const float w0b = IN_(17)[(l * 2 + d) * A_W + col], a0b = IN_(19)[(l * 2 + d) * A_W + col]; float lw[16], la[16];
                rp_lowrank<4>(lw, afw, WLRh, 64 * d, n, hi); rp_lowrank<4>(la, afa, WLRh, 128 + 64 * d, n, hi);
#pragma unroll
                for (int t = 0; t < 16; ++t) { const float z = w0b + lw[t]; const float decay = __expf(-__expf(-(fmaxf(-z, 0.f) + __logf(1.0f + __expf(-fabsf(z)))) - 0.5f)); const float av = sigmoidf_(a0b + la[t]);
                    float* sd = SD + (((size_t)h * 2 + d) * T + tau0 + t) * 192 + lane; sd[0] = decay; sd[64] = kkv[t] * av; sd[128] = kv[t] * (1.0f + (av - 1.0f) * ka_w); } }
        }
    }
}
#undef RP_WIN
#undef RP_CONV
constexpr int SP_WAVE_LDS = 16640;
__device__ __forceinline__ void scan_prep_phase(const Frame& F, unsigned char* ws) {
    const float* SS = (const float*)(ws + WS_SS); const float* SD = (const float*)(ws + WS_SD); unsigned char* FR = ws + WS_FR;
    LAS bf16_t* R1 = (LAS bf16_t*)(F.lds + F.wave * SP_WAVE_LDS); LAS bf16_t* R2 = R1 + 32 * 72; LAS bf16_t* BbT = R2 + 32 * 72; LAS bf16_t* KbT = BbT + 64 * 16; LAS bf16_t* VT = KbT + 64 * 16; LAS float* Lm = (LAS float*)(VT + 64 * 16);
    const int lane = F.lane, n = lane & 31, hi = lane >> 5;
    const int gw = F.bid * 8 + F.wave, NGW = F.G * 8;
    for (int it = gw; it < 2 * NHA * SC_NCHUNK; it += NGW) {
        const int chain = it / SC_NCHUNK, c = it % SC_NCHUNK, h = chain >> 1, d = chain & 1;
        const int tau_first = sc_tau(d, c, 0), dstep = d ? -1 : 1;
        const float* ssb = SS + (size_t)h * T * 192 + lane; const float* sdb = SD + ((size_t)h * 2 + d) * T * 192 + lane;
        float xw[16], xb[16], xk[16], xkk[16], xr[16], xv[16];
#pragma unroll
        for (int s = 0; s < 16; ++s) { const size_t o = (size_t)(tau_first + dstep * s) * 192; xw[s] = sdb[o]; xb[s] = sdb[o + 64]; xk[s] = sdb[o + 128]; xkk[s] = ssb[o]; xr[s] = ssb[o + 64]; xv[s] = ssb[o + 128]; }
        float gC = 1.f;
#pragma unroll
        for (int s = 0; s < 16; ++s) gC *= xw[s];
        float g = 1.f;
#pragma unroll
        for (int s = 0; s < 16; ++s) {
            const float gm1 = g; g *= xw[s]; const float ig = 1.0f / g; const float bh = xb[s] * ig, kh = xk[s] * ig;
            R1[s * 72 + lane] = f2bf16(-xkk[s] * gm1); R1[(16 + s) * 72 + lane] = f2bf16(xr[s] * g);
            R2[s * 72 + lane] = f2bf16(bh); R2[(16 + s) * 72 + lane] = f2bf16(kh);
            BbT[lane * 16 + s] = f2bf16(bh * gC); KbT[lane * 16 + s] = f2bf16(kh * gC); VT[lane * 16 + s] = f2bf16(xv[s]); }
        asm volatile("s_waitcnt lgkmcnt(0)" ::: "memory");
        unsigned char* dst = FR + ((size_t)chain * SC_NCHUNK + c) * SC_CHUNK_BYTES;
        rp_f32x16 C = {};
#pragma unroll
        for (int kb = 0; kb < 4; ++kb) { const rp_bf16x8 a_ = *(const LAS rp_bf16x8*)(R2 + n * 72 + 16 * kb + 8 * hi), b_ = *(const LAS rp_bf16x8*)(R1 + n * 72 + 16 * kb + 8 * hi);
            C = __builtin_amdgcn_mfma_f32_32x32x16_bf16(a_, b_, C, 0, 0, 0); }
        const int tt_ = n & 15; const bool incl = n >= 16;
#pragma unroll
        for (int r = 0; r < 16; ++r) { const int s = ((r & 7) & 3) + 8 * ((r & 7) >> 2) + 4 * hi; if (!(s < tt_ || (incl && s == tt_))) C[r] = 0.f; }
        if (n < 16) {
#pragma unroll
            for (int r = 0; r < 8; ++r) Lm[((r & 3) + 8 * (r >> 2) + 4 * hi) * 20 + n] = C[r]; }
        { u32x4 f4; f4.x = cvt_pk_bf16(C[8], C[9]); f4.y = cvt_pk_bf16(C[10], C[11]); f4.z = cvt_pk_bf16(C[12], C[13]); f4.w = cvt_pk_bf16(C[14], C[15]);
          u32x4 f6; f6.x = cvt_pk_bf16(C[0], C[1]); f6.y = cvt_pk_bf16(C[2], C[3]); f6.z = cvt_pk_bf16(C[4], C[5]); f6.w = cvt_pk_bf16(C[6], C[7]);
          if (n < 16) f6 = (u32x4){0u, 0u, 0u, 0u};
          *(u32x4*)(dst + 4 * 1024 + lane * 16) = f4; *(u32x4*)(dst + 6 * 1024 + lane * 16) = f6; }
        asm volatile("s_waitcnt lgkmcnt(0)" ::: "memory");
        { float Tc[16];
#pragma unroll
          for (int s = 15; s >= 0; --s) { float acc = (s == n) ? 1.f : 0.f;
#pragma unroll
              for (int u = s + 1; u < 16; ++u) acc += Lm[s * 20 + u] * Tc[u];
              Tc[s] = acc; }
          u32x4 f5; f5.x = cvt_pk_bf16(hi ? Tc[4] : Tc[0], hi ? Tc[5] : Tc[1]); f5.y = cvt_pk_bf16(hi ? Tc[6] : Tc[2], hi ? Tc[7] : Tc[3]);
          f5.z = cvt_pk_bf16(hi ? Tc[12] : Tc[8], hi ? Tc[13] : Tc[9]); f5.w = cvt_pk_bf16(hi ? Tc[14] : Tc[10], hi ? Tc[15] : Tc[11]);
          if (n >= 16) f5 = (u32x4){0u, 0u, 0u, 0u};
          *(u32x4*)(dst + 5 * 1024 + lane * 16) = f5; }
#pragma unroll
        for (int f = 0; f < 4; ++f) { const u32x2 p0 = *(const LAS u32x2*)(R1 + n * 72 + 16 * f + 4 * hi), p1 = *(const LAS u32x2*)(R1 + n * 72 + 16 * f + 8 + 4 * hi);
            *(u32x4*)(dst + f * 1024 + lane * 16) = (u32x4){p0.x, p0.y, p1.x, p1.y}; }
#pragma unroll
        for (int jb = 0; jb < 2; ++jb) { const int row = 32 * jb + n;
            const u32x2 b0 = *(const LAS u32x2*)(BbT + row * 16 + 4 * hi), b1 = *(const LAS u32x2*)(BbT + row * 16 + 8 + 4 * hi), k0 = *(const LAS u32x2*)(KbT + row * 16 + 4 * hi), k1 = *(const LAS u32x2*)(KbT + row * 16 + 8 + 4 * hi);
            const u32x2 v0 = *(const LAS u32x2*)(VT + row * 16 + 4 * hi), v1 = *(const LAS u32x2*)(VT + row * 16 + 8 + 4 * hi);
            *(u32x4*)(dst + (7 + 2 * jb) * 1024 + lane * 16) = (u32x4){b0.x, b0.y, b1.x, b1.y}; *(u32x4*)(dst + (8 + 2 * jb) * 1024 + lane * 16) = (u32x4){k0.x, k0.y, k1.x, k1.y};
            *(u32x4*)(dst + (11 + jb) * 1024 + lane * 16) = (u32x4){v0.x, v0.y, v1.x, v1.y}; }
        { const int jj = lane & 31; ((float*)(dst + 13 * 1024))[((jj >> 2) & 1) * 32 + (lane >> 5) * 16 + (jj & 3) + 4 * (jj >> 3)] = gC; }
        asm volatile("s_waitcnt lgkmcnt(0)" ::: "memory");
    }
}
constexpr int RF_ACT_BYTES = 16 * 320 * 2;
__device__ __forceinline__ void rwkv_fused_phase(const Frame& F, unsigned char* ws, int l) {
    const bf16_t* PX = (const bf16_t*)(ws + WS_PX); unsigned char* FR = ws + WS_FR;
    float* GB = (float*)(ws + WS_G); float* VB = (float*)(ws + WS_SS) + (size_t)T * A_W; float* BS = (float*)(ws + WS_SD);
    const bf16_t* WLR = (const bf16_t*)(ws + WS_WLR) + (size_t)l * A_W * WLR_K;
    const float* cw = IN_(16) + (size_t)l * 3 * A_IN;
    LAS bf16_t* ACT = (LAS bf16_t*)F.lds;
    LAS bf16_t* R1 = (LAS bf16_t*)(F.lds + RF_ACT_BYTES + F.wave * SP_WAVE_LDS); LAS bf16_t* R2 = R1 + 32 * 72; LAS bf16_t* BbT = R2 + 32 * 72; LAS bf16_t* KbT = BbT + 64 * 16; LAS bf16_t* VT = KbT + 64 * 16; LAS float* Lm = (LAS float*)(VT + 64 * 16);
    const int lane = F.lane, n = lane & 31, hi = lane >> 5, hh = F.wave >> 1, d = F.wave & 1;
    for (int it = F.bid; it < (T / 16) * 5; it += F.G) {
        const int tg = it / 5, hg = it % 5, tau0 = tg * 16, h = hg * 4 + hh, col = h * 64 + lane;
        __syncthreads();
        for (int e = F.tid; e < 16 * 320; e += 512) { const int t = e / 320, c = e % 320, cc = 3840 + c;
            const float val = conv3_at(PX, tau0 + t, PXA + cc, cw[cc], cw[A_IN + cc], cw[2 * A_IN + cc]);
            const float act = c < 64 ? 1.0f - 2.0f / (1.0f + __expf(2.0f * val)) : (c < 128 ? val : sigmoidf_(val));
            ACT[t * 320 + c] = f2bf16(act); }
        __syncthreads();
        const bf16_t* prow0 = PX + (size_t)(tau0 > 0 ? tau0 - 1 : 0) * PXW; const int roff = tau0 > 0 ? 0 : -1;
#define RP_WIN(x, ucol_) do { _Pragma("unroll") for (int i_ = 0; i_ < 18; ++i_) { int ri_ = i_ + roff; ri_ = ri_ < 0 ? 0 : ri_; ri_ = (tau0 - 1 + i_ > T - 1) ? (T - 1 - (tau0 > 0 ? tau0 - 1 : 0)) : ri_; x[i_] = bf2f((prow0 + (size_t)ri_ * PXW)[ucol_]); } } while (0)
#define RP_CONV(x, t_, w0_, w1_, w2_) (x[(t_)] * (has_left(tau0 + (t_)) ? (w0_) : 0.f) + x[(t_) + 1] * (w1_) + x[(t_) + 2] * (has_right(tau0 + (t_)) ? (w2_) : 0.f))
        const bf16_t* WLRh = WLR + (size_t)h * 64 * WLR_K;
        const RpAfLds afw{ACT + (n & 15) * 320 + 8 * hi}, afa{ACT + (n & 15) * 320 + 64 + 8 * hi}, afg{ACT + (n & 15) * 320 + 128 + 8 * hi};
        float xw[16], xb[16], xk[16], xkk[16], xr[16], xv[16];
        { float wr_[18], wk_[18], wv_[18]; const unsigned uc = (unsigned)(PXA + col); RP_WIN(wr_, uc); RP_WIN(wk_, uc + A_W); RP_WIN(wv_, uc + 2 * A_W);
          if (d == 0) { float lg[16]; rp_lowrank<12>(lg, afg, WLRh, 256, n, hi);
#pragma unroll
              for (int t = 0; t < 16; ++t) GB[(size_t)(tau0 + t) * A_W + col] = lg[t]; }
          const float cr0 = cw[col], cr1 = cw[A_IN + col], cr2 = cw[2 * A_IN + col], ck0 = cw[A_W + col], ck1 = cw[A_IN + A_W + col], ck2 = cw[2 * A_IN + A_W + col];
          const float cv0 = cw[2 * A_W + col], cv1 = cw[A_IN + 2 * A_W + col], cv2 = cw[2 * A_IN + 2 * A_W + col], kk_w = IN_(22)[l * A_W + col];
#pragma unroll
          for (int t = 0; t < 16; ++t) { xr[t] = RP_CONV(wr_, t, cr0, cr1, cr2); xv[t] = RP_CONV(wv_, t, cv0, cv1, cv2); xk[t] = RP_CONV(wk_, t, ck0, ck1, ck2);
              const float kr = xk[t] * kk_w; const float nrm = sqrtf(wave_sum(kr * kr)); xkk[t] = kr / fmaxf(nrm, 1e-12f); } }
        if (d == 0) {
#pragma unroll
            for (int t = 0; t < 16; ++t) VB[(size_t)(tau0 + t) * A_W + col] = xv[t]; }
        { const float ka_w = IN_(23)[l * A_W + col], w0b = IN_(17)[(l * 2 + d) * A_W + col], a0b = IN_(19)[(l * 2 + d) * A_W + col]; float la[16];
          rp_lowrank<4>(xw, afw, WLRh, 64 * d, n, hi); rp_lowrank<4>(la, afa, WLRh, 128 + 64 * d, n, hi);
#pragma unroll
          for (int t = 0; t < 16; ++t) { const float z = w0b + xw[t]; xw[t] = __expf(-__expf(-(fmaxf(-z, 0.f) + __logf(1.0f + __expf(-fabsf(z)))) - 0.5f)); const float av = sigmoidf_(a0b + la[t]);
              xb[t] = xkk[t] * av; xk[t] = xk[t] * (1.0f + (av - 1.0f) * ka_w); }
          { const float rk_w = IN_(24)[l * A_W + col]; float pr[16];
#pragma unroll
            for (int t = 0; t < 16; ++t) pr[t] = xr[t] * xk[t] * rk_w;
            const float sb = wave_sum16(pr, lane);
            if ((lane & 3) == 0) BS[((size_t)d * T + tau0 + (lane >> 2)) * NHA + h] = sb; } }
        if (d) {
#pragma unroll
            for (int s = 0; s < 8; ++s) { float t_;
                t_ = xw[s]; xw[s] = xw[15 - s]; xw[15 - s] = t_; t_ = xb[s]; xb[s] = xb[15 - s]; xb[15 - s] = t_; t_ = xk[s]; xk[s] = xk[15 - s]; xk[15 - s] = t_;
                t_ = xkk[s]; xkk[s] = xkk[15 - s]; xkk[15 - s] = t_; t_ = xr[s]; xr[s] = xr[15 - s]; xr[15 - s] = t_; t_ = xv[s]; xv[s] = xv[15 - s]; xv[15 - s] = t_; } }
        const int c = d == 0 ? tg : (tg < NCTX / 16 ? NCTX / 16 - 1 - tg : NCTX / 16 + (T / 16 - 1) - tg);
        float gC = 1.f;
#pragma unroll
        for (int s = 0; s < 16; ++s) gC *= xw[s];
        float g = 1.f;
#pragma unroll
        for (int s = 0; s < 16; ++s) {
            const float gm1 = g; g *= xw[s]; const float ig = 1.0f / g; const float bh = xb[s] * ig, kh = xk[s] * ig;
            R1[s * 72 + lane] = f2bf16(-xkk[s] * gm1); R1[(16 + s) * 72 + lane] = f2bf16(xr[s] * g);
            R2[s * 72 + lane] = f2bf16(bh); R2[(16 + s) * 72 + lane] = f2bf16(kh);
            BbT[lane * 16 + s] = f2bf16(bh * gC); KbT[lane * 16 + s] = f2bf16(kh * gC); VT[lane * 16 + s] = f2bf16(xv[s]); }
        asm volatile("s_waitcnt lgkmcnt(0)" ::: "memory");
        unsigned char* dst = FR + ((size_t)(h * 2 + d) * SC_NCHUNK + c) * SC_CHUNK_BYTES;
        rp_f32x16 C = {};
#pragma unroll
        for (int kb = 0; kb < 4; ++kb) { const rp_bf16x8 a_ = *(const LAS rp_bf16x8*)(R2 + n * 72 + 16 * kb + 8 * hi), b_ = *(const LAS rp_bf16x8*)(R1 + n * 72 + 16 * kb + 8 * hi);
            C = __builtin_amdgcn_mfma_f32_32x32x16_bf16(a_, b_, C, 0, 0, 0); }
        const int tt_ = n & 15; const bool incl = n >= 16;
#pragma unroll
        for (int r = 0; r < 16; ++r) { const int s = ((r & 7) & 3) + 8 * ((r & 7) >> 2) + 4 * hi; if (!(s < tt_ || (incl && s == tt_))) C[r] = 0.f; }
        if (n < 16) {
#pragma unroll
            for (int r = 0; r < 8; ++r) Lm[((r & 3) + 8 * (r >> 2) + 4 * hi) * 20 + n] = C[r]; }
        { u32x4 f4; f4.x = cvt_pk_bf16(C[8], C[9]); f4.y = cvt_pk_bf16(C[10], C[11]); f4.z = cvt_pk_bf16(C[12], C[13]); f4.w = cvt_pk_bf16(C[14], C[15]);
          u32x4 f6; f6.x = cvt_pk_bf16(C[0], C[1]); f6.y = cvt_pk_bf16(C[2], C[3]); f6.z = cvt_pk_bf16(C[4], C[5]); f6.w = cvt_pk_bf16(C[6], C[7]);
          if (n < 16) f6 = (u32x4){0u, 0u, 0u, 0u};
          *(u32x4*)(dst + 4 * 1024 + lane * 16) = f4; *(u32x4*)(dst + 6 * 1024 + lane * 16) = f6; }
        asm volatile("s_waitcnt lgkmcnt(0)" ::: "memory");
        { float Tc[16];
#pragma unroll
          for (int s = 15; s >= 0; --s) { float acc = (s == n) ? 1.f : 0.f;
#pragma unroll
              for (int u = s + 1; u < 16; ++u) acc += Lm[s * 20 + u] * Tc[u];
              Tc[s] = acc; }
          u32x4 f5; f5.x = cvt_pk_bf16(hi ? Tc[4] : Tc[0], hi ? Tc[5] : Tc[1]); f5.y = cvt_pk_bf16(hi ? Tc[6] : Tc[2], hi ? Tc[7] : Tc[3]);
          f5.z = cvt_pk_bf16(hi ? Tc[12] : Tc[8], hi ? Tc[13] : Tc[9]); f5.w = cvt_pk_bf16(hi ? Tc[14] : Tc[10], hi ? Tc[15] : Tc[11]);
          if (n >= 16) f5 = (u32x4){0u, 0u, 0u, 0u};
          *(u32x4*)(dst + 5 * 1024 + lane * 16) = f5; }
#pragma unroll
        for (int f = 0; f < 4; ++f) { const u32x2 p0 = *(const LAS u32x2*)(R1 + n * 72 + 16 * f + 4 * hi), p1 = *(const LAS u32x2*)(R1 + n * 72 + 16 * f + 8 + 4 * hi);
            *(u32x4*)(dst + f * 1024 + lane * 16) = (u32x4){p0.x, p0.y, p1.x, p1.y}; }
#pragma unroll
        for (int jb = 0; jb < 2; ++jb) { const int row = 32 * jb + n;
            const u32x2 b0 = *(const LAS u32x2*)(BbT + row * 16 + 4 * hi), b1 = *(const LAS u32x2*)(BbT + row * 16 + 8 + 4 * hi), k0 = *(const LAS u32x2*)(KbT + row * 16 + 4 * hi), k1 = *(const LAS u32x2*)(KbT + row * 16 + 8 + 4 * hi);
            const u32x2 v0 = *(const LAS u32x2*)(VT + row * 16 + 4 * hi), v1 = *(const LAS u32x2*)(VT + row * 16 + 8 + 4 * hi);
            *(u32x4*)(dst + (7 + 2 * jb) * 1024 + lane * 16) = (u32x4){b0.x, b0.y, b1.x, b1.y}; *(u32x4*)(dst + (8 + 2 * jb) * 1024 + lane * 16) = (u32x4){k0.x, k0.y, k1.x, k1.y};
            *(u32x4*)(dst + (11 + jb) * 1024 + lane * 16) = (u32x4){v0.x, v0.y, v1.x, v1.y}; }
        { const int jj = lane & 31; ((float*)(dst + 13 * 1024))[((jj >> 2) & 1) * 32 + (lane >> 5) * 16 + (jj & 3) + 4 * (jj >> 3)] = gC; }
        asm volatile("s_waitcnt lgkmcnt(0)" ::: "memory");
    }
#undef RP_WIN
#undef RP_CONV
}
__device__ __forceinline__ void mixer_phase(const Frame& F0, unsigned char* ws0, int lq, bool need_ctx, char* lds_g) {
    const int l = lq & 3;
#ifndef MK_MIX
#define MK_MIX 15
#endif
    { const Frame F = opq(F0); unsigned char* ws = opq_ptr(ws0);
      if (MK_MIX & 1) for (int chain = F.bid; chain < 2 * NHA; chain += F.G) scan_chain_mfma(F, ws, chain); }
    const Frame& F = F0;
    const int n_xa = 32 * NHC, n_ca = need_ctx ? NHC : 0, n_att = n_xa + n_ca, n_hy = 640, n_ch = need_ctx ? 160 : 0;
    unsigned* qatt = (unsigned*)(ws0 + WS_CTL) + CW_QUEUE + 64 * lq; unsigned* qhy = qatt + 32;
    int item;
#define MIX_POP(q) do { if (F.tid == 0) F.MISC[16] = __hip_atomic_fetch_add((q), 1u, __ATOMIC_RELAXED, __HIP_MEMORY_SCOPE_AGENT); __syncthreads(); item = (int)F.MISC[16]; __syncthreads(); } while (0)
    if (F.bid >= 2 * NHA) {
        MIX_POP(qatt);
        while (item < n_att) {
            if (MK_MIX & 2) { unsigned char* ws = opq_ptr(ws0);
                const bf16_t* QF = (const bf16_t*)(ws + WS_QF); const bf16_t* KF = (const bf16_t*)(ws + WS_KF); const bf16_t* KVRAW = (const bf16_t*)(ws + WS_KVRAW); bf16_t* OB = (bf16_t*)(ws + WS_OBUF);
                const bool is_xa = item < n_xa; const int h = is_xa ? item % NHC : item - n_xa, row0 = is_xa ? NCTX + (item / NHC) * 256 : 0;
                for (int rp = 0; rp < REP(13); ++rp) att::attn_body(QF + (size_t)row0 * NQ + h * 192, KF + h * 192, KVRAW + h * 256 + 128, OB + (size_t)row0 * DM + 2560 + h * 128, is_xa ? T : NCTX, lds_g); }
            MIX_POP(qatt);
        }
    }
    MIX_POP(qhy);
    while (item < n_hy + n_ch) {
        const Frame Fu = opq(F0); unsigned char* ws = opq_ptr(ws0);
        if ((MK_MIX & 4) && item < n_hy) hyena_unit(Fu, ws, l, item);
        else if ((MK_MIX & 8) && item >= n_hy) hyena_ctx_unit(Fu, ws, l, item - n_hy);
        MIX_POP(qhy);
    }
#undef MIX_POP
}

__device__ __forceinline__ void hyena_taps_tail(const Frame& F0, unsigned char* ws0, int lt, int first, int end) {
    if (F0.bid < 48) return;
#pragma unroll 1
    for (int p = first + F0.bid - 48; p < end; p += 208) hyena_taps_unit(opq(F0), opq_ptr(ws0), lt, p);
}
constexpr int NPH = 2 + 14 * NL;
__global__ void __launch_bounds__(512, 2) mk_fwd(Args a) {
    extern __shared__ __attribute__((aligned(16))) unsigned char lds[];
    Frame F; F.lds = (LAS unsigned char*)lds; F.MISC = (volatile LAS unsigned*)(F.lds + LDS_MISC);
    F.tid = threadIdx.x; F.lane = F.tid & 63; F.wave = __builtin_amdgcn_readfirstlane(F.tid >> 6); F.bid = blockIdx.x; F.G = gridDim.x;
    if (F.tid < 64) F.MISC[F.tid] = 0u;
    if (F.tid < 46) *(LAS unsigned long long*)(F.lds + LDS_PTAB + 8 * F.tid) = (unsigned long long)(uintptr_t)a.in[F.tid];
    __syncthreads();
    unsigned char* ws = a.ws;
    const int lo = a.ph_lo, hi = a.ph_hi;
    XcdBarrier bar = xcd_barrier_post((unsigned*)(ws + WS_CTL) + CW_BAR, F.MISC + 8);
#ifndef MK_MASK
#define MK_MASK 0xffff
#endif
#define EN(x) (((MK_MASK) >> (x)) & 1)
#define IN(k) (lo <= (k) && (k) < hi)
#define SEAM(k) do { if (IN(k) && IN((k) + 1)) xcd_barrier(bar); } while (0)
#define WSP opq_ptr(ws)
#define P_XS(w) ((float*)((w) + WS_XS))
#define P_ABUF(w) ((bf16_t*)((w) + WS_ABUF))
#define P_HBUF(w) ((bf16_t*)((w) + WS_HBUF))
#define P_OBUF(w) ((bf16_t*)((w) + WS_OBUF))
#define P_MODX(w, l) ((const float*)((w) + WS_MOD) + ((size_t)(l) * 2 + 0) * NMOD)
#define P_MODC(w, l) ((const float*)((w) + WS_MOD) + ((size_t)(l) * 2 + 1) * NMOD)
#define P_WL(w, l) ((const bf16_t*)((w) + WS_WB) + (size_t)(l) * W_LAYER)
    if (EN(0) && IN(0)) for (int rp = 0; rp < REP(0); ++rp) phase0(opq(F), opq_ptr(ws));
    SEAM(0);
    if (EN(1) && IN(1)) phase_mod(opq(F), opq_ptr(ws));
    SEAM(1);
#pragma clang loop unroll(full)
    for (int l = 0; l < NL; ++l) {
        const int pb = 2 + 14 * l; const bool need_ctx = l < NL - 1;
        if (EN(2) && IN(pb + 0)) for (int rp = 0; rp < REP(2); ++rp) { unsigned char* w = WSP; norm_phase(opq(F), P_XS(w), IN_(7) + l * DM, P_MODX(w, l), P_MODC(w, l), 0, 1, P_ABUF(w), l > 0 ? (const bf16_t*)(w + WS_SLAB) : nullptr, l > 0 ? P_MODC(w, l - 1) + 8 * DM : nullptr, 0.5f); }
        SEAM(pb + 0);
        if (EN(3) && IN(pb + 1)) { unsigned char* w = WSP; pg8::Gemm g{P_ABUF(w), P_WL(w, l) + W_G1, T, 2 * FF, DM, DM}; pg8::StaticOrder S; S.init(T, 2 * FF, F.G, F.bid); pg8::EpiSwiGLU E{P_HBUF(w), FF};
            pg8::gemm_phase<pg8::EpiSwiGLU, pg8::StaticOrder>(F.lds, g, S, E, nullptr);
            hyena_taps_tail(F, ws, l, 0, l == 0 ? 640 : 416); }
        SEAM(pb + 1);
        if (EN(4) && IN(pb + 2)) {
            { unsigned char* w = WSP; pg8::Gemm g{P_HBUF(w), P_WL(w, l) + W_D1, T, DM, FF, FF}; pg8::StaticOrderX S; S.init(T, DM, F.G, F.bid); pg8::EpiResid E{P_XS(w), P_MODX(w, l) + 2 * DM, P_MODC(w, l) + 2 * DM, 0.5f, nullptr};
              pg8::gemm_phase<pg8::EpiResid, pg8::StaticOrderX>(F.lds, g, S, E, nullptr); }
            if (true) { __syncthreads();
              if (F.bid < 256) { unsigned char* w = WSP; const int ks = F.bid >> 4, ksz = FF / 16; pg8::Gemm g{P_HBUF(w) + ks * ksz, P_WL(w, l) + W_D1 + ks * ksz, NCTX, DM, ksz, FF}; pg8::OneUnit S{F.bid & 15};
                  pg8::EpiBf16<0> E{(bf16_t*)(w + WS_SLAB) + (size_t)ks * NCTX * DM, DM, nullptr, 0, 0};
                  pg8::gemm_phase<pg8::EpiBf16<0>, pg8::OneUnit>(F.lds, g, S, E, nullptr); } }
        }
        SEAM(pb + 2);
        if (EN(5) && IN(pb + 3)) for (int rp = 0; rp < REP(2); ++rp) { unsigned char* w = WSP; norm_phase(opq(F), P_XS(w), IN_(8) + l * DM, P_MODX(w, l), P_MODC(w, l), 3, 4, P_ABUF(w), (const bf16_t*)(w + WS_SLAB), P_MODC(w, l) + 2 * DM, 0.5f); }
        SEAM(pb + 3);
        if (EN(6) && IN(pb + 4)) { unsigned char* w = WSP; pg8::Gemm g{P_ABUF(w), P_WL(w, l) + W_IN, T, PXW, DM, DM}; pg8::StaticOrder S; S.init(T, PXW, F.G, F.bid); pg8::EpiBf16<0> E{(bf16_t*)(w + WS_PX), PXW, nullptr, 0, 0};
            pg8::gemm_phase<pg8::EpiBf16<0>, pg8::StaticOrder>(F.lds, g, S, E, nullptr); }
        SEAM(pb + 4);
        if (EN(7) && IN(pb + 5)) { for (int rp = 0; rp < REP(7); ++rp) rwkv_fused_phase(opq(F), opq_ptr(ws), l); if (!(MK_ONLYRP)) { for (int rp = 0; rp < REP(8); ++rp) mla_prep_phase(opq(F), opq_ptr(ws), l); hyena_prep_phase(opq(F), opq_ptr(ws), l); } }
        SEAM(pb + 5);
        if (EN(8) && IN(pb + 6)) {
            { unsigned char* w = WSP; pg8::Gemm g{(const bf16_t*)(w + WS_QA), P_WL(w, l) + W_Q, T, NQ, 1024, 1024}; pg8::StaticOrder S; S.init(T, NQ, F.G, F.bid); pg8::EpiBf16<0> E{(bf16_t*)(w + WS_QRAW), NQ, nullptr, 0, 0};
              pg8::gemm_phase<pg8::EpiBf16<0>, pg8::StaticOrder>(F.lds, g, S, E, nullptr); }
            __syncthreads();
            { unsigned char* w = WSP; pg8::Gemm g{(const bf16_t*)(w + WS_KVA), P_WL(w, l) + W_KV, T, NKV, 512, 512}; pg8::StaticOrder S; S.init(T, NKV, F.G, F.bid); pg8::EpiBf16<0> E{(bf16_t*)(w + WS_KVRAW), NKV, nullptr, 0, 0};
              pg8::gemm_phase<pg8::EpiBf16<0>, pg8::StaticOrder>(F.lds, g, S, E, nullptr); }
        }
        SEAM(pb + 6);
        if (EN(9) && IN(pb + 7)) { for (int rp = 0; rp < REP(8); ++rp) qkv_final_phase(opq(F), opq_ptr(ws), l, need_ctx); }
        SEAM(pb + 7);
        if (EN(10) && IN(pb + 8)) for (int rp = 0; rp < REP(10); ++rp) mixer_phase(F, ws, l + 4 * rp, need_ctx, (char*)lds);
        SEAM(pb + 8);
        if (EN(11) && IN(pb + 9)) { for (int rp = 0; rp < REP(8); ++rp) rwkv_out_phase(opq(F), opq_ptr(ws), l, need_ctx); hyena_out_phase(opq(F), opq_ptr(ws), need_ctx); }
        SEAM(pb + 9);
        if (EN(12) && IN(pb + 10)) {
            { unsigned char* w = WSP; pg8::Gemm g{P_OBUF(w), P_WL(w, l) + W_OUT, T, DM, DM, DM}; pg8::StaticOrderX S; S.init(T, DM, F.G, F.bid); pg8::EpiResid E{P_XS(w), P_MODX(w, l) + 5 * DM, P_MODC(w, l) + 5 * DM, 1.0f, nullptr};
              pg8::gemm_phase<pg8::EpiResid, pg8::StaticOrderX>(F.lds, g, S, E, nullptr); }
            if (need_ctx) { __syncthreads();
              if (F.bid < 256) { unsigned char* w = WSP; const int ks = F.bid >> 4, ksz = DM / 16; pg8::Gemm g{P_OBUF(w) + ks * ksz, P_WL(w, l) + W_OUT + ks * ksz, NCTX, DM, ksz, DM}; pg8::OneUnit S{F.bid & 15};
                  pg8::EpiBf16<0> E{(bf16_t*)(w + WS_SLAB) + (size_t)ks * NCTX * DM, DM, nullptr, 0, 0};
                  pg8::gemm_phase<pg8::EpiBf16<0>, pg8::OneUnit>(F.lds, g, S, E, nullptr); } }
        }
        SEAM(pb + 10);
        if (EN(13) && IN(pb + 11)) for (int rp = 0; rp < REP(2); ++rp) { unsigned char* w = WSP; norm_phase(opq(F), P_XS(w), IN_(9) + l * DM, P_MODX(w, l), P_MODC(w, l), 6, 7, P_ABUF(w), need_ctx ? (const bf16_t*)(w + WS_SLAB) : nullptr, P_MODC(w, l) + 5 * DM, 1.0f); }
        SEAM(pb + 11);
        if (EN(14) && IN(pb + 12)) { if (need_ctx) { unsigned char* w = WSP; pg8::Gemm g{P_ABUF(w), P_WL(w, l) + W_G2, T, 2 * FF, DM, DM}; pg8::StaticOrder S; S.init(T, 2 * FF, F.G, F.bid); pg8::EpiSwiGLU E{P_HBUF(w), FF};
            pg8::gemm_phase<pg8::EpiSwiGLU, pg8::StaticOrder>(F.lds, g, S, E, nullptr);
            hyena_taps_tail(F, ws, l + 1, 416, 640); }       else { unsigned char* w = WSP; pg8::Gemm g{P_ABUF(w), P_WL(w, l) + W_G2, T, 2 * FF, DM, DM}; pg8::StaticOrderX S; S.init(T, 2 * FF, F.G, F.bid); pg8::EpiSwiGLU E{P_HBUF(w), FF};
            pg8::gemm_phase<pg8::EpiSwiGLU, pg8::StaticOrderX>(F.lds, g, S, E, nullptr); } }
        SEAM(pb + 12);
        if (EN(15) && IN(pb + 13)) {
            { unsigned char* w = WSP; pg8::Gemm g{P_HBUF(w), P_WL(w, l) + W_D2, T, DM, FF, FF}; pg8::StaticOrderX S; S.init(T, DM, F.G, F.bid); pg8::EpiResid E{P_XS(w), P_MODX(w, l) + 8 * DM, P_MODC(w, l) + 8 * DM, 0.5f, l == NL - 1 ? a.out : nullptr};
              pg8::gemm_phase<pg8::EpiResid, pg8::StaticOrderX>(F.lds, g, S, E, nullptr); }
            if (need_ctx) { __syncthreads();
              if (F.bid < 256) { unsigned char* w = WSP; const int ks = F.bid >> 4, ksz = FF / 16; pg8::Gemm g{P_HBUF(w) + ks * ksz, P_WL(w, l) + W_D2 + ks * ksz, NCTX, DM, ksz, FF}; pg8::OneUnit S{F.bid & 15};
                  pg8::EpiBf16<0> E{(bf16_t*)(w + WS_SLAB) + (size_t)ks * NCTX * DM, DM, nullptr, 0, 0};
                  pg8::gemm_phase<pg8::EpiBf16<0>, pg8::OneUnit>(F.lds, g, S, E, nullptr); } }
        }
        SEAM(pb + 13);
    }
#undef IN
#undef SEAM
}

#ifndef MK_LAUNCHES
#define MK_LAUNCHES 1
#endif
extern "C" void kernel_launch(void* const* d_in, const int* in_sizes, int n_in, void* d_out, int out_size, void* d_ws, size_t ws_size, hipStream_t stream) {
    static int grid = 0;
    if (grid == 0) {
        if (n_in != 46 || in_sizes[0] != SEQ * DM || out_size != SEQ * DM || ws_size < WS_END) {
            fprintf(stderr, "kernel_launch: shape mismatch: n_in %d in0 %d out %d ws %zu (need %zu); nothing launched\n", n_in, n_in > 0 ? in_sizes[0] : -1, out_size, ws_size, (size_t)WS_END); grid = -1; return; }
        int dev = 0, cus = 0, per_cu = 0;
        if (hipGetDevice(&dev) != hipSuccess || hipDeviceGetAttribute(&cus, hipDeviceAttributeMultiprocessorCount, dev) != hipSuccess) { fprintf(stderr, "kernel_launch: device query failed\n"); grid = -1; return; }
        if (hipFuncSetAttribute((const void*)mk_fwd, hipFuncAttributeMaxDynamicSharedMemorySize, LDS_BYTES) != hipSuccess) { fprintf(stderr, "kernel_launch: hipFuncSetAttribute failed\n"); grid = -1; return; }
        if (hipOccupancyMaxActiveBlocksPerMultiprocessor(&per_cu, (const void*)mk_fwd, 512, LDS_BYTES) != hipSuccess || per_cu < 1) fprintf(stderr, "kernel_launch: note: occupancy query reports %d blocks per CU\n", per_cu);
        (void)hipGetLastError();
        grid = cus;
        if (cus != 256) { fprintf(stderr, "kernel_launch: built for 256 CUs (split-K of the context panel, hyena scratch), found %d; nothing launched\n", cus); grid = -1; return; }
    }
    if (grid < 0) return;
    if (hipMemsetAsync((char*)d_ws + WS_CTL, 0, CTL_BYTES, stream) != hipSuccess) { fprintf(stderr, "kernel_launch: memset failed\n"); return; }
    Args a{};
    for (int i = 0; i < 46; ++i) a.in[i] = (const float*)d_in[i];
    a.out = (float*)d_out; a.ws = (unsigned char*)d_ws;
    a.ph_lo = 0; a.ph_hi = NPH;
    hipLaunchKernelGGL(mk_fwd, dim3(grid), dim3(512), LDS_BYTES, stream, a);
    const hipError_t le = hipPeekAtLastError();
    if (le != hipSuccess) fprintf(stderr, "kernel_launch: launch failed: %s\n", hipGetErrorName(le));
}
```

```cpp
#include <hip/hip_runtime.h>
#include <stdint.h>
#include <cstdio>

#define LAS __attribute__((address_space(3)))
#define CAS __attribute__((address_space(4)))
typedef unsigned short bf16_t;
typedef float f32x4 __attribute__((ext_vector_type(4)));
typedef float f32x2 __attribute__((ext_vector_type(2)));
typedef unsigned u32x4 __attribute__((ext_vector_type(4)));
typedef unsigned u32x2 __attribute__((ext_vector_type(2)));

constexpr int T = 8448, NCTX = 256, SEQ = 8192, DM = 4096, FF = 6144, NL = 4;
constexpr int A_W = 1280, A_IN = 4160, B_IN = 3840, C_IN = 1600, NHA = 20;
constexpr int PXW = 9728, PXA = 0, PXB = 4160, PXC = 8000;
constexpr int NQ = 2304, NKV = 3072, NHC = 12;
constexpr int NMOD = 9 * DM;
constexpr float NORM_EPS = 1e-6f, GN_EPS = 64e-5f;

constexpr size_t MiB = 1u << 20;
constexpr size_t al(size_t x) { return (x + MiB - 1) / MiB * MiB; }
constexpr size_t WS_CTL = 0, CTL_BYTES = MiB;
constexpr size_t WS_XS = WS_CTL + CTL_BYTES;
constexpr size_t WS_ABUF = WS_XS + al((size_t)T * DM * 4);
constexpr size_t WS_HBUF = WS_ABUF + al((size_t)T * DM * 2);
constexpr size_t WS_OBUF = WS_HBUF + al((size_t)T * FF * 2);
constexpr size_t WS_PX = WS_OBUF + al((size_t)T * DM * 2);
constexpr size_t WS_MOD = WS_PX + al((size_t)T * PXW * 4);
constexpr size_t WS_HP = WS_MOD + al((size_t)NL * 2 * NMOD * 4);
constexpr size_t WS_SS = WS_HP + MiB;
constexpr size_t WS_SD = WS_SS + al((size_t)NHA * T * 192 * 4);
constexpr size_t WS_WLR = WS_SD + al((size_t)NHA * 2 * T * 192 * 4);
constexpr size_t WS_G = WS_WLR + al((size_t)NL * A_W * 448 * 2);
constexpr size_t WS_Y = WS_G + al((size_t)T * A_W * 4);
constexpr size_t WS_QA = WS_Y + al((size_t)2 * T * A_W * 4);
constexpr size_t WS_KVA = WS_QA + al((size_t)T * 1024 * 2);
constexpr size_t WS_KPE = WS_KVA + al((size_t)T * 512 * 2);
constexpr size_t WS_QRAW = WS_KPE + al((size_t)T * 64 * 2);
constexpr size_t WS_KVRAW = WS_QRAW + al((size_t)T * NQ * 2);
constexpr size_t WS_QF = WS_KVRAW + al((size_t)T * NKV * 2);
constexpr size_t WS_KF = WS_QF + al((size_t)T * NQ * 2);
constexpr size_t WS_H3 = WS_KF + al((size_t)T * NQ * 2);
constexpr size_t WS_HSCR = WS_H3 + al((size_t)NL * T * 64 * 4);
constexpr size_t WS_FR = WS_HSCR + al((size_t)640 * 16384 * 8 + 640 * 8);
constexpr size_t WS_GT = WS_FR + al((size_t)40 * 528 * (14 * 1024));
constexpr size_t WS_X0T = WS_GT + al((size_t)1280 * T * 4);
constexpr size_t WS_SLAB = WS_FR;
constexpr size_t WS_WB = WS_X0T + al((size_t)1280 * T * 4);
constexpr size_t W_G1 = 0, W_D1 = W_G1 + (size_t)2 * FF * DM, W_IN = W_D1 + (size_t)DM * FF, W_OUT = W_IN + (size_t)PXW * DM, W_G2 = W_OUT + (size_t)DM * DM,
                 W_D2 = W_G2 + (size_t)2 * FF * DM, W_Q = W_D2 + (size_t)DM * FF, W_KV = W_Q + (size_t)NQ * 1024, W_LAYER = W_KV + (size_t)NKV * 512;
constexpr size_t WS_END = WS_WB + al(W_LAYER * NL * 2);
constexpr int CW_BAR = 4096;
constexpr int CW_QUEUE = 8192;

constexpr int LDS_MISC = 143360, LDS_BYTES = 147456;

__device__ __forceinline__ float wave_sum(float v) {
#pragma unroll
    for (int o = 1; o < 64; o <<= 1) v += __shfl_xor(v, o);
    return v;
}
__device__ __forceinline__ float wave_sum16(const float (&x)[16], int lane) {
    const bool b5 = (lane & 32) != 0, b4 = (lane & 16) != 0, b3 = (lane & 8) != 0, b2 = (lane & 4) != 0;
    float k8[8], k4[4], k2[2];
#pragma unroll
    for (int i = 0; i < 8; ++i) k8[i] = (b5 ? x[8 + i] : x[i]) + __shfl_xor(b5 ? x[i] : x[8 + i], 32);
#pragma unroll
    for (int i = 0; i < 4; ++i) k4[i] = (b4 ? k8[4 + i] : k8[i]) + __shfl_xor(b4 ? k8[i] : k8[4 + i], 16);
#pragma unroll
    for (int i = 0; i < 2; ++i) k2[i] = (b3 ? k4[2 + i] : k4[i]) + __shfl_xor(b3 ? k4[i] : k4[2 + i], 8);
    float k1 = (b2 ? k2[1] : k2[0]) + __shfl_xor(b2 ? k2[0] : k2[1], 4);
    k1 += __shfl_xor(k1, 1); k1 += __shfl_xor(k1, 2);
    return k1;
}
typedef __bf16 bf16x2_t __attribute__((ext_vector_type(2)));
__device__ __forceinline__ unsigned cvt_pk_bf16(float lo, float hi) { const f32x2 v = {lo, hi}; return __builtin_bit_cast(unsigned, __builtin_convertvector(v, bf16x2_t)); }
__device__ __forceinline__ float bf2f(unsigned short b) { return __uint_as_float(((unsigned)b) << 16); }
__device__ __forceinline__ f32x4 bf4f(u32x2 w) { return (f32x4){__uint_as_float(w.x << 16), __uint_as_float(w.x & 0xffff0000u), __uint_as_float(w.y << 16), __uint_as_float(w.y & 0xffff0000u)}; }
__device__ __forceinline__ float sigmoidf_(float x) { return 1.0f / (1.0f + __expf(-x)); }
__device__ __forceinline__ float siluf_(float x) { return x / (1.0f + __expf(-x)); }
__device__ __forceinline__ bool has_left(int tau) { return tau != 0 && tau != NCTX; }
__device__ __forceinline__ bool has_right(int tau) { return tau != NCTX - 1 && tau != T - 1; }

struct Args { const float* in[46]; float* out; unsigned char* ws; int ph_lo, ph_hi; };
struct Frame { LAS unsigned char* lds; volatile LAS unsigned* MISC; int tid, lane, wave, bid, G; };
constexpr int LDS_PTAB = LDS_MISC + 2048;
__device__ __forceinline__ const float* inp(const Frame& F, int i) {
    const volatile LAS unsigned* p = (const volatile LAS unsigned*)(F.lds + LDS_PTAB) + 2 * i;
    const unsigned lo = __builtin_amdgcn_readfirstlane(p[0]), hi = __builtin_amdgcn_readfirstlane(p[1]);
    return (const float*)(((unsigned long long)hi << 32) | lo);
}
#define IN_(i) inp(F, (i))
__device__ __forceinline__ Frame opq(const Frame& F) { Frame G = F; asm volatile("" : "+v"(G.tid), "+s"(G.wave), "+s"(G.bid)); G.lane = G.tid & 63; return G; }
__device__ __forceinline__ unsigned char* opq_ptr(unsigned char* p) { asm volatile("" : "+s"(p)); return p; }
#ifndef MK_REP
#define MK_REP 0
#endif
#ifndef MK_ONLYRP
#define MK_ONLYRP 0
#endif
#define REP(x) (1 + (((MK_REP) >> (x)) & 1))
#define XB_TMO      128
#define XB_XCNT(j)  (256  + 64 * (j))
#define XB_XSUB(j)  (1280 + 64 * (j))
#define XB_XGEN(j)  (2304 + 64 * (j))
#define XB_TOP      3328
#define XB_TOPGEN   3392
#define XCD_BAR_WORDS 3456
#define XB_SPIN_CAP (1u << 18)

__device__ __forceinline__ unsigned xb_ld(unsigned* p)              { return __hip_atomic_load(p, __ATOMIC_RELAXED, __HIP_MEMORY_SCOPE_AGENT); }
__device__ __forceinline__ unsigned xb_add(unsigned* p, unsigned v) { return __hip_atomic_fetch_add(p, v, __ATOMIC_RELAXED, __HIP_MEMORY_SCOPE_AGENT); }
__device__ __forceinline__ unsigned xb_xcc_id() { return (unsigned)__builtin_amdgcn_s_getreg((3 << 11) | 20) & 0xFu; }
#define XB_SPIN(cond, bar) do { unsigned _sp = 0; while (cond) { __builtin_amdgcn_s_sleep(1); \
    if ((++_sp & 255u) == 0u) { if (xb_ld(&(bar)[XB_TMO])) break; if (_sp > XB_SPIN_CAP) { atomicAdd(&(bar)[XB_TMO], 1u); break; } } } } while (0)

struct XcdBarrier {
    unsigned* bar; unsigned x;
    volatile LAS unsigned* st;
};

__device__ __forceinline__ XcdBarrier xcd_barrier_post(unsigned* bar, volatile LAS unsigned* st) {
    XcdBarrier b; b.bar = bar; b.x = xb_xcc_id(); b.st = st;
    if (threadIdx.x == 0) (void)xb_add(&bar[XB_XCNT(b.x)], 1u);
    return b;
}
__device__ __forceinline__ void xcd_barrier_complete(unsigned* bar, unsigned x, unsigned& nloc, unsigned& nx) {
    const unsigned G = gridDim.x * gridDim.y * gridDim.z;
    unsigned sum, cnt, mine, sp = 0u;
    for (;;) {
        sum = 0u; cnt = 0u; mine = 0u;
#pragma unroll
        for (unsigned j = 0; j < 16; ++j) { const unsigned c = xb_ld(&bar[XB_XCNT(j)]); sum += c; cnt += (c > 0u) ? 1u : 0u; mine = (j == x) ? c : mine; }
        if (sum == G) break;
        __builtin_amdgcn_s_sleep(1);
        if ((++sp & 255u) == 0u) { if (xb_ld(&bar[XB_TMO])) break; if (sp > XB_SPIN_CAP) { atomicAdd(&bar[XB_TMO], 1u); break; } }
    }
    nloc = mine > 0u ? mine : 1u; nx = cnt > 0u ? cnt : 1u;
}

__device__ __forceinline__ void xcd_barrier(const XcdBarrier& b) {
    asm volatile("s_waitcnt vmcnt(0)" ::: "memory");
    __syncthreads();
    if (threadIdx.x == 0) {
        unsigned* bar = b.bar;
        __builtin_amdgcn_s_waitcnt(0);
        unsigned nloc = b.st[0], nx = b.st[1];
        if (nloc == 0u) { xcd_barrier_complete(bar, b.x, nloc, nx); b.st[0] = nloc; b.st[1] = nx; }
        const unsigned old = xb_add(&bar[XB_XSUB(b.x)], 1u);
        const unsigned gen = old / nloc;
        if (old + 1u == (gen + 1u) * nloc) {
            __builtin_amdgcn_fence(__ATOMIC_RELEASE, "agent");
            asm volatile("s_waitcnt vmcnt(0)" ::: "memory");
            const unsigned og = xb_add(&bar[XB_TOP], 1u);
            const unsigned tg = og / nx;
            if (og + 1u == (tg + 1u) * nx) xb_add(&bar[XB_TOPGEN], 1u);
            else XB_SPIN(xb_ld(&bar[XB_TOPGEN]) == tg, bar);
            __builtin_amdgcn_fence(__ATOMIC_ACQUIRE, "agent");
            xb_add(&bar[XB_XGEN(b.x)], 1u);
            asm volatile("s_waitcnt vmcnt(0)" ::: "memory");
        } else {
            XB_SPIN(xb_ld(&bar[XB_XGEN(b.x)]) == gen, bar);
            __builtin_amdgcn_fence(__ATOMIC_ACQUIRE, "agent");
            asm volatile("s_waitcnt vmcnt(0)" ::: "memory");
        }
    }
    __syncthreads();
}
namespace pg8 {
#define PG8_LAS __attribute__((address_space(3)))
typedef unsigned short bf16_t;
typedef short bf16x8 __attribute__((ext_vector_type(8)));
typedef float f32x4 __attribute__((ext_vector_type(4)));
typedef unsigned u32x4 __attribute__((ext_vector_type(4)));
constexpr int BM = 256, BK = 64, HALF = 128, HTB = HALF * BK * 2  , STAGE_BYTES = 8 * HTB, NXCD = 8, WGM = 4;

__host__ __device__ __forceinline__ int lds_byte(int r, int c) { const int st = (r >> 4) * 2 + (c >> 5), rr = r & 15, cc = c & 31, ob = rr * 64 + cc * 2; return st * 1024 + (ob ^ (((ob >> 9) & 1) << 5)); }
__host__ __device__ __forceinline__ void stage_rc(int b, int& R, int& C) { const int st = b / 1024, sb = b % 1024, swz = sb ^ (((sb >> 9) & 1) << 5); R = (st >> 1) * 16 + swz / 64; C = (st & 1) * 32 + (swz % 64) / 2; }
__host__ __device__ __forceinline__ int perm32(int rho) { const int n = rho >> 4, i = rho & 15; return 8 * (i >> 2) + 4 * n + (i & 3); }

struct Unit { int pm, pn; };
struct Gemm { const bf16_t* A; const bf16_t* Bt; int M, N, K, ld; };

struct StaticOrder {
    int nM, nN, nwg, G, c;
    __host__ __device__ void init(int M, int N, int G_, int c_) { nM = M / BM; nN = N / BM; nwg = nM * nN; G = G_; c = c_; }
    __host__ __device__ bool next(int i, Unit& u) const {
        const long L = (long)i * G + c; if (L >= nwg) return false;
        int wgid = (int)L; { const int q = nwg / NXCD, r = nwg % NXCD, xcd = wgid % NXCD, off = wgid / NXCD; wgid = (xcd < r ? xcd * (q + 1) : r * (q + 1) + (xcd - r) * q) + off; }
        const int nig = WGM * nN, gid = wgid / nig, fm = gid * WGM, gsz = (nM - fm) < WGM ? (nM - fm) : WGM;
        u.pm = fm + ((wgid % nig) % gsz); u.pn = (wgid % nig) / gsz; return true;
    }
    __device__ __forceinline__ void a_ready(const Unit&) const {}
    __device__ __forceinline__ void done(const Unit&) const {}
};
struct CountedOrder : StaticOrder {
    const unsigned* ready; unsigned need; unsigned* tmo;
    __device__ __forceinline__ void a_ready(const Unit& u) const {
        if (threadIdx.x < 64) {
            const unsigned long long t0 = __builtin_amdgcn_s_memrealtime(); unsigned polls = 0;
            while ((unsigned)__builtin_amdgcn_readfirstlane(__hip_atomic_load(ready + 64 * u.pm, __ATOMIC_RELAXED, __HIP_MEMORY_SCOPE_AGENT)) < need) {
                if ((++polls & 255u) == 0u && __builtin_amdgcn_readfirstlane(__hip_atomic_load(tmo, __ATOMIC_RELAXED, __HIP_MEMORY_SCOPE_AGENT)) != 0u) break;
                if (__builtin_amdgcn_s_memrealtime() - t0 > 2000000ull) {
                    if (threadIdx.x == 0) { unsigned expect = 0u; __hip_atomic_compare_exchange_strong(tmo + 1, &expect, 0x600u | (unsigned)(u.pm & 0xff), __ATOMIC_RELAXED, __ATOMIC_RELAXED, __HIP_MEMORY_SCOPE_AGENT); __hip_atomic_store(tmo, 1u, __ATOMIC_RELAXED, __HIP_MEMORY_SCOPE_AGENT); }
                    break; }
                __builtin_amdgcn_s_sleep(2); }
            __builtin_amdgcn_fence(__ATOMIC_ACQUIRE, "agent");
            asm volatile("s_waitcnt vmcnt(0)" ::: "memory");
        }
#if !defined(BROKEN_HOOK_NO_BARRIER)
        asm volatile("" ::: "memory"); __builtin_amdgcn_s_barrier(); asm volatile("" ::: "memory");
#endif
    }
};

__device__ __forceinline__ unsigned cvt_pk_bf16(float lo, float hi) { unsigned r; asm volatile("v_cvt_pk_bf16_f32 %0, %1, %2" : "=v"(r) : "v"(lo), "v"(hi)); return r; }
typedef float f32x2 __attribute__((ext_vector_type(2)));
__device__ __forceinline__ f32x2 gelu_pk(f32x2 v) {
    const f32x2 av = __builtin_elementwise_abs(v), d = av * 0.2316418882f + 1.0f;
    f32x2 t; t.x = __builtin_amdgcn_rcpf(d.x); t.y = __builtin_amdgcn_rcpf(d.y);
    f32x2 q = t * 0.5307027145f + (-0.7265760135f); q = q * t + 0.7107068705f; q = q * t + (-0.142248368f); q = q * t + 0.127414796f; q = q * t;
    const f32x2 s = (v * v) * (-0.72134752044f);
    f32x2 e; e.x = __builtin_amdgcn_exp2f(s.x); e.y = __builtin_amdgcn_exp2f(s.y);
    const f32x2 m = v * (q * e), r = v - m;
    f32x2 o; o.x = v.x < 0.f ? m.x : r.x; o.y = v.y < 0.f ? m.y : r.y; return o;
}

struct EpiF32 {
    static constexpr bool PERM = false, AFTER_DRAIN = false;
    float* C; int ldc; const float* bias;
    __device__ __forceinline__ void operator()(const f32x4 (&acc)[2][2][4][2], const Unit& u, int wr, int wc, int fr, int fq) const {
        const int row0 = u.pm * BM + wr * 64 + fr, col0 = u.pn * BM + wc * 32 + 4 * fq;
        f32x4 bv[2][2];
#pragma unroll
        for (int bj = 0; bj < 2; ++bj)
#pragma unroll
            for (int n = 0; n < 2; ++n) bv[bj][n] = bias ? *(const f32x4*)(bias + col0 + bj * HALF + n * 16) : (f32x4){0.f, 0.f, 0.f, 0.f};
#pragma unroll
        for (int ai = 0; ai < 2; ++ai)
#pragma unroll
            for (int m = 0; m < 4; ++m) { float* rowp = C + (size_t)(row0 + ai * HALF + m * 16) * ldc + col0;
#pragma unroll
                for (int bj = 0; bj < 2; ++bj)
#pragma unroll
                    for (int n = 0; n < 2; ++n) *(f32x4*)(rowp + bj * HALF + n * 16) = acc[ai][bj][m][n] + bv[bj][n]; }
    }
};
template <int ACT  > struct EpiBf16 {
    static constexpr bool PERM = true, AFTER_DRAIN = false;
    bf16_t* O; int ldc; const float* bias; int split_cols; size_t split_stride;
    __device__ __forceinline__ void operator()(const f32x4 (&acc)[2][2][4][2], const Unit& u, int wr, int wc, int fr, int fq) const {
        const int row0 = u.pm * BM + wr * 64 + fr; int colt = u.pn * BM; bf16_t* base = O;
        if (split_cols) { const int t = colt / split_cols; base += (size_t)t * split_stride; colt -= t * split_cols; }
        const int col0 = colt + wc * 32 + 8 * fq, bcol0 = u.pn * BM + wc * 32 + 8 * fq;
        f32x4 bv[2][2];
#pragma unroll
        for (int bj = 0; bj < 2; ++bj)
#pragma unroll
            for (int n = 0; n < 2; ++n) bv[bj][n] = bias ? *(const f32x4*)(bias + bcol0 + bj * HALF + 4 * n) : (f32x4){0.f, 0.f, 0.f, 0.f};
#pragma unroll
        for (int ai = 0; ai < 2; ++ai)
#pragma unroll
            for (int m = 0; m < 4; ++m) { bf16_t* rowp = base + (size_t)(row0 + ai * HALF + m * 16) * ldc + col0;
#pragma unroll
                for (int bj = 0; bj < 2; ++bj) { f32x4 v0 = acc[ai][bj][m][0] + bv[bj][0], v1 = acc[ai][bj][m][1] + bv[bj][1];
                    if (ACT == 1) { f32x2 a = gelu_pk((f32x2){v0[0], v0[1]}), b = gelu_pk((f32x2){v0[2], v0[3]}), c = gelu_pk((f32x2){v1[0], v1[1]}), d = gelu_pk((f32x2){v1[2], v1[3]});
                        v0 = (f32x4){a.x, a.y, b.x, b.y}; v1 = (f32x4){c.x, c.y, d.x, d.y}; }
                    if (ACT == 2) {
#pragma unroll
                        for (int j = 0; j < 4; ++j) { v0[j] = 0.5f * v0[j] * (1.0f + erff(v0[j] * 0.70710678f)); v1[j] = 0.5f * v1[j] * (1.0f + erff(v1[j] * 0.70710678f)); } }
                    u32x4 w; w.x = cvt_pk_bf16(v0[0], v0[1]); w.y = cvt_pk_bf16(v0[2], v0[3]); w.z = cvt_pk_bf16(v1[0], v1[1]); w.w = cvt_pk_bf16(v1[2], v1[3]);
                    *(u32x4*)(rowp + bj * HALF) = w; } }
    }
};
}
namespace pg8 {
struct EpiSwiGLU {
    static constexpr bool PERM = true, AFTER_DRAIN = false;
    bf16_t* O; int ldc;
    __device__ __forceinline__ void operator()(const f32x4 (&acc)[2][2][4][2], const Unit& u, int wr, int wc, int fr, int fq) const {
        const int row0 = u.pm * BM + wr * 64 + fr, col0 = u.pn * HALF + wc * 32 + 8 * fq;
#pragma unroll
        for (int ai = 0; ai < 2; ++ai)
#pragma unroll
            for (int m = 0; m < 4; ++m) { bf16_t* rowp = O + (size_t)(row0 + ai * HALF + m * 16) * ldc + col0;
                float h[8];
#pragma unroll
                for (int n = 0; n < 2; ++n)
#pragma unroll
                    for (int j = 0; j < 4; ++j) { const float g = acc[ai][0][m][n][j], up = acc[ai][1][m][n][j]; h[n * 4 + j] = g * __builtin_amdgcn_rcpf(1.0f + __builtin_amdgcn_exp2f(-1.4426950408889634f * g)) * up; }
                u32x4 w; w.x = cvt_pk_bf16(h[0], h[1]); w.y = cvt_pk_bf16(h[2], h[3]); w.z = cvt_pk_bf16(h[4], h[5]); w.w = cvt_pk_bf16(h[6], h[7]);
                *(u32x4*)rowp = w; }
    }
};
struct EpiResid {
    static constexpr bool PERM = false, AFTER_DRAIN = false;
    float* X; const float* gate_x; const float* gate_c; float fac; float* out_x;
    __device__ __forceinline__ void operator()(const f32x4 (&acc)[2][2][4][2], const Unit& u, int wr, int wc, int fr, int fq) const {
        const int row0 = u.pm * BM + wr * 64 + fr, col0 = u.pn * BM + wc * 32 + 4 * fq;
        const float* gv = (u.pm == 0) ? gate_c : gate_x;
        float* dst = (u.pm != 0 && out_x) ? out_x - (size_t)256 * 4096 : X;
        f32x4 gg[2][2];
#pragma unroll
        for (int bj = 0; bj < 2; ++bj)
#pragma unroll
            for (int n = 0; n < 2; ++n) gg[bj][n] = *(const f32x4*)(gv + col0 + bj * HALF + n * 16) * fac;
#pragma unroll
        for (int ai = 0; ai < 2; ++ai)
#pragma unroll
            for (int m = 0; m < 4; ++m) { const size_t off = (size_t)(row0 + ai * HALF + m * 16) * 4096 + col0;
#pragma unroll
                for (int bj = 0; bj < 2; ++bj)
#pragma unroll
                    for (int n = 0; n < 2; ++n) { const f32x4 b = *(const f32x4*)(X + off + bj * HALF + n * 16); *(f32x4*)(dst + off + bj * HALF + n * 16) = b + gg[bj][n] * acc[ai][bj][m][n]; } }
    }
};
struct OneUnit { int pn;
    __host__ __device__ bool next(int i, Unit& u) const { u.pm = 0; u.pn = pn; return i == 0; }
    __device__ __forceinline__ void a_ready(const Unit&) const {}
    __device__ __forceinline__ void done(const Unit&) const {}
};
struct StaticOrderX { StaticOrder b;
    __host__ __device__ void init(int M, int N, int G_, int c_) { b.init(M - BM, N, G_, c_); }
    __host__ __device__ bool next(int i, Unit& u) const { const bool ok = b.next(i, u); u.pm += 1; return ok; }
    __device__ __forceinline__ void a_ready(const Unit&) const {}
    __device__ __forceinline__ void done(const Unit&) const {}
};
}
namespace pg8 {
template <class Epi, class Sched, bool STAMP = false>
__device__ __forceinline__ void gemm_phase(PG8_LAS unsigned char* lds, const Gemm g, const Sched& S, const Epi& E, unsigned long long* stamps) {
    int tid_ = threadIdx.x; asm volatile("" : "+v"(tid_));
    const int tid = tid_, wid = __builtin_amdgcn_readfirstlane(tid >> 6), lane = tid & 63, wr = wid >> 2, wc = wid & 3, fr = lane & 15, fq = lane >> 4;
    const int K = g.ld, nt = g.K / BK;
    int ts_lo = 0, ts_hi = 0, nts = 0; const unsigned long long rt_entry = STAMP ? (unsigned long long)wall_clock64() : 0ull;
#define PG8_STAMP() do { if (STAMP && wid == 0 && nts < 64) { const unsigned long long _c = (unsigned long long)clock64(); \
        ts_lo = (lane == nts) ? (int)(unsigned)_c : ts_lo; ts_hi = (lane == nts) ? (int)(unsigned)(_c >> 32) : ts_hi; ++nts; } } while (0)
    PG8_STAMP();
    unsigned voffA[2], voffB[2];
#pragma unroll
    for (int i = 0; i < 2; ++i) { int R, C; stage_rc(tid * 16 + i * 8192, R, C); const int Rb = Epi::PERM ? ((R & ~31) + perm32(R & 31)) : R;
        voffA[i] = (unsigned)(R * K + C) * 2u; voffB[i] = (unsigned)(Rb * K + C) * 2u; }
    const size_t kstep = (size_t)(BK * 2);
    const size_t hstep = (size_t)HALF * K * 2;
    const size_t tstep = 2 * hstep;
    const unsigned ldsw = (unsigned)wid * 1024u;
    const int aoff = lds_byte(wr * 64 + fr, fq * 8), boff = lds_byte(wc * 32 + fr, fq * 8);
#define PG8_SA(b, h) (((b) * 2 + (h)) * HTB)
#define PG8_SB(b, h) ((4 + (b) * 2 + (h)) * HTB)
#define PG8_STAGE(bufoff, gbase, voff) do { _Pragma("unroll") for (int _i = 0; _i < 2; ++_i) \
        __builtin_amdgcn_global_load_lds((const unsigned*)((const char*)(gbase) + (voff)[_i]), (PG8_LAS unsigned*)(lds + (bufoff) + ldsw + _i * 8192), 16, 0, 0); } while (0)
#define PG8_LDA(dst, b, h) do { _Pragma("unroll") for (int m = 0; m < 4; ++m) _Pragma("unroll") for (int k = 0; k < 2; ++k) dst[m][k] = *(const PG8_LAS bf16x8*)(lds + PG8_SA(b, h) + aoff + m * 2048 + k * 1024); } while (0)
#define PG8_LDB(dst, b, h) do { _Pragma("unroll") for (int n = 0; n < 2; ++n) _Pragma("unroll") for (int k = 0; k < 2; ++k) dst[n][k] = *(const PG8_LAS bf16x8*)(lds + PG8_SB(b, h) + boff + n * 2048 + k * 1024); } while (0)
#define PG8_MMA(ai, bj, At, Bt) do { __builtin_amdgcn_s_setprio(1); _Pragma("unroll") for (int m = 0; m < 4; ++m) _Pragma("unroll") for (int n = 0; n < 2; ++n) _Pragma("unroll") for (int k = 0; k < 2; ++k) \
        acc[ai][bj][m][n] = __builtin_amdgcn_mfma_f32_16x16x32_bf16(Bt[n][k], At[m][k], acc[ai][bj][m][n], 0, 0, 0); __builtin_amdgcn_s_setprio(0); } while (0)
#define PG8_WAIT_V(n) asm volatile("s_waitcnt vmcnt(" #n ")" ::: "memory")
#define PG8_WAIT_L(n) asm volatile("s_waitcnt lgkmcnt(" #n ")" ::: "memory")
#define PG8_BAR __builtin_amdgcn_s_barrier()
#define PG8_SCHED __builtin_amdgcn_sched_barrier(0)
    Unit cur, nxt; int ui = 0;
    if (!S.next(0, cur)) return;
    f32x4 acc[2][2][4][2];
#pragma unroll
    for (int a = 0; a < 2; ++a)
#pragma unroll
        for (int b = 0; b < 2; ++b)
#pragma unroll
            for (int m = 0; m < 4; ++m)
#pragma unroll
                for (int n = 0; n < 2; ++n) acc[a][b][m][n] = (f32x4){0.f, 0.f, 0.f, 0.f};
    bf16x8 At[4][2], B0[2][2], B1[2][2];
    const char* cA = (const char*)g.A + (size_t)cur.pm * tstep; const char* cB = (const char*)g.Bt + (size_t)cur.pn * tstep;
    S.a_ready(cur);
    PG8_STAGE(PG8_SB(0, 0), cB, voffB); PG8_STAGE(PG8_SA(0, 0), cA, voffA); PG8_STAGE(PG8_SB(0, 1), cB + hstep, voffB); PG8_STAGE(PG8_SA(0, 1), cA + hstep, voffA);
    if (wr == 1) PG8_BAR;
    PG8_WAIT_V(4); PG8_BAR;
    PG8_STAGE(PG8_SB(1, 0), cB + kstep, voffB); PG8_STAGE(PG8_SA(1, 0), cA + kstep, voffA); PG8_STAGE(PG8_SB(1, 1), cB + hstep + kstep, voffB);
    PG8_WAIT_V(6); PG8_BAR;
    PG8_STAMP();
    for (;;) {
        const bool has_next = S.next(ui + 1, nxt);
        const char* nA = has_next ? (const char*)g.A + (size_t)nxt.pm * tstep : cA; const char* nB = has_next ? (const char*)g.Bt + (size_t)nxt.pn * tstep : cB;
        for (int t = 0; t < nt; t += 2) {
            const bool last = (t == nt - 2);
            const char* a1 = cA + (size_t)(t + 1) * kstep;
            const char* a2 = last ? nA : cA + (size_t)(t + 2) * kstep; const char* b2 = last ? nB : cB + (size_t)(t + 2) * kstep;
            const char* a3 = a2 + kstep; const char* b3 = b2 + kstep;
            if (last && has_next) S.a_ready(nxt);
            PG8_LDB(B0, 0, 0); PG8_SCHED; PG8_LDA(At, 0, 0); PG8_STAGE(PG8_SA(1, 1), a1 + hstep, voffA);
            PG8_WAIT_L(8); PG8_BAR; PG8_WAIT_L(0); PG8_MMA(0, 0, At, B0); PG8_BAR; PG8_SCHED;
            PG8_LDB(B1, 0, 1); PG8_STAGE(PG8_SB(0, 0), b2, voffB);
            PG8_BAR; PG8_WAIT_L(0); PG8_MMA(0, 1, At, B1); PG8_BAR;
            PG8_LDA(At, 0, 1); PG8_STAGE(PG8_SA(0, 0), a2, voffA);
            PG8_BAR; PG8_WAIT_L(0); PG8_MMA(1, 0, At, B0); PG8_BAR; PG8_SCHED;
            PG8_STAGE(PG8_SB(0, 1), b2 + hstep, voffB);
            PG8_WAIT_V(6); PG8_BAR; PG8_MMA(1, 1, At, B1); PG8_BAR;
            PG8_LDB(B0, 1, 0); PG8_SCHED; PG8_LDA(At, 1, 0); PG8_STAGE(PG8_SA(0, 1), a2 + hstep, voffA);
            PG8_WAIT_L(8); PG8_BAR; PG8_WAIT_L(0); PG8_MMA(0, 0, At, B0); PG8_BAR; PG8_SCHED;
            PG8_LDB(B1, 1, 1); PG8_STAGE(PG8_SB(1, 0), b3, voffB);
            PG8_BAR; PG8_WAIT_L(0); PG8_MMA(0, 1, At, B1); PG8_BAR;
            PG8_LDA(At, 1, 1); PG8_STAGE(PG8_SA(1, 0), a3, voffA);
            PG8_BAR; PG8_WAIT_L(0); PG8_MMA(1, 0, At, B0); PG8_BAR; PG8_SCHED;
            PG8_STAGE(PG8_SB(1, 1), b3 + hstep, voffB);
            PG8_WAIT_V(6); PG8_BAR; PG8_MMA(1, 1, At, B1); PG8_BAR;
        }
        PG8_STAMP();
        if constexpr (!Epi::AFTER_DRAIN) { E(acc, cur, wr, wc, fr, fq); S.done(cur); }
        PG8_STAMP();
        if (!has_next) break;
#pragma unroll
        for (int a = 0; a < 2; ++a)
#pragma unroll
            for (int b = 0; b < 2; ++b)
#pragma unroll
                for (int m = 0; m < 4; ++m)
#pragma unroll
                    for (int n = 0; n < 2; ++n) acc[a][b][m][n] = (f32x4){0.f, 0.f, 0.f, 0.f};
        cur = nxt; cA = nA; cB = nB; ++ui;
    }
    PG8_WAIT_V(0);
    if (wr == 0) PG8_BAR;
    PG8_BAR;
    if constexpr (Epi::AFTER_DRAIN) { E.fused(acc, cur, wr, wc, fr, fq, lds, wid, lane); S.done(cur); }
    PG8_STAMP();
    if (STAMP && wid == 0) { stamps[lane] = lane < nts ? (((unsigned long long)(unsigned)ts_hi << 32) | (unsigned)ts_lo) : 0ull;
        if (lane == 62) stamps[62] = rt_entry; if (lane == 63) stamps[63] = (unsigned long long)wall_clock64(); }
#undef PG8_STAMP
#undef PG8_SA
#undef PG8_SB
#undef PG8_STAGE
#undef PG8_LDA
#undef PG8_LDB
#undef PG8_MMA
#undef PG8_WAIT_V
#undef PG8_WAIT_L
#undef PG8_BAR
#undef PG8_SCHED
}
}
#define LDS_WAIT() asm volatile("s_waitcnt lgkmcnt(0)" ::: "memory")

__device__ __forceinline__ int map_row(int n, int mode) {
    if (mode == 1) { const int j = n < FF ? n : n - FF; return (j >> 7) * 256 + (n < FF ? 0 : 128) + (j & 127); }
    return n;
}
__device__ __forceinline__ void transpose_item(const float* __restrict__ W, int K, int N, bf16_t* WT, int mode, LAS float* scr, int item, int lane) {
    const int nblk = N / 32, kb = item / nblk, nb = item % nblk, k0 = 64 * kb, n0 = 32 * nb;
#pragma unroll 8
    for (int i = 0; i < 32; ++i) { const int kk = 2 * i + (lane >> 5); scr[kk * 33 + (lane & 31)] = W[(size_t)(k0 + kk) * N + n0 + (lane & 31)]; }
    LDS_WAIT(); asm volatile("" ::: "memory");
    const int c = lane & 7;
#pragma unroll
    for (int j = 0; j < 4; ++j) { const int n = (lane >> 3) + 8 * j; const LAS float* s = scr + (8 * c) * 33 + n;
        u32x4 o; o.x = cvt_pk_bf16(s[0 * 33], s[1 * 33]); o.y = cvt_pk_bf16(s[2 * 33], s[3 * 33]); o.z = cvt_pk_bf16(s[4 * 33], s[5 * 33]); o.w = cvt_pk_bf16(s[6 * 33], s[7 * 33]);
        *(u32x4*)(WT + (size_t)map_row(n0 + n, mode) * K + k0 + 8 * c) = o; }
    LDS_WAIT(); asm volatile("" ::: "memory");
}
constexpr int I_G = (DM / 64) * (2 * FF / 32), I_D = (FF / 64) * (DM / 32), I_IN = (DM / 64) * (9600 / 32), I_OUT = (DM / 64) * (DM / 32), I_Q = (1024 / 64) * (NQ / 32), I_KV = (512 / 64) * (NKV / 32);
constexpr int I_LAYER = 2 * I_G + 2 * I_D + I_IN + I_OUT + I_Q + I_KV;

__device__ __forceinline__ void phase0(const Frame& F, unsigned char* ws) {
    const int gw = F.bid * 8 + F.wave, NGW = F.G * 8;
    const size_t gt = (size_t)F.bid * 512 + F.tid, NGT = (size_t)F.G * 512;
    LAS float* scr = (LAS float*)(F.lds + F.wave * 8704);
    bf16_t* WB = (bf16_t*)(ws + WS_WB);
    for (int it = gw; it < NL * I_LAYER; it += NGW) {
        const int l = it / I_LAYER; int r = it - l * I_LAYER; bf16_t* wl = WB + (size_t)l * W_LAYER;
        if (r < I_G) { transpose_item(IN_(10) + (size_t)l * DM * 2 * FF, DM, 2 * FF, wl + W_G1, 1, scr, r, F.lane); continue; } r -= I_G;
        if (r < I_D) { transpose_item(IN_(11) + (size_t)l * FF * DM, FF, DM, wl + W_D1, 0, scr, r, F.lane); continue; } r -= I_D;
        if (r < I_G) { transpose_item(IN_(12) + (size_t)l * DM * 2 * FF, DM, 2 * FF, wl + W_G2, 1, scr, r, F.lane); continue; } r -= I_G;
        if (r < I_D) { transpose_item(IN_(13) + (size_t)l * FF * DM, FF, DM, wl + W_D2, 0, scr, r, F.lane); continue; } r -= I_D;
        if (r < I_IN) { transpose_item(IN_(14) + (size_t)l * DM * 9600, DM, 9600, wl + W_IN, 0, scr, r, F.lane); continue; } r -= I_IN;
        if (r < I_OUT) { transpose_item(IN_(15) + (size_t)l * DM * DM, DM, DM, wl + W_OUT, 0, scr, r, F.lane); continue; } r -= I_OUT;
        if (r < I_Q) { transpose_item(IN_(39) + (size_t)l * 1024 * NQ, 1024, NQ, wl + W_Q, 0, scr, r, F.lane); continue; } r -= I_Q;
        transpose_item(IN_(41) + (size_t)l * 512 * NKV, 512, NKV, wl + W_KV, 0, scr, r, F.lane);
    }
    for (size_t i = gt; i < (size_t)NL * 128 * 512; i += NGT) {
        const int l = (int)(i / (128 * 512)), rr = (int)((i / 512) % 128), c = (int)(i % 512);
        const int row = 9600 + rr;
        *(u32x4*)(WB + (size_t)l * W_LAYER + W_IN + (size_t)row * DM + c * 8) = (u32x4){0u, 0u, 0u, 0u};
    }
    { bf16_t* WLR = (bf16_t*)(ws + WS_WLR); const float* wu = IN_(18); const float* au = IN_(20); const float* gu = IN_(21);
      for (size_t i = gt; i < (size_t)NL * 448 * A_W; i += NGT) { const int l = (int)(i / (448 * A_W)), k = (int)((i / A_W) % 448), col = (int)(i % A_W);
          float v;
          if (k < 128) v = wu[(((size_t)l * 2 + (k >> 6)) * 64 + (k & 63)) * A_W + col];
          else if (k < 256) v = au[(((size_t)l * 2 + ((k - 128) >> 6)) * 64 + (k & 63)) * A_W + col];
          else v = gu[((size_t)l * 192 + (k - 256)) * A_W + col];
          WLR[((size_t)l * A_W + col) * 448 + k] = (bf16_t)(cvt_pk_bf16(v, v) & 0xffffu); } }
    { f32x4* xs = (f32x4*)(ws + WS_XS); const f32x4* cx = (const f32x4*)IN_(2); const f32x4* xx = (const f32x4*)IN_(0);
      for (size_t i = gt; i < (size_t)T * DM / 4; i += NGT) xs[i] = i < (size_t)NCTX * DM / 4 ? cx[i] : xx[i - (size_t)NCTX * DM / 4]; }
    { float* HP = (float*)(ws + WS_HP);
      for (int it = F.bid; it < NL * 16; it += F.G) { const int l = it >> 4, ch = it & 15, w = F.tid >> 8, j = F.tid & 255;
          const float* cv = w ? IN_(3) : IN_(1); const float* ad = IN_(4) + ((size_t)l * DM + ch * 256) * 256 + j; float s = 0.f;
          for (int i = 0; i < 256; ++i) s += siluf_(cv[ch * 256 + i]) * ad[(size_t)i * 256];
          HP[((l * 16 + ch) * 2 + w) * 256 + j] = s; } }
    { float* H3 = (float*)(ws + WS_H3);
      LAS float* zb = (LAS float*)(F.lds + 73728); LAS float* ha = zb + 8 * 36; LAS float* hb = ha + 8 * 64;
      for (int it = F.bid; it < NL * (T / 8); it += F.G) { const int l = it / (T / 8), pb = it % (T / 8);
          if (F.tid < 8 * 33) { const int p = F.tid / 33, i = F.tid % 33, P = pb * 8 + p; const int L = P < NCTX ? NCTX : SEQ, t = P < NCTX ? P : P - NCTX;
              float z;
              if (i == 0) z = (float)t / (float)(L - 1);
              else { const int b = (i - 1) & 15; const float fb = 1e-4f + (float)b * ((15.0f - 1e-4f) / 15.0f); const float rev2 = 2.0f * fb * (float)t / (float)L;
                  z = i <= 16 ? cospif(rev2) : -sinpif(rev2); }
              zb[p * 36 + i] = z; }
          __syncthreads();
          const int p = F.tid >> 6, j = F.tid & 63; const float fq = IN_(36)[l * 64 + j];
          { const float* w1 = IN_(29) + (size_t)l * 33 * 64 + j; float s = IN_(30)[l * 64 + j];
            for (int i = 0; i < 33; ++i) s += zb[p * 36 + i] * w1[i * 64];
            ha[p * 64 + j] = sinf(fq * s); }
          __syncthreads();
          { const float* w2 = IN_(31) + (size_t)l * 64 * 64 + j; float s = IN_(32)[l * 64 + j];
            for (int i = 0; i < 64; ++i) s += ha[p * 64 + i] * w2[i * 64];
            hb[p * 64 + j] = sinf(fq * s); }
          __syncthreads();
          { const float* w3 = IN_(33) + (size_t)l * 64 * 64 + j; float s = IN_(34)[l * 64 + j];
            for (int i = 0; i < 64; ++i) s += hb[p * 64 + i] * w3[i * 64];
            ((bf16_t*)H3)[((size_t)l * 64 + j) * T + pb * 8 + p] = (bf16_t)(cvt_pk_bf16(sinf(fq * s), 0.f) & 0xffffu); }
          __syncthreads(); } }
}
__device__ __forceinline__ void phase_mod(const Frame& F, unsigned char* ws) {
    const float* HP = (const float*)(ws + WS_HP); float* MOD = (float*)(ws + WS_MOD);
    LAS float* hs = (LAS float*)F.lds;
    for (int it = F.bid; it < NL * (NMOD / 512); it += F.G) { const int l = it / (NMOD / 512), nb = it % (NMOD / 512);
        { const int w = F.tid >> 8, j = F.tid & 255; float s = 0.f;
          for (int ch = 0; ch < 16; ++ch) s += HP[((l * 16 + ch) * 2 + w) * 256 + j];
          hs[w * 256 + j] = s; }
        __syncthreads();
        const int n = nb * 512 + F.tid; const float* au = IN_(5) + (size_t)l * 256 * NMOD + n; float s0 = IN_(6)[(size_t)l * NMOD + n], s1 = s0;
        for (int j = 0; j < 256; ++j) { const float u = au[(size_t)j * NMOD]; s0 += hs[j] * u; s1 += hs[256 + j] * u; }
        MOD[((size_t)l * 2 + 0) * NMOD + n] = s0; MOD[((size_t)l * 2 + 1) * NMOD + n] = s1;
        __syncthreads(); }
}
__device__ __forceinline__ void norm_phase(const Frame& F, float* XS, const float* __restrict__ gain, const float* modx, const float* modc, int ish, int isc, bf16_t* out, const bf16_t* slab, const float* sgate, float sfac) {
    const int gw = F.bid * 8 + F.wave, NGW = F.G * 8;
    int row_lo = 0;
    if (slab) { row_lo = NCTX;
        LAS float* red = (LAS float*)F.lds;
        for (int row = F.bid; row < NCTX; row += F.G) { const size_t o = (size_t)row * DM + F.wave * 512;
            f32x4 v[2]; float s = 0.f;
#pragma unroll
            for (int j = 0; j < 2; ++j) { f32x4 acc = (f32x4){0.f, 0.f, 0.f, 0.f};
#pragma unroll
                for (int ks = 0; ks < 16; ++ks) acc += bf4f(((const u32x2*)(slab + (size_t)ks * NCTX * DM + o) + F.lane)[64 * j]);
                v[j] = ((const f32x4*)(XS + o) + F.lane)[64 * j] + acc * ((const f32x4*)(sgate + F.wave * 512) + F.lane)[64 * j] * sfac;
                ((f32x4*)(XS + o) + F.lane)[64 * j] = v[j]; s += (v[j].x * v[j].x + v[j].y * v[j].y) + (v[j].z * v[j].z + v[j].w * v[j].w); }
            s = wave_sum(s); if (F.lane == 0) red[F.wave] = s;
            __syncthreads();
            float tot = 0.f;
#pragma unroll
            for (int w = 0; w < 8; ++w) tot += red[w];
            const float rstd = rsqrtf(tot * (1.0f / DM) + NORM_EPS);
#pragma unroll
            for (int j = 0; j < 2; ++j) { const int c4 = F.wave * 128 + F.lane + 64 * j;
                const f32x4 y = v[j] * rstd * ((const f32x4*)gain)[c4] * (((const f32x4*)(modc + (size_t)isc * DM))[c4] + 1.0f) + ((const f32x4*)(modc + (size_t)ish * DM))[c4];
                u32x2 w2; w2.x = cvt_pk_bf16(y.x, y.y); w2.y = cvt_pk_bf16(y.z, y.w); ((u32x2*)(out + (size_t)row * DM))[c4] = w2; }
            __syncthreads(); } }
    for (int row = row_lo + gw; row < T; row += NGW) {
        const float* mod = row < NCTX ? modc : modx;
        const f32x4* xr = (const f32x4*)(XS + (size_t)row * DM) + F.lane; const f32x4* g4 = (const f32x4*)gain + F.lane;
        const f32x4* sh4 = (const f32x4*)(mod + (size_t)ish * DM) + F.lane; const f32x4* sc4 = (const f32x4*)(mod + (size_t)isc * DM) + F.lane;
        f32x4 v[16]; float s = 0.f;
#pragma unroll
        for (int j = 0; j < 16; ++j) { v[j] = xr[64 * j]; s += (v[j].x * v[j].x + v[j].y * v[j].y) + (v[j].z * v[j].z + v[j].w * v[j].w); }
        const float rstd = rsqrtf(wave_sum(s) * (1.0f / DM) + NORM_EPS);
        u32x2* o = (u32x2*)(out + (size_t)row * DM) + F.lane;
#pragma unroll
        for (int j = 0; j < 16; ++j) { const f32x4 y = v[j] * rstd * g4[64 * j] * (sc4[64 * j] + 1.0f) + sh4[64 * j];
            u32x2 w; w.x = cvt_pk_bf16(y.x, y.y); w.y = cvt_pk_bf16(y.z, y.w); o[64 * j] = w; }
    }
}
__device__ __forceinline__ float conv3_at(const bf16_t* PX, int tau, int col, float w0, float w1, float w2) {
    const bf16_t* p = PX + (size_t)tau * PXW + col;
    const bool hl = has_left(tau), hr = has_right(tau);
    return bf2f(p[0]) * w1 + bf2f(p[hl ? -PXW : 0]) * (hl ? w0 : 0.f) + bf2f(p[hr ? PXW : 0]) * (hr ? w2 : 0.f);
}
__device__ __forceinline__ float rope_apply(float val, int tau, int j) {
    const int pos = tau - NCTX, prow = pos >> 6, pcol = pos & 63;
    const float inv = __powf(10000.0f, -(float)(j & 15) * (1.0f / 16.0f));
    const float ang = (float)(j < 32 ? prow : pcol) * inv;
    float sn, cs; sincosf(ang, &sn, &cs);
    const float partner = __shfl_xor(val, 16);
    const float rot = (j & 16) ? partner : -partner;
    return val * cs + rot * sn;
}
__device__ __forceinline__ void mla_prep_phase(const Frame& F, unsigned char* ws, int l) {
    const bf16_t* PX = (const bf16_t*)(ws + WS_PX); bf16_t* QA = (bf16_t*)(ws + WS_QA); bf16_t* KVA = (bf16_t*)(ws + WS_KVA); bf16_t* KPE = (bf16_t*)(ws + WS_KPE);
    const int gw = F.bid * 8 + F.wave, NGW = F.G * 8;
    const f32x4* gq = (const f32x4*)(IN_(38) + l * 1024) + F.lane; const f32x4* gkv = (const f32x4*)(IN_(40) + l * 512) + F.lane; const float gpe = IN_(45)[l * 64 + F.lane];
    for (int tau = gw; tau < T; tau += NGW) {
        const u32x2* p = (const u32x2*)(PX + (size_t)tau * PXW + PXC) + F.lane;
        f32x4 q[4], kv[2]; float sq = 0.f, skv = 0.f;
#pragma unroll
        for (int j = 0; j < 4; ++j) { q[j] = bf4f(p[64 * j]); sq += (q[j].x * q[j].x + q[j].y * q[j].y) + (q[j].z * q[j].z + q[j].w * q[j].w); }
#pragma unroll
        for (int j = 0; j < 2; ++j) { kv[j] = bf4f(p[256 + 64 * j]); skv += (kv[j].x * kv[j].x + kv[j].y * kv[j].y) + (kv[j].z * kv[j].z + kv[j].w * kv[j].w); }
        const float pe = bf2f(PX[(size_t)tau * PXW + PXC + 1536 + F.lane]);
        const float rq = rsqrtf(wave_sum(sq) * (1.0f / 1024.0f) + NORM_EPS), rkv = rsqrtf(wave_sum(skv) * (1.0f / 512.0f) + NORM_EPS), rpe = rsqrtf(wave_sum(pe * pe) * (1.0f / 64.0f) + NORM_EPS);
        u32x2* oq = (u32x2*)(QA + (size_t)tau * 1024) + F.lane; u32x2* okv = (u32x2*)(KVA + (size_t)tau * 512) + F.lane;
#pragma unroll
        for (int j = 0; j < 4; ++j) { const f32x4 y = q[j] * rq * gq[64 * j]; u32x2 w; w.x = cvt_pk_bf16(y.x, y.y); w.y = cvt_pk_bf16(y.z, y.w); oq[64 * j] = w; }
#pragma unroll
        for (int j = 0; j < 2; ++j) { const f32x4 y = kv[j] * rkv * gkv[64 * j]; u32x2 w; w.x = cvt_pk_bf16(y.x, y.y); w.y = cvt_pk_bf16(y.z, y.w); okv[64 * j] = w; }
        float kp = pe * rpe * gpe;
        if (tau >= NCTX) kp = rope_apply(kp, tau, F.lane);
        KPE[(size_t)tau * 64 + F.lane] = (bf16_t)(cvt_pk_bf16(kp, kp) & 0xffffu);
    }
}
__device__ __forceinline__ void qkv_final_phase(const Frame& F, unsigned char* ws, int l, bool need_ctx) {
    const bf16_t* QRAW = (const bf16_t*)(ws + WS_QRAW); const bf16_t* KVRAW = (const bf16_t*)(ws + WS_KVRAW); const bf16_t* KPE = (const bf16_t*)(ws + WS_KPE);
    bf16_t* QF = (bf16_t*)(ws + WS_QF); bf16_t* KF = (bf16_t*)(ws + WS_KF);
    const int gw = F.bid * 8 + F.wave, NGW = F.G * 8, ln = F.lane;
    const float gqn0 = IN_(42)[l * 128 + 2 * ln], gqn1 = IN_(42)[l * 128 + 2 * ln + 1], gqp = IN_(43)[l * 64 + ln];
    const float gkn0 = IN_(44)[l * 128 + 2 * ln], gkn1 = IN_(44)[l * 128 + 2 * ln + 1];
    (void)need_ctx;
    for (int tau = gw; tau < T; tau += NGW) {
        float cs = 1.f, sn = 0.f;
        if (tau >= NCTX) { const int pos = tau - NCTX, prow = pos >> 6, pcol = pos & 63; const float inv = __powf(10000.0f, -(float)(ln & 15) * (1.0f / 16.0f)); sincosf((float)(ln < 32 ? prow : pcol) * inv, &sn, &cs); }
        const bf16_t kpe = KPE[(size_t)tau * 64 + ln];
        const bf16_t* qrow = QRAW + (size_t)tau * NQ; const bf16_t* krow = KVRAW + (size_t)tau * NKV;
        unsigned qn[NHC], kn[NHC]; bf16_t qpv[NHC];
#pragma unroll
        for (int h = 0; h < NHC; ++h) { qn[h] = *(const unsigned*)(qrow + h * 192 + 2 * ln); qpv[h] = qrow[h * 192 + 128 + ln]; kn[h] = *(const unsigned*)(krow + h * 256 + 2 * ln); }
#pragma unroll
        for (int h = 0; h < NHC; ++h) {
            const float q0 = bf2f((unsigned short)(qn[h] & 0xffffu)), q1 = bf2f((unsigned short)(qn[h] >> 16)), qp = bf2f(qpv[h]), k0 = bf2f((unsigned short)(kn[h] & 0xffffu)), k1 = bf2f((unsigned short)(kn[h] >> 16));
            const float rqn = rsqrtf(wave_sum(q0 * q0 + q1 * q1) * (1.0f / 128.0f) + NORM_EPS), rqp = rsqrtf(wave_sum(qp * qp) * (1.0f / 64.0f) + NORM_EPS), rkn = rsqrtf(wave_sum(k0 * k0 + k1 * k1) * (1.0f / 128.0f) + NORM_EPS);
            float qpe = qp * rqp * gqp;
            { const float partner = __shfl_xor(qpe, 16); const float rot = (ln & 16) ? partner : -partner; qpe = qpe * cs + rot * sn; }
            *(unsigned*)(QF + (size_t)tau * NQ + h * 192 + 2 * ln) = cvt_pk_bf16(q0 * rqn * gqn0, q1 * rqn * gqn1);
            QF[(size_t)tau * NQ + h * 192 + 128 + ln] = (bf16_t)(cvt_pk_bf16(qpe, qpe) & 0xffffu);
            *(unsigned*)(KF + (size_t)tau * NQ + h * 192 + 2 * ln) = cvt_pk_bf16(k0 * rkn * gkn0, k1 * rkn * gkn1);
            KF[(size_t)tau * NQ + h * 192 + 128 + ln] = kpe; }
    }
}
__device__ __forceinline__ void rwkv_out_phase(const Frame& F, unsigned char* ws, int l, bool need_ctx) {
    const float* SS = (const float*)(ws + WS_SS); const float* SD = (const float*)(ws + WS_SD); const float* GB = (const float*)(ws + WS_G); const float* Y = (const float*)(ws + WS_Y);
    bf16_t* OB = (bf16_t*)(ws + WS_OBUF);
    const int gw = F.bid * 8 + F.wave, NGW = F.G * 8, ln = F.lane;
    for (int it = (need_ctx ? 0 : NCTX * 5) + gw; it < T * 5; it += NGW) { const int tau = it / 5, h0 = (it % 5) * 4;
        float y0[4], y1[4], v[4], sa[4], sb[4], g[4];
#pragma unroll
        for (int q = 0; q < 4; ++q) { const int h = h0 + q, col = h * 64 + ln; const size_t o = (size_t)tau * A_W + col;
            y0[q] = Y[o]; y1[q] = Y[(size_t)T * A_W + o]; v[q] = SS[(size_t)T * A_W + o];
            sa[q] = SD[(size_t)tau * NHA + h]; sb[q] = SD[((size_t)T + tau) * NHA + h]; g[q] = GB[o]; }
#pragma unroll
        for (int q = 0; q < 4; ++q) { const int col = (h0 + q) * 64 + ln;
            const float y = y0[q] + y1[q];
            const float mu = wave_sum(y) * (1.0f / 64.0f); const float dy = y - mu; const float var = wave_sum(dy * dy) * (1.0f / 64.0f);
            const float yn = dy * rsqrtf(var + GN_EPS) * IN_(25)[l * A_W + col] + IN_(26)[l * A_W + col];
            const float bonus = 0.5f * (sa[q] + sb[q]) * v[q];
            const float ov = (yn + bonus) * g[q];
            OB[(size_t)tau * DM + col] = (bf16_t)(cvt_pk_bf16(ov, ov) & 0xffffu); }
    }
}
__device__ __forceinline__ void hyena_prep_phase(const Frame& F, unsigned char* ws, int l) {
    const bf16_t* PX = (const bf16_t*)(ws + WS_PX); float* GT = (float*)(ws + WS_GT); float* X0T = (float*)(ws + WS_X0T);
    LAS float* LGt = (LAS float*)F.lds; LAS float* LX0 = LGt + 64 * 65;
    const float* cw = IN_(27) + (size_t)l * 3 * B_IN; const float* cb = IN_(28) + (size_t)l * B_IN;
    for (int it = F.bid; it < (T / 64) * 20; it += F.G) { const int tt = it / 20, ct = it % 20;
        { const int t = F.tid >> 3, c0 = ct * 64 + (F.tid & 7) * 8, tau = tt * 64 + t;
          f32x4 u[3][2];
#pragma unroll
          for (int grp = 0; grp < 3; ++grp)
#pragma unroll
              for (int q = 0; q < 2; ++q) { const int c = grp * 1280 + c0 + 4 * q; const bf16_t* p = PX + (size_t)tau * PXW + PXB + c;
                  const bool hl = has_left(tau), hr = has_right(tau);
                  const f32x4 y = bf4f(*(const u32x2*)p) * *(const f32x4*)(cw + B_IN + c) + *(const f32x4*)(cb + c) + bf4f(*(const u32x2*)(p - (hl ? PXW : 0))) * (*(const f32x4*)(cw + c) * (hl ? 1.f : 0.f))
                                + bf4f(*(const u32x2*)(p + (hr ? PXW : 0))) * (*(const f32x4*)(cw + 2 * B_IN + c) * (hr ? 1.f : 0.f));
                  u[grp][q] = y; }
#pragma unroll
          for (int q = 0; q < 2; ++q)
#pragma unroll
              for (int e = 0; e < 4; ++e) { const int ch = (F.tid & 7) * 8 + 4 * q + e; LGt[ch * 65 + t] = u[1][q][e] * u[2][q][e]; LX0[ch * 65 + t] = u[0][q][e]; } }
        __syncthreads();
        { const int ch = F.tid >> 3, t0 = (F.tid & 7) * 8; const size_t o = (size_t)(ct * 64 + ch) * T + tt * 64 + t0;
          f32x4 a0, a1, b0, b1;
#pragma unroll
          for (int e = 0; e < 4; ++e) { a0[e] = LGt[ch * 65 + t0 + e]; a1[e] = LGt[ch * 65 + t0 + 4 + e]; b0[e] = LX0[ch * 65 + t0 + e]; b1[e] = LX0[ch * 65 + t0 + 4 + e]; }
          *(f32x4*)(GT + o) = a0; *(f32x4*)(GT + o + 4) = a1; *(f32x4*)(X0T + o) = b0; *(f32x4*)(X0T + o + 4) = b1; }
        __syncthreads(); }
}
__device__ __forceinline__ void hyena_out_phase(const Frame& F, unsigned char* ws, bool need_ctx) {
    const float* YT = (const float*)(ws + WS_GT); bf16_t* OB = (bf16_t*)(ws + WS_OBUF);
    LAS float* L = (LAS float*)F.lds;
    const int it0 = need_ctx ? 0 : (NCTX / 64) * 20;
    for (int it = it0 + F.bid; it < (T / 64) * 20; it += F.G) { const int tt = it / 20, ct = it % 20;
        { const int ch = F.tid >> 3, t0 = (F.tid & 7) * 8; const size_t o = (size_t)(ct * 64 + ch) * T + tt * 64 + t0;
          const f32x4 a0 = *(const f32x4*)(YT + o), a1 = *(const f32x4*)(YT + o + 4);
#pragma unroll
          for (int e = 0; e < 4; ++e) { L[ch * 65 + t0 + e] = a0[e]; L[ch * 65 + t0 + 4 + e] = a1[e]; } }
        __syncthreads();
        { const int t = F.tid >> 3, c0 = (F.tid & 7) * 8; float x[8];
#pragma unroll
          for (int e = 0; e < 8; ++e) x[e] = L[(c0 + e) * 65 + t];
          u32x4 w; w.x = cvt_pk_bf16(x[0], x[1]); w.y = cvt_pk_bf16(x[2], x[3]); w.z = cvt_pk_bf16(x[4], x[5]); w.w = cvt_pk_bf16(x[6], x[7]);
          *(u32x4*)(OB + (size_t)(tt * 64 + t) * DM + 1280 + ct * 64 + c0) = w; }
        __syncthreads(); }
}
namespace att {
constexpr int DK = 192, DV = 128, NW = 8, QBLK = 32, KVBLK = 64;
constexpr float SCALE = 0.07216878364870322f;
constexpr float THR = 8.f;
#ifndef ATT_SDEPTH
#define ATT_SDEPTH 2
#endif
constexpr int SDEPTH = ATT_SDEPTH;
constexpr int LDQ = 2304, LDK = 2304, LDV = 3072, LDO = 4096;
constexpr int SHM_V = KVBLK * DV * 2, SHM_K = KVBLK * DK * 2, SHM_ATTN = 2 * SHM_V + 2 * SHM_K + NW * 64 * 4 + NW * 4096;
using bf16x8 = __attribute__((ext_vector_type(8))) short;
using s16x4  = __attribute__((ext_vector_type(4))) short;
using f32x16 = __attribute__((ext_vector_type(16))) float;
using u32x4  = __attribute__((ext_vector_type(4))) unsigned;
#define KSWZ(row, colB) ((row) * 384 + ((colB) ^ (((row) & 7) << 4)))
#define SBAR() __builtin_amdgcn_sched_barrier(0)
__device__ __forceinline__ int crow(int r, int hi) { return (r & 3) + 8 * (r >> 2) + 4 * hi; }
__device__ __forceinline__ unsigned cvtpk(float lo, float hi) { unsigned r; asm volatile("v_cvt_pk_bf16_f32 %0, %1, %2" : "=v"(r) : "v"(lo), "v"(hi)); return r; }
__device__ __forceinline__ void partialSM(f32x16& p0, f32x16& p1, float& m_reg, float& mn, float& alpha) {
  constexpr float C = SCALE * 1.4426950408889634f;
  float pmax = p0[0]; for (int r = 1; r < 16; ++r) pmax = fmaxf(pmax, p0[r]); for (int r = 0; r < 16; ++r) pmax = fmaxf(pmax, p1[r]);
  { auto rr = __builtin_amdgcn_permlane32_swap(__float_as_uint(pmax), __float_as_uint(pmax), false, false);
    pmax = fmaxf(__uint_as_float(rr[0]), __uint_as_float(rr[1])); }
  if (__builtin_expect(__all(pmax - m_reg <= THR / SCALE), 1)) { mn = m_reg; alpha = 1.f; }
  else { mn = fmaxf(m_reg, pmax); alpha = __builtin_amdgcn_exp2f((m_reg - mn) * C); m_reg = mn; }
  float mnC = -mn * C;
  for (int r = 0; r < 16; ++r) p0[r] = fmaf(p0[r], C, mnC); for (int r = 0; r < 16; ++r) p1[r] = fmaf(p1[r], C, mnC);
  for (int r = 0; r < 16; ++r) p0[r] = __builtin_amdgcn_exp2f(p0[r]);
}
__device__ __forceinline__ void finishSM(f32x16& p0, f32x16& p1, float alpha, float& l_reg, bf16x8& pa0, bf16x8& pa1, bf16x8& pa2, bf16x8& pa3) {
  for (int r = 0; r < 16; ++r) p1[r] = __builtin_amdgcn_exp2f(p1[r]);
  float ps = 0; for (int r = 0; r < 16; ++r) ps += p0[r]; for (int r = 0; r < 16; ++r) ps += p1[r];
  { auto rr = __builtin_amdgcn_permlane32_swap(__float_as_uint(ps), __float_as_uint(ps), false, false);
    ps = __uint_as_float(rr[0]) + __uint_as_float(rr[1]); }
  l_reg = l_reg * alpha + ps;
#define PK4(P, BASE, OUT) do { unsigned a0 = cvtpk(P[BASE + 0], P[BASE + 1]), a1 = cvtpk(P[BASE + 2], P[BASE + 3]);   \
    unsigned b0 = cvtpk(P[BASE + 4], P[BASE + 5]), b1 = cvtpk(P[BASE + 6], P[BASE + 7]);                              \
    auto r0 = __builtin_amdgcn_permlane32_swap(a0, b0, false, false); auto r1 = __builtin_amdgcn_permlane32_swap(a1, b1, false, false); \
    u32x4 w = {r0[0], r1[0], r0[1], r1[1]}; OUT = *reinterpret_cast<bf16x8*>(&w); } while (0)
  PK4(p0, 0, pa0); PK4(p0, 8, pa1); PK4(p1, 0, pa2); PK4(p1, 8, pa3);
#undef PK4
}
__device__ __forceinline__ void qkt(f32x16& p0, f32x16& p1, const char* Ks, const bf16x8* qr, const char* qrl, int r32, int hi) {
  p0 = f32x16{}; p1 = f32x16{};
#pragma unroll
  for (int d0 = 0; d0 < 8; ++d0) { int cb = (d0 * 16 + hi * 8) * 2;
    bf16x8 b0 = *reinterpret_cast<const bf16x8*>(Ks + KSWZ(r32, cb));
    bf16x8 b1 = *reinterpret_cast<const bf16x8*>(Ks + KSWZ(32 + r32, cb));
    p0 = __builtin_amdgcn_mfma_f32_32x32x16_bf16(b0, qr[d0], p0, 0, 0, 0);
    p1 = __builtin_amdgcn_mfma_f32_32x32x16_bf16(b1, qr[d0], p1, 0, 0, 0); }
#pragma unroll
  for (int d0 = 8; d0 < 12; ++d0) { int cb = (d0 * 16 + hi * 8) * 2;
    bf16x8 b0 = *reinterpret_cast<const bf16x8*>(Ks + KSWZ(r32, cb));
    bf16x8 b1 = *reinterpret_cast<const bf16x8*>(Ks + KSWZ(32 + r32, cb));
    const bf16x8 q = *reinterpret_cast<const bf16x8*>(qrl + ((((d0 - 8) * 2 + hi) ^ (r32 & 7)) << 4));
    p0 = __builtin_amdgcn_mfma_f32_32x32x16_bf16(b0, q, p0, 0, 0, 0);
    p1 = __builtin_amdgcn_mfma_f32_32x32x16_bf16(b1, q, p1, 0, 0, 0); }
}
__device__ __forceinline__ int v_st(int k, int c) { const int kk = (k & ~0xC) | ((k & 4) << 1) | ((k & 8) >> 1); return ((kk >> 3) * 4 + (c >> 5)) * 512 + ((kk & 7) * 32 + (c & 31)) * 2; }
__device__ __forceinline__ int v_rd_base(int lane) { return ((lane & 3) << 3) | (((lane >> 2) & 3) << 6) | (((lane >> 4) & 1) << 5) | (((lane >> 5) & 1) << 8); }
constexpr int v_rd_off(int d0, int ks, int half) { return d0 * 512 + ks * 4096 + half * 2048; }
template <int OFF> __device__ __forceinline__ s16x4 tr_read(int vb) {
  s16x4 r; asm volatile("ds_read_b64_tr_b16 %0, %1 offset:%2" : "=&v"(r) : "v"(vb), "i"(OFF) : "memory"); return r;
}
template <int D0> __device__ __forceinline__ void pv_one(f32x16& od, int vb, bf16x8 pa0, bf16x8 pa1, bf16x8 pa2, bf16x8 pa3) {
  const s16x4 l0 = tr_read<v_rd_off(D0, 0, 0)>(vb), h0 = tr_read<v_rd_off(D0, 0, 1)>(vb), l1 = tr_read<v_rd_off(D0, 1, 0)>(vb), h1 = tr_read<v_rd_off(D0, 1, 1)>(vb);
  const s16x4 l2 = tr_read<v_rd_off(D0, 2, 0)>(vb), h2 = tr_read<v_rd_off(D0, 2, 1)>(vb), l3 = tr_read<v_rd_off(D0, 3, 0)>(vb), h3 = tr_read<v_rd_off(D0, 3, 1)>(vb);
  asm volatile("s_waitcnt lgkmcnt(0)" ::: "memory"); SBAR();
#define PK(L, H) (bf16x8){L[0], L[1], L[2], L[3], H[0], H[1], H[2], H[3]}
  od = __builtin_amdgcn_mfma_f32_32x32x16_bf16(pa0, PK(l0, h0), od, 0, 0, 0);
  od = __builtin_amdgcn_mfma_f32_32x32x16_bf16(pa1, PK(l1, h1), od, 0, 0, 0);
  od = __builtin_amdgcn_mfma_f32_32x32x16_bf16(pa2, PK(l2, h2), od, 0, 0, 0);
  od = __builtin_amdgcn_mfma_f32_32x32x16_bf16(pa3, PK(l3, h3), od, 0, 0, 0);
#undef PK
}
__device__ __forceinline__ void pv_d0(f32x16* o, int vb, bf16x8 pa0, bf16x8 pa1, bf16x8 pa2, bf16x8 pa3) {
  pv_one<0>(o[0], vb, pa0, pa1, pa2, pa3); pv_one<1>(o[1], vb, pa0, pa1, pa2, pa3); pv_one<2>(o[2], vb, pa0, pa1, pa2, pa3); pv_one<3>(o[3], vb, pa0, pa1, pa2, pa3);
}
__device__ __forceinline__ void attn_body(const bf16_t* __restrict__ Qb, const bf16_t* __restrict__ Kh, const bf16_t* __restrict__ Vh, bf16_t* __restrict__ Ob, int seq, char* lds) {
  int tid_ = threadIdx.x; asm volatile("" : "+v"(tid_));
  const int tid = tid_, wid = tid >> 6, lane = tid & 63, r32 = lane & 31, hi = lane >> 5;
  char* V_lds = lds; char* K_lds = lds + 2 * SHM_V;
  float* ws = (float*)(lds + 2 * SHM_V + 2 * SHM_K) + wid * 64; float* li_l = ws; float* al_l = ws + 32;
  float m_reg = -1e30f, l_reg = 0; f32x16 o[4] = {}; bf16x8 qr[8];
  const bf16_t* Qw = Qb + (long)(wid * QBLK + r32) * LDQ + hi * 8;
  char* qrl = lds + 2 * SHM_V + 2 * SHM_K + NW * 64 * 4 + wid * 4096 + r32 * 128;
#pragma unroll
  for (int d0 = 0; d0 < 8; ++d0) qr[d0] = *reinterpret_cast<const bf16x8*>(Qw + d0 * 16);
#pragma unroll
  for (int d0 = 8; d0 < 12; ++d0) *reinterpret_cast<bf16x8*>(qrl + ((((d0 - 8) * 2 + hi) ^ (r32 & 7)) << 4)) = *reinterpret_cast<const bf16x8*>(Qw + d0 * 16);
  asm volatile("s_waitcnt lgkmcnt(0)" ::: "memory");
  unsigned kgo[3], vgo[2];
#pragma unroll
  for (int i = 0; i < 3; ++i) { const int p = (i * 8 + wid) * 64 + lane, row = p / 24, slot = p % 24, ch = slot ^ (row & 7); kgo[i] = (unsigned)(row * LDK + ch * 8) * 2u; }
#pragma unroll
  for (int i = 0; i < 2; ++i) { const int p = (i * 8 + wid) * 64 + lane, sub = p >> 5, within = p & 31, kk = (sub >> 2) * 8 + (within >> 2), c = (sub & 3) * 32 + (within & 3) * 8;
    const int k = (kk & ~0xC) | ((kk & 4) << 1) | ((kk & 8) >> 1); vgo[i] = (unsigned)(k * LDV + c) * 2u; }
  const int vb0 = (int)(uintptr_t)V_lds + v_rd_base(lane);
  typedef __attribute__((address_space(3))) unsigned lds_u32;
#define DMA_K(b, k0) do { const char* kg = (const char*)Kh + (size_t)(k0) * (LDK * 2); \
    _Pragma("unroll") for (int _i = 0; _i < 3; ++_i) __builtin_amdgcn_global_load_lds((const unsigned*)(kg + kgo[_i]), (lds_u32*)(K_lds + (b) * SHM_K + (_i * 8 + wid) * 1024), 16, 0, 0); } while (0)
#define DMA_V(b, k0) do { const char* vg = (const char*)Vh + (size_t)(k0) * (LDV * 2); \
    _Pragma("unroll") for (int _i = 0; _i < 2; ++_i) __builtin_amdgcn_global_load_lds((const unsigned*)(vg + vgo[_i]), (lds_u32*)(V_lds + (b) * SHM_V + (_i * 8 + wid) * 1024), 16, 0, 0); } while (0)
#define RESC(a) do { if (__any((a) < 1.f)) { if (hi == 0) al_l[r32] = (a); asm volatile("s_waitcnt lgkmcnt(0)" ::: "memory"); \
    for (int d = 0; d < 4; ++d) for (int r = 0; r < 16; ++r) o[d][r] *= al_l[crow(r, hi)]; } } while (0)
#define ENDSTEP() do { asm volatile("s_waitcnt vmcnt(0)" ::: "memory"); __syncthreads(); } while (0)
  f32x16 pA0, pA1, pB0, pB1; float mnA, mnB, alA, alB; bf16x8 pa0, pa1, pa2, pa3; const int NT = seq / KVBLK;
  DMA_K(0, 0); ENDSTEP();
  DMA_K(1, KVBLK); DMA_V(0, 0);
  qkt(pA0, pA1, K_lds, qr, qrl, r32, hi); partialSM(pA0, pA1, m_reg, mnA, alA);
  ENDSTEP();
  for (int j = 1; j + 1 < NT; j += 2) {
    DMA_K(0, (j + 1) * KVBLK); DMA_V(1, j * KVBLK);
    SBAR(); qkt(pB0, pB1, K_lds + SHM_K, qr, qrl, r32, hi);
    finishSM(pA0, pA1, alA, l_reg, pa0, pa1, pa2, pa3); SBAR();
    pv_d0(o, vb0, pa0, pa1, pa2, pa3); partialSM(pB0, pB1, m_reg, mnB, alB);
    RESC(alB); ENDSTEP();
    if (j + 2 < NT) DMA_K(1, (j + 2) * KVBLK);
    DMA_V(0, (j + 1) * KVBLK);
    SBAR(); qkt(pA0, pA1, K_lds, qr, qrl, r32, hi);
    finishSM(pB0, pB1, alB, l_reg, pa0, pa1, pa2, pa3); SBAR();
    pv_d0(o, vb0 + (int)SHM_V, pa0, pa1, pa2, pa3); partialSM(pA0, pA1, m_reg, mnA, alA);
    RESC(alA); ENDSTEP();
  }
  DMA_V(1, (NT - 1) * KVBLK);
  SBAR(); qkt(pB0, pB1, K_lds + SHM_K, qr, qrl, r32, hi);
  finishSM(pA0, pA1, alA, l_reg, pa0, pa1, pa2, pa3); SBAR();
  pv_d0(o, vb0, pa0, pa1, pa2, pa3); partialSM(pB0, pB1, m_reg, mnB, alB);
  RESC(alB); ENDSTEP();
  finishSM(pB0, pB1, alB, l_reg, pa0, pa1, pa2, pa3); SBAR();
  pv_d0(o, vb0 + (int)SHM_V, pa0, pa1, pa2, pa3);
#undef DMA_K
#undef DMA_V
#undef ENDSTEP
  if (hi == 0) li_l[r32] = l_reg; asm volatile("s_waitcnt lgkmcnt(0)" ::: "memory");
  float rli[16];
#pragma unroll
  for (int r = 0; r < 16; ++r) rli[r] = __builtin_amdgcn_rcpf(li_l[crow(r, hi)]);
  bf16_t* Ow = Ob + (long)(wid * QBLK) * LDO;
#pragma unroll
  for (int r = 0; r < 16; ++r) { int orow = crow(r, hi);
#pragma unroll
    for (int d0 = 0; d0 < 4; ++d0) { const float val = o[d0][r] * rli[r]; Ow[(long)orow * LDO + d0 * 32 + r32] = (bf16_t)(cvtpk(val, val) & 0xffff); } }
  __syncthreads();
#undef RESC
}
}
__device__ __forceinline__ f32x2 cmul(f32x2 a, f32x2 b) { return (f32x2){a.x * b.x - a.y * b.y, a.x * b.y + a.y * b.x}; }
__device__ __forceinline__ int rev4_14(int k) { const unsigned r = __brev((unsigned)k) >> 18; return (int)(((r & 0x1555u) << 1) | ((r >> 1) & 0x1555u)); }
#define ZI(i) ((i) + ((i) >> 5))
__device__ __forceinline__ void fft_tw(int j, int q, float sign, f32x2& w1, f32x2& w2, f32x2& w3) {
    const float rev = (float)j / (float)(4 * q); const float sn = __builtin_amdgcn_sinf(rev), cs = __builtin_amdgcn_cosf(rev);
    w1 = (f32x2){cs, sign * sn}; w2 = cmul(w1, w1); w3 = cmul(w2, w1);
}
__device__ __forceinline__ void fft16k_dif(LAS f32x2* Z, int tid) {
#pragma unroll 1
    for (int s = 0; s < 7; ++s) { int lq = 12 - 2 * s; asm volatile("" : "+s"(lq)); const int q = 1 << lq;
        const bool shared = q <= 512; f32x2 w1, w2, w3; fft_tw(tid & (q - 1), q, -1.f, w1, w2, w3);
#pragma unroll 2
        for (int i = 0; i < 8; ++i) { const int b = tid + 512 * i, j = b & (q - 1), base = ((b >> lq) << (lq + 2)) + j;
            const int i0 = ZI(base), i1 = ZI(base + q), i2 = ZI(base + 2 * q), i3 = ZI(base + 3 * q);
            const f32x2 a0 = Z[i0], a1 = Z[i1], a2 = Z[i2], a3 = Z[i3];
            const f32x2 t0 = a0 + a2, t1 = a0 - a2, t2 = a1 + a3, t3 = a1 - a3;
            if (!shared) fft_tw(j, q, -1.f, w1, w2, w3);
            Z[i0] = t0 + t2; Z[i1] = cmul((f32x2){t1.x + t3.y, t1.y - t3.x}, w1); Z[i2] = cmul(t0 - t2, w2); Z[i3] = cmul((f32x2){t1.x - t3.y, t1.y + t3.x}, w3); }
        __syncthreads(); }
}
__device__ __forceinline__ void fft16k_dit_inv(LAS f32x2* Z, int tid) {
#pragma unroll 1
    for (int s = 0; s < 7; ++s) { int lq = 2 * s; asm volatile("" : "+s"(lq)); const int q = 1 << lq;
        const bool shared = q <= 512; f32x2 w1, w2, w3; fft_tw(tid & (q - 1), q, 1.f, w1, w2, w3);
#pragma unroll 2
        for (int i = 0; i < 8; ++i) { const int b = tid + 512 * i, j = b & (q - 1), base = ((b >> lq) << (lq + 2)) + j;
            if (!shared) fft_tw(j, q, 1.f, w1, w2, w3);
            const int i0 = ZI(base), i1 = ZI(base + q), i2 = ZI(base + 2 * q), i3 = ZI(base + 3 * q);
            const f32x2 b0 = Z[i0], b1 = cmul(Z[i1], w1), b2 = cmul(Z[i2], w2), b3 = cmul(Z[i3], w3);
            const f32x2 t0 = b0 + b2, t1 = b0 - b2, t2 = b1 + b3, t3 = b1 - b3;
            Z[i0] = t0 + t2; Z[i1] = (f32x2){t1.x - t3.y, t1.y + t3.x}; Z[i2] = t0 - t2; Z[i3] = (f32x2){t1.x + t3.y, t1.y - t3.x}; }
        __syncthreads(); }
}
constexpr float HY_MIN_DECAY = -3.0701134573253945f, HY_MAX_DECAY = -15.350567286626973f;
__device__ __forceinline__ float hy_delta(int c) { return fabsf(HY_MIN_DECAY + (HY_MAX_DECAY - HY_MIN_DECAY) * ((float)c / 1279.0f)); }
__device__ __forceinline__ float conv3b_at(const bf16_t* PX, int tau, int col, const float* cw, int l, int c) {
    const float* w = cw + (size_t)l * 3 * B_IN;
    return conv3_at(PX, tau, col, w[c], w[B_IN + c], w[2 * B_IN + c]);
}
__device__ __forceinline__ void hyena_taps_unit(const Frame& F, unsigned char* ws, int l, int pair) {
    LAS f32x2* Z = (LAS f32x2*)F.lds; LAS float* red = (LAS float*)(F.lds + LDS_MISC + 128);
    const int tid = F.tid, c0 = 2 * pair;
    const bf16_t* H3x = (const bf16_t*)(ws + WS_H3) + (size_t)l * 64 * T + NCTX;
    f32x2* scr = (f32x2*)(ws + WS_HSCR) + (size_t)pair * 16384; float* htn = (float*)(ws + WS_HSCR + (size_t)640 * 16384 * 8) + 2 * pair;
    LAS f32x4* FW = (LAS f32x4*)(F.lds + LDS_MISC + 256);
    if (tid < 256) { const int j = tid >> 2, q = tid & 3; ((LAS float*)FW)[tid] = IN_(35)[(size_t)l * 64 * 2560 + (size_t)j * 2560 + (q >> 1) * 1280 + c0 + (q & 1)]; }
    __syncthreads();
    const float d0 = hy_delta(c0), d1 = hy_delta(c0 + 1);
#ifndef HYS
#define HYS 31
#endif
    float s0, s1, sc0 = 0.f, sc1 = 0.f;
    {
    s0 = 0.f; s1 = 0.f;
    if (HYS & 1)
#pragma unroll 1
    for (int i = 0; i < 2; ++i) { const int tb = 4096 * i + 8 * tid; const bf16_t* hc = H3x + tb;
        asm volatile("" ::: "memory");
        f32x4 acc[8];
#pragma unroll
        for (int p = 0; p < 8; ++p) acc[p] = (f32x4){0.f, 0.f, 0.f, 0.f};
#pragma unroll 8
        for (int j = 0; j < 64; ++j) { const f32x4 w = FW[j]; const u32x4 hv = *(const u32x4*)(hc + (size_t)j * T);
#pragma unroll
            for (int p = 0; p < 4; ++p) { acc[2 * p] += w * __uint_as_float(hv[p] << 16); acc[2 * p + 1] += w * __uint_as_float(hv[p] & 0xffff0000u); } }
#pragma unroll
        for (int p = 0; p < 8; ++p) { const int t = tb + p;
            const float tl = (float)t * (1.0f / 8191.0f), e0 = __expf(-tl * d0), e1 = __expf(-tl * d1);
            const float f0 = acc[p].x * e0, f1 = acc[p].y * e1, b0 = acc[p].z * e0, b1 = acc[p].w * e1;
            Z[ZI(t)] = (f32x2){f0, f1}; s0 += fabsf(f0); s1 += fabsf(f1);
            if (t < 8191) { Z[ZI(16383 - t)] = (f32x2){b0, b1}; s0 += fabsf(b0); s1 += fabsf(b1); } } }
    if (tid == 0) { float zz = 0.f; asm volatile("" : "+v"(zz)); Z[ZI(8192)] = (f32x2){zz, zz}; }
    s0 = wave_sum(s0); s1 = wave_sum(s1);
    if (F.lane == 0) { red[F.wave * 2] = s0; red[F.wave * 2 + 1] = s1; }
    __syncthreads();
    float n0 = 0.f, n1 = 0.f;
#pragma unroll
    for (int w = 0; w < 8; ++w) { n0 += red[2 * w]; n1 += red[2 * w + 1]; }
    sc0 = 1.0f / (16384.0f * n0); sc1 = 1.0f / (16384.0f * n1);
    if (HYS & 2) fft16k_dif(Z, tid);
#pragma unroll 4
    for (int i = 0; i < 32; ++i) scr[tid + 512 * i] = Z[ZI(tid + 512 * i)];
    __syncthreads();
    }
    if (tid == 0) { htn[0] = sc0; htn[1] = sc1; }
    __syncthreads();
}
__device__ __forceinline__ void hyena_unit(const Frame& F, unsigned char* ws, int l, int pair) {
    LAS f32x2* Z = (LAS f32x2*)F.lds;
    const int tid = F.tid, c0 = 2 * pair;
    float* GT = (float*)(ws + WS_GT); const float* X0T = (const float*)(ws + WS_X0T);
    const f32x2* scr = (const f32x2*)(ws + WS_HSCR) + (size_t)pair * 16384; const float* htn = (const float*)(ws + WS_HSCR + (size_t)640 * 16384 * 8) + 2 * pair;
    const float sc0 = htn[0], sc1 = htn[1];
#ifndef HYS
#define HYS 31
#endif
    for (int rp15 = 0; rp15 < REP(15); ++rp15) {
    const float* g0p = GT + (size_t)c0 * T + NCTX; const float* g1p = g0p + T;
    { float zz = 0.f; asm volatile("" : "+v"(zz));
#pragma unroll 4
      for (int i = 0; i < 16; ++i) { const int t = tid + 512 * i; Z[ZI(t)] = (f32x2){g0p[t], g1p[t]}; Z[ZI(8192 + t)] = (f32x2){zz, zz}; } }
    __syncthreads();
    if (HYS & 2) fft16k_dif(Z, tid);
    if (HYS & 8)
#pragma unroll 2
    for (int i = 0; i < 17; ++i) { const int k = tid + 512 * i; if (i == 16 && tid != 0) break;
        const int pk = rev4_14(k & 16383), pn = rev4_14((16384 - k) & 16383);
        const f32x2 A = Z[ZI(pk)], B = Z[ZI(pn)], At = scr[pk], Bt = scr[pn];
        const f32x2 G0 = (f32x2){0.5f * (A.x + B.x), 0.5f * (A.y - B.y)}, G1 = (f32x2){0.5f * (A.y + B.y), -0.5f * (A.x - B.x)};
        const f32x2 H0 = (f32x2){0.5f * (At.x + Bt.x), 0.5f * (At.y - Bt.y)}, H1 = (f32x2){0.5f * (At.y + Bt.y), -0.5f * (At.x - Bt.x)};
        const f32x2 P0 = cmul(G0, H0), P1 = cmul(G1, H1);
        Z[ZI(pk)] = (f32x2){P0.x - P1.y, P0.y + P1.x};
        if (pn != pk) Z[ZI(pn)] = (f32x2){P0.x + P1.y, P1.x - P0.y}; }
    __syncthreads();
    if (HYS & 2) fft16k_dit_inv(Z, tid);
    }
    const float bb0 = IN_(37)[l * 1280 + c0], bb1 = IN_(37)[l * 1280 + c0 + 1];
    { float* y0p = GT + (size_t)c0 * T + NCTX; float* y1p = y0p + T; const float* x0p = X0T + (size_t)c0 * T + NCTX; const float* x1p = x0p + T;
#pragma unroll 4
      for (int i = 0; i < 16; ++i) { const int t = tid + 512 * i; const f32x2 z = Z[ZI(t)]; const float ga = y0p[t], gb = y1p[t];
          y0p[t] = x0p[t] * (z.x * sc0 + ga * bb0); y1p[t] = x1p[t] * (z.y * sc1 + gb * bb1); } }
    __syncthreads();
}
__device__ __forceinline__ void hyena_ctx_unit(const Frame& F, unsigned char* ws, int l, int unit) {
    LAS float* TF = (LAS float*)F.lds; LAS float* TB = TF + 2048; LAS float* GG = TB + 2048;
    const int tid = F.tid, t = tid >> 1, cc = (tid & 1) * 4, cbase = unit * 8 + cc;
    const bf16_t* H3c = (const bf16_t*)(ws + WS_H3) + (size_t)l * 64 * T; float* GT = (float*)(ws + WS_GT); const float* X0T = (const float*)(ws + WS_X0T);
    { float f[4] = {0.f, 0.f, 0.f, 0.f}, b[4] = {0.f, 0.f, 0.f, 0.f};
      const float* wbase = IN_(35) + (size_t)l * 64 * 2560 + cbase;
      for (int j = 0; j < 64; ++j) { const float hv = bf2f(H3c[(size_t)j * T + t]); const float* wrow = wbase + (size_t)j * 2560;
#pragma unroll
          for (int q = 0; q < 4; ++q) { f[q] += hv * wrow[q]; b[q] += hv * wrow[1280 + q]; } }
      const float tl = (float)t * (1.0f / 255.0f);
#pragma unroll
      for (int q = 0; q < 4; ++q) { const float e = __expf(-tl * hy_delta(cbase + q)); TF[t * 8 + cc + q] = f[q] * e; TB[t * 8 + cc + q] = b[q] * e; GG[t * 8 + cc + q] = GT[(size_t)(cbase + q) * T + t]; } }
    __syncthreads();
    float nrm[4] = {0.f, 0.f, 0.f, 0.f}, y[4] = {0.f, 0.f, 0.f, 0.f};
    for (int s = 0; s < 256; ++s) {
#pragma unroll
        for (int q = 0; q < 4; ++q) { nrm[q] += fabsf(TF[s * 8 + cc + q]) + (s < 255 ? fabsf(TB[s * 8 + cc + q]) : 0.f);
            const int o = t - s; const float tap = o >= 0 ? TF[o * 8 + cc + q] : TB[(-o - 1) * 8 + cc + q];
            y[q] += tap * GG[s * 8 + cc + q]; } }
    __syncthreads();
#pragma unroll
    for (int q = 0; q < 4; ++q) GT[(size_t)(cbase + q) * T + t] = X0T[(size_t)(cbase + q) * T + t] * (y[q] / nrm[q] + GG[t * 8 + cc + q] * IN_(37)[l * 1280 + cbase + q]);
    __syncthreads();
}
constexpr int SC_C = 16, SC_NCHUNK = T / SC_C, SC_CHUNK_BYTES = 14 * 1024;
__device__ __forceinline__ int sc_tau(int d, int c, int t) { return d == 0 ? SC_C * c + t : (c < NCTX / SC_C ? NCTX - 1 - SC_C * c - t : T - 1 - SC_C * (c - NCTX / SC_C) - t); }
__device__ __forceinline__ int sc_perm(int e, int hi) { return (e & 3) + 8 * (e >> 2) + 4 * hi; }
constexpr size_t WS_FR_BYTES = (size_t)2 * NHA * SC_NCHUNK * SC_CHUNK_BYTES;

typedef short sc_bf16x8 __attribute__((ext_vector_type(8)));
typedef float sc_f32x16 __attribute__((ext_vector_type(16)));
__device__ __forceinline__ sc_bf16x8 sc_pack8(const sc_f32x16& a, int base) {
    u32x4 w; w.x = cvt_pk_bf16(a[base + 0], a[base + 1]); w.y = cvt_pk_bf16(a[base + 2], a[base + 3]); w.z = cvt_pk_bf16(a[base + 4], a[base + 5]); w.w = cvt_pk_bf16(a[base + 6], a[base + 7]);
    return *reinterpret_cast<sc_bf16x8*>(&w);
}
constexpr int SC_NSLOT = 9, SC_AHEAD = 7;
__device__ __forceinline__ void scan_chain_mfma(const Frame& F, unsigned char* ws, int chain) {
    const int h = chain >> 1, d = chain & 1, lane = F.lane, n = lane & 31, hi = lane >> 5, ib = F.wave;
    const unsigned char* FRc = ws + WS_FR + (size_t)chain * SC_NCHUNK * SC_CHUNK_BYTES;
    float* Yd = (float*)(ws + WS_Y) + (size_t)d * T * A_W + h * 64;
    LAS unsigned char* buf = F.lds;
    typedef __attribute__((address_space(3))) unsigned sc_lds_u32;
#define SCM_DMA(c_) do { if (ib < 7) { const unsigned char* src_ = FRc + (size_t)(c_) * SC_CHUNK_BYTES; LAS unsigned char* dst_ = buf + ((c_) % SC_NSLOT) * SC_CHUNK_BYTES; \
        _Pragma("unroll") for (int i_ = 0; i_ < 2; ++i_) __builtin_amdgcn_global_load_lds((const unsigned*)(src_ + (i_ * 7 + ib) * 1024 + lane * 16), (sc_lds_u32*)(dst_ + (i_ * 7 + ib) * 1024), 16, 0, 0); } } while (0)
    sc_f32x16 S0 = {}, S1 = {};
    int yoff[8];
#pragma unroll
    for (int r = 0; r < 8; ++r) { const int t = (r & 3) + 8 * (r >> 2) + 4 * hi; yoff[r] = (d ? -t : t) * A_W + 32 * ib + n; }
    __syncthreads();
#pragma unroll
    for (int c = 0; c < SC_AHEAD; ++c) SCM_DMA(c);
    asm volatile("s_waitcnt vmcnt(12)" ::: "memory"); __builtin_amdgcn_s_barrier(); asm volatile("" ::: "memory");
#pragma unroll 1
    for (int c = 0; c < SC_NCHUNK; ++c) {
        const bool steady = c + SC_AHEAD < SC_NCHUNK;
        if (steady) SCM_DMA(c + SC_AHEAD);
        if (ib < 2) {
                const LAS unsigned char* fb = buf + (c % SC_NSLOT) * SC_CHUNK_BYTES;
                sc_bf16x8 fr[11]; sc_bf16x8 vf; f32x4 gt[8];
                { const unsigned fa = (unsigned)(uintptr_t)fb + lane * 16, va = fa + (11 + ib) * 1024, ga = (unsigned)(uintptr_t)fb + 13 * 1024 + hi * 128;
#define SC_DSRD(dst, addr, off) asm volatile("ds_read_b128 %0, %1 offset:%2" : "=v"(dst) : "v"(addr), "i"(off))
                  SC_DSRD(fr[0], fa, 0); SC_DSRD(fr[1], fa, 1024); SC_DSRD(fr[2], fa, 2048); SC_DSRD(fr[3], fa, 3072); SC_DSRD(fr[4], fa, 4096); SC_DSRD(fr[5], fa, 5120);
                  SC_DSRD(fr[6], fa, 6144); SC_DSRD(fr[7], fa, 7168); SC_DSRD(fr[8], fa, 8192); SC_DSRD(fr[9], fa, 9216); SC_DSRD(fr[10], fa, 10240); SC_DSRD(vf, va, 0);
                  SC_DSRD(gt[0], ga, 0); SC_DSRD(gt[1], ga, 16); SC_DSRD(gt[2], ga, 32); SC_DSRD(gt[3], ga, 48); SC_DSRD(gt[4], ga, 64); SC_DSRD(gt[5], ga, 80); SC_DSRD(gt[6], ga, 96); SC_DSRD(gt[7], ga, 112);
#undef SC_DSRD
                  asm volatile("s_waitcnt lgkmcnt(0)" : "+v"(fr[0]), "+v"(fr[1]), "+v"(fr[2]), "+v"(fr[3]), "+v"(fr[4]), "+v"(fr[5]), "+v"(fr[6]), "+v"(fr[7]), "+v"(fr[8]), "+v"(fr[9]), "+v"(fr[10]), "+v"(vf) :: "memory");
                  asm volatile("" : "+v"(gt[0]), "+v"(gt[1]), "+v"(gt[2]), "+v"(gt[3]), "+v"(gt[4]), "+v"(gt[5]), "+v"(gt[6]), "+v"(gt[7])); }
                const sc_bf16x8 sb00 = sc_pack8(S0, 0), sb01 = sc_pack8(S0, 8), sb10 = sc_pack8(S1, 0), sb11 = sc_pack8(S1, 8);
                sc_f32x16 P = {}, P2 = {};
                P = __builtin_amdgcn_mfma_f32_32x32x16_bf16(fr[0], sb00, P, 0, 0, 0);
                P2 = __builtin_amdgcn_mfma_f32_32x32x16_bf16(fr[2], sb10, P2, 0, 0, 0);
                P = __builtin_amdgcn_mfma_f32_32x32x16_bf16(fr[1], sb01, P, 0, 0, 0);
                P2 = __builtin_amdgcn_mfma_f32_32x32x16_bf16(fr[3], sb11, P2, 0, 0, 0);
                P = __builtin_amdgcn_mfma_f32_32x32x16_bf16(fr[4], vf, P, 0, 0, 0);
#pragma unroll
                for (int q = 0; q < 4; ++q)
#pragma unroll
                    for (int e = 0; e < 4; ++e) { S0[4 * q + e] *= gt[q][e]; S1[4 * q + e] *= gt[4 + q][e]; }
                S0 = __builtin_amdgcn_mfma_f32_32x32x16_bf16(fr[8], vf, S0, 0, 0, 0);
                S1 = __builtin_amdgcn_mfma_f32_32x32x16_bf16(fr[10], vf, S1, 0, 0, 0);
#pragma unroll
                for (int r = 0; r < 16; ++r) P[r] += P2[r];
                const sc_bf16x8 xb = sc_pack8(P, 0);
                sc_f32x16 U = {};
                U = __builtin_amdgcn_mfma_f32_32x32x16_bf16(fr[5], xb, U, 0, 0, 0);
                const sc_bf16x8 ub = sc_pack8(U, 0);
                S0 = __builtin_amdgcn_mfma_f32_32x32x16_bf16(fr[7], ub, S0, 0, 0, 0);
                S1 = __builtin_amdgcn_mfma_f32_32x32x16_bf16(fr[9], ub, S1, 0, 0, 0);
                P = __builtin_amdgcn_mfma_f32_32x32x16_bf16(fr[6], ub, P, 0, 0, 0);
                float* yb = Yd + (size_t)sc_tau(d, c, 0) * A_W;
#pragma unroll
                for (int r = 0; r < 8; ++r) yb[yoff[r]] = P[8 + r];
        }
        if (steady) asm volatile("s_waitcnt vmcnt(12)" ::: "memory"); else asm volatile("s_waitcnt vmcnt(0)" ::: "memory");
        asm volatile("s_waitcnt lgkmcnt(0)" ::: "memory"); __builtin_amdgcn_s_barrier(); asm volatile("" ::: "memory");
    }
    asm volatile("s_waitcnt vmcnt(0)" ::: "memory"); __syncthreads();
#undef SCM_DMA
}
__device__ __forceinline__ float conv3_u(const float* PX, int tau, unsigned ucol, float w0, float w1, float w2) {
    const float* p = PX + (size_t)tau * PXW;
    float y = p[ucol] * w1;
    if (has_left(tau)) y += (p - PXW)[ucol] * w0;
    if (has_right(tau)) y += (p + PXW)[ucol] * w2;
    return y;
}
constexpr int WLR_K = 448;
constexpr int RP_WAVE_LDS = 16896;
typedef short rp_bf16x8 __attribute__((ext_vector_type(8)));
typedef float rp_f32x16 __attribute__((ext_vector_type(16)));
__device__ __forceinline__ unsigned short f2bf16(float x) { return (unsigned short)(cvt_pk_bf16(x, x) & 0xffffu); }
template <int NKB, class AF>
__device__ __forceinline__ void rp_lowrank(float (&dst)[16], const AF& afrag, const bf16_t* WLRh, int kw0, int n, int hi) {
    rp_f32x16 c0 = {}, c1 = {}; const bf16_t* wb0 = WLRh + (size_t)n * WLR_K + kw0 + 8 * hi; const bf16_t* wb1 = wb0 + (size_t)32 * WLR_K;
#pragma unroll
    for (int kb = 0; kb < NKB; ++kb) { const rp_bf16x8 b0 = *(const rp_bf16x8*)(wb0 + 16 * kb), b1 = *(const rp_bf16x8*)(wb1 + 16 * kb); const rp_bf16x8 a_ = afrag(kb);
        c0 = __builtin_amdgcn_mfma_f32_32x32x16_bf16(a_, b0, c0, 0, 0, 0); c1 = __builtin_amdgcn_mfma_f32_32x32x16_bf16(a_, b1, c1, 0, 0, 0); }
#pragma unroll
    for (int r = 0; r < 8; ++r) { auto sw = __builtin_amdgcn_permlane32_swap(__float_as_uint(c0[r]), __float_as_uint(c1[r]), false, false);
        dst[(r & 3) + 8 * (r >> 2)] = __uint_as_float(sw[0]); dst[(r & 3) + 8 * (r >> 2) + 4] = __uint_as_float(sw[1]); }
}
struct RpAfLds { const LAS bf16_t* base; __device__ __forceinline__ rp_bf16x8 operator()(int kb) const { return *(const LAS rp_bf16x8*)(base + 16 * kb); } };
__device__ __forceinline__ void rwkv_elem_phase(const Frame& F, unsigned char* ws, int l) {
    const float* PX = (const float*)(ws + WS_PX); float* SS = (float*)(ws + WS_SS); float* SD = (float*)(ws + WS_SD); float* GB = (float*)(ws + WS_G);
    const bf16_t* WLR = (const bf16_t*)(ws + WS_WLR) + (size_t)l * A_W * WLR_K;
    const float* cw = IN_(16) + (size_t)l * 3 * A_IN;
    LAS bf16_t* ACT = (LAS bf16_t*)(F.lds + F.wave * 10752);
    const int lane = F.lane, n = lane & 31, hi = lane >> 5;
    const int gw = F.bid * 8 + F.wave, NGW = F.G * 8;
    for (int it = gw; it < (T / 16) * 10; it += NGW) {
        const int tg = it / 10, hq = it % 10, tau0 = tg * 16;
        asm volatile("s_waitcnt lgkmcnt(0)" ::: "memory");
        const float* prow0 = PX + (size_t)(tau0 > 0 ? tau0 - 1 : 0) * PXW; const int roff = tau0 > 0 ? 0 : -1;
#define RP_WIN(x, ucol_) do { _Pragma("unroll") for (int i_ = 0; i_ < 18; ++i_) { int ri_ = i_ + roff; ri_ = ri_ < 0 ? 0 : ri_; ri_ = (tau0 - 1 + i_ > T - 1) ? (T - 1 - (tau0 > 0 ? tau0 - 1 : 0)) : ri_; x[i_] = (prow0 + (size_t)ri_ * PXW)[ucol_]; } } while (0)
#define RP_CONV(x, t_, w0_, w1_, w2_) (x[(t_)] * (has_left(tau0 + (t_)) ? (w0_) : 0.f) + x[(t_) + 1] * (w1_) + x[(t_) + 2] * (has_right(tau0 + (t_)) ? (w2_) : 0.f))
#pragma unroll
        for (int i = 0; i < 5; ++i) { const int c = lane + 64 * i, col = 3840 + c; const float c0 = cw[col], c1 = cw[A_IN + col], c2 = cw[2 * A_IN + col];
            float x[18]; RP_WIN(x, (unsigned)(PXA + col));
#pragma unroll
            for (int t = 0; t < 16; ++t) { const float val = RP_CONV(x, t, c0, c1, c2);
                const float act = i == 0 ? 1.0f - 2.0f / (1.0f + __expf(2.0f * val)) : (i == 1 ? val : sigmoidf_(val));
                ACT[t * 328 + c] = f2bf16(act); } }
        asm volatile("s_waitcnt lgkmcnt(0)" ::: "memory");
        const RpAfLds afw{ACT + (n & 15) * 328 + 8 * hi}, afa{ACT + (n & 15) * 328 + 64 + 8 * hi}, afg{ACT + (n & 15) * 328 + 128 + 8 * hi};
#pragma unroll 1
        for (int hh = 0; hh < 2; ++hh) {
            const int h = hq * 2 + hh, col = h * 64 + lane; const bf16_t* WLRh = WLR + (size_t)h * 64 * WLR_K;
            { float lg[16]; rp_lowrank<12>(lg, afg, WLRh, 256, n, hi);
#pragma unroll
              for (int t = 0; t < 16; ++t) GB[(size_t)(tau0 + t) * A_W + col] = lg[t]; }
            const float cr0 = cw[col], cr1 = cw[A_IN + col], cr2 = cw[2 * A_IN + col];
            const float ck0 = cw[A_W + col], ck1 = cw[A_IN + A_W + col], ck2 = cw[2 * A_IN + A_W + col];
            const float cv0 = cw[2 * A_W + col], cv1 = cw[A_IN + 2 * A_W + col], cv2 = cw[2 * A_IN + 2 * A_W + col];
            const float kk_w = IN_(22)[l * A_W + col], ka_w = IN_(23)[l * A_W + col];
            float kkv[16], kv[16];
            { float xr[18], xk[18], xv[18]; const unsigned uc = (unsigned)(PXA + col); RP_WIN(xr, uc); RP_WIN(xk, uc + A_W); RP_WIN(xv, uc + 2 * A_W);
#pragma unroll
              for (int t = 0; t < 16; ++t) { const int tau = tau0 + t;
                  const float r = RP_CONV(xr, t, cr0, cr1, cr2), v = RP_CONV(xv, t, cv0, cv1, cv2); kv[t] = RP_CONV(xk, t, ck0, ck1, ck2);
                  const float kr = kv[t] * kk_w; const float nrm = sqrtf(wave_sum(kr * kr)); kkv[t] = kr / fmaxf(nrm, 1e-12f);
                  float* ss = SS + ((size_t)h * T + tau) * 192 + lane; ss[0] = kkv[t]; ss[64] = r; ss[128] = v; } }
#pragma unroll 1
            for (int d = 0; d < 2; ++d) { const float w0b = IN_(17)[(l * 2 + d) * A_W + col], a0b = IN_(19)[(l * 2 + d) * A_W + col]; float lw[16], la[16];
                rp_lowrank<4>(lw, afw, WLRh, 64 * d, n, hi); rp_lowrank<4>(la, afa, WLRh, 128 + 64 * d, n, hi);
#pragma unroll
                for (int t = 0; t < 16; ++t) { const float z = w0b + lw[t]; const float decay = __expf(-__expf(-(fmaxf(-z, 0.f) + __logf(1.0f + __expf(-fabsf(z)))) - 0.5f)); const float av = sigmoidf_(a0b + la[t]);
                    float* sd = SD + (((size_t)h * 2 + d) * T + tau0 + t) * 192 + lane; sd[0] = decay; sd[64] = kkv[t] * av; sd[128] = kv[t] * (1.0f + (av - 1.0f) * ka_w); } }
        }
    }
}
#undef RP_WIN
#undef RP_CONV
constexpr int SP_WAVE_LDS = 16640;
__device__ __forceinline__ void scan_prep_phase(const Frame& F, unsigned char* ws) {
    const float* SS = (const float*)(ws + WS_SS); const float* SD = (const float*)(ws + WS_SD); unsigned char* FR = ws + WS_FR;
    LAS bf16_t* R1 = (LAS bf16_t*)(F.lds + F.wave * SP_WAVE_LDS); LAS bf16_t* R2 = R1 + 32 * 72; LAS bf16_t* BbT = R2 + 32 * 72; LAS bf16_t* KbT = BbT + 64 * 16; LAS bf16_t* VT = KbT + 64 * 16; LAS float* Lm = (LAS float*)(VT + 64 * 16);
    const int lane = F.lane, n = lane & 31, hi = lane >> 5;
    const int gw = F.bid * 8 + F.wave, NGW = F.G * 8;
    for (int it = gw; it < 2 * NHA * SC_NCHUNK; it += NGW) {
        const int chain = it / SC_NCHUNK, c = it % SC_NCHUNK, h = chain >> 1, d = chain & 1;
        const int tau_first = sc_tau(d, c, 0), dstep = d ? -1 : 1;
        const float* ssb = SS + (size_t)h * T * 192 + lane; const float* sdb = SD + ((size_t)h * 2 + d) * T * 192 + lane;
        float xw[16], xb[16], xk[16], xkk[16], xr[16], xv[16];
#pragma unroll
        for (int s = 0; s < 16; ++s) { const size_t o = (size_t)(tau_first + dstep * s) * 192; xw[s] = sdb[o]; xb[s] = sdb[o + 64]; xk[s] = sdb[o + 128]; xkk[s] = ssb[o]; xr[s] = ssb[o + 64]; xv[s] = ssb[o + 128]; }
        float gC = 1.f;
#pragma unroll
        for (int s = 0; s < 16; ++s) gC *= xw[s];
        float g = 1.f;
#pragma unroll
        for (int s = 0; s < 16; ++s) {
            const float gm1 = g; g *= xw[s]; const float ig = 1.0f / g; const float bh = xb[s] * ig, kh = xk[s] * ig;
            R1[s * 72 + lane] = f2bf16(-xkk[s] * gm1); R1[(16 + s) * 72 + lane] = f2bf16(xr[s] * g);
            R2[s * 72 + lane] = f2bf16(bh); R2[(16 + s) * 72 + lane] = f2bf16(kh);
            BbT[lane * 16 + s] = f2bf16(bh * gC); KbT[lane * 16 + s] = f2bf16(kh * gC); VT[lane * 16 + s] = f2bf16(xv[s]); }
        asm volatile("s_waitcnt lgkmcnt(0)" ::: "memory");
        unsigned char* dst = FR + ((size_t)chain * SC_NCHUNK + c) * SC_CHUNK_BYTES;
        rp_f32x16 C = {};
#pragma unroll
        for (int kb = 0; kb < 4; ++kb) { const rp_bf16x8 a_ = *(const LAS rp_bf16x8*)(R2 + n * 72 + 16 * kb + 8 * hi), b_ = *(const LAS rp_bf16x8*)(R1 + n * 72 + 16 * kb + 8 * hi);
            C = __builtin_amdgcn_mfma_f32_32x32x16_bf16(a_, b_, C, 0, 0, 0); }
        const int tt_ = n & 15; const bool incl = n >= 16;
#pragma unroll
        for (int r = 0; r < 16; ++r) { const int s = ((r & 7) & 3) + 8 * ((r & 7) >> 2) + 4 * hi; if (!(s < tt_ || (incl && s == tt_))) C[r] = 0.f; }
        if (n < 16) {
#pragma unroll
            for (int r = 0; r < 8; ++r) Lm[((r & 3) + 8 * (r >> 2) + 4 * hi) * 20 + n] = C[r]; }
        { u32x4 f4; f4.x = cvt_pk_bf16(C[8], C[9]); f4.y = cvt_pk_bf16(C[10], C[11]); f4.z = cvt_pk_bf16(C[12], C[13]); f4.w = cvt_pk_bf16(C[14], C[15]);
          u32x4 f6; f6.x = cvt_pk_bf16(C[0], C[1]); f6.y = cvt_pk_bf16(C[2], C[3]); f6.z = cvt_pk_bf16(C[4], C[5]); f6.w = cvt_pk_bf16(C[6], C[7]);
          if (n < 16) f6 = (u32x4){0u, 0u, 0u, 0u};
          *(u32x4*)(dst + 4 * 1024 + lane * 16) = f4; *(u32x4*)(dst + 6 * 1024 + lane * 16) = f6; }
        asm volatile("s_waitcnt lgkmcnt(0)" ::: "memory");
        { float Tc[16];
#pragma unroll
          for (int s = 15; s >= 0; --s) { float acc = (s == n) ? 1.f : 0.f;
#pragma unroll
              for (int u = s + 1; u < 16; ++u) acc += Lm[s * 20 + u] * Tc[u];
              Tc[s] = acc; }
          u32x4 f5; f5.x = cvt_pk_bf16(hi ? Tc[4] : Tc[0], hi ? Tc[5] : Tc[1]); f5.y = cvt_pk_bf16(hi ? Tc[6] : Tc[2], hi ? Tc[7] : Tc[3]);
          f5.z = cvt_pk_bf16(hi ? Tc[12] : Tc[8], hi ? Tc[13] : Tc[9]); f5.w = cvt_pk_bf16(hi ? Tc[14] : Tc[10], hi ? Tc[15] : Tc[11]);
          if (n >= 16) f5 = (u32x4){0u, 0u, 0u, 0u};
          *(u32x4*)(dst + 5 * 1024 + lane * 16) = f5; }
#pragma unroll
        for (int f = 0; f < 4; ++f) { const u32x2 p0 = *(const LAS u32x2*)(R1 + n * 72 + 16 * f + 4 * hi), p1 = *(const LAS u32x2*)(R1 + n * 72 + 16 * f + 8 + 4 * hi);
            *(u32x4*)(dst + f * 1024 + lane * 16) = (u32x4){p0.x, p0.y, p1.x, p1.y}; }
#pragma unroll
        for (int jb = 0; jb < 2; ++jb) { const int row = 32 * jb + n;
            const u32x2 b0 = *(const LAS u32x2*)(BbT + row * 16 + 4 * hi), b1 = *(const LAS u32x2*)(BbT + row * 16 + 8 + 4 * hi), k0 = *(const LAS u32x2*)(KbT + row * 16 + 4 * hi), k1 = *(const LAS u32x2*)(KbT + row * 16 + 8 + 4 * hi);
            const u32x2 v0 = *(const LAS u32x2*)(VT + row * 16 + 4 * hi), v1 = *(const LAS u32x2*)(VT + row * 16 + 8 + 4 * hi);
            *(u32x4*)(dst + (7 + 2 * jb) * 1024 + lane * 16) = (u32x4){b0.x, b0.y, b1.x, b1.y}; *(u32x4*)(dst + (8 + 2 * jb) * 1024 + lane * 16) = (u32x4){k0.x, k0.y, k1.x, k1.y};
            *(u32x4*)(dst + (11 + jb) * 1024 + lane * 16) = (u32x4){v0.x, v0.y, v1.x, v1.y}; }
        { const int jj = lane & 31; ((float*)(dst + 13 * 1024))[((jj >> 2) & 1) * 32 + (lane >> 5) * 16 + (jj & 3) + 4 * (jj >> 3)] = gC; }
        asm volatile("s_waitcnt lgkmcnt(0)" ::: "memory");
    }
}
constexpr int RF_ACT_BYTES = 16 * 320 * 2;
__device__ __forceinline__ void rwkv_fused_phase(const Frame& F, unsigned char* ws, int l) {
    const bf16_t* PX = (const bf16_t*)(ws + WS_PX); unsigned char* FR = ws + WS_FR;
    float* GB = (float*)(ws + WS_G); float* VB = (float*)(ws + WS_SS) + (size_t)T * A_W; float* BS = (float*)(ws + WS_SD);
    const bf16_t* WLR = (const bf16_t*)(ws + WS_WLR) + (size_t)l * A_W * WLR_K;
    const float* cw = IN_(16) + (size_t)l * 3 * A_IN;
    LAS bf16_t* ACT = (LAS bf16_t*)F.lds;
    LAS bf16_t* R1 = (LAS bf16_t*)(F.lds + RF_ACT_BYTES + F.wave * SP_WAVE_LDS); LAS bf16_t* R2 = R1 + 32 * 72; LAS bf16_t* BbT = R2 + 32 * 72; LAS bf16_t* KbT = BbT + 64 * 16; LAS bf16_t* VT = KbT + 64 * 16; LAS float* Lm = (LAS float*)(VT + 64 * 16);
    const int lane = F.lane, n = lane & 31, hi = lane >> 5, hh = F.wave >> 1, d = F.wave & 1;
    for (int it = F.bid; it < (T / 16) * 5; it += F.G) {
        const int tg = it / 5, hg = it % 5, tau0 = tg * 16, h = hg * 4 + hh, col = h * 64 + lane;
        __syncthreads();
        { int tq = F.tid; asm volatile("" : "+v"(tq));
#pragma unroll
          for (int i = 0; i < 3; ++i) { const int item = tq + 512 * i;
              if (item < 16 * 80) { const int t = item / 80, c = 4 * (item % 80), cc = 3840 + c, tau = tau0 + t;
                  const bf16_t* p = PX + (size_t)tau * PXW + PXA + cc; const bool hl = has_left(tau), hr = has_right(tau);
                  const f32x4 x1 = bf4f(*(const u32x2*)p), x0 = bf4f(*(const u32x2*)(p - (hl ? PXW : 0))), x2 = bf4f(*(const u32x2*)(p + (hr ? PXW : 0)));
                  const f32x4 w0 = *(const f32x4*)(cw + cc), w1 = *(const f32x4*)(cw + A_IN + cc), w2 = *(const f32x4*)(cw + 2 * A_IN + cc);
                  const f32x4 val = x1 * w1 + x0 * (w0 * (hl ? 1.f : 0.f)) + x2 * (w2 * (hr ? 1.f : 0.f));
                  f32x4 act;
#pragma unroll
                  for (int e = 0; e < 4; ++e) act[e] = c < 64 ? 1.0f - 2.0f / (1.0f + __expf(2.0f * val[e])) : (c < 128 ? val[e] : sigmoidf_(val[e]));
                  u32x2 o; o.x = cvt_pk_bf16(act.x, act.y); o.y = cvt_pk_bf16(act.z, act.w);
                  *(LAS u32x2*)(ACT + t * 320 + c) = o; } } }
        __syncthreads();
        const bf16_t* prow0 = PX + (size_t)(tau0 > 0 ? tau0 - 1 : 0) * PXW; const int roff = tau0 > 0 ? 0 : -1;
#define RP_WIN(x, ucol_) do { _Pragma("unroll") for (int i_ = 0; i_ < 18; ++i_) { int ri_ = i_ + roff; ri_ = ri_ < 0 ? 0 : ri_; ri_ = (tau0 - 1 + i_ > T - 1) ? (T - 1 - (tau0 > 0 ? tau0 - 1 : 0)) : ri_; x[i_] = bf2f((prow0 + (size_t)ri_ * PXW)[ucol_]); } } while (0)
#define RP_CONV(x, t_, w0_, w1_, w2_) (x[(t_)] * (has_left(tau0 + (t_)) ? (w0_) : 0.f) + x[(t_) + 1] * (w1_) + x[(t_) + 2] * (has_right(tau0 + (t_)) ? (w2_) : 0.f))
        const bf16_t* WLRh = WLR + (size_t)h * 64 * WLR_K;
        const RpAfLds afw{ACT + (n & 15) * 320 + 8 * hi}, afa{ACT + (n & 15) * 320 + 64 + 8 * hi}, afg{ACT + (n & 15) * 320 + 128 + 8 * hi};
        float xw[16], xb[16], xk[16], xkk[16], xr[16], xv[16];
        { float wr_[18], wk_[18], wv_[18]; const unsigned uc = (unsigned)(PXA + col); RP_WIN(wr_, uc); RP_WIN(wk_, uc + A_W); RP_WIN(wv_, uc + 2 * A_W);
          if (d == 0) { float lg[16]; rp_lowrank<12>(lg, afg, WLRh, 256, n, hi);
#pragma unroll
              for (int t = 0; t < 16; ++t) GB[(size_t)(tau0 + t) * A_W + col] = lg[t]; }
          const float cr0 = cw[col], cr1 = cw[A_IN + col], cr2 = cw[2 * A_IN + col], ck0 = cw[A_W + col], ck1 = cw[A_IN + A_W + col], ck2 = cw[2 * A_IN + A_W + col];
          const float cv0 = cw[2 * A_W + col], cv1 = cw[A_IN + 2 * A_W + col], cv2 = cw[2 * A_IN + 2 * A_W + col], kk_w = IN_(22)[l * A_W + col];
#pragma unroll
          for (int t = 0; t < 16; ++t) { xr[t] = RP_CONV(wr_, t, cr0, cr1, cr2); xv[t] = RP_CONV(wv_, t, cv0, cv1, cv2); xk[t] = RP_CONV(wk_, t, ck0, ck1, ck2);
              const float kr = xk[t] * kk_w; const float nrm = sqrtf(wave_sum(kr * kr)); xkk[t] = kr / fmaxf(nrm, 1e-12f); } }
        if (d == 0) {
#pragma unroll
            for (int t = 0; t < 16; ++t) VB[(size_t)(tau0 + t) * A_W + col] = xv[t]; }
        { const float ka_w = IN_(23)[l * A_W + col], w0b = IN_(17)[(l * 2 + d) * A_W + col], a0b = IN_(19)[(l * 2 + d) * A_W + col]; float la[16];
          rp_lowrank<4>(xw, afw, WLRh, 64 * d, n, hi); rp_lowrank<4>(la, afa, WLRh, 128 + 64 * d, n, hi);
#pragma unroll
          for (int t = 0; t < 16; ++t) { const float z = w0b + xw[t]; xw[t] = __expf(-__expf(-(fmaxf(-z, 0.f) + __logf(1.0f + __expf(-fabsf(z)))) - 0.5f)); const float av = sigmoidf_(a0b + la[t]);
              xb[t] = xkk[t] * av; xk[t] = xk[t] * (1.0f + (av - 1.0f) * ka_w); }
          { const float rk_w = IN_(24)[l * A_W + col]; float pr[16];
#pragma unroll
            for (int t = 0; t < 16; ++t) pr[t] = xr[t] * xk[t] * rk_w;
            const float sb = wave_sum16(pr, lane);
            if ((lane & 3) == 0) BS[((size_t)d * T + tau0 + (lane >> 2)) * NHA + h] = sb; } }
        if (d) {
#pragma unroll
            for (int s = 0; s < 8; ++s) { float t_;
                t_ = xw[s]; xw[s] = xw[15 - s]; xw[15 - s] = t_; t_ = xb[s]; xb[s] = xb[15 - s]; xb[15 - s] = t_; t_ = xk[s]; xk[s] = xk[15 - s]; xk[15 - s] = t_;
                t_ = xkk[s]; xkk[s] = xkk[15 - s]; xkk[15 - s] = t_; t_ = xr[s]; xr[s] = xr[15 - s]; xr[15 - s] = t_; t_ = xv[s]; xv[s] = xv[15 - s]; xv[15 - s] = t_; } }
        const int c = d == 0 ? tg : (tg < NCTX / 16 ? NCTX / 16 - 1 - tg : NCTX / 16 + (T / 16 - 1) - tg);
        float gC = 1.f;
#pragma unroll
        for (int s = 0; s < 16; ++s) gC *= xw[s];
        float g = 1.f;
#pragma unroll
        for (int s = 0; s < 16; ++s) {
            const float gm1 = g; g *= xw[s]; const float ig = 1.0f / g; const float bh = xb[s] * ig, kh = xk[s] * ig;
            R1[s * 72 + lane] = f2bf16(-xkk[s] * gm1); R1[(16 + s) * 72 + lane] = f2bf16(xr[s] * g);
            R2[s * 72 + lane] = f2bf16(bh); R2[(16 + s) * 72 + lane] = f2bf16(kh);
            xb[s] = bh * gC; xk[s] = kh * gC; }
        asm volatile("s_waitcnt lgkmcnt(0)" ::: "memory");
        unsigned char* dst = FR + ((size_t)(h * 2 + d) * SC_NCHUNK + c) * SC_CHUNK_BYTES;
        rp_f32x16 C = {};
#pragma unroll
        for (int kb = 0; kb < 4; ++kb) { const rp_bf16x8 a_ = *(const LAS rp_bf16x8*)(R2 + n * 72 + 16 * kb + 8 * hi), b_ = *(const LAS rp_bf16x8*)(R1 + n * 72 + 16 * kb + 8 * hi);
            C = __builtin_amdgcn_mfma_f32_32x32x16_bf16(a_, b_, C, 0, 0, 0); }
        const int tt_ = n & 15; const bool incl = n >= 16;
#pragma unroll
        for (int r = 0; r < 16; ++r) { const int s = ((r & 7) & 3) + 8 * ((r & 7) >> 2) + 4 * hi; if (!(s < tt_ || (incl && s == tt_))) C[r] = 0.f; }
        if (n < 16) {
#pragma unroll
            for (int r = 0; r < 8; ++r) Lm[((r & 3) + 8 * (r >> 2) + 4 * hi) * 20 + n] = C[r]; }
        { u32x4 f4; f4.x = cvt_pk_bf16(C[8], C[9]); f4.y = cvt_pk_bf16(C[10], C[11]); f4.z = cvt_pk_bf16(C[12], C[13]); f4.w = cvt_pk_bf16(C[14], C[15]);
          u32x4 f6; f6.x = cvt_pk_bf16(C[0], C[1]); f6.y = cvt_pk_bf16(C[2], C[3]); f6.z = cvt_pk_bf16(C[4], C[5]); f6.w = cvt_pk_bf16(C[6], C[7]);
          if (n < 16) f6 = (u32x4){0u, 0u, 0u, 0u};
          *(u32x4*)(dst + 4 * 1024 + lane * 16) = f4; *(u32x4*)(dst + 6 * 1024 + lane * 16) = f6; }
        asm volatile("s_waitcnt lgkmcnt(0)" ::: "memory");
        { float Tc[16];
#pragma unroll
          for (int s = 15; s >= 0; --s) { float acc = (s == n) ? 1.f : 0.f;
#pragma unroll
              for (int u = s + 1; u < 16; ++u) acc += Lm[s * 20 + u] * Tc[u];
              Tc[s] = acc; }
          u32x4 f5; f5.x = cvt_pk_bf16(hi ? Tc[4] : Tc[0], hi ? Tc[5] : Tc[1]); f5.y = cvt_pk_bf16(hi ? Tc[6] : Tc[2], hi ? Tc[7] : Tc[3]);
          f5.z = cvt_pk_bf16(hi ? Tc[12] : Tc[8], hi ? Tc[13] : Tc[9]); f5.w = cvt_pk_bf16(hi ? Tc[14] : Tc[10], hi ? Tc[15] : Tc[11]);
          if (n >= 16) f5 = (u32x4){0u, 0u, 0u, 0u};
          *(u32x4*)(dst + 5 * 1024 + lane * 16) = f5; }
#pragma unroll
        for (int f = 0; f < 4; ++f) { const u32x2 p0 = *(const LAS u32x2*)(R1 + n * 72 + 16 * f + 4 * hi), p1 = *(const LAS u32x2*)(R1 + n * 72 + 16 * f + 8 + 4 * hi);
            *(u32x4*)(dst + f * 1024 + lane * 16) = (u32x4){p0.x, p0.y, p1.x, p1.y}; }
#define RF_FRAG(x_, fa_, fb_) do { unsigned pk_[8]; _Pragma("unroll") for (int m_ = 0; m_ < 8; ++m_) pk_[m_] = cvt_pk_bf16(x_[2 * m_], x_[2 * m_ + 1]); \
            const bool h1_ = hi != 0; const u32x4 own_ = {h1_ ? pk_[2] : pk_[0], h1_ ? pk_[3] : pk_[1], h1_ ? pk_[6] : pk_[4], h1_ ? pk_[7] : pk_[5]}; \
            u32x4 rcv_ = {h1_ ? pk_[0] : pk_[2], h1_ ? pk_[1] : pk_[3], h1_ ? pk_[4] : pk_[6], h1_ ? pk_[5] : pk_[7]}; \
            rcv_.x = __shfl_xor(rcv_.x, 32); rcv_.y = __shfl_xor(rcv_.y, 32); rcv_.z = __shfl_xor(rcv_.z, 32); rcv_.w = __shfl_xor(rcv_.w, 32); \
            *(u32x4*)(dst + (fa_) * 1024 + lane * 16) = h1_ ? rcv_ : own_; *(u32x4*)(dst + (fb_) * 1024 + lane * 16) = h1_ ? own_ : rcv_; } while (0)
        RF_FRAG(xb, 7, 9); RF_FRAG(xk, 8, 10); RF_FRAG(xv, 11, 12);
#undef RF_FRAG
        { const int jj = lane & 31; ((float*)(dst + 13 * 1024))[((jj >> 2) & 1) * 32 + (lane >> 5) * 16 + (jj & 3) + 4 * (jj >> 3)] = gC; }
        asm volatile("s_waitcnt lgkmcnt(0)" ::: "memory");
    }
#undef RP_WIN
#undef RP_CONV
}
__device__ __forceinline__ void mixer_phase(const Frame& F0, unsigned char* ws0, int lq, bool need_ctx, char* lds_g) {
    const int l = lq & 3;
#ifndef MK_MIX
#define MK_MIX 15
#endif
    { const Frame F = opq(F0); unsigned char* ws = opq_ptr(ws0);
      if (MK_MIX & 1) for (int chain = F.bid; chain < 2 * NHA; chain += F.G) scan_chain_mfma(F, ws, chain); }
    const Frame& F = F0;
    const int n_xa = 32 * NHC, n_ca = need_ctx ? NHC : 0, n_att = n_xa + n_ca, n_hy = 640, n_ch = need_ctx ? 160 : 0;
    unsigned* qatt = (unsigned*)(ws0 + WS_CTL) + CW_QUEUE + 64 * lq; unsigned* qhy = qatt + 32;
    int item;
#define MIX_POP(q) do { if (F.tid == 0) F.MISC[16] = __hip_atomic_fetch_add((q), 1u, __ATOMIC_RELAXED, __HIP_MEMORY_SCOPE_AGENT); __syncthreads(); item = (int)F.MISC[16]; __syncthreads(); } while (0)
    if (F.bid >= 2 * NHA) {
        MIX_POP(qatt);
        while (item < n_att) {
            if (MK_MIX & 2) { unsigned char* ws = opq_ptr(ws0);
                const bf16_t* QF = (const bf16_t*)(ws + WS_QF); const bf16_t* KF = (const bf16_t*)(ws + WS_KF); const bf16_t* KVRAW = (const bf16_t*)(ws + WS_KVRAW); bf16_t* OB = (bf16_t*)(ws + WS_OBUF);
                const bool is_xa = item < n_xa; const int h = is_xa ? item % NHC : item - n_xa, row0 = is_xa ? NCTX + (item / NHC) * 256 : 0;
                for (int rp = 0; rp < REP(13); ++rp) att::attn_body(QF + (size_t)row0 * NQ + h * 192, KF + h * 192, KVRAW + h * 256 + 128, OB + (size_t)row0 * DM + 2560 + h * 128, is_xa ? T : NCTX, lds_g); }
            MIX_POP(qatt);
        }
    }
    MIX_POP(qhy);
    while (item < n_hy + n_ch) {
        const Frame Fu = opq(F0); unsigned char* ws = opq_ptr(ws0);
        if ((MK_MIX & 4) && item < n_hy) hyena_unit(Fu, ws, l, item);
        else if ((MK_MIX & 8) && item >= n_hy) hyena_ctx_unit(Fu, ws, l, item - n_hy);
        MIX_POP(qhy);
    }
#undef MIX_POP
}

__device__ __forceinline__ void hyena_taps_tail(const Frame& F0, unsigned char* ws0, int lt, int first, int end) {
    if (F0.bid < 48) return;
#pragma unroll 1
    for (int p = first + F0.bid - 48; p < end; p += 208) hyena_taps_unit(opq(F0), opq_ptr(ws0), lt, p);
}
constexpr int NPH = 2 + 14 * NL;
__global__ void __launch_bounds__(512, 2) mk_fwd(Args a) {
    extern __shared__ __attribute__((aligned(16))) unsigned char lds[];
    Frame F; F.lds = (LAS unsigned char*)lds; F.MISC = (volatile LAS unsigned*)(F.lds + LDS_MISC);
    F.tid = threadIdx.x; F.lane = F.tid & 63; F.wave = __builtin_amdgcn_readfirstlane(F.tid >> 6); F.bid = blockIdx.x; F.G = gridDim.x;
    if (F.tid < 64) F.MISC[F.tid] = 0u;
    if (F.tid < 46) *(LAS unsigned long long*)(F.lds + LDS_PTAB + 8 * F.tid) = (unsigned long long)(uintptr_t)a.in[F.tid];
    __syncthreads();
    unsigned char* ws = a.ws;
    const int lo = a.ph_lo, hi = a.ph_hi;
    XcdBarrier bar = xcd_barrier_post((unsigned*)(ws + WS_CTL) + CW_BAR, F.MISC + 8);
#ifndef MK_MASK
#define MK_MASK 0xffff
#endif
#define EN(x) (((MK_MASK) >> (x)) & 1)
#define IN(k) (lo <= (k) && (k) < hi)
#define SEAM(k) do { if (IN(k) && IN((k) + 1)) xcd_barrier(bar); } while (0)
#define WSP opq_ptr(ws)
#define P_XS(w) ((float*)((w) + WS_XS))
#define P_ABUF(w) ((bf16_t*)((w) + WS_ABUF))
#define P_HBUF(w) ((bf16_t*)((w) + WS_HBUF))
#define P_OBUF(w) ((bf16_t*)((w) + WS_OBUF))
#define P_MODX(w, l) ((const float*)((w) + WS_MOD) + ((size_t)(l) * 2 + 0) * NMOD)
#define P_MODC(w, l) ((const float*)((w) + WS_MOD) + ((size_t)(l) * 2 + 1) * NMOD)
#define P_WL(w, l) ((const bf16_t*)((w) + WS_WB) + (size_t)(l) * W_LAYER)
    if (EN(0) && IN(0)) for (int rp = 0; rp < REP(0); ++rp) phase0(opq(F), opq_ptr(ws));
    SEAM(0);
    if (EN(1) && IN(1)) phase_mod(opq(F), opq_ptr(ws));
    SEAM(1);
#pragma clang loop unroll(full)
    for (int l = 0; l < NL; ++l) {
        const int pb = 2 + 14 * l; const bool need_ctx = l < NL - 1;
        if (EN(2) && IN(pb + 0)) for (int rp = 0; rp < REP(2); ++rp) { unsigned char* w = WSP; norm_phase(opq(F), P_XS(w), IN_(7) + l * DM, P_MODX(w, l), P_MODC(w, l), 0, 1, P_ABUF(w), l > 0 ? (const bf16_t*)(w + WS_SLAB) : nullptr, l > 0 ? P_MODC(w, l - 1) + 8 * DM : nullptr, 0.5f); }
        SEAM(pb + 0);
        if (EN(3) && IN(pb + 1)) { unsigned char* w = WSP; pg8::Gemm g{P_ABUF(w), P_WL(w, l) + W_G1, T, 2 * FF, DM, DM}; pg8::StaticOrder S; S.init(T, 2 * FF, F.G, F.bid); pg8::EpiSwiGLU E{P_HBUF(w), FF};
            pg8::gemm_phase<pg8::EpiSwiGLU, pg8::StaticOrder>(F.lds, g, S, E, nullptr);
            hyena_taps_tail(F, ws, l, 0, l == 0 ? 640 : 416); }
        SEAM(pb + 1);
        if (EN(4) && IN(pb + 2)) {
            { unsigned char* w = WSP; pg8::Gemm g{P_HBUF(w), P_WL(w, l) + W_D1, T, DM, FF, FF}; pg8::StaticOrderX S; S.init(T, DM, F.G, F.bid); pg8::EpiResid E{P_XS(w), P_MODX(w, l) + 2 * DM, P_MODC(w, l) + 2 * DM, 0.5f, nullptr};
              pg8::gemm_phase<pg8::EpiResid, pg8::StaticOrderX>(F.lds, g, S, E, nullptr); }
            if (true) { __syncthreads();
              if (F.bid < 256) { unsigned char* w = WSP; const int ks = F.bid >> 4, ksz = FF / 16; pg8::Gemm g{P_HBUF(w) + ks * ksz, P_WL(w, l) + W_D1 + ks * ksz, NCTX, DM, ksz, FF}; pg8::OneUnit S{F.bid & 15};
                  pg8::EpiBf16<0> E{(bf16_t*)(w + WS_SLAB) + (size_t)ks * NCTX * DM, DM, nullptr, 0, 0};
                  pg8::gemm_phase<pg8::EpiBf16<0>, pg8::OneUnit>(F.lds, g, S, E, nullptr); } }
        }
        SEAM(pb + 2);
        if (EN(5) && IN(pb + 3)) for (int rp = 0; rp < REP(2); ++rp) { unsigned char* w = WSP; norm_phase(opq(F), P_XS(w), IN_(8) + l * DM, P_MODX(w, l), P_MODC(w, l), 3, 4, P_ABUF(w), (const bf16_t*)(w + WS_SLAB), P_MODC(w, l) + 2 * DM, 0.5f); }
        SEAM(pb + 3);
        if (EN(6) && IN(pb + 4)) { unsigned char* w = WSP; pg8::Gemm g{P_ABUF(w), P_WL(w, l) + W_IN, T, PXW, DM, DM}; pg8::StaticOrder S; S.init(T, PXW, F.G, F.bid); pg8::EpiBf16<0> E{(bf16_t*)(w + WS_PX), PXW, nullptr, 0, 0};
            pg8::gemm_phase<pg8::EpiBf16<0>, pg8::StaticOrder>(F.lds, g, S, E, nullptr); }
        SEAM(pb + 4);
        if (EN(7) && IN(pb + 5)) { for (int rp = 0; rp < REP(7); ++rp) rwkv_fused_phase(opq(F), opq_ptr(ws), l); if (!(MK_ONLYRP)) { for (int rp = 0; rp < REP(8); ++rp) mla_prep_phase(opq(F), opq_ptr(ws), l); hyena_prep_phase(opq(F), opq_ptr(ws), l); } }
        SEAM(pb + 5);
        if (EN(8) && IN(pb + 6)) {
            { unsigned char* w = WSP; pg8::Gemm g{(const bf16_t*)(w + WS_QA), P_WL(w, l) + W_Q, T, NQ, 1024, 1024}; pg8::StaticOrder S; S.init(T, NQ, F.G, F.bid); pg8::EpiBf16<0> E{(bf16_t*)(w + WS_QRAW), NQ, nullptr, 0, 0};
              pg8::gemm_phase<pg8::EpiBf16<0>, pg8::StaticOrder>(F.lds, g, S, E, nullptr); }
            __syncthreads();
            { unsigned char* w = WSP; pg8::Gemm g{(const bf16_t*)(w + WS_KVA), P_WL(w, l) + W_KV, T, NKV, 512, 512}; pg8::StaticOrder S; S.init(T, NKV, F.G, F.bid); pg8::EpiBf16<0> E{(bf16_t*)(w + WS_KVRAW), NKV, nullptr, 0, 0};
              pg8::gemm_phase<pg8::EpiBf16<0>, pg8::StaticOrder>(F.lds, g, S, E, nullptr); }
        }
        SEAM(pb + 6);
        if (EN(9) && IN(pb + 7)) { for (int rp = 0; rp < REP(8); ++rp) qkv_final_phase(opq(F), opq_ptr(ws), l, need_ctx); }
        SEAM(pb + 7);
        if (EN(10) && IN(pb + 8)) for (int rp = 0; rp < REP(10); ++rp) mixer_phase(F, ws, l + 4 * rp, need_ctx, (char*)lds);
        SEAM(pb + 8);
        if (EN(11) && IN(pb + 9)) { for (int rp = 0; rp < REP(8); ++rp) rwkv_out_phase(opq(F), opq_ptr(ws), l, need_ctx); hyena_out_phase(opq(F), opq_ptr(ws), need_ctx); }
        SEAM(pb + 9);
        if (EN(12) && IN(pb + 10)) {
            { unsigned char* w = WSP; pg8::Gemm g{P_OBUF(w), P_WL(w, l) + W_OUT, T, DM, DM, DM}; pg8::StaticOrderX S; S.init(T, DM, F.G, F.bid); pg8::EpiResid E{P_XS(w), P_MODX(w, l) + 5 * DM, P_MODC(w, l) + 5 * DM, 1.0f, nullptr};
              pg8::gemm_phase<pg8::EpiResid, pg8::StaticOrderX>(F.lds, g, S, E, nullptr); }
            if (need_ctx) { __syncthreads();
              if (F.bid < 256) { unsigned char* w = WSP; const int ks = F.bid >> 4, ksz = DM / 16; pg8::Gemm g{P_OBUF(w) + ks * ksz, P_WL(w, l) + W_OUT + ks * ksz, NCTX, DM, ksz, DM}; pg8::OneUnit S{F.bid & 15};
                  pg8::EpiBf16<0> E{(bf16_t*)(w + WS_SLAB) + (size_t)ks * NCTX * DM, DM, nullptr, 0, 0};
                  pg8::gemm_phase<pg8::EpiBf16<0>, pg8::OneUnit>(F.lds, g, S, E, nullptr); } }
        }
        SEAM(pb + 10);
        if (EN(13) && IN(pb + 11)) for (int rp = 0; rp < REP(2); ++rp) { unsigned char* w = WSP; norm_phase(opq(F), P_XS(w), IN_(9) + l * DM, P_MODX(w, l), P_MODC(w, l), 6, 7, P_ABUF(w), need_ctx ? (const bf16_t*)(w + WS_SLAB) : nullptr, P_MODC(w, l) + 5 * DM, 1.0f); }
        SEAM(pb + 11);
        if (EN(14) && IN(pb + 12)) { if (need_ctx) { unsigned char* w = WSP; pg8::Gemm g{P_ABUF(w), P_WL(w, l) + W_G2, T, 2 * FF, DM, DM}; pg8::StaticOrder S; S.init(T, 2 * FF, F.G, F.bid); pg8::EpiSwiGLU E{P_HBUF(w), FF};
            pg8::gemm_phase<pg8::EpiSwiGLU, pg8::StaticOrder>(F.lds, g, S, E, nullptr);
            hyena_taps_tail(F, ws, l + 1, 416, 640); }       else { unsigned char* w = WSP; pg8::Gemm g{P_ABUF(w), P_WL(w, l) + W_G2, T, 2 * FF, DM, DM}; pg8::StaticOrderX S; S.init(T, 2 * FF, F.G, F.bid); pg8::EpiSwiGLU E{P_HBUF(w), FF};
            pg8::gemm_phase<pg8::EpiSwiGLU, pg8::StaticOrderX>(F.lds, g, S, E, nullptr); } }
        SEAM(pb + 12);
        if (EN(15) && IN(pb + 13)) {
            { unsigned char* w = WSP; pg8::Gemm g{P_HBUF(w), P_WL(w, l) + W_D2, T, DM, FF, FF}; pg8::StaticOrderX S; S.init(T, DM, F.G, F.bid); pg8::EpiResid E{P_XS(w), P_MODX(w, l) + 8 * DM, P_MODC(w, l) + 8 * DM, 0.5f, l == NL - 1 ? a.out : nullptr};
              pg8::gemm_phase<pg8::EpiResid, pg8::StaticOrderX>(F.lds, g, S, E, nullptr); }
            if (need_ctx) { __syncthreads();
              if (F.bid < 256) { unsigned char* w = WSP; const int ks = F.bid >> 4, ksz = FF / 16; pg8::Gemm g{P_HBUF(w) + ks * ksz, P_WL(w, l) + W_D2 + ks * ksz, NCTX, DM, ksz, FF}; pg8::OneUnit S{F.bid & 15};
                  pg8::EpiBf16<0> E{(bf16_t*)(w + WS_SLAB) + (size_t)ks * NCTX * DM, DM, nullptr, 0, 0};
                  pg8::gemm_phase<pg8::EpiBf16<0>, pg8::OneUnit>(F.lds, g, S, E, nullptr); } }
        }
        SEAM(pb + 13);
    }
#undef IN
#undef SEAM
}

#ifndef MK_LAUNCHES
#define MK_LAUNCHES 1
#endif
extern "C" void kernel_launch(void* const* d_in, const int* in_sizes, int n_in, void* d_out, int out_size, void* d_ws, size_t ws_size, hipStream_t stream) {
    static int grid = 0;
    if (grid == 0) {
        if (n_in != 46 || in_sizes[0] != SEQ * DM || out_size != SEQ * DM || ws_size < WS_END) {
            fprintf(stderr, "kernel_launch: shape mismatch: n_in %d in0 %d out %d ws %zu (need %zu); nothing launched\n", n_in, n_in > 0 ? in_sizes[0] : -1, out_size, ws_size, (size_t)WS_END); grid = -1; return; }
        int dev = 0, cus = 0, per_cu = 0;
        if (hipGetDevice(&dev) != hipSuccess || hipDeviceGetAttribute(&cus, hipDeviceAttributeMultiprocessorCount, dev) != hipSuccess) { fprintf(stderr, "kernel_launch: device query failed\n"); grid = -1; return; }
        if (hipFuncSetAttribute((const void*)mk_fwd, hipFuncAttributeMaxDynamicSharedMemorySize, LDS_BYTES) != hipSuccess) { fprintf(stderr, "kernel_launch: hipFuncSetAttribute failed\n"); grid = -1; return; }
        if (hipOccupancyMaxActiveBlocksPerMultiprocessor(&per_cu, (const void*)mk_fwd, 512, LDS_BYTES) != hipSuccess || per_cu < 1) fprintf(stderr, "kernel_launch: note: occupancy query reports %d blocks per CU\n", per_cu);
        (void)hipGetLastError();
        grid = cus;
        if (cus != 256) { fprintf(stderr, "kernel_launch: built for 256 CUs (split-K of the context panel, hyena scratch), found %d; nothing launched\n", cus); grid = -1; return; }
    }
    if (grid < 0) return;
    if (hipMemsetAsync((char*)d_ws + WS_CTL, 0, CTL_BYTES, stream) != hipSuccess) { fprintf(stderr, "kernel_launch: memset failed\n"); return; }
    Args a{};
    for (int i = 0; i < 46; ++i) a.in[i] = (const float*)d_in[i];
    a.out = (float*)d_out; a.ws = (unsigned char*)d_ws;
    a.ph_lo = 0; a.ph_hi = NPH;
    hipLaunchKernelGGL(mk_fwd, dim3(grid), dim3(512), LDS_BYTES, stream, a);
    const hipError_t le = hipPeekAtLastError();
    if (le != hipSuccess) fprintf(stderr, "kernel_launch: launch failed: %s\n", hipGetErrorName(le));
}
```

```cpp
#include <hip/hip_runtime.h>
#include <stdint.h>
#include <cstdio>

#define LAS __attribute__((address_space(3)))
#define CAS __attribute__((address_space(4)))
typedef unsigned short bf16_t;
typedef float f32x4 __attribute__((ext_vector_type(4)));
typedef float f32x2 __attribute__((ext_vector_type(2)));
typedef unsigned u32x4 __attribute__((ext_vector_type(4)));
typedef unsigned u32x2 __attribute__((ext_vector_type(2)));

constexpr int T = 8448, NCTX = 256, SEQ = 8192, DM = 4096, FF = 6144, NL = 4;
constexpr int A_W = 1280, A_IN = 4160, B_IN = 3840, C_IN = 1600, NHA = 20;
constexpr int PXW = 9728, PXA = 0, PXB = 4160, PXC = 8000;
constexpr int NQ = 2304, NKV = 3072, NHC = 12;
constexpr int NMOD = 9 * DM;
constexpr float NORM_EPS = 1e-6f, GN_EPS = 64e-5f;

constexpr size_t MiB = 1u << 20;
constexpr size_t al(size_t x) { return (x + MiB - 1) / MiB * MiB; }
constexpr size_t WS_CTL = 0, CTL_BYTES = MiB;
constexpr size_t WS_XS = WS_CTL + CTL_BYTES;
constexpr size_t WS_ABUF = WS_XS + al((size_t)T * DM * 4);
constexpr size_t WS_HBUF = WS_ABUF + al((size_t)T * DM * 2);
constexpr size_t WS_OBUF = WS_HBUF + al((size_t)T * FF * 2);
constexpr size_t WS_PX = WS_OBUF + al((size_t)T * DM * 2);
constexpr size_t WS_MOD = WS_PX + al((size_t)T * PXW * 4);
constexpr size_t WS_HP = WS_MOD + al((size_t)NL * 2 * NMOD * 4);
constexpr size_t WS_SS = WS_HP + MiB;
constexpr size_t WS_SD = WS_SS + al((size_t)NHA * T * 192 * 4);
constexpr size_t WS_WLR = WS_SD + al((size_t)NHA * 2 * T * 192 * 4);
constexpr size_t WS_G = WS_WLR + al((size_t)NL * A_W * 448 * 2);
constexpr size_t WS_Y = WS_G + al((size_t)T * A_W * 4);
constexpr size_t WS_QA = WS_Y + al((size_t)2 * T * A_W * 4);
constexpr size_t WS_KVA = WS_QA + al((size_t)T * 1024 * 2);
constexpr size_t WS_KPE = WS_KVA + al((size_t)T * 512 * 2);
constexpr size_t WS_QRAW = WS_KPE + al((size_t)T * 64 * 2);
constexpr size_t WS_KVRAW = WS_QRAW + al((size_t)T * NQ * 2);
constexpr size_t WS_QF = WS_KVRAW + al((size_t)T * NKV * 2);
constexpr size_t WS_KF = WS_QF + al((size_t)T * NQ * 2);
constexpr size_t WS_H3 = WS_KF + al((size_t)T * NQ * 2);
constexpr size_t WS_HSCR = WS_H3 + al((size_t)NL * T * 64 * 4);
constexpr size_t WS_FR = WS_HSCR + al((size_t)640 * 16384 * 8 + 640 * 8);
constexpr size_t WS_GT = WS_FR + al((size_t)40 * 528 * (14 * 1024));
constexpr size_t WS_X0T = WS_GT + al((size_t)1280 * T * 4);
constexpr size_t WS_SLAB = WS_FR;
constexpr size_t WS_WB = WS_X0T + al((size_t)1280 * T * 4);
constexpr size_t W_G1 = 0, W_D1 = W_G1 + (size_t)2 * FF * DM, W_IN = W_D1 + (size_t)DM * FF, W_OUT = W_IN + (size_t)PXW * DM, W_G2 = W_OUT + (size_t)DM * DM,
                 W_D2 = W_G2 + (size_t)2 * FF * DM, W_Q = W_D2 + (size_t)DM * FF, W_KV = W_Q + (size_t)NQ * 1024, W_LAYER = W_KV + (size_t)NKV * 512;
constexpr size_t WS_END = WS_WB + al(W_LAYER * NL * 2);
constexpr int CW_BAR = 4096;
constexpr int CW_QUEUE = 8192;

constexpr int LDS_MISC = 143360, LDS_BYTES = 147456;

__device__ __forceinline__ float wave_sum(float v) {
#pragma unroll
    for (int o = 1; o < 64; o <<= 1) v += __shfl_xor(v, o);
    return v;
}
__device__ __forceinline__ float wave_sum16(const float (&x)[16], int lane) {
    const bool b5 = (lane & 32) != 0, b4 = (lane & 16) != 0, b3 = (lane & 8) != 0, b2 = (lane & 4) != 0;
    float k8[8], k4[4], k2[2];
#pragma unroll
    for (int i = 0; i < 8; ++i) k8[i] = (b5 ? x[8 + i] : x[i]) + __shfl_xor(b5 ? x[i] : x[8 + i], 32);
#pragma unroll
    for (int i = 0; i < 4; ++i) k4[i] = (b4 ? k8[4 + i] : k8[i]) + __shfl_xor(b4 ? k8[i] : k8[4 + i], 16);
#pragma unroll
    for (int i = 0; i < 2; ++i) k2[i] = (b3 ? k4[2 + i] : k4[i]) + __shfl_xor(b3 ? k4[i] : k4[2 + i], 8);
    float k1 = (b2 ? k2[1] : k2[0]) + __shfl_xor(b2 ? k2[0] : k2[1], 4);
    k1 += __shfl_xor(k1, 1); k1 += __shfl_xor(k1, 2);
    return k1;
}
typedef __bf16 bf16x2_t __attribute__((ext_vector_type(2)));
__device__ __forceinline__ unsigned cvt_pk_bf16(float lo, float hi) { const f32x2 v = {lo, hi}; return __builtin_bit_cast(unsigned, __builtin_convertvector(v, bf16x2_t)); }
__device__ __forceinline__ float bf2f(unsigned short b) { return __uint_as_float(((unsigned)b) << 16); }
__device__ __forceinline__ f32x4 bf4f(u32x2 w) { return (f32x4){__uint_as_float(w.x << 16), __uint_as_float(w.x & 0xffff0000u), __uint_as_float(w.y << 16), __uint_as_float(w.y & 0xffff0000u)}; }
__device__ __forceinline__ float sigmoidf_(float x) { return 1.0f / (1.0f + __expf(-x)); }
__device__ __forceinline__ float siluf_(float x) { return x / (1.0f + __expf(-x)); }
__device__ __forceinline__ bool has_left(int tau) { return tau != 0 && tau != NCTX; }
__device__ __forceinline__ bool has_right(int tau) { return tau != NCTX - 1 && tau != T - 1; }

struct Args { const float* in[46]; float* out; unsigned char* ws; int ph_lo, ph_hi; };
struct Frame { LAS unsigned char* lds; volatile LAS unsigned* MISC; int tid, lane, wave, bid, G; };
constexpr int LDS_PTAB = LDS_MISC + 2048;
__device__ __forceinline__ const float* inp(const Frame& F, int i) {
    const volatile LAS unsigned* p = (const volatile LAS unsigned*)(F.lds + LDS_PTAB) + 2 * i;
    const unsigned lo = __builtin_amdgcn_readfirstlane(p[0]), hi = __builtin_amdgcn_readfirstlane(p[1]);
    return (const float*)(((unsigned long long)hi << 32) | lo);
}
#define IN_(i) inp(F, (i))
__device__ __forceinline__ Frame opq(const Frame& F) { Frame G = F; asm volatile("" : "+v"(G.tid), "+s"(G.wave), "+s"(G.bid)); G.lane = G.tid & 63; return G; }
__device__ __forceinline__ unsigned char* opq_ptr(unsigned char* p) { asm volatile("" : "+s"(p)); return p; }
#ifndef MK_REP
#define MK_REP 0
#endif
#ifndef MK_ONLYRP
#define MK_ONLYRP 0
#endif
#define REP(x) (1 + (((MK_REP) >> (x)) & 1))
#define XB_TMO      128
#define XB_XCNT(j)  (256  + 64 * (j))
#define XB_XSUB(j)  (1280 + 64 * (j))
#define XB_XGEN(j)  (2304 + 64 * (j))
#define XB_TOP      3328
#define XB_TOPGEN   3392
#define XCD_BAR_WORDS 3456
#define XB_SPIN_CAP (1u << 18)

__device__ __forceinline__ unsigned xb_ld(unsigned* p)              { return __hip_atomic_load(p, __ATOMIC_RELAXED, __HIP_MEMORY_SCOPE_AGENT); }
__device__ __forceinline__ unsigned xb_add(unsigned* p, unsigned v) { return __hip_atomic_fetch_add(p, v, __ATOMIC_RELAXED, __HIP_MEMORY_SCOPE_AGENT); }
__device__ __forceinline__ unsigned xb_xcc_id() { return (unsigned)__builtin_amdgcn_s_getreg((3 << 11) | 20) & 0xFu; }
#define XB_SPIN(cond, bar) do { unsigned _sp = 0; while (cond) { __builtin_amdgcn_s_sleep(1); \
    if ((++_sp & 255u) == 0u) { if (xb_ld(&(bar)[XB_TMO])) break; if (_sp > XB_SPIN_CAP) { atomicAdd(&(bar)[XB_TMO], 1u); break; } } } } while (0)

struct XcdBarrier {
    unsigned* bar; unsigned x;
    volatile LAS unsigned* st;
};

__device__ __forceinline__ XcdBarrier xcd_barrier_post(unsigned* bar, volatile LAS unsigned* st) {
    XcdBarrier b; b.bar = bar; b.x = xb_xcc_id(); b.st = st;
    if (threadIdx.x == 0) (void)xb_add(&bar[XB_XCNT(b.x)], 1u);
    return b;
}
__device__ __forceinline__ void xcd_barrier_complete(unsigned* bar, unsigned x, unsigned& nloc, unsigned& nx) {
    const unsigned G = gridDim.x * gridDim.y * gridDim.z;
    unsigned sum, cnt, mine, sp = 0u;
    for (;;) {
        sum = 0u; cnt = 0u; mine = 0u;
#pragma unroll
        for (unsigned j = 0; j < 16; ++j) { const unsigned c = xb_ld(&bar[XB_XCNT(j)]); sum += c; cnt += (c > 0u) ? 1u : 0u; mine = (j == x) ? c : mine; }
        if (sum == G) break;
        __builtin_amdgcn_s_sleep(1);
        if ((++sp & 255u) == 0u) { if (xb_ld(&bar[XB_TMO])) break; if (sp > XB_SPIN_CAP) { atomicAdd(&bar[XB_TMO], 1u); break; } }
    }
    nloc = mine > 0u ? mine : 1u; nx = cnt > 0u ? cnt : 1u;
}

__device__ __forceinline__ void xcd_barrier(const XcdBarrier& b) {
    asm volatile("s_waitcnt vmcnt(0)" ::: "memory");
    __syncthreads();
    if (threadIdx.x == 0) {
        unsigned* bar = b.bar;
        __builtin_amdgcn_s_waitcnt(0);
        unsigned nloc = b.st[0], nx = b.st[1];
        if (nloc == 0u) { xcd_barrier_complete(bar, b.x, nloc, nx); b.st[0] = nloc; b.st[1] = nx; }
        const unsigned old = xb_add(&bar[XB_XSUB(b.x)], 1u);
        const unsigned gen = old / nloc;
        if (old + 1u == (gen + 1u) * nloc) {
            __builtin_amdgcn_fence(__ATOMIC_RELEASE, "agent");
            asm volatile("s_waitcnt vmcnt(0)" ::: "memory");
            const unsigned og = xb_add(&bar[XB_TOP], 1u);
            const unsigned tg = og / nx;
            if (og + 1u == (tg + 1u) * nx) xb_add(&bar[XB_TOPGEN], 1u);
            else XB_SPIN(xb_ld(&bar[XB_TOPGEN]) == tg, bar);
            __builtin_amdgcn_fence(__ATOMIC_ACQUIRE, "agent");
            xb_add(&bar[XB_XGEN(b.x)], 1u);
            asm volatile("s_waitcnt vmcnt(0)" ::: "memory");
        } else {
            XB_SPIN(xb_ld(&bar[XB_XGEN(b.x)]) == gen, bar);
            __builtin_amdgcn_fence(__ATOMIC_ACQUIRE, "agent");
            asm volatile("s_waitcnt vmcnt(0)" ::: "memory");
        }
    }
    __syncthreads();
}
namespace pg8 {
#define PG8_LAS __attribute__((address_space(3)))
typedef unsigned short bf16_t;
typedef short bf16x8 __attribute__((ext_vector_type(8)));
typedef float f32x4 __attribute__((ext_vector_type(4)));
typedef unsigned u32x4 __attribute__((ext_vector_type(4)));
constexpr int BM = 256, BK = 64, HALF = 128, HTB = HALF * BK * 2  , STAGE_BYTES = 8 * HTB, NXCD = 8, WGM = 4;

__host__ __device__ __forceinline__ int lds_byte(int r, int c) { const int st = (r >> 4) * 2 + (c >> 5), rr = r & 15, cc = c & 31, ob = rr * 64 + cc * 2; return st * 1024 + (ob ^ (((ob >> 9) & 1) << 5)); }
__host__ __device__ __forceinline__ void stage_rc(int b, int& R, int& C) { const int st = b / 1024, sb = b % 1024, swz = sb ^ (((sb >> 9) & 1) << 5); R = (st >> 1) * 16 + swz / 64; C = (st & 1) * 32 + (swz % 64) / 2; }
__host__ __device__ __forceinline__ int perm32(int rho) { const int n = rho >> 4, i = rho & 15; return 8 * (i >> 2) + 4 * n + (i & 3); }

struct Unit { int pm, pn; };
struct Gemm { const bf16_t* A; const bf16_t* Bt; int M, N, K, ld; };

struct StaticOrder {
    int nM, nN, nwg, G, c;
    __host__ __device__ void init(int M, int N, int G_, int c_) { nM = M / BM; nN = N / BM; nwg = nM * nN; G = G_; c = c_; }
    __host__ __device__ bool next(int i, Unit& u) const {
        const long L = (long)i * G + c; if (L >= nwg) return false;
        int wgid = (int)L; { const int q = nwg / NXCD, r = nwg % NXCD, xcd = wgid % NXCD, off = wgid / NXCD; wgid = (xcd < r ? xcd * (q + 1) : r * (q + 1) + (xcd - r) * q) + off; }
        const int nig = WGM * nN, gid = wgid / nig, fm = gid * WGM, gsz = (nM - fm) < WGM ? (nM - fm) : WGM;
        u.pm = fm + ((wgid % nig) % gsz); u.pn = (wgid % nig) / gsz; return true;
    }
    __device__ __forceinline__ void a_ready(const Unit&) const {}
    __device__ __forceinline__ void done(const Unit&) const {}
};
struct CountedOrder : StaticOrder {
    const unsigned* ready; unsigned need; unsigned* tmo;
    __device__ __forceinline__ void a_ready(const Unit& u) const {
        if (threadIdx.x < 64) {
            const unsigned long long t0 = __builtin_amdgcn_s_memrealtime(); unsigned polls = 0;
            while ((unsigned)__builtin_amdgcn_readfirstlane(__hip_atomic_load(ready + 64 * u.pm, __ATOMIC_RELAXED, __HIP_MEMORY_SCOPE_AGENT)) < need) {
                if ((++polls & 255u) == 0u && __builtin_amdgcn_readfirstlane(__hip_atomic_load(tmo, __ATOMIC_RELAXED, __HIP_MEMORY_SCOPE_AGENT)) != 0u) break;
                if (__builtin_amdgcn_s_memrealtime() - t0 > 2000000ull) {
                    if (threadIdx.x == 0) { unsigned expect = 0u; __hip_atomic_compare_exchange_strong(tmo + 1, &expect, 0x600u | (unsigned)(u.pm & 0xff), __ATOMIC_RELAXED, __ATOMIC_RELAXED, __HIP_MEMORY_SCOPE_AGENT); __hip_atomic_store(tmo, 1u, __ATOMIC_RELAXED, __HIP_MEMORY_SCOPE_AGENT); }
                    break; }
                __builtin_amdgcn_s_sleep(2); }
            __builtin_amdgcn_fence(__ATOMIC_ACQUIRE, "agent");
            asm volatile("s_waitcnt vmcnt(0)" ::: "memory");
        }
#if !defined(BROKEN_HOOK_NO_BARRIER)
        asm volatile("" ::: "memory"); __builtin_amdgcn_s_barrier(); asm volatile("" ::: "memory");
#endif
    }
};

__device__ __forceinline__ unsigned cvt_pk_bf16(float lo, float hi) { unsigned r; asm volatile("v_cvt_pk_bf16_f32 %0, %1, %2" : "=v"(r) : "v"(lo), "v"(hi)); return r; }
typedef float f32x2 __attribute__((ext_vector_type(2)));
__device__ __forceinline__ f32x2 gelu_pk(f32x2 v) {
    const f32x2 av = __builtin_elementwise_abs(v), d = av * 0.2316418882f + 1.0f;
    f32x2 t; t.x = __builtin_amdgcn_rcpf(d.x); t.y = __builtin_amdgcn_rcpf(d.y);
    f32x2 q = t * 0.5307027145f + (-0.7265760135f); q = q * t + 0.7107068705f; q = q * t + (-0.142248368f); q = q * t + 0.127414796f; q = q * t;
    const f32x2 s = (v * v) * (-0.72134752044f);
    f32x2 e; e.x = __builtin_amdgcn_exp2f(s.x); e.y = __builtin_amdgcn_exp2f(s.y);
    const f32x2 m = v * (q * e), r = v - m;
    f32x2 o; o.x = v.x < 0.f ? m.x : r.x; o.y = v.y < 0.f ? m.y : r.y; return o;
}

struct EpiF32 {
    static constexpr bool PERM = false, AFTER_DRAIN = false;
    float* C; int ldc; const float* bias;
    __device__ __forceinline__ void operator()(const f32x4 (&acc)[2][2][4][2], const Unit& u, int wr, int wc, int fr, int fq) const {
        const int row0 = u.pm * BM + wr * 64 + fr, col0 = u.pn * BM + wc * 32 + 4 * fq;
        f32x4 bv[2][2];
#pragma unroll
        for (int bj = 0; bj < 2; ++bj)
#pragma unroll
            for (int n = 0; n < 2; ++n) bv[bj][n] = bias ? *(const f32x4*)(bias + col0 + bj * HALF + n * 16) : (f32x4){0.f, 0.f, 0.f, 0.f};
#pragma unroll
        for (int ai = 0; ai < 2; ++ai)
#pragma unroll
            for (int m = 0; m < 4; ++m) { float* rowp = C + (size_t)(row0 + ai * HALF + m * 16) * ldc + col0;
#pragma unroll
                for (int bj = 0; bj < 2; ++bj)
#pragma unroll
                    for (int n = 0; n < 2; ++n) *(f32x4*)(rowp + bj * HALF + n * 16) = acc[ai][bj][m][n] + bv[bj][n]; }
    }
};
template <int ACT  > struct EpiBf16 {
    static constexpr bool PERM = true, AFTER_DRAIN = false;
    bf16_t* O; int ldc; const float* bias; int split_cols; size_t split_stride;
    __device__ __forceinline__ void operator()(const f32x4 (&acc)[2][2][4][2], const Unit& u, int wr, int wc, int fr, int fq) const {
        const int row0 = u.pm * BM + wr * 64 + fr; int colt = u.pn * BM; bf16_t* base = O;
        if (split_cols) { const int t = colt / split_cols; base += (size_t)t * split_stride; colt -= t * split_cols; }
        const int col0 = colt + wc * 32 + 8 * fq, bcol0 = u.pn * BM + wc * 32 + 8 * fq;
        f32x4 bv[2][2];
#pragma unroll
        for (int bj = 0; bj < 2; ++bj)
#pragma unroll
            for (int n = 0; n < 2; ++n) bv[bj][n] = bias ? *(const f32x4*)(bias + bcol0 + bj * HALF + 4 * n) : (f32x4){0.f, 0.f, 0.f, 0.f};
#pragma unroll
        for (int ai = 0; ai < 2; ++ai)
#pragma unroll
            for (int m = 0; m < 4; ++m) { bf16_t* rowp = base + (size_t)(row0 + ai * HALF + m * 16) * ldc + col0;
#pragma unroll
                for (int bj = 0; bj < 2; ++bj) { f32x4 v0 = acc[ai][bj][m][0] + bv[bj][0], v1 = acc[ai][bj][m][1] + bv[bj][1];
                    if (ACT == 1) { f32x2 a = gelu_pk((f32x2){v0[0], v0[1]}), b = gelu_pk((f32x2){v0[2], v0[3]}), c = gelu_pk((f32x2){v1[0], v1[1]}), d = gelu_pk((f32x2){v1[2], v1[3]});
                        v0 = (f32x4){a.x, a.y, b.x, b.y}; v1 = (f32x4){c.x, c.y, d.x, d.y}; }
                    if (ACT == 2) {
#pragma unroll
                        for (int j = 0; j < 4; ++j) { v0[j] = 0.5f * v0[j] * (1.0f + erff(v0[j] * 0.70710678f)); v1[j] = 0.5f * v1[j] * (1.0f + erff(v1[j] * 0.70710678f)); } }
                    u32x4 w; w.x = cvt_pk_bf16(v0[0], v0[1]); w.y = cvt_pk_bf16(v0[2], v0[3]); w.z = cvt_pk_bf16(v1[0], v1[1]); w.w = cvt_pk_bf16(v1[2], v1[3]);
                    *(u32x4*)(rowp + bj * HALF) = w; } }
    }
};
}
namespace pg8 {
struct EpiSwiGLU {
    static constexpr bool PERM = true, AFTER_DRAIN = false;
    bf16_t* O; int ldc;
    __device__ __forceinline__ void operator()(const f32x4 (&acc)[2][2][4][2], const Unit& u, int wr, int wc, int fr, int fq) const {
        const int row0 = u.pm * BM + wr * 64 + fr, col0 = u.pn * HALF + wc * 32 + 8 * fq;
#pragma unroll
        for (int ai = 0; ai < 2; ++ai)
#pragma unroll
            for (int m = 0; m < 4; ++m) { bf16_t* rowp = O + (size_t)(row0 + ai * HALF + m * 16) * ldc + col0;
                float h[8];
#pragma unroll
                for (int n = 0; n < 2; ++n)
#pragma unroll
                    for (int j = 0; j < 4; ++j) { const float g = acc[ai][0][m][n][j], up = acc[ai][1][m][n][j]; h[n * 4 + j] = g * __builtin_amdgcn_rcpf(1.0f + __builtin_amdgcn_exp2f(-1.4426950408889634f * g)) * up; }
                u32x4 w; w.x = cvt_pk_bf16(h[0], h[1]); w.y = cvt_pk_bf16(h[2], h[3]); w.z = cvt_pk_bf16(h[4], h[5]); w.w = cvt_pk_bf16(h[6], h[7]);
                *(u32x4*)rowp = w; }
    }
};
struct EpiResid {
    static constexpr bool PERM = false, AFTER_DRAIN = false;
    float* X; const float* gate_x; const float* gate_c; float fac; float* out_x;
    __device__ __forceinline__ void operator()(const f32x4 (&acc)[2][2][4][2], const Unit& u, int wr, int wc, int fr, int fq) const {
        const int row0 = u.pm * BM + wr * 64 + fr, col0 = u.pn * BM + wc * 32 + 4 * fq;
        const float* gv = (u.pm == 0) ? gate_c : gate_x;
        float* dst = (u.pm != 0 && out_x) ? out_x - (size_t)256 * 4096 : X;
        f32x4 gg[2][2];
#pragma unroll
        for (int bj = 0; bj < 2; ++bj)
#pragma unroll
            for (int n = 0; n < 2; ++n) gg[bj][n] = *(const f32x4*)(gv + col0 + bj * HALF + n * 16) * fac;
#pragma unroll
        for (int ai = 0; ai < 2; ++ai)
#pragma unroll
            for (int m = 0; m < 4; ++m) { const size_t off = (size_t)(row0 + ai * HALF + m * 16) * 4096 + col0;
#pragma unroll
                for (int bj = 0; bj < 2; ++bj)
#pragma unroll
                    for (int n = 0; n < 2; ++n) { const f32x4 b = *(const f32x4*)(X + off + bj * HALF + n * 16); *(f32x4*)(dst + off + bj * HALF + n * 16) = b + gg[bj][n] * acc[ai][bj][m][n]; } }
    }
};
struct OneUnit { int pn;
    __host__ __device__ bool next(int i, Unit& u) const { u.pm = 0; u.pn = pn; return i == 0; }
    __device__ __forceinline__ void a_ready(const Unit&) const {}
    __device__ __forceinline__ void done(const Unit&) const {}
};
struct StaticOrderX { StaticOrder b;
    __host__ __device__ void init(int M, int N, int G_, int c_) { b.init(M - BM, N, G_, c_); }
    __host__ __device__ bool next(int i, Unit& u) const { const bool ok = b.next(i, u); u.pm += 1; return ok; }
    __device__ __forceinline__ void a_ready(const Unit&) const {}
    __device__ __forceinline__ void done(const Unit&) const {}
};
}
namespace pg8 {
template <class Epi, class Sched, bool STAMP = false>
__device__ __forceinline__ void gemm_phase(PG8_LAS unsigned char* lds, const Gemm g, const Sched& S, const Epi& E, unsigned long long* stamps) {
    int tid_ = threadIdx.x; asm volatile("" : "+v"(tid_));
    const int tid = tid_, wid = __builtin_amdgcn_readfirstlane(tid >> 6), lane = tid & 63, wr = wid >> 2, wc = wid & 3, fr = lane & 15, fq = lane >> 4;
    const int K = g.ld, nt = g.K / BK;
    int ts_lo = 0, ts_hi = 0, nts = 0; const unsigned long long rt_entry = STAMP ? (unsigned long long)wall_clock64() : 0ull;
#define PG8_STAMP() do { if (STAMP && wid == 0 && nts < 64) { const unsigned long long _c = (unsigned long long)clock64(); \
        ts_lo = (lane == nts) ? (int)(unsigned)_c : ts_lo; ts_hi = (lane == nts) ? (int)(unsigned)(_c >> 32) : ts_hi; ++nts; } } while (0)
    PG8_STAMP();
    unsigned voffA[2], voffB[2];
#pragma unroll
    for (int i = 0; i < 2; ++i) { int R, C; stage_rc(tid * 16 + i * 8192, R, C); const int Rb = Epi::PERM ? ((R & ~31) + perm32(R & 31)) : R;
        voffA[i] = (unsigned)(R * K + C) * 2u; voffB[i] = (unsigned)(Rb * K + C) * 2u; }
    const size_t kstep = (size_t)(BK * 2);
    const size_t hstep = (size_t)HALF * K * 2;
    const size_t tstep = 2 * hstep;
    const unsigned ldsw = (unsigned)wid * 1024u;
    const int aoff = lds_byte(wr * 64 + fr, fq * 8), boff = lds_byte(wc * 32 + fr, fq * 8);
#define PG8_SA(b, h) (((b) * 2 + (h)) * HTB)
#define PG8_SB(b, h) ((4 + (b) * 2 + (h)) * HTB)
#define PG8_STAGE(bufoff, gbase, voff) do { _Pragma("unroll") for (int _i = 0; _i < 2; ++_i) \
        __builtin_amdgcn_global_load_lds((const unsigned*)((const char*)(gbase) + (voff)[_i]), (PG8_LAS unsigned*)(lds + (bufoff) + ldsw + _i * 8192), 16, 0, 0); } while (0)
#define PG8_LDA(dst, b, h) do { _Pragma("unroll") for (int m = 0; m < 4; ++m) _Pragma("unroll") for (int k = 0; k < 2; ++k) dst[m][k] = *(const PG8_LAS bf16x8*)(lds + PG8_SA(b, h) + aoff + m * 2048 + k * 1024); } while (0)
#define PG8_LDB(dst, b, h) do { _Pragma("unroll") for (int n = 0; n < 2; ++n) _Pragma("unroll") for (int k = 0; k < 2; ++k) dst[n][k] = *(const PG8_LAS bf16x8*)(lds + PG8_SB(b, h) + boff + n * 2048 + k * 1024); } while (0)
#define PG8_MMA(ai, bj, At, Bt) do { __builtin_amdgcn_s_setprio(1); _Pragma("unroll") for (int m = 0; m < 4; ++m) _Pragma("unroll") for (int n = 0; n < 2; ++n) _Pragma("unroll") for (int k = 0; k < 2; ++k) \
        acc[ai][bj][m][n] = __builtin_amdgcn_mfma_f32_16x16x32_bf16(Bt[n][k], At[m][k], acc[ai][bj][m][n], 0, 0, 0); __builtin_amdgcn_s_setprio(0); } while (0)
#define PG8_WAIT_V(n) asm volatile("s_waitcnt vmcnt(" #n ")" ::: "memory")
#define PG8_WAIT_L(n) asm volatile("s_waitcnt lgkmcnt(" #n ")" ::: "memory")
#define PG8_BAR __builtin_amdgcn_s_barrier()
#define PG8_SCHED __builtin_amdgcn_sched_barrier(0)
    Unit cur, nxt; int ui = 0;
    if (!S.next(0, cur)) return;
    f32x4 acc[2][2][4][2];
#pragma unroll
    for (int a = 0; a < 2; ++a)
#pragma unroll
        for (int b = 0; b < 2; ++b)
#pragma unroll
            for (int m = 0; m < 4; ++m)
#pragma unroll
                for (int n = 0; n < 2; ++n) acc[a][b][m][n] = (f32x4){0.f, 0.f, 0.f, 0.f};
    bf16x8 At[4][2], B0[2][2], B1[2][2];
    const char* cA = (const char*)g.A + (size_t)cur.pm * tstep; const char* cB = (const char*)g.Bt + (size_t)cur.pn * tstep;
    S.a_ready(cur);
    PG8_STAGE(PG8_SB(0, 0), cB, voffB); PG8_STAGE(PG8_SA(0, 0), cA, voffA); PG8_STAGE(PG8_SB(0, 1), cB + hstep, voffB); PG8_STAGE(PG8_SA(0, 1), cA + hstep, voffA);
    if (wr == 1) PG8_BAR;
    PG8_WAIT_V(4); PG8_BAR;
    PG8_STAGE(PG8_SB(1, 0), cB + kstep, voffB); PG8_STAGE(PG8_SA(1, 0), cA + kstep, voffA); PG8_STAGE(PG8_SB(1, 1), cB + hstep + kstep, voffB);
    PG8_WAIT_V(6); PG8_BAR;
    PG8_STAMP();
    for (;;) {
        const bool has_next = S.next(ui + 1, nxt);
        const char* nA = has_next ? (const char*)g.A + (size_t)nxt.pm * tstep : cA; const char* nB = has_next ? (const char*)g.Bt + (size_t)nxt.pn * tstep : cB;
        for (int t = 0; t < nt; t += 2) {
            const bool last = (t == nt - 2);
            const char* a1 = cA + (size_t)(t + 1) * kstep;
            const char* a2 = last ? nA : cA + (size_t)(t + 2) * kstep; const char* b2 = last ? nB : cB + (size_t)(t + 2) * kstep;
            const char* a3 = a2 + kstep; const char* b3 = b2 + kstep;
            if (last && has_next) S.a_ready(nxt);
            PG8_LDB(B0, 0, 0); PG8_SCHED; PG8_LDA(At, 0, 0); PG8_STAGE(PG8_SA(1, 1), a1 + hstep, voffA);
            PG8_WAIT_L(8); PG8_BAR; PG8_WAIT_L(0); PG8_MMA(0, 0, At, B0); PG8_BAR; PG8_SCHED;
            PG8_LDB(B1, 0, 1); PG8_STAGE(PG8_SB(0, 0), b2, voffB);
            PG8_BAR; PG8_WAIT_L(0); PG8_MMA(0, 1, At, B1); PG8_BAR;
            PG8_LDA(At, 0, 1); PG8_STAGE(PG8_SA(0, 0), a2, voffA);
            PG8_BAR; PG8_WAIT_L(0); PG8_MMA(1, 0, At, B0); PG8_BAR; PG8_SCHED;
            PG8_STAGE(PG8_SB(0, 1), b2 + hstep, voffB);
            PG8_WAIT_V(6); PG8_BAR; PG8_MMA(1, 1, At, B1); PG8_BAR;
            PG8_LDB(B0, 1, 0); PG8_SCHED; PG8_LDA(At, 1, 0); PG8_STAGE(PG8_SA(0, 1), a2 + hstep, voffA);
            PG8_WAIT_L(8); PG8_BAR; PG8_WAIT_L(0); PG8_MMA(0, 0, At, B0); PG8_BAR; PG8_SCHED;
            PG8_LDB(B1, 1, 1); PG8_STAGE(PG8_SB(1, 0), b3, voffB);
            PG8_BAR; PG8_WAIT_L(0); PG8_MMA(0, 1, At, B1); PG8_BAR;
            PG8_LDA(At, 1, 1); PG8_STAGE(PG8_SA(1, 0), a3, voffA);
            PG8_BAR; PG8_WAIT_L(0); PG8_MMA(1, 0, At, B0); PG8_BAR; PG8_SCHED;
            PG8_STAGE(PG8_SB(1, 1), b3 + hstep, voffB);
            PG8_WAIT_V(6); PG8_BAR; PG8_MMA(1, 1, At, B1); PG8_BAR;
        }
        PG8_STAMP();
        if constexpr (!Epi::AFTER_DRAIN) { E(acc, cur, wr, wc, fr, fq); S.done(cur); }
        PG8_STAMP();
        if (!has_next) break;
#pragma unroll
        for (int a = 0; a < 2; ++a)
#pragma unroll
            for (int b = 0; b < 2; ++b)
#pragma unroll
                for (int m = 0; m < 4; ++m)
#pragma unroll
                    for (int n = 0; n < 2; ++n) acc[a][b][m][n] = (f32x4){0.f, 0.f, 0.f, 0.f};
        cur = nxt; cA = nA; cB = nB; ++ui;
    }
    PG8_WAIT_V(0);
    if (wr == 0) PG8_BAR;
    PG8_BAR;
    if constexpr (Epi::AFTER_DRAIN) { E.fused(acc, cur, wr, wc, fr, fq, lds, wid, lane); S.done(cur); }
    PG8_STAMP();
    if (STAMP && wid == 0) { stamps[lane] = lane < nts ? (((unsigned long long)(unsigned)ts_hi << 32) | (unsigned)ts_lo) : 0ull;
        if (lane == 62) stamps[62] = rt_entry; if (lane == 63) stamps[63] = (unsigned long long)wall_clock64(); }
#undef PG8_STAMP
#undef PG8_SA
#undef PG8_SB
#undef PG8_STAGE
#undef PG8_LDA
#undef PG8_LDB
#undef PG8_MMA
#undef PG8_WAIT_V
#undef PG8_WAIT_L
#undef PG8_BAR
#undef PG8_SCHED
}
}
#define LDS_WAIT() asm volatile("s_waitcnt lgkmcnt(0)" ::: "memory")

__device__ __forceinline__ int map_row(int n, int mode) {
    if (mode == 1) { const int j = n < FF ? n : n - FF; return (j >> 7) * 256 + (n < FF ? 0 : 128) + (j & 127); }
    return n;
}
__device__ __forceinline__ void transpose_item(const float* __restrict__ W, int K, int N, bf16_t* WT, int mode, LAS float* scr, int item, int lane) {
    const int nblk = N / 32, kb = item / nblk, nb = item % nblk, k0 = 64 * kb, n0 = 32 * nb;
#pragma unroll 8
    for (int i = 0; i < 32; ++i) { const int kk = 2 * i + (lane >> 5); scr[kk * 33 + (lane & 31)] = W[(size_t)(k0 + kk) * N + n0 + (lane & 31)]; }
    LDS_WAIT(); asm volatile("" ::: "memory");
    const int c = lane & 7;
#pragma unroll
    for (int j = 0; j < 4; ++j) { const int n = (lane >> 3) + 8 * j; const LAS float* s = scr + (8 * c) * 33 + n;
        u32x4 o; o.x = cvt_pk_bf16(s[0 * 33], s[1 * 33]); o.y = cvt_pk_bf16(s[2 * 33], s[3 * 33]); o.z = cvt_pk_bf16(s[4 * 33], s[5 * 33]); o.w = cvt_pk_bf16(s[6 * 33], s[7 * 33]);
        *(u32x4*)(WT + (size_t)map_row(n0 + n, mode) * K + k0 + 8 * c) = o; }
    LDS_WAIT(); asm volatile("" ::: "memory");
}
constexpr int I_G = (DM / 64) * (2 * FF / 32), I_D = (FF / 64) * (DM / 32), I_IN = (DM / 64) * (9600 / 32), I_OUT = (DM / 64) * (DM / 32), I_Q = (1024 / 64) * (NQ / 32), I_KV = (512 / 64) * (NKV / 32);
constexpr int I_LAYER = 2 * I_G + 2 * I_D + I_IN + I_OUT + I_Q + I_KV;

__device__ __forceinline__ void phase0(const Frame& F, unsigned char* ws) {
    const int gw = F.bid * 8 + F.wave, NGW = F.G * 8;
    const size_t gt = (size_t)F.bid * 512 + F.tid, NGT = (size_t)F.G * 512;
    LAS float* scr = (LAS float*)(F.lds + F.wave * 8704);
    bf16_t* WB = (bf16_t*)(ws + WS_WB);
    for (int it = gw; it < NL * I_LAYER; it += NGW) {
        const int l = it / I_LAYER; int r = it - l * I_LAYER; bf16_t* wl = WB + (size_t)l * W_LAYER;
        if (r < I_G) { transpose_item(IN_(10) + (size_t)l * DM * 2 * FF, DM, 2 * FF, wl + W_G1, 1, scr, r, F.lane); continue; } r -= I_G;
        if (r < I_D) { transpose_item(IN_(11) + (size_t)l * FF * DM, FF, DM, wl + W_D1, 0, scr, r, F.lane); continue; } r -= I_D;
        if (r < I_G) { transpose_item(IN_(12) + (size_t)l * DM * 2 * FF, DM, 2 * FF, wl + W_G2, 1, scr, r, F.lane); continue; } r -= I_G;
        if (r < I_D) { transpose_item(IN_(13) + (size_t)l * FF * DM, FF, DM, wl + W_D2, 0, scr, r, F.lane); continue; } r -= I_D;
        if (r < I_IN) { transpose_item(IN_(14) + (size_t)l * DM * 9600, DM, 9600, wl + W_IN, 0, scr, r, F.lane); continue; } r -= I_IN;
        if (r < I_OUT) { transpose_item(IN_(15) + (size_t)l * DM * DM, DM, DM, wl + W_OUT, 0, scr, r, F.lane); continue; } r -= I_OUT;
        if (r < I_Q) { transpose_item(IN_(39) + (size_t)l * 1024 * NQ, 1024, NQ, wl + W_Q, 0, scr, r, F.lane); continue; } r -= I_Q;
        transpose_item(IN_(41) + (size_t)l * 512 * NKV, 512, NKV, wl + W_KV, 0, scr, r, F.lane);
    }
    for (size_t i = gt; i < (size_t)NL * 128 * 512; i += NGT) {
        const int l = (int)(i / (128 * 512)), rr = (int)((i / 512) % 128), c = (int)(i % 512);
        const int row = 9600 + rr;
        *(u32x4*)(WB + (size_t)l * W_LAYER + W_IN + (size_t)row * DM + c * 8) = (u32x4){0u, 0u, 0u, 0u};
    }
    { bf16_t* WLR = (bf16_t*)(ws + WS_WLR); const float* wu = IN_(18); const float* au = IN_(20); const float* gu = IN_(21);
      for (size_t i = gt; i < (size_t)NL * 448 * A_W; i += NGT) { const int l = (int)(i / (448 * A_W)), k = (int)((i / A_W) % 448), col = (int)(i % A_W);
          float v;
          if (k < 128) v = wu[(((size_t)l * 2 + (k >> 6)) * 64 + (k & 63)) * A_W + col];
          else if (k < 256) v = au[(((size_t)l * 2 + ((k - 128) >> 6)) * 64 + (k & 63)) * A_W + col];
          else v = gu[((size_t)l * 192 + (k - 256)) * A_W + col];
          WLR[((size_t)l * A_W + col) * 448 + k] = (bf16_t)(cvt_pk_bf16(v, v) & 0xffffu); } }
    { f32x4* xs = (f32x4*)(ws + WS_XS); const f32x4* cx = (const f32x4*)IN_(2); const f32x4* xx = (const f32x4*)IN_(0);
      for (size_t i = gt; i < (size_t)T * DM / 4; i += NGT) xs[i] = i < (size_t)NCTX * DM / 4 ? cx[i] : xx[i - (size_t)NCTX * DM / 4]; }
    { float* HP = (float*)(ws + WS_HP);
      for (int it = F.bid; it < NL * 16; it += F.G) { const int l = it >> 4, ch = it & 15, w = F.tid >> 8, j = F.tid & 255;
          const float* cv = w ? IN_(3) : IN_(1); const float* ad = IN_(4) + ((size_t)l * DM + ch * 256) * 256 + j; float s = 0.f;
          for (int i = 0; i < 256; ++i) s += siluf_(cv[ch * 256 + i]) * ad[(size_t)i * 256];
          HP[((l * 16 + ch) * 2 + w) * 256 + j] = s; } }
    { float* H3 = (float*)(ws + WS_H3);
      LAS float* zb = (LAS float*)(F.lds + 73728); LAS float* ha = zb + 8 * 36; LAS float* hb = ha + 8 * 64;
      for (int it = F.bid; it < NL * (T / 8); it += F.G) { const int l = it / (T / 8), pb = it % (T / 8);
          if (F.tid < 8 * 33) { const int p = F.tid / 33, i = F.tid % 33, P = pb * 8 + p; const int L = P < NCTX ? NCTX : SEQ, t = P < NCTX ? P : P - NCTX;
              float z;
              if (i == 0) z = (float)t / (float)(L - 1);
              else { const int b = (i - 1) & 15; const float fb = 1e-4f + (float)b * ((15.0f - 1e-4f) / 15.0f); const float rev2 = 2.0f * fb * (float)t / (float)L;
                  z = i <= 16 ? cospif(rev2) : -sinpif(rev2); }
              zb[p * 36 + i] = z; }
          __syncthreads();
          const int p = F.tid >> 6, j = F.tid & 63; const float fq = IN_(36)[l * 64 + j];
          { const float* w1 = IN_(29) + (size_t)l * 33 * 64 + j; float s = IN_(30)[l * 64 + j];
            for (int i = 0; i < 33; ++i) s += zb[p * 36 + i] * w1[i * 64];
            ha[p * 64 + j] = sinf(fq * s); }
          __syncthreads();
          { const float* w2 = IN_(31) + (size_t)l * 64 * 64 + j; float s = IN_(32)[l * 64 + j];
            for (int i = 0; i < 64; ++i) s += ha[p * 64 + i] * w2[i * 64];
            hb[p * 64 + j] = sinf(fq * s); }
          __syncthreads();
          { const float* w3 = IN_(33) + (size_t)l * 64 * 64 + j; float s = IN_(34)[l * 64 + j];
            for (int i = 0; i < 64; ++i) s += hb[p * 64 + i] * w3[i * 64];
            ((bf16_t*)H3)[((size_t)l * 64 + j) * T + pb * 8 + p] = (bf16_t)(cvt_pk_bf16(sinf(fq * s), 0.f) & 0xffffu); }
          __syncthreads(); } }
}
__device__ __forceinline__ void phase_mod(const Frame& F, unsigned char* ws) {
    const float* HP = (const float*)(ws + WS_HP); float* MOD = (float*)(ws + WS_MOD);
    LAS float* hs = (LAS float*)F.lds;
    for (int it = F.bid; it < NL * (NMOD / 512); it += F.G) { const int l = it / (NMOD / 512), nb = it % (NMOD / 512);
        { const int w = F.tid >> 8, j = F.tid & 255; float s = 0.f;
          for (int ch = 0; ch < 16; ++ch) s += HP[((l * 16 + ch) * 2 + w) * 256 + j];
          hs[w * 256 + j] = s; }
        __syncthreads();
        const int n = nb * 512 + F.tid; const float* au = IN_(5) + (size_t)l * 256 * NMOD + n; float s0 = IN_(6)[(size_t)l * NMOD + n], s1 = s0;
        for (int j = 0; j < 256; ++j) { const float u = au[(size_t)j * NMOD]; s0 += hs[j] * u; s1 += hs[256 + j] * u; }
        MOD[((size_t)l * 2 + 0) * NMOD + n] = s0; MOD[((size_t)l * 2 + 1) * NMOD + n] = s1;
        __syncthreads(); }
}
__device__ __forceinline__ void norm_phase(const Frame& F, float* XS, const float* __restrict__ gain, const float* modx, const float* modc, int ish, int isc, bf16_t* out, const bf16_t* slab, const float* sgate, float sfac) {
    const int gw = F.bid * 8 + F.wave, NGW = F.G * 8;
    int row_lo = 0;
    if (slab) { row_lo = NCTX;
        LAS float* red = (LAS float*)F.lds;
        for (int row = F.bid; row < NCTX; row += F.G) { const size_t o = (size_t)row * DM + F.wave * 512;
            f32x4 v[2]; float s = 0.f;
#pragma unroll
            for (int j = 0; j < 2; ++j) { f32x4 acc = (f32x4){0.f, 0.f, 0.f, 0.f};
#pragma unroll
                for (int ks = 0; ks < 16; ++ks) acc += bf4f(((const u32x2*)(slab + (size_t)ks * NCTX * DM + o) + F.lane)[64 * j]);
                v[j] = ((const f32x4*)(XS + o) + F.lane)[64 * j] + acc * ((const f32x4*)(sgate + F.wave * 512) + F.lane)[64 * j] * sfac;
                ((f32x4*)(XS + o) + F.lane)[64 * j] = v[j]; s += (v[j].x * v[j].x + v[j].y * v[j].y) + (v[j].z * v[j].z + v[j].w * v[j].w); }
            s = wave_sum(s); if (F.lane == 0) red[F.wave] = s;
            __syncthreads();
            float tot = 0.f;
#pragma unroll
            for (int w = 0; w < 8; ++w) tot += red[w];
            const float rstd = rsqrtf(tot * (1.0f / DM) + NORM_EPS);
#pragma unroll
            for (int j = 0; j < 2; ++j) { const int c4 = F.wave * 128 + F.lane + 64 * j;
                const f32x4 y = v[j] * rstd * ((const f32x4*)gain)[c4] * (((const f32x4*)(modc + (size_t)isc * DM))[c4] + 1.0f) + ((const f32x4*)(modc + (size_t)ish * DM))[c4];
                u32x2 w2; w2.x = cvt_pk_bf16(y.x, y.y); w2.y = cvt_pk_bf16(y.z, y.w); ((u32x2*)(out + (size_t)row * DM))[c4] = w2; }
            __syncthreads(); } }
    for (int row = row_lo + gw; row < T; row += NGW) {
        const float* mod = row < NCTX ? modc : modx;
        const f32x4* xr = (const f32x4*)(XS + (size_t)row * DM) + F.lane; const f32x4* g4 = (const f32x4*)gain + F.lane;
        const f32x4* sh4 = (const f32x4*)(mod + (size_t)ish * DM) + F.lane; const f32x4* sc4 = (const f32x4*)(mod + (size_t)isc * DM) + F.lane;
        f32x4 v[16]; float s = 0.f;
#pragma unroll
        for (int j = 0; j < 16; ++j) { v[j] = xr[64 * j]; s += (v[j].x * v[j].x + v[j].y * v[j].y) + (v[j].z * v[j].z + v[j].w * v[j].w); }
        const float rstd = rsqrtf(wave_sum(s) * (1.0f / DM) + NORM_EPS);
        u32x2* o = (u32x2*)(out + (size_t)row * DM) + F.lane;
#pragma unroll
        for (int j = 0; j < 16; ++j) { const f32x4 y = v[j] * rstd * g4[64 * j] * (sc4[64 * j] + 1.0f) + sh4[64 * j];
            u32x2 w; w.x = cvt_pk_bf16(y.x, y.y); w.y = cvt_pk_bf16(y.z, y.w); o[64 * j] = w; }
    }
}
__device__ __forceinline__ float conv3_at(const bf16_t* PX, int tau, int col, float w0, float w1, float w2) {
    const bf16_t* p = PX + (size_t)tau * PXW + col;
    const bool hl = has_left(tau), hr = has_right(tau);
    return bf2f(p[0]) * w1 + bf2f(p[hl ? -PXW : 0]) * (hl ? w0 : 0.f) + bf2f(p[hr ? PXW : 0]) * (hr ? w2 : 0.f);
}
__device__ __forceinline__ float rope_apply(float val, int tau, int j) {
    const int pos = tau - NCTX, prow = pos >> 6, pcol = pos & 63;
    const float inv = __powf(10000.0f, -(float)(j & 15) * (1.0f / 16.0f));
    const float ang = (float)(j < 32 ? prow : pcol) * inv;
    float sn, cs; sincosf(ang, &sn, &cs);
    const float partner = __shfl_xor(val, 16);
    const float rot = (j & 16) ? partner : -partner;
    return val * cs + rot * sn;
}
__device__ __forceinline__ void mla_prep_phase(const Frame& F, unsigned char* ws, int l) {
    const bf16_t* PX = (const bf16_t*)(ws + WS_PX); bf16_t* QA = (bf16_t*)(ws + WS_QA); bf16_t* KVA = (bf16_t*)(ws + WS_KVA); bf16_t* KPE = (bf16_t*)(ws + WS_KPE);
    const int gw = F.bid * 8 + F.wave, NGW = F.G * 8;
    const f32x4* gq = (const f32x4*)(IN_(38) + l * 1024) + F.lane; const f32x4* gkv = (const f32x4*)(IN_(40) + l * 512) + F.lane; const float gpe = IN_(45)[l * 64 + F.lane];
    for (int tau = gw; tau < T; tau += NGW) {
        const u32x2* p = (const u32x2*)(PX + (size_t)tau * PXW + PXC) + F.lane;
        f32x4 q[4], kv[2]; float sq = 0.f, skv = 0.f;
#pragma unroll
        for (int j = 0; j < 4; ++j) { q[j] = bf4f(p[64 * j]); sq += (q[j].x * q[j].x + q[j].y * q[j].y) + (q[j].z * q[j].z + q[j].w * q[j].w); }
#pragma unroll
        for (int j = 0; j < 2; ++j) { kv[j] = bf4f(p[256 + 64 * j]); skv += (kv[j].x * kv[j].x + kv[j].y * kv[j].y) + (kv[j].z * kv[j].z + kv[j].w * kv[j].w); }
        const float pe = bf2f(PX[(size_t)tau * PXW + PXC + 1536 + F.lane]);
        const float rq = rsqrtf(wave_sum(sq) * (1.0f / 1024.0f) + NORM_EPS), rkv = rsqrtf(wave_sum(skv) * (1.0f / 512.0f) + NORM_EPS), rpe = rsqrtf(wave_sum(pe * pe) * (1.0f / 64.0f) + NORM_EPS);
        u32x2* oq = (u32x2*)(QA + (size_t)tau * 1024) + F.lane; u32x2* okv = (u32x2*)(KVA + (size_t)tau * 512) + F.lane;
#pragma unroll
        for (int j = 0; j < 4; ++j) { const f32x4 y = q[j] * rq * gq[64 * j]; u32x2 w; w.x = cvt_pk_bf16(y.x, y.y); w.y = cvt_pk_bf16(y.z, y.w); oq[64 * j] = w; }
#pragma unroll
        for (int j = 0; j < 2; ++j) { const f32x4 y = kv[j] * rkv * gkv[64 * j]; u32x2 w; w.x = cvt_pk_bf16(y.x, y.y); w.y = cvt_pk_bf16(y.z, y.w); okv[64 * j] = w; }
        float kp = pe * rpe * gpe;
        if (tau >= NCTX) kp = rope_apply(kp, tau, F.lane);
        KPE[(size_t)tau * 64 + F.lane] = (bf16_t)(cvt_pk_bf16(kp, kp) & 0xffffu);
    }
}
__device__ __forceinline__ void qkv_final_phase(const Frame& F, unsigned char* ws, int l, bool need_ctx) {
    const bf16_t* QRAW = (const bf16_t*)(ws + WS_QRAW); const bf16_t* KVRAW = (const bf16_t*)(ws + WS_KVRAW); const bf16_t* KPE = (const bf16_t*)(ws + WS_KPE);
    bf16_t* QF = (bf16_t*)(ws + WS_QF); bf16_t* KF = (bf16_t*)(ws + WS_KF);
    const int gw = F.bid * 8 + F.wave, NGW = F.G * 8, ln = F.lane;
    const float gqn0 = IN_(42)[l * 128 + 2 * ln], gqn1 = IN_(42)[l * 128 + 2 * ln + 1], gqp = IN_(43)[l * 64 + ln];
    const float gkn0 = IN_(44)[l * 128 + 2 * ln], gkn1 = IN_(44)[l * 128 + 2 * ln + 1];
    (void)need_ctx;
    for (int tau = gw; tau < T; tau += NGW) {
        float cs = 1.f, sn = 0.f;
        if (tau >= NCTX) { const int pos = tau - NCTX, prow = pos >> 6, pcol = pos & 63; const float inv = __powf(10000.0f, -(float)(ln & 15) * (1.0f / 16.0f)); sincosf((float)(ln < 32 ? prow : pcol) * inv, &sn, &cs); }
        const bf16_t kpe = KPE[(size_t)tau * 64 + ln];
        const bf16_t* qrow = QRAW + (size_t)tau * NQ; const bf16_t* krow = KVRAW + (size_t)tau * NKV;
        unsigned qn[NHC], kn[NHC]; bf16_t qpv[NHC];
#pragma unroll
        for (int h = 0; h < NHC; ++h) { qn[h] = *(const unsigned*)(qrow + h * 192 + 2 * ln); qpv[h] = qrow[h * 192 + 128 + ln]; kn[h] = *(const unsigned*)(krow + h * 256 + 2 * ln); }
#pragma unroll
        for (int h = 0; h < NHC; ++h) {
            const float q0 = bf2f((unsigned short)(qn[h] & 0xffffu)), q1 = bf2f((unsigned short)(qn[h] >> 16)), qp = bf2f(qpv[h]), k0 = bf2f((unsigned short)(kn[h] & 0xffffu)), k1 = bf2f((unsigned short)(kn[h] >> 16));
            const float rqn = rsqrtf(wave_sum(q0 * q0 + q1 * q1) * (1.0f / 128.0f) + NORM_EPS), rqp = rsqrtf(wave_sum(qp * qp) * (1.0f / 64.0f) + NORM_EPS), rkn = rsqrtf(wave_sum(k0 * k0 + k1 * k1) * (1.0f / 128.0f) + NORM_EPS);
            float qpe = qp * rqp * gqp;
            { const float partner = __shfl_xor(qpe, 16); const float rot = (ln & 16) ? partner : -partner; qpe = qpe * cs + rot * sn; }
            *(unsigned*)(QF + (size_t)tau * NQ + h * 192 + 2 * ln) = cvt_pk_bf16(q0 * rqn * gqn0, q1 * rqn * gqn1);
            QF[(size_t)tau * NQ + h * 192 + 128 + ln] = (bf16_t)(cvt_pk_bf16(qpe, qpe) & 0xffffu);
            *(unsigned*)(KF + (size_t)tau * NQ + h * 192 + 2 * ln) = cvt_pk_bf16(k0 * rkn * gkn0, k1 * rkn * gkn1);
            KF[(size_t)tau * NQ + h * 192 + 128 + ln] = kpe; }
    }
}
__device__ __forceinline__ void rwkv_out_phase(const Frame& F, unsigned char* ws, int l, bool need_ctx) {
    const float* SS = (const float*)(ws + WS_SS); const float* SD = (const float*)(ws + WS_SD); const float* GB = (const float*)(ws + WS_G); const float* Y = (const float*)(ws + WS_Y);
    bf16_t* OB = (bf16_t*)(ws + WS_OBUF);
    const int gw = F.bid * 8 + F.wave, NGW = F.G * 8, ln = F.lane;
    for (int it = (need_ctx ? 0 : NCTX * 5) + gw; it < T * 5; it += NGW) { const int tau = it / 5, h0 = (it % 5) * 4;
        float y0[4], y1[4], v[4], sa[4], sb[4], g[4];
#pragma unroll
        for (int q = 0; q < 4; ++q) { const int h = h0 + q, col = h * 64 + ln; const size_t o = (size_t)tau * A_W + col;
            y0[q] = Y[o]; y1[q] = Y[(size_t)T * A_W + o]; v[q] = SS[(size_t)T * A_W + o];
            sa[q] = SD[(size_t)tau * NHA + h]; sb[q] = SD[((size_t)T + tau) * NHA + h]; g[q] = GB[o]; }
#pragma unroll
        for (int q = 0; q < 4; ++q) { const int col = (h0 + q) * 64 + ln;
            const float y = y0[q] + y1[q];
            const float mu = wave_sum(y) * (1.0f / 64.0f); const float dy = y - mu; const float var = wave_sum(dy * dy) * (1.0f / 64.0f);
            const float yn = dy * rsqrtf(var + GN_EPS) * IN_(25)[l * A_W + col] + IN_(26)[l * A_W + col];
            const float bonus = 0.5f * (sa[q] + sb[q]) * v[q];
            const float ov = (yn + bonus) * g[q];
            OB[(size_t)tau * DM + col] = (bf16_t)(cvt_pk_bf16(ov, ov) & 0xffffu); }
    }
}
__device__ __forceinline__ void hyena_prep_phase(const Frame& F, unsigned char* ws, int l) {
    const bf16_t* PX = (const bf16_t*)(ws + WS_PX); float* GT = (float*)(ws + WS_GT); float* X0T = (float*)(ws + WS_X0T);
    LAS float* LGt = (LAS float*)F.lds; LAS float* LX0 = LGt + 64 * 65;
    const float* cw = IN_(27) + (size_t)l * 3 * B_IN; const float* cb = IN_(28) + (size_t)l * B_IN;
    for (int it = F.bid; it < (T / 64) * 20; it += F.G) { const int tt = it / 20, ct = it % 20;
        { const int t = F.tid >> 3, c0 = ct * 64 + (F.tid & 7) * 8, tau = tt * 64 + t;
          f32x4 u[3][2];
#pragma unroll
          for (int grp = 0; grp < 3; ++grp)
#pragma unroll
              for (int q = 0; q < 2; ++q) { const int c = grp * 1280 + c0 + 4 * q; const bf16_t* p = PX + (size_t)tau * PXW + PXB + c;
                  const bool hl = has_left(tau), hr = has_right(tau);
                  const f32x4 y = bf4f(*(const u32x2*)p) * *(const f32x4*)(cw + B_IN + c) + *(const f32x4*)(cb + c) + bf4f(*(const u32x2*)(p - (hl ? PXW : 0))) * (*(const f32x4*)(cw + c) * (hl ? 1.f : 0.f))
                                + bf4f(*(const u32x2*)(p + (hr ? PXW : 0))) * (*(const f32x4*)(cw + 2 * B_IN + c) * (hr ? 1.f : 0.f));
                  u[grp][q] = y; }
#pragma unroll
          for (int q = 0; q < 2; ++q)
#pragma unroll
              for (int e = 0; e < 4; ++e) { const int ch = (F.tid & 7) * 8 + 4 * q + e; LGt[ch * 65 + t] = u[1][q][e] * u[2][q][e]; LX0[ch * 65 + t] = u[0][q][e]; } }
        __syncthreads();
        { const int ch = F.tid >> 3, t0 = (F.tid & 7) * 8; const size_t o = (size_t)(ct * 64 + ch) * T + tt * 64 + t0;
          f32x4 a0, a1, b0, b1;
#pragma unroll
          for (int e = 0; e < 4; ++e) { a0[e] = LGt[ch * 65 + t0 + e]; a1[e] = LGt[ch * 65 + t0 + 4 + e]; b0[e] = LX0[ch * 65 + t0 + e]; b1[e] = LX0[ch * 65 + t0 + 4 + e]; }
          *(f32x4*)(GT + o) = a0; *(f32x4*)(GT + o + 4) = a1; *(f32x4*)(X0T + o) = b0; *(f32x4*)(X0T + o + 4) = b1; }
        __syncthreads(); }
}
__device__ __forceinline__ void hyena_out_phase(const Frame& F, unsigned char* ws, bool need_ctx) {
    const float* YT = (const float*)(ws + WS_GT); bf16_t* OB = (bf16_t*)(ws + WS_OBUF);
    LAS float* L = (LAS float*)F.lds;
    const int it0 = need_ctx ? 0 : (NCTX / 64) * 20;
    for (int it = it0 + F.bid; it < (T / 64) * 20; it += F.G) { const int tt = it / 20, ct = it % 20;
        { const int ch = F.tid >> 3, t0 = (F.tid & 7) * 8; const size_t o = (size_t)(ct * 64 + ch) * T + tt * 64 + t0;
          const f32x4 a0 = *(const f32x4*)(YT + o), a1 = *(const f32x4*)(YT + o + 4);
#pragma unroll
          for (int e = 0; e < 4; ++e) { L[ch * 65 + t0 + e] = a0[e]; L[ch * 65 + t0 + 4 + e] = a1[e]; } }
        __syncthreads();
        { const int t = F.tid >> 3, c0 = (F.tid & 7) * 8; float x[8];
#pragma unroll
          for (int e = 0; e < 8; ++e) x[e] = L[(c0 + e) * 65 + t];
          u32x4 w; w.x = cvt_pk_bf16(x[0], x[1]); w.y = cvt_pk_bf16(x[2], x[3]); w.z = cvt_pk_bf16(x[4], x[5]); w.w = cvt_pk_bf16(x[6], x[7]);
          *(u32x4*)(OB + (size_t)(tt * 64 + t) * DM + 1280 + ct * 64 + c0) = w; }
        __syncthreads(); }
}
namespace att {
constexpr int DK = 192, DV = 128, NW = 8, QBLK = 32, KVBLK = 64;
constexpr float SCALE = 0.07216878364870322f;
constexpr float THR = 8.f;
#ifndef ATT_SDEPTH
#define ATT_SDEPTH 2
#endif
constexpr int SDEPTH = ATT_SDEPTH;
constexpr int LDQ = 2304, LDK = 2304, LDV = 3072, LDO = 4096;
constexpr int SHM_V = KVBLK * DV * 2, SHM_K = KVBLK * DK * 2, SHM_ATTN = 2 * SHM_V + 2 * SHM_K + NW * 64 * 4 + NW * 4096;
using bf16x8 = __attribute__((ext_vector_type(8))) short;
using s16x4  = __attribute__((ext_vector_type(4))) short;
using f32x16 = __attribute__((ext_vector_type(16))) float;
using u32x4  = __attribute__((ext_vector_type(4))) unsigned;
#define KSWZ(row, colB) ((row) * 384 + ((colB) ^ (((row) & 7) << 4)))
#define SBAR() __builtin_amdgcn_sched_barrier(0)
__device__ __forceinline__ int crow(int r, int hi) { return (r & 3) + 8 * (r >> 2) + 4 * hi; }
__device__ __forceinline__ unsigned cvtpk(float lo, float hi) { unsigned r; asm volatile("v_cvt_pk_bf16_f32 %0, %1, %2" : "=v"(r) : "v"(lo), "v"(hi)); return r; }
__device__ __forceinline__ void partialSM(f32x16& p0, f32x16& p1, float& m_reg, float& mn, float& alpha) {
  constexpr float C = SCALE * 1.4426950408889634f;
  float pmax = p0[0]; for (int r = 1; r < 16; ++r) pmax = fmaxf(pmax, p0[r]); for (int r = 0; r < 16; ++r) pmax = fmaxf(pmax, p1[r]);
  { auto rr = __builtin_amdgcn_permlane32_swap(__float_as_uint(pmax), __float_as_uint(pmax), false, false);
    pmax = fmaxf(__uint_as_float(rr[0]), __uint_as_float(rr[1])); }
  if (__builtin_expect(__all(pmax - m_reg <= THR / SCALE), 1)) { mn = m_reg; alpha = 1.f; }
  else { mn = fmaxf(m_reg, pmax); alpha = __builtin_amdgcn_exp2f((m_reg - mn) * C); m_reg = mn; }
  float mnC = -mn * C;
  for (int r = 0; r < 16; ++r) p0[r] = fmaf(p0[r], C, mnC); for (int r = 0; r < 16; ++r) p1[r] = fmaf(p1[r], C, mnC);
  for (int r = 0; r < 16; ++r) p0[r] = __builtin_amdgcn_exp2f(p0[r]);
}
__device__ __forceinline__ void finishSM(f32x16& p0, f32x16& p1, float alpha, float& l_reg, bf16x8& pa0, bf16x8& pa1, bf16x8& pa2, bf16x8& pa3) {
  for (int r = 0; r < 16; ++r) p1[r] = __builtin_amdgcn_exp2f(p1[r]);
  float ps = 0; for (int r = 0; r < 16; ++r) ps += p0[r]; for (int r = 0; r < 16; ++r) ps += p1[r];
  { auto rr = __builtin_amdgcn_permlane32_swap(__float_as_uint(ps), __float_as_uint(ps), false, false);
    ps = __uint_as_float(rr[0]) + __uint_as_float(rr[1]); }
  l_reg = l_reg * alpha + ps;
#define PK4(P, BASE, OUT) do { unsigned a0 = cvtpk(P[BASE + 0], P[BASE + 1]), a1 = cvtpk(P[BASE + 2], P[BASE + 3]);   \
    unsigned b0 = cvtpk(P[BASE + 4], P[BASE + 5]), b1 = cvtpk(P[BASE + 6], P[BASE + 7]);                              \
    auto r0 = __builtin_amdgcn_permlane32_swap(a0, b0, false, false); auto r1 = __builtin_amdgcn_permlane32_swap(a1, b1, false, false); \
    u32x4 w = {r0[0], r1[0], r0[1], r1[1]}; OUT = *reinterpret_cast<bf16x8*>(&w); } while (0)
  PK4(p0, 0, pa0); PK4(p0, 8, pa1); PK4(p1, 0, pa2); PK4(p1, 8, pa3);
#undef PK4
}
__device__ __forceinline__ void qkt(f32x16& p0, f32x16& p1, const char* Ks, const bf16x8* qr, const char* qrl, int r32, int hi) {
  p0 = f32x16{}; p1 = f32x16{};
#pragma unroll
  for (int d0 = 0; d0 < 8; ++d0) { int cb = (d0 * 16 + hi * 8) * 2;
    bf16x8 b0 = *reinterpret_cast<const bf16x8*>(Ks + KSWZ(r32, cb));
    bf16x8 b1 = *reinterpret_cast<const bf16x8*>(Ks + KSWZ(32 + r32, cb));
    p0 = __builtin_amdgcn_mfma_f32_32x32x16_bf16(b0, qr[d0], p0, 0, 0, 0);
    p1 = __builtin_amdgcn_mfma_f32_32x32x16_bf16(b1, qr[d0], p1, 0, 0, 0); }
#pragma unroll
  for (int d0 = 8; d0 < 12; ++d0) { int cb = (d0 * 16 + hi * 8) * 2;
    bf16x8 b0 = *reinterpret_cast<const bf16x8*>(Ks + KSWZ(r32, cb));
    bf16x8 b1 = *reinterpret_cast<const bf16x8*>(Ks + KSWZ(32 + r32, cb));
    const bf16x8 q = *reinterpret_cast<const bf16x8*>(qrl + ((((d0 - 8) * 2 + hi) ^ (r32 & 7)) << 4));
    p0 = __builtin_amdgcn_mfma_f32_32x32x16_bf16(b0, q, p0, 0, 0, 0);
    p1 = __builtin_amdgcn_mfma_f32_32x32x16_bf16(b1, q, p1, 0, 0, 0); }
}
__device__ __forceinline__ int v_st(int k, int c) { const int kk = (k & ~0xC) | ((k & 4) << 1) | ((k & 8) >> 1); return ((kk >> 3) * 4 + (c >> 5)) * 512 + ((kk & 7) * 32 + (c & 31)) * 2; }
__device__ __forceinline__ int v_rd_base(int lane) { return ((lane & 3) << 3) | (((lane >> 2) & 3) << 6) | (((lane >> 4) & 1) << 5) | (((lane >> 5) & 1) << 8); }
constexpr int v_rd_off(int d0, int ks, int half) { return d0 * 512 + ks * 4096 + half * 2048; }
template <int OFF> __device__ __forceinline__ s16x4 tr_read(int vb) {
  s16x4 r; asm volatile("ds_read_b64_tr_b16 %0, %1 offset:%2" : "=&v"(r) : "v"(vb), "i"(OFF) : "memory"); return r;
}
template <int D0> __device__ __forceinline__ void pv_one(f32x16& od, int vb, bf16x8 pa0, bf16x8 pa1, bf16x8 pa2, bf16x8 pa3) {
  const s16x4 l0 = tr_read<v_rd_off(D0, 0, 0)>(vb), h0 = tr_read<v_rd_off(D0, 0, 1)>(vb), l1 = tr_read<v_rd_off(D0, 1, 0)>(vb), h1 = tr_read<v_rd_off(D0, 1, 1)>(vb);
  const s16x4 l2 = tr_read<v_rd_off(D0, 2, 0)>(vb), h2 = tr_read<v_rd_off(D0, 2, 1)>(vb), l3 = tr_read<v_rd_off(D0, 3, 0)>(vb), h3 = tr_read<v_rd_off(D0, 3, 1)>(vb);
  asm volatile("s_waitcnt lgkmcnt(0)" ::: "memory"); SBAR();
#define PK(L, H) (bf16x8){L[0], L[1], L[2], L[3], H[0], H[1], H[2], H[3]}
  od = __builtin_amdgcn_mfma_f32_32x32x16_bf16(pa0, PK(l0, h0), od, 0, 0, 0);
  od = __builtin_amdgcn_mfma_f32_32x32x16_bf16(pa1, PK(l1, h1), od, 0, 0, 0);
  od = __builtin_amdgcn_mfma_f32_32x32x16_bf16(pa2, PK(l2, h2), od, 0, 0, 0);
  od = __builtin_amdgcn_mfma_f32_32x32x16_bf16(pa3, PK(l3, h3), od, 0, 0, 0);
#undef PK
}
__device__ __forceinline__ void pv_d0(f32x16* o, int vb, bf16x8 pa0, bf16x8 pa1, bf16x8 pa2, bf16x8 pa3) {
  pv_one<0>(o[0], vb, pa0, pa1, pa2, pa3); pv_one<1>(o[1], vb, pa0, pa1, pa2, pa3); pv_one<2>(o[2], vb, pa0, pa1, pa2, pa3); pv_one<3>(o[3], vb, pa0, pa1, pa2, pa3);
}
__device__ __forceinline__ void attn_body(const bf16_t* __restrict__ Qb, const bf16_t* __restrict__ Kh, const bf16_t* __restrict__ Vh, bf16_t* __restrict__ Ob, int seq, char* lds) {
  int tid_ = threadIdx.x; asm volatile("" : "+v"(tid_));
  const int tid = tid_, wid = tid >> 6, lane = tid & 63, r32 = lane & 31, hi = lane >> 5;
  char* V_lds = lds; char* K_lds = lds + 2 * SHM_V;
  float* ws = (float*)(lds + 2 * SHM_V + 2 * SHM_K) + wid * 64; float* li_l = ws; float* al_l = ws + 32;
  float m_reg = -1e30f, l_reg = 0; f32x16 o[4] = {}; bf16x8 qr[8];
  const bf16_t* Qw = Qb + (long)(wid * QBLK + r32) * LDQ + hi * 8;
  char* qrl = lds + 2 * SHM_V + 2 * SHM_K + NW * 64 * 4 + wid * 4096 + r32 * 128;
#pragma unroll
  for (int d0 = 0; d0 < 8; ++d0) qr[d0] = *reinterpret_cast<const bf16x8*>(Qw + d0 * 16);
#pragma unroll
  for (int d0 = 8; d0 < 12; ++d0) *reinterpret_cast<bf16x8*>(qrl + ((((d0 - 8) * 2 + hi) ^ (r32 & 7)) << 4)) = *reinterpret_cast<const bf16x8*>(Qw + d0 * 16);
  asm volatile("s_waitcnt lgkmcnt(0)" ::: "memory");
  unsigned kgo[3], vgo[2];
#pragma unroll
  for (int i = 0; i < 3; ++i) { const int p = (i * 8 + wid) * 64 + lane, row = p / 24, slot = p % 24, ch = slot ^ (row & 7); kgo[i] = (unsigned)(row * LDK + ch * 8) * 2u; }
#pragma unroll
  for (int i = 0; i < 2; ++i) { const int p = (i * 8 + wid) * 64 + lane, sub = p >> 5, within = p & 31, kk = (sub >> 2) * 8 + (within >> 2), c = (sub & 3) * 32 + (within & 3) * 8;
    const int k = (kk & ~0xC) | ((kk & 4) << 1) | ((kk & 8) >> 1); vgo[i] = (unsigned)(k * LDV + c) * 2u; }
  const int vb0 = (int)(uintptr_t)V_lds + v_rd_base(lane);
  typedef __attribute__((address_space(3))) unsigned lds_u32;
#define DMA_K(b, k0) do { const char* kg = (const char*)Kh + (size_t)(k0) * (LDK * 2); \
    _Pragma("unroll") for (int _i = 0; _i < 3; ++_i) __builtin_amdgcn_global_load_lds((const unsigned*)(kg + kgo[_i]), (lds_u32*)(K_lds + (b) * SHM_K + (_i * 8 + wid) * 1024), 16, 0, 0); } while (0)
#define DMA_V(b, k0) do { const char* vg = (const char*)Vh + (size_t)(k0) * (LDV * 2); \
    _Pragma("unroll") for (int _i = 0; _i < 2; ++_i) __builtin_amdgcn_global_load_lds((const unsigned*)(vg + vgo[_i]), (lds_u32*)(V_lds + (b) * SHM_V + (_i * 8 + wid) * 1024), 16, 0, 0); } while (0)
#define RESC(a) do { if (__any((a) < 1.f)) { if (hi == 0) al_l[r32] = (a); asm volatile("s_waitcnt lgkmcnt(0)" ::: "memory"); \
    for (int d = 0; d < 4; ++d) for (int r = 0; r < 16; ++r) o[d][r] *= al_l[crow(r, hi)]; } } while (0)
#define ENDSTEP() do { asm volatile("s_waitcnt vmcnt(0)" ::: "memory"); __syncthreads(); } while (0)
  f32x16 pA0, pA1, pB0, pB1; float mnA, mnB, alA, alB; bf16x8 pa0, pa1, pa2, pa3; const int NT = seq / KVBLK;
  DMA_K(0, 0); ENDSTEP();
  DMA_K(1, KVBLK); DMA_V(0, 0);
  qkt(pA0, pA1, K_lds, qr, qrl, r32, hi); partialSM(pA0, pA1, m_reg, mnA, alA);
  ENDSTEP();
  for (int j = 1; j + 1 < NT; j += 2) {
    DMA_K(0, (j + 1) * KVBLK); DMA_V(1, j * KVBLK);
    SBAR(); qkt(pB0, pB1, K_lds + SHM_K, qr, qrl, r32, hi);
    finishSM(pA0, pA1, alA, l_reg, pa0, pa1, pa2, pa3); SBAR();
    pv_d0(o, vb0, pa0, pa1, pa2, pa3); partialSM(pB0, pB1, m_reg, mnB, alB);
    RESC(alB); ENDSTEP();
    if (j + 2 < NT) DMA_K(1, (j + 2) * KVBLK);
    DMA_V(0, (j + 1) * KVBLK);
    SBAR(); qkt(pA0, pA1, K_lds, qr, qrl, r32, hi);
    finishSM(pB0, pB1, alB, l_reg, pa0, pa1, pa2, pa3); SBAR();
    pv_d0(o, vb0 + (int)SHM_V, pa0, pa1, pa2, pa3); partialSM(pA0, pA1, m_reg, mnA, alA);
    RESC(alA); ENDSTEP();
  }
  DMA_V(1, (NT - 1) * KVBLK);
  SBAR(); qkt(pB0, pB1, K_lds + SHM_K, qr, qrl, r32, hi);
  finishSM(pA0, pA1, alA, l_reg, pa0, pa1, pa2, pa3); SBAR();
  pv_d0(o, vb0, pa0, pa1, pa2, pa3); partialSM(pB0, pB1, m_reg, mnB, alB);
  RESC(alB); ENDSTEP();
  finishSM(pB0, pB1, alB, l_reg, pa0, pa1, pa2, pa3); SBAR();
  pv_d0(o, vb0 + (int)SHM_V, pa0, pa1, pa2, pa3);
#undef DMA_K
#undef DMA_V
#undef ENDSTEP
  if (hi == 0) li_l[r32] = l_reg; asm volatile("s_waitcnt lgkmcnt(0)" ::: "memory");
  float rli[16];
#pragma unroll
  for (int r = 0; r < 16; ++r) rli[r] = __builtin_amdgcn_rcpf(li_l[crow(r, hi)]);
  bf16_t* Ow = Ob + (long)(wid * QBLK) * LDO;
#pragma unroll
  for (int r = 0; r < 16; ++r) { int orow = crow(r, hi);
#pragma unroll
    for (int d0 = 0; d0 < 4; ++d0) { const float val = o[d0][r] * rli[r]; Ow[(long)orow * LDO + d0 * 32 + r32] = (bf16_t)(cvtpk(val, val) & 0xffff); } }
  __syncthreads();
#undef RESC
}
}
__device__ __forceinline__ f32x2 cmul(f32x2 a, f32x2 b) { return (f32x2){a.x * b.x - a.y * b.y, a.x * b.y + a.y * b.x}; }
__device__ __forceinline__ int rev4_14(int k) { const unsigned r = __brev((unsigned)k) >> 18; return (int)(((r & 0x1555u) << 1) | ((r >> 1) & 0x1555u)); }
#define ZI(i) ((i) + ((i) >> 5))
__device__ __forceinline__ void fft_tw(int j, int q, float sign, f32x2& w1, f32x2& w2, f32x2& w3) {
    const float rev = (float)j / (float)(4 * q); const float sn = __builtin_amdgcn_sinf(rev), cs = __builtin_amdgcn_cosf(rev);
    w1 = (f32x2){cs, sign * sn}; w2 = cmul(w1, w1); w3 = cmul(w2, w1);
}
__device__ __forceinline__ void fft16k_dif(LAS f32x2* Z, int tid) {
#pragma unroll 1
    for (int s = 0; s < 7; ++s) { int lq = 12 - 2 * s; asm volatile("" : "+s"(lq)); const int q = 1 << lq;
        const bool shared = q <= 512; f32x2 w1, w2, w3; fft_tw(tid & (q - 1), q, -1.f, w1, w2, w3);
#pragma unroll 2
        for (int i = 0; i < 8; ++i) { const int b = tid + 512 * i, j = b & (q - 1), base = ((b >> lq) << (lq + 2)) + j;
            const int i0 = ZI(base), i1 = ZI(base + q), i2 = ZI(base + 2 * q), i3 = ZI(base + 3 * q);
            const f32x2 a0 = Z[i0], a1 = Z[i1], a2 = Z[i2], a3 = Z[i3];
            const f32x2 t0 = a0 + a2, t1 = a0 - a2, t2 = a1 + a3, t3 = a1 - a3;
            if (!shared) fft_tw(j, q, -1.f, w1, w2, w3);
            Z[i0] = t0 + t2; Z[i1] = cmul((f32x2){t1.x + t3.y, t1.y - t3.x}, w1); Z[i2] = cmul(t0 - t2, w2); Z[i3] = cmul((f32x2){t1.x - t3.y, t1.y + t3.x}, w3); }
        __syncthreads(); }
}
__device__ __forceinline__ void fft16k_dit_inv(LAS f32x2* Z, int tid) {
#pragma unroll 1
    for (int s = 0; s < 7; ++s) { int lq = 2 * s; asm volatile("" : "+s"(lq)); const int q = 1 << lq;
        const bool shared = q <= 512; f32x2 w1, w2, w3; fft_tw(tid & (q - 1), q, 1.f, w1, w2, w3);
#pragma unroll 2
        for (int i = 0; i < 8; ++i) { const int b = tid + 512 * i, j = b & (q - 1), base = ((b >> lq) << (lq + 2)) + j;
            if (!shared) fft_tw(j, q, 1.f, w1, w2, w3);
            const int i0 = ZI(base), i1 = ZI(base + q), i2 = ZI(base + 2 * q), i3 = ZI(base + 3 * q);
            const f32x2 b0 = Z[i0], b1 = cmul(Z[i1], w1), b2 = cmul(Z[i2], w2), b3 = cmul(Z[i3], w3);
            const f32x2 t0 = b0 + b2, t1 = b0 - b2, t2 = b1 + b3, t3 = b1 - b3;
            Z[i0] = t0 + t2; Z[i1] = (f32x2){t1.x - t3.y, t1.y + t3.x}; Z[i2] = t0 - t2; Z[i3] = (f32x2){t1.x + t3.y, t1.y - t3.x}; }
        __syncthreads(); }
}
constexpr float HY_MIN_DECAY = -3.0701134573253945f, HY_MAX_DECAY = -15.350567286626973f;
__device__ __forceinline__ float hy_delta(int c) { return fabsf(HY_MIN_DECAY + (HY_MAX_DECAY - HY_MIN_DECAY) * ((float)c / 1279.0f)); }
__device__ __forceinline__ float conv3b_at(const bf16_t* PX, int tau, int col, const float* cw, int l, int c) {
    const float* w = cw + (size_t)l * 3 * B_IN;
    return conv3_at(PX, tau, col, w[c], w[B_IN + c], w[2 * B_IN + c]);
}
__device__ __forceinline__ void hyena_taps_unit(const Frame& F, unsigned char* ws, int l, int pair) {
    LAS f32x2* Z = (LAS f32x2*)F.lds; LAS float* red = (LAS float*)(F.lds + LDS_MISC + 128);
    const int tid = F.tid, c0 = 2 * pair;
    const bf16_t* H3x = (const bf16_t*)(ws + WS_H3) + (size_t)l * 64 * T + NCTX;
    f32x2* scr = (f32x2*)(ws + WS_HSCR) + (size_t)pair * 16384; float* htn = (float*)(ws + WS_HSCR + (size_t)640 * 16384 * 8) + 2 * pair;
    LAS f32x4* FW = (LAS f32x4*)(F.lds + LDS_MISC + 256);
    if (tid < 256) { const int j = tid >> 2, q = tid & 3; ((LAS float*)FW)[tid] = IN_(35)[(size_t)l * 64 * 2560 + (size_t)j * 2560 + (q >> 1) * 1280 + c0 + (q & 1)]; }
    __syncthreads();
    const float d0 = hy_delta(c0), d1 = hy_delta(c0 + 1);
#ifndef HYS
#define HYS 31
#endif
    float s0, s1, sc0 = 0.f, sc1 = 0.f;
    {
    s0 = 0.f; s1 = 0.f;
    if (HYS & 1)
#pragma unroll 1
    for (int i = 0; i < 2; ++i) { const int tb = 4096 * i + 8 * tid; const bf16_t* hc = H3x + tb;
        asm volatile("" ::: "memory");
        f32x4 acc[8];
#pragma unroll
        for (int p = 0; p < 8; ++p) acc[p] = (f32x4){0.f, 0.f, 0.f, 0.f};
#pragma unroll 8
        for (int j = 0; j < 64; ++j) { const f32x4 w = FW[j]; const u32x4 hv = *(const u32x4*)(hc + (size_t)j * T);
#pragma unroll
            for (int p = 0; p < 4; ++p) { acc[2 * p] += w * __uint_as_float(hv[p] << 16); acc[2 * p + 1] += w * __uint_as_float(hv[p] & 0xffff0000u); } }
#pragma unroll
        for (int p = 0; p < 8; ++p) { const int t = tb + p;
            const float tl = (float)t * (1.0f / 8191.0f), e0 = __expf(-tl * d0), e1 = __expf(-tl * d1);
            const float f0 = acc[p].x * e0, f1 = acc[p].y * e1, b0 = acc[p].z * e0, b1 = acc[p].w * e1;
            Z[ZI(t)] = (f32x2){f0, f1}; s0 += fabsf(f0); s1 += fabsf(f1);
            if (t < 8191) { Z[ZI(16383 - t)] = (f32x2){b0, b1}; s0 += fabsf(b0); s1 += fabsf(b1); } } }
    if (tid == 0) { float zz = 0.f; asm volatile("" : "+v"(zz)); Z[ZI(8192)] = (f32x2){zz, zz}; }
    s0 = wave_sum(s0); s1 = wave_sum(s1);
    if (F.lane == 0) { red[F.wave * 2] = s0; red[F.wave * 2 + 1] = s1; }
    __syncthreads();
    float n0 = 0.f, n1 = 0.f;
#pragma unroll
    for (int w = 0; w < 8; ++w) { n0 += red[2 * w]; n1 += red[2 * w + 1]; }
    sc0 = 1.0f / (16384.0f * n0); sc1 = 1.0f / (16384.0f * n1);
    if (HYS & 2) fft16k_dif(Z, tid);
#pragma unroll 4
    for (int i = 0; i < 32; ++i) scr[tid + 512 * i] = Z[ZI(tid + 512 * i)];
    __syncthreads();
    }
    if (tid == 0) { htn[0] = sc0; htn[1] = sc1; }
    __syncthreads();
}
__device__ __forceinline__ void hyena_unit(const Frame& F, unsigned char* ws, int l, int pair) {
    LAS f32x2* Z = (LAS f32x2*)F.lds;
    const int tid = F.tid, c0 = 2 * pair;
    float* GT = (float*)(ws + WS_GT); const float* X0T = (const float*)(ws + WS_X0T);
    const f32x2* scr = (const f32x2*)(ws + WS_HSCR) + (size_t)pair * 16384; const float* htn = (const float*)(ws + WS_HSCR + (size_t)640 * 16384 * 8) + 2 * pair;
    const float sc0 = htn[0], sc1 = htn[1];
#ifndef HYS
#define HYS 31
#endif
    for (int rp15 = 0; rp15 < REP(15); ++rp15) {
    const float* g0p = GT + (size_t)c0 * T + NCTX; const float* g1p = g0p + T;
    { float zz = 0.f; asm volatile("" : "+v"(zz));
#pragma unroll 4
      for (int i = 0; i < 16; ++i) { const int t = tid + 512 * i; Z[ZI(t)] = (f32x2){g0p[t], g1p[t]}; Z[ZI(8192 + t)] = (f32x2){zz, zz}; } }
    __syncthreads();
    if (HYS & 2) fft16k_dif(Z, tid);
    if (HYS & 8)
#pragma unroll 2
    for (int i = 0; i < 17; ++i) { const int k = tid + 512 * i; if (i == 16 && tid != 0) break;
        const int pk = rev4_14(k & 16383), pn = rev4_14((16384 - k) & 16383);
        const f32x2 A = Z[ZI(pk)], B = Z[ZI(pn)], At = scr[pk], Bt = scr[pn];
        const f32x2 G0 = (f32x2){0.5f * (A.x + B.x), 0.5f * (A.y - B.y)}, G1 = (f32x2){0.5f * (A.y + B.y), -0.5f * (A.x - B.x)};
        const f32x2 H0 = (f32x2){0.5f * (At.x + Bt.x), 0.5f * (At.y - Bt.y)}, H1 = (f32x2){0.5f * (At.y + Bt.y), -0.5f * (At.x - Bt.x)};
        const f32x2 P0 = cmul(G0, H0), P1 = cmul(G1, H1);
        Z[ZI(pk)] = (f32x2){P0.x - P1.y, P0.y + P1.x};
        if (pn != pk) Z[ZI(pn)] = (f32x2){P0.x + P1.y, P1.x - P0.y}; }
    __syncthreads();
    if (HYS & 2) fft16k_dit_inv(Z, tid);
    }
    const float bb0 = IN_(37)[l * 1280 + c0], bb1 = IN_(37)[l * 1280 + c0 + 1];
    { float* y0p = GT + (size_t)c0 * T + NCTX; float* y1p = y0p + T; const float* x0p = X0T + (size_t)c0 * T + NCTX; const float* x1p = x0p + T;
#pragma unroll 4
      for (int i = 0; i < 16; ++i) { const int t = tid + 512 * i; const f32x2 z = Z[ZI(t)]; const float ga = y0p[t], gb = y1p[t];
          y0p[t] = x0p[t] * (z.x * sc0 + ga * bb0); y1p[t] = x1p[t] * (z.y * sc1 + gb * bb1); } }
    __syncthreads();
}
__device__ __forceinline__ void hyena_ctx_unit(const Frame& F, unsigned char* ws, int l, int unit) {
    LAS float* TF = (LAS float*)F.lds; LAS float* TB = TF + 2048; LAS float* GG = TB + 2048;
    const int tid = F.tid, t = tid >> 1, cc = (tid & 1) * 4, cbase = unit * 8 + cc;
    const bf16_t* H3c = (const bf16_t*)(ws + WS_H3) + (size_t)l * 64 * T; float* GT = (float*)(ws + WS_GT); const float* X0T = (const float*)(ws + WS_X0T);
    { float f[4] = {0.f, 0.f, 0.f, 0.f}, b[4] = {0.f, 0.f, 0.f, 0.f};
      const float* wbase = IN_(35) + (size_t)l * 64 * 2560 + cbase;
      for (int j = 0; j < 64; ++j) { const float hv = bf2f(H3c[(size_t)j * T + t]); const float* wrow = wbase + (size_t)j * 2560;
#pragma unroll
          for (int q = 0; q < 4; ++q) { f[q] += hv * wrow[q]; b[q] += hv * wrow[1280 + q]; } }
      const float tl = (float)t * (1.0f / 255.0f);
#pragma unroll
      for (int q = 0; q < 4; ++q) { const float e = __expf(-tl * hy_delta(cbase + q)); TF[t * 8 + cc + q] = f[q] * e; TB[t * 8 + cc + q] = b[q] * e; GG[t * 8 + cc + q] = GT[(size_t)(cbase + q) * T + t]; } }
    __syncthreads();
    float nrm[4] = {0.f, 0.f, 0.f, 0.f}, y[4] = {0.f, 0.f, 0.f, 0.f};
    for (int s = 0; s < 256; ++s) {
#pragma unroll
        for (int q = 0; q < 4; ++q) { nrm[q] += fabsf(TF[s * 8 + cc + q]) + (s < 255 ? fabsf(TB[s * 8 + cc + q]) : 0.f);
            const int o = t - s; const float tap = o >= 0 ? TF[o * 8 + cc + q] : TB[(-o - 1) * 8 + cc + q];
            y[q] += tap * GG[s * 8 + cc + q]; } }
    __syncthreads();
#pragma unroll
    for (int q = 0; q < 4; ++q) GT[(size_t)(cbase + q) * T + t] = X0T[(size_t)(cbase + q) * T + t] * (y[q] / nrm[q] + GG[t * 8 + cc + q] * IN_(37)[l * 1280 + cbase + q]);
    __syncthreads();
}
constexpr int SC_C = 16, SC_NCHUNK = T / SC_C, SC_CHUNK_BYTES = 14 * 1024;
__device__ __forceinline__ int sc_tau(int d, int c, int t) { return d == 0 ? SC_C * c + t : (c < NCTX / SC_C ? NCTX - 1 - SC_C * c - t : T - 1 - SC_C * (c - NCTX / SC_C) - t); }
__device__ __forceinline__ int sc_perm(int e, int hi) { return (e & 3) + 8 * (e >> 2) + 4 * hi; }
constexpr size_t WS_FR_BYTES = (size_t)2 * NHA * SC_NCHUNK * SC_CHUNK_BYTES;

typedef short sc_bf16x8 __attribute__((ext_vector_type(8)));
typedef float sc_f32x16 __attribute__((ext_vector_type(16)));
__device__ __forceinline__ sc_bf16x8 sc_pack8(const sc_f32x16& a, int base) {
    u32x4 w; w.x = cvt_pk_bf16(a[base + 0], a[base + 1]); w.y = cvt_pk_bf16(a[base + 2], a[base + 3]); w.z = cvt_pk_bf16(a[base + 4], a[base + 5]); w.w = cvt_pk_bf16(a[base + 6], a[base + 7]);
    return *reinterpret_cast<sc_bf16x8*>(&w);
}
constexpr int SC_NSLOT = 9, SC_AHEAD = 7;
__device__ __forceinline__ void scan_chain_mfma(const Frame& F, unsigned char* ws, int chain) {
    const int h = chain >> 1, d = chain & 1, lane = F.lane, n = lane & 31, hi = lane >> 5, ib = F.wave;
    const unsigned char* FRc = ws + WS_FR + (size_t)chain * SC_NCHUNK * SC_CHUNK_BYTES;
    float* Yd = (float*)(ws + WS_Y) + (size_t)d * T * A_W + h * 64;
    LAS unsigned char* buf = F.lds;
    typedef __attribute__((address_space(3))) unsigned sc_lds_u32;
#define SCM_DMA(c_) do { if (ib < 7) { const unsigned char* src_ = FRc + (size_t)(c_) * SC_CHUNK_BYTES; LAS unsigned char* dst_ = buf + ((c_) % SC_NSLOT) * SC_CHUNK_BYTES; \
        _Pragma("unroll") for (int i_ = 0; i_ < 2; ++i_) __builtin_amdgcn_global_load_lds((const unsigned*)(src_ + (i_ * 7 + ib) * 1024 + lane * 16), (sc_lds_u32*)(dst_ + (i_ * 7 + ib) * 1024), 16, 0, 0); } } while (0)
    sc_f32x16 S0 = {}, S1 = {};
    int yoff[8];
#pragma unroll
    for (int r = 0; r < 8; ++r) { const int t = (r & 3) + 8 * (r >> 2) + 4 * hi; yoff[r] = (d ? -t : t) * A_W + 32 * ib + n; }
    __syncthreads();
#pragma unroll
    for (int c = 0; c < SC_AHEAD; ++c) SCM_DMA(c);
    asm volatile("s_waitcnt vmcnt(12)" ::: "memory"); __builtin_amdgcn_s_barrier(); asm volatile("" ::: "memory");
#pragma unroll 1
    for (int c = 0; c < SC_NCHUNK; ++c) {
        const bool steady = c + SC_AHEAD < SC_NCHUNK;
        if (steady) SCM_DMA(c + SC_AHEAD);
        if (ib < 2) {
                const LAS unsigned char* fb = buf + (c % SC_NSLOT) * SC_CHUNK_BYTES;
                sc_bf16x8 fr[11]; sc_bf16x8 vf; f32x4 gt[8];
                { const unsigned fa = (unsigned)(uintptr_t)fb + lane * 16, va = fa + (11 + ib) * 1024, ga = (unsigned)(uintptr_t)fb + 13 * 1024 + hi * 128;
#define SC_DSRD(dst, addr, off) asm volatile("ds_read_b128 %0, %1 offset:%2" : "=v"(dst) : "v"(addr), "i"(off))
                  SC_DSRD(fr[0], fa, 0); SC_DSRD(fr[1], fa, 1024); SC_DSRD(fr[2], fa, 2048); SC_DSRD(fr[3], fa, 3072); SC_DSRD(fr[4], fa, 4096); SC_DSRD(fr[5], fa, 5120);
                  SC_DSRD(fr[6], fa, 6144); SC_DSRD(fr[7], fa, 7168); SC_DSRD(fr[8], fa, 8192); SC_DSRD(fr[9], fa, 9216); SC_DSRD(fr[10], fa, 10240); SC_DSRD(vf, va, 0);
                  SC_DSRD(gt[0], ga, 0); SC_DSRD(gt[1], ga, 16); SC_DSRD(gt[2], ga, 32); SC_DSRD(gt[3], ga, 48); SC_DSRD(gt[4], ga, 64); SC_DSRD(gt[5], ga, 80); SC_DSRD(gt[6], ga, 96); SC_DSRD(gt[7], ga, 112);
#undef SC_DSRD
                  asm volatile("s_waitcnt lgkmcnt(0)" : "+v"(fr[0]), "+v"(fr[1]), "+v"(fr[2]), "+v"(fr[3]), "+v"(fr[4]), "+v"(fr[5]), "+v"(fr[6]), "+v"(fr[7]), "+v"(fr[8]), "+v"(fr[9]), "+v"(fr[10]), "+v"(vf) :: "memory");
                  asm volatile("" : "+v"(gt[0]), "+v"(gt[1]), "+v"(gt[2]), "+v"(gt[3]), "+v"(gt[4]), "+v"(gt[5]), "+v"(gt[6]), "+v"(gt[7])); }
                const sc_bf16x8 sb00 = sc_pack8(S0, 0), sb01 = sc_pack8(S0, 8), sb10 = sc_pack8(S1, 0), sb11 = sc_pack8(S1, 8);
                sc_f32x16 P = {}, P2 = {};
                P = __builtin_amdgcn_mfma_f32_32x32x16_bf16(fr[0], sb00, P, 0, 0, 0);
                P2 = __builtin_amdgcn_mfma_f32_32x32x16_bf16(fr[2], sb10, P2, 0, 0, 0);
                P = __builtin_amdgcn_mfma_f32_32x32x16_bf16(fr[1], sb01, P, 0, 0, 0);
                P2 = __builtin_amdgcn_mfma_f32_32x32x16_bf16(fr[3], sb11, P2, 0, 0, 0);
                P = __builtin_amdgcn_mfma_f32_32x32x16_bf16(fr[4], vf, P, 0, 0, 0);
#pragma unroll
                for (int q = 0; q < 4; ++q)
#pragma unroll
                    for (int e = 0; e < 4; ++e) { S0[4 * q + e] *= gt[q][e]; S1[4 * q + e] *= gt[4 + q][e]; }
                S0 = __builtin_amdgcn_mfma_f32_32x32x16_bf16(fr[8], vf, S0, 0, 0, 0);
                S1 = __builtin_amdgcn_mfma_f32_32x32x16_bf16(fr[10], vf, S1, 0, 0, 0);
#pragma unroll
                for (int r = 0; r < 16; ++r) P[r] += P2[r];
                const sc_bf16x8 xb = sc_pack8(P, 0);
                sc_f32x16 U = {};
                U = __builtin_amdgcn_mfma_f32_32x32x16_bf16(fr[5], xb, U, 0, 0, 0);
                const sc_bf16x8 ub = sc_pack8(U, 0);
                S0 = __builtin_amdgcn_mfma_f32_32x32x16_bf16(fr[7], ub, S0, 0, 0, 0);
                S1 = __builtin_amdgcn_mfma_f32_32x32x16_bf16(fr[9], ub, S1, 0, 0, 0);
                P = __builtin_amdgcn_mfma_f32_32x32x16_bf16(fr[6], ub, P, 0, 0, 0);
                float* yb = Yd + (size_t)sc_tau(d, c, 0) * A_W;
#pragma unroll
                for (int r = 0; r < 8; ++r) yb[yoff[r]] = P[8 + r];
        }
        if (steady) asm volatile("s_waitcnt vmcnt(12)" ::: "memory"); else asm volatile("s_waitcnt vmcnt(0)" ::: "memory");
        asm volatile("s_waitcnt lgkmcnt(0)" ::: "memory"); __builtin_amdgcn_s_barrier(); asm volatile("" ::: "memory");
    }
    asm volatile("s_waitcnt vmcnt(0)" ::: "memory"); __syncthreads();
#undef SCM_DMA
}
__device__ __forceinline__ float conv3_u(const float* PX, int tau, unsigned ucol, float w0, float w1, float w2) {
    const float* p = PX + (size_t)tau * PXW;
    float y = p[ucol] * w1;
    if (has_left(tau)) y += (p - PXW)[ucol] * w0;
    if (has_right(tau)) y += (p + PXW)[ucol] * w2;
    return y;
}
constexpr int WLR_K = 448;
constexpr int RP_WAVE_LDS = 16896;
typedef short rp_bf16x8 __attribute__((ext_vector_type(8)));
typedef float rp_f32x16 __attribute__((ext_vector_type(16)));
__device__ __forceinline__ unsigned short f2bf16(float x) { return (unsigned short)(cvt_pk_bf16(x, x) & 0xffffu); }
template <int NKB, class AF>
__device__ __forceinline__ void rp_lowrank(float (&dst)[16], const AF& afrag, const bf16_t* WLRh, int kw0, int n, int hi) {
    rp_f32x16 c0 = {}, c1 = {}; const bf16_t* wb0 = WLRh + (size_t)n * WLR_K + kw0 + 8 * hi; const bf16_t* wb1 = wb0 + (size_t)32 * WLR_K;
#pragma unroll
    for (int kb = 0; kb < NKB; ++kb) { const rp_bf16x8 b0 = *(const rp_bf16x8*)(wb0 + 16 * kb), b1 = *(const rp_bf16x8*)(wb1 + 16 * kb); const rp_bf16x8 a_ = afrag(kb);
        c0 = __builtin_amdgcn_mfma_f32_32x32x16_bf16(a_, b0, c0, 0, 0, 0); c1 = __builtin_amdgcn_mfma_f32_32x32x16_bf16(a_, b1, c1, 0, 0, 0); }
#pragma unroll
    for (int r = 0; r < 8; ++r) { auto sw = __builtin_amdgcn_permlane32_swap(__float_as_uint(c0[r]), __float_as_uint(c1[r]), false, false);
        dst[(r & 3) + 8 * (r >> 2)] = __uint_as_float(sw[0]); dst[(r & 3) + 8 * (r >> 2) + 4] = __uint_as_float(sw[1]); }
}
struct RpAfLds { const LAS bf16_t* base; __device__ __forceinline__ rp_bf16x8 operator()(int kb) const { return *(const LAS rp_bf16x8*)(base + 16 * kb); } };
__device__ __forceinline__ void rwkv_elem_phase(const Frame& F, unsigned char* ws, int l) {
    const float* PX = (const float*)(ws + WS_PX); float* SS = (float*)(ws + WS_SS); float* SD = (float*)(ws + WS_SD); float* GB = (float*)(ws + WS_G);
    const bf16_t* WLR = (const bf16_t*)(ws + WS_WLR) + (size_t)l * A_W * WLR_K;
    const float* cw = IN_(16) + (size_t)l * 3 * A_IN;
    LAS bf16_t* ACT = (LAS bf16_t*)(F.lds + F.wave * 10752);
    const int lane = F.lane, n = lane & 31, hi = lane >> 5;
    const int gw = F.bid * 8 + F.wave, NGW = F.G * 8;
    for (int it = gw; it < (T / 16) * 10; it += NGW) {
        const int tg = it / 10, hq = it % 10, tau0 = tg * 16;
        asm volatile("s_waitcnt lgkmcnt(0)" ::: "memory");
        const float* prow0 = PX + (size_t)(tau0 > 0 ? tau0 - 1 : 0) * PXW; const int roff = tau0 > 0 ? 0 : -1;
#define RP_WIN(x, ucol_) do { _Pragma("unroll") for (int i_ = 0; i_ < 18; ++i_) { int ri_ = i_ + roff; ri_ = ri_ < 0 ? 0 : ri_; ri_ = (tau0 - 1 + i_ > T - 1) ? (T - 1 - (tau0 > 0 ? tau0 - 1 : 0)) : ri_; x[i_] = (prow0 + (size_t)ri_ * PXW)[ucol_]; } } while (0)
#define RP_CONV(x, t_, w0_, w1_, w2_) (x[(t_)] * (has_left(tau0 + (t_)) ? (w0_) : 0.f) + x[(t_) + 1] * (w1_) + x[(t_) + 2] * (has_right(tau0 + (t_)) ? (w2_) : 0.f))
#pragma unroll
        for (int i = 0; i < 5; ++i) { const int c = lane + 64 * i, col = 3840 + c; const float c0 = cw[col], c1 = cw[A_IN + col], c2 = cw[2 * A_IN + col];
            float x[18]; RP_WIN(x, (unsigned)(PXA + col));
#pragma unroll
            for (int t = 0; t < 16; ++t) { const float val = RP_CONV(x, t, c0, c1, c2);
                const float act = i == 0 ? 1.0f - 2.0f / (1.0f + __expf(2.0f * val)) : (i == 1 ? val : sigmoidf_(val));
                ACT[t * 328 + c] = f2bf16(act); } }
        asm volatile("s_waitcnt lgkmcnt(0)" ::: "memory");
        const RpAfLds afw{ACT + (n & 15) * 328 + 8 * hi}, afa{ACT + (n & 15) * 328 + 64 + 8 * hi}, afg{ACT + (n & 15) * 328 + 128 + 8 * hi};
#pragma unroll 1
        for (int hh = 0; hh < 2; ++hh) {
            const int h = hq * 2 + hh, col = h * 64 + lane; const bf16_t* WLRh = WLR + (size_t)h * 64 * WLR_K;
            { float lg[16]; rp_lowrank<12>(lg, afg, WLRh, 256, n, hi);
#pragma unroll
              for (int t = 0; t < 16; ++t) GB[(size_t)(tau0 + t) * A_W + col] = lg[t]; }
            const float cr0 = cw[col], cr1 = cw[A_IN + col], cr2 = cw[2 * A_IN + col];
            const float ck0 = cw[A_W + col], ck1 = cw[A_IN + A_W + col], ck2 = cw[2 * A_IN + A_W + col];
            const float cv0 = cw[2 * A_W + col], cv1 = cw[A_IN + 2 * A_W + col], cv2 = cw[2 * A_IN + 2 * A_W + col];
            const float kk_w = IN_(22)[l * A_W + col], ka_w = IN_(23)[l * A_W + col];
            float kkv[16], kv[16];
            { float xr[18], xk[18], xv[18]; const unsigned uc = (unsigned)(PXA + col); RP_WIN(xr, uc); RP_WIN(xk, uc + A_W); RP_WIN(xv, uc + 2 * A_W);
#pragma unroll
              for (int t = 0; t < 16; ++t) { const int tau = tau0 + t;
                  const float r = RP_CONV(xr, t, cr0, cr1, cr2), v = RP_CONV(xv, t, cv0, cv1, cv2); kv[t] = RP_CONV(xk, t, ck0, ck1, ck2);
                  const float kr = kv[t] * kk_w; const float nrm = sqrtf(wave_sum(kr * kr)); kkv[t] = kr / fmaxf(nrm, 1e-12f);
                  float* ss = SS + ((size_t)h * T + tau) * 192 + lane; ss[0] = kkv[t]; ss[64] = r; ss[128] = v; } }
#pragma unroll 1
            for (int d = 0; d < 2; ++d) { const float w0b = IN_(17)[(l * 2 + d) * A_W + col], a0b = IN_(19)[(l * 2 + d) * A_W + col]; float lw[16], la[16];
                rp_lowrank<4>(lw, afw, WLRh, 64 * d, n, hi); rp_lowrank<4>(la, afa, WLRh, 128 + 64 * d, n, hi);
#pragma unroll
                for (int t = 0; t < 16; ++t) { const float z = w0b + lw[t]; const float decay = __expf(-__expf(-(fmaxf(-z, 0.f) + __logf(1.0f + __expf(-fabsf(z)))) - 0.5f)); const float av = sigmoidf_(a0b + la[t]);
                    float* sd = SD + (((size_t)h * 2 + d) * T + tau0 + t) * 192 + lane; sd[0] = decay; sd[64] = kkv[t] * av; sd[128] = kv[t] * (1.0f + (av - 1.0f) * ka_w); } }
        }
    }
}
#undef RP_WIN
#undef RP_CONV
constexpr int SP_WAVE_LDS = 16640;
__device__ __forceinline__ void scan_prep_phase(const Frame& F, unsigned char* ws) {
    const float* SS = (const float*)(ws + WS_SS); const float* SD = (const float*)(ws + WS_SD); unsigned char* FR = ws + WS_FR;
    LAS bf16_t* R1 = (LAS bf16_t*)(F.lds + F.wave * SP_WAVE_LDS); LAS bf16_t* R2 = R1 + 32 * 72; LAS bf16_t* BbT = R2 + 32 * 72; LAS bf16_t* KbT = BbT + 64 * 16; LAS bf16_t* VT = KbT + 64 * 16; LAS float* Lm = (LAS float*)(VT + 64 * 16);
    const int lane = F.lane, n = lane & 31, hi = lane >> 5;
    const int gw = F.bid * 8 + F.wave, NGW = F.G * 8;
    for (int it = gw; it < 2 * NHA * SC_NCHUNK; it += NGW) {
        const int chain = it / SC_NCHUNK, c = it % SC_NCHUNK, h = chain >> 1, d = chain & 1;
        const int tau_first = sc_tau(d, c, 0), dstep = d ? -1 : 1;
        const float* ssb = SS + (size_t)h * T * 192 + lane; const float* sdb = SD + ((size_t)h * 2 + d) * T * 192 + lane;
        float xw[16], xb[16], xk[16], xkk[16], xr[16], xv[16];
#pragma unroll
        for (int s = 0; s < 16; ++s) { const size_t o = (size_t)(tau_first + dstep * s) * 192; xw[s] = sdb[o]; xb[s] = sdb[o + 64]; xk[s] = sdb[o + 128]; xkk[s] = ssb[o]; xr[s] = ssb[o + 64]; xv[s] = ssb[o + 128]; }
        float gC = 1.f;
#pragma unroll
        for (int s = 0; s < 16; ++s) gC *= xw[s];
        float g = 1.f;
#pragma unroll
        for (int s = 0; s < 16; ++s) {
            const float gm1 = g; g *= xw[s]; const float ig = 1.0f / g; const float bh = xb[s] * ig, kh = xk[s] * ig;
            R1[s * 72 + lane] = f2bf16(-xkk[s] * gm1); R1[(16 + s) * 72 + lane] = f2bf16(xr[s] * g);
            R2[s * 72 + lane] = f2bf16(bh); R2[(16 + s) * 72 + lane] = f2bf16(kh);
            BbT[lane * 16 + s] = f2bf16(bh * gC); KbT[lane * 16 + s] = f2bf16(kh * gC); VT[lane * 16 + s] = f2bf16(xv[s]); }
        asm volatile("s_waitcnt lgkmcnt(0)" ::: "memory");
        unsigned char* dst = FR + ((size_t)chain * SC_NCHUNK + c) * SC_CHUNK_BYTES;
        rp_f32x16 C = {};
#pragma unroll
        for (int kb = 0; kb < 4; ++kb) { const rp_bf16x8 a_ = *(const LAS rp_bf16x8*)(R2 + n * 72 + 16 * kb + 8 * hi), b_ = *(const LAS rp_bf16x8*)(R1 + n * 72 + 16 * kb + 8 * hi);
            C = __builtin_amdgcn_mfma_f32_32x32x16_bf16(a_, b_, C, 0, 0, 0); }
        const int tt_ = n & 15; const bool incl = n >= 16;
#pragma unroll
        for (int r = 0; r < 16; ++r) { const int s = ((r & 7) & 3) + 8 * ((r & 7) >> 2) + 4 * hi; if (!(s < tt_ || (incl && s == tt_))) C[r] = 0.f; }
        if (n < 16) {
#pragma unroll
            for (int r = 0; r < 8; ++r) Lm[((r & 3) + 8 * (r >> 2) + 4 * hi) * 20 + n] = C[r]; }
        { u32x4 f4; f4.x = cvt_pk_bf16(C[8], C[9]); f4.y = cvt_pk_bf16(C[10], C[11]); f4.z = cvt_pk_bf16(C[12], C[13]); f4.w = cvt_pk_bf16(C[14], C[15]);
          u32x4 f6; f6.x = cvt_pk_bf16(C[0], C[1]); f6.y = cvt_pk_bf16(C[2], C[3]); f6.z = cvt_pk_bf16(C[4], C[5]); f6.w = cvt_pk_bf16(C[6], C[7]);
          if (n < 16) f6 = (u32x4){0u, 0u, 0u, 0u};
          *(u32x4*)(dst + 4 * 1024 + lane * 16) = f4; *(u32x4*)(dst + 6 * 1024 + lane * 16) = f6; }
        asm volatile("s_waitcnt lgkmcnt(0)" ::: "memory");
        { float Tc[16];
#pragma unroll
          for (int s = 15; s >= 0; --s) { float acc = (s == n) ? 1.f : 0.f;
#pragma unroll
              for (int u = s + 1; u < 16; ++u) acc += Lm[s * 20 + u] * Tc[u];
              Tc[s] = acc; }
          u32x4 f5; f5.x = cvt_pk_bf16(hi ? Tc[4] : Tc[0], hi ? Tc[5] : Tc[1]); f5.y = cvt_pk_bf16(hi ? Tc[6] : Tc[2], hi ? Tc[7] : Tc[3]);
          f5.z = cvt_pk_bf16(hi ? Tc[12] : Tc[8], hi ? Tc[13] : Tc[9]); f5.w = cvt_pk_bf16(hi ? Tc[14] : Tc[10], hi ? Tc[15] : Tc[11]);
          if (n >= 16) f5 = (u32x4){0u, 0u, 0u, 0u};
          *(u32x4*)(dst + 5 * 1024 + lane * 16) = f5; }
#pragma unroll
        for (int f = 0; f < 4; ++f) { const u32x2 p0 = *(const LAS u32x2*)(R1 + n * 72 + 16 * f + 4 * hi), p1 = *(const LAS u32x2*)(R1 + n * 72 + 16 * f + 8 + 4 * hi);
            *(u32x4*)(dst + f * 1024 + lane * 16) = (u32x4){p0.x, p0.y, p1.x, p1.y}; }
#pragma unroll
        for (int jb = 0; jb < 2; ++jb) { const int row = 32 * jb + n;
            const u32x2 b0 = *(const LAS u32x2*)(BbT + row * 16 + 4 * hi), b1 = *(const LAS u32x2*)(BbT + row * 16 + 8 + 4 * hi), k0 = *(const LAS u32x2*)(KbT + row * 16 + 4 * hi), k1 = *(const LAS u32x2*)(KbT + row * 16 + 8 + 4 * hi);
            const u32x2 v0 = *(const LAS u32x2*)(VT + row * 16 + 4 * hi), v1 = *(const LAS u32x2*)(VT + row * 16 + 8 + 4 * hi);
            *(u32x4*)(dst + (7 + 2 * jb) * 1024 + lane * 16) = (u32x4){b0.x, b0.y, b1.x, b1.y}; *(u32x4*)(dst + (8 + 2 * jb) * 1024 + lane * 16) = (u32x4){k0.x, k0.y, k1.x, k1.y};
            *(u32x4*)(dst + (11 + jb) * 1024 + lane * 16) = (u32x4){v0.x, v0.y, v1.x, v1.y}; }
        { const int jj = lane & 31; ((float*)(dst + 13 * 1024))[((jj >> 2) & 1) * 32 + (lane >> 5) * 16 + (jj & 3) + 4 * (jj >> 3)] = gC; }
        asm volatile("s_waitcnt lgkmcnt(0)" ::: "memory");
    }
}
constexpr int RF_ACT_BYTES = 16 * 320 * 2;
__device__ __forceinline__ void rwkv_fused_phase(const Frame& F, unsigned char* ws, int l) {
    const bf16_t* PX = (const bf16_t*)(ws + WS_PX); unsigned char* FR = ws + WS_FR;
    float* GB = (float*)(ws + WS_G); float* VB = (float*)(ws + WS_SS) + (size_t)T * A_W; float* BS = (float*)(ws + WS_SD);
    const bf16_t* WLR = (const bf16_t*)(ws + WS_WLR) + (size_t)l * A_W * WLR_K;
    const float* cw = IN_(16) + (size_t)l * 3 * A_IN;
    LAS bf16_t* ACT = (LAS bf16_t*)F.lds;
    LAS bf16_t* R1 = (LAS bf16_t*)(F.lds + RF_ACT_BYTES + F.wave * SP_WAVE_LDS); LAS bf16_t* R2 = R1 + 32 * 72; LAS bf16_t* BbT = R2 + 32 * 72; LAS bf16_t* KbT = BbT + 64 * 16; LAS bf16_t* VT = KbT + 64 * 16; LAS float* Lm = (LAS float*)(VT + 64 * 16);
    const int lane = F.lane, n = lane & 31, hi = lane >> 5, hh = F.wave >> 1, d = F.wave & 1;
    for (int it = F.bid; it < (T / 16) * 5; it += F.G) {
        const int tg = it / 5, hg = it % 5, tau0 = tg * 16, h = hg * 4 + hh, col = h * 64 + lane;
        const bf16_t* prow0 = PX + (size_t)(tau0 > 0 ? tau0 - 1 : 0) * PXW; const int roff = tau0 > 0 ? 0 : -1;
#define RP_WIN(x, ucol_) do { _Pragma("unroll") for (int i_ = 0; i_ < 18; ++i_) { int ri_ = i_ + roff; ri_ = ri_ < 0 ? 0 : ri_; ri_ = (tau0 - 1 + i_ > T - 1) ? (T - 1 - (tau0 > 0 ? tau0 - 1 : 0)) : ri_; x[i_] = bf2f((prow0 + (size_t)ri_ * PXW)[ucol_]); } } while (0)
#define RP_CONV(x, t_, w0_, w1_, w2_) (x[(t_)] * (has_left(tau0 + (t_)) ? (w0_) : 0.f) + x[(t_) + 1] * (w1_) + x[(t_) + 2] * (has_right(tau0 + (t_)) ? (w2_) : 0.f))
        float wr_[18], wk_[18], wv_[18]; { const unsigned uc = (unsigned)(PXA + col); RP_WIN(wr_, uc); RP_WIN(wk_, uc + A_W); RP_WIN(wv_, uc + 2 * A_W); }
        const float cr0 = cw[col], cr1 = cw[A_IN + col], cr2 = cw[2 * A_IN + col], ck0 = cw[A_W + col], ck1 = cw[A_IN + A_W + col], ck2 = cw[2 * A_IN + A_W + col];
        const float cv0 = cw[2 * A_W + col], cv1 = cw[A_IN + 2 * A_W + col], cv2 = cw[2 * A_IN + 2 * A_W + col], kk_w = IN_(22)[l * A_W + col];
        __syncthreads();
        { int tq = F.tid; asm volatile("" : "+v"(tq));
#pragma unroll
          for (int i = 0; i < 3; ++i) { const int item = tq + 512 * i;
              if (item < 16 * 80) { const int t = item / 80, c = 4 * (item % 80), cc = 3840 + c, tau = tau0 + t;
                  const bf16_t* p = PX + (size_t)tau * PXW + PXA + cc; const bool hl = has_left(tau), hr = has_right(tau);
                  const f32x4 x1 = bf4f(*(const u32x2*)p), x0 = bf4f(*(const u32x2*)(p - (hl ? PXW : 0))), x2 = bf4f(*(const u32x2*)(p + (hr ? PXW : 0)));
                  const f32x4 w0 = *(const f32x4*)(cw + cc), w1 = *(const f32x4*)(cw + A_IN + cc), w2 = *(const f32x4*)(cw + 2 * A_IN + cc);
                  const f32x4 val = x1 * w1 + x0 * (w0 * (hl ? 1.f : 0.f)) + x2 * (w2 * (hr ? 1.f : 0.f));
                  f32x4 act;
#pragma unroll
                  for (int e = 0; e < 4; ++e) act[e] = c < 64 ? 1.0f - 2.0f / (1.0f + __expf(2.0f * val[e])) : (c < 128 ? val[e] : sigmoidf_(val[e]));
                  u32x2 o; o.x = cvt_pk_bf16(act.x, act.y); o.y = cvt_pk_bf16(act.z, act.w);
                  *(LAS u32x2*)(ACT + t * 320 + c) = o; } } }
        __syncthreads();
        const bf16_t* WLRh = WLR + (size_t)h * 64 * WLR_K;
        const RpAfLds afw{ACT + (n & 15) * 320 + 8 * hi}, afa{ACT + (n & 15) * 320 + 64 + 8 * hi}, afg{ACT + (n & 15) * 320 + 128 + 8 * hi};
        float xw[16], xb[16], xk[16], xkk[16], xr[16], xv[16];
        {
          if (d == 0) { float lg[16]; rp_lowrank<12>(lg, afg, WLRh, 256, n, hi);
#pragma unroll
              for (int t = 0; t < 16; ++t) GB[(size_t)(tau0 + t) * A_W + col] = lg[t]; }
#pragma unroll
          for (int t = 0; t < 16; ++t) { xr[t] = RP_CONV(wr_, t, cr0, cr1, cr2); xv[t] = RP_CONV(wv_, t, cv0, cv1, cv2); xk[t] = RP_CONV(wk_, t, ck0, ck1, ck2);
              const float kr = xk[t] * kk_w; const float nrm = sqrtf(wave_sum(kr * kr)); xkk[t] = kr / fmaxf(nrm, 1e-12f); } }
        if (d == 0) {
#pragma unroll
            for (int t = 0; t < 16; ++t) VB[(size_t)(tau0 + t) * A_W + col] = xv[t]; }
        { const float ka_w = IN_(23)[l * A_W + col], w0b = IN_(17)[(l * 2 + d) * A_W + col], a0b = IN_(19)[(l * 2 + d) * A_W + col]; float la[16];
          rp_lowrank<4>(xw, afw, WLRh, 64 * d, n, hi); rp_lowrank<4>(la, afa, WLRh, 128 + 64 * d, n, hi);
#pragma unroll
          for (int t = 0; t < 16; ++t) { const float z = w0b + xw[t]; xw[t] = __expf(-__expf(-(fmaxf(-z, 0.f) + __logf(1.0f + __expf(-fabsf(z)))) - 0.5f)); const float av = sigmoidf_(a0b + la[t]);
              xb[t] = xkk[t] * av; xk[t] = xk[t] * (1.0f + (av - 1.0f) * ka_w); }
          { const float rk_w = IN_(24)[l * A_W + col]; float pr[16];
#pragma unroll
            for (int t = 0; t < 16; ++t) pr[t] = xr[t] * xk[t] * rk_w;
            const float sb = wave_sum16(pr, lane);
            if ((lane & 3) == 0) BS[((size_t)d * T + tau0 + (lane >> 2)) * NHA + h] = sb; } }
        if (d) {
#pragma unroll
            for (int s = 0; s < 8; ++s) { float t_;
                t_ = xw[s]; xw[s] = xw[15 - s]; xw[15 - s] = t_; t_ = xb[s]; xb[s] = xb[15 - s]; xb[15 - s] = t_; t_ = xk[s]; xk[s] = xk[15 - s]; xk[15 - s] = t_;
                t_ = xkk[s]; xkk[s] = xkk[15 - s]; xkk[15 - s] = t_; t_ = xr[s]; xr[s] = xr[15 - s]; xr[15 - s] = t_; t_ = xv[s]; xv[s] = xv[15 - s]; xv[15 - s] = t_; } }
        const int c = d == 0 ? tg : (tg < NCTX / 16 ? NCTX / 16 - 1 - tg : NCTX / 16 + (T / 16 - 1) - tg);
        float gC = 1.f;
#pragma unroll
        for (int s = 0; s < 16; ++s) gC *= xw[s];
        float g = 1.f;
#pragma unroll
        for (int s = 0; s < 16; ++s) {
            const float gm1 = g; g *= xw[s]; const float ig = 1.0f / g; const float bh = xb[s] * ig, kh = xk[s] * ig;
            R1[s * 72 + lane] = f2bf16(-xkk[s] * gm1); R1[(16 + s) * 72 + lane] = f2bf16(xr[s] * g);
            R2[s * 72 + lane] = f2bf16(bh); R2[(16 + s) * 72 + lane] = f2bf16(kh);
            xb[s] = bh * gC; xk[s] = kh * gC; }
        asm volatile("s_waitcnt lgkmcnt(0)" ::: "memory");
        unsigned char* dst = FR + ((size_t)(h * 2 + d) * SC_NCHUNK + c) * SC_CHUNK_BYTES;
        rp_f32x16 C = {};
#pragma unroll
        for (int kb = 0; kb < 4; ++kb) { const rp_bf16x8 a_ = *(const LAS rp_bf16x8*)(R2 + n * 72 + 16 * kb + 8 * hi), b_ = *(const LAS rp_bf16x8*)(R1 + n * 72 + 16 * kb + 8 * hi);
            C = __builtin_amdgcn_mfma_f32_32x32x16_bf16(a_, b_, C, 0, 0, 0); }
        const int tt_ = n & 15; const bool incl = n >= 16;
#pragma unroll
        for (int r = 0; r < 16; ++r) { const int s = ((r & 7) & 3) + 8 * ((r & 7) >> 2) + 4 * hi; if (!(s < tt_ || (incl && s == tt_))) C[r] = 0.f; }
        if (n < 16) {
#pragma unroll
            for (int r = 0; r < 8; ++r) Lm[((r & 3) + 8 * (r >> 2) + 4 * hi) * 20 + n] = C[r]; }
        { u32x4 f4; f4.x = cvt_pk_bf16(C[8], C[9]); f4.y = cvt_pk_bf16(C[10], C[11]); f4.z = cvt_pk_bf16(C[12], C[13]); f4.w = cvt_pk_bf16(C[14], C[15]);
          u32x4 f6; f6.x = cvt_pk_bf16(C[0], C[1]); f6.y = cvt_pk_bf16(C[2], C[3]); f6.z = cvt_pk_bf16(C[4], C[5]); f6.w = cvt_pk_bf16(C[6], C[7]);
          if (n < 16) f6 = (u32x4){0u, 0u, 0u, 0u};
          *(u32x4*)(dst + 4 * 1024 + lane * 16) = f4; *(u32x4*)(dst + 6 * 1024 + lane * 16) = f6; }
        asm volatile("s_waitcnt lgkmcnt(0)" ::: "memory");
        { float Tc[16];
#pragma unroll
          for (int s = 15; s >= 0; --s) { float acc = (s == n) ? 1.f : 0.f;
#pragma unroll
              for (int u = s + 1; u < 16; ++u) acc += Lm[s * 20 + u] * Tc[u];
              Tc[s] = acc; }
          u32x4 f5; f5.x = cvt_pk_bf16(hi ? Tc[4] : Tc[0], hi ? Tc[5] : Tc[1]); f5.y = cvt_pk_bf16(hi ? Tc[6] : Tc[2], hi ? Tc[7] : Tc[3]);
          f5.z = cvt_pk_bf16(hi ? Tc[12] : Tc[8], hi ? Tc[13] : Tc[9]); f5.w = cvt_pk_bf16(hi ? Tc[14] : Tc[10], hi ? Tc[15] : Tc[11]);
          if (n >= 16) f5 = (u32x4){0u, 0u, 0u, 0u};
          *(u32x4*)(dst + 5 * 1024 + lane * 16) = f5; }
#pragma unroll
        for (int f = 0; f < 4; ++f) { const u32x2 p0 = *(const LAS u32x2*)(R1 + n * 72 + 16 * f + 4 * hi), p1 = *(const LAS u32x2*)(R1 + n * 72 + 16 * f + 8 + 4 * hi);
            *(u32x4*)(dst + f * 1024 + lane * 16) = (u32x4){p0.x, p0.y, p1.x, p1.y}; }
#define RF_FRAG(x_, fa_, fb_) do { unsigned pk_[8]; _Pragma("unroll") for (int m_ = 0; m_ < 8; ++m_) pk_[m_] = cvt_pk_bf16(x_[2 * m_], x_[2 * m_ + 1]); \
            const bool h1_ = hi != 0; const u32x4 own_ = {h1_ ? pk_[2] : pk_[0], h1_ ? pk_[3] : pk_[1], h1_ ? pk_[6] : pk_[4], h1_ ? pk_[7] : pk_[5]}; \
            u32x4 rcv_ = {h1_ ? pk_[0] : pk_[2], h1_ ? pk_[1] : pk_[3], h1_ ? pk_[4] : pk_[6], h1_ ? pk_[5] : pk_[7]}; \
            rcv_.x = __shfl_xor(rcv_.x, 32); rcv_.y = __shfl_xor(rcv_.y, 32); rcv_.z = __shfl_xor(rcv_.z, 32); rcv_.w = __shfl_xor(rcv_.w, 32); \
            *(u32x4*)(dst + (fa_) * 1024 + lane * 16) = h1_ ? rcv_ : own_; *(u32x4*)(dst + (fb_) * 1024 + lane * 16) = h1_ ? own_ : rcv_; } while (0)
        RF_FRAG(xb, 7, 9); RF_FRAG(xk, 8, 10); RF_FRAG(xv, 11, 12);
#undef RF_FRAG
        { const int jj = lane & 31; ((float*)(dst + 13 * 1024))[((jj >> 2) & 1) * 32 + (lane >> 5) * 16 + (jj & 3) + 4 * (jj >> 3)] = gC; }
        asm volatile("s_waitcnt lgkmcnt(0)" ::: "memory");
    }
#undef RP_WIN
#undef RP_CONV
}
__device__ __forceinline__ void mixer_phase(const Frame& F0, unsigned char* ws0, int lq, bool need_ctx, char* lds_g) {
    const int l = lq & 3;
#ifndef MK_MIX
#define MK_MIX 15
#endif
    { const Frame F = opq(F0); unsigned char* ws = opq_ptr(ws0);
      if (MK_MIX & 1) for (int chain = F.bid; chain < 2 * NHA; chain += F.G) scan_chain_mfma(F, ws, chain); }
    const Frame& F = F0;
    const int n_xa = 32 * NHC, n_ca = need_ctx ? NHC : 0, n_att = n_xa + n_ca, n_hy = 640, n_ch = need_ctx ? 160 : 0;
    unsigned* qatt = (unsigned*)(ws0 + WS_CTL) + CW_QUEUE + 64 * lq; unsigned* qhy = qatt + 32;
    int item;
#define MIX_POP(q) do { if (F.tid == 0) F.MISC[16] = __hip_atomic_fetch_add((q), 1u, __ATOMIC_RELAXED, __HIP_MEMORY_SCOPE_AGENT); __syncthreads(); item = (int)F.MISC[16]; __syncthreads(); } while (0)
    if (F.bid >= 2 * NHA) {
        MIX_POP(qatt);
        while (item < n_att) {
            if (MK_MIX & 2) { unsigned char* ws = opq_ptr(ws0);
                const bf16_t* QF = (const bf16_t*)(ws + WS_QF); const bf16_t* KF = (const bf16_t*)(ws + WS_KF); const bf16_t* KVRAW = (const bf16_t*)(ws + WS_KVRAW); bf16_t* OB = (bf16_t*)(ws + WS_OBUF);
                const bool is_xa = item < n_xa; const int h = is_xa ? item % NHC : item - n_xa, row0 = is_xa ? NCTX + (item / NHC) * 256 : 0;
                for (int rp = 0; rp < REP(13); ++rp) att::attn_body(QF + (size_t)row0 * NQ + h * 192, KF + h * 192, KVRAW + h * 256 + 128, OB + (size_t)row0 * DM + 2560 + h * 128, is_xa ? T : NCTX, lds_g); }
            MIX_POP(qatt);
        }
    }
    MIX_POP(qhy);
    while (item < n_hy + n_ch) {
        const Frame Fu = opq(F0); unsigned char* ws = opq_ptr(ws0);
        if ((MK_MIX & 4) && item < n_hy) hyena_unit(Fu, ws, l, item);
        else if ((MK_MIX & 8) && item >= n_hy) hyena_ctx_unit(Fu, ws, l, item - n_hy);
        MIX_POP(qhy);
    }
#undef MIX_POP
}

__device__ __forceinline__ void hyena_taps_tail(const Frame& F0, unsigned char* ws0, int lt, int first, int end) {
    if (F0.bid < 48) return;
#pragma unroll 1
    for (int p = first + F0.bid - 48; p < end; p += 208) hyena_taps_unit(opq(F0), opq_ptr(ws0), lt, p);
}
constexpr int NPH = 2 + 14 * NL;
__global__ void __launch_bounds__(512, 2) mk_fwd(Args a) {
    extern __shared__ __attribute__((aligned(16))) unsigned char lds[];
    Frame F; F.lds = (LAS unsigned char*)lds; F.MISC = (volatile LAS unsigned*)(F.lds + LDS_MISC);
    F.tid = threadIdx.x; F.lane = F.tid & 63; F.wave = __builtin_amdgcn_readfirstlane(F.tid >> 6); F.bid = blockIdx.x; F.G = gridDim.x;
    if (F.tid < 64) F.MISC[F.tid] = 0u;
    if (F.tid < 46) *(LAS unsigned long long*)(F.lds + LDS_PTAB + 8 * F.tid) = (unsigned long long)(uintptr_t)a.in[F.tid];
    __syncthreads();
    unsigned char* ws = a.ws;
    const int lo = a.ph_lo, hi = a.ph_hi;
    XcdBarrier bar = xcd_barrier_post((unsigned*)(ws + WS_CTL) + CW_BAR, F.MISC + 8);
#ifndef MK_MASK
#define MK_MASK 0xffff
#endif
#define EN(x) (((MK_MASK) >> (x)) & 1)
#define IN(k) (lo <= (k) && (k) < hi)
#define SEAM(k) do { if (IN(k) && IN((k) + 1)) xcd_barrier(bar); } while (0)
#define WSP opq_ptr(ws)
#define P_XS(w) ((float*)((w) + WS_XS))
#define P_ABUF(w) ((bf16_t*)((w) + WS_ABUF))
#define P_HBUF(w) ((bf16_t*)((w) + WS_HBUF))
#define P_OBUF(w) ((bf16_t*)((w) + WS_OBUF))
#define P_MODX(w, l) ((const float*)((w) + WS_MOD) + ((size_t)(l) * 2 + 0) * NMOD)
#define P_MODC(w, l) ((const float*)((w) + WS_MOD) + ((size_t)(l) * 2 + 1) * NMOD)
#define P_WL(w, l) ((const bf16_t*)((w) + WS_WB) + (size_t)(l) * W_LAYER)
    if (EN(0) && IN(0)) for (int rp = 0; rp < REP(0); ++rp) phase0(opq(F), opq_ptr(ws));
    SEAM(0);
    if (EN(1) && IN(1)) phase_mod(opq(F), opq_ptr(ws));
    SEAM(1);
#pragma clang loop unroll(full)
    for (int l = 0; l < NL; ++l) {
        const int pb = 2 + 14 * l; const bool need_ctx = l < NL - 1;
        if (EN(2) && IN(pb + 0)) for (int rp = 0; rp < REP(2); ++rp) { unsigned char* w = WSP; norm_phase(opq(F), P_XS(w), IN_(7) + l * DM, P_MODX(w, l), P_MODC(w, l), 0, 1, P_ABUF(w), l > 0 ? (const bf16_t*)(w + WS_SLAB) : nullptr, l > 0 ? P_MODC(w, l - 1) + 8 * DM : nullptr, 0.5f); }
        SEAM(pb + 0);
        if (EN(3) && IN(pb + 1)) { unsigned char* w = WSP; pg8::Gemm g{P_ABUF(w), P_WL(w, l) + W_G1, T, 2 * FF, DM, DM}; pg8::StaticOrder S; S.init(T, 2 * FF, F.G, F.bid); pg8::EpiSwiGLU E{P_HBUF(w), FF};
            pg8::gemm_phase<pg8::EpiSwiGLU, pg8::StaticOrder>(F.lds, g, S, E, nullptr);
            hyena_taps_tail(F, ws, l, 0, l == 0 ? 640 : 416); }
        SEAM(pb + 1);
        if (EN(4) && IN(pb + 2)) {
            { unsigned char* w = WSP; pg8::Gemm g{P_HBUF(w), P_WL(w, l) + W_D1, T, DM, FF, FF}; pg8::StaticOrderX S; S.init(T, DM, F.G, F.bid); pg8::EpiResid E{P_XS(w), P_MODX(w, l) + 2 * DM, P_MODC(w, l) + 2 * DM, 0.5f, nullptr};
              pg8::gemm_phase<pg8::EpiResid, pg8::StaticOrderX>(F.lds, g, S, E, nullptr); }
            if (true) { __syncthreads();
              if (F.bid < 256) { unsigned char* w = WSP; const int ks = F.bid >> 4, ksz = FF / 16; pg8::Gemm g{P_HBUF(w) + ks * ksz, P_WL(w, l) + W_D1 + ks * ksz, NCTX, DM, ksz, FF}; pg8::OneUnit S{F.bid & 15};
                  pg8::EpiBf16<0> E{(bf16_t*)(w + WS_SLAB) + (size_t)ks * NCTX * DM, DM, nullptr, 0, 0};
                  pg8::gemm_phase<pg8::EpiBf16<0>, pg8::OneUnit>(F.lds, g, S, E, nullptr); } }
        }
        SEAM(pb + 2);
        if (EN(5) && IN(pb + 3)) for (int rp = 0; rp < REP(2); ++rp) { unsigned char* w = WSP; norm_phase(opq(F), P_XS(w), IN_(8) + l * DM, P_MODX(w, l), P_MODC(w, l), 3, 4, P_ABUF(w), (const bf16_t*)(w + WS_SLAB), P_MODC(w, l) + 2 * DM, 0.5f); }
        SEAM(pb + 3);
        if (EN(6) && IN(pb + 4)) { unsigned char* w = WSP; pg8::Gemm g{P_ABUF(w), P_WL(w, l) + W_IN, T, PXW, DM, DM}; pg8::StaticOrder S; S.init(T, PXW, F.G, F.bid); pg8::EpiBf16<0> E{(bf16_t*)(w + WS_PX), PXW, nullptr, 0, 0};
            pg8::gemm_phase<pg8::EpiBf16<0>, pg8::StaticOrder>(F.lds, g, S, E, nullptr); }
        SEAM(pb + 4);
        if (EN(7) && IN(pb + 5)) { for (int rp = 0; rp < REP(7); ++rp) rwkv_fused_phase(opq(F), opq_ptr(ws), l); if (!(MK_ONLYRP)) { for (int rp = 0; rp < REP(8); ++rp) mla_prep_phase(opq(F), opq_ptr(ws), l); hyena_prep_phase(opq(F), opq_ptr(ws), l); } }
        SEAM(pb + 5);
        if (EN(8) && IN(pb + 6)) {
            { unsigned char* w = WSP; pg8::Gemm g{(const bf16_t*)(w + WS_QA), P_WL(w, l) + W_Q, T, NQ, 1024, 1024}; pg8::StaticOrder S; S.init(T, NQ, F.G, F.bid); pg8::EpiBf16<0> E{(bf16_t*)(w + WS_QRAW), NQ, nullptr, 0, 0};
              pg8::gemm_phase<pg8::EpiBf16<0>, pg8::StaticOrder>(F.lds, g, S, E, nullptr); }
            __syncthreads();
            { unsigned char* w = WSP; pg8::Gemm g{(const bf16_t*)(w + WS_KVA), P_WL(w, l) + W_KV, T, NKV, 512, 512}; pg8::StaticOrder S; S.init(T, NKV, F.G, F.bid); pg8::EpiBf16<0> E{(bf16_t*)(w + WS_KVRAW), NKV, nullptr, 0, 0};
              pg8::gemm_phase<pg8::EpiBf16<0>, pg8::StaticOrder>(F.lds, g, S, E, nullptr); }
        }
        SEAM(pb + 6);
        if (EN(9) && IN(pb + 7)) { for (int rp = 0; rp < REP(8); ++rp) qkv_final_phase(opq(F), opq_ptr(ws), l, need_ctx); }
        SEAM(pb + 7);
        if (EN(10) && IN(pb + 8)) for (int rp = 0; rp < REP(10); ++rp) mixer_phase(F, ws, l + 4 * rp, need_ctx, (char*)lds);
        SEAM(pb + 8);
        if (EN(11) && IN(pb + 9)) { for (int rp = 0; rp < REP(8); ++rp) rwkv_out_phase(opq(F), opq_ptr(ws), l, need_ctx); hyena_out_phase(opq(F), opq_ptr(ws), need_ctx); }
        SEAM(pb + 9);
        if (EN(12) && IN(pb + 10)) {
            { unsigned char* w = WSP; pg8::Gemm g{P_OBUF(w), P_WL(w, l) + W_OUT, T, DM, DM, DM}; pg8::StaticOrderX S; S.init(T, DM, F.G, F.bid); pg8::EpiResid E{P_XS(w), P_MODX(w, l) + 5 * DM, P_MODC(w, l) + 5 * DM, 1.0f, nullptr};
              pg8::gemm_phase<pg8::EpiResid, pg8::StaticOrderX>(F.lds, g, S, E, nullptr); }
            if (need_ctx) { __syncthreads();
              if (F.bid < 256) { unsigned char* w = WSP; const int ks = F.bid >> 4, ksz = DM / 16; pg8::Gemm g{P_OBUF(w) + ks * ksz, P_WL(w, l) + W_OUT + ks * ksz, NCTX, DM, ksz, DM}; pg8::OneUnit S{F.bid & 15};
                  pg8::EpiBf16<0> E{(bf16_t*)(w + WS_SLAB) + (size_t)ks * NCTX * DM, DM, nullptr, 0, 0};
                  pg8::gemm_phase<pg8::EpiBf16<0>, pg8::OneUnit>(F.lds, g, S, E, nullptr); } }
        }
        SEAM(pb + 10);
        if (EN(13) && IN(pb + 11)) for (int rp = 0; rp < REP(2); ++rp) { unsigned char* w = WSP; norm_phase(opq(F), P_XS(w), IN_(9) + l * DM, P_MODX(w, l), P_MODC(w, l), 6, 7, P_ABUF(w), need_ctx ? (const bf16_t*)(w + WS_SLAB) : nullptr, P_MODC(w, l) + 5 * DM, 1.0f); }
        SEAM(pb + 11);
        if (EN(14) && IN(pb + 12)) { if (need_ctx) { unsigned char* w = WSP; pg8::Gemm g{P_ABUF(w), P_WL(w, l) + W_G2, T, 2 * FF, DM, DM}; pg8::StaticOrder S; S.init(T, 2 * FF, F.G, F.bid); pg8::EpiSwiGLU E{P_HBUF(w), FF};
            pg8::gemm_phase<pg8::EpiSwiGLU, pg8::StaticOrder>(F.lds, g, S, E, nullptr);
            hyena_taps_tail(F, ws, l + 1, 416, 640); }       else { unsigned char* w = WSP; pg8::Gemm g{P_ABUF(w), P_WL(w, l) + W_G2, T, 2 * FF, DM, DM}; pg8::StaticOrderX S; S.init(T, 2 * FF, F.G, F.bid); pg8::EpiSwiGLU E{P_HBUF(w), FF};
            pg8::gemm_phase<pg8::EpiSwiGLU, pg8::StaticOrderX>(F.lds, g, S, E, nullptr); } }
        SEAM(pb + 12);
        if (EN(15) && IN(pb + 13)) {
            { unsigned char* w = WSP; pg8::Gemm g{P_HBUF(w), P_WL(w, l) + W_D2, T, DM, FF, FF}; pg8::StaticOrderX S; S.init(T, DM, F.G, F.bid); pg8::EpiResid E{P_XS(w), P_MODX(w, l) + 8 * DM, P_MODC(w, l) + 8 * DM, 0.5f, l == NL - 1 ? a.out : nullptr};
              pg8::gemm_phase<pg8::EpiResid, pg8::StaticOrderX>(F.lds, g, S, E, nullptr); }
            if (need_ctx) { __syncthreads();
              if (F.bid < 256) { unsigned char* w = WSP; const int ks = F.bid >> 4, ksz = FF / 16; pg8::Gemm g{P_HBUF(w) + ks * ksz, P_WL(w, l) + W_D2 + ks * ksz, NCTX, DM, ksz, FF}; pg8::OneUnit S{F.bid & 15};
                  pg8::EpiBf16<0> E{(bf16_t*)(w + WS_SLAB) + (size_t)ks * NCTX * DM, DM, nullptr, 0, 0};
                  pg8::gemm_phase<pg8::EpiBf16<0>, pg8::OneUnit>(F.lds, g, S, E, nullptr); } }
        }
        SEAM(pb + 13);
    }
#undef IN
#undef SEAM
}

#ifndef MK_LAUNCHES
#define MK_LAUNCHES 1
#endif
extern "C" void kernel_launch(void* const* d_in, const int* in_sizes, int n_in, void* d_out, int out_size, void* d_ws, size_t ws_size, hipStream_t stream) {
    static int grid = 0;
    if (grid == 0) {
        if (n_in != 46 || in_sizes[0] != SEQ * DM || out_size != SEQ * DM || ws_size < WS_END) {
            fprintf(stderr, "kernel_launch: shape mismatch: n_in %d in0 %d out %d ws %zu (need %zu); nothing launched\n", n_in, n_in > 0 ? in_sizes[0] : -1, out_size, ws_size, (size_t)WS_END); grid = -1; return; }
        int dev = 0, cus = 0, per_cu = 0;
        if (hipGetDevice(&dev) != hipSuccess || hipDeviceGetAttribute(&cus, hipDeviceAttributeMultiprocessorCount, dev) != hipSuccess) { fprintf(stderr, "kernel_launch: device query failed\n"); grid = -1; return; }
        if (hipFuncSetAttribute((const void*)mk_fwd, hipFuncAttributeMaxDynamicSharedMemorySize, LDS_BYTES) != hipSuccess) { fprintf(stderr, "kernel_launch: hipFuncSetAttribute failed\n"); grid = -1; return; }
        if (hipOccupancyMaxActiveBlocksPerMultiprocessor(&per_cu, (const void*)mk_fwd, 512, LDS_BYTES) != hipSuccess || per_cu < 1) fprintf(stderr, "kernel_launch: note: occupancy query reports %d blocks per CU\n", per_cu);
        (void)hipGetLastError();
        grid = cus;
        if (cus != 256) { fprintf(stderr, "kernel_launch: built for 256 CUs (split-K of the context panel, hyena scratch), found %d; nothing launched\n", cus); grid = -1; return; }
    }
    if (grid < 0) return;
    if (hipMemsetAsync((char*)d_ws + WS_CTL, 0, CTL_BYTES, stream) != hipSuccess) { fprintf(stderr, "kernel_launch: memset failed\n"); return; }
    Args a{};
    for (int i = 0; i < 46; ++i) a.in[i] = (const float*)d_in[i];
    a.out = (float*)d_out; a.ws = (unsigned char*)d_ws;
    a.ph_lo = 0; a.ph_hi = NPH;
    hipLaunchKernelGGL(mk_fwd, dim3(grid), dim3(512), LDS_BYTES, stream, a);
    const hipError_t le = hipPeekAtLastError();
    if (le != hipSuccess) fprintf(stderr, "kernel_launch: launch failed: %s\n", hipGetErrorName(le));
}
```

```cpp
#include <hip/hip_runtime.h>
#include <stdint.h>
#include <cstdio>

#define LAS __attribute__((address_space(3)))
#define CAS __attribute__((address_space(4)))
typedef unsigned short bf16_t;
typedef float f32x4 __attribute__((ext_vector_type(4)));
typedef float f32x2 __attribute__((ext_vector_type(2)));
typedef unsigned u32x4 __attribute__((ext_vector_type(4)));
typedef unsigned u32x2 __attribute__((ext_vector_type(2)));

constexpr int T = 8448, NCTX = 256, SEQ = 8192, DM = 4096, FF = 6144, NL = 4;
constexpr int A_W = 1280, A_IN = 4160, B_IN = 3840, C_IN = 1600, NHA = 20;
constexpr int PXW = 9728, PXA = 0, PXB = 4160, PXC = 8000;
constexpr int NQ = 2304, NKV = 3072, NHC = 12;
constexpr int NMOD = 9 * DM;
constexpr float NORM_EPS = 1e-6f, GN_EPS = 64e-5f;

constexpr size_t MiB = 1u << 20;
constexpr size_t al(size_t x) { return (x + MiB - 1) / MiB * MiB; }
constexpr size_t WS_CTL = 0, CTL_BYTES = MiB;
constexpr size_t WS_XS = WS_CTL + CTL_BYTES;
constexpr size_t WS_ABUF = WS_XS + al((size_t)T * DM * 4);
constexpr size_t WS_HBUF = WS_ABUF + al((size_t)T * DM * 2);
constexpr size_t WS_OBUF = WS_HBUF + al((size_t)T * FF * 2);
constexpr size_t WS_PX = WS_OBUF + al((size_t)T * DM * 2);
constexpr size_t WS_MOD = WS_PX + al((size_t)T * PXW * 4);
constexpr size_t WS_HP = WS_MOD + al((size_t)NL * 2 * NMOD * 4);
constexpr size_t WS_SS = WS_HP + MiB;
constexpr size_t WS_SD = WS_SS + al((size_t)NHA * T * 192 * 4);
constexpr size_t WS_WLR = WS_SD + al((size_t)NHA * 2 * T * 192 * 4);
constexpr size_t WS_G = WS_WLR + al((size_t)NL * A_W * 448 * 2);
constexpr size_t WS_Y = WS_G + al((size_t)T * A_W * 4);
constexpr size_t WS_QA = WS_Y + al((size_t)2 * T * A_W * 4);
constexpr size_t WS_KVA = WS_QA + al((size_t)T * 1024 * 2);
constexpr size_t WS_KPE = WS_KVA + al((size_t)T * 512 * 2);
constexpr size_t WS_QRAW = WS_KPE + al((size_t)T * 64 * 2);
constexpr size_t WS_KVRAW = WS_QRAW + al((size_t)T * NQ * 2);
constexpr size_t WS_QF = WS_KVRAW + al((size_t)T * NKV * 2);
constexpr size_t WS_KF = WS_QF + al((size_t)T * NQ * 2);
constexpr size_t WS_H3 = WS_KF + al((size_t)T * NQ * 2);
constexpr size_t WS_HSCR = WS_H3 + al((size_t)NL * T * 64 * 4);
constexpr int HT_STRIDE = 17 * 512;
constexpr size_t WS_HTN = WS_HSCR + (size_t)640 * HT_STRIDE * 16;
constexpr size_t WS_FR = WS_HSCR + al((size_t)640 * HT_STRIDE * 16 + 640 * 8);
constexpr size_t WS_GT = WS_FR + al((size_t)40 * 528 * (14 * 1024));
constexpr size_t WS_X0T = WS_GT + al((size_t)1280 * T * 4);
constexpr size_t WS_SLAB = WS_FR;
constexpr size_t WS_WB = WS_X0T + al((size_t)1280 * T * 4);
constexpr size_t W_G1 = 0, W_D1 = W_G1 + (size_t)2 * FF * DM, W_IN = W_D1 + (size_t)DM * FF, W_OUT = W_IN + (size_t)PXW * DM, W_G2 = W_OUT + (size_t)DM * DM,
                 W_D2 = W_G2 + (size_t)2 * FF * DM, W_Q = W_D2 + (size_t)DM * FF, W_KV = W_Q + (size_t)NQ * 1024, W_LAYER = W_KV + (size_t)NKV * 512;
constexpr size_t WS_END = WS_WB + al(W_LAYER * NL * 2);
constexpr int CW_BAR = 4096;
constexpr int CW_QUEUE = 8192;

constexpr int LDS_MISC = 143360, LDS_BYTES = 147456;

__device__ __forceinline__ float wave_sum(float v) {
#pragma unroll
    for (int o = 1; o < 64; o <<= 1) v += __shfl_xor(v, o);
    return v;
}
__device__ __forceinline__ float wave_sum16(const float (&x)[16], int lane) {
    const bool b5 = (lane & 32) != 0, b4 = (lane & 16) != 0, b3 = (lane & 8) != 0, b2 = (lane & 4) != 0;
    float k8[8], k4[4], k2[2];
#pragma unroll
    for (int i = 0; i < 8; ++i) k8[i] = (b5 ? x[8 + i] : x[i]) + __shfl_xor(b5 ? x[i] : x[8 + i], 32);
#pragma unroll
    for (int i = 0; i < 4; ++i) k4[i] = (b4 ? k8[4 + i] : k8[i]) + __shfl_xor(b4 ? k8[i] : k8[4 + i], 16);
#pragma unroll
    for (int i = 0; i < 2; ++i) k2[i] = (b3 ? k4[2 + i] : k4[i]) + __shfl_xor(b3 ? k4[i] : k4[2 + i], 8);
    float k1 = (b2 ? k2[1] : k2[0]) + __shfl_xor(b2 ? k2[0] : k2[1], 4);
    k1 += __shfl_xor(k1, 1); k1 += __shfl_xor(k1, 2);
    return k1;
}
typedef __bf16 bf16x2_t __attribute__((ext_vector_type(2)));
__device__ __forceinline__ unsigned cvt_pk_bf16(float lo, float hi) { const f32x2 v = {lo, hi}; return __builtin_bit_cast(unsigned, __builtin_convertvector(v, bf16x2_t)); }
__device__ __forceinline__ float bf2f(unsigned short b) { return __uint_as_float(((unsigned)b) << 16); }
__device__ __forceinline__ f32x4 bf4f(u32x2 w) { return (f32x4){__uint_as_float(w.x << 16), __uint_as_float(w.x & 0xffff0000u), __uint_as_float(w.y << 16), __uint_as_float(w.y & 0xffff0000u)}; }
__device__ __forceinline__ float sigmoidf_(float x) { return 1.0f / (1.0f + __expf(-x)); }
__device__ __forceinline__ float siluf_(float x) { return x / (1.0f + __expf(-x)); }
__device__ __forceinline__ bool has_left(int tau) { return tau != 0 && tau != NCTX; }
__device__ __forceinline__ bool has_right(int tau) { return tau != NCTX - 1 && tau != T - 1; }

struct Args { const float* in[46]; float* out; unsigned char* ws; int ph_lo, ph_hi; };
struct Frame { LAS unsigned char* lds; volatile LAS unsigned* MISC; int tid, lane, wave, bid, G; };
constexpr int LDS_PTAB = LDS_MISC + 2048;
__device__ __forceinline__ const float* inp(const Frame& F, int i) {
    const volatile LAS unsigned* p = (const volatile LAS unsigned*)(F.lds + LDS_PTAB) + 2 * i;
    const unsigned lo = __builtin_amdgcn_readfirstlane(p[0]), hi = __builtin_amdgcn_readfirstlane(p[1]);
    return (const float*)(((unsigned long long)hi << 32) | lo);
}
#define IN_(i) inp(F, (i))
__device__ __forceinline__ Frame opq(const Frame& F) { Frame G = F; asm volatile("" : "+v"(G.tid), "+s"(G.wave), "+s"(G.bid)); G.lane = G.tid & 63; return G; }
__device__ __forceinline__ unsigned char* opq_ptr(unsigned char* p) { asm volatile("" : "+s"(p)); return p; }
#ifndef MK_REP
#define MK_REP 0
#endif
#ifndef MK_ONLYRP
#define MK_ONLYRP 0
#endif
#define REP(x) (1 + (((MK_REP) >> (x)) & 1))
#define XB_TMO      128
#define XB_XCNT(j)  (256  + 64 * (j))
#define XB_XSUB(j)  (1280 + 64 * (j))
#define XB_XGEN(j)  (2304 + 64 * (j))
#define XB_TOP      3328
#define XB_TOPGEN   3392
#define XCD_BAR_WORDS 3456
#define XB_SPIN_CAP (1u << 18)

__device__ __forceinline__ unsigned xb_ld(unsigned* p)              { return __hip_atomic_load(p, __ATOMIC_RELAXED, __HIP_MEMORY_SCOPE_AGENT); }
__device__ __forceinline__ unsigned xb_add(unsigned* p, unsigned v) { return __hip_atomic_fetch_add(p, v, __ATOMIC_RELAXED, __HIP_MEMORY_SCOPE_AGENT); }
__device__ __forceinline__ unsigned xb_xcc_id() { return (unsigned)__builtin_amdgcn_s_getreg((3 << 11) | 20) & 0xFu; }
#define XB_SPIN(cond, bar) do { unsigned _sp = 0; while (cond) { __builtin_amdgcn_s_sleep(1); \
    if ((++_sp & 255u) == 0u) { if (xb_ld(&(bar)[XB_TMO])) break; if (_sp > XB_SPIN_CAP) { atomicAdd(&(bar)[XB_TMO], 1u); break; } } } } while (0)

struct XcdBarrier {
    unsigned* bar; unsigned x;
    volatile LAS unsigned* st;
};

__device__ __forceinline__ XcdBarrier xcd_barrier_post(unsigned* bar, volatile LAS unsigned* st) {
    XcdBarrier b; b.bar = bar; b.x = xb_xcc_id(); b.st = st;
    if (threadIdx.x == 0) (void)xb_add(&bar[XB_XCNT(b.x)], 1u);
    return b;
}
__device__ __forceinline__ void xcd_barrier_complete(unsigned* bar, unsigned x, unsigned& nloc, unsigned& nx) {
    const unsigned G = gridDim.x * gridDim.y * gridDim.z;
    unsigned sum, cnt, mine, sp = 0u;
    for (;;) {
        sum = 0u; cnt = 0u; mine = 0u;
#pragma unroll
        for (unsigned j = 0; j < 16; ++j) { const unsigned c = xb_ld(&bar[XB_XCNT(j)]); sum += c; cnt += (c > 0u) ? 1u : 0u; mine = (j == x) ? c : mine; }
        if (sum == G) break;
        __builtin_amdgcn_s_sleep(1);
        if ((++sp & 255u) == 0u) { if (xb_ld(&bar[XB_TMO])) break; if (sp > XB_SPIN_CAP) { atomicAdd(&bar[XB_TMO], 1u); break; } }
    }
    nloc = mine > 0u ? mine : 1u; nx = cnt > 0u ? cnt : 1u;
}

__device__ __forceinline__ void xcd_barrier(const XcdBarrier& b) {
    asm volatile("s_waitcnt vmcnt(0)" ::: "memory");
    __syncthreads();
    if (threadIdx.x == 0) {
        unsigned* bar = b.bar;
        __builtin_amdgcn_s_waitcnt(0);
        unsigned nloc = b.st[0], nx = b.st[1];
        if (nloc == 0u) { xcd_barrier_complete(bar, b.x, nloc, nx); b.st[0] = nloc; b.st[1] = nx; }
        const unsigned old = xb_add(&bar[XB_XSUB(b.x)], 1u);
        const unsigned gen = old / nloc;
        if (old + 1u == (gen + 1u) * nloc) {
            __builtin_amdgcn_fence(__ATOMIC_RELEASE, "agent");
            asm volatile("s_waitcnt vmcnt(0)" ::: "memory");
            const unsigned og = xb_add(&bar[XB_TOP], 1u);
            const unsigned tg = og / nx;
            if (og + 1u == (tg + 1u) * nx) xb_add(&bar[XB_TOPGEN], 1u);
            else XB_SPIN(xb_ld(&bar[XB_TOPGEN]) == tg, bar);
            __builtin_amdgcn_fence(__ATOMIC_ACQUIRE, "agent");
            xb_add(&bar[XB_XGEN(b.x)], 1u);
            asm volatile("s_waitcnt vmcnt(0)" ::: "memory");
        } else {
            XB_SPIN(xb_ld(&bar[XB_XGEN(b.x)]) == gen, bar);
            __builtin_amdgcn_fence(__ATOMIC_ACQUIRE, "agent");
            asm volatile("s_waitcnt vmcnt(0)" ::: "memory");
        }
    }
    __syncthreads();
}
namespace pg8 {
#define PG8_LAS __attribute__((address_space(3)))
typedef unsigned short bf16_t;
typedef short bf16x8 __attribute__((ext_vector_type(8)));
typedef float f32x4 __attribute__((ext_vector_type(4)));
typedef unsigned u32x4 __attribute__((ext_vector_type(4)));
constexpr int BM = 256, BK = 64, HALF = 128, HTB = HALF * BK * 2  , STAGE_BYTES = 8 * HTB, NXCD = 8, WGM = 4;

__host__ __device__ __forceinline__ int lds_byte(int r, int c) { const int st = (r >> 4) * 2 + (c >> 5), rr = r & 15, cc = c & 31, ob = rr * 64 + cc * 2; return st * 1024 + (ob ^ (((ob >> 9) & 1) << 5)); }
__host__ __device__ __forceinline__ void stage_rc(int b, int& R, int& C) { const int st = b / 1024, sb = b % 1024, swz = sb ^ (((sb >> 9) & 1) << 5); R = (st >> 1) * 16 + swz / 64; C = (st & 1) * 32 + (swz % 64) / 2; }
__host__ __device__ __forceinline__ int perm32(int rho) { const int n = rho >> 4, i = rho & 15; return 8 * (i >> 2) + 4 * n + (i & 3); }

struct Unit { int pm, pn; };
struct Gemm { const bf16_t* A; const bf16_t* Bt; int M, N, K, ld; };

struct StaticOrder {
    int nM, nN, nwg, G, c;
    __host__ __device__ void init(int M, int N, int G_, int c_) { nM = M / BM; nN = N / BM; nwg = nM * nN; G = G_; c = c_; }
    __host__ __device__ bool next(int i, Unit& u) const {
        const long L = (long)i * G + c; if (L >= nwg) return false;
        int wgid = (int)L; { const int q = nwg / NXCD, r = nwg % NXCD, xcd = wgid % NXCD, off = wgid / NXCD; wgid = (xcd < r ? xcd * (q + 1) : r * (q + 1) + (xcd - r) * q) + off; }
        const int nig = WGM * nN, gid = wgid / nig, fm = gid * WGM, gsz = (nM - fm) < WGM ? (nM - fm) : WGM;
        u.pm = fm + ((wgid % nig) % gsz); u.pn = (wgid % nig) / gsz; return true;
    }
    __device__ __forceinline__ void a_ready(const Unit&) const {}
    __device__ __forceinline__ void done(const Unit&) const {}
};
struct CountedOrder : StaticOrder {
    const unsigned* ready; unsigned need; unsigned* tmo;
    __device__ __forceinline__ void a_ready(const Unit& u) const {
        if (threadIdx.x < 64) {
            const unsigned long long t0 = __builtin_amdgcn_s_memrealtime(); unsigned polls = 0;
            while ((unsigned)__builtin_amdgcn_readfirstlane(__hip_atomic_load(ready + 64 * u.pm, __ATOMIC_RELAXED, __HIP_MEMORY_SCOPE_AGENT)) < need) {
                if ((++polls & 255u) == 0u && __builtin_amdgcn_readfirstlane(__hip_atomic_load(tmo, __ATOMIC_RELAXED, __HIP_MEMORY_SCOPE_AGENT)) != 0u) break;
                if (__builtin_amdgcn_s_memrealtime() - t0 > 2000000ull) {
                    if (threadIdx.x == 0) { unsigned expect = 0u; __hip_atomic_compare_exchange_strong(tmo + 1, &expect, 0x600u | (unsigned)(u.pm & 0xff), __ATOMIC_RELAXED, __ATOMIC_RELAXED, __HIP_MEMORY_SCOPE_AGENT); __hip_atomic_store(tmo, 1u, __ATOMIC_RELAXED, __HIP_MEMORY_SCOPE_AGENT); }
                    break; }
                __builtin_amdgcn_s_sleep(2); }
            __builtin_amdgcn_fence(__ATOMIC_ACQUIRE, "agent");
            asm volatile("s_waitcnt vmcnt(0)" ::: "memory");
        }
#if !defined(BROKEN_HOOK_NO_BARRIER)
        asm volatile("" ::: "memory"); __builtin_amdgcn_s_barrier(); asm volatile("" ::: "memory");
#endif
    }
};

__device__ __forceinline__ unsigned cvt_pk_bf16(float lo, float hi) { unsigned r; asm volatile("v_cvt_pk_bf16_f32 %0, %1, %2" : "=v"(r) : "v"(lo), "v"(hi)); return r; }
typedef float f32x2 __attribute__((ext_vector_type(2)));
__device__ __forceinline__ f32x2 gelu_pk(f32x2 v) {
    const f32x2 av = __builtin_elementwise_abs(v), d = av * 0.2316418882f + 1.0f;
    f32x2 t; t.x = __builtin_amdgcn_rcpf(d.x); t.y = __builtin_amdgcn_rcpf(d.y);
    f32x2 q = t * 0.5307027145f + (-0.7265760135f); q = q * t + 0.7107068705f; q = q * t + (-0.142248368f); q = q * t + 0.127414796f; q = q * t;
    const f32x2 s = (v * v) * (-0.72134752044f);
    f32x2 e; e.x = __builtin_amdgcn_exp2f(s.x); e.y = __builtin_amdgcn_exp2f(s.y);
    const f32x2 m = v * (q * e), r = v - m;
    f32x2 o; o.x = v.x < 0.f ? m.x : r.x; o.y = v.y < 0.f ? m.y : r.y; return o;
}

struct EpiF32 {
    static constexpr bool PERM = false, AFTER_DRAIN = false;
    float* C; int ldc; const float* bias;
    __device__ __forceinline__ void operator()(const f32x4 (&acc)[2][2][4][2], const Unit& u, int wr, int wc, int fr, int fq) const {
        const int row0 = u.pm * BM + wr * 64 + fr, col0 = u.pn * BM + wc * 32 + 4 * fq;
        f32x4 bv[2][2];
#pragma unroll
        for (int bj = 0; bj < 2; ++bj)
#pragma unroll
            for (int n = 0; n < 2; ++n) bv[bj][n] = bias ? *(const f32x4*)(bias + col0 + bj * HALF + n * 16) : (f32x4){0.f, 0.f, 0.f, 0.f};
#pragma unroll
        for (int ai = 0; ai < 2; ++ai)
#pragma unroll
            for (int m = 0; m < 4; ++m) { float* rowp = C + (size_t)(row0 + ai * HALF + m * 16) * ldc + col0;
#pragma unroll
                for (int bj = 0; bj < 2; ++bj)
#pragma unroll
                    for (int n = 0; n < 2; ++n) *(f32x4*)(rowp + bj * HALF + n * 16) = acc[ai][bj][m][n] + bv[bj][n]; }
    }
};
template <int ACT  > struct EpiBf16 {
    static constexpr bool PERM = true, AFTER_DRAIN = false;
    bf16_t* O; int ldc; const float* bias; int split_cols; size_t split_stride;
    __device__ __forceinline__ void operator()(const f32x4 (&acc)[2][2][4][2], const Unit& u, int wr, int wc, int fr, int fq) const {
        const int row0 = u.pm * BM + wr * 64 + fr; int colt = u.pn * BM; bf16_t* base = O;
        if (split_cols) { const int t = colt / split_cols; base += (size_t)t * split_stride; colt -= t * split_cols; }
        const int col0 = colt + wc * 32 + 8 * fq, bcol0 = u.pn * BM + wc * 32 + 8 * fq;
        f32x4 bv[2][2];
#pragma unroll
        for (int bj = 0; bj < 2; ++bj)
#pragma unroll
            for (int n = 0; n < 2; ++n) bv[bj][n] = bias ? *(const f32x4*)(bias + bcol0 + bj * HALF + 4 * n) : (f32x4){0.f, 0.f, 0.f, 0.f};
#pragma unroll
        for (int ai = 0; ai < 2; ++ai)
#pragma unroll
            for (int m = 0; m < 4; ++m) { bf16_t* rowp = base + (size_t)(row0 + ai * HALF + m * 16) * ldc + col0;
#pragma unroll
                for (int bj = 0; bj < 2; ++bj) { f32x4 v0 = acc[ai][bj][m][0] + bv[bj][0], v1 = acc[ai][bj][m][1] + bv[bj][1];
                    if (ACT == 1) { f32x2 a = gelu_pk((f32x2){v0[0], v0[1]}), b = gelu_pk((f32x2){v0[2], v0[3]}), c = gelu_pk((f32x2){v1[0], v1[1]}), d = gelu_pk((f32x2){v1[2], v1[3]});
                        v0 = (f32x4){a.x, a.y, b.x, b.y}; v1 = (f32x4){c.x, c.y, d.x, d.y}; }
                    if (ACT == 2) {
#pragma unroll
                        for (int j = 0; j < 4; ++j) { v0[j] = 0.5f * v0[j] * (1.0f + erff(v0[j] * 0.70710678f)); v1[j] = 0.5f * v1[j] * (1.0f + erff(v1[j] * 0.70710678f)); } }
                    u32x4 w; w.x = cvt_pk_bf16(v0[0], v0[1]); w.y = cvt_pk_bf16(v0[2], v0[3]); w.z = cvt_pk_bf16(v1[0], v1[1]); w.w = cvt_pk_bf16(v1[2], v1[3]);
                    *(u32x4*)(rowp + bj * HALF) = w; } }
    }
};
}
namespace pg8 {
struct EpiSwiGLU {
    static constexpr bool PERM = true, AFTER_DRAIN = false;
    bf16_t* O; int ldc;
    __device__ __forceinline__ void operator()(const f32x4 (&acc)[2][2][4][2], const Unit& u, int wr, int wc, int fr, int fq) const {
        const int row0 = u.pm * BM + wr * 64 + fr, col0 = u.pn * HALF + wc * 32 + 8 * fq;
#pragma unroll
        for (int ai = 0; ai < 2; ++ai)
#pragma unroll
            for (int m = 0; m < 4; ++m) { bf16_t* rowp = O + (size_t)(row0 + ai * HALF + m * 16) * ldc + col0;
                float h[8];
#pragma unroll
                for (int n = 0; n < 2; ++n)
#pragma unroll
                    for (int j = 0; j < 4; ++j) { const float g = acc[ai][0][m][n][j], up = acc[ai][1][m][n][j]; h[n * 4 + j] = g * __builtin_amdgcn_rcpf(1.0f + __builtin_amdgcn_exp2f(-1.4426950408889634f * g)) * up; }
                u32x4 w; w.x = cvt_pk_bf16(h[0], h[1]); w.y = cvt_pk_bf16(h[2], h[3]); w.z = cvt_pk_bf16(h[4], h[5]); w.w = cvt_pk_bf16(h[6], h[7]);
                *(u32x4*)rowp = w; }
    }
};
struct EpiResid {
    static constexpr bool PERM = false, AFTER_DRAIN = false;
    float* X; const float* gate_x; const float* gate_c; float fac; float* out_x;
    __device__ __forceinline__ void operator()(const f32x4 (&acc)[2][2][4][2], const Unit& u, int wr, int wc, int fr, int fq) const {
        const int row0 = u.pm * BM + wr * 64 + fr, col0 = u.pn * BM + wc * 32 + 4 * fq;
        const float* gv = (u.pm == 0) ? gate_c : gate_x;
        float* dst = (u.pm != 0 && out_x) ? out_x - (size_t)256 * 4096 : X;
        f32x4 gg[2][2];
#pragma unroll
        for (int bj = 0; bj < 2; ++bj)
#pragma unroll
            for (int n = 0; n < 2; ++n) gg[bj][n] = *(const f32x4*)(gv + col0 + bj * HALF + n * 16) * fac;
#pragma unroll
        for (int ai = 0; ai < 2; ++ai)
#pragma unroll
            for (int m = 0; m < 4; ++m) { const size_t off = (size_t)(row0 + ai * HALF + m * 16) * 4096 + col0;
#pragma unroll
                for (int bj = 0; bj < 2; ++bj)
#pragma unroll
                    for (int n = 0; n < 2; ++n) { const f32x4 b = *(const f32x4*)(X + off + bj * HALF + n * 16); *(f32x4*)(dst + off + bj * HALF + n * 16) = b + gg[bj][n] * acc[ai][bj][m][n]; } }
    }
};
struct OneUnit { int pn;
    __host__ __device__ bool next(int i, Unit& u) const { u.pm = 0; u.pn = pn; return i == 0; }
    __device__ __forceinline__ void a_ready(const Unit&) const {}
    __device__ __forceinline__ void done(const Unit&) const {}
};
struct StaticOrderX { StaticOrder b;
    __host__ __device__ void init(int M, int N, int G_, int c_) { b.init(M - BM, N, G_, c_); }
    __host__ __device__ bool next(int i, Unit& u) const { const bool ok = b.next(i, u); u.pm += 1; return ok; }
    __device__ __forceinline__ void a_ready(const Unit&) const {}
    __device__ __forceinline__ void done(const Unit&) const {}
};
}
namespace pg8 {
template <class Epi, class Sched, bool STAMP = false>
__device__ __forceinline__ void gemm_phase(PG8_LAS unsigned char* lds, const Gemm g, const Sched& S, const Epi& E, unsigned long long* stamps) {
    int tid_ = threadIdx.x; asm volatile("" : "+v"(tid_));
    const int tid = tid_, wid = __builtin_amdgcn_readfirstlane(tid >> 6), lane = tid & 63, wr = wid >> 2, wc = wid & 3, fr = lane & 15, fq = lane >> 4;
    const int K = g.ld, nt = g.K / BK;
    int ts_lo = 0, ts_hi = 0, nts = 0; const unsigned long long rt_entry = STAMP ? (unsigned long long)wall_clock64() : 0ull;
#define PG8_STAMP() do { if (STAMP && wid == 0 && nts < 64) { const unsigned long long _c = (unsigned long long)clock64(); \
        ts_lo = (lane == nts) ? (int)(unsigned)_c : ts_lo; ts_hi = (lane == nts) ? (int)(unsigned)(_c >> 32) : ts_hi; ++nts; } } while (0)
    PG8_STAMP();
    unsigned voffA[2], voffB[2];
#pragma unroll
    for (int i = 0; i < 2; ++i) { int R, C; stage_rc(tid * 16 + i * 8192, R, C); const int Rb = Epi::PERM ? ((R & ~31) + perm32(R & 31)) : R;
        voffA[i] = (unsigned)(R * K + C) * 2u; voffB[i] = (unsigned)(Rb * K + C) * 2u; }
    const size_t kstep = (size_t)(BK * 2);
    const size_t hstep = (size_t)HALF * K * 2;
    const size_t tstep = 2 * hstep;
    const unsigned ldsw = (unsigned)wid * 1024u;
    const int aoff = lds_byte(wr * 64 + fr, fq * 8), boff = lds_byte(wc * 32 + fr, fq * 8);
#define PG8_SA(b, h) (((b) * 2 + (h)) * HTB)
#define PG8_SB(b, h) ((4 + (b) * 2 + (h)) * HTB)
#define PG8_STAGE(bufoff, gbase, voff) do { _Pragma("unroll") for (int _i = 0; _i < 2; ++_i) \
        __builtin_amdgcn_global_load_lds((const unsigned*)((const char*)(gbase) + (voff)[_i]), (PG8_LAS unsigned*)(lds + (bufoff) + ldsw + _i * 8192), 16, 0, 0); } while (0)
#define PG8_LDA(dst, b, h) do { _Pragma("unroll") for (int m = 0; m < 4; ++m) _Pragma("unroll") for (int k = 0; k < 2; ++k) dst[m][k] = *(const PG8_LAS bf16x8*)(lds + PG8_SA(b, h) + aoff + m * 2048 + k * 1024); } while (0)
#define PG8_LDB(dst, b, h) do { _Pragma("unroll") for (int n = 0; n < 2; ++n) _Pragma("unroll") for (int k = 0; k < 2; ++k) dst[n][k] = *(const PG8_LAS bf16x8*)(lds + PG8_SB(b, h) + boff + n * 2048 + k * 1024); } while (0)
#define PG8_MMA(ai, bj, At, Bt) do { __builtin_amdgcn_s_setprio(1); _Pragma("unroll") for (int m = 0; m < 4; ++m) _Pragma("unroll") for (int n = 0; n < 2; ++n) _Pragma("unroll") for (int k = 0; k < 2; ++k) \
        acc[ai][bj][m][n] = __builtin_amdgcn_mfma_f32_16x16x32_bf16(Bt[n][k], At[m][k], acc[ai][bj][m][n], 0, 0, 0); __builtin_amdgcn_s_setprio(0); } while (0)
#define PG8_WAIT_V(n) asm volatile("s_waitcnt vmcnt(" #n ")" ::: "memory")
#define PG8_WAIT_L(n) asm volatile("s_waitcnt lgkmcnt(" #n ")" ::: "memory")
#define PG8_BAR __builtin_amdgcn_s_barrier()
#define PG8_SCHED __builtin_amdgcn_sched_barrier(0)
    Unit cur, nxt; int ui = 0;
    if (!S.next(0, cur)) return;
    f32x4 acc[2][2][4][2];
#pragma unroll
    for (int a = 0; a < 2; ++a)
#pragma unroll
        for (int b = 0; b < 2; ++b)
#pragma unroll
            for (int m = 0; m < 4; ++m)
#pragma unroll
                for (int n = 0; n < 2; ++n) acc[a][b][m][n] = (f32x4){0.f, 0.f, 0.f, 0.f};
    bf16x8 At[4][2], B0[2][2], B1[2][2];
    const char* cA = (const char*)g.A + (size_t)cur.pm * tstep; const char* cB = (const char*)g.Bt + (size_t)cur.pn * tstep;
    S.a_ready(cur);
    PG8_STAGE(PG8_SB(0, 0), cB, voffB); PG8_STAGE(PG8_SA(0, 0), cA, voffA); PG8_STAGE(PG8_SB(0, 1), cB + hstep, voffB); PG8_STAGE(PG8_SA(0, 1), cA + hstep, voffA);
    if (wr == 1) PG8_BAR;
    PG8_WAIT_V(4); PG8_BAR;
    PG8_STAGE(PG8_SB(1, 0), cB + kstep, voffB); PG8_STAGE(PG8_SA(1, 0), cA + kstep, voffA); PG8_STAGE(PG8_SB(1, 1), cB + hstep + kstep, voffB);
    PG8_WAIT_V(6); PG8_BAR;
    PG8_STAMP();
    for (;;) {
        const bool has_next = S.next(ui + 1, nxt);
        const char* nA = has_next ? (const char*)g.A + (size_t)nxt.pm * tstep : cA; const char* nB = has_next ? (const char*)g.Bt + (size_t)nxt.pn * tstep : cB;
        for (int t = 0; t < nt; t += 2) {
            const bool last = (t == nt - 2);
            const char* a1 = cA + (size_t)(t + 1) * kstep;
            const char* a2 = last ? nA : cA + (size_t)(t + 2) * kstep; const char* b2 = last ? nB : cB + (size_t)(t + 2) * kstep;
            const char* a3 = a2 + kstep; const char* b3 = b2 + kstep;
            if (last && has_next) S.a_ready(nxt);
            PG8_LDB(B0, 0, 0); PG8_SCHED; PG8_LDA(At, 0, 0); PG8_STAGE(PG8_SA(1, 1), a1 + hstep, voffA);
            PG8_WAIT_L(8); PG8_BAR; PG8_WAIT_L(0); PG8_MMA(0, 0, At, B0); PG8_BAR; PG8_SCHED;
            PG8_LDB(B1, 0, 1); PG8_STAGE(PG8_SB(0, 0), b2, voffB);
            PG8_BAR; PG8_WAIT_L(0); PG8_MMA(0, 1, At, B1); PG8_BAR;
            PG8_LDA(At, 0, 1); PG8_STAGE(PG8_SA(0, 0), a2, voffA);
            PG8_BAR; PG8_WAIT_L(0); PG8_MMA(1, 0, At, B0); PG8_BAR; PG8_SCHED;
            PG8_STAGE(PG8_SB(0, 1), b2 + hstep, voffB);
            PG8_WAIT_V(6); PG8_BAR; PG8_MMA(1, 1, At, B1); PG8_BAR;
            PG8_LDB(B0, 1, 0); PG8_SCHED; PG8_LDA(At, 1, 0); PG8_STAGE(PG8_SA(0, 1), a2 + hstep, voffA);
            PG8_WAIT_L(8); PG8_BAR; PG8_WAIT_L(0); PG8_MMA(0, 0, At, B0); PG8_BAR; PG8_SCHED;
            PG8_LDB(B1, 1, 1); PG8_STAGE(PG8_SB(1, 0), b3, voffB);
            PG8_BAR; PG8_WAIT_L(0); PG8_MMA(0, 1, At, B1); PG8_BAR;
            PG8_LDA(At, 1, 1); PG8_STAGE(PG8_SA(1, 0), a3, voffA);
            PG8_BAR; PG8_WAIT_L(0); PG8_MMA(1, 0, At, B0); PG8_BAR; PG8_SCHED;
            PG8_STAGE(PG8_SB(1, 1), b3 + hstep, voffB);
            PG8_WAIT_V(6); PG8_BAR; PG8_MMA(1, 1, At, B1); PG8_BAR;
        }
        PG8_STAMP();
        if constexpr (!Epi::AFTER_DRAIN) { E(acc, cur, wr, wc, fr, fq); S.done(cur); }
        PG8_STAMP();
        if (!has_next) break;
#pragma unroll
        for (int a = 0; a < 2; ++a)
#pragma unroll
            for (int b = 0; b < 2; ++b)
#pragma unroll
                for (int m = 0; m < 4; ++m)
#pragma unroll
                    for (int n = 0; n < 2; ++n) acc[a][b][m][n] = (f32x4){0.f, 0.f, 0.f, 0.f};
        cur = nxt; cA = nA; cB = nB; ++ui;
    }
    PG8_WAIT_V(0);
    if (wr == 0) PG8_BAR;
    PG8_BAR;
    if constexpr (Epi::AFTER_DRAIN) { E.fused(acc, cur, wr, wc, fr, fq, lds, wid, lane); S.done(cur); }
    PG8_STAMP();
    if (STAMP && wid == 0) { stamps[lane] = lane < nts ? (((unsigned long long)(unsigned)ts_hi << 32) | (unsigned)ts_lo) : 0ull;
        if (lane == 62) stamps[62] = rt_entry; if (lane == 63) stamps[63] = (unsigned long long)wall_clock64(); }
#undef PG8_STAMP
#undef PG8_SA
#undef PG8_SB
#undef PG8_STAGE
#undef PG8_LDA
#undef PG8_LDB
#undef PG8_MMA
#undef PG8_WAIT_V
#undef PG8_WAIT_L
#undef PG8_BAR
#undef PG8_SCHED
}
}
#define LDS_WAIT() asm volatile("s_waitcnt lgkmcnt(0)" ::: "memory")

__device__ __forceinline__ int map_row(int n, int mode) {
    if (mode == 1) { const int j = n < FF ? n : n - FF; return (j >> 7) * 256 + (n < FF ? 0 : 128) + (j & 127); }
    return n;
}
__device__ __forceinline__ void transpose_item(const float* __restrict__ W, int K, int N, bf16_t* WT, int mode, LAS float* scr, int item, int lane) {
    const int nblk = N / 32, kb = item / nblk, nb = item % nblk, k0 = 64 * kb, n0 = 32 * nb;
#pragma unroll 8
    for (int i = 0; i < 32; ++i) { const int kk = 2 * i + (lane >> 5); scr[kk * 33 + (lane & 31)] = W[(size_t)(k0 + kk) * N + n0 + (lane & 31)]; }
    LDS_WAIT(); asm volatile("" ::: "memory");
    const int c = lane & 7;
#pragma unroll
    for (int j = 0; j < 4; ++j) { const int n = (lane >> 3) + 8 * j; const LAS float* s = scr + (8 * c) * 33 + n;
        u32x4 o; o.x = cvt_pk_bf16(s[0 * 33], s[1 * 33]); o.y = cvt_pk_bf16(s[2 * 33], s[3 * 33]); o.z = cvt_pk_bf16(s[4 * 33], s[5 * 33]); o.w = cvt_pk_bf16(s[6 * 33], s[7 * 33]);
        *(u32x4*)(WT + (size_t)map_row(n0 + n, mode) * K + k0 + 8 * c) = o; }
    LDS_WAIT(); asm volatile("" ::: "memory");
}
constexpr int I_G = (DM / 64) * (2 * FF / 32), I_D = (FF / 64) * (DM / 32), I_IN = (DM / 64) * (9600 / 32), I_OUT = (DM / 64) * (DM / 32), I_Q = (1024 / 64) * (NQ / 32), I_KV = (512 / 64) * (NKV / 32);
constexpr int I_LAYER = 2 * I_G + 2 * I_D + I_IN + I_OUT + I_Q + I_KV;

__device__ __forceinline__ void phase0(const Frame& F, unsigned char* ws) {
    const int gw = F.bid * 8 + F.wave, NGW = F.G * 8;
    const size_t gt = (size_t)F.bid * 512 + F.tid, NGT = (size_t)F.G * 512;
    LAS float* scr = (LAS float*)(F.lds + F.wave * 8704);
    bf16_t* WB = (bf16_t*)(ws + WS_WB);
    for (int it = gw; it < NL * I_LAYER; it += NGW) {
        const int l = it / I_LAYER; int r = it - l * I_LAYER; bf16_t* wl = WB + (size_t)l * W_LAYER;
        if (r < I_G) { transpose_item(IN_(10) + (size_t)l * DM * 2 * FF, DM, 2 * FF, wl + W_G1, 1, scr, r, F.lane); continue; } r -= I_G;
        if (r < I_D) { transpose_item(IN_(11) + (size_t)l * FF * DM, FF, DM, wl + W_D1, 0, scr, r, F.lane); continue; } r -= I_D;
        if (r < I_G) { transpose_item(IN_(12) + (size_t)l * DM * 2 * FF, DM, 2 * FF, wl + W_G2, 1, scr, r, F.lane); continue; } r -= I_G;
        if (r < I_D) { transpose_item(IN_(13) + (size_t)l * FF * DM, FF, DM, wl + W_D2, 0, scr, r, F.lane); continue; } r -= I_D;
        if (r < I_IN) { transpose_item(IN_(14) + (size_t)l * DM * 9600, DM, 9600, wl + W_IN, 0, scr, r, F.lane); continue; } r -= I_IN;
        if (r < I_OUT) { transpose_item(IN_(15) + (size_t)l * DM * DM, DM, DM, wl + W_OUT, 0, scr, r, F.lane); continue; } r -= I_OUT;
        if (r < I_Q) { transpose_item(IN_(39) + (size_t)l * 1024 * NQ, 1024, NQ, wl + W_Q, 0, scr, r, F.lane); continue; } r -= I_Q;
        transpose_item(IN_(41) + (size_t)l * 512 * NKV, 512, NKV, wl + W_KV, 0, scr, r, F.lane);
    }
    for (size_t i = gt; i < (size_t)NL * 128 * 512; i += NGT) {
        const int l = (int)(i / (128 * 512)), rr = (int)((i / 512) % 128), c = (int)(i % 512);
        const int row = 9600 + rr;
        *(u32x4*)(WB + (size_t)l * W_LAYER + W_IN + (size_t)row * DM + c * 8) = (u32x4){0u, 0u, 0u, 0u};
    }
    { bf16_t* WLR = (bf16_t*)(ws + WS_WLR); const float* wu = IN_(18); const float* au = IN_(20); const float* gu = IN_(21);
      for (size_t i = gt; i < (size_t)NL * 448 * A_W; i += NGT) { const int l = (int)(i / (448 * A_W)), k = (int)((i / A_W) % 448), col = (int)(i % A_W);
          float v;
          if (k < 128) v = wu[(((size_t)l * 2 + (k >> 6)) * 64 + (k & 63)) * A_W + col];
          else if (k < 256) v = au[(((size_t)l * 2 + ((k - 128) >> 6)) * 64 + (k & 63)) * A_W + col];
          else v = gu[((size_t)l * 192 + (k - 256)) * A_W + col];
          WLR[((size_t)l * A_W + col) * 448 + k] = (bf16_t)(cvt_pk_bf16(v, v) & 0xffffu); } }
    { f32x4* xs = (f32x4*)(ws + WS_XS); const f32x4* cx = (const f32x4*)IN_(2); const f32x4* xx = (const f32x4*)IN_(0);
      for (size_t i = gt; i < (size_t)T * DM / 4; i += NGT) xs[i] = i < (size_t)NCTX * DM / 4 ? cx[i] : xx[i - (size_t)NCTX * DM / 4]; }
    { float* HP = (float*)(ws + WS_HP);
      for (int it = F.bid; it < NL * 16; it += F.G) { const int l = it >> 4, ch = it & 15, w = F.tid >> 8, j = F.tid & 255;
          const float* cv = w ? IN_(3) : IN_(1); const float* ad = IN_(4) + ((size_t)l * DM + ch * 256) * 256 + j; float s = 0.f;
          for (int i = 0; i < 256; ++i) s += siluf_(cv[ch * 256 + i]) * ad[(size_t)i * 256];
          HP[((l * 16 + ch) * 2 + w) * 256 + j] = s; } }
    { float* H3 = (float*)(ws + WS_H3);
      LAS float* zb = (LAS float*)(F.lds + 73728); LAS float* ha = zb + 8 * 36; LAS float* hb = ha + 8 * 64;
      for (int it = F.bid; it < NL * (T / 8); it += F.G) { const int l = it / (T / 8), pb = it % (T / 8);
          if (F.tid < 8 * 33) { const int p = F.tid / 33, i = F.tid % 33, P = pb * 8 + p; const int L = P < NCTX ? NCTX : SEQ, t = P < NCTX ? P : P - NCTX;
              float z;
              if (i == 0) z = (float)t / (float)(L - 1);
              else { const int b = (i - 1) & 15; const float fb = 1e-4f + (float)b * ((15.0f - 1e-4f) / 15.0f); const float rev2 = 2.0f * fb * (float)t / (float)L;
                  z = i <= 16 ? cospif(rev2) : -sinpif(rev2); }
              zb[p * 36 + i] = z; }
          __syncthreads();
          const int p = F.tid >> 6, j = F.tid & 63; const float fq = IN_(36)[l * 64 + j];
          { const float* w1 = IN_(29) + (size_t)l * 33 * 64 + j; float s = IN_(30)[l * 64 + j];
            for (int i = 0; i < 33; ++i) s += zb[p * 36 + i] * w1[i * 64];
            ha[p * 64 + j] = sinf(fq * s); }
          __syncthreads();
          { const float* w2 = IN_(31) + (size_t)l * 64 * 64 + j; float s = IN_(32)[l * 64 + j];
            for (int i = 0; i < 64; ++i) s += ha[p * 64 + i] * w2[i * 64];
            hb[p * 64 + j] = sinf(fq * s); }
          __syncthreads();
          { const float* w3 = IN_(33) + (size_t)l * 64 * 64 + j; float s = IN_(34)[l * 64 + j];
            for (int i = 0; i < 64; ++i) s += hb[p * 64 + i] * w3[i * 64];
            ((bf16_t*)H3)[((size_t)l * 64 + j) * T + pb * 8 + p] = (bf16_t)(cvt_pk_bf16(sinf(fq * s), 0.f) & 0xffffu); }
          __syncthreads(); } }
}
__device__ __forceinline__ void phase_mod(const Frame& F, unsigned char* ws) {
    const float* HP = (const float*)(ws + WS_HP); float* MOD = (float*)(ws + WS_MOD);
    LAS float* hs = (LAS float*)F.lds;
    for (int it = F.bid; it < NL * (NMOD / 512); it += F.G) { const int l = it / (NMOD / 512), nb = it % (NMOD / 512);
        { const int w = F.tid >> 8, j = F.tid & 255; float s = 0.f;
          for (int ch = 0; ch < 16; ++ch) s += HP[((l * 16 + ch) * 2 + w) * 256 + j];
          hs[w * 256 + j] = s; }
        __syncthreads();
        const int n = nb * 512 + F.tid; const float* au = IN_(5) + (size_t)l * 256 * NMOD + n; float s0 = IN_(6)[(size_t)l * NMOD + n], s1 = s0;
        for (int j = 0; j < 256; ++j) { const float u = au[(size_t)j * NMOD]; s0 += hs[j] * u; s1 += hs[256 + j] * u; }
        MOD[((size_t)l * 2 + 0) * NMOD + n] = s0; MOD[((size_t)l * 2 + 1) * NMOD + n] = s1;
        __syncthreads(); }
}
__device__ __forceinline__ void norm_phase(const Frame& F, float* XS, const float* __restrict__ gain, const float* modx, const float* modc, int ish, int isc, bf16_t* out, const bf16_t* slab, const float* sgate, float sfac) {
    const int gw = F.bid * 8 + F.wave, NGW = F.G * 8;
    int row_lo = 0;
    if (slab) { row_lo = NCTX;
        LAS float* red = (LAS float*)F.lds;
        for (int row = F.bid; row < NCTX; row += F.G) { const size_t o = (size_t)row * DM + F.wave * 512;
            f32x4 v[2]; float s = 0.f;
#pragma unroll
            for (int j = 0; j < 2; ++j) { f32x4 acc = (f32x4){0.f, 0.f, 0.f, 0.f};
#pragma unroll
                for (int ks = 0; ks < 16; ++ks) acc += bf4f(((const u32x2*)(slab + (size_t)ks * NCTX * DM + o) + F.lane)[64 * j]);
                v[j] = ((const f32x4*)(XS + o) + F.lane)[64 * j] + acc * ((const f32x4*)(sgate + F.wave * 512) + F.lane)[64 * j] * sfac;
                ((f32x4*)(XS + o) + F.lane)[64 * j] = v[j]; s += (v[j].x * v[j].x + v[j].y * v[j].y) + (v[j].z * v[j].z + v[j].w * v[j].w); }
            s = wave_sum(s); if (F.lane == 0) red[F.wave] = s;
            __syncthreads();
            float tot = 0.f;
#pragma unroll
            for (int w = 0; w < 8; ++w) tot += red[w];
            const float rstd = rsqrtf(tot * (1.0f / DM) + NORM_EPS);
#pragma unroll
            for (int j = 0; j < 2; ++j) { const int c4 = F.wave * 128 + F.lane + 64 * j;
                const f32x4 y = v[j] * rstd * ((const f32x4*)gain)[c4] * (((const f32x4*)(modc + (size_t)isc * DM))[c4] + 1.0f) + ((const f32x4*)(modc + (size_t)ish * DM))[c4];
                u32x2 w2; w2.x = cvt_pk_bf16(y.x, y.y); w2.y = cvt_pk_bf16(y.z, y.w); ((u32x2*)(out + (size_t)row * DM))[c4] = w2; }
            __syncthreads(); } }
    for (int row = row_lo + gw; row < T; row += NGW) {
        const float* mod = row < NCTX ? modc : modx;
        const f32x4* xr = (const f32x4*)(XS + (size_t)row * DM) + F.lane; const f32x4* g4 = (const f32x4*)gain + F.lane;
        const f32x4* sh4 = (const f32x4*)(mod + (size_t)ish * DM) + F.lane; const f32x4* sc4 = (const f32x4*)(mod + (size_t)isc * DM) + F.lane;
        f32x4 v[16]; float s = 0.f;
#pragma unroll
        for (int j = 0; j < 16; ++j) { v[j] = xr[64 * j]; s += (v[j].x * v[j].x + v[j].y * v[j].y) + (v[j].z * v[j].z + v[j].w * v[j].w); }
        const float rstd = rsqrtf(wave_sum(s) * (1.0f / DM) + NORM_EPS);
        u32x2* o = (u32x2*)(out + (size_t)row * DM) + F.lane;
#pragma unroll
        for (int j = 0; j < 16; ++j) { const f32x4 y = v[j] * rstd * g4[64 * j] * (sc4[64 * j] + 1.0f) + sh4[64 * j];
            u32x2 w; w.x = cvt_pk_bf16(y.x, y.y); w.y = cvt_pk_bf16(y.z, y.w); o[64 * j] = w; }
    }
}
__device__ __forceinline__ float conv3_at(const bf16_t* PX, int tau, int col, float w0, float w1, float w2) {
    const bf16_t* p = PX + (size_t)tau * PXW + col;
    const bool hl = has_left(tau), hr = has_right(tau);
    return bf2f(p[0]) * w1 + bf2f(p[hl ? -PXW : 0]) * (hl ? w0 : 0.f) + bf2f(p[hr ? PXW : 0]) * (hr ? w2 : 0.f);
}
__device__ __forceinline__ float rope_apply(float val, int tau, int j) {
    const int pos = tau - NCTX, prow = pos >> 6, pcol = pos & 63;
    const float inv = __powf(10000.0f, -(float)(j & 15) * (1.0f / 16.0f));
    const float ang = (float)(j < 32 ? prow : pcol) * inv;
    float sn, cs; sincosf(ang, &sn, &cs);
    const float partner = __shfl_xor(val, 16);
    const float rot = (j & 16) ? partner : -partner;
    return val * cs + rot * sn;
}
__device__ __forceinline__ void mla_prep_phase(const Frame& F, unsigned char* ws, int l) {
    const bf16_t* PX = (const bf16_t*)(ws + WS_PX); bf16_t* QA = (bf16_t*)(ws + WS_QA); bf16_t* KVA = (bf16_t*)(ws + WS_KVA); bf16_t* KPE = (bf16_t*)(ws + WS_KPE);
    const int gw = F.bid * 8 + F.wave, NGW = F.G * 8;
    const f32x4* gq = (const f32x4*)(IN_(38) + l * 1024) + F.lane; const f32x4* gkv = (const f32x4*)(IN_(40) + l * 512) + F.lane; const float gpe = IN_(45)[l * 64 + F.lane];
    for (int tau = gw; tau < T; tau += NGW) {
        const u32x2* p = (const u32x2*)(PX + (size_t)tau * PXW + PXC) + F.lane;
        f32x4 q[4], kv[2]; float sq = 0.f, skv = 0.f;
#pragma unroll
        for (int j = 0; j < 4; ++j) { q[j] = bf4f(p[64 * j]); sq += (q[j].x * q[j].x + q[j].y * q[j].y) + (q[j].z * q[j].z + q[j].w * q[j].w); }
#pragma unroll
        for (int j = 0; j < 2; ++j) { kv[j] = bf4f(p[256 + 64 * j]); skv += (kv[j].x * kv[j].x + kv[j].y * kv[j].y) + (kv[j].z * kv[j].z + kv[j].w * kv[j].w); }
        const float pe = bf2f(PX[(size_t)tau * PXW + PXC + 1536 + F.lane]);
        const float rq = rsqrtf(wave_sum(sq) * (1.0f / 1024.0f) + NORM_EPS), rkv = rsqrtf(wave_sum(skv) * (1.0f / 512.0f) + NORM_EPS), rpe = rsqrtf(wave_sum(pe * pe) * (1.0f / 64.0f) + NORM_EPS);
        u32x2* oq = (u32x2*)(QA + (size_t)tau * 1024) + F.lane; u32x2* okv = (u32x2*)(KVA + (size_t)tau * 512) + F.lane;
#pragma unroll
        for (int j = 0; j < 4; ++j) { const f32x4 y = q[j] * rq * gq[64 * j]; u32x2 w; w.x = cvt_pk_bf16(y.x, y.y); w.y = cvt_pk_bf16(y.z, y.w); oq[64 * j] = w; }
#pragma unroll
        for (int j = 0; j < 2; ++j) { const f32x4 y = kv[j] * rkv * gkv[64 * j]; u32x2 w; w.x = cvt_pk_bf16(y.x, y.y); w.y = cvt_pk_bf16(y.z, y.w); okv[64 * j] = w; }
        float kp = pe * rpe * gpe;
        if (tau >= NCTX) kp = rope_apply(kp, tau, F.lane);
        KPE[(size_t)tau * 64 + F.lane] = (bf16_t)(cvt_pk_bf16(kp, kp) & 0xffffu);
    }
}
__device__ __forceinline__ void qkv_final_phase(const Frame& F, unsigned char* ws, int l, bool need_ctx) {
    const bf16_t* QRAW = (const bf16_t*)(ws + WS_QRAW); const bf16_t* KVRAW = (const bf16_t*)(ws + WS_KVRAW); const bf16_t* KPE = (const bf16_t*)(ws + WS_KPE);
    bf16_t* QF = (bf16_t*)(ws + WS_QF); bf16_t* KF = (bf16_t*)(ws + WS_KF);
    const int gw = F.bid * 8 + F.wave, NGW = F.G * 8, ln = F.lane;
    const float gqn0 = IN_(42)[l * 128 + 2 * ln], gqn1 = IN_(42)[l * 128 + 2 * ln + 1], gqp = IN_(43)[l * 64 + ln];
    const float gkn0 = IN_(44)[l * 128 + 2 * ln], gkn1 = IN_(44)[l * 128 + 2 * ln + 1];
    (void)need_ctx;
    for (int tau = gw; tau < T; tau += NGW) {
        float cs = 1.f, sn = 0.f;
        if (tau >= NCTX) { const int pos = tau - NCTX, prow = pos >> 6, pcol = pos & 63; const float inv = __powf(10000.0f, -(float)(ln & 15) * (1.0f / 16.0f)); sincosf((float)(ln < 32 ? prow : pcol) * inv, &sn, &cs); }
        const bf16_t kpe = KPE[(size_t)tau * 64 + ln];
        const bf16_t* qrow = QRAW + (size_t)tau * NQ; const bf16_t* krow = KVRAW + (size_t)tau * NKV;
        unsigned qn[NHC], kn[NHC]; bf16_t qpv[NHC];
#pragma unroll
        for (int h = 0; h < NHC; ++h) { qn[h] = *(const unsigned*)(qrow + h * 192 + 2 * ln); qpv[h] = qrow[h * 192 + 128 + ln]; kn[h] = *(const unsigned*)(krow + h * 256 + 2 * ln); }
#pragma unroll
        for (int h = 0; h < NHC; ++h) {
            const float q0 = bf2f((unsigned short)(qn[h] & 0xffffu)), q1 = bf2f((unsigned short)(qn[h] >> 16)), qp = bf2f(qpv[h]), k0 = bf2f((unsigned short)(kn[h] & 0xffffu)), k1 = bf2f((unsigned short)(kn[h] >> 16));
            const float rqn = rsqrtf(wave_sum(q0 * q0 + q1 * q1) * (1.0f / 128.0f) + NORM_EPS), rqp = rsqrtf(wave_sum(qp * qp) * (1.0f / 64.0f) + NORM_EPS), rkn = rsqrtf(wave_sum(k0 * k0 + k1 * k1) * (1.0f / 128.0f) + NORM_EPS);
            float qpe = qp * rqp * gqp;
            { const float partner = __shfl_xor(qpe, 16); const float rot = (ln & 16) ? partner : -partner; qpe = qpe * cs + rot * sn; }
            *(unsigned*)(QF + (size_t)tau * NQ + h * 192 + 2 * ln) = cvt_pk_bf16(q0 * rqn * gqn0, q1 * rqn * gqn1);
            QF[(size_t)tau * NQ + h * 192 + 128 + ln] = (bf16_t)(cvt_pk_bf16(qpe, qpe) & 0xffffu);
            *(unsigned*)(KF + (size_t)tau * NQ + h * 192 + 2 * ln) = cvt_pk_bf16(k0 * rkn * gkn0, k1 * rkn * gkn1);
            KF[(size_t)tau * NQ + h * 192 + 128 + ln] = kpe; }
    }
}
__device__ __forceinline__ void rwkv_out_phase(const Frame& F, unsigned char* ws, int l, bool need_ctx) {
    const float* SS = (const float*)(ws + WS_SS); const float* SD = (const float*)(ws + WS_SD); const float* GB = (const float*)(ws + WS_G); const float* Y = (const float*)(ws + WS_Y);
    bf16_t* OB = (bf16_t*)(ws + WS_OBUF);
    const int gw = F.bid * 8 + F.wave, NGW = F.G * 8, ln = F.lane;
    for (int it = (need_ctx ? 0 : NCTX * 5) + gw; it < T * 5; it += NGW) { const int tau = it / 5, h0 = (it % 5) * 4;
        float y0[4], y1[4], v[4], sa[4], sb[4], g[4];
#pragma unroll
        for (int q = 0; q < 4; ++q) { const int h = h0 + q, col = h * 64 + ln; const size_t o = (size_t)tau * A_W + col;
            y0[q] = Y[o]; y1[q] = Y[(size_t)T * A_W + o]; v[q] = SS[(size_t)T * A_W + o];
            sa[q] = SD[(size_t)tau * NHA + h]; sb[q] = SD[((size_t)T + tau) * NHA + h]; g[q] = GB[o]; }
#pragma unroll
        for (int q = 0; q < 4; ++q) { const int col = (h0 + q) * 64 + ln;
            const float y = y0[q] + y1[q];
            const float mu = wave_sum(y) * (1.0f / 64.0f); const float dy = y - mu; const float var = wave_sum(dy * dy) * (1.0f / 64.0f);
            const float yn = dy * rsqrtf(var + GN_EPS) * IN_(25)[l * A_W + col] + IN_(26)[l * A_W + col];
            const float bonus = 0.5f * (sa[q] + sb[q]) * v[q];
            const float ov = (yn + bonus) * g[q];
            OB[(size_t)tau * DM + col] = (bf16_t)(cvt_pk_bf16(ov, ov) & 0xffffu); }
    }
}
__device__ __forceinline__ void hyena_prep_phase(const Frame& F, unsigned char* ws, int l) {
    const bf16_t* PX = (const bf16_t*)(ws + WS_PX); float* GT = (float*)(ws + WS_GT); float* X0T = (float*)(ws + WS_X0T);
    LAS float* LGt = (LAS float*)F.lds; LAS float* LX0 = LGt + 64 * 65;
    const float* cw = IN_(27) + (size_t)l * 3 * B_IN; const float* cb = IN_(28) + (size_t)l * B_IN;
    for (int it = F.bid; it < (T / 64) * 20; it += F.G) { const int tt = it / 20, ct = it % 20;
        { const int t = F.tid >> 3, c0 = ct * 64 + (F.tid & 7) * 8, tau = tt * 64 + t;
          f32x4 u[3][2];
#pragma unroll
          for (int grp = 0; grp < 3; ++grp)
#pragma unroll
              for (int q = 0; q < 2; ++q) { const int c = grp * 1280 + c0 + 4 * q; const bf16_t* p = PX + (size_t)tau * PXW + PXB + c;
                  const bool hl = has_left(tau), hr = has_right(tau);
                  const f32x4 y = bf4f(*(const u32x2*)p) * *(const f32x4*)(cw + B_IN + c) + *(const f32x4*)(cb + c) + bf4f(*(const u32x2*)(p - (hl ? PXW : 0))) * (*(const f32x4*)(cw + c) * (hl ? 1.f : 0.f))
                                + bf4f(*(const u32x2*)(p + (hr ? PXW : 0))) * (*(const f32x4*)(cw + 2 * B_IN + c) * (hr ? 1.f : 0.f));
                  u[grp][q] = y; }
#pragma unroll
          for (int q = 0; q < 2; ++q)
#pragma unroll
              for (int e = 0; e < 4; ++e) { const int ch = (F.tid & 7) * 8 + 4 * q + e; LGt[ch * 65 + t] = u[1][q][e] * u[2][q][e]; LX0[ch * 65 + t] = u[0][q][e]; } }
        __syncthreads();
        { const int ch = F.tid >> 3, t0 = (F.tid & 7) * 8; const size_t o = (size_t)(ct * 64 + ch) * T + tt * 64 + t0;
          f32x4 a0, a1, b0, b1;
#pragma unroll
          for (int e = 0; e < 4; ++e) { a0[e] = LGt[ch * 65 + t0 + e]; a1[e] = LGt[ch * 65 + t0 + 4 + e]; b0[e] = LX0[ch * 65 + t0 + e]; b1[e] = LX0[ch * 65 + t0 + 4 + e]; }
          *(f32x4*)(GT + o) = a0; *(f32x4*)(GT + o + 4) = a1; *(f32x4*)(X0T + o) = b0; *(f32x4*)(X0T + o + 4) = b1; }
        __syncthreads(); }
}
__device__ __forceinline__ void hyena_out_phase(const Frame& F, unsigned char* ws, bool need_ctx) {
    const float* YT = (const float*)(ws + WS_GT); bf16_t* OB = (bf16_t*)(ws + WS_OBUF);
    LAS float* L = (LAS float*)F.lds;
    const int it0 = need_ctx ? 0 : (NCTX / 64) * 20;
    for (int it = it0 + F.bid; it < (T / 64) * 20; it += F.G) { const int tt = it / 20, ct = it % 20;
        { const int ch = F.tid >> 3, t0 = (F.tid & 7) * 8; const size_t o = (size_t)(ct * 64 + ch) * T + tt * 64 + t0;
          const f32x4 a0 = *(const f32x4*)(YT + o), a1 = *(const f32x4*)(YT + o + 4);
#pragma unroll
          for (int e = 0; e < 4; ++e) { L[ch * 65 + t0 + e] = a0[e]; L[ch * 65 + t0 + 4 + e] = a1[e]; } }
        __syncthreads();
        { const int t = F.tid >> 3, c0 = (F.tid & 7) * 8; float x[8];
#pragma unroll
          for (int e = 0; e < 8; ++e) x[e] = L[(c0 + e) * 65 + t];
          u32x4 w; w.x = cvt_pk_bf16(x[0], x[1]); w.y = cvt_pk_bf16(x[2], x[3]); w.z = cvt_pk_bf16(x[4], x[5]); w.w = cvt_pk_bf16(x[6], x[7]);
          *(u32x4*)(OB + (size_t)(tt * 64 + t) * DM + 1280 + ct * 64 + c0) = w; }
        __syncthreads(); }
}
namespace att {
constexpr int DK = 192, DV = 128, NW = 8, QBLK = 32, KVBLK = 64;
constexpr float SCALE = 0.07216878364870322f;
constexpr float THR = 8.f;
#ifndef ATT_SDEPTH
#define ATT_SDEPTH 2
#endif
constexpr int SDEPTH = ATT_SDEPTH;
constexpr int LDQ = 2304, LDK = 2304, LDV = 3072, LDO = 4096;
constexpr int SHM_V = KVBLK * DV * 2, SHM_K = KVBLK * DK * 2, SHM_ATTN = 2 * SHM_V + 2 * SHM_K + NW * 64 * 4 + NW * 4096;
using bf16x8 = __attribute__((ext_vector_type(8))) short;
using s16x4  = __attribute__((ext_vector_type(4))) short;
using f32x16 = __attribute__((ext_vector_type(16))) float;
using u32x4  = __attribute__((ext_vector_type(4))) unsigned;
#define KSWZ(row, colB) ((row) * 384 + ((colB) ^ (((row) & 7) << 4)))
#define SBAR() __builtin_amdgcn_sched_barrier(0)
__device__ __forceinline__ int crow(int r, int hi) { return (r & 3) + 8 * (r >> 2) + 4 * hi; }
__device__ __forceinline__ unsigned cvtpk(float lo, float hi) { unsigned r; asm volatile("v_cvt_pk_bf16_f32 %0, %1, %2" : "=v"(r) : "v"(lo), "v"(hi)); return r; }
__device__ __forceinline__ void partialSM(f32x16& p0, f32x16& p1, float& m_reg, float& mn, float& alpha) {
  constexpr float C = SCALE * 1.4426950408889634f;
  float pmax = p0[0]; for (int r = 1; r < 16; ++r) pmax = fmaxf(pmax, p0[r]); for (int r = 0; r < 16; ++r) pmax = fmaxf(pmax, p1[r]);
  { auto rr = __builtin_amdgcn_permlane32_swap(__float_as_uint(pmax), __float_as_uint(pmax), false, false);
    pmax = fmaxf(__uint_as_float(rr[0]), __uint_as_float(rr[1])); }
  if (__builtin_expect(__all(pmax - m_reg <= THR / SCALE), 1)) { mn = m_reg; alpha = 1.f; }
  else { mn = fmaxf(m_reg, pmax); alpha = __builtin_amdgcn_exp2f((m_reg - mn) * C); m_reg = mn; }
  float mnC = -mn * C;
  for (int r = 0; r < 16; ++r) p0[r] = fmaf(p0[r], C, mnC); for (int r = 0; r < 16; ++r) p1[r] = fmaf(p1[r], C, mnC);
  for (int r = 0; r < 16; ++r) p0[r] = __builtin_amdgcn_exp2f(p0[r]);
}
__device__ __forceinline__ void finishSM(f32x16& p0, f32x16& p1, float alpha, float& l_reg, bf16x8& pa0, bf16x8& pa1, bf16x8& pa2, bf16x8& pa3) {
  for (int r = 0; r < 16; ++r) p1[r] = __builtin_amdgcn_exp2f(p1[r]);
  float ps = 0; for (int r = 0; r < 16; ++r) ps += p0[r]; for (int r = 0; r < 16; ++r) ps += p1[r];
  { auto rr = __builtin_amdgcn_permlane32_swap(__float_as_uint(ps), __float_as_uint(ps), false, false);
    ps = __uint_as_float(rr[0]) + __uint_as_float(rr[1]); }
  l_reg = l_reg * alpha + ps;
#define PK4(P, BASE, OUT) do { unsigned a0 = cvtpk(P[BASE + 0], P[BASE + 1]), a1 = cvtpk(P[BASE + 2], P[BASE + 3]);   \
    unsigned b0 = cvtpk(P[BASE + 4], P[BASE + 5]), b1 = cvtpk(P[BASE + 6], P[BASE + 7]);                              \
    auto r0 = __builtin_amdgcn_permlane32_swap(a0, b0, false, false); auto r1 = __builtin_amdgcn_permlane32_swap(a1, b1, false, false); \
    u32x4 w = {r0[0], r1[0], r0[1], r1[1]}; OUT = *reinterpret_cast<bf16x8*>(&w); } while (0)
  PK4(p0, 0, pa0); PK4(p0, 8, pa1); PK4(p1, 0, pa2); PK4(p1, 8, pa3);
#undef PK4
}
__device__ __forceinline__ void qkt(f32x16& p0, f32x16& p1, const char* Ks, const bf16x8* qr, const char* qrl, int r32, int hi) {
  p0 = f32x16{}; p1 = f32x16{};
#pragma unroll
  for (int d0 = 0; d0 < 8; ++d0) { int cb = (d0 * 16 + hi * 8) * 2;
    bf16x8 b0 = *reinterpret_cast<const bf16x8*>(Ks + KSWZ(r32, cb));
    bf16x8 b1 = *reinterpret_cast<const bf16x8*>(Ks + KSWZ(32 + r32, cb));
    p0 = __builtin_amdgcn_mfma_f32_32x32x16_bf16(b0, qr[d0], p0, 0, 0, 0);
    p1 = __builtin_amdgcn_mfma_f32_32x32x16_bf16(b1, qr[d0], p1, 0, 0, 0); }
#pragma unroll
  for (int d0 = 8; d0 < 12; ++d0) { int cb = (d0 * 16 + hi * 8) * 2;
    bf16x8 b0 = *reinterpret_cast<const bf16x8*>(Ks + KSWZ(r32, cb));
    bf16x8 b1 = *reinterpret_cast<const bf16x8*>(Ks + KSWZ(32 + r32, cb));
    const bf16x8 q = *reinterpret_cast<const bf16x8*>(qrl + ((((d0 - 8) * 2 + hi) ^ (r32 & 7)) << 4));
    p0 = __builtin_amdgcn_mfma_f32_32x32x16_bf16(b0, q, p0, 0, 0, 0);
    p1 = __builtin_amdgcn_mfma_f32_32x32x16_bf16(b1, q, p1, 0, 0, 0); }
}
__device__ __forceinline__ int v_st(int k, int c) { const int kk = (k & ~0xC) | ((k & 4) << 1) | ((k & 8) >> 1); return ((kk >> 3) * 4 + (c >> 5)) * 512 + ((kk & 7) * 32 + (c & 31)) * 2; }
__device__ __forceinline__ int v_rd_base(int lane) { return ((lane & 3) << 3) | (((lane >> 2) & 3) << 6) | (((lane >> 4) & 1) << 5) | (((lane >> 5) & 1) << 8); }
constexpr int v_rd_off(int d0, int ks, int half) { return d0 * 512 + ks * 4096 + half * 2048; }
template <int OFF> __device__ __forceinline__ s16x4 tr_read(int vb) {
  s16x4 r; asm volatile("ds_read_b64_tr_b16 %0, %1 offset:%2" : "=&v"(r) : "v"(vb), "i"(OFF) : "memory"); return r;
}
template <int D0> __device__ __forceinline__ void pv_one(f32x16& od, int vb, bf16x8 pa0, bf16x8 pa1, bf16x8 pa2, bf16x8 pa3) {
  const s16x4 l0 = tr_read<v_rd_off(D0, 0, 0)>(vb), h0 = tr_read<v_rd_off(D0, 0, 1)>(vb), l1 = tr_read<v_rd_off(D0, 1, 0)>(vb), h1 = tr_read<v_rd_off(D0, 1, 1)>(vb);
  const s16x4 l2 = tr_read<v_rd_off(D0, 2, 0)>(vb), h2 = tr_read<v_rd_off(D0, 2, 1)>(vb), l3 = tr_read<v_rd_off(D0, 3, 0)>(vb), h3 = tr_read<v_rd_off(D0, 3, 1)>(vb);
  asm volatile("s_waitcnt lgkmcnt(0)" ::: "memory"); SBAR();
#define PK(L, H) (bf16x8){L[0], L[1], L[2], L[3], H[0], H[1], H[2], H[3]}
  od = __builtin_amdgcn_mfma_f32_32x32x16_bf16(pa0, PK(l0, h0), od, 0, 0, 0);
  od = __builtin_amdgcn_mfma_f32_32x32x16_bf16(pa1, PK(l1, h1), od, 0, 0, 0);
  od = __builtin_amdgcn_mfma_f32_32x32x16_bf16(pa2, PK(l2, h2), od, 0, 0, 0);
  od = __builtin_amdgcn_mfma_f32_32x32x16_bf16(pa3, PK(l3, h3), od, 0, 0, 0);
#undef PK
}
__device__ __forceinline__ void pv_d0(f32x16* o, int vb, bf16x8 pa0, bf16x8 pa1, bf16x8 pa2, bf16x8 pa3) {
  pv_one<0>(o[0], vb, pa0, pa1, pa2, pa3); pv_one<1>(o[1], vb, pa0, pa1, pa2, pa3); pv_one<2>(o[2], vb, pa0, pa1, pa2, pa3); pv_one<3>(o[3], vb, pa0, pa1, pa2, pa3);
}
__device__ __forceinline__ void attn_body(const bf16_t* __restrict__ Qb, const bf16_t* __restrict__ Kh, const bf16_t* __restrict__ Vh, bf16_t* __restrict__ Ob, int seq, char* lds) {
  int tid_ = threadIdx.x; asm volatile("" : "+v"(tid_));
  const int tid = tid_, wid = tid >> 6, lane = tid & 63, r32 = lane & 31, hi = lane >> 5;
  char* V_lds = lds; char* K_lds = lds + 2 * SHM_V;
  float* ws = (float*)(lds + 2 * SHM_V + 2 * SHM_K) + wid * 64; float* li_l = ws; float* al_l = ws + 32;
  float m_reg = -1e30f, l_reg = 0; f32x16 o[4] = {}; bf16x8 qr[8];
  const bf16_t* Qw = Qb + (long)(wid * QBLK + r32) * LDQ + hi * 8;
  char* qrl = lds + 2 * SHM_V + 2 * SHM_K + NW * 64 * 4 + wid * 4096 + r32 * 128;
#pragma unroll
  for (int d0 = 0; d0 < 8; ++d0) qr[d0] = *reinterpret_cast<const bf16x8*>(Qw + d0 * 16);
#pragma unroll
  for (int d0 = 8; d0 < 12; ++d0) *reinterpret_cast<bf16x8*>(qrl + ((((d0 - 8) * 2 + hi) ^ (r32 & 7)) << 4)) = *reinterpret_cast<const bf16x8*>(Qw + d0 * 16);
  asm volatile("s_waitcnt lgkmcnt(0)" ::: "memory");
  unsigned kgo[3], vgo[2];
#pragma unroll
  for (int i = 0; i < 3; ++i) { const int p = (i * 8 + wid) * 64 + lane, row = p / 24, slot = p % 24, ch = slot ^ (row & 7); kgo[i] = (unsigned)(row * LDK + ch * 8) * 2u; }
#pragma unroll
  for (int i = 0; i < 2; ++i) { const int p = (i * 8 + wid) * 64 + lane, sub = p >> 5, within = p & 31, kk = (sub >> 2) * 8 + (within >> 2), c = (sub & 3) * 32 + (within & 3) * 8;
    const int k = (kk & ~0xC) | ((kk & 4) << 1) | ((kk & 8) >> 1); vgo[i] = (unsigned)(k * LDV + c) * 2u; }
  const int vb0 = (int)(uintptr_t)V_lds + v_rd_base(lane);
  typedef __attribute__((address_space(3))) unsigned lds_u32;
#define DMA_K(b, k0) do { const char* kg = (const char*)Kh + (size_t)(k0) * (LDK * 2); \
    _Pragma("unroll") for (int _i = 0; _i < 3; ++_i) __builtin_amdgcn_global_load_lds((const unsigned*)(kg + kgo[_i]), (lds_u32*)(K_lds + (b) * SHM_K + (_i * 8 + wid) * 1024), 16, 0, 0); } while (0)
#define DMA_V(b, k0) do { const char* vg = (const char*)Vh + (size_t)(k0) * (LDV * 2); \
    _Pragma("unroll") for (int _i = 0; _i < 2; ++_i) __builtin_amdgcn_global_load_lds((const unsigned*)(vg + vgo[_i]), (lds_u32*)(V_lds + (b) * SHM_V + (_i * 8 + wid) * 1024), 16, 0, 0); } while (0)
#define RESC(a) do { if (__any((a) < 1.f)) { if (hi == 0) al_l[r32] = (a); asm volatile("s_waitcnt lgkmcnt(0)" ::: "memory"); \
    for (int d = 0; d < 4; ++d) for (int r = 0; r < 16; ++r) o[d][r] *= al_l[crow(r, hi)]; } } while (0)
#define ENDSTEP() do { asm volatile("s_waitcnt vmcnt(0)" ::: "memory"); __syncthreads(); } while (0)
  f32x16 pA0, pA1, pB0, pB1; float mnA, mnB, alA, alB; bf16x8 pa0, pa1, pa2, pa3; const int NT = seq / KVBLK;
  DMA_K(0, 0); ENDSTEP();
  DMA_K(1, KVBLK); DMA_V(0, 0);
  qkt(pA0, pA1, K_lds, qr, qrl, r32, hi); partialSM(pA0, pA1, m_reg, mnA, alA);
  ENDSTEP();
  for (int j = 1; j + 1 < NT; j += 2) {
    DMA_K(0, (j + 1) * KVBLK); DMA_V(1, j * KVBLK);
    SBAR(); qkt(pB0, pB1, K_lds + SHM_K, qr, qrl, r32, hi);
    finishSM(pA0, pA1, alA, l_reg, pa0, pa1, pa2, pa3); SBAR();
    pv_d0(o, vb0, pa0, pa1, pa2, pa3); partialSM(pB0, pB1, m_reg, mnB, alB);
    RESC(alB); ENDSTEP();
    if (j + 2 < NT) DMA_K(1, (j + 2) * KVBLK);
    DMA_V(0, (j + 1) * KVBLK);
    SBAR(); qkt(pA0, pA1, K_lds, qr, qrl, r32, hi);
    finishSM(pB0, pB1, alB, l_reg, pa0, pa1, pa2, pa3); SBAR();
    pv_d0(o, vb0 + (int)SHM_V, pa0, pa1, pa2, pa3); partialSM(pA0, pA1, m_reg, mnA, alA);
    RESC(alA); ENDSTEP();
  }
  DMA_V(1, (NT - 1) * KVBLK);
  SBAR(); qkt(pB0, pB1, K_lds + SHM_K, qr, qrl, r32, hi);
  finishSM(pA0, pA1, alA, l_reg, pa0, pa1, pa2, pa3); SBAR();
  pv_d0(o, vb0, pa0, pa1, pa2, pa3); partialSM(pB0, pB1, m_reg, mnB, alB);
  RESC(alB); ENDSTEP();
  finishSM(pB0, pB1, alB, l_reg, pa0, pa1, pa2, pa3); SBAR();
  pv_d0(o, vb0 + (int)SHM_V, pa0, pa1, pa2, pa3);
#undef DMA_K
#undef DMA_V
#undef ENDSTEP
  if (hi == 0) li_l[r32] = l_reg; asm volatile("s_waitcnt lgkmcnt(0)" ::: "memory");
  float rli[16];
#pragma unroll
  for (int r = 0; r < 16; ++r) rli[r] = __builtin_amdgcn_rcpf(li_l[crow(r, hi)]);
  bf16_t* Ow = Ob + (long)(wid * QBLK) * LDO;
#pragma unroll
  for (int r = 0; r < 16; ++r) { int orow = crow(r, hi);
#pragma unroll
    for (int d0 = 0; d0 < 4; ++d0) { const float val = o[d0][r] * rli[r]; Ow[(long)orow * LDO + d0 * 32 + r32] = (bf16_t)(cvtpk(val, val) & 0xffff); } }
  __syncthreads();
#undef RESC
}
}
__device__ __forceinline__ f32x2 cmul(f32x2 a, f32x2 b) { return (f32x2){a.x * b.x - a.y * b.y, a.x * b.y + a.y * b.x}; }
__device__ __forceinline__ int rev4_14(int k) { const unsigned r = __brev((unsigned)k) >> 18; return (int)(((r & 0x1555u) << 1) | ((r >> 1) & 0x1555u)); }
#define ZI(i) ((i) + ((i) >> 5))
__device__ __forceinline__ void fft_tw(int j, int q, float sign, f32x2& w1, f32x2& w2, f32x2& w3) {
    const float rev = (float)j / (float)(4 * q); const float sn = __builtin_amdgcn_sinf(rev), cs = __builtin_amdgcn_cosf(rev);
    w1 = (f32x2){cs, sign * sn}; w2 = cmul(w1, w1); w3 = cmul(w2, w1);
}
__device__ __forceinline__ void fft16k_dif(LAS f32x2* Z, int tid) {
#pragma unroll 1
    for (int s = 0; s < 7; ++s) { int lq = 12 - 2 * s; asm volatile("" : "+s"(lq)); const int q = 1 << lq;
        const bool shared = q <= 512; f32x2 w1, w2, w3; fft_tw(tid & (q - 1), q, -1.f, w1, w2, w3);
#pragma unroll 2
        for (int i = 0; i < 8; ++i) { const int b = tid + 512 * i, j = b & (q - 1), base = ((b >> lq) << (lq + 2)) + j;
            const int i0 = ZI(base), i1 = ZI(base + q), i2 = ZI(base + 2 * q), i3 = ZI(base + 3 * q);
            const f32x2 a0 = Z[i0], a1 = Z[i1], a2 = Z[i2], a3 = Z[i3];
            const f32x2 t0 = a0 + a2, t1 = a0 - a2, t2 = a1 + a3, t3 = a1 - a3;
            if (!shared) fft_tw(j, q, -1.f, w1, w2, w3);
            Z[i0] = t0 + t2; Z[i1] = cmul((f32x2){t1.x + t3.y, t1.y - t3.x}, w1); Z[i2] = cmul(t0 - t2, w2); Z[i3] = cmul((f32x2){t1.x - t3.y, t1.y + t3.x}, w3); }
        __syncthreads(); }
}
__device__ __forceinline__ void fft16k_dit_inv(LAS f32x2* Z, int tid) {
#pragma unroll 1
    for (int s = 0; s < 7; ++s) { int lq = 2 * s; asm volatile("" : "+s"(lq)); const int q = 1 << lq;
        const bool shared = q <= 512; f32x2 w1, w2, w3; fft_tw(tid & (q - 1), q, 1.f, w1, w2, w3);
#pragma unroll 2
        for (int i = 0; i < 8; ++i) { const int b = tid + 512 * i, j = b & (q - 1), base = ((b >> lq) << (lq + 2)) + j;
            if (!shared) fft_tw(j, q, 1.f, w1, w2, w3);
            const int i0 = ZI(base), i1 = ZI(base + q), i2 = ZI(base + 2 * q), i3 = ZI(base + 3 * q);
            const f32x2 b0 = Z[i0], b1 = cmul(Z[i1], w1), b2 = cmul(Z[i2], w2), b3 = cmul(Z[i3], w3);
            const f32x2 t0 = b0 + b2, t1 = b0 - b2, t2 = b1 + b3, t3 = b1 - b3;
            Z[i0] = t0 + t2; Z[i1] = (f32x2){t1.x - t3.y, t1.y + t3.x}; Z[i2] = t0 - t2; Z[i3] = (f32x2){t1.x + t3.y, t1.y - t3.x}; }
        __syncthreads(); }
}
constexpr float HY_MIN_DECAY = -3.0701134573253945f, HY_MAX_DECAY = -15.350567286626973f;
__device__ __forceinline__ float hy_delta(int c) { return fabsf(HY_MIN_DECAY + (HY_MAX_DECAY - HY_MIN_DECAY) * ((float)c / 1279.0f)); }
__device__ __forceinline__ float conv3b_at(const bf16_t* PX, int tau, int col, const float* cw, int l, int c) {
    const float* w = cw + (size_t)l * 3 * B_IN;
    return conv3_at(PX, tau, col, w[c], w[B_IN + c], w[2 * B_IN + c]);
}
__device__ __forceinline__ void hyena_taps_unit(const Frame& F, unsigned char* ws, int l, int pair) {
    LAS f32x2* Z = (LAS f32x2*)F.lds; LAS float* red = (LAS float*)(F.lds + LDS_MISC + 128);
    const int tid = F.tid, c0 = 2 * pair;
    const bf16_t* H3x = (const bf16_t*)(ws + WS_H3) + (size_t)l * 64 * T + NCTX;
    f32x4* scr4 = (f32x4*)(ws + WS_HSCR) + (size_t)pair * HT_STRIDE; float* htn = (float*)(ws + WS_HTN) + 2 * pair;
    LAS f32x4* FW = (LAS f32x4*)(F.lds + LDS_MISC + 256);
    if (tid < 256) { const int j = tid >> 2, q = tid & 3; ((LAS float*)FW)[tid] = IN_(35)[(size_t)l * 64 * 2560 + (size_t)j * 2560 + (q >> 1) * 1280 + c0 + (q & 1)]; }
    __syncthreads();
    const float d0 = hy_delta(c0), d1 = hy_delta(c0 + 1);
#ifndef HYS
#define HYS 31
#endif
    float s0, s1, sc0 = 0.f, sc1 = 0.f;
    {
    s0 = 0.f; s1 = 0.f;
    if (HYS & 1)
#pragma unroll 1
    for (int i = 0; i < 2; ++i) { const int tb = 4096 * i + 8 * tid; const bf16_t* hc = H3x + tb;
        asm volatile("" ::: "memory");
        f32x4 acc[8];
#pragma unroll
        for (int p = 0; p < 8; ++p) acc[p] = (f32x4){0.f, 0.f, 0.f, 0.f};
#pragma unroll 8
        for (int j = 0; j < 64; ++j) { const f32x4 w = FW[j]; const u32x4 hv = *(const u32x4*)(hc + (size_t)j * T);
#pragma unroll
            for (int p = 0; p < 4; ++p) { acc[2 * p] += w * __uint_as_float(hv[p] << 16); acc[2 * p + 1] += w * __uint_as_float(hv[p] & 0xffff0000u); } }
#pragma unroll
        for (int p = 0; p < 8; ++p) { const int t = tb + p;
            const float tl = (float)t * (1.0f / 8191.0f), e0 = __expf(-tl * d0), e1 = __expf(-tl * d1);
            const float f0 = acc[p].x * e0, f1 = acc[p].y * e1, b0 = acc[p].z * e0, b1 = acc[p].w * e1;
            Z[ZI(t)] = (f32x2){f0, f1}; s0 += fabsf(f0); s1 += fabsf(f1);
            if (t < 8191) { Z[ZI(16383 - t)] = (f32x2){b0, b1}; s0 += fabsf(b0); s1 += fabsf(b1); } } }
    if (tid == 0) { float zz = 0.f; asm volatile("" : "+v"(zz)); Z[ZI(8192)] = (f32x2){zz, zz}; }
    s0 = wave_sum(s0); s1 = wave_sum(s1);
    if (F.lane == 0) { red[F.wave * 2] = s0; red[F.wave * 2 + 1] = s1; }
    __syncthreads();
    float n0 = 0.f, n1 = 0.f;
#pragma unroll
    for (int w = 0; w < 8; ++w) { n0 += red[2 * w]; n1 += red[2 * w + 1]; }
    sc0 = 1.0f / (16384.0f * n0); sc1 = 1.0f / (16384.0f * n1);
    if (HYS & 2) fft16k_dif(Z, tid);
#pragma unroll 2
    for (int i = 0; i < 17; ++i) { const int k = tid + 512 * i; if (i == 16 && tid != 0) break;
        const int pk = rev4_14(k & 16383), pn = rev4_14((16384 - k) & 16383);
        const f32x2 At = Z[ZI(pk)], Bt = Z[ZI(pn)];
        scr4[k] = (f32x4){0.5f * (At.x + Bt.x), 0.5f * (At.y - Bt.y), 0.5f * (At.y + Bt.y), -0.5f * (At.x - Bt.x)}; }
    __syncthreads();
    }
    if (tid == 0) { htn[0] = sc0; htn[1] = sc1; }
    __syncthreads();
}
__device__ __forceinline__ void hyena_unit(const Frame& F, unsigned char* ws, int l, int pair) {
    LAS f32x2* Z = (LAS f32x2*)F.lds;
    const int tid = F.tid, c0 = 2 * pair;
    float* GT = (float*)(ws + WS_GT); const float* X0T = (const float*)(ws + WS_X0T);
    const f32x4* scr4 = (const f32x4*)(ws + WS_HSCR) + (size_t)pair * HT_STRIDE; const float* htn = (const float*)(ws + WS_HTN) + 2 * pair;
    const float sc0 = htn[0], sc1 = htn[1];
#ifndef HYS
#define HYS 31
#endif
    for (int rp15 = 0; rp15 < REP(15); ++rp15) {
    const float* g0p = GT + (size_t)c0 * T + NCTX; const float* g1p = g0p + T;
    f32x4 Hr[17];
    { float zz = 0.f; asm volatile("" : "+v"(zz));
      f32x2 ga[8], gb[8];
#pragma unroll
      for (int i = 0; i < 8; ++i) { const int t = 2 * tid + 1024 * i; ga[i] = *(const f32x2*)(g0p + t); gb[i] = *(const f32x2*)(g1p + t); }
#pragma unroll
      for (int i = 0; i < 17; ++i) Hr[i] = scr4[i < 16 ? tid + 512 * i : 8192];
#pragma unroll
      for (int i = 0; i < 8; ++i) { const int t = 2 * tid + 1024 * i; Z[ZI(t)] = (f32x2){ga[i].x, gb[i].x}; Z[ZI(t + 1)] = (f32x2){ga[i].y, gb[i].y}; Z[ZI(8192 + t)] = (f32x2){zz, zz}; Z[ZI(8193 + t)] = (f32x2){zz, zz}; } }
    __syncthreads();
    if (HYS & 2) fft16k_dif(Z, tid);
    if (HYS & 8)
#pragma unroll
    for (int i = 0; i < 17; ++i) { const int k = tid + 512 * i; if (i == 16 && tid != 0) break;
        const int pk = rev4_14(k & 16383), pn = rev4_14((16384 - k) & 16383);
        const f32x2 A = Z[ZI(pk)], B = Z[ZI(pn)];
        const f32x2 G0 = (f32x2){0.5f * (A.x + B.x), 0.5f * (A.y - B.y)}, G1 = (f32x2){0.5f * (A.y + B.y), -0.5f * (A.x - B.x)};
        const f32x2 H0 = (f32x2){Hr[i].x, Hr[i].y}, H1 = (f32x2){Hr[i].z, Hr[i].w};
        const f32x2 P0 = cmul(G0, H0), P1 = cmul(G1, H1);
        Z[ZI(pk)] = (f32x2){P0.x - P1.y, P0.y + P1.x};
        if (pn != pk) Z[ZI(pn)] = (f32x2){P0.x + P1.y, P1.x - P0.y}; }
    __syncthreads();
    if (HYS & 2) fft16k_dit_inv(Z, tid);
    }
    const float bb0 = IN_(37)[l * 1280 + c0], bb1 = IN_(37)[l * 1280 + c0 + 1];
    { float* y0p = GT + (size_t)c0 * T + NCTX; float* y1p = y0p + T; const float* x0p = X0T + (size_t)c0 * T + NCTX; const float* x1p = x0p + T;
      f32x2 ga[8], gb[8], xa[8], xb[8];
#pragma unroll
      for (int i = 0; i < 8; ++i) { const int t = 2 * tid + 1024 * i; ga[i] = *(const f32x2*)(y0p + t); gb[i] = *(const f32x2*)(y1p + t); xa[i] = *(const f32x2*)(x0p + t); xb[i] = *(const f32x2*)(x1p + t); }
#pragma unroll
      for (int i = 0; i < 8; ++i) { const int t = 2 * tid + 1024 * i; const f32x2 z0 = Z[ZI(t)], z1 = Z[ZI(t + 1)];
          *(f32x2*)(y0p + t) = (f32x2){xa[i].x * (z0.x * sc0 + ga[i].x * bb0), xa[i].y * (z1.x * sc0 + ga[i].y * bb0)};
          *(f32x2*)(y1p + t) = (f32x2){xb[i].x * (z0.y * sc1 + gb[i].x * bb1), xb[i].y * (z1.y * sc1 + gb[i].y * bb1)}; } }
    __syncthreads();
}
__device__ __forceinline__ void hyena_ctx_unit(const Frame& F, unsigned char* ws, int l, int unit) {
    LAS float* TF = (LAS float*)F.lds; LAS float* TB = TF + 2048; LAS float* GG = TB + 2048;
    const int tid = F.tid, t = tid >> 1, cc = (tid & 1) * 4, cbase = unit * 8 + cc;
    const bf16_t* H3c = (const bf16_t*)(ws + WS_H3) + (size_t)l * 64 * T; float* GT = (float*)(ws + WS_GT); const float* X0T = (const float*)(ws + WS_X0T);
    { float f[4] = {0.f, 0.f, 0.f, 0.f}, b[4] = {0.f, 0.f, 0.f, 0.f};
      const float* wbase = IN_(35) + (size_t)l * 64 * 2560 + cbase;
      for (int j = 0; j < 64; ++j) { const float hv = bf2f(H3c[(size_t)j * T + t]); const float* wrow = wbase + (size_t)j * 2560;
#pragma unroll
          for (int q = 0; q < 4; ++q) { f[q] += hv * wrow[q]; b[q] += hv * wrow[1280 + q]; } }
      const float tl = (float)t * (1.0f / 255.0f);
#pragma unroll
      for (int q = 0; q < 4; ++q) { const float e = __expf(-tl * hy_delta(cbase + q)); TF[t * 8 + cc + q] = f[q] * e; TB[t * 8 + cc + q] = b[q] * e; GG[t * 8 + cc + q] = GT[(size_t)(cbase + q) * T + t]; } }
    __syncthreads();
    float nrm[4] = {0.f, 0.f, 0.f, 0.f}, y[4] = {0.f, 0.f, 0.f, 0.f};
    for (int s = 0; s < 256; ++s) {
#pragma unroll
        for (int q = 0; q < 4; ++q) { nrm[q] += fabsf(TF[s * 8 + cc + q]) + (s < 255 ? fabsf(TB[s * 8 + cc + q]) : 0.f);
            const int o = t - s; const float tap = o >= 0 ? TF[o * 8 + cc + q] : TB[(-o - 1) * 8 + cc + q];
            y[q] += tap * GG[s * 8 + cc + q]; } }
    __syncthreads();
#pragma unroll
    for (int q = 0; q < 4; ++q) GT[(size_t)(cbase + q) * T + t] = X0T[(size_t)(cbase + q) * T + t] * (y[q] / nrm[q] + GG[t * 8 + cc + q] * IN_(37)[l * 1280 + cbase + q]);
    __syncthreads();
}
constexpr int SC_C = 16, SC_NCHUNK = T / SC_C, SC_CHUNK_BYTES = 14 * 1024;
__device__ __forceinline__ int sc_tau(int d, int c, int t) { return d == 0 ? SC_C * c + t : (c < NCTX / SC_C ? NCTX - 1 - SC_C * c - t : T - 1 - SC_C * (c - NCTX / SC_C) - t); }
__device__ __forceinline__ int sc_perm(int e, int hi) { return (e & 3) + 8 * (e >> 2) + 4 * hi; }
constexpr size_t WS_FR_BYTES = (size_t)2 * NHA * SC_NCHUNK * SC_CHUNK_BYTES;

typedef short sc_bf16x8 __attribute__((ext_vector_type(8)));
typedef float sc_f32x16 __attribute__((ext_vector_type(16)));
__device__ __forceinline__ sc_bf16x8 sc_pack8(const sc_f32x16& a, int base) {
    u32x4 w; w.x = cvt_pk_bf16(a[base + 0], a[base + 1]); w.y = cvt_pk_bf16(a[base + 2], a[base + 3]); w.z = cvt_pk_bf16(a[base + 4], a[base + 5]); w.w = cvt_pk_bf16(a[base + 6], a[base + 7]);
    return *reinterpret_cast<sc_bf16x8*>(&w);
}
constexpr int SC_NSLOT = 9, SC_AHEAD = 7;
__device__ __forceinline__ void scan_chain_mfma(const Frame& F, unsigned char* ws, int chain) {
    const int h = chain >> 1, d = chain & 1, lane = F.lane, n = lane & 31, hi = lane >> 5, ib = F.wave;
    const unsigned char* FRc = ws + WS_FR + (size_t)chain * SC_NCHUNK * SC_CHUNK_BYTES;
    float* Yd = (float*)(ws + WS_Y) + (size_t)d * T * A_W + h * 64;
    LAS unsigned char* buf = F.lds;
    typedef __attribute__((address_space(3))) unsigned sc_lds_u32;
#define SCM_DMA(c_) do { if (ib < 7) { const unsigned char* src_ = FRc + (size_t)(c_) * SC_CHUNK_BYTES; LAS unsigned char* dst_ = buf + ((c_) % SC_NSLOT) * SC_CHUNK_BYTES; \
        _Pragma("unroll") for (int i_ = 0; i_ < 2; ++i_) __builtin_amdgcn_global_load_lds((const unsigned*)(src_ + (i_ * 7 + ib) * 1024 + lane * 16), (sc_lds_u32*)(dst_ + (i_ * 7 + ib) * 1024), 16, 0, 0); } } while (0)
    sc_f32x16 S0 = {}, S1 = {};
    int yoff[8];
#pragma unroll
    for (int r = 0; r < 8; ++r) { const int t = (r & 3) + 8 * (r >> 2) + 4 * hi; yoff[r] = (d ? -t : t) * A_W + 32 * ib + n; }
    __syncthreads();
#pragma unroll
    for (int c = 0; c < SC_AHEAD; ++c) SCM_DMA(c);
    asm volatile("s_waitcnt vmcnt(12)" ::: "memory"); __builtin_amdgcn_s_barrier(); asm volatile("" ::: "memory");
#pragma unroll 1
    for (int c = 0; c < SC_NCHUNK; ++c) {
        const bool steady = c + SC_AHEAD < SC_NCHUNK;
        if (steady) SCM_DMA(c + SC_AHEAD);
        if (ib < 2) {
                const LAS unsigned char* fb = buf + (c % SC_NSLOT) * SC_CHUNK_BYTES;
                sc_bf16x8 fr[11]; sc_bf16x8 vf; f32x4 gt[8];
                { const unsigned fa = (unsigned)(uintptr_t)fb + lane * 16, va = fa + (11 + ib) * 1024, ga = (unsigned)(uintptr_t)fb + 13 * 1024 + hi * 128;
#define SC_DSRD(dst, addr, off) asm volatile("ds_read_b128 %0, %1 offset:%2" : "=v"(dst) : "v"(addr), "i"(off))
                  SC_DSRD(fr[0], fa, 0); SC_DSRD(fr[1], fa, 1024); SC_DSRD(fr[2], fa, 2048); SC_DSRD(fr[3], fa, 3072); SC_DSRD(fr[4], fa, 4096); SC_DSRD(fr[5], fa, 5120);
                  SC_DSRD(fr[6], fa, 6144); SC_DSRD(fr[7], fa, 7168); SC_DSRD(fr[8], fa, 8192); SC_DSRD(fr[9], fa, 9216); SC_DSRD(fr[10], fa, 10240); SC_DSRD(vf, va, 0);
                  SC_DSRD(gt[0], ga, 0); SC_DSRD(gt[1], ga, 16); SC_DSRD(gt[2], ga, 32); SC_DSRD(gt[3], ga, 48); SC_DSRD(gt[4], ga, 64); SC_DSRD(gt[5], ga, 80); SC_DSRD(gt[6], ga, 96); SC_DSRD(gt[7], ga, 112);
#undef SC_DSRD
                  asm volatile("s_waitcnt lgkmcnt(0)" : "+v"(fr[0]), "+v"(fr[1]), "+v"(fr[2]), "+v"(fr[3]), "+v"(fr[4]), "+v"(fr[5]), "+v"(fr[6]), "+v"(fr[7]), "+v"(fr[8]), "+v"(fr[9]), "+v"(fr[10]), "+v"(vf) :: "memory");
                  asm volatile("" : "+v"(gt[0]), "+v"(gt[1]), "+v"(gt[2]), "+v"(gt[3]), "+v"(gt[4]), "+v"(gt[5]), "+v"(gt[6]), "+v"(gt[7])); }
                const sc_bf16x8 sb00 = sc_pack8(S0, 0), sb01 = sc_pack8(S0, 8), sb10 = sc_pack8(S1, 0), sb11 = sc_pack8(S1, 8);
                sc_f32x16 P = {}, P2 = {};
                P = __builtin_amdgcn_mfma_f32_32x32x16_bf16(fr[0], sb00, P, 0, 0, 0);
                P2 = __builtin_amdgcn_mfma_f32_32x32x16_bf16(fr[2], sb10, P2, 0, 0, 0);
                P = __builtin_amdgcn_mfma_f32_32x32x16_bf16(fr[1], sb01, P, 0, 0, 0);
                P2 = __builtin_amdgcn_mfma_f32_32x32x16_bf16(fr[3], sb11, P2, 0, 0, 0);
                P = __builtin_amdgcn_mfma_f32_32x32x16_bf16(fr[4], vf, P, 0, 0, 0);
#pragma unroll
                for (int q = 0; q < 4; ++q)
#pragma unroll
                    for (int e = 0; e < 4; ++e) { S0[4 * q + e] *= gt[q][e]; S1[4 * q + e] *= gt[4 + q][e]; }
                S0 = __builtin_amdgcn_mfma_f32_32x32x16_bf16(fr[8], vf, S0, 0, 0, 0);
                S1 = __builtin_amdgcn_mfma_f32_32x32x16_bf16(fr[10], vf, S1, 0, 0, 0);
#pragma unroll
                for (int r = 0; r < 16; ++r) P[r] += P2[r];
                const sc_bf16x8 xb = sc_pack8(P, 0);
                sc_f32x16 U = {};
                U = __builtin_amdgcn_mfma_f32_32x32x16_bf16(fr[5], xb, U, 0, 0, 0);
                const sc_bf16x8 ub = sc_pack8(U, 0);
                S0 = __builtin_amdgcn_mfma_f32_32x32x16_bf16(fr[7], ub, S0, 0, 0, 0);
                S1 = __builtin_amdgcn_mfma_f32_32x32x16_bf16(fr[9], ub, S1, 0, 0, 0);
                P = __builtin_amdgcn_mfma_f32_32x32x16_bf16(fr[6], ub, P, 0, 0, 0);
                float* yb = Yd + (size_t)sc_tau(d, c, 0) * A_W;
#pragma unroll
                for (int r = 0; r < 8; ++r) yb[yoff[r]] = P[8 + r];
        }
        if (steady) asm volatile("s_waitcnt vmcnt(12)" ::: "memory"); else asm volatile("s_waitcnt vmcnt(0)" ::: "memory");
        asm volatile("s_waitcnt lgkmcnt(0)" ::: "memory"); __builtin_amdgcn_s_barrier(); asm volatile("" ::: "memory");
    }
    asm volatile("s_waitcnt vmcnt(0)" ::: "memory"); __syncthreads();
#undef SCM_DMA
}
__device__ __forceinline__ float conv3_u(const float* PX, int tau, unsigned ucol, float w0, float w1, float w2) {
    const float* p = PX + (size_t)tau * PXW;
    float y = p[ucol] * w1;
    if (has_left(tau)) y += (p - PXW)[ucol] * w0;
    if (has_right(tau)) y += (p + PXW)[ucol] * w2;
    return y;
}
constexpr int WLR_K = 448;
constexpr int RP_WAVE_LDS = 16896;
typedef short rp_bf16x8 __attribute__((ext_vector_type(8)));
typedef float rp_f32x16 __attribute__((ext_vector_type(16)));
__device__ __forceinline__ unsigned short f2bf16(float x) { return (unsigned short)(cvt_pk_bf16(x, x) & 0xffffu); }
template <int NKB, class AF>
__device__ __forceinline__ void rp_lowrank(float (&dst)[16], const AF& afrag, const bf16_t* WLRh, int kw0, int n, int hi) {
    rp_f32x16 c0 = {}, c1 = {}; const bf16_t* wb0 = WLRh + (size_t)n * WLR_K + kw0 + 8 * hi; const bf16_t* wb1 = wb0 + (size_t)32 * WLR_K;
#pragma unroll
    for (int kb = 0; kb < NKB; ++kb) { const rp_bf16x8 b0 = *(const rp_bf16x8*)(wb0 + 16 * kb), b1 = *(const rp_bf16x8*)(wb1 + 16 * kb); const rp_bf16x8 a_ = afrag(kb);
        c0 = __builtin_amdgcn_mfma_f32_32x32x16_bf16(a_, b0, c0, 0, 0, 0); c1 = __builtin_amdgcn_mfma_f32_32x32x16_bf16(a_, b1, c1, 0, 0, 0); }
#pragma unroll
    for (int r = 0; r < 8; ++r) { auto sw = __builtin_amdgcn_permlane32_swap(__float_as_uint(c0[r]), __float_as_uint(c1[r]), false, false);
        dst[(r & 3) + 8 * (r >> 2)] = __uint_as_float(sw[0]); dst[(r & 3) + 8 * (r >> 2) + 4] = __uint_as_float(sw[1]); }
}
struct RpAfLds { const LAS bf16_t* base; __device__ __forceinline__ rp_bf16x8 operator()(int kb) const { return *(const LAS rp_bf16x8*)(base + 16 * kb); } };
__device__ __forceinline__ void rwkv_elem_phase(const Frame& F, unsigned char* ws, int l) {
    const float* PX = (const float*)(ws + WS_PX); float* SS = (float*)(ws + WS_SS); float* SD = (float*)(ws + WS_SD); float* GB = (float*)(ws + WS_G);
    const bf16_t* WLR = (const bf16_t*)(ws + WS_WLR) + (size_t)l * A_W * WLR_K;
    const float* cw = IN_(16) + (size_t)l * 3 * A_IN;
    LAS bf16_t* ACT = (LAS bf16_t*)(F.lds + F.wave * 10752);
    const int lane = F.lane, n = lane & 31, hi = lane >> 5;
    const int gw = F.bid * 8 + F.wave, NGW = F.G * 8;
    for (int it = gw; it < (T / 16) * 10; it += NGW) {
        const int tg = it / 10, hq = it % 10, tau0 = tg * 16;
        asm volatile("s_waitcnt lgkmcnt(0)" ::: "memory");
        const float* prow0 = PX + (size_t)(tau0 > 0 ? tau0 - 1 : 0) * PXW; const int roff = tau0 > 0 ? 0 : -1;
#define RP_WIN(x, ucol_) do { _Pragma("unroll") for (int i_ = 0; i_ < 18; ++i_) { int ri_ = i_ + roff; ri_ = ri_ < 0 ? 0 : ri_; ri_ = (tau0 - 1 + i_ > T - 1) ? (T - 1 - (tau0 > 0 ? tau0 - 1 : 0)) : ri_; x[i_] = (prow0 + (size_t)ri_ * PXW)[ucol_]; } } while (0)
#define RP_CONV(x, t_, w0_, w1_, w2_) (x[(t_)] * (has_left(tau0 + (t_)) ? (w0_) : 0.f) + x[(t_) + 1] * (w1_) + x[(t_) + 2] * (has_right(tau0 + (t_)) ? (w2_) : 0.f))
#pragma unroll
        for (int i = 0; i < 5; ++i) { const int c = lane + 64 * i, col = 3840 + c; const float c0 = cw[col], c1 = cw[A_IN + col], c2 = cw[2 * A_IN + col];
            float x[18]; RP_WIN(x, (unsigned)(PXA + col));
#pragma unroll
            for (int t = 0; t < 16; ++t) { const float val = RP_CONV(x, t, c0, c1, c2);
                const float act = i == 0 ? 1.0f - 2.0f / (1.0f + __expf(2.0f * val)) : (i == 1 ? val : sigmoidf_(val));
                ACT[t * 328 + c] = f2bf16(act); } }
        asm volatile("s_waitcnt lgkmcnt(0)" ::: "memory");
        const RpAfLds afw{ACT + (n & 15) * 328 + 8 * hi}, afa{ACT + (n & 15) * 328 + 64 + 8 * hi}, afg{ACT + (n & 15) * 328 + 128 + 8 * hi};
#pragma unroll 1
        for (int hh = 0; hh < 2; ++hh) {
            const int h = hq * 2 + hh, col = h * 64 + lane; const bf16_t* WLRh = WLR + (size_t)h * 64 * WLR_K;
            { float lg[16]; rp_lowrank<12>(lg, afg, WLRh, 256, n, hi);
#pragma unroll
              for (int t = 0; t < 16; ++t) GB[(size_t)(tau0 + t) * A_W + col] = lg[t]; }
            const float cr0 = cw[col], cr1 = cw[A_IN + col], cr2 = cw[2 * A_IN + col];
            const float ck0 = cw[A_W + col], ck1 = cw[A_IN + A_W + col], ck2 = cw[2 * A_IN + A_W + col];
            const float cv0 = cw[2 * A_W + col], cv1 = cw[A_IN + 2 * A_W + col], cv2 = cw[2 * A_IN + 2 * A_W + col];
            const float kk_w = IN_(22)[l * A_W + col], ka_w = IN_(23)[l * A_W + col];
            float kkv[16], kv[16];
            { float xr[18], xk[18], xv[18]; const unsigned uc = (unsigned)(PXA + col); RP_WIN(xr, uc); RP_WIN(xk, uc + A_W); RP_WIN(xv, uc + 2 * A_W);
#pragma unroll
              for (int t = 0; t < 16; ++t) { const int tau = tau0 + t;
                  const float r = RP_CONV(xr, t, cr0, cr1, cr2), v = RP_CONV(xv, t, cv0, cv1, cv2); kv[t] = RP_CONV(xk, t, ck0, ck1, ck2);
                  const float kr = kv[t] * kk_w; const float nrm = sqrtf(wave_sum(kr * kr)); kkv[t] = kr / fmaxf(nrm, 1e-12f);
                  float* ss = SS + ((size_t)h * T + tau) * 192 + lane; ss[0] = kkv[t]; ss[64] = r; ss[128] = v; } }
#pragma unroll 1
            for (int d = 0; d < 2; ++d) { const float w0b = IN_(17)[(l * 2 + d) * A_W + col], a0b = IN_(19)[(l * 2 + d) * A_W + col]; float lw[16], la[16];
                rp_lowrank<4>(lw, afw, WLRh, 64 * d, n, hi); rp_lowrank<4>(la, afa, WLRh, 128 + 64 * d, n, hi);
#pragma unroll
                for (int t = 0; t < 16; ++t) { const float z = w0b + lw[t]; const float decay = __expf(-__expf(-(fmaxf(-z, 0.f) + __logf(1.0f + __expf(-fabsf(z)))) - 0.5f)); const float av = sigmoidf_(a0b + la[t]);
                    float* sd = SD + (((size_t)h * 2 + d) * T + tau0 + t) * 192 + lane; sd[0] = decay; sd[64] = kkv[t] * av; sd[128] = kv[t] * (1.0f + (av - 1.0f) * ka_w); } }
        }
    }
}
#undef RP_WIN
#undef RP_CONV
constexpr int SP_WAVE_LDS = 16640;
__device__ __forceinline__ void scan_prep_phase(const Frame& F, unsigned char* ws) {
    const float* SS = (const float*)(ws + WS_SS); const float* SD = (const float*)(ws + WS_SD); unsigned char* FR = ws + WS_FR;
    LAS bf16_t* R1 = (LAS bf16_t*)(F.lds + F.wave * SP_WAVE_LDS); LAS bf16_t* R2 = R1 + 32 * 72; LAS bf16_t* BbT = R2 + 32 * 72; LAS bf16_t* KbT = BbT + 64 * 16; LAS bf16_t* VT = KbT + 64 * 16; LAS float* Lm = (LAS float*)(VT + 64 * 16);
    const int lane = F.lane, n = lane & 31, hi = lane >> 5;
    const int gw = F.bid * 8 + F.wave, NGW = F.G * 8;
    for (int it = gw; it < 2 * NHA * SC_NCHUNK; it += NGW) {
        const int chain = it / SC_NCHUNK, c = it % SC_NCHUNK, h = chain >> 1, d = chain & 1;
        const int tau_first = sc_tau(d, c, 0), dstep = d ? -1 : 1;
        const float* ssb = SS + (size_t)h * T * 192 + lane; const float* sdb = SD + ((size_t)h * 2 + d) * T * 192 + lane;
        float xw[16], xb[16], xk[16], xkk[16], xr[16], xv[16];
#pragma unroll
        for (int s = 0; s < 16; ++s) { const size_t o = (size_t)(tau_first + dstep * s) * 192; xw[s] = sdb[o]; xb[s] = sdb[o + 64]; xk[s] = sdb[o + 128]; xkk[s] = ssb[o]; xr[s] = ssb[o + 64]; xv[s] = ssb[o + 128]; }
        float gC = 1.f;
#pragma unroll
        for (int s = 0; s < 16; ++s) gC *= xw[s];
        float g = 1.f;
#pragma unroll
        for (int s = 0; s < 16; ++s) {
            const float gm1 = g; g *= xw[s]; const float ig = 1.0f / g; const float bh = xb[s] * ig, kh = xk[s] * ig;
            R1[s * 72 + lane] = f2bf16(-xkk[s] * gm1); R1[(16 + s) * 72 + lane] = f2bf16(xr[s] * g);
            R2[s * 72 + lane] = f2bf16(bh); R2[(16 + s) * 72 + lane] = f2bf16(kh);
            BbT[lane * 16 + s] = f2bf16(bh * gC); KbT[lane * 16 + s] = f2bf16(kh * gC); VT[lane * 16 + s] = f2bf16(xv[s]); }
        asm volatile("s_waitcnt lgkmcnt(0)" ::: "memory");
        unsigned char* dst = FR + ((size_t)chain * SC_NCHUNK + c) * SC_CHUNK_BYTES;
        rp_f32x16 C = {};
#pragma unroll
        for (int kb = 0; kb < 4; ++kb) { const rp_bf16x8 a_ = *(const LAS rp_bf16x8*)(R2 + n * 72 + 16 * kb + 8 * hi), b_ = *(const LAS rp_bf16x8*)(R1 + n * 72 + 16 * kb + 8 * hi);
            C = __builtin_amdgcn_mfma_f32_32x32x16_bf16(a_, b_, C, 0, 0, 0); }
        const int tt_ = n & 15; const bool incl = n >= 16;
#pragma unroll
        for (int r = 0; r < 16; ++r) { const int s = ((r & 7) & 3) + 8 * ((r & 7) >> 2) + 4 * hi; if (!(s < tt_ || (incl && s == tt_))) C[r] = 0.f; }
        if (n < 16) {
#pragma unroll
            for (int r = 0; r < 8; ++r) Lm[((r & 3) + 8 * (r >> 2) + 4 * hi) * 20 + n] = C[r]; }
        { u32x4 f4; f4.x = cvt_pk_bf16(C[8], C[9]); f4.y = cvt_pk_bf16(C[10], C[11]); f4.z = cvt_pk_bf16(C[12], C[13]); f4.w = cvt_pk_bf16(C[14], C[15]);
          u32x4 f6; f6.x = cvt_pk_bf16(C[0], C[1]); f6.y = cvt_pk_bf16(C[2], C[3]); f6.z = cvt_pk_bf16(C[4], C[5]); f6.w = cvt_pk_bf16(C[6], C[7]);
          if (n < 16) f6 = (u32x4){0u, 0u, 0u, 0u};
          *(u32x4*)(dst + 4 * 1024 + lane * 16) = f4; *(u32x4*)(dst + 6 * 1024 + lane * 16) = f6; }
        asm volatile("s_waitcnt lgkmcnt(0)" ::: "memory");
        { float Tc[16];
#pragma unroll
          for (int s = 15; s >= 0; --s) { float acc = (s == n) ? 1.f : 0.f;
#pragma unroll
              for (int u = s + 1; u < 16; ++u) acc += Lm[s * 20 + u] * Tc[u];
              Tc[s] = acc; }
          u32x4 f5; f5.x = cvt_pk_bf16(hi ? Tc[4] : Tc[0], hi ? Tc[5] : Tc[1]); f5.y = cvt_pk_bf16(hi ? Tc[6] : Tc[2], hi ? Tc[7] : Tc[3]);
          f5.z = cvt_pk_bf16(hi ? Tc[12] : Tc[8], hi ? Tc[13] : Tc[9]); f5.w = cvt_pk_bf16(hi ? Tc[14] : Tc[10], hi ? Tc[15] : Tc[11]);
          if (n >= 16) f5 = (u32x4){0u, 0u, 0u, 0u};
          *(u32x4*)(dst + 5 * 1024 + lane * 16) = f5; }
#pragma unroll
        for (int f = 0; f < 4; ++f) { const u32x2 p0 = *(const LAS u32x2*)(R1 + n * 72 + 16 * f + 4 * hi), p1 = *(const LAS u32x2*)(R1 + n * 72 + 16 * f + 8 + 4 * hi);
            *(u32x4*)(dst + f * 1024 + lane * 16) = (u32x4){p0.x, p0.y, p1.x, p1.y}; }
#pragma unroll
        for (int jb = 0; jb < 2; ++jb) { const int row = 32 * jb + n;
            const u32x2 b0 = *(const LAS u32x2*)(BbT + row * 16 + 4 * hi), b1 = *(const LAS u32x2*)(BbT + row * 16 + 8 + 4 * hi), k0 = *(const LAS u32x2*)(KbT + row * 16 + 4 * hi), k1 = *(const LAS u32x2*)(KbT + row * 16 + 8 + 4 * hi);
            const u32x2 v0 = *(const LAS u32x2*)(VT + row * 16 + 4 * hi), v1 = *(const LAS u32x2*)(VT + row * 16 + 8 + 4 * hi);
            *(u32x4*)(dst + (7 + 2 * jb) * 1024 + lane * 16) = (u32x4){b0.x, b0.y, b1.x, b1.y}; *(u32x4*)(dst + (8 + 2 * jb) * 1024 + lane * 16) = (u32x4){k0.x, k0.y, k1.x, k1.y};
            *(u32x4*)(dst + (11 + jb) * 1024 + lane * 16) = (u32x4){v0.x, v0.y, v1.x, v1.y}; }
        { const int jj = lane & 31; ((float*)(dst + 13 * 1024))[((jj >> 2) & 1) * 32 + (lane >> 5) * 16 + (jj & 3) + 4 * (jj >> 3)] = gC; }
        asm volatile("s_waitcnt lgkmcnt(0)" ::: "memory");
    }
}
constexpr int RF_ACT_BYTES = 16 * 320 * 2;
__device__ __forceinline__ void rwkv_fused_phase(const Frame& F, unsigned char* ws, int l) {
    const bf16_t* PX = (const bf16_t*)(ws + WS_PX); unsigned char* FR = ws + WS_FR;
    float* GB = (float*)(ws + WS_G); float* VB = (float*)(ws + WS_SS) + (size_t)T * A_W; float* BS = (float*)(ws + WS_SD);
    const bf16_t* WLR = (const bf16_t*)(ws + WS_WLR) + (size_t)l * A_W * WLR_K;
    const float* cw = IN_(16) + (size_t)l * 3 * A_IN;
    LAS bf16_t* ACT = (LAS bf16_t*)F.lds;
    LAS bf16_t* R1 = (LAS bf16_t*)(F.lds + RF_ACT_BYTES + F.wave * SP_WAVE_LDS); LAS bf16_t* R2 = R1 + 32 * 72; LAS bf16_t* BbT = R2 + 32 * 72; LAS bf16_t* KbT = BbT + 64 * 16; LAS bf16_t* VT = KbT + 64 * 16; LAS float* Lm = (LAS float*)(VT + 64 * 16);
    const int lane = F.lane, n = lane & 31, hi = lane >> 5, hh = F.wave >> 1, d = F.wave & 1;
    for (int it = F.bid; it < (T / 16) * 5; it += F.G) {
        const int tg = it / 5, hg = it % 5, tau0 = tg * 16, h = hg * 4 + hh, col = h * 64 + lane;
        const bf16_t* prow0 = PX + (size_t)(tau0 > 0 ? tau0 - 1 : 0) * PXW; const int roff = tau0 > 0 ? 0 : -1;
#define RP_WIN(x, ucol_) do { _Pragma("unroll") for (int i_ = 0; i_ < 18; ++i_) { int ri_ = i_ + roff; ri_ = ri_ < 0 ? 0 : ri_; ri_ = (tau0 - 1 + i_ > T - 1) ? (T - 1 - (tau0 > 0 ? tau0 - 1 : 0)) : ri_; x[i_] = bf2f((prow0 + (size_t)ri_ * PXW)[ucol_]); } } while (0)
#define RP_CONV(x, t_, w0_, w1_, w2_) (x[(t_)] * (has_left(tau0 + (t_)) ? (w0_) : 0.f) + x[(t_) + 1] * (w1_) + x[(t_) + 2] * (has_right(tau0 + (t_)) ? (w2_) : 0.f))
        float wr_[18], wk_[18], wv_[18]; { const unsigned uc = (unsigned)(PXA + col); RP_WIN(wr_, uc); RP_WIN(wk_, uc + A_W); RP_WIN(wv_, uc + 2 * A_W); }
        const float cr0 = cw[col], cr1 = cw[A_IN + col], cr2 = cw[2 * A_IN + col], ck0 = cw[A_W + col], ck1 = cw[A_IN + A_W + col], ck2 = cw[2 * A_IN + A_W + col];
        const float cv0 = cw[2 * A_W + col], cv1 = cw[A_IN + 2 * A_W + col], cv2 = cw[2 * A_IN + 2 * A_W + col], kk_w = IN_(22)[l * A_W + col];
        __syncthreads();
        { int tq = F.tid; asm volatile("" : "+v"(tq));
#pragma unroll
          for (int i = 0; i < 3; ++i) { const int item = tq + 512 * i;
              if (item < 16 * 80) { const int t = item / 80, c = 4 * (item % 80), cc = 3840 + c, tau = tau0 + t;
                  const bf16_t* p = PX + (size_t)tau * PXW + PXA + cc; const bool hl = has_left(tau), hr = has_right(tau);
                  const f32x4 x1 = bf4f(*(const u32x2*)p), x0 = bf4f(*(const u32x2*)(p - (hl ? PXW : 0))), x2 = bf4f(*(const u32x2*)(p + (hr ? PXW : 0)));
                  const f32x4 w0 = *(const f32x4*)(cw + cc), w1 = *(const f32x4*)(cw + A_IN + cc), w2 = *(const f32x4*)(cw + 2 * A_IN + cc);
                  const f32x4 val = x1 * w1 + x0 * (w0 * (hl ? 1.f : 0.f)) + x2 * (w2 * (hr ? 1.f : 0.f));
                  f32x4 act;
#pragma unroll
                  for (int e = 0; e < 4; ++e) act[e] = c < 64 ? 1.0f - 2.0f / (1.0f + __expf(2.0f * val[e])) : (c < 128 ? val[e] : sigmoidf_(val[e]));
                  u32x2 o; o.x = cvt_pk_bf16(act.x, act.y); o.y = cvt_pk_bf16(act.z, act.w);
                  *(LAS u32x2*)(ACT + t * 320 + c) = o; } } }
        __syncthreads();
        const bf16_t* WLRh = WLR + (size_t)h * 64 * WLR_K;
        const RpAfLds afw{ACT + (n & 15) * 320 + 8 * hi}, afa{ACT + (n & 15) * 320 + 64 + 8 * hi}, afg{ACT + (n & 15) * 320 + 128 + 8 * hi};
        float xw[16], xb[16], xk[16], xkk[16], xr[16], xv[16];
        {
          if (d == 0) { float lg[16]; rp_lowrank<12>(lg, afg, WLRh, 256, n, hi);
#pragma unroll
              for (int t = 0; t < 16; ++t) GB[(size_t)(tau0 + t) * A_W + col] = lg[t]; }
#pragma unroll
          for (int t = 0; t < 16; ++t) { xr[t] = RP_CONV(wr_, t, cr0, cr1, cr2); xv[t] = RP_CONV(wv_, t, cv0, cv1, cv2); xk[t] = RP_CONV(wk_, t, ck0, ck1, ck2);
              const float kr = xk[t] * kk_w; const float nrm = sqrtf(wave_sum(kr * kr)); xkk[t] = kr / fmaxf(nrm, 1e-12f); } }
        if (d == 0) {
#pragma unroll
            for (int t = 0; t < 16; ++t) VB[(size_t)(tau0 + t) * A_W + col] = xv[t]; }
        { const float ka_w = IN_(23)[l * A_W + col], w0b = IN_(17)[(l * 2 + d) * A_W + col], a0b = IN_(19)[(l * 2 + d) * A_W + col]; float la[16];
          rp_lowrank<4>(xw, afw, WLRh, 64 * d, n, hi); rp_lowrank<4>(la, afa, WLRh, 128 + 64 * d, n, hi);
#pragma unroll
          for (int t = 0; t < 16; ++t) { const float z = w0b + xw[t]; xw[t] = __expf(-__expf(-(fmaxf(-z, 0.f) + __logf(1.0f + __expf(-fabsf(z)))) - 0.5f)); const float av = sigmoidf_(a0b + la[t]);
              xb[t] = xkk[t] * av; xk[t] = xk[t] * (1.0f + (av - 1.0f) * ka_w); }
          { const float rk_w = IN_(24)[l * A_W + col]; float pr[16];
#pragma unroll
            for (int t = 0; t < 16; ++t) pr[t] = xr[t] * xk[t] * rk_w;
            const float sb = wave_sum16(pr, lane);
            if ((lane & 3) == 0) BS[((size_t)d * T + tau0 + (lane >> 2)) * NHA + h] = sb; } }
        if (d) {
#pragma unroll
            for (int s = 0; s < 8; ++s) { float t_;
                t_ = xw[s]; xw[s] = xw[15 - s]; xw[15 - s] = t_; t_ = xb[s]; xb[s] = xb[15 - s]; xb[15 - s] = t_; t_ = xk[s]; xk[s] = xk[15 - s]; xk[15 - s] = t_;
                t_ = xkk[s]; xkk[s] = xkk[15 - s]; xkk[15 - s] = t_; t_ = xr[s]; xr[s] = xr[15 - s]; xr[15 - s] = t_; t_ = xv[s]; xv[s] = xv[15 - s]; xv[15 - s] = t_; } }
        const int c = d == 0 ? tg : (tg < NCTX / 16 ? NCTX / 16 - 1 - tg : NCTX / 16 + (T / 16 - 1) - tg);
        float gC = 1.f;
#pragma unroll
        for (int s = 0; s < 16; ++s) gC *= xw[s];
        float g = 1.f;
#pragma unroll
        for (int s = 0; s < 16; ++s) {
            const float gm1 = g; g *= xw[s]; const float ig = 1.0f / g; const float bh = xb[s] * ig, kh = xk[s] * ig;
            R1[s * 72 + lane] = f2bf16(-xkk[s] * gm1); R1[(16 + s) * 72 + lane] = f2bf16(xr[s] * g);
            R2[s * 72 + lane] = f2bf16(bh); R2[(16 + s) * 72 + lane] = f2bf16(kh);
            xb[s] = bh * gC; xk[s] = kh * gC; }
        asm volatile("s_waitcnt lgkmcnt(0)" ::: "memory");
        unsigned char* dst = FR + ((size_t)(h * 2 + d) * SC_NCHUNK + c) * SC_CHUNK_BYTES;
        rp_f32x16 C = {};
#pragma unroll
        for (int kb = 0; kb < 4; ++kb) { const rp_bf16x8 a_ = *(const LAS rp_bf16x8*)(R2 + n * 72 + 16 * kb + 8 * hi), b_ = *(const LAS rp_bf16x8*)(R1 + n * 72 + 16 * kb + 8 * hi);
            C = __builtin_amdgcn_mfma_f32_32x32x16_bf16(a_, b_, C, 0, 0, 0); }
        const int tt_ = n & 15; const bool incl = n >= 16;
#pragma unroll
        for (int r = 0; r < 16; ++r) { const int s = ((r & 7) & 3) + 8 * ((r & 7) >> 2) + 4 * hi; if (!(s < tt_ || (incl && s == tt_))) C[r] = 0.f; }
        if (n < 16) {
#pragma unroll
            for (int r = 0; r < 8; ++r) Lm[((r & 3) + 8 * (r >> 2) + 4 * hi) * 20 + n] = C[r]; }
        { u32x4 f4; f4.x = cvt_pk_bf16(C[8], C[9]); f4.y = cvt_pk_bf16(C[10], C[11]); f4.z = cvt_pk_bf16(C[12], C[13]); f4.w = cvt_pk_bf16(C[14], C[15]);
          u32x4 f6; f6.x = cvt_pk_bf16(C[0], C[1]); f6.y = cvt_pk_bf16(C[2], C[3]); f6.z = cvt_pk_bf16(C[4], C[5]); f6.w = cvt_pk_bf16(C[6], C[7]);
          if (n < 16) f6 = (u32x4){0u, 0u, 0u, 0u};
          *(u32x4*)(dst + 4 * 1024 + lane * 16) = f4; *(u32x4*)(dst + 6 * 1024 + lane * 16) = f6; }
        asm volatile("s_waitcnt lgkmcnt(0)" ::: "memory");
        { float Tc[16];
#pragma unroll
          for (int s = 15; s >= 0; --s) { float acc = (s == n) ? 1.f : 0.f;
#pragma unroll
              for (int u = s + 1; u < 16; ++u) acc += Lm[s * 20 + u] * Tc[u];
              Tc[s] = acc; }
          u32x4 f5; f5.x = cvt_pk_bf16(hi ? Tc[4] : Tc[0], hi ? Tc[5] : Tc[1]); f5.y = cvt_pk_bf16(hi ? Tc[6] : Tc[2], hi ? Tc[7] : Tc[3]);
          f5.z = cvt_pk_bf16(hi ? Tc[12] : Tc[8], hi ? Tc[13] : Tc[9]); f5.w = cvt_pk_bf16(hi ? Tc[14] : Tc[10], hi ? Tc[15] : Tc[11]);
          if (n >= 16) f5 = (u32x4){0u, 0u, 0u, 0u};
          *(u32x4*)(dst + 5 * 1024 + lane * 16) = f5; }
#pragma unroll
        for (int f = 0; f < 4; ++f) { const u32x2 p0 = *(const LAS u32x2*)(R1 + n * 72 + 16 * f + 4 * hi), p1 = *(const LAS u32x2*)(R1 + n * 72 + 16 * f + 8 + 4 * hi);
            *(u32x4*)(dst + f * 1024 + lane * 16) = (u32x4){p0.x, p0.y, p1.x, p1.y}; }
#define RF_FRAG(x_, fa_, fb_) do { unsigned pk_[8]; _Pragma("unroll") for (int m_ = 0; m_ < 8; ++m_) pk_[m_] = cvt_pk_bf16(x_[2 * m_], x_[2 * m_ + 1]); \
            const bool h1_ = hi != 0; const u32x4 own_ = {h1_ ? pk_[2] : pk_[0], h1_ ? pk_[3] : pk_[1], h1_ ? pk_[6] : pk_[4], h1_ ? pk_[7] : pk_[5]}; \
            u32x4 rcv_ = {h1_ ? pk_[0] : pk_[2], h1_ ? pk_[1] : pk_[3], h1_ ? pk_[4] : pk_[6], h1_ ? pk_[5] : pk_[7]}; \
            rcv_.x = __shfl_xor(rcv_.x, 32); rcv_.y = __shfl_xor(rcv_.y, 32); rcv_.z = __shfl_xor(rcv_.z, 32); rcv_.w = __shfl_xor(rcv_.w, 32); \
            *(u32x4*)(dst + (fa_) * 1024 + lane * 16) = h1_ ? rcv_ : own_; *(u32x4*)(dst + (fb_) * 1024 + lane * 16) = h1_ ? own_ : rcv_; } while (0)
        RF_FRAG(xb, 7, 9); RF_FRAG(xk, 8, 10); RF_FRAG(xv, 11, 12);
#undef RF_FRAG
        { const int jj = lane & 31; ((float*)(dst + 13 * 1024))[((jj >> 2) & 1) * 32 + (lane >> 5) * 16 + (jj & 3) + 4 * (jj >> 3)] = gC; }
        asm volatile("s_waitcnt lgkmcnt(0)" ::: "memory");
    }
#undef RP_WIN
#undef RP_CONV
}
__device__ __forceinline__ void mixer_phase(const Frame& F0, unsigned char* ws0, int lq, bool need_ctx, char* lds_g) {
    const int l = lq & 3;
#ifndef MK_MIX
#define MK_MIX 15
#endif
    { const Frame F = opq(F0); unsigned char* ws = opq_ptr(ws0);
      if (MK_MIX & 1) for (int chain = F.bid; chain < 2 * NHA; chain += F.G) scan_chain_mfma(F, ws, chain); }
    const Frame& F = F0;
    const int n_xa = 32 * NHC, n_ca = need_ctx ? NHC : 0, n_att = n_xa + n_ca, n_hy = 640, n_ch = need_ctx ? 160 : 0;
    unsigned* qatt = (unsigned*)(ws0 + WS_CTL) + CW_QUEUE + 64 * lq; unsigned* qhy = qatt + 32;
    int item;
#define MIX_POP(q) do { if (F.tid == 0) F.MISC[16] = __hip_atomic_fetch_add((q), 1u, __ATOMIC_RELAXED, __HIP_MEMORY_SCOPE_AGENT); __syncthreads(); item = (int)F.MISC[16]; __syncthreads(); } while (0)
    if (F.bid >= 2 * NHA) {
        MIX_POP(qatt);
        while (item < n_att) {
            if (MK_MIX & 2) { unsigned char* ws = opq_ptr(ws0);
                const bf16_t* QF = (const bf16_t*)(ws + WS_QF); const bf16_t* KF = (const bf16_t*)(ws + WS_KF); const bf16_t* KVRAW = (const bf16_t*)(ws + WS_KVRAW); bf16_t* OB = (bf16_t*)(ws + WS_OBUF);
                const bool is_xa = item < n_xa; const int h = is_xa ? item % NHC : item - n_xa, row0 = is_xa ? NCTX + (item / NHC) * 256 : 0;
                for (int rp = 0; rp < REP(13); ++rp) att::attn_body(QF + (size_t)row0 * NQ + h * 192, KF + h * 192, KVRAW + h * 256 + 128, OB + (size_t)row0 * DM + 2560 + h * 128, is_xa ? T : NCTX, lds_g); }
            MIX_POP(qatt);
        }
    }
    MIX_POP(qhy);
    while (item < n_hy + n_ch) {
        const Frame Fu = opq(F0); unsigned char* ws = opq_ptr(ws0);
        if ((MK_MIX & 4) && item < n_hy) hyena_unit(Fu, ws, l, item);
        else if ((MK_MIX & 8) && item >= n_hy) hyena_ctx_unit(Fu, ws, l, item - n_hy);
        MIX_POP(qhy);
    }
#undef MIX_POP
}

__device__ __forceinline__ void hyena_taps_tail(const Frame& F0, unsigned char* ws0, int lt, int first, int end) {
    if (F0.bid < 48) return;
#pragma unroll 1
    for (int p = first + F0.bid - 48; p < end; p += 208) hyena_taps_unit(opq(F0), opq_ptr(ws0), lt, p);
}
constexpr int NPH = 2 + 14 * NL;
__global__ void __launch_bounds__(512, 2) mk_fwd(Args a) {
    extern __shared__ __attribute__((aligned(16))) unsigned char lds[];
    Frame F; F.lds = (LAS unsigned char*)lds; F.MISC = (volatile LAS unsigned*)(F.lds + LDS_MISC);
    F.tid = threadIdx.x; F.lane = F.tid & 63; F.wave = __builtin_amdgcn_readfirstlane(F.tid >> 6); F.bid = blockIdx.x; F.G = gridDim.x;
    if (F.tid < 64) F.MISC[F.tid] = 0u;
    if (F.tid < 46) *(LAS unsigned long long*)(F.lds + LDS_PTAB + 8 * F.tid) = (unsigned long long)(uintptr_t)a.in[F.tid];
    __syncthreads();
    unsigned char* ws = a.ws;
    const int lo = a.ph_lo, hi = a.ph_hi;
    XcdBarrier bar = xcd_barrier_post((unsigned*)(ws + WS_CTL) + CW_BAR, F.MISC + 8);
#ifndef MK_MASK
#define MK_MASK 0xffff
#endif
#define EN(x) (((MK_MASK) >> (x)) & 1)
#define IN(k) (lo <= (k) && (k) < hi)
#define SEAM(k) do { if (IN(k) && IN((k) + 1)) xcd_barrier(bar); } while (0)
#define WSP opq_ptr(ws)
#define P_XS(w) ((float*)((w) + WS_XS))
#define P_ABUF(w) ((bf16_t*)((w) + WS_ABUF))
#define P_HBUF(w) ((bf16_t*)((w) + WS_HBUF))
#define P_OBUF(w) ((bf16_t*)((w) + WS_OBUF))
#define P_MODX(w, l) ((const float*)((w) + WS_MOD) + ((size_t)(l) * 2 + 0) * NMOD)
#define P_MODC(w, l) ((const float*)((w) + WS_MOD) + ((size_t)(l) * 2 + 1) * NMOD)
#define P_WL(w, l) ((const bf16_t*)((w) + WS_WB) + (size_t)(l) * W_LAYER)
    if (EN(0) && IN(0)) for (int rp = 0; rp < REP(0); ++rp) phase0(opq(F), opq_ptr(ws));
    SEAM(0);
    if (EN(1) && IN(1)) phase_mod(opq(F), opq_ptr(ws));
    SEAM(1);
#pragma clang loop unroll(full)
    for (int l = 0; l < NL; ++l) {
        const int pb = 2 + 14 * l; const bool need_ctx = l < NL - 1;
        if (EN(2) && IN(pb + 0)) for (int rp = 0; rp < REP(2); ++rp) { unsigned char* w = WSP; norm_phase(opq(F), P_XS(w), IN_(7) + l * DM, P_MODX(w, l), P_MODC(w, l), 0, 1, P_ABUF(w), l > 0 ? (const bf16_t*)(w + WS_SLAB) : nullptr, l > 0 ? P_MODC(w, l - 1) + 8 * DM : nullptr, 0.5f); }
        SEAM(pb + 0);
        if (EN(3) && IN(pb + 1)) { unsigned char* w = WSP; pg8::Gemm g{P_ABUF(w), P_WL(w, l) + W_G1, T, 2 * FF, DM, DM}; pg8::StaticOrder S; S.init(T, 2 * FF, F.G, F.bid); pg8::EpiSwiGLU E{P_HBUF(w), FF};
            pg8::gemm_phase<pg8::EpiSwiGLU, pg8::StaticOrder>(F.lds, g, S, E, nullptr);
            hyena_taps_tail(F, ws, l, 0, l == 0 ? 640 : 416); }
        SEAM(pb + 1);
        if (EN(4) && IN(pb + 2)) {
            { unsigned char* w = WSP; pg8::Gemm g{P_HBUF(w), P_WL(w, l) + W_D1, T, DM, FF, FF}; pg8::StaticOrderX S; S.init(T, DM, F.G, F.bid); pg8::EpiResid E{P_XS(w), P_MODX(w, l) + 2 * DM, P_MODC(w, l) + 2 * DM, 0.5f, nullptr};
              pg8::gemm_phase<pg8::EpiResid, pg8::StaticOrderX>(F.lds, g, S, E, nullptr); }
            if (true) { __syncthreads();
              if (F.bid < 256) { unsigned char* w = WSP; const int ks = F.bid >> 4, ksz = FF / 16; pg8::Gemm g{P_HBUF(w) + ks * ksz, P_WL(w, l) + W_D1 + ks * ksz, NCTX, DM, ksz, FF}; pg8::OneUnit S{F.bid & 15};
                  pg8::EpiBf16<0> E{(bf16_t*)(w + WS_SLAB) + (size_t)ks * NCTX * DM, DM, nullptr, 0, 0};
                  pg8::gemm_phase<pg8::EpiBf16<0>, pg8::OneUnit>(F.lds, g, S, E, nullptr); } }
        }
        SEAM(pb + 2);
        if (EN(5) && IN(pb + 3)) for (int rp = 0; rp < REP(2); ++rp) { unsigned char* w = WSP; norm_phase(opq(F), P_XS(w), IN_(8) + l * DM, P_MODX(w, l), P_MODC(w, l), 3, 4, P_ABUF(w), (const bf16_t*)(w + WS_SLAB), P_MODC(w, l) + 2 * DM, 0.5f); }
        SEAM(pb + 3);
        if (EN(6) && IN(pb + 4)) { unsigned char* w = WSP; pg8::Gemm g{P_ABUF(w), P_WL(w, l) + W_IN, T, PXW, DM, DM}; pg8::StaticOrder S; S.init(T, PXW, F.G, F.bid); pg8::EpiBf16<0> E{(bf16_t*)(w + WS_PX), PXW, nullptr, 0, 0};
            pg8::gemm_phase<pg8::EpiBf16<0>, pg8::StaticOrder>(F.lds, g, S, E, nullptr); }
        SEAM(pb + 4);
        if (EN(7) && IN(pb + 5)) { for (int rp = 0; rp < REP(7); ++rp) rwkv_fused_phase(opq(F), opq_ptr(ws), l); if (!(MK_ONLYRP)) { for (int rp = 0; rp < REP(8); ++rp) mla_prep_phase(opq(F), opq_ptr(ws), l); hyena_prep_phase(opq(F), opq_ptr(ws), l); } }
        SEAM(pb + 5);
        if (EN(8) && IN(pb + 6)) {
            { unsigned char* w = WSP; pg8::Gemm g{(const bf16_t*)(w + WS_QA), P_WL(w, l) + W_Q, T, NQ, 1024, 1024}; pg8::StaticOrder S; S.init(T, NQ, F.G, F.bid); pg8::EpiBf16<0> E{(bf16_t*)(w + WS_QRAW), NQ, nullptr, 0, 0};
              pg8::gemm_phase<pg8::EpiBf16<0>, pg8::StaticOrder>(F.lds, g, S, E, nullptr); }
            __syncthreads();
            { unsigned char* w = WSP; pg8::Gemm g{(const bf16_t*)(w + WS_KVA), P_WL(w, l) + W_KV, T, NKV, 512, 512}; pg8::StaticOrder S; S.init(T, NKV, F.G, F.bid); pg8::EpiBf16<0> E{(bf16_t*)(w + WS_KVRAW), NKV, nullptr, 0, 0};
              pg8::gemm_phase<pg8::EpiBf16<0>, pg8::StaticOrder>(F.lds, g, S, E, nullptr); }
        }
        SEAM(pb + 6);
        if (EN(9) && IN(pb + 7)) { for (int rp = 0; rp < REP(8); ++rp) qkv_final_phase(opq(F), opq_ptr(ws), l, need_ctx); }
        SEAM(pb + 7);
        if (EN(10) && IN(pb + 8)) for (int rp = 0; rp < REP(10); ++rp) mixer_phase(F, ws, l + 4 * rp, need_ctx, (char*)lds);
        SEAM(pb + 8);
        if (EN(11) && IN(pb + 9)) { for (int rp = 0; rp < REP(8); ++rp) rwkv_out_phase(opq(F), opq_ptr(ws), l, need_ctx); hyena_out_phase(opq(F), opq_ptr(ws), need_ctx); }
        SEAM(pb + 9);
        if (EN(12) && IN(pb + 10)) {
            { unsigned char* w = WSP; pg8::Gemm g{P_OBUF(w), P_WL(w, l) + W_OUT, T, DM, DM, DM}; pg8::StaticOrderX S; S.init(T, DM, F.G, F.bid); pg8::EpiResid E{P_XS(w), P_MODX(w, l) + 5 * DM, P_MODC(w, l) + 5 * DM, 1.0f, nullptr};
              pg8::gemm_phase<pg8::EpiResid, pg8::StaticOrderX>(F.lds, g, S, E, nullptr); }
            if (need_ctx) { __syncthreads();
              if (F.bid < 256) { unsigned char* w = WSP; const int ks = F.bid >> 4, ksz = DM / 16; pg8::Gemm g{P_OBUF(w) + ks * ksz, P_WL(w, l) + W_OUT + ks * ksz, NCTX, DM, ksz, DM}; pg8::OneUnit S{F.bid & 15};
                  pg8::EpiBf16<0> E{(bf16_t*)(w + WS_SLAB) + (size_t)ks * NCTX * DM, DM, nullptr, 0, 0};
                  pg8::gemm_phase<pg8::EpiBf16<0>, pg8::OneUnit>(F.lds, g, S, E, nullptr); } }
        }
        SEAM(pb + 10);
        if (EN(13) && IN(pb + 11)) for (int rp = 0; rp < REP(2); ++rp) { unsigned char* w = WSP; norm_phase(opq(F), P_XS(w), IN_(9) + l * DM, P_MODX(w, l), P_MODC(w, l), 6, 7, P_ABUF(w), need_ctx ? (const bf16_t*)(w + WS_SLAB) : nullptr, P_MODC(w, l) + 5 * DM, 1.0f); }
        SEAM(pb + 11);
        if (EN(14) && IN(pb + 12)) { if (need_ctx) { unsigned char* w = WSP; pg8::Gemm g{P_ABUF(w), P_WL(w, l) + W_G2, T, 2 * FF, DM, DM}; pg8::StaticOrder S; S.init(T, 2 * FF, F.G, F.bid); pg8::EpiSwiGLU E{P_HBUF(w), FF};
            pg8::gemm_phase<pg8::EpiSwiGLU, pg8::StaticOrder>(F.lds, g, S, E, nullptr);
            hyena_taps_tail(F, ws, l + 1, 416, 640); }       else { unsigned char* w = WSP; pg8::Gemm g{P_ABUF(w), P_WL(w, l) + W_G2, T, 2 * FF, DM, DM}; pg8::StaticOrderX S; S.init(T, 2 * FF, F.G, F.bid); pg8::EpiSwiGLU E{P_HBUF(w), FF};
            pg8::gemm_phase<pg8::EpiSwiGLU, pg8::StaticOrderX>(F.lds, g, S, E, nullptr); } }
        SEAM(pb + 12);
        if (EN(15) && IN(pb + 13)) {
            { unsigned char* w = WSP; pg8::Gemm g{P_HBUF(w), P_WL(w, l) + W_D2, T, DM, FF, FF}; pg8::StaticOrderX S; S.init(T, DM, F.G, F.bid); pg8::EpiResid E{P_XS(w), P_MODX(w, l) + 8 * DM, P_MODC(w, l) + 8 * DM, 0.5f, l == NL - 1 ? a.out : nullptr};
              pg8::gemm_phase<pg8::EpiResid, pg8::StaticOrderX>(F.lds, g, S, E, nullptr); }
            if (need_ctx) { __syncthreads();
              if (F.bid < 256) { unsigned char* w = WSP; const int ks = F.bid >> 4, ksz = FF / 16; pg8::Gemm g{P_HBUF(w) + ks * ksz, P_WL(w, l) + W_D2 + ks * ksz, NCTX, DM, ksz, FF}; pg8::OneUnit S{F.bid & 15};
                  pg8::EpiBf16<0> E{(bf16_t*)(w + WS_SLAB) + (size_t)ks * NCTX * DM, DM, nullptr, 0, 0};
                  pg8::gemm_phase<pg8::EpiBf16<0>, pg8::OneUnit>(F.lds, g, S, E, nullptr); } }
        }
        SEAM(pb + 13);
    }
#undef IN
#undef SEAM
}

#ifndef MK_LAUNCHES
#define MK_LAUNCHES 1
#endif
extern "C" void kernel_launch(void* const* d_in, const int* in_sizes, int n_in, void* d_out, int out_size, void* d_ws, size_t ws_size, hipStream_t stream) {
    static int grid = 0;
    if (grid == 0) {
        if (n_in != 46 || in_sizes[0] != SEQ * DM || out_size != SEQ * DM || ws_size < WS_END) {
            fprintf(stderr, "kernel_launch: shape mismatch: n_in %d in0 %d out %d ws %zu (need %zu); nothing launched\n", n_in, n_in > 0 ? in_sizes[0] : -1, out_size, ws_size, (size_t)WS_END); grid = -1; return; }
        int dev = 0, cus = 0, per_cu = 0;
        if (hipGetDevice(&dev) != hipSuccess || hipDeviceGetAttribute(&cus, hipDeviceAttributeMultiprocessorCount, dev) != hipSuccess) { fprintf(stderr, "kernel_launch: device query failed\n"); grid = -1; return; }
        if (hipFuncSetAttribute((const void*)mk_fwd, hipFuncAttributeMaxDynamicSharedMemorySize, LDS_BYTES) != hipSuccess) { fprintf(stderr, "kernel_launch: hipFuncSetAttribute failed\n"); grid = -1; return; }
        if (hipOccupancyMaxActiveBlocksPerMultiprocessor(&per_cu, (const void*)mk_fwd, 512, LDS_BYTES) != hipSuccess || per_cu < 1) fprintf(stderr, "kernel_launch: note: occupancy query reports %d blocks per CU\n", per_cu);
        (void)hipGetLastError();
        grid = cus;
        if (cus != 256) { fprintf(stderr, "kernel_launch: built for 256 CUs (split-K of the context panel, hyena scratch), found %d; nothing launched\n", cus); grid = -1; return; }
    }
    if (grid < 0) return;
    if (hipMemsetAsync((char*)d_ws + WS_CTL, 0, CTL_BYTES, stream) != hipSuccess) { fprintf(stderr, "kernel_launch: memset failed\n"); return; }
    Args a{};
    for (int i = 0; i < 46; ++i) a.in[i] = (const float*)d_in[i];
    a.out = (float*)d_out; a.ws = (unsigned char*)d_ws;
    a.ph_lo = 0; a.ph_hi = NPH;
    hipLaunchKernelGGL(mk_fwd, dim3(grid), dim3(512), LDS_BYTES, stream, a);
    const hipError_t le = hipPeekAtLastError();
    if (le != hipSuccess) fprintf(stderr, "kernel_launch: launch failed: %s\n", hipGetErrorName(le));
}
```

```cpp
#include <hip/hip_runtime.h>
#include <stdint.h>
#include <cstdio>

#define LAS __attribute__((address_space(3)))
#define CAS __attribute__((address_space(4)))
typedef unsigned short bf16_t;
typedef float f32x4 __attribute__((ext_vector_type(4)));
typedef float f32x2 __attribute__((ext_vector_type(2)));
typedef unsigned u32x4 __attribute__((ext_vector_type(4)));
typedef unsigned u32x2 __attribute__((ext_vector_type(2)));

constexpr int T = 8448, NCTX = 256, SEQ = 8192, DM = 4096, FF = 6144, NL = 4;
constexpr int A_W = 1280, A_IN = 4160, B_IN = 3840, C_IN = 1600, NHA = 20;
constexpr int PXW = 9728, PXA = 0, PXB = 4160, PXC = 8000;
constexpr int NQ = 2304, NKV = 3072, NHC = 12;
constexpr int NMOD = 9 * DM;
constexpr float NORM_EPS = 1e-6f, GN_EPS = 64e-5f;

constexpr size_t MiB = 1u << 20;
constexpr size_t al(size_t x) { return (x + MiB - 1) / MiB * MiB; }
constexpr size_t WS_CTL = 0, CTL_BYTES = MiB;
constexpr size_t WS_XS = WS_CTL + CTL_BYTES;
constexpr size_t WS_ABUF = WS_XS + al((size_t)T * DM * 4);
constexpr size_t WS_HBUF = WS_ABUF + al((size_t)T * DM * 2);
constexpr size_t WS_OBUF = WS_HBUF + al((size_t)T * FF * 2);
constexpr size_t WS_PX = WS_OBUF + al((size_t)T * DM * 2);
constexpr size_t WS_MOD = WS_PX + al((size_t)T * PXW * 4);
constexpr size_t WS_HP = WS_MOD + al((size_t)NL * 2 * NMOD * 4);
constexpr size_t WS_SS = WS_HP + MiB;
constexpr size_t WS_SD = WS_SS + al((size_t)NHA * T * 192 * 4);
constexpr size_t WS_WLR = WS_SD + al((size_t)NHA * 2 * T * 192 * 4);
constexpr size_t WS_G = WS_WLR + al((size_t)NL * A_W * 448 * 2);
constexpr size_t WS_Y = WS_G + al((size_t)T * A_W * 4);
constexpr size_t WS_QA = WS_Y + al((size_t)2 * T * A_W * 4);
constexpr size_t WS_KVA = WS_QA + al((size_t)T * 1024 * 2);
constexpr size_t WS_KPE = WS_KVA + al((size_t)T * 512 * 2);
constexpr size_t WS_QRAW = WS_KPE + al((size_t)T * 64 * 2);
constexpr size_t WS_KVRAW = WS_QRAW + al((size_t)T * NQ * 2);
constexpr size_t WS_QF = WS_KVRAW + al((size_t)T * NKV * 2);
constexpr size_t WS_KF = WS_QF + al((size_t)T * NQ * 2);
constexpr size_t WS_H3 = WS_KF + al((size_t)T * NQ * 2);
constexpr size_t WS_HSCR = WS_H3 + al((size_t)NL * T * 64 * 4);
constexpr int HT_STRIDE = 17 * 512;
constexpr size_t WS_HTN = WS_HSCR + (size_t)640 * HT_STRIDE * 16;
constexpr size_t WS_FR = WS_HSCR + al((size_t)640 * HT_STRIDE * 16 + 640 * 8);
constexpr size_t WS_GT = WS_FR + al((size_t)40 * 528 * (14 * 1024));
constexpr size_t WS_X0T = WS_GT + al((size_t)1280 * T * 4);
constexpr size_t WS_SLAB = WS_FR;
constexpr size_t WS_WB = WS_X0T + al((size_t)1280 * T * 4);
constexpr size_t W_G1 = 0, W_D1 = W_G1 + (size_t)2 * FF * DM, W_IN = W_D1 + (size_t)DM * FF, W_OUT = W_IN + (size_t)PXW * DM, W_G2 = W_OUT + (size_t)DM * DM,
                 W_D2 = W_G2 + (size_t)2 * FF * DM, W_Q = W_D2 + (size_t)DM * FF, W_KV = W_Q + (size_t)NQ * 1024, W_LAYER = W_KV + (size_t)NKV * 512;
constexpr size_t WS_END = WS_WB + al(W_LAYER * NL * 2);
constexpr int CW_BAR = 4096;
constexpr int CW_QUEUE = 8192;

constexpr int LDS_MISC = 143360, LDS_BYTES = 147456;

__device__ __forceinline__ float wave_sum(float v) {
#pragma unroll
    for (int o = 1; o < 64; o <<= 1) v += __shfl_xor(v, o);
    return v;
}
__device__ __forceinline__ float wave_sum16(const float (&x)[16], int lane) {
    const bool b5 = (lane & 32) != 0, b4 = (lane & 16) != 0, b3 = (lane & 8) != 0, b2 = (lane & 4) != 0;
    float k8[8], k4[4], k2[2];
#pragma unroll
    for (int i = 0; i < 8; ++i) k8[i] = (b5 ? x[8 + i] : x[i]) + __shfl_xor(b5 ? x[i] : x[8 + i], 32);
#pragma unroll
    for (int i = 0; i < 4; ++i) k4[i] = (b4 ? k8[4 + i] : k8[i]) + __shfl_xor(b4 ? k8[i] : k8[4 + i], 16);
#pragma unroll
    for (int i = 0; i < 2; ++i) k2[i] = (b3 ? k4[2 + i] : k4[i]) + __shfl_xor(b3 ? k4[i] : k4[2 + i], 8);
    float k1 = (b2 ? k2[1] : k2[0]) + __shfl_xor(b2 ? k2[0] : k2[1], 4);
    k1 += __shfl_xor(k1, 1); k1 += __shfl_xor(k1, 2);
    return k1;
}
typedef __bf16 bf16x2_t __attribute__((ext_vector_type(2)));
__device__ __forceinline__ unsigned cvt_pk_bf16(float lo, float hi) { const f32x2 v = {lo, hi}; return __builtin_bit_cast(unsigned, __builtin_convertvector(v, bf16x2_t)); }
__device__ __forceinline__ float bf2f(unsigned short b) { return __uint_as_float(((unsigned)b) << 16); }
__device__ __forceinline__ f32x4 bf4f(u32x2 w) { return (f32x4){__uint_as_float(w.x << 16), __uint_as_float(w.x & 0xffff0000u), __uint_as_float(w.y << 16), __uint_as_float(w.y & 0xffff0000u)}; }
__device__ __forceinline__ float sigmoidf_(float x) { return 1.0f / (1.0f + __expf(-x)); }
__device__ __forceinline__ float siluf_(float x) { return x / (1.0f + __expf(-x)); }
__device__ __forceinline__ bool has_left(int tau) { return tau != 0 && tau != NCTX; }
__device__ __forceinline__ bool has_right(int tau) { return tau != NCTX - 1 && tau != T - 1; }

struct Args { const float* in[46]; float* out; unsigned char* ws; int ph_lo, ph_hi; };
struct Frame { LAS unsigned char* lds; volatile LAS unsigned* MISC; int tid, lane, wave, bid, G; };
constexpr int LDS_PTAB = LDS_MISC + 2048;
__device__ __forceinline__ const float* inp(const Frame& F, int i) {
    const volatile LAS unsigned* p = (const volatile LAS unsigned*)(F.lds + LDS_PTAB) + 2 * i;
    const unsigned lo = __builtin_amdgcn_readfirstlane(p[0]), hi = __builtin_amdgcn_readfirstlane(p[1]);
    return (const float*)(((unsigned long long)hi << 32) | lo);
}
#define IN_(i) inp(F, (i))
__device__ __forceinline__ Frame opq(const Frame& F) { Frame G = F; asm volatile("" : "+v"(G.tid), "+s"(G.wave), "+s"(G.bid)); G.lane = G.tid & 63; return G; }
__device__ __forceinline__ unsigned char* opq_ptr(unsigned char* p) { asm volatile("" : "+s"(p)); return p; }
#ifndef MK_REP
#define MK_REP 0
#endif
#ifndef MK_ONLYRP
#define MK_ONLYRP 0
#endif
#define REP(x) (1 + (((MK_REP) >> (x)) & 1))
#define XB_TMO      128
#define XB_XCNT(j)  (256  + 64 * (j))
#define XB_XSUB(j)  (1280 + 64 * (j))
#define XB_XGEN(j)  (2304 + 64 * (j))
#define XB_TOP      3328
#define XB_TOPGEN   3392
#define XCD_BAR_WORDS 3456
#define XB_SPIN_CAP (1u << 18)

__device__ __forceinline__ unsigned xb_ld(unsigned* p)              { return __hip_atomic_load(p, __ATOMIC_RELAXED, __HIP_MEMORY_SCOPE_AGENT); }
__device__ __forceinline__ unsigned xb_add(unsigned* p, unsigned v) { return __hip_atomic_fetch_add(p, v, __ATOMIC_RELAXED, __HIP_MEMORY_SCOPE_AGENT); }
__device__ __forceinline__ unsigned xb_xcc_id() { return (unsigned)__builtin_amdgcn_s_getreg((3 << 11) | 20) & 0xFu; }
#define XB_SPIN(cond, bar) do { unsigned _sp = 0; while (cond) { __builtin_amdgcn_s_sleep(1); \
    if ((++_sp & 255u) == 0u) { if (xb_ld(&(bar)[XB_TMO])) break; if (_sp > XB_SPIN_CAP) { atomicAdd(&(bar)[XB_TMO], 1u); break; } } } } while (0)

struct XcdBarrier {
    unsigned* bar; unsigned x;
    volatile LAS unsigned* st;
};

__device__ __forceinline__ XcdBarrier xcd_barrier_post(unsigned* bar, volatile LAS unsigned* st) {
    XcdBarrier b; b.bar = bar; b.x = xb_xcc_id(); b.st = st;
    if (threadIdx.x == 0) (void)xb_add(&bar[XB_XCNT(b.x)], 1u);
    return b;
}
__device__ __forceinline__ void xcd_barrier_complete(unsigned* bar, unsigned x, unsigned& nloc, unsigned& nx) {
    const unsigned G = gridDim.x * gridDim.y * gridDim.z;
    unsigned sum, cnt, mine, sp = 0u;
    for (;;) {
        sum = 0u; cnt = 0u; mine = 0u;
#pragma unroll
        for (unsigned j = 0; j < 16; ++j) { const unsigned c = xb_ld(&bar[XB_XCNT(j)]); sum += c; cnt += (c > 0u) ? 1u : 0u; mine = (j == x) ? c : mine; }
        if (sum == G) break;
        __builtin_amdgcn_s_sleep(1);
        if ((++sp & 255u) == 0u) { if (xb_ld(&bar[XB_TMO])) break; if (sp > XB_SPIN_CAP) { atomicAdd(&bar[XB_TMO], 1u); break; } }
    }
    nloc = mine > 0u ? mine : 1u; nx = cnt > 0u ? cnt : 1u;
}

__device__ __forceinline__ void xcd_barrier(const XcdBarrier& b) {
    asm volatile("s_waitcnt vmcnt(0)" ::: "memory");
    __syncthreads();
    if (threadIdx.x == 0) {
        unsigned* bar = b.bar;
        __builtin_amdgcn_s_waitcnt(0);
        unsigned nloc = b.st[0], nx = b.st[1];
        if (nloc == 0u) { xcd_barrier_complete(bar, b.x, nloc, nx); b.st[0] = nloc; b.st[1] = nx; }
        const unsigned old = xb_add(&bar[XB_XSUB(b.x)], 1u);
        const unsigned gen = old / nloc;
        if (old + 1u == (gen + 1u) * nloc) {
            __builtin_amdgcn_fence(__ATOMIC_RELEASE, "agent");
            asm volatile("s_waitcnt vmcnt(0)" ::: "memory");
            const unsigned og = xb_add(&bar[XB_TOP], 1u);
            const unsigned tg = og / nx;
            if (og + 1u == (tg + 1u) * nx) xb_add(&bar[XB_TOPGEN], 1u);
            else XB_SPIN(xb_ld(&bar[XB_TOPGEN]) == tg, bar);
            __builtin_amdgcn_fence(__ATOMIC_ACQUIRE, "agent");
            xb_add(&bar[XB_XGEN(b.x)], 1u);
            asm volatile("s_waitcnt vmcnt(0)" ::: "memory");
        } else {
            XB_SPIN(xb_ld(&bar[XB_XGEN(b.x)]) == gen, bar);
            __builtin_amdgcn_fence(__ATOMIC_ACQUIRE, "agent");
            asm volatile("s_waitcnt vmcnt(0)" ::: "memory");
        }
    }
    __syncthreads();
}
namespace pg8 {
#define PG8_LAS __attribute__((address_space(3)))
typedef unsigned short bf16_t;
typedef short bf16x8 __attribute__((ext_vector_type(8)));
typedef float f32x4 __attribute__((ext_vector_type(4)));
typedef unsigned u32x4 __attribute__((ext_vector_type(4)));
constexpr int BM = 256, BK = 64, HALF = 128, HTB = HALF * BK * 2  , STAGE_BYTES = 8 * HTB, NXCD = 8, WGM = 4;

__host__ __device__ __forceinline__ int lds_byte(int r, int c) { const int st = (r >> 4) * 2 + (c >> 5), rr = r & 15, cc = c & 31, ob = rr * 64 + cc * 2; return st * 1024 + (ob ^ (((ob >> 9) & 1) << 5)); }
__host__ __device__ __forceinline__ void stage_rc(int b, int& R, int& C) { const int st = b / 1024, sb = b % 1024, swz = sb ^ (((sb >> 9) & 1) << 5); R = (st >> 1) * 16 + swz / 64; C = (st & 1) * 32 + (swz % 64) / 2; }
__host__ __device__ __forceinline__ int perm32(int rho) { const int n = rho >> 4, i = rho & 15; return 8 * (i >> 2) + 4 * n + (i & 3); }

struct Unit { int pm, pn; };
struct Gemm { const bf16_t* A; const bf16_t* Bt; int M, N, K, ld; };

struct StaticOrder {
    int nM, nN, nwg, G, c;
    __host__ __device__ void init(int M, int N, int G_, int c_) { nM = M / BM; nN = N / BM; nwg = nM * nN; G = G_; c = c_; }
    __host__ __device__ bool next(int i, Unit& u) const {
        const long L = (long)i * G + c; if (L >= nwg) return false;
        int wgid = (int)L; { const int q = nwg / NXCD, r = nwg % NXCD, xcd = wgid % NXCD, off = wgid / NXCD; wgid = (xcd < r ? xcd * (q + 1) : r * (q + 1) + (xcd - r) * q) + off; }
        const int nig = WGM * nN, gid = wgid / nig, fm = gid * WGM, gsz = (nM - fm) < WGM ? (nM - fm) : WGM;
        u.pm = fm + ((wgid % nig) % gsz); u.pn = (wgid % nig) / gsz; return true;
    }
    __device__ __forceinline__ void a_ready(const Unit&) const {}
    __device__ __forceinline__ void done(const Unit&) const {}
};
struct CountedOrder : StaticOrder {
    const unsigned* ready; unsigned need; unsigned* tmo;
    __device__ __forceinline__ void a_ready(const Unit& u) const {
        if (threadIdx.x < 64) {
            const unsigned long long t0 = __builtin_amdgcn_s_memrealtime(); unsigned polls = 0;
            while ((unsigned)__builtin_amdgcn_readfirstlane(__hip_atomic_load(ready + 64 * u.pm, __ATOMIC_RELAXED, __HIP_MEMORY_SCOPE_AGENT)) < need) {
                if ((++polls & 255u) == 0u && __builtin_amdgcn_readfirstlane(__hip_atomic_load(tmo, __ATOMIC_RELAXED, __HIP_MEMORY_SCOPE_AGENT)) != 0u) break;
                if (__builtin_amdgcn_s_memrealtime() - t0 > 2000000ull) {
                    if (threadIdx.x == 0) { unsigned expect = 0u; __hip_atomic_compare_exchange_strong(tmo + 1, &expect, 0x600u | (unsigned)(u.pm & 0xff), __ATOMIC_RELAXED, __ATOMIC_RELAXED, __HIP_MEMORY_SCOPE_AGENT); __hip_atomic_store(tmo, 1u, __ATOMIC_RELAXED, __HIP_MEMORY_SCOPE_AGENT); }
                    break; }
                __builtin_amdgcn_s_sleep(2); }
            __builtin_amdgcn_fence(__ATOMIC_ACQUIRE, "agent");
            asm volatile("s_waitcnt vmcnt(0)" ::: "memory");
        }
#if !defined(BROKEN_HOOK_NO_BARRIER)
        asm volatile("" ::: "memory"); __builtin_amdgcn_s_barrier(); asm volatile("" ::: "memory");
#endif
    }
};

__device__ __forceinline__ unsigned cvt_pk_bf16(float lo, float hi) { unsigned r; asm volatile("v_cvt_pk_bf16_f32 %0, %1, %2" : "=v"(r) : "v"(lo), "v"(hi)); return r; }
typedef float f32x2 __attribute__((ext_vector_type(2)));
__device__ __forceinline__ f32x2 gelu_pk(f32x2 v) {
    const f32x2 av = __builtin_elementwise_abs(v), d = av * 0.2316418882f + 1.0f;
    f32x2 t; t.x = __builtin_amdgcn_rcpf(d.x); t.y = __builtin_amdgcn_rcpf(d.y);
    f32x2 q = t * 0.5307027145f + (-0.7265760135f); q = q * t + 0.7107068705f; q = q * t + (-0.142248368f); q = q * t + 0.127414796f; q = q * t;
    const f32x2 s = (v * v) * (-0.72134752044f);
    f32x2 e; e.x = __builtin_amdgcn_exp2f(s.x); e.y = __builtin_amdgcn_exp2f(s.y);
    const f32x2 m = v * (q * e), r = v - m;
    f32x2 o; o.x = v.x < 0.f ? m.x : r.x; o.y = v.y < 0.f ? m.y : r.y; return o;
}

struct EpiF32 {
    static constexpr bool PERM = false, AFTER_DRAIN = false;
    float* C; int ldc; const float* bias;
    __device__ __forceinline__ void operator()(const f32x4 (&acc)[2][2][4][2], const Unit& u, int wr, int wc, int fr, int fq) const {
        const int row0 = u.pm * BM + wr * 64 + fr, col0 = u.pn * BM + wc * 32 + 4 * fq;
        f32x4 bv[2][2];
#pragma unroll
        for (int bj = 0; bj < 2; ++bj)
#pragma unroll
            for (int n = 0; n < 2; ++n) bv[bj][n] = bias ? *(const f32x4*)(bias + col0 + bj * HALF + n * 16) : (f32x4){0.f, 0.f, 0.f, 0.f};
#pragma unroll
        for (int ai = 0; ai < 2; ++ai)
#pragma unroll
            for (int m = 0; m < 4; ++m) { float* rowp = C + (size_t)(row0 + ai * HALF + m * 16) * ldc + col0;
#pragma unroll
                for (int bj = 0; bj < 2; ++bj)
#pragma unroll
                    for (int n = 0; n < 2; ++n) *(f32x4*)(rowp + bj * HALF + n * 16) = acc[ai][bj][m][n] + bv[bj][n]; }
    }
};
template <int ACT  > struct EpiBf16 {
    static constexpr bool PERM = true, AFTER_DRAIN = false;
    bf16_t* O; int ldc; const float* bias; int split_cols; size_t split_stride;
    __device__ __forceinline__ void operator()(const f32x4 (&acc)[2][2][4][2], const Unit& u, int wr, int wc, int fr, int fq) const {
        const int row0 = u.pm * BM + wr * 64 + fr; int colt = u.pn * BM; bf16_t* base = O;
        if (split_cols) { const int t = colt / split_cols; base += (size_t)t * split_stride; colt -= t * split_cols; }
        const int col0 = colt + wc * 32 + 8 * fq, bcol0 = u.pn * BM + wc * 32 + 8 * fq;
        f32x4 bv[2][2];
#pragma unroll
        for (int bj = 0; bj < 2; ++bj)
#pragma unroll
            for (int n = 0; n < 2; ++n) bv[bj][n] = bias ? *(const f32x4*)(bias + bcol0 + bj * HALF + 4 * n) : (f32x4){0.f, 0.f, 0.f, 0.f};
#pragma unroll
        for (int ai = 0; ai < 2; ++ai)
#pragma unroll
            for (int m = 0; m < 4; ++m) { bf16_t* rowp = base + (size_t)(row0 + ai * HALF + m * 16) * ldc + col0;
#pragma unroll
                for (int bj = 0; bj < 2; ++bj) { f32x4 v0 = acc[ai][bj][m][0] + bv[bj][0], v1 = acc[ai][bj][m][1] + bv[bj][1];
                    if (ACT == 1) { f32x2 a = gelu_pk((f32x2){v0[0], v0[1]}), b = gelu_pk((f32x2){v0[2], v0[3]}), c = gelu_pk((f32x2){v1[0], v1[1]}), d = gelu_pk((f32x2){v1[2], v1[3]});
                        v0 = (f32x4){a.x, a.y, b.x, b.y}; v1 = (f32x4){c.x, c.y, d.x, d.y}; }
                    if (ACT == 2) {
#pragma unroll
                        for (int j = 0; j < 4; ++j) { v0[j] = 0.5f * v0[j] * (1.0f + erff(v0[j] * 0.70710678f)); v1[j] = 0.5f * v1[j] * (1.0f + erff(v1[j] * 0.70710678f)); } }
                    u32x4 w; w.x = cvt_pk_bf16(v0[0], v0[1]); w.y = cvt_pk_bf16(v0[2], v0[3]); w.z = cvt_pk_bf16(v1[0], v1[1]); w.w = cvt_pk_bf16(v1[2], v1[3]);
                    *(u32x4*)(rowp + bj * HALF) = w; } }
    }
};
}
namespace pg8 {
struct EpiSwiGLU {
    static constexpr bool PERM = true, AFTER_DRAIN = false;
    bf16_t* O; int ldc;
    __device__ __forceinline__ void operator()(const f32x4 (&acc)[2][2][4][2], const Unit& u, int wr, int wc, int fr, int fq) const {
        const int row0 = u.pm * BM + wr * 64 + fr, col0 = u.pn * HALF + wc * 32 + 8 * fq;
#pragma unroll
        for (int ai = 0; ai < 2; ++ai)
#pragma unroll
            for (int m = 0; m < 4; ++m) { bf16_t* rowp = O + (size_t)(row0 + ai * HALF + m * 16) * ldc + col0;
                float h[8];
#pragma unroll
                for (int n = 0; n < 2; ++n)
#pragma unroll
                    for (int j = 0; j < 4; ++j) { const float g = acc[ai][0][m][n][j], up = acc[ai][1][m][n][j]; h[n * 4 + j] = g * __builtin_amdgcn_rcpf(1.0f + __builtin_amdgcn_exp2f(-1.4426950408889634f * g)) * up; }
                u32x4 w; w.x = cvt_pk_bf16(h[0], h[1]); w.y = cvt_pk_bf16(h[2], h[3]); w.z = cvt_pk_bf16(h[4], h[5]); w.w = cvt_pk_bf16(h[6], h[7]);
                *(u32x4*)rowp = w; }
    }
};
struct EpiResid {
    static constexpr bool PERM = false, AFTER_DRAIN = false;
    float* X; const float* gate_x; const float* gate_c; float fac; float* out_x;
    __device__ __forceinline__ void operator()(const f32x4 (&acc)[2][2][4][2], const Unit& u, int wr, int wc, int fr, int fq) const {
        const int row0 = u.pm * BM + wr * 64 + fr, col0 = u.pn * BM + wc * 32 + 4 * fq;
        const float* gv = (u.pm == 0) ? gate_c : gate_x;
        float* dst = (u.pm != 0 && out_x) ? out_x - (size_t)256 * 4096 : X;
        f32x4 gg[2][2];
#pragma unroll
        for (int bj = 0; bj < 2; ++bj)
#pragma unroll
            for (int n = 0; n < 2; ++n) gg[bj][n] = *(const f32x4*)(gv + col0 + bj * HALF + n * 16) * fac;
#pragma unroll
        for (int ai = 0; ai < 2; ++ai)
#pragma unroll
            for (int m = 0; m < 4; ++m) { const size_t off = (size_t)(row0 + ai * HALF + m * 16) * 4096 + col0;
#pragma unroll
                for (int bj = 0; bj < 2; ++bj)
#pragma unroll
                    for (int n = 0; n < 2; ++n) { const f32x4 b = *(const f32x4*)(X + off + bj * HALF + n * 16); *(f32x4*)(dst + off + bj * HALF + n * 16) = b + gg[bj][n] * acc[ai][bj][m][n]; } }
    }
};
struct OneUnit { int pn;
    __host__ __device__ bool next(int i, Unit& u) const { u.pm = 0; u.pn = pn; return i == 0; }
    __device__ __forceinline__ void a_ready(const Unit&) const {}
    __device__ __forceinline__ void done(const Unit&) const {}
};
struct StaticOrderX { StaticOrder b;
    __host__ __device__ void init(int M, int N, int G_, int c_) { b.init(M - BM, N, G_, c_); }
    __host__ __device__ bool next(int i, Unit& u) const { const bool ok = b.next(i, u); u.pm += 1; return ok; }
    __device__ __forceinline__ void a_ready(const Unit&) const {}
    __device__ __forceinline__ void done(const Unit&) const {}
};
}
namespace pg8 {
template <class Epi, class Sched, bool STAMP = false>
__device__ __forceinline__ void gemm_phase(PG8_LAS unsigned char* lds, const Gemm g, const Sched& S, const Epi& E, unsigned long long* stamps) {
    int tid_ = threadIdx.x; asm volatile("" : "+v"(tid_));
    const int tid = tid_, wid = __builtin_amdgcn_readfirstlane(tid >> 6), lane = tid & 63, wr = wid >> 2, wc = wid & 3, fr = lane & 15, fq = lane >> 4;
    const int K = g.ld, nt = g.K / BK;
    int ts_lo = 0, ts_hi = 0, nts = 0; const unsigned long long rt_entry = STAMP ? (unsigned long long)wall_clock64() : 0ull;
#define PG8_STAMP() do { if (STAMP && wid == 0 && nts < 64) { const unsigned long long _c = (unsigned long long)clock64(); \
        ts_lo = (lane == nts) ? (int)(unsigned)_c : ts_lo; ts_hi = (lane == nts) ? (int)(unsigned)(_c >> 32) : ts_hi; ++nts; } } while (0)
    PG8_STAMP();
    unsigned voffA[2], voffB[2];
#pragma unroll
    for (int i = 0; i < 2; ++i) { int R, C; stage_rc(tid * 16 + i * 8192, R, C); const int Rb = Epi::PERM ? ((R & ~31) + perm32(R & 31)) : R;
        voffA[i] = (unsigned)(R * K + C) * 2u; voffB[i] = (unsigned)(Rb * K + C) * 2u; }
    const size_t kstep = (size_t)(BK * 2);
    const size_t hstep = (size_t)HALF * K * 2;
    const size_t tstep = 2 * hstep;
    const unsigned ldsw = (unsigned)wid * 1024u;
    const int aoff = lds_byte(wr * 64 + fr, fq * 8), boff = lds_byte(wc * 32 + fr, fq * 8);
#define PG8_SA(b, h) (((b) * 2 + (h)) * HTB)
#define PG8_SB(b, h) ((4 + (b) * 2 + (h)) * HTB)
#define PG8_STAGE(bufoff, gbase, voff) do { _Pragma("unroll") for (int _i = 0; _i < 2; ++_i) \
        __builtin_amdgcn_global_load_lds((const unsigned*)((const char*)(gbase) + (voff)[_i]), (PG8_LAS unsigned*)(lds + (bufoff) + ldsw + _i * 8192), 16, 0, 0); } while (0)
#define PG8_LDA(dst, b, h) do { _Pragma("unroll") for (int m = 0; m < 4; ++m) _Pragma("unroll") for (int k = 0; k < 2; ++k) dst[m][k] = *(const PG8_LAS bf16x8*)(lds + PG8_SA(b, h) + aoff + m * 2048 + k * 1024); } while (0)
#define PG8_LDB(dst, b, h) do { _Pragma("unroll") for (int n = 0; n < 2; ++n) _Pragma("unroll") for (int k = 0; k < 2; ++k) dst[n][k] = *(const PG8_LAS bf16x8*)(lds + PG8_SB(b, h) + boff + n * 2048 + k * 1024); } while (0)
#define PG8_MMA(ai, bj, At, Bt) do { __builtin_amdgcn_s_setprio(1); _Pragma("unroll") for (int m = 0; m < 4; ++m) _Pragma("unroll") for (int n = 0; n < 2; ++n) _Pragma("unroll") for (int k = 0; k < 2; ++k) \
        acc[ai][bj][m][n] = __builtin_amdgcn_mfma_f32_16x16x32_bf16(Bt[n][k], At[m][k], acc[ai][bj][m][n], 0, 0, 0); __builtin_amdgcn_s_setprio(0); } while (0)
#define PG8_WAIT_V(n) asm volatile("s_waitcnt vmcnt(" #n ")" ::: "memory")
#define PG8_WAIT_L(n) asm volatile("s_waitcnt lgkmcnt(" #n ")" ::: "memory")
#define PG8_BAR __builtin_amdgcn_s_barrier()
#define PG8_SCHED __builtin_amdgcn_sched_barrier(0)
    Unit cur, nxt; int ui = 0;
    if (!S.next(0, cur)) return;
    f32x4 acc[2][2][4][2];
#pragma unroll
    for (int a = 0; a < 2; ++a)
#pragma unroll
        for (int b = 0; b < 2; ++b)
#pragma unroll
            for (int m = 0; m < 4; ++m)
#pragma unroll
                for (int n = 0; n < 2; ++n) acc[a][b][m][n] = (f32x4){0.f, 0.f, 0.f, 0.f};
    bf16x8 At[4][2], B0[2][2], B1[2][2];
    const char* cA = (const char*)g.A + (size_t)cur.pm * tstep; const char* cB = (const char*)g.Bt + (size_t)cur.pn * tstep;
    S.a_ready(cur);
    PG8_STAGE(PG8_SB(0, 0), cB, voffB); PG8_STAGE(PG8_SA(0, 0), cA, voffA); PG8_STAGE(PG8_SB(0, 1), cB + hstep, voffB); PG8_STAGE(PG8_SA(0, 1), cA + hstep, voffA);
    if (wr == 1) PG8_BAR;
    PG8_WAIT_V(4); PG8_BAR;
    PG8_STAGE(PG8_SB(1, 0), cB + kstep, voffB); PG8_STAGE(PG8_SA(1, 0), cA + kstep, voffA); PG8_STAGE(PG8_SB(1, 1), cB + hstep + kstep, voffB);
    PG8_WAIT_V(6); PG8_BAR;
    PG8_STAMP();
    for (;;) {
        const bool has_next = S.next(ui + 1, nxt);
        const char* nA = has_next ? (const char*)g.A + (size_t)nxt.pm * tstep : cA; const char* nB = has_next ? (const char*)g.Bt + (size_t)nxt.pn * tstep : cB;
        for (int t = 0; t < nt; t += 2) {
            const bool last = (t == nt - 2);
            const char* a1 = cA + (size_t)(t + 1) * kstep;
            const char* a2 = last ? nA : cA + (size_t)(t + 2) * kstep; const char* b2 = last ? nB : cB + (size_t)(t + 2) * kstep;
            const char* a3 = a2 + kstep; const char* b3 = b2 + kstep;
            if (last && has_next) S.a_ready(nxt);
            PG8_LDB(B0, 0, 0); PG8_SCHED; PG8_LDA(At, 0, 0); PG8_STAGE(PG8_SA(1, 1), a1 + hstep, voffA);
            PG8_WAIT_L(8); PG8_BAR; PG8_WAIT_L(0); PG8_MMA(0, 0, At, B0); PG8_BAR; PG8_SCHED;
            PG8_LDB(B1, 0, 1); PG8_STAGE(PG8_SB(0, 0), b2, voffB);
            PG8_BAR; PG8_WAIT_L(0); PG8_MMA(0, 1, At, B1); PG8_BAR;
            PG8_LDA(At, 0, 1); PG8_STAGE(PG8_SA(0, 0), a2, voffA);
            PG8_BAR; PG8_WAIT_L(0); PG8_MMA(1, 0, At, B0); PG8_BAR; PG8_SCHED;
            PG8_STAGE(PG8_SB(0, 1), b2 + hstep, voffB);
            PG8_WAIT_V(6); PG8_BAR; PG8_MMA(1, 1, At, B1); PG8_BAR;
            PG8_LDB(B0, 1, 0); PG8_SCHED; PG8_LDA(At, 1, 0); PG8_STAGE(PG8_SA(0, 1), a2 + hstep, voffA);
            PG8_WAIT_L(8); PG8_BAR; PG8_WAIT_L(0); PG8_MMA(0, 0, At, B0); PG8_BAR; PG8_SCHED;
            PG8_LDB(B1, 1, 1); PG8_STAGE(PG8_SB(1, 0), b3, voffB);
            PG8_BAR; PG8_WAIT_L(0); PG8_MMA(0, 1, At, B1); PG8_BAR;
            PG8_LDA(At, 1, 1); PG8_STAGE(PG8_SA(1, 0), a3, voffA);
            PG8_BAR; PG8_WAIT_L(0); PG8_MMA(1, 0, At, B0); PG8_BAR; PG8_SCHED;
            PG8_STAGE(PG8_SB(1, 1), b3 + hstep, voffB);
            PG8_WAIT_V(6); PG8_BAR; PG8_MMA(1, 1, At, B1); PG8_BAR;
        }
        PG8_STAMP();
        if constexpr (!Epi::AFTER_DRAIN) { E(acc, cur, wr, wc, fr, fq); S.done(cur); }
        PG8_STAMP();
        if (!has_next) break;
#pragma unroll
        for (int a = 0; a < 2; ++a)
#pragma unroll
            for (int b = 0; b < 2; ++b)
#pragma unroll
                for (int m = 0; m < 4; ++m)
#pragma unroll
                    for (int n = 0; n < 2; ++n) acc[a][b][m][n] = (f32x4){0.f, 0.f, 0.f, 0.f};
        cur = nxt; cA = nA; cB = nB; ++ui;
    }
    PG8_WAIT_V(0);
    if (wr == 0) PG8_BAR;
    PG8_BAR;
    if constexpr (Epi::AFTER_DRAIN) { E.fused(acc, cur, wr, wc, fr, fq, lds, wid, lane); S.done(cur); }
    PG8_STAMP();
    if (STAMP && wid == 0) { stamps[lane] = lane < nts ? (((unsigned long long)(unsigned)ts_hi << 32) | (unsigned)ts_lo) : 0ull;
        if (lane == 62) stamps[62] = rt_entry; if (lane == 63) stamps[63] = (unsigned long long)wall_clock64(); }
#undef PG8_STAMP
#undef PG8_SA
#undef PG8_SB
#undef PG8_STAGE
#undef PG8_LDA
#undef PG8_LDB
#undef PG8_MMA
#undef PG8_WAIT_V
#undef PG8_WAIT_L
#undef PG8_BAR
#undef PG8_SCHED
}
}
#define LDS_WAIT() asm volatile("s_waitcnt lgkmcnt(0)" ::: "memory")

__device__ __forceinline__ int map_row(int n, int mode) {
    if (mode == 1) { const int j = n < FF ? n : n - FF; return (j >> 7) * 256 + (n < FF ? 0 : 128) + (j & 127); }
    return n;
}
__device__ __forceinline__ void transpose_item(const float* __restrict__ W, int K, int N, bf16_t* WT, int mode, LAS float* scr, int item, int lane) {
    const int nblk = N / 32, kb = item / nblk, nb = item % nblk, k0 = 64 * kb, n0 = 32 * nb;
#pragma unroll 8
    for (int i = 0; i < 32; ++i) { const int kk = 2 * i + (lane >> 5); scr[kk * 33 + (lane & 31)] = W[(size_t)(k0 + kk) * N + n0 + (lane & 31)]; }
    LDS_WAIT(); asm volatile("" ::: "memory");
    const int c = lane & 7;
#pragma unroll
    for (int j = 0; j < 4; ++j) { const int n = (lane >> 3) + 8 * j; const LAS float* s = scr + (8 * c) * 33 + n;
        u32x4 o; o.x = cvt_pk_bf16(s[0 * 33], s[1 * 33]); o.y = cvt_pk_bf16(s[2 * 33], s[3 * 33]); o.z = cvt_pk_bf16(s[4 * 33], s[5 * 33]); o.w = cvt_pk_bf16(s[6 * 33], s[7 * 33]);
        *(u32x4*)(WT + (size_t)map_row(n0 + n, mode) * K + k0 + 8 * c) = o; }
    LDS_WAIT(); asm volatile("" ::: "memory");
}
constexpr int I_G = (DM / 64) * (2 * FF / 32), I_D = (FF / 64) * (DM / 32), I_IN = (DM / 64) * (9600 / 32), I_OUT = (DM / 64) * (DM / 32), I_Q = (1024 / 64) * (NQ / 32), I_KV = (512 / 64) * (NKV / 32);
constexpr int I_LAYER = 2 * I_G + 2 * I_D + I_IN + I_OUT + I_Q + I_KV;

__device__ __forceinline__ void phase0(const Frame& F, unsigned char* ws) {
    const int gw = F.bid * 8 + F.wave, NGW = F.G * 8;
    const size_t gt = (size_t)F.bid * 512 + F.tid, NGT = (size_t)F.G * 512;
    LAS float* scr = (LAS float*)(F.lds + F.wave * 8704);
    bf16_t* WB = (bf16_t*)(ws + WS_WB);
    for (int it = gw; it < NL * I_LAYER; it += NGW) {
        const int l = it / I_LAYER; int r = it - l * I_LAYER; bf16_t* wl = WB + (size_t)l * W_LAYER;
        if (r < I_G) { transpose_item(IN_(10) + (size_t)l * DM * 2 * FF, DM, 2 * FF, wl + W_G1, 1, scr, r, F.lane); continue; } r -= I_G;
        if (r < I_D) { transpose_item(IN_(11) + (size_t)l * FF * DM, FF, DM, wl + W_D1, 0, scr, r, F.lane); continue; } r -= I_D;
        if (r < I_G) { transpose_item(IN_(12) + (size_t)l * DM * 2 * FF, DM, 2 * FF, wl + W_G2, 1, scr, r, F.lane); continue; } r -= I_G;
        if (r < I_D) { transpose_item(IN_(13) + (size_t)l * FF * DM, FF, DM, wl + W_D2, 0, scr, r, F.lane); continue; } r -= I_D;
        if (r < I_IN) { transpose_item(IN_(14) + (size_t)l * DM * 9600, DM, 9600, wl + W_IN, 0, scr, r, F.lane); continue; } r -= I_IN;
        if (r < I_OUT) { transpose_item(IN_(15) + (size_t)l * DM * DM, DM, DM, wl + W_OUT, 0, scr, r, F.lane); continue; } r -= I_OUT;
        if (r < I_Q) { transpose_item(IN_(39) + (size_t)l * 1024 * NQ, 1024, NQ, wl + W_Q, 0, scr, r, F.lane); continue; } r -= I_Q;
        transpose_item(IN_(41) + (size_t)l * 512 * NKV, 512, NKV, wl + W_KV, 0, scr, r, F.lane);
    }
    for (size_t i = gt; i < (size_t)NL * 128 * 512; i += NGT) {
        const int l = (int)(i / (128 * 512)), rr = (int)((i / 512) % 128), c = (int)(i % 512);
        const int row = 9600 + rr;
        *(u32x4*)(WB + (size_t)l * W_LAYER + W_IN + (size_t)row * DM + c * 8) = (u32x4){0u, 0u, 0u, 0u};
    }
    { bf16_t* WLR = (bf16_t*)(ws + WS_WLR); const float* wu = IN_(18); const float* au = IN_(20); const float* gu = IN_(21);
      for (size_t i = gt; i < (size_t)NL * 448 * A_W; i += NGT) { const int l = (int)(i / (448 * A_W)), k = (int)((i / A_W) % 448), col = (int)(i % A_W);
          float v;
          if (k < 128) v = wu[(((size_t)l * 2 + (k >> 6)) * 64 + (k & 63)) * A_W + col];
          else if (k < 256) v = au[(((size_t)l * 2 + ((k - 128) >> 6)) * 64 + (k & 63)) * A_W + col];
          else v = gu[((size_t)l * 192 + (k - 256)) * A_W + col];
          WLR[((size_t)l * A_W + col) * 448 + k] = (bf16_t)(cvt_pk_bf16(v, v) & 0xffffu); } }
    { f32x4* xs = (f32x4*)(ws + WS_XS); const f32x4* cx = (const f32x4*)IN_(2); const f32x4* xx = (const f32x4*)IN_(0);
      for (size_t i = gt; i < (size_t)T * DM / 4; i += NGT) xs[i] = i < (size_t)NCTX * DM / 4 ? cx[i] : xx[i - (size_t)NCTX * DM / 4]; }
    { float* HP = (float*)(ws + WS_HP);
      for (int it = F.bid; it < NL * 16; it += F.G) { const int l = it >> 4, ch = it & 15, w = F.tid >> 8, j = F.tid & 255;
          const float* cv = w ? IN_(3) : IN_(1); const float* ad = IN_(4) + ((size_t)l * DM + ch * 256) * 256 + j; float s = 0.f;
          for (int i = 0; i < 256; ++i) s += siluf_(cv[ch * 256 + i]) * ad[(size_t)i * 256];
          HP[((l * 16 + ch) * 2 + w) * 256 + j] = s; } }
    { float* H3 = (float*)(ws + WS_H3);
      LAS float* zb = (LAS float*)(F.lds + 73728); LAS float* ha = zb + 8 * 36; LAS float* hb = ha + 8 * 64;
      for (int it = F.bid; it < NL * (T / 8); it += F.G) { const int l = it / (T / 8), pb = it % (T / 8);
          if (F.tid < 8 * 33) { const int p = F.tid / 33, i = F.tid % 33, P = pb * 8 + p; const int L = P < NCTX ? NCTX : SEQ, t = P < NCTX ? P : P - NCTX;
              float z;
              if (i == 0) z = (float)t / (float)(L - 1);
              else { const int b = (i - 1) & 15; const float fb = 1e-4f + (float)b * ((15.0f - 1e-4f) / 15.0f); const float rev2 = 2.0f * fb * (float)t / (float)L;
                  z = i <= 16 ? cospif(rev2) : -sinpif(rev2); }
              zb[p * 36 + i] = z; }
          __syncthreads();
          const int p = F.tid >> 6, j = F.tid & 63; const float fq = IN_(36)[l * 64 + j];
          { const float* w1 = IN_(29) + (size_t)l * 33 * 64 + j; float s = IN_(30)[l * 64 + j];
            for (int i = 0; i < 33; ++i) s += zb[p * 36 + i] * w1[i * 64];
            ha[p * 64 + j] = sinf(fq * s); }
          __syncthreads();
          { const float* w2 = IN_(31) + (size_t)l * 64 * 64 + j; float s = IN_(32)[l * 64 + j];
            for (int i = 0; i < 64; ++i) s += ha[p * 64 + i] * w2[i * 64];
            hb[p * 64 + j] = sinf(fq * s); }
          __syncthreads();
          { const float* w3 = IN_(33) + (size_t)l * 64 * 64 + j; float s = IN_(34)[l * 64 + j];
            for (int i = 0; i < 64; ++i) s += hb[p * 64 + i] * w3[i * 64];
            ((bf16_t*)H3)[((size_t)l * 64 + j) * T + pb * 8 + p] = (bf16_t)(cvt_pk_bf16(sinf(fq * s), 0.f) & 0xffffu); }
          __syncthreads(); } }
}
__device__ __forceinline__ void phase_mod(const Frame& F, unsigned char* ws) {
    const float* HP = (const float*)(ws + WS_HP); float* MOD = (float*)(ws + WS_MOD);
    LAS float* hs = (LAS float*)F.lds;
    for (int it = F.bid; it < NL * (NMOD / 512); it += F.G) { const int l = it / (NMOD / 512), nb = it % (NMOD / 512);
        { const int w = F.tid >> 8, j = F.tid & 255; float s = 0.f;
          for (int ch = 0; ch < 16; ++ch) s += HP[((l * 16 + ch) * 2 + w) * 256 + j];
          hs[w * 256 + j] = s; }
        __syncthreads();
        const int n = nb * 512 + F.tid; const float* au = IN_(5) + (size_t)l * 256 * NMOD + n; float s0 = IN_(6)[(size_t)l * NMOD + n], s1 = s0;
        for (int j = 0; j < 256; ++j) { const float u = au[(size_t)j * NMOD]; s0 += hs[j] * u; s1 += hs[256 + j] * u; }
        MOD[((size_t)l * 2 + 0) * NMOD + n] = s0; MOD[((size_t)l * 2 + 1) * NMOD + n] = s1;
        __syncthreads(); }
}
__device__ __forceinline__ void norm_phase(const Frame& F, float* XS, const float* __restrict__ gain, const float* modx, const float* modc, int ish, int isc, bf16_t* out, const bf16_t* slab, const float* sgate, float sfac) {
    const int gw = F.bid * 8 + F.wave, NGW = F.G * 8;
    int row_lo = 0;
    if (slab) { row_lo = NCTX;
        LAS float* red = (LAS float*)F.lds;
        for (int row = F.bid; row < NCTX; row += F.G) { const size_t o = (size_t)row * DM + F.wave * 512;
            f32x4 v[2]; float s = 0.f;
#pragma unroll
            for (int j = 0; j < 2; ++j) { f32x4 acc = (f32x4){0.f, 0.f, 0.f, 0.f};
#pragma unroll
                for (int ks = 0; ks < 16; ++ks) acc += bf4f(((const u32x2*)(slab + (size_t)ks * NCTX * DM + o) + F.lane)[64 * j]);
                v[j] = ((const f32x4*)(XS + o) + F.lane)[64 * j] + acc * ((const f32x4*)(sgate + F.wave * 512) + F.lane)[64 * j] * sfac;
                ((f32x4*)(XS + o) + F.lane)[64 * j] = v[j]; s += (v[j].x * v[j].x + v[j].y * v[j].y) + (v[j].z * v[j].z + v[j].w * v[j].w); }
            s = wave_sum(s); if (F.lane == 0) red[F.wave] = s;
            __syncthreads();
            float tot = 0.f;
#pragma unroll
            for (int w = 0; w < 8; ++w) tot += red[w];
            const float rstd = rsqrtf(tot * (1.0f / DM) + NORM_EPS);
#pragma unroll
            for (int j = 0; j < 2; ++j) { const int c4 = F.wave * 128 + F.lane + 64 * j;
                const f32x4 y = v[j] * rstd * ((const f32x4*)gain)[c4] * (((const f32x4*)(modc + (size_t)isc * DM))[c4] + 1.0f) + ((const f32x4*)(modc + (size_t)ish * DM))[c4];
                u32x2 w2; w2.x = cvt_pk_bf16(y.x, y.y); w2.y = cvt_pk_bf16(y.z, y.w); ((u32x2*)(out + (size_t)row * DM))[c4] = w2; }
            __syncthreads(); } }
    for (int row = row_lo + gw; row < T; row += NGW) {
        const float* mod = row < NCTX ? modc : modx;
        const f32x4* xr = (const f32x4*)(XS + (size_t)row * DM) + F.lane; const f32x4* g4 = (const f32x4*)gain + F.lane;
        const f32x4* sh4 = (const f32x4*)(mod + (size_t)ish * DM) + F.lane; const f32x4* sc4 = (const f32x4*)(mod + (size_t)isc * DM) + F.lane;
        f32x4 v[16]; float s = 0.f;
#pragma unroll
        for (int j = 0; j < 16; ++j) { v[j] = xr[64 * j]; s += (v[j].x * v[j].x + v[j].y * v[j].y) + (v[j].z * v[j].z + v[j].w * v[j].w); }
        const float rstd = rsqrtf(wave_sum(s) * (1.0f / DM) + NORM_EPS);
        u32x2* o = (u32x2*)(out + (size_t)row * DM) + F.lane;
#pragma unroll
        for (int j = 0; j < 16; ++j) { const f32x4 y = v[j] * rstd * g4[64 * j] * (sc4[64 * j] + 1.0f) + sh4[64 * j];
            u32x2 w; w.x = cvt_pk_bf16(y.x, y.y); w.y = cvt_pk_bf16(y.z, y.w); o[64 * j] = w; }
    }
}
__device__ __forceinline__ float conv3_at(const bf16_t* PX, int tau, int col, float w0, float w1, float w2) {
    const bf16_t* p = PX + (size_t)tau * PXW + col;
    const bool hl = has_left(tau), hr = has_right(tau);
    return bf2f(p[0]) * w1 + bf2f(p[hl ? -PXW : 0]) * (hl ? w0 : 0.f) + bf2f(p[hr ? PXW : 0]) * (hr ? w2 : 0.f);
}
__device__ __forceinline__ float rope_apply(float val, int tau, int j) {
    const int pos = tau - NCTX, prow = pos >> 6, pcol = pos & 63;
    const float inv = __powf(10000.0f, -(float)(j & 15) * (1.0f / 16.0f));
    const float ang = (float)(j < 32 ? prow : pcol) * inv;
    float sn, cs; sincosf(ang, &sn, &cs);
    const float partner = __shfl_xor(val, 16);
    const float rot = (j & 16) ? partner : -partner;
    return val * cs + rot * sn;
}
__device__ __forceinline__ void mla_prep_phase(const Frame& F, unsigned char* ws, int l) {
    const bf16_t* PX = (const bf16_t*)(ws + WS_PX); bf16_t* QA = (bf16_t*)(ws + WS_QA); bf16_t* KVA = (bf16_t*)(ws + WS_KVA); bf16_t* KPE = (bf16_t*)(ws + WS_KPE);
    const int gw = F.bid * 8 + F.wave, NGW = F.G * 8;
    const f32x4* gq = (const f32x4*)(IN_(38) + l * 1024) + F.lane; const f32x4* gkv = (const f32x4*)(IN_(40) + l * 512) + F.lane; const float gpe = IN_(45)[l * 64 + F.lane];
    for (int tau = gw; tau < T; tau += NGW) {
        const u32x2* p = (const u32x2*)(PX + (size_t)tau * PXW + PXC) + F.lane;
        f32x4 q[4], kv[2]; float sq = 0.f, skv = 0.f;
#pragma unroll
        for (int j = 0; j < 4; ++j) { q[j] = bf4f(p[64 * j]); sq += (q[j].x * q[j].x + q[j].y * q[j].y) + (q[j].z * q[j].z + q[j].w * q[j].w); }
#pragma unroll
        for (int j = 0; j < 2; ++j) { kv[j] = bf4f(p[256 + 64 * j]); skv += (kv[j].x * kv[j].x + kv[j].y * kv[j].y) + (kv[j].z * kv[j].z + kv[j].w * kv[j].w); }
        const float pe = bf2f(PX[(size_t)tau * PXW + PXC + 1536 + F.lane]);
        const float rq = rsqrtf(wave_sum(sq) * (1.0f / 1024.0f) + NORM_EPS), rkv = rsqrtf(wave_sum(skv) * (1.0f / 512.0f) + NORM_EPS), rpe = rsqrtf(wave_sum(pe * pe) * (1.0f / 64.0f) + NORM_EPS);
        u32x2* oq = (u32x2*)(QA + (size_t)tau * 1024) + F.lane; u32x2* okv = (u32x2*)(KVA + (size_t)tau * 512) + F.lane;
#pragma unroll
        for (int j = 0; j < 4; ++j) { const f32x4 y = q[j] * rq * gq[64 * j]; u32x2 w; w.x = cvt_pk_bf16(y.x, y.y); w.y = cvt_pk_bf16(y.z, y.w); oq[64 * j] = w; }
#pragma unroll
        for (int j = 0; j < 2; ++j) { const f32x4 y = kv[j] * rkv * gkv[64 * j]; u32x2 w; w.x = cvt_pk_bf16(y.x, y.y); w.y = cvt_pk_bf16(y.z, y.w); okv[64 * j] = w; }
        float kp = pe * rpe * gpe;
        if (tau >= NCTX) kp = rope_apply(kp, tau, F.lane);
        KPE[(size_t)tau * 64 + F.lane] = (bf16_t)(cvt_pk_bf16(kp, kp) & 0xffffu);
    }
}
__device__ __forceinline__ void qkv_final_phase(const Frame& F, unsigned char* ws, int l, bool need_ctx) {
    const bf16_t* QRAW = (const bf16_t*)(ws + WS_QRAW); const bf16_t* KVRAW = (const bf16_t*)(ws + WS_KVRAW); const bf16_t* KPE = (const bf16_t*)(ws + WS_KPE);
    bf16_t* QF = (bf16_t*)(ws + WS_QF); bf16_t* KF = (bf16_t*)(ws + WS_KF);
    const int gw = F.bid * 8 + F.wave, NGW = F.G * 8, ln = F.lane;
    const float gqn0 = IN_(42)[l * 128 + 2 * ln], gqn1 = IN_(42)[l * 128 + 2 * ln + 1], gqp = IN_(43)[l * 64 + ln];
    const float gkn0 = IN_(44)[l * 128 + 2 * ln], gkn1 = IN_(44)[l * 128 + 2 * ln + 1];
    (void)need_ctx;
    for (int tau = gw; tau < T; tau += NGW) {
        float cs = 1.f, sn = 0.f;
        if (tau >= NCTX) { const int pos = tau - NCTX, prow = pos >> 6, pcol = pos & 63; const float inv = __powf(10000.0f, -(float)(ln & 15) * (1.0f / 16.0f)); sincosf((float)(ln < 32 ? prow : pcol) * inv, &sn, &cs); }
        const bf16_t kpe = KPE[(size_t)tau * 64 + ln];
        const bf16_t* qrow = QRAW + (size_t)tau * NQ; const bf16_t* krow = KVRAW + (size_t)tau * NKV;
        unsigned qn[NHC], kn[NHC]; bf16_t qpv[NHC];
#pragma unroll
        for (int h = 0; h < NHC; ++h) { qn[h] = *(const unsigned*)(qrow + h * 192 + 2 * ln); qpv[h] = qrow[h * 192 + 128 + ln]; kn[h] = *(const unsigned*)(krow + h * 256 + 2 * ln); }
#pragma unroll
        for (int h = 0; h < NHC; ++h) {
            const float q0 = bf2f((unsigned short)(qn[h] & 0xffffu)), q1 = bf2f((unsigned short)(qn[h] >> 16)), qp = bf2f(qpv[h]), k0 = bf2f((unsigned short)(kn[h] & 0xffffu)), k1 = bf2f((unsigned short)(kn[h] >> 16));
            const float rqn = rsqrtf(wave_sum(q0 * q0 + q1 * q1) * (1.0f / 128.0f) + NORM_EPS), rqp = rsqrtf(wave_sum(qp * qp) * (1.0f / 64.0f) + NORM_EPS), rkn = rsqrtf(wave_sum(k0 * k0 + k1 * k1) * (1.0f / 128.0f) + NORM_EPS);
            float qpe = qp * rqp * gqp;
            { const float partner = __shfl_xor(qpe, 16); const float rot = (ln & 16) ? partner : -partner; qpe = qpe * cs + rot * sn; }
            *(unsigned*)(QF + (size_t)tau * NQ + h * 192 + 2 * ln) = cvt_pk_bf16(q0 * rqn * gqn0, q1 * rqn * gqn1);
            QF[(size_t)tau * NQ + h * 192 + 128 + ln] = (bf16_t)(cvt_pk_bf16(qpe, qpe) & 0xffffu);
            *(unsigned*)(KF + (size_t)tau * NQ + h * 192 + 2 * ln) = cvt_pk_bf16(k0 * rkn * gkn0, k1 * rkn * gkn1);
            KF[(size_t)tau * NQ + h * 192 + 128 + ln] = kpe; }
    }
}
__device__ __forceinline__ void rwkv_out_phase(const Frame& F, unsigned char* ws, int l, bool need_ctx) {
    const float* SS = (const float*)(ws + WS_SS); const float* SD = (const float*)(ws + WS_SD); const float* GB = (const float*)(ws + WS_G); const float* Y = (const float*)(ws + WS_Y);
    bf16_t* OB = (bf16_t*)(ws + WS_OBUF);
    const int gw = F.bid * 8 + F.wave, NGW = F.G * 8, ln = F.lane;
    for (int it = (need_ctx ? 0 : NCTX * 5) + gw; it < T * 5; it += NGW) { const int tau = it / 5, h0 = (it % 5) * 4;
        float y0[4], y1[4], v[4], sa[4], sb[4], g[4];
#pragma unroll
        for (int q = 0; q < 4; ++q) { const int h = h0 + q, col = h * 64 + ln; const size_t o = (size_t)tau * A_W + col;
            y0[q] = Y[o]; y1[q] = Y[(size_t)T * A_W + o]; v[q] = SS[(size_t)T * A_W + o];
            sa[q] = SD[(size_t)tau * NHA + h]; sb[q] = SD[((size_t)T + tau) * NHA + h]; g[q] = GB[o]; }
#pragma unroll
        for (int q = 0; q < 4; ++q) { const int col = (h0 + q) * 64 + ln;
            const float y = y0[q] + y1[q];
            const float mu = wave_sum(y) * (1.0f / 64.0f); const float dy = y - mu; const float var = wave_sum(dy * dy) * (1.0f / 64.0f);
            const float yn = dy * rsqrtf(var + GN_EPS) * IN_(25)[l * A_W + col] + IN_(26)[l * A_W + col];
            const float bonus = 0.5f * (sa[q] + sb[q]) * v[q];
            const float ov = (yn + bonus) * g[q];
            OB[(size_t)tau * DM + col] = (bf16_t)(cvt_pk_bf16(ov, ov) & 0xffffu); }
    }
}
__device__ __forceinline__ void hyena_prep_phase(const Frame& F, unsigned char* ws, int l) {
    const bf16_t* PX = (const bf16_t*)(ws + WS_PX); float* GT = (float*)(ws + WS_GT); float* X0T = (float*)(ws + WS_X0T);
    LAS float* LGt = (LAS float*)F.lds; LAS float* LX0 = LGt + 64 * 65;
    const float* cw = IN_(27) + (size_t)l * 3 * B_IN; const float* cb = IN_(28) + (size_t)l * B_IN;
    int it0, istep, iend;
    if (F.bid < 80) { it0 = F.bid * 5; istep = 1; iend = it0 + 5; } else { it0 = 400 + (F.bid - 80); istep = 176; iend = (T / 64) * 20; }
    for (int it = it0; it < iend; it += istep) { const int tt = it / 20, ct = it % 20;
        { const int t = F.tid >> 3, c0 = ct * 64 + (F.tid & 7) * 8, tau = tt * 64 + t;
          f32x4 u[3][2];
#pragma unroll
          for (int grp = 0; grp < 3; ++grp)
#pragma unroll
              for (int q = 0; q < 2; ++q) { const int c = grp * 1280 + c0 + 4 * q; const bf16_t* p = PX + (size_t)tau * PXW + PXB + c;
                  const bool hl = has_left(tau), hr = has_right(tau);
                  const f32x4 y = bf4f(*(const u32x2*)p) * *(const f32x4*)(cw + B_IN + c) + *(const f32x4*)(cb + c) + bf4f(*(const u32x2*)(p - (hl ? PXW : 0))) * (*(const f32x4*)(cw + c) * (hl ? 1.f : 0.f))
                                + bf4f(*(const u32x2*)(p + (hr ? PXW : 0))) * (*(const f32x4*)(cw + 2 * B_IN + c) * (hr ? 1.f : 0.f));
                  u[grp][q] = y; }
#pragma unroll
          for (int q = 0; q < 2; ++q)
#pragma unroll
              for (int e = 0; e < 4; ++e) { const int ch = (F.tid & 7) * 8 + 4 * q + e; LGt[ch * 65 + t] = u[1][q][e] * u[2][q][e]; LX0[ch * 65 + t] = u[0][q][e]; } }
        __syncthreads();
        { const int ch = F.tid >> 3, t0 = (F.tid & 7) * 8; const size_t o = (size_t)(ct * 64 + ch) * T + tt * 64 + t0;
          f32x4 a0, a1, b0, b1;
#pragma unroll
          for (int e = 0; e < 4; ++e) { a0[e] = LGt[ch * 65 + t0 + e]; a1[e] = LGt[ch * 65 + t0 + 4 + e]; b0[e] = LX0[ch * 65 + t0 + e]; b1[e] = LX0[ch * 65 + t0 + 4 + e]; }
          *(f32x4*)(GT + o) = a0; *(f32x4*)(GT + o + 4) = a1; *(f32x4*)(X0T + o) = b0; *(f32x4*)(X0T + o + 4) = b1; }
        __syncthreads(); }
}
__device__ __forceinline__ void hyena_out_phase(const Frame& F, unsigned char* ws, bool need_ctx) {
    const float* YT = (const float*)(ws + WS_GT); bf16_t* OB = (bf16_t*)(ws + WS_OBUF);
    LAS float* L = (LAS float*)F.lds;
    const int it0 = need_ctx ? 0 : (NCTX / 64) * 20;
    for (int it = it0 + F.bid; it < (T / 64) * 20; it += F.G) { const int tt = it / 20, ct = it % 20;
        { const int ch = F.tid >> 3, t0 = (F.tid & 7) * 8; const size_t o = (size_t)(ct * 64 + ch) * T + tt * 64 + t0;
          const f32x4 a0 = *(const f32x4*)(YT + o), a1 = *(const f32x4*)(YT + o + 4);
#pragma unroll
          for (int e = 0; e < 4; ++e) { L[ch * 65 + t0 + e] = a0[e]; L[ch * 65 + t0 + 4 + e] = a1[e]; } }
        __syncthreads();
        { const int t = F.tid >> 3, c0 = (F.tid & 7) * 8; float x[8];
#pragma unroll
          for (int e = 0; e < 8; ++e) x[e] = L[(c0 + e) * 65 + t];
          u32x4 w; w.x = cvt_pk_bf16(x[0], x[1]); w.y = cvt_pk_bf16(x[2], x[3]); w.z = cvt_pk_bf16(x[4], x[5]); w.w = cvt_pk_bf16(x[6], x[7]);
          *(u32x4*)(OB + (size_t)(tt * 64 + t) * DM + 1280 + ct * 64 + c0) = w; }
        __syncthreads(); }
}
namespace att {
constexpr int DK = 192, DV = 128, NW = 8, QBLK = 32, KVBLK = 64;
constexpr float SCALE = 0.07216878364870322f;
constexpr float THR = 8.f;
#ifndef ATT_SDEPTH
#define ATT_SDEPTH 2
#endif
constexpr int SDEPTH = ATT_SDEPTH;
constexpr int LDQ = 2304, LDK = 2304, LDV = 3072, LDO = 4096;
constexpr int SHM_V = KVBLK * DV * 2, SHM_K = KVBLK * DK * 2, SHM_ATTN = 2 * SHM_V + 2 * SHM_K + NW * 64 * 4 + NW * 4096;
using bf16x8 = __attribute__((ext_vector_type(8))) short;
using s16x4  = __attribute__((ext_vector_type(4))) short;
using f32x16 = __attribute__((ext_vector_type(16))) float;
using u32x4  = __attribute__((ext_vector_type(4))) unsigned;
#define KSWZ(row, colB) ((row) * 384 + ((colB) ^ (((row) & 7) << 4)))
#define SBAR() __builtin_amdgcn_sched_barrier(0)
__device__ __forceinline__ int crow(int r, int hi) { return (r & 3) + 8 * (r >> 2) + 4 * hi; }
__device__ __forceinline__ unsigned cvtpk(float lo, float hi) { unsigned r; asm volatile("v_cvt_pk_bf16_f32 %0, %1, %2" : "=v"(r) : "v"(lo), "v"(hi)); return r; }
__device__ __forceinline__ void partialSM(f32x16& p0, f32x16& p1, float& m_reg, float& mn, float& alpha) {
  constexpr float C = SCALE * 1.4426950408889634f;
  float pmax = p0[0]; for (int r = 1; r < 16; ++r) pmax = fmaxf(pmax, p0[r]); for (int r = 0; r < 16; ++r) pmax = fmaxf(pmax, p1[r]);
  { auto rr = __builtin_amdgcn_permlane32_swap(__float_as_uint(pmax), __float_as_uint(pmax), false, false);
    pmax = fmaxf(__uint_as_float(rr[0]), __uint_as_float(rr[1])); }
  if (__builtin_expect(__all(pmax - m_reg <= THR / SCALE), 1)) { mn = m_reg; alpha = 1.f; }
  else { mn = fmaxf(m_reg, pmax); alpha = __builtin_amdgcn_exp2f((m_reg - mn) * C); m_reg = mn; }
  float mnC = -mn * C;
  for (int r = 0; r < 16; ++r) p0[r] = fmaf(p0[r], C, mnC); for (int r = 0; r < 16; ++r) p1[r] = fmaf(p1[r], C, mnC);
  for (int r = 0; r < 16; ++r) p0[r] = __builtin_amdgcn_exp2f(p0[r]);
}
__device__ __forceinline__ void finishSM(f32x16& p0, f32x16& p1, float alpha, float& l_reg, bf16x8& pa0, bf16x8& pa1, bf16x8& pa2, bf16x8& pa3) {
  for (int r = 0; r < 16; ++r) p1[r] = __builtin_amdgcn_exp2f(p1[r]);
  float ps = 0; for (int r = 0; r < 16; ++r) ps += p0[r]; for (int r = 0; r < 16; ++r) ps += p1[r];
  { auto rr = __builtin_amdgcn_permlane32_swap(__float_as_uint(ps), __float_as_uint(ps), false, false);
    ps = __uint_as_float(rr[0]) + __uint_as_float(rr[1]); }
  l_reg = l_reg * alpha + ps;
#define PK4(P, BASE, OUT) do { unsigned a0 = cvtpk(P[BASE + 0], P[BASE + 1]), a1 = cvtpk(P[BASE + 2], P[BASE + 3]);   \
    unsigned b0 = cvtpk(P[BASE + 4], P[BASE + 5]), b1 = cvtpk(P[BASE + 6], P[BASE + 7]);                              \
    auto r0 = __builtin_amdgcn_permlane32_swap(a0, b0, false, false); auto r1 = __builtin_amdgcn_permlane32_swap(a1, b1, false, false); \
    u32x4 w = {r0[0], r1[0], r0[1], r1[1]}; OUT = *reinterpret_cast<bf16x8*>(&w); } while (0)
  PK4(p0, 0, pa0); PK4(p0, 8, pa1); PK4(p1, 0, pa2); PK4(p1, 8, pa3);
#undef PK4
}
__device__ __forceinline__ void qkt(f32x16& p0, f32x16& p1, const char* Ks, const bf16x8* qr, const char* qrl, int r32, int hi) {
  p0 = f32x16{}; p1 = f32x16{};
#pragma unroll
  for (int d0 = 0; d0 < 8; ++d0) { int cb = (d0 * 16 + hi * 8) * 2;
    bf16x8 b0 = *reinterpret_cast<const bf16x8*>(Ks + KSWZ(r32, cb));
    bf16x8 b1 = *reinterpret_cast<const bf16x8*>(Ks + KSWZ(32 + r32, cb));
    p0 = __builtin_amdgcn_mfma_f32_32x32x16_bf16(b0, qr[d0], p0, 0, 0, 0);
    p1 = __builtin_amdgcn_mfma_f32_32x32x16_bf16(b1, qr[d0], p1, 0, 0, 0); }
#pragma unroll
  for (int d0 = 8; d0 < 12; ++d0) { int cb = (d0 * 16 + hi * 8) * 2;
    bf16x8 b0 = *reinterpret_cast<const bf16x8*>(Ks + KSWZ(r32, cb));
    bf16x8 b1 = *reinterpret_cast<const bf16x8*>(Ks + KSWZ(32 + r32, cb));
    const bf16x8 q = *reinterpret_cast<const bf16x8*>(qrl + ((((d0 - 8) * 2 + hi) ^ (r32 & 7)) << 4));
    p0 = __builtin_amdgcn_mfma_f32_32x32x16_bf16(b0, q, p0, 0, 0, 0);
    p1 = __builtin_amdgcn_mfma_f32_32x32x16_bf16(b1, q, p1, 0, 0, 0); }
}
__device__ __forceinline__ int v_st(int k, int c) { const int kk = (k & ~0xC) | ((k & 4) << 1) | ((k & 8) >> 1); return ((kk >> 3) * 4 + (c >> 5)) * 512 + ((kk & 7) * 32 + (c & 31)) * 2; }
__device__ __forceinline__ int v_rd_base(int lane) { return ((lane & 3) << 3) | (((lane >> 2) & 3) << 6) | (((lane >> 4) & 1) << 5) | (((lane >> 5) & 1) << 8); }
constexpr int v_rd_off(int d0, int ks, int half) { return d0 * 512 + ks * 4096 + half * 2048; }
template <int OFF> __device__ __forceinline__ s16x4 tr_read(int vb) {
  s16x4 r; asm volatile("ds_read_b64_tr_b16 %0, %1 offset:%2" : "=&v"(r) : "v"(vb), "i"(OFF) : "memory"); return r;
}
template <int D0> __device__ __forceinline__ void pv_one(f32x16& od, int vb, bf16x8 pa0, bf16x8 pa1, bf16x8 pa2, bf16x8 pa3) {
  const s16x4 l0 = tr_read<v_rd_off(D0, 0, 0)>(vb), h0 = tr_read<v_rd_off(D0, 0, 1)>(vb), l1 = tr_read<v_rd_off(D0, 1, 0)>(vb), h1 = tr_read<v_rd_off(D0, 1, 1)>(vb);
  const s16x4 l2 = tr_read<v_rd_off(D0, 2, 0)>(vb), h2 = tr_read<v_rd_off(D0, 2, 1)>(vb), l3 = tr_read<v_rd_off(D0, 3, 0)>(vb), h3 = tr_read<v_rd_off(D0, 3, 1)>(vb);
  asm volatile("s_waitcnt lgkmcnt(0)" ::: "memory"); SBAR();
#define PK(L, H) (bf16x8){L[0], L[1], L[2], L[3], H[0], H[1], H[2], H[3]}
  od = __builtin_amdgcn_mfma_f32_32x32x16_bf16(pa0, PK(l0, h0), od, 0, 0, 0);
  od = __builtin_amdgcn_mfma_f32_32x32x16_bf16(pa1, PK(l1, h1), od, 0, 0, 0);
  od = __builtin_amdgcn_mfma_f32_32x32x16_bf16(pa2, PK(l2, h2), od, 0, 0, 0);
  od = __builtin_amdgcn_mfma_f32_32x32x16_bf16(pa3, PK(l3, h3), od, 0, 0, 0);
#undef PK
}
__device__ __forceinline__ void pv_d0(f32x16* o, int vb, bf16x8 pa0, bf16x8 pa1, bf16x8 pa2, bf16x8 pa3) {
  pv_one<0>(o[0], vb, pa0, pa1, pa2, pa3); pv_one<1>(o[1], vb, pa0, pa1, pa2, pa3); pv_one<2>(o[2], vb, pa0, pa1, pa2, pa3); pv_one<3>(o[3], vb, pa0, pa1, pa2, pa3);
}
__device__ __forceinline__ void attn_body(const bf16_t* __restrict__ Qb, const bf16_t* __restrict__ Kh, const bf16_t* __restrict__ Vh, bf16_t* __restrict__ Ob, int seq, char* lds) {
  int tid_ = threadIdx.x; asm volatile("" : "+v"(tid_));
  const int tid = tid_, wid = tid >> 6, lane = tid & 63, r32 = lane & 31, hi = lane >> 5;
  char* V_lds = lds; char* K_lds = lds + 2 * SHM_V;
  float* ws = (float*)(lds + 2 * SHM_V + 2 * SHM_K) + wid * 64; float* li_l = ws; float* al_l = ws + 32;
  float m_reg = -1e30f, l_reg = 0; f32x16 o[4] = {}; bf16x8 qr[8];
  const bf16_t* Qw = Qb + (long)(wid * QBLK + r32) * LDQ + hi * 8;
  char* qrl = lds + 2 * SHM_V + 2 * SHM_K + NW * 64 * 4 + wid * 4096 + r32 * 128;
#pragma unroll
  for (int d0 = 0; d0 < 8; ++d0) qr[d0] = *reinterpret_cast<const bf16x8*>(Qw + d0 * 16);
#pragma unroll
  for (int d0 = 8; d0 < 12; ++d0) *reinterpret_cast<bf16x8*>(qrl + ((((d0 - 8) * 2 + hi) ^ (r32 & 7)) << 4)) = *reinterpret_cast<const bf16x8*>(Qw + d0 * 16);
  asm volatile("s_waitcnt lgkmcnt(0)" ::: "memory");
  unsigned kgo[3], vgo[2];
#pragma unroll
  for (int i = 0; i < 3; ++i) { const int p = (i * 8 + wid) * 64 + lane, row = p / 24, slot = p % 24, ch = slot ^ (row & 7); kgo[i] = (unsigned)(row * LDK + ch * 8) * 2u; }
#pragma unroll
  for (int i = 0; i < 2; ++i) { const int p = (i * 8 + wid) * 64 + lane, sub = p >> 5, within = p & 31, kk = (sub >> 2) * 8 + (within >> 2), c = (sub & 3) * 32 + (within & 3) * 8;
    const int k = (kk & ~0xC) | ((kk & 4) << 1) | ((kk & 8) >> 1); vgo[i] = (unsigned)(k * LDV + c) * 2u; }
  const int vb0 = (int)(uintptr_t)V_lds + v_rd_base(lane);
  typedef __attribute__((address_space(3))) unsigned lds_u32;
#define DMA_K(b, k0) do { const char* kg = (const char*)Kh + (size_t)(k0) * (LDK * 2); \
    _Pragma("unroll") for (int _i = 0; _i < 3; ++_i) __builtin_amdgcn_global_load_lds((const unsigned*)(kg + kgo[_i]), (lds_u32*)(K_lds + (b) * SHM_K + (_i * 8 + wid) * 1024), 16, 0, 0); } while (0)
#define DMA_V(b, k0) do { const char* vg = (const char*)Vh + (size_t)(k0) * (LDV * 2); \
    _Pragma("unroll") for (int _i = 0; _i < 2; ++_i) __builtin_amdgcn_global_load_lds((const unsigned*)(vg + vgo[_i]), (lds_u32*)(V_lds + (b) * SHM_V + (_i * 8 + wid) * 1024), 16, 0, 0); } while (0)
#define RESC(a) do { if (__any((a) < 1.f)) { if (hi == 0) al_l[r32] = (a); asm volatile("s_waitcnt lgkmcnt(0)" ::: "memory"); \
    for (int d = 0; d < 4; ++d) for (int r = 0; r < 16; ++r) o[d][r] *= al_l[crow(r, hi)]; } } while (0)
#define ENDSTEP() do { asm volatile("s_waitcnt vmcnt(0)" ::: "memory"); __syncthreads(); } while (0)
  f32x16 pA0, pA1, pB0, pB1; float mnA, mnB, alA, alB; bf16x8 pa0, pa1, pa2, pa3; const int NT = seq / KVBLK;
  DMA_K(0, 0); ENDSTEP();
  DMA_K(1, KVBLK); DMA_V(0, 0);
  qkt(pA0, pA1, K_lds, qr, qrl, r32, hi); partialSM(pA0, pA1, m_reg, mnA, alA);
  ENDSTEP();
  for (int j = 1; j + 1 < NT; j += 2) {
    DMA_K(0, (j + 1) * KVBLK); DMA_V(1, j * KVBLK);
    SBAR(); qkt(pB0, pB1, K_lds + SHM_K, qr, qrl, r32, hi);
    finishSM(pA0, pA1, alA, l_reg, pa0, pa1, pa2, pa3); SBAR();
    pv_d0(o, vb0, pa0, pa1, pa2, pa3); partialSM(pB0, pB1, m_reg, mnB, alB);
    RESC(alB); ENDSTEP();
    if (j + 2 < NT) DMA_K(1, (j + 2) * KVBLK);
    DMA_V(0, (j + 1) * KVBLK);
    SBAR(); qkt(pA0, pA1, K_lds, qr, qrl, r32, hi);
    finishSM(pB0, pB1, alB, l_reg, pa0, pa1, pa2, pa3); SBAR();
    pv_d0(o, vb0 + (int)SHM_V, pa0, pa1, pa2, pa3); partialSM(pA0, pA1, m_reg, mnA, alA);
    RESC(alA); ENDSTEP();
  }
  DMA_V(1, (NT - 1) * KVBLK);
  SBAR(); qkt(pB0, pB1, K_lds + SHM_K, qr, qrl, r32, hi);
  finishSM(pA0, pA1, alA, l_reg, pa0, pa1, pa2, pa3); SBAR();
  pv_d0(o, vb0, pa0, pa1, pa2, pa3); partialSM(pB0, pB1, m_reg, mnB, alB);
  RESC(alB); ENDSTEP();
  finishSM(pB0, pB1, alB, l_reg, pa0, pa1, pa2, pa3); SBAR();
  pv_d0(o, vb0 + (int)SHM_V, pa0, pa1, pa2, pa3);
#undef DMA_K
#undef DMA_V
#undef ENDSTEP
  if (hi == 0) li_l[r32] = l_reg; asm volatile("s_waitcnt lgkmcnt(0)" ::: "memory");
  float rli[16];
#pragma unroll
  for (int r = 0; r < 16; ++r) rli[r] = __builtin_amdgcn_rcpf(li_l[crow(r, hi)]);
  bf16_t* Ow = Ob + (long)(wid * QBLK) * LDO;
#pragma unroll
  for (int r = 0; r < 16; ++r) { int orow = crow(r, hi);
#pragma unroll
    for (int d0 = 0; d0 < 4; ++d0) { const float val = o[d0][r] * rli[r]; Ow[(long)orow * LDO + d0 * 32 + r32] = (bf16_t)(cvtpk(val, val) & 0xffff); } }
  __syncthreads();
#undef RESC
}
}
__device__ __forceinline__ f32x2 cmul(f32x2 a, f32x2 b) { return (f32x2){a.x * b.x - a.y * b.y, a.x * b.y + a.y * b.x}; }
__device__ __forceinline__ int rev4_14(int k) { const unsigned r = __brev((unsigned)k) >> 18; return (int)(((r & 0x1555u) << 1) | ((r >> 1) & 0x1555u)); }
#define ZI(i) ((i) + ((i) >> 5))
__device__ __forceinline__ void fft_tw(int j, int q, float sign, f32x2& w1, f32x2& w2, f32x2& w3) {
    const float rev = (float)j / (float)(4 * q); const float sn = __builtin_amdgcn_sinf(rev), cs = __builtin_amdgcn_cosf(rev);
    w1 = (f32x2){cs, sign * sn}; w2 = cmul(w1, w1); w3 = cmul(w2, w1);
}
__device__ __forceinline__ void fft16k_dif(LAS f32x2* Z, int tid) {
#pragma unroll 1
    for (int s = 0; s < 7; ++s) { int lq = 12 - 2 * s; asm volatile("" : "+s"(lq)); const int q = 1 << lq;
        const bool shared = q <= 512; f32x2 w1, w2, w3; fft_tw(tid & (q - 1), q, -1.f, w1, w2, w3);
#pragma unroll 2
        for (int i = 0; i < 8; ++i) { const int b = tid + 512 * i, j = b & (q - 1), base = ((b >> lq) << (lq + 2)) + j;
            const int i0 = ZI(base), i1 = ZI(base + q), i2 = ZI(base + 2 * q), i3 = ZI(base + 3 * q);
            const f32x2 a0 = Z[i0], a1 = Z[i1], a2 = Z[i2], a3 = Z[i3];
            const f32x2 t0 = a0 + a2, t1 = a0 - a2, t2 = a1 + a3, t3 = a1 - a3;
            if (!shared) fft_tw(j, q, -1.f, w1, w2, w3);
            Z[i0] = t0 + t2; Z[i1] = cmul((f32x2){t1.x + t3.y, t1.y - t3.x}, w1); Z[i2] = cmul(t0 - t2, w2); Z[i3] = cmul((f32x2){t1.x - t3.y, t1.y + t3.x}, w3); }
        __syncthreads(); }
}
__device__ __forceinline__ void fft16k_dit_inv(LAS f32x2* Z, int tid) {
#pragma unroll 1
    for (int s = 0; s < 7; ++s) { int lq = 2 * s; asm volatile("" : "+s"(lq)); const int q = 1 << lq;
        const bool shared = q <= 512; f32x2 w1, w2, w3; fft_tw(tid & (q - 1), q, 1.f, w1, w2, w3);
#pragma unroll 2
        for (int i = 0; i < 8; ++i) { const int b = tid + 512 * i, j = b & (q - 1), base = ((b >> lq) << (lq + 2)) + j;
            if (!shared) fft_tw(j, q, 1.f, w1, w2, w3);
            const int i0 = ZI(base), i1 = ZI(base + q), i2 = ZI(base + 2 * q), i3 = ZI(base + 3 * q);
            const f32x2 b0 = Z[i0], b1 = cmul(Z[i1], w1), b2 = cmul(Z[i2], w2), b3 = cmul(Z[i3], w3);
            const f32x2 t0 = b0 + b2, t1 = b0 - b2, t2 = b1 + b3, t3 = b1 - b3;
            Z[i0] = t0 + t2; Z[i1] = (f32x2){t1.x - t3.y, t1.y + t3.x}; Z[i2] = t0 - t2; Z[i3] = (f32x2){t1.x + t3.y, t1.y - t3.x}; }
        __syncthreads(); }
}
constexpr float HY_MIN_DECAY = -3.0701134573253945f, HY_MAX_DECAY = -15.350567286626973f;
__device__ __forceinline__ float hy_delta(int c) { return fabsf(HY_MIN_DECAY + (HY_MAX_DECAY - HY_MIN_DECAY) * ((float)c / 1279.0f)); }
__device__ __forceinline__ float conv3b_at(const bf16_t* PX, int tau, int col, const float* cw, int l, int c) {
    const float* w = cw + (size_t)l * 3 * B_IN;
    return conv3_at(PX, tau, col, w[c], w[B_IN + c], w[2 * B_IN + c]);
}
__device__ __forceinline__ void hyena_taps_unit(const Frame& F, unsigned char* ws, int l, int pair) {
    LAS f32x2* Z = (LAS f32x2*)F.lds; LAS float* red = (LAS float*)(F.lds + LDS_MISC + 128);
    const int tid = F.tid, c0 = 2 * pair;
    const bf16_t* H3x = (const bf16_t*)(ws + WS_H3) + (size_t)l * 64 * T + NCTX;
    f32x4* scr4 = (f32x4*)(ws + WS_HSCR) + (size_t)pair * HT_STRIDE; float* htn = (float*)(ws + WS_HTN) + 2 * pair;
    LAS f32x4* FW = (LAS f32x4*)(F.lds + LDS_MISC + 256);
    if (tid < 256) { const int j = tid >> 2, q = tid & 3; ((LAS float*)FW)[tid] = IN_(35)[(size_t)l * 64 * 2560 + (size_t)j * 2560 + (q >> 1) * 1280 + c0 + (q & 1)]; }
    __syncthreads();
    const float d0 = hy_delta(c0), d1 = hy_delta(c0 + 1);
#ifndef HYS
#define HYS 31
#endif
    float s0, s1, sc0 = 0.f, sc1 = 0.f;
    {
    s0 = 0.f; s1 = 0.f;
    if (HYS & 1)
#pragma unroll 1
    for (int i = 0; i < 2; ++i) { const int tb = 4096 * i + 8 * tid; const bf16_t* hc = H3x + tb;
        asm volatile("" ::: "memory");
        f32x4 acc[8];
#pragma unroll
        for (int p = 0; p < 8; ++p) acc[p] = (f32x4){0.f, 0.f, 0.f, 0.f};
#pragma unroll 8
        for (int j = 0; j < 64; ++j) { const f32x4 w = FW[j]; const u32x4 hv = *(const u32x4*)(hc + (size_t)j * T);
#pragma unroll
            for (int p = 0; p < 4; ++p) { acc[2 * p] += w * __uint_as_float(hv[p] << 16); acc[2 * p + 1] += w * __uint_as_float(hv[p] & 0xffff0000u); } }
#pragma unroll
        for (int p = 0; p < 8; ++p) { const int t = tb + p;
            const float tl = (float)t * (1.0f / 8191.0f), e0 = __expf(-tl * d0), e1 = __expf(-tl * d1);
            const float f0 = acc[p].x * e0, f1 = acc[p].y * e1, b0 = acc[p].z * e0, b1 = acc[p].w * e1;
            Z[ZI(t)] = (f32x2){f0, f1}; s0 += fabsf(f0); s1 += fabsf(f1);
            if (t < 8191) { Z[ZI(16383 - t)] = (f32x2){b0, b1}; s0 += fabsf(b0); s1 += fabsf(b1); } } }
    if (tid == 0) { float zz = 0.f; asm volatile("" : "+v"(zz)); Z[ZI(8192)] = (f32x2){zz, zz}; }
    s0 = wave_sum(s0); s1 = wave_sum(s1);
    if (F.lane == 0) { red[F.wave * 2] = s0; red[F.wave * 2 + 1] = s1; }
    __syncthreads();
    float n0 = 0.f, n1 = 0.f;
#pragma unroll
    for (int w = 0; w < 8; ++w) { n0 += red[2 * w]; n1 += red[2 * w + 1]; }
    sc0 = 1.0f / (16384.0f * n0); sc1 = 1.0f / (16384.0f * n1);
    if (HYS & 2) fft16k_dif(Z, tid);
#pragma unroll 2
    for (int i = 0; i < 17; ++i) { const int k = tid + 512 * i; if (i == 16 && tid != 0) break;
        const int pk = rev4_14(k & 16383), pn = rev4_14((16384 - k) & 16383);
        const f32x2 At = Z[ZI(pk)], Bt = Z[ZI(pn)];
        scr4[k] = (f32x4){0.5f * (At.x + Bt.x), 0.5f * (At.y - Bt.y), 0.5f * (At.y + Bt.y), -0.5f * (At.x - Bt.x)}; }
    __syncthreads();
    }
    if (tid == 0) { htn[0] = sc0; htn[1] = sc1; }
    __syncthreads();
}
__device__ __forceinline__ void hyena_unit(const Frame& F, unsigned char* ws, int l, int pair) {
    LAS f32x2* Z = (LAS f32x2*)F.lds;
    const int tid = F.tid, c0 = 2 * pair;
    float* GT = (float*)(ws + WS_GT); const float* X0T = (const float*)(ws + WS_X0T);
    const f32x4* scr4 = (const f32x4*)(ws + WS_HSCR) + (size_t)pair * HT_STRIDE; const float* htn = (const float*)(ws + WS_HTN) + 2 * pair;
    const float sc0 = htn[0], sc1 = htn[1];
#ifndef HYS
#define HYS 31
#endif
    for (int rp15 = 0; rp15 < REP(15); ++rp15) {
    const float* g0p = GT + (size_t)c0 * T + NCTX; const float* g1p = g0p + T;
    f32x4 Hr[17];
    { float zz = 0.f; asm volatile("" : "+v"(zz));
      f32x2 ga[8], gb[8];
#pragma unroll
      for (int i = 0; i < 8; ++i) { const int t = 2 * tid + 1024 * i; ga[i] = *(const f32x2*)(g0p + t); gb[i] = *(const f32x2*)(g1p + t); }
#pragma unroll
      for (int i = 0; i < 17; ++i) Hr[i] = scr4[i < 16 ? tid + 512 * i : 8192];
#pragma unroll
      for (int i = 0; i < 8; ++i) { const int t = 2 * tid + 1024 * i; Z[ZI(t)] = (f32x2){ga[i].x, gb[i].x}; Z[ZI(t + 1)] = (f32x2){ga[i].y, gb[i].y}; Z[ZI(8192 + t)] = (f32x2){zz, zz}; Z[ZI(8193 + t)] = (f32x2){zz, zz}; } }
    __syncthreads();
    if (HYS & 2) fft16k_dif(Z, tid);
    if (HYS & 8)
#pragma unroll
    for (int i = 0; i < 17; ++i) { const int k = tid + 512 * i; if (i == 16 && tid != 0) break;
        const int pk = rev4_14(k & 16383), pn = rev4_14((16384 - k) & 16383);
        const f32x2 A = Z[ZI(pk)], B = Z[ZI(pn)];
        const f32x2 G0 = (f32x2){0.5f * (A.x + B.x), 0.5f * (A.y - B.y)}, G1 = (f32x2){0.5f * (A.y + B.y), -0.5f * (A.x - B.x)};
        const f32x2 H0 = (f32x2){Hr[i].x, Hr[i].y}, H1 = (f32x2){Hr[i].z, Hr[i].w};
        const f32x2 P0 = cmul(G0, H0), P1 = cmul(G1, H1);
        Z[ZI(pk)] = (f32x2){P0.x - P1.y, P0.y + P1.x};
        if (pn != pk) Z[ZI(pn)] = (f32x2){P0.x + P1.y, P1.x - P0.y}; }
    __syncthreads();
    if (HYS & 2) fft16k_dit_inv(Z, tid);
    }
    const float bb0 = IN_(37)[l * 1280 + c0], bb1 = IN_(37)[l * 1280 + c0 + 1];
    { float* y0p = GT + (size_t)c0 * T + NCTX; float* y1p = y0p + T; const float* x0p = X0T + (size_t)c0 * T + NCTX; const float* x1p = x0p + T;
      f32x2 ga[8], gb[8], xa[8], xb[8];
#pragma unroll
      for (int i = 0; i < 8; ++i) { const int t = 2 * tid + 1024 * i; ga[i] = *(const f32x2*)(y0p + t); gb[i] = *(const f32x2*)(y1p + t); xa[i] = *(const f32x2*)(x0p + t); xb[i] = *(const f32x2*)(x1p + t); }
#pragma unroll
      for (int i = 0; i < 8; ++i) { const int t = 2 * tid + 1024 * i; const f32x2 z0 = Z[ZI(t)], z1 = Z[ZI(t + 1)];
          *(f32x2*)(y0p + t) = (f32x2){xa[i].x * (z0.x * sc0 + ga[i].x * bb0), xa[i].y * (z1.x * sc0 + ga[i].y * bb0)};
          *(f32x2*)(y1p + t) = (f32x2){xb[i].x * (z0.y * sc1 + gb[i].x * bb1), xb[i].y * (z1.y * sc1 + gb[i].y * bb1)}; } }
    __syncthreads();
}
__device__ __forceinline__ void hyena_ctx_unit(const Frame& F, unsigned char* ws, int l, int unit) {
    LAS float* TF = (LAS float*)F.lds; LAS float* TB = TF + 2048; LAS float* GG = TB + 2048;
    const int tid = F.tid, t = tid >> 1, cc = (tid & 1) * 4, cbase = unit * 8 + cc;
    const bf16_t* H3c = (const bf16_t*)(ws + WS_H3) + (size_t)l * 64 * T; float* GT = (float*)(ws + WS_GT); const float* X0T = (const float*)(ws + WS_X0T);
    { float f[4] = {0.f, 0.f, 0.f, 0.f}, b[4] = {0.f, 0.f, 0.f, 0.f};
      const float* wbase = IN_(35) + (size_t)l * 64 * 2560 + cbase;
      for (int j = 0; j < 64; ++j) { const float hv = bf2f(H3c[(size_t)j * T + t]); const float* wrow = wbase + (size_t)j * 2560;
#pragma unroll
          for (int q = 0; q < 4; ++q) { f[q] += hv * wrow[q]; b[q] += hv * wrow[1280 + q]; } }
      const float tl = (float)t * (1.0f / 255.0f);
#pragma unroll
      for (int q = 0; q < 4; ++q) { const float e = __expf(-tl * hy_delta(cbase + q)); TF[t * 8 + cc + q] = f[q] * e; TB[t * 8 + cc + q] = b[q] * e; GG[t * 8 + cc + q] = GT[(size_t)(cbase + q) * T + t]; } }
    __syncthreads();
    float nrm[4] = {0.f, 0.f, 0.f, 0.f}, y[4] = {0.f, 0.f, 0.f, 0.f};
    for (int s = 0; s < 256; ++s) {
#pragma unroll
        for (int q = 0; q < 4; ++q) { nrm[q] += fabsf(TF[s * 8 + cc + q]) + (s < 255 ? fabsf(TB[s * 8 + cc + q]) : 0.f);
            const int o = t - s; const float tap = o >= 0 ? TF[o * 8 + cc + q] : TB[(-o - 1) * 8 + cc + q];
            y[q] += tap * GG[s * 8 + cc + q]; } }
    __syncthreads();
#pragma unroll
    for (int q = 0; q < 4; ++q) GT[(size_t)(cbase + q) * T + t] = X0T[(size_t)(cbase + q) * T + t] * (y[q] / nrm[q] + GG[t * 8 + cc + q] * IN_(37)[l * 1280 + cbase + q]);
    __syncthreads();
}
constexpr int SC_C = 16, SC_NCHUNK = T / SC_C, SC_CHUNK_BYTES = 14 * 1024;
__device__ __forceinline__ int sc_tau(int d, int c, int t) { return d == 0 ? SC_C * c + t : (c < NCTX / SC_C ? NCTX - 1 - SC_C * c - t : T - 1 - SC_C * (c - NCTX / SC_C) - t); }
__device__ __forceinline__ int sc_perm(int e, int hi) { return (e & 3) + 8 * (e >> 2) + 4 * hi; }
constexpr size_t WS_FR_BYTES = (size_t)2 * NHA * SC_NCHUNK * SC_CHUNK_BYTES;

typedef short sc_bf16x8 __attribute__((ext_vector_type(8)));
typedef float sc_f32x16 __attribute__((ext_vector_type(16)));
__device__ __forceinline__ sc_bf16x8 sc_pack8(const sc_f32x16& a, int base) {
    u32x4 w; w.x = cvt_pk_bf16(a[base + 0], a[base + 1]); w.y = cvt_pk_bf16(a[base + 2], a[base + 3]); w.z = cvt_pk_bf16(a[base + 4], a[base + 5]); w.w = cvt_pk_bf16(a[base + 6], a[base + 7]);
    return *reinterpret_cast<sc_bf16x8*>(&w);
}
constexpr int SC_NSLOT = 9, SC_AHEAD = 7;
__device__ __forceinline__ void scan_chain_mfma(const Frame& F, unsigned char* ws, int chain) {
    const int h = chain >> 1, d = chain & 1, lane = F.lane, n = lane & 31, hi = lane >> 5, ib = F.wave;
    const unsigned char* FRc = ws + WS_FR + (size_t)chain * SC_NCHUNK * SC_CHUNK_BYTES;
    float* Yd = (float*)(ws + WS_Y) + (size_t)d * T * A_W + h * 64;
    LAS unsigned char* buf = F.lds;
    typedef __attribute__((address_space(3))) unsigned sc_lds_u32;
#define SCM_DMA(c_) do { if (ib < 7) { const unsigned char* src_ = FRc + (size_t)(c_) * SC_CHUNK_BYTES; LAS unsigned char* dst_ = buf + ((c_) % SC_NSLOT) * SC_CHUNK_BYTES; \
        _Pragma("unroll") for (int i_ = 0; i_ < 2; ++i_) __builtin_amdgcn_global_load_lds((const unsigned*)(src_ + (i_ * 7 + ib) * 1024 + lane * 16), (sc_lds_u32*)(dst_ + (i_ * 7 + ib) * 1024), 16, 0, 0); } } while (0)
    sc_f32x16 S0 = {}, S1 = {};
    int yoff[8];
#pragma unroll
    for (int r = 0; r < 8; ++r) { const int t = (r & 3) + 8 * (r >> 2) + 4 * hi; yoff[r] = (d ? -t : t) * A_W + 32 * ib + n; }
    __syncthreads();
#pragma unroll
    for (int c = 0; c < SC_AHEAD; ++c) SCM_DMA(c);
    asm volatile("s_waitcnt vmcnt(12)" ::: "memory"); __builtin_amdgcn_s_barrier(); asm volatile("" ::: "memory");
#pragma unroll 1
    for (int c = 0; c < SC_NCHUNK; ++c) {
        const bool steady = c + SC_AHEAD < SC_NCHUNK;
        if (steady) SCM_DMA(c + SC_AHEAD);
        if (ib < 2) {
                const LAS unsigned char* fb = buf + (c % SC_NSLOT) * SC_CHUNK_BYTES;
                sc_bf16x8 fr[11]; sc_bf16x8 vf; f32x4 gt[8];
                { const unsigned fa = (unsigned)(uintptr_t)fb + lane * 16, va = fa + (11 + ib) * 1024, ga = (unsigned)(uintptr_t)fb + 13 * 1024 + hi * 128;
#define SC_DSRD(dst, addr, off) asm volatile("ds_read_b128 %0, %1 offset:%2" : "=v"(dst) : "v"(addr), "i"(off))
                  SC_DSRD(fr[0], fa, 0); SC_DSRD(fr[1], fa, 1024); SC_DSRD(fr[2], fa, 2048); SC_DSRD(fr[3], fa, 3072); SC_DSRD(fr[4], fa, 4096); SC_DSRD(fr[5], fa, 5120);
                  SC_DSRD(fr[6], fa, 6144); SC_DSRD(fr[7], fa, 7168); SC_DSRD(fr[8], fa, 8192); SC_DSRD(fr[9], fa, 9216); SC_DSRD(fr[10], fa, 10240); SC_DSRD(vf, va, 0);
                  SC_DSRD(gt[0], ga, 0); SC_DSRD(gt[1], ga, 16); SC_DSRD(gt[2], ga, 32); SC_DSRD(gt[3], ga, 48); SC_DSRD(gt[4], ga, 64); SC_DSRD(gt[5], ga, 80); SC_DSRD(gt[6], ga, 96); SC_DSRD(gt[7], ga, 112);
#undef SC_DSRD
                  asm volatile("s_waitcnt lgkmcnt(0)" : "+v"(fr[0]), "+v"(fr[1]), "+v"(fr[2]), "+v"(fr[3]), "+v"(fr[4]), "+v"(fr[5]), "+v"(fr[6]), "+v"(fr[7]), "+v"(fr[8]), "+v"(fr[9]), "+v"(fr[10]), "+v"(vf) :: "memory");
                  asm volatile("" : "+v"(gt[0]), "+v"(gt[1]), "+v"(gt[2]), "+v"(gt[3]), "+v"(gt[4]), "+v"(gt[5]), "+v"(gt[6]), "+v"(gt[7])); }
                const sc_bf16x8 sb00 = sc_pack8(S0, 0), sb01 = sc_pack8(S0, 8), sb10 = sc_pack8(S1, 0), sb11 = sc_pack8(S1, 8);
                sc_f32x16 P = {}, P2 = {};
                P = __builtin_amdgcn_mfma_f32_32x32x16_bf16(fr[0], sb00, P, 0, 0, 0);
                P2 = __builtin_amdgcn_mfma_f32_32x32x16_bf16(fr[2], sb10, P2, 0, 0, 0);
                P = __builtin_amdgcn_mfma_f32_32x32x16_bf16(fr[1], sb01, P, 0, 0, 0);
                P2 = __builtin_amdgcn_mfma_f32_32x32x16_bf16(fr[3], sb11, P2, 0, 0, 0);
                P = __builtin_amdgcn_mfma_f32_32x32x16_bf16(fr[4], vf, P, 0, 0, 0);
#pragma unroll
                for (int q = 0; q < 4; ++q)
#pragma unroll
                    for (int e = 0; e < 4; ++e) { S0[4 * q + e] *= gt[q][e]; S1[4 * q + e] *= gt[4 + q][e]; }
                S0 = __builtin_amdgcn_mfma_f32_32x32x16_bf16(fr[8], vf, S0, 0, 0, 0);
                S1 = __builtin_amdgcn_mfma_f32_32x32x16_bf16(fr[10], vf, S1, 0, 0, 0);
#pragma unroll
                for (int r = 0; r < 16; ++r) P[r] += P2[r];
                const sc_bf16x8 xb = sc_pack8(P, 0);
                sc_f32x16 U = {};
                U = __builtin_amdgcn_mfma_f32_32x32x16_bf16(fr[5], xb, U, 0, 0, 0);
                const sc_bf16x8 ub = sc_pack8(U, 0);
                S0 = __builtin_amdgcn_mfma_f32_32x32x16_bf16(fr[7], ub, S0, 0, 0, 0);
                S1 = __builtin_amdgcn_mfma_f32_32x32x16_bf16(fr[9], ub, S1, 0, 0, 0);
                P = __builtin_amdgcn_mfma_f32_32x32x16_bf16(fr[6], ub, P, 0, 0, 0);
                float* yb = Yd + (size_t)sc_tau(d, c, 0) * A_W;
#pragma unroll
                for (int r = 0; r < 8; ++r) yb[yoff[r]] = P[8 + r];
        }
        if (steady) asm volatile("s_waitcnt vmcnt(12)" ::: "memory"); else asm volatile("s_waitcnt vmcnt(0)" ::: "memory");
        asm volatile("s_waitcnt lgkmcnt(0)" ::: "memory"); __builtin_amdgcn_s_barrier(); asm volatile("" ::: "memory");
    }
    asm volatile("s_waitcnt vmcnt(0)" ::: "memory"); __syncthreads();
#undef SCM_DMA
}
__device__ __forceinline__ float conv3_u(const float* PX, int tau, unsigned ucol, float w0, float w1, float w2) {
    const float* p = PX + (size_t)tau * PXW;
    float y = p[ucol] * w1;
    if (has_left(tau)) y += (p - PXW)[ucol] * w0;
    if (has_right(tau)) y += (p + PXW)[ucol] * w2;
    return y;
}
constexpr int WLR_K = 448;
constexpr int RP_WAVE_LDS = 16896;
typedef short rp_bf16x8 __attribute__((ext_vector_type(8)));
typedef float rp_f32x16 __attribute__((ext_vector_type(16)));
__device__ __forceinline__ unsigned short f2bf16(float x) { return (unsigned short)(cvt_pk_bf16(x, x) & 0xffffu); }
template <int NKB, class AF>
__device__ __forceinline__ void rp_lowrank(float (&dst)[16], const AF& afrag, const bf16_t* WLRh, int kw0, int n, int hi) {
    rp_f32x16 c0 = {}, c1 = {}; const bf16_t* wb0 = WLRh + (size_t)n * WLR_K + kw0 + 8 * hi; const bf16_t* wb1 = wb0 + (size_t)32 * WLR_K;
#pragma unroll
    for (int kb = 0; kb < NKB; ++kb) { const rp_bf16x8 b0 = *(const rp_bf16x8*)(wb0 + 16 * kb), b1 = *(const rp_bf16x8*)(wb1 + 16 * kb); const rp_bf16x8 a_ = afrag(kb);
        c0 = __builtin_amdgcn_mfma_f32_32x32x16_bf16(a_, b0, c0, 0, 0, 0); c1 = __builtin_amdgcn_mfma_f32_32x32x16_bf16(a_, b1, c1, 0, 0, 0); }
#pragma unroll
    for (int r = 0; r < 8; ++r) { auto sw = __builtin_amdgcn_permlane32_swap(__float_as_uint(c0[r]), __float_as_uint(c1[r]), false, false);
        dst[(r & 3) + 8 * (r >> 2)] = __uint_as_float(sw[0]); dst[(r & 3) + 8 * (r >> 2) + 4] = __uint_as_float(sw[1]); }
}
struct RpAfLds { const LAS bf16_t* base; __device__ __forceinline__ rp_bf16x8 operator()(int kb) const { return *(const LAS rp_bf16x8*)(base + 16 * kb); } };
__device__ __forceinline__ void rwkv_elem_phase(const Frame& F, unsigned char* ws, int l) {
    const float* PX = (const float*)(ws + WS_PX); float* SS = (float*)(ws + WS_SS); float* SD = (float*)(ws + WS_SD); float* GB = (float*)(ws + WS_G);
    const bf16_t* WLR = (const bf16_t*)(ws + WS_WLR) + (size_t)l * A_W * WLR_K;
    const float* cw = IN_(16) + (size_t)l * 3 * A_IN;
    LAS bf16_t* ACT = (LAS bf16_t*)(F.lds + F.wave * 10752);
    const int lane = F.lane, n = lane & 31, hi = lane >> 5;
    const int gw = F.bid * 8 + F.wave, NGW = F.G * 8;
    for (int it = gw; it < (T / 16) * 10; it += NGW) {
        const int tg = it / 10, hq = it % 10, tau0 = tg * 16;
        asm volatile("s_waitcnt lgkmcnt(0)" ::: "memory");
        const float* prow0 = PX + (size_t)(tau0 > 0 ? tau0 - 1 : 0) * PXW; const int roff = tau0 > 0 ? 0 : -1;
#define RP_WIN(x, ucol_) do { _Pragma("unroll") for (int i_ = 0; i_ < 18; ++i_) { int ri_ = i_ + roff; ri_ = ri_ < 0 ? 0 : ri_; ri_ = (tau0 - 1 + i_ > T - 1) ? (T - 1 - (tau0 > 0 ? tau0 - 1 : 0)) : ri_; x[i_] = (prow0 + (size_t)ri_ * PXW)[ucol_]; } } while (0)
#define RP_CONV(x, t_, w0_, w1_, w2_) (x[(t_)] * (has_left(tau0 + (t_)) ? (w0_) : 0.f) + x[(t_) + 1] * (w1_) + x[(t_) + 2] * (has_right(tau0 + (t_)) ? (w2_) : 0.f))
#pragma unroll
        for (int i = 0; i < 5; ++i) { const int c = lane + 64 * i, col = 3840 + c; const float c0 = cw[col], c1 = cw[A_IN + col], c2 = cw[2 * A_IN + col];
            float x[18]; RP_WIN(x, (unsigned)(PXA + col));
#pragma unroll
            for (int t = 0; t < 16; ++t) { const float val = RP_CONV(x, t, c0, c1, c2);
                const float act = i == 0 ? 1.0f - 2.0f / (1.0f + __expf(2.0f * val)) : (i == 1 ? val : sigmoidf_(val));
                ACT[t * 328 + c] = f2bf16(act); } }
        asm volatile("s_waitcnt lgkmcnt(0)" ::: "memory");
        const RpAfLds afw{ACT + (n & 15) * 328 + 8 * hi}, afa{ACT + (n & 15) * 328 + 64 + 8 * hi}, afg{ACT + (n & 15) * 328 + 128 + 8 * hi};
#pragma unroll 1
        for (int hh = 0; hh < 2; ++hh) {
            const int h = hq * 2 + hh, col = h * 64 + lane; const bf16_t* WLRh = WLR + (size_t)h * 64 * WLR_K;
            { float lg[16]; rp_lowrank<12>(lg, afg, WLRh, 256, n, hi);
#pragma unroll
              for (int t = 0; t < 16; ++t) GB[(size_t)(tau0 + t) * A_W + col] = lg[t]; }
            const float cr0 = cw[col], cr1 = cw[A_IN + col], cr2 = cw[2 * A_IN + col];
            const float ck0 = cw[A_W + col], ck1 = cw[A_IN + A_W + col], ck2 = cw[2 * A_IN + A_W + col];
            const float cv0 = cw[2 * A_W + col], cv1 = cw[A_IN + 2 * A_W + col], cv2 = cw[2 * A_IN + 2 * A_W + col];
            const float kk_w = IN_(22)[l * A_W + col], ka_w = IN_(23)[l * A_W + col];
            float kkv[16], kv[16];
            { float xr[18], xk[18], xv[18]; const unsigned uc = (unsigned)(PXA + col); RP_WIN(xr, uc); RP_WIN(xk, uc + A_W); RP_WIN(xv, uc + 2 * A_W);
#pragma unroll
              for (int t = 0; t < 16; ++t) { const int tau = tau0 + t;
                  const float r = RP_CONV(xr, t, cr0, cr1, cr2), v = RP_CONV(xv, t, cv0, cv1, cv2); kv[t] = RP_CONV(xk, t, ck0, ck1, ck2);
                  const float kr = kv[t] * kk_w; const float nrm = sqrtf(wave_sum(kr * kr)); kkv[t] = kr / fmaxf(nrm, 1e-12f);
                  float* ss = SS + ((size_t)h * T + tau) * 192 + lane; ss[0] = kkv[t]; ss[64] = r; ss[128] = v; } }
#pragma unroll 1
            for (int d = 0; d < 2; ++d) { const float w0b = IN_(17)[(l * 2 + d) * A_W + col], a0b = IN_(19)[(l * 2 + d) * A_W + col]; float lw[16], la[16];
                rp_lowrank<4>(lw, afw, WLRh, 64 * d, n, hi); rp_lowrank<4>(la, afa, WLRh, 128 + 64 * d, n, hi);
#pragma unroll
                for (int t = 0; t < 16; ++t) { const float z = w0b + lw[t]; const float decay = __expf(-__expf(-(fmaxf(-z, 0.f) + __logf(1.0f + __expf(-fabsf(z)))) - 0.5f)); const float av = sigmoidf_(a0b + la[t]);
                    float* sd = SD + (((size_t)h * 2 + d) * T + tau0 + t) * 192 + lane; sd[0] = decay; sd[64] = kkv[t] * av; sd[128] = kv[t] * (1.0f + (av - 1.0f) * ka_w); } }
        }
    }
}
#undef RP_WIN
#undef RP_CONV
constexpr int SP_WAVE_LDS = 16640;
__device__ __forceinline__ void scan_prep_phase(const Frame& F, unsigned char* ws) {
    const float* SS = (const float*)(ws + WS_SS); const float* SD = (const float*)(ws + WS_SD); unsigned char* FR = ws + WS_FR;
    LAS bf16_t* R1 = (LAS bf16_t*)(F.lds + F.wave * SP_WAVE_LDS); LAS bf16_t* R2 = R1 + 32 * 72; LAS bf16_t* BbT = R2 + 32 * 72; LAS bf16_t* KbT = BbT + 64 * 16; LAS bf16_t* VT = KbT + 64 * 16; LAS float* Lm = (LAS float*)(VT + 64 * 16);
    const int lane = F.lane, n = lane & 31, hi = lane >> 5;
    const int gw = F.bid * 8 + F.wave, NGW = F.G * 8;
    for (int it = gw; it < 2 * NHA * SC_NCHUNK; it += NGW) {
        const int chain = it / SC_NCHUNK, c = it % SC_NCHUNK, h = chain >> 1, d = chain & 1;
        const int tau_first = sc_tau(d, c, 0), dstep = d ? -1 : 1;
        const float* ssb = SS + (size_t)h * T * 192 + lane; const float* sdb = SD + ((size_t)h * 2 + d) * T * 192 + lane;
        float xw[16], xb[16], xk[16], xkk[16], xr[16], xv[16];
#pragma unroll
        for (int s = 0; s < 16; ++s) { const size_t o = (size_t)(tau_first + dstep * s) * 192; xw[s] = sdb[o]; xb[s] = sdb[o + 64]; xk[s] = sdb[o + 128]; xkk[s] = ssb[o]; xr[s] = ssb[o + 64]; xv[s] = ssb[o + 128]; }
        float gC = 1.f;
#pragma unroll
        for (int s = 0; s < 16; ++s) gC *= xw[s];
        float g = 1.f;
#pragma unroll
        for (int s = 0; s < 16; ++s) {
            const float gm1 = g; g *= xw[s]; const float ig = 1.0f / g; const float bh = xb[s] * ig, kh = xk[s] * ig;
            R1[s * 72 + lane] = f2bf16(-xkk[s] * gm1); R1[(16 + s) * 72 + lane] = f2bf16(xr[s] * g);
            R2[s * 72 + lane] = f2bf16(bh); R2[(16 + s) * 72 + lane] = f2bf16(kh);
            BbT[lane * 16 + s] = f2bf16(bh * gC); KbT[lane * 16 + s] = f2bf16(kh * gC); VT[lane * 16 + s] = f2bf16(xv[s]); }
        asm volatile("s_waitcnt lgkmcnt(0)" ::: "memory");
        unsigned char* dst = FR + ((size_t)chain * SC_NCHUNK + c) * SC_CHUNK_BYTES;
        rp_f32x16 C = {};
#pragma unroll
        for (int kb = 0; kb < 4; ++kb) { const rp_bf16x8 a_ = *(const LAS rp_bf16x8*)(R2 + n * 72 + 16 * kb + 8 * hi), b_ = *(const LAS rp_bf16x8*)(R1 + n * 72 + 16 * kb + 8 * hi);
            C = __builtin_amdgcn_mfma_f32_32x32x16_bf16(a_, b_, C, 0, 0, 0); }
        const int tt_ = n & 15; const bool incl = n >= 16;
#pragma unroll
        for (int r = 0; r < 16; ++r) { const int s = ((r & 7) & 3) + 8 * ((r & 7) >> 2) + 4 * hi; if (!(s < tt_ || (incl && s == tt_))) C[r] = 0.f; }
        if (n < 16) {
#pragma unroll
            for (int r = 0; r < 8; ++r) Lm[((r & 3) + 8 * (r >> 2) + 4 * hi) * 20 + n] = C[r]; }
        { u32x4 f4; f4.x = cvt_pk_bf16(C[8], C[9]); f4.y = cvt_pk_bf16(C[10], C[11]); f4.z = cvt_pk_bf16(C[12], C[13]); f4.w = cvt_pk_bf16(C[14], C[15]);
          u32x4 f6; f6.x = cvt_pk_bf16(C[0], C[1]); f6.y = cvt_pk_bf16(C[2], C[3]); f6.z = cvt_pk_bf16(C[4], C[5]); f6.w = cvt_pk_bf16(C[6], C[7]);
          if (n < 16) f6 = (u32x4){0u, 0u, 0u, 0u};
          *(u32x4*)(dst + 4 * 1024 + lane * 16) = f4; *(u32x4*)(dst + 6 * 1024 + lane * 16) = f6; }
        asm volatile("s_waitcnt lgkmcnt(0)" ::: "memory");
        { float Tc[16];
#pragma unroll
          for (int s = 15; s >= 0; --s) { float acc = (s == n) ? 1.f : 0.f;
#pragma unroll
              for (int u = s + 1; u < 16; ++u) acc += Lm[s * 20 + u] * Tc[u];
              Tc[s] = acc; }
          u32x4 f5; f5.x = cvt_pk_bf16(hi ? Tc[4] : Tc[0], hi ? Tc[5] : Tc[1]); f5.y = cvt_pk_bf16(hi ? Tc[6] : Tc[2], hi ? Tc[7] : Tc[3]);
          f5.z = cvt_pk_bf16(hi ? Tc[12] : Tc[8], hi ? Tc[13] : Tc[9]); f5.w = cvt_pk_bf16(hi ? Tc[14] : Tc[10], hi ? Tc[15] : Tc[11]);
          if (n >= 16) f5 = (u32x4){0u, 0u, 0u, 0u};
          *(u32x4*)(dst + 5 * 1024 + lane * 16) = f5; }
#pragma unroll
        for (int f = 0; f < 4; ++f) { const u32x2 p0 = *(const LAS u32x2*)(R1 + n * 72 + 16 * f + 4 * hi), p1 = *(const LAS u32x2*)(R1 + n * 72 + 16 * f + 8 + 4 * hi);
            *(u32x4*)(dst + f * 1024 + lane * 16) = (u32x4){p0.x, p0.y, p1.x, p1.y}; }
#pragma unroll
        for (int jb = 0; jb < 2; ++jb) { const int row = 32 * jb + n;
            const u32x2 b0 = *(const LAS u32x2*)(BbT + row * 16 + 4 * hi), b1 = *(const LAS u32x2*)(BbT + row * 16 + 8 + 4 * hi), k0 = *(const LAS u32x2*)(KbT + row * 16 + 4 * hi), k1 = *(const LAS u32x2*)(KbT + row * 16 + 8 + 4 * hi);
            const u32x2 v0 = *(const LAS u32x2*)(VT + row * 16 + 4 * hi), v1 = *(const LAS u32x2*)(VT + row * 16 + 8 + 4 * hi);
            *(u32x4*)(dst + (7 + 2 * jb) * 1024 + lane * 16) = (u32x4){b0.x, b0.y, b1.x, b1.y}; *(u32x4*)(dst + (8 + 2 * jb) * 1024 + lane * 16) = (u32x4){k0.x, k0.y, k1.x, k1.y};
            *(u32x4*)(dst + (11 + jb) * 1024 + lane * 16) = (u32x4){v0.x, v0.y, v1.x, v1.y}; }
        { const int jj = lane & 31; ((float*)(dst + 13 * 1024))[((jj >> 2) & 1) * 32 + (lane >> 5) * 16 + (jj & 3) + 4 * (jj >> 3)] = gC; }
        asm volatile("s_waitcnt lgkmcnt(0)" ::: "memory");
    }
}
constexpr int RF_ACT_BYTES = 16 * 320 * 2;
__device__ __forceinline__ void rwkv_fused_phase(const Frame& F, unsigned char* ws, int l) {
    const bf16_t* PX = (const bf16_t*)(ws + WS_PX); unsigned char* FR = ws + WS_FR;
    float* GB = (float*)(ws + WS_G); float* VB = (float*)(ws + WS_SS) + (size_t)T * A_W; float* BS = (float*)(ws + WS_SD);
    const bf16_t* WLR = (const bf16_t*)(ws + WS_WLR) + (size_t)l * A_W * WLR_K;
    const float* cw = IN_(16) + (size_t)l * 3 * A_IN;
    LAS bf16_t* ACT = (LAS bf16_t*)F.lds;
    LAS bf16_t* R1 = (LAS bf16_t*)(F.lds + RF_ACT_BYTES + F.wave * SP_WAVE_LDS); LAS bf16_t* R2 = R1 + 32 * 72; LAS bf16_t* BbT = R2 + 32 * 72; LAS bf16_t* KbT = BbT + 64 * 16; LAS bf16_t* VT = KbT + 64 * 16; LAS float* Lm = (LAS float*)(VT + 64 * 16);
    const int lane = F.lane, n = lane & 31, hi = lane >> 5, hh = F.wave >> 1, d = F.wave & 1;
    for (int it = F.bid; it < (T / 16) * 5; it += F.G) {
        const int tg = it / 5, hg = it % 5, tau0 = tg * 16, h = hg * 4 + hh, col = h * 64 + lane;
        const bf16_t* prow0 = PX + (size_t)(tau0 > 0 ? tau0 - 1 : 0) * PXW; const int roff = tau0 > 0 ? 0 : -1;
#define RP_WIN(x, ucol_) do { _Pragma("unroll") for (int i_ = 0; i_ < 18; ++i_) { int ri_ = i_ + roff; ri_ = ri_ < 0 ? 0 : ri_; ri_ = (tau0 - 1 + i_ > T - 1) ? (T - 1 - (tau0 > 0 ? tau0 - 1 : 0)) : ri_; x[i_] = bf2f((prow0 + (size_t)ri_ * PXW)[ucol_]); } } while (0)
#define RP_CONV(x, t_, w0_, w1_, w2_) (x[(t_)] * (has_left(tau0 + (t_)) ? (w0_) : 0.f) + x[(t_) + 1] * (w1_) + x[(t_) + 2] * (has_right(tau0 + (t_)) ? (w2_) : 0.f))
        float wr_[18], wk_[18], wv_[18]; { const unsigned uc = (unsigned)(PXA + col); RP_WIN(wr_, uc); RP_WIN(wk_, uc + A_W); RP_WIN(wv_, uc + 2 * A_W); }
        const float cr0 = cw[col], cr1 = cw[A_IN + col], cr2 = cw[2 * A_IN + col], ck0 = cw[A_W + col], ck1 = cw[A_IN + A_W + col], ck2 = cw[2 * A_IN + A_W + col];
        const float cv0 = cw[2 * A_W + col], cv1 = cw[A_IN + 2 * A_W + col], cv2 = cw[2 * A_IN + 2 * A_W + col], kk_w = IN_(22)[l * A_W + col];
        __syncthreads();
        { int tq = F.tid; asm volatile("" : "+v"(tq));
#pragma unroll
          for (int i = 0; i < 3; ++i) { const int item = tq + 512 * i;
              if (item < 16 * 80) { const int t = item / 80, c = 4 * (item % 80), cc = 3840 + c, tau = tau0 + t;
                  const bf16_t* p = PX + (size_t)tau * PXW + PXA + cc; const bool hl = has_left(tau), hr = has_right(tau);
                  const f32x4 x1 = bf4f(*(const u32x2*)p), x0 = bf4f(*(const u32x2*)(p - (hl ? PXW : 0))), x2 = bf4f(*(const u32x2*)(p + (hr ? PXW : 0)));
                  const f32x4 w0 = *(const f32x4*)(cw + cc), w1 = *(const f32x4*)(cw + A_IN + cc), w2 = *(const f32x4*)(cw + 2 * A_IN + cc);
                  const f32x4 val = x1 * w1 + x0 * (w0 * (hl ? 1.f : 0.f)) + x2 * (w2 * (hr ? 1.f : 0.f));
                  f32x4 act;
#pragma unroll
                  for (int e = 0; e < 4; ++e) act[e] = c < 64 ? 1.0f - 2.0f / (1.0f + __expf(2.0f * val[e])) : (c < 128 ? val[e] : sigmoidf_(val[e]));
                  u32x2 o; o.x = cvt_pk_bf16(act.x, act.y); o.y = cvt_pk_bf16(act.z, act.w);
                  *(LAS u32x2*)(ACT + t * 320 + c) = o; } } }
        __syncthreads();
        const bf16_t* WLRh = WLR + (size_t)h * 64 * WLR_K;
        const RpAfLds afw{ACT + (n & 15) * 320 + 8 * hi}, afa{ACT + (n & 15) * 320 + 64 + 8 * hi}, afg{ACT + (n & 15) * 320 + 128 + 8 * hi};
        float xw[16], xb[16], xk[16], xkk[16], xr[16], xv[16];
        {
          if (d == 0) { float lg[16]; rp_lowrank<12>(lg, afg, WLRh, 256, n, hi);
#pragma unroll
              for (int t = 0; t < 16; ++t) GB[(size_t)(tau0 + t) * A_W + col] = lg[t]; }
#pragma unroll
          for (int t = 0; t < 16; ++t) { xr[t] = RP_CONV(wr_, t, cr0, cr1, cr2); xv[t] = RP_CONV(wv_, t, cv0, cv1, cv2); xk[t] = RP_CONV(wk_, t, ck0, ck1, ck2);
              const float kr = xk[t] * kk_w; const float nrm = sqrtf(wave_sum(kr * kr)); xkk[t] = kr / fmaxf(nrm, 1e-12f); } }
        if (d == 0) {
#pragma unroll
            for (int t = 0; t < 16; ++t) VB[(size_t)(tau0 + t) * A_W + col] = xv[t]; }
        { const float ka_w = IN_(23)[l * A_W + col], w0b = IN_(17)[(l * 2 + d) * A_W + col], a0b = IN_(19)[(l * 2 + d) * A_W + col]; float la[16];
          rp_lowrank<4>(xw, afw, WLRh, 64 * d, n, hi); rp_lowrank<4>(la, afa, WLRh, 128 + 64 * d, n, hi);
#pragma unroll
          for (int t = 0; t < 16; ++t) { const float z = w0b + xw[t]; xw[t] = __expf(-__expf(-(fmaxf(-z, 0.f) + __logf(1.0f + __expf(-fabsf(z)))) - 0.5f)); const float av = sigmoidf_(a0b + la[t]);
              xb[t] = xkk[t] * av; xk[t] = xk[t] * (1.0f + (av - 1.0f) * ka_w); }
          { const float rk_w = IN_(24)[l * A_W + col]; float pr[16];
#pragma unroll
            for (int t = 0; t < 16; ++t) pr[t] = xr[t] * xk[t] * rk_w;
            const float sb = wave_sum16(pr, lane);
            if ((lane & 3) == 0) BS[((size_t)d * T + tau0 + (lane >> 2)) * NHA + h] = sb; } }
        if (d) {
#pragma unroll
            for (int s = 0; s < 8; ++s) { float t_;
                t_ = xw[s]; xw[s] = xw[15 - s]; xw[15 - s] = t_; t_ = xb[s]; xb[s] = xb[15 - s]; xb[15 - s] = t_; t_ = xk[s]; xk[s] = xk[15 - s]; xk[15 - s] = t_;
                t_ = xkk[s]; xkk[s] = xkk[15 - s]; xkk[15 - s] = t_; t_ = xr[s]; xr[s] = xr[15 - s]; xr[15 - s] = t_; t_ = xv[s]; xv[s] = xv[15 - s]; xv[15 - s] = t_; } }
        const int c = d == 0 ? tg : (tg < NCTX / 16 ? NCTX / 16 - 1 - tg : NCTX / 16 + (T / 16 - 1) - tg);
        float gC = 1.f;
#pragma unroll
        for (int s = 0; s < 16; ++s) gC *= xw[s];
        float g = 1.f;
#pragma unroll
        for (int s = 0; s < 16; ++s) {
            const float gm1 = g; g *= xw[s]; const float ig = 1.0f / g; const float bh = xb[s] * ig, kh = xk[s] * ig;
            R1[s * 72 + lane] = f2bf16(-xkk[s] * gm1); R1[(16 + s) * 72 + lane] = f2bf16(xr[s] * g);
            R2[s * 72 + lane] = f2bf16(bh); R2[(16 + s) * 72 + lane] = f2bf16(kh);
            xb[s] = bh * gC; xk[s] = kh * gC; }
        asm volatile("s_waitcnt lgkmcnt(0)" ::: "memory");
        unsigned char* dst = FR + ((size_t)(h * 2 + d) * SC_NCHUNK + c) * SC_CHUNK_BYTES;
        rp_f32x16 C = {};
#pragma unroll
        for (int kb = 0; kb < 4; ++kb) { const rp_bf16x8 a_ = *(const LAS rp_bf16x8*)(R2 + n * 72 + 16 * kb + 8 * hi), b_ = *(const LAS rp_bf16x8*)(R1 + n * 72 + 16 * kb + 8 * hi);
            C = __builtin_amdgcn_mfma_f32_32x32x16_bf16(a_, b_, C, 0, 0, 0); }
        const int tt_ = n & 15; const bool incl = n >= 16;
#pragma unroll
        for (int r = 0; r < 16; ++r) { const int s = ((r & 7) & 3) + 8 * ((r & 7) >> 2) + 4 * hi; if (!(s < tt_ || (incl && s == tt_))) C[r] = 0.f; }
        if (n < 16) {
#pragma unroll
            for (int r = 0; r < 8; ++r) Lm[((r & 3) + 8 * (r >> 2) + 4 * hi) * 20 + n] = C[r]; }
        { u32x4 f4; f4.x = cvt_pk_bf16(C[8], C[9]); f4.y = cvt_pk_bf16(C[10], C[11]); f4.z = cvt_pk_bf16(C[12], C[13]); f4.w = cvt_pk_bf16(C[14], C[15]);
          u32x4 f6; f6.x = cvt_pk_bf16(C[0], C[1]); f6.y = cvt_pk_bf16(C[2], C[3]); f6.z = cvt_pk_bf16(C[4], C[5]); f6.w = cvt_pk_bf16(C[6], C[7]);
          if (n < 16) f6 = (u32x4){0u, 0u, 0u, 0u};
          *(u32x4*)(dst + 4 * 1024 + lane * 16) = f4; *(u32x4*)(dst + 6 * 1024 + lane * 16) = f6; }
        asm volatile("s_waitcnt lgkmcnt(0)" ::: "memory");
        { float Tc[16];
#pragma unroll
          for (int s = 15; s >= 0; --s) { float acc = (s == n) ? 1.f : 0.f;
#pragma unroll
              for (int u = s + 1; u < 16; ++u) acc += Lm[s * 20 + u] * Tc[u];
              Tc[s] = acc; }
          u32x4 f5; f5.x = cvt_pk_bf16(hi ? Tc[4] : Tc[0], hi ? Tc[5] : Tc[1]); f5.y = cvt_pk_bf16(hi ? Tc[6] : Tc[2], hi ? Tc[7] : Tc[3]);
          f5.z = cvt_pk_bf16(hi ? Tc[12] : Tc[8], hi ? Tc[13] : Tc[9]); f5.w = cvt_pk_bf16(hi ? Tc[14] : Tc[10], hi ? Tc[15] : Tc[11]);
          if (n >= 16) f5 = (u32x4){0u, 0u, 0u, 0u};
          *(u32x4*)(dst + 5 * 1024 + lane * 16) = f5; }
#pragma unroll
        for (int f = 0; f < 4; ++f) { const u32x2 p0 = *(const LAS u32x2*)(R1 + n * 72 + 16 * f + 4 * hi), p1 = *(const LAS u32x2*)(R1 + n * 72 + 16 * f + 8 + 4 * hi);
            *(u32x4*)(dst + f * 1024 + lane * 16) = (u32x4){p0.x, p0.y, p1.x, p1.y}; }
#define RF_FRAG(x_, fa_, fb_) do { unsigned pk_[8]; _Pragma("unroll") for (int m_ = 0; m_ < 8; ++m_) pk_[m_] = cvt_pk_bf16(x_[2 * m_], x_[2 * m_ + 1]); \
            const bool h1_ = hi != 0; const u32x4 own_ = {h1_ ? pk_[2] : pk_[0], h1_ ? pk_[3] : pk_[1], h1_ ? pk_[6] : pk_[4], h1_ ? pk_[7] : pk_[5]}; \
            u32x4 rcv_ = {h1_ ? pk_[0] : pk_[2], h1_ ? pk_[1] : pk_[3], h1_ ? pk_[4] : pk_[6], h1_ ? pk_[5] : pk_[7]}; \
            rcv_.x = __shfl_xor(rcv_.x, 32); rcv_.y = __shfl_xor(rcv_.y, 32); rcv_.z = __shfl_xor(rcv_.z, 32); rcv_.w = __shfl_xor(rcv_.w, 32); \
            *(u32x4*)(dst + (fa_) * 1024 + lane * 16) = h1_ ? rcv_ : own_; *(u32x4*)(dst + (fb_) * 1024 + lane * 16) = h1_ ? own_ : rcv_; } while (0)
        RF_FRAG(xb, 7, 9); RF_FRAG(xk, 8, 10); RF_FRAG(xv, 11, 12);
#undef RF_FRAG
        { const int jj = lane & 31; ((float*)(dst + 13 * 1024))[((jj >> 2) & 1) * 32 + (lane >> 5) * 16 + (jj & 3) + 4 * (jj >> 3)] = gC; }
        asm volatile("s_waitcnt lgkmcnt(0)" ::: "memory");
    }
#undef RP_WIN
#undef RP_CONV
}
__device__ __forceinline__ void mixer_phase(const Frame& F0, unsigned char* ws0, int lq, bool need_ctx, char* lds_g) {
    const int l = lq & 3;
#ifndef MK_MIX
#define MK_MIX 15
#endif
    { const Frame F = opq(F0); unsigned char* ws = opq_ptr(ws0);
      if (MK_MIX & 1) for (int chain = F.bid; chain < 2 * NHA; chain += F.G) scan_chain_mfma(F, ws, chain); }
    const Frame& F = F0;
    const int n_xa = 32 * NHC, n_ca = need_ctx ? NHC : 0, n_att = n_xa + n_ca, n_hy = 640, n_ch = need_ctx ? 160 : 0;
    unsigned* qatt = (unsigned*)(ws0 + WS_CTL) + CW_QUEUE + 64 * lq; unsigned* qhy = qatt + 32;
    int item;
#define MIX_POP(q) do { if (F.tid == 0) F.MISC[16] = __hip_atomic_fetch_add((q), 1u, __ATOMIC_RELAXED, __HIP_MEMORY_SCOPE_AGENT); __syncthreads(); item = (int)F.MISC[16]; __syncthreads(); } while (0)
    if (F.bid >= 2 * NHA) {
        MIX_POP(qatt);
        while (item < n_att) {
            if (MK_MIX & 2) { unsigned char* ws = opq_ptr(ws0);
                const bf16_t* QF = (const bf16_t*)(ws + WS_QF); const bf16_t* KF = (const bf16_t*)(ws + WS_KF); const bf16_t* KVRAW = (const bf16_t*)(ws + WS_KVRAW); bf16_t* OB = (bf16_t*)(ws + WS_OBUF);
                const bool is_xa = item < n_xa; const int h = is_xa ? item % NHC : item - n_xa, row0 = is_xa ? NCTX + (item / NHC) * 256 : 0;
                for (int rp = 0; rp < REP(13); ++rp) att::attn_body(QF + (size_t)row0 * NQ + h * 192, KF + h * 192, KVRAW + h * 256 + 128, OB + (size_t)row0 * DM + 2560 + h * 128, is_xa ? T : NCTX, lds_g); }
            MIX_POP(qatt);
        }
    }
    MIX_POP(qhy);
    while (item < n_hy + n_ch) {
        const Frame Fu = opq(F0); unsigned char* ws = opq_ptr(ws0);
        if ((MK_MIX & 4) && item < n_hy) hyena_unit(Fu, ws, l, item);
        else if ((MK_MIX & 8) && item >= n_hy) hyena_ctx_unit(Fu, ws, l, item - n_hy);
        MIX_POP(qhy);
    }
#undef MIX_POP
}

__device__ __forceinline__ void hyena_taps_tail(const Frame& F0, unsigned char* ws0, int lt, int first, int end) {
    if (F0.bid < 48) return;
#pragma unroll 1
    for (int p = first + F0.bid - 48; p < end; p += 208) hyena_taps_unit(opq(F0), opq_ptr(ws0), lt, p);
}
constexpr int NPH = 2 + 14 * NL;
__global__ void __launch_bounds__(512, 2) mk_fwd(Args a) {
    extern __shared__ __attribute__((aligned(16))) unsigned char lds[];
    Frame F; F.lds = (LAS unsigned char*)lds; F.MISC = (volatile LAS unsigned*)(F.lds + LDS_MISC);
    F.tid = threadIdx.x; F.lane = F.tid & 63; F.wave = __builtin_amdgcn_readfirstlane(F.tid >> 6); F.bid = blockIdx.x; F.G = gridDim.x;
    if (F.tid < 64) F.MISC[F.tid] = 0u;
    if (F.tid < 46) *(LAS unsigned long long*)(F.lds + LDS_PTAB + 8 * F.tid) = (unsigned long long)(uintptr_t)a.in[F.tid];
    __syncthreads();
    unsigned char* ws = a.ws;
    const int lo = a.ph_lo, hi = a.ph_hi;
    XcdBarrier bar = xcd_barrier_post((unsigned*)(ws + WS_CTL) + CW_BAR, F.MISC + 8);
#ifndef MK_MASK
#define MK_MASK 0xffff
#endif
#define EN(x) (((MK_MASK) >> (x)) & 1)
#define IN(k) (lo <= (k) && (k) < hi)
#define SEAM(k) do { if (IN(k) && IN((k) + 1)) xcd_barrier(bar); } while (0)
#define WSP opq_ptr(ws)
#define P_XS(w) ((float*)((w) + WS_XS))
#define P_ABUF(w) ((bf16_t*)((w) + WS_ABUF))
#define P_HBUF(w) ((bf16_t*)((w) + WS_HBUF))
#define P_OBUF(w) ((bf16_t*)((w) + WS_OBUF))
#define P_MODX(w, l) ((const float*)((w) + WS_MOD) + ((size_t)(l) * 2 + 0) * NMOD)
#define P_MODC(w, l) ((const float*)((w) + WS_MOD) + ((size_t)(l) * 2 + 1) * NMOD)
#define P_WL(w, l) ((const bf16_t*)((w) + WS_WB) + (size_t)(l) * W_LAYER)
    if (EN(0) && IN(0)) for (int rp = 0; rp < REP(0); ++rp) phase0(opq(F), opq_ptr(ws));
    SEAM(0);
    if (EN(1) && IN(1)) phase_mod(opq(F), opq_ptr(ws));
    SEAM(1);
#pragma clang loop unroll(full)
    for (int l = 0; l < NL; ++l) {
        const int pb = 2 + 14 * l; const bool need_ctx = l < NL - 1;
        if (EN(2) && IN(pb + 0)) for (int rp = 0; rp < REP(2); ++rp) { unsigned char* w = WSP; norm_phase(opq(F), P_XS(w), IN_(7) + l * DM, P_MODX(w, l), P_MODC(w, l), 0, 1, P_ABUF(w), l > 0 ? (const bf16_t*)(w + WS_SLAB) : nullptr, l > 0 ? P_MODC(w, l - 1) + 8 * DM : nullptr, 0.5f); }
        SEAM(pb + 0);
        if (EN(3) && IN(pb + 1)) { unsigned char* w = WSP; pg8::Gemm g{P_ABUF(w), P_WL(w, l) + W_G1, T, 2 * FF, DM, DM}; pg8::StaticOrder S; S.init(T, 2 * FF, F.G, F.bid); pg8::EpiSwiGLU E{P_HBUF(w), FF};
            pg8::gemm_phase<pg8::EpiSwiGLU, pg8::StaticOrder>(F.lds, g, S, E, nullptr);
            hyena_taps_tail(F, ws, l, 0, l == 0 ? 640 : 416); }
        SEAM(pb + 1);
        if (EN(4) && IN(pb + 2)) {
            { unsigned char* w = WSP; pg8::Gemm g{P_HBUF(w), P_WL(w, l) + W_D1, T, DM, FF, FF}; pg8::StaticOrderX S; S.init(T, DM, F.G, F.bid); pg8::EpiResid E{P_XS(w), P_MODX(w, l) + 2 * DM, P_MODC(w, l) + 2 * DM, 0.5f, nullptr};
              pg8::gemm_phase<pg8::EpiResid, pg8::StaticOrderX>(F.lds, g, S, E, nullptr); }
            if (true) { __syncthreads();
              if (F.bid < 256) { unsigned char* w = WSP; const int ks = F.bid >> 4, ksz = FF / 16; pg8::Gemm g{P_HBUF(w) + ks * ksz, P_WL(w, l) + W_D1 + ks * ksz, NCTX, DM, ksz, FF}; pg8::OneUnit S{F.bid & 15};
                  pg8::EpiBf16<0> E{(bf16_t*)(w + WS_SLAB) + (size_t)ks * NCTX * DM, DM, nullptr, 0, 0};
                  pg8::gemm_phase<pg8::EpiBf16<0>, pg8::OneUnit>(F.lds, g, S, E, nullptr); } }
        }
        SEAM(pb + 2);
        if (EN(5) && IN(pb + 3)) for (int rp = 0; rp < REP(2); ++rp) { unsigned char* w = WSP; norm_phase(opq(F), P_XS(w), IN_(8) + l * DM, P_MODX(w, l), P_MODC(w, l), 3, 4, P_ABUF(w), (const bf16_t*)(w + WS_SLAB), P_MODC(w, l) + 2 * DM, 0.5f); }
        SEAM(pb + 3);
        if (EN(6) && IN(pb + 4)) { unsigned char* w = WSP; pg8::Gemm g{P_ABUF(w), P_WL(w, l) + W_IN, T, PXW, DM, DM}; pg8::StaticOrder S; S.init(T, PXW, F.G, F.bid); pg8::EpiBf16<0> E{(bf16_t*)(w + WS_PX), PXW, nullptr, 0, 0};
            pg8::gemm_phase<pg8::EpiBf16<0>, pg8::StaticOrder>(F.lds, g, S, E, nullptr); }
        SEAM(pb + 4);
        if (EN(7) && IN(pb + 5)) { for (int rp = 0; rp < REP(7); ++rp) rwkv_fused_phase(opq(F), opq_ptr(ws), l); if (!(MK_ONLYRP)) { for (int rp = 0; rp < REP(8); ++rp) mla_prep_phase(opq(F), opq_ptr(ws), l); hyena_prep_phase(opq(F), opq_ptr(ws), l); } }
        SEAM(pb + 5);
        if (EN(8) && IN(pb + 6)) {
            { unsigned char* w = WSP; pg8::Gemm g{(const bf16_t*)(w + WS_QA), P_WL(w, l) + W_Q, T, NQ, 1024, 1024}; pg8::StaticOrder S; S.init(T, NQ, F.G, F.bid); pg8::EpiBf16<0> E{(bf16_t*)(w + WS_QRAW), NQ, nullptr, 0, 0};
              pg8::gemm_phase<pg8::EpiBf16<0>, pg8::StaticOrder>(F.lds, g, S, E, nullptr); }
            __syncthreads();
            { unsigned char* w = WSP; pg8::Gemm g{(const bf16_t*)(w + WS_KVA), P_WL(w, l) + W_KV, T, NKV, 512, 512}; pg8::StaticOrder S; S.init(T, NKV, F.G, (F.bid + 208) & 255);     pg8::EpiBf16<0> E{(bf16_t*)(w + WS_KVRAW), NKV, nullptr, 0, 0};
              pg8::gemm_phase<pg8::EpiBf16<0>, pg8::StaticOrder>(F.lds, g, S, E, nullptr); }
        }
        SEAM(pb + 6);
        if (EN(9) && IN(pb + 7)) { for (int rp = 0; rp < REP(8); ++rp) qkv_final_phase(opq(F), opq_ptr(ws), l, need_ctx); }
        SEAM(pb + 7);
        if (EN(10) && IN(pb + 8)) for (int rp = 0; rp < REP(10); ++rp) mixer_phase(F, ws, l + 4 * rp, need_ctx, (char*)lds);
        SEAM(pb + 8);
        if (EN(11) && IN(pb + 9)) { for (int rp = 0; rp < REP(8); ++rp) rwkv_out_phase(opq(F), opq_ptr(ws), l, need_ctx); hyena_out_phase(opq(F), opq_ptr(ws), need_ctx); }
        SEAM(pb + 9);
        if (EN(12) && IN(pb + 10)) {
            { unsigned char* w = WSP; pg8::Gemm g{P_OBUF(w), P_WL(w, l) + W_OUT, T, DM, DM, DM}; pg8::StaticOrderX S; S.init(T, DM, F.G, F.bid); pg8::EpiResid E{P_XS(w), P_MODX(w, l) + 5 * DM, P_MODC(w, l) + 5 * DM, 1.0f, nullptr};
              pg8::gemm_phase<pg8::EpiResid, pg8::StaticOrderX>(F.lds, g, S, E, nullptr); }
            if (need_ctx) { __syncthreads();
              if (F.bid < 256) { unsigned char* w = WSP; const int ks = F.bid >> 4, ksz = DM / 16; pg8::Gemm g{P_OBUF(w) + ks * ksz, P_WL(w, l) + W_OUT + ks * ksz, NCTX, DM, ksz, DM}; pg8::OneUnit S{F.bid & 15};
                  pg8::EpiBf16<0> E{(bf16_t*)(w + WS_SLAB) + (size_t)ks * NCTX * DM, DM, nullptr, 0, 0};
                  pg8::gemm_phase<pg8::EpiBf16<0>, pg8::OneUnit>(F.lds, g, S, E, nullptr); } }
        }
        SEAM(pb + 10);
        if (EN(13) && IN(pb + 11)) for (int rp = 0; rp < REP(2); ++rp) { unsigned char* w = WSP; norm_phase(opq(F), P_XS(w), IN_(9) + l * DM, P_MODX(w, l), P_MODC(w, l), 6, 7, P_ABUF(w), need_ctx ? (const bf16_t*)(w + WS_SLAB) : nullptr, P_MODC(w, l) + 5 * DM, 1.0f); }
        SEAM(pb + 11);
        if (EN(14) && IN(pb + 12)) { if (need_ctx) { unsigned char* w = WSP; pg8::Gemm g{P_ABUF(w), P_WL(w, l) + W_G2, T, 2 * FF, DM, DM}; pg8::StaticOrder S; S.init(T, 2 * FF, F.G, F.bid); pg8::EpiSwiGLU E{P_HBUF(w), FF};
            pg8::gemm_phase<pg8::EpiSwiGLU, pg8::StaticOrder>(F.lds, g, S, E, nullptr);
            hyena_taps_tail(F, ws, l + 1, 416, 640); }       else { unsigned char* w = WSP; pg8::Gemm g{P_ABUF(w), P_WL(w, l) + W_G2, T, 2 * FF, DM, DM}; pg8::StaticOrderX S; S.init(T, 2 * FF, F.G, F.bid); pg8::EpiSwiGLU E{P_HBUF(w), FF};
            pg8::gemm_phase<pg8::EpiSwiGLU, pg8::StaticOrderX>(F.lds, g, S, E, nullptr); } }
        SEAM(pb + 12);
        if (EN(15) && IN(pb + 13)) {
            { unsigned char* w = WSP; pg8::Gemm g{P_HBUF(w), P_WL(w, l) + W_D2, T, DM, FF, FF}; pg8::StaticOrderX S; S.init(T, DM, F.G, F.bid); pg8::EpiResid E{P_XS(w), P_MODX(w, l) + 8 * DM, P_MODC(w, l) + 8 * DM, 0.5f, l == NL - 1 ? a.out : nullptr};
              pg8::gemm_phase<pg8::EpiResid, pg8::StaticOrderX>(F.lds, g, S, E, nullptr); }
            if (need_ctx) { __syncthreads();
              if (F.bid < 256) { unsigned char* w = WSP; const int ks = F.bid >> 4, ksz = FF / 16; pg8::Gemm g{P_HBUF(w) + ks * ksz, P_WL(w, l) + W_D2 + ks * ksz, NCTX, DM, ksz, FF}; pg8::OneUnit S{F.bid & 15};
                  pg8::EpiBf16<0> E{(bf16_t*)(w + WS_SLAB) + (size_t)ks * NCTX * DM, DM, nullptr, 0, 0};
                  pg8::gemm_phase<pg8::EpiBf16<0>, pg8::OneUnit>(F.lds, g, S, E, nullptr); } }
        }
        SEAM(pb + 13);
    }
#undef IN
#undef SEAM
}

#ifndef MK_LAUNCHES
#define MK_LAUNCHES 1
#endif
extern "C" void kernel_launch(void* const* d_in, const int* in_sizes, int n_in, void* d_out, int out_size, void* d_ws, size_t ws_size, hipStream_t stream) {
    static int grid = 0;
    if (grid == 0) {
        if (n_in != 46 || in_sizes[0] != SEQ * DM || out_size != SEQ * DM || ws_size < WS_END) {
            fprintf(stderr, "kernel_launch: shape mismatch: n_in %d in0 %d out %d ws %zu (need %zu); nothing launched\n", n_in, n_in > 0 ? in_sizes[0] : -1, out_size, ws_size, (size_t)WS_END); grid = -1; return; }
        int dev = 0, cus = 0, per_cu = 0;
        if (hipGetDevice(&dev) != hipSuccess || hipDeviceGetAttribute(&cus, hipDeviceAttributeMultiprocessorCount, dev) != hipSuccess) { fprintf(stderr, "kernel_launch: device query failed\n"); grid = -1; return; }
        if (hipFuncSetAttribute((const void*)mk_fwd, hipFuncAttributeMaxDynamicSharedMemorySize, LDS_BYTES) != hipSuccess) { fprintf(stderr, "kernel_launch: hipFuncSetAttribute failed\n"); grid = -1; return; }
        if (hipOccupancyMaxActiveBlocksPerMultiprocessor(&per_cu, (const void*)mk_fwd, 512, LDS_BYTES) != hipSuccess || per_cu < 1) fprintf(stderr, "kernel_launch: note: occupancy query reports %d blocks per CU\n", per_cu);
        (void)hipGetLastError();
        grid = cus;
        if (cus != 256) { fprintf(stderr, "kernel_launch: built for 256 CUs (split-K of the context panel, hyena scratch), found %d; nothing launched\n", cus); grid = -1; return; }
    }
    if (grid < 0) return;
    if (hipMemsetAsync((char*)d_ws + WS_CTL, 0, CTL_BYTES, stream) != hipSuccess) { fprintf(stderr, "kernel_launch: memset failed\n"); return; }
    Args a{};
    for (int i = 0; i < 46; ++i) a.in[i] = (const float*)d_in[i];
    a.out = (float*)d_out; a.ws = (unsigned char*)d_ws;
    a.ph_lo = 0; a.ph_hi = NPH;
    hipLaunchKernelGGL(mk_fwd, dim3(grid), dim3(512), LDS_BYTES, stream, a);
    const hipError_t le = hipPeekAtLastError();
    if (le != hipSuccess) fprintf(stderr, "kernel_launch: launch failed: %s\n", hipGetErrorName(le));
}
```

```cpp
#include <hip/hip_runtime.h>
#include <stdint.h>
#include <cstdio>

#define LAS __attribute__((address_space(3)))
#define CAS __attribute__((address_space(4)))
typedef unsigned short bf16_t;
typedef float f32x4 __attribute__((ext_vector_type(4)));
typedef float f32x2 __attribute__((ext_vector_type(2)));
typedef unsigned u32x4 __attribute__((ext_vector_type(4)));
typedef unsigned u32x2 __attribute__((ext_vector_type(2)));

constexpr int T = 8448, NCTX = 256, SEQ = 8192, DM = 4096, FF = 6144, NL = 4;
constexpr int A_W = 1280, A_IN = 4160, B_IN = 3840, C_IN = 1600, NHA = 20;
constexpr int PXW = 9728, PXA = 0, PXB = 4160, PXC = 8000;
constexpr int NQ = 2304, NKV = 3072, NHC = 12;
constexpr int NMOD = 9 * DM;
constexpr float NORM_EPS = 1e-6f, GN_EPS = 64e-5f;

constexpr size_t MiB = 1u << 20;
constexpr size_t al(size_t x) { return (x + MiB - 1) / MiB * MiB; }
constexpr size_t WS_CTL = 0, CTL_BYTES = MiB;
constexpr size_t WS_XS = WS_CTL + CTL_BYTES;
constexpr size_t WS_ABUF = WS_XS + al((size_t)T * DM * 4);
constexpr size_t WS_HBUF = WS_ABUF + al((size_t)T * DM * 2);
constexpr size_t WS_OBUF = WS_HBUF + al((size_t)T * FF * 2);
constexpr size_t WS_PX = WS_OBUF + al((size_t)T * DM * 2);
constexpr size_t WS_MOD = WS_PX + al((size_t)T * PXW * 4);
constexpr size_t WS_HP = WS_MOD + al((size_t)NL * 2 * NMOD * 4);
constexpr size_t WS_SS = WS_HP + MiB;
constexpr size_t WS_SD = WS_SS + al((size_t)NHA * T * 192 * 4);
constexpr size_t WS_WLR = WS_SD + al((size_t)NHA * 2 * T * 192 * 4);
constexpr size_t WS_G = WS_WLR + al((size_t)NL * A_W * 448 * 2);
constexpr size_t WS_Y = WS_G + al((size_t)T * A_W * 4);
constexpr size_t WS_QA = WS_Y + al((size_t)2 * T * A_W * 4);
constexpr size_t WS_KVA = WS_QA + al((size_t)T * 1024 * 2);
constexpr size_t WS_KPE = WS_KVA + al((size_t)T * 512 * 2);
constexpr size_t WS_QRAW = WS_KPE + al((size_t)T * 64 * 2);
constexpr size_t WS_KVRAW = WS_QRAW + al((size_t)T * NQ * 2);
constexpr size_t WS_QF = WS_KVRAW + al((size_t)T * NKV * 2);
constexpr size_t WS_KF = WS_QF + al((size_t)T * NQ * 2);
constexpr size_t WS_H3 = WS_KF + al((size_t)T * NQ * 2);
constexpr size_t WS_HSCR = WS_H3 + al((size_t)NL * T * 64 * 4);
constexpr int HT_STRIDE = 17 * 512;
constexpr size_t WS_HTN = WS_HSCR + (size_t)640 * HT_STRIDE * 16;
constexpr size_t WS_FR = WS_HSCR + al((size_t)640 * HT_STRIDE * 16 + 640 * 8);
constexpr size_t WS_GT = WS_FR + al((size_t)40 * 528 * (14 * 1024));
constexpr size_t WS_X0T = WS_GT + al((size_t)1280 * T * 4);
constexpr size_t WS_SLAB = WS_FR;
constexpr size_t WS_WB = WS_X0T + al((size_t)1280 * T * 4);
constexpr size_t W_G1 = 0, W_D1 = W_G1 + (size_t)2 * FF * DM, W_IN = W_D1 + (size_t)DM * FF, W_OUT = W_IN + (size_t)PXW * DM, W_G2 = W_OUT + (size_t)DM * DM,
                 W_D2 = W_G2 + (size_t)2 * FF * DM, W_Q = W_D2 + (size_t)DM * FF, W_KV = W_Q + (size_t)NQ * 1024, W_LAYER = W_KV + (size_t)NKV * 512;
constexpr size_t WS_END = WS_WB + al(W_LAYER * NL * 2);
constexpr int CW_BAR = 4096;
constexpr int CW_QUEUE = 8192;

constexpr int LDS_MISC = 143360, LDS_BYTES = 147456;

__device__ __forceinline__ float wave_sum(float v) {
#pragma unroll
    for (int o = 1; o < 64; o <<= 1) v += __shfl_xor(v, o);
    return v;
}
__device__ __forceinline__ float wave_sum16(const float (&x)[16], int lane) {
    const bool b5 = (lane & 32) != 0, b4 = (lane & 16) != 0, b3 = (lane & 8) != 0, b2 = (lane & 4) != 0;
    float k8[8], k4[4], k2[2];
#pragma unroll
    for (int i = 0; i < 8; ++i) k8[i] = (b5 ? x[8 + i] : x[i]) + __shfl_xor(b5 ? x[i] : x[8 + i], 32);
#pragma unroll
    for (int i = 0; i < 4; ++i) k4[i] = (b4 ? k8[4 + i] : k8[i]) + __shfl_xor(b4 ? k8[i] : k8[4 + i], 16);
#pragma unroll
    for (int i = 0; i < 2; ++i) k2[i] = (b3 ? k4[2 + i] : k4[i]) + __shfl_xor(b3 ? k4[i] : k4[2 + i], 8);
    float k1 = (b2 ? k2[1] : k2[0]) + __shfl_xor(b2 ? k2[0] : k2[1], 4);
    k1 += __shfl_xor(k1, 1); k1 += __shfl_xor(k1, 2);
    return k1;
}
typedef __bf16 bf16x2_t __attribute__((ext_vector_type(2)));
__device__ __forceinline__ unsigned cvt_pk_bf16(float lo, float hi) { const f32x2 v = {lo, hi}; return __builtin_bit_cast(unsigned, __builtin_convertvector(v, bf16x2_t)); }
__device__ __forceinline__ float bf2f(unsigned short b) { return __uint_as_float(((unsigned)b) << 16); }
__device__ __forceinline__ f32x4 bf4f(u32x2 w) { return (f32x4){__uint_as_float(w.x << 16), __uint_as_float(w.x & 0xffff0000u), __uint_as_float(w.y << 16), __uint_as_float(w.y & 0xffff0000u)}; }
__device__ __forceinline__ float sigmoidf_(float x) { return 1.0f / (1.0f + __expf(-x)); }
__device__ __forceinline__ float siluf_(float x) { return x / (1.0f + __expf(-x)); }
__device__ __forceinline__ bool has_left(int tau) { return tau != 0 && tau != NCTX; }
__device__ __forceinline__ bool has_right(int tau) { return tau != NCTX - 1 && tau != T - 1; }

struct Args { const float* in[46]; float* out; unsigned char* ws; int ph_lo, ph_hi; };
struct Frame { LAS unsigned char* lds; volatile LAS unsigned* MISC; int tid, lane, wave, bid, G; };
constexpr int LDS_PTAB = LDS_MISC + 2048;
__device__ __forceinline__ const float* inp(const Frame& F, int i) {
    const volatile LAS unsigned* p = (const volatile LAS unsigned*)(F.lds + LDS_PTAB) + 2 * i;
    const unsigned lo = __builtin_amdgcn_readfirstlane(p[0]), hi = __builtin_amdgcn_readfirstlane(p[1]);
    return (const float*)(((unsigned long long)hi << 32) | lo);
}
#define IN_(i) inp(F, (i))
__device__ __forceinline__ Frame opq(const Frame& F) { Frame G = F; asm volatile("" : "+v"(G.tid), "+s"(G.wave), "+s"(G.bid)); G.lane = G.tid & 63; return G; }
__device__ __forceinline__ unsigned char* opq_ptr(unsigned char* p) { asm volatile("" : "+s"(p)); return p; }
#ifndef MK_REP
#define MK_REP 0
#endif
#ifndef MK_ONLYRP
#define MK_ONLYRP 0
#endif
#define REP(x) (1 + (((MK_REP) >> (x)) & 1))
#define XB_TMO      128
#define XB_XCNT(j)  (256  + 64 * (j))
#define XB_XSUB(j)  (1280 + 64 * (j))
#define XB_XGEN(j)  (2304 + 64 * (j))
#define XB_TOP      3328
#define XB_TOPGEN   3392
#define XCD_BAR_WORDS 3456
#define XB_SPIN_CAP (1u << 18)

__device__ __forceinline__ unsigned xb_ld(unsigned* p)              { return __hip_atomic_load(p, __ATOMIC_RELAXED, __HIP_MEMORY_SCOPE_AGENT); }
__device__ __forceinline__ unsigned xb_add(unsigned* p, unsigned v) { return __hip_atomic_fetch_add(p, v, __ATOMIC_RELAXED, __HIP_MEMORY_SCOPE_AGENT); }
__device__ __forceinline__ unsigned xb_xcc_id() { return (unsigned)__builtin_amdgcn_s_getreg((3 << 11) | 20) & 0xFu; }
#define XB_SPIN(cond, bar) do { unsigned _sp = 0; while (cond) { __builtin_amdgcn_s_sleep(1); \
    if ((++_sp & 255u) == 0u) { if (xb_ld(&(bar)[XB_TMO])) break; if (_sp > XB_SPIN_CAP) { atomicAdd(&(bar)[XB_TMO], 1u); break; } } } } while (0)

struct XcdBarrier {
    unsigned* bar; unsigned x;
    volatile LAS unsigned* st;
};

__device__ __forceinline__ XcdBarrier xcd_barrier_post(unsigned* bar, volatile LAS unsigned* st) {
    XcdBarrier b; b.bar = bar; b.x = xb_xcc_id(); b.st = st;
    if (threadIdx.x == 0) (void)xb_add(&bar[XB_XCNT(b.x)], 1u);
    return b;
}
__device__ __forceinline__ void xcd_barrier_complete(unsigned* bar, unsigned x, unsigned& nloc, unsigned& nx) {
    const unsigned G = gridDim.x * gridDim.y * gridDim.z;
    unsigned sum, cnt, mine, sp = 0u;
    for (;;) {
        sum = 0u; cnt = 0u; mine = 0u;
#pragma unroll
        for (unsigned j = 0; j < 16; ++j) { const unsigned c = xb_ld(&bar[XB_XCNT(j)]); sum += c; cnt += (c > 0u) ? 1u : 0u; mine = (j == x) ? c : mine; }
        if (sum == G) break;
        __builtin_amdgcn_s_sleep(1);
        if ((++sp & 255u) == 0u) { if (xb_ld(&bar[XB_TMO])) break; if (sp > XB_SPIN_CAP) { atomicAdd(&bar[XB_TMO], 1u); break; } }
    }
    nloc = mine > 0u ? mine : 1u; nx = cnt > 0u ? cnt : 1u;
}

__device__ __forceinline__ void xcd_barrier(const XcdBarrier& b) {
    asm volatile("s_waitcnt vmcnt(0)" ::: "memory");
    __syncthreads();
    if (threadIdx.x == 0) {
        unsigned* bar = b.bar;
        __builtin_amdgcn_s_waitcnt(0);
        unsigned nloc = b.st[0], nx = b.st[1];
        if (nloc == 0u) { xcd_barrier_complete(bar, b.x, nloc, nx); b.st[0] = nloc; b.st[1] = nx; }
        const unsigned old = xb_add(&bar[XB_XSUB(b.x)], 1u);
        const unsigned gen = old / nloc;
        if (old + 1u == (gen + 1u) * nloc) {
            __builtin_amdgcn_fence(__ATOMIC_RELEASE, "agent");
            asm volatile("s_waitcnt vmcnt(0)" ::: "memory");
            const unsigned og = xb_add(&bar[XB_TOP], 1u);
            const unsigned tg = og / nx;
            if (og + 1u == (tg + 1u) * nx) xb_add(&bar[XB_TOPGEN], 1u);
            else XB_SPIN(xb_ld(&bar[XB_TOPGEN]) == tg, bar);
            __builtin_amdgcn_fence(__ATOMIC_ACQUIRE, "agent");
            xb_add(&bar[XB_XGEN(b.x)], 1u);
            asm volatile("s_waitcnt vmcnt(0)" ::: "memory");
        } else {
            XB_SPIN(xb_ld(&bar[XB_XGEN(b.x)]) == gen, bar);
            __builtin_amdgcn_fence(__ATOMIC_ACQUIRE, "agent");
            asm volatile("s_waitcnt vmcnt(0)" ::: "memory");
        }
    }
    __syncthreads();
}
namespace pg8 {
#define PG8_LAS __attribute__((address_space(3)))
typedef unsigned short bf16_t;
typedef short bf16x8 __attribute__((ext_vector_type(8)));
typedef float f32x4 __attribute__((ext_vector_type(4)));
typedef unsigned u32x4 __attribute__((ext_vector_type(4)));
constexpr int BM = 256, BK = 64, HALF = 128, HTB = HALF * BK * 2  , STAGE_BYTES = 8 * HTB, NXCD = 8, WGM = 4;

__host__ __device__ __forceinline__ int lds_byte(int r, int c) { const int st = (r >> 4) * 2 + (c >> 5), rr = r & 15, cc = c & 31, ob = rr * 64 + cc * 2; return st * 1024 + (ob ^ (((ob >> 9) & 1) << 5)); }
__host__ __device__ __forceinline__ void stage_rc(int b, int& R, int& C) { const int st = b / 1024, sb = b % 1024, swz = sb ^ (((sb >> 9) & 1) << 5); R = (st >> 1) * 16 + swz / 64; C = (st & 1) * 32 + (swz % 64) / 2; }
__host__ __device__ __forceinline__ int perm32(int rho) { const int n = rho >> 4, i = rho & 15; return 8 * (i >> 2) + 4 * n + (i & 3); }

struct Unit { int pm, pn; };
struct Gemm { const bf16_t* A; const bf16_t* Bt; int M, N, K, ld; };

struct StaticOrder {
    int nM, nN, nwg, G, c;
    __host__ __device__ void init(int M, int N, int G_, int c_) { nM = M / BM; nN = N / BM; nwg = nM * nN; G = G_; c = c_; }
    __host__ __device__ bool next(int i, Unit& u) const {
        const long L = (long)i * G + c; if (L >= nwg) return false;
        int wgid = (int)L; { const int q = nwg / NXCD, r = nwg % NXCD, xcd = wgid % NXCD, off = wgid / NXCD; wgid = (xcd < r ? xcd * (q + 1) : r * (q + 1) + (xcd - r) * q) + off; }
        const int nig = WGM * nN, gid = wgid / nig, fm = gid * WGM, gsz = (nM - fm) < WGM ? (nM - fm) : WGM;
        u.pm = fm + ((wgid % nig) % gsz); u.pn = (wgid % nig) / gsz; return true;
    }
    __device__ __forceinline__ void a_ready(const Unit&) const {}
    __device__ __forceinline__ void done(const Unit&) const {}
};
struct CountedOrder : StaticOrder {
    const unsigned* ready; unsigned need; unsigned* tmo;
    __device__ __forceinline__ void a_ready(const Unit& u) const {
        if (threadIdx.x < 64) {
            const unsigned long long t0 = __builtin_amdgcn_s_memrealtime(); unsigned polls = 0;
            while ((unsigned)__builtin_amdgcn_readfirstlane(__hip_atomic_load(ready + 64 * u.pm, __ATOMIC_RELAXED, __HIP_MEMORY_SCOPE_AGENT)) < need) {
                if ((++polls & 255u) == 0u && __builtin_amdgcn_readfirstlane(__hip_atomic_load(tmo, __ATOMIC_RELAXED, __HIP_MEMORY_SCOPE_AGENT)) != 0u) break;
                if (__builtin_amdgcn_s_memrealtime() - t0 > 2000000ull) {
                    if (threadIdx.x == 0) { unsigned expect = 0u; __hip_atomic_compare_exchange_strong(tmo + 1, &expect, 0x600u | (unsigned)(u.pm & 0xff), __ATOMIC_RELAXED, __ATOMIC_RELAXED, __HIP_MEMORY_SCOPE_AGENT); __hip_atomic_store(tmo, 1u, __ATOMIC_RELAXED, __HIP_MEMORY_SCOPE_AGENT); }
                    break; }
                __builtin_amdgcn_s_sleep(2); }
            __builtin_amdgcn_fence(__ATOMIC_ACQUIRE, "agent");
            asm volatile("s_waitcnt vmcnt(0)" ::: "memory");
        }
#if !defined(BROKEN_HOOK_NO_BARRIER)
        asm volatile("" ::: "memory"); __builtin_amdgcn_s_barrier(); asm volatile("" ::: "memory");
#endif
    }
};

__device__ __forceinline__ unsigned cvt_pk_bf16(float lo, float hi) { unsigned r; asm volatile("v_cvt_pk_bf16_f32 %0, %1, %2" : "=v"(r) : "v"(lo), "v"(hi)); return r; }
typedef float f32x2 __attribute__((ext_vector_type(2)));
__device__ __forceinline__ f32x2 gelu_pk(f32x2 v) {
    const f32x2 av = __builtin_elementwise_abs(v), d = av * 0.2316418882f + 1.0f;
    f32x2 t; t.x = __builtin_amdgcn_rcpf(d.x); t.y = __builtin_amdgcn_rcpf(d.y);
    f32x2 q = t * 0.5307027145f + (-0.7265760135f); q = q * t + 0.7107068705f; q = q * t + (-0.142248368f); q = q * t + 0.127414796f; q = q * t;
    const f32x2 s = (v * v) * (-0.72134752044f);
    f32x2 e; e.x = __builtin_amdgcn_exp2f(s.x); e.y = __builtin_amdgcn_exp2f(s.y);
    const f32x2 m = v * (q * e), r = v - m;
    f32x2 o; o.x = v.x < 0.f ? m.x : r.x; o.y = v.y < 0.f ? m.y : r.y; return o;
}

struct EpiF32 {
    static constexpr bool PERM = false, AFTER_DRAIN = false;
    float* C; int ldc; const float* bias;
    __device__ __forceinline__ void operator()(const f32x4 (&acc)[2][2][4][2], const Unit& u, int wr, int wc, int fr, int fq) const {
        const int row0 = u.pm * BM + wr * 64 + fr, col0 = u.pn * BM + wc * 32 + 4 * fq;
        f32x4 bv[2][2];
#pragma unroll
        for (int bj = 0; bj < 2; ++bj)
#pragma unroll
            for (int n = 0; n < 2; ++n) bv[bj][n] = bias ? *(const f32x4*)(bias + col0 + bj * HALF + n * 16) : (f32x4){0.f, 0.f, 0.f, 0.f};
#pragma unroll
        for (int ai = 0; ai < 2; ++ai)
#pragma unroll
            for (int m = 0; m < 4; ++m) { float* rowp = C + (size_t)(row0 + ai * HALF + m * 16) * ldc + col0;
#pragma unroll
                for (int bj = 0; bj < 2; ++bj)
#pragma unroll
                    for (int n = 0; n < 2; ++n) *(f32x4*)(rowp + bj * HALF + n * 16) = acc[ai][bj][m][n] + bv[bj][n]; }
    }
};
template <int ACT  > struct EpiBf16 {
    static constexpr bool PERM = true, AFTER_DRAIN = false;
    bf16_t* O; int ldc; const float* bias; int split_cols; size_t split_stride;
    __device__ __forceinline__ void operator()(const f32x4 (&acc)[2][2][4][2], const Unit& u, int wr, int wc, int fr, int fq) const {
        const int row0 = u.pm * BM + wr * 64 + fr; int colt = u.pn * BM; bf16_t* base = O;
        if (split_cols) { const int t = colt / split_cols; base += (size_t)t * split_stride; colt -= t * split_cols; }
        const int col0 = colt + wc * 32 + 8 * fq, bcol0 = u.pn * BM + wc * 32 + 8 * fq;
        f32x4 bv[2][2];
#pragma unroll
        for (int bj = 0; bj < 2; ++bj)
#pragma unroll
            for (int n = 0; n < 2; ++n) bv[bj][n] = bias ? *(const f32x4*)(bias + bcol0 + bj * HALF + 4 * n) : (f32x4){0.f, 0.f, 0.f, 0.f};
#pragma unroll
        for (int ai = 0; ai < 2; ++ai)
#pragma unroll
            for (int m = 0; m < 4; ++m) { bf16_t* rowp = base + (size_t)(row0 + ai * HALF + m * 16) * ldc + col0;
#pragma unroll
                for (int bj = 0; bj < 2; ++bj) { f32x4 v0 = acc[ai][bj][m][0] + bv[bj][0], v1 = acc[ai][bj][m][1] + bv[bj][1];
                    if (ACT == 1) { f32x2 a = gelu_pk((f32x2){v0[0], v0[1]}), b = gelu_pk((f32x2){v0[2], v0[3]}), c = gelu_pk((f32x2){v1[0], v1[1]}), d = gelu_pk((f32x2){v1[2], v1[3]});
                        v0 = (f32x4){a.x, a.y, b.x, b.y}; v1 = (f32x4){c.x, c.y, d.x, d.y}; }
                    if (ACT == 2) {
#pragma unroll
                        for (int j = 0; j < 4; ++j) { v0[j] = 0.5f * v0[j] * (1.0f + erff(v0[j] * 0.70710678f)); v1[j] = 0.5f * v1[j] * (1.0f + erff(v1[j] * 0.70710678f)); } }
                    u32x4 w; w.x = cvt_pk_bf16(v0[0], v0[1]); w.y = cvt_pk_bf16(v0[2], v0[3]); w.z = cvt_pk_bf16(v1[0], v1[1]); w.w = cvt_pk_bf16(v1[2], v1[3]);
                    *(u32x4*)(rowp + bj * HALF) = w; } }
    }
};
}
namespace pg8 {
struct EpiSwiGLU {
    static constexpr bool PERM = true, AFTER_DRAIN = false;
    bf16_t* O; int ldc;
    __device__ __forceinline__ void operator()(const f32x4 (&acc)[2][2][4][2], const Unit& u, int wr, int wc, int fr, int fq) const {
        const int row0 = u.pm * BM + wr * 64 + fr, col0 = u.pn * HALF + wc * 32 + 8 * fq;
#pragma unroll
        for (int ai = 0; ai < 2; ++ai)
#pragma unroll
            for (int m = 0; m < 4; ++m) { bf16_t* rowp = O + (size_t)(row0 + ai * HALF + m * 16) * ldc + col0;
                float h[8];
#pragma unroll
                for (int n = 0; n < 2; ++n)
#pragma unroll
                    for (int j = 0; j < 4; ++j) { const float g = acc[ai][0][m][n][j], up = acc[ai][1][m][n][j]; h[n * 4 + j] = g * __builtin_amdgcn_rcpf(1.0f + __builtin_amdgcn_exp2f(-1.4426950408889634f * g)) * up; }
                u32x4 w; w.x = cvt_pk_bf16(h[0], h[1]); w.y = cvt_pk_bf16(h[2], h[3]); w.z = cvt_pk_bf16(h[4], h[5]); w.w = cvt_pk_bf16(h[6], h[7]);
                *(u32x4*)rowp = w; }
    }
};
struct EpiResid {
    static constexpr bool PERM = false, AFTER_DRAIN = false;
    float* X; const float* gate_x; const float* gate_c; float fac; float* out_x; const float* src_x;
    __device__ __forceinline__ void operator()(const f32x4 (&acc)[2][2][4][2], const Unit& u, int wr, int wc, int fr, int fq) const {
        const int row0 = u.pm * BM + wr * 64 + fr, col0 = u.pn * BM + wc * 32 + 4 * fq;
        const float* gv = (u.pm == 0) ? gate_c : gate_x;
        float* dst = (u.pm != 0 && out_x) ? out_x - (size_t)256 * 4096 : X; const float* src = (u.pm != 0 && src_x) ? src_x - (size_t)256 * 4096 : X;
        f32x4 gg[2][2];
#pragma unroll
        for (int bj = 0; bj < 2; ++bj)
#pragma unroll
            for (int n = 0; n < 2; ++n) gg[bj][n] = *(const f32x4*)(gv + col0 + bj * HALF + n * 16) * fac;
#pragma unroll
        for (int ai = 0; ai < 2; ++ai)
#pragma unroll
            for (int m = 0; m < 4; ++m) { const size_t off = (size_t)(row0 + ai * HALF + m * 16) * 4096 + col0;
#pragma unroll
                for (int bj = 0; bj < 2; ++bj)
#pragma unroll
                    for (int n = 0; n < 2; ++n) { const f32x4 b = *(const f32x4*)(src + off + bj * HALF + n * 16); *(f32x4*)(dst + off + bj * HALF + n * 16) = b + gg[bj][n] * acc[ai][bj][m][n]; } }
    }
};
struct OneUnit { int pn;
    __host__ __device__ bool next(int i, Unit& u) const { u.pm = 0; u.pn = pn; return i == 0; }
    __device__ __forceinline__ void a_ready(const Unit&) const {}
    __device__ __forceinline__ void done(const Unit&) const {}
};
struct StaticOrderX { StaticOrder b;
    __host__ __device__ void init(int M, int N, int G_, int c_) { b.init(M - BM, N, G_, c_); }
    __host__ __device__ bool next(int i, Unit& u) const { const bool ok = b.next(i, u); u.pm += 1; return ok; }
    __device__ __forceinline__ void a_ready(const Unit&) const {}
    __device__ __forceinline__ void done(const Unit&) const {}
};
}
namespace pg8 {
template <class Epi, class Sched, bool STAMP = false>
__device__ __forceinline__ void gemm_phase(PG8_LAS unsigned char* lds, const Gemm g, const Sched& S, const Epi& E, unsigned long long* stamps) {
    int tid_ = threadIdx.x; asm volatile("" : "+v"(tid_));
    const int tid = tid_, wid = __builtin_amdgcn_readfirstlane(tid >> 6), lane = tid & 63, wr = wid >> 2, wc = wid & 3, fr = lane & 15, fq = lane >> 4;
    const int K = g.ld, nt = g.K / BK;
    int ts_lo = 0, ts_hi = 0, nts = 0; const unsigned long long rt_entry = STAMP ? (unsigned long long)wall_clock64() : 0ull;
#define PG8_STAMP() do { if (STAMP && wid == 0 && nts < 64) { const unsigned long long _c = (unsigned long long)clock64(); \
        ts_lo = (lane == nts) ? (int)(unsigned)_c : ts_lo; ts_hi = (lane == nts) ? (int)(unsigned)(_c >> 32) : ts_hi; ++nts; } } while (0)
    PG8_STAMP();
    unsigned voffA[2], voffB[2];
#pragma unroll
    for (int i = 0; i < 2; ++i) { int R, C; stage_rc(tid * 16 + i * 8192, R, C); const int Rb = Epi::PERM ? ((R & ~31) + perm32(R & 31)) : R;
        voffA[i] = (unsigned)(R * K + C) * 2u; voffB[i] = (unsigned)(Rb * K + C) * 2u; }
    const size_t kstep = (size_t)(BK * 2);
    const size_t hstep = (size_t)HALF * K * 2;
    const size_t tstep = 2 * hstep;
    const unsigned ldsw = (unsigned)wid * 1024u;
    const int aoff = lds_byte(wr * 64 + fr, fq * 8), boff = lds_byte(wc * 32 + fr, fq * 8);
#define PG8_SA(b, h) (((b) * 2 + (h)) * HTB)
#define PG8_SB(b, h) ((4 + (b) * 2 + (h)) * HTB)
#define PG8_STAGE(bufoff, gbase, voff) do { _Pragma("unroll") for (int _i = 0; _i < 2; ++_i) \
        __builtin_amdgcn_global_load_lds((const unsigned*)((const char*)(gbase) + (voff)[_i]), (PG8_LAS unsigned*)(lds + (bufoff) + ldsw + _i * 8192), 16, 0, 0); } while (0)
#define PG8_LDA(dst, b, h) do { _Pragma("unroll") for (int m = 0; m < 4; ++m) _Pragma("unroll") for (int k = 0; k < 2; ++k) dst[m][k] = *(const PG8_LAS bf16x8*)(lds + PG8_SA(b, h) + aoff + m * 2048 + k * 1024); } while (0)
#define PG8_LDB(dst, b, h) do { _Pragma("unroll") for (int n = 0; n < 2; ++n) _Pragma("unroll") for (int k = 0; k < 2; ++k) dst[n][k] = *(const PG8_LAS bf16x8*)(lds + PG8_SB(b, h) + boff + n * 2048 + k * 1024); } while (0)
#define PG8_MMA(ai, bj, At, Bt) do { __builtin_amdgcn_s_setprio(1); _Pragma("unroll") for (int m = 0; m < 4; ++m) _Pragma("unroll") for (int n = 0; n < 2; ++n) _Pragma("unroll") for (int k = 0; k < 2; ++k) \
        acc[ai][bj][m][n] = __builtin_amdgcn_mfma_f32_16x16x32_bf16(Bt[n][k], At[m][k], acc[ai][bj][m][n], 0, 0, 0); __builtin_amdgcn_s_setprio(0); } while (0)
#define PG8_WAIT_V(n) asm volatile("s_waitcnt vmcnt(" #n ")" ::: "memory")
#define PG8_WAIT_L(n) asm volatile("s_waitcnt lgkmcnt(" #n ")" ::: "memory")
#define PG8_BAR __builtin_amdgcn_s_barrier()
#define PG8_SCHED __builtin_amdgcn_sched_barrier(0)
    Unit cur, nxt; int ui = 0;
    if (!S.next(0, cur)) return;
    f32x4 acc[2][2][4][2];
#pragma unroll
    for (int a = 0; a < 2; ++a)
#pragma unroll
        for (int b = 0; b < 2; ++b)
#pragma unroll
            for (int m = 0; m < 4; ++m)
#pragma unroll
                for (int n = 0; n < 2; ++n) acc[a][b][m][n] = (f32x4){0.f, 0.f, 0.f, 0.f};
    bf16x8 At[4][2], B0[2][2], B1[2][2];
    const char* cA = (const char*)g.A + (size_t)cur.pm * tstep; const char* cB = (const char*)g.Bt + (size_t)cur.pn * tstep;
    S.a_ready(cur);
    PG8_STAGE(PG8_SB(0, 0), cB, voffB); PG8_STAGE(PG8_SA(0, 0), cA, voffA); PG8_STAGE(PG8_SB(0, 1), cB + hstep, voffB); PG8_STAGE(PG8_SA(0, 1), cA + hstep, voffA);
    if (wr == 1) PG8_BAR;
    PG8_WAIT_V(4); PG8_BAR;
    PG8_STAGE(PG8_SB(1, 0), cB + kstep, voffB); PG8_STAGE(PG8_SA(1, 0), cA + kstep, voffA); PG8_STAGE(PG8_SB(1, 1), cB + hstep + kstep, voffB);
    PG8_WAIT_V(6); PG8_BAR;
    PG8_STAMP();
    for (;;) {
        const bool has_next = S.next(ui + 1, nxt);
        const char* nA = has_next ? (const char*)g.A + (size_t)nxt.pm * tstep : cA; const char* nB = has_next ? (const char*)g.Bt + (size_t)nxt.pn * tstep : cB;
        for (int t = 0; t < nt; t += 2) {
            const bool last = (t == nt - 2);
            const char* a1 = cA + (size_t)(t + 1) * kstep;
            const char* a2 = last ? nA : cA + (size_t)(t + 2) * kstep; const char* b2 = last ? nB : cB + (size_t)(t + 2) * kstep;
            const char* a3 = a2 + kstep; const char* b3 = b2 + kstep;
            if (last && has_next) S.a_ready(nxt);
            PG8_LDB(B0, 0, 0); PG8_SCHED; PG8_LDA(At, 0, 0); PG8_STAGE(PG8_SA(1, 1), a1 + hstep, voffA);
            PG8_WAIT_L(8); PG8_BAR; PG8_WAIT_L(0); PG8_MMA(0, 0, At, B0); PG8_BAR; PG8_SCHED;
            PG8_LDB(B1, 0, 1); PG8_STAGE(PG8_SB(0, 0), b2, voffB);
            PG8_BAR; PG8_WAIT_L(0); PG8_MMA(0, 1, At, B1); PG8_BAR;
            PG8_LDA(At, 0, 1); PG8_STAGE(PG8_SA(0, 0), a2, voffA);
            PG8_BAR; PG8_WAIT_L(0); PG8_MMA(1, 0, At, B0); PG8_BAR; PG8_SCHED;
            PG8_STAGE(PG8_SB(0, 1), b2 + hstep, voffB);
            PG8_WAIT_V(6); PG8_BAR; PG8_MMA(1, 1, At, B1); PG8_BAR;
            PG8_LDB(B0, 1, 0); PG8_SCHED; PG8_LDA(At, 1, 0); PG8_STAGE(PG8_SA(0, 1), a2 + hstep, voffA);
            PG8_WAIT_L(8); PG8_BAR; PG8_WAIT_L(0); PG8_MMA(0, 0, At, B0); PG8_BAR; PG8_SCHED;
            PG8_LDB(B1, 1, 1); PG8_STAGE(PG8_SB(1, 0), b3, voffB);
            PG8_BAR; PG8_WAIT_L(0); PG8_MMA(0, 1, At, B1); PG8_BAR;
            PG8_LDA(At, 1, 1); PG8_STAGE(PG8_SA(1, 0), a3, voffA);
            PG8_BAR; PG8_WAIT_L(0); PG8_MMA(1, 0, At, B0); PG8_BAR; PG8_SCHED;
            PG8_STAGE(PG8_SB(1, 1), b3 + hstep, voffB);
            PG8_WAIT_V(6); PG8_BAR; PG8_MMA(1, 1, At, B1); PG8_BAR;
        }
        PG8_STAMP();
        if constexpr (!Epi::AFTER_DRAIN) { E(acc, cur, wr, wc, fr, fq); S.done(cur); }
        PG8_STAMP();
        if (!has_next) break;
#pragma unroll
        for (int a = 0; a < 2; ++a)
#pragma unroll
            for (int b = 0; b < 2; ++b)
#pragma unroll
                for (int m = 0; m < 4; ++m)
#pragma unroll
                    for (int n = 0; n < 2; ++n) acc[a][b][m][n] = (f32x4){0.f, 0.f, 0.f, 0.f};
        cur = nxt; cA = nA; cB = nB; ++ui;
    }
    PG8_WAIT_V(0);
    if (wr == 0) PG8_BAR;
    PG8_BAR;
    if constexpr (Epi::AFTER_DRAIN) { E.fused(acc, cur, wr, wc, fr, fq, lds, wid, lane); S.done(cur); }
    PG8_STAMP();
    if (STAMP && wid == 0) { stamps[lane] = lane < nts ? (((unsigned long long)(unsigned)ts_hi << 32) | (unsigned)ts_lo) : 0ull;
        if (lane == 62) stamps[62] = rt_entry; if (lane == 63) stamps[63] = (unsigned long long)wall_clock64(); }
#undef PG8_STAMP
#undef PG8_SA
#undef PG8_SB
#undef PG8_STAGE
#undef PG8_LDA
#undef PG8_LDB
#undef PG8_MMA
#undef PG8_WAIT_V
#undef PG8_WAIT_L
#undef PG8_BAR
#undef PG8_SCHED
}
}
#define LDS_WAIT() asm volatile("s_waitcnt lgkmcnt(0)" ::: "memory")

__device__ __forceinline__ int map_row(int n, int mode) {
    if (mode == 1) { const int j = n < FF ? n : n - FF; return (j >> 7) * 256 + (n < FF ? 0 : 128) + (j & 127); }
    return n;
}
__device__ __forceinline__ void transpose_item(const float* __restrict__ W, int K, int N, bf16_t* WT, int mode, LAS float* scr, int item, int lane) {
    const int nblk = N / 32, kb = item / nblk, nb = item % nblk, k0 = 64 * kb, n0 = 32 * nb;
#pragma unroll
    for (int i = 0; i < 32; ++i) { const int kk = 2 * i + (lane >> 5); scr[kk * 33 + (lane & 31)] = W[(size_t)(k0 + kk) * N + n0 + (lane & 31)]; }
    LDS_WAIT(); asm volatile("" ::: "memory");
    const int c = lane & 7;
#pragma unroll
    for (int j = 0; j < 4; ++j) { const int n = (lane >> 3) + 8 * j; const LAS float* s = scr + (8 * c) * 33 + n;
        u32x4 o; o.x = cvt_pk_bf16(s[0 * 33], s[1 * 33]); o.y = cvt_pk_bf16(s[2 * 33], s[3 * 33]); o.z = cvt_pk_bf16(s[4 * 33], s[5 * 33]); o.w = cvt_pk_bf16(s[6 * 33], s[7 * 33]);
        *(u32x4*)(WT + (size_t)map_row(n0 + n, mode) * K + k0 + 8 * c) = o; }
    LDS_WAIT(); asm volatile("" ::: "memory");
}
constexpr int I_G = (DM / 64) * (2 * FF / 32), I_D = (FF / 64) * (DM / 32), I_IN = (DM / 64) * (9600 / 32), I_OUT = (DM / 64) * (DM / 32), I_Q = (1024 / 64) * (NQ / 32), I_KV = (512 / 64) * (NKV / 32);
constexpr int I_LAYER = 2 * I_G + 2 * I_D + I_IN + I_OUT + I_Q + I_KV;

__device__ __forceinline__ void phase0(const Frame& F, unsigned char* ws) {
    const int gw = F.bid * 8 + F.wave, NGW = F.G * 8;
    const size_t gt = (size_t)F.bid * 512 + F.tid, NGT = (size_t)F.G * 512;
    LAS float* scr = (LAS float*)(F.lds + F.wave * 8704);
    bf16_t* WB = (bf16_t*)(ws + WS_WB);
    for (int it = gw; it < NL * I_LAYER; it += NGW) {
        const int l = it / I_LAYER; int r = it - l * I_LAYER; bf16_t* wl = WB + (size_t)l * W_LAYER;
        if (r < I_G) { transpose_item(IN_(10) + (size_t)l * DM * 2 * FF, DM, 2 * FF, wl + W_G1, 1, scr, r, F.lane); continue; } r -= I_G;
        if (r < I_D) { transpose_item(IN_(11) + (size_t)l * FF * DM, FF, DM, wl + W_D1, 0, scr, r, F.lane); continue; } r -= I_D;
        if (r < I_G) { transpose_item(IN_(12) + (size_t)l * DM * 2 * FF, DM, 2 * FF, wl + W_G2, 1, scr, r, F.lane); continue; } r -= I_G;
        if (r < I_D) { transpose_item(IN_(13) + (size_t)l * FF * DM, FF, DM, wl + W_D2, 0, scr, r, F.lane); continue; } r -= I_D;
        if (r < I_IN) { transpose_item(IN_(14) + (size_t)l * DM * 9600, DM, 9600, wl + W_IN, 0, scr, r, F.lane); continue; } r -= I_IN;
        if (r < I_OUT) { transpose_item(IN_(15) + (size_t)l * DM * DM, DM, DM, wl + W_OUT, 0, scr, r, F.lane); continue; } r -= I_OUT;
        if (r < I_Q) { transpose_item(IN_(39) + (size_t)l * 1024 * NQ, 1024, NQ, wl + W_Q, 0, scr, r, F.lane); continue; } r -= I_Q;
        transpose_item(IN_(41) + (size_t)l * 512 * NKV, 512, NKV, wl + W_KV, 0, scr, r, F.lane);
    }
    for (size_t i = gt; i < (size_t)NL * 128 * 512; i += NGT) {
        const int l = (int)(i / (128 * 512)), rr = (int)((i / 512) % 128), c = (int)(i % 512);
        const int row = 9600 + rr;
        *(u32x4*)(WB + (size_t)l * W_LAYER + W_IN + (size_t)row * DM + c * 8) = (u32x4){0u, 0u, 0u, 0u};
    }
    { bf16_t* WLR = (bf16_t*)(ws + WS_WLR); const float* wu = IN_(18); const float* au = IN_(20); const float* gu = IN_(21);
      for (size_t i = gt; i < (size_t)NL * 448 * A_W; i += NGT) { const int l = (int)(i / (448 * A_W)), k = (int)((i / A_W) % 448), col = (int)(i % A_W);
          float v;
          if (k < 128) v = wu[(((size_t)l * 2 + (k >> 6)) * 64 + (k & 63)) * A_W + col];
          else if (k < 256) v = au[(((size_t)l * 2 + ((k - 128) >> 6)) * 64 + (k & 63)) * A_W + col];
          else v = gu[((size_t)l * 192 + (k - 256)) * A_W + col];
          WLR[((size_t)l * A_W + col) * 448 + k] = (bf16_t)(cvt_pk_bf16(v, v) & 0xffffu); } }
    { f32x4* xs = (f32x4*)(ws + WS_XS); const f32x4* cx = (const f32x4*)IN_(2);
      for (size_t i = gt; i < (size_t)NCTX * DM / 4; i += NGT) xs[i] = cx[i]; }
    { float* HP = (float*)(ws + WS_HP);
      for (int it = F.bid; it < NL * 16; it += F.G) { const int l = it >> 4, ch = it & 15, w = F.tid >> 8, j = F.tid & 255;
          const float* cv = w ? IN_(3) : IN_(1); const float* ad = IN_(4) + ((size_t)l * DM + ch * 256) * 256 + j; float s = 0.f;
          for (int i = 0; i < 256; ++i) s += siluf_(cv[ch * 256 + i]) * ad[(size_t)i * 256];
          HP[((l * 16 + ch) * 2 + w) * 256 + j] = s; } }
    { float* H3 = (float*)(ws + WS_H3);
      LAS float* zb = (LAS float*)(F.lds + 73728); LAS float* ha = zb + 8 * 36; LAS float* hb = ha + 8 * 64;
      for (int it = F.bid; it < NL * (T / 8); it += F.G) { const int l = it / (T / 8), pb = it % (T / 8);
          if (F.tid < 8 * 33) { const int p = F.tid / 33, i = F.tid % 33, P = pb * 8 + p; const int L = P < NCTX ? NCTX : SEQ, t = P < NCTX ? P : P - NCTX;
              float z;
              if (i == 0) z = (float)t / (float)(L - 1);
              else { const int b = (i - 1) & 15; const float fb = 1e-4f + (float)b * ((15.0f - 1e-4f) / 15.0f); const float rev2 = 2.0f * fb * (float)t / (float)L;
                  z = i <= 16 ? cospif(rev2) : -sinpif(rev2); }
              zb[p * 36 + i] = z; }
          __syncthreads();
          const int p = F.tid >> 6, j = F.tid & 63; const float fq = IN_(36)[l * 64 + j];
          { const float* w1 = IN_(29) + (size_t)l * 33 * 64 + j; float s = IN_(30)[l * 64 + j];
            for (int i = 0; i < 33; ++i) s += zb[p * 36 + i] * w1[i * 64];
            ha[p * 64 + j] = sinf(fq * s); }
          __syncthreads();
          { const float* w2 = IN_(31) + (size_t)l * 64 * 64 + j; float s = IN_(32)[l * 64 + j];
            for (int i = 0; i < 64; ++i) s += ha[p * 64 + i] * w2[i * 64];
            hb[p * 64 + j] = sinf(fq * s); }
          __syncthreads();
          { const float* w3 = IN_(33) + (size_t)l * 64 * 64 + j; float s = IN_(34)[l * 64 + j];
            for (int i = 0; i < 64; ++i) s += hb[p * 64 + i] * w3[i * 64];
            ((bf16_t*)H3)[((size_t)l * 64 + j) * T + pb * 8 + p] = (bf16_t)(cvt_pk_bf16(sinf(fq * s), 0.f) & 0xffffu); }
          __syncthreads(); } }
}
__device__ __forceinline__ void phase_mod(const Frame& F, unsigned char* ws) {
    const float* HP = (const float*)(ws + WS_HP); float* MOD = (float*)(ws + WS_MOD);
    LAS float* hs = (LAS float*)F.lds;
    for (int it = F.bid; it < NL * (NMOD / 512); it += F.G) { const int l = it / (NMOD / 512), nb = it % (NMOD / 512);
        { const int w = F.tid >> 8, j = F.tid & 255; float s = 0.f;
          for (int ch = 0; ch < 16; ++ch) s += HP[((l * 16 + ch) * 2 + w) * 256 + j];
          hs[w * 256 + j] = s; }
        __syncthreads();
        const int n = nb * 512 + F.tid; const float* au = IN_(5) + (size_t)l * 256 * NMOD + n; float s0 = IN_(6)[(size_t)l * NMOD + n], s1 = s0;
        for (int j = 0; j < 256; ++j) { const float u = au[(size_t)j * NMOD]; s0 += hs[j] * u; s1 += hs[256 + j] * u; }
        MOD[((size_t)l * 2 + 0) * NMOD + n] = s0; MOD[((size_t)l * 2 + 1) * NMOD + n] = s1;
        __syncthreads(); }
}
__device__ __forceinline__ void norm_phase(const Frame& F, float* XS, const float* __restrict__ gain, const float* modx, const float* modc, int ish, int isc, bf16_t* out, const bf16_t* slab, const float* sgate, float sfac, const float* XL) {
    const int gw = F.bid * 8 + F.wave, NGW = F.G * 8;
    int row_lo = 0;
    if (slab) { row_lo = NCTX;
        LAS float* red = (LAS float*)F.lds;
        for (int row = F.bid; row < NCTX; row += F.G) { const size_t o = (size_t)row * DM + F.wave * 512;
            f32x4 v[2]; float s = 0.f;
#pragma unroll
            for (int j = 0; j < 2; ++j) { f32x4 acc = (f32x4){0.f, 0.f, 0.f, 0.f};
#pragma unroll
                for (int ks = 0; ks < 16; ++ks) acc += bf4f(((const u32x2*)(slab + (size_t)ks * NCTX * DM + o) + F.lane)[64 * j]);
                v[j] = ((const f32x4*)(XS + o) + F.lane)[64 * j] + acc * ((const f32x4*)(sgate + F.wave * 512) + F.lane)[64 * j] * sfac;
                ((f32x4*)(XS + o) + F.lane)[64 * j] = v[j]; s += (v[j].x * v[j].x + v[j].y * v[j].y) + (v[j].z * v[j].z + v[j].w * v[j].w); }
            s = wave_sum(s); if (F.lane == 0) red[F.wave] = s;
            __syncthreads();
            float tot = 0.f;
#pragma unroll
            for (int w = 0; w < 8; ++w) tot += red[w];
            const float rstd = rsqrtf(tot * (1.0f / DM) + NORM_EPS);
#pragma unroll
            for (int j = 0; j < 2; ++j) { const int c4 = F.wave * 128 + F.lane + 64 * j;
                const f32x4 y = v[j] * rstd * ((const f32x4*)gain)[c4] * (((const f32x4*)(modc + (size_t)isc * DM))[c4] + 1.0f) + ((const f32x4*)(modc + (size_t)ish * DM))[c4];
                u32x2 w2; w2.x = cvt_pk_bf16(y.x, y.y); w2.y = cvt_pk_bf16(y.z, y.w); ((u32x2*)(out + (size_t)row * DM))[c4] = w2; }
            __syncthreads(); } }
    for (int row = row_lo + gw; row < T; row += NGW) {
        const float* mod = row < NCTX ? modc : modx;
        const f32x4* xr = (const f32x4*)((row < NCTX ? (const float*)XS : XL) + (size_t)row * DM) + F.lane; const f32x4* g4 = (const f32x4*)gain + F.lane;
        const f32x4* sh4 = (const f32x4*)(mod + (size_t)ish * DM) + F.lane; const f32x4* sc4 = (const f32x4*)(mod + (size_t)isc * DM) + F.lane;
        f32x4 v[16]; float s = 0.f;
#pragma unroll
        for (int j = 0; j < 16; ++j) { v[j] = xr[64 * j]; s += (v[j].x * v[j].x + v[j].y * v[j].y) + (v[j].z * v[j].z + v[j].w * v[j].w); }
        const float rstd = rsqrtf(wave_sum(s) * (1.0f / DM) + NORM_EPS);
        u32x2* o = (u32x2*)(out + (size_t)row * DM) + F.lane;
#pragma unroll
        for (int j = 0; j < 16; ++j) { const f32x4 y = v[j] * rstd * g4[64 * j] * (sc4[64 * j] + 1.0f) + sh4[64 * j];
            u32x2 w; w.x = cvt_pk_bf16(y.x, y.y); w.y = cvt_pk_bf16(y.z, y.w); o[64 * j] = w; }
    }
}
__device__ __forceinline__ float conv3_at(const bf16_t* PX, int tau, int col, float w0, float w1, float w2) {
    const bf16_t* p = PX + (size_t)tau * PXW + col;
    const bool hl = has_left(tau), hr = has_right(tau);
    return bf2f(p[0]) * w1 + bf2f(p[hl ? -PXW : 0]) * (hl ? w0 : 0.f) + bf2f(p[hr ? PXW : 0]) * (hr ? w2 : 0.f);
}
__device__ __forceinline__ float rope_apply(float val, int tau, int j) {
    const int pos = tau - NCTX, prow = pos >> 6, pcol = pos & 63;
    const float inv = __powf(10000.0f, -(float)(j & 15) * (1.0f / 16.0f));
    const float ang = (float)(j < 32 ? prow : pcol) * inv;
    float sn, cs; sincosf(ang, &sn, &cs);
    const float partner = __shfl_xor(val, 16);
    const float rot = (j & 16) ? partner : -partner;
    return val * cs + rot * sn;
}
__device__ __forceinline__ void mla_prep_phase(const Frame& F, unsigned char* ws, int l) {
    const bf16_t* PX = (const bf16_t*)(ws + WS_PX); bf16_t* QA = (bf16_t*)(ws + WS_QA); bf16_t* KVA = (bf16_t*)(ws + WS_KVA); bf16_t* KPE = (bf16_t*)(ws + WS_KPE);
    const int gw = F.bid * 8 + F.wave, NGW = F.G * 8;
    const f32x4* gq = (const f32x4*)(IN_(38) + l * 1024) + F.lane; const f32x4* gkv = (const f32x4*)(IN_(40) + l * 512) + F.lane; const float gpe = IN_(45)[l * 64 + F.lane];
    for (int tau = gw; tau < T; tau += NGW) {
        const u32x2* p = (const u32x2*)(PX + (size_t)tau * PXW + PXC) + F.lane;
        f32x4 q[4], kv[2]; float sq = 0.f, skv = 0.f;
#pragma unroll
        for (int j = 0; j < 4; ++j) { q[j] = bf4f(p[64 * j]); sq += (q[j].x * q[j].x + q[j].y * q[j].y) + (q[j].z * q[j].z + q[j].w * q[j].w); }
#pragma unroll
        for (int j = 0; j < 2; ++j) { kv[j] = bf4f(p[256 + 64 * j]); skv += (kv[j].x * kv[j].x + kv[j].y * kv[j].y) + (kv[j].z * kv[j].z + kv[j].w * kv[j].w); }
        const float pe = bf2f(PX[(size_t)tau * PXW + PXC + 1536 + F.lane]);
        const float rq = rsqrtf(wave_sum(sq) * (1.0f / 1024.0f) + NORM_EPS), rkv = rsqrtf(wave_sum(skv) * (1.0f / 512.0f) + NORM_EPS), rpe = rsqrtf(wave_sum(pe * pe) * (1.0f / 64.0f) + NORM_EPS);
        u32x2* oq = (u32x2*)(QA + (size_t)tau * 1024) + F.lane; u32x2* okv = (u32x2*)(KVA + (size_t)tau * 512) + F.lane;
#pragma unroll
        for (int j = 0; j < 4; ++j) { const f32x4 y = q[j] * rq * gq[64 * j]; u32x2 w; w.x = cvt_pk_bf16(y.x, y.y); w.y = cvt_pk_bf16(y.z, y.w); oq[64 * j] = w; }
#pragma unroll
        for (int j = 0; j < 2; ++j) { const f32x4 y = kv[j] * rkv * gkv[64 * j]; u32x2 w; w.x = cvt_pk_bf16(y.x, y.y); w.y = cvt_pk_bf16(y.z, y.w); okv[64 * j] = w; }
        float kp = pe * rpe * gpe;
        if (tau >= NCTX) kp = rope_apply(kp, tau, F.lane);
        KPE[(size_t)tau * 64 + F.lane] = (bf16_t)(cvt_pk_bf16(kp, kp) & 0xffffu);
    }
}
__device__ __forceinline__ void qkv_final_phase(const Frame& F, unsigned char* ws, int l, bool need_ctx) {
    const bf16_t* QRAW = (const bf16_t*)(ws + WS_QRAW); const bf16_t* KVRAW = (const bf16_t*)(ws + WS_KVRAW); const bf16_t* KPE = (const bf16_t*)(ws + WS_KPE);
    bf16_t* QF = (bf16_t*)(ws + WS_QF); bf16_t* KF = (bf16_t*)(ws + WS_KF);
    const int gw = F.bid * 8 + F.wave, NGW = F.G * 8, ln = F.lane;
    const float gqn0 = IN_(42)[l * 128 + 2 * ln], gqn1 = IN_(42)[l * 128 + 2 * ln + 1], gqp = IN_(43)[l * 64 + ln];
    const float gkn0 = IN_(44)[l * 128 + 2 * ln], gkn1 = IN_(44)[l * 128 + 2 * ln + 1];
    (void)need_ctx;
    for (int tau = gw; tau < T; tau += NGW) {
        float cs = 1.f, sn = 0.f;
        if (tau >= NCTX) { const int pos = tau - NCTX, prow = pos >> 6, pcol = pos & 63; const float inv = __powf(10000.0f, -(float)(ln & 15) * (1.0f / 16.0f)); sincosf((float)(ln < 32 ? prow : pcol) * inv, &sn, &cs); }
        const bf16_t kpe = KPE[(size_t)tau * 64 + ln];
        const bf16_t* qrow = QRAW + (size_t)tau * NQ; const bf16_t* krow = KVRAW + (size_t)tau * NKV;
        unsigned qn[NHC], kn[NHC]; bf16_t qpv[NHC];
#pragma unroll
        for (int h = 0; h < NHC; ++h) { qn[h] = *(const unsigned*)(qrow + h * 192 + 2 * ln); qpv[h] = qrow[h * 192 + 128 + ln]; kn[h] = *(const unsigned*)(krow + h * 256 + 2 * ln); }
#pragma unroll
        for (int h = 0; h < NHC; ++h) {
            const float q0 = bf2f((unsigned short)(qn[h] & 0xffffu)), q1 = bf2f((unsigned short)(qn[h] >> 16)), qp = bf2f(qpv[h]), k0 = bf2f((unsigned short)(kn[h] & 0xffffu)), k1 = bf2f((unsigned short)(kn[h] >> 16));
            const float rqn = rsqrtf(wave_sum(q0 * q0 + q1 * q1) * (1.0f / 128.0f) + NORM_EPS), rqp = rsqrtf(wave_sum(qp * qp) * (1.0f / 64.0f) + NORM_EPS), rkn = rsqrtf(wave_sum(k0 * k0 + k1 * k1) * (1.0f / 128.0f) + NORM_EPS);
            float qpe = qp * rqp * gqp;
            { const float partner = __shfl_xor(qpe, 16); const float rot = (ln & 16) ? partner : -partner; qpe = qpe * cs + rot * sn; }
            *(unsigned*)(QF + (size_t)tau * NQ + h * 192 + 2 * ln) = cvt_pk_bf16(q0 * rqn * gqn0, q1 * rqn * gqn1);
            QF[(size_t)tau * NQ + h * 192 + 128 + ln] = (bf16_t)(cvt_pk_bf16(qpe, qpe) & 0xffffu);
            *(unsigned*)(KF + (size_t)tau * NQ + h * 192 + 2 * ln) = cvt_pk_bf16(k0 * rkn * gkn0, k1 * rkn * gkn1);
            KF[(size_t)tau * NQ + h * 192 + 128 + ln] = kpe; }
    }
}
__device__ __forceinline__ void rwkv_out_phase(const Frame& F, unsigned char* ws, int l, bool need_ctx) {
    const float* SS = (const float*)(ws + WS_SS); const float* SD = (const float*)(ws + WS_SD); const float* GB = (const float*)(ws + WS_G); const float* Y = (const float*)(ws + WS_Y);
    bf16_t* OB = (bf16_t*)(ws + WS_OBUF);
    const int gw = F.bid * 8 + F.wave, NGW = F.G * 8, ln = F.lane;
    for (int it = (need_ctx ? 0 : NCTX * 5) + gw; it < T * 5; it += NGW) { const int tau = it / 5, h0 = (it % 5) * 4;
        float y0[4], y1[4], v[4], sa[4], sb[4], g[4];
#pragma unroll
        for (int q = 0; q < 4; ++q) { const int h = h0 + q, col = h * 64 + ln; const size_t o = (size_t)tau * A_W + col;
            y0[q] = Y[o]; y1[q] = Y[(size_t)T * A_W + o]; v[q] = SS[(size_t)T * A_W + o];
            sa[q] = SD[(size_t)tau * NHA + h]; sb[q] = SD[((size_t)T + tau) * NHA + h]; g[q] = GB[o]; }
#pragma unroll
        for (int q = 0; q < 4; ++q) { const int col = (h0 + q) * 64 + ln;
            const float y = y0[q] + y1[q];
            const float mu = wave_sum(y) * (1.0f / 64.0f); const float dy = y - mu; const float var = wave_sum(dy * dy) * (1.0f / 64.0f);
            const float yn = dy * rsqrtf(var + GN_EPS) * IN_(25)[l * A_W + col] + IN_(26)[l * A_W + col];
            const float bonus = 0.5f * (sa[q] + sb[q]) * v[q];
            const float ov = (yn + bonus) * g[q];
            OB[(size_t)tau * DM + col] = (bf16_t)(cvt_pk_bf16(ov, ov) & 0xffffu); }
    }
}
__device__ __forceinline__ void hyena_prep_phase(const Frame& F, unsigned char* ws, int l) {
    const bf16_t* PX = (const bf16_t*)(ws + WS_PX); float* GT = (float*)(ws + WS_GT); float* X0T = (float*)(ws + WS_X0T);
    LAS float* LGt = (LAS float*)F.lds; LAS float* LX0 = LGt + 64 * 65;
    const float* cw = IN_(27) + (size_t)l * 3 * B_IN; const float* cb = IN_(28) + (size_t)l * B_IN;
    int it0, istep, iend;
    if (F.bid < 80) { it0 = F.bid * 5; istep = 1; iend = it0 + 5; } else { it0 = 400 + (F.bid - 80); istep = 176; iend = (T / 64) * 20; }
    for (int it = it0; it < iend; it += istep) { const int tt = it / 20, ct = it % 20;
        { const int t = F.tid >> 3, c0 = ct * 64 + (F.tid & 7) * 8, tau = tt * 64 + t;
          f32x4 u[3][2];
#pragma unroll
          for (int grp = 0; grp < 3; ++grp)
#pragma unroll
              for (int q = 0; q < 2; ++q) { const int c = grp * 1280 + c0 + 4 * q; const bf16_t* p = PX + (size_t)tau * PXW + PXB + c;
                  const bool hl = has_left(tau), hr = has_right(tau);
                  const f32x4 y = bf4f(*(const u32x2*)p) * *(const f32x4*)(cw + B_IN + c) + *(const f32x4*)(cb + c) + bf4f(*(const u32x2*)(p - (hl ? PXW : 0))) * (*(const f32x4*)(cw + c) * (hl ? 1.f : 0.f))
                                + bf4f(*(const u32x2*)(p + (hr ? PXW : 0))) * (*(const f32x4*)(cw + 2 * B_IN + c) * (hr ? 1.f : 0.f));
                  u[grp][q] = y; }
#pragma unroll
          for (int q = 0; q < 2; ++q)
#pragma unroll
              for (int e = 0; e < 4; ++e) { const int ch = (F.tid & 7) * 8 + 4 * q + e; LGt[ch * 65 + t] = u[1][q][e] * u[2][q][e]; LX0[ch * 65 + t] = u[0][q][e]; } }
        __syncthreads();
        { const int ch = F.tid >> 3, t0 = (F.tid & 7) * 8; const size_t o = (size_t)(ct * 64 + ch) * T + tt * 64 + t0;
          f32x4 a0, a1, b0, b1;
#pragma unroll
          for (int e = 0; e < 4; ++e) { a0[e] = LGt[ch * 65 + t0 + e]; a1[e] = LGt[ch * 65 + t0 + 4 + e]; b0[e] = LX0[ch * 65 + t0 + e]; b1[e] = LX0[ch * 65 + t0 + 4 + e]; }
          *(f32x4*)(GT + o) = a0; *(f32x4*)(GT + o + 4) = a1; *(f32x4*)(X0T + o) = b0; *(f32x4*)(X0T + o + 4) = b1; }
        __syncthreads(); }
}
__device__ __forceinline__ void hyena_out_phase(const Frame& F, unsigned char* ws, bool need_ctx) {
    const float* YT = (const float*)(ws + WS_GT); bf16_t* OB = (bf16_t*)(ws + WS_OBUF);
    LAS float* L = (LAS float*)F.lds;
    const int it0 = need_ctx ? 0 : (NCTX / 64) * 20;
    for (int it = it0 + F.bid; it < (T / 64) * 20; it += F.G) { const int tt = it / 20, ct = it % 20;
        { const int ch = F.tid >> 3, t0 = (F.tid & 7) * 8; const size_t o = (size_t)(ct * 64 + ch) * T + tt * 64 + t0;
          const f32x4 a0 = *(const f32x4*)(YT + o), a1 = *(const f32x4*)(YT + o + 4);
#pragma unroll
          for (int e = 0; e < 4; ++e) { L[ch * 65 + t0 + e] = a0[e]; L[ch * 65 + t0 + 4 + e] = a1[e]; } }
        __syncthreads();
        { const int t = F.tid >> 3, c0 = (F.tid & 7) * 8; float x[8];
#pragma unroll
          for (int e = 0; e < 8; ++e) x[e] = L[(c0 + e) * 65 + t];
          u32x4 w; w.x = cvt_pk_bf16(x[0], x[1]); w.y = cvt_pk_bf16(x[2], x[3]); w.z = cvt_pk_bf16(x[4], x[5]); w.w = cvt_pk_bf16(x[6], x[7]);
          *(u32x4*)(OB + (size_t)(tt * 64 + t) * DM + 1280 + ct * 64 + c0) = w; }
        __syncthreads(); }
}
namespace att {
constexpr int DK = 192, DV = 128, NW = 8, QBLK = 32, KVBLK = 64;
constexpr float SCALE = 0.07216878364870322f;
constexpr float THR = 8.f;
#ifndef ATT_SDEPTH
#define ATT_SDEPTH 2
#endif
constexpr int SDEPTH = ATT_SDEPTH;
constexpr int LDQ = 2304, LDK = 2304, LDV = 3072, LDO = 4096;
constexpr int SHM_V = KVBLK * DV * 2, SHM_K = KVBLK * DK * 2, SHM_ATTN = 2 * SHM_V + 2 * SHM_K + NW * 64 * 4 + NW * 4096;
using bf16x8 = __attribute__((ext_vector_type(8))) short;
using s16x4  = __attribute__((ext_vector_type(4))) short;
using f32x16 = __attribute__((ext_vector_type(16))) float;
using u32x4  = __attribute__((ext_vector_type(4))) unsigned;
#define KSWZ(row, colB) ((row) * 384 + ((colB) ^ (((row) & 7) << 4)))
#define SBAR() __builtin_amdgcn_sched_barrier(0)
__device__ __forceinline__ int crow(int r, int hi) { return (r & 3) + 8 * (r >> 2) + 4 * hi; }
__device__ __forceinline__ unsigned cvtpk(float lo, float hi) { unsigned r; asm volatile("v_cvt_pk_bf16_f32 %0, %1, %2" : "=v"(r) : "v"(lo), "v"(hi)); return r; }
__device__ __forceinline__ void partialSM(f32x16& p0, f32x16& p1, float& m_reg, float& mn, float& alpha) {
  constexpr float C = SCALE * 1.4426950408889634f;
  float pmax = p0[0]; for (int r = 1; r < 16; ++r) pmax = fmaxf(pmax, p0[r]); for (int r = 0; r < 16; ++r) pmax = fmaxf(pmax, p1[r]);
  { auto rr = __builtin_amdgcn_permlane32_swap(__float_as_uint(pmax), __float_as_uint(pmax), false, false);
    pmax = fmaxf(__uint_as_float(rr[0]), __uint_as_float(rr[1])); }
  if (__builtin_expect(__all(pmax - m_reg <= THR / SCALE), 1)) { mn = m_reg; alpha = 1.f; }
  else { mn = fmaxf(m_reg, pmax); alpha = __builtin_amdgcn_exp2f((m_reg - mn) * C); m_reg = mn; }
  float mnC = -mn * C;
  for (int r = 0; r < 16; ++r) p0[r] = fmaf(p0[r], C, mnC); for (int r = 0; r < 16; ++r) p1[r] = fmaf(p1[r], C, mnC);
  for (int r = 0; r < 16; ++r) p0[r] = __builtin_amdgcn_exp2f(p0[r]);
}
__device__ __forceinline__ void finishSM(f32x16& p0, f32x16& p1, float alpha, float& l_reg, bf16x8& pa0, bf16x8& pa1, bf16x8& pa2, bf16x8& pa3) {
  for (int r = 0; r < 16; ++r) p1[r] = __builtin_amdgcn_exp2f(p1[r]);
  float ps = 0; for (int r = 0; r < 16; ++r) ps += p0[r]; for (int r = 0; r < 16; ++r) ps += p1[r];
  { auto rr = __builtin_amdgcn_permlane32_swap(__float_as_uint(ps), __float_as_uint(ps), false, false);
    ps = __uint_as_float(rr[0]) + __uint_as_float(rr[1]); }
  l_reg = l_reg * alpha + ps;
#define PK4(P, BASE, OUT) do { unsigned a0 = cvtpk(P[BASE + 0], P[BASE + 1]), a1 = cvtpk(P[BASE + 2], P[BASE + 3]);   \
    unsigned b0 = cvtpk(P[BASE + 4], P[BASE + 5]), b1 = cvtpk(P[BASE + 6], P[BASE + 7]);                              \
    auto r0 = __builtin_amdgcn_permlane32_swap(a0, b0, false, false); auto r1 = __builtin_amdgcn_permlane32_swap(a1, b1, false, false); \
    u32x4 w = {r0[0], r1[0], r0[1], r1[1]}; OUT = *reinterpret_cast<bf16x8*>(&w); } while (0)
  PK4(p0, 0, pa0); PK4(p0, 8, pa1); PK4(p1, 0, pa2); PK4(p1, 8, pa3);
#undef PK4
}
__device__ __forceinline__ void qkt(f32x16& p0, f32x16& p1, const char* Ks, const bf16x8* qr, const char* qrl, int r32, int hi) {
  p0 = f32x16{}; p1 = f32x16{};
#pragma unroll
  for (int d0 = 0; d0 < 8; ++d0) { int cb = (d0 * 16 + hi * 8) * 2;
    bf16x8 b0 = *reinterpret_cast<const bf16x8*>(Ks + KSWZ(r32, cb));
    bf16x8 b1 = *reinterpret_cast<const bf16x8*>(Ks + KSWZ(32 + r32, cb));
    p0 = __builtin_amdgcn_mfma_f32_32x32x16_bf16(b0, qr[d0], p0, 0, 0, 0);
    p1 = __builtin_amdgcn_mfma_f32_32x32x16_bf16(b1, qr[d0], p1, 0, 0, 0); }
#pragma unroll
  for (int d0 = 8; d0 < 12; ++d0) { int cb = (d0 * 16 + hi * 8) * 2;
    bf16x8 b0 = *reinterpret_cast<const bf16x8*>(Ks + KSWZ(r32, cb));
    bf16x8 b1 = *reinterpret_cast<const bf16x8*>(Ks + KSWZ(32 + r32, cb));
    const bf16x8 q = *reinterpret_cast<const bf16x8*>(qrl + ((((d0 - 8) * 2 + hi) ^ (r32 & 7)) << 4));
    p0 = __builtin_amdgcn_mfma_f32_32x32x16_bf16(b0, q, p0, 0, 0, 0);
    p1 = __builtin_amdgcn_mfma_f32_32x32x16_bf16(b1, q, p1, 0, 0, 0); }
}
__device__ __forceinline__ int v_st(int k, int c) { const int kk = (k & ~0xC) | ((k & 4) << 1) | ((k & 8) >> 1); return ((kk >> 3) * 4 + (c >> 5)) * 512 + ((kk & 7) * 32 + (c & 31)) * 2; }
__device__ __forceinline__ int v_rd_base(int lane) { return ((lane & 3) << 3) | (((lane >> 2) & 3) << 6) | (((lane >> 4) & 1) << 5) | (((lane >> 5) & 1) << 8); }
constexpr int v_rd_off(int d0, int ks, int half) { return d0 * 512 + ks * 4096 + half * 2048; }
template <int OFF> __device__ __forceinline__ s16x4 tr_read(int vb) {
  s16x4 r; asm volatile("ds_read_b64_tr_b16 %0, %1 offset:%2" : "=&v"(r) : "v"(vb), "i"(OFF) : "memory"); return r;
}
template <int D0> __device__ __forceinline__ void pv_one(f32x16& od, int vb, bf16x8 pa0, bf16x8 pa1, bf16x8 pa2, bf16x8 pa3) {
  const s16x4 l0 = tr_read<v_rd_off(D0, 0, 0)>(vb), h0 = tr_read<v_rd_off(D0, 0, 1)>(vb), l1 = tr_read<v_rd_off(D0, 1, 0)>(vb), h1 = tr_read<v_rd_off(D0, 1, 1)>(vb);
  const s16x4 l2 = tr_read<v_rd_off(D0, 2, 0)>(vb), h2 = tr_read<v_rd_off(D0, 2, 1)>(vb), l3 = tr_read<v_rd_off(D0, 3, 0)>(vb), h3 = tr_read<v_rd_off(D0, 3, 1)>(vb);
  asm volatile("s_waitcnt lgkmcnt(0)" ::: "memory"); SBAR();
#define PK(L, H) (bf16x8){L[0], L[1], L[2], L[3], H[0], H[1], H[2], H[3]}
  od = __builtin_amdgcn_mfma_f32_32x32x16_bf16(pa0, PK(l0, h0), od, 0, 0, 0);
  od = __builtin_amdgcn_mfma_f32_32x32x16_bf16(pa1, PK(l1, h1), od, 0, 0, 0);
  od = __builtin_amdgcn_mfma_f32_32x32x16_bf16(pa2, PK(l2, h2), od, 0, 0, 0);
  od = __builtin_amdgcn_mfma_f32_32x32x16_bf16(pa3, PK(l3, h3), od, 0, 0, 0);
#undef PK
}
__device__ __forceinline__ void pv_d0(f32x16* o, int vb, bf16x8 pa0, bf16x8 pa1, bf16x8 pa2, bf16x8 pa3) {
  pv_one<0>(o[0], vb, pa0, pa1, pa2, pa3); pv_one<1>(o[1], vb, pa0, pa1, pa2, pa3); pv_one<2>(o[2], vb, pa0, pa1, pa2, pa3); pv_one<3>(o[3], vb, pa0, pa1, pa2, pa3);
}
__device__ __forceinline__ void attn_body(const bf16_t* __restrict__ Qb, const bf16_t* __restrict__ Kh, const bf16_t* __restrict__ Vh, bf16_t* __restrict__ Ob, int seq, char* lds) {
  int tid_ = threadIdx.x; asm volatile("" : "+v"(tid_));
  const int tid = tid_, wid = tid >> 6, lane = tid & 63, r32 = lane & 31, hi = lane >> 5;
  char* V_lds = lds; char* K_lds = lds + 2 * SHM_V;
  float* ws = (float*)(lds + 2 * SHM_V + 2 * SHM_K) + wid * 64; float* li_l = ws; float* al_l = ws + 32;
  float m_reg = -1e30f, l_reg = 0; f32x16 o[4] = {}; bf16x8 qr[8];
  const bf16_t* Qw = Qb + (long)(wid * QBLK + r32) * LDQ + hi * 8;
  char* qrl = lds + 2 * SHM_V + 2 * SHM_K + NW * 64 * 4 + wid * 4096 + r32 * 128;
#pragma unroll
  for (int d0 = 0; d0 < 8; ++d0) qr[d0] = *reinterpret_cast<const bf16x8*>(Qw + d0 * 16);
#pragma unroll
  for (int d0 = 8; d0 < 12; ++d0) *reinterpret_cast<bf16x8*>(qrl + ((((d0 - 8) * 2 + hi) ^ (r32 & 7)) << 4)) = *reinterpret_cast<const bf16x8*>(Qw + d0 * 16);
  asm volatile("s_waitcnt lgkmcnt(0)" ::: "memory");
  unsigned kgo[3], vgo[2];
#pragma unroll
  for (int i = 0; i < 3; ++i) { const int p = (i * 8 + wid) * 64 + lane, row = p / 24, slot = p % 24, ch = slot ^ (row & 7); kgo[i] = (unsigned)(row * LDK + ch * 8) * 2u; }
#pragma unroll
  for (int i = 0; i < 2; ++i) { const int p = (i * 8 + wid) * 64 + lane, sub = p >> 5, within = p & 31, kk = (sub >> 2) * 8 + (within >> 2), c = (sub & 3) * 32 + (within & 3) * 8;
    const int k = (kk & ~0xC) | ((kk & 4) << 1) | ((kk & 8) >> 1); vgo[i] = (unsigned)(k * LDV + c) * 2u; }
  const int vb0 = (int)(uintptr_t)V_lds + v_rd_base(lane);
  typedef __attribute__((address_space(3))) unsigned lds_u32;
#define DMA_K(b, k0) do { const char* kg = (const char*)Kh + (size_t)(k0) * (LDK * 2); \
    _Pragma("unroll") for (int _i = 0; _i < 3; ++_i) __builtin_amdgcn_global_load_lds((const unsigned*)(kg + kgo[_i]), (lds_u32*)(K_lds + (b) * SHM_K + (_i * 8 + wid) * 1024), 16, 0, 0); } while (0)
#define DMA_V(b, k0) do { const char* vg = (const char*)Vh + (size_t)(k0) * (LDV * 2); \
    _Pragma("unroll") for (int _i = 0; _i < 2; ++_i) __builtin_amdgcn_global_load_lds((const unsigned*)(vg + vgo[_i]), (lds_u32*)(V_lds + (b) * SHM_V + (_i * 8 + wid) * 1024), 16, 0, 0); } while (0)
#define RESC(a) do { if (__any((a) < 1.f)) { if (hi == 0) al_l[r32] = (a); asm volatile("s_waitcnt lgkmcnt(0)" ::: "memory"); \
    for (int d = 0; d < 4; ++d) for (int r = 0; r < 16; ++r) o[d][r] *= al_l[crow(r, hi)]; } } while (0)
#define ENDSTEP() do { asm volatile("s_waitcnt vmcnt(0)" ::: "memory"); __syncthreads(); } while (0)
  f32x16 pA0, pA1, pB0, pB1; float mnA, mnB, alA, alB; bf16x8 pa0, pa1, pa2, pa3; const int NT = seq / KVBLK;
  DMA_K(0, 0); ENDSTEP();
  DMA_K(1, KVBLK); DMA_V(0, 0);
  qkt(pA0, pA1, K_lds, qr, qrl, r32, hi); partialSM(pA0, pA1, m_reg, mnA, alA);
  ENDSTEP();
  for (int j = 1; j + 1 < NT; j += 2) {
    DMA_K(0, (j + 1) * KVBLK); DMA_V(1, j * KVBLK);
    SBAR(); qkt(pB0, pB1, K_lds + SHM_K, qr, qrl, r32, hi);
    finishSM(pA0, pA1, alA, l_reg, pa0, pa1, pa2, pa3); SBAR();
    pv_d0(o, vb0, pa0, pa1, pa2, pa3); partialSM(pB0, pB1, m_reg, mnB, alB);
    RESC(alB); ENDSTEP();
    if (j + 2 < NT) DMA_K(1, (j + 2) * KVBLK);
    DMA_V(0, (j + 1) * KVBLK);
    SBAR(); qkt(pA0, pA1, K_lds, qr, qrl, r32, hi);
    finishSM(pB0, pB1, alB, l_reg, pa0, pa1, pa2, pa3); SBAR();
    pv_d0(o, vb0 + (int)SHM_V, pa0, pa1, pa2, pa3); partialSM(pA0, pA1, m_reg, mnA, alA);
    RESC(alA); ENDSTEP();
  }
  DMA_V(1, (NT - 1) * KVBLK);
  SBAR(); qkt(pB0, pB1, K_lds + SHM_K, qr, qrl, r32, hi);
  finishSM(pA0, pA1, alA, l_reg, pa0, pa1, pa2, pa3); SBAR();
  pv_d0(o, vb0, pa0, pa1, pa2, pa3); partialSM(pB0, pB1, m_reg, mnB, alB);
  RESC(alB); ENDSTEP();
  finishSM(pB0, pB1, alB, l_reg, pa0, pa1, pa2, pa3); SBAR();
  pv_d0(o, vb0 + (int)SHM_V, pa0, pa1, pa2, pa3);
#undef DMA_K
#undef DMA_V
#undef ENDSTEP
  if (hi == 0) li_l[r32] = l_reg; asm volatile("s_waitcnt lgkmcnt(0)" ::: "memory");
  float rli[16];
#pragma unroll
  for (int r = 0; r < 16; ++r) rli[r] = __builtin_amdgcn_rcpf(li_l[crow(r, hi)]);
  bf16_t* Ow = Ob + (long)(wid * QBLK) * LDO;
#pragma unroll
  for (int r = 0; r < 16; ++r) { int orow = crow(r, hi);
#pragma unroll
    for (int d0 = 0; d0 < 4; ++d0) { const float val = o[d0][r] * rli[r]; Ow[(long)orow * LDO + d0 * 32 + r32] = (bf16_t)(cvtpk(val, val) & 0xffff); } }
  __syncthreads();
#undef RESC
}
}
__device__ __forceinline__ f32x2 cmul(f32x2 a, f32x2 b) { return (f32x2){a.x * b.x - a.y * b.y, a.x * b.y + a.y * b.x}; }
__device__ __forceinline__ int rev4_14(int k) { const unsigned r = __brev((unsigned)k) >> 18; return (int)(((r & 0x1555u) << 1) | ((r >> 1) & 0x1555u)); }
#define ZI(i) ((i) + ((i) >> 5))
__device__ __forceinline__ void fft_tw(int j, int q, float sign, f32x2& w1, f32x2& w2, f32x2& w3) {
    const float rev = (float)j / (float)(4 * q); const float sn = __builtin_amdgcn_sinf(rev), cs = __builtin_amdgcn_cosf(rev);
    w1 = (f32x2){cs, sign * sn}; w2 = cmul(w1, w1); w3 = cmul(w2, w1);
}
__device__ __forceinline__ void fft16k_dif(LAS f32x2* Z, int tid) {
#pragma unroll 1
    for (int s = 0; s < 7; ++s) { int lq = 12 - 2 * s; asm volatile("" : "+s"(lq)); const int q = 1 << lq;
        const bool shared = q <= 512; f32x2 w1, w2, w3; fft_tw(tid & (q - 1), q, -1.f, w1, w2, w3);
#pragma unroll 2
        for (int i = 0; i < 8; ++i) { const int b = tid + 512 * i, j = b & (q - 1), base = ((b >> lq) << (lq + 2)) + j;
            const int i0 = ZI(base), i1 = ZI(base + q), i2 = ZI(base + 2 * q), i3 = ZI(base + 3 * q);
            const f32x2 a0 = Z[i0], a1 = Z[i1], a2 = Z[i2], a3 = Z[i3];
            const f32x2 t0 = a0 + a2, t1 = a0 - a2, t2 = a1 + a3, t3 = a1 - a3;
            if (!shared) fft_tw(j, q, -1.f, w1, w2, w3);
            Z[i0] = t0 + t2; Z[i1] = cmul((f32x2){t1.x + t3.y, t1.y - t3.x}, w1); Z[i2] = cmul(t0 - t2, w2); Z[i3] = cmul((f32x2){t1.x - t3.y, t1.y + t3.x}, w3); }
        __syncthreads(); }
}
__device__ __forceinline__ void fft16k_dit_inv(LAS f32x2* Z, int tid) {
#pragma unroll 1
    for (int s = 0; s < 7; ++s) { int lq = 2 * s; asm volatile("" : "+s"(lq)); const int q = 1 << lq;
        const bool shared = q <= 512; f32x2 w1, w2, w3; fft_tw(tid & (q - 1), q, 1.f, w1, w2, w3);
#pragma unroll 2
        for (int i = 0; i < 8; ++i) { const int b = tid + 512 * i, j = b & (q - 1), base = ((b >> lq) << (lq + 2)) + j;
            if (!shared) fft_tw(j, q, 1.f, w1, w2, w3);
            const int i0 = ZI(base), i1 = ZI(base + q), i2 = ZI(base + 2 * q), i3 = ZI(base + 3 * q);
            const f32x2 b0 = Z[i0], b1 = cmul(Z[i1], w1), b2 = cmul(Z[i2], w2), b3 = cmul(Z[i3], w3);
            const f32x2 t0 = b0 + b2, t1 = b0 - b2, t2 = b1 + b3, t3 = b1 - b3;
            Z[i0] = t0 + t2; Z[i1] = (f32x2){t1.x - t3.y, t1.y + t3.x}; Z[i2] = t0 - t2; Z[i3] = (f32x2){t1.x + t3.y, t1.y - t3.x}; }
        __syncthreads(); }
}
constexpr float HY_MIN_DECAY = -3.0701134573253945f, HY_MAX_DECAY = -15.350567286626973f;
__device__ __forceinline__ float hy_delta(int c) { return fabsf(HY_MIN_DECAY + (HY_MAX_DECAY - HY_MIN_DECAY) * ((float)c / 1279.0f)); }
__device__ __forceinline__ float conv3b_at(const bf16_t* PX, int tau, int col, const float* cw, int l, int c) {
    const float* w = cw + (size_t)l * 3 * B_IN;
    return conv3_at(PX, tau, col, w[c], w[B_IN + c], w[2 * B_IN + c]);
}
__device__ __forceinline__ void hyena_taps_unit(const Frame& F, unsigned char* ws, int l, int pair) {
    LAS f32x2* Z = (LAS f32x2*)F.lds; LAS float* red = (LAS float*)(F.lds + LDS_MISC + 128);
    const int tid = F.tid, c0 = 2 * pair;
    const bf16_t* H3x = (const bf16_t*)(ws + WS_H3) + (size_t)l * 64 * T + NCTX;
    f32x4* scr4 = (f32x4*)(ws + WS_HSCR) + (size_t)pair * HT_STRIDE; float* htn = (float*)(ws + WS_HTN) + 2 * pair;
    LAS f32x4* FW = (LAS f32x4*)(F.lds + LDS_MISC + 256);
    if (tid < 256) { const int j = tid >> 2, q = tid & 3; ((LAS float*)FW)[tid] = IN_(35)[(size_t)l * 64 * 2560 + (size_t)j * 2560 + (q >> 1) * 1280 + c0 + (q & 1)]; }
    __syncthreads();
    const float d0 = hy_delta(c0), d1 = hy_delta(c0 + 1);
#ifndef HYS
#define HYS 31
#endif
    float s0, s1, sc0 = 0.f, sc1 = 0.f;
    {
    s0 = 0.f; s1 = 0.f;
    if (HYS & 1)
#pragma unroll 1
    for (int i = 0; i < 2; ++i) { const int tb = 4096 * i + 8 * tid; const bf16_t* hc = H3x + tb;
        asm volatile("" ::: "memory");
        f32x4 acc[8];
#pragma unroll
        for (int p = 0; p < 8; ++p) acc[p] = (f32x4){0.f, 0.f, 0.f, 0.f};
#pragma unroll 8
        for (int j = 0; j < 64; ++j) { const f32x4 w = FW[j]; const u32x4 hv = *(const u32x4*)(hc + (size_t)j * T);
#pragma unroll
            for (int p = 0; p < 4; ++p) { acc[2 * p] += w * __uint_as_float(hv[p] << 16); acc[2 * p + 1] += w * __uint_as_float(hv[p] & 0xffff0000u); } }
#pragma unroll
        for (int p = 0; p < 8; ++p) { const int t = tb + p;
            const float tl = (float)t * (1.0f / 8191.0f), e0 = __expf(-tl * d0), e1 = __expf(-tl * d1);
            const float f0 = acc[p].x * e0, f1 = acc[p].y * e1, b0 = acc[p].z * e0, b1 = acc[p].w * e1;
            Z[ZI(t)] = (f32x2){f0, f1}; s0 += fabsf(f0); s1 += fabsf(f1);
            if (t < 8191) { Z[ZI(16383 - t)] = (f32x2){b0, b1}; s0 += fabsf(b0); s1 += fabsf(b1); } } }
    if (tid == 0) { float zz = 0.f; asm volatile("" : "+v"(zz)); Z[ZI(8192)] = (f32x2){zz, zz}; }
    s0 = wave_sum(s0); s1 = wave_sum(s1);
    if (F.lane == 0) { red[F.wave * 2] = s0; red[F.wave * 2 + 1] = s1; }
    __syncthreads();
    float n0 = 0.f, n1 = 0.f;
#pragma unroll
    for (int w = 0; w < 8; ++w) { n0 += red[2 * w]; n1 += red[2 * w + 1]; }
    sc0 = 1.0f / (16384.0f * n0); sc1 = 1.0f / (16384.0f * n1);
    if (HYS & 2) fft16k_dif(Z, tid);
#pragma unroll 2
    for (int i = 0; i < 17; ++i) { const int k = tid + 512 * i; if (i == 16 && tid != 0) break;
        const int pk = rev4_14(k & 16383), pn = rev4_14((16384 - k) & 16383);
        const f32x2 At = Z[ZI(pk)], Bt = Z[ZI(pn)];
        scr4[k] = (f32x4){0.5f * (At.x + Bt.x), 0.5f * (At.y - Bt.y), 0.5f * (At.y + Bt.y), -0.5f * (At.x - Bt.x)}; }
    __syncthreads();
    }
    if (tid == 0) { htn[0] = sc0; htn[1] = sc1; }
    __syncthreads();
}
__device__ __forceinline__ void hyena_unit(const Frame& F, unsigned char* ws, int l, int pair) {
    LAS f32x2* Z = (LAS f32x2*)F.lds;
    const int tid = F.tid, c0 = 2 * pair;
    float* GT = (float*)(ws + WS_GT); const float* X0T = (const float*)(ws + WS_X0T);
    const f32x4* scr4 = (const f32x4*)(ws + WS_HSCR) + (size_t)pair * HT_STRIDE; const float* htn = (const float*)(ws + WS_HTN) + 2 * pair;
    const float sc0 = htn[0], sc1 = htn[1];
#ifndef HYS
#define HYS 31
#endif
    for (int rp15 = 0; rp15 < REP(15); ++rp15) {
    const float* g0p = GT + (size_t)c0 * T + NCTX; const float* g1p = g0p + T;
    f32x4 Hr[17];
    { float zz = 0.f; asm volatile("" : "+v"(zz));
      f32x2 ga[8], gb[8];
#pragma unroll
      for (int i = 0; i < 8; ++i) { const int t = 2 * tid + 1024 * i; ga[i] = *(const f32x2*)(g0p + t); gb[i] = *(const f32x2*)(g1p + t); }
#pragma unroll
      for (int i = 0; i < 17; ++i) Hr[i] = scr4[i < 16 ? tid + 512 * i : 8192];
#pragma unroll
      for (int i = 0; i < 8; ++i) { const int t = 2 * tid + 1024 * i; Z[ZI(t)] = (f32x2){ga[i].x, gb[i].x}; Z[ZI(t + 1)] = (f32x2){ga[i].y, gb[i].y}; Z[ZI(8192 + t)] = (f32x2){zz, zz}; Z[ZI(8193 + t)] = (f32x2){zz, zz}; } }
    __syncthreads();
    if (HYS & 2) fft16k_dif(Z, tid);
    if (HYS & 8)
#pragma unroll
    for (int i = 0; i < 17; ++i) { const int k = tid + 512 * i; if (i == 16 && tid != 0) break;
        const int pk = rev4_14(k & 16383), pn = rev4_14((16384 - k) & 16383);
        const f32x2 A = Z[ZI(pk)], B = Z[ZI(pn)];
        const f32x2 G0 = (f32x2){0.5f * (A.x + B.x), 0.5f * (A.y - B.y)}, G1 = (f32x2){0.5f * (A.y + B.y), -0.5f * (A.x - B.x)};
        const f32x2 H0 = (f32x2){Hr[i].x, Hr[i].y}, H1 = (f32x2){Hr[i].z, Hr[i].w};
        const f32x2 P0 = cmul(G0, H0), P1 = cmul(G1, H1);
        Z[ZI(pk)] = (f32x2){P0.x - P1.y, P0.y + P1.x};
        if (pn != pk) Z[ZI(pn)] = (f32x2){P0.x + P1.y, P1.x - P0.y}; }
    __syncthreads();
    if (HYS & 2) fft16k_dit_inv(Z, tid);
    }
    const float bb0 = IN_(37)[l * 1280 + c0], bb1 = IN_(37)[l * 1280 + c0 + 1];
    { float* y0p = GT + (size_t)c0 * T + NCTX; float* y1p = y0p + T; const float* x0p = X0T + (size_t)c0 * T + NCTX; const float* x1p = x0p + T;
      f32x2 ga[8], gb[8], xa[8], xb[8];
#pragma unroll
      for (int i = 0; i < 8; ++i) { const int t = 2 * tid + 1024 * i; ga[i] = *(const f32x2*)(y0p + t); gb[i] = *(const f32x2*)(y1p + t); xa[i] = *(const f32x2*)(x0p + t); xb[i] = *(const f32x2*)(x1p + t); }
#pragma unroll
      for (int i = 0; i < 8; ++i) { const int t = 2 * tid + 1024 * i; const f32x2 z0 = Z[ZI(t)], z1 = Z[ZI(t + 1)];
          *(f32x2*)(y0p + t) = (f32x2){xa[i].x * (z0.x * sc0 + ga[i].x * bb0), xa[i].y * (z1.x * sc0 + ga[i].y * bb0)};
          *(f32x2*)(y1p + t) = (f32x2){xb[i].x * (z0.y * sc1 + gb[i].x * bb1), xb[i].y * (z1.y * sc1 + gb[i].y * bb1)}; } }
    __syncthreads();
}
__device__ __forceinline__ void hyena_ctx_unit(const Frame& F, unsigned char* ws, int l, int unit) {
    LAS float* TF = (LAS float*)F.lds; LAS float* TB = TF + 2048; LAS float* GG = TB + 2048;
    const int tid = F.tid, t = tid >> 1, cc = (tid & 1) * 4, cbase = unit * 8 + cc;
    const bf16_t* H3c = (const bf16_t*)(ws + WS_H3) + (size_t)l * 64 * T; float* GT = (float*)(ws + WS_GT); const float* X0T = (const float*)(ws + WS_X0T);
    { float f[4] = {0.f, 0.f, 0.f, 0.f}, b[4] = {0.f, 0.f, 0.f, 0.f};
      const float* wbase = IN_(35) + (size_t)l * 64 * 2560 + cbase;
      for (int j = 0; j < 64; ++j) { const float hv = bf2f(H3c[(size_t)j * T + t]); const float* wrow = wbase + (size_t)j * 2560;
#pragma unroll
          for (int q = 0; q < 4; ++q) { f[q] += hv * wrow[q]; b[q] += hv * wrow[1280 + q]; } }
      const float tl = (float)t * (1.0f / 255.0f);
#pragma unroll
      for (int q = 0; q < 4; ++q) { const float e = __expf(-tl * hy_delta(cbase + q)); TF[t * 8 + cc + q] = f[q] * e; TB[t * 8 + cc + q] = b[q] * e; GG[t * 8 + cc + q] = GT[(size_t)(cbase + q) * T + t]; } }
    __syncthreads();
    float nrm[4] = {0.f, 0.f, 0.f, 0.f}, y[4] = {0.f, 0.f, 0.f, 0.f};
    for (int s = 0; s < 256; ++s) {
#pragma unroll
        for (int q = 0; q < 4; ++q) { nrm[q] += fabsf(TF[s * 8 + cc + q]) + (s < 255 ? fabsf(TB[s * 8 + cc + q]) : 0.f);
            const int o = t - s; const float tap = o >= 0 ? TF[o * 8 + cc + q] : TB[(-o - 1) * 8 + cc + q];
            y[q] += tap * GG[s * 8 + cc + q]; } }
    __syncthreads();
#pragma unroll
    for (int q = 0; q < 4; ++q) GT[(size_t)(cbase + q) * T + t] = X0T[(size_t)(cbase + q) * T + t] * (y[q] / nrm[q] + GG[t * 8 + cc + q] * IN_(37)[l * 1280 + cbase + q]);
    __syncthreads();
}
constexpr int SC_C = 16, SC_NCHUNK = T / SC_C, SC_CHUNK_BYTES = 14 * 1024;
__device__ __forceinline__ int sc_tau(int d, int c, int t) { return d == 0 ? SC_C * c + t : (c < NCTX / SC_C ? NCTX - 1 - SC_C * c - t : T - 1 - SC_C * (c - NCTX / SC_C) - t); }
__device__ __forceinline__ int sc_perm(int e, int hi) { return (e & 3) + 8 * (e >> 2) + 4 * hi; }
constexpr size_t WS_FR_BYTES = (size_t)2 * NHA * SC_NCHUNK * SC_CHUNK_BYTES;

typedef short sc_bf16x8 __attribute__((ext_vector_type(8)));
typedef float sc_f32x16 __attribute__((ext_vector_type(16)));
__device__ __forceinline__ sc_bf16x8 sc_pack8(const sc_f32x16& a, int base) {
    u32x4 w; w.x = cvt_pk_bf16(a[base + 0], a[base + 1]); w.y = cvt_pk_bf16(a[base + 2], a[base + 3]); w.z = cvt_pk_bf16(a[base + 4], a[base + 5]); w.w = cvt_pk_bf16(a[base + 6], a[base + 7]);
    return *reinterpret_cast<sc_bf16x8*>(&w);
}
constexpr int SC_NSLOT = 9, SC_AHEAD = 7;
__device__ __forceinline__ void scan_chain_mfma(const Frame& F, unsigned char* ws, int chain) {
    const int h = chain >> 1, d = chain & 1, lane = F.lane, n = lane & 31, hi = lane >> 5, ib = F.wave;
    const unsigned char* FRc = ws + WS_FR + (size_t)chain * SC_NCHUNK * SC_CHUNK_BYTES;
    float* Yd = (float*)(ws + WS_Y) + (size_t)d * T * A_W + h * 64;
    LAS unsigned char* buf = F.lds;
    typedef __attribute__((address_space(3))) unsigned sc_lds_u32;
#define SCM_DMA(c_) do { if (ib < 7) { const unsigned char* src_ = FRc + (size_t)(c_) * SC_CHUNK_BYTES; LAS unsigned char* dst_ = buf + ((c_) % SC_NSLOT) * SC_CHUNK_BYTES; \
        _Pragma("unroll") for (int i_ = 0; i_ < 2; ++i_) __builtin_amdgcn_global_load_lds((const unsigned*)(src_ + (i_ * 7 + ib) * 1024 + lane * 16), (sc_lds_u32*)(dst_ + (i_ * 7 + ib) * 1024), 16, 0, 0); } } while (0)
    sc_f32x16 S0 = {}, S1 = {};
    int yoff[8];
#pragma unroll
    for (int r = 0; r < 8; ++r) { const int t = (r & 3) + 8 * (r >> 2) + 4 * hi; yoff[r] = (d ? -t : t) * A_W + 32 * ib + n; }
    __syncthreads();
#pragma unroll
    for (int c = 0; c < SC_AHEAD; ++c) SCM_DMA(c);
    asm volatile("s_waitcnt vmcnt(12)" ::: "memory"); __builtin_amdgcn_s_barrier(); asm volatile("" ::: "memory");
#pragma unroll 1
    for (int c = 0; c < SC_NCHUNK; ++c) {
        const bool steady = c + SC_AHEAD < SC_NCHUNK;
        if (steady) SCM_DMA(c + SC_AHEAD);
        if (ib < 2) {
                const LAS unsigned char* fb = buf + (c % SC_NSLOT) * SC_CHUNK_BYTES;
                sc_bf16x8 fr[11]; sc_bf16x8 vf; f32x4 gt[8];
                { const unsigned fa = (unsigned)(uintptr_t)fb + lane * 16, va = fa + (11 + ib) * 1024, ga = (unsigned)(uintptr_t)fb + 13 * 1024 + hi * 128;
#define SC_DSRD(dst, addr, off) asm volatile("ds_read_b128 %0, %1 offset:%2" : "=v"(dst) : "v"(addr), "i"(off))
                  SC_DSRD(fr[0], fa, 0); SC_DSRD(fr[1], fa, 1024); SC_DSRD(fr[2], fa, 2048); SC_DSRD(fr[3], fa, 3072); SC_DSRD(fr[4], fa, 4096); SC_DSRD(fr[5], fa, 5120);
                  SC_DSRD(fr[6], fa, 6144); SC_DSRD(fr[7], fa, 7168); SC_DSRD(fr[8], fa, 8192); SC_DSRD(fr[9], fa, 9216); SC_DSRD(fr[10], fa, 10240); SC_DSRD(vf, va, 0);
                  SC_DSRD(gt[0], ga, 0); SC_DSRD(gt[1], ga, 16); SC_DSRD(gt[2], ga, 32); SC_DSRD(gt[3], ga, 48); SC_DSRD(gt[4], ga, 64); SC_DSRD(gt[5], ga, 80); SC_DSRD(gt[6], ga, 96); SC_DSRD(gt[7], ga, 112);
#undef SC_DSRD
                  asm volatile("s_waitcnt lgkmcnt(0)" : "+v"(fr[0]), "+v"(fr[1]), "+v"(fr[2]), "+v"(fr[3]), "+v"(fr[4]), "+v"(fr[5]), "+v"(fr[6]), "+v"(fr[7]), "+v"(fr[8]), "+v"(fr[9]), "+v"(fr[10]), "+v"(vf) :: "memory");
                  asm volatile("" : "+v"(gt[0]), "+v"(gt[1]), "+v"(gt[2]), "+v"(gt[3]), "+v"(gt[4]), "+v"(gt[5]), "+v"(gt[6]), "+v"(gt[7])); }
                const sc_bf16x8 sb00 = sc_pack8(S0, 0), sb01 = sc_pack8(S0, 8), sb10 = sc_pack8(S1, 0), sb11 = sc_pack8(S1, 8);
                sc_f32x16 P = {}, P2 = {};
                P = __builtin_amdgcn_mfma_f32_32x32x16_bf16(fr[0], sb00, P, 0, 0, 0);
                P2 = __builtin_amdgcn_mfma_f32_32x32x16_bf16(fr[2], sb10, P2, 0, 0, 0);
                P = __builtin_amdgcn_mfma_f32_32x32x16_bf16(fr[1], sb01, P, 0, 0, 0);
                P2 = __builtin_amdgcn_mfma_f32_32x32x16_bf16(fr[3], sb11, P2, 0, 0, 0);
                P = __builtin_amdgcn_mfma_f32_32x32x16_bf16(fr[4], vf, P, 0, 0, 0);
#pragma unroll
                for (int q = 0; q < 4; ++q)
#pragma unroll
                    for (int e = 0; e < 4; ++e) { S0[4 * q + e] *= gt[q][e]; S1[4 * q + e] *= gt[4 + q][e]; }
                S0 = __builtin_amdgcn_mfma_f32_32x32x16_bf16(fr[8], vf, S0, 0, 0, 0);
                S1 = __builtin_amdgcn_mfma_f32_32x32x16_bf16(fr[10], vf, S1, 0, 0, 0);
#pragma unroll
                for (int r = 0; r < 16; ++r) P[r] += P2[r];
                const sc_bf16x8 xb = sc_pack8(P, 0);
                sc_f32x16 U = {};
                U = __builtin_amdgcn_mfma_f32_32x32x16_bf16(fr[5], xb, U, 0, 0, 0);
                const sc_bf16x8 ub = sc_pack8(U, 0);
                S0 = __builtin_amdgcn_mfma_f32_32x32x16_bf16(fr[7], ub, S0, 0, 0, 0);
                S1 = __builtin_amdgcn_mfma_f32_32x32x16_bf16(fr[9], ub, S1, 0, 0, 0);
                P = __builtin_amdgcn_mfma_f32_32x32x16_bf16(fr[6], ub, P, 0, 0, 0);
                float* yb = Yd + (size_t)sc_tau(d, c, 0) * A_W;
#pragma unroll
                for (int r = 0; r < 8; ++r) yb[yoff[r]] = P[8 + r];
        }
        if (steady) asm volatile("s_waitcnt vmcnt(12)" ::: "memory"); else asm volatile("s_waitcnt vmcnt(0)" ::: "memory");
        asm volatile("s_waitcnt lgkmcnt(0)" ::: "memory"); __builtin_amdgcn_s_barrier(); asm volatile("" ::: "memory");
    }
    asm volatile("s_waitcnt vmcnt(0)" ::: "memory"); __syncthreads();
#undef SCM_DMA
}
__device__ __forceinline__ float conv3_u(const float* PX, int tau, unsigned ucol, float w0, float w1, float w2) {
    const float* p = PX + (size_t)tau * PXW;
    float y = p[ucol] * w1;
    if (has_left(tau)) y += (p - PXW)[ucol] * w0;
    if (has_right(tau)) y += (p + PXW)[ucol] * w2;
    return y;
}
constexpr int WLR_K = 448;
constexpr int RP_WAVE_LDS = 16896;
typedef short rp_bf16x8 __attribute__((ext_vector_type(8)));
typedef float rp_f32x16 __attribute__((ext_vector_type(16)));
__device__ __forceinline__ unsigned short f2bf16(float x) { return (unsigned short)(cvt_pk_bf16(x, x) & 0xffffu); }
template <int NKB, class AF>
__device__ __forceinline__ void rp_lowrank(float (&dst)[16], const AF& afrag, const bf16_t* WLRh, int kw0, int n, int hi) {
    rp_f32x16 c0 = {}, c1 = {}; const bf16_t* wb0 = WLRh + (size_t)n * WLR_K + kw0 + 8 * hi; const bf16_t* wb1 = wb0 + (size_t)32 * WLR_K;
#pragma unroll
    for (int kb = 0; kb < NKB; ++kb) { const rp_bf16x8 b0 = *(const rp_bf16x8*)(wb0 + 16 * kb), b1 = *(const rp_bf16x8*)(wb1 + 16 * kb); const rp_bf16x8 a_ = afrag(kb);
        c0 = __builtin_amdgcn_mfma_f32_32x32x16_bf16(a_, b0, c0, 0, 0, 0); c1 = __builtin_amdgcn_mfma_f32_32x32x16_bf16(a_, b1, c1, 0, 0, 0); }
#pragma unroll
    for (int r = 0; r < 8; ++r) { auto sw = __builtin_amdgcn_permlane32_swap(__float_as_uint(c0[r]), __float_as_uint(c1[r]), false, false);
        dst[(r & 3) + 8 * (r >> 2)] = __uint_as_float(sw[0]); dst[(r & 3) + 8 * (r >> 2) + 4] = __uint_as_float(sw[1]); }
}
struct RpAfLds { const LAS bf16_t* base; __device__ __forceinline__ rp_bf16x8 operator()(int kb) const { return *(const LAS rp_bf16x8*)(base + 16 * kb); } };
__device__ __forceinline__ void rwkv_elem_phase(const Frame& F, unsigned char* ws, int l) {
    const float* PX = (const float*)(ws + WS_PX); float* SS = (float*)(ws + WS_SS); float* SD = (float*)(ws + WS_SD); float* GB = (float*)(ws + WS_G);
    const bf16_t* WLR = (const bf16_t*)(ws + WS_WLR) + (size_t)l * A_W * WLR_K;
    const float* cw = IN_(16) + (size_t)l * 3 * A_IN;
    LAS bf16_t* ACT = (LAS bf16_t*)(F.lds + F.wave * 10752);
    const int lane = F.lane, n = lane & 31, hi = lane >> 5;
    const int gw = F.bid * 8 + F.wave, NGW = F.G * 8;
    for (int it = gw; it < (T / 16) * 10; it += NGW) {
        const int tg = it / 10, hq = it % 10, tau0 = tg * 16;
        asm volatile("s_waitcnt lgkmcnt(0)" ::: "memory");
        const float* prow0 = PX + (size_t)(tau0 > 0 ? tau0 - 1 : 0) * PXW; const int roff = tau0 > 0 ? 0 : -1;
#define RP_WIN(x, ucol_) do { _Pragma("unroll") for (int i_ = 0; i_ < 18; ++i_) { int ri_ = i_ + roff; ri_ = ri_ < 0 ? 0 : ri_; ri_ = (tau0 - 1 + i_ > T - 1) ? (T - 1 - (tau0 > 0 ? tau0 - 1 : 0)) : ri_; x[i_] = (prow0 + (size_t)ri_ * PXW)[ucol_]; } } while (0)
#define RP_CONV(x, t_, w0_, w1_, w2_) (x[(t_)] * (has_left(tau0 + (t_)) ? (w0_) : 0.f) + x[(t_) + 1] * (w1_) + x[(t_) + 2] * (has_right(tau0 + (t_)) ? (w2_) : 0.f))
#pragma unroll
        for (int i = 0; i < 5; ++i) { const int c = lane + 64 * i, col = 3840 + c; const float c0 = cw[col], c1 = cw[A_IN + col], c2 = cw[2 * A_IN + col];
            float x[18]; RP_WIN(x, (unsigned)(PXA + col));
#pragma unroll
            for (int t = 0; t < 16; ++t) { const float val = RP_CONV(x, t, c0, c1, c2);
                const float act = i == 0 ? 1.0f - 2.0f / (1.0f + __expf(2.0f * val)) : (i == 1 ? val : sigmoidf_(val));
                ACT[t * 328 + c] = f2bf16(act); } }
        asm volatile("s_waitcnt lgkmcnt(0)" ::: "memory");
        const RpAfLds afw{ACT + (n & 15) * 328 + 8 * hi}, afa{ACT + (n & 15) * 328 + 64 + 8 * hi}, afg{ACT + (n & 15) * 328 + 128 + 8 * hi};
#pragma unroll 1
        for (int hh = 0; hh < 2; ++hh) {
            const int h = hq * 2 + hh, col = h * 64 + lane; const bf16_t* WLRh = WLR + (size_t)h * 64 * WLR_K;
            { float lg[16]; rp_lowrank<12>(lg, afg, WLRh, 256, n, hi);
#pragma unroll
              for (int t = 0; t < 16; ++t) GB[(size_t)(tau0 + t) * A_W + col] = lg[t]; }
            const float cr0 = cw[col], cr1 = cw[A_IN + col], cr2 = cw[2 * A_IN + col];
            const float ck0 = cw[A_W + col], ck1 = cw[A_IN + A_W + col], ck2 = cw[2 * A_IN + A_W + col];
            const float cv0 = cw[2 * A_W + col], cv1 = cw[A_IN + 2 * A_W + col], cv2 = cw[2 * A_IN + 2 * A_W + col];
            const float kk_w = IN_(22)[l * A_W + col], ka_w = IN_(23)[l * A_W + col];
            float kkv[16], kv[16];
            { float xr[18], xk[18], xv[18]; const unsigned uc = (unsigned)(PXA + col); RP_WIN(xr, uc); RP_WIN(xk, uc + A_W); RP_WIN(xv, uc + 2 * A_W);
#pragma unroll
              for (int t = 0; t < 16; ++t) { const int tau = tau0 + t;
                  const float r = RP_CONV(xr, t, cr0, cr1, cr2), v = RP_CONV(xv, t, cv0, cv1, cv2); kv[t] = RP_CONV(xk, t, ck0, ck1, ck2);
                  const float kr = kv[t] * kk_w; const float nrm = sqrtf(wave_sum(kr * kr)); kkv[t] = kr / fmaxf(nrm, 1e-12f);
                  float* ss = SS + ((size_t)h * T + tau) * 192 + lane; ss[0] = kkv[t]; ss[64] = r; ss[128] = v; } }
#pragma unroll 1
            for (int d = 0; d < 2; ++d) { const float w0b = IN_(17)[(l * 2 + d) * A_W + col], a0b = IN_(19)[(l * 2 + d) * A_W + col]; float lw[16], la[16];
                rp_lowrank<4>(lw, afw, WLRh, 64 * d, n, hi); rp_lowrank<4>(la, afa, WLRh, 128 + 64 * d, n, hi);
#pragma unroll
                for (int t = 0; t < 16; ++t) { const float z = w0b + lw[t]; const float decay = __expf(-__expf(-(fmaxf(-z, 0.f) + __logf(1.0f + __expf(-fabsf(z)))) - 0.5f)); const float av = sigmoidf_(a0b + la[t]);
                    float* sd = SD + (((size_t)h * 2 + d) * T + tau0 + t) * 192 + lane; sd[0] = decay; sd[64] = kkv[t] * av; sd[128] = kv[t] * (1.0f + (av - 1.0f) * ka_w); } }
        }
    }
}
#undef RP_WIN
#undef RP_CONV
constexpr int SP_WAVE_LDS = 16640;
__device__ __forceinline__ void scan_prep_phase(const Frame& F, unsigned char* ws) {
    const float* SS = (const float*)(ws + WS_SS); const float* SD = (const float*)(ws + WS_SD); unsigned char* FR = ws + WS_FR;
    LAS bf16_t* R1 = (LAS bf16_t*)(F.lds + F.wave * SP_WAVE_LDS); LAS bf16_t* R2 = R1 + 32 * 72; LAS bf16_t* BbT = R2 + 32 * 72; LAS bf16_t* KbT = BbT + 64 * 16; LAS bf16_t* VT = KbT + 64 * 16; LAS float* Lm = (LAS float*)(VT + 64 * 16);
    const int lane = F.lane, n = lane & 31, hi = lane >> 5;
    const int gw = F.bid * 8 + F.wave, NGW = F.G * 8;
    for (int it = gw; it < 2 * NHA * SC_NCHUNK; it += NGW) {
        const int chain = it / SC_NCHUNK, c = it % SC_NCHUNK, h = chain >> 1, d = chain & 1;
        const int tau_first = sc_tau(d, c, 0), dstep = d ? -1 : 1;
        const float* ssb = SS + (size_t)h * T * 192 + lane; const float* sdb = SD + ((size_t)h * 2 + d) * T * 192 + lane;
        float xw[16], xb[16], xk[16], xkk[16], xr[16], xv[16];
#pragma unroll
        for (int s = 0; s < 16; ++s) { const size_t o = (size_t)(tau_first + dstep * s) * 192; xw[s] = sdb[o]; xb[s] = sdb[o + 64]; xk[s] = sdb[o + 128]; xkk[s] = ssb[o]; xr[s] = ssb[o + 64]; xv[s] = ssb[o + 128]; }
        float gC = 1.f;
#pragma unroll
        for (int s = 0; s < 16; ++s) gC *= xw[s];
        float g = 1.f;
#pragma unroll
        for (int s = 0; s < 16; ++s) {
            const float gm1 = g; g *= xw[s]; const float ig = 1.0f / g; const float bh = xb[s] * ig, kh = xk[s] * ig;
            R1[s * 72 + lane] = f2bf16(-xkk[s] * gm1); R1[(16 + s) * 72 + lane] = f2bf16(xr[s] * g);
            R2[s * 72 + lane] = f2bf16(bh); R2[(16 + s) * 72 + lane] = f2bf16(kh);
            BbT[lane * 16 + s] = f2bf16(bh * gC); KbT[lane * 16 + s] = f2bf16(kh * gC); VT[lane * 16 + s] = f2bf16(xv[s]); }
        asm volatile("s_waitcnt lgkmcnt(0)" ::: "memory");
        unsigned char* dst = FR + ((size_t)chain * SC_NCHUNK + c) * SC_CHUNK_BYTES;
        rp_f32x16 C = {};
#pragma unroll
        for (int kb = 0; kb < 4; ++kb) { const rp_bf16x8 a_ = *(const LAS rp_bf16x8*)(R2 + n * 72 + 16 * kb + 8 * hi), b_ = *(const LAS rp_bf16x8*)(R1 + n * 72 + 16 * kb + 8 * hi);
            C = __builtin_amdgcn_mfma_f32_32x32x16_bf16(a_, b_, C, 0, 0, 0); }
        const int tt_ = n & 15; const bool incl = n >= 16;
#pragma unroll
        for (int r = 0; r < 16; ++r) { const int s = ((r & 7) & 3) + 8 * ((r & 7) >> 2) + 4 * hi; if (!(s < tt_ || (incl && s == tt_))) C[r] = 0.f; }
        if (n < 16) {
#pragma unroll
            for (int r = 0; r < 8; ++r) Lm[((r & 3) + 8 * (r >> 2) + 4 * hi) * 20 + n] = C[r]; }
        { u32x4 f4; f4.x = cvt_pk_bf16(C[8], C[9]); f4.y = cvt_pk_bf16(C[10], C[11]); f4.z = cvt_pk_bf16(C[12], C[13]); f4.w = cvt_pk_bf16(C[14], C[15]);
          u32x4 f6; f6.x = cvt_pk_bf16(C[0], C[1]); f6.y = cvt_pk_bf16(C[2], C[3]); f6.z = cvt_pk_bf16(C[4], C[5]); f6.w = cvt_pk_bf16(C[6], C[7]);
          if (n < 16) f6 = (u32x4){0u, 0u, 0u, 0u};
          *(u32x4*)(dst + 4 * 1024 + lane * 16) = f4; *(u32x4*)(dst + 6 * 1024 + lane * 16) = f6; }
        asm volatile("s_waitcnt lgkmcnt(0)" ::: "memory");
        { float Tc[16];
#pragma unroll
          for (int s = 15; s >= 0; --s) { float acc = (s == n) ? 1.f : 0.f;
#pragma unroll
              for (int u = s + 1; u < 16; ++u) acc += Lm[s * 20 + u] * Tc[u];
              Tc[s] = acc; }
          u32x4 f5; f5.x = cvt_pk_bf16(hi ? Tc[4] : Tc[0], hi ? Tc[5] : Tc[1]); f5.y = cvt_pk_bf16(hi ? Tc[6] : Tc[2], hi ? Tc[7] : Tc[3]);
          f5.z = cvt_pk_bf16(hi ? Tc[12] : Tc[8], hi ? Tc[13] : Tc[9]); f5.w = cvt_pk_bf16(hi ? Tc[14] : Tc[10], hi ? Tc[15] : Tc[11]);
          if (n >= 16) f5 = (u32x4){0u, 0u, 0u, 0u};
          *(u32x4*)(dst + 5 * 1024 + lane * 16) = f5; }
#pragma unroll
        for (int f = 0; f < 4; ++f) { const u32x2 p0 = *(const LAS u32x2*)(R1 + n * 72 + 16 * f + 4 * hi), p1 = *(const LAS u32x2*)(R1 + n * 72 + 16 * f + 8 + 4 * hi);
            *(u32x4*)(dst + f * 1024 + lane * 16) = (u32x4){p0.x, p0.y, p1.x, p1.y}; }
#pragma unroll
        for (int jb = 0; jb < 2; ++jb) { const int row = 32 * jb + n;
            const u32x2 b0 = *(const LAS u32x2*)(BbT + row * 16 + 4 * hi), b1 = *(const LAS u32x2*)(BbT + row * 16 + 8 + 4 * hi), k0 = *(const LAS u32x2*)(KbT + row * 16 + 4 * hi), k1 = *(const LAS u32x2*)(KbT + row * 16 + 8 + 4 * hi);
            const u32x2 v0 = *(const LAS u32x2*)(VT + row * 16 + 4 * hi), v1 = *(const LAS u32x2*)(VT + row * 16 + 8 + 4 * hi);
            *(u32x4*)(dst + (7 + 2 * jb) * 1024 + lane * 16) = (u32x4){b0.x, b0.y, b1.x, b1.y}; *(u32x4*)(dst + (8 + 2 * jb) * 1024 + lane * 16) = (u32x4){k0.x, k0.y, k1.x, k1.y};
            *(u32x4*)(dst + (11 + jb) * 1024 + lane * 16) = (u32x4){v0.x, v0.y, v1.x, v1.y}; }
        { const int jj = lane & 31; ((float*)(dst + 13 * 1024))[((jj >> 2) & 1) * 32 + (lane >> 5) * 16 + (jj & 3) + 4 * (jj >> 3)] = gC; }
        asm volatile("s_waitcnt lgkmcnt(0)" ::: "memory");
    }
}
constexpr int RF_ACT_BYTES = 16 * 320 * 2;
__device__ __forceinline__ void rwkv_fused_phase(const Frame& F, unsigned char* ws, int l) {
    const bf16_t* PX = (const bf16_t*)(ws + WS_PX); unsigned char* FR = ws + WS_FR;
    float* GB = (float*)(ws + WS_G); float* VB = (float*)(ws + WS_SS) + (size_t)T * A_W; float* BS = (float*)(ws + WS_SD);
    const bf16_t* WLR = (const bf16_t*)(ws + WS_WLR) + (size_t)l * A_W * WLR_K;
    const float* cw = IN_(16) + (size_t)l * 3 * A_IN;
    LAS bf16_t* ACT = (LAS bf16_t*)F.lds;
    LAS bf16_t* R1 = (LAS bf16_t*)(F.lds + RF_ACT_BYTES + F.wave * SP_WAVE_LDS); LAS bf16_t* R2 = R1 + 32 * 72; LAS bf16_t* BbT = R2 + 32 * 72; LAS bf16_t* KbT = BbT + 64 * 16; LAS bf16_t* VT = KbT + 64 * 16; LAS float* Lm = (LAS float*)(VT + 64 * 16);
    const int lane = F.lane, n = lane & 31, hi = lane >> 5, hh = F.wave >> 1, d = F.wave & 1;
    for (int it = F.bid; it < (T / 16) * 5; it += F.G) {
        const int tg = it / 5, hg = it % 5, tau0 = tg * 16, h = hg * 4 + hh, col = h * 64 + lane;
        const bf16_t* prow0 = PX + (size_t)(tau0 > 0 ? tau0 - 1 : 0) * PXW; const int roff = tau0 > 0 ? 0 : -1;
#define RP_WIN(x, ucol_) do { _Pragma("unroll") for (int i_ = 0; i_ < 18; ++i_) { int ri_ = i_ + roff; ri_ = ri_ < 0 ? 0 : ri_; ri_ = (tau0 - 1 + i_ > T - 1) ? (T - 1 - (tau0 > 0 ? tau0 - 1 : 0)) : ri_; x[i_] = bf2f((prow0 + (size_t)ri_ * PXW)[ucol_]); } } while (0)
#define RP_CONV(x, t_, w0_, w1_, w2_) (x[(t_)] * (has_left(tau0 + (t_)) ? (w0_) : 0.f) + x[(t_) + 1] * (w1_) + x[(t_) + 2] * (has_right(tau0 + (t_)) ? (w2_) : 0.f))
        float wr_[18], wk_[18], wv_[18]; { const unsigned uc = (unsigned)(PXA + col); RP_WIN(wr_, uc); RP_WIN(wk_, uc + A_W); RP_WIN(wv_, uc + 2 * A_W); }
        const float cr0 = cw[col], cr1 = cw[A_IN + col], cr2 = cw[2 * A_IN + col], ck0 = cw[A_W + col], ck1 = cw[A_IN + A_W + col], ck2 = cw[2 * A_IN + A_W + col];
        const float cv0 = cw[2 * A_W + col], cv1 = cw[A_IN + 2 * A_W + col], cv2 = cw[2 * A_IN + 2 * A_W + col], kk_w = IN_(22)[l * A_W + col];
        __syncthreads();
        { int tq = F.tid; asm volatile("" : "+v"(tq));
#pragma unroll
          for (int i = 0; i < 3; ++i) { const int item = tq + 512 * i;
              if (item < 16 * 80) { const int t = item / 80, c = 4 * (item % 80), cc = 3840 + c, tau = tau0 + t;
                  const bf16_t* p = PX + (size_t)tau * PXW + PXA + cc; const bool hl = has_left(tau), hr = has_right(tau);
                  const f32x4 x1 = bf4f(*(const u32x2*)p), x0 = bf4f(*(const u32x2*)(p - (hl ? PXW : 0))), x2 = bf4f(*(const u32x2*)(p + (hr ? PXW : 0)));
                  const f32x4 w0 = *(const f32x4*)(cw + cc), w1 = *(const f32x4*)(cw + A_IN + cc), w2 = *(const f32x4*)(cw + 2 * A_IN + cc);
                  const f32x4 val = x1 * w1 + x0 * (w0 * (hl ? 1.f : 0.f)) + x2 * (w2 * (hr ? 1.f : 0.f));
                  f32x4 act;
#pragma unroll
                  for (int e = 0; e < 4; ++e) act[e] = c < 64 ? 1.0f - 2.0f / (1.0f + __expf(2.0f * val[e])) : (c < 128 ? val[e] : sigmoidf_(val[e]));
                  u32x2 o; o.x = cvt_pk_bf16(act.x, act.y); o.y = cvt_pk_bf16(act.z, act.w);
                  *(LAS u32x2*)(ACT + t * 320 + c) = o; } } }
        __syncthreads();
        const bf16_t* WLRh = WLR + (size_t)h * 64 * WLR_K;
        const RpAfLds afw{ACT + (n & 15) * 320 + 8 * hi}, afa{ACT + (n & 15) * 320 + 64 + 8 * hi}, afg{ACT + (n & 15) * 320 + 128 + 8 * hi};
        float xw[16], xb[16], xk[16], xkk[16], xr[16], xv[16];
        {
          if (d == 0) { float lg[16]; rp_lowrank<12>(lg, afg, WLRh, 256, n, hi);
#pragma unroll
              for (int t = 0; t < 16; ++t) GB[(size_t)(tau0 + t) * A_W + col] = lg[t]; }
#pragma unroll
          for (int t = 0; t < 16; ++t) { xr[t] = RP_CONV(wr_, t, cr0, cr1, cr2); xv[t] = RP_CONV(wv_, t, cv0, cv1, cv2); xk[t] = RP_CONV(wk_, t, ck0, ck1, ck2);
              const float kr = xk[t] * kk_w; const float nrm = sqrtf(wave_sum(kr * kr)); xkk[t] = kr / fmaxf(nrm, 1e-12f); } }
        if (d == 0) {
#pragma unroll
            for (int t = 0; t < 16; ++t) VB[(size_t)(tau0 + t) * A_W + col] = xv[t]; }
        { const float ka_w = IN_(23)[l * A_W + col], w0b = IN_(17)[(l * 2 + d) * A_W + col], a0b = IN_(19)[(l * 2 + d) * A_W + col]; float la[16];
          rp_lowrank<4>(xw, afw, WLRh, 64 * d, n, hi); rp_lowrank<4>(la, afa, WLRh, 128 + 64 * d, n, hi);
#pragma unroll
          for (int t = 0; t < 16; ++t) { const float z = w0b + xw[t]; xw[t] = __expf(-__expf(-(fmaxf(-z, 0.f) + __logf(1.0f + __expf(-fabsf(z)))) - 0.5f)); const float av = sigmoidf_(a0b + la[t]);
              xb[t] = xkk[t] * av; xk[t] = xk[t] * (1.0f + (av - 1.0f) * ka_w); }
          { const float rk_w = IN_(24)[l * A_W + col]; float pr[16];
#pragma unroll
            for (int t = 0; t < 16; ++t) pr[t] = xr[t] * xk[t] * rk_w;
            const float sb = wave_sum16(pr, lane);
            if ((lane & 3) == 0) BS[((size_t)d * T + tau0 + (lane >> 2)) * NHA + h] = sb; } }
        if (d) {
#pragma unroll
            for (int s = 0; s < 8; ++s) { float t_;
                t_ = xw[s]; xw[s] = xw[15 - s]; xw[15 - s] = t_; t_ = xb[s]; xb[s] = xb[15 - s]; xb[15 - s] = t_; t_ = xk[s]; xk[s] = xk[15 - s]; xk[15 - s] = t_;
                t_ = xkk[s]; xkk[s] = xkk[15 - s]; xkk[15 - s] = t_; t_ = xr[s]; xr[s] = xr[15 - s]; xr[15 - s] = t_; t_ = xv[s]; xv[s] = xv[15 - s]; xv[15 - s] = t_; } }
        const int c = d == 0 ? tg : (tg < NCTX / 16 ? NCTX / 16 - 1 - tg : NCTX / 16 + (T / 16 - 1) - tg);
        float gC = 1.f;
#pragma unroll
        for (int s = 0; s < 16; ++s) gC *= xw[s];
        float g = 1.f;
#pragma unroll
        for (int s = 0; s < 16; ++s) {
            const float gm1 = g; g *= xw[s]; const float ig = 1.0f / g; const float bh = xb[s] * ig, kh = xk[s] * ig;
            R1[s * 72 + lane] = f2bf16(-xkk[s] * gm1); R1[(16 + s) * 72 + lane] = f2bf16(xr[s] * g);
            R2[s * 72 + lane] = f2bf16(bh); R2[(16 + s) * 72 + lane] = f2bf16(kh);
            xb[s] = bh * gC; xk[s] = kh * gC; }
        asm volatile("s_waitcnt lgkmcnt(0)" ::: "memory");
        unsigned char* dst = FR + ((size_t)(h * 2 + d) * SC_NCHUNK + c) * SC_CHUNK_BYTES;
        rp_f32x16 C = {};
#pragma unroll
        for (int kb = 0; kb < 4; ++kb) { const rp_bf16x8 a_ = *(const LAS rp_bf16x8*)(R2 + n * 72 + 16 * kb + 8 * hi), b_ = *(const LAS rp_bf16x8*)(R1 + n * 72 + 16 * kb + 8 * hi);
            C = __builtin_amdgcn_mfma_f32_32x32x16_bf16(a_, b_, C, 0, 0, 0); }
        const int tt_ = n & 15; const bool incl = n >= 16;
#pragma unroll
        for (int r = 0; r < 16; ++r) { const int s = ((r & 7) & 3) + 8 * ((r & 7) >> 2) + 4 * hi; if (!(s < tt_ || (incl && s == tt_))) C[r] = 0.f; }
        if (n < 16) {
#pragma unroll
            for (int r = 0; r < 8; ++r) Lm[((r & 3) + 8 * (r >> 2) + 4 * hi) * 20 + n] = C[r]; }
        { u32x4 f4; f4.x = cvt_pk_bf16(C[8], C[9]); f4.y = cvt_pk_bf16(C[10], C[11]); f4.z = cvt_pk_bf16(C[12], C[13]); f4.w = cvt_pk_bf16(C[14], C[15]);
          u32x4 f6; f6.x = cvt_pk_bf16(C[0], C[1]); f6.y = cvt_pk_bf16(C[2], C[3]); f6.z = cvt_pk_bf16(C[4], C[5]); f6.w = cvt_pk_bf16(C[6], C[7]);
          if (n < 16) f6 = (u32x4){0u, 0u, 0u, 0u};
          *(u32x4*)(dst + 4 * 1024 + lane * 16) = f4; *(u32x4*)(dst + 6 * 1024 + lane * 16) = f6; }
        asm volatile("s_waitcnt lgkmcnt(0)" ::: "memory");
        { float Tc[16];
#pragma unroll
          for (int s = 15; s >= 0; --s) { float acc = (s == n) ? 1.f : 0.f;
#pragma unroll
              for (int u = s + 1; u < 16; ++u) acc += Lm[s * 20 + u] * Tc[u];
              Tc[s] = acc; }
          u32x4 f5; f5.x = cvt_pk_bf16(hi ? Tc[4] : Tc[0], hi ? Tc[5] : Tc[1]); f5.y = cvt_pk_bf16(hi ? Tc[6] : Tc[2], hi ? Tc[7] : Tc[3]);
          f5.z = cvt_pk_bf16(hi ? Tc[12] : Tc[8], hi ? Tc[13] : Tc[9]); f5.w = cvt_pk_bf16(hi ? Tc[14] : Tc[10], hi ? Tc[15] : Tc[11]);
          if (n >= 16) f5 = (u32x4){0u, 0u, 0u, 0u};
          *(u32x4*)(dst + 5 * 1024 + lane * 16) = f5; }
#pragma unroll
        for (int f = 0; f < 4; ++f) { const u32x2 p0 = *(const LAS u32x2*)(R1 + n * 72 + 16 * f + 4 * hi), p1 = *(const LAS u32x2*)(R1 + n * 72 + 16 * f + 8 + 4 * hi);
            *(u32x4*)(dst + f * 1024 + lane * 16) = (u32x4){p0.x, p0.y, p1.x, p1.y}; }
#define RF_FRAG(x_, fa_, fb_) do { unsigned pk_[8]; _Pragma("unroll") for (int m_ = 0; m_ < 8; ++m_) pk_[m_] = cvt_pk_bf16(x_[2 * m_], x_[2 * m_ + 1]); \
            const bool h1_ = hi != 0; const u32x4 own_ = {h1_ ? pk_[2] : pk_[0], h1_ ? pk_[3] : pk_[1], h1_ ? pk_[6] : pk_[4], h1_ ? pk_[7] : pk_[5]}; \
            u32x4 rcv_ = {h1_ ? pk_[0] : pk_[2], h1_ ? pk_[1] : pk_[3], h1_ ? pk_[4] : pk_[6], h1_ ? pk_[5] : pk_[7]}; \
            rcv_.x = __shfl_xor(rcv_.x, 32); rcv_.y = __shfl_xor(rcv_.y, 32); rcv_.z = __shfl_xor(rcv_.z, 32); rcv_.w = __shfl_xor(rcv_.w, 32); \
            *(u32x4*)(dst + (fa_) * 1024 + lane * 16) = h1_ ? rcv_ : own_; *(u32x4*)(dst + (fb_) * 1024 + lane * 16) = h1_ ? own_ : rcv_; } while (0)
        RF_FRAG(xb, 7, 9); RF_FRAG(xk, 8, 10); RF_FRAG(xv, 11, 12);
#undef RF_FRAG
        { const int jj = lane & 31; ((float*)(dst + 13 * 1024))[((jj >> 2) & 1) * 32 + (lane >> 5) * 16 + (jj & 3) + 4 * (jj >> 3)] = gC; }
        asm volatile("s_waitcnt lgkmcnt(0)" ::: "memory");
    }
#undef RP_WIN
#undef RP_CONV
}
__device__ __forceinline__ void mixer_phase(const Frame& F0, unsigned char* ws0, int lq, bool need_ctx, char* lds_g) {
    const int l = lq & 3;
#ifndef MK_MIX
#define MK_MIX 15
#endif
    { const Frame F = opq(F0); unsigned char* ws = opq_ptr(ws0);
      if (MK_MIX & 1) for (int chain = F.bid; chain < 2 * NHA; chain += F.G) scan_chain_mfma(F, ws, chain); }
    const Frame& F = F0;
    const int n_xa = 32 * NHC, n_ca = need_ctx ? NHC : 0, n_att = n_xa + n_ca, n_hy = 640, n_ch = need_ctx ? 160 : 0;
    unsigned* qatt = (unsigned*)(ws0 + WS_CTL) + CW_QUEUE + 64 * lq; unsigned* qhy = qatt + 32;
    int item;
#define MIX_POP(q) do { if (F.tid == 0) F.MISC[16] = __hip_atomic_fetch_add((q), 1u, __ATOMIC_RELAXED, __HIP_MEMORY_SCOPE_AGENT); __syncthreads(); item = (int)F.MISC[16]; __syncthreads(); } while (0)
    if (F.bid >= 2 * NHA) {
        MIX_POP(qatt);
        while (item < n_att) {
            if (MK_MIX & 2) { unsigned char* ws = opq_ptr(ws0);
                const bf16_t* QF = (const bf16_t*)(ws + WS_QF); const bf16_t* KF = (const bf16_t*)(ws + WS_KF); const bf16_t* KVRAW = (const bf16_t*)(ws + WS_KVRAW); bf16_t* OB = (bf16_t*)(ws + WS_OBUF);
                const bool is_xa = item < n_xa; const int h = is_xa ? item % NHC : item - n_xa, row0 = is_xa ? NCTX + (item / NHC) * 256 : 0;
                for (int rp = 0; rp < REP(13); ++rp) att::attn_body(QF + (size_t)row0 * NQ + h * 192, KF + h * 192, KVRAW + h * 256 + 128, OB + (size_t)row0 * DM + 2560 + h * 128, is_xa ? T : NCTX, lds_g); }
            MIX_POP(qatt);
        }
    }
    MIX_POP(qhy);
    while (item < n_hy + n_ch) {
        const Frame Fu = opq(F0); unsigned char* ws = opq_ptr(ws0);
        if ((MK_MIX & 4) && item < n_hy) hyena_unit(Fu, ws, l, item);
        else if ((MK_MIX & 8) && item >= n_hy) hyena_ctx_unit(Fu, ws, l, item - n_hy);
        MIX_POP(qhy);
    }
#undef MIX_POP
}

__device__ __forceinline__ void hyena_taps_tail(const Frame& F0, unsigned char* ws0, int lt, int first, int end) {
    if (F0.bid < 48) return;
#pragma unroll 1
    for (int p = first + F0.bid - 48; p < end; p += 208) hyena_taps_unit(opq(F0), opq_ptr(ws0), lt, p);
}
constexpr int NPH = 2 + 14 * NL;
__global__ void __launch_bounds__(512, 2) mk_fwd(Args a) {
    extern __shared__ __attribute__((aligned(16))) unsigned char lds[];
    Frame F; F.lds = (LAS unsigned char*)lds; F.MISC = (volatile LAS unsigned*)(F.lds + LDS_MISC);
    F.tid = threadIdx.x; F.lane = F.tid & 63; F.wave = __builtin_amdgcn_readfirstlane(F.tid >> 6); F.bid = blockIdx.x; F.G = gridDim.x;
    if (F.tid < 64) F.MISC[F.tid] = 0u;
    if (F.tid < 46) *(LAS unsigned long long*)(F.lds + LDS_PTAB + 8 * F.tid) = (unsigned long long)(uintptr_t)a.in[F.tid];
    __syncthreads();
    unsigned char* ws = a.ws;
    const int lo = a.ph_lo, hi = a.ph_hi;
    XcdBarrier bar = xcd_barrier_post((unsigned*)(ws + WS_CTL) + CW_BAR, F.MISC + 8);
#ifndef MK_MASK
#define MK_MASK 0xffff
#endif
#define EN(x) (((MK_MASK) >> (x)) & 1)
#define IN(k) (lo <= (k) && (k) < hi)
#define SEAM(k) do { if (IN(k) && IN((k) + 1)) xcd_barrier(bar); } while (0)
#define WSP opq_ptr(ws)
#define P_XS(w) ((float*)((w) + WS_XS))
#define P_ABUF(w) ((bf16_t*)((w) + WS_ABUF))
#define P_HBUF(w) ((bf16_t*)((w) + WS_HBUF))
#define P_OBUF(w) ((bf16_t*)((w) + WS_OBUF))
#define P_MODX(w, l) ((const float*)((w) + WS_MOD) + ((size_t)(l) * 2 + 0) * NMOD)
#define P_MODC(w, l) ((const float*)((w) + WS_MOD) + ((size_t)(l) * 2 + 1) * NMOD)
#define P_WL(w, l) ((const bf16_t*)((w) + WS_WB) + (size_t)(l) * W_LAYER)
    if (EN(0) && IN(0)) for (int rp = 0; rp < REP(0); ++rp) phase0(opq(F), opq_ptr(ws));
    SEAM(0);
    if (EN(1) && IN(1)) phase_mod(opq(F), opq_ptr(ws));
    SEAM(1);
#pragma clang loop unroll(full)
    for (int l = 0; l < NL; ++l) {
        const int pb = 2 + 14 * l; const bool need_ctx = l < NL - 1;
        if (EN(2) && IN(pb + 0)) for (int rp = 0; rp < REP(2); ++rp) { unsigned char* w = WSP; norm_phase(opq(F), P_XS(w), IN_(7) + l * DM, P_MODX(w, l), P_MODC(w, l), 0, 1, P_ABUF(w), l > 0 ? (const bf16_t*)(w + WS_SLAB) : nullptr, l > 0 ? P_MODC(w, l - 1) + 8 * DM : nullptr, 0.5f, l == 0 ? IN_(0) - (size_t)NCTX * DM : (const float*)P_XS(w)); }
        SEAM(pb + 0);
        if (EN(3) && IN(pb + 1)) { unsigned char* w = WSP; pg8::Gemm g{P_ABUF(w), P_WL(w, l) + W_G1, T, 2 * FF, DM, DM}; pg8::StaticOrder S; S.init(T, 2 * FF, F.G, F.bid); pg8::EpiSwiGLU E{P_HBUF(w), FF};
            pg8::gemm_phase<pg8::EpiSwiGLU, pg8::StaticOrder>(F.lds, g, S, E, nullptr);
            hyena_taps_tail(F, ws, l, 0, l == 0 ? 640 : 416); }
        SEAM(pb + 1);
        if (EN(4) && IN(pb + 2)) {
            { unsigned char* w = WSP; pg8::Gemm g{P_HBUF(w), P_WL(w, l) + W_D1, T, DM, FF, FF}; pg8::StaticOrderX S; S.init(T, DM, F.G, F.bid); pg8::EpiResid E{P_XS(w), P_MODX(w, l) + 2 * DM, P_MODC(w, l) + 2 * DM, 0.5f, nullptr, l == 0 ? IN_(0) : nullptr};
              pg8::gemm_phase<pg8::EpiResid, pg8::StaticOrderX>(F.lds, g, S, E, nullptr); }
            if (true) { __syncthreads();
              if (F.bid < 256) { unsigned char* w = WSP; const int ks = F.bid >> 4, ksz = FF / 16; pg8::Gemm g{P_HBUF(w) + ks * ksz, P_WL(w, l) + W_D1 + ks * ksz, NCTX, DM, ksz, FF}; pg8::OneUnit S{F.bid & 15};
                  pg8::EpiBf16<0> E{(bf16_t*)(w + WS_SLAB) + (size_t)ks * NCTX * DM, DM, nullptr, 0, 0};
                  pg8::gemm_phase<pg8::EpiBf16<0>, pg8::OneUnit>(F.lds, g, S, E, nullptr); } }
        }
        SEAM(pb + 2);
        if (EN(5) && IN(pb + 3)) for (int rp = 0; rp < REP(2); ++rp) { unsigned char* w = WSP; norm_phase(opq(F), P_XS(w), IN_(8) + l * DM, P_MODX(w, l), P_MODC(w, l), 3, 4, P_ABUF(w), (const bf16_t*)(w + WS_SLAB), P_MODC(w, l) + 2 * DM, 0.5f, P_XS(w)); }
        SEAM(pb + 3);
        if (EN(6) && IN(pb + 4)) { unsigned char* w = WSP; pg8::Gemm g{P_ABUF(w), P_WL(w, l) + W_IN, T, PXW, DM, DM}; pg8::StaticOrder S; S.init(T, PXW, F.G, F.bid); pg8::EpiBf16<0> E{(bf16_t*)(w + WS_PX), PXW, nullptr, 0, 0};
            pg8::gemm_phase<pg8::EpiBf16<0>, pg8::StaticOrder>(F.lds, g, S, E, nullptr); }
        SEAM(pb + 4);
        if (EN(7) && IN(pb + 5)) { for (int rp = 0; rp < REP(7); ++rp) rwkv_fused_phase(opq(F), opq_ptr(ws), l); if (!(MK_ONLYRP)) { for (int rp = 0; rp < REP(8); ++rp) mla_prep_phase(opq(F), opq_ptr(ws), l); hyena_prep_phase(opq(F), opq_ptr(ws), l); } }
        SEAM(pb + 5);
        if (EN(8) && IN(pb + 6)) {
            { unsigned char* w = WSP; pg8::Gemm g{(const bf16_t*)(w + WS_QA), P_WL(w, l) + W_Q, T, NQ, 1024, 1024}; pg8::StaticOrder S; S.init(T, NQ, F.G, F.bid); pg8::EpiBf16<0> E{(bf16_t*)(w + WS_QRAW), NQ, nullptr, 0, 0};
              pg8::gemm_phase<pg8::EpiBf16<0>, pg8::StaticOrder>(F.lds, g, S, E, nullptr); }
            __syncthreads();
            { unsigned char* w = WSP; pg8::Gemm g{(const bf16_t*)(w + WS_KVA), P_WL(w, l) + W_KV, T, NKV, 512, 512}; pg8::StaticOrder S; S.init(T, NKV, F.G, (F.bid + 208) & 255);     pg8::EpiBf16<0> E{(bf16_t*)(w + WS_KVRAW), NKV, nullptr, 0, 0};
              pg8::gemm_phase<pg8::EpiBf16<0>, pg8::StaticOrder>(F.lds, g, S, E, nullptr); }
        }
        SEAM(pb + 6);
        if (EN(9) && IN(pb + 7)) { for (int rp = 0; rp < REP(8); ++rp) qkv_final_phase(opq(F), opq_ptr(ws), l, need_ctx); }
        SEAM(pb + 7);
        if (EN(10) && IN(pb + 8)) for (int rp = 0; rp < REP(10); ++rp) mixer_phase(F, ws, l + 4 * rp, need_ctx, (char*)lds);
        SEAM(pb + 8);
        if (EN(11) && IN(pb + 9)) { for (int rp = 0; rp < REP(8); ++rp) rwkv_out_phase(opq(F), opq_ptr(ws), l, need_ctx); hyena_out_phase(opq(F), opq_ptr(ws), need_ctx); }
        SEAM(pb + 9);
        if (EN(12) && IN(pb + 10)) {
            { unsigned char* w = WSP; pg8::Gemm g{P_OBUF(w), P_WL(w, l) + W_OUT, T, DM, DM, DM}; pg8::StaticOrderX S; S.init(T, DM, F.G, F.bid); pg8::EpiResid E{P_XS(w), P_MODX(w, l) + 5 * DM, P_MODC(w, l) + 5 * DM, 1.0f, nullptr, nullptr};
              pg8::gemm_phase<pg8::EpiResid, pg8::StaticOrderX>(F.lds, g, S, E, nullptr); }
            if (need_ctx) { __syncthreads();
              if (F.bid < 256) { unsigned char* w = WSP; const int ks = F.bid >> 4, ksz = DM / 16; pg8::Gemm g{P_OBUF(w) + ks * ksz, P_WL(w, l) + W_OUT + ks * ksz, NCTX, DM, ksz, DM}; pg8::OneUnit S{F.bid & 15};
                  pg8::EpiBf16<0> E{(bf16_t*)(w + WS_SLAB) + (size_t)ks * NCTX * DM, DM, nullptr, 0, 0};
                  pg8::gemm_phase<pg8::EpiBf16<0>, pg8::OneUnit>(F.lds, g, S, E, nullptr); } }
        }
        SEAM(pb + 10);
        if (EN(13) && IN(pb + 11)) for (int rp = 0; rp < REP(2); ++rp) { unsigned char* w = WSP; norm_phase(opq(F), P_XS(w), IN_(9) + l * DM, P_MODX(w, l), P_MODC(w, l), 6, 7, P_ABUF(w), need_ctx ? (const bf16_t*)(w + WS_SLAB) : nullptr, P_MODC(w, l) + 5 * DM, 1.0f, P_XS(w)); }
        SEAM(pb + 11);
        if (EN(14) && IN(pb + 12)) { if (need_ctx) { unsigned char* w = WSP; pg8::Gemm g{P_ABUF(w), P_WL(w, l) + W_G2, T, 2 * FF, DM, DM}; pg8::StaticOrder S; S.init(T, 2 * FF, F.G, F.bid); pg8::EpiSwiGLU E{P_HBUF(w), FF};
            pg8::gemm_phase<pg8::EpiSwiGLU, pg8::StaticOrder>(F.lds, g, S, E, nullptr);
            hyena_taps_tail(F, ws, l + 1, 416, 640); }       else { unsigned char* w = WSP; pg8::Gemm g{P_ABUF(w), P_WL(w, l) + W_G2, T, 2 * FF, DM, DM}; pg8::StaticOrderX S; S.init(T, 2 * FF, F.G, F.bid); pg8::EpiSwiGLU E{P_HBUF(w), FF};
            pg8::gemm_phase<pg8::EpiSwiGLU, pg8::StaticOrderX>(F.lds, g, S, E, nullptr); } }
        SEAM(pb + 12);
        if (EN(15) && IN(pb + 13)) {
            { unsigned char* w = WSP; pg8::Gemm g{P_HBUF(w), P_WL(w, l) + W_D2, T, DM, FF, FF}; pg8::StaticOrderX S; S.init(T, DM, F.G, F.bid); pg8::EpiResid E{P_XS(w), P_MODX(w, l) + 8 * DM, P_MODC(w, l) + 8 * DM, 0.5f, l == NL - 1 ? a.out : nullptr, nullptr};
              pg8::gemm_phase<pg8::EpiResid, pg8::StaticOrderX>(F.lds, g, S, E, nullptr); }
            if (need_ctx) { __syncthreads();
              if (F.bid < 256) { unsigned char* w = WSP; const int ks = F.bid >> 4, ksz = FF / 16; pg8::Gemm g{P_HBUF(w) + ks * ksz, P_WL(w, l) + W_D2 + ks * ksz, NCTX, DM, ksz, FF}; pg8::OneUnit S{F.bid & 15};
                  pg8::EpiBf16<0> E{(bf16_t*)(w + WS_SLAB) + (size_t)ks * NCTX * DM, DM, nullptr, 0, 0};
                  pg8::gemm_phase<pg8::EpiBf16<0>, pg8::OneUnit>(F.lds, g, S, E, nullptr); } }
        }
        SEAM(pb + 13);
    }
#undef IN
#undef SEAM
}

#ifndef MK_LAUNCHES
#define MK_LAUNCHES 1
#endif
extern "C" void kernel_launch(void* const* d_in, const int* in_sizes, int n_in, void* d_out, int out_size, void* d_ws, size_t ws_size, hipStream_t stream) {
    static int grid = 0;
    if (grid == 0) {
        if (n_in != 46 || in_sizes[0] != SEQ * DM || out_size != SEQ * DM || ws_size < WS_END) {
            fprintf(stderr, "kernel_launch: shape mismatch: n_in %d in0 %d out %d ws %zu (need %zu); nothing launched\n", n_in, n_in > 0 ? in_sizes[0] : -1, out_size, ws_size, (size_t)WS_END); grid = -1; return; }
        int dev = 0, cus = 0, per_cu = 0;
        if (hipGetDevice(&dev) != hipSuccess || hipDeviceGetAttribute(&cus, hipDeviceAttributeMultiprocessorCount, dev) != hipSuccess) { fprintf(stderr, "kernel_launch: device query failed\n"); grid = -1; return; }
        if (hipFuncSetAttribute((const void*)mk_fwd, hipFuncAttributeMaxDynamicSharedMemorySize, LDS_BYTES) != hipSuccess) { fprintf(stderr, "kernel_launch: hipFuncSetAttribute failed\n"); grid = -1; return; }
        if (hipOccupancyMaxActiveBlocksPerMultiprocessor(&per_cu, (const void*)mk_fwd, 512, LDS_BYTES) != hipSuccess || per_cu < 1) fprintf(stderr, "kernel_launch: note: occupancy query reports %d blocks per CU\n", per_cu);
        (void)hipGetLastError();
        grid = cus;
        if (cus != 256) { fprintf(stderr, "kernel_launch: built for 256 CUs (split-K of the context panel, hyena scratch), found %d; nothing launched\n", cus); grid = -1; return; }
    }
    if (grid < 0) return;
    if (hipMemsetAsync((char*)d_ws + WS_CTL, 0, CTL_BYTES, stream) != hipSuccess) { fprintf(stderr, "kernel_launch: memset failed\n"); return; }
    Args a{};
    for (int i = 0; i < 46; ++i) a.in[i] = (const float*)d_in[i];
    a.out = (float*)d_out; a.ws = (unsigned char*)d_ws;
    a.ph_lo = 0; a.ph_hi = NPH;
    hipLaunchKernelGGL(mk_fwd, dim3(grid), dim3(512), LDS_BYTES, stream, a);
    const hipError_t le = hipPeekAtLastError();
    if (le != hipSuccess) fprintf(stderr, "kernel_launch: launch failed: %s\n", hipGetErrorName(le));
}
```

```cpp
#include <hip/hip_runtime.h>
#include <stdint.h>
#include <cstdio>

#define LAS __attribute__((address_space(3)))
#define CAS __attribute__((address_space(4)))
typedef unsigned short bf16_t;
typedef float f32x4 __attribute__((ext_vector_type(4)));
typedef float f32x2 __attribute__((ext_vector_type(2)));
typedef unsigned u32x4 __attribute__((ext_vector_type(4)));
typedef unsigned u32x2 __attribute__((ext_vector_type(2)));

constexpr int T = 8448, NCTX = 256, SEQ = 8192, DM = 4096, FF = 6144, NL = 4;
constexpr int A_W = 1280, A_IN = 4160, B_IN = 3840, C_IN = 1600, NHA = 20;
constexpr int PXW = 9728, PXA = 0, PXB = 4160, PXC = 8000;
constexpr int NQ = 2304, NKV = 3072, NHC = 12;
constexpr int NMOD = 9 * DM;
constexpr float NORM_EPS = 1e-6f, GN_EPS = 64e-5f;

constexpr size_t MiB = 1u << 20;
constexpr size_t al(size_t x) { return (x + MiB - 1) / MiB * MiB; }
constexpr size_t WS_CTL = 0, CTL_BYTES = MiB;
constexpr size_t WS_XS = WS_CTL + CTL_BYTES;
constexpr size_t WS_ABUF = WS_XS + al((size_t)T * DM * 4);
constexpr size_t WS_HBUF = WS_ABUF + al((size_t)T * DM * 2);
constexpr size_t WS_OBUF = WS_HBUF + al((size_t)T * FF * 2);
constexpr size_t WS_PX = WS_OBUF + al((size_t)T * DM * 2);
constexpr size_t WS_MOD = WS_PX + al((size_t)T * PXW * 4);
constexpr size_t WS_HP = WS_MOD + al((size_t)NL * 2 * NMOD * 4);
constexpr size_t WS_SS = WS_HP + MiB;
constexpr size_t WS_SD = WS_SS + al((size_t)NHA * T * 192 * 4);
constexpr size_t WS_WLR = WS_SD + al((size_t)NHA * 2 * T * 192 * 4);
constexpr size_t WS_G = WS_WLR + al((size_t)NL * A_W * 448 * 2);
constexpr size_t WS_Y = WS_G + al((size_t)T * A_W * 4);
constexpr size_t WS_QA = WS_Y + al((size_t)2 * T * A_W * 4);
constexpr size_t WS_KVA = WS_QA + al((size_t)T * 1024 * 2);
constexpr size_t WS_KPE = WS_KVA + al((size_t)T * 512 * 2);
constexpr size_t WS_QRAW = WS_KPE + al((size_t)T * 64 * 2);
constexpr size_t WS_KVRAW = WS_QRAW + al((size_t)T * NQ * 2);
constexpr size_t WS_QF = WS_KVRAW + al((size_t)T * NKV * 2);
constexpr size_t WS_KF = WS_QF + al((size_t)T * NQ * 2);
constexpr size_t WS_H3 = WS_KF + al((size_t)T * NQ * 2);
constexpr size_t WS_HSCR = WS_H3 + al((size_t)NL * T * 64 * 4);
constexpr int HT_STRIDE = 17 * 512;
constexpr size_t WS_HTN = WS_HSCR + (size_t)640 * HT_STRIDE * 16;
constexpr size_t WS_FR = WS_HSCR + al((size_t)640 * HT_STRIDE * 16 + 640 * 8);
constexpr size_t WS_GT = WS_FR + al((size_t)40 * 528 * (14 * 1024));
constexpr size_t WS_X0T = WS_GT + al((size_t)1280 * T * 4);
constexpr size_t WS_SLAB = WS_FR;
constexpr size_t WS_WB = WS_X0T + al((size_t)1280 * T * 4);
constexpr size_t W_G1 = 0, W_D1 = W_G1 + (size_t)2 * FF * DM, W_IN = W_D1 + (size_t)DM * FF, W_OUT = W_IN + (size_t)PXW * DM, W_G2 = W_OUT + (size_t)DM * DM,
                 W_D2 = W_G2 + (size_t)2 * FF * DM, W_Q = W_D2 + (size_t)DM * FF, W_KV = W_Q + (size_t)NQ * 1024, W_LAYER = W_KV + (size_t)NKV * 512;
constexpr size_t WS_END = WS_WB + al(W_LAYER * NL * 2);
constexpr int CW_BAR = 4096;
constexpr int CW_QUEUE = 8192;

constexpr int LDS_MISC = 143360, LDS_BYTES = 147456;

__device__ __forceinline__ float wave_sum(float v) {
#pragma unroll
    for (int o = 1; o < 64; o <<= 1) v += __shfl_xor(v, o);
    return v;
}
__device__ __forceinline__ float wave_sum16(const float (&x)[16], int lane) {
    const bool b5 = (lane & 32) != 0, b4 = (lane & 16) != 0, b3 = (lane & 8) != 0, b2 = (lane & 4) != 0;
    float k8[8], k4[4], k2[2];
#pragma unroll
    for (int i = 0; i < 8; ++i) k8[i] = (b5 ? x[8 + i] : x[i]) + __shfl_xor(b5 ? x[i] : x[8 + i], 32);
#pragma unroll
    for (int i = 0; i < 4; ++i) k4[i] = (b4 ? k8[4 + i] : k8[i]) + __shfl_xor(b4 ? k8[i] : k8[4 + i], 16);
#pragma unroll
    for (int i = 0; i < 2; ++i) k2[i] = (b3 ? k4[2 + i] : k4[i]) + __shfl_xor(b3 ? k4[i] : k4[2 + i], 8);
    float k1 = (b2 ? k2[1] : k2[0]) + __shfl_xor(b2 ? k2[0] : k2[1], 4);
    k1 += __shfl_xor(k1, 1); k1 += __shfl_xor(k1, 2);
    return k1;
}
typedef __bf16 bf16x2_t __attribute__((ext_vector_type(2)));
__device__ __forceinline__ unsigned cvt_pk_bf16(float lo, float hi) { const f32x2 v = {lo, hi}; return __builtin_bit_cast(unsigned, __builtin_convertvector(v, bf16x2_t)); }
__device__ __forceinline__ float bf2f(unsigned short b) { return __uint_as_float(((unsigned)b) << 16); }
__device__ __forceinline__ f32x4 bf4f(u32x2 w) { return (f32x4){__uint_as_float(w.x << 16), __uint_as_float(w.x & 0xffff0000u), __uint_as_float(w.y << 16), __uint_as_float(w.y & 0xffff0000u)}; }
__device__ __forceinline__ float sigmoidf_(float x) { return 1.0f / (1.0f + __expf(-x)); }
__device__ __forceinline__ float siluf_(float x) { return x / (1.0f + __expf(-x)); }
__device__ __forceinline__ bool has_left(int tau) { return tau != 0 && tau != NCTX; }
__device__ __forceinline__ bool has_right(int tau) { return tau != NCTX - 1 && tau != T - 1; }

struct Args { const float* in[46]; float* out; unsigned char* ws; int ph_lo, ph_hi; };
struct Frame { LAS unsigned char* lds; volatile LAS unsigned* MISC; int tid, lane, wave, bid, G; };
constexpr int LDS_PTAB = LDS_MISC + 2048;
__device__ __forceinline__ const float* inp(const Frame& F, int i) {
    const volatile LAS unsigned* p = (const volatile LAS unsigned*)(F.lds + LDS_PTAB) + 2 * i;
    const unsigned lo = __builtin_amdgcn_readfirstlane(p[0]), hi = __builtin_amdgcn_readfirstlane(p[1]);
    return (const float*)(((unsigned long long)hi << 32) | lo);
}
#define IN_(i) inp(F, (i))
__device__ __forceinline__ Frame opq(const Frame& F) { Frame G = F; asm volatile("" : "+v"(G.tid), "+s"(G.wave), "+s"(G.bid)); G.lane = G.tid & 63; return G; }
__device__ __forceinline__ unsigned char* opq_ptr(unsigned char* p) { asm volatile("" : "+s"(p)); return p; }
#ifndef MK_REP
#define MK_REP 0
#endif
#ifndef MK_ONLYRP
#define MK_ONLYRP 0
#endif
#define REP(x) (1 + (((MK_REP) >> (x)) & 1))
#define XB_TMO      128
#define XB_XCNT(j)  (256  + 64 * (j))
#define XB_XSUB(j)  (1280 + 64 * (j))
#define XB_XGEN(j)  (2304 + 64 * (j))
#define XB_TOP      3328
#define XB_TOPGEN   3392
#define XCD_BAR_WORDS 3456
#define XB_SPIN_CAP (1u << 18)

__device__ __forceinline__ unsigned xb_ld(unsigned* p)              { return __hip_atomic_load(p, __ATOMIC_RELAXED, __HIP_MEMORY_SCOPE_AGENT); }
__device__ __forceinline__ unsigned xb_add(unsigned* p, unsigned v) { return __hip_atomic_fetch_add(p, v, __ATOMIC_RELAXED, __HIP_MEMORY_SCOPE_AGENT); }
__device__ __forceinline__ unsigned xb_xcc_id() { return (unsigned)__builtin_amdgcn_s_getreg((3 << 11) | 20) & 0xFu; }
#define XB_SPIN(cond, bar) do { unsigned _sp = 0; while (cond) { __builtin_amdgcn_s_sleep(1); \
    if ((++_sp & 255u) == 0u) { if (xb_ld(&(bar)[XB_TMO])) break; if (_sp > XB_SPIN_CAP) { atomicAdd(&(bar)[XB_TMO], 1u); break; } } } } while (0)

struct XcdBarrier {
    unsigned* bar; unsigned x;
    volatile LAS unsigned* st;
};

__device__ __forceinline__ XcdBarrier xcd_barrier_post(unsigned* bar, volatile LAS unsigned* st) {
    XcdBarrier b; b.bar = bar; b.x = xb_xcc_id(); b.st = st;
    if (threadIdx.x == 0) (void)xb_add(&bar[XB_XCNT(b.x)], 1u);
    return b;
}
__device__ __forceinline__ void xcd_barrier_complete(unsigned* bar, unsigned x, unsigned& nloc, unsigned& nx) {
    const unsigned G = gridDim.x * gridDim.y * gridDim.z;
    unsigned sum, cnt, mine, sp = 0u;
    for (;;) {
        sum = 0u; cnt = 0u; mine = 0u;
#pragma unroll
        for (unsigned j = 0; j < 16; ++j) { const unsigned c = xb_ld(&bar[XB_XCNT(j)]); sum += c; cnt += (c > 0u) ? 1u : 0u; mine = (j == x) ? c : mine; }
        if (sum == G) break;
        __builtin_amdgcn_s_sleep(1);
        if ((++sp & 255u) == 0u) { if (xb_ld(&bar[XB_TMO])) break; if (sp > XB_SPIN_CAP) { atomicAdd(&bar[XB_TMO], 1u); break; } }
    }
    nloc = mine > 0u ? mine : 1u; nx = cnt > 0u ? cnt : 1u;
}

__device__ __forceinline__ void xcd_barrier(const XcdBarrier& b) {
    asm volatile("s_waitcnt vmcnt(0)" ::: "memory");
    __syncthreads();
    if (threadIdx.x == 0) {
        unsigned* bar = b.bar;
        __builtin_amdgcn_s_waitcnt(0);
        unsigned nloc = b.st[0], nx = b.st[1];
        if (nloc == 0u) { xcd_barrier_complete(bar, b.x, nloc, nx); b.st[0] = nloc; b.st[1] = nx; }
        const unsigned old = xb_add(&bar[XB_XSUB(b.x)], 1u);
        const unsigned gen = old / nloc;
        if (old + 1u == (gen + 1u) * nloc) {
            __builtin_amdgcn_fence(__ATOMIC_RELEASE, "agent");
            asm volatile("s_waitcnt vmcnt(0)" ::: "memory");
            const unsigned og = xb_add(&bar[XB_TOP], 1u);
            const unsigned tg = og / nx;
            if (og + 1u == (tg + 1u) * nx) xb_add(&bar[XB_TOPGEN], 1u);
            else XB_SPIN(xb_ld(&bar[XB_TOPGEN]) == tg, bar);
            __builtin_amdgcn_fence(__ATOMIC_ACQUIRE, "agent");
            xb_add(&bar[XB_XGEN(b.x)], 1u);
            asm volatile("s_waitcnt vmcnt(0)" ::: "memory");
        } else {
            XB_SPIN(xb_ld(&bar[XB_XGEN(b.x)]) == gen, bar);
            __builtin_amdgcn_fence(__ATOMIC_ACQUIRE, "agent");
            asm volatile("s_waitcnt vmcnt(0)" ::: "memory");
        }
    }
    __syncthreads();
}
namespace pg8 {
#define PG8_LAS __attribute__((address_space(3)))
typedef unsigned short bf16_t;
typedef short bf16x8 __attribute__((ext_vector_type(8)));
typedef float f32x4 __attribute__((ext_vector_type(4)));
typedef unsigned u32x4 __attribute__((ext_vector_type(4)));
constexpr int BM = 256, BK = 64, HALF = 128, HTB = HALF * BK * 2  , STAGE_BYTES = 8 * HTB, NXCD = 8, WGM = 4;

__host__ __device__ __forceinline__ int lds_byte(int r, int c) { const int st = (r >> 4) * 2 + (c >> 5), rr = r & 15, cc = c & 31, ob = rr * 64 + cc * 2; return st * 1024 + (ob ^ (((ob >> 9) & 1) << 5)); }
__host__ __device__ __forceinline__ void stage_rc(int b, int& R, int& C) { const int st = b / 1024, sb = b % 1024, swz = sb ^ (((sb >> 9) & 1) << 5); R = (st >> 1) * 16 + swz / 64; C = (st & 1) * 32 + (swz % 64) / 2; }
__host__ __device__ __forceinline__ int perm32(int rho) { const int n = rho >> 4, i = rho & 15; return 8 * (i >> 2) + 4 * n + (i & 3); }

struct Unit { int pm, pn; };
struct Gemm { const bf16_t* A; const bf16_t* Bt; int M, N, K, ld; };

struct StaticOrder {
    int nM, nN, nwg, G, c;
    __host__ __device__ void init(int M, int N, int G_, int c_) { nM = M / BM; nN = N / BM; nwg = nM * nN; G = G_; c = c_; }
    __host__ __device__ bool next(int i, Unit& u) const {
        const long L = (long)i * G + c; if (L >= nwg) return false;
        int wgid = (int)L; { const int q = nwg / NXCD, r = nwg % NXCD, xcd = wgid % NXCD, off = wgid / NXCD; wgid = (xcd < r ? xcd * (q + 1) : r * (q + 1) + (xcd - r) * q) + off; }
        const int nig = WGM * nN, gid = wgid / nig, fm = gid * WGM, gsz = (nM - fm) < WGM ? (nM - fm) : WGM;
        u.pm = fm + ((wgid % nig) % gsz); u.pn = (wgid % nig) / gsz; return true;
    }
    __device__ __forceinline__ void a_ready(const Unit&) const {}
    __device__ __forceinline__ void done(const Unit&) const {}
};
struct CountedOrder : StaticOrder {
    const unsigned* ready; unsigned need; unsigned* tmo;
    __device__ __forceinline__ void a_ready(const Unit& u) const {
        if (threadIdx.x < 64) {
            const unsigned long long t0 = __builtin_amdgcn_s_memrealtime(); unsigned polls = 0;
            while ((unsigned)__builtin_amdgcn_readfirstlane(__hip_atomic_load(ready + 64 * u.pm, __ATOMIC_RELAXED, __HIP_MEMORY_SCOPE_AGENT)) < need) {
                if ((++polls & 255u) == 0u && __builtin_amdgcn_readfirstlane(__hip_atomic_load(tmo, __ATOMIC_RELAXED, __HIP_MEMORY_SCOPE_AGENT)) != 0u) break;
                if (__builtin_amdgcn_s_memrealtime() - t0 > 2000000ull) {
                    if (threadIdx.x == 0) { unsigned expect = 0u; __hip_atomic_compare_exchange_strong(tmo + 1, &expect, 0x600u | (unsigned)(u.pm & 0xff), __ATOMIC_RELAXED, __ATOMIC_RELAXED, __HIP_MEMORY_SCOPE_AGENT); __hip_atomic_store(tmo, 1u, __ATOMIC_RELAXED, __HIP_MEMORY_SCOPE_AGENT); }
                    break; }
                __builtin_amdgcn_s_sleep(2); }
            __builtin_amdgcn_fence(__ATOMIC_ACQUIRE, "agent");
            asm volatile("s_waitcnt vmcnt(0)" ::: "memory");
        }
#if !defined(BROKEN_HOOK_NO_BARRIER)
        asm volatile("" ::: "memory"); __builtin_amdgcn_s_barrier(); asm volatile("" ::: "memory");
#endif
    }
};

__device__ __forceinline__ unsigned cvt_pk_bf16(float lo, float hi) { unsigned r; asm volatile("v_cvt_pk_bf16_f32 %0, %1, %2" : "=v"(r) : "v"(lo), "v"(hi)); return r; }
typedef float f32x2 __attribute__((ext_vector_type(2)));
__device__ __forceinline__ f32x2 gelu_pk(f32x2 v) {
    const f32x2 av = __builtin_elementwise_abs(v), d = av * 0.2316418882f + 1.0f;
    f32x2 t; t.x = __builtin_amdgcn_rcpf(d.x); t.y = __builtin_amdgcn_rcpf(d.y);
    f32x2 q = t * 0.5307027145f + (-0.7265760135f); q = q * t + 0.7107068705f; q = q * t + (-0.142248368f); q = q * t + 0.127414796f; q = q * t;
    const f32x2 s = (v * v) * (-0.72134752044f);
    f32x2 e; e.x = __builtin_amdgcn_exp2f(s.x); e.y = __builtin_amdgcn_exp2f(s.y);
    const f32x2 m = v * (q * e), r = v - m;
    f32x2 o; o.x = v.x < 0.f ? m.x : r.x; o.y = v.y < 0.f ? m.y : r.y; return o;
}

struct EpiF32 {
    static constexpr bool PERM = false, AFTER_DRAIN = false;
    float* C; int ldc; const float* bias;
    __device__ __forceinline__ void operator()(const f32x4 (&acc)[2][2][4][2], const Unit& u, int wr, int wc, int fr, int fq) const {
        const int row0 = u.pm * BM + wr * 64 + fr, col0 = u.pn * BM + wc * 32 + 4 * fq;
        f32x4 bv[2][2];
#pragma unroll
        for (int bj = 0; bj < 2; ++bj)
#pragma unroll
            for (int n = 0; n < 2; ++n) bv[bj][n] = bias ? *(const f32x4*)(bias + col0 + bj * HALF + n * 16) : (f32x4){0.f, 0.f, 0.f, 0.f};
#pragma unroll
        for (int ai = 0; ai < 2; ++ai)
#pragma unroll
            for (int m = 0; m < 4; ++m) { float* rowp = C + (size_t)(row0 + ai * HALF + m * 16) * ldc + col0;
#pragma unroll
                for (int bj = 0; bj < 2; ++bj)
#pragma unroll
                    for (int n = 0; n < 2; ++n) *(f32x4*)(rowp + bj * HALF + n * 16) = acc[ai][bj][m][n] + bv[bj][n]; }
    }
};
template <int ACT  > struct EpiBf16 {
    static constexpr bool PERM = true, AFTER_DRAIN = false;
    bf16_t* O; int ldc; const float* bias; int split_cols; size_t split_stride;
    __device__ __forceinline__ void operator()(const f32x4 (&acc)[2][2][4][2], const Unit& u, int wr, int wc, int fr, int fq) const {
        const int row0 = u.pm * BM + wr * 64 + fr; int colt = u.pn * BM; bf16_t* base = O;
        if (split_cols) { const int t = colt / split_cols; base += (size_t)t * split_stride; colt -= t * split_cols; }
        const int col0 = colt + wc * 32 + 8 * fq, bcol0 = u.pn * BM + wc * 32 + 8 * fq;
        f32x4 bv[2][2];
#pragma unroll
        for (int bj = 0; bj < 2; ++bj)
#pragma unroll
            for (int n = 0; n < 2; ++n) bv[bj][n] = bias ? *(const f32x4*)(bias + bcol0 + bj * HALF + 4 * n) : (f32x4){0.f, 0.f, 0.f, 0.f};
#pragma unroll
        for (int ai = 0; ai < 2; ++ai)
#pragma unroll
            for (int m = 0; m < 4; ++m) { bf16_t* rowp = base + (size_t)(row0 + ai * HALF + m * 16) * ldc + col0;
#pragma unroll
                for (int bj = 0; bj < 2; ++bj) { f32x4 v0 = acc[ai][bj][m][0] + bv[bj][0], v1 = acc[ai][bj][m][1] + bv[bj][1];
                    if (ACT == 1) { f32x2 a = gelu_pk((f32x2){v0[0], v0[1]}), b = gelu_pk((f32x2){v0[2], v0[3]}), c = gelu_pk((f32x2){v1[0], v1[1]}), d = gelu_pk((f32x2){v1[2], v1[3]});
                        v0 = (f32x4){a.x, a.y, b.x, b.y}; v1 = (f32x4){c.x, c.y, d.x, d.y}; }
                    if (ACT == 2) {
#pragma unroll
                        for (int j = 0; j < 4; ++j) { v0[j] = 0.5f * v0[j] * (1.0f + erff(v0[j] * 0.70710678f)); v1[j] = 0.5f * v1[j] * (1.0f + erff(v1[j] * 0.70710678f)); } }
                    u32x4 w; w.x = cvt_pk_bf16(v0[0], v0[1]); w.y = cvt_pk_bf16(v0[2], v0[3]); w.z = cvt_pk_bf16(v1[0], v1[1]); w.w = cvt_pk_bf16(v1[2], v1[3]);
                    *(u32x4*)(rowp + bj * HALF) = w; } }
    }
};
}
namespace pg8 {
struct EpiSwiGLU {
    static constexpr bool PERM = true, AFTER_DRAIN = false;
    bf16_t* O; int ldc;
    __device__ __forceinline__ void operator()(const f32x4 (&acc)[2][2][4][2], const Unit& u, int wr, int wc, int fr, int fq) const {
        const int row0 = u.pm * BM + wr * 64 + fr, col0 = u.pn * HALF + wc * 32 + 8 * fq;
#pragma unroll
        for (int ai = 0; ai < 2; ++ai)
#pragma unroll
            for (int m = 0; m < 4; ++m) { bf16_t* rowp = O + (size_t)(row0 + ai * HALF + m * 16) * ldc + col0;
                float h[8];
#pragma unroll
                for (int n = 0; n < 2; ++n)
#pragma unroll
                    for (int j = 0; j < 4; ++j) { const float g = acc[ai][0][m][n][j], up = acc[ai][1][m][n][j]; h[n * 4 + j] = g * __builtin_amdgcn_rcpf(1.0f + __builtin_amdgcn_exp2f(-1.4426950408889634f * g)) * up; }
                u32x4 w; w.x = cvt_pk_bf16(h[0], h[1]); w.y = cvt_pk_bf16(h[2], h[3]); w.z = cvt_pk_bf16(h[4], h[5]); w.w = cvt_pk_bf16(h[6], h[7]);
                *(u32x4*)rowp = w; }
    }
};
struct EpiResid {
    static constexpr bool PERM = false, AFTER_DRAIN = false;
    float* X; const float* gate_x; const float* gate_c; float fac; float* out_x; const float* src_x;
    __device__ __forceinline__ void operator()(const f32x4 (&acc)[2][2][4][2], const Unit& u, int wr, int wc, int fr, int fq) const {
        const int row0 = u.pm * BM + wr * 64 + fr, col0 = u.pn * BM + wc * 32 + 4 * fq;
        const float* gv = (u.pm == 0) ? gate_c : gate_x;
        float* dst = (u.pm != 0 && out_x) ? out_x - (size_t)256 * 4096 : X; const float* src = (u.pm != 0 && src_x) ? src_x - (size_t)256 * 4096 : X;
        f32x4 gg[2][2];
#pragma unroll
        for (int bj = 0; bj < 2; ++bj)
#pragma unroll
            for (int n = 0; n < 2; ++n) gg[bj][n] = *(const f32x4*)(gv + col0 + bj * HALF + n * 16) * fac;
#pragma unroll
        for (int ai = 0; ai < 2; ++ai)
#pragma unroll
            for (int m = 0; m < 4; ++m) { const size_t off = (size_t)(row0 + ai * HALF + m * 16) * 4096 + col0;
#pragma unroll
                for (int bj = 0; bj < 2; ++bj)
#pragma unroll
                    for (int n = 0; n < 2; ++n) { const f32x4 b = *(const f32x4*)(src + off + bj * HALF + n * 16); *(f32x4*)(dst + off + bj * HALF + n * 16) = b + gg[bj][n] * acc[ai][bj][m][n]; } }
    }
};
struct OneUnit { int pn;
    __host__ __device__ bool next(int i, Unit& u) const { u.pm = 0; u.pn = pn; return i == 0; }
    __device__ __forceinline__ void a_ready(const Unit&) const {}
    __device__ __forceinline__ void done(const Unit&) const {}
};
struct StaticOrderX { StaticOrder b;
    __host__ __device__ void init(int M, int N, int G_, int c_) { b.init(M - BM, N, G_, c_); }
    __host__ __device__ bool next(int i, Unit& u) const { const bool ok = b.next(i, u); u.pm += 1; return ok; }
    __device__ __forceinline__ void a_ready(const Unit&) const {}
    __device__ __forceinline__ void done(const Unit&) const {}
};
}
namespace pg8 {
template <class Epi, class Sched, bool STAMP = false>
__device__ __forceinline__ void gemm_phase(PG8_LAS unsigned char* lds, const Gemm g, const Sched& S, const Epi& E, unsigned long long* stamps) {
    int tid_ = threadIdx.x; asm volatile("" : "+v"(tid_));
    const int tid = tid_, wid = __builtin_amdgcn_readfirstlane(tid >> 6), lane = tid & 63, wr = wid >> 2, wc = wid & 3, fr = lane & 15, fq = lane >> 4;
    const int K = g.ld, nt = g.K / BK;
    int ts_lo = 0, ts_hi = 0, nts = 0; const unsigned long long rt_entry = STAMP ? (unsigned long long)wall_clock64() : 0ull;
#define PG8_STAMP() do { if (STAMP && wid == 0 && nts < 64) { const unsigned long long _c = (unsigned long long)clock64(); \
        ts_lo = (lane == nts) ? (int)(unsigned)_c : ts_lo; ts_hi = (lane == nts) ? (int)(unsigned)(_c >> 32) : ts_hi; ++nts; } } while (0)
    PG8_STAMP();
    unsigned voffA[2], voffB[2];
#pragma unroll
    for (int i = 0; i < 2; ++i) { int R, C; stage_rc(tid * 16 + i * 8192, R, C); const int Rb = Epi::PERM ? ((R & ~31) + perm32(R & 31)) : R;
        voffA[i] = (unsigned)(R * K + C) * 2u; voffB[i] = (unsigned)(Rb * K + C) * 2u; }
    const size_t kstep = (size_t)(BK * 2);
    const size_t hstep = (size_t)HALF * K * 2;
    const size_t tstep = 2 * hstep;
    const unsigned ldsw = (unsigned)wid * 1024u;
    const int aoff = lds_byte(wr * 64 + fr, fq * 8), boff = lds_byte(wc * 32 + fr, fq * 8);
#define PG8_SA(b, h) (((b) * 2 + (h)) * HTB)
#define PG8_SB(b, h) ((4 + (b) * 2 + (h)) * HTB)
#define PG8_STAGE(bufoff, gbase, voff) do { _Pragma("unroll") for (int _i = 0; _i < 2; ++_i) \
        __builtin_amdgcn_global_load_lds((const unsigned*)((const char*)(gbase) + (voff)[_i]), (PG8_LAS unsigned*)(lds + (bufoff) + ldsw + _i * 8192), 16, 0, 0); } while (0)
#define PG8_LDA(dst, b, h) do { _Pragma("unroll") for (int m = 0; m < 4; ++m) _Pragma("unroll") for (int k = 0; k < 2; ++k) dst[m][k] = *(const PG8_LAS bf16x8*)(lds + PG8_SA(b, h) + aoff + m * 2048 + k * 1024); } while (0)
#define PG8_LDB(dst, b, h) do { _Pragma("unroll") for (int n = 0; n < 2; ++n) _Pragma("unroll") for (int k = 0; k < 2; ++k) dst[n][k] = *(const PG8_LAS bf16x8*)(lds + PG8_SB(b, h) + boff + n * 2048 + k * 1024); } while (0)
#define PG8_MMA(ai, bj, At, Bt) do { __builtin_amdgcn_s_setprio(1); _Pragma("unroll") for (int m = 0; m < 4; ++m) _Pragma("unroll") for (int n = 0; n < 2; ++n) _Pragma("unroll") for (int k = 0; k < 2; ++k) \
        acc[ai][bj][m][n] = __builtin_amdgcn_mfma_f32_16x16x32_bf16(Bt[n][k], At[m][k], acc[ai][bj][m][n], 0, 0, 0); __builtin_amdgcn_s_setprio(0); } while (0)
#define PG8_WAIT_V(n) asm volatile("s_waitcnt vmcnt(" #n ")" ::: "memory")
#define PG8_WAIT_L(n) asm volatile("s_waitcnt lgkmcnt(" #n ")" ::: "memory")
#define PG8_BAR __builtin_amdgcn_s_barrier()
#define PG8_SCHED __builtin_amdgcn_sched_barrier(0)
    Unit cur, nxt; int ui = 0;
    if (!S.next(0, cur)) return;
    f32x4 acc[2][2][4][2];
#pragma unroll
    for (int a = 0; a < 2; ++a)
#pragma unroll
        for (int b = 0; b < 2; ++b)
#pragma unroll
            for (int m = 0; m < 4; ++m)
#pragma unroll
                for (int n = 0; n < 2; ++n) acc[a][b][m][n] = (f32x4){0.f, 0.f, 0.f, 0.f};
    bf16x8 At[4][2], B0[2][2], B1[2][2];
    const char* cA = (const char*)g.A + (size_t)cur.pm * tstep; const char* cB = (const char*)g.Bt + (size_t)cur.pn * tstep;
    S.a_ready(cur);
    PG8_STAGE(PG8_SB(0, 0), cB, voffB); PG8_STAGE(PG8_SA(0, 0), cA, voffA); PG8_STAGE(PG8_SB(0, 1), cB + hstep, voffB); PG8_STAGE(PG8_SA(0, 1), cA + hstep, voffA);
    if (wr == 1) PG8_BAR;
    PG8_WAIT_V(4); PG8_BAR;
    PG8_STAGE(PG8_SB(1, 0), cB + kstep, voffB); PG8_STAGE(PG8_SA(1, 0), cA + kstep, voffA); PG8_STAGE(PG8_SB(1, 1), cB + hstep + kstep, voffB);
    PG8_WAIT_V(6); PG8_BAR;
    PG8_STAMP();
    for (;;) {
        const bool has_next = S.next(ui + 1, nxt);
        const char* nA = has_next ? (const char*)g.A + (size_t)nxt.pm * tstep : cA; const char* nB = has_next ? (const char*)g.Bt + (size_t)nxt.pn * tstep : cB;
        for (int t = 0; t < nt; t += 2) {
            const bool last = (t == nt - 2);
            const char* a1 = cA + (size_t)(t + 1) * kstep;
            const char* a2 = last ? nA : cA + (size_t)(t + 2) * kstep; const char* b2 = last ? nB : cB + (size_t)(t + 2) * kstep;
            const char* a3 = a2 + kstep; const char* b3 = b2 + kstep;
            if (last && has_next) S.a_ready(nxt);
            PG8_LDB(B0, 0, 0); PG8_SCHED; PG8_LDA(At, 0, 0); PG8_STAGE(PG8_SA(1, 1), a1 + hstep, voffA);
            PG8_WAIT_L(8); PG8_BAR; PG8_WAIT_L(0); PG8_MMA(0, 0, At, B0); PG8_BAR; PG8_SCHED;
            PG8_LDB(B1, 0, 1); PG8_STAGE(PG8_SB(0, 0), b2, voffB);
            PG8_BAR; PG8_WAIT_L(0); PG8_MMA(0, 1, At, B1); PG8_BAR;
            PG8_LDA(At, 0, 1); PG8_STAGE(PG8_SA(0, 0), a2, voffA);
            PG8_BAR; PG8_WAIT_L(0); PG8_MMA(1, 0, At, B0); PG8_BAR; PG8_SCHED;
            PG8_STAGE(PG8_SB(0, 1), b2 + hstep, voffB);
            PG8_WAIT_V(6); PG8_BAR; PG8_MMA(1, 1, At, B1); PG8_BAR;
            PG8_LDB(B0, 1, 0); PG8_SCHED; PG8_LDA(At, 1, 0); PG8_STAGE(PG8_SA(0, 1), a2 + hstep, voffA);
            PG8_WAIT_L(8); PG8_BAR; PG8_WAIT_L(0); PG8_MMA(0, 0, At, B0); PG8_BAR; PG8_SCHED;
            PG8_LDB(B1, 1, 1); PG8_STAGE(PG8_SB(1, 0), b3, voffB);
            PG8_BAR; PG8_WAIT_L(0); PG8_MMA(0, 1, At, B1); PG8_BAR;
            PG8_LDA(At, 1, 1); PG8_STAGE(PG8_SA(1, 0), a3, voffA);
            PG8_BAR; PG8_WAIT_L(0); PG8_MMA(1, 0, At, B0); PG8_BAR; PG8_SCHED;
            PG8_STAGE(PG8_SB(1, 1), b3 + hstep, voffB);
            PG8_WAIT_V(6); PG8_BAR; PG8_MMA(1, 1, At, B1); PG8_BAR;
        }
        PG8_STAMP();
        if constexpr (!Epi::AFTER_DRAIN) { E(acc, cur, wr, wc, fr, fq); S.done(cur); }
        PG8_STAMP();
        if (!has_next) break;
#pragma unroll
        for (int a = 0; a < 2; ++a)
#pragma unroll
            for (int b = 0; b < 2; ++b)
#pragma unroll
                for (int m = 0; m < 4; ++m)
#pragma unroll
                    for (int n = 0; n < 2; ++n) acc[a][b][m][n] = (f32x4){0.f, 0.f, 0.f, 0.f};
        cur = nxt; cA = nA; cB = nB; ++ui;
    }
    PG8_WAIT_V(0);
    if (wr == 0) PG8_BAR;
    PG8_BAR;
    if constexpr (Epi::AFTER_DRAIN) { E.fused(acc, cur, wr, wc, fr, fq, lds, wid, lane); S.done(cur); }
    PG8_STAMP();
    if (STAMP && wid == 0) { stamps[lane] = lane < nts ? (((unsigned long long)(unsigned)ts_hi << 32) | (unsigned)ts_lo) : 0ull;
        if (lane == 62) stamps[62] = rt_entry; if (lane == 63) stamps[63] = (unsigned long long)wall_clock64(); }
#undef PG8_STAMP
#undef PG8_SA
#undef PG8_SB
#undef PG8_STAGE
#undef PG8_LDA
#undef PG8_LDB
#undef PG8_MMA
#undef PG8_WAIT_V
#undef PG8_WAIT_L
#undef PG8_BAR
#undef PG8_SCHED
}
}
#define LDS_WAIT() asm volatile("s_waitcnt lgkmcnt(0)" ::: "memory")

__device__ __forceinline__ int map_row(int n, int mode) {
    if (mode == 1) { const int j = n < FF ? n : n - FF; return (j >> 7) * 256 + (n < FF ? 0 : 128) + (j & 127); }
    return n;
}
__device__ __forceinline__ void transpose_item(const float* __restrict__ W, int K, int N, bf16_t* WT, int mode, LAS float* scr, int item, int lane) {
    const int nblk = N / 32, kb = item / nblk, nb = item % nblk, k0 = 64 * kb, n0 = 32 * nb;
#pragma unroll
    for (int i = 0; i < 32; ++i) { const int kk = 2 * i + (lane >> 5); scr[kk * 33 + (lane & 31)] = W[(size_t)(k0 + kk) * N + n0 + (lane & 31)]; }
    LDS_WAIT(); asm volatile("" ::: "memory");
    const int c = lane & 7;
#pragma unroll
    for (int j = 0; j < 4; ++j) { const int n = (lane >> 3) + 8 * j; const LAS float* s = scr + (8 * c) * 33 + n;
        u32x4 o; o.x = cvt_pk_bf16(s[0 * 33], s[1 * 33]); o.y = cvt_pk_bf16(s[2 * 33], s[3 * 33]); o.z = cvt_pk_bf16(s[4 * 33], s[5 * 33]); o.w = cvt_pk_bf16(s[6 * 33], s[7 * 33]);
        *(u32x4*)(WT + (size_t)map_row(n0 + n, mode) * K + k0 + 8 * c) = o; }
    LDS_WAIT(); asm volatile("" ::: "memory");
}
constexpr int I_G = (DM / 64) * (2 * FF / 32), I_D = (FF / 64) * (DM / 32), I_IN = (DM / 64) * (9600 / 32), I_OUT = (DM / 64) * (DM / 32), I_Q = (1024 / 64) * (NQ / 32), I_KV = (512 / 64) * (NKV / 32);
constexpr int I_LAYER = 2 * I_G + 2 * I_D + I_IN + I_OUT + I_Q + I_KV;

__device__ __forceinline__ void phase0(const Frame& F, unsigned char* ws) {
    const int gw = F.bid * 8 + F.wave, NGW = F.G * 8;
    const size_t gt = (size_t)F.bid * 512 + F.tid, NGT = (size_t)F.G * 512;
    LAS float* scr = (LAS float*)(F.lds + F.wave * 8704);
    bf16_t* WB = (bf16_t*)(ws + WS_WB);
    for (int it = gw; it < NL * I_LAYER; it += NGW) {
        const int l = it / I_LAYER; int r = it - l * I_LAYER; bf16_t* wl = WB + (size_t)l * W_LAYER;
        if (r < I_G) { transpose_item(IN_(10) + (size_t)l * DM * 2 * FF, DM, 2 * FF, wl + W_G1, 1, scr, r, F.lane); continue; } r -= I_G;
        if (r < I_D) { transpose_item(IN_(11) + (size_t)l * FF * DM, FF, DM, wl + W_D1, 0, scr, r, F.lane); continue; } r -= I_D;
        if (r < I_G) { transpose_item(IN_(12) + (size_t)l * DM * 2 * FF, DM, 2 * FF, wl + W_G2, 1, scr, r, F.lane); continue; } r -= I_G;
        if (r < I_D) { transpose_item(IN_(13) + (size_t)l * FF * DM, FF, DM, wl + W_D2, 0, scr, r, F.lane); continue; } r -= I_D;
        if (r < I_IN) { transpose_item(IN_(14) + (size_t)l * DM * 9600, DM, 9600, wl + W_IN, 0, scr, r, F.lane); continue; } r -= I_IN;
        if (r < I_OUT) { transpose_item(IN_(15) + (size_t)l * DM * DM, DM, DM, wl + W_OUT, 0, scr, r, F.lane); continue; } r -= I_OUT;
        if (r < I_Q) { transpose_item(IN_(39) + (size_t)l * 1024 * NQ, 1024, NQ, wl + W_Q, 0, scr, r, F.lane); continue; } r -= I_Q;
        transpose_item(IN_(41) + (size_t)l * 512 * NKV, 512, NKV, wl + W_KV, 0, scr, r, F.lane);
    }
    for (size_t i = gt; i < (size_t)NL * 128 * 512; i += NGT) {
        const int l = (int)(i / (128 * 512)), rr = (int)((i / 512) % 128), c = (int)(i % 512);
        const int row = 9600 + rr;
        *(u32x4*)(WB + (size_t)l * W_LAYER + W_IN + (size_t)row * DM + c * 8) = (u32x4){0u, 0u, 0u, 0u};
    }
    { bf16_t* WLR = (bf16_t*)(ws + WS_WLR); const float* wu = IN_(18); const float* au = IN_(20); const float* gu = IN_(21);
      for (size_t i = gt; i < (size_t)NL * 448 * A_W; i += NGT) { const int l = (int)(i / (448 * A_W)), k = (int)((i / A_W) % 448), col = (int)(i % A_W);
          float v;
          if (k < 128) v = wu[(((size_t)l * 2 + (k >> 6)) * 64 + (k & 63)) * A_W + col];
          else if (k < 256) v = au[(((size_t)l * 2 + ((k - 128) >> 6)) * 64 + (k & 63)) * A_W + col];
          else v = gu[((size_t)l * 192 + (k - 256)) * A_W + col];
          WLR[((size_t)l * A_W + col) * 448 + k] = (bf16_t)(cvt_pk_bf16(v, v) & 0xffffu); } }
    { f32x4* xs = (f32x4*)(ws + WS_XS); const f32x4* cx = (const f32x4*)IN_(2);
      for (size_t i = gt; i < (size_t)NCTX * DM / 4; i += NGT) xs[i] = cx[i]; }
    { float* HP = (float*)(ws + WS_HP);
      for (int it = F.bid; it < NL * 16; it += F.G) { const int l = it >> 4, ch = it & 15, w = F.tid >> 8, j = F.tid & 255;
          const float* cv = w ? IN_(3) : IN_(1); const float* ad = IN_(4) + ((size_t)l * DM + ch * 256) * 256 + j; float s = 0.f;
          for (int i = 0; i < 256; ++i) s += siluf_(cv[ch * 256 + i]) * ad[(size_t)i * 256];
          HP[((l * 16 + ch) * 2 + w) * 256 + j] = s; } }
    { float* H3 = (float*)(ws + WS_H3);
      LAS float* zb = (LAS float*)(F.lds + 73728); LAS float* ha = zb + 8 * 36; LAS float* hb = ha + 8 * 64;
      for (int it = F.bid; it < NL * (T / 8); it += F.G) { const int l = it / (T / 8), pb = it % (T / 8);
          if (F.tid < 8 * 33) { const int p = F.tid / 33, i = F.tid % 33, P = pb * 8 + p; const int L = P < NCTX ? NCTX : SEQ, t = P < NCTX ? P : P - NCTX;
              float z;
              if (i == 0) z = (float)t / (float)(L - 1);
              else { const int b = (i - 1) & 15; const float fb = 1e-4f + (float)b * ((15.0f - 1e-4f) / 15.0f); const float rev2 = 2.0f * fb * (float)t / (float)L;
                  z = i <= 16 ? cospif(rev2) : -sinpif(rev2); }
              zb[p * 36 + i] = z; }
          __syncthreads();
          const int p = F.tid >> 6, j = F.tid & 63; const float fq = IN_(36)[l * 64 + j];
          { const float* w1 = IN_(29) + (size_t)l * 33 * 64 + j; float s = IN_(30)[l * 64 + j];
            for (int i = 0; i < 33; ++i) s += zb[p * 36 + i] * w1[i * 64];
            ha[p * 64 + j] = sinf(fq * s); }
          __syncthreads();
          { const float* w2 = IN_(31) + (size_t)l * 64 * 64 + j; float s = IN_(32)[l * 64 + j];
            for (int i = 0; i < 64; ++i) s += ha[p * 64 + i] * w2[i * 64];
            hb[p * 64 + j] = sinf(fq * s); }
          __syncthreads();
          { const float* w3 = IN_(33) + (size_t)l * 64 * 64 + j; float s = IN_(34)[l * 64 + j];
            for (int i = 0; i < 64; ++i) s += hb[p * 64 + i] * w3[i * 64];
            ((bf16_t*)H3)[((size_t)l * 64 + j) * T + pb * 8 + p] = (bf16_t)(cvt_pk_bf16(sinf(fq * s), 0.f) & 0xffffu); }
          __syncthreads(); } }
}
__device__ __forceinline__ void phase_mod(const Frame& F, unsigned char* ws) {
    const float* HP = (const float*)(ws + WS_HP); float* MOD = (float*)(ws + WS_MOD);
    LAS float* hs = (LAS float*)F.lds;
    for (int it = F.bid; it < NL * (NMOD / 512); it += F.G) { const int l = it / (NMOD / 512), nb = it % (NMOD / 512);
        { const int w = F.tid >> 8, j = F.tid & 255; float s = 0.f;
          for (int ch = 0; ch < 16; ++ch) s += HP[((l * 16 + ch) * 2 + w) * 256 + j];
          hs[w * 256 + j] = s; }
        __syncthreads();
        const int n = nb * 512 + F.tid; const float* au = IN_(5) + (size_t)l * 256 * NMOD + n; float s0 = IN_(6)[(size_t)l * NMOD + n], s1 = s0;
        for (int j = 0; j < 256; ++j) { const float u = au[(size_t)j * NMOD]; s0 += hs[j] * u; s1 += hs[256 + j] * u; }
        MOD[((size_t)l * 2 + 0) * NMOD + n] = s0; MOD[((size_t)l * 2 + 1) * NMOD + n] = s1;
        __syncthreads(); }
}
__device__ __forceinline__ void norm_phase(const Frame& F, float* XS, const float* __restrict__ gain, const float* modx, const float* modc, int ish, int isc, bf16_t* out, const bf16_t* slab, const float* sgate, float sfac, const float* XL) {
    const int gw = F.bid * 8 + F.wave, NGW = F.G * 8;
    int row_lo = 0;
    if (slab) { row_lo = NCTX;
        LAS float* red = (LAS float*)F.lds;
        for (int row = F.bid; row < NCTX; row += F.G) { const size_t o = (size_t)row * DM + F.wave * 512;
            f32x4 v[2]; float s = 0.f;
#pragma unroll
            for (int j = 0; j < 2; ++j) { f32x4 acc = (f32x4){0.f, 0.f, 0.f, 0.f};
#pragma unroll
                for (int ks = 0; ks < 16; ++ks) acc += bf4f(((const u32x2*)(slab + (size_t)ks * NCTX * DM + o) + F.lane)[64 * j]);
                v[j] = ((const f32x4*)(XS + o) + F.lane)[64 * j] + acc * ((const f32x4*)(sgate + F.wave * 512) + F.lane)[64 * j] * sfac;
                ((f32x4*)(XS + o) + F.lane)[64 * j] = v[j]; s += (v[j].x * v[j].x + v[j].y * v[j].y) + (v[j].z * v[j].z + v[j].w * v[j].w); }
            s = wave_sum(s); if (F.lane == 0) red[F.wave] = s;
            __syncthreads();
            float tot = 0.f;
#pragma unroll
            for (int w = 0; w < 8; ++w) tot += red[w];
            const float rstd = rsqrtf(tot * (1.0f / DM) + NORM_EPS);
#pragma unroll
            for (int j = 0; j < 2; ++j) { const int c4 = F.wave * 128 + F.lane + 64 * j;
                const f32x4 y = v[j] * rstd * ((const f32x4*)gain)[c4] * (((const f32x4*)(modc + (size_t)isc * DM))[c4] + 1.0f) + ((const f32x4*)(modc + (size_t)ish * DM))[c4];
                u32x2 w2; w2.x = cvt_pk_bf16(y.x, y.y); w2.y = cvt_pk_bf16(y.z, y.w); ((u32x2*)(out + (size_t)row * DM))[c4] = w2; }
            __syncthreads(); } }
    for (int row = row_lo + gw; row < T; row += NGW) {
        const float* mod = row < NCTX ? modc : modx;
        const f32x4* xr = (const f32x4*)((row < NCTX ? (const float*)XS : XL) + (size_t)row * DM) + F.lane; const f32x4* g4 = (const f32x4*)gain + F.lane;
        const f32x4* sh4 = (const f32x4*)(mod + (size_t)ish * DM) + F.lane; const f32x4* sc4 = (const f32x4*)(mod + (size_t)isc * DM) + F.lane;
        f32x4 v[16]; float s = 0.f;
#pragma unroll
        for (int j = 0; j < 16; ++j) { v[j] = xr[64 * j]; s += (v[j].x * v[j].x + v[j].y * v[j].y) + (v[j].z * v[j].z + v[j].w * v[j].w); }
        const float rstd = rsqrtf(wave_sum(s) * (1.0f / DM) + NORM_EPS);
        u32x2* o = (u32x2*)(out + (size_t)row * DM) + F.lane;
#pragma unroll
        for (int j = 0; j < 16; ++j) { const f32x4 y = v[j] * rstd * g4[64 * j] * (sc4[64 * j] + 1.0f) + sh4[64 * j];
            u32x2 w; w.x = cvt_pk_bf16(y.x, y.y); w.y = cvt_pk_bf16(y.z, y.w); o[64 * j] = w; }
    }
}
__device__ __forceinline__ float conv3_at(const bf16_t* PX, int tau, int col, float w0, float w1, float w2) {
    const bf16_t* p = PX + (size_t)tau * PXW + col;
    const bool hl = has_left(tau), hr = has_right(tau);
    return bf2f(p[0]) * w1 + bf2f(p[hl ? -PXW : 0]) * (hl ? w0 : 0.f) + bf2f(p[hr ? PXW : 0]) * (hr ? w2 : 0.f);
}
__device__ __forceinline__ float rope_apply(float val, int tau, int j) {
    const int pos = tau - NCTX, prow = pos >> 6, pcol = pos & 63;
    const float inv = __powf(10000.0f, -(float)(j & 15) * (1.0f / 16.0f));
    const float ang = (float)(j < 32 ? prow : pcol) * inv;
    float sn, cs; sincosf(ang, &sn, &cs);
    const float partner = __shfl_xor(val, 16);
    const float rot = (j & 16) ? partner : -partner;
    return val * cs + rot * sn;
}
__device__ __forceinline__ void mla_prep_phase(const Frame& F, unsigned char* ws, int l) {
    const bf16_t* PX = (const bf16_t*)(ws + WS_PX); bf16_t* QA = (bf16_t*)(ws + WS_QA); bf16_t* KVA = (bf16_t*)(ws + WS_KVA); bf16_t* KPE = (bf16_t*)(ws + WS_KPE);
    const int gw = F.bid * 8 + F.wave, NGW = F.G * 8;
    const f32x4* gq = (const f32x4*)(IN_(38) + l * 1024) + F.lane; const f32x4* gkv = (const f32x4*)(IN_(40) + l * 512) + F.lane; const float gpe = IN_(45)[l * 64 + F.lane];
    for (int tau = gw; tau < T; tau += NGW) {
        const u32x2* p = (const u32x2*)(PX + (size_t)tau * PXW + PXC) + F.lane;
        f32x4 q[4], kv[2]; float sq = 0.f, skv = 0.f;
#pragma unroll
        for (int j = 0; j < 4; ++j) { q[j] = bf4f(p[64 * j]); sq += (q[j].x * q[j].x + q[j].y * q[j].y) + (q[j].z * q[j].z + q[j].w * q[j].w); }
#pragma unroll
        for (int j = 0; j < 2; ++j) { kv[j] = bf4f(p[256 + 64 * j]); skv += (kv[j].x * kv[j].x + kv[j].y * kv[j].y) + (kv[j].z * kv[j].z + kv[j].w * kv[j].w); }
        const float pe = bf2f(PX[(size_t)tau * PXW + PXC + 1536 + F.lane]);
        const float rq = rsqrtf(wave_sum(sq) * (1.0f / 1024.0f) + NORM_EPS), rkv = rsqrtf(wave_sum(skv) * (1.0f / 512.0f) + NORM_EPS), rpe = rsqrtf(wave_sum(pe * pe) * (1.0f / 64.0f) + NORM_EPS);
        u32x2* oq = (u32x2*)(QA + (size_t)tau * 1024) + F.lane; u32x2* okv = (u32x2*)(KVA + (size_t)tau * 512) + F.lane;
#pragma unroll
        for (int j = 0; j < 4; ++j) { const f32x4 y = q[j] * rq * gq[64 * j]; u32x2 w; w.x = cvt_pk_bf16(y.x, y.y); w.y = cvt_pk_bf16(y.z, y.w); oq[64 * j] = w; }
#pragma unroll
        for (int j = 0; j < 2; ++j) { const f32x4 y = kv[j] * rkv * gkv[64 * j]; u32x2 w; w.x = cvt_pk_bf16(y.x, y.y); w.y = cvt_pk_bf16(y.z, y.w); okv[64 * j] = w; }
        float kp = pe * rpe * gpe;
        if (tau >= NCTX) kp = rope_apply(kp, tau, F.lane);
        KPE[(size_t)tau * 64 + F.lane] = (bf16_t)(cvt_pk_bf16(kp, kp) & 0xffffu);
    }
}
__device__ __forceinline__ void qkv_final_phase(const Frame& F, unsigned char* ws, int l, bool need_ctx) {
    const bf16_t* QRAW = (const bf16_t*)(ws + WS_QRAW); const bf16_t* KVRAW = (const bf16_t*)(ws + WS_KVRAW); const bf16_t* KPE = (const bf16_t*)(ws + WS_KPE);
    bf16_t* QF = (bf16_t*)(ws + WS_QF); bf16_t* KF = (bf16_t*)(ws + WS_KF);
    const int gw = F.bid * 8 + F.wave, NGW = F.G * 8, ln = F.lane;
    const float gqn0 = IN_(42)[l * 128 + 2 * ln], gqn1 = IN_(42)[l * 128 + 2 * ln + 1], gqp = IN_(43)[l * 64 + ln];
    const float gkn0 = IN_(44)[l * 128 + 2 * ln], gkn1 = IN_(44)[l * 128 + 2 * ln + 1];
    (void)need_ctx;
    for (int tau = gw; tau < T; tau += NGW) {
        float cs = 1.f, sn = 0.f;
        if (tau >= NCTX) { const int pos = tau - NCTX, prow = pos >> 6, pcol = pos & 63; const float inv = __powf(10000.0f, -(float)(ln & 15) * (1.0f / 16.0f)); sincosf((float)(ln < 32 ? prow : pcol) * inv, &sn, &cs); }
        const bf16_t kpe = KPE[(size_t)tau * 64 + ln];
        const bf16_t* qrow = QRAW + (size_t)tau * NQ; const bf16_t* krow = KVRAW + (size_t)tau * NKV;
        unsigned qn[NHC], kn[NHC]; bf16_t qpv[NHC];
#pragma unroll
        for (int h = 0; h < NHC; ++h) { qn[h] = *(const unsigned*)(qrow + h * 192 + 2 * ln); qpv[h] = qrow[h * 192 + 128 + ln]; kn[h] = *(const unsigned*)(krow + h * 256 + 2 * ln); }
#pragma unroll
        for (int h = 0; h < NHC; ++h) {
            const float q0 = bf2f((unsigned short)(qn[h] & 0xffffu)), q1 = bf2f((unsigned short)(qn[h] >> 16)), qp = bf2f(qpv[h]), k0 = bf2f((unsigned short)(kn[h] & 0xffffu)), k1 = bf2f((unsigned short)(kn[h] >> 16));
            const float rqn = rsqrtf(wave_sum(q0 * q0 + q1 * q1) * (1.0f / 128.0f) + NORM_EPS), rqp = rsqrtf(wave_sum(qp * qp) * (1.0f / 64.0f) + NORM_EPS), rkn = rsqrtf(wave_sum(k0 * k0 + k1 * k1) * (1.0f / 128.0f) + NORM_EPS);
            float qpe = qp * rqp * gqp;
            { const float partner = __shfl_xor(qpe, 16); const float rot = (ln & 16) ? partner : -partner; qpe = qpe * cs + rot * sn; }
            *(unsigned*)(QF + (size_t)tau * NQ + h * 192 + 2 * ln) = cvt_pk_bf16(q0 * rqn * gqn0, q1 * rqn * gqn1);
            QF[(size_t)tau * NQ + h * 192 + 128 + ln] = (bf16_t)(cvt_pk_bf16(qpe, qpe) & 0xffffu);
            *(unsigned*)(KF + (size_t)tau * NQ + h * 192 + 2 * ln) = cvt_pk_bf16(k0 * rkn * gkn0, k1 * rkn * gkn1);
            KF[(size_t)tau * NQ + h * 192 + 128 + ln] = kpe; }
    }
}
__device__ __forceinline__ void rwkv_out_phase(const Frame& F, unsigned char* ws, int l, bool need_ctx) {
    const float* SS = (const float*)(ws + WS_SS); const float* SD = (const float*)(ws + WS_SD); const float* GB = (const float*)(ws + WS_G); const float* Y = (const float*)(ws + WS_Y);
    bf16_t* OB = (bf16_t*)(ws + WS_OBUF);
    const int gw = F.bid * 8 + F.wave, NGW = F.G * 8, ln = F.lane;
    const f32x2* gnw = (const f32x2*)(IN_(25) + l * A_W); const f32x2* gnb = (const f32x2*)(IN_(26) + l * A_W);
    for (int it = (need_ctx ? 0 : NCTX * 5) + gw; it < T * 5; it += NGW) { const int tau = it / 5, h0 = (it % 5) * 4;
        f32x2 y0[2], y1[2], v[2], g[2]; float sa[2], sb[2];
#pragma unroll
        for (int p = 0; p < 2; ++p) { const int h = h0 + 2 * p + (ln >> 5); const size_t o2 = ((size_t)tau * A_W + (h0 + 2 * p) * 64) / 2 + ln;
            y0[p] = ((const f32x2*)Y)[o2]; y1[p] = ((const f32x2*)(Y + (size_t)T * A_W))[o2]; v[p] = ((const f32x2*)(SS + (size_t)T * A_W))[o2]; g[p] = ((const f32x2*)GB)[o2];
            sa[p] = SD[(size_t)tau * NHA + h]; sb[p] = SD[((size_t)T + tau) * NHA + h]; }
#pragma unroll
        for (int p = 0; p < 2; ++p) { const int c2 = (h0 + 2 * p) * 32 + ln;
            const f32x2 y = y0[p] + y1[p];
            float s1 = y.x + y.y;
#pragma unroll
            for (int o = 1; o < 32; o <<= 1) s1 += __shfl_xor(s1, o);
            const float mu = s1 * (1.0f / 64.0f); const f32x2 dy = y - mu; float s2 = dy.x * dy.x + dy.y * dy.y;
#pragma unroll
            for (int o = 1; o < 32; o <<= 1) s2 += __shfl_xor(s2, o);
            const f32x2 yn = dy * rsqrtf(s2 * (1.0f / 64.0f) + GN_EPS) * gnw[c2] + gnb[c2];
            const f32x2 ov = (yn + v[p] * (0.5f * (sa[p] + sb[p]))) * g[p];
            *(unsigned*)(OB + (size_t)tau * DM + 2 * c2) = cvt_pk_bf16(ov.x, ov.y); }
    }
}
__device__ __forceinline__ void hyena_prep_phase(const Frame& F, unsigned char* ws, int l) {
    const bf16_t* PX = (const bf16_t*)(ws + WS_PX); float* GT = (float*)(ws + WS_GT); float* X0T = (float*)(ws + WS_X0T);
    LAS float* LGt = (LAS float*)F.lds; LAS float* LX0 = LGt + 64 * 65;
    const float* cw = IN_(27) + (size_t)l * 3 * B_IN; const float* cb = IN_(28) + (size_t)l * B_IN;
    int it0, istep, iend;
    if (F.bid < 80) { it0 = F.bid * 5; istep = 1; iend = it0 + 5; } else { it0 = 400 + (F.bid - 80); istep = 176; iend = (T / 64) * 20; }
    for (int it = it0; it < iend; it += istep) { const int tt = it / 20, ct = it % 20;
        { const int t = F.tid >> 3, c0 = ct * 64 + (F.tid & 7) * 8, tau = tt * 64 + t;
          f32x4 u[3][2];
#pragma unroll
          for (int grp = 0; grp < 3; ++grp)
#pragma unroll
              for (int q = 0; q < 2; ++q) { const int c = grp * 1280 + c0 + 4 * q; const bf16_t* p = PX + (size_t)tau * PXW + PXB + c;
                  const bool hl = has_left(tau), hr = has_right(tau);
                  const f32x4 y = bf4f(*(const u32x2*)p) * *(const f32x4*)(cw + B_IN + c) + *(const f32x4*)(cb + c) + bf4f(*(const u32x2*)(p - (hl ? PXW : 0))) * (*(const f32x4*)(cw + c) * (hl ? 1.f : 0.f))
                                + bf4f(*(const u32x2*)(p + (hr ? PXW : 0))) * (*(const f32x4*)(cw + 2 * B_IN + c) * (hr ? 1.f : 0.f));
                  u[grp][q] = y; }
#pragma unroll
          for (int q = 0; q < 2; ++q)
#pragma unroll
              for (int e = 0; e < 4; ++e) { const int ch = (F.tid & 7) * 8 + 4 * q + e; LGt[ch * 65 + t] = u[1][q][e] * u[2][q][e]; LX0[ch * 65 + t] = u[0][q][e]; } }
        __syncthreads();
        { const int ch = F.tid >> 3, t0 = (F.tid & 7) * 8; const size_t o = (size_t)(ct * 64 + ch) * T + tt * 64 + t0;
          f32x4 a0, a1, b0, b1;
#pragma unroll
          for (int e = 0; e < 4; ++e) { a0[e] = LGt[ch * 65 + t0 + e]; a1[e] = LGt[ch * 65 + t0 + 4 + e]; b0[e] = LX0[ch * 65 + t0 + e]; b1[e] = LX0[ch * 65 + t0 + 4 + e]; }
          *(f32x4*)(GT + o) = a0; *(f32x4*)(GT + o + 4) = a1; *(f32x4*)(X0T + o) = b0; *(f32x4*)(X0T + o + 4) = b1; }
        __syncthreads(); }
}
__device__ __forceinline__ void hyena_out_phase(const Frame& F, unsigned char* ws, bool need_ctx) {
    const float* YT = (const float*)(ws + WS_GT); bf16_t* OB = (bf16_t*)(ws + WS_OBUF);
    LAS float* L = (LAS float*)F.lds;
    const int it0 = need_ctx ? 0 : (NCTX / 64) * 20;
    for (int it = it0 + F.bid; it < (T / 64) * 20; it += F.G) { const int tt = it / 20, ct = it % 20;
        { const int ch = F.tid >> 3, t0 = (F.tid & 7) * 8; const size_t o = (size_t)(ct * 64 + ch) * T + tt * 64 + t0;
          const f32x4 a0 = *(const f32x4*)(YT + o), a1 = *(const f32x4*)(YT + o + 4);
#pragma unroll
          for (int e = 0; e < 4; ++e) { L[ch * 65 + t0 + e] = a0[e]; L[ch * 65 + t0 + 4 + e] = a1[e]; } }
        __syncthreads();
        { const int t = F.tid >> 3, c0 = (F.tid & 7) * 8; float x[8];
#pragma unroll
          for (int e = 0; e < 8; ++e) x[e] = L[(c0 + e) * 65 + t];
          u32x4 w; w.x = cvt_pk_bf16(x[0], x[1]); w.y = cvt_pk_bf16(x[2], x[3]); w.z = cvt_pk_bf16(x[4], x[5]); w.w = cvt_pk_bf16(x[6], x[7]);
          *(u32x4*)(OB + (size_t)(tt * 64 + t) * DM + 1280 + ct * 64 + c0) = w; }
        __syncthreads(); }
}
namespace att {
constexpr int DK = 192, DV = 128, NW = 8, QBLK = 32, KVBLK = 64;
constexpr float SCALE = 0.07216878364870322f;
constexpr float THR = 8.f;
#ifndef ATT_SDEPTH
#define ATT_SDEPTH 2
#endif
constexpr int SDEPTH = ATT_SDEPTH;
constexpr int LDQ = 2304, LDK = 2304, LDV = 3072, LDO = 4096;
constexpr int SHM_V = KVBLK * DV * 2, SHM_K = KVBLK * DK * 2, SHM_ATTN = 2 * SHM_V + 2 * SHM_K + NW * 64 * 4 + NW * 4096;
using bf16x8 = __attribute__((ext_vector_type(8))) short;
using s16x4  = __attribute__((ext_vector_type(4))) short;
using f32x16 = __attribute__((ext_vector_type(16))) float;
using u32x4  = __attribute__((ext_vector_type(4))) unsigned;
#define KSWZ(row, colB) ((row) * 384 + ((colB) ^ (((row) & 7) << 4)))
#define SBAR() __builtin_amdgcn_sched_barrier(0)
__device__ __forceinline__ int crow(int r, int hi) { return (r & 3) + 8 * (r >> 2) + 4 * hi; }
__device__ __forceinline__ unsigned cvtpk(float lo, float hi) { unsigned r; asm volatile("v_cvt_pk_bf16_f32 %0, %1, %2" : "=v"(r) : "v"(lo), "v"(hi)); return r; }
__device__ __forceinline__ void partialSM(f32x16& p0, f32x16& p1, float& m_reg, float& mn, float& alpha) {
  constexpr float C = SCALE * 1.4426950408889634f;
  float pmax = p0[0]; for (int r = 1; r < 16; ++r) pmax = fmaxf(pmax, p0[r]); for (int r = 0; r < 16; ++r) pmax = fmaxf(pmax, p1[r]);
  { auto rr = __builtin_amdgcn_permlane32_swap(__float_as_uint(pmax), __float_as_uint(pmax), false, false);
    pmax = fmaxf(__uint_as_float(rr[0]), __uint_as_float(rr[1])); }
  if (__builtin_expect(__all(pmax - m_reg <= THR / SCALE), 1)) { mn = m_reg; alpha = 1.f; }
  else { mn = fmaxf(m_reg, pmax); alpha = __builtin_amdgcn_exp2f((m_reg - mn) * C); m_reg = mn; }
  float mnC = -mn * C;
  for (int r = 0; r < 16; ++r) p0[r] = fmaf(p0[r], C, mnC); for (int r = 0; r < 16; ++r) p1[r] = fmaf(p1[r], C, mnC);
  for (int r = 0; r < 16; ++r) p0[r] = __builtin_amdgcn_exp2f(p0[r]);
}
__device__ __forceinline__ void finishSM(f32x16& p0, f32x16& p1, float alpha, float& l_reg, bf16x8& pa0, bf16x8& pa1, bf16x8& pa2, bf16x8& pa3) {
  for (int r = 0; r < 16; ++r) p1[r] = __builtin_amdgcn_exp2f(p1[r]);
  float ps = 0; for (int r = 0; r < 16; ++r) ps += p0[r]; for (int r = 0; r < 16; ++r) ps += p1[r];
  { auto rr = __builtin_amdgcn_permlane32_swap(__float_as_uint(ps), __float_as_uint(ps), false, false);
    ps = __uint_as_float(rr[0]) + __uint_as_float(rr[1]); }
  l_reg = l_reg * alpha + ps;
#define PK4(P, BASE, OUT) do { unsigned a0 = cvtpk(P[BASE + 0], P[BASE + 1]), a1 = cvtpk(P[BASE + 2], P[BASE + 3]);   \
    unsigned b0 = cvtpk(P[BASE + 4], P[BASE + 5]), b1 = cvtpk(P[BASE + 6], P[BASE + 7]);                              \
    auto r0 = __builtin_amdgcn_permlane32_swap(a0, b0, false, false); auto r1 = __builtin_amdgcn_permlane32_swap(a1, b1, false, false); \
    u32x4 w = {r0[0], r1[0], r0[1], r1[1]}; OUT = *reinterpret_cast<bf16x8*>(&w); } while (0)
  PK4(p0, 0, pa0); PK4(p0, 8, pa1); PK4(p1, 0, pa2); PK4(p1, 8, pa3);
#undef PK4
}
__device__ __forceinline__ void qkt(f32x16& p0, f32x16& p1, const char* Ks, const bf16x8* qr, const char* qrl, int r32, int hi) {
  p0 = f32x16{}; p1 = f32x16{};
#pragma unroll
  for (int d0 = 0; d0 < 8; ++d0) { int cb = (d0 * 16 + hi * 8) * 2;
    bf16x8 b0 = *reinterpret_cast<const bf16x8*>(Ks + KSWZ(r32, cb));
    bf16x8 b1 = *reinterpret_cast<const bf16x8*>(Ks + KSWZ(32 + r32, cb));
    p0 = __builtin_amdgcn_mfma_f32_32x32x16_bf16(b0, qr[d0], p0, 0, 0, 0);
    p1 = __builtin_amdgcn_mfma_f32_32x32x16_bf16(b1, qr[d0], p1, 0, 0, 0); }
#pragma unroll
  for (int d0 = 8; d0 < 12; ++d0) { int cb = (d0 * 16 + hi * 8) * 2;
    bf16x8 b0 = *reinterpret_cast<const bf16x8*>(Ks + KSWZ(r32, cb));
    bf16x8 b1 = *reinterpret_cast<const bf16x8*>(Ks + KSWZ(32 + r32, cb));
    const bf16x8 q = *reinterpret_cast<const bf16x8*>(qrl + ((((d0 - 8) * 2 + hi) ^ (r32 & 7)) << 4));
    p0 = __builtin_amdgcn_mfma_f32_32x32x16_bf16(b0, q, p0, 0, 0, 0);
    p1 = __builtin_amdgcn_mfma_f32_32x32x16_bf16(b1, q, p1, 0, 0, 0); }
}
__device__ __forceinline__ int v_st(int k, int c) { const int kk = (k & ~0xC) | ((k & 4) << 1) | ((k & 8) >> 1); return ((kk >> 3) * 4 + (c >> 5)) * 512 + ((kk & 7) * 32 + (c & 31)) * 2; }
__device__ __forceinline__ int v_rd_base(int lane) { return ((lane & 3) << 3) | (((lane >> 2) & 3) << 6) | (((lane >> 4) & 1) << 5) | (((lane >> 5) & 1) << 8); }
constexpr int v_rd_off(int d0, int ks, int half) { return d0 * 512 + ks * 4096 + half * 2048; }
template <int OFF> __device__ __forceinline__ s16x4 tr_read(int vb) {
  s16x4 r; asm volatile("ds_read_b64_tr_b16 %0, %1 offset:%2" : "=&v"(r) : "v"(vb), "i"(OFF) : "memory"); return r;
}
template <int D0> __device__ __forceinline__ void pv_one(f32x16& od, int vb, bf16x8 pa0, bf16x8 pa1, bf16x8 pa2, bf16x8 pa3) {
  const s16x4 l0 = tr_read<v_rd_off(D0, 0, 0)>(vb), h0 = tr_read<v_rd_off(D0, 0, 1)>(vb), l1 = tr_read<v_rd_off(D0, 1, 0)>(vb), h1 = tr_read<v_rd_off(D0, 1, 1)>(vb);
  const s16x4 l2 = tr_read<v_rd_off(D0, 2, 0)>(vb), h2 = tr_read<v_rd_off(D0, 2, 1)>(vb), l3 = tr_read<v_rd_off(D0, 3, 0)>(vb), h3 = tr_read<v_rd_off(D0, 3, 1)>(vb);
  asm volatile("s_waitcnt lgkmcnt(0)" ::: "memory"); SBAR();
#define PK(L, H) (bf16x8){L[0], L[1], L[2], L[3], H[0], H[1], H[2], H[3]}
  od = __builtin_amdgcn_mfma_f32_32x32x16_bf16(pa0, PK(l0, h0), od, 0, 0, 0);
  od = __builtin_amdgcn_mfma_f32_32x32x16_bf16(pa1, PK(l1, h1), od, 0, 0, 0);
  od = __builtin_amdgcn_mfma_f32_32x32x16_bf16(pa2, PK(l2, h2), od, 0, 0, 0);
  od = __builtin_amdgcn_mfma_f32_32x32x16_bf16(pa3, PK(l3, h3), od, 0, 0, 0);
#undef PK
}
__device__ __forceinline__ void pv_d0(f32x16* o, int vb, bf16x8 pa0, bf16x8 pa1, bf16x8 pa2, bf16x8 pa3) {
  pv_one<0>(o[0], vb, pa0, pa1, pa2, pa3); pv_one<1>(o[1], vb, pa0, pa1, pa2, pa3); pv_one<2>(o[2], vb, pa0, pa1, pa2, pa3); pv_one<3>(o[3], vb, pa0, pa1, pa2, pa3);
}
__device__ __forceinline__ void attn_body(const bf16_t* __restrict__ Qb, const bf16_t* __restrict__ Kh, const bf16_t* __restrict__ Vh, bf16_t* __restrict__ Ob, int seq, char* lds) {
  int tid_ = threadIdx.x; asm volatile("" : "+v"(tid_));
  const int tid = tid_, wid = tid >> 6, lane = tid & 63, r32 = lane & 31, hi = lane >> 5;
  char* V_lds = lds; char* K_lds = lds + 2 * SHM_V;
  float* ws = (float*)(lds + 2 * SHM_V + 2 * SHM_K) + wid * 64; float* li_l = ws; float* al_l = ws + 32;
  float m_reg = -1e30f, l_reg = 0; f32x16 o[4] = {}; bf16x8 qr[8];
  const bf16_t* Qw = Qb + (long)(wid * QBLK + r32) * LDQ + hi * 8;
  char* qrl = lds + 2 * SHM_V + 2 * SHM_K + NW * 64 * 4 + wid * 4096 + r32 * 128;
#pragma unroll
  for (int d0 = 0; d0 < 8; ++d0) qr[d0] = *reinterpret_cast<const bf16x8*>(Qw + d0 * 16);
#pragma unroll
  for (int d0 = 8; d0 < 12; ++d0) *reinterpret_cast<bf16x8*>(qrl + ((((d0 - 8) * 2 + hi) ^ (r32 & 7)) << 4)) = *reinterpret_cast<const bf16x8*>(Qw + d0 * 16);
  asm volatile("s_waitcnt lgkmcnt(0)" ::: "memory");
  unsigned kgo[3], vgo[2];
#pragma unroll
  for (int i = 0; i < 3; ++i) { const int p = (i * 8 + wid) * 64 + lane, row = p / 24, slot = p % 24, ch = slot ^ (row & 7); kgo[i] = (unsigned)(row * LDK + ch * 8) * 2u; }
#pragma unroll
  for (int i = 0; i < 2; ++i) { const int p = (i * 8 + wid) * 64 + lane, sub = p >> 5, within = p & 31, kk = (sub >> 2) * 8 + (within >> 2), c = (sub & 3) * 32 + (within & 3) * 8;
    const int k = (kk & ~0xC) | ((kk & 4) << 1) | ((kk & 8) >> 1); vgo[i] = (unsigned)(k * LDV + c) * 2u; }
  const int vb0 = (int)(uintptr_t)V_lds + v_rd_base(lane);
  typedef __attribute__((address_space(3))) unsigned lds_u32;
#define DMA_K(b, k0) do { const char* kg = (const char*)Kh + (size_t)(k0) * (LDK * 2); \
    _Pragma("unroll") for (int _i = 0; _i < 3; ++_i) __builtin_amdgcn_global_load_lds((const unsigned*)(kg + kgo[_i]), (lds_u32*)(K_lds + (b) * SHM_K + (_i * 8 + wid) * 1024), 16, 0, 0); } while (0)
#define DMA_V(b, k0) do { const char* vg = (const char*)Vh + (size_t)(k0) * (LDV * 2); \
    _Pragma("unroll") for (int _i = 0; _i < 2; ++_i) __builtin_amdgcn_global_load_lds((const unsigned*)(vg + vgo[_i]), (lds_u32*)(V_lds + (b) * SHM_V + (_i * 8 + wid) * 1024), 16, 0, 0); } while (0)
#define RESC(a) do { if (__any((a) < 1.f)) { if (hi == 0) al_l[r32] = (a); asm volatile("s_waitcnt lgkmcnt(0)" ::: "memory"); \
    for (int d = 0; d < 4; ++d) for (int r = 0; r < 16; ++r) o[d][r] *= al_l[crow(r, hi)]; } } while (0)
#define ENDSTEP() do { asm volatile("s_waitcnt vmcnt(0)" ::: "memory"); __syncthreads(); } while (0)
  f32x16 pA0, pA1, pB0, pB1; float mnA, mnB, alA, alB; bf16x8 pa0, pa1, pa2, pa3; const int NT = seq / KVBLK;
  DMA_K(0, 0); ENDSTEP();
  DMA_K(1, KVBLK); DMA_V(0, 0);
  qkt(pA0, pA1, K_lds, qr, qrl, r32, hi); partialSM(pA0, pA1, m_reg, mnA, alA);
  ENDSTEP();
  for (int j = 1; j + 1 < NT; j += 2) {
    DMA_K(0, (j + 1) * KVBLK); DMA_V(1, j * KVBLK);
    SBAR(); qkt(pB0, pB1, K_lds + SHM_K, qr, qrl, r32, hi);
    finishSM(pA0, pA1, alA, l_reg, pa0, pa1, pa2, pa3); SBAR();
    pv_d0(o, vb0, pa0, pa1, pa2, pa3); partialSM(pB0, pB1, m_reg, mnB, alB);
    RESC(alB); ENDSTEP();
    if (j + 2 < NT) DMA_K(1, (j + 2) * KVBLK);
    DMA_V(0, (j + 1) * KVBLK);
    SBAR(); qkt(pA0, pA1, K_lds, qr, qrl, r32, hi);
    finishSM(pB0, pB1, alB, l_reg, pa0, pa1, pa2, pa3); SBAR();
    pv_d0(o, vb0 + (int)SHM_V, pa0, pa1, pa2, pa3); partialSM(pA0, pA1, m_reg, mnA, alA);
    RESC(alA); ENDSTEP();
  }
  DMA_V(1, (NT - 1) * KVBLK);
  SBAR(); qkt(pB0, pB1, K_lds + SHM_K, qr, qrl, r32, hi);
  finishSM(pA0, pA1, alA, l_reg, pa0, pa1, pa2, pa3); SBAR();
  pv_d0(o, vb0, pa0, pa1, pa2, pa3); partialSM(pB0, pB1, m_reg, mnB, alB);
  RESC(alB); ENDSTEP();
  finishSM(pB0, pB1, alB, l_reg, pa0, pa1, pa2, pa3); SBAR();
  pv_d0(o, vb0 + (int)SHM_V, pa0, pa1, pa2, pa3);
#undef DMA_K
#undef DMA_V
#undef ENDSTEP
  if (hi == 0) li_l[r32] = l_reg; asm volatile("s_waitcnt lgkmcnt(0)" ::: "memory");
  float rli[16];
#pragma unroll
  for (int r = 0; r < 16; ++r) rli[r] = __builtin_amdgcn_rcpf(li_l[crow(r, hi)]);
  bf16_t* Ow = Ob + (long)(wid * QBLK) * LDO;
#pragma unroll
  for (int r = 0; r < 16; ++r) { int orow = crow(r, hi);
#pragma unroll
    for (int d0 = 0; d0 < 4; ++d0) { const float val = o[d0][r] * rli[r]; Ow[(long)orow * LDO + d0 * 32 + r32] = (bf16_t)(cvtpk(val, val) & 0xffff); } }
  __syncthreads();
#undef RESC
}
}
__device__ __forceinline__ f32x2 cmul(f32x2 a, f32x2 b) { return (f32x2){a.x * b.x - a.y * b.y, a.x * b.y + a.y * b.x}; }
__device__ __forceinline__ int rev4_14(int k) { const unsigned r = __brev((unsigned)k) >> 18; return (int)(((r & 0x1555u) << 1) | ((r >> 1) & 0x1555u)); }
#define ZI(i) ((i) + ((i) >> 5))
__device__ __forceinline__ void fft_tw(int j, int q, float sign, f32x2& w1, f32x2& w2, f32x2& w3) {
    const float rev = (float)j / (float)(4 * q); const float sn = __builtin_amdgcn_sinf(rev), cs = __builtin_amdgcn_cosf(rev);
    w1 = (f32x2){cs, sign * sn}; w2 = cmul(w1, w1); w3 = cmul(w2, w1);
}
__device__ __forceinline__ void fft16k_dif(LAS f32x2* Z, int tid) {
#pragma unroll 1
    for (int s = 0; s < 7; ++s) { int lq = 12 - 2 * s; asm volatile("" : "+s"(lq)); const int q = 1 << lq;
        const bool shared = q <= 512; f32x2 w1, w2, w3; fft_tw(tid & (q - 1), q, -1.f, w1, w2, w3);
#pragma unroll 2
        for (int i = 0; i < 8; ++i) { const int b = tid + 512 * i, j = b & (q - 1), base = ((b >> lq) << (lq + 2)) + j;
            const int i0 = ZI(base), i1 = ZI(base + q), i2 = ZI(base + 2 * q), i3 = ZI(base + 3 * q);
            const f32x2 a0 = Z[i0], a1 = Z[i1], a2 = Z[i2], a3 = Z[i3];
            const f32x2 t0 = a0 + a2, t1 = a0 - a2, t2 = a1 + a3, t3 = a1 - a3;
            if (!shared) fft_tw(j, q, -1.f, w1, w2, w3);
            Z[i0] = t0 + t2; Z[i1] = cmul((f32x2){t1.x + t3.y, t1.y - t3.x}, w1); Z[i2] = cmul(t0 - t2, w2); Z[i3] = cmul((f32x2){t1.x - t3.y, t1.y + t3.x}, w3); }
        __syncthreads(); }
}
__device__ __forceinline__ void fft16k_dit_inv(LAS f32x2* Z, int tid) {
#pragma unroll 1
    for (int s = 0; s < 7; ++s) { int lq = 2 * s; asm volatile("" : "+s"(lq)); const int q = 1 << lq;
        const bool shared = q <= 512; f32x2 w1, w2, w3; fft_tw(tid & (q - 1), q, 1.f, w1, w2, w3);
#pragma unroll 2
        for (int i = 0; i < 8; ++i) { const int b = tid + 512 * i, j = b & (q - 1), base = ((b >> lq) << (lq + 2)) + j;
            if (!shared) fft_tw(j, q, 1.f, w1, w2, w3);
            const int i0 = ZI(base), i1 = ZI(base + q), i2 = ZI(base + 2 * q), i3 = ZI(base + 3 * q);
            const f32x2 b0 = Z[i0], b1 = cmul(Z[i1], w1), b2 = cmul(Z[i2], w2), b3 = cmul(Z[i3], w3);
            const f32x2 t0 = b0 + b2, t1 = b0 - b2, t2 = b1 + b3, t3 = b1 - b3;
            Z[i0] = t0 + t2; Z[i1] = (f32x2){t1.x - t3.y, t1.y + t3.x}; Z[i2] = t0 - t2; Z[i3] = (f32x2){t1.x + t3.y, t1.y - t3.x}; }
        __syncthreads(); }
}
constexpr float HY_MIN_DECAY = -3.0701134573253945f, HY_MAX_DECAY = -15.350567286626973f;
__device__ __forceinline__ float hy_delta(int c) { return fabsf(HY_MIN_DECAY + (HY_MAX_DECAY - HY_MIN_DECAY) * ((float)c / 1279.0f)); }
__device__ __forceinline__ float conv3b_at(const bf16_t* PX, int tau, int col, const float* cw, int l, int c) {
    const float* w = cw + (size_t)l * 3 * B_IN;
    return conv3_at(PX, tau, col, w[c], w[B_IN + c], w[2 * B_IN + c]);
}
__device__ __forceinline__ void hyena_taps_unit(const Frame& F, unsigned char* ws, int l, int pair) {
    LAS f32x2* Z = (LAS f32x2*)F.lds; LAS float* red = (LAS float*)(F.lds + LDS_MISC + 128);
    const int tid = F.tid, c0 = 2 * pair;
    const bf16_t* H3x = (const bf16_t*)(ws + WS_H3) + (size_t)l * 64 * T + NCTX;
    f32x4* scr4 = (f32x4*)(ws + WS_HSCR) + (size_t)pair * HT_STRIDE; float* htn = (float*)(ws + WS_HTN) + 2 * pair;
    LAS f32x4* FW = (LAS f32x4*)(F.lds + LDS_MISC + 256);
    if (tid < 256) { const int j = tid >> 2, q = tid & 3; ((LAS float*)FW)[tid] = IN_(35)[(size_t)l * 64 * 2560 + (size_t)j * 2560 + (q >> 1) * 1280 + c0 + (q & 1)]; }
    __syncthreads();
    const float d0 = hy_delta(c0), d1 = hy_delta(c0 + 1);
#ifndef HYS
#define HYS 31
#endif
    float s0, s1, sc0 = 0.f, sc1 = 0.f;
    {
    s0 = 0.f; s1 = 0.f;
    if (HYS & 1)
#pragma unroll 1
    for (int i = 0; i < 2; ++i) { const int tb = 4096 * i + 8 * tid; const bf16_t* hc = H3x + tb;
        asm volatile("" ::: "memory");
        f32x4 acc[8];
#pragma unroll
        for (int p = 0; p < 8; ++p) acc[p] = (f32x4){0.f, 0.f, 0.f, 0.f};
#pragma unroll 8
        for (int j = 0; j < 64; ++j) { const f32x4 w = FW[j]; const u32x4 hv = *(const u32x4*)(hc + (size_t)j * T);
#pragma unroll
            for (int p = 0; p < 4; ++p) { acc[2 * p] += w * __uint_as_float(hv[p] << 16); acc[2 * p + 1] += w * __uint_as_float(hv[p] & 0xffff0000u); } }
#pragma unroll
        for (int p = 0; p < 8; ++p) { const int t = tb + p;
            const float tl = (float)t * (1.0f / 8191.0f), e0 = __expf(-tl * d0), e1 = __expf(-tl * d1);
            const float f0 = acc[p].x * e0, f1 = acc[p].y * e1, b0 = acc[p].z * e0, b1 = acc[p].w * e1;
            Z[ZI(t)] = (f32x2){f0, f1}; s0 += fabsf(f0); s1 += fabsf(f1);
            if (t < 8191) { Z[ZI(16383 - t)] = (f32x2){b0, b1}; s0 += fabsf(b0); s1 += fabsf(b1); } } }
    if (tid == 0) { float zz = 0.f; asm volatile("" : "+v"(zz)); Z[ZI(8192)] = (f32x2){zz, zz}; }
    s0 = wave_sum(s0); s1 = wave_sum(s1);
    if (F.lane == 0) { red[F.wave * 2] = s0; red[F.wave * 2 + 1] = s1; }
    __syncthreads();
    float n0 = 0.f, n1 = 0.f;
#pragma unroll
    for (int w = 0; w < 8; ++w) { n0 += red[2 * w]; n1 += red[2 * w + 1]; }
    sc0 = 1.0f / (16384.0f * n0); sc1 = 1.0f / (16384.0f * n1);
    if (HYS & 2) fft16k_dif(Z, tid);
#pragma unroll 2
    for (int i = 0; i < 17; ++i) { const int k = tid + 512 * i; if (i == 16 && tid != 0) break;
        const int pk = rev4_14(k & 16383), pn = rev4_14((16384 - k) & 16383);
        const f32x2 At = Z[ZI(pk)], Bt = Z[ZI(pn)];
        scr4[k] = (f32x4){0.5f * (At.x + Bt.x), 0.5f * (At.y - Bt.y), 0.5f * (At.y + Bt.y), -0.5f * (At.x - Bt.x)}; }
    __syncthreads();
    }
    if (tid == 0) { htn[0] = sc0; htn[1] = sc1; }
    __syncthreads();
}
__device__ __forceinline__ void hyena_unit(const Frame& F, unsigned char* ws, int l, int pair) {
    LAS f32x2* Z = (LAS f32x2*)F.lds;
    const int tid = F.tid, c0 = 2 * pair;
    float* GT = (float*)(ws + WS_GT); const float* X0T = (const float*)(ws + WS_X0T);
    const f32x4* scr4 = (const f32x4*)(ws + WS_HSCR) + (size_t)pair * HT_STRIDE; const float* htn = (const float*)(ws + WS_HTN) + 2 * pair;
    const float sc0 = htn[0], sc1 = htn[1];
#ifndef HYS
#define HYS 31
#endif
    for (int rp15 = 0; rp15 < REP(15); ++rp15) {
    const float* g0p = GT + (size_t)c0 * T + NCTX; const float* g1p = g0p + T;
    f32x4 Hr[17];
    { float zz = 0.f; asm volatile("" : "+v"(zz));
      f32x2 ga[8], gb[8];
#pragma unroll
      for (int i = 0; i < 8; ++i) { const int t = 2 * tid + 1024 * i; ga[i] = *(const f32x2*)(g0p + t); gb[i] = *(const f32x2*)(g1p + t); }
#pragma unroll
      for (int i = 0; i < 17; ++i) Hr[i] = scr4[i < 16 ? tid + 512 * i : 8192];
#pragma unroll
      for (int i = 0; i < 8; ++i) { const int t = 2 * tid + 1024 * i; Z[ZI(t)] = (f32x2){ga[i].x, gb[i].x}; Z[ZI(t + 1)] = (f32x2){ga[i].y, gb[i].y}; Z[ZI(8192 + t)] = (f32x2){zz, zz}; Z[ZI(8193 + t)] = (f32x2){zz, zz}; } }
    __syncthreads();
    if (HYS & 2) fft16k_dif(Z, tid);
    if (HYS & 8)
#pragma unroll
    for (int i = 0; i < 17; ++i) { const int k = tid + 512 * i; if (i == 16 && tid != 0) break;
        const int pk = rev4_14(k & 16383), pn = rev4_14((16384 - k) & 16383);
        const f32x2 A = Z[ZI(pk)], B = Z[ZI(pn)];
        const f32x2 G0 = (f32x2){0.5f * (A.x + B.x), 0.5f * (A.y - B.y)}, G1 = (f32x2){0.5f * (A.y + B.y), -0.5f * (A.x - B.x)};
        const f32x2 H0 = (f32x2){Hr[i].x, Hr[i].y}, H1 = (f32x2){Hr[i].z, Hr[i].w};
        const f32x2 P0 = cmul(G0, H0), P1 = cmul(G1, H1);
        Z[ZI(pk)] = (f32x2){P0.x - P1.y, P0.y + P1.x};
        if (pn != pk) Z[ZI(pn)] = (f32x2){P0.x + P1.y, P1.x - P0.y}; }
    __syncthreads();
    if (HYS & 2) fft16k_dit_inv(Z, tid);
    }
    const float bb0 = IN_(37)[l * 1280 + c0], bb1 = IN_(37)[l * 1280 + c0 + 1];
    { float* y0p = GT + (size_t)c0 * T + NCTX; float* y1p = y0p + T; const float* x0p = X0T + (size_t)c0 * T + NCTX; const float* x1p = x0p + T;
      f32x2 ga[8], gb[8], xa[8], xb[8];
#pragma unroll
      for (int i = 0; i < 8; ++i) { const int t = 2 * tid + 1024 * i; ga[i] = *(const f32x2*)(y0p + t); gb[i] = *(const f32x2*)(y1p + t); xa[i] = *(const f32x2*)(x0p + t); xb[i] = *(const f32x2*)(x1p + t); }
#pragma unroll
      for (int i = 0; i < 8; ++i) { const int t = 2 * tid + 1024 * i; const f32x2 z0 = Z[ZI(t)], z1 = Z[ZI(t + 1)];
          *(f32x2*)(y0p + t) = (f32x2){xa[i].x * (z0.x * sc0 + ga[i].x * bb0), xa[i].y * (z1.x * sc0 + ga[i].y * bb0)};
          *(f32x2*)(y1p + t) = (f32x2){xb[i].x * (z0.y * sc1 + gb[i].x * bb1), xb[i].y * (z1.y * sc1 + gb[i].y * bb1)}; } }
    __syncthreads();
}
__device__ __forceinline__ void hyena_ctx_unit(const Frame& F, unsigned char* ws, int l, int unit) {
    LAS float* TF = (LAS float*)F.lds; LAS float* TB = TF + 2048; LAS float* GG = TB + 2048;
    const int tid = F.tid, t = tid >> 1, cc = (tid & 1) * 4, cbase = unit * 8 + cc;
    const bf16_t* H3c = (const bf16_t*)(ws + WS_H3) + (size_t)l * 64 * T; float* GT = (float*)(ws + WS_GT); const float* X0T = (const float*)(ws + WS_X0T);
    { float f[4] = {0.f, 0.f, 0.f, 0.f}, b[4] = {0.f, 0.f, 0.f, 0.f};
      const float* wbase = IN_(35) + (size_t)l * 64 * 2560 + cbase;
      for (int j = 0; j < 64; ++j) { const float hv = bf2f(H3c[(size_t)j * T + t]); const float* wrow = wbase + (size_t)j * 2560;
#pragma unroll
          for (int q = 0; q < 4; ++q) { f[q] += hv * wrow[q]; b[q] += hv * wrow[1280 + q]; } }
      const float tl = (float)t * (1.0f / 255.0f);
#pragma unroll
      for (int q = 0; q < 4; ++q) { const float e = __expf(-tl * hy_delta(cbase + q)); TF[t * 8 + cc + q] = f[q] * e; TB[t * 8 + cc + q] = b[q] * e; GG[t * 8 + cc + q] = GT[(size_t)(cbase + q) * T + t]; } }
    __syncthreads();
    float nrm[4] = {0.f, 0.f, 0.f, 0.f}, y[4] = {0.f, 0.f, 0.f, 0.f};
    for (int s = 0; s < 256; ++s) {
#pragma unroll
        for (int q = 0; q < 4; ++q) { nrm[q] += fabsf(TF[s * 8 + cc + q]) + (s < 255 ? fabsf(TB[s * 8 + cc + q]) : 0.f);
            const int o = t - s; const float tap = o >= 0 ? TF[o * 8 + cc + q] : TB[(-o - 1) * 8 + cc + q];
            y[q] += tap * GG[s * 8 + cc + q]; } }
    __syncthreads();
#pragma unroll
    for (int q = 0; q < 4; ++q) GT[(size_t)(cbase + q) * T + t] = X0T[(size_t)(cbase + q) * T + t] * (y[q] / nrm[q] + GG[t * 8 + cc + q] * IN_(37)[l * 1280 + cbase + q]);
    __syncthreads();
}
constexpr int SC_C = 16, SC_NCHUNK = T / SC_C, SC_CHUNK_BYTES = 14 * 1024;
__device__ __forceinline__ int sc_tau(int d, int c, int t) { return d == 0 ? SC_C * c + t : (c < NCTX / SC_C ? NCTX - 1 - SC_C * c - t : T - 1 - SC_C * (c - NCTX / SC_C) - t); }
__device__ __forceinline__ int sc_perm(int e, int hi) { return (e & 3) + 8 * (e >> 2) + 4 * hi; }
constexpr size_t WS_FR_BYTES = (size_t)2 * NHA * SC_NCHUNK * SC_CHUNK_BYTES;

typedef short sc_bf16x8 __attribute__((ext_vector_type(8)));
typedef float sc_f32x16 __attribute__((ext_vector_type(16)));
__device__ __forceinline__ sc_bf16x8 sc_pack8(const sc_f32x16& a, int base) {
    u32x4 w; w.x = cvt_pk_bf16(a[base + 0], a[base + 1]); w.y = cvt_pk_bf16(a[base + 2], a[base + 3]); w.z = cvt_pk_bf16(a[base + 4], a[base + 5]); w.w = cvt_pk_bf16(a[base + 6], a[base + 7]);
    return *reinterpret_cast<sc_bf16x8*>(&w);
}
constexpr int SC_NSLOT = 9, SC_AHEAD = 7;
__device__ __forceinline__ void scan_chain_mfma(const Frame& F, unsigned char* ws, int chain) {
    const int h = chain >> 1, d = chain & 1, lane = F.lane, n = lane & 31, hi = lane >> 5, ib = F.wave;
    const unsigned char* FRc = ws + WS_FR + (size_t)chain * SC_NCHUNK * SC_CHUNK_BYTES;
    float* Yd = (float*)(ws + WS_Y) + (size_t)d * T * A_W + h * 64;
    LAS unsigned char* buf = F.lds;
    typedef __attribute__((address_space(3))) unsigned sc_lds_u32;
#define SCM_DMA(c_) do { if (ib < 7) { const unsigned char* src_ = FRc + (size_t)(c_) * SC_CHUNK_BYTES; LAS unsigned char* dst_ = buf + ((c_) % SC_NSLOT) * SC_CHUNK_BYTES; \
        _Pragma("unroll") for (int i_ = 0; i_ < 2; ++i_) __builtin_amdgcn_global_load_lds((const unsigned*)(src_ + (i_ * 7 + ib) * 1024 + lane * 16), (sc_lds_u32*)(dst_ + (i_ * 7 + ib) * 1024), 16, 0, 0); } } while (0)
    sc_f32x16 S0 = {}, S1 = {};
    int yoff[8];
#pragma unroll
    for (int r = 0; r < 8; ++r) { const int t = (r & 3) + 8 * (r >> 2) + 4 * hi; yoff[r] = (d ? -t : t) * A_W + 32 * ib + n; }
    __syncthreads();
#pragma unroll
    for (int c = 0; c < SC_AHEAD; ++c) SCM_DMA(c);
    asm volatile("s_waitcnt vmcnt(12)" ::: "memory"); __builtin_amdgcn_s_barrier(); asm volatile("" ::: "memory");
#pragma unroll 1
    for (int c = 0; c < SC_NCHUNK; ++c) {
        const bool steady = c + SC_AHEAD < SC_NCHUNK;
        if (steady) SCM_DMA(c + SC_AHEAD);
        if (ib < 2) {
                const LAS unsigned char* fb = buf + (c % SC_NSLOT) * SC_CHUNK_BYTES;
                sc_bf16x8 fr[11]; sc_bf16x8 vf; f32x4 gt[8];
                { const unsigned fa = (unsigned)(uintptr_t)fb + lane * 16, va = fa + (11 + ib) * 1024, ga = (unsigned)(uintptr_t)fb + 13 * 1024 + hi * 128;
#define SC_DSRD(dst, addr, off) asm volatile("ds_read_b128 %0, %1 offset:%2" : "=v"(dst) : "v"(addr), "i"(off))
                  SC_DSRD(fr[0], fa, 0); SC_DSRD(fr[1], fa, 1024); SC_DSRD(fr[2], fa, 2048); SC_DSRD(fr[3], fa, 3072); SC_DSRD(fr[4], fa, 4096); SC_DSRD(fr[5], fa, 5120);
                  SC_DSRD(fr[6], fa, 6144); SC_DSRD(fr[7], fa, 7168); SC_DSRD(fr[8], fa, 8192); SC_DSRD(fr[9], fa, 9216); SC_DSRD(fr[10], fa, 10240); SC_DSRD(vf, va, 0);
                  SC_DSRD(gt[0], ga, 0); SC_DSRD(gt[1], ga, 16); SC_DSRD(gt[2], ga, 32); SC_DSRD(gt[3], ga, 48); SC_DSRD(gt[4], ga, 64); SC_DSRD(gt[5], ga, 80); SC_DSRD(gt[6], ga, 96); SC_DSRD(gt[7], ga, 112);
#undef SC_DSRD
                  asm volatile("s_waitcnt lgkmcnt(0)" : "+v"(fr[0]), "+v"(fr[1]), "+v"(fr[2]), "+v"(fr[3]), "+v"(fr[4]), "+v"(fr[5]), "+v"(fr[6]), "+v"(fr[7]), "+v"(fr[8]), "+v"(fr[9]), "+v"(fr[10]), "+v"(vf) :: "memory");
                  asm volatile("" : "+v"(gt[0]), "+v"(gt[1]), "+v"(gt[2]), "+v"(gt[3]), "+v"(gt[4]), "+v"(gt[5]), "+v"(gt[6]), "+v"(gt[7])); }
                const sc_bf16x8 sb00 = sc_pack8(S0, 0), sb01 = sc_pack8(S0, 8), sb10 = sc_pack8(S1, 0), sb11 = sc_pack8(S1, 8);
                sc_f32x16 P = {}, P2 = {};
                P = __builtin_amdgcn_mfma_f32_32x32x16_bf16(fr[0], sb00, P, 0, 0, 0);
                P2 = __builtin_amdgcn_mfma_f32_32x32x16_bf16(fr[2], sb10, P2, 0, 0, 0);
                P = __builtin_amdgcn_mfma_f32_32x32x16_bf16(fr[1], sb01, P, 0, 0, 0);
                P2 = __builtin_amdgcn_mfma_f32_32x32x16_bf16(fr[3], sb11, P2, 0, 0, 0);
                P = __builtin_amdgcn_mfma_f32_32x32x16_bf16(fr[4], vf, P, 0, 0, 0);
#pragma unroll
                for (int q = 0; q < 4; ++q)
#pragma unroll
                    for (int e = 0; e < 4; ++e) { S0[4 * q + e] *= gt[q][e]; S1[4 * q + e] *= gt[4 + q][e]; }
                S0 = __builtin_amdgcn_mfma_f32_32x32x16_bf16(fr[8], vf, S0, 0, 0, 0);
                S1 = __builtin_amdgcn_mfma_f32_32x32x16_bf16(fr[10], vf, S1, 0, 0, 0);
#pragma unroll
                for (int r = 0; r < 16; ++r) P[r] += P2[r];
                const sc_bf16x8 xb = sc_pack8(P, 0);
                sc_f32x16 U = {};
                U = __builtin_amdgcn_mfma_f32_32x32x16_bf16(fr[5], xb, U, 0, 0, 0);
                const sc_bf16x8 ub = sc_pack8(U, 0);
                S0 = __builtin_amdgcn_mfma_f32_32x32x16_bf16(fr[7], ub, S0, 0, 0, 0);
                S1 = __builtin_amdgcn_mfma_f32_32x32x16_bf16(fr[9], ub, S1, 0, 0, 0);
                P = __builtin_amdgcn_mfma_f32_32x32x16_bf16(fr[6], ub, P, 0, 0, 0);
                float* yb = Yd + (size_t)sc_tau(d, c, 0) * A_W;
#pragma unroll
                for (int r = 0; r < 8; ++r) yb[yoff[r]] = P[8 + r];
        }
        if (steady) asm volatile("s_waitcnt vmcnt(12)" ::: "memory"); else asm volatile("s_waitcnt vmcnt(0)" ::: "memory");
        asm volatile("s_waitcnt lgkmcnt(0)" ::: "memory"); __builtin_amdgcn_s_barrier(); asm volatile("" ::: "memory");
    }
    asm volatile("s_waitcnt vmcnt(0)" ::: "memory"); __syncthreads();
#undef SCM_DMA
}
__device__ __forceinline__ float conv3_u(const float* PX, int tau, unsigned ucol, float w0, float w1, float w2) {
    const float* p = PX + (size_t)tau * PXW;
    float y = p[ucol] * w1;
    if (has_left(tau)) y += (p - PXW)[ucol] * w0;
    if (has_right(tau)) y += (p + PXW)[ucol] * w2;
    return y;
}
constexpr int WLR_K = 448;
constexpr int RP_WAVE_LDS = 16896;
typedef short rp_bf16x8 __attribute__((ext_vector_type(8)));
typedef float rp_f32x16 __attribute__((ext_vector_type(16)));
__device__ __forceinline__ unsigned short f2bf16(float x) { return (unsigned short)(cvt_pk_bf16(x, x) & 0xffffu); }
template <int NKB, class AF>
__device__ __forceinline__ void rp_lowrank(float (&dst)[16], const AF& afrag, const bf16_t* WLRh, int kw0, int n, int hi) {
    rp_f32x16 c0 = {}, c1 = {}; const bf16_t* wb0 = WLRh + (size_t)n * WLR_K + kw0 + 8 * hi; const bf16_t* wb1 = wb0 + (size_t)32 * WLR_K;
#pragma unroll
    for (int kb = 0; kb < NKB; ++kb) { const rp_bf16x8 b0 = *(const rp_bf16x8*)(wb0 + 16 * kb), b1 = *(const rp_bf16x8*)(wb1 + 16 * kb); const rp_bf16x8 a_ = afrag(kb);
        c0 = __builtin_amdgcn_mfma_f32_32x32x16_bf16(a_, b0, c0, 0, 0, 0); c1 = __builtin_amdgcn_mfma_f32_32x32x16_bf16(a_, b1, c1, 0, 0, 0); }
#pragma unroll
    for (int r = 0; r < 8; ++r) { auto sw = __builtin_amdgcn_permlane32_swap(__float_as_uint(c0[r]), __float_as_uint(c1[r]), false, false);
        dst[(r & 3) + 8 * (r >> 2)] = __uint_as_float(sw[0]); dst[(r & 3) + 8 * (r >> 2) + 4] = __uint_as_float(sw[1]); }
}
struct RpAfLds { const LAS bf16_t* base; __device__ __forceinline__ rp_bf16x8 operator()(int kb) const { return *(const LAS rp_bf16x8*)(base + 16 * kb); } };
__device__ __forceinline__ void rwkv_elem_phase(const Frame& F, unsigned char* ws, int l) {
    const float* PX = (const float*)(ws + WS_PX); float* SS = (float*)(ws + WS_SS); float* SD = (float*)(ws + WS_SD); float* GB = (float*)(ws + WS_G);
    const bf16_t* WLR = (const bf16_t*)(ws + WS_WLR) + (size_t)l * A_W * WLR_K;
    const float* cw = IN_(16) + (size_t)l * 3 * A_IN;
    LAS bf16_t* ACT = (LAS bf16_t*)(F.lds + F.wave * 10752);
    const int lane = F.lane, n = lane & 31, hi = lane >> 5;
    const int gw = F.bid * 8 + F.wave, NGW = F.G * 8;
    for (int it = gw; it < (T / 16) * 10; it += NGW) {
        const int tg = it / 10, hq = it % 10, tau0 = tg * 16;
        asm volatile("s_waitcnt lgkmcnt(0)" ::: "memory");
        const float* prow0 = PX + (size_t)(tau0 > 0 ? tau0 - 1 : 0) * PXW; const int roff = tau0 > 0 ? 0 : -1;
#define RP_WIN(x, ucol_) do { _Pragma("unroll") for (int i_ = 0; i_ < 18; ++i_) { int ri_ = i_ + roff; ri_ = ri_ < 0 ? 0 : ri_; ri_ = (tau0 - 1 + i_ > T - 1) ? (T - 1 - (tau0 > 0 ? tau0 - 1 : 0)) : ri_; x[i_] = (prow0 + (size_t)ri_ * PXW)[ucol_]; } } while (0)
#define RP_CONV(x, t_, w0_, w1_, w2_) (x[(t_)] * (has_left(tau0 + (t_)) ? (w0_) : 0.f) + x[(t_) + 1] * (w1_) + x[(t_) + 2] * (has_right(tau0 + (t_)) ? (w2_) : 0.f))
#pragma unroll
        for (int i = 0; i < 5; ++i) { const int c = lane + 64 * i, col = 3840 + c; const float c0 = cw[col], c1 = cw[A_IN + col], c2 = cw[2 * A_IN + col];
            float x[18]; RP_WIN(x, (unsigned)(PXA + col));
#pragma unroll
            for (int t = 0; t < 16; ++t) { const float val = RP_CONV(x, t, c0, c1, c2);
                const float act = i == 0 ? 1.0f - 2.0f / (1.0f + __expf(2.0f * val)) : (i == 1 ? val : sigmoidf_(val));
                ACT[t * 328 + c] = f2bf16(act); } }
        asm volatile("s_waitcnt lgkmcnt(0)" ::: "memory");
        const RpAfLds afw{ACT + (n & 15) * 328 + 8 * hi}, afa{ACT + (n & 15) * 328 + 64 + 8 * hi}, afg{ACT + (n & 15) * 328 + 128 + 8 * hi};
#pragma unroll 1
        for (int hh = 0; hh < 2; ++hh) {
            const int h = hq * 2 + hh, col = h * 64 + lane; const bf16_t* WLRh = WLR + (size_t)h * 64 * WLR_K;
            { float lg[16]; rp_lowrank<12>(lg, afg, WLRh, 256, n, hi);
#pragma unroll
              for (int t = 0; t < 16; ++t) GB[(size_t)(tau0 + t) * A_W + col] = lg[t]; }
            const float cr0 = cw[col], cr1 = cw[A_IN + col], cr2 = cw[2 * A_IN + col];
            const float ck0 = cw[A_W + col], ck1 = cw[A_IN + A_W + col], ck2 = cw[2 * A_IN + A_W + col];
            const float cv0 = cw[2 * A_W + col], cv1 = cw[A_IN + 2 * A_W + col], cv2 = cw[2 * A_IN + 2 * A_W + col];
            const float kk_w = IN_(22)[l * A_W + col], ka_w = IN_(23)[l * A_W + col];
            float kkv[16], kv[16];
            { float xr[18], xk[18], xv[18]; const unsigned uc = (unsigned)(PXA + col); RP_WIN(xr, uc); RP_WIN(xk, uc + A_W); RP_WIN(xv, uc + 2 * A_W);
#pragma unroll
              for (int t = 0; t < 16; ++t) { const int tau = tau0 + t;
                  const float r = RP_CONV(xr, t, cr0, cr1, cr2), v = RP_CONV(xv, t, cv0, cv1, cv2); kv[t] = RP_CONV(xk, t, ck0, ck1, ck2);
                  const float kr = kv[t] * kk_w; const float nrm = sqrtf(wave_sum(kr * kr)); kkv[t] = kr / fmaxf(nrm, 1e-12f);
                  float* ss = SS + ((size_t)h * T + tau) * 192 + lane; ss[0] = kkv[t]; ss[64] = r; ss[128] = v; } }
#pragma unroll 1
            for (int d = 0; d < 2; ++d) { const float w0b = IN_(17)[(l * 2 + d) * A_W + col], a0b = IN_(19)[(l * 2 + d) * A_W + col]; float lw[16], la[16];
                rp_lowrank<4>(lw, afw, WLRh, 64 * d, n, hi); rp_lowrank<4>(la, afa, WLRh, 128 + 64 * d, n, hi);
#pragma unroll
                for (int t = 0; t < 16; ++t) { const float z = w0b + lw[t]; const float decay = __expf(-__expf(-(fmaxf(-z, 0.f) + __logf(1.0f + __expf(-fabsf(z)))) - 0.5f)); const float av = sigmoidf_(a0b + la[t]);
                    float* sd = SD + (((size_t)h * 2 + d) * T + tau0 + t) * 192 + lane; sd[0] = decay; sd[64] = kkv[t] * av; sd[128] = kv[t] * (1.0f + (av - 1.0f) * ka_w); } }
        }
    }
}
#undef RP_WIN
#undef RP_CONV
constexpr int SP_WAVE_LDS = 16640;
__device__ __forceinline__ void scan_prep_phase(const Frame& F, unsigned char* ws) {
    const float* SS = (const float*)(ws + WS_SS); const float* SD = (const float*)(ws + WS_SD); unsigned char* FR = ws + WS_FR;
    LAS bf16_t* R1 = (LAS bf16_t*)(F.lds + F.wave * SP_WAVE_LDS); LAS bf16_t* R2 = R1 + 32 * 72; LAS bf16_t* BbT = R2 + 32 * 72; LAS bf16_t* KbT = BbT + 64 * 16; LAS bf16_t* VT = KbT + 64 * 16; LAS float* Lm = (LAS float*)(VT + 64 * 16);
    const int lane = F.lane, n = lane & 31, hi = lane >> 5;
    const int gw = F.bid * 8 + F.wave, NGW = F.G * 8;
    for (int it = gw; it < 2 * NHA * SC_NCHUNK; it += NGW) {
        const int chain = it / SC_NCHUNK, c = it % SC_NCHUNK, h = chain >> 1, d = chain & 1;
        const int tau_first = sc_tau(d, c, 0), dstep = d ? -1 : 1;
        const float* ssb = SS + (size_t)h * T * 192 + lane; const float* sdb = SD + ((size_t)h * 2 + d) * T * 192 + lane;
        float xw[16], xb[16], xk[16], xkk[16], xr[16], xv[16];
#pragma unroll
        for (int s = 0; s < 16; ++s) { const size_t o = (size_t)(tau_first + dstep * s) * 192; xw[s] = sdb[o]; xb[s] = sdb[o + 64]; xk[s] = sdb[o + 128]; xkk[s] = ssb[o]; xr[s] = ssb[o + 64]; xv[s] = ssb[o + 128]; }
        float gC = 1.f;
#pragma unroll
        for (int s = 0; s < 16; ++s) gC *= xw[s];
        float g = 1.f;
#pragma unroll
        for (int s = 0; s < 16; ++s) {
            const float gm1 = g; g *= xw[s]; const float ig = 1.0f / g; const float bh = xb[s] * ig, kh = xk[s] * ig;
            R1[s * 72 + lane] = f2bf16(-xkk[s] * gm1); R1[(16 + s) * 72 + lane] = f2bf16(xr[s] * g);
            R2[s * 72 + lane] = f2bf16(bh); R2[(16 + s) * 72 + lane] = f2bf16(kh);
            BbT[lane * 16 + s] = f2bf16(bh * gC); KbT[lane * 16 + s] = f2bf16(kh * gC); VT[lane * 16 + s] = f2bf16(xv[s]); }
        asm volatile("s_waitcnt lgkmcnt(0)" ::: "memory");
        unsigned char* dst = FR + ((size_t)chain * SC_NCHUNK + c) * SC_CHUNK_BYTES;
        rp_f32x16 C = {};
#pragma unroll
        for (int kb = 0; kb < 4; ++kb) { const rp_bf16x8 a_ = *(const LAS rp_bf16x8*)(R2 + n * 72 + 16 * kb + 8 * hi), b_ = *(const LAS rp_bf16x8*)(R1 + n * 72 + 16 * kb + 8 * hi);
            C = __builtin_amdgcn_mfma_f32_32x32x16_bf16(a_, b_, C, 0, 0, 0); }
        const int tt_ = n & 15; const bool incl = n >= 16;
#pragma unroll
        for (int r = 0; r < 16; ++r) { const int s = ((r & 7) & 3) + 8 * ((r & 7) >> 2) + 4 * hi; if (!(s < tt_ || (incl && s == tt_))) C[r] = 0.f; }
        if (n < 16) {
#pragma unroll
            for (int r = 0; r < 8; ++r) Lm[((r & 3) + 8 * (r >> 2) + 4 * hi) * 20 + n] = C[r]; }
        { u32x4 f4; f4.x = cvt_pk_bf16(C[8], C[9]); f4.y = cvt_pk_bf16(C[10], C[11]); f4.z = cvt_pk_bf16(C[12], C[13]); f4.w = cvt_pk_bf16(C[14], C[15]);
          u32x4 f6; f6.x = cvt_pk_bf16(C[0], C[1]); f6.y = cvt_pk_bf16(C[2], C[3]); f6.z = cvt_pk_bf16(C[4], C[5]); f6.w = cvt_pk_bf16(C[6], C[7]);
          if (n < 16) f6 = (u32x4){0u, 0u, 0u, 0u};
          *(u32x4*)(dst + 4 * 1024 + lane * 16) = f4; *(u32x4*)(dst + 6 * 1024 + lane * 16) = f6; }
        asm volatile("s_waitcnt lgkmcnt(0)" ::: "memory");
        { float Tc[16];
#pragma unroll
          for (int s = 15; s >= 0; --s) { float acc = (s == n) ? 1.f : 0.f;
#pragma unroll
              for (int u = s + 1; u < 16; ++u) acc += Lm[s * 20 + u] * Tc[u];
              Tc[s] = acc; }
          u32x4 f5; f5.x = cvt_pk_bf16(hi ? Tc[4] : Tc[0], hi ? Tc[5] : Tc[1]); f5.y = cvt_pk_bf16(hi ? Tc[6] : Tc[2], hi ? Tc[7] : Tc[3]);
          f5.z = cvt_pk_bf16(hi ? Tc[12] : Tc[8], hi ? Tc[13] : Tc[9]); f5.w = cvt_pk_bf16(hi ? Tc[14] : Tc[10], hi ? Tc[15] : Tc[11]);
          if (n >= 16) f5 = (u32x4){0u, 0u, 0u, 0u};
          *(u32x4*)(dst + 5 * 1024 + lane * 16) = f5; }
#pragma unroll
        for (int f = 0; f < 4; ++f) { const u32x2 p0 = *(const LAS u32x2*)(R1 + n * 72 + 16 * f + 4 * hi), p1 = *(const LAS u32x2*)(R1 + n * 72 + 16 * f + 8 + 4 * hi);
            *(u32x4*)(dst + f * 1024 + lane * 16) = (u32x4){p0.x, p0.y, p1.x, p1.y}; }
#pragma unroll
        for (int jb = 0; jb < 2; ++jb) { const int row = 32 * jb + n;
            const u32x2 b0 = *(const LAS u32x2*)(BbT + row * 16 + 4 * hi), b1 = *(const LAS u32x2*)(BbT + row * 16 + 8 + 4 * hi), k0 = *(const LAS u32x2*)(KbT + row * 16 + 4 * hi), k1 = *(const LAS u32x2*)(KbT + row * 16 + 8 + 4 * hi);
            const u32x2 v0 = *(const LAS u32x2*)(VT + row * 16 + 4 * hi), v1 = *(const LAS u32x2*)(VT + row * 16 + 8 + 4 * hi);
            *(u32x4*)(dst + (7 + 2 * jb) * 1024 + lane * 16) = (u32x4){b0.x, b0.y, b1.x, b1.y}; *(u32x4*)(dst + (8 + 2 * jb) * 1024 + lane * 16) = (u32x4){k0.x, k0.y, k1.x, k1.y};
            *(u32x4*)(dst + (11 + jb) * 1024 + lane * 16) = (u32x4){v0.x, v0.y, v1.x, v1.y}; }
        { const int jj = lane & 31; ((float*)(dst + 13 * 1024))[((jj >> 2) & 1) * 32 + (lane >> 5) * 16 + (jj & 3) + 4 * (jj >> 3)] = gC; }
        asm volatile("s_waitcnt lgkmcnt(0)" ::: "memory");
    }
}
constexpr int RF_ACT_BYTES = 16 * 320 * 2;
__device__ __forceinline__ void rwkv_fused_phase(const Frame& F, unsigned char* ws, int l) {
    const bf16_t* PX = (const bf16_t*)(ws + WS_PX); unsigned char* FR = ws + WS_FR;
    float* GB = (float*)(ws + WS_G); float* VB = (float*)(ws + WS_SS) + (size_t)T * A_W; float* BS = (float*)(ws + WS_SD);
    const bf16_t* WLR = (const bf16_t*)(ws + WS_WLR) + (size_t)l * A_W * WLR_K;
    const float* cw = IN_(16) + (size_t)l * 3 * A_IN;
    LAS bf16_t* ACT = (LAS bf16_t*)F.lds;
    LAS bf16_t* R1 = (LAS bf16_t*)(F.lds + RF_ACT_BYTES + F.wave * SP_WAVE_LDS); LAS bf16_t* R2 = R1 + 32 * 72; LAS bf16_t* BbT = R2 + 32 * 72; LAS bf16_t* KbT = BbT + 64 * 16; LAS bf16_t* VT = KbT + 64 * 16; LAS float* Lm = (LAS float*)(VT + 64 * 16);
    const int lane = F.lane, n = lane & 31, hi = lane >> 5, hh = F.wave >> 1, d = F.wave & 1;
    for (int it = F.bid; it < (T / 16) * 5; it += F.G) {
        const int tg = it / 5, hg = it % 5, tau0 = tg * 16, h = hg * 4 + hh, col = h * 64 + lane;
        const bf16_t* prow0 = PX + (size_t)(tau0 > 0 ? tau0 - 1 : 0) * PXW; const int roff = tau0 > 0 ? 0 : -1;
#define RP_WIN(x, ucol_) do { _Pragma("unroll") for (int i_ = 0; i_ < 18; ++i_) { int ri_ = i_ + roff; ri_ = ri_ < 0 ? 0 : ri_; ri_ = (tau0 - 1 + i_ > T - 1) ? (T - 1 - (tau0 > 0 ? tau0 - 1 : 0)) : ri_; x[i_] = bf2f((prow0 + (size_t)ri_ * PXW)[ucol_]); } } while (0)
#define RP_CONV(x, t_, w0_, w1_, w2_) (x[(t_)] * (has_left(tau0 + (t_)) ? (w0_) : 0.f) + x[(t_) + 1] * (w1_) + x[(t_) + 2] * (has_right(tau0 + (t_)) ? (w2_) : 0.f))
        float wr_[18], wk_[18], wv_[18]; { const unsigned uc = (unsigned)(PXA + col); RP_WIN(wr_, uc); RP_WIN(wk_, uc + A_W); RP_WIN(wv_, uc + 2 * A_W); }
        const float cr0 = cw[col], cr1 = cw[A_IN + col], cr2 = cw[2 * A_IN + col], ck0 = cw[A_W + col], ck1 = cw[A_IN + A_W + col], ck2 = cw[2 * A_IN + A_W + col];
        const float cv0 = cw[2 * A_W + col], cv1 = cw[A_IN + 2 * A_W + col], cv2 = cw[2 * A_IN + 2 * A_W + col], kk_w = IN_(22)[l * A_W + col];
        __syncthreads();
        { int tq = F.tid; asm volatile("" : "+v"(tq));
#pragma unroll
          for (int i = 0; i < 3; ++i) { const int item = tq + 512 * i;
              if (item < 16 * 80) { const int t = item / 80, c = 4 * (item % 80), cc = 3840 + c, tau = tau0 + t;
                  const bf16_t* p = PX + (size_t)tau * PXW + PXA + cc; const bool hl = has_left(tau), hr = has_right(tau);
                  const f32x4 x1 = bf4f(*(const u32x2*)p), x0 = bf4f(*(const u32x2*)(p - (hl ? PXW : 0))), x2 = bf4f(*(const u32x2*)(p + (hr ? PXW : 0)));
                  const f32x4 w0 = *(const f32x4*)(cw + cc), w1 = *(const f32x4*)(cw + A_IN + cc), w2 = *(const f32x4*)(cw + 2 * A_IN + cc);
                  const f32x4 val = x1 * w1 + x0 * (w0 * (hl ? 1.f : 0.f)) + x2 * (w2 * (hr ? 1.f : 0.f));
                  f32x4 act;
#pragma unroll
                  for (int e = 0; e < 4; ++e) act[e] = c < 64 ? 1.0f - 2.0f / (1.0f + __expf(2.0f * val[e])) : (c < 128 ? val[e] : sigmoidf_(val[e]));
                  u32x2 o; o.x = cvt_pk_bf16(act.x, act.y); o.y = cvt_pk_bf16(act.z, act.w);
                  *(LAS u32x2*)(ACT + t * 320 + c) = o; } } }
        __syncthreads();
        const bf16_t* WLRh = WLR + (size_t)h * 64 * WLR_K;
        const RpAfLds afw{ACT + (n & 15) * 320 + 8 * hi}, afa{ACT + (n & 15) * 320 + 64 + 8 * hi}, afg{ACT + (n & 15) * 320 + 128 + 8 * hi};
        float xw[16], xb[16], xk[16], xkk[16], xr[16], xv[16];
        {
          if (d == 0) { float lg[16]; rp_lowrank<12>(lg, afg, WLRh, 256, n, hi);
#pragma unroll
              for (int t = 0; t < 16; ++t) GB[(size_t)(tau0 + t) * A_W + col] = lg[t]; }
#pragma unroll
          for (int t = 0; t < 16; ++t) { xr[t] = RP_CONV(wr_, t, cr0, cr1, cr2); xv[t] = RP_CONV(wv_, t, cv0, cv1, cv2); xk[t] = RP_CONV(wk_, t, ck0, ck1, ck2);
              const float kr = xk[t] * kk_w; const float nrm = sqrtf(wave_sum(kr * kr)); xkk[t] = kr / fmaxf(nrm, 1e-12f); } }
        if (d == 0) {
#pragma unroll
            for (int t = 0; t < 16; ++t) VB[(size_t)(tau0 + t) * A_W + col] = xv[t]; }
        { const float ka_w = IN_(23)[l * A_W + col], w0b = IN_(17)[(l * 2 + d) * A_W + col], a0b = IN_(19)[(l * 2 + d) * A_W + col]; float la[16];
          rp_lowrank<4>(xw, afw, WLRh, 64 * d, n, hi); rp_lowrank<4>(la, afa, WLRh, 128 + 64 * d, n, hi);
#pragma unroll
          for (int t = 0; t < 16; ++t) { const float z = w0b + xw[t]; xw[t] = __expf(-__expf(-(fmaxf(-z, 0.f) + __logf(1.0f + __expf(-fabsf(z)))) - 0.5f)); const float av = sigmoidf_(a0b + la[t]);
              xb[t] = xkk[t] * av; xk[t] = xk[t] * (1.0f + (av - 1.0f) * ka_w); }
          { const float rk_w = IN_(24)[l * A_W + col]; float pr[16];
#pragma unroll
            for (int t = 0; t < 16; ++t) pr[t] = xr[t] * xk[t] * rk_w;
            const float sb = wave_sum16(pr, lane);
            if ((lane & 3) == 0) BS[((size_t)d * T + tau0 + (lane >> 2)) * NHA + h] = sb; } }
        if (d) {
#pragma unroll
            for (int s = 0; s < 8; ++s) { float t_;
                t_ = xw[s]; xw[s] = xw[15 - s]; xw[15 - s] = t_; t_ = xb[s]; xb[s] = xb[15 - s]; xb[15 - s] = t_; t_ = xk[s]; xk[s] = xk[15 - s]; xk[15 - s] = t_;
                t_ = xkk[s]; xkk[s] = xkk[15 - s]; xkk[15 - s] = t_; t_ = xr[s]; xr[s] = xr[15 - s]; xr[15 - s] = t_; t_ = xv[s]; xv[s] = xv[15 - s]; xv[15 - s] = t_; } }
        const int c = d == 0 ? tg : (tg < NCTX / 16 ? NCTX / 16 - 1 - tg : NCTX / 16 + (T / 16 - 1) - tg);
        float gC = 1.f;
#pragma unroll
        for (int s = 0; s < 16; ++s) gC *= xw[s];
        float g = 1.f;
#pragma unroll
        for (int s = 0; s < 16; ++s) {
            const float gm1 = g; g *= xw[s]; const float ig = 1.0f / g; const float bh = xb[s] * ig, kh = xk[s] * ig;
            R1[s * 72 + lane] = f2bf16(-xkk[s] * gm1); R1[(16 + s) * 72 + lane] = f2bf16(xr[s] * g);
            R2[s * 72 + lane] = f2bf16(bh); R2[(16 + s) * 72 + lane] = f2bf16(kh);
            xb[s] = bh * gC; xk[s] = kh * gC; }
        asm volatile("s_waitcnt lgkmcnt(0)" ::: "memory");
        unsigned char* dst = FR + ((size_t)(h * 2 + d) * SC_NCHUNK + c) * SC_CHUNK_BYTES;
        rp_f32x16 C = {};
#pragma unroll
        for (int kb = 0; kb < 4; ++kb) { const rp_bf16x8 a_ = *(const LAS rp_bf16x8*)(R2 + n * 72 + 16 * kb + 8 * hi), b_ = *(const LAS rp_bf16x8*)(R1 + n * 72 + 16 * kb + 8 * hi);
            C = __builtin_amdgcn_mfma_f32_32x32x16_bf16(a_, b_, C, 0, 0, 0); }
        const int tt_ = n & 15; const bool incl = n >= 16;
#pragma unroll
        for (int r = 0; r < 16; ++r) { const int s = ((r & 7) & 3) + 8 * ((r & 7) >> 2) + 4 * hi; if (!(s < tt_ || (incl && s == tt_))) C[r] = 0.f; }
        if (n < 16) {
#pragma unroll
            for (int r = 0; r < 8; ++r) Lm[((r & 3) + 8 * (r >> 2) + 4 * hi) * 20 + n] = C[r]; }
        { u32x4 f4; f4.x = cvt_pk_bf16(C[8], C[9]); f4.y = cvt_pk_bf16(C[10], C[11]); f4.z = cvt_pk_bf16(C[12], C[13]); f4.w = cvt_pk_bf16(C[14], C[15]);
          u32x4 f6; f6.x = cvt_pk_bf16(C[0], C[1]); f6.y = cvt_pk_bf16(C[2], C[3]); f6.z = cvt_pk_bf16(C[4], C[5]); f6.w = cvt_pk_bf16(C[6], C[7]);
          if (n < 16) f6 = (u32x4){0u, 0u, 0u, 0u};
          *(u32x4*)(dst + 4 * 1024 + lane * 16) = f4; *(u32x4*)(dst + 6 * 1024 + lane * 16) = f6; }
        asm volatile("s_waitcnt lgkmcnt(0)" ::: "memory");
        { float Tc[16];
#pragma unroll
          for (int s = 15; s >= 0; --s) { float acc = (s == n) ? 1.f : 0.f;
#pragma unroll
              for (int u = s + 1; u < 16; ++u) acc += Lm[s * 20 + u] * Tc[u];
              Tc[s] = acc; }
          u32x4 f5; f5.x = cvt_pk_bf16(hi ? Tc[4] : Tc[0], hi ? Tc[5] : Tc[1]); f5.y = cvt_pk_bf16(hi ? Tc[6] : Tc[2], hi ? Tc[7] : Tc[3]);
          f5.z = cvt_pk_bf16(hi ? Tc[12] : Tc[8], hi ? Tc[13] : Tc[9]); f5.w = cvt_pk_bf16(hi ? Tc[14] : Tc[10], hi ? Tc[15] : Tc[11]);
          if (n >= 16) f5 = (u32x4){0u, 0u, 0u, 0u};
          *(u32x4*)(dst + 5 * 1024 + lane * 16) = f5; }
#pragma unroll
        for (int f = 0; f < 4; ++f) { const u32x2 p0 = *(const LAS u32x2*)(R1 + n * 72 + 16 * f + 4 * hi), p1 = *(const LAS u32x2*)(R1 + n * 72 + 16 * f + 8 + 4 * hi);
            *(u32x4*)(dst + f * 1024 + lane * 16) = (u32x4){p0.x, p0.y, p1.x, p1.y}; }
#define RF_FRAG(x_, fa_, fb_) do { unsigned pk_[8]; _Pragma("unroll") for (int m_ = 0; m_ < 8; ++m_) pk_[m_] = cvt_pk_bf16(x_[2 * m_], x_[2 * m_ + 1]); \
            const bool h1_ = hi != 0; const u32x4 own_ = {h1_ ? pk_[2] : pk_[0], h1_ ? pk_[3] : pk_[1], h1_ ? pk_[6] : pk_[4], h1_ ? pk_[7] : pk_[5]}; \
            u32x4 rcv_ = {h1_ ? pk_[0] : pk_[2], h1_ ? pk_[1] : pk_[3], h1_ ? pk_[4] : pk_[6], h1_ ? pk_[5] : pk_[7]}; \
            rcv_.x = __shfl_xor(rcv_.x, 32); rcv_.y = __shfl_xor(rcv_.y, 32); rcv_.z = __shfl_xor(rcv_.z, 32); rcv_.w = __shfl_xor(rcv_.w, 32); \
            *(u32x4*)(dst + (fa_) * 1024 + lane * 16) = h1_ ? rcv_ : own_; *(u32x4*)(dst + (fb_) * 1024 + lane * 16) = h1_ ? own_ : rcv_; } while (0)
        RF_FRAG(xb, 7, 9); RF_FRAG(xk, 8, 10); RF_FRAG(xv, 11, 12);
#undef RF_FRAG
        { const int jj = lane & 31; ((float*)(dst + 13 * 1024))[((jj >> 2) & 1) * 32 + (lane >> 5) * 16 + (jj & 3) + 4 * (jj >> 3)] = gC; }
        asm volatile("s_waitcnt lgkmcnt(0)" ::: "memory");
    }
#undef RP_WIN
#undef RP_CONV
}
__device__ __forceinline__ void mixer_phase(const Frame& F0, unsigned char* ws0, int lq, bool need_ctx, char* lds_g) {
    const int l = lq & 3;
#ifndef MK_MIX
#define MK_MIX 15
#endif
    { const Frame F = opq(F0); unsigned char* ws = opq_ptr(ws0);
      if (MK_MIX & 1) for (int chain = F.bid; chain < 2 * NHA; chain += F.G) scan_chain_mfma(F, ws, chain); }
    const Frame& F = F0;
    const int n_xa = 32 * NHC, n_ca = need_ctx ? NHC : 0, n_att = n_xa + n_ca, n_hy = 640, n_ch = need_ctx ? 160 : 0;
    unsigned* qatt = (unsigned*)(ws0 + WS_CTL) + CW_QUEUE + 64 * lq; unsigned* qhy = qatt + 32;
    int item;
#define MIX_POP(q) do { if (F.tid == 0) F.MISC[16] = __hip_atomic_fetch_add((q), 1u, __ATOMIC_RELAXED, __HIP_MEMORY_SCOPE_AGENT); __syncthreads(); item = (int)F.MISC[16]; __syncthreads(); } while (0)
    if (F.bid >= 2 * NHA) {
        MIX_POP(qatt);
        while (item < n_att) {
            if (MK_MIX & 2) { unsigned char* ws = opq_ptr(ws0);
                const bf16_t* QF = (const bf16_t*)(ws + WS_QF); const bf16_t* KF = (const bf16_t*)(ws + WS_KF); const bf16_t* KVRAW = (const bf16_t*)(ws + WS_KVRAW); bf16_t* OB = (bf16_t*)(ws + WS_OBUF);
                const bool is_xa = item < n_xa; const int h = is_xa ? item % NHC : item - n_xa, row0 = is_xa ? NCTX + (item / NHC) * 256 : 0;
                for (int rp = 0; rp < REP(13); ++rp) att::attn_body(QF + (size_t)row0 * NQ + h * 192, KF + h * 192, KVRAW + h * 256 + 128, OB + (size_t)row0 * DM + 2560 + h * 128, is_xa ? T : NCTX, lds_g); }
            MIX_POP(qatt);
        }
    }
    MIX_POP(qhy);
    while (item < n_hy + n_ch) {
        const Frame Fu = opq(F0); unsigned char* ws = opq_ptr(ws0);
        if ((MK_MIX & 4) && item < n_hy) hyena_unit(Fu, ws, l, item);
        else if ((MK_MIX & 8) && item >= n_hy) hyena_ctx_unit(Fu, ws, l, item - n_hy);
        MIX_POP(qhy);
    }
#undef MIX_POP
}

__device__ __forceinline__ void hyena_taps_tail(const Frame& F0, unsigned char* ws0, int lt, int first, int end) {
    if (F0.bid < 48) return;
#pragma unroll 1
    for (int p = first + F0.bid - 48; p < end; p += 208) hyena_taps_unit(opq(F0), opq_ptr(ws0), lt, p);
}
constexpr int NPH = 2 + 14 * NL;
__global__ void __launch_bounds__(512, 2) mk_fwd(Args a) {
    extern __shared__ __attribute__((aligned(16))) unsigned char lds[];
    Frame F; F.lds = (LAS unsigned char*)lds; F.MISC = (volatile LAS unsigned*)(F.lds + LDS_MISC);
    F.tid = threadIdx.x; F.lane = F.tid & 63; F.wave = __builtin_amdgcn_readfirstlane(F.tid >> 6); F.bid = blockIdx.x; F.G = gridDim.x;
    if (F.tid < 64) F.MISC[F.tid] = 0u;
    if (F.tid < 46) *(LAS unsigned long long*)(F.lds + LDS_PTAB + 8 * F.tid) = (unsigned long long)(uintptr_t)a.in[F.tid];
    __syncthreads();
    unsigned char* ws = a.ws;
    const int lo = a.ph_lo, hi = a.ph_hi;
    XcdBarrier bar = xcd_barrier_post((unsigned*)(ws + WS_CTL) + CW_BAR, F.MISC + 8);
#ifndef MK_MASK
#define MK_MASK 0xffff
#endif
#define EN(x) (((MK_MASK) >> (x)) & 1)
#define IN(k) (lo <= (k) && (k) < hi)
#define SEAM(k) do { if (IN(k) && IN((k) + 1)) xcd_barrier(bar); } while (0)
#define WSP opq_ptr(ws)
#define P_XS(w) ((float*)((w) + WS_XS))
#define P_ABUF(w) ((bf16_t*)((w) + WS_ABUF))
#define P_HBUF(w) ((bf16_t*)((w) + WS_HBUF))
#define P_OBUF(w) ((bf16_t*)((w) + WS_OBUF))
#define P_MODX(w, l) ((const float*)((w) + WS_MOD) + ((size_t)(l) * 2 + 0) * NMOD)
#define P_MODC(w, l) ((const float*)((w) + WS_MOD) + ((size_t)(l) * 2 + 1) * NMOD)
#define P_WL(w, l) ((const bf16_t*)((w) + WS_WB) + (size_t)(l) * W_LAYER)
    if (EN(0) && IN(0)) for (int rp = 0; rp < REP(0); ++rp) phase0(opq(F), opq_ptr(ws));
    SEAM(0);
    if (EN(1) && IN(1)) phase_mod(opq(F), opq_ptr(ws));
    SEAM(1);
#pragma clang loop unroll(full)
    for (int l = 0; l < NL; ++l) {
        const int pb = 2 + 14 * l; const bool need_ctx = l < NL - 1;
        if (EN(2) && IN(pb + 0)) for (int rp = 0; rp < REP(2); ++rp) { unsigned char* w = WSP; norm_phase(opq(F), P_XS(w), IN_(7) + l * DM, P_MODX(w, l), P_MODC(w, l), 0, 1, P_ABUF(w), l > 0 ? (const bf16_t*)(w + WS_SLAB) : nullptr, l > 0 ? P_MODC(w, l - 1) + 8 * DM : nullptr, 0.5f, l == 0 ? IN_(0) - (size_t)NCTX * DM : (const float*)P_XS(w)); }
        SEAM(pb + 0);
        if (EN(3) && IN(pb + 1)) { unsigned char* w = WSP; pg8::Gemm g{P_ABUF(w), P_WL(w, l) + W_G1, T, 2 * FF, DM, DM}; pg8::StaticOrder S; S.init(T, 2 * FF, F.G, F.bid); pg8::EpiSwiGLU E{P_HBUF(w), FF};
            pg8::gemm_phase<pg8::EpiSwiGLU, pg8::StaticOrder>(F.lds, g, S, E, nullptr);
            hyena_taps_tail(F, ws, l, 0, l == 0 ? 640 : 416); }
        SEAM(pb + 1);
        if (EN(4) && IN(pb + 2)) {
            { unsigned char* w = WSP; pg8::Gemm g{P_HBUF(w), P_WL(w, l) + W_D1, T, DM, FF, FF}; pg8::StaticOrderX S; S.init(T, DM, F.G, F.bid); pg8::EpiResid E{P_XS(w), P_MODX(w, l) + 2 * DM, P_MODC(w, l) + 2 * DM, 0.5f, nullptr, l == 0 ? IN_(0) : nullptr};
              pg8::gemm_phase<pg8::EpiResid, pg8::StaticOrderX>(F.lds, g, S, E, nullptr); }
            if (true) { __syncthreads();
              if (F.bid < 256) { unsigned char* w = WSP; const int ks = F.bid >> 4, ksz = FF / 16; pg8::Gemm g{P_HBUF(w) + ks * ksz, P_WL(w, l) + W_D1 + ks * ksz, NCTX, DM, ksz, FF}; pg8::OneUnit S{F.bid & 15};
                  pg8::EpiBf16<0> E{(bf16_t*)(w + WS_SLAB) + (size_t)ks * NCTX * DM, DM, nullptr, 0, 0};
                  pg8::gemm_phase<pg8::EpiBf16<0>, pg8::OneUnit>(F.lds, g, S, E, nullptr); } }
        }
        SEAM(pb + 2);
        if (EN(5) && IN(pb + 3)) for (int rp = 0; rp < REP(2); ++rp) { unsigned char* w = WSP; norm_phase(opq(F), P_XS(w), IN_(8) + l * DM, P_MODX(w, l), P_MODC(w, l), 3, 4, P_ABUF(w), (const bf16_t*)(w + WS_SLAB), P_MODC(w, l) + 2 * DM, 0.5f, P_XS(w)); }
        SEAM(pb + 3);
        if (EN(6) && IN(pb + 4)) { unsigned char* w = WSP; pg8::Gemm g{P_ABUF(w), P_WL(w, l) + W_IN, T, PXW, DM, DM}; pg8::StaticOrder S; S.init(T, PXW, F.G, F.bid); pg8::EpiBf16<0> E{(bf16_t*)(w + WS_PX), PXW, nullptr, 0, 0};
            pg8::gemm_phase<pg8::EpiBf16<0>, pg8::StaticOrder>(F.lds, g, S, E, nullptr); }
        SEAM(pb + 4);
        if (EN(7) && IN(pb + 5)) { for (int rp = 0; rp < REP(7); ++rp) rwkv_fused_phase(opq(F), opq_ptr(ws), l); if (!(MK_ONLYRP)) { for (int rp = 0; rp < REP(8); ++rp) mla_prep_phase(opq(F), opq_ptr(ws), l); hyena_prep_phase(opq(F), opq_ptr(ws), l); } }
        SEAM(pb + 5);
        if (EN(8) && IN(pb + 6)) {
            { unsigned char* w = WSP; pg8::Gemm g{(const bf16_t*)(w + WS_QA), P_WL(w, l) + W_Q, T, NQ, 1024, 1024}; pg8::StaticOrder S; S.init(T, NQ, F.G, F.bid); pg8::EpiBf16<0> E{(bf16_t*)(w + WS_QRAW), NQ, nullptr, 0, 0};
              pg8::gemm_phase<pg8::EpiBf16<0>, pg8::StaticOrder>(F.lds, g, S, E, nullptr); }
            __syncthreads();
            { unsigned char* w = WSP; pg8::Gemm g{(const bf16_t*)(w + WS_KVA), P_WL(w, l) + W_KV, T, NKV, 512, 512}; pg8::StaticOrder S; S.init(T, NKV, F.G, (F.bid + 208) & 255);     pg8::EpiBf16<0> E{(bf16_t*)(w + WS_KVRAW), NKV, nullptr, 0, 0};
              pg8::gemm_phase<pg8::EpiBf16<0>, pg8::StaticOrder>(F.lds, g, S, E, nullptr); }
        }
        SEAM(pb + 6);
        if (EN(9) && IN(pb + 7)) { for (int rp = 0; rp < REP(8); ++rp) qkv_final_phase(opq(F), opq_ptr(ws), l, need_ctx); }
        SEAM(pb + 7);
        if (EN(10) && IN(pb + 8)) for (int rp = 0; rp < REP(10); ++rp) mixer_phase(F, ws, l + 4 * rp, need_ctx, (char*)lds);
        SEAM(pb + 8);
        if (EN(11) && IN(pb + 9)) { for (int rp = 0; rp < REP(8); ++rp) rwkv_out_phase(opq(F), opq_ptr(ws), l, need_ctx); hyena_out_phase(opq(F), opq_ptr(ws), need_ctx); }
        SEAM(pb + 9);
        if (EN(12) && IN(pb + 10)) {
            { unsigned char* w = WSP; pg8::Gemm g{P_OBUF(w), P_WL(w, l) + W_OUT, T, DM, DM, DM}; pg8::StaticOrderX S; S.init(T, DM, F.G, F.bid); pg8::EpiResid E{P_XS(w), P_MODX(w, l) + 5 * DM, P_MODC(w, l) + 5 * DM, 1.0f, nullptr, nullptr};
              pg8::gemm_phase<pg8::EpiResid, pg8::StaticOrderX>(F.lds, g, S, E, nullptr); }
            if (need_ctx) { __syncthreads();
              if (F.bid < 256) { unsigned char* w = WSP; const int ks = F.bid >> 4, ksz = DM / 16; pg8::Gemm g{P_OBUF(w) + ks * ksz, P_WL(w, l) + W_OUT + ks * ksz, NCTX, DM, ksz, DM}; pg8::OneUnit S{F.bid & 15};
                  pg8::EpiBf16<0> E{(bf16_t*)(w + WS_SLAB) + (size_t)ks * NCTX * DM, DM, nullptr, 0, 0};
                  pg8::gemm_phase<pg8::EpiBf16<0>, pg8::OneUnit>(F.lds, g, S, E, nullptr); } }
        }
        SEAM(pb + 10);
        if (EN(13) && IN(pb + 11)) for (int rp = 0; rp < REP(2); ++rp) { unsigned char* w = WSP; norm_phase(opq(F), P_XS(w), IN_(9) + l * DM, P_MODX(w, l), P_MODC(w, l), 6, 7, P_ABUF(w), need_ctx ? (const bf16_t*)(w + WS_SLAB) : nullptr, P_MODC(w, l) + 5 * DM, 1.0f, P_XS(w)); }
        SEAM(pb + 11);
        if (EN(14) && IN(pb + 12)) { if (need_ctx) { unsigned char* w = WSP; pg8::Gemm g{P_ABUF(w), P_WL(w, l) + W_G2, T, 2 * FF, DM, DM}; pg8::StaticOrder S; S.init(T, 2 * FF, F.G, F.bid); pg8::EpiSwiGLU E{P_HBUF(w), FF};
            pg8::gemm_phase<pg8::EpiSwiGLU, pg8::StaticOrder>(F.lds, g, S, E, nullptr);
            hyena_taps_tail(F, ws, l + 1, 416, 640); }       else { unsigned char* w = WSP; pg8::Gemm g{P_ABUF(w), P_WL(w, l) + W_G2, T, 2 * FF, DM, DM}; pg8::StaticOrderX S; S.init(T, 2 * FF, F.G, F.bid); pg8::EpiSwiGLU E{P_HBUF(w), FF};
            pg8::gemm_phase<pg8::EpiSwiGLU, pg8::StaticOrderX>(F.lds, g, S, E, nullptr); } }
        SEAM(pb + 12);
        if (EN(15) && IN(pb + 13)) {
            { unsigned char* w = WSP; pg8::Gemm g{P_HBUF(w), P_WL(w, l) + W_D2, T, DM, FF, FF}; pg8::StaticOrderX S; S.init(T, DM, F.G, F.bid); pg8::EpiResid E{P_XS(w), P_MODX(w, l) + 8 * DM, P_MODC(w, l) + 8 * DM, 0.5f, l == NL - 1 ? a.out : nullptr, nullptr};
              pg8::gemm_phase<pg8::EpiResid, pg8::StaticOrderX>(F.lds, g, S, E, nullptr); }
            if (need_ctx) { __syncthreads();
              if (F.bid < 256) { unsigned char* w = WSP; const int ks = F.bid >> 4, ksz = FF / 16; pg8::Gemm g{P_HBUF(w) + ks * ksz, P_WL(w, l) + W_D2 + ks * ksz, NCTX, DM, ksz, FF}; pg8::OneUnit S{F.bid & 15};
                  pg8::EpiBf16<0> E{(bf16_t*)(w + WS_SLAB) + (size_t)ks * NCTX * DM, DM, nullptr, 0, 0};
                  pg8::gemm_phase<pg8::EpiBf16<0>, pg8::OneUnit>(F.lds, g, S, E, nullptr); } }
        }
        SEAM(pb + 13);
    }
#undef IN
#undef SEAM
}

#ifndef MK_LAUNCHES
#define MK_LAUNCHES 1
#endif
extern "C" void kernel_launch(void* const* d_in, const int* in_sizes, int n_in, void* d_out, int out_size, void* d_ws, size_t ws_size, hipStream_t stream) {
    static int grid = 0;
    if (grid == 0) {
        if (n_in != 46 || in_sizes[0] != SEQ * DM || out_size != SEQ * DM || ws_size < WS_END) {
            fprintf(stderr, "kernel_launch: shape mismatch: n_in %d in0 %d out %d ws %zu (need %zu); nothing launched\n", n_in, n_in > 0 ? in_sizes[0] : -1, out_size, ws_size, (size_t)WS_END); grid = -1; return; }
        int dev = 0, cus = 0, per_cu = 0;
        if (hipGetDevice(&dev) != hipSuccess || hipDeviceGetAttribute(&cus, hipDeviceAttributeMultiprocessorCount, dev) != hipSuccess) { fprintf(stderr, "kernel_launch: device query failed\n"); grid = -1; return; }
        if (hipFuncSetAttribute((const void*)mk_fwd, hipFuncAttributeMaxDynamicSharedMemorySize, LDS_BYTES) != hipSuccess) { fprintf(stderr, "kernel_launch: hipFuncSetAttribute failed\n"); grid = -1; return; }
        if (hipOccupancyMaxActiveBlocksPerMultiprocessor(&per_cu, (const void*)mk_fwd, 512, LDS_BYTES) != hipSuccess || per_cu < 1) fprintf(stderr, "kernel_launch: note: occupancy query reports %d blocks per CU\n", per_cu);
        (void)hipGetLastError();
        grid = cus;
        if (cus != 256) { fprintf(stderr, "kernel_launch: built for 256 CUs (split-K of the context panel, hyena scratch), found %d; nothing launched\n", cus); grid = -1; return; }
    }
    if (grid < 0) return;
    if (hipMemsetAsync((char*)d_ws + WS_CTL, 0, CTL_BYTES, stream) != hipSuccess) { fprintf(stderr, "kernel_launch: memset failed\n"); return; }
    Args a{};
    for (int i = 0; i < 46; ++i) a.in[i] = (const float*)d_in[i];
    a.out = (float*)d_out; a.ws = (unsigned char*)d_ws;
    a.ph_lo = 0; a.ph_hi = NPH;
    hipLaunchKernelGGL(mk_fwd, dim3(grid), dim3(512), LDS_BYTES, stream, a);
    const hipError_t le = hipPeekAtLastError();
    if (le != hipSuccess) fprintf(stderr, "kernel_launch: launch failed: %s\n", hipGetErrorName(le));
}
```

```cpp
#include <hip/hip_runtime.h>
#include <stdint.h>
#include <cstdio>

#define LAS __attribute__((address_space(3)))
#define CAS __attribute__((address_space(4)))
typedef unsigned short bf16_t;
typedef float f32x4 __attribute__((ext_vector_type(4)));
typedef float f32x2 __attribute__((ext_vector_type(2)));
typedef unsigned u32x4 __attribute__((ext_vector_type(4)));
typedef unsigned u32x2 __attribute__((ext_vector_type(2)));

constexpr int T = 8448, NCTX = 256, SEQ = 8192, DM = 4096, FF = 6144, NL = 4;
constexpr int A_W = 1280, A_IN = 4160, B_IN = 3840, C_IN = 1600, NHA = 20;
constexpr int PXW = 9728, PXA = 0, PXB = 4160, PXC = 8000;
constexpr int NQ = 2304, NKV = 3072, NHC = 12;
constexpr int NMOD = 9 * DM;
constexpr float NORM_EPS = 1e-6f, GN_EPS = 64e-5f;

constexpr size_t MiB = 1u << 20;
constexpr size_t al(size_t x) { return (x + MiB - 1) / MiB * MiB; }
constexpr size_t WS_CTL = 0, CTL_BYTES = MiB;
constexpr size_t WS_XS = WS_CTL + CTL_BYTES;
constexpr size_t WS_ABUF = WS_XS + al((size_t)T * DM * 4);
constexpr size_t WS_HBUF = WS_ABUF + al((size_t)T * DM * 2);
constexpr size_t WS_OBUF = WS_HBUF + al((size_t)T * FF * 2);
constexpr size_t WS_PX = WS_OBUF + al((size_t)T * DM * 2);
constexpr size_t WS_MOD = WS_PX + al((size_t)T * PXW * 4);
constexpr size_t WS_HP = WS_MOD + al((size_t)NL * 2 * NMOD * 4);
constexpr size_t WS_SS = WS_HP + MiB;
constexpr size_t WS_SD = WS_SS + al((size_t)NHA * T * 192 * 4);
constexpr size_t WS_WLR = WS_SD + al((size_t)NHA * 2 * T * 192 * 4);
constexpr size_t WS_G = WS_WLR + al((size_t)NL * A_W * 448 * 2);
constexpr size_t WS_Y = WS_G + al((size_t)T * A_W * 4);
constexpr size_t WS_QA = WS_Y + al((size_t)2 * T * A_W * 4);
constexpr size_t WS_KVA = WS_QA + al((size_t)T * 1024 * 2);
constexpr size_t WS_KPE = WS_KVA + al((size_t)T * 512 * 2);
constexpr size_t WS_QRAW = WS_KPE + al((size_t)T * 64 * 2);
constexpr size_t WS_KVRAW = WS_QRAW + al((size_t)T * NQ * 2);
constexpr size_t WS_QF = WS_KVRAW + al((size_t)T * NKV * 2);
constexpr size_t WS_KF = WS_QF + al((size_t)T * NQ * 2);
constexpr size_t WS_H3 = WS_KF + al((size_t)T * NQ * 2);
constexpr size_t WS_HSCR = WS_H3 + al((size_t)NL * T * 64 * 4);
constexpr int HT_STRIDE = 17 * 512;
constexpr size_t WS_HTN = WS_HSCR + (size_t)640 * HT_STRIDE * 16;
constexpr size_t WS_FR = WS_HSCR + al((size_t)640 * HT_STRIDE * 16 + 640 * 8);
constexpr size_t WS_GT = WS_FR + al((size_t)40 * 528 * (14 * 1024));
constexpr size_t WS_X0T = WS_GT + al((size_t)1280 * T * 4);
constexpr size_t WS_SLAB = WS_FR;
constexpr size_t WS_WB = WS_X0T + al((size_t)1280 * T * 4);
constexpr size_t W_G1 = 0, W_D1 = W_G1 + (size_t)2 * FF * DM, W_IN = W_D1 + (size_t)DM * FF, W_OUT = W_IN + (size_t)PXW * DM, W_G2 = W_OUT + (size_t)DM * DM,
                 W_D2 = W_G2 + (size_t)2 * FF * DM, W_Q = W_D2 + (size_t)DM * FF, W_KV = W_Q + (size_t)NQ * 1024, W_LAYER = W_KV + (size_t)NKV * 512;
constexpr size_t WS_END = WS_WB + al(W_LAYER * NL * 2);
constexpr int CW_BAR = 4096;
constexpr int CW_QUEUE = 8192;

constexpr int LDS_MISC = 143360, LDS_BYTES = 147456;

__device__ __forceinline__ float wave_sum(float v) {
#pragma unroll
    for (int o = 1; o < 64; o <<= 1) v += __shfl_xor(v, o);
    return v;
}
__device__ __forceinline__ float wave_sum16(const float (&x)[16], int lane) {
    const bool b5 = (lane & 32) != 0, b4 = (lane & 16) != 0, b3 = (lane & 8) != 0, b2 = (lane & 4) != 0;
    float k8[8], k4[4], k2[2];
#pragma unroll
    for (int i = 0; i < 8; ++i) k8[i] = (b5 ? x[8 + i] : x[i]) + __shfl_xor(b5 ? x[i] : x[8 + i], 32);
#pragma unroll
    for (int i = 0; i < 4; ++i) k4[i] = (b4 ? k8[4 + i] : k8[i]) + __shfl_xor(b4 ? k8[i] : k8[4 + i], 16);
#pragma unroll
    for (int i = 0; i < 2; ++i) k2[i] = (b3 ? k4[2 + i] : k4[i]) + __shfl_xor(b3 ? k4[i] : k4[2 + i], 8);
    float k1 = (b2 ? k2[1] : k2[0]) + __shfl_xor(b2 ? k2[0] : k2[1], 4);
    k1 += __shfl_xor(k1, 1); k1 += __shfl_xor(k1, 2);
    return k1;
}
typedef __bf16 bf16x2_t __attribute__((ext_vector_type(2)));
__device__ __forceinline__ unsigned cvt_pk_bf16(float lo, float hi) { const f32x2 v = {lo, hi}; return __builtin_bit_cast(unsigned, __builtin_convertvector(v, bf16x2_t)); }
__device__ __forceinline__ float bf2f(unsigned short b) { return __uint_as_float(((unsigned)b) << 16); }
__device__ __forceinline__ f32x4 bf4f(u32x2 w) { return (f32x4){__uint_as_float(w.x << 16), __uint_as_float(w.x & 0xffff0000u), __uint_as_float(w.y << 16), __uint_as_float(w.y & 0xffff0000u)}; }
__device__ __forceinline__ float sigmoidf_(float x) { return 1.0f / (1.0f + __expf(-x)); }
__device__ __forceinline__ float siluf_(float x) { return x / (1.0f + __expf(-x)); }
__device__ __forceinline__ bool has_left(int tau) { return tau != 0 && tau != NCTX; }
__device__ __forceinline__ bool has_right(int tau) { return tau != NCTX - 1 && tau != T - 1; }

struct Args { const float* in[46]; float* out; unsigned char* ws; int ph_lo, ph_hi; };
struct Frame { LAS unsigned char* lds; volatile LAS unsigned* MISC; int tid, lane, wave, bid, G; };
constexpr int LDS_PTAB = LDS_MISC + 2048;
__device__ __forceinline__ const float* inp(const Frame& F, int i) {
    const volatile LAS unsigned* p = (const volatile LAS unsigned*)(F.lds + LDS_PTAB) + 2 * i;
    const unsigned lo = __builtin_amdgcn_readfirstlane(p[0]), hi = __builtin_amdgcn_readfirstlane(p[1]);
    return (const float*)(((unsigned long long)hi << 32) | lo);
}
#define IN_(i) inp(F, (i))
__device__ __forceinline__ Frame opq(const Frame& F) { Frame G = F; asm volatile("" : "+v"(G.tid), "+s"(G.wave), "+s"(G.bid)); G.lane = G.tid & 63; return G; }
__device__ __forceinline__ unsigned char* opq_ptr(unsigned char* p) { asm volatile("" : "+s"(p)); return p; }
#ifndef MK_REP
#define MK_REP 0
#endif
#ifndef MK_ONLYRP
#define MK_ONLYRP 0
#endif
#define REP(x) (1 + (((MK_REP) >> (x)) & 1))
#define XB_TMO      128
#define XB_XCNT(j)  (256  + 64 * (j))
#define XB_XSUB(j)  (1280 + 64 * (j))
#define XB_XGEN(j)  (2304 + 64 * (j))
#define XB_TOP      3328
#define XB_TOPGEN   3392
#define XCD_BAR_WORDS 3456
#define XB_SPIN_CAP (1u << 18)

__device__ __forceinline__ unsigned xb_ld(unsigned* p)              { return __hip_atomic_load(p, __ATOMIC_RELAXED, __HIP_MEMORY_SCOPE_AGENT); }
__device__ __forceinline__ unsigned xb_add(unsigned* p, unsigned v) { return __hip_atomic_fetch_add(p, v, __ATOMIC_RELAXED, __HIP_MEMORY_SCOPE_AGENT); }
__device__ __forceinline__ unsigned xb_xcc_id() { return (unsigned)__builtin_amdgcn_s_getreg((3 << 11) | 20) & 0xFu; }
#define XB_SPIN(cond, bar) do { unsigned _sp = 0; while (cond) { __builtin_amdgcn_s_sleep(1); \
    if ((++_sp & 255u) == 0u) { if (xb_ld(&(bar)[XB_TMO])) break; if (_sp > XB_SPIN_CAP) { atomicAdd(&(bar)[XB_TMO], 1u); break; } } } } while (0)

struct XcdBarrier {
    unsigned* bar; unsigned x;
    volatile LAS unsigned* st;
};

__device__ __forceinline__ XcdBarrier xcd_barrier_post(unsigned* bar, volatile LAS unsigned* st) {
    XcdBarrier b; b.bar = bar; b.x = xb_xcc_id(); b.st = st;
    if (threadIdx.x == 0) (void)xb_add(&bar[XB_XCNT(b.x)], 1u);
    return b;
}
__device__ __forceinline__ void xcd_barrier_complete(unsigned* bar, unsigned x, unsigned& nloc, unsigned& nx) {
    const unsigned G = gridDim.x * gridDim.y * gridDim.z;
    unsigned sum, cnt, mine, sp = 0u;
    for (;;) {
        sum = 0u; cnt = 0u; mine = 0u;
#pragma unroll
        for (unsigned j = 0; j < 16; ++j) { const unsigned c = xb_ld(&bar[XB_XCNT(j)]); sum += c; cnt += (c > 0u) ? 1u : 0u; mine = (j == x) ? c : mine; }
        if (sum == G) break;
        __builtin_amdgcn_s_sleep(1);
        if ((++sp & 255u) == 0u) { if (xb_ld(&bar[XB_TMO])) break; if (sp > XB_SPIN_CAP) { atomicAdd(&bar[XB_TMO], 1u); break; } }
    }
    nloc = mine > 0u ? mine : 1u; nx = cnt > 0u ? cnt : 1u;
}

__device__ __forceinline__ void xcd_barrier(const XcdBarrier& b) {
    asm volatile("s_waitcnt vmcnt(0)" ::: "memory");
    __syncthreads();
    if (threadIdx.x == 0) {
        unsigned* bar = b.bar;
        __builtin_amdgcn_s_waitcnt(0);
        unsigned nloc = b.st[0], nx = b.st[1];
        if (nloc == 0u) { xcd_barrier_complete(bar, b.x, nloc, nx); b.st[0] = nloc; b.st[1] = nx; }
        const unsigned old = xb_add(&bar[XB_XSUB(b.x)], 1u);
        const unsigned gen = old / nloc;
        if (old + 1u == (gen + 1u) * nloc) {
            __builtin_amdgcn_fence(__ATOMIC_RELEASE, "agent");
            asm volatile("s_waitcnt vmcnt(0)" ::: "memory");
            const unsigned og = xb_add(&bar[XB_TOP], 1u);
            const unsigned tg = og / nx;
            if (og + 1u == (tg + 1u) * nx) xb_add(&bar[XB_TOPGEN], 1u);
            else XB_SPIN(xb_ld(&bar[XB_TOPGEN]) == tg, bar);
            __builtin_amdgcn_fence(__ATOMIC_ACQUIRE, "agent");
            xb_add(&bar[XB_XGEN(b.x)], 1u);
            asm volatile("s_waitcnt vmcnt(0)" ::: "memory");
        } else {
            XB_SPIN(xb_ld(&bar[XB_XGEN(b.x)]) == gen, bar);
            __builtin_amdgcn_fence(__ATOMIC_ACQUIRE, "agent");
            asm volatile("s_waitcnt vmcnt(0)" ::: "memory");
        }
    }
    __syncthreads();
}
namespace pg8 {
#define PG8_LAS __attribute__((address_space(3)))
typedef unsigned short bf16_t;
typedef short bf16x8 __attribute__((ext_vector_type(8)));
typedef float f32x4 __attribute__((ext_vector_type(4)));
typedef unsigned u32x4 __attribute__((ext_vector_type(4)));
constexpr int BM = 256, BK = 64, HALF = 128, HTB = HALF * BK * 2  , STAGE_BYTES = 8 * HTB, NXCD = 8, WGM = 4;

__host__ __device__ __forceinline__ int lds_byte(int r, int c) { const int st = (r >> 4) * 2 + (c >> 5), rr = r & 15, cc = c & 31, ob = rr * 64 + cc * 2; return st * 1024 + (ob ^ (((ob >> 9) & 1) << 5)); }
__host__ __device__ __forceinline__ void stage_rc(int b, int& R, int& C) { const int st = b / 1024, sb = b % 1024, swz = sb ^ (((sb >> 9) & 1) << 5); R = (st >> 1) * 16 + swz / 64; C = (st & 1) * 32 + (swz % 64) / 2; }
__host__ __device__ __forceinline__ int perm32(int rho) { const int n = rho >> 4, i = rho & 15; return 8 * (i >> 2) + 4 * n + (i & 3); }

struct Unit { int pm, pn; };
struct Gemm { const bf16_t* A; const bf16_t* Bt; int M, N, K, ld; };

struct StaticOrder {
    int nM, nN, nwg, G, c;
    __host__ __device__ void init(int M, int N, int G_, int c_) { nM = M / BM; nN = N / BM; nwg = nM * nN; G = G_; c = c_; }
    __host__ __device__ bool next(int i, Unit& u) const {
        const long L = (long)i * G + c; if (L >= nwg) return false;
        int wgid = (int)L; { const int q = nwg / NXCD, r = nwg % NXCD, xcd = wgid % NXCD, off = wgid / NXCD; wgid = (xcd < r ? xcd * (q + 1) : r * (q + 1) + (xcd - r) * q) + off; }
        const int nig = WGM * nN, gid = wgid / nig, fm = gid * WGM, gsz = (nM - fm) < WGM ? (nM - fm) : WGM;
        u.pm = fm + ((wgid % nig) % gsz); u.pn = (wgid % nig) / gsz; return true;
    }
    __device__ __forceinline__ void a_ready(const Unit&) const {}
    __device__ __forceinline__ void done(const Unit&) const {}
};
struct CountedOrder : StaticOrder {
    const unsigned* ready; unsigned need; unsigned* tmo;
    __device__ __forceinline__ void a_ready(const Unit& u) const {
        if (threadIdx.x < 64) {
            const unsigned long long t0 = __builtin_amdgcn_s_memrealtime(); unsigned polls = 0;
            while ((unsigned)__builtin_amdgcn_readfirstlane(__hip_atomic_load(ready + 64 * u.pm, __ATOMIC_RELAXED, __HIP_MEMORY_SCOPE_AGENT)) < need) {
                if ((++polls & 255u) == 0u && __builtin_amdgcn_readfirstlane(__hip_atomic_load(tmo, __ATOMIC_RELAXED, __HIP_MEMORY_SCOPE_AGENT)) != 0u) break;
                if (__builtin_amdgcn_s_memrealtime() - t0 > 2000000ull) {
                    if (threadIdx.x == 0) { unsigned expect = 0u; __hip_atomic_compare_exchange_strong(tmo + 1, &expect, 0x600u | (unsigned)(u.pm & 0xff), __ATOMIC_RELAXED, __ATOMIC_RELAXED, __HIP_MEMORY_SCOPE_AGENT); __hip_atomic_store(tmo, 1u, __ATOMIC_RELAXED, __HIP_MEMORY_SCOPE_AGENT); }
                    break; }
                __builtin_amdgcn_s_sleep(2); }
            __builtin_amdgcn_fence(__ATOMIC_ACQUIRE, "agent");
            asm volatile("s_waitcnt vmcnt(0)" ::: "memory");
        }
#if !defined(BROKEN_HOOK_NO_BARRIER)
        asm volatile("" ::: "memory"); __builtin_amdgcn_s_barrier(); asm volatile("" ::: "memory");
#endif
    }
};

__device__ __forceinline__ unsigned cvt_pk_bf16(float lo, float hi) { unsigned r; asm volatile("v_cvt_pk_bf16_f32 %0, %1, %2" : "=v"(r) : "v"(lo), "v"(hi)); return r; }
typedef float f32x2 __attribute__((ext_vector_type(2)));
__device__ __forceinline__ f32x2 gelu_pk(f32x2 v) {
    const f32x2 av = __builtin_elementwise_abs(v), d = av * 0.2316418882f + 1.0f;
    f32x2 t; t.x = __builtin_amdgcn_rcpf(d.x); t.y = __builtin_amdgcn_rcpf(d.y);
    f32x2 q = t * 0.5307027145f + (-0.7265760135f); q = q * t + 0.7107068705f; q = q * t + (-0.142248368f); q = q * t + 0.127414796f; q = q * t;
    const f32x2 s = (v * v) * (-0.72134752044f);
    f32x2 e; e.x = __builtin_amdgcn_exp2f(s.x); e.y = __builtin_amdgcn_exp2f(s.y);
    const f32x2 m = v * (q * e), r = v - m;
    f32x2 o; o.x = v.x < 0.f ? m.x : r.x; o.y = v.y < 0.f ? m.y : r.y; return o;
}

struct EpiF32 {
    static constexpr bool PERM = false, AFTER_DRAIN = false;
    float* C; int ldc; const float* bias;
    __device__ __forceinline__ void operator()(const f32x4 (&acc)[2][2][4][2], const Unit& u, int wr, int wc, int fr, int fq) const {
        const int row0 = u.pm * BM + wr * 64 + fr, col0 = u.pn * BM + wc * 32 + 4 * fq;
        f32x4 bv[2][2];
#pragma unroll
        for (int bj = 0; bj < 2; ++bj)
#pragma unroll
            for (int n = 0; n < 2; ++n) bv[bj][n] = bias ? *(const f32x4*)(bias + col0 + bj * HALF + n * 16) : (f32x4){0.f, 0.f, 0.f, 0.f};
#pragma unroll
        for (int ai = 0; ai < 2; ++ai)
#pragma unroll
            for (int m = 0; m < 4; ++m) { float* rowp = C + (size_t)(row0 + ai * HALF + m * 16) * ldc + col0;
#pragma unroll
                for (int bj = 0; bj < 2; ++bj)
#pragma unroll
                    for (int n = 0; n < 2; ++n) *(f32x4*)(rowp + bj * HALF + n * 16) = acc[ai][bj][m][n] + bv[bj][n]; }
    }
};
template <int ACT  > struct EpiBf16 {
    static constexpr bool PERM = true, AFTER_DRAIN = false;
    bf16_t* O; int ldc; const float* bias; int split_cols; size_t split_stride;
    __device__ __forceinline__ void operator()(const f32x4 (&acc)[2][2][4][2], const Unit& u, int wr, int wc, int fr, int fq) const {
        const int row0 = u.pm * BM + wr * 64 + fr; int colt = u.pn * BM; bf16_t* base = O;
        if (split_cols) { const int t = colt / split_cols; base += (size_t)t * split_stride; colt -= t * split_cols; }
        const int col0 = colt + wc * 32 + 8 * fq, bcol0 = u.pn * BM + wc * 32 + 8 * fq;
        f32x4 bv[2][2];
#pragma unroll
        for (int bj = 0; bj < 2; ++bj)
#pragma unroll
            for (int n = 0; n < 2; ++n) bv[bj][n] = bias ? *(const f32x4*)(bias + bcol0 + bj * HALF + 4 * n) : (f32x4){0.f, 0.f, 0.f, 0.f};
#pragma unroll
        for (int ai = 0; ai < 2; ++ai)
#pragma unroll
            for (int m = 0; m < 4; ++m) { bf16_t* rowp = base + (size_t)(row0 + ai * HALF + m * 16) * ldc + col0;
#pragma unroll
                for (int bj = 0; bj < 2; ++bj) { f32x4 v0 = acc[ai][bj][m][0] + bv[bj][0], v1 = acc[ai][bj][m][1] + bv[bj][1];
                    if (ACT == 1) { f32x2 a = gelu_pk((f32x2){v0[0], v0[1]}), b = gelu_pk((f32x2){v0[2], v0[3]}), c = gelu_pk((f32x2){v1[0], v1[1]}), d = gelu_pk((f32x2){v1[2], v1[3]});
                        v0 = (f32x4){a.x, a.y, b.x, b.y}; v1 = (f32x4){c.x, c.y, d.x, d.y}; }
                    if (ACT == 2) {
#pragma unroll
                        for (int j = 0; j < 4; ++j) { v0[j] = 0.5f * v0[j] * (1.0f + erff(v0[j] * 0.70710678f)); v1[j] = 0.5f * v1[j] * (1.0f + erff(v1[j] * 0.70710678f)); } }
                    u32x4 w; w.x = cvt_pk_bf16(v0[0], v0[1]); w.y = cvt_pk_bf16(v0[2], v0[3]); w.z = cvt_pk_bf16(v1[0], v1[1]); w.w = cvt_pk_bf16(v1[2], v1[3]);
                    *(u32x4*)(rowp + bj * HALF) = w; } }
    }
};
}
namespace pg8 {
struct EpiSwiGLU {
    static constexpr bool PERM = true, AFTER_DRAIN = false;
    bf16_t* O; int ldc;
    __device__ __forceinline__ void operator()(const f32x4 (&acc)[2][2][4][2], const Unit& u, int wr, int wc, int fr, int fq) const {
        const int row0 = u.pm * BM + wr * 64 + fr, col0 = u.pn * HALF + wc * 32 + 8 * fq;
#pragma unroll
        for (int ai = 0; ai < 2; ++ai)
#pragma unroll
            for (int m = 0; m < 4; ++m) { bf16_t* rowp = O + (size_t)(row0 + ai * HALF + m * 16) * ldc + col0;
                float h[8];
#pragma unroll
                for (int n = 0; n < 2; ++n)
#pragma unroll
                    for (int j = 0; j < 4; ++j) { const float g = acc[ai][0][m][n][j], up = acc[ai][1][m][n][j]; h[n * 4 + j] = g * __builtin_amdgcn_rcpf(1.0f + __builtin_amdgcn_exp2f(-1.4426950408889634f * g)) * up; }
                u32x4 w; w.x = cvt_pk_bf16(h[0], h[1]); w.y = cvt_pk_bf16(h[2], h[3]); w.z = cvt_pk_bf16(h[4], h[5]); w.w = cvt_pk_bf16(h[6], h[7]);
                *(u32x4*)rowp = w; }
    }
};
struct EpiResid {
    static constexpr bool PERM = false, AFTER_DRAIN = false;
    float* X; const float* gate_x; const float* gate_c; float fac; float* out_x; const float* src_x;
    __device__ __forceinline__ void operator()(const f32x4 (&acc)[2][2][4][2], const Unit& u, int wr, int wc, int fr, int fq) const {
        const int row0 = u.pm * BM + wr * 64 + fr, col0 = u.pn * BM + wc * 32 + 4 * fq;
        const float* gv = (u.pm == 0) ? gate_c : gate_x;
        float* dst = (u.pm != 0 && out_x) ? out_x - (size_t)256 * 4096 : X; const float* src = (u.pm != 0 && src_x) ? src_x - (size_t)256 * 4096 : X;
        f32x4 gg[2][2];
#pragma unroll
        for (int bj = 0; bj < 2; ++bj)
#pragma unroll
            for (int n = 0; n < 2; ++n) gg[bj][n] = *(const f32x4*)(gv + col0 + bj * HALF + n * 16) * fac;
#pragma unroll
        for (int ai = 0; ai < 2; ++ai)
#pragma unroll
            for (int m = 0; m < 4; ++m) { const size_t off = (size_t)(row0 + ai * HALF + m * 16) * 4096 + col0;
#pragma unroll
                for (int bj = 0; bj < 2; ++bj)
#pragma unroll
                    for (int n = 0; n < 2; ++n) { const f32x4 b = *(const f32x4*)(src + off + bj * HALF + n * 16); *(f32x4*)(dst + off + bj * HALF + n * 16) = b + gg[bj][n] * acc[ai][bj][m][n]; } }
    }
};
struct OneUnit { int pn;
    __host__ __device__ bool next(int i, Unit& u) const { u.pm = 0; u.pn = pn; return i == 0; }
    __device__ __forceinline__ void a_ready(const Unit&) const {}
    __device__ __forceinline__ void done(const Unit&) const {}
};
struct StaticOrderX { StaticOrder b;
    __host__ __device__ void init(int M, int N, int G_, int c_) { b.init(M - BM, N, G_, c_); }
    __host__ __device__ bool next(int i, Unit& u) const { const bool ok = b.next(i, u); u.pm += 1; return ok; }
    __device__ __forceinline__ void a_ready(const Unit&) const {}
    __device__ __forceinline__ void done(const Unit&) const {}
};
}
namespace pg8 {
template <class Epi, class Sched, bool STAMP = false>
__device__ __forceinline__ void gemm_phase(PG8_LAS unsigned char* lds, const Gemm g, const Sched& S, const Epi& E, unsigned long long* stamps) {
    int tid_ = threadIdx.x; asm volatile("" : "+v"(tid_));
    const int tid = tid_, wid = __builtin_amdgcn_readfirstlane(tid >> 6), lane = tid & 63, wr = wid >> 2, wc = wid & 3, fr = lane & 15, fq = lane >> 4;
    const int K = g.ld, nt = g.K / BK;
    int ts_lo = 0, ts_hi = 0, nts = 0; const unsigned long long rt_entry = STAMP ? (unsigned long long)wall_clock64() : 0ull;
#define PG8_STAMP() do { if (STAMP && wid == 0 && nts < 64) { const unsigned long long _c = (unsigned long long)clock64(); \
        ts_lo = (lane == nts) ? (int)(unsigned)_c : ts_lo; ts_hi = (lane == nts) ? (int)(unsigned)(_c >> 32) : ts_hi; ++nts; } } while (0)
    PG8_STAMP();
    unsigned voffA[2], voffB[2];
#pragma unroll
    for (int i = 0; i < 2; ++i) { int R, C; stage_rc(tid * 16 + i * 8192, R, C); const int Rb = Epi::PERM ? ((R & ~31) + perm32(R & 31)) : R;
        voffA[i] = (unsigned)(R * K + C) * 2u; voffB[i] = (unsigned)(Rb * K + C) * 2u; }
    const size_t kstep = (size_t)(BK * 2);
    const size_t hstep = (size_t)HALF * K * 2;
    const size_t tstep = 2 * hstep;
    const unsigned ldsw = (unsigned)wid * 1024u;
    const int aoff = lds_byte(wr * 64 + fr, fq * 8), boff = lds_byte(wc * 32 + fr, fq * 8);
#define PG8_SA(b, h) (((b) * 2 + (h)) * HTB)
#define PG8_SB(b, h) ((4 + (b) * 2 + (h)) * HTB)
#define PG8_STAGE(bufoff, gbase, voff) do { _Pragma("unroll") for (int _i = 0; _i < 2; ++_i) \
        __builtin_amdgcn_global_load_lds((const unsigned*)((const char*)(gbase) + (voff)[_i]), (PG8_LAS unsigned*)(lds + (bufoff) + ldsw + _i * 8192), 16, 0, 0); } while (0)
#define PG8_LDA(dst, b, h) do { _Pragma("unroll") for (int m = 0; m < 4; ++m) _Pragma("unroll") for (int k = 0; k < 2; ++k) dst[m][k] = *(const PG8_LAS bf16x8*)(lds + PG8_SA(b, h) + aoff + m * 2048 + k * 1024); } while (0)
#define PG8_LDB(dst, b, h) do { _Pragma("unroll") for (int n = 0; n < 2; ++n) _Pragma("unroll") for (int k = 0; k < 2; ++k) dst[n][k] = *(const PG8_LAS bf16x8*)(lds + PG8_SB(b, h) + boff + n * 2048 + k * 1024); } while (0)
#define PG8_MMA(ai, bj, At, Bt) do { __builtin_amdgcn_s_setprio(1); _Pragma("unroll") for (int m = 0; m < 4; ++m) _Pragma("unroll") for (int n = 0; n < 2; ++n) _Pragma("unroll") for (int k = 0; k < 2; ++k) \
        acc[ai][bj][m][n] = __builtin_amdgcn_mfma_f32_16x16x32_bf16(Bt[n][k], At[m][k], acc[ai][bj][m][n], 0, 0, 0); __builtin_amdgcn_s_setprio(0); } while (0)
#define PG8_WAIT_V(n) asm volatile("s_waitcnt vmcnt(" #n ")" ::: "memory")
#define PG8_WAIT_L(n) asm volatile("s_waitcnt lgkmcnt(" #n ")" ::: "memory")
#define PG8_BAR __builtin_amdgcn_s_barrier()
#define PG8_SCHED __builtin_amdgcn_sched_barrier(0)
    Unit cur, nxt; int ui = 0;
    if (!S.next(0, cur)) return;
    f32x4 acc[2][2][4][2];
#pragma unroll
    for (int a = 0; a < 2; ++a)
#pragma unroll
        for (int b = 0; b < 2; ++b)
#pragma unroll
            for (int m = 0; m < 4; ++m)
#pragma unroll
                for (int n = 0; n < 2; ++n) acc[a][b][m][n] = (f32x4){0.f, 0.f, 0.f, 0.f};
    bf16x8 At[4][2], B0[2][2], B1[2][2];
    const char* cA = (const char*)g.A + (size_t)cur.pm * tstep; const char* cB = (const char*)g.Bt + (size_t)cur.pn * tstep;
    S.a_ready(cur);
    PG8_STAGE(PG8_SB(0, 0), cB, voffB); PG8_STAGE(PG8_SA(0, 0), cA, voffA); PG8_STAGE(PG8_SB(0, 1), cB + hstep, voffB); PG8_STAGE(PG8_SA(0, 1), cA + hstep, voffA);
    if (wr == 1) PG8_BAR;
    PG8_WAIT_V(4); PG8_BAR;
    PG8_STAGE(PG8_SB(1, 0), cB + kstep, voffB); PG8_STAGE(PG8_SA(1, 0), cA + kstep, voffA); PG8_STAGE(PG8_SB(1, 1), cB + hstep + kstep, voffB);
    PG8_WAIT_V(6); PG8_BAR;
    PG8_STAMP();
    for (;;) {
        const bool has_next = S.next(ui + 1, nxt);
        const char* nA = has_next ? (const char*)g.A + (size_t)nxt.pm * tstep : cA; const char* nB = has_next ? (const char*)g.Bt + (size_t)nxt.pn * tstep : cB;
        for (int t = 0; t < nt; t += 2) {
            const bool last = (t == nt - 2);
            const char* a1 = cA + (size_t)(t + 1) * kstep;
            const char* a2 = last ? nA : cA + (size_t)(t + 2) * kstep; const char* b2 = last ? nB : cB + (size_t)(t + 2) * kstep;
            const char* a3 = a2 + kstep; const char* b3 = b2 + kstep;
            if (last && has_next) S.a_ready(nxt);
            PG8_LDB(B0, 0, 0); PG8_SCHED; PG8_LDA(At, 0, 0); PG8_STAGE(PG8_SA(1, 1), a1 + hstep, voffA);
            PG8_WAIT_L(8); PG8_BAR; PG8_WAIT_L(0); PG8_MMA(0, 0, At, B0); PG8_BAR; PG8_SCHED;
            PG8_LDB(B1, 0, 1); PG8_STAGE(PG8_SB(0, 0), b2, voffB);
            PG8_BAR; PG8_WAIT_L(0); PG8_MMA(0, 1, At, B1); PG8_BAR;
            PG8_LDA(At, 0, 1); PG8_STAGE(PG8_SA(0, 0), a2, voffA);
            PG8_BAR; PG8_WAIT_L(0); PG8_MMA(1, 0, At, B0); PG8_BAR; PG8_SCHED;
            PG8_STAGE(PG8_SB(0, 1), b2 + hstep, voffB);
            PG8_WAIT_V(6); PG8_BAR; PG8_MMA(1, 1, At, B1); PG8_BAR;
            PG8_LDB(B0, 1, 0); PG8_SCHED; PG8_LDA(At, 1, 0); PG8_STAGE(PG8_SA(0, 1), a2 + hstep, voffA);
            PG8_WAIT_L(8); PG8_BAR; PG8_WAIT_L(0); PG8_MMA(0, 0, At, B0); PG8_BAR; PG8_SCHED;
            PG8_LDB(B1, 1, 1); PG8_STAGE(PG8_SB(1, 0), b3, voffB);
            PG8_BAR; PG8_WAIT_L(0); PG8_MMA(0, 1, At, B1); PG8_BAR;
            PG8_LDA(At, 1, 1); PG8_STAGE(PG8_SA(1, 0), a3, voffA);
            PG8_BAR; PG8_WAIT_L(0); PG8_MMA(1, 0, At, B0); PG8_BAR; PG8_SCHED;
            PG8_STAGE(PG8_SB(1, 1), b3 + hstep, voffB);
            PG8_WAIT_V(6); PG8_BAR; PG8_MMA(1, 1, At, B1); PG8_BAR;
        }
        PG8_STAMP();
        if constexpr (!Epi::AFTER_DRAIN) { E(acc, cur, wr, wc, fr, fq); S.done(cur); }
        PG8_STAMP();
        if (!has_next) break;
#pragma unroll
        for (int a = 0; a < 2; ++a)
#pragma unroll
            for (int b = 0; b < 2; ++b)
#pragma unroll
                for (int m = 0; m < 4; ++m)
#pragma unroll
                    for (int n = 0; n < 2; ++n) acc[a][b][m][n] = (f32x4){0.f, 0.f, 0.f, 0.f};
        cur = nxt; cA = nA; cB = nB; ++ui;
    }
    PG8_WAIT_V(0);
    if (wr == 0) PG8_BAR;
    PG8_BAR;
    if constexpr (Epi::AFTER_DRAIN) { E.fused(acc, cur, wr, wc, fr, fq, lds, wid, lane); S.done(cur); }
    PG8_STAMP();
    if (STAMP && wid == 0) { stamps[lane] = lane < nts ? (((unsigned long long)(unsigned)ts_hi << 32) | (unsigned)ts_lo) : 0ull;
        if (lane == 62) stamps[62] = rt_entry; if (lane == 63) stamps[63] = (unsigned long long)wall_clock64(); }
#undef PG8_STAMP
#undef PG8_SA
#undef PG8_SB
#undef PG8_STAGE
#undef PG8_LDA
#undef PG8_LDB
#undef PG8_MMA
#undef PG8_WAIT_V
#undef PG8_WAIT_L
#undef PG8_BAR
#undef PG8_SCHED
}
}
#define LDS_WAIT() asm volatile("s_waitcnt lgkmcnt(0)" ::: "memory")

__device__ __forceinline__ int map_row(int n, int mode) {
    if (mode == 1) { const int j = n < FF ? n : n - FF; return (j >> 7) * 256 + (n < FF ? 0 : 128) + (j & 127); }
    return n;
}
__device__ __forceinline__ void transpose_item(const float* __restrict__ W, int K, int N, bf16_t* WT, int mode, LAS float* scr, int item, int lane) {
    const int nblk = N / 32, kb = item / nblk, nb = item % nblk, k0 = 64 * kb, n0 = 32 * nb;
#pragma unroll
    for (int i = 0; i < 32; ++i) { const int kk = 2 * i + (lane >> 5); scr[kk * 33 + (lane & 31)] = W[(size_t)(k0 + kk) * N + n0 + (lane & 31)]; }
    LDS_WAIT(); asm volatile("" ::: "memory");
    const int c = lane & 7;
#pragma unroll
    for (int j = 0; j < 4; ++j) { const int n = (lane >> 3) + 8 * j; const LAS float* s = scr + (8 * c) * 33 + n;
        u32x4 o; o.x = cvt_pk_bf16(s[0 * 33], s[1 * 33]); o.y = cvt_pk_bf16(s[2 * 33], s[3 * 33]); o.z = cvt_pk_bf16(s[4 * 33], s[5 * 33]); o.w = cvt_pk_bf16(s[6 * 33], s[7 * 33]);
        *(u32x4*)(WT + (size_t)map_row(n0 + n, mode) * K + k0 + 8 * c) = o; }
    LDS_WAIT(); asm volatile("" ::: "memory");
}
constexpr int I_G = (DM / 64) * (2 * FF / 32), I_D = (FF / 64) * (DM / 32), I_IN = (DM / 64) * (9600 / 32), I_OUT = (DM / 64) * (DM / 32), I_Q = (1024 / 64) * (NQ / 32), I_KV = (512 / 64) * (NKV / 32);
constexpr int I_LAYER = 2 * I_G + 2 * I_D + I_IN + I_OUT + I_Q + I_KV;

__device__ __forceinline__ void phase0(const Frame& F, unsigned char* ws) {
    const int gw = F.bid * 8 + F.wave, NGW = F.G * 8;
    const size_t gt = (size_t)F.bid * 512 + F.tid, NGT = (size_t)F.G * 512;
    LAS float* scr = (LAS float*)(F.lds + F.wave * 8704);
    bf16_t* WB = (bf16_t*)(ws + WS_WB);
    for (int it = gw; it < NL * I_LAYER; it += NGW) {
        const int l = it / I_LAYER; int r = it - l * I_LAYER; bf16_t* wl = WB + (size_t)l * W_LAYER;
        if (r < I_G) { transpose_item(IN_(10) + (size_t)l * DM * 2 * FF, DM, 2 * FF, wl + W_G1, 1, scr, r, F.lane); continue; } r -= I_G;
        if (r < I_D) { transpose_item(IN_(11) + (size_t)l * FF * DM, FF, DM, wl + W_D1, 0, scr, r, F.lane); continue; } r -= I_D;
        if (r < I_G) { transpose_item(IN_(12) + (size_t)l * DM * 2 * FF, DM, 2 * FF, wl + W_G2, 1, scr, r, F.lane); continue; } r -= I_G;
        if (r < I_D) { transpose_item(IN_(13) + (size_t)l * FF * DM, FF, DM, wl + W_D2, 0, scr, r, F.lane); continue; } r -= I_D;
        if (r < I_IN) { transpose_item(IN_(14) + (size_t)l * DM * 9600, DM, 9600, wl + W_IN, 0, scr, r, F.lane); continue; } r -= I_IN;
        if (r < I_OUT) { transpose_item(IN_(15) + (size_t)l * DM * DM, DM, DM, wl + W_OUT, 0, scr, r, F.lane); continue; } r -= I_OUT;
        if (r < I_Q) { transpose_item(IN_(39) + (size_t)l * 1024 * NQ, 1024, NQ, wl + W_Q, 0, scr, r, F.lane); continue; } r -= I_Q;
        transpose_item(IN_(41) + (size_t)l * 512 * NKV, 512, NKV, wl + W_KV, 0, scr, r, F.lane);
    }
    for (size_t i = gt; i < (size_t)NL * 128 * 512; i += NGT) {
        const int l = (int)(i / (128 * 512)), rr = (int)((i / 512) % 128), c = (int)(i % 512);
        const int row = 9600 + rr;
        *(u32x4*)(WB + (size_t)l * W_LAYER + W_IN + (size_t)row * DM + c * 8) = (u32x4){0u, 0u, 0u, 0u};
    }
    { bf16_t* WLR = (bf16_t*)(ws + WS_WLR); const float* wu = IN_(18); const float* au = IN_(20); const float* gu = IN_(21);
      for (size_t i = gt; i < (size_t)NL * 448 * A_W; i += NGT) { const int l = (int)(i / (448 * A_W)), k = (int)((i / A_W) % 448), col = (int)(i % A_W);
          float v;
          if (k < 128) v = wu[(((size_t)l * 2 + (k >> 6)) * 64 + (k & 63)) * A_W + col];
          else if (k < 256) v = au[(((size_t)l * 2 + ((k - 128) >> 6)) * 64 + (k & 63)) * A_W + col];
          else v = gu[((size_t)l * 192 + (k - 256)) * A_W + col];
          WLR[((size_t)l * A_W + col) * 448 + k] = (bf16_t)(cvt_pk_bf16(v, v) & 0xffffu); } }
    { f32x4* xs = (f32x4*)(ws + WS_XS); const f32x4* cx = (const f32x4*)IN_(2);
      for (size_t i = gt; i < (size_t)NCTX * DM / 4; i += NGT) xs[i] = cx[i]; }
    { float* HP = (float*)(ws + WS_HP);
      for (int it = F.bid; it < NL * 16; it += F.G) { const int l = it >> 4, ch = it & 15, w = F.tid >> 8, j = F.tid & 255;
          const float* cv = w ? IN_(3) : IN_(1); const float* ad = IN_(4) + ((size_t)l * DM + ch * 256) * 256 + j; float s = 0.f;
          for (int i = 0; i < 256; ++i) s += siluf_(cv[ch * 256 + i]) * ad[(size_t)i * 256];
          HP[((l * 16 + ch) * 2 + w) * 256 + j] = s; } }
    { float* H3 = (float*)(ws + WS_H3);
      LAS float* zb = (LAS float*)(F.lds + 73728); LAS float* ha = zb + 8 * 36; LAS float* hb = ha + 8 * 64;
      for (int it = F.bid; it < NL * (T / 8); it += F.G) { const int l = it / (T / 8), pb = it % (T / 8);
          if (F.tid < 8 * 33) { const int p = F.tid / 33, i = F.tid % 33, P = pb * 8 + p; const int L = P < NCTX ? NCTX : SEQ, t = P < NCTX ? P : P - NCTX;
              float z;
              if (i == 0) z = (float)t / (float)(L - 1);
              else { const int b = (i - 1) & 15; const float fb = 1e-4f + (float)b * ((15.0f - 1e-4f) / 15.0f); const float rev2 = 2.0f * fb * (float)t / (float)L;
                  z = i <= 16 ? cospif(rev2) : -sinpif(rev2); }
              zb[p * 36 + i] = z; }
          __syncthreads();
          const int p = F.tid >> 6, j = F.tid & 63; const float fq = IN_(36)[l * 64 + j];
          { const float* w1 = IN_(29) + (size_t)l * 33 * 64 + j; float s = IN_(30)[l * 64 + j];
            for (int i = 0; i < 33; ++i) s += zb[p * 36 + i] * w1[i * 64];
            ha[p * 64 + j] = sinf(fq * s); }
          __syncthreads();
          { const float* w2 = IN_(31) + (size_t)l * 64 * 64 + j; float s = IN_(32)[l * 64 + j];
            for (int i = 0; i < 64; ++i) s += ha[p * 64 + i] * w2[i * 64];
            hb[p * 64 + j] = sinf(fq * s); }
          __syncthreads();
          { const float* w3 = IN_(33) + (size_t)l * 64 * 64 + j; float s = IN_(34)[l * 64 + j];
            for (int i = 0; i < 64; ++i) s += hb[p * 64 + i] * w3[i * 64];
            ((bf16_t*)H3)[((size_t)l * 64 + j) * T + pb * 8 + p] = (bf16_t)(cvt_pk_bf16(sinf(fq * s), 0.f) & 0xffffu); }
          __syncthreads(); } }
}
__device__ __forceinline__ void phase_mod(const Frame& F, unsigned char* ws) {
    const float* HP = (const float*)(ws + WS_HP); float* MOD = (float*)(ws + WS_MOD);
    LAS float* hs = (LAS float*)F.lds;
    for (int it = F.bid; it < NL * (NMOD / 512); it += F.G) { const int l = it / (NMOD / 512), nb = it % (NMOD / 512);
        { const int w = F.tid >> 8, j = F.tid & 255; float s = 0.f;
          for (int ch = 0; ch < 16; ++ch) s += HP[((l * 16 + ch) * 2 + w) * 256 + j];
          hs[w * 256 + j] = s; }
        __syncthreads();
        const int n = nb * 512 + F.tid; const float* au = IN_(5) + (size_t)l * 256 * NMOD + n; float s0 = IN_(6)[(size_t)l * NMOD + n], s1 = s0;
        for (int j = 0; j < 256; ++j) { const float u = au[(size_t)j * NMOD]; s0 += hs[j] * u; s1 += hs[256 + j] * u; }
        MOD[((size_t)l * 2 + 0) * NMOD + n] = s0; MOD[((size_t)l * 2 + 1) * NMOD + n] = s1;
        __syncthreads(); }
}
__device__ __forceinline__ void norm_phase(const Frame& F, float* XS, const float* __restrict__ gain, const float* modx, const float* modc, int ish, int isc, bf16_t* out, const bf16_t* slab, const float* sgate, float sfac, const float* XL) {
    const int gw = F.bid * 8 + F.wave, NGW = F.G * 8;
    int row_lo = 0;
    if (slab) { row_lo = NCTX;
        LAS float* red = (LAS float*)F.lds;
        for (int row = F.bid; row < NCTX; row += F.G) { const size_t o = (size_t)row * DM + F.wave * 512;
            f32x4 v[2]; float s = 0.f;
#pragma unroll
            for (int j = 0; j < 2; ++j) { f32x4 acc = (f32x4){0.f, 0.f, 0.f, 0.f};
#pragma unroll
                for (int ks = 0; ks < 16; ++ks) acc += bf4f(((const u32x2*)(slab + (size_t)ks * NCTX * DM + o) + F.lane)[64 * j]);
                v[j] = ((const f32x4*)(XS + o) + F.lane)[64 * j] + acc * ((const f32x4*)(sgate + F.wave * 512) + F.lane)[64 * j] * sfac;
                ((f32x4*)(XS + o) + F.lane)[64 * j] = v[j]; s += (v[j].x * v[j].x + v[j].y * v[j].y) + (v[j].z * v[j].z + v[j].w * v[j].w); }
            s = wave_sum(s); if (F.lane == 0) red[F.wave] = s;
            __syncthreads();
            float tot = 0.f;
#pragma unroll
            for (int w = 0; w < 8; ++w) tot += red[w];
            const float rstd = rsqrtf(tot * (1.0f / DM) + NORM_EPS);
#pragma unroll
            for (int j = 0; j < 2; ++j) { const int c4 = F.wave * 128 + F.lane + 64 * j;
                const f32x4 y = v[j] * rstd * ((const f32x4*)gain)[c4] * (((const f32x4*)(modc + (size_t)isc * DM))[c4] + 1.0f) + ((const f32x4*)(modc + (size_t)ish * DM))[c4];
                u32x2 w2; w2.x = cvt_pk_bf16(y.x, y.y); w2.y = cvt_pk_bf16(y.z, y.w); ((u32x2*)(out + (size_t)row * DM))[c4] = w2; }
            __syncthreads(); } }
    for (int row = row_lo + gw; row < T; row += NGW) {
        const float* mod = row < NCTX ? modc : modx;
        const f32x4* xr = (const f32x4*)((row < NCTX ? (const float*)XS : XL) + (size_t)row * DM) + F.lane; const f32x4* g4 = (const f32x4*)gain + F.lane;
        const f32x4* sh4 = (const f32x4*)(mod + (size_t)ish * DM) + F.lane; const f32x4* sc4 = (const f32x4*)(mod + (size_t)isc * DM) + F.lane;
        f32x4 v[16]; float s = 0.f;
#pragma unroll
        for (int j = 0; j < 16; ++j) { v[j] = xr[64 * j]; s += (v[j].x * v[j].x + v[j].y * v[j].y) + (v[j].z * v[j].z + v[j].w * v[j].w); }
        const float rstd = rsqrtf(wave_sum(s) * (1.0f / DM) + NORM_EPS);
        u32x2* o = (u32x2*)(out + (size_t)row * DM) + F.lane;
#pragma unroll
        for (int j = 0; j < 16; ++j) { const f32x4 y = v[j] * rstd * g4[64 * j] * (sc4[64 * j] + 1.0f) + sh4[64 * j];
            u32x2 w; w.x = cvt_pk_bf16(y.x, y.y); w.y = cvt_pk_bf16(y.z, y.w); o[64 * j] = w; }
    }
}
__device__ __forceinline__ float conv3_at(const bf16_t* PX, int tau, int col, float w0, float w1, float w2) {
    const bf16_t* p = PX + (size_t)tau * PXW + col;
    const bool hl = has_left(tau), hr = has_right(tau);
    return bf2f(p[0]) * w1 + bf2f(p[hl ? -PXW : 0]) * (hl ? w0 : 0.f) + bf2f(p[hr ? PXW : 0]) * (hr ? w2 : 0.f);
}
__device__ __forceinline__ float rope_apply(float val, int tau, int j) {
    const int pos = tau - NCTX, prow = pos >> 6, pcol = pos & 63;
    const float inv = __powf(10000.0f, -(float)(j & 15) * (1.0f / 16.0f));
    const float ang = (float)(j < 32 ? prow : pcol) * inv;
    float sn, cs; sincosf(ang, &sn, &cs);
    const float partner = __shfl_xor(val, 16);
    const float rot = (j & 16) ? partner : -partner;
    return val * cs + rot * sn;
}
__device__ __forceinline__ void mla_prep_phase(const Frame& F, unsigned char* ws, int l) {
    const bf16_t* PX = (const bf16_t*)(ws + WS_PX); bf16_t* QA = (bf16_t*)(ws + WS_QA); bf16_t* KVA = (bf16_t*)(ws + WS_KVA); bf16_t* KPE = (bf16_t*)(ws + WS_KPE);
    const int gw = F.bid * 8 + F.wave, NGW = F.G * 8;
    const f32x4* gq = (const f32x4*)(IN_(38) + l * 1024) + F.lane; const f32x4* gkv = (const f32x4*)(IN_(40) + l * 512) + F.lane; const float gpe = IN_(45)[l * 64 + F.lane];
    for (int tau = gw; tau < T; tau += NGW) {
        const u32x2* p = (const u32x2*)(PX + (size_t)tau * PXW + PXC) + F.lane;
        f32x4 q[4], kv[2]; float sq = 0.f, skv = 0.f;
#pragma unroll
        for (int j = 0; j < 4; ++j) { q[j] = bf4f(p[64 * j]); sq += (q[j].x * q[j].x + q[j].y * q[j].y) + (q[j].z * q[j].z + q[j].w * q[j].w); }
#pragma unroll
        for (int j = 0; j < 2; ++j) { kv[j] = bf4f(p[256 + 64 * j]); skv += (kv[j].x * kv[j].x + kv[j].y * kv[j].y) + (kv[j].z * kv[j].z + kv[j].w * kv[j].w); }
        const float pe = bf2f(PX[(size_t)tau * PXW + PXC + 1536 + F.lane]);
        const float rq = rsqrtf(wave_sum(sq) * (1.0f / 1024.0f) + NORM_EPS), rkv = rsqrtf(wave_sum(skv) * (1.0f / 512.0f) + NORM_EPS), rpe = rsqrtf(wave_sum(pe * pe) * (1.0f / 64.0f) + NORM_EPS);
        u32x2* oq = (u32x2*)(QA + (size_t)tau * 1024) + F.lane; u32x2* okv = (u32x2*)(KVA + (size_t)tau * 512) + F.lane;
#pragma unroll
        for (int j = 0; j < 4; ++j) { const f32x4 y = q[j] * rq * gq[64 * j]; u32x2 w; w.x = cvt_pk_bf16(y.x, y.y); w.y = cvt_pk_bf16(y.z, y.w); oq[64 * j] = w; }
#pragma unroll
        for (int j = 0; j < 2; ++j) { const f32x4 y = kv[j] * rkv * gkv[64 * j]; u32x2 w; w.x = cvt_pk_bf16(y.x, y.y); w.y = cvt_pk_bf16(y.z, y.w); okv[64 * j] = w; }
        float kp = pe * rpe * gpe;
        if (tau >= NCTX) kp = rope_apply(kp, tau, F.lane);
        KPE[(size_t)tau * 64 + F.lane] = (bf16_t)(cvt_pk_bf16(kp, kp) & 0xffffu);
    }
}
__device__ __forceinline__ void qkv_final_phase(const Frame& F, unsigned char* ws, int l, bool need_ctx) {
    const bf16_t* QRAW = (const bf16_t*)(ws + WS_QRAW); const bf16_t* KVRAW = (const bf16_t*)(ws + WS_KVRAW); const bf16_t* KPE = (const bf16_t*)(ws + WS_KPE);
    bf16_t* QF = (bf16_t*)(ws + WS_QF); bf16_t* KF = (bf16_t*)(ws + WS_KF);
    const int gw = F.bid * 8 + F.wave, NGW = F.G * 8, ln = F.lane;
    const int l5 = ln & 31, hb = ln >> 5;
    const f32x4 gqn = *(const f32x4*)(IN_(42) + l * 128 + 4 * l5), gkn = *(const f32x4*)(IN_(44) + l * 128 + 4 * l5); const f32x2 gqp = *(const f32x2*)(IN_(43) + l * 64 + 2 * l5);
    (void)need_ctx;
    for (int tau = gw; tau < T; tau += NGW) {
        float cs[2] = {1.f, 1.f}, sn[2] = {0.f, 0.f};
        if (tau >= NCTX) { const int pos = tau - NCTX, prow = pos >> 6, pcol = pos & 63;
#pragma unroll
            for (int e = 0; e < 2; ++e) { const int j = 2 * l5 + e; const float inv = __powf(10000.0f, -(float)(j & 15) * (1.0f / 16.0f)); sincosf((float)(j < 32 ? prow : pcol) * inv, &sn[e], &cs[e]); } }
        const unsigned kpe = *(const unsigned*)(KPE + (size_t)tau * 64 + 2 * l5);
        const bf16_t* qrow = QRAW + (size_t)tau * NQ; const bf16_t* krow = KVRAW + (size_t)tau * NKV;
        u32x2 qn[NHC / 2], kn[NHC / 2]; unsigned qpv[NHC / 2];
#pragma unroll
        for (int p = 0; p < NHC / 2; ++p) { const int h = 2 * p + hb; qn[p] = *(const u32x2*)(qrow + h * 192 + 4 * l5); qpv[p] = *(const unsigned*)(qrow + h * 192 + 128 + 2 * l5); kn[p] = *(const u32x2*)(krow + h * 256 + 4 * l5); }
#pragma unroll
        for (int p = 0; p < NHC / 2; ++p) { const int h = 2 * p + hb;
            const f32x4 q4 = bf4f(qn[p]), k4 = bf4f(kn[p]); const float qp0 = __uint_as_float(qpv[p] << 16), qp1 = __uint_as_float(qpv[p] & 0xffff0000u);
            float s1 = (q4.x * q4.x + q4.y * q4.y) + (q4.z * q4.z + q4.w * q4.w), s2 = qp0 * qp0 + qp1 * qp1, s3 = (k4.x * k4.x + k4.y * k4.y) + (k4.z * k4.z + k4.w * k4.w);
#pragma unroll
            for (int o = 1; o < 32; o <<= 1) { s1 += __shfl_xor(s1, o); s2 += __shfl_xor(s2, o); s3 += __shfl_xor(s3, o); }
            const float rqn = rsqrtf(s1 * (1.0f / 128.0f) + NORM_EPS), rqp = rsqrtf(s2 * (1.0f / 64.0f) + NORM_EPS), rkn = rsqrtf(s3 * (1.0f / 128.0f) + NORM_EPS);
            float qe0 = qp0 * rqp * gqp.x, qe1 = qp1 * rqp * gqp.y;
            { const float pa0 = __shfl_xor(qe0, 8), pa1 = __shfl_xor(qe1, 8); const float r0 = (l5 & 8) ? pa0 : -pa0, r1 = (l5 & 8) ? pa1 : -pa1; qe0 = qe0 * cs[0] + r0 * sn[0]; qe1 = qe1 * cs[1] + r1 * sn[1]; }
            const f32x4 qo = q4 * rqn * gqn, ko = k4 * rkn * gkn;
            bf16_t* qf = QF + (size_t)tau * NQ + h * 192; bf16_t* kf = KF + (size_t)tau * NQ + h * 192;
            u32x2 w; w.x = cvt_pk_bf16(qo.x, qo.y); w.y = cvt_pk_bf16(qo.z, qo.w); *(u32x2*)(qf + 4 * l5) = w;
            *(unsigned*)(qf + 128 + 2 * l5) = cvt_pk_bf16(qe0, qe1);
            w.x = cvt_pk_bf16(ko.x, ko.y); w.y = cvt_pk_bf16(ko.z, ko.w); *(u32x2*)(kf + 4 * l5) = w;
            *(unsigned*)(kf + 128 + 2 * l5) = kpe; }
    }
}
__device__ __forceinline__ void rwkv_out_phase(const Frame& F, unsigned char* ws, int l, bool need_ctx) {
    const float* SS = (const float*)(ws + WS_SS); const float* SD = (const float*)(ws + WS_SD); const float* GB = (const float*)(ws + WS_G); const float* Y = (const float*)(ws + WS_Y);
    bf16_t* OB = (bf16_t*)(ws + WS_OBUF);
    const int gw = F.bid * 8 + F.wave, NGW = F.G * 8, ln = F.lane;
    const f32x2* gnw = (const f32x2*)(IN_(25) + l * A_W); const f32x2* gnb = (const f32x2*)(IN_(26) + l * A_W);
    for (int it = (need_ctx ? 0 : NCTX * 5) + gw; it < T * 5; it += NGW) { const int tau = it / 5, h0 = (it % 5) * 4;
        f32x2 y0[2], y1[2], v[2], g[2]; float sa[2], sb[2];
#pragma unroll
        for (int p = 0; p < 2; ++p) { const int h = h0 + 2 * p + (ln >> 5); const size_t o2 = ((size_t)tau * A_W + (h0 + 2 * p) * 64) / 2 + ln;
            y0[p] = ((const f32x2*)Y)[o2]; y1[p] = ((const f32x2*)(Y + (size_t)T * A_W))[o2]; v[p] = ((const f32x2*)(SS + (size_t)T * A_W))[o2]; g[p] = ((const f32x2*)GB)[o2];
            sa[p] = SD[(size_t)tau * NHA + h]; sb[p] = SD[((size_t)T + tau) * NHA + h]; }
#pragma unroll
        for (int p = 0; p < 2; ++p) { const int c2 = (h0 + 2 * p) * 32 + ln;
            const f32x2 y = y0[p] + y1[p];
            float s1 = y.x + y.y;
#pragma unroll
            for (int o = 1; o < 32; o <<= 1) s1 += __shfl_xor(s1, o);
            const float mu = s1 * (1.0f / 64.0f); const f32x2 dy = y - mu; float s2 = dy.x * dy.x + dy.y * dy.y;
#pragma unroll
            for (int o = 1; o < 32; o <<= 1) s2 += __shfl_xor(s2, o);
            const f32x2 yn = dy * rsqrtf(s2 * (1.0f / 64.0f) + GN_EPS) * gnw[c2] + gnb[c2];
            const f32x2 ov = (yn + v[p] * (0.5f * (sa[p] + sb[p]))) * g[p];
            *(unsigned*)(OB + (size_t)tau * DM + 2 * c2) = cvt_pk_bf16(ov.x, ov.y); }
    }
}
__device__ __forceinline__ void hyena_prep_phase(const Frame& F, unsigned char* ws, int l) {
    const bf16_t* PX = (const bf16_t*)(ws + WS_PX); float* GT = (float*)(ws + WS_GT); float* X0T = (float*)(ws + WS_X0T);
    LAS float* LGt = (LAS float*)F.lds; LAS float* LX0 = LGt + 64 * 65;
    const float* cw = IN_(27) + (size_t)l * 3 * B_IN; const float* cb = IN_(28) + (size_t)l * B_IN;
    int it0, istep, iend;
    if (F.bid < 80) { it0 = F.bid * 5; istep = 1; iend = it0 + 5; } else { it0 = 400 + (F.bid - 80); istep = 176; iend = (T / 64) * 20; }
    for (int it = it0; it < iend; it += istep) { const int tt = it / 20, ct = it % 20;
        { const int t = F.tid >> 3, c0 = ct * 64 + (F.tid & 7) * 8, tau = tt * 64 + t;
          f32x4 u[3][2];
#pragma unroll
          for (int grp = 0; grp < 3; ++grp)
#pragma unroll
              for (int q = 0; q < 2; ++q) { const int c = grp * 1280 + c0 + 4 * q; const bf16_t* p = PX + (size_t)tau * PXW + PXB + c;
                  const bool hl = has_left(tau), hr = has_right(tau);
                  const f32x4 y = bf4f(*(const u32x2*)p) * *(const f32x4*)(cw + B_IN + c) + *(const f32x4*)(cb + c) + bf4f(*(const u32x2*)(p - (hl ? PXW : 0))) * (*(const f32x4*)(cw + c) * (hl ? 1.f : 0.f))
                                + bf4f(*(const u32x2*)(p + (hr ? PXW : 0))) * (*(const f32x4*)(cw + 2 * B_IN + c) * (hr ? 1.f : 0.f));
                  u[grp][q] = y; }
#pragma unroll
          for (int q = 0; q < 2; ++q)
#pragma unroll
              for (int e = 0; e < 4; ++e) { const int ch = (F.tid & 7) * 8 + 4 * q + e; LGt[ch * 65 + t] = u[1][q][e] * u[2][q][e]; LX0[ch * 65 + t] = u[0][q][e]; } }
        __syncthreads();
        { const int ch = F.tid >> 3, t0 = (F.tid & 7) * 8; const size_t o = (size_t)(ct * 64 + ch) * T + tt * 64 + t0;
          f32x4 a0, a1, b0, b1;
#pragma unroll
          for (int e = 0; e < 4; ++e) { a0[e] = LGt[ch * 65 + t0 + e]; a1[e] = LGt[ch * 65 + t0 + 4 + e]; b0[e] = LX0[ch * 65 + t0 + e]; b1[e] = LX0[ch * 65 + t0 + 4 + e]; }
          *(f32x4*)(GT + o) = a0; *(f32x4*)(GT + o + 4) = a1; *(f32x4*)(X0T + o) = b0; *(f32x4*)(X0T + o + 4) = b1; }
        __syncthreads(); }
}
__device__ __forceinline__ void hyena_out_phase(const Frame& F, unsigned char* ws, bool need_ctx) {
    const float* YT = (const float*)(ws + WS_GT); bf16_t* OB = (bf16_t*)(ws + WS_OBUF);
    LAS float* L = (LAS float*)F.lds;
    const int it0 = need_ctx ? 0 : (NCTX / 64) * 20;
    for (int it = it0 + F.bid; it < (T / 64) * 20; it += F.G) { const int tt = it / 20, ct = it % 20;
        { const int ch = F.tid >> 3, t0 = (F.tid & 7) * 8; const size_t o = (size_t)(ct * 64 + ch) * T + tt * 64 + t0;
          const f32x4 a0 = *(const f32x4*)(YT + o), a1 = *(const f32x4*)(YT + o + 4);
#pragma unroll
          for (int e = 0; e < 4; ++e) { L[ch * 65 + t0 + e] = a0[e]; L[ch * 65 + t0 + 4 + e] = a1[e]; } }
        __syncthreads();
        { const int t = F.tid >> 3, c0 = (F.tid & 7) * 8; float x[8];
#pragma unroll
          for (int e = 0; e < 8; ++e) x[e] = L[(c0 + e) * 65 + t];
          u32x4 w; w.x = cvt_pk_bf16(x[0], x[1]); w.y = cvt_pk_bf16(x[2], x[3]); w.z = cvt_pk_bf16(x[4], x[5]); w.w = cvt_pk_bf16(x[6], x[7]);
          *(u32x4*)(OB + (size_t)(tt * 64 + t) * DM + 1280 + ct * 64 + c0) = w; }
        __syncthreads(); }
}
namespace att {
constexpr int DK = 192, DV = 128, NW = 8, QBLK = 32, KVBLK = 64;
constexpr float SCALE = 0.07216878364870322f;
constexpr float THR = 8.f;
#ifndef ATT_SDEPTH
#define ATT_SDEPTH 2
#endif
constexpr int SDEPTH = ATT_SDEPTH;
constexpr int LDQ = 2304, LDK = 2304, LDV = 3072, LDO = 4096;
constexpr int SHM_V = KVBLK * DV * 2, SHM_K = KVBLK * DK * 2, SHM_ATTN = 2 * SHM_V + 2 * SHM_K + NW * 64 * 4 + NW * 4096;
using bf16x8 = __attribute__((ext_vector_type(8))) short;
using s16x4  = __attribute__((ext_vector_type(4))) short;
using f32x16 = __attribute__((ext_vector_type(16))) float;
using u32x4  = __attribute__((ext_vector_type(4))) unsigned;
#define KSWZ(row, colB) ((row) * 384 + ((colB) ^ (((row) & 7) << 4)))
#define SBAR() __builtin_amdgcn_sched_barrier(0)
__device__ __forceinline__ int crow(int r, int hi) { return (r & 3) + 8 * (r >> 2) + 4 * hi; }
__device__ __forceinline__ unsigned cvtpk(float lo, float hi) { unsigned r; asm volatile("v_cvt_pk_bf16_f32 %0, %1, %2" : "=v"(r) : "v"(lo), "v"(hi)); return r; }
__device__ __forceinline__ void partialSM(f32x16& p0, f32x16& p1, float& m_reg, float& mn, float& alpha) {
  constexpr float C = SCALE * 1.4426950408889634f;
  float pmax = p0[0]; for (int r = 1; r < 16; ++r) pmax = fmaxf(pmax, p0[r]); for (int r = 0; r < 16; ++r) pmax = fmaxf(pmax, p1[r]);
  { auto rr = __builtin_amdgcn_permlane32_swap(__float_as_uint(pmax), __float_as_uint(pmax), false, false);
    pmax = fmaxf(__uint_as_float(rr[0]), __uint_as_float(rr[1])); }
  if (__builtin_expect(__all(pmax - m_reg <= THR / SCALE), 1)) { mn = m_reg; alpha = 1.f; }
  else { mn = fmaxf(m_reg, pmax); alpha = __builtin_amdgcn_exp2f((m_reg - mn) * C); m_reg = mn; }
  float mnC = -mn * C;
  for (int r = 0; r < 16; ++r) p0[r] = fmaf(p0[r], C, mnC); for (int r = 0; r < 16; ++r) p1[r] = fmaf(p1[r], C, mnC);
  for (int r = 0; r < 16; ++r) p0[r] = __builtin_amdgcn_exp2f(p0[r]);
}
__device__ __forceinline__ void finishSM(f32x16& p0, f32x16& p1, float alpha, float& l_reg, bf16x8& pa0, bf16x8& pa1, bf16x8& pa2, bf16x8& pa3) {
  for (int r = 0; r < 16; ++r) p1[r] = __builtin_amdgcn_exp2f(p1[r]);
  float ps = 0; for (int r = 0; r < 16; ++r) ps += p0[r]; for (int r = 0; r < 16; ++r) ps += p1[r];
  { auto rr = __builtin_amdgcn_permlane32_swap(__float_as_uint(ps), __float_as_uint(ps), false, false);
    ps = __uint_as_float(rr[0]) + __uint_as_float(rr[1]); }
  l_reg = l_reg * alpha + ps;
#define PK4(P, BASE, OUT) do { unsigned a0 = cvtpk(P[BASE + 0], P[BASE + 1]), a1 = cvtpk(P[BASE + 2], P[BASE + 3]);   \
    unsigned b0 = cvtpk(P[BASE + 4], P[BASE + 5]), b1 = cvtpk(P[BASE + 6], P[BASE + 7]);                              \
    auto r0 = __builtin_amdgcn_permlane32_swap(a0, b0, false, false); auto r1 = __builtin_amdgcn_permlane32_swap(a1, b1, false, false); \
    u32x4 w = {r0[0], r1[0], r0[1], r1[1]}; OUT = *reinterpret_cast<bf16x8*>(&w); } while (0)
  PK4(p0, 0, pa0); PK4(p0, 8, pa1); PK4(p1, 0, pa2); PK4(p1, 8, pa3);
#undef PK4
}
__device__ __forceinline__ void qkt(f32x16& p0, f32x16& p1, const char* Ks, const bf16x8* qr, const char* qrl, int r32, int hi) {
  p0 = f32x16{}; p1 = f32x16{};
#pragma unroll
  for (int d0 = 0; d0 < 8; ++d0) { int cb = (d0 * 16 + hi * 8) * 2;
    bf16x8 b0 = *reinterpret_cast<const bf16x8*>(Ks + KSWZ(r32, cb));
    bf16x8 b1 = *reinterpret_cast<const bf16x8*>(Ks + KSWZ(32 + r32, cb));
    p0 = __builtin_amdgcn_mfma_f32_32x32x16_bf16(b0, qr[d0], p0, 0, 0, 0);
    p1 = __builtin_amdgcn_mfma_f32_32x32x16_bf16(b1, qr[d0], p1, 0, 0, 0); }
#pragma unroll
  for (int d0 = 8; d0 < 12; ++d0) { int cb = (d0 * 16 + hi * 8) * 2;
    bf16x8 b0 = *reinterpret_cast<const bf16x8*>(Ks + KSWZ(r32, cb));
    bf16x8 b1 = *reinterpret_cast<const bf16x8*>(Ks + KSWZ(32 + r32, cb));
    const bf16x8 q = *reinterpret_cast<const bf16x8*>(qrl + ((((d0 - 8) * 2 + hi) ^ (r32 & 7)) << 4));
    p0 = __builtin_amdgcn_mfma_f32_32x32x16_bf16(b0, q, p0, 0, 0, 0);
    p1 = __builtin_amdgcn_mfma_f32_32x32x16_bf16(b1, q, p1, 0, 0, 0); }
}
__device__ __forceinline__ int v_st(int k, int c) { const int kk = (k & ~0xC) | ((k & 4) << 1) | ((k & 8) >> 1); return ((kk >> 3) * 4 + (c >> 5)) * 512 + ((kk & 7) * 32 + (c & 31)) * 2; }
__device__ __forceinline__ int v_rd_base(int lane) { return ((lane & 3) << 3) | (((lane >> 2) & 3) << 6) | (((lane >> 4) & 1) << 5) | (((lane >> 5) & 1) << 8); }
constexpr int v_rd_off(int d0, int ks, int half) { return d0 * 512 + ks * 4096 + half * 2048; }
template <int OFF> __device__ __forceinline__ s16x4 tr_read(int vb) {
  s16x4 r; asm volatile("ds_read_b64_tr_b16 %0, %1 offset:%2" : "=&v"(r) : "v"(vb), "i"(OFF) : "memory"); return r;
}
template <int D0> __device__ __forceinline__ void pv_one(f32x16& od, int vb, bf16x8 pa0, bf16x8 pa1, bf16x8 pa2, bf16x8 pa3) {
  const s16x4 l0 = tr_read<v_rd_off(D0, 0, 0)>(vb), h0 = tr_read<v_rd_off(D0, 0, 1)>(vb), l1 = tr_read<v_rd_off(D0, 1, 0)>(vb), h1 = tr_read<v_rd_off(D0, 1, 1)>(vb);
  const s16x4 l2 = tr_read<v_rd_off(D0, 2, 0)>(vb), h2 = tr_read<v_rd_off(D0, 2, 1)>(vb), l3 = tr_read<v_rd_off(D0, 3, 0)>(vb), h3 = tr_read<v_rd_off(D0, 3, 1)>(vb);
  asm volatile("s_waitcnt lgkmcnt(0)" ::: "memory"); SBAR();
#define PK(L, H) (bf16x8){L[0], L[1], L[2], L[3], H[0], H[1], H[2], H[3]}
  od = __builtin_amdgcn_mfma_f32_32x32x16_bf16(pa0, PK(l0, h0), od, 0, 0, 0);
  od = __builtin_amdgcn_mfma_f32_32x32x16_bf16(pa1, PK(l1, h1), od, 0, 0, 0);
  od = __builtin_amdgcn_mfma_f32_32x32x16_bf16(pa2, PK(l2, h2), od, 0, 0, 0);
  od = __builtin_amdgcn_mfma_f32_32x32x16_bf16(pa3, PK(l3, h3), od, 0, 0, 0);
#undef PK
}
__device__ __forceinline__ void pv_d0(f32x16* o, int vb, bf16x8 pa0, bf16x8 pa1, bf16x8 pa2, bf16x8 pa3) {
  pv_one<0>(o[0], vb, pa0, pa1, pa2, pa3); pv_one<1>(o[1], vb, pa0, pa1, pa2, pa3); pv_one<2>(o[2], vb, pa0, pa1, pa2, pa3); pv_one<3>(o[3], vb, pa0, pa1, pa2, pa3);
}
__device__ __forceinline__ void attn_body(const bf16_t* __restrict__ Qb, const bf16_t* __restrict__ Kh, const bf16_t* __restrict__ Vh, bf16_t* __restrict__ Ob, int seq, char* lds) {
  int tid_ = threadIdx.x; asm volatile("" : "+v"(tid_));
  const int tid = tid_, wid = tid >> 6, lane = tid & 63, r32 = lane & 31, hi = lane >> 5;
  char* V_lds = lds; char* K_lds = lds + 2 * SHM_V;
  float* ws = (float*)(lds + 2 * SHM_V + 2 * SHM_K) + wid * 64; float* li_l = ws; float* al_l = ws + 32;
  float m_reg = -1e30f, l_reg = 0; f32x16 o[4] = {}; bf16x8 qr[8];
  const bf16_t* Qw = Qb + (long)(wid * QBLK + r32) * LDQ + hi * 8;
  char* qrl = lds + 2 * SHM_V + 2 * SHM_K + NW * 64 * 4 + wid * 4096 + r32 * 128;
#pragma unroll
  for (int d0 = 0; d0 < 8; ++d0) qr[d0] = *reinterpret_cast<const bf16x8*>(Qw + d0 * 16);
#pragma unroll
  for (int d0 = 8; d0 < 12; ++d0) *reinterpret_cast<bf16x8*>(qrl + ((((d0 - 8) * 2 + hi) ^ (r32 & 7)) << 4)) = *reinterpret_cast<const bf16x8*>(Qw + d0 * 16);
  asm volatile("s_waitcnt lgkmcnt(0)" ::: "memory");
  unsigned kgo[3], vgo[2];
#pragma unroll
  for (int i = 0; i < 3; ++i) { const int p = (i * 8 + wid) * 64 + lane, row = p / 24, slot = p % 24, ch = slot ^ (row & 7); kgo[i] = (unsigned)(row * LDK + ch * 8) * 2u; }
#pragma unroll
  for (int i = 0; i < 2; ++i) { const int p = (i * 8 + wid) * 64 + lane, sub = p >> 5, within = p & 31, kk = (sub >> 2) * 8 + (within >> 2), c = (sub & 3) * 32 + (within & 3) * 8;
    const int k = (kk & ~0xC) | ((kk & 4) << 1) | ((kk & 8) >> 1); vgo[i] = (unsigned)(k * LDV + c) * 2u; }
  const int vb0 = (int)(uintptr_t)V_lds + v_rd_base(lane);
  typedef __attribute__((address_space(3))) unsigned lds_u32;
#define DMA_K(b, k0) do { const char* kg = (const char*)Kh + (size_t)(k0) * (LDK * 2); \
    _Pragma("unroll") for (int _i = 0; _i < 3; ++_i) __builtin_amdgcn_global_load_lds((const unsigned*)(kg + kgo[_i]), (lds_u32*)(K_lds + (b) * SHM_K + (_i * 8 + wid) * 1024), 16, 0, 0); } while (0)
#define DMA_V(b, k0) do { const char* vg = (const char*)Vh + (size_t)(k0) * (LDV * 2); \
    _Pragma("unroll") for (int _i = 0; _i < 2; ++_i) __builtin_amdgcn_global_load_lds((const unsigned*)(vg + vgo[_i]), (lds_u32*)(V_lds + (b) * SHM_V + (_i * 8 + wid) * 1024), 16, 0, 0); } while (0)
#define RESC(a) do { if (__any((a) < 1.f)) { if (hi == 0) al_l[r32] = (a); asm volatile("s_waitcnt lgkmcnt(0)" ::: "memory"); \
    for (int d = 0; d < 4; ++d) for (int r = 0; r < 16; ++r) o[d][r] *= al_l[crow(r, hi)]; } } while (0)
#define ENDSTEP() do { asm volatile("s_waitcnt vmcnt(0)" ::: "memory"); __syncthreads(); } while (0)
  f32x16 pA0, pA1, pB0, pB1; float mnA, mnB, alA, alB; bf16x8 pa0, pa1, pa2, pa3; const int NT = seq / KVBLK;
  DMA_K(0, 0); ENDSTEP();
  DMA_K(1, KVBLK); DMA_V(0, 0);
  qkt(pA0, pA1, K_lds, qr, qrl, r32, hi); partialSM(pA0, pA1, m_reg, mnA, alA);
  ENDSTEP();
  for (int j = 1; j + 1 < NT; j += 2) {
    DMA_K(0, (j + 1) * KVBLK); DMA_V(1, j * KVBLK);
    SBAR(); qkt(pB0, pB1, K_lds + SHM_K, qr, qrl, r32, hi);
    finishSM(pA0, pA1, alA, l_reg, pa0, pa1, pa2, pa3); SBAR();
    pv_d0(o, vb0, pa0, pa1, pa2, pa3); partialSM(pB0, pB1, m_reg, mnB, alB);
    RESC(alB); ENDSTEP();
    if (j + 2 < NT) DMA_K(1, (j + 2) * KVBLK);
    DMA_V(0, (j + 1) * KVBLK);
    SBAR(); qkt(pA0, pA1, K_lds, qr, qrl, r32, hi);
    finishSM(pB0, pB1, alB, l_reg, pa0, pa1, pa2, pa3); SBAR();
    pv_d0(o, vb0 + (int)SHM_V, pa0, pa1, pa2, pa3); partialSM(pA0, pA1, m_reg, mnA, alA);
    RESC(alA); ENDSTEP();
  }
  DMA_V(1, (NT - 1) * KVBLK);
  SBAR(); qkt(pB0, pB1, K_lds + SHM_K, qr, qrl, r32, hi);
  finishSM(pA0, pA1, alA, l_reg, pa0, pa1, pa2, pa3); SBAR();
  pv_d0(o, vb0, pa0, pa1, pa2, pa3); partialSM(pB0, pB1, m_reg, mnB, alB);
  RESC(alB); ENDSTEP();
  finishSM(pB0, pB1, alB, l_reg, pa0, pa1, pa2, pa3); SBAR();
  pv_d0(o, vb0 + (int)SHM_V, pa0, pa1, pa2, pa3);
#undef DMA_K
#undef DMA_V
#undef ENDSTEP
  if (hi == 0) li_l[r32] = l_reg; asm volatile("s_waitcnt lgkmcnt(0)" ::: "memory");
  float rli[16];
#pragma unroll
  for (int r = 0; r < 16; ++r) rli[r] = __builtin_amdgcn_rcpf(li_l[crow(r, hi)]);
  bf16_t* Ow = Ob + (long)(wid * QBLK) * LDO;
#pragma unroll
  for (int r = 0; r < 16; ++r) { int orow = crow(r, hi);
#pragma unroll
    for (int d0 = 0; d0 < 4; ++d0) { const float val = o[d0][r] * rli[r]; Ow[(long)orow * LDO + d0 * 32 + r32] = (bf16_t)(cvtpk(val, val) & 0xffff); } }
  __syncthreads();
#undef RESC
}
}
__device__ __forceinline__ f32x2 cmul(f32x2 a, f32x2 b) { return (f32x2){a.x * b.x - a.y * b.y, a.x * b.y + a.y * b.x}; }
__device__ __forceinline__ int rev4_14(int k) { const unsigned r = __brev((unsigned)k) >> 18; return (int)(((r & 0x1555u) << 1) | ((r >> 1) & 0x1555u)); }
#define ZI(i) ((i) + ((i) >> 5))
__device__ __forceinline__ void fft_tw(int j, int q, float sign, f32x2& w1, f32x2& w2, f32x2& w3) {
    const float rev = (float)j / (float)(4 * q); const float sn = __builtin_amdgcn_sinf(rev), cs = __builtin_amdgcn_cosf(rev);
    w1 = (f32x2){cs, sign * sn}; w2 = cmul(w1, w1); w3 = cmul(w2, w1);
}
__device__ __forceinline__ void fft16k_dif(LAS f32x2* Z, int tid) {
#pragma unroll 1
    for (int s = 0; s < 7; ++s) { int lq = 12 - 2 * s; asm volatile("" : "+s"(lq)); const int q = 1 << lq;
        const bool shared = q <= 512; f32x2 w1, w2, w3; fft_tw(tid & (q - 1), q, -1.f, w1, w2, w3);
#pragma unroll 2
        for (int i = 0; i < 8; ++i) { const int b = tid + 512 * i, j = b & (q - 1), base = ((b >> lq) << (lq + 2)) + j;
            const int i0 = ZI(base), i1 = ZI(base + q), i2 = ZI(base + 2 * q), i3 = ZI(base + 3 * q);
            const f32x2 a0 = Z[i0], a1 = Z[i1], a2 = Z[i2], a3 = Z[i3];
            const f32x2 t0 = a0 + a2, t1 = a0 - a2, t2 = a1 + a3, t3 = a1 - a3;
            if (!shared) fft_tw(j, q, -1.f, w1, w2, w3);
            Z[i0] = t0 + t2; Z[i1] = cmul((f32x2){t1.x + t3.y, t1.y - t3.x}, w1); Z[i2] = cmul(t0 - t2, w2); Z[i3] = cmul((f32x2){t1.x - t3.y, t1.y + t3.x}, w3); }
        __syncthreads(); }
}
__device__ __forceinline__ void fft16k_dit_inv(LAS f32x2* Z, int tid) {
#pragma unroll 1
    for (int s = 0; s < 7; ++s) { int lq = 2 * s; asm volatile("" : "+s"(lq)); const int q = 1 << lq;
        const bool shared = q <= 512; f32x2 w1, w2, w3; fft_tw(tid & (q - 1), q, 1.f, w1, w2, w3);
#pragma unroll 2
        for (int i = 0; i < 8; ++i) { const int b = tid + 512 * i, j = b & (q - 1), base = ((b >> lq) << (lq + 2)) + j;
            if (!shared) fft_tw(j, q, 1.f, w1, w2, w3);
            const int i0 = ZI(base), i1 = ZI(base + q), i2 = ZI(base + 2 * q), i3 = ZI(base + 3 * q);
            const f32x2 b0 = Z[i0], b1 = cmul(Z[i1], w1), b2 = cmul(Z[i2], w2), b3 = cmul(Z[i3], w3);
            const f32x2 t0 = b0 + b2, t1 = b0 - b2, t2 = b1 + b3, t3 = b1 - b3;
            Z[i0] = t0 + t2; Z[i1] = (f32x2){t1.x - t3.y, t1.y + t3.x}; Z[i2] = t0 - t2; Z[i3] = (f32x2){t1.x + t3.y, t1.y - t3.x}; }
        __syncthreads(); }
}
constexpr float HY_MIN_DECAY = -3.0701134573253945f, HY_MAX_DECAY = -15.350567286626973f;
__device__ __forceinline__ float hy_delta(int c) { return fabsf(HY_MIN_DECAY + (HY_MAX_DECAY - HY_MIN_DECAY) * ((float)c / 1279.0f)); }
__device__ __forceinline__ float conv3b_at(const bf16_t* PX, int tau, int col, const float* cw, int l, int c) {
    const float* w = cw + (size_t)l * 3 * B_IN;
    return conv3_at(PX, tau, col, w[c], w[B_IN + c], w[2 * B_IN + c]);
}
__device__ __forceinline__ void hyena_taps_unit(const Frame& F, unsigned char* ws, int l, int pair) {
    LAS f32x2* Z = (LAS f32x2*)F.lds; LAS float* red = (LAS float*)(F.lds + LDS_MISC + 128);
    const int tid = F.tid, c0 = 2 * pair;
    const bf16_t* H3x = (const bf16_t*)(ws + WS_H3) + (size_t)l * 64 * T + NCTX;
    f32x4* scr4 = (f32x4*)(ws + WS_HSCR) + (size_t)pair * HT_STRIDE; float* htn = (float*)(ws + WS_HTN) + 2 * pair;
    LAS f32x4* FW = (LAS f32x4*)(F.lds + LDS_MISC + 256);
    if (tid < 256) { const int j = tid >> 2, q = tid & 3; ((LAS float*)FW)[tid] = IN_(35)[(size_t)l * 64 * 2560 + (size_t)j * 2560 + (q >> 1) * 1280 + c0 + (q & 1)]; }
    __syncthreads();
    const float d0 = hy_delta(c0), d1 = hy_delta(c0 + 1);
#ifndef HYS
#define HYS 31
#endif
    float s0, s1, sc0 = 0.f, sc1 = 0.f;
    {
    s0 = 0.f; s1 = 0.f;
    if (HYS & 1)
#pragma unroll 1
    for (int i = 0; i < 2; ++i) { const int tb = 4096 * i + 8 * tid; const bf16_t* hc = H3x + tb;
        asm volatile("" ::: "memory");
        f32x4 acc[8];
#pragma unroll
        for (int p = 0; p < 8; ++p) acc[p] = (f32x4){0.f, 0.f, 0.f, 0.f};
#pragma unroll 8
        for (int j = 0; j < 64; ++j) { const f32x4 w = FW[j]; const u32x4 hv = *(const u32x4*)(hc + (size_t)j * T);
#pragma unroll
            for (int p = 0; p < 4; ++p) { acc[2 * p] += w * __uint_as_float(hv[p] << 16); acc[2 * p + 1] += w * __uint_as_float(hv[p] & 0xffff0000u); } }
#pragma unroll
        for (int p = 0; p < 8; ++p) { const int t = tb + p;
            const float tl = (float)t * (1.0f / 8191.0f), e0 = __expf(-tl * d0), e1 = __expf(-tl * d1);
            const float f0 = acc[p].x * e0, f1 = acc[p].y * e1, b0 = acc[p].z * e0, b1 = acc[p].w * e1;
            Z[ZI(t)] = (f32x2){f0, f1}; s0 += fabsf(f0); s1 += fabsf(f1);
            if (t < 8191) { Z[ZI(16383 - t)] = (f32x2){b0, b1}; s0 += fabsf(b0); s1 += fabsf(b1); } } }
    if (tid == 0) { float zz = 0.f; asm volatile("" : "+v"(zz)); Z[ZI(8192)] = (f32x2){zz, zz}; }
    s0 = wave_sum(s0); s1 = wave_sum(s1);
    if (F.lane == 0) { red[F.wave * 2] = s0; red[F.wave * 2 + 1] = s1; }
    __syncthreads();
    float n0 = 0.f, n1 = 0.f;
#pragma unroll
    for (int w = 0; w < 8; ++w) { n0 += red[2 * w]; n1 += red[2 * w + 1]; }
    sc0 = 1.0f / (16384.0f * n0); sc1 = 1.0f / (16384.0f * n1);
    if (HYS & 2) fft16k_dif(Z, tid);
#pragma unroll 2
    for (int i = 0; i < 17; ++i) { const int k = tid + 512 * i; if (i == 16 && tid != 0) break;
        const int pk = rev4_14(k & 16383), pn = rev4_14((16384 - k) & 16383);
        const f32x2 At = Z[ZI(pk)], Bt = Z[ZI(pn)];
        scr4[k] = (f32x4){0.5f * (At.x + Bt.x), 0.5f * (At.y - Bt.y), 0.5f * (At.y + Bt.y), -0.5f * (At.x - Bt.x)}; }
    __syncthreads();
    }
    if (tid == 0) { htn[0] = sc0; htn[1] = sc1; }
    __syncthreads();
}
__device__ __forceinline__ void hyena_unit(const Frame& F, unsigned char* ws, int l, int pair) {
    LAS f32x2* Z = (LAS f32x2*)F.lds;
    const int tid = F.tid, c0 = 2 * pair;
    float* GT = (float*)(ws + WS_GT); const float* X0T = (const float*)(ws + WS_X0T);
    const f32x4* scr4 = (const f32x4*)(ws + WS_HSCR) + (size_t)pair * HT_STRIDE; const float* htn = (const float*)(ws + WS_HTN) + 2 * pair;
    const float sc0 = htn[0], sc1 = htn[1];
#ifndef HYS
#define HYS 31
#endif
    for (int rp15 = 0; rp15 < REP(15); ++rp15) {
    const float* g0p = GT + (size_t)c0 * T + NCTX; const float* g1p = g0p + T;
    f32x4 Hr[17];
    { float zz = 0.f; asm volatile("" : "+v"(zz));
      f32x2 ga[8], gb[8];
#pragma unroll
      for (int i = 0; i < 8; ++i) { const int t = 2 * tid + 1024 * i; ga[i] = *(const f32x2*)(g0p + t); gb[i] = *(const f32x2*)(g1p + t); }
#pragma unroll
      for (int i = 0; i < 17; ++i) Hr[i] = scr4[i < 16 ? tid + 512 * i : 8192];
#pragma unroll
      for (int i = 0; i < 8; ++i) { const int t = 2 * tid + 1024 * i; Z[ZI(t)] = (f32x2){ga[i].x, gb[i].x}; Z[ZI(t + 1)] = (f32x2){ga[i].y, gb[i].y}; Z[ZI(8192 + t)] = (f32x2){zz, zz}; Z[ZI(8193 + t)] = (f32x2){zz, zz}; } }
    __syncthreads();
    if (HYS & 2) fft16k_dif(Z, tid);
    if (HYS & 8)
#pragma unroll
    for (int i = 0; i < 17; ++i) { const int k = tid + 512 * i; if (i == 16 && tid != 0) break;
        const int pk = rev4_14(k & 16383), pn = rev4_14((16384 - k) & 16383);
        const f32x2 A = Z[ZI(pk)], B = Z[ZI(pn)];
        const f32x2 G0 = (f32x2){0.5f * (A.x + B.x), 0.5f * (A.y - B.y)}, G1 = (f32x2){0.5f * (A.y + B.y), -0.5f * (A.x - B.x)};
        const f32x2 H0 = (f32x2){Hr[i].x, Hr[i].y}, H1 = (f32x2){Hr[i].z, Hr[i].w};
        const f32x2 P0 = cmul(G0, H0), P1 = cmul(G1, H1);
        Z[ZI(pk)] = (f32x2){P0.x - P1.y, P0.y + P1.x};
        if (pn != pk) Z[ZI(pn)] = (f32x2){P0.x + P1.y, P1.x - P0.y}; }
    __syncthreads();
    if (HYS & 2) fft16k_dit_inv(Z, tid);
    }
    const float bb0 = IN_(37)[l * 1280 + c0], bb1 = IN_(37)[l * 1280 + c0 + 1];
    { float* y0p = GT + (size_t)c0 * T + NCTX; float* y1p = y0p + T; const float* x0p = X0T + (size_t)c0 * T + NCTX; const float* x1p = x0p + T;
      f32x2 ga[8], gb[8], xa[8], xb[8];
#pragma unroll
      for (int i = 0; i < 8; ++i) { const int t = 2 * tid + 1024 * i; ga[i] = *(const f32x2*)(y0p + t); gb[i] = *(const f32x2*)(y1p + t); xa[i] = *(const f32x2*)(x0p + t); xb[i] = *(const f32x2*)(x1p + t); }
#pragma unroll
      for (int i = 0; i < 8; ++i) { const int t = 2 * tid + 1024 * i; const f32x2 z0 = Z[ZI(t)], z1 = Z[ZI(t + 1)];
          *(f32x2*)(y0p + t) = (f32x2){xa[i].x * (z0.x * sc0 + ga[i].x * bb0), xa[i].y * (z1.x * sc0 + ga[i].y * bb0)};
          *(f32x2*)(y1p + t) = (f32x2){xb[i].x * (z0.y * sc1 + gb[i].x * bb1), xb[i].y * (z1.y * sc1 + gb[i].y * bb1)}; } }
    __syncthreads();
}
__device__ __forceinline__ void hyena_ctx_unit(const Frame& F, unsigned char* ws, int l, int unit) {
    LAS float* TF = (LAS float*)F.lds; LAS float* TB = TF + 2048; LAS float* GG = TB + 2048;
    const int tid = F.tid, t = tid >> 1, cc = (tid & 1) * 4, cbase = unit * 8 + cc;
    const bf16_t* H3c = (const bf16_t*)(ws + WS_H3) + (size_t)l * 64 * T; float* GT = (float*)(ws + WS_GT); const float* X0T = (const float*)(ws + WS_X0T);
    { float f[4] = {0.f, 0.f, 0.f, 0.f}, b[4] = {0.f, 0.f, 0.f, 0.f};
      const float* wbase = IN_(35) + (size_t)l * 64 * 2560 + cbase;
      for (int j = 0; j < 64; ++j) { const float hv = bf2f(H3c[(size_t)j * T + t]); const float* wrow = wbase + (size_t)j * 2560;
#pragma unroll
          for (int q = 0; q < 4; ++q) { f[q] += hv * wrow[q]; b[q] += hv * wrow[1280 + q]; } }
      const float tl = (float)t * (1.0f / 255.0f);
#pragma unroll
      for (int q = 0; q < 4; ++q) { const float e = __expf(-tl * hy_delta(cbase + q)); TF[t * 8 + cc + q] = f[q] * e; TB[t * 8 + cc + q] = b[q] * e; GG[t * 8 + cc + q] = GT[(size_t)(cbase + q) * T + t]; } }
    __syncthreads();
    float nrm[4] = {0.f, 0.f, 0.f, 0.f}, y[4] = {0.f, 0.f, 0.f, 0.f};
    for (int s = 0; s < 256; ++s) {
#pragma unroll
        for (int q = 0; q < 4; ++q) { nrm[q] += fabsf(TF[s * 8 + cc + q]) + (s < 255 ? fabsf(TB[s * 8 + cc + q]) : 0.f);
            const int o = t - s; const float tap = o >= 0 ? TF[o * 8 + cc + q] : TB[(-o - 1) * 8 + cc + q];
            y[q] += tap * GG[s * 8 + cc + q]; } }
    __syncthreads();
#pragma unroll
    for (int q = 0; q < 4; ++q) GT[(size_t)(cbase + q) * T + t] = X0T[(size_t)(cbase + q) * T + t] * (y[q] / nrm[q] + GG[t * 8 + cc + q] * IN_(37)[l * 1280 + cbase + q]);
    __syncthreads();
}
constexpr int SC_C = 16, SC_NCHUNK = T / SC_C, SC_CHUNK_BYTES = 14 * 1024;
__device__ __forceinline__ int sc_tau(int d, int c, int t) { return d == 0 ? SC_C * c + t : (c < NCTX / SC_C ? NCTX - 1 - SC_C * c - t : T - 1 - SC_C * (c - NCTX / SC_C) - t); }
__device__ __forceinline__ int sc_perm(int e, int hi) { return (e & 3) + 8 * (e >> 2) + 4 * hi; }
constexpr size_t WS_FR_BYTES = (size_t)2 * NHA * SC_NCHUNK * SC_CHUNK_BYTES;

typedef short sc_bf16x8 __attribute__((ext_vector_type(8)));
typedef float sc_f32x16 __attribute__((ext_vector_type(16)));
__device__ __forceinline__ sc_bf16x8 sc_pack8(const sc_f32x16& a, int base) {
    u32x4 w; w.x = cvt_pk_bf16(a[base + 0], a[base + 1]); w.y = cvt_pk_bf16(a[base + 2], a[base + 3]); w.z = cvt_pk_bf16(a[base + 4], a[base + 5]); w.w = cvt_pk_bf16(a[base + 6], a[base + 7]);
    return *reinterpret_cast<sc_bf16x8*>(&w);
}
constexpr int SC_NSLOT = 9, SC_AHEAD = 7;
__device__ __forceinline__ void scan_chain_mfma(const Frame& F, unsigned char* ws, int chain) {
    const int h = chain >> 1, d = chain & 1, lane = F.lane, n = lane & 31, hi = lane >> 5, ib = F.wave;
    const unsigned char* FRc = ws + WS_FR + (size_t)chain * SC_NCHUNK * SC_CHUNK_BYTES;
    float* Yd = (float*)(ws + WS_Y) + (size_t)d * T * A_W + h * 64;
    LAS unsigned char* buf = F.lds;
    typedef __attribute__((address_space(3))) unsigned sc_lds_u32;
#define SCM_DMA(c_) do { if (ib < 7) { const unsigned char* src_ = FRc + (size_t)(c_) * SC_CHUNK_BYTES; LAS unsigned char* dst_ = buf + ((c_) % SC_NSLOT) * SC_CHUNK_BYTES; \
        _Pragma("unroll") for (int i_ = 0; i_ < 2; ++i_) __builtin_amdgcn_global_load_lds((const unsigned*)(src_ + (i_ * 7 + ib) * 1024 + lane * 16), (sc_lds_u32*)(dst_ + (i_ * 7 + ib) * 1024), 16, 0, 0); } } while (0)
    sc_f32x16 S0 = {}, S1 = {};
    int yoff[8];
#pragma unroll
    for (int r = 0; r < 8; ++r) { const int t = (r & 3) + 8 * (r >> 2) + 4 * hi; yoff[r] = (d ? -t : t) * A_W + 32 * ib + n; }
    __syncthreads();
#pragma unroll
    for (int c = 0; c < SC_AHEAD; ++c) SCM_DMA(c);
    asm volatile("s_waitcnt vmcnt(12)" ::: "memory"); __builtin_amdgcn_s_barrier(); asm volatile("" ::: "memory");
#pragma unroll 1
    for (int c = 0; c < SC_NCHUNK; ++c) {
        const bool steady = c + SC_AHEAD < SC_NCHUNK;
        if (steady) SCM_DMA(c + SC_AHEAD);
        if (ib < 2) {
                const LAS unsigned char* fb = buf + (c % SC_NSLOT) * SC_CHUNK_BYTES;
                sc_bf16x8 fr[11]; sc_bf16x8 vf; f32x4 gt[8];
                { const unsigned fa = (unsigned)(uintptr_t)fb + lane * 16, va = fa + (11 + ib) * 1024, ga = (unsigned)(uintptr_t)fb + 13 * 1024 + hi * 128;
#define SC_DSRD(dst, addr, off) asm volatile("ds_read_b128 %0, %1 offset:%2" : "=v"(dst) : "v"(addr), "i"(off))
                  SC_DSRD(fr[0], fa, 0); SC_DSRD(fr[1], fa, 1024); SC_DSRD(fr[2], fa, 2048); SC_DSRD(fr[3], fa, 3072); SC_DSRD(fr[4], fa, 4096); SC_DSRD(fr[5], fa, 5120);
                  SC_DSRD(fr[6], fa, 6144); SC_DSRD(fr[7], fa, 7168); SC_DSRD(fr[8], fa, 8192); SC_DSRD(fr[9], fa, 9216); SC_DSRD(fr[10], fa, 10240); SC_DSRD(vf, va, 0);
                  SC_DSRD(gt[0], ga, 0); SC_DSRD(gt[1], ga, 16); SC_DSRD(gt[2], ga, 32); SC_DSRD(gt[3], ga, 48); SC_DSRD(gt[4], ga, 64); SC_DSRD(gt[5], ga, 80); SC_DSRD(gt[6], ga, 96); SC_DSRD(gt[7], ga, 112);
#undef SC_DSRD
                  asm volatile("s_waitcnt lgkmcnt(0)" : "+v"(fr[0]), "+v"(fr[1]), "+v"(fr[2]), "+v"(fr[3]), "+v"(fr[4]), "+v"(fr[5]), "+v"(fr[6]), "+v"(fr[7]), "+v"(fr[8]), "+v"(fr[9]), "+v"(fr[10]), "+v"(vf) :: "memory");
                  asm volatile("" : "+v"(gt[0]), "+v"(gt[1]), "+v"(gt[2]), "+v"(gt[3]), "+v"(gt[4]), "+v"(gt[5]), "+v"(gt[6]), "+v"(gt[7])); }
                const sc_bf16x8 sb00 = sc_pack8(S0, 0), sb01 = sc_pack8(S0, 8), sb10 = sc_pack8(S1, 0), sb11 = sc_pack8(S1, 8);
                sc_f32x16 P = {}, P2 = {};
                P = __builtin_amdgcn_mfma_f32_32x32x16_bf16(fr[0], sb00, P, 0, 0, 0);
                P2 = __builtin_amdgcn_mfma_f32_32x32x16_bf16(fr[2], sb10, P2, 0, 0, 0);
                P = __builtin_amdgcn_mfma_f32_32x32x16_bf16(fr[1], sb01, P, 0, 0, 0);
                P2 = __builtin_amdgcn_mfma_f32_32x32x16_bf16(fr[3], sb11, P2, 0, 0, 0);
                P = __builtin_amdgcn_mfma_f32_32x32x16_bf16(fr[4], vf, P, 0, 0, 0);
#pragma unroll
                for (int q = 0; q < 4; ++q)
#pragma unroll
                    for (int e = 0; e < 4; ++e) { S0[4 * q + e] *= gt[q][e]; S1[4 * q + e] *= gt[4 + q][e]; }
                S0 = __builtin_amdgcn_mfma_f32_32x32x16_bf16(fr[8], vf, S0, 0, 0, 0);
                S1 = __builtin_amdgcn_mfma_f32_32x32x16_bf16(fr[10], vf, S1, 0, 0, 0);
#pragma unroll
                for (int r = 0; r < 16; ++r) P[r] += P2[r];
                const sc_bf16x8 xb = sc_pack8(P, 0);
                sc_f32x16 U = {};
                U = __builtin_amdgcn_mfma_f32_32x32x16_bf16(fr[5], xb, U, 0, 0, 0);
                const sc_bf16x8 ub = sc_pack8(U, 0);
                S0 = __builtin_amdgcn_mfma_f32_32x32x16_bf16(fr[7], ub, S0, 0, 0, 0);
                S1 = __builtin_amdgcn_mfma_f32_32x32x16_bf16(fr[9], ub, S1, 0, 0, 0);
                P = __builtin_amdgcn_mfma_f32_32x32x16_bf16(fr[6], ub, P, 0, 0, 0);
                float* yb = Yd + (size_t)sc_tau(d, c, 0) * A_W;
#pragma unroll
                for (int r = 0; r < 8; ++r) yb[yoff[r]] = P[8 + r];
        }
        if (steady) asm volatile("s_waitcnt vmcnt(12)" ::: "memory"); else asm volatile("s_waitcnt vmcnt(0)" ::: "memory");
        asm volatile("s_waitcnt lgkmcnt(0)" ::: "memory"); __builtin_amdgcn_s_barrier(); asm volatile("" ::: "memory");
    }
    asm volatile("s_waitcnt vmcnt(0)" ::: "memory"); __syncthreads();
#undef SCM_DMA
}
__device__ __forceinline__ float conv3_u(const float* PX, int tau, unsigned ucol, float w0, float w1, float w2) {
    const float* p = PX + (size_t)tau * PXW;
    float y = p[ucol] * w1;
    if (has_left(tau)) y += (p - PXW)[ucol] * w0;
    if (has_right(tau)) y += (p + PXW)[ucol] * w2;
    return y;
}
constexpr int WLR_K = 448;
constexpr int RP_WAVE_LDS = 16896;
typedef short rp_bf16x8 __attribute__((ext_vector_type(8)));
typedef float rp_f32x16 __attribute__((ext_vector_type(16)));
__device__ __forceinline__ unsigned short f2bf16(float x) { return (unsigned short)(cvt_pk_bf16(x, x) & 0xffffu); }
template <int NKB, class AF>
__device__ __forceinline__ void rp_lowrank(float (&dst)[16], const AF& afrag, const bf16_t* WLRh, int kw0, int n, int hi) {
    rp_f32x16 c0 = {}, c1 = {}; const bf16_t* wb0 = WLRh + (size_t)n * WLR_K + kw0 + 8 * hi; const bf16_t* wb1 = wb0 + (size_t)32 * WLR_K;
#pragma unroll
    for (int kb = 0; kb < NKB; ++kb) { const rp_bf16x8 b0 = *(const rp_bf16x8*)(wb0 + 16 * kb), b1 = *(const rp_bf16x8*)(wb1 + 16 * kb); const rp_bf16x8 a_ = afrag(kb);
        c0 = __builtin_amdgcn_mfma_f32_32x32x16_bf16(a_, b0, c0, 0, 0, 0); c1 = __builtin_amdgcn_mfma_f32_32x32x16_bf16(a_, b1, c1, 0, 0, 0); }
#pragma unroll
    for (int r = 0; r < 8; ++r) { auto sw = __builtin_amdgcn_permlane32_swap(__float_as_uint(c0[r]), __float_as_uint(c1[r]), false, false);
        dst[(r & 3) + 8 * (r >> 2)] = __uint_as_float(sw[0]); dst[(r & 3) + 8 * (r >> 2) + 4] = __uint_as_float(sw[1]); }
}
struct RpAfLds { const LAS bf16_t* base; __device__ __forceinline__ rp_bf16x8 operator()(int kb) const { return *(const LAS rp_bf16x8*)(base + 16 * kb); } };
__device__ __forceinline__ void rwkv_elem_phase(const Frame& F, unsigned char* ws, int l) {
    const float* PX = (const float*)(ws + WS_PX); float* SS = (float*)(ws + WS_SS); float* SD = (float*)(ws + WS_SD); float* GB = (float*)(ws + WS_G);
    const bf16_t* WLR = (const bf16_t*)(ws + WS_WLR) + (size_t)l * A_W * WLR_K;
    const float* cw = IN_(16) + (size_t)l * 3 * A_IN;
    LAS bf16_t* ACT = (LAS bf16_t*)(F.lds + F.wave * 10752);
    const int lane = F.lane, n = lane & 31, hi = lane >> 5;
    const int gw = F.bid * 8 + F.wave, NGW = F.G * 8;
    for (int it = gw; it < (T / 16) * 10; it += NGW) {
        const int tg = it / 10, hq = it % 10, tau0 = tg * 16;
        asm volatile("s_waitcnt lgkmcnt(0)" ::: "memory");
        const float* prow0 = PX + (size_t)(tau0 > 0 ? tau0 - 1 : 0) * PXW; const int roff = tau0 > 0 ? 0 : -1;
#define RP_WIN(x, ucol_) do { _Pragma("unroll") for (int i_ = 0; i_ < 18; ++i_) { int ri_ = i_ + roff; ri_ = ri_ < 0 ? 0 : ri_; ri_ = (tau0 - 1 + i_ > T - 1) ? (T - 1 - (tau0 > 0 ? tau0 - 1 : 0)) : ri_; x[i_] = (prow0 + (size_t)ri_ * PXW)[ucol_]; } } while (0)
#define RP_CONV(x, t_, w0_, w1_, w2_) (x[(t_)] * (has_left(tau0 + (t_)) ? (w0_) : 0.f) + x[(t_) + 1] * (w1_) + x[(t_) + 2] * (has_right(tau0 + (t_)) ? (w2_) : 0.f))
#pragma unroll
        for (int i = 0; i < 5; ++i) { const int c = lane + 64 * i, col = 3840 + c; const float c0 = cw[col], c1 = cw[A_IN + col], c2 = cw[2 * A_IN + col];
            float x[18]; RP_WIN(x, (unsigned)(PXA + col));
#pragma unroll
            for (int t = 0; t < 16; ++t) { const float val = RP_CONV(x, t, c0, c1, c2);
                const float act = i == 0 ? 1.0f - 2.0f / (1.0f + __expf(2.0f * val)) : (i == 1 ? val : sigmoidf_(val));
                ACT[t * 328 + c] = f2bf16(act); } }
        asm volatile("s_waitcnt lgkmcnt(0)" ::: "memory");
        const RpAfLds afw{ACT + (n & 15) * 328 + 8 * hi}, afa{ACT + (n & 15) * 328 + 64 + 8 * hi}, afg{ACT + (n & 15) * 328 + 128 + 8 * hi};
#pragma unroll 1
        for (int hh = 0; hh < 2; ++hh) {
            const int h = hq * 2 + hh, col = h * 64 + lane; const bf16_t* WLRh = WLR + (size_t)h * 64 * WLR_K;
            { float lg[16]; rp_lowrank<12>(lg, afg, WLRh, 256, n, hi);
#pragma unroll
              for (int t = 0; t < 16; ++t) GB[(size_t)(tau0 + t) * A_W + col] = lg[t]; }
            const float cr0 = cw[col], cr1 = cw[A_IN + col], cr2 = cw[2 * A_IN + col];
            const float ck0 = cw[A_W + col], ck1 = cw[A_IN + A_W + col], ck2 = cw[2 * A_IN + A_W + col];
            const float cv0 = cw[2 * A_W + col], cv1 = cw[A_IN + 2 * A_W + col], cv2 = cw[2 * A_IN + 2 * A_W + col];
            const float kk_w = IN_(22)[l * A_W + col], ka_w = IN_(23)[l * A_W + col];
            float kkv[16], kv[16];
            { float xr[18], xk[18], xv[18]; const unsigned uc = (unsigned)(PXA + col); RP_WIN(xr, uc); RP_WIN(xk, uc + A_W); RP_WIN(xv, uc + 2 * A_W);
#pragma unroll
              for (int t = 0; t < 16; ++t) { const int tau = tau0 + t;
                  const float r = RP_CONV(xr, t, cr0, cr1, cr2), v = RP_CONV(xv, t, cv0, cv1, cv2); kv[t] = RP_CONV(xk, t, ck0, ck1, ck2);
                  const float kr = kv[t] * kk_w; const float nrm = sqrtf(wave_sum(kr * kr)); kkv[t] = kr / fmaxf(nrm, 1e-12f);
                  float* ss = SS + ((size_t)h * T + tau) * 192 + lane; ss[0] = kkv[t]; ss[64] = r; ss[128] = v; } }
#pragma unroll 1
            for (int d = 0; d < 2; ++d) { const float w0b = IN_(17)[(l * 2 + d) * A_W + col], a0b = IN_(19)[(l * 2 + d) * A_W + col]; float lw[16], la[16];
                rp_lowrank<4>(lw, afw, WLRh, 64 * d, n, hi); rp_lowrank<4>(la, afa, WLRh, 128 + 64 * d, n, hi);
#pragma unroll
                for (int t = 0; t < 16; ++t) { const float z = w0b + lw[t]; const float decay = __expf(-__expf(-(fmaxf(-z, 0.f) + __logf(1.0f + __expf(-fabsf(z)))) - 0.5f)); const float av = sigmoidf_(a0b + la[t]);
                    float* sd = SD + (((size_t)h * 2 + d) * T + tau0 + t) * 192 + lane; sd[0] = decay; sd[64] = kkv[t] * av; sd[128] = kv[t] * (1.0f + (av - 1.0f) * ka_w); } }
        }
    }
}
#undef RP_WIN
#undef RP_CONV
constexpr int SP_WAVE_LDS = 16640;
__device__ __forceinline__ void scan_prep_phase(const Frame& F, unsigned char* ws) {
    const float* SS = (const float*)(ws + WS_SS); const float* SD = (const float*)(ws + WS_SD); unsigned char* FR = ws + WS_FR;
    LAS bf16_t* R1 = (LAS bf16_t*)(F.lds + F.wave * SP_WAVE_LDS); LAS bf16_t* R2 = R1 + 32 * 72; LAS bf16_t* BbT = R2 + 32 * 72; LAS bf16_t* KbT = BbT + 64 * 16; LAS bf16_t* VT = KbT + 64 * 16; LAS float* Lm = (LAS float*)(VT + 64 * 16);
    const int lane = F.lane, n = lane & 31, hi = lane >> 5;
    const int gw = F.bid * 8 + F.wave, NGW = F.G * 8;
    for (int it = gw; it < 2 * NHA * SC_NCHUNK; it += NGW) {
        const int chain = it / SC_NCHUNK, c = it % SC_NCHUNK, h = chain >> 1, d = chain & 1;
        const int tau_first = sc_tau(d, c, 0), dstep = d ? -1 : 1;
        const float* ssb = SS + (size_t)h * T * 192 + lane; const float* sdb = SD + ((size_t)h * 2 + d) * T * 192 + lane;
        float xw[16], xb[16], xk[16], xkk[16], xr[16], xv[16];
#pragma unroll
        for (int s = 0; s < 16; ++s) { const size_t o = (size_t)(tau_first + dstep * s) * 192; xw[s] = sdb[o]; xb[s] = sdb[o + 64]; xk[s] = sdb[o + 128]; xkk[s] = ssb[o]; xr[s] = ssb[o + 64]; xv[s] = ssb[o + 128]; }
        float gC = 1.f;
#pragma unroll
        for (int s = 0; s < 16; ++s) gC *= xw[s];
        float g = 1.f;
#pragma unroll
        for (int s = 0; s < 16; ++s) {
            const float gm1 = g; g *= xw[s]; const float ig = 1.0f / g; const float bh = xb[s] * ig, kh = xk[s] * ig;
            R1[s * 72 + lane] = f2bf16(-xkk[s] * gm1); R1[(16 + s) * 72 + lane] = f2bf16(xr[s] * g);
            R2[s * 72 + lane] = f2bf16(bh); R2[(16 + s) * 72 + lane] = f2bf16(kh);
            BbT[lane * 16 + s] = f2bf16(bh * gC); KbT[lane * 16 + s] = f2bf16(kh * gC); VT[lane * 16 + s] = f2bf16(xv[s]); }
        asm volatile("s_waitcnt lgkmcnt(0)" ::: "memory");
        unsigned char* dst = FR + ((size_t)chain * SC_NCHUNK + c) * SC_CHUNK_BYTES;
        rp_f32x16 C = {};
#pragma unroll
        for (int kb = 0; kb < 4; ++kb) { const rp_bf16x8 a_ = *(const LAS rp_bf16x8*)(R2 + n * 72 + 16 * kb + 8 * hi), b_ = *(const LAS rp_bf16x8*)(R1 + n * 72 + 16 * kb + 8 * hi);
            C = __builtin_amdgcn_mfma_f32_32x32x16_bf16(a_, b_, C, 0, 0, 0); }
        const int tt_ = n & 15; const bool incl = n >= 16;
#pragma unroll
        for (int r = 0; r < 16; ++r) { const int s = ((r & 7) & 3) + 8 * ((r & 7) >> 2) + 4 * hi; if (!(s < tt_ || (incl && s == tt_))) C[r] = 0.f; }
        if (n < 16) {
#pragma unroll
            for (int r = 0; r < 8; ++r) Lm[((r & 3) + 8 * (r >> 2) + 4 * hi) * 20 + n] = C[r]; }
        { u32x4 f4; f4.x = cvt_pk_bf16(C[8], C[9]); f4.y = cvt_pk_bf16(C[10], C[11]); f4.z = cvt_pk_bf16(C[12], C[13]); f4.w = cvt_pk_bf16(C[14], C[15]);
          u32x4 f6; f6.x = cvt_pk_bf16(C[0], C[1]); f6.y = cvt_pk_bf16(C[2], C[3]); f6.z = cvt_pk_bf16(C[4], C[5]); f6.w = cvt_pk_bf16(C[6], C[7]);
          if (n < 16) f6 = (u32x4){0u, 0u, 0u, 0u};
          *(u32x4*)(dst + 4 * 1024 + lane * 16) = f4; *(u32x4*)(dst + 6 * 1024 + lane * 16) = f6; }
        asm volatile("s_waitcnt lgkmcnt(0)" ::: "memory");
        { float Tc[16];
#pragma unroll
          for (int s = 15; s >= 0; --s) { float acc = (s == n) ? 1.f : 0.f;
#pragma unroll
              for (int u = s + 1; u < 16; ++u) acc += Lm[s * 20 + u] * Tc[u];
              Tc[s] = acc; }
          u32x4 f5; f5.x = cvt_pk_bf16(hi ? Tc[4] : Tc[0], hi ? Tc[5] : Tc[1]); f5.y = cvt_pk_bf16(hi ? Tc[6] : Tc[2], hi ? Tc[7] : Tc[3]);
          f5.z = cvt_pk_bf16(hi ? Tc[12] : Tc[8], hi ? Tc[13] : Tc[9]); f5.w = cvt_pk_bf16(hi ? Tc[14] : Tc[10], hi ? Tc[15] : Tc[11]);
          if (n >= 16) f5 = (u32x4){0u, 0u, 0u, 0u};
          *(u32x4*)(dst + 5 * 1024 + lane * 16) = f5; }
#pragma unroll
        for (int f = 0; f < 4; ++f) { const u32x2 p0 = *(const LAS u32x2*)(R1 + n * 72 + 16 * f + 4 * hi), p1 = *(const LAS u32x2*)(R1 + n * 72 + 16 * f + 8 + 4 * hi);
            *(u32x4*)(dst + f * 1024 + lane * 16) = (u32x4){p0.x, p0.y, p1.x, p1.y}; }
#pragma unroll
        for (int jb = 0; jb < 2; ++jb) { const int row = 32 * jb + n;
            const u32x2 b0 = *(const LAS u32x2*)(BbT + row * 16 + 4 * hi), b1 = *(const LAS u32x2*)(BbT + row * 16 + 8 + 4 * hi), k0 = *(const LAS u32x2*)(KbT + row * 16 + 4 * hi), k1 = *(const LAS u32x2*)(KbT + row * 16 + 8 + 4 * hi);
            const u32x2 v0 = *(const LAS u32x2*)(VT + row * 16 + 4 * hi), v1 = *(const LAS u32x2*)(VT + row * 16 + 8 + 4 * hi);
            *(u32x4*)(dst + (7 + 2 * jb) * 1024 + lane * 16) = (u32x4){b0.x, b0.y, b1.x, b1.y}; *(u32x4*)(dst + (8 + 2 * jb) * 1024 + lane * 16) = (u32x4){k0.x, k0.y, k1.x, k1.y};
            *(u32x4*)(dst + (11 + jb) * 1024 + lane * 16) = (u32x4){v0.x, v0.y, v1.x, v1.y}; }
        { const int jj = lane & 31; ((float*)(dst + 13 * 1024))[((jj >> 2) & 1) * 32 + (lane >> 5) * 16 + (jj & 3) + 4 * (jj >> 3)] = gC; }
        asm volatile("s_waitcnt lgkmcnt(0)" ::: "memory");
    }
}
constexpr int RF_ACT_BYTES = 16 * 320 * 2;
__device__ __forceinline__ void rwkv_fused_phase(const Frame& F, unsigned char* ws, int l) {
    const bf16_t* PX = (const bf16_t*)(ws + WS_PX); unsigned char* FR = ws + WS_FR;
    float* GB = (float*)(ws + WS_G); float* VB = (float*)(ws + WS_SS) + (size_t)T * A_W; float* BS = (float*)(ws + WS_SD);
    const bf16_t* WLR = (const bf16_t*)(ws + WS_WLR) + (size_t)l * A_W * WLR_K;
    const float* cw = IN_(16) + (size_t)l * 3 * A_IN;
    LAS bf16_t* ACT = (LAS bf16_t*)F.lds;
    LAS bf16_t* R1 = (LAS bf16_t*)(F.lds + RF_ACT_BYTES + F.wave * SP_WAVE_LDS); LAS bf16_t* R2 = R1 + 32 * 72; LAS bf16_t* BbT = R2 + 32 * 72; LAS bf16_t* KbT = BbT + 64 * 16; LAS bf16_t* VT = KbT + 64 * 16; LAS float* Lm = (LAS float*)(VT + 64 * 16);
    const int lane = F.lane, n = lane & 31, hi = lane >> 5, hh = F.wave >> 1, d = F.wave & 1;
    for (int it = F.bid; it < (T / 16) * 5; it += F.G) {
        const int tg = it / 5, hg = it % 5, tau0 = tg * 16, h = hg * 4 + hh, col = h * 64 + lane;
        const bf16_t* prow0 = PX + (size_t)(tau0 > 0 ? tau0 - 1 : 0) * PXW; const int roff = tau0 > 0 ? 0 : -1;
#define RP_WIN(x, ucol_) do { _Pragma("unroll") for (int i_ = 0; i_ < 18; ++i_) { int ri_ = i_ + roff; ri_ = ri_ < 0 ? 0 : ri_; ri_ = (tau0 - 1 + i_ > T - 1) ? (T - 1 - (tau0 > 0 ? tau0 - 1 : 0)) : ri_; x[i_] = bf2f((prow0 + (size_t)ri_ * PXW)[ucol_]); } } while (0)
#define RP_CONV(x, t_, w0_, w1_, w2_) (x[(t_)] * (has_left(tau0 + (t_)) ? (w0_) : 0.f) + x[(t_) + 1] * (w1_) + x[(t_) + 2] * (has_right(tau0 + (t_)) ? (w2_) : 0.f))
        float wr_[18], wk_[18], wv_[18]; { const unsigned uc = (unsigned)(PXA + col); RP_WIN(wr_, uc); RP_WIN(wk_, uc + A_W); RP_WIN(wv_, uc + 2 * A_W); }
        const float cr0 = cw[col], cr1 = cw[A_IN + col], cr2 = cw[2 * A_IN + col], ck0 = cw[A_W + col], ck1 = cw[A_IN + A_W + col], ck2 = cw[2 * A_IN + A_W + col];
        const float cv0 = cw[2 * A_W + col], cv1 = cw[A_IN + 2 * A_W + col], cv2 = cw[2 * A_IN + 2 * A_W + col], kk_w = IN_(22)[l * A_W + col];
        __syncthreads();
        { int tq = F.tid; asm volatile("" : "+v"(tq));
#pragma unroll
          for (int i = 0; i < 3; ++i) { const int item = tq + 512 * i;
              if (item < 16 * 80) { const int t = item / 80, c = 4 * (item % 80), cc = 3840 + c, tau = tau0 + t;
                  const bf16_t* p = PX + (size_t)tau * PXW + PXA + cc; const bool hl = has_left(tau), hr = has_right(tau);
                  const f32x4 x1 = bf4f(*(const u32x2*)p), x0 = bf4f(*(const u32x2*)(p - (hl ? PXW : 0))), x2 = bf4f(*(const u32x2*)(p + (hr ? PXW : 0)));
                  const f32x4 w0 = *(const f32x4*)(cw + cc), w1 = *(const f32x4*)(cw + A_IN + cc), w2 = *(const f32x4*)(cw + 2 * A_IN + cc);
                  const f32x4 val = x1 * w1 + x0 * (w0 * (hl ? 1.f : 0.f)) + x2 * (w2 * (hr ? 1.f : 0.f));
                  f32x4 act;
#pragma unroll
                  for (int e = 0; e < 4; ++e) act[e] = c < 64 ? 1.0f - 2.0f / (1.0f + __expf(2.0f * val[e])) : (c < 128 ? val[e] : sigmoidf_(val[e]));
                  u32x2 o; o.x = cvt_pk_bf16(act.x, act.y); o.y = cvt_pk_bf16(act.z, act.w);
                  *(LAS u32x2*)(ACT + t * 320 + c) = o; } } }
        __syncthreads();
        const bf16_t* WLRh = WLR + (size_t)h * 64 * WLR_K;
        const RpAfLds afw{ACT + (n & 15) * 320 + 8 * hi}, afa{ACT + (n & 15) * 320 + 64 + 8 * hi}, afg{ACT + (n & 15) * 320 + 128 + 8 * hi};
        float xw[16], xb[16], xk[16], xkk[16], xr[16], xv[16];
        {
          if (d == 0) { float lg[16]; rp_lowrank<12>(lg, afg, WLRh, 256, n, hi);
#pragma unroll
              for (int t = 0; t < 16; ++t) GB[(size_t)(tau0 + t) * A_W + col] = lg[t]; }
#pragma unroll
          for (int t = 0; t < 16; ++t) { xr[t] = RP_CONV(wr_, t, cr0, cr1, cr2); xv[t] = RP_CONV(wv_, t, cv0, cv1, cv2); xk[t] = RP_CONV(wk_, t, ck0, ck1, ck2);
              const float kr = xk[t] * kk_w; const float nrm = sqrtf(wave_sum(kr * kr)); xkk[t] = kr / fmaxf(nrm, 1e-12f); } }
        if (d == 0) {
#pragma unroll
            for (int t = 0; t < 16; ++t) VB[(size_t)(tau0 + t) * A_W + col] = xv[t]; }
        { const float ka_w = IN_(23)[l * A_W + col], w0b = IN_(17)[(l * 2 + d) * A_W + col], a0b = IN_(19)[(l * 2 + d) * A_W + col]; float la[16];
          rp_lowrank<4>(xw, afw, WLRh, 64 * d, n, hi); rp_lowrank<4>(la, afa, WLRh, 128 + 64 * d, n, hi);
#pragma unroll
          for (int t = 0; t < 16; ++t) { const float z = w0b + xw[t]; xw[t] = __expf(-__expf(-(fmaxf(-z, 0.f) + __logf(1.0f + __expf(-fabsf(z)))) - 0.5f)); const float av = sigmoidf_(a0b + la[t]);
              xb[t] = xkk[t] * av; xk[t] = xk[t] * (1.0f + (av - 1.0f) * ka_w); }
          { const float rk_w = IN_(24)[l * A_W + col]; float pr[16];
#pragma unroll
            for (int t = 0; t < 16; ++t) pr[t] = xr[t] * xk[t] * rk_w;
            const float sb = wave_sum16(pr, lane);
            if ((lane & 3) == 0) BS[((size_t)d * T + tau0 + (lane >> 2)) * NHA + h] = sb; } }
        if (d) {
#pragma unroll
            for (int s = 0; s < 8; ++s) { float t_;
                t_ = xw[s]; xw[s] = xw[15 - s]; xw[15 - s] = t_; t_ = xb[s]; xb[s] = xb[15 - s]; xb[15 - s] = t_; t_ = xk[s]; xk[s] = xk[15 - s]; xk[15 - s] = t_;
                t_ = xkk[s]; xkk[s] = xkk[15 - s]; xkk[15 - s] = t_; t_ = xr[s]; xr[s] = xr[15 - s]; xr[15 - s] = t_; t_ = xv[s]; xv[s] = xv[15 - s]; xv[15 - s] = t_; } }
        const int c = d == 0 ? tg : (tg < NCTX / 16 ? NCTX / 16 - 1 - tg : NCTX / 16 + (T / 16 - 1) - tg);
        float gC = 1.f;
#pragma unroll
        for (int s = 0; s < 16; ++s) gC *= xw[s];
        float g = 1.f;
#pragma unroll
        for (int s = 0; s < 16; ++s) {
            const float gm1 = g; g *= xw[s]; const float ig = 1.0f / g; const float bh = xb[s] * ig, kh = xk[s] * ig;
            R1[s * 72 + lane] = f2bf16(-xkk[s] * gm1); R1[(16 + s) * 72 + lane] = f2bf16(xr[s] * g);
            R2[s * 72 + lane] = f2bf16(bh); R2[(16 + s) * 72 + lane] = f2bf16(kh);
            xb[s] = bh * gC; xk[s] = kh * gC; }
        asm volatile("s_waitcnt lgkmcnt(0)" ::: "memory");
        unsigned char* dst = FR + ((size_t)(h * 2 + d) * SC_NCHUNK + c) * SC_CHUNK_BYTES;
        rp_f32x16 C = {};
#pragma unroll
        for (int kb = 0; kb < 4; ++kb) { const rp_bf16x8 a_ = *(const LAS rp_bf16x8*)(R2 + n * 72 + 16 * kb + 8 * hi), b_ = *(const LAS rp_bf16x8*)(R1 + n * 72 + 16 * kb + 8 * hi);
            C = __builtin_amdgcn_mfma_f32_32x32x16_bf16(a_, b_, C, 0, 0, 0); }
        const int tt_ = n & 15; const bool incl = n >= 16;
#pragma unroll
        for (int r = 0; r < 16; ++r) { const int s = ((r & 7) & 3) + 8 * ((r & 7) >> 2) + 4 * hi; if (!(s < tt_ || (incl && s == tt_))) C[r] = 0.f; }
        if (n < 16) {
#pragma unroll
            for (int r = 0; r < 8; ++r) Lm[((r & 3) + 8 * (r >> 2) + 4 * hi) * 20 + n] = C[r]; }
        { u32x4 f4; f4.x = cvt_pk_bf16(C[8], C[9]); f4.y = cvt_pk_bf16(C[10], C[11]); f4.z = cvt_pk_bf16(C[12], C[13]); f4.w = cvt_pk_bf16(C[14], C[15]);
          u32x4 f6; f6.x = cvt_pk_bf16(C[0], C[1]); f6.y = cvt_pk_bf16(C[2], C[3]); f6.z = cvt_pk_bf16(C[4], C[5]); f6.w = cvt_pk_bf16(C[6], C[7]);
          if (n < 16) f6 = (u32x4){0u, 0u, 0u, 0u};
          *(u32x4*)(dst + 4 * 1024 + lane * 16) = f4; *(u32x4*)(dst + 6 * 1024 + lane * 16) = f6; }
        asm volatile("s_waitcnt lgkmcnt(0)" ::: "memory");
        { float Tc[16];
#pragma unroll
          for (int s = 15; s >= 0; --s) { float acc = (s == n) ? 1.f : 0.f;
#pragma unroll
              for (int u = s + 1; u < 16; ++u) acc += Lm[s * 20 + u] * Tc[u];
              Tc[s] = acc; }
          u32x4 f5; f5.x = cvt_pk_bf16(hi ? Tc[4] : Tc[0], hi ? Tc[5] : Tc[1]); f5.y = cvt_pk_bf16(hi ? Tc[6] : Tc[2], hi ? Tc[7] : Tc[3]);
          f5.z = cvt_pk_bf16(hi ? Tc[12] : Tc[8], hi ? Tc[13] : Tc[9]); f5.w = cvt_pk_bf16(hi ? Tc[14] : Tc[10], hi ? Tc[15] : Tc[11]);
          if (n >= 16) f5 = (u32x4){0u, 0u, 0u, 0u};
          *(u32x4*)(dst + 5 * 1024 + lane * 16) = f5; }
#pragma unroll
        for (int f = 0; f < 4; ++f) { const u32x2 p0 = *(const LAS u32x2*)(R1 + n * 72 + 16 * f + 4 * hi), p1 = *(const LAS u32x2*)(R1 + n * 72 + 16 * f + 8 + 4 * hi);
            *(u32x4*)(dst + f * 1024 + lane * 16) = (u32x4){p0.x, p0.y, p1.x, p1.y}; }
#define RF_FRAG(x_, fa_, fb_) do { unsigned pk_[8]; _Pragma("unroll") for (int m_ = 0; m_ < 8; ++m_) pk_[m_] = cvt_pk_bf16(x_[2 * m_], x_[2 * m_ + 1]); \
            const bool h1_ = hi != 0; const u32x4 own_ = {h1_ ? pk_[2] : pk_[0], h1_ ? pk_[3] : pk_[1], h1_ ? pk_[6] : pk_[4], h1_ ? pk_[7] : pk_[5]}; \
            u32x4 rcv_ = {h1_ ? pk_[0] : pk_[2], h1_ ? pk_[1] : pk_[3], h1_ ? pk_[4] : pk_[6], h1_ ? pk_[5] : pk_[7]}; \
            rcv_.x = __shfl_xor(rcv_.x, 32); rcv_.y = __shfl_xor(rcv_.y, 32); rcv_.z = __shfl_xor(rcv_.z, 32); rcv_.w = __shfl_xor(rcv_.w, 32); \
            *(u32x4*)(dst + (fa_) * 1024 + lane * 16) = h1_ ? rcv_ : own_; *(u32x4*)(dst + (fb_) * 1024 + lane * 16) = h1_ ? own_ : rcv_; } while (0)
        RF_FRAG(xb, 7, 9); RF_FRAG(xk, 8, 10); RF_FRAG(xv, 11, 12);
#undef RF_FRAG
        { const int jj = lane & 31; ((float*)(dst + 13 * 1024))[((jj >> 2) & 1) * 32 + (lane >> 5) * 16 + (jj & 3) + 4 * (jj >> 3)] = gC; }
        asm volatile("s_waitcnt lgkmcnt(0)" ::: "memory");
    }
#undef RP_WIN
#undef RP_CONV
}
__device__ __forceinline__ void mixer_phase(const Frame& F0, unsigned char* ws0, int lq, bool need_ctx, char* lds_g) {
    const int l = lq & 3;
#ifndef MK_MIX
#define MK_MIX 15
#endif
    { const Frame F = opq(F0); unsigned char* ws = opq_ptr(ws0);
      if (MK_MIX & 1) for (int chain = F.bid; chain < 2 * NHA; chain += F.G) scan_chain_mfma(F, ws, chain); }
    const Frame& F = F0;
    const int n_xa = 32 * NHC, n_ca = need_ctx ? NHC : 0, n_att = n_xa + n_ca, n_hy = 640, n_ch = need_ctx ? 160 : 0;
    unsigned* qatt = (unsigned*)(ws0 + WS_CTL) + CW_QUEUE + 64 * lq; unsigned* qhy = qatt + 32;
    int item;
#define MIX_POP(q) do { if (F.tid == 0) F.MISC[16] = __hip_atomic_fetch_add((q), 1u, __ATOMIC_RELAXED, __HIP_MEMORY_SCOPE_AGENT); __syncthreads(); item = (int)F.MISC[16]; __syncthreads(); } while (0)
    if (F.bid >= 2 * NHA) {
        MIX_POP(qatt);
        while (item < n_att) {
            if (MK_MIX & 2) { unsigned char* ws = opq_ptr(ws0);
                const bf16_t* QF = (const bf16_t*)(ws + WS_QF); const bf16_t* KF = (const bf16_t*)(ws + WS_KF); const bf16_t* KVRAW = (const bf16_t*)(ws + WS_KVRAW); bf16_t* OB = (bf16_t*)(ws + WS_OBUF);
                const bool is_xa = item < n_xa; const int h = is_xa ? item % NHC : item - n_xa, row0 = is_xa ? NCTX + (item / NHC) * 256 : 0;
                for (int rp = 0; rp < REP(13); ++rp) att::attn_body(QF + (size_t)row0 * NQ + h * 192, KF + h * 192, KVRAW + h * 256 + 128, OB + (size_t)row0 * DM + 2560 + h * 128, is_xa ? T : NCTX, lds_g); }
            MIX_POP(qatt);
        }
    }
    MIX_POP(qhy);
    while (item < n_hy + n_ch) {
        const Frame Fu = opq(F0); unsigned char* ws = opq_ptr(ws0);
        if ((MK_MIX & 4) && item < n_hy) hyena_unit(Fu, ws, l, item);
        else if ((MK_MIX & 8) && item >= n_hy) hyena_ctx_unit(Fu, ws, l, item - n_hy);
        MIX_POP(qhy);
    }
#undef MIX_POP
}

__device__ __forceinline__ void hyena_taps_tail(const Frame& F0, unsigned char* ws0, int lt, int first, int end) {
    if (F0.bid < 48) return;
#pragma unroll 1
    for (int p = first + F0.bid - 48; p < end; p += 208) hyena_taps_unit(opq(F0), opq_ptr(ws0), lt, p);
}
constexpr int NPH = 2 + 14 * NL;
__global__ void __launch_bounds__(512, 2) mk_fwd(Args a) {
    extern __shared__ __attribute__((aligned(16))) unsigned char lds[];
    Frame F; F.lds = (LAS unsigned char*)lds; F.MISC = (volatile LAS unsigned*)(F.lds + LDS_MISC);
    F.tid = threadIdx.x; F.lane = F.tid & 63; F.wave = __builtin_amdgcn_readfirstlane(F.tid >> 6); F.bid = blockIdx.x; F.G = gridDim.x;
    if (F.tid < 64) F.MISC[F.tid] = 0u;
    if (F.tid < 46) *(LAS unsigned long long*)(F.lds + LDS_PTAB + 8 * F.tid) = (unsigned long long)(uintptr_t)a.in[F.tid];
    __syncthreads();
    unsigned char* ws = a.ws;
    const int lo = a.ph_lo, hi = a.ph_hi;
    XcdBarrier bar = xcd_barrier_post((unsigned*)(ws + WS_CTL) + CW_BAR, F.MISC + 8);
#ifndef MK_MASK
#define MK_MASK 0xffff
#endif
#define EN(x) (((MK_MASK) >> (x)) & 1)
#define IN(k) (lo <= (k) && (k) < hi)
#define SEAM(k) do { if (IN(k) && IN((k) + 1)) xcd_barrier(bar); } while (0)
#define WSP opq_ptr(ws)
#define P_XS(w) ((float*)((w) + WS_XS))
#define P_ABUF(w) ((bf16_t*)((w) + WS_ABUF))
#define P_HBUF(w) ((bf16_t*)((w) + WS_HBUF))
#define P_OBUF(w) ((bf16_t*)((w) + WS_OBUF))
#define P_MODX(w, l) ((const float*)((w) + WS_MOD) + ((size_t)(l) * 2 + 0) * NMOD)
#define P_MODC(w, l) ((const float*)((w) + WS_MOD) + ((size_t)(l) * 2 + 1) * NMOD)
#define P_WL(w, l) ((const bf16_t*)((w) + WS_WB) + (size_t)(l) * W_LAYER)
    if (EN(0) && IN(0)) for (int rp = 0; rp < REP(0); ++rp) phase0(opq(F), opq_ptr(ws));
    SEAM(0);
    if (EN(1) && IN(1)) phase_mod(opq(F), opq_ptr(ws));
    SEAM(1);
#pragma clang loop unroll(full)
    for (int l = 0; l < NL; ++l) {
        const int pb = 2 + 14 * l; const bool need_ctx = l < NL - 1;
        if (EN(2) && IN(pb + 0)) for (int rp = 0; rp < REP(2); ++rp) { unsigned char* w = WSP; norm_phase(opq(F), P_XS(w), IN_(7) + l * DM, P_MODX(w, l), P_MODC(w, l), 0, 1, P_ABUF(w), l > 0 ? (const bf16_t*)(w + WS_SLAB) : nullptr, l > 0 ? P_MODC(w, l - 1) + 8 * DM : nullptr, 0.5f, l == 0 ? IN_(0) - (size_t)NCTX * DM : (const float*)P_XS(w)); }
        SEAM(pb + 0);
        if (EN(3) && IN(pb + 1)) { unsigned char* w = WSP; pg8::Gemm g{P_ABUF(w), P_WL(w, l) + W_G1, T, 2 * FF, DM, DM}; pg8::StaticOrder S; S.init(T, 2 * FF, F.G, F.bid); pg8::EpiSwiGLU E{P_HBUF(w), FF};
            pg8::gemm_phase<pg8::EpiSwiGLU, pg8::StaticOrder>(F.lds, g, S, E, nullptr);
            hyena_taps_tail(F, ws, l, 0, l == 0 ? 640 : 416); }
        SEAM(pb + 1);
        if (EN(4) && IN(pb + 2)) {
            { unsigned char* w = WSP; pg8::Gemm g{P_HBUF(w), P_WL(w, l) + W_D1, T, DM, FF, FF}; pg8::StaticOrderX S; S.init(T, DM, F.G, F.bid); pg8::EpiResid E{P_XS(w), P_MODX(w, l) + 2 * DM, P_MODC(w, l) + 2 * DM, 0.5f, nullptr, l == 0 ? IN_(0) : nullptr};
              pg8::gemm_phase<pg8::EpiResid, pg8::StaticOrderX>(F.lds, g, S, E, nullptr); }
            if (true) { __syncthreads();
              if (F.bid < 256) { unsigned char* w = WSP; const int ks = F.bid >> 4, ksz = FF / 16; pg8::Gemm g{P_HBUF(w) + ks * ksz, P_WL(w, l) + W_D1 + ks * ksz, NCTX, DM, ksz, FF}; pg8::OneUnit S{F.bid & 15};
                  pg8::EpiBf16<0> E{(bf16_t*)(w + WS_SLAB) + (size_t)ks * NCTX * DM, DM, nullptr, 0, 0};
                  pg8::gemm_phase<pg8::EpiBf16<0>, pg8::OneUnit>(F.lds, g, S, E, nullptr); } }
        }
        SEAM(pb + 2);
        if (EN(5) && IN(pb + 3)) for (int rp = 0; rp < REP(2); ++rp) { unsigned char* w = WSP; norm_phase(opq(F), P_XS(w), IN_(8) + l * DM, P_MODX(w, l), P_MODC(w, l), 3, 4, P_ABUF(w), (const bf16_t*)(w + WS_SLAB), P_MODC(w, l) + 2 * DM, 0.5f, P_XS(w)); }
        SEAM(pb + 3);
        if (EN(6) && IN(pb + 4)) { unsigned char* w = WSP; pg8::Gemm g{P_ABUF(w), P_WL(w, l) + W_IN, T, PXW, DM, DM}; pg8::StaticOrder S; S.init(T, PXW, F.G, F.bid); pg8::EpiBf16<0> E{(bf16_t*)(w + WS_PX), PXW, nullptr, 0, 0};
            pg8::gemm_phase<pg8::EpiBf16<0>, pg8::StaticOrder>(F.lds, g, S, E, nullptr); }
        SEAM(pb + 4);
        if (EN(7) && IN(pb + 5)) { for (int rp = 0; rp < REP(7); ++rp) rwkv_fused_phase(opq(F), opq_ptr(ws), l); if (!(MK_ONLYRP)) { for (int rp = 0; rp < REP(8); ++rp) mla_prep_phase(opq(F), opq_ptr(ws), l); hyena_prep_phase(opq(F), opq_ptr(ws), l); } }
        SEAM(pb + 5);
        if (EN(8) && IN(pb + 6)) {
            { unsigned char* w = WSP; pg8::Gemm g{(const bf16_t*)(w + WS_QA), P_WL(w, l) + W_Q, T, NQ, 1024, 1024}; pg8::StaticOrder S; S.init(T, NQ, F.G, F.bid); pg8::EpiBf16<0> E{(bf16_t*)(w + WS_QRAW), NQ, nullptr, 0, 0};
              pg8::gemm_phase<pg8::EpiBf16<0>, pg8::StaticOrder>(F.lds, g, S, E, nullptr); }
            __syncthreads();
            { unsigned char* w = WSP; pg8::Gemm g{(const bf16_t*)(w + WS_KVA), P_WL(w, l) + W_KV, T, NKV, 512, 512}; pg8::StaticOrder S; S.init(T, NKV, F.G, (F.bid + 208) & 255);     pg8::EpiBf16<0> E{(bf16_t*)(w + WS_KVRAW), NKV, nullptr, 0, 0};
              pg8::gemm_phase<pg8::EpiBf16<0>, pg8::StaticOrder>(F.lds, g, S, E, nullptr); }
        }
        SEAM(pb + 6);
        if (EN(9) && IN(pb + 7)) { for (int rp = 0; rp < REP(8); ++rp) qkv_final_phase(opq(F), opq_ptr(ws), l, need_ctx); }
        SEAM(pb + 7);
        if (EN(10) && IN(pb + 8)) for (int rp = 0; rp < REP(10); ++rp) mixer_phase(F, ws, l + 4 * rp, need_ctx, (char*)lds);
        SEAM(pb + 8);
        if (EN(11) && IN(pb + 9)) { for (int rp = 0; rp < REP(8); ++rp) rwkv_out_phase(opq(F), opq_ptr(ws), l, need_ctx); hyena_out_phase(opq(F), opq_ptr(ws), need_ctx); }
        SEAM(pb + 9);
        if (EN(12) && IN(pb + 10)) {
            { unsigned char* w = WSP; pg8::Gemm g{P_OBUF(w), P_WL(w, l) + W_OUT, T, DM, DM, DM}; pg8::StaticOrderX S; S.init(T, DM, F.G, F.bid); pg8::EpiResid E{P_XS(w), P_MODX(w, l) + 5 * DM, P_MODC(w, l) + 5 * DM, 1.0f, nullptr, nullptr};
              pg8::gemm_phase<pg8::EpiResid, pg8::StaticOrderX>(F.lds, g, S, E, nullptr); }
            if (need_ctx) { __syncthreads();
              if (F.bid < 256) { unsigned char* w = WSP; const int ks = F.bid >> 4, ksz = DM / 16; pg8::Gemm g{P_OBUF(w) + ks * ksz, P_WL(w, l) + W_OUT + ks * ksz, NCTX, DM, ksz, DM}; pg8::OneUnit S{F.bid & 15};
                  pg8::EpiBf16<0> E{(bf16_t*)(w + WS_SLAB) + (size_t)ks * NCTX * DM, DM, nullptr, 0, 0};
                  pg8::gemm_phase<pg8::EpiBf16<0>, pg8::OneUnit>(F.lds, g, S, E, nullptr); } }
        }
        SEAM(pb + 10);
        if (EN(13) && IN(pb + 11)) for (int rp = 0; rp < REP(2); ++rp) { unsigned char* w = WSP; norm_phase(opq(F), P_XS(w), IN_(9) + l * DM, P_MODX(w, l), P_MODC(w, l), 6, 7, P_ABUF(w), need_ctx ? (const bf16_t*)(w + WS_SLAB) : nullptr, P_MODC(w, l) + 5 * DM, 1.0f, P_XS(w)); }
        SEAM(pb + 11);
        if (EN(14) && IN(pb + 12)) { if (need_ctx) { unsigned char* w = WSP; pg8::Gemm g{P_ABUF(w), P_WL(w, l) + W_G2, T, 2 * FF, DM, DM}; pg8::StaticOrder S; S.init(T, 2 * FF, F.G, F.bid); pg8::EpiSwiGLU E{P_HBUF(w), FF};
            pg8::gemm_phase<pg8::EpiSwiGLU, pg8::StaticOrder>(F.lds, g, S, E, nullptr);
            hyena_taps_tail(F, ws, l + 1, 416, 640); }       else { unsigned char* w = WSP; pg8::Gemm g{P_ABUF(w), P_WL(w, l) + W_G2, T, 2 * FF, DM, DM}; pg8::StaticOrderX S; S.init(T, 2 * FF, F.G, F.bid); pg8::EpiSwiGLU E{P_HBUF(w), FF};
            pg8::gemm_phase<pg8::EpiSwiGLU, pg8::StaticOrderX>(F.lds, g, S, E, nullptr); } }
        SEAM(pb + 12);
        if (EN(15) && IN(pb + 13)) {
            { unsigned char* w = WSP; pg8::Gemm g{P_HBUF(w), P_WL(w, l) + W_D2, T, DM, FF, FF}; pg8::StaticOrderX S; S.init(T, DM, F.G, F.bid); pg8::EpiResid E{P_XS(w), P_MODX(w, l) + 8 * DM, P_MODC(w, l) + 8 * DM, 0.5f, l == NL - 1 ? a.out : nullptr, nullptr};
              pg8::gemm_phase<pg8::EpiResid, pg8::StaticOrderX>(F.lds, g, S, E, nullptr); }
            if (need_ctx) { __syncthreads();
              if (F.bid < 256) { unsigned char* w = WSP; const int ks = F.bid >> 4, ksz = FF / 16; pg8::Gemm g{P_HBUF(w) + ks * ksz, P_WL(w, l) + W_D2 + ks * ksz, NCTX, DM, ksz, FF}; pg8::OneUnit S{F.bid & 15};
                  pg8::EpiBf16<0> E{(bf16_t*)(w + WS_SLAB) + (size_t)ks * NCTX * DM, DM, nullptr, 0, 0};
                  pg8::gemm_phase<pg8::EpiBf16<0>, pg8::OneUnit>(F.lds, g, S, E, nullptr); } }
        }
        SEAM(pb + 13);
    }
#undef IN
#undef SEAM
}

#ifndef MK_LAUNCHES
#define MK_LAUNCHES 1
#endif
extern "C" void kernel_launch(void* const* d_in, const int* in_sizes, int n_in, void* d_out, int out_size, void* d_ws, size_t ws_size, hipStream_t stream) {
    static int grid = 0;
    if (grid == 0) {
        if (n_in != 46 || in_sizes[0] != SEQ * DM || out_size != SEQ * DM || ws_size < WS_END) {
            fprintf(stderr, "kernel_launch: shape mismatch: n_in %d in0 %d out %d ws %zu (need %zu); nothing launched\n", n_in, n_in > 0 ? in_sizes[0] : -1, out_size, ws_size, (size_t)WS_END); grid = -1; return; }
        int dev = 0, cus = 0, per_cu = 0;
        if (hipGetDevice(&dev) != hipSuccess || hipDeviceGetAttribute(&cus, hipDeviceAttributeMultiprocessorCount, dev) != hipSuccess) { fprintf(stderr, "kernel_launch: device query failed\n"); grid = -1; return; }
        if (hipFuncSetAttribute((const void*)mk_fwd, hipFuncAttributeMaxDynamicSharedMemorySize, LDS_BYTES) != hipSuccess) { fprintf(stderr, "kernel_launch: hipFuncSetAttribute failed\n"); grid = -1; return; }
        if (hipOccupancyMaxActiveBlocksPerMultiprocessor(&per_cu, (const void*)mk_fwd, 512, LDS_BYTES) != hipSuccess || per_cu < 1) fprintf(stderr, "kernel_launch: note: occupancy query reports %d blocks per CU\n", per_cu);
        (void)hipGetLastError();
        grid = cus;
        if (cus != 256) { fprintf(stderr, "kernel_launch: built for 256 CUs (split-K of the context panel, hyena scratch), found %d; nothing launched\n", cus); grid = -1; return; }
    }
    if (grid < 0) return;
    if (hipMemsetAsync((char*)d_ws + WS_CTL, 0, CTL_BYTES, stream) != hipSuccess) { fprintf(stderr, "kernel_launch: memset failed\n"); return; }
    Args a{};
    for (int i = 0; i < 46; ++i) a.in[i] = (const float*)d_in[i];
    a.out = (float*)d_out; a.ws = (unsigned char*)d_ws;
    a.ph_lo = 0; a.ph_hi = NPH;
    hipLaunchKernelGGL(mk_fwd, dim3(grid), dim3(512), LDS_BYTES, stream, a);
    const hipError_t le = hipPeekAtLastError();
    if (le != hipSuccess) fprintf(stderr, "kernel_launch: launch failed: %s\n", hipGetErrorName(le));
}
```
